# Optimizing an MI355X kernel written in HIP

```python
import math
import jax, jax.numpy as jnp
from jax import lax
import numpy as np


D_MODEL = 2048
BATCH = 4
SEQ = 4096
DEPTH = 2
DEC_BATCH = 32
DEC_SEQ = 64
PAST_LEN = 2048

CHUNK = 64
Q_BLOCK = 128
EPS = 1e-6
NEG_INF = -1e30
ROPE_THETA = 10000.0
MLA_HEADS = 16
Q_LORA = 512
KV_LORA = 512
NOPE_DIM = 128
ROPE_DIM = 64
V_DIM = 128
MLA_QK_DIM = NOPE_DIM + ROPE_DIM
MLA_SCALE = MLA_QK_DIM ** -0.5
RET_HEADS = 8
RET_QK_DIM = 128
RET_V_DIM = 256
RET_QK_WIDTH = RET_HEADS * RET_QK_DIM
RET_V_WIDTH = RET_HEADS * RET_V_DIM
PEER_HEADS = 8
N_KEYS = 128
N_EXPERTS = N_KEYS * N_KEYS
PEER_QDIM = 256
PEER_HALF = PEER_QDIM // 2
PEER_TOPK = 16
PEER_BLOCK = 128
IN_SIZES = (Q_LORA, KV_LORA, ROPE_DIM, RET_QK_WIDTH, RET_QK_WIDTH, RET_V_WIDTH, RET_V_WIDTH, D_MODEL, D_MODEL)
IN_WIDTH = Q_LORA + KV_LORA + ROPE_DIM + 2 * RET_QK_WIDTH + 2 * RET_V_WIDTH + 2 * D_MODEL

kernel_name = 'hybrid_mla_retention_peer_stream'


def rmsnorm(x, g):
    xf = x.astype(jnp.float32)
    y = xf * lax.rsqrt(jnp.mean(xf * xf, axis=-1, keepdims=True) + EPS)
    return (y * g.astype(jnp.float32)).astype(x.dtype)


def ada_params(c, w, b):
    m = jax.nn.silu(c) @ w + b
    return m.reshape(c.shape[0], 6, D_MODEL)


def modulate(x, g, shift, scale):
    return rmsnorm(x, g) * (1.0 + scale[:, None, :]) + shift[:, None, :]


def rotary(x, pos):
    d = x.shape[-1]
    half = d // 2
    inv = ROPE_THETA ** (-jnp.arange(half, dtype=jnp.float32) * 2.0 / d)
    ang = pos.astype(jnp.float32)[:, None] * inv[None, :]
    cos = jnp.cos(ang)[None, :, None, :]
    sin = jnp.sin(ang)[None, :, None, :]
    xf = x.astype(jnp.float32)
    x1, x2 = xf[..., :half], xf[..., half:]
    return jnp.concatenate([x1 * cos - x2 * sin, x1 * sin + x2 * cos], axis=-1).astype(x.dtype)


def mla_prompt(q_nope, q_rope, ckv, krope, w_ukv):
    B, S = q_nope.shape[:2]
    kv = jnp.einsum('bsc,chd->bshd', ckv, w_ukv)
    k_nope, v = kv[..., :NOPE_DIM], kv[..., NOPE_DIM:]
    outs = []
    for q0 in range(0, S, Q_BLOCK):
        kend = q0 + Q_BLOCK
        s = (jnp.einsum('bqhd,bkhd->bhqk', q_nope[:, q0:kend], k_nope[:, :kend])
             + jnp.einsum('bqhd,bkd->bhqk', q_rope[:, q0:kend], krope[:, :kend]))
        s = s.astype(jnp.float32) * MLA_SCALE
        qpos = jnp.arange(q0, kend)
        kpos = jnp.arange(kend)
        mask = (kpos[None, :] // CHUNK) <= (qpos[:, None] // CHUNK)
        p = jax.nn.softmax(jnp.where(mask[None, None], s, NEG_INF), axis=-1).astype(v.dtype)
        outs.append(jnp.einsum('bhqk,bkhd->bqhd', p, v[:, :kend]))
    return jnp.concatenate(outs, axis=1)


def mla_sample(q_nope, q_rope, ckv_all, krope_all, w_ukv):
    w_uk = w_ukv[..., :NOPE_DIM]
    w_uv = w_ukv[..., NOPE_DIM:]
    q_lat = jnp.einsum('bqhd,chd->bqhc', q_nope, w_uk)
    s = (jnp.einsum('bqhc,bkc->bhqk', q_lat, ckv_all)
         + jnp.einsum('bqhd,bkd->bhqk', q_rope, krope_all))
    p = jax.nn.softmax(s.astype(jnp.float32) * MLA_SCALE, axis=-1).astype(ckv_all.dtype)
    o_lat = jnp.einsum('bhqk,bkc->bqhc', p, ckv_all)
    return jnp.einsum('bqhc,chd->bqhd', o_lat, w_uv)


def ret_log_gamma():
    return jnp.log1p(-(2.0 ** (-5.0 - jnp.arange(RET_HEADS, dtype=jnp.float32))))


def retention_chunk(q, k, v, state):
    L = q.shape[1]
    lg = ret_log_gamma()
    idx = jnp.arange(L, dtype=jnp.float32)
    diff = idx[:, None] - idx[None, :]
    dmask = jnp.where(diff[None] >= 0, jnp.exp(jnp.maximum(diff, 0.0)[None] * lg[:, None, None]), 0.0)
    inner = jnp.einsum('bqhd,bkhd->bhqk', q, k) * dmask[None]
    o = jnp.einsum('bhqk,bkhe->bqhe', inner, v)
    q_decay = jnp.exp((idx + 1.0)[:, None] * lg[None, :])
    o = o + jnp.einsum('bqhd,bhde->bqhe', q * q_decay[None, :, :, None], state)
    k_decay = jnp.exp((L - 1.0 - idx)[:, None] * lg[None, :])
    new_state = (state * jnp.exp(L * lg)[None, :, None, None]
                 + jnp.einsum('bkhd,bkhe->bhde', k * k_decay[None, :, :, None], v))
    return o, new_state


def retention_prompt(q, k, v):
    B, T = q.shape[:2]
    n_chunks = T // CHUNK

    def chunks(a):
        return jnp.swapaxes(a.reshape(B, n_chunks, CHUNK, *a.shape[2:]), 0, 1)

    def step(state, qkv):
        o, state = retention_chunk(*qkv, state)
        return state, o

    state0 = jnp.zeros((B, RET_HEADS, RET_QK_DIM, RET_V_DIM), jnp.float32)
    state, o = lax.scan(step, state0, (chunks(q), chunks(k), chunks(v)))
    return jnp.swapaxes(o, 0, 1).reshape(B, T, RET_HEADS, RET_V_DIM), state


def head_groupnorm(o):
    mu = jnp.mean(o, axis=-1, keepdims=True)
    var = jnp.mean(jnp.square(o - mu), axis=-1, keepdims=True)
    return (o - mu) * lax.rsqrt(var + EPS)


def token_mixer(h, pos, ckv_past, krope_past, ret_state, w_in, g_q, w_uq, g_kv, w_ukv, w_a, w_b, w_o):
    B, T, _ = h.shape
    split_at = np.cumsum(IN_SIZES)[:-1].tolist()
    cq, ckv, kr, rq, rk, rv, rg, ga, gb = jnp.split(h @ w_in, split_at, axis=-1)
    q = (rmsnorm(cq, g_q) @ w_uq).reshape(B, T, MLA_HEADS, MLA_QK_DIM)
    q_nope = q[..., :NOPE_DIM]
    q_rope = rotary(q[..., NOPE_DIM:], pos)
    ckv = rmsnorm(ckv, g_kv)
    kr = rotary(kr[:, :, None, :], pos)[:, :, 0, :]
    if ckv_past is None:
        o_a = mla_prompt(q_nope, q_rope, ckv, kr, w_ukv)
    else:
        o_a = mla_sample(q_nope, q_rope, jnp.concatenate([ckv_past, ckv], axis=1),
                         jnp.concatenate([krope_past, kr], axis=1), w_ukv)
    y_a = o_a.reshape(B, T, MLA_HEADS * V_DIM) @ w_a
    f32 = jnp.float32
    rq = rotary(rq.reshape(B, T, RET_HEADS, RET_QK_DIM), pos).astype(f32)
    rk = rotary(rk.reshape(B, T, RET_HEADS, RET_QK_DIM), pos).astype(f32) * (RET_QK_DIM ** -0.5)
    rv = rv.reshape(B, T, RET_HEADS, RET_V_DIM).astype(f32)
    if ret_state is None:
        o_b, new_state = retention_prompt(rq, rk, rv)
    else:
        o_b, new_state = retention_chunk(rq, rk, rv, ret_state.astype(f32))
    o_b = head_groupnorm(o_b).reshape(B, T, RET_V_WIDTH)
    y_b = (jax.nn.silu(rg.astype(f32)) * o_b).astype(h.dtype) @ w_b
    mixed = jax.nn.sigmoid(ga) * y_a + jax.nn.sigmoid(gb) * y_b
    return mixed @ w_o, ckv, kr, new_state.astype(h.dtype)


def peer(h, w_pq, k1, k2, u_emb, v_emb):
    B, T, D = h.shape
    x = h.reshape(B * T, D)
    n = x.shape[0]
    n_pad = (-n) % PEER_BLOCK
    blocks = jnp.pad(x, ((0, n_pad), (0, 0))).reshape(-1, PEER_BLOCK, D)

    def block_fn(xb):
        q = (xb @ w_pq).reshape(PEER_BLOCK, PEER_HEADS, 2, PEER_HALF)
        s1 = jnp.einsum('thd,kd->thk', q[:, :, 0], k1).astype(jnp.float32)
        s2 = jnp.einsum('thd,kd->thk', q[:, :, 1], k2).astype(jnp.float32)
        v1, i1 = lax.top_k(s1, PEER_TOPK)
        v2, i2 = lax.top_k(s2, PEER_TOPK)
        cand = (v1[..., :, None] + v2[..., None, :]).reshape(PEER_BLOCK, PEER_HEADS, PEER_TOPK * PEER_TOPK)
        cand_idx = (i1[..., :, None] * N_KEYS + i2[..., None, :]).reshape(PEER_BLOCK, PEER_HEADS, PEER_TOPK * PEER_TOPK)
        best, sel = lax.top_k(cand, PEER_TOPK)
        eidx = jnp.take_along_axis(cand_idx, sel, axis=-1)
        g = jax.nn.softmax(best, axis=-1).astype(xb.dtype)
        act = jax.nn.gelu(jnp.einsum('thkd,td->thk', u_emb[eidx], xb), approximate=False)
        return jnp.einsum('thk,thkd->td', g * act, v_emb[eidx])

    out = lax.map(block_fn, blocks).reshape(-1, D)[:n]
    return out.reshape(B, T, D)


def setup_inputs(seed: int = 0) -> dict:
    key = jax.random.key(seed)
    ks = jax.random.split(key, 32)
    f32 = jnp.float32

    def nrm(k, shape, scale):
        return jax.random.normal(k, shape, f32) * scale

    def gain(k, shape):
        return 1.0 + 0.02 * jax.random.normal(k, shape, f32)

    return {
        'x_prompt': nrm(ks[0], (BATCH, SEQ, D_MODEL), 1.0),
        'x_sample': nrm(ks[1], (DEC_BATCH, DEC_SEQ, D_MODEL), 1.0),
        'c_prompt': nrm(ks[2], (BATCH, D_MODEL), 1.0),
        'c_sample': nrm(ks[3], (DEC_BATCH, D_MODEL), 1.0),
        'cache_ckv': nrm(ks[4], (DEPTH, DEC_BATCH, PAST_LEN, KV_LORA), 1.0),
        'cache_krope': nrm(ks[5], (DEPTH, DEC_BATCH, PAST_LEN, ROPE_DIM), 1.0),
        'state_ret': nrm(ks[6], (DEPTH, DEC_BATCH, RET_HEADS, RET_QK_DIM, RET_V_DIM), 1.0),
        'w_ada': nrm(ks[7], (DEPTH, D_MODEL, 6 * D_MODEL), 0.5 * D_MODEL ** -0.5),
        'b_ada': nrm(ks[8], (DEPTH, 6 * D_MODEL), 0.01),
        'g_mix': gain(ks[9], (DEPTH, D_MODEL)),
        'g_ffn': gain(ks[10], (DEPTH, D_MODEL)),
        'w_in': nrm(ks[11], (DEPTH, D_MODEL, IN_WIDTH), D_MODEL ** -0.5),
        'g_q': gain(ks[12], (DEPTH, Q_LORA)),
        'w_uq': nrm(ks[13], (DEPTH, Q_LORA, MLA_HEADS * MLA_QK_DIM), Q_LORA ** -0.5),
        'g_kv': gain(ks[14], (DEPTH, KV_LORA)),
        'w_ukv': nrm(ks[15], (DEPTH, KV_LORA, MLA_HEADS, NOPE_DIM + V_DIM), KV_LORA ** -0.5),
        'w_a': nrm(ks[16], (DEPTH, MLA_HEADS * V_DIM, D_MODEL), (MLA_HEADS * V_DIM) ** -0.5),
        'w_b': nrm(ks[17], (DEPTH, RET_V_WIDTH, D_MODEL), RET_V_WIDTH ** -0.5),
        'w_o': nrm(ks[18], (DEPTH, D_MODEL, D_MODEL), D_MODEL ** -0.5),
        'w_pq': nrm(ks[19], (DEPTH, D_MODEL, PEER_HEADS * PEER_QDIM), D_MODEL ** -0.5),
        'peer_k1': nrm(ks[20], (DEPTH, N_KEYS, PEER_HALF), PEER_HALF ** -0.5),
        'peer_k2': nrm(ks[21], (DEPTH, N_KEYS, PEER_HALF), PEER_HALF ** -0.5),
        'peer_u': nrm(ks[22], (DEPTH, N_EXPERTS, D_MODEL), D_MODEL ** -0.5),
        'peer_v': nrm(ks[23], (DEPTH, N_EXPERTS, D_MODEL), 0.25),
        'g_final': gain(ks[24], (D_MODEL,)),
    }


def reference(x_prompt, x_sample, c_prompt, c_sample, cache_ckv, cache_krope, state_ret,
              w_ada, b_ada, g_mix, g_ffn, w_in, g_q, w_uq, g_kv, w_ukv, w_a, w_b, w_o,
              w_pq, peer_k1, peer_k2, peer_u, peer_v, g_final):
    pos_p = jnp.arange(x_prompt.shape[1], dtype=jnp.int32)
    pos_s = cache_ckv.shape[2] + jnp.arange(x_sample.shape[1], dtype=jnp.int32)
    xp, xs = x_prompt, x_sample
    ckv_p, kr_p, st_p, ckv_s, kr_s, st_s = [], [], [], [], [], []
    for l in range(DEPTH):
        mix_w = (w_in[l], g_q[l], w_uq[l], g_kv[l], w_ukv[l], w_a[l], w_b[l], w_o[l])
        mp = ada_params(c_prompt, w_ada[l], b_ada[l])
        ms = ada_params(c_sample, w_ada[l], b_ada[l])
        yp, a1, a2, a3 = token_mixer(modulate(xp, g_mix[l], mp[:, 0], mp[:, 1]), pos_p, None, None, None, *mix_w)
        ys, b1, b2, b3 = token_mixer(modulate(xs, g_mix[l], ms[:, 0], ms[:, 1]), pos_s,
                                     cache_ckv[l], cache_krope[l], state_ret[l], *mix_w)
        xp = xp + mp[:, 2][:, None, :] * yp
        xs = xs + ms[:, 2][:, None, :] * ys
        ckv_p.append(a1); kr_p.append(a2); st_p.append(a3)
        ckv_s.append(b1); kr_s.append(b2); st_s.append(b3)
        peer_w = (w_pq[l], peer_k1[l], peer_k2[l], peer_u[l], peer_v[l])
        xp = xp + mp[:, 5][:, None, :] * peer(modulate(xp, g_ffn[l], mp[:, 3], mp[:, 4]), *peer_w)
        xs = xs + ms[:, 5][:, None, :] * peer(modulate(xs, g_ffn[l], ms[:, 3], ms[:, 4]), *peer_w)
    y_prompt = rmsnorm(xp, g_final)
    y_sample = rmsnorm(xs, g_final)
    return (y_prompt, y_sample,
            jnp.stack(ckv_p, 0), jnp.stack(kr_p, 0), jnp.stack(st_p, 0),
            jnp.stack(ckv_s, 0), jnp.stack(kr_s, 0), jnp.stack(st_s, 0))
```

```cpp
#include <hip/hip_runtime.h>
#include <cstdio>
#include <cstdint>
#include <cmath>

#define LAS __attribute__((address_space(3)))
typedef unsigned short bf16_t;
typedef short bf16x8 __attribute__((ext_vector_type(8)));
typedef float f32x4 __attribute__((ext_vector_type(4)));
typedef float f32x2 __attribute__((ext_vector_type(2)));
typedef float f32x16 __attribute__((ext_vector_type(16)));
typedef unsigned u32x4 __attribute__((ext_vector_type(4)));
typedef unsigned u32x2 __attribute__((ext_vector_type(2)));
typedef short s16x4 __attribute__((ext_vector_type(4)));

constexpr int DM = 2048, NB = 4, SEQ = 4096, DEPTH = 2, DB = 32, DS = 64, PAST = 2048;
constexpr int TP = NB * SEQ, TS = DB * DS, T = TP + TS;
constexpr int NCOND = NB + DB;
constexpr int QLORA = 512, KVLORA = 512, ROPE = 64, NOPE = 128, VD = 128, MH = 16, QKD = 192;
constexpr int RH = 8, RQK = 128, RV = 256;
constexpr int PH = 8, NKEYS = 128, NEXP = 16384, PTOPK = 16;
constexpr int INW = 11328, INWP = 11520;
constexpr int C_CQ = 0, C_CKV = 512, C_KR = 1024, C_RQ = 1088, C_RK = 2112, C_RV = 3136, C_RG = 5184, C_GA = 7232, C_GB = 9280;
constexpr int KALL = PAST + DS;
constexpr int KPAD = 2304;
constexpr int QLD = 640;
constexpr float EPS = 1e-6f;
constexpr float MLA_SCALE = 0.07216878364870322f;

constexpr long O_Y = 0;
constexpr long O_CKVP = (long)T * DM;
constexpr long O_KRP = O_CKVP + 2L * TP * 512;
constexpr long O_RETP = O_KRP + 2L * TP * 64;
constexpr long O_CKVS = O_RETP + 2L * NB * RH * RQK * RV;
constexpr long O_KRS = O_CKVS + 2L * TS * 512;
constexpr long O_RETS = O_KRS + 2L * TS * 64;
constexpr long O_END = O_RETS + 2L * DB * RH * RQK * RV;

constexpr size_t al256(size_t x) { return (x + 255) / 256 * 256; }
constexpr size_t WS_CTL = 0;
constexpr size_t CTL_BYTES = 65536;
constexpr size_t WS_TAB64 = WS_CTL + CTL_BYTES;
constexpr size_t WS_TAB128 = WS_TAB64 + 4096UL * 32 * 2 * 4;
constexpr size_t WS_ADA = WS_TAB128 + 4096UL * 64 * 2 * 4;
constexpr size_t WS_ADAP = WS_ADA + 2UL * NCOND * 12288 * 4;
constexpr size_t WS_WIN = WS_ADAP + 8UL * 2 * NCOND * 12288 * 4;
constexpr size_t WS_WUQ = WS_WIN + 2UL * INWP * DM * 2;
constexpr size_t WS_WUKV = WS_WUQ + 2UL * 3072 * 512 * 2;
constexpr size_t WS_WUK = WS_WUKV + 2UL * 4096 * 512 * 2;
constexpr size_t WS_WA = WS_WUK + 2UL * 16 * 512 * 256 * 2;
constexpr size_t WS_WB = WS_WA + 2UL * DM * DM * 2;
constexpr size_t WS_WO = WS_WB + 2UL * DM * DM * 2;
constexpr size_t WS_WPQ = WS_WO + 2UL * DM * DM * 2;
constexpr size_t WS_PK1 = WS_WPQ + 2UL * DM * DM * 2;
constexpr size_t WS_PK2 = WS_PK1 + 2UL * 128 * 128 * 2;
constexpr size_t WS_H = WS_PK2 + 2UL * 128 * 128 * 2;
constexpr size_t WS_Y = WS_H + (size_t)T * DM * 2;
constexpr size_t WS_CQN = WS_Y + (size_t)T * INWP * 2;
constexpr size_t WS_CKVNP = WS_CQN + (size_t)T * 512 * 2;
constexpr size_t WS_KRP = WS_CKVNP + (size_t)TP * 512 * 2;
constexpr size_t WS_Q = WS_KRP + (size_t)TP * 64 * 2;
constexpr size_t WS_YA = WS_Q;
constexpr size_t WS_KV = WS_Q + (size_t)T * 3072 * 2 + 4096;
constexpr size_t WS_SP = WS_KV;
constexpr size_t WS_MIX = WS_KV;
constexpr size_t WS_OA = WS_KV + 32UL * 1024 * KPAD * 2;
constexpr size_t WS_QP = WS_OA;
constexpr size_t WS_CKA = WS_OA + (size_t)T * DM * 2;
constexpr size_t WS_CKT = WS_CKA + 32UL * KPAD * QLD * 2;
constexpr size_t WS_QL = WS_CKT + 32UL * 512 * KPAD * 2;
constexpr size_t WS_OL = WS_QL + 32UL * 1024 * QLD * 2;
constexpr size_t WS_OB = WS_OL + 16UL * 2048 * 512 * 2;
constexpr size_t WS_BG = WS_OB + (size_t)T * DM * 2;
constexpr size_t WS_PIDX = WS_BG + (size_t)T * DM * 2;
constexpr size_t WS_PW = WS_PIDX + (size_t)T * 128 * 4;
constexpr size_t WS_PU = WS_PW + (size_t)T * 128 * 4;
constexpr size_t WS_PV = WS_PU + (size_t)NEXP * DM;
constexpr size_t WS_PSU = WS_PV + (size_t)NEXP * DM;
constexpr size_t WS_PSV = WS_PSU + (size_t)NEXP * 4;
constexpr size_t WS_END = WS_PSV + (size_t)NEXP * 4;
static_assert((size_t)TP * 4096 * 2 <= 32UL * 1024 * KPAD * 2, "KV fits in the SP region");
static_assert(WS_END <= 1590000000UL, "workspace map too large");
static_assert(WS_WIN % 256 == 0 && WS_H % 256 == 0 && WS_Y % 256 == 0 && WS_Q % 256 == 0 && WS_KV % 256 == 0 && WS_CKA % 256 == 0, "alignment");

constexpr int LDS_BYTES = 147456;
constexpr int LDS_BARW = LDS_BYTES - 32;
constexpr size_t CTL_RANK = 16384;
constexpr size_t WS_DOTP = WS_Q;
constexpr size_t WS_ACT = WS_DOTP + 8UL * T * 128 * 4;
constexpr size_t WS_PIDXT = WS_ACT + (size_t)T * 128 * 4;
static_assert(WS_PIDXT + (size_t)T * 128 * 4 <= WS_KV, "PEER scratch fits in the Q region");

struct Params {
    const float *x_prompt, *x_sample, *c_prompt, *c_sample, *cache_ckv, *cache_krope, *state_ret, *w_ada, *b_ada, *g_mix, *g_ffn, *w_in, *g_q, *w_uq, *g_kv, *w_ukv,
                *w_a, *w_b, *w_o, *w_pq, *peer_k1, *peer_k2, *peer_u, *peer_v, *g_final;
    float* out; unsigned char* ws;
    float lg[8];
    int grid; int pad_;
};

typedef const __attribute__((address_space(4))) Params KParams;
__device__ __forceinline__ KParams* okarg() {
    const uintptr_t k = (uintptr_t)__builtin_amdgcn_kernarg_segment_ptr();
    unsigned lo = (unsigned)k, hi = (unsigned)(k >> 32);
    asm volatile("" : "+s"(lo), "+s"(hi)); return (KParams*)(((uintptr_t)hi << 32) | lo); }
#define KP (*okarg())
__device__ __forceinline__ int ogrid() { return KP.grid; }
__device__ __forceinline__ int obid() { int b = (int)blockIdx.x; asm volatile("" : "+s"(b) :: "memory"); return b; }
__device__ __forceinline__ int otid() { int t = (int)threadIdx.x; asm volatile("" : "+v"(t) :: "memory"); return t; }
template <class P> __device__ __forceinline__ P* gp(P* p) { return (P*)(__attribute__((address_space(1))) P*)(uintptr_t)p; }
template <class P> __device__ __forceinline__ P* optr(P* p) {
    unsigned lo = __builtin_amdgcn_readfirstlane((unsigned)(uintptr_t)p), hi = __builtin_amdgcn_readfirstlane((unsigned)((uintptr_t)p >> 32));
    asm volatile("" : "+s"(lo), "+s"(hi)); return gp((P*)(((uintptr_t)hi << 32) | lo)); }
typedef __bf16 bf16v2_t __attribute__((ext_vector_type(2)));
__device__ __forceinline__ unsigned cvt_pk_bf16(float lo, float hi) { f32x2 v = {lo, hi}; bf16v2_t r = __builtin_convertvector(v, bf16v2_t); return __builtin_bit_cast(unsigned, r); }
__device__ __forceinline__ bf16_t f2bf(float f) { return (bf16_t)(cvt_pk_bf16(f, 0.f) & 0xffffu); }
__device__ __forceinline__ float bf2f(bf16_t b) { return __uint_as_float(((unsigned)b) << 16); }
__device__ __forceinline__ float bflo(unsigned w) { return __uint_as_float(w << 16); }
__device__ __forceinline__ float bfhi(unsigned w) { return __uint_as_float(w & 0xffff0000u); }
__device__ __forceinline__ void unpack8(const u32x4 w, float (&f)[8]) { f[0] = bflo(w.x); f[1] = bfhi(w.x); f[2] = bflo(w.y); f[3] = bfhi(w.y); f[4] = bflo(w.z); f[5] = bfhi(w.z); f[6] = bflo(w.w); f[7] = bfhi(w.w); }
__device__ __forceinline__ u32x4 pack8(const float (&f)[8]) { u32x4 w; w.x = cvt_pk_bf16(f[0], f[1]); w.y = cvt_pk_bf16(f[2], f[3]); w.z = cvt_pk_bf16(f[4], f[5]); w.w = cvt_pk_bf16(f[6], f[7]); return w; }
template <int K> __device__ __forceinline__ float sx(float v) {
    if constexpr (K == 32) { const auto rr = __builtin_amdgcn_permlane32_swap(__float_as_uint(v), __float_as_uint(v), false, false); return __uint_as_float((otid() & 32) ? rr[0] : rr[1]); }
    else return __int_as_float(__builtin_amdgcn_ds_swizzle(__float_as_int(v), (K << 10) | 0x1F));
}
__device__ __forceinline__ float wave_sum(float v) { v += sx<32>(v); v += sx<16>(v); v += sx<8>(v); v += sx<4>(v); v += sx<2>(v); v += sx<1>(v); return v; }
__device__ __forceinline__ float wave_max(float v) { v = fmaxf(v, sx<32>(v)); v = fmaxf(v, sx<16>(v)); v = fmaxf(v, sx<8>(v)); v = fmaxf(v, sx<4>(v)); v = fmaxf(v, sx<2>(v)); v = fmaxf(v, sx<1>(v)); return v; }
__device__ __forceinline__ float sigmoidf_(float x) { return 1.0f / (1.0f + __expf(-x)); }
__device__ __forceinline__ float siluf_(float x) { return x / (1.0f + __expf(-x)); }
__device__ __forceinline__ int cond_row(int t) { return t < TP ? (t >> 12) : NB + ((t - TP) >> 6); }
__device__ __forceinline__ int tok_pos(int t) { return t < TP ? (t & 4095) : PAST + ((t - TP) & 63); }

#define XB_TMO      128
#define XB_XCNT(j)  (256  + 64 * (j))
#define XB_XSUB(j)  (1280 + 64 * (j))
#define XB_XGEN(j)  (2304 + 64 * (j))
#define XB_TOP      3328
#define XB_TOPGEN   3392
#define XCD_BAR_WORDS 3456
#define XB_SPIN_CAP (1u << 22)
__device__ __forceinline__ unsigned xb_ld(unsigned* p)              { return __hip_atomic_load(p, __ATOMIC_RELAXED, __HIP_MEMORY_SCOPE_AGENT); }
__device__ __forceinline__ unsigned xb_add(unsigned* p, unsigned v) { return __hip_atomic_fetch_add(p, v, __ATOMIC_RELAXED, __HIP_MEMORY_SCOPE_AGENT); }
__device__ __forceinline__ unsigned xb_xcc_id() { return (unsigned)__builtin_amdgcn_s_getreg((3 << 11) | 20) & 0xFu; }
#define XB_SPIN(cond, bar) do { unsigned _sp = 0; while (cond) { __builtin_amdgcn_s_sleep(1); \
    if ((++_sp & 255u) == 0u) { if (xb_ld(&(bar)[XB_TMO])) break; if (_sp > XB_SPIN_CAP) { atomicAdd(&(bar)[XB_TMO], 1u); break; } } } } while (0)
struct XcdBarrier { unsigned* bar; unsigned x; volatile LAS unsigned* st; };
__device__ __forceinline__ XcdBarrier xcd_barrier_post(unsigned* bar, volatile LAS unsigned* st) {
    XcdBarrier b; b.bar = bar; b.x = xb_xcc_id(); b.st = st;
    if (threadIdx.x == 0) (void)xb_add(&bar[XB_XCNT(b.x)], 1u);
    return b;
}
__device__ __forceinline__ void xcd_barrier_complete(unsigned* bar, unsigned x, unsigned& nloc, unsigned& nx) {
    const unsigned G = (unsigned)KP.grid;
    unsigned sum, cnt, mine, sp = 0u;
    for (;;) {
        sum = 0u; cnt = 0u; mine = 0u;
#pragma unroll
        for (unsigned j = 0; j < 16; ++j) { const unsigned c = xb_ld(&bar[XB_XCNT(j)]); sum += c; cnt += (c > 0u) ? 1u : 0u; mine = (j == x) ? c : mine; }
        if (sum == G) break;
        __builtin_amdgcn_s_sleep(1);
        if ((++sp & 255u) == 0u) { if (xb_ld(&bar[XB_TMO])) break; if (sp > XB_SPIN_CAP) { atomicAdd(&bar[XB_TMO], 1u); break; } }
    }
    nloc = mine > 0u ? mine : 1u; nx = cnt > 0u ? cnt : 1u;
}
__device__ __forceinline__ void xcd_barrier(const XcdBarrier& b) {
    asm volatile("s_waitcnt vmcnt(0)" ::: "memory");
    __syncthreads();
    if (otid() == 0) {
        unsigned* bar = (unsigned*)(gp(KP.ws) + WS_CTL);
        unsigned bx = xb_xcc_id(); asm volatile("" : "+s"(bx));
        __builtin_amdgcn_s_waitcnt(0);
        unsigned nloc = b.st[0], nx = b.st[1];
        if (nloc == 0u) { xcd_barrier_complete(bar, bx, nloc, nx); b.st[0] = nloc; b.st[1] = nx; }
        const unsigned old = xb_add(&bar[XB_XSUB(bx)], 1u);
        const unsigned gen = old / nloc;
        if (old + 1u == (gen + 1u) * nloc) {
            __builtin_amdgcn_fence(__ATOMIC_RELEASE, "agent");
            asm volatile("s_waitcnt vmcnt(0)" ::: "memory");
            const unsigned og = xb_add(&bar[XB_TOP], 1u);
            const unsigned tg = og / nx;
            if (og + 1u == (tg + 1u) * nx) xb_add(&bar[XB_TOPGEN], 1u);
            else XB_SPIN(xb_ld(&bar[XB_TOPGEN]) == tg, bar);
            __builtin_amdgcn_fence(__ATOMIC_ACQUIRE, "agent");
            xb_add(&bar[XB_XGEN(bx)], 1u);
            asm volatile("s_waitcnt vmcnt(0)" ::: "memory");
        } else {
            XB_SPIN(xb_ld(&bar[XB_XGEN(bx)]) == gen, bar);
            __builtin_amdgcn_fence(__ATOMIC_ACQUIRE, "agent");
            asm volatile("s_waitcnt vmcnt(0)" ::: "memory");
        }
    }
    __syncthreads();
}
namespace pg8 {
constexpr int BM = 256, BK = 64, HALF = 128, HTB = HALF * BK * 2, STAGE_BYTES = 8 * HTB, NXCD = 8, WGM = 8;
__host__ __device__ __forceinline__ int lds_byte(int r, int c) { const int st = (r >> 4) * 2 + (c >> 5), rr = r & 15, cc = c & 31, ob = rr * 64 + cc * 2; return st * 1024 + (ob ^ (((ob >> 9) & 1) << 5)); }
__host__ __device__ __forceinline__ void stage_rc(int b, int& R, int& C) { const int st = b / 1024, sb = b % 1024, swz = sb ^ (((sb >> 9) & 1) << 5); R = (st >> 1) * 16 + swz / 64; C = (st & 1) * 32 + (swz % 64) / 2; }
__host__ __device__ __forceinline__ int perm32(int rho) { const int n = rho >> 4, i = rho & 15; return 8 * (i >> 2) + 4 * n + (i & 3); }

struct Unit { int pm, pn; long aoff, boff; int x0, x1; };
struct Gemm { const bf16_t* A; const bf16_t* Bt; int K; int lda, ldb; };

template <int MODE> struct Sched {
    int nM, nN, nwg, G, c; long lda, ldb;
    __device__ void init(int nM_, int nN_, int nwg_, long lda_, long ldb_) { nM = nM_; nN = nN_; nwg = nwg_; G = ogrid(); c = obid(); lda = lda_; ldb = ldb_; }
    __device__ bool next(int i, Unit& u) const {
        const long L = (long)i * G + c; if (L >= nwg) return false;
        int wgid = (int)L;
        if (MODE == 0) {
            { const int q = nwg / NXCD, r = nwg % NXCD, xcd = wgid % NXCD, off = wgid / NXCD; wgid = (xcd < r ? xcd * (q + 1) : r * (q + 1) + (xcd - r) * q) + off; }
            const int nig = WGM * nN, gid = wgid / nig, fm = gid * WGM, gsz = (nM - fm) < WGM ? (nM - fm) : WGM;
            u.pm = fm + ((wgid % nig) % gsz); u.pn = (wgid % nig) / gsz; u.x0 = 0; u.x1 = 0;
            u.aoff = (long)u.pm * 256 * lda * 2; u.boff = (long)u.pn * 256 * ldb * 2;
        } else if (MODE == 1) {
            const int h = wgid >> 4, rem = wgid & 15, rt = rem >> 1, pn = rem & 1;
            u.pm = rt; u.pn = pn; u.x0 = h; u.x1 = rt;
            u.aoff = ((long)(TP + 256 * rt) * 3072 + h * 192) * 2; u.boff = ((long)(h * 512 + 256 * pn) * 256) * 2;
        } else if (MODE == 2) {
            const int b = wgid / 36, rem = wgid % 36, pm = rem / 9, pn = rem % 9;
            u.pm = pm; u.pn = pn; u.x0 = b; u.x1 = 0;
            u.aoff = ((long)(b * 1024 + 256 * pm) * QLD) * 2; u.boff = ((long)(b * KPAD + 256 * pn) * QLD) * 2;
        } else if (MODE == 3) {
            const int b = wgid >> 3, pm = (wgid & 7) >> 1, pn = wgid & 1;
            u.pm = pm; u.pn = pn; u.x0 = b; u.x1 = 0;
            u.aoff = ((long)(b * 1024 + 256 * pm) * KPAD) * 2; u.boff = ((long)(b * 512 + 256 * pn) * KPAD) * 2;
        } else {
            const int h = wgid >> 3, rt = wgid & 7;
            u.pm = rt; u.pn = 0; u.x0 = h; u.x1 = rt;
            u.aoff = ((long)(h * 2048 + 256 * rt) * 512) * 2; u.boff = ((long)(h * 256) * 512) * 2;
        }
        return true;
    }
};

template <class Epi, class SchedT>
__device__ __forceinline__ void gemm_phase(LAS unsigned char* lds, const Gemm g, const SchedT& S, const Epi& E) {
    const int tid = otid(), wid = __builtin_amdgcn_readfirstlane(tid >> 6), lane = tid & 63, wr = wid >> 2, wc = wid & 3, fr = lane & 15, fq = lane >> 4;
    const int K = g.K, nt = K / BK;
    unsigned voffA[2], voffB[2];
#pragma unroll
    for (int i = 0; i < 2; ++i) { int R, C; stage_rc(tid * 16 + i * 8192, R, C); const int Rb = Epi::PERM ? ((R & ~31) + perm32(R & 31)) : R;
        voffA[i] = (unsigned)(R * g.lda + C) * 2u; voffB[i] = (unsigned)(Rb * g.ldb + C) * 2u; }
    const size_t kstep = (size_t)(BK * 2);
    const size_t hstepA = (size_t)HALF * g.lda * 2, hstepB = (size_t)HALF * g.ldb * 2;
    const unsigned ldsw = (unsigned)wid * 1024u;
    const int aoff = lds_byte(wr * 64 + fr, fq * 8), boff = lds_byte(wc * 32 + fr, fq * 8);
#define PG8_SA(b, h) (((b) * 2 + (h)) * HTB)
#define PG8_SB(b, h) ((4 + (b) * 2 + (h)) * HTB)
#define PG8_STAGE(bufoff, gbase, voff) do { _Pragma("unroll") for (int _i = 0; _i < 2; ++_i) \
        __builtin_amdgcn_global_load_lds((const unsigned*)((const char*)(gbase) + (voff)[_i]), (LAS unsigned*)(lds + (bufoff) + ldsw + _i * 8192), 16, 0, 0); } while (0)
#define PG8_LDA(dst, b, h) do { _Pragma("unroll") for (int m = 0; m < 4; ++m) _Pragma("unroll") for (int k = 0; k < 2; ++k) dst[m][k] = *(const LAS bf16x8*)(lds + PG8_SA(b, h) + aoff + m * 2048 + k * 1024); } while (0)
#define PG8_LDB(dst, b, h) do { _Pragma("unroll") for (int n = 0; n < 2; ++n) _Pragma("unroll") for (int k = 0; k < 2; ++k) dst[n][k] = *(const LAS bf16x8*)(lds + PG8_SB(b, h) + boff + n * 2048 + k * 1024); } while (0)
#define PG8_MMA(ai, bj, At, Bt) do { __builtin_amdgcn_s_setprio(1); _Pragma("unroll") for (int m = 0; m < 4; ++m) _Pragma("unroll") for (int n = 0; n < 2; ++n) _Pragma("unroll") for (int k = 0; k < 2; ++k) \
        acc[ai][bj][m][n] = __builtin_amdgcn_mfma_f32_16x16x32_bf16(Bt[n][k], At[m][k], acc[ai][bj][m][n], 0, 0, 0); __builtin_amdgcn_s_setprio(0); } while (0)
#define PG8_WAIT_V(n) asm volatile("s_waitcnt vmcnt(" #n ")" ::: "memory")
#define PG8_WAIT_L(n) asm volatile("s_waitcnt lgkmcnt(" #n ")" ::: "memory")
#define PG8_BAR __builtin_amdgcn_s_barrier()
#define PG8_SCHED __builtin_amdgcn_sched_barrier(0)
    Unit cur, nxt; int ui = 0;
    if (!S.next(0, cur)) return;
    f32x4 acc[2][2][4][2];
#pragma unroll
    for (int a = 0; a < 2; ++a)
#pragma unroll
        for (int b = 0; b < 2; ++b)
#pragma unroll
            for (int m = 0; m < 4; ++m)
#pragma unroll
                for (int n = 0; n < 2; ++n) acc[a][b][m][n] = (f32x4){0.f, 0.f, 0.f, 0.f};
    bf16x8 At[4][2], B0[2][2], B1[2][2];
    const char* cA = (const char*)g.A + cur.aoff; const char* cB = (const char*)g.Bt + cur.boff;
    PG8_STAGE(PG8_SB(0, 0), cB, voffB); PG8_STAGE(PG8_SA(0, 0), cA, voffA); PG8_STAGE(PG8_SB(0, 1), cB + hstepB, voffB); PG8_STAGE(PG8_SA(0, 1), cA + hstepA, voffA);
    if (wr == 1) PG8_BAR;
    PG8_WAIT_V(4); PG8_BAR;
    PG8_STAGE(PG8_SB(1, 0), cB + kstep, voffB); PG8_STAGE(PG8_SA(1, 0), cA + kstep, voffA); PG8_STAGE(PG8_SB(1, 1), cB + hstepB + kstep, voffB);
    PG8_WAIT_V(6); PG8_BAR;
    for (;;) {
        const bool has_next = S.next(ui + 1, nxt);
        const char* nA = has_next ? (const char*)g.A + nxt.aoff : cA; const char* nB = has_next ? (const char*)g.Bt + nxt.boff : cB;
        for (int t = 0; t < nt; t += 2) {
            const bool last = (t == nt - 2);
            const char* a1 = cA + (size_t)(t + 1) * kstep;
            const char* a2 = last ? nA : cA + (size_t)(t + 2) * kstep; const char* b2 = last ? nB : cB + (size_t)(t + 2) * kstep;
            const char* a3 = a2 + kstep; const char* b3 = b2 + kstep;
            PG8_LDB(B0, 0, 0); PG8_SCHED; PG8_LDA(At, 0, 0); PG8_STAGE(PG8_SA(1, 1), a1 + hstepA, voffA);
            PG8_WAIT_L(8); PG8_BAR; PG8_WAIT_L(0); PG8_MMA(0, 0, At, B0); PG8_BAR; PG8_SCHED;
            PG8_LDB(B1, 0, 1); PG8_STAGE(PG8_SB(0, 0), b2, voffB);
            PG8_BAR; PG8_WAIT_L(0); PG8_MMA(0, 1, At, B1); PG8_BAR;
            PG8_LDA(At, 0, 1); PG8_STAGE(PG8_SA(0, 0), a2, voffA);
            PG8_BAR; PG8_WAIT_L(0); PG8_MMA(1, 0, At, B0); PG8_BAR; PG8_SCHED;
            PG8_STAGE(PG8_SB(0, 1), b2 + hstepB, voffB);
            PG8_WAIT_V(6); PG8_BAR; PG8_MMA(1, 1, At, B1); PG8_BAR;
            PG8_LDB(B0, 1, 0); PG8_SCHED; PG8_LDA(At, 1, 0); PG8_STAGE(PG8_SA(0, 1), a2 + hstepA, voffA);
            PG8_WAIT_L(8); PG8_BAR; PG8_WAIT_L(0); PG8_MMA(0, 0, At, B0); PG8_BAR; PG8_SCHED;
            PG8_LDB(B1, 1, 1); PG8_STAGE(PG8_SB(1, 0), b3, voffB);
            PG8_BAR; PG8_WAIT_L(0); PG8_MMA(0, 1, At, B1); PG8_BAR;
            PG8_LDA(At, 1, 1); PG8_STAGE(PG8_SA(1, 0), a3, voffA);
            PG8_BAR; PG8_WAIT_L(0); PG8_MMA(1, 0, At, B0); PG8_BAR; PG8_SCHED;
            PG8_STAGE(PG8_SB(1, 1), b3 + hstepB, voffB);
            PG8_WAIT_V(6); PG8_BAR; PG8_MMA(1, 1, At, B1); PG8_BAR;
        }
        E(acc, cur, wr, wc, fr, fq);
        if (!has_next) break;
#pragma unroll
        for (int a = 0; a < 2; ++a)
#pragma unroll
            for (int b = 0; b < 2; ++b)
#pragma unroll
                for (int m = 0; m < 4; ++m)
#pragma unroll
                    for (int n = 0; n < 2; ++n) acc[a][b][m][n] = (f32x4){0.f, 0.f, 0.f, 0.f};
        cur = nxt; cA = nA; cB = nB; ++ui;
    }
    PG8_WAIT_V(0);
    if (wr == 0) PG8_BAR;
    PG8_BAR;
#undef PG8_SA
#undef PG8_SB
#undef PG8_STAGE
#undef PG8_LDA
#undef PG8_LDB
#undef PG8_MMA
#undef PG8_WAIT_V
#undef PG8_WAIT_L
#undef PG8_BAR
#undef PG8_SCHED
}

struct EpiBf16 {
    static constexpr bool PERM = true;
    bf16_t* O; long ldc; long bstride;
    __device__ __forceinline__ void operator()(const f32x4 (&acc)[2][2][4][2], const Unit& u, int wr, int wc, int fr, int fq) const {
        bf16_t* base = O + (long)u.x0 * bstride + (long)(u.pm * BM + wr * 64 + fr) * ldc + u.pn * BM + wc * 32 + 8 * fq;
#pragma unroll
        for (int ai = 0; ai < 2; ++ai)
#pragma unroll
            for (int m = 0; m < 4; ++m) { bf16_t* rowp = base + (long)(ai * HALF + m * 16) * ldc;
#pragma unroll
                for (int bj = 0; bj < 2; ++bj) { const f32x4 v0 = acc[ai][bj][m][0], v1 = acc[ai][bj][m][1];
                    u32x4 w; w.x = cvt_pk_bf16(v0[0], v0[1]); w.y = cvt_pk_bf16(v0[2], v0[3]); w.z = cvt_pk_bf16(v1[0], v1[1]); w.w = cvt_pk_bf16(v1[2], v1[3]);
                    *(u32x4*)(rowp + bj * HALF) = w; } }
    }
};
template <int RMODE> struct EpiRowMap {
    static constexpr bool PERM = true;
    bf16_t* O;
    __device__ __forceinline__ void operator()(const f32x4 (&acc)[2][2][4][2], const Unit& u, int wr, int wc, int fr, int fq) const {
        const int col0 = u.pn * BM + wc * 32 + 8 * fq;
#pragma unroll
        for (int ai = 0; ai < 2; ++ai)
#pragma unroll
            for (int m = 0; m < 4; ++m) { const int r = ai * HALF + wr * 64 + m * 16 + fr; long drow; long ldc;
                if (RMODE == 1) { const int ts = 256 * u.x1 + r; drow = (long)(ts >> 6) * 1024 + u.x0 * 64 + (ts & 63); ldc = QLD; }
                else { const int qr = 256 * u.pm + r; drow = (long)(qr >> 6) * 2048 + u.x0 * 64 + (qr & 63); ldc = 512; }
                bf16_t* rowp = O + drow * ldc + col0;
#pragma unroll
                for (int bj = 0; bj < 2; ++bj) { const f32x4 v0 = acc[ai][bj][m][0], v1 = acc[ai][bj][m][1];
                    u32x4 w; w.x = cvt_pk_bf16(v0[0], v0[1]); w.y = cvt_pk_bf16(v0[2], v0[3]); w.z = cvt_pk_bf16(v1[0], v1[1]); w.w = cvt_pk_bf16(v1[2], v1[3]);
                    *(u32x4*)(rowp + bj * HALF) = w; } }
    }
};
struct EpiOV {
    static constexpr bool PERM = true;
    bf16_t* O;
    __device__ __forceinline__ void operator()(const f32x4 (&acc)[2][2][4][2], const Unit& u, int wr, int wc, int fr, int fq) const {
#pragma unroll
        for (int ai = 0; ai < 2; ++ai)
#pragma unroll
            for (int m = 0; m < 4; ++m) { const int r = ai * HALF + wr * 64 + m * 16 + fr;
                bf16_t* rowp = O + (long)(TP + 256 * u.x1 + r) * DM + u.x0 * 128 + wc * 32 + 8 * fq;
                const f32x4 v0 = acc[ai][1][m][0], v1 = acc[ai][1][m][1];
                u32x4 w; w.x = cvt_pk_bf16(v0[0], v0[1]); w.y = cvt_pk_bf16(v0[2], v0[3]); w.z = cvt_pk_bf16(v1[0], v1[1]); w.w = cvt_pk_bf16(v1[2], v1[3]);
                *(u32x4*)rowp = w; }
    }
};
struct EpiMix {
    static constexpr bool PERM = true;
    const bf16_t* Y; const bf16_t* YA; bf16_t* MIX;
    __device__ __forceinline__ void operator()(const f32x4 (&acc)[2][2][4][2], const Unit& u, int wr, int wc, int fr, int fq) const {
#pragma unroll
        for (int ai = 0; ai < 2; ++ai)
#pragma unroll
            for (int m = 0; m < 4; ++m) { const long t = (long)u.pm * BM + ai * HALF + wr * 64 + m * 16 + fr;
#pragma unroll
                for (int bj = 0; bj < 2; ++bj) { const int c = u.pn * BM + bj * HALF + wc * 32 + 8 * fq;
                    const u32x4 ga = *(const u32x4*)(Y + t * INWP + C_GA + c), gb = *(const u32x4*)(Y + t * INWP + C_GB + c), ya = *(const u32x4*)(YA + t * DM + c);
                    float fa[8], fb[8], fy[8], o[8]; unpack8(ga, fa); unpack8(gb, fb); unpack8(ya, fy);
                    const f32x4 v0 = acc[ai][bj][m][0], v1 = acc[ai][bj][m][1];
                    const float av[8] = {v0[0], v0[1], v0[2], v0[3], v1[0], v1[1], v1[2], v1[3]};
#pragma unroll
                    for (int j = 0; j < 8; ++j) {
#if defined(DBG_MIX) && DBG_MIX == 1
                        o[j] = sigmoidf_(fb[j]) * av[j];
#elif defined(DBG_MIX) && DBG_MIX == 2
                        o[j] = sigmoidf_(fa[j]) * fy[j];
#else
                        o[j] = sigmoidf_(fa[j]) * fy[j] + sigmoidf_(fb[j]) * av[j];
#endif
                    }
                    *(u32x4*)(MIX + t * DM + c) = pack8(o); } }
    }
};
struct EpiRes {
    static constexpr bool PERM = false;
    float* X; const float* gate;
    const float* XinP; const float* XinS;
    __device__ __forceinline__ void operator()(const f32x4 (&acc)[2][2][4][2], const Unit& u, int wr, int wc, int fr, int fq) const {
#pragma unroll
        for (int ai = 0; ai < 2; ++ai)
#pragma unroll
            for (int m = 0; m < 4; ++m) { const int t = u.pm * BM + ai * HALF + wr * 64 + m * 16 + fr; const float* gr = gate + (long)cond_row(t) * 12288; float* xr = X + (long)t * DM; const float* xi = t < TP ? XinP + (long)t * DM : XinS + (long)(t - TP) * DM;
#pragma unroll
                for (int bj = 0; bj < 2; ++bj)
#pragma unroll
                    for (int n = 0; n < 2; ++n) { const int c = u.pn * BM + bj * HALF + wc * 32 + n * 16 + 4 * fq;
                        const f32x4 gv = *(const f32x4*)(gr + c); const f32x4 xv = *(const f32x4*)(xi + c);
                        *(f32x4*)(xr + c) = xv + gv * acc[ai][bj][m][n]; } }
    }
};

struct EpiQ {
    static constexpr bool PERM = true;
    bf16_t* Q; bf16_t* QL; const float* T64;
    __device__ __forceinline__ void operator()(const f32x4 (&acc)[2][2][4][2], const Unit& u, int wr, int wc, int fr, int fq) const {
        const int grp = u.pn / 3, typ = u.pn - 3 * grp;
        if (typ < 2) {
#pragma unroll
            for (int ai = 0; ai < 2; ++ai)
#pragma unroll
                for (int m = 0; m < 4; ++m) { const long t = (long)u.pm * BM + ai * HALF + wr * 64 + m * 16 + fr;
#pragma unroll
                    for (int bj = 0; bj < 2; ++bj) { const f32x4 v0 = acc[ai][bj][m][0], v1 = acc[ai][bj][m][1];
                        u32x4 w; w.x = cvt_pk_bf16(v0[0], v0[1]); w.y = cvt_pk_bf16(v0[2], v0[3]); w.z = cvt_pk_bf16(v1[0], v1[1]); w.w = cvt_pk_bf16(v1[2], v1[3]);
                        *(u32x4*)(Q + t * 3072 + 768 * grp + 192 * (2 * typ + bj) + wc * 32 + 8 * fq) = w; } }
        } else {
#pragma unroll
            for (int ai = 0; ai < 2; ++ai)
#pragma unroll
                for (int m = 0; m < 4; ++m) { const int t = u.pm * BM + ai * HALF + wr * 64 + m * 16 + fr; const int pos = tok_pos(t);
                    const float* cs = T64 + ((long)pos * 32 + 8 * fq) * 2; float cv[8], sv[8];
#pragma unroll
                    for (int j = 0; j < 4; ++j) { const f32x4 qv = *(const f32x4*)(cs + 4 * j); cv[2 * j] = qv[0]; sv[2 * j] = qv[1]; cv[2 * j + 1] = qv[2]; sv[2 * j + 1] = qv[3]; }
                    const f32x4 a0 = acc[ai][0][m][0], a1 = acc[ai][0][m][1], b0 = acc[ai][1][m][0], b1 = acc[ai][1][m][1];
                    const float x1[8] = {a0[0], a0[1], a0[2], a0[3], a1[0], a1[1], a1[2], a1[3]}, x2[8] = {b0[0], b0[1], b0[2], b0[3], b1[0], b1[1], b1[2], b1[3]};
                    float o1[8], o2[8];
#pragma unroll
                    for (int j = 0; j < 8; ++j) { o1[j] = x1[j] * cv[j] - x2[j] * sv[j]; o2[j] = x1[j] * sv[j] + x2[j] * cv[j]; }
                    const u32x4 w1 = pack8(o1), w2 = pack8(o2); const int hd = 4 * grp + wc;
                    bf16_t* qd = Q + (long)t * 3072 + hd * 192 + 128 + 8 * fq; *(u32x4*)qd = w1; *(u32x4*)(qd + 32) = w2;
                    if (t >= TP) { const int ts = t - TP; bf16_t* d = QL + ((long)(ts >> 6) * 1024 + hd * 64 + (ts & 63)) * QLD + 512 + 8 * fq; *(u32x4*)d = w1; *(u32x4*)(d + 32) = w2; } }
        }
    }
};
}
namespace att {
constexpr int NW = 8, QBLK = 32, KVBLK = 64;
constexpr float SCALE = MLA_SCALE;
constexpr float THR = 8.f;
constexpr int KROW = 384;
constexpr int SHM_V = KVBLK * 128 * 2, SHM_K = KVBLK * KROW;
constexpr int QR_PITCH = 144, SHM_QR = 256 * QR_PITCH;
constexpr int SHM_ATTN = 2 * SHM_V + 2 * SHM_K + NW * 64 * 4 + SHM_QR;
#define KSWZ(row, colB) ((row) * att::KROW + ((colB) ^ (((row) & 7) << 4)))
#define SBAR() __builtin_amdgcn_sched_barrier(0)
__device__ __forceinline__ int crow(int r, int hi) { return (r & 3) + 8 * (r >> 2) + 4 * hi; }

__device__ __forceinline__ void partialSM(f32x16& p0, f32x16& p1, float& m_reg, float& mn, float& alpha) {
  constexpr float C = SCALE * 1.4426950408889634f;
  float pmax = p0[0];
#pragma unroll
  for (int r = 1; r < 16; ++r) pmax = fmaxf(pmax, p0[r]);
#pragma unroll
  for (int r = 0; r < 16; ++r) pmax = fmaxf(pmax, p1[r]);
  { auto rr = __builtin_amdgcn_permlane32_swap(__float_as_uint(pmax), __float_as_uint(pmax), false, false);
    pmax = fmaxf(__uint_as_float(rr[0]), __uint_as_float(rr[1])); }
  if (__builtin_expect(__all(pmax - m_reg <= THR / SCALE), 1)) { mn = m_reg; alpha = 1.f; }
  else { mn = fmaxf(m_reg, pmax); alpha = __builtin_amdgcn_exp2f((m_reg - mn) * C); m_reg = mn; }
  float mnC = -mn * C;
#pragma unroll
  for (int r = 0; r < 16; ++r) p0[r] = fmaf(p0[r], C, mnC);
#pragma unroll
  for (int r = 0; r < 16; ++r) p1[r] = fmaf(p1[r], C, mnC);
#pragma unroll
  for (int r = 0; r < 16; ++r) p0[r] = __builtin_amdgcn_exp2f(p0[r]);
}
__device__ __forceinline__ void finishSM(f32x16& p0, f32x16& p1, float alpha, float& l_reg, bf16x8& pa0, bf16x8& pa1, bf16x8& pa2, bf16x8& pa3) {
#pragma unroll
  for (int r = 0; r < 16; ++r) p1[r] = __builtin_amdgcn_exp2f(p1[r]);
  float ps = 0;
#pragma unroll
  for (int r = 0; r < 16; ++r) ps += p0[r];
#pragma unroll
  for (int r = 0; r < 16; ++r) ps += p1[r];
  { auto rr = __builtin_amdgcn_permlane32_swap(__float_as_uint(ps), __float_as_uint(ps), false, false);
    ps = __uint_as_float(rr[0]) + __uint_as_float(rr[1]); }
  l_reg = l_reg * alpha + ps;
#define PK4(P, BASE, OUT) do { unsigned a0 = cvt_pk_bf16(P[BASE + 0], P[BASE + 1]), a1 = cvt_pk_bf16(P[BASE + 2], P[BASE + 3]);   \
    unsigned b0 = cvt_pk_bf16(P[BASE + 4], P[BASE + 5]), b1 = cvt_pk_bf16(P[BASE + 6], P[BASE + 7]);                              \
    auto r0 = __builtin_amdgcn_permlane32_swap(a0, b0, false, false); auto r1 = __builtin_amdgcn_permlane32_swap(a1, b1, false, false); \
    u32x4 w = {r0[0], r1[0], r0[1], r1[1]}; OUT = *reinterpret_cast<bf16x8*>(&w); } while (0)
  PK4(p0, 0, pa0); PK4(p0, 8, pa1); PK4(p1, 0, pa2); PK4(p1, 8, pa3);
#undef PK4
}
__device__ __forceinline__ void qkt(f32x16& p0, f32x16& p1, const char* Ks, const bf16x8* qr, const char* qrope, const int (&kbase)[4], bool vis) {
  p0 = f32x16{}; p1 = f32x16{};
  if (vis) {
#pragma unroll
  for (int d0 = 0; d0 < 12; ++d0) {
    bf16x8 b0 = *reinterpret_cast<const bf16x8*>(Ks + kbase[d0 & 3] + (d0 >> 2) * 128);
    bf16x8 b1 = *reinterpret_cast<const bf16x8*>(Ks + kbase[d0 & 3] + (d0 >> 2) * 128 + 32 * KROW);
    const bf16x8 qv = d0 < 8 ? qr[d0 < 8 ? d0 : 0] : *reinterpret_cast<const bf16x8*>(qrope + (d0 - 8) * 32);
    p0 = __builtin_amdgcn_mfma_f32_32x32x16_bf16(b0, qv, p0, 0, 0, 0);
    p1 = __builtin_amdgcn_mfma_f32_32x32x16_bf16(b1, qv, p1, 0, 0, 0); }
  }
  if (!vis) {
#pragma unroll
    for (int r = 0; r < 16; ++r) { p0[r] = -1e30f; p1[r] = -1e30f; } }
}
__device__ __forceinline__ int v_st(int k, int c) { const int kk = (k & ~0xC) | ((k & 4) << 1) | ((k & 8) >> 1); return ((kk >> 3) * 4 + (c >> 5)) * 512 + ((kk & 7) * 32 + (c & 31)) * 2; }
__device__ __forceinline__ int v_rd_base(int lane) { return ((lane & 3) << 3) | (((lane >> 2) & 3) << 6) | (((lane >> 4) & 1) << 5) | (((lane >> 5) & 1) << 8); }
constexpr int v_rd_off(int d0, int ks, int half) { return d0 * 512 + ks * 4096 + half * 2048; }
template <int OFF> __device__ __forceinline__ s16x4 tr_read(int vb) {
  s16x4 r; asm volatile("ds_read_b64_tr_b16 %0, %1 offset:%2" : "=&v"(r) : "v"(vb), "i"(OFF) : "memory"); return r;
}
template <int D0> __device__ __forceinline__ void pv_one(f32x16& od, int vb, bf16x8 pa0, bf16x8 pa1, bf16x8 pa2, bf16x8 pa3) {
  const s16x4 l0 = tr_read<v_rd_off(D0, 0, 0)>(vb), h0 = tr_read<v_rd_off(D0, 0, 1)>(vb), l1 = tr_read<v_rd_off(D0, 1, 0)>(vb), h1 = tr_read<v_rd_off(D0, 1, 1)>(vb);
  const s16x4 l2 = tr_read<v_rd_off(D0, 2, 0)>(vb), h2 = tr_read<v_rd_off(D0, 2, 1)>(vb), l3 = tr_read<v_rd_off(D0, 3, 0)>(vb), h3 = tr_read<v_rd_off(D0, 3, 1)>(vb);
  asm volatile("s_waitcnt lgkmcnt(0)" ::: "memory"); SBAR();
#define PK(L, H) (bf16x8){L[0], L[1], L[2], L[3], H[0], H[1], H[2], H[3]}
  od = __builtin_amdgcn_mfma_f32_32x32x16_bf16(pa0, PK(l0, h0), od, 0, 0, 0);
  od = __builtin_amdgcn_mfma_f32_32x32x16_bf16(pa1, PK(l1, h1), od, 0, 0, 0);
  od = __builtin_amdgcn_mfma_f32_32x32x16_bf16(pa2, PK(l2, h2), od, 0, 0, 0);
  od = __builtin_amdgcn_mfma_f32_32x32x16_bf16(pa3, PK(l3, h3), od, 0, 0, 0);
#undef PK
}
__device__ __forceinline__ void pv_d0(f32x16* o, int vb, bf16x8 pa0, bf16x8 pa1, bf16x8 pa2, bf16x8 pa3) {
  pv_one<0>(o[0], vb, pa0, pa1, pa2, pa3); pv_one<1>(o[1], vb, pa0, pa1, pa2, pa3); pv_one<2>(o[2], vb, pa0, pa1, pa2, pa3); pv_one<3>(o[3], vb, pa0, pa1, pa2, pa3);
}

__device__ __forceinline__ void attn_block(const bf16_t* __restrict__ Qb, const bf16_t* __restrict__ Kn, const bf16_t* __restrict__ Kr, const bf16_t* __restrict__ Vh,
                                           bf16_t* __restrict__ Ob, int qb, char* lds) {
  constexpr int LDQ = 3072, LDK = 4096, LDR = 64, LDO = 2048;
  const int tid = otid(), wid = tid >> 6, lane = tid & 63, r32 = lane & 31, hi = lane >> 5;
  char* V_lds = lds; char* K_lds = lds + 2 * SHM_V;
  float* ws = (float*)(lds + 2 * SHM_V + 2 * SHM_K) + wid * 64; float* li_l = ws; float* al_l = ws + 32;
  float m_reg = -1e30f, l_reg = 0; f32x16 o[4] = {}; bf16x8 qr[8];
  const bf16_t* Qw = Qb + (long)(wid * QBLK + r32) * LDQ + hi * 8;
#pragma unroll
  for (int d0 = 0; d0 < 8; ++d0) qr[d0] = *reinterpret_cast<const bf16x8*>(Qw + d0 * 16);
  char* qrope = lds + 2 * SHM_V + 2 * SHM_K + NW * 64 * 4 + (wid * QBLK + r32) * QR_PITCH + hi * 16;
#pragma unroll
  for (int d0 = 8; d0 < 12; ++d0) *reinterpret_cast<bf16x8*>(qrope + (d0 - 8) * 32) = *reinterpret_cast<const bf16x8*>(Qw + d0 * 16);
  asm volatile("s_waitcnt lgkmcnt(0)" ::: "memory");
  const int NT = 4 * qb + 4, jmax = 4 * qb + (wid >> 1);
  int kbase[4];
#pragma unroll
  for (int dl = 0; dl < 4; ++dl) kbase[dl] = r32 * KROW + (((dl << 5) | (hi << 4)) ^ ((r32 & 7) << 4));
  const int sr = tid >> 4, sc = (tid & 15) * 8, vst0 = v_st(sr, sc), vst1 = v_st(32 + sr, sc);
  const int rr = tid >> 3, rc = (tid & 7) * 8;
  const int vb0 = (int)(uintptr_t)V_lds + v_rd_base(lane);
  bf16x8 vs0, vs1, ks0, ks1, kr0;
#define SLOAD(k0) do { vs0 = *reinterpret_cast<const bf16x8*>(&Vh[(long)((k0) + sr) * LDK + sc]); vs1 = *reinterpret_cast<const bf16x8*>(&Vh[(long)((k0) + 32 + sr) * LDK + sc]); \
    ks0 = *reinterpret_cast<const bf16x8*>(&Kn[(long)((k0) + sr) * LDK + sc]); ks1 = *reinterpret_cast<const bf16x8*>(&Kn[(long)((k0) + 32 + sr) * LDK + sc]); \
    kr0 = *reinterpret_cast<const bf16x8*>(&Kr[(long)((k0) + rr) * LDR + rc]); } while (0)
#define SWRITE(b) do { *(bf16x8*)(V_lds + (b) * SHM_V + vst0) = vs0; *(bf16x8*)(V_lds + (b) * SHM_V + vst1) = vs1; int kc = sc * 2; \
    *(bf16x8*)(K_lds + (b) * SHM_K + KSWZ(sr, kc)) = ks0; *(bf16x8*)(K_lds + (b) * SHM_K + KSWZ(32 + sr, kc)) = ks1; \
    *(bf16x8*)(K_lds + (b) * SHM_K + KSWZ(rr, 256 + rc * 2)) = kr0; } while (0)
#define SWAIT() asm volatile("s_waitcnt vmcnt(0)" ::: "memory")
#define RESC(a) do { if (__any((a) < 1.f)) { if (hi == 0) al_l[r32] = (a); asm volatile("s_waitcnt lgkmcnt(0)" ::: "memory"); \
    _Pragma("unroll") for (int d = 0; d < 4; ++d) _Pragma("unroll") for (int r = 0; r < 16; ++r) o[d][r] *= al_l[crow(r, hi)]; } } while (0)
  f32x16 pA0, pA1, pB0, pB1; float mnA, mnB, alA, alB; bf16x8 pa0, pa1, pa2, pa3;
  SLOAD(0); SWAIT(); SWRITE(0); __syncthreads();
  qkt(pA0, pA1, K_lds, qr, qrope, kbase, true); partialSM(pA0, pA1, m_reg, mnA, alA);
  SLOAD(KVBLK);
  SWAIT(); SWRITE(1); __syncthreads();
  for (int j = 1; j + 1 < NT; j += 2) {
    SBAR(); qkt(pB0, pB1, K_lds + SHM_K, qr, qrope, kbase, j <= jmax);
    finishSM(pA0, pA1, alA, l_reg, pa0, pa1, pa2, pa3); SBAR();
    SLOAD((j + 1) * KVBLK); SBAR();
    if (j - 1 <= jmax) pv_d0(o, vb0, pa0, pa1, pa2, pa3);
    partialSM(pB0, pB1, m_reg, mnB, alB);
    __syncthreads(); SWAIT(); SWRITE(0);
    RESC(alB); __syncthreads();
    SBAR(); qkt(pA0, pA1, K_lds, qr, qrope, kbase, j + 1 <= jmax);
    finishSM(pB0, pB1, alB, l_reg, pa0, pa1, pa2, pa3); SBAR();
    SLOAD((j + 2) * KVBLK); SBAR();
    if (j <= jmax) pv_d0(o, vb0 + (int)SHM_V, pa0, pa1, pa2, pa3);
    partialSM(pA0, pA1, m_reg, mnA, alA);
    __syncthreads(); SWAIT(); SWRITE(1);
    RESC(alA); __syncthreads();
  }
  SBAR(); qkt(pB0, pB1, K_lds + SHM_K, qr, qrope, kbase, NT - 1 <= jmax);
  finishSM(pA0, pA1, alA, l_reg, pa0, pa1, pa2, pa3); SBAR();
  if (NT - 2 <= jmax) pv_d0(o, vb0, pa0, pa1, pa2, pa3);
  partialSM(pB0, pB1, m_reg, mnB, alB);
  __syncthreads(); RESC(alB);
  finishSM(pB0, pB1, alB, l_reg, pa0, pa1, pa2, pa3); SBAR();
  if (NT - 1 <= jmax) pv_d0(o, vb0 + (int)SHM_V, pa0, pa1, pa2, pa3);
  if (hi == 0) li_l[r32] = l_reg; asm volatile("s_waitcnt lgkmcnt(0)" ::: "memory");
  float rli[16];
#pragma unroll
  for (int r = 0; r < 16; ++r) rli[r] = __builtin_amdgcn_rcpf(li_l[crow(r, hi)]);
  bf16_t* Ow = Ob + (long)(wid * QBLK) * LDO;
#pragma unroll
  for (int r = 0; r < 16; ++r) { int orow = crow(r, hi);
#pragma unroll
    for (int d0 = 0; d0 < 4; ++d0) Ow[(long)orow * LDO + d0 * 32 + r32] = f2bf(o[d0][r] * rli[r]); }
  __syncthreads();
#undef SLOAD
#undef SWRITE
#undef SWAIT
#undef RESC
}
}
namespace ret {
constexpr int QP_ = 136;
__device__ __forceinline__ bf16x8 ldfrag(const bf16_t* p) { return *reinterpret_cast<const bf16x8*>(p); }
template <int CL> struct Lay {
    static constexpr int IP = CL + 8;
    static constexpr int QS = 0, KS = QS + CL * QP_ * 2, VT = KS + CL * QP_ * 2, VDT = VT + 32 * IP * 2, IN = VDT + 32 * IP * 2, ST = IN + CL * IP * 2, VS = ST + 32 * QP_ * 2, END = VS + CL * 40 * 2;
};
static_assert(Lay<128>::END <= LDS_BARW, "retention LDS");

template <int CL>
__device__ __forceinline__ void run(const bf16_t* __restrict__ Y, bf16_t* __restrict__ OB, const float* __restrict__ sp, float* __restrict__ so, long tok0, int nch, int h, int es, float lg, char* lds, int tid) {
    using L = Lay<CL>; constexpr int IP = L::IP, NQT = CL / 16, NKS = CL / 32, NPC = CL / 32;
    const int wid = __builtin_amdgcn_readfirstlane(tid >> 6), lane = tid & 63, l15 = lane & 15, l4 = lane >> 4;
    bf16_t* Qs = (bf16_t*)(lds + L::QS); bf16_t* Ks = (bf16_t*)(lds + L::KS); bf16_t* Vt = (bf16_t*)(lds + L::VT); bf16_t* Vdt = (bf16_t*)(lds + L::VDT); bf16_t* In = (bf16_t*)(lds + L::IN); bf16_t* St = (bf16_t*)(lds + L::ST); bf16_t* Vs = (bf16_t*)(lds + L::VS);
    const float gCL = __expf((float)CL * lg);
    f32x4 Sacc[2];
    if (sp) {
#pragma unroll
        for (int ej = 0; ej < 2; ++ej)
#pragma unroll
            for (int r = 0; r < 4; ++r) Sacc[ej][r] = sp[(long)(16 * wid + 4 * l4 + r) * RV + 16 * ej + l15];
    } else { Sacc[0] = (f32x4){0.f, 0.f, 0.f, 0.f}; Sacc[1] = (f32x4){0.f, 0.f, 0.f, 0.f}; }
    for (int i = tid; i < CL * IP / 8; i += 512) reinterpret_cast<u32x4*>(In)[i] = (u32x4){0u, 0u, 0u, 0u};
    u32x4 pq[NPC], pk[NPC], pv;
    const int vk = tid >> 2, ve0 = (tid & 3) * 8;
#define RET_LOAD(cc) do { const bf16_t* yrow_ = Y + (tok0 + (long)(cc) * CL) * INWP; \
        _Pragma("unroll") for (int i = 0; i < NPC; ++i) { const int idx = tid + i * 512, k = idx >> 4, d0 = (idx & 15) * 8; \
            pq[i] = *reinterpret_cast<const u32x4*>(yrow_ + (long)k * INWP + C_RQ + h * 128 + d0); pk[i] = *reinterpret_cast<const u32x4*>(yrow_ + (long)k * INWP + C_RK + h * 128 + d0); } \
        if (tid < 4 * CL) pv = *reinterpret_cast<const u32x4*>(yrow_ + (long)vk * INWP + C_RV + h * 256 + es * 32 + ve0); } while (0)
    RET_LOAD(0);
    for (int c = 0; c < nch; ++c) {
#pragma unroll
        for (int ej = 0; ej < 2; ++ej) { u32x2 w; w.x = cvt_pk_bf16(Sacc[ej][0], Sacc[ej][1]); w.y = cvt_pk_bf16(Sacc[ej][2], Sacc[ej][3]);
            *reinterpret_cast<u32x2*>(St + (16 * ej + l15) * QP_ + 16 * wid + 4 * l4) = w; }
#pragma unroll
        for (int i = 0; i < NPC; ++i) { const int idx = tid + i * 512, k = idx >> 4, d0 = (idx & 15) * 8;
            *reinterpret_cast<u32x4*>(Qs + k * QP_ + d0) = pq[i]; *reinterpret_cast<u32x4*>(Ks + k * QP_ + d0) = pk[i]; }
        if (tid < 4 * CL) *reinterpret_cast<u32x4*>(Vs + vk * 40 + ve0) = pv;
        if (c + 1 < nch) RET_LOAD(c + 1);
        __syncthreads();
        if (tid < 4 * CL) { const int e = tid & 31, kg = tid >> 5; float f[8], fd[8];
#pragma unroll
            for (int j = 0; j < 8; ++j) { f[j] = bf2f(Vs[(8 * kg + j) * 40 + e]); fd[j] = f[j] * __expf((float)(CL - 1 - 8 * kg - j) * lg); }
            *reinterpret_cast<u32x4*>(Vt + e * IP + 8 * kg) = pack8(f); *reinterpret_cast<u32x4*>(Vdt + e * IP + 8 * kg) = pack8(fd); }
#pragma unroll
        for (int it_ = 0; it_ < (NQT * (NQT + 1) / 2 + 7) / 8; ++it_) { const int idx = wid + 8 * it_; if (idx >= NQT * (NQT + 1) / 2) break;
            int qi = 0; while ((qi + 1) * (qi + 2) / 2 <= idx) ++qi; const int kj = idx - qi * (qi + 1) / 2;
            f32x4 a = (f32x4){0.f, 0.f, 0.f, 0.f}; const bf16_t* qp = Qs + (16 * qi + l15) * QP_ + 8 * l4; const bf16_t* kp = Ks + (16 * kj + l15) * QP_ + 8 * l4;
#pragma unroll
            for (int ks = 0; ks < 4; ++ks) a = __builtin_amdgcn_mfma_f32_16x16x32_bf16(ldfrag(qp + 32 * ks), ldfrag(kp + 32 * ks), a, 0, 0, 0);
            const int q0 = 16 * qi + 4 * l4, k = 16 * kj + l15;
#pragma unroll
            for (int r = 0; r < 4; ++r) { const int q = q0 + r; const float dm = (q >= k) ? __expf((float)(q - k) * lg) : 0.f;
                In[q * IP + k] = f2bf(a[r] * dm); } }
        __syncthreads();
#pragma unroll
        for (int ot = 0; ot < (2 * NQT) / 8; ++ot) { const int tI = wid + 8 * ot, qi = tI >> 1, ej = tI & 1; f32x4 a = (f32x4){0.f, 0.f, 0.f, 0.f};
#pragma unroll
            for (int ks = 0; ks < 4; ++ks) a = __builtin_amdgcn_mfma_f32_16x16x32_bf16(ldfrag(Qs + (16 * qi + l15) * QP_ + 32 * ks + 8 * l4), ldfrag(St + (16 * ej + l15) * QP_ + 32 * ks + 8 * l4), a, 0, 0, 0);
#pragma unroll
            for (int r = 0; r < 4; ++r) a[r] *= __expf((float)(16 * qi + 4 * l4 + r + 1) * lg);
#pragma unroll
            for (int ks = 0; ks < NKS; ++ks) if (ks <= (qi >> 1)) a = __builtin_amdgcn_mfma_f32_16x16x32_bf16(ldfrag(In + (16 * qi + l15) * IP + 32 * ks + 8 * l4), ldfrag(Vt + (16 * ej + l15) * IP + 32 * ks + 8 * l4), a, 0, 0, 0);
            bf16_t* op = OB + ((long)(h * 8 + es) * T + tok0 + (long)c * CL + 16 * qi + 4 * l4) * 32 + 16 * ej + l15;
#pragma unroll
            for (int r = 0; r < 4; ++r) op[r * 32] = f2bf(a[r]); }
        { f32x4 s0 = Sacc[0] * gCL, s1 = Sacc[1] * gCL;
#pragma unroll
          for (int ks = 0; ks < NKS; ++ks) { bf16x8 af;
#pragma unroll
              for (int j = 0; j < 8; ++j) af[j] = (short)Ks[(32 * ks + 8 * l4 + j) * QP_ + 16 * wid + l15];
              s0 = __builtin_amdgcn_mfma_f32_16x16x32_bf16(af, ldfrag(Vdt + l15 * IP + 32 * ks + 8 * l4), s0, 0, 0, 0);
              s1 = __builtin_amdgcn_mfma_f32_16x16x32_bf16(af, ldfrag(Vdt + (16 + l15) * IP + 32 * ks + 8 * l4), s1, 0, 0, 0); }
          Sacc[0] = s0; Sacc[1] = s1; }
        __syncthreads();
    }
#undef RET_LOAD
#pragma unroll
    for (int ej = 0; ej < 2; ++ej)
#pragma unroll
        for (int r = 0; r < 4; ++r) so[(long)(16 * wid + 4 * l4 + r) * RV + 16 * ej + l15] = Sacc[ej][r];
}

__device__ __forceinline__ void unit(KParams& p, int l, int u, char* lds) {
    const int tid = otid(); unsigned char* ws = optr(gp(p.ws)); const bf16_t* Y = (const bf16_t*)(ws + WS_Y); bf16_t* OB = (bf16_t*)(ws + WS_OB);
    const bool samp = u >= 256; const int v = samp ? u - 256 : u; const int b = v >> 6, h = (v >> 3) & 7, es = v & 7; const float lg = p.lg[h];
    if (samp) run<64>(Y, OB, gp(p.state_ret) + ((((long)l * DB + b) * RH + h) * RQK) * RV + es * 32, gp(p.out) + O_RETS + ((((long)l * DB + b) * RH + h) * RQK) * RV + es * 32, (long)TP + b * 64, 1, h, es, lg, lds, tid);
    else run<64>(Y, OB, nullptr, gp(p.out) + O_RETP + ((((long)l * NB + b) * RH + h) * RQK) * RV + es * 32, (long)b * SEQ, SEQ / 64, h, es, lg, lds, tid);
}
}
namespace peer {
__device__ __forceinline__ void ins16(float (&l)[16], float x) {
#pragma unroll
    for (int j = 0; j < 16; ++j) { const float hi = fmaxf(l[j], x); x = fminf(l[j], x); l[j] = hi; }
}
#define CE_DESC(a, b) do { const float hi_ = fmaxf(a, b), lo_ = fminf(a, b); a = hi_; b = lo_; } while (0)
#define CE_ASC(a, b) do { const float hi_ = fmaxf(a, b), lo_ = fminf(a, b); a = lo_; b = hi_; } while (0)
__device__ __forceinline__ void sort16_desc(float (&v)[16]) {
#pragma unroll
    for (int k = 2; k <= 16; k <<= 1)
#pragma unroll
        for (int j = k >> 1; j >= 1; j >>= 1)
#pragma unroll
            for (int i = 0; i < 16; ++i) { const int l = i ^ j; if (l > i) { if ((i & k) == 0) CE_DESC(v[i], v[l]); else CE_ASC(v[i], v[l]); } }
}
__device__ __forceinline__ void merge16_desc(float (&l)[16], const float (&o)[16]) {
#pragma unroll
    for (int i = 0; i < 16; ++i) l[i] = fmaxf(l[i], o[15 - i]);
#pragma unroll
    for (int j = 8; j >= 1; j >>= 1)
#pragma unroll
        for (int i = 0; i < 16; ++i) { const int m = i ^ j; if (m > i) CE_DESC(l[i], l[m]); }
}
constexpr int KPITCH = 136;
__device__ __forceinline__ void half_top16(const bf16_t* __restrict__ qrow, const bf16_t* __restrict__ keys, int lane, float (&l)[16]) {
    const int r32 = lane & 31, g = lane >> 5;
#pragma unroll
    for (int j = 0; j < 16; ++j) l[j] = -3.0e38f;
    bf16x8 qf[8];
#pragma unroll
    for (int ks = 0; ks < 8; ++ks) qf[ks] = *reinterpret_cast<const bf16x8*>(qrow + 16 * ks + 8 * g);
#pragma unroll 1
    for (int kb = 0; kb < 4; ++kb) { f32x16 a = f32x16{};
#pragma unroll
        for (int ks = 0; ks < 8; ++ks) { const bf16x8 kf = *reinterpret_cast<const bf16x8*>(keys + (32 * kb + r32) * KPITCH + 16 * ks + 8 * g);
            a = __builtin_amdgcn_mfma_f32_32x32x16_bf16(kf, qf[ks], a, 0, 0, 0); }
        float blk[16];
#pragma unroll
        for (int r = 0; r < 16; ++r) { const unsigned key = (unsigned)(32 * kb + (r & 3) + 8 * (r >> 2) + 4 * g);
            blk[r] = __uint_as_float((__float_as_uint(a[r]) & ~0x7Fu) | key); }
        sort16_desc(blk); merge16_desc(l, blk); }
}
__device__ __forceinline__ void merge_lists(float (&l)[16], const float (&o)[16]) { merge16_desc(l, o); }
__device__ __forceinline__ void select_unit(const bf16_t* __restrict__ QP, const bf16_t* __restrict__ k1, const bf16_t* __restrict__ k2, int* __restrict__ PIDX, float* __restrict__ PW,
                                            int t0, int h, int lane, float* lds_lane  ) {
    const int r32 = lane & 31, g = lane >> 5;
    const bf16_t* qrow = QP + (long)(t0 + r32) * DM + h * 256;
    float la[16], lb[16];
    half_top16(qrow, k1, lane, la);
    half_top16(qrow + 128, k2, lane, lb);
    float m0[16], m1[16];
#pragma unroll
    for (int j = 0; j < 16; ++j) { auto rr = __builtin_amdgcn_permlane32_swap(__float_as_uint(la[j]), __float_as_uint(lb[j]), false, false); m0[j] = __uint_as_float(rr[0]); m1[j] = __uint_as_float(rr[1]); }
    merge_lists(m0, m1);
    float L1[16], L2[16];
#pragma unroll
    for (int j = 0; j < 16; ++j) { auto rr = __builtin_amdgcn_permlane32_swap(__float_as_uint(m0[j]), __float_as_uint(m0[j]), false, false);
        L1[j] = __uint_as_float(rr[0]); L2[j] = __uint_as_float(rr[1]); }
#define CAND(i, j) __uint_as_float((__float_as_uint(L1[i] + L2[j]) & ~0xFFu) | (unsigned)((i) * 16 + (j)))
    float best[16], c2[16], c3[16];
#pragma unroll
    for (int j = 0; j < 16; ++j) best[j] = CAND(0, j);
    sort16_desc(best);
    c2[0] = CAND(1, 0); c2[1] = CAND(1, 1); c2[2] = CAND(1, 2); c2[3] = CAND(1, 3); c2[4] = CAND(1, 4); c2[5] = CAND(1, 5); c2[6] = CAND(1, 6); c2[7] = CAND(1, 7);
    c2[8] = CAND(2, 0); c2[9] = CAND(2, 1); c2[10] = CAND(2, 2); c2[11] = CAND(2, 3); c2[12] = CAND(2, 4); c2[13] = CAND(4, 0); c2[14] = CAND(4, 1); c2[15] = CAND(4, 2);
    sort16_desc(c2); merge16_desc(best, c2);
    c3[0] = CAND(3, 0); c3[1] = CAND(3, 1); c3[2] = CAND(3, 2); c3[3] = CAND(3, 3); c3[4] = CAND(5, 0); c3[5] = CAND(5, 1); c3[6] = CAND(6, 0); c3[7] = CAND(6, 1);
    c3[8] = CAND(7, 0); c3[9] = CAND(7, 1); c3[10] = CAND(8, 0); c3[11] = CAND(9, 0); c3[12] = CAND(10, 0); c3[13] = CAND(11, 0); c3[14] = CAND(12, 0); c3[15] = CAND(13, 0);
    sort16_desc(c3); merge16_desc(best, c3);
    ins16(best, CAND(14, 0)); ins16(best, CAND(15, 0));
#undef CAND
#pragma unroll
    for (int j = 0; j < 16; ++j) { lds_lane[j] = __uint_as_float(__float_as_uint(L1[j]) & 0x7Fu); lds_lane[16 + j] = __uint_as_float(__float_as_uint(L2[j]) & 0x7Fu); }
    asm volatile("s_waitcnt lgkmcnt(0)" ::: "memory");
    float wsum = 0.f, w[16]; int ei[16];
    const float mx = best[0];
#pragma unroll
    for (int k = 0; k < 16; ++k) { const unsigned code = __float_as_uint(best[k]) & 0xFFu; const int i = (int)(code >> 4), j = (int)(code & 15u);
        const int i1 = (int)__float_as_uint(lds_lane[i]), i2 = (int)__float_as_uint(lds_lane[16 + j]); ei[k] = i1 * NKEYS + i2;
        w[k] = __expf(best[k] - mx); wsum += w[k]; }
    const float inv = 1.0f / wsum;
    if (g == 0) { int* ip = PIDX + (long)(t0 + r32) * 128 + h * 16; float* wp = PW + (long)(t0 + r32) * 128 + h * 16;
#pragma unroll
        for (int k = 0; k < 16; k += 4) { *reinterpret_cast<int4*>(ip + k) = make_int4(ei[k], ei[k + 1], ei[k + 2], ei[k + 3]);
            *reinterpret_cast<float4*>(wp + k) = make_float4(w[k] * inv, w[k + 1] * inv, w[k + 2] * inv, w[k + 3] * inv); } }
}

__device__ __forceinline__ float gelu_exact(float x) { return 0.5f * x * (1.0f + erff(x * 0.70710678118654752f)); }

__device__ __forceinline__ void dec16(const u32x4 w, f32x2 (&f)[8]) {
    f[0] = __builtin_amdgcn_cvt_pk_f32_fp8((int)w.x, false); f[1] = __builtin_amdgcn_cvt_pk_f32_fp8((int)w.x, true);
    f[2] = __builtin_amdgcn_cvt_pk_f32_fp8((int)w.y, false); f[3] = __builtin_amdgcn_cvt_pk_f32_fp8((int)w.y, true);
    f[4] = __builtin_amdgcn_cvt_pk_f32_fp8((int)w.z, false); f[5] = __builtin_amdgcn_cvt_pk_f32_fp8((int)w.z, true);
    f[6] = __builtin_amdgcn_cvt_pk_f32_fp8((int)w.w, false); f[7] = __builtin_amdgcn_cvt_pk_f32_fp8((int)w.w, true);
}
__device__ __forceinline__ void gather_token(const bf16_t* __restrict__ H, const unsigned char* __restrict__ PU, const unsigned char* __restrict__ PV, const float* __restrict__ SU, const float* __restrict__ SV,
                                             const int* __restrict__ PIDX, const float* __restrict__ PW, float* __restrict__ X, const float* __restrict__ gate  , int t, int lane) {
    f32x2 xf[2][8];
#pragma unroll
    for (int hlf = 0; hlf < 2; ++hlf)
#pragma unroll
        for (int q = 0; q < 2; ++q) { const u32x4 w = *reinterpret_cast<const u32x4*>(H + (long)t * DM + 1024 * hlf + 16 * lane + 8 * q);
            xf[hlf][4 * q + 0] = (f32x2){bflo(w.x), bfhi(w.x)}; xf[hlf][4 * q + 1] = (f32x2){bflo(w.y), bfhi(w.y)}; xf[hlf][4 * q + 2] = (f32x2){bflo(w.z), bfhi(w.z)}; xf[hlf][4 * q + 3] = (f32x2){bflo(w.w), bfhi(w.w)}; }
    f32x2 out[2][8];
#pragma unroll
    for (int hlf = 0; hlf < 2; ++hlf)
#pragma unroll
        for (int i = 0; i < 8; ++i) out[hlf][i] = (f32x2){0.f, 0.f};
    const int myidx0 = PIDX[(long)t * 128 + lane], myidx1 = PIDX[(long)t * 128 + 64 + lane];
    const float myw0 = PW[(long)t * 128 + lane], myw1 = PW[(long)t * 128 + 64 + lane];
    const float msu0 = SU[myidx0], msu1 = SU[myidx1], msv0 = SV[myidx0], msv1 = SV[myidx1];
    for (int hk = 0; hk < 128; hk += 4) {
        const int src = hk & 63; const bool lo = hk < 64;
        const int selidx = lo ? myidx0 : myidx1; const int selw = __float_as_int(lo ? myw0 : myw1), selsu = __float_as_int(lo ? msu0 : msu1), selsv = __float_as_int(lo ? msv0 : msv1);
        int e[4]; float g[4], su[4], sv[4];
#pragma unroll
        for (int k = 0; k < 4; ++k) { e[k] = __builtin_amdgcn_readlane(selidx, src + k); g[k] = __int_as_float(__builtin_amdgcn_readlane(selw, src + k));
            su[k] = __int_as_float(__builtin_amdgcn_readlane(selsu, src + k)); sv[k] = __int_as_float(__builtin_amdgcn_readlane(selsv, src + k)); }
        u32x4 uw[4][2], vw[4][2];
#pragma unroll
        for (int k = 0; k < 4; ++k) { uw[k][0] = *reinterpret_cast<const u32x4*>(PU + ((long)(lane >> 3) * NEXP + e[k]) * 128 + 16 * (lane & 7)); uw[k][1] = *reinterpret_cast<const u32x4*>(PU + ((long)(8 + (lane >> 3)) * NEXP + e[k]) * 128 + 16 * (lane & 7)); }
#pragma unroll
        for (int k = 0; k < 4; ++k) { { const u32x2 a0 = *reinterpret_cast<const u32x2*>(PV + ((long)(2 * lane) * NEXP + e[k]) * 8), a1 = *reinterpret_cast<const u32x2*>(PV + ((long)(2 * lane + 1) * NEXP + e[k]) * 8);
              const u32x2 b0 = *reinterpret_cast<const u32x2*>(PV + ((long)(128 + 2 * lane) * NEXP + e[k]) * 8), b1 = *reinterpret_cast<const u32x2*>(PV + ((long)(129 + 2 * lane) * NEXP + e[k]) * 8);
              vw[k][0] = (u32x4){a0.x, a0.y, a1.x, a1.y}; vw[k][1] = (u32x4){b0.x, b0.y, b1.x, b1.y}; } }
        float a[4];
#pragma unroll
        for (int k = 0; k < 4; ++k) { f32x2 d = (f32x2){0.f, 0.f};
#pragma unroll
            for (int hlf = 0; hlf < 2; ++hlf) { f32x2 f[8]; dec16(uw[k][hlf], f);
#pragma unroll
                for (int i = 0; i < 8; ++i) d = __builtin_elementwise_fma(f[i], xf[hlf][i], d); }
            a[k] = wave_sum(d[0] + d[1]); }
#pragma unroll
        for (int k = 0; k < 4; ++k) { const float ak = g[k] * gelu_exact(a[k] * su[k]) * sv[k]; const f32x2 a2 = (f32x2){ak, ak};
#pragma unroll
            for (int hlf = 0; hlf < 2; ++hlf) { f32x2 f[8]; dec16(vw[k][hlf], f);
#pragma unroll
                for (int i = 0; i < 8; ++i) out[hlf][i] = __builtin_elementwise_fma(f[i], a2, out[hlf][i]); } }
    }
    const float* gr = gate + (long)cond_row(t) * 12288;
#pragma unroll
    for (int hlf = 0; hlf < 2; ++hlf)
#pragma unroll
        for (int q = 0; q < 4; ++q) { const int c = 1024 * hlf + 16 * lane + 4 * q; float* xp = X + (long)t * DM + c;
            const f32x4 gv = *reinterpret_cast<const f32x4*>(gr + c); f32x4 xv = *reinterpret_cast<const f32x4*>(xp);
            xv[0] += gv[0] * out[hlf][2 * q][0]; xv[1] += gv[1] * out[hlf][2 * q][1]; xv[2] += gv[2] * out[hlf][2 * q + 1][0]; xv[3] += gv[3] * out[hlf][2 * q + 1][1];
            *reinterpret_cast<f32x4*>(xp) = xv; }
}

constexpr int SW = 128, NSL = DM / SW;
struct XInfo { int rank, xi, nx, nloc; };
__device__ __forceinline__ void upass(const bf16_t* __restrict__ H, const unsigned char* __restrict__ PU, const int* __restrict__ PIDX, const float* __restrict__ PW, const float* __restrict__ SU, const float* __restrict__ SV,
                                      float* __restrict__ DOTP, unsigned* __restrict__ PACKT, const XInfo xin, int wid, int lane) {
    const int g = lane >> 3, c = lane & 7; const int nwv = xin.nloc * 8;
    const int tlo = (int)((long)T * xin.xi / xin.nx), thi = (int)((long)T * (xin.xi + 1) / xin.nx); const int wv = tlo + xin.rank * 8 + wid;
    float* dp = DOTP;
    for (int s = 0; s < NSL; ++s) { const bool first = (s == 0), lastS = (s == NSL - 1);
        const __amdgpu_buffer_rsrc_t urs = __builtin_amdgcn_make_buffer_rsrc((void*)(PU + (long)s * NEXP * SW), 0, NEXP * SW, 0x00020000);
#define UP_ROW(e_) __builtin_bit_cast(u32x4, __builtin_amdgcn_raw_buffer_load_b128(urs, (e_) * SW + 16 * c, 0, 0))
#define UP_IDX(tt, q4) (*reinterpret_cast<const int4*>(PIDX + (long)(tt) * 128 + 16 * g + 4 * (q4)))
#define UP_X(tt, q2) (*reinterpret_cast<const u32x4*>(H + (long)(tt) * DM + SW * s + 16 * c + 8 * (q2)))
        if (wv >= thi) continue;
        u32x4 A[8], B[8]; int4 en[4]; u32x4 xn[2];
        { int4 e0[4];
#pragma unroll
          for (int q4 = 0; q4 < 4; ++q4) e0[q4] = UP_IDX(wv, q4);
          A[0] = UP_ROW(e0[0].x); A[1] = UP_ROW(e0[0].y); A[2] = UP_ROW(e0[0].z); A[3] = UP_ROW(e0[0].w); A[4] = UP_ROW(e0[1].x); A[5] = UP_ROW(e0[1].y); A[6] = UP_ROW(e0[1].z); A[7] = UP_ROW(e0[1].w);
          B[0] = UP_ROW(e0[2].x); B[1] = UP_ROW(e0[2].y); B[2] = UP_ROW(e0[2].z); B[3] = UP_ROW(e0[2].w); B[4] = UP_ROW(e0[3].x); B[5] = UP_ROW(e0[3].y); B[6] = UP_ROW(e0[3].z); B[7] = UP_ROW(e0[3].w);
          const int t1 = (wv + nwv < thi) ? wv + nwv : wv;
#pragma unroll
          for (int q4 = 0; q4 < 4; ++q4) en[q4] = UP_IDX(t1, q4);
          xn[0] = UP_X(wv, 0); xn[1] = UP_X(wv, 1); }
#pragma unroll 1
        for (int t = wv; t < thi; t += nwv) {
            const int tn = (t + nwv < thi) ? t + nwv : t, tnn = (tn + nwv < thi) ? tn + nwv : tn;
            f32x2 xf[8];
#pragma unroll
            for (int q2 = 0; q2 < 2; ++q2) { const u32x4 hw = xn[q2];
                xf[4 * q2 + 0] = (f32x2){bflo(hw.x), bfhi(hw.x)}; xf[4 * q2 + 1] = (f32x2){bflo(hw.y), bfhi(hw.y)}; xf[4 * q2 + 2] = (f32x2){bflo(hw.z), bfhi(hw.z)}; xf[4 * q2 + 3] = (f32x2){bflo(hw.w), bfhi(hw.w)}; }
            xn[0] = UP_X(tn, 0); xn[1] = UP_X(tn, 1);
            float d[16];
#pragma unroll
            for (int i = 0; i < 8; ++i) { f32x2 f[8]; dec16(A[i], f); f32x2 a = (f32x2){0.f, 0.f};
#pragma unroll
                for (int k = 0; k < 8; ++k) a = __builtin_elementwise_fma(f[k], xf[k], a);
                d[i] = a[0] + a[1]; }
            A[0] = UP_ROW(en[0].x); A[1] = UP_ROW(en[0].y); A[2] = UP_ROW(en[0].z); A[3] = UP_ROW(en[0].w); A[4] = UP_ROW(en[1].x); A[5] = UP_ROW(en[1].y); A[6] = UP_ROW(en[1].z); A[7] = UP_ROW(en[1].w);
#pragma unroll
            for (int i = 0; i < 8; ++i) { f32x2 f[8]; dec16(B[i], f); f32x2 a = (f32x2){0.f, 0.f};
#pragma unroll
                for (int k = 0; k < 8; ++k) a = __builtin_elementwise_fma(f[k], xf[k], a);
                d[8 + i] = a[0] + a[1]; }
            B[0] = UP_ROW(en[2].x); B[1] = UP_ROW(en[2].y); B[2] = UP_ROW(en[2].z); B[3] = UP_ROW(en[2].w); B[4] = UP_ROW(en[3].x); B[5] = UP_ROW(en[3].y); B[6] = UP_ROW(en[3].z); B[7] = UP_ROW(en[3].w);
#pragma unroll
            for (int q4 = 0; q4 < 4; ++q4) en[q4] = UP_IDX(tnn, q4);
            float r8[8], r4[4], r2[2];
#pragma unroll
            for (int k = 0; k < 8; ++k) { const float keep = (c & 4) ? d[k + 8] : d[k], send = (c & 4) ? d[k] : d[k + 8]; r8[k] = keep + sx<4>(send); }
#pragma unroll
            for (int k = 0; k < 4; ++k) { const float keep = (c & 2) ? r8[k + 4] : r8[k], send = (c & 2) ? r8[k] : r8[k + 4]; r4[k] = keep + sx<2>(send); }
#pragma unroll
            for (int k = 0; k < 2; ++k) { const float keep = (c & 1) ? r4[k + 2] : r4[k], send = (c & 1) ? r4[k] : r4[k + 2]; r2[k] = keep + sx<1>(send); }
            float* o = dp + (long)t * 128 + 16 * g + 2 * c;
            f32x2 acc = (f32x2){r2[0], r2[1]};
            if (!first) acc += *reinterpret_cast<const f32x2*>(o);
            if (!lastS) *reinterpret_cast<f32x2*>(o) = acc;
            else {
                const int p0 = 16 * g + 2 * c; const int2 ee = *reinterpret_cast<const int2*>(PIDX + (long)t * 128 + p0); const f32x2 gw = *reinterpret_cast<const f32x2*>(PW + (long)t * 128 + p0);
                const float a0 = gw[0] * gelu_exact(acc[0] * SU[ee.x]) * SV[ee.x], a1 = gw[1] * gelu_exact(acc[1] * SU[ee.y]) * SV[ee.y];
                u32x2 pk; pk.x = (cvt_pk_bf16(0.f, a0) & 0xffff0000u) | (unsigned)ee.x; pk.y = (cvt_pk_bf16(0.f, a1) & 0xffff0000u) | (unsigned)ee.y;
                *reinterpret_cast<u32x2*>(PACKT + ((long)(p0 >> 2) * T + t) * 4 + (p0 & 3)) = pk; }
        }
#undef UP_ROW
#undef UP_IDX
#undef UP_X
    }
}
__device__ __forceinline__ void actpass(const float* __restrict__ DOTP, const int* __restrict__ PIDX, const float* __restrict__ PW, const float* __restrict__ SU, const float* __restrict__ SV, float* __restrict__ ACT, int nx, long gt, long nt) {
    for (long i = gt; i < (long)T * 128; i += nt) { float dsum = 0.f;
        for (int x = 0; x < nx; ++x) dsum += DOTP[(long)x * T * 128 + i];
        const int e = PIDX[i]; const float av = PW[i] * gelu_exact(dsum * SU[e]) * SV[e]; const long t = i >> 7; const int pp = (int)(i & 127);
        reinterpret_cast<unsigned*>(ACT)[((long)(pp >> 2) * T + t) * 4 + (pp & 3)] = (cvt_pk_bf16(0.f, av) & 0xffff0000u) | (unsigned)e; }
}
__device__ __forceinline__ void vpass(const unsigned char* __restrict__ PV, const int* __restrict__ PIDX, const float* __restrict__ ACT, float* __restrict__ X, const float* __restrict__ gate, const XInfo xin, int wid, int lane) {
    const int g = lane >> 3, c = lane & 7; const int wv = xin.rank * 8 + wid, nwv = xin.nloc * 8;
    for (int s = xin.xi; s < NSL; s += xin.nx) {
        int4 en[4]; f32x4 an[4];
#pragma unroll
        for (int q4 = 0; q4 < 4; ++q4) { en[q4] = *reinterpret_cast<const int4*>(PIDX + (long)(wv < T ? wv : 0) * 128 + 16 * g + 4 * q4); an[q4] = *reinterpret_cast<const f32x4*>(ACT + (long)(wv < T ? wv : 0) * 128 + 16 * g + 4 * q4); }
        for (int t = wv; t < T; t += nwv) {
            int e[16]; float a[16];
#pragma unroll
            for (int q4 = 0; q4 < 4; ++q4) { e[4 * q4] = en[q4].x; e[4 * q4 + 1] = en[q4].y; e[4 * q4 + 2] = en[q4].z; e[4 * q4 + 3] = en[q4].w; a[4 * q4] = an[q4][0]; a[4 * q4 + 1] = an[q4][1]; a[4 * q4 + 2] = an[q4][2]; a[4 * q4 + 3] = an[q4][3]; }
            u32x4 w[16];
#pragma unroll
            for (int i = 0; i < 16; ++i) w[i] = *reinterpret_cast<const u32x4*>(PV + ((long)s * NEXP + e[i]) * SW + 16 * c);
            { const int tn = (t + nwv < T) ? t + nwv : t;
#pragma unroll
              for (int q4 = 0; q4 < 4; ++q4) { en[q4] = *reinterpret_cast<const int4*>(PIDX + (long)tn * 128 + 16 * g + 4 * q4); an[q4] = *reinterpret_cast<const f32x4*>(ACT + (long)tn * 128 + 16 * g + 4 * q4); } }
            f32x2 o[8];
#pragma unroll
            for (int k = 0; k < 8; ++k) o[k] = (f32x2){0.f, 0.f};
#pragma unroll
            for (int i = 0; i < 16; ++i) { f32x2 f[8]; dec16(w[i], f); const f32x2 a2 = (f32x2){a[i], a[i]};
#pragma unroll
                for (int k = 0; k < 8; ++k) o[k] = __builtin_elementwise_fma(f[k], a2, o[k]); }
            f32x2 r4[4], r2[2], r1;
#pragma unroll
            for (int k = 0; k < 4; ++k) { const f32x2 keep = (g & 4) ? o[k + 4] : o[k], send = (g & 4) ? o[k] : o[k + 4]; r4[k] = keep + (f32x2){sx<32>(send[0]), sx<32>(send[1])}; }
#pragma unroll
            for (int k = 0; k < 2; ++k) { const f32x2 keep = (g & 2) ? r4[k + 2] : r4[k], send = (g & 2) ? r4[k] : r4[k + 2]; r2[k] = keep + (f32x2){sx<16>(send[0]), sx<16>(send[1])}; }
            { const f32x2 keep = (g & 1) ? r2[1] : r2[0], send = (g & 1) ? r2[0] : r2[1]; r1 = keep + (f32x2){sx<8>(send[0]), sx<8>(send[1])}; }
            const int col = SW * s + 16 * c + 2 * g;
            const f32x2 gv = *reinterpret_cast<const f32x2*>(gate + (long)cond_row(t) * 12288 + col);
            float* xp = X + (long)t * DM + col; f32x2 xv = *reinterpret_cast<const f32x2*>(xp);
            xv += gv * r1; *reinterpret_cast<f32x2*>(xp) = xv;
        }
    }
}

__device__ __forceinline__ void vpass_lds(const unsigned char* __restrict__ PV, const unsigned* __restrict__ PACKT, float* __restrict__ X, const float* __restrict__ gate, char* lds, int bid, int nb, int s_end, int tid) {
    const int wid = tid >> 6, lane = tid & 63;
    for (int s = bid; s < s_end; s += nb) {
        __syncthreads();
        { const u32x4* src = reinterpret_cast<const u32x4*>(PV + (long)s * NEXP * 8); u32x4* dst = reinterpret_cast<u32x4*>(lds);
#pragma unroll 4
          for (int i = tid; i < NEXP * 8 / 16; i += 512) dst[i] = src[i]; }
        __syncthreads();
        u32x4 h0[8], h1[8];
        const __amdgpu_buffer_rsrc_t vrs = __builtin_amdgcn_make_buffer_rsrc((void*)PACKT, 0, (int)((size_t)T * 128 * 4), 0x00020000);
#define VP_LD(k, toff) __builtin_bit_cast(u32x4, __builtin_amdgcn_raw_buffer_load_b128(vrs, (int)(toff), (int)((size_t)(k) * T * 16), 0))
        { const unsigned toff = (unsigned)(wid * 64 + lane) * 16u;
#pragma unroll
          for (int k = 0; k < 8; ++k) h0[k] = VP_LD(k, toff);
#pragma unroll
          for (int k = 0; k < 8; ++k) h1[k] = VP_LD(8 + k, toff); }
#define VP_STEP(HB) do { _Pragma("unroll") for (int kk = 0; kk < 8; kk += 2) { unsigned pw[8]; \
            _Pragma("unroll") for (int k = 0; k < 2; ++k) { pw[4 * k] = HB[kk + k].x; pw[4 * k + 1] = HB[kk + k].y; pw[4 * k + 2] = HB[kk + k].z; pw[4 * k + 3] = HB[kk + k].w; } \
            u32x2 w[8]; \
            _Pragma("unroll") for (int k = 0; k < 8; ++k) w[k] = *reinterpret_cast<const u32x2*>(lds + (pw[k] & 0xffffu) * 8u); \
            _Pragma("unroll") for (int k = 0; k < 8; ++k) { const float a = __uint_as_float(pw[k] & 0xffff0000u); \
                const f32x2 f0 = __builtin_amdgcn_cvt_pk_f32_fp8((int)w[k].x, false), f1 = __builtin_amdgcn_cvt_pk_f32_fp8((int)w[k].x, true), f2 = __builtin_amdgcn_cvt_pk_f32_fp8((int)w[k].y, false), f3 = __builtin_amdgcn_cvt_pk_f32_fp8((int)w[k].y, true); \
                acc[0] = fmaf(a, f0[0], acc[0]); acc[1] = fmaf(a, f0[1], acc[1]); acc[2] = fmaf(a, f1[0], acc[2]); acc[3] = fmaf(a, f1[1], acc[3]); \
                acc[4] = fmaf(a, f2[0], acc[4]); acc[5] = fmaf(a, f2[1], acc[5]); acc[6] = fmaf(a, f3[0], acc[6]); acc[7] = fmaf(a, f3[1], acc[7]); } } } while (0)
#pragma unroll 1
        for (int tg = wid; tg < T / 64; tg += 8) { const int t = tg * 64 + lane; const int tgn = (tg + 8 < T / 64) ? tg + 8 : tg;
            const unsigned toff = (unsigned)t * 16u, toffn = (unsigned)(tgn * 64 + lane) * 16u;
            float acc[8];
#pragma unroll
            for (int j = 0; j < 8; ++j) acc[j] = 0.f;
            VP_STEP(h0);
#pragma unroll
            for (int k = 0; k < 8; ++k) h0[k] = VP_LD(16 + k, toff);
            VP_STEP(h1);
#pragma unroll
            for (int k = 0; k < 8; ++k) h1[k] = VP_LD(24 + k, toff);
            VP_STEP(h0);
#pragma unroll
            for (int k = 0; k < 8; ++k) h0[k] = VP_LD(k, toffn);
            VP_STEP(h1);
#pragma unroll
            for (int k = 0; k < 8; ++k) h1[k] = VP_LD(8 + k, toffn);
            const float* gr = gate + (long)cond_row(t) * 12288 + 8 * s; float* xp = X + (long)t * DM + 8 * s;
            const f32x4 g0 = *reinterpret_cast<const f32x4*>(gr), g1 = *reinterpret_cast<const f32x4*>(gr + 4);
            f32x4 x0 = *reinterpret_cast<const f32x4*>(xp), x1 = *reinterpret_cast<const f32x4*>(xp + 4);
            x0[0] += g0[0] * acc[0]; x0[1] += g0[1] * acc[1]; x0[2] += g0[2] * acc[2]; x0[3] += g0[3] * acc[3];
            x1[0] += g1[0] * acc[4]; x1[1] += g1[1] * acc[5]; x1[2] += g1[2] * acc[6]; x1[3] += g1[3] * acc[7];
            *reinterpret_cast<f32x4*>(xp) = x0; *reinterpret_cast<f32x4*>(xp + 4) = x1; }
#undef VP_STEP
#undef VP_LD
    }
    __syncthreads();
}
}
namespace ph {
__device__ __forceinline__ int gwave() { return obid() * 8 + (otid() >> 6); }
__device__ __forceinline__ int nwaves() { return ogrid() * 8; }
__device__ __forceinline__ long gthread() { return (long)obid() * 512 + otid(); }
__device__ __forceinline__ long nthreads() { return (long)ogrid() * 512; }

__device__ __forceinline__ void transpose_tile(const float* __restrict__ src, int C, int r0, int c0, bf16_t* __restrict__ dst, long dpitch, float* tile) {
    const int tid = otid();
#pragma unroll
    for (int i = 0; i < 8; ++i) { const int idx = tid + 512 * i, r = idx >> 6, c = idx & 63; tile[r * 65 + c] = src[(long)(r0 + r) * C + c0 + c]; }
    __syncthreads();
    { const int c = tid >> 3, rc = (tid & 7) * 8; float f[8];
#pragma unroll
      for (int j = 0; j < 8; ++j) f[j] = tile[(rc + j) * 65 + c];
      *reinterpret_cast<u32x4*>(dst + (long)(c0 + c) * dpitch + r0 + rc) = pack8(f); }
    __syncthreads();
}

__device__ __forceinline__ void zero_chunks(bf16_t* base, long nrows, long rowpitch, int col0, int nchunk) {
    const long total = nrows * nchunk;
    for (long i = gthread(); i < total; i += nthreads()) { const long r = i / nchunk; const int ch = (int)(i % nchunk);
        *reinterpret_cast<u32x4*>(base + r * rowpitch + col0 + ch * 8) = (u32x4){0u, 0u, 0u, 0u}; }
}

__device__ __forceinline__ void prologue(KParams& p, char* lds) {
    unsigned char* ws = optr(gp(p.ws)); const int tid = otid();
    float* tile = (float*)lds;
    { struct TJob { const float* src; bf16_t* dst; int R, C, r0, c0, perm; };
      auto decode = [&](int it) { TJob j; j.perm = 0; const int l = it / 10656; int r = it % 10656;
        if (r < 5664) { j.src = gp(p.w_in) + (long)l * DM * INW; j.R = DM; j.C = INW; j.dst = (bf16_t*)(ws + WS_WIN) + (long)l * INWP * DM; }
        else if (r < 6048) { r -= 5664; j.src = gp(p.w_uq) + (long)l * 512 * 3072; j.R = 512; j.C = 3072; j.dst = (bf16_t*)(ws + WS_WUQ) + (long)l * 3072 * 512; j.perm = 1; }
        else if (r < 6560) { r -= 6048; j.src = gp(p.w_ukv) + (long)l * 512 * 4096; j.R = 512; j.C = 4096; j.dst = (bf16_t*)(ws + WS_WUKV) + (long)l * 4096 * 512; }
        else { r -= 6560; const int m = r >> 10; r &= 1023; j.R = DM; j.C = DM;
            j.src = (m == 0 ? gp(p.w_a) : m == 1 ? gp(p.w_b) : m == 2 ? gp(p.w_o) : gp(p.w_pq)) + (long)l * DM * DM;
            j.dst = (bf16_t*)(ws + (m == 0 ? WS_WA : m == 1 ? WS_WB : m == 2 ? WS_WO : WS_WPQ)) + (long)l * DM * DM; }
        const int ntc = j.C / 64; j.r0 = (r / ntc) * 64; j.c0 = (r % ntc) * 64; return j; };
      const int NTILES = 2 * 10656, G_ = ogrid(); int it = obid(); float v[8]; TJob cur{};
      if (it < NTILES) { cur = decode(it);
#pragma unroll
        for (int i = 0; i < 8; ++i) { const int idx = tid + 512 * i, r = idx >> 6, c = idx & 63; v[i] = cur.src[(long)(cur.r0 + r) * cur.C + cur.c0 + c]; } }
      while (it < NTILES) { const int itn = it + G_; float vn[8]; TJob nxt{};
        if (itn < NTILES) { nxt = decode(itn);
#pragma unroll
            for (int i = 0; i < 8; ++i) { const int idx = tid + 512 * i, r = idx >> 6, c = idx & 63; vn[i] = nxt.src[(long)(nxt.r0 + r) * nxt.C + nxt.c0 + c]; } }
#pragma unroll
        for (int i = 0; i < 8; ++i) { const int idx = tid + 512 * i, r = idx >> 6, c = idx & 63; tile[r * 65 + c] = v[i]; }
        __syncthreads();
        { const int c = tid >> 3, rc = (tid & 7) * 8; float f[8];
#pragma unroll
          for (int jj = 0; jj < 8; ++jj) f[jj] = tile[(rc + jj) * 65 + c];
          int drow = cur.c0 + c;
          if (cur.perm) { const int gq = drow / 768, o = drow - 768 * gq, hh = o / 192, w = o - 192 * hh;
              drow = 768 * gq + (w < 128 ? 128 * hh + w : (w < 160 ? 512 + 32 * hh + (w - 128) : 640 + 32 * hh + (w - 160))); }
          *reinterpret_cast<u32x4*>(cur.dst + (long)drow * cur.R + cur.r0 + rc) = pack8(f); }
        __syncthreads();
#pragma unroll
        for (int i = 0; i < 8; ++i) v[i] = vn[i];
        cur = nxt; it = itn; } }
    for (long i = gthread(); i < 2L * 16 * 512 * 32; i += nthreads()) { const int ch = (int)(i & 31); const long row = i >> 5; const int c = (int)(row & 511), h = (int)((row >> 9) & 15), l = (int)(row >> 13);
        u32x4 w = (u32x4){0u, 0u, 0u, 0u};
        if (ch < 16) { const float* s = gp(p.w_ukv) + (((long)l * 512 + c) * 16 + h) * 256 + ch * 8; float f[8];
#pragma unroll
            for (int j = 0; j < 8; ++j) f[j] = s[j];
            w = pack8(f); }
        *reinterpret_cast<u32x4*>((bf16_t*)(ws + WS_WUK) + row * 256 + ch * 8) = w; }
    for (long i = gthread(); i < 2L * 4096; i += nthreads()) { const bool second = i >= 4096; const long j8 = (second ? i - 4096 : i) * 8; const float* s = (second ? gp(p.peer_k2) : gp(p.peer_k1)) + j8; float f[8];
#pragma unroll
        for (int j = 0; j < 8; ++j) f[j] = s[j];
        *reinterpret_cast<u32x4*>((bf16_t*)(ws + (second ? WS_PK2 : WS_PK1)) + j8) = pack8(f); }
    for (int l = 0; l < 2; ++l) zero_chunks((bf16_t*)(ws + WS_WIN) + ((long)l * INWP + INW) * DM, INWP - INW, DM, 0, DM / 8);
    for (int b = 0; b < DB; ++b) zero_chunks((bf16_t*)(ws + WS_CKA) + ((long)b * KPAD + KALL) * QLD, KPAD - KALL, QLD, 0, QLD / 8);
    zero_chunks((bf16_t*)(ws + WS_CKA), (long)DB * KPAD, QLD, 576, 8);
    zero_chunks((bf16_t*)(ws + WS_CKT), (long)DB * 512, KPAD, KALL, (KPAD - KALL) / 8);
    zero_chunks((bf16_t*)(ws + WS_QL), (long)DB * 1024, QLD, 576, 8);
    for (long i = gthread(); i < 4096L * 96; i += nthreads()) { const int pos = (int)(i / 96), k = (int)(i % 96); const bool big = k >= 32; const int fi = big ? k - 32 : k; const float d = big ? 128.f : 64.f;
        const float inv = __builtin_amdgcn_exp2f(-(2.0f * (float)fi / d) * 13.287712379549449f);
        const float ang = (float)pos * inv; double rv = (double)ang * 0.15915494309189535; rv -= floor(rv); const float fr = (float)rv;
        float* dst = big ? (float*)(ws + WS_TAB128) + ((long)pos * 64 + fi) * 2 : (float*)(ws + WS_TAB64) + ((long)pos * 32 + fi) * 2;
        dst[0] = __builtin_amdgcn_cosf(fr); dst[1] = __builtin_amdgcn_sinf(fr); }
    { float* sc = (float*)lds;
      for (int it = obid(); it < 2 * 12 * 8; it += ogrid()) { const int l = it / 96, cc = (it % 96) / 8, ks = it % 8;
        __syncthreads();
        for (int i = tid; i < NCOND * 256; i += 512) { const int r = i >> 8, k = i & 255; const float c = r < NB ? gp(p.c_prompt)[(long)r * DM + ks * 256 + k] : gp(p.c_sample)[(long)(r - NB) * DM + ks * 256 + k]; sc[i] = siluf_(c); }
        __syncthreads();
        float a0[NCOND], a1[NCOND];
#pragma unroll
        for (int r = 0; r < NCOND; ++r) { a0[r] = 0.f; a1[r] = 0.f; }
        const float* wp = gp(p.w_ada) + ((long)l * DM + ks * 256) * 12288 + cc * 1024 + 2 * tid;
#pragma unroll 1
        for (int k = 0; k < 256; k += 4) { const f32x2 w0 = *reinterpret_cast<const f32x2*>(wp), w1 = *reinterpret_cast<const f32x2*>(wp + 12288), w2 = *reinterpret_cast<const f32x2*>(wp + 2 * 12288), w3 = *reinterpret_cast<const f32x2*>(wp + 3 * 12288);
            wp += 4 * 12288;
#pragma unroll
            for (int r = 0; r < NCOND; ++r) { const f32x4 s = *reinterpret_cast<const f32x4*>(sc + r * 256 + k);
                a0[r] = fmaf(s[0], w0[0], fmaf(s[1], w1[0], fmaf(s[2], w2[0], fmaf(s[3], w3[0], a0[r]))));
                a1[r] = fmaf(s[0], w0[1], fmaf(s[1], w1[1], fmaf(s[2], w2[1], fmaf(s[3], w3[1], a1[r]))));
                if ((r % 6) == 5) __builtin_amdgcn_sched_barrier(0); } }
        float* dst = (float*)(ws + WS_ADAP) + (((long)ks * 2 + l) * NCOND) * 12288 + cc * 1024 + 2 * tid;
#pragma unroll
        for (int r = 0; r < NCOND; ++r) *reinterpret_cast<f32x2*>(dst + (long)r * 12288) = (f32x2){a0[r], a1[r]}; }
      __syncthreads(); }
}

__device__ __forceinline__ void ada_reduce(KParams& p) {
    unsigned char* ws = optr(gp(p.ws)); const float* ap = (const float*)(ws + WS_ADAP); float* ad = (float*)(ws + WS_ADA); const long n = 2L * NCOND * 12288;
    for (long i = gthread(); i < n; i += nthreads()) { const int l = (int)(i / (NCOND * 12288L)); const int j = (int)(i % 12288);
        float s = gp(p.b_ada)[(long)l * 12288 + j];
#pragma unroll
        for (int ks = 0; ks < 8; ++ks) s += ap[(long)ks * n + i];
        ad[i] = s; }
}

__device__ __forceinline__ void modulate(KParams& p, int l, int which) {
    const int lane = otid() & 63; unsigned char* ws = optr(gp(p.ws)); const float* X = gp(p.out); bf16_t* H = (bf16_t*)(ws + WS_H);
    const float* g = (which ? gp(p.g_ffn) : gp(p.g_mix)) + (long)l * DM; const float* ada = (const float*)(ws + WS_ADA) + (long)l * NCOND * 12288 + (which ? 3 : 0) * DM;
    for (int t = gwave(); t < T; t += nwaves()) {
        const float* xr = (l == 0 && which == 0) ? (t < TP ? gp(p.x_prompt) + (long)t * DM : gp(p.x_sample) + (long)(t - TP) * DM) : X + (long)t * DM; f32x4 v[8]; float ss = 0.f;
#pragma unroll
        for (int j = 0; j < 8; ++j) { v[j] = *reinterpret_cast<const f32x4*>(xr + 256 * j + 4 * lane); ss += v[j][0] * v[j][0] + v[j][1] * v[j][1] + v[j][2] * v[j][2] + v[j][3] * v[j][3]; }
        ss = wave_sum(ss); const float rinv = rsqrtf(ss * (1.0f / DM) + EPS);
        const float* sh = ada + (long)cond_row(t) * 12288; const float* sc = sh + DM;
#pragma unroll
        for (int j = 0; j < 8; ++j) { const int c = 256 * j + 4 * lane; const f32x4 gv = *reinterpret_cast<const f32x4*>(g + c), sv = *reinterpret_cast<const f32x4*>(sc + c), hv = *reinterpret_cast<const f32x4*>(sh + c);
            const f32x4 y = v[j] * rinv * gv * (sv + 1.0f) + hv; u32x2 w; w.x = cvt_pk_bf16(y[0], y[1]); w.y = cvt_pk_bf16(y[2], y[3]);
            *reinterpret_cast<u32x2*>(H + (long)t * DM + c) = w; }
    }
}

__device__ __forceinline__ void cache_convert(KParams& p, int l, char* lds, int it0, int it1, int bidx, int nb) {
    const int tid = otid(); unsigned char* ws = optr(gp(p.ws)); float* tile = (float*)lds; bf16_t* CKA = (bf16_t*)(ws + WS_CKA); bf16_t* CKT = (bf16_t*)(ws + WS_CKT);
    { const int NT_ = it1, G_ = nb; int it = it0 + bidx; float v[8];
      const float* cbase = gp(p.cache_ckv) + (long)l * DB * PAST * 512;
#define CC_SRC(itx) (cbase + (((long)((itx) >> 8)) * PAST + (((itx) >> 3) & 31) * 64) * 512 + ((itx) & 7) * 64)
      if (it < NT_) { const float* src = CC_SRC(it);
#pragma unroll
        for (int i = 0; i < 8; ++i) { const int idx = tid + 512 * i, r = idx >> 6, c = idx & 63; v[i] = src[(long)r * 512 + c]; } }
      while (it < NT_) { const int b = it >> 8, kt = (it >> 3) & 31, ct = it & 7; const int itn = it + G_; float vn[8];
        if (itn < NT_) { const float* src = CC_SRC(itn);
#pragma unroll
            for (int i = 0; i < 8; ++i) { const int idx = tid + 512 * i, r = idx >> 6, c = idx & 63; vn[i] = src[(long)r * 512 + c]; } }
#pragma unroll
        for (int i = 0; i < 8; ++i) { const int idx = tid + 512 * i, r = idx >> 6, c = idx & 63; tile[r * 65 + c] = v[i]; }
        __syncthreads();
        { const int r = tid >> 3, cc = (tid & 7) * 8; float f[8];
#pragma unroll
          for (int j = 0; j < 8; ++j) f[j] = tile[r * 65 + cc + j];
          *reinterpret_cast<u32x4*>(CKA + ((long)b * KPAD + kt * 64 + r) * QLD + ct * 64 + cc) = pack8(f);
#pragma unroll
          for (int j = 0; j < 8; ++j) f[j] = tile[(cc + j) * 65 + r];
          *reinterpret_cast<u32x4*>(CKT + ((long)b * 512 + ct * 64 + r) * KPAD + kt * 64 + cc) = pack8(f); }
        __syncthreads();
#pragma unroll
        for (int i = 0; i < 8; ++i) v[i] = vn[i];
        it = itn; }
#undef CC_SRC
    }
    for (long i = (long)it0 * 64 + (long)bidx * 512 + tid; i < (long)it1 * 64; i += (long)nb * 512) { const long row = i >> 3; const int ch = (int)(i & 7); const int b = (int)(row >> 11), k = (int)(row & 2047);
        const float* s = gp(p.cache_krope) + (((long)l * DB + b) * PAST + k) * 64 + ch * 8; float f[8];
#pragma unroll
        for (int j = 0; j < 8; ++j) f[j] = s[j];
        *reinterpret_cast<u32x4*>(CKA + ((long)b * KPAD + k) * QLD + 512 + ch * 8) = pack8(f); }
}

__device__ __forceinline__ void post_win(KParams& p, int l) {
    const int lane = otid() & 63; unsigned char* ws = optr(gp(p.ws));
    bf16_t* Y = (bf16_t*)(ws + WS_Y); bf16_t* CQN = (bf16_t*)(ws + WS_CQN); bf16_t* CKVNP = (bf16_t*)(ws + WS_CKVNP); bf16_t* KRP = (bf16_t*)(ws + WS_KRP); bf16_t* CKA = (bf16_t*)(ws + WS_CKA); bf16_t* CKT = (bf16_t*)(ws + WS_CKT);
    const float* T64 = (const float*)(ws + WS_TAB64); const float* T128 = (const float*)(ws + WS_TAB128);
    for (int t = gwave(); t < T; t += nwaves()) {
        bf16_t* y = Y + (long)t * INWP; const int pos = tok_pos(t); const bool samp = t >= TP; const int ts = t - TP, b = ts >> 6, s = ts & 63;
        { float f[8], o[8]; unpack8(*reinterpret_cast<const u32x4*>(y + C_CQ + 8 * lane), f); float ss = 0.f;
#pragma unroll
          for (int j = 0; j < 8; ++j) ss += f[j] * f[j];
          ss = wave_sum(ss); const float rinv = rsqrtf(ss * (1.0f / 512.f) + EPS); const float* g = gp(p.g_q) + (long)l * 512 + 8 * lane;
#pragma unroll
          for (int j = 0; j < 8; ++j) o[j] = f[j] * rinv * g[j];
          *reinterpret_cast<u32x4*>(CQN + (long)t * 512 + 8 * lane) = pack8(o); }
        { float f[8], o[8]; unpack8(*reinterpret_cast<const u32x4*>(y + C_CKV + 8 * lane), f); float ss = 0.f;
#pragma unroll
          for (int j = 0; j < 8; ++j) ss += f[j] * f[j];
          ss = wave_sum(ss); const float rinv = rsqrtf(ss * (1.0f / 512.f) + EPS); const float* g = gp(p.g_kv) + (long)l * 512 + 8 * lane;
#pragma unroll
          for (int j = 0; j < 8; ++j) o[j] = f[j] * rinv * g[j];
          float* od = gp(p.out) + (samp ? O_CKVS + ((long)l * TS + ts) * 512 : O_CKVP + ((long)l * TP + t) * 512) + 8 * lane;
          *reinterpret_cast<f32x4*>(od) = (f32x4){o[0], o[1], o[2], o[3]}; *reinterpret_cast<f32x4*>(od + 4) = (f32x4){o[4], o[5], o[6], o[7]};
          const u32x4 w = pack8(o);
          if (!samp) *reinterpret_cast<u32x4*>(CKVNP + (long)t * 512 + 8 * lane) = w;
          else { *reinterpret_cast<u32x4*>(CKA + ((long)b * KPAD + PAST + s) * QLD + 8 * lane) = w;
#pragma unroll
              for (int j = 0; j < 8; ++j) CKT[((long)b * 512 + 8 * lane + j) * KPAD + PAST + s] = f2bf(o[j]); } }
        if (lane < 32) { const float x1 = bf2f(y[C_KR + lane]), x2 = bf2f(y[C_KR + 32 + lane]); const float c = T64[((long)pos * 32 + lane) * 2], sn = T64[((long)pos * 32 + lane) * 2 + 1];
            const float o1 = x1 * c - x2 * sn, o2 = x1 * sn + x2 * c;
            float* od = gp(p.out) + (samp ? O_KRS + ((long)l * TS + ts) * 64 : O_KRP + ((long)l * TP + t) * 64); od[lane] = o1; od[32 + lane] = o2;
            if (!samp) { KRP[(long)t * 64 + lane] = f2bf(o1); KRP[(long)t * 64 + 32 + lane] = f2bf(o2); }
            else { bf16_t* d = CKA + ((long)b * KPAD + PAST + s) * QLD + 512; d[lane] = f2bf(o1); d[32 + lane] = f2bf(o2); } }
        { const int hh = lane >> 3, d0 = (lane & 7) * 8; const float* cs = T128 + ((long)pos * 64 + d0) * 2; float cv[8], sv[8];
#pragma unroll
          for (int j = 0; j < 4; ++j) { const f32x4 q = *reinterpret_cast<const f32x4*>(cs + 4 * j); cv[2 * j] = q[0]; sv[2 * j] = q[1]; cv[2 * j + 1] = q[2]; sv[2 * j + 1] = q[3]; }
#pragma unroll
          for (int which = 0; which < 2; ++which) { bf16_t* base = y + (which ? C_RK : C_RQ) + hh * 128 + d0; const float sca = which ? 0.08838834764831845f : 1.0f;
              float a[8], bq[8], o1[8], o2[8]; unpack8(*reinterpret_cast<const u32x4*>(base), a); unpack8(*reinterpret_cast<const u32x4*>(base + 64), bq);
#pragma unroll
              for (int j = 0; j < 8; ++j) { o1[j] = (a[j] * cv[j] - bq[j] * sv[j]) * sca; o2[j] = (a[j] * sv[j] + bq[j] * cv[j]) * sca; }
              *reinterpret_cast<u32x4*>(base) = pack8(o1); *reinterpret_cast<u32x4*>(base + 64) = pack8(o2); } }
    }
}

__device__ __forceinline__ void post_q(KParams& p) {
    const int lane = otid() & 63; unsigned char* ws = optr(gp(p.ws)); bf16_t* Q = (bf16_t*)(ws + WS_Q); bf16_t* QL = (bf16_t*)(ws + WS_QL); const float* T64 = (const float*)(ws + WS_TAB64);
    for (int t = gwave(); t < T; t += nwaves()) { const int pos = tok_pos(t); const int hd = lane >> 2, d0 = (lane & 3) * 8;
        bf16_t* base = Q + (long)t * 3072 + hd * 192 + 128 + d0; const float* cs = T64 + ((long)pos * 32 + d0) * 2; float cv[8], sv[8];
#pragma unroll
        for (int j = 0; j < 4; ++j) { const f32x4 q = *reinterpret_cast<const f32x4*>(cs + 4 * j); cv[2 * j] = q[0]; sv[2 * j] = q[1]; cv[2 * j + 1] = q[2]; sv[2 * j + 1] = q[3]; }
        float a[8], bq[8], o1[8], o2[8]; unpack8(*reinterpret_cast<const u32x4*>(base), a); unpack8(*reinterpret_cast<const u32x4*>(base + 32), bq);
#pragma unroll
        for (int j = 0; j < 8; ++j) { o1[j] = a[j] * cv[j] - bq[j] * sv[j]; o2[j] = a[j] * sv[j] + bq[j] * cv[j]; }
        const u32x4 w1 = pack8(o1), w2 = pack8(o2);
        *reinterpret_cast<u32x4*>(base) = w1; *reinterpret_cast<u32x4*>(base + 32) = w2;
        if (t >= TP) { const int ts = t - TP, b = ts >> 6, s = ts & 63; bf16_t* d = QL + ((long)b * 1024 + hd * 64 + s) * QLD + 512 + d0;
            *reinterpret_cast<u32x4*>(d) = w1; *reinterpret_cast<u32x4*>(d + 32) = w2; } }
}

__device__ __forceinline__ void softmax_rows(KParams& p) {
    const int lane = otid() & 63; unsigned char* ws = optr(gp(p.ws)); bf16_t* SP = (bf16_t*)(ws + WS_SP);
    for (int r = gwave(); r < DB * 1024; r += nwaves()) { bf16_t* row = SP + (long)r * KPAD; float v[5][8]; float mx = -3.0e38f;
#pragma unroll
        for (int j = 0; j < 5; ++j) { const int ch = lane + 64 * j;
            if (ch < KALL / 8) { unpack8(*reinterpret_cast<const u32x4*>(row + ch * 8), v[j]);
#pragma unroll
                for (int i = 0; i < 8; ++i) { v[j][i] *= MLA_SCALE; mx = fmaxf(mx, v[j][i]); } }
            else {
#pragma unroll
                for (int i = 0; i < 8; ++i) v[j][i] = -3.0e38f; } }
        mx = wave_max(mx); float sum = 0.f;
#pragma unroll
        for (int j = 0; j < 5; ++j) { const int ch = lane + 64 * j;
#pragma unroll
            for (int i = 0; i < 8; ++i) { v[j][i] = (ch < KALL / 8) ? __expf(v[j][i] - mx) : 0.f; sum += v[j][i]; } }
        sum = wave_sum(sum); const float inv = 1.0f / sum;
#pragma unroll
        for (int j = 0; j < 5; ++j) { const int ch = lane + 64 * j;
            if (ch < KPAD / 8) { float o[8];
#pragma unroll
                for (int i = 0; i < 8; ++i) o[i] = v[j][i] * inv;
                *reinterpret_cast<u32x4*>(row + ch * 8) = pack8(o); } } }
}

__device__ __forceinline__ void gnorm_gate(KParams& p, int w0, int nw) {
    const int lane = otid() & 63; unsigned char* ws = optr(gp(p.ws)); const bf16_t* OB = (const bf16_t*)(ws + WS_OB); const bf16_t* Y = (const bf16_t*)(ws + WS_Y); bf16_t* BG = (bf16_t*)(ws + WS_BG);
    for (int t = w0; t < T; t += nw) { const int c0 = (lane >> 3) * 256 + (lane & 7) * 32; float x[4][8]; float s = 0.f;
#pragma unroll
        for (int i = 0; i < 4; ++i) { unpack8(*reinterpret_cast<const u32x4*>(OB + ((long)lane * T + t) * 32 + 8 * i), x[i]);
#pragma unroll
            for (int j = 0; j < 8; ++j) s += x[i][j]; }
        s += sx<1>(s); s += sx<2>(s); s += sx<4>(s); const float mu = s * (1.0f / 256.f); float q = 0.f;
#pragma unroll
        for (int i = 0; i < 4; ++i)
#pragma unroll
            for (int j = 0; j < 8; ++j) { const float d = x[i][j] - mu; q += d * d; }
        q += sx<1>(q); q += sx<2>(q); q += sx<4>(q); const float rstd = rsqrtf(q * (1.0f / 256.f) + EPS);
#pragma unroll
        for (int i = 0; i < 4; ++i) { float g[8], o[8]; unpack8(*reinterpret_cast<const u32x4*>(Y + (long)t * INWP + C_RG + c0 + 8 * i), g);
#pragma unroll
            for (int j = 0; j < 8; ++j) o[j] = siluf_(g[j]) * (x[i][j] - mu) * rstd;
            *reinterpret_cast<u32x4*>(BG + (long)t * DM + c0 + 8 * i) = pack8(o); } }
}

__device__ __forceinline__ void peer_convert(KParams& p, int l, int r0, int r1, int w0, int nw) {
    unsigned char* ws = optr(gp(p.ws)); const int lane = otid() & 63;
    const float* su = gp(p.peer_u) + (long)l * NEXP * DM; const float* sv = gp(p.peer_v) + (long)l * NEXP * DM;
    for (int r = r0 + w0; r < r1; r += nw) { const bool second = r >= NEXP; const int row = second ? r - NEXP : r; const float* s = (second ? sv : su) + (long)row * DM;
        f32x4 v[8]; float am = 0.f;
#pragma unroll
        for (int j = 0; j < 8; ++j) { v[j] = *reinterpret_cast<const f32x4*>(s + 512 * (j >> 2) * 2 + 16 * lane + 4 * (j & 3));
            am = fmaxf(am, fmaxf(fmaxf(fabsf(v[j][0]), fabsf(v[j][1])), fmaxf(fabsf(v[j][2]), fabsf(v[j][3])))); }
        am = wave_max(am);
        float sc = 1.0f, isc = 1.0f;
        if (am > 0.f) { const int e = (int)((__float_as_uint(am) >> 23) & 0xffu) - 127;
            int k = 7 - e; k = k > 100 ? 100 : (k < -100 ? -100 : k);
            sc = __uint_as_float((unsigned)(127 + k) << 23); isc = __uint_as_float((unsigned)(127 - k) << 23); }
        unsigned w[8];
#pragma unroll
        for (int j = 0; j < 8; ++j) { int pk = __builtin_amdgcn_cvt_pk_fp8_f32(v[j][0] * sc, v[j][1] * sc, 0, false); pk = __builtin_amdgcn_cvt_pk_fp8_f32(v[j][2] * sc, v[j][3] * sc, pk, true); w[j] = (unsigned)pk; }
        if (!second) {
            unsigned char* dst = ws + WS_PU + ((long)(lane >> 3) * NEXP + row) * 128 + 16 * (lane & 7);
            *reinterpret_cast<u32x4*>(dst) = (u32x4){w[0], w[1], w[2], w[3]};
            *reinterpret_cast<u32x4*>(dst + 8L * NEXP * 128) = (u32x4){w[4], w[5], w[6], w[7]};
        } else {
            unsigned char* dst = ws + WS_PV + ((long)(2 * lane) * NEXP + row) * 8;
            *reinterpret_cast<u32x2*>(dst) = (u32x2){w[0], w[1]}; *reinterpret_cast<u32x2*>(dst + (long)NEXP * 8) = (u32x2){w[2], w[3]};
            *reinterpret_cast<u32x2*>(dst + 128L * NEXP * 8) = (u32x2){w[4], w[5]}; *reinterpret_cast<u32x2*>(dst + 129L * NEXP * 8) = (u32x2){w[6], w[7]}; }
        if (lane == 0) ((float*)(ws + (second ? WS_PSV : WS_PSU)))[row] = isc; }
}

__device__ __forceinline__ void final_norm(KParams& p) {
    const int lane = otid() & 63; float* X = gp(p.out);
    for (int t = gwave(); t < T; t += nwaves()) { float* xr = X + (long)t * DM; f32x4 v[8]; float ss = 0.f;
#pragma unroll
        for (int j = 0; j < 8; ++j) { v[j] = *reinterpret_cast<const f32x4*>(xr + 256 * j + 4 * lane); ss += v[j][0] * v[j][0] + v[j][1] * v[j][1] + v[j][2] * v[j][2] + v[j][3] * v[j][3]; }
        ss = wave_sum(ss); const float rinv = rsqrtf(ss * (1.0f / DM) + EPS);
#pragma unroll
        for (int j = 0; j < 8; ++j) { const int c = 256 * j + 4 * lane; const f32x4 gv = *reinterpret_cast<const f32x4*>(gp(p.g_final) + c); *reinterpret_cast<f32x4*>(xr + c) = v[j] * rinv * gv; } }
}
}
__global__ void __launch_bounds__(512, 2) mega_fwd(Params p_by_value_unused) {
    extern __shared__ __attribute__((aligned(16))) unsigned char shm[];
    LAS unsigned char* lds = (LAS unsigned char*)shm; char* ldsg = (char*)shm;
    if (threadIdx.x < 8) ((LAS unsigned*)(lds + LDS_BARW))[threadIdx.x] = 0u;
    __syncthreads();
    if (threadIdx.x == 0) { unsigned* tk = (unsigned*)(gp(KP.ws) + WS_CTL + CTL_RANK) + 64 * xb_xcc_id(); ((volatile LAS unsigned*)(lds + LDS_BARW))[2] = xb_add(tk, 1u); }
    const XcdBarrier bar = xcd_barrier_post((unsigned*)(gp(KP.ws) + WS_CTL), (volatile LAS unsigned*)(lds + LDS_BARW));
#define GRID_SYNC() xcd_barrier(bar)
#ifndef STOP_AT
#define STOP_AT 0
#endif
#ifdef DBG_DUMP
#define STOPCHK(n) do { if (STOP_AT == (n)) { float* xo = gp(KP.out); const bf16_t* src = (const bf16_t*)(gp(KP.ws) + DBG_DUMP); for (long i = ph::gthread(); i < (long)T * DM; i += ph::nthreads()) xo[i] = bf2f(src[i]); return; } } while (0)
#elif defined(DBG_SANITIZE)
#define STOPCHK(n) do { if (STOP_AT == (n) || (STOP_AT > 100 && l == 1 && STOP_AT - 100 == (n))) { float* xo = gp(KP.out); for (long i = ph::gthread(); i < (long)T * DM; i += ph::nthreads()) { const float v = xo[i]; if (!(v - v == 0.0f)) xo[i] = 7.0f; } return; } } while (0)
#else
#define STOPCHK(n) do { if (STOP_AT == (n) || (STOP_AT > 100 && l == 1 && STOP_AT - 100 == (n))) return; } while (0)
#endif
    using namespace pg8;
#define WSP(off) ((bf16_t*)(optr(gp(KP.ws)) + (off)))
#define H WSP(WS_H)
#define Y WSP(WS_Y)
#define CQN WSP(WS_CQN)
#define CKVNP WSP(WS_CKVNP)
#define KRP WSP(WS_KRP)
#define Q WSP(WS_Q)
#define YA WSP(WS_YA)
#define KV WSP(WS_KV)
#define SP WSP(WS_SP)
#define MIX WSP(WS_MIX)
#define OA WSP(WS_OA)
#define QP WSP(WS_QP)
#define CKA WSP(WS_CKA)
#define CKT WSP(WS_CKT)
#define QL WSP(WS_QL)
#define OL WSP(WS_OL)
#define BG WSP(WS_BG)
    int l = 0;
    ph::prologue(KP, ldsg);
#ifdef DUP_PRO
    ph::prologue(KP, ldsg);
#endif
    GRID_SYNC(); STOPCHK(1);
    if (threadIdx.x == 0) { unsigned* barw = (unsigned*)(gp(KP.ws) + WS_CTL); const unsigned me = xb_xcc_id(); unsigned nx = 0, xi = 0, nloc = 1;
        for (unsigned j = 0; j < 16; ++j) { const unsigned cn = xb_ld(&barw[XB_XCNT(j)]); if (cn) { if (j < me) ++xi; ++nx; } if (j == me) nloc = cn ? cn : 1u; }
        volatile LAS unsigned* iw = (volatile LAS unsigned*)(lds + LDS_BARW); iw[3] = xi; iw[4] = nx; iw[5] = nloc; }
    __syncthreads();
    ph::ada_reduce(KP);
    GRID_SYNC(); STOPCHK(2);
    for (l = 0; l < DEPTH; ++l) {
#define WIN (WSP(WS_WIN) + (long)l * INWP * DM)
#define WUQ (WSP(WS_WUQ) + (long)l * 3072 * 512)
#define WUKV (WSP(WS_WUKV) + (long)l * 4096 * 512)
#define WUK (WSP(WS_WUK) + (long)l * 16 * 512 * 256)
#define WA (WSP(WS_WA) + (long)l * DM * DM)
#define WB (WSP(WS_WB) + (long)l * DM * DM)
#define WO (WSP(WS_WO) + (long)l * DM * DM)
#define WPQ (WSP(WS_WPQ) + (long)l * DM * DM)
#define ADA ((const float*)(optr(gp(KP.ws)) + WS_ADA) + (long)l * NCOND * 12288)
        ph::modulate(KP, l, 0);
        ph::cache_convert(KP, l, ldsg, l == 0 ? 0 : 4096, 8192, obid(), ogrid());
        GRID_SYNC(); STOPCHK(3);
        { Sched<0> S; S.init(T / 256, INWP / 256, (T / 256) * (INWP / 256), DM, DM); gemm_phase(lds, Gemm{H, WIN, DM, DM, DM}, S, EpiBf16{Y, INWP, 0}); }
#ifdef DUP_WIN
        { Sched<0> S; S.init(T / 256, INWP / 256, (T / 256) * (INWP / 256), DM, DM); gemm_phase(lds, Gemm{H, WIN, DM, DM, DM}, S, EpiBf16{Y, INWP, 0}); }
#endif
        GRID_SYNC(); STOPCHK(4);
        ph::post_win(KP, l);
        GRID_SYNC(); STOPCHK(5);
        { Sched<0> S; S.init(T / 256, 3072 / 256, (T / 256) * 12, 512, 512); gemm_phase(lds, Gemm{CQN, WUQ, 512, 512, 512}, S, EpiQ{Q, QL, (const float*)(optr(gp(KP.ws)) + WS_TAB64)}); }
        { Sched<0> S; S.init(TP / 256, 4096 / 256, (TP / 256) * 16, 512, 512); gemm_phase(lds, Gemm{CKVNP, WUKV, 512, 512, 512}, S, EpiBf16{KV, 4096, 0}); }
        GRID_SYNC(); STOPCHK(6);
#ifndef DUP_ATTN
#define DUP_ATTN 1
#endif
#ifndef DUP_RET
#define DUP_RET 1
#endif
#ifndef DUP_GATHER
#define DUP_GATHER 0
#endif
#pragma unroll 1
        for (int rep_ = 0; rep_ < DUP_ATTN; ++rep_)
        { for (int u = obid(); u < 512; u += ogrid()) { const int c = u & 255, i = u >> 8, xcd = c & 7, slot = c >> 3; const int bh = xcd * 4 + (slot >> 3) + 32 * i, pr = slot & 7, b = bh >> 4, h = bh & 15;
#pragma unroll 1
              for (int z = 0; z < 2; ++z) { const int qb = z ? 15 - pr : pr; const long tok0 = (long)b * SEQ + 256 * qb;
                  att::attn_block(Q + tok0 * 3072 + h * 192, KV + (long)b * SEQ * 4096 + h * 256, KRP + (long)b * SEQ * 64, KV + (long)b * SEQ * 4096 + h * 256 + 128, OA + tok0 * DM + h * 128, qb, ldsg); } } }
        { Sched<1> S; S.init(0, 0, 256, 3072, 256); gemm_phase(lds, Gemm{Q, WUK, 256, 3072, 256}, S, EpiRowMap<1>{QL}); }
        GRID_SYNC(); STOPCHK(8);
        { Sched<2> S; S.init(0, 0, DB * 36, QLD, QLD); gemm_phase(lds, Gemm{QL, CKA, QLD, QLD, QLD}, S, EpiBf16{SP, KPAD, 1024L * KPAD}); }
        GRID_SYNC(); STOPCHK(9);
        ph::softmax_rows(KP);
        GRID_SYNC(); STOPCHK(10);
        { Sched<3> S; S.init(0, 0, 256, KPAD, KPAD); gemm_phase(lds, Gemm{SP, CKT, 2176, KPAD, KPAD}, S, EpiRowMap<3>{OL}); }
        GRID_SYNC(); STOPCHK(11);
        { Sched<4> S; S.init(0, 0, 128, 512, 512); gemm_phase(lds, Gemm{OL, WUKV, 512, 512, 512}, S, EpiOV{OA}); }
#pragma unroll 1
        for (int rep_ = 0; rep_ < DUP_RET; ++rep_)
        for (int u = obid(); u < 256 + DB * 64; u += ogrid()) ret::unit(KP, l, u, ldsg);
#ifdef DUP_RETP
        for (int u = obid(); u < 256; u += ogrid()) ret::unit(KP, l, u, ldsg);
#endif
        GRID_SYNC(); STOPCHK(12);
        { Sched<0> S; S.init(T / 256, DM / 256, (T / 256) * 8, DM, DM); gemm_phase(lds, Gemm{OA, WA, DM, DM, DM}, S, EpiBf16{YA, DM, 0}); }
        { const int G_ = ogrid(), rem_ = ((T / 256) * 8) % G_; const int b_ = obid();
          if (rem_ == 0) ph::gnorm_gate(KP, ph::gwave(), ph::nwaves());
          else if (b_ >= rem_) ph::gnorm_gate(KP, (b_ - rem_) * 8 + (otid() >> 6), (G_ - rem_) * 8); }
#ifdef DUP_WA
        { Sched<0> S; S.init(T / 256, DM / 256, (T / 256) * 8, DM, DM); gemm_phase(lds, Gemm{OA, WA, DM, DM, DM}, S, EpiBf16{YA, DM, 0}); }
#endif
        GRID_SYNC(); STOPCHK(14);
        { Sched<0> S; S.init(T / 256, DM / 256, (T / 256) * 8, DM, DM); gemm_phase(lds, Gemm{BG, WB, DM, DM, DM}, S, EpiMix{Y, YA, MIX}); }
        { const int G_ = ogrid(), rem_ = ((T / 256) * 8) % G_; const int b_ = obid();
          if (rem_ == 0) ph::peer_convert(KP, l, 0, NEXP, ph::gwave(), ph::nwaves());
          else if (b_ >= rem_) ph::peer_convert(KP, l, 0, NEXP, (b_ - rem_) * 8 + (otid() >> 6), (G_ - rem_) * 8); }
        GRID_SYNC(); STOPCHK(15);
        { Sched<0> S; S.init(T / 256, DM / 256, (T / 256) * 8, DM, DM); gemm_phase(lds, Gemm{MIX, WO, DM, DM, DM}, S, EpiRes{gp(KP.out), ADA + 2 * DM, l == 0 ? gp(KP.x_prompt) : gp(KP.out), l == 0 ? gp(KP.x_sample) : gp(KP.out) + (long)TP * DM}); }
        { const int G_ = ogrid(), rem_ = ((T / 256) * 8) % G_; const int b_ = obid();
          if (rem_ == 0) ph::peer_convert(KP, l, NEXP, 2 * NEXP, ph::gwave(), ph::nwaves());
          else if (b_ >= rem_) ph::peer_convert(KP, l, NEXP, 2 * NEXP, (b_ - rem_) * 8 + (otid() >> 6), (G_ - rem_) * 8); }
        GRID_SYNC(); STOPCHK(16);
        ph::modulate(KP, l, 1);
        GRID_SYNC(); STOPCHK(17);
        { Sched<0> S; S.init(T / 256, DM / 256, (T / 256) * 8, DM, DM); gemm_phase(lds, Gemm{H, WPQ, DM, DM, DM}, S, EpiBf16{QP, DM, 0}); }
        if (l + 1 < DEPTH) { const int G_ = ogrid(), rem_ = ((T / 256) * 8) % G_; const int b_ = obid();
          if (rem_ == 0) ph::cache_convert(KP, l + 1, ldsg, 0, 4096, b_, G_);
          else if (b_ >= rem_) ph::cache_convert(KP, l + 1, ldsg, 0, 4096, b_ - rem_, G_ - rem_); }
        GRID_SYNC(); STOPCHK(18);
        { const int tid_ = otid(); const int lane = tid_ & 63; float* strip = (float*)ldsg + tid_ * 33; unsigned char* ws = optr(gp(KP.ws));
          const bf16_t* k1g = (const bf16_t*)(ws + WS_PK1) + (long)l * 128 * 128; const bf16_t* k2g = (const bf16_t*)(ws + WS_PK2) + (long)l * 128 * 128;
          bf16_t* k1 = (bf16_t*)(ldsg + 512 * 33 * 4 + 64); bf16_t* k2 = k1 + 128 * peer::KPITCH;
          for (int i = tid_; i < 2 * 128 * 16; i += 512) { const int which = i >> 11, r = (i >> 4) & 127, ch = i & 15;
              *reinterpret_cast<u32x4*>((which ? k2 : k1) + r * peer::KPITCH + ch * 8) = *reinterpret_cast<const u32x4*>((which ? k2g : k1g) + r * 128 + ch * 8); }
          __syncthreads();
          for (int wu = ph::gwave(); wu < (T / 32) * PH; wu += ph::nwaves()) peer::select_unit(QP, k1, k2, (int*)(ws + WS_PIDX), (float*)(ws + WS_PW), (wu >> 3) * 32, wu & 7, lane, strip);
#ifdef DUP_SEL
          for (int wu = ph::gwave(); wu < (T / 32) * PH; wu += ph::nwaves()) peer::select_unit(QP, k1, k2, (int*)(ws + WS_PIDX), (float*)(ws + WS_PW), (wu >> 3) * 32, wu & 7, lane, strip);
#endif
        }
        GRID_SYNC(); STOPCHK(19);
        { const int tid_ = otid(); const int lane = tid_ & 63, wid = tid_ >> 6; unsigned char* ws = optr(gp(KP.ws));
          volatile LAS unsigned* iw = (volatile LAS unsigned*)(lds + LDS_BARW); peer::XInfo xin; xin.rank = __builtin_amdgcn_readfirstlane((int)iw[2]); xin.xi = __builtin_amdgcn_readfirstlane((int)iw[3]); xin.nx = __builtin_amdgcn_readfirstlane((int)iw[4]); xin.nloc = __builtin_amdgcn_readfirstlane((int)iw[5]);
          if (xin.nx >= 1 && xin.nx <= 8) {
              peer::upass(H, (const unsigned char*)(ws + WS_PU), (const int*)(ws + WS_PIDX), (const float*)(ws + WS_PW), (const float*)(ws + WS_PSU), (const float*)(ws + WS_PSV), (float*)(ws + WS_DOTP), (unsigned*)(ws + WS_ACT), xin, wid, lane);
              GRID_SYNC();
              int vs0_, vsn_, vse_;
              if ((256 % xin.nx) == 0) { const int spx = 256 / xin.nx; vs0_ = xin.xi * spx + xin.rank; vsn_ = xin.nloc; vse_ = (xin.xi + 1) * spx; }
              else { vs0_ = obid(); vsn_ = ogrid(); vse_ = 256; }
              peer::vpass_lds((const unsigned char*)(ws + WS_PV), (const unsigned*)(ws + WS_ACT), gp(KP.out), ADA + 5 * DM, ldsg, vs0_, vsn_, vse_, tid_);
#ifdef DUP_VP
              peer::vpass_lds((const unsigned char*)(ws + WS_PV), (const unsigned*)(ws + WS_ACT), (float*)(ws + WS_OB), ADA + 5 * DM, ldsg, vs0_, vsn_, vse_, tid_);
#endif
          } else {
              for (int t = ph::gwave(); t < T; t += ph::nwaves()) peer::gather_token(H, (const unsigned char*)(ws + WS_PU), (const unsigned char*)(ws + WS_PV), (const float*)(ws + WS_PSU), (const float*)(ws + WS_PSV), (const int*)(ws + WS_PIDX), (const float*)(ws + WS_PW), gp(KP.out), ADA + 5 * DM, t, lane);
          } }
        GRID_SYNC(); STOPCHK(20);
    }
    ph::final_norm(KP);
}

extern "C" void kernel_launch(void* const* d_in, const int* in_sizes, int n_in, void* d_out, int out_size, void* d_ws, size_t ws_size, hipStream_t stream) {
    static int grid = 0;
    if (grid == 0) {
        if (n_in != 25 || out_size != (int)O_END || ws_size < WS_END) { fprintf(stderr, "kernel_launch: shape mismatch: n_in %d out %d (want %ld) ws %zu (want >= %zu)\n", n_in, out_size, O_END, ws_size, (size_t)WS_END); grid = -1; return; }
        int dev = 0, cus = 0, per_cu = 0;
        if (hipGetDevice(&dev) != hipSuccess || hipDeviceGetAttribute(&cus, hipDeviceAttributeMultiprocessorCount, dev) != hipSuccess) { fprintf(stderr, "kernel_launch: device query failed\n"); grid = -1; return; }
        if (hipFuncSetAttribute((const void*)mega_fwd, hipFuncAttributeMaxDynamicSharedMemorySize, LDS_BYTES) != hipSuccess) { fprintf(stderr, "kernel_launch: hipFuncSetAttribute failed\n"); grid = -1; return; }
        if (hipOccupancyMaxActiveBlocksPerMultiprocessor(&per_cu, (const void*)mega_fwd, 512, LDS_BYTES) != hipSuccess || per_cu < 1) { fprintf(stderr, "kernel_launch: occupancy query says %d blocks per CU\n", per_cu); grid = -1; return; }
        grid = cus;
#ifdef FORCE_GRID
        grid = FORCE_GRID;
#endif
    }
    if (grid < 0) return;
    (void)hipMemsetAsync((char*)d_ws + WS_CTL, 0, CTL_BYTES, stream);
    Params p{};
    const float* const* in = (const float* const*)d_in;
    p.x_prompt = in[0]; p.x_sample = in[1]; p.c_prompt = in[2]; p.c_sample = in[3]; p.cache_ckv = in[4]; p.cache_krope = in[5]; p.state_ret = in[6]; p.w_ada = in[7]; p.b_ada = in[8];
    p.g_mix = in[9]; p.g_ffn = in[10]; p.w_in = in[11]; p.g_q = in[12]; p.w_uq = in[13]; p.g_kv = in[14]; p.w_ukv = in[15]; p.w_a = in[16]; p.w_b = in[17]; p.w_o = in[18]; p.w_pq = in[19];
    p.peer_k1 = in[20]; p.peer_k2 = in[21]; p.peer_u = in[22]; p.peer_v = in[23]; p.g_final = in[24];
    p.out = (float*)d_out; p.ws = (unsigned char*)d_ws;
    for (int h = 0; h < 8; ++h) p.lg[h] = (float)log1p(-pow(2.0, -5.0 - (double)h));
    p.grid = grid; p.pad_ = 0;
    hipLaunchKernelGGL(mega_fwd, dim3(grid), dim3(512), LDS_BYTES, stream, p);
    const hipError_t le = hipGetLastError();
    if (le != hipSuccess) fprintf(stderr, "kernel_launch: launch failed: %s\n", hipGetErrorName(le));
}
```

```cpp
#include <hip/hip_runtime.h>
#include <cstdio>
#include <cstdint>
#include <cmath>

#define LAS __attribute__((address_space(3)))
typedef unsigned short bf16_t;
typedef short bf16x8 __attribute__((ext_vector_type(8)));
typedef float f32x4 __attribute__((ext_vector_type(4)));
typedef float f32x2 __attribute__((ext_vector_type(2)));
typedef float f32x16 __attribute__((ext_vector_type(16)));
typedef unsigned u32x4 __attribute__((ext_vector_type(4)));
typedef unsigned u32x2 __attribute__((ext_vector_type(2)));
typedef short s16x4 __attribute__((ext_vector_type(4)));

constexpr int DM = 2048, NB = 4, SEQ = 4096, DEPTH = 2, DB = 32, DS = 64, PAST = 2048;
constexpr int TP = NB * SEQ, TS = DB * DS, T = TP + TS;
constexpr int NCOND = NB + DB;
constexpr int QLORA = 512, KVLORA = 512, ROPE = 64, NOPE = 128, VD = 128, MH = 16, QKD = 192;
constexpr int RH = 8, RQK = 128, RV = 256;
constexpr int PH = 8, NKEYS = 128, NEXP = 16384, PTOPK = 16;
constexpr int INW = 11328, INWP = 11520;
constexpr int C_CQ = 0, C_CKV = 512, C_KR = 1024, C_RQ = 1088, C_RK = 2112, C_RV = 3136, C_RG = 5184, C_GA = 7232, C_GB = 9280;
constexpr int KALL = PAST + DS;
constexpr int KPAD = 2304;
constexpr int QLD = 640;
constexpr float EPS = 1e-6f;
constexpr float MLA_SCALE = 0.07216878364870322f;

constexpr long O_Y = 0;
constexpr long O_CKVP = (long)T * DM;
constexpr long O_KRP = O_CKVP + 2L * TP * 512;
constexpr long O_RETP = O_KRP + 2L * TP * 64;
constexpr long O_CKVS = O_RETP + 2L * NB * RH * RQK * RV;
constexpr long O_KRS = O_CKVS + 2L * TS * 512;
constexpr long O_RETS = O_KRS + 2L * TS * 64;
constexpr long O_END = O_RETS + 2L * DB * RH * RQK * RV;

constexpr size_t al256(size_t x) { return (x + 255) / 256 * 256; }
constexpr size_t WS_CTL = 0;
constexpr size_t CTL_BYTES = 65536 + 2UL * 32768 * 4;
constexpr size_t CTL_RSUM = 65536;
constexpr size_t WS_TAB64 = WS_CTL + CTL_BYTES;
constexpr size_t WS_TAB128 = WS_TAB64 + 4096UL * 32 * 2 * 4;
constexpr size_t WS_ADA = WS_TAB128 + 4096UL * 64 * 2 * 4;
constexpr size_t WS_ADAP = WS_ADA + 2UL * NCOND * 12288 * 4;
constexpr size_t WS_WIN = WS_ADAP + 8UL * 2 * NCOND * 12288 * 4;
constexpr size_t WS_WUQ = WS_WIN + 2UL * INWP * DM * 2;
constexpr size_t WS_WUKV = WS_WUQ + 2UL * 3072 * 512 * 2;
constexpr size_t WS_WUK = WS_WUKV + 2UL * 4096 * 512 * 2;
constexpr size_t WS_WA = WS_WUK + 2UL * 16 * 512 * 256 * 2;
constexpr size_t WS_WB = WS_WA + 2UL * DM * DM * 2;
constexpr size_t WS_WO = WS_WB + 2UL * DM * DM * 2;
constexpr size_t WS_WPQ = WS_WO + 2UL * DM * DM * 2;
constexpr size_t WS_PK1 = WS_WPQ + 2UL * DM * DM * 2;
constexpr size_t WS_PK2 = WS_PK1 + 2UL * 128 * 128 * 2;
constexpr size_t WS_H = WS_PK2 + 2UL * 128 * 128 * 2;
constexpr size_t WS_Y = WS_H + (size_t)T * DM * 2;
constexpr size_t WS_CQN = WS_Y + (size_t)T * INWP * 2;
constexpr size_t WS_CKVNP = WS_CQN + (size_t)T * 512 * 2;
constexpr size_t WS_KRP = WS_CKVNP + (size_t)TP * 512 * 2;
constexpr size_t WS_Q = WS_KRP + (size_t)TP * 64 * 2;
constexpr size_t WS_YA = WS_Q;
constexpr size_t WS_KV = WS_Q + (size_t)T * 3072 * 2 + 4096;
constexpr size_t WS_SP = WS_KV;
constexpr size_t WS_MIX = WS_KV;
constexpr size_t WS_OA = WS_KV + 32UL * 1024 * KPAD * 2;
constexpr size_t WS_QP = WS_OA;
constexpr size_t WS_CKA = WS_OA + (size_t)T * DM * 2;
constexpr size_t WS_CKT = WS_CKA + 32UL * KPAD * QLD * 2;
constexpr size_t WS_QL = WS_CKT + 32UL * 512 * KPAD * 2;
constexpr size_t WS_OL = WS_QL + 32UL * 1024 * QLD * 2;
constexpr size_t WS_OB = WS_OL + 16UL * 2048 * 512 * 2;
constexpr size_t WS_BG = WS_OB + (size_t)T * DM * 2;
constexpr size_t WS_PIDX = WS_BG + (size_t)T * DM * 2;
constexpr size_t WS_PW = WS_PIDX + (size_t)T * 128 * 4;
constexpr size_t WS_PU = WS_PW + (size_t)T * 128 * 4;
constexpr size_t WS_PV = WS_PU + (size_t)NEXP * DM;
constexpr size_t WS_PSU = WS_PV + (size_t)NEXP * DM;
constexpr size_t WS_PSV = WS_PSU + (size_t)NEXP * 4;
constexpr size_t WS_END = WS_PSV + (size_t)NEXP * 4;
static_assert((size_t)TP * 4096 * 2 <= 32UL * 1024 * KPAD * 2, "KV fits in the SP region");
static_assert(WS_END <= 1590000000UL, "workspace map too large");
static_assert(WS_WIN % 256 == 0 && WS_H % 256 == 0 && WS_Y % 256 == 0 && WS_Q % 256 == 0 && WS_KV % 256 == 0 && WS_CKA % 256 == 0, "alignment");

constexpr int LDS_BYTES = 147456;
constexpr int LDS_BARW = LDS_BYTES - 32;
constexpr size_t CTL_RANK = 16384;
constexpr size_t WS_DOTP = WS_Q;
constexpr size_t WS_ACT = WS_DOTP + 8UL * T * 128 * 4;
constexpr size_t WS_PIDXT = WS_ACT + (size_t)T * 128 * 4;
static_assert(WS_PIDXT + (size_t)T * 128 * 4 <= WS_KV, "PEER scratch fits in the Q region");

struct Params {
    const float *x_prompt, *x_sample, *c_prompt, *c_sample, *cache_ckv, *cache_krope, *state_ret, *w_ada, *b_ada, *g_mix, *g_ffn, *w_in, *g_q, *w_uq, *g_kv, *w_ukv,
                *w_a, *w_b, *w_o, *w_pq, *peer_k1, *peer_k2, *peer_u, *peer_v, *g_final;
    float* out; unsigned char* ws;
    float lg[8];
    int grid; int pad_;
};

typedef const __attribute__((address_space(4))) Params KParams;
__device__ __forceinline__ KParams* okarg() {
    const uintptr_t k = (uintptr_t)__builtin_amdgcn_kernarg_segment_ptr();
    unsigned lo = (unsigned)k, hi = (unsigned)(k >> 32);
    asm volatile("" : "+s"(lo), "+s"(hi)); return (KParams*)(((uintptr_t)hi << 32) | lo); }
#define KP (*okarg())
__device__ __forceinline__ int ogrid() { return KP.grid; }
__device__ __forceinline__ int obid() { int b = (int)blockIdx.x; asm volatile("" : "+s"(b) :: "memory"); return b; }
__device__ __forceinline__ int otid() { int t = (int)threadIdx.x; asm volatile("" : "+v"(t) :: "memory"); return t; }
template <class P> __device__ __forceinline__ P* gp(P* p) { return (P*)(__attribute__((address_space(1))) P*)(uintptr_t)p; }
template <class P> __device__ __forceinline__ P* optr(P* p) {
    unsigned lo = __builtin_amdgcn_readfirstlane((unsigned)(uintptr_t)p), hi = __builtin_amdgcn_readfirstlane((unsigned)((uintptr_t)p >> 32));
    asm volatile("" : "+s"(lo), "+s"(hi)); return gp((P*)(((uintptr_t)hi << 32) | lo)); }
typedef __bf16 bf16v2_t __attribute__((ext_vector_type(2)));
__device__ __forceinline__ unsigned cvt_pk_bf16(float lo, float hi) { f32x2 v = {lo, hi}; bf16v2_t r = __builtin_convertvector(v, bf16v2_t); return __builtin_bit_cast(unsigned, r); }
__device__ __forceinline__ bf16_t f2bf(float f) { return (bf16_t)(cvt_pk_bf16(f, 0.f) & 0xffffu); }
__device__ __forceinline__ float bf2f(bf16_t b) { return __uint_as_float(((unsigned)b) << 16); }
__device__ __forceinline__ float bflo(unsigned w) { return __uint_as_float(w << 16); }
__device__ __forceinline__ float bfhi(unsigned w) { return __uint_as_float(w & 0xffff0000u); }
__device__ __forceinline__ void unpack8(const u32x4 w, float (&f)[8]) { f[0] = bflo(w.x); f[1] = bfhi(w.x); f[2] = bflo(w.y); f[3] = bfhi(w.y); f[4] = bflo(w.z); f[5] = bfhi(w.z); f[6] = bflo(w.w); f[7] = bfhi(w.w); }
__device__ __forceinline__ u32x4 pack8(const float (&f)[8]) { u32x4 w; w.x = cvt_pk_bf16(f[0], f[1]); w.y = cvt_pk_bf16(f[2], f[3]); w.z = cvt_pk_bf16(f[4], f[5]); w.w = cvt_pk_bf16(f[6], f[7]); return w; }
template <int K> __device__ __forceinline__ float sx(float v) {
    if constexpr (K == 32) { const auto rr = __builtin_amdgcn_permlane32_swap(__float_as_uint(v), __float_as_uint(v), false, false); return __uint_as_float((otid() & 32) ? rr[0] : rr[1]); }
    else return __int_as_float(__builtin_amdgcn_ds_swizzle(__float_as_int(v), (K << 10) | 0x1F));
}
__device__ __forceinline__ float wave_sum(float v) { v += sx<32>(v); v += sx<16>(v); v += sx<8>(v); v += sx<4>(v); v += sx<2>(v); v += sx<1>(v); return v; }
__device__ __forceinline__ float wave_max(float v) { v = fmaxf(v, sx<32>(v)); v = fmaxf(v, sx<16>(v)); v = fmaxf(v, sx<8>(v)); v = fmaxf(v, sx<4>(v)); v = fmaxf(v, sx<2>(v)); v = fmaxf(v, sx<1>(v)); return v; }
__device__ __forceinline__ float sigmoidf_(float x) { return 1.0f / (1.0f + __expf(-x)); }
__device__ __forceinline__ float siluf_(float x) { return x / (1.0f + __expf(-x)); }
__device__ __forceinline__ int cond_row(int t) { return t < TP ? (t >> 12) : NB + ((t - TP) >> 6); }
__device__ __forceinline__ int tok_pos(int t) { return t < TP ? (t & 4095) : PAST + ((t - TP) & 63); }

#define XB_TMO      128
#define XB_XCNT(j)  (256  + 64 * (j))
#define XB_XSUB(j)  (1280 + 64 * (j))
#define XB_XGEN(j)  (2304 + 64 * (j))
#define XB_TOP      3328
#define XB_TOPGEN   3392
#define XCD_BAR_WORDS 3456
#define XB_SPIN_CAP (1u << 22)
__device__ __forceinline__ unsigned xb_ld(unsigned* p)              { return __hip_atomic_load(p, __ATOMIC_RELAXED, __HIP_MEMORY_SCOPE_AGENT); }
__device__ __forceinline__ unsigned xb_add(unsigned* p, unsigned v) { return __hip_atomic_fetch_add(p, v, __ATOMIC_RELAXED, __HIP_MEMORY_SCOPE_AGENT); }
__device__ __forceinline__ unsigned xb_xcc_id() { return (unsigned)__builtin_amdgcn_s_getreg((3 << 11) | 20) & 0xFu; }
#define XB_SPIN(cond, bar) do { unsigned _sp = 0; while (cond) { __builtin_amdgcn_s_sleep(1); \
    if ((++_sp & 255u) == 0u) { if (xb_ld(&(bar)[XB_TMO])) break; if (_sp > XB_SPIN_CAP) { atomicAdd(&(bar)[XB_TMO], 1u); break; } } } } while (0)
struct XcdBarrier { unsigned* bar; unsigned x; volatile LAS unsigned* st; };
__device__ __forceinline__ XcdBarrier xcd_barrier_post(unsigned* bar, volatile LAS unsigned* st) {
    XcdBarrier b; b.bar = bar; b.x = xb_xcc_id(); b.st = st;
    if (threadIdx.x == 0) (void)xb_add(&bar[XB_XCNT(b.x)], 1u);
    return b;
}
__device__ __forceinline__ void xcd_barrier_complete(unsigned* bar, unsigned x, unsigned& nloc, unsigned& nx) {
    const unsigned G = (unsigned)KP.grid;
    unsigned sum, cnt, mine, sp = 0u;
    for (;;) {
        sum = 0u; cnt = 0u; mine = 0u;
#pragma unroll
        for (unsigned j = 0; j < 16; ++j) { const unsigned c = xb_ld(&bar[XB_XCNT(j)]); sum += c; cnt += (c > 0u) ? 1u : 0u; mine = (j == x) ? c : mine; }
        if (sum == G) break;
        __builtin_amdgcn_s_sleep(1);
        if ((++sp & 255u) == 0u) { if (xb_ld(&bar[XB_TMO])) break; if (sp > XB_SPIN_CAP) { atomicAdd(&bar[XB_TMO], 1u); break; } }
    }
    nloc = mine > 0u ? mine : 1u; nx = cnt > 0u ? cnt : 1u;
}
__device__ __forceinline__ void xcd_barrier(const XcdBarrier& b) {
    asm volatile("s_waitcnt vmcnt(0)" ::: "memory");
    __syncthreads();
    if (otid() == 0) {
        unsigned* bar = (unsigned*)(gp(KP.ws) + WS_CTL);
        unsigned bx = xb_xcc_id(); asm volatile("" : "+s"(bx));
        __builtin_amdgcn_s_waitcnt(0);
        unsigned nloc = b.st[0], nx = b.st[1];
        if (nloc == 0u) { xcd_barrier_complete(bar, bx, nloc, nx); b.st[0] = nloc; b.st[1] = nx; }
        const unsigned old = xb_add(&bar[XB_XSUB(bx)], 1u);
        const unsigned gen = old / nloc;
        if (old + 1u == (gen + 1u) * nloc) {
            __builtin_amdgcn_fence(__ATOMIC_RELEASE, "agent");
            asm volatile("s_waitcnt vmcnt(0)" ::: "memory");
            const unsigned og = xb_add(&bar[XB_TOP], 1u);
            const unsigned tg = og / nx;
            if (og + 1u == (tg + 1u) * nx) xb_add(&bar[XB_TOPGEN], 1u);
            else XB_SPIN(xb_ld(&bar[XB_TOPGEN]) == tg, bar);
            __builtin_amdgcn_fence(__ATOMIC_ACQUIRE, "agent");
            xb_add(&bar[XB_XGEN(bx)], 1u);
            asm volatile("s_waitcnt vmcnt(0)" ::: "memory");
        } else {
            XB_SPIN(xb_ld(&bar[XB_XGEN(bx)]) == gen, bar);
            __builtin_amdgcn_fence(__ATOMIC_ACQUIRE, "agent");
            asm volatile("s_waitcnt vmcnt(0)" ::: "memory");
        }
    }
    __syncthreads();
}
namespace pg8 {
constexpr int BM = 256, BK = 64, HALF = 128, HTB = HALF * BK * 2, STAGE_BYTES = 8 * HTB, NXCD = 8, WGM = 8;
__host__ __device__ __forceinline__ int lds_byte(int r, int c) { const int st = (r >> 4) * 2 + (c >> 5), rr = r & 15, cc = c & 31, ob = rr * 64 + cc * 2; return st * 1024 + (ob ^ (((ob >> 9) & 1) << 5)); }
__host__ __device__ __forceinline__ void stage_rc(int b, int& R, int& C) { const int st = b / 1024, sb = b % 1024, swz = sb ^ (((sb >> 9) & 1) << 5); R = (st >> 1) * 16 + swz / 64; C = (st & 1) * 32 + (swz % 64) / 2; }
__host__ __device__ __forceinline__ int perm32(int rho) { const int n = rho >> 4, i = rho & 15; return 8 * (i >> 2) + 4 * n + (i & 3); }

struct Unit { int pm, pn; long aoff, boff; int x0, x1; };
struct Gemm { const bf16_t* A; const bf16_t* Bt; int K; int lda, ldb; };

template <int MODE> struct Sched {
    int nM, nN, nwg, G, c; long lda, ldb;
    __device__ void init(int nM_, int nN_, int nwg_, long lda_, long ldb_) { nM = nM_; nN = nN_; nwg = nwg_; G = ogrid(); c = obid(); lda = lda_; ldb = ldb_; }
    __device__ bool next(int i, Unit& u) const {
        const long L = (long)i * G + c; if (L >= nwg) return false;
        int wgid = (int)L;
        if (MODE == 0) {
            { const int q = nwg / NXCD, r = nwg % NXCD, xcd = wgid % NXCD, off = wgid / NXCD; wgid = (xcd < r ? xcd * (q + 1) : r * (q + 1) + (xcd - r) * q) + off; }
            const int nig = WGM * nN, gid = wgid / nig, fm = gid * WGM, gsz = (nM - fm) < WGM ? (nM - fm) : WGM;
            u.pm = fm + ((wgid % nig) % gsz); u.pn = (wgid % nig) / gsz; u.x0 = 0; u.x1 = 0;
            u.aoff = (long)u.pm * 256 * lda * 2; u.boff = (long)u.pn * 256 * ldb * 2;
        } else if (MODE == 1) {
            const int h = wgid >> 4, rem = wgid & 15, rt = rem >> 1, pn = rem & 1;
            u.pm = rt; u.pn = pn; u.x0 = h; u.x1 = rt;
            u.aoff = ((long)(TP + 256 * rt) * 3072 + h * 192) * 2; u.boff = ((long)(h * 512 + 256 * pn) * 256) * 2;
        } else if (MODE == 2) {
            const int b = wgid / 36, rem = wgid % 36, pm = rem / 9, pn = rem % 9;
            u.pm = pm; u.pn = pn; u.x0 = b; u.x1 = 0;
            u.aoff = ((long)(b * 1024 + 256 * pm) * QLD) * 2; u.boff = ((long)(b * KPAD + 256 * pn) * QLD) * 2;
        } else if (MODE == 3) {
            const int b = wgid >> 3, pm = (wgid & 7) >> 1, pn = wgid & 1;
            u.pm = pm; u.pn = pn; u.x0 = b; u.x1 = 0;
            u.aoff = ((long)(b * 1024 + 256 * pm) * KPAD) * 2; u.boff = ((long)(b * 512 + 256 * pn) * KPAD) * 2;
        } else {
            const int h = wgid >> 3, rt = wgid & 7;
            u.pm = rt; u.pn = 0; u.x0 = h; u.x1 = rt;
            u.aoff = ((long)(h * 2048 + 256 * rt) * 512) * 2; u.boff = ((long)(h * 256) * 512) * 2;
        }
        return true;
    }
};

template <class Epi, class SchedT>
__device__ __forceinline__ void gemm_phase(LAS unsigned char* lds, const Gemm g, const SchedT& S, const Epi& E) {
    const int tid = otid(), wid = __builtin_amdgcn_readfirstlane(tid >> 6), lane = tid & 63, wr = wid >> 2, wc = wid & 3, fr = lane & 15, fq = lane >> 4;
    const int K = g.K, nt = K / BK;
    unsigned voffA[2], voffB[2];
#pragma unroll
    for (int i = 0; i < 2; ++i) { int R, C; stage_rc(tid * 16 + i * 8192, R, C); const int Rb = Epi::PERM ? ((R & ~31) + perm32(R & 31)) : R;
        voffA[i] = (unsigned)(R * g.lda + C) * 2u; voffB[i] = (unsigned)(Rb * g.ldb + C) * 2u; }
    const size_t kstep = (size_t)(BK * 2);
    const size_t hstepA = (size_t)HALF * g.lda * 2, hstepB = (size_t)HALF * g.ldb * 2;
    const unsigned ldsw = (unsigned)wid * 1024u;
    const int aoff = lds_byte(wr * 64 + fr, fq * 8), boff = lds_byte(wc * 32 + fr, fq * 8);
#define PG8_SA(b, h) (((b) * 2 + (h)) * HTB)
#define PG8_SB(b, h) ((4 + (b) * 2 + (h)) * HTB)
#define PG8_STAGE(bufoff, gbase, voff) do { _Pragma("unroll") for (int _i = 0; _i < 2; ++_i) \
        __builtin_amdgcn_global_load_lds((const unsigned*)((const char*)(gbase) + (voff)[_i]), (LAS unsigned*)(lds + (bufoff) + ldsw + _i * 8192), 16, 0, 0); } while (0)
#define PG8_LDA(dst, b, h) do { _Pragma("unroll") for (int m = 0; m < 4; ++m) _Pragma("unroll") for (int k = 0; k < 2; ++k) dst[m][k] = *(const LAS bf16x8*)(lds + PG8_SA(b, h) + aoff + m * 2048 + k * 1024); } while (0)
#define PG8_LDB(dst, b, h) do { _Pragma("unroll") for (int n = 0; n < 2; ++n) _Pragma("unroll") for (int k = 0; k < 2; ++k) dst[n][k] = *(const LAS bf16x8*)(lds + PG8_SB(b, h) + boff + n * 2048 + k * 1024); } while (0)
#define PG8_MMA(ai, bj, At, Bt) do { __builtin_amdgcn_s_setprio(1); _Pragma("unroll") for (int m = 0; m < 4; ++m) _Pragma("unroll") for (int n = 0; n < 2; ++n) _Pragma("unroll") for (int k = 0; k < 2; ++k) \
        acc[ai][bj][m][n] = __builtin_amdgcn_mfma_f32_16x16x32_bf16(Bt[n][k], At[m][k], acc[ai][bj][m][n], 0, 0, 0); __builtin_amdgcn_s_setprio(0); } while (0)
#define PG8_WAIT_V(n) asm volatile("s_waitcnt vmcnt(" #n ")" ::: "memory")
#define PG8_WAIT_L(n) asm volatile("s_waitcnt lgkmcnt(" #n ")" ::: "memory")
#define PG8_BAR __builtin_amdgcn_s_barrier()
#define PG8_SCHED __builtin_amdgcn_sched_barrier(0)
    Unit cur, nxt; int ui = 0;
    if (!S.next(0, cur)) return;
    f32x4 acc[2][2][4][2];
#pragma unroll
    for (int a = 0; a < 2; ++a)
#pragma unroll
        for (int b = 0; b < 2; ++b)
#pragma unroll
            for (int m = 0; m < 4; ++m)
#pragma unroll
                for (int n = 0; n < 2; ++n) acc[a][b][m][n] = (f32x4){0.f, 0.f, 0.f, 0.f};
    bf16x8 At[4][2], B0[2][2], B1[2][2];
    const char* cA = (const char*)g.A + cur.aoff; const char* cB = (const char*)g.Bt + cur.boff;
    PG8_STAGE(PG8_SB(0, 0), cB, voffB); PG8_STAGE(PG8_SA(0, 0), cA, voffA); PG8_STAGE(PG8_SB(0, 1), cB + hstepB, voffB); PG8_STAGE(PG8_SA(0, 1), cA + hstepA, voffA);
    if (wr == 1) PG8_BAR;
    PG8_WAIT_V(4); PG8_BAR;
    PG8_STAGE(PG8_SB(1, 0), cB + kstep, voffB); PG8_STAGE(PG8_SA(1, 0), cA + kstep, voffA); PG8_STAGE(PG8_SB(1, 1), cB + hstepB + kstep, voffB);
    PG8_WAIT_V(6); PG8_BAR;
    for (;;) {
        const bool has_next = S.next(ui + 1, nxt);
        const char* nA = has_next ? (const char*)g.A + nxt.aoff : cA; const char* nB = has_next ? (const char*)g.Bt + nxt.boff : cB;
        for (int t = 0; t < nt; t += 2) {
            const bool last = (t == nt - 2);
            const char* a1 = cA + (size_t)(t + 1) * kstep;
            const char* a2 = last ? nA : cA + (size_t)(t + 2) * kstep; const char* b2 = last ? nB : cB + (size_t)(t + 2) * kstep;
            const char* a3 = a2 + kstep; const char* b3 = b2 + kstep;
            PG8_LDB(B0, 0, 0); PG8_SCHED; PG8_LDA(At, 0, 0); PG8_STAGE(PG8_SA(1, 1), a1 + hstepA, voffA);
            PG8_WAIT_L(8); PG8_BAR; PG8_WAIT_L(0); PG8_MMA(0, 0, At, B0); PG8_BAR; PG8_SCHED;
            PG8_LDB(B1, 0, 1); PG8_STAGE(PG8_SB(0, 0), b2, voffB);
            PG8_BAR; PG8_WAIT_L(0); PG8_MMA(0, 1, At, B1); PG8_BAR;
            PG8_LDA(At, 0, 1); PG8_STAGE(PG8_SA(0, 0), a2, voffA);
            PG8_BAR; PG8_WAIT_L(0); PG8_MMA(1, 0, At, B0); PG8_BAR; PG8_SCHED;
            PG8_STAGE(PG8_SB(0, 1), b2 + hstepB, voffB);
            PG8_WAIT_V(6); PG8_BAR; PG8_MMA(1, 1, At, B1); PG8_BAR;
            PG8_LDB(B0, 1, 0); PG8_SCHED; PG8_LDA(At, 1, 0); PG8_STAGE(PG8_SA(0, 1), a2 + hstepA, voffA);
            PG8_WAIT_L(8); PG8_BAR; PG8_WAIT_L(0); PG8_MMA(0, 0, At, B0); PG8_BAR; PG8_SCHED;
            PG8_LDB(B1, 1, 1); PG8_STAGE(PG8_SB(1, 0), b3, voffB);
            PG8_BAR; PG8_WAIT_L(0); PG8_MMA(0, 1, At, B1); PG8_BAR;
            PG8_LDA(At, 1, 1); PG8_STAGE(PG8_SA(1, 0), a3, voffA);
            PG8_BAR; PG8_WAIT_L(0); PG8_MMA(1, 0, At, B0); PG8_BAR; PG8_SCHED;
            PG8_STAGE(PG8_SB(1, 1), b3 + hstepB, voffB);
            PG8_WAIT_V(6); PG8_BAR; PG8_MMA(1, 1, At, B1); PG8_BAR;
        }
        E(acc, cur, wr, wc, fr, fq);
        if (!has_next) break;
#pragma unroll
        for (int a = 0; a < 2; ++a)
#pragma unroll
            for (int b = 0; b < 2; ++b)
#pragma unroll
                for (int m = 0; m < 4; ++m)
#pragma unroll
                    for (int n = 0; n < 2; ++n) acc[a][b][m][n] = (f32x4){0.f, 0.f, 0.f, 0.f};
        cur = nxt; cA = nA; cB = nB; ++ui;
    }
    PG8_WAIT_V(0);
    if (wr == 0) PG8_BAR;
    PG8_BAR;
#undef PG8_SA
#undef PG8_SB
#undef PG8_STAGE
#undef PG8_LDA
#undef PG8_LDB
#undef PG8_MMA
#undef PG8_WAIT_V
#undef PG8_WAIT_L
#undef PG8_BAR
#undef PG8_SCHED
}

struct EpiBf16 {
    static constexpr bool PERM = true;
    bf16_t* O; long ldc; long bstride;
    __device__ __forceinline__ void operator()(const f32x4 (&acc)[2][2][4][2], const Unit& u, int wr, int wc, int fr, int fq) const {
        bf16_t* base = O + (long)u.x0 * bstride + (long)(u.pm * BM + wr * 64 + fr) * ldc + u.pn * BM + wc * 32 + 8 * fq;
#pragma unroll
        for (int ai = 0; ai < 2; ++ai)
#pragma unroll
            for (int m = 0; m < 4; ++m) { bf16_t* rowp = base + (long)(ai * HALF + m * 16) * ldc;
#pragma unroll
                for (int bj = 0; bj < 2; ++bj) { const f32x4 v0 = acc[ai][bj][m][0], v1 = acc[ai][bj][m][1];
                    u32x4 w; w.x = cvt_pk_bf16(v0[0], v0[1]); w.y = cvt_pk_bf16(v0[2], v0[3]); w.z = cvt_pk_bf16(v1[0], v1[1]); w.w = cvt_pk_bf16(v1[2], v1[3]);
                    *(u32x4*)(rowp + bj * HALF) = w; } }
    }
};
template <int RMODE> struct EpiRowMap {
    static constexpr bool PERM = true;
    bf16_t* O; const float* rsum;
    __device__ __forceinline__ void operator()(const f32x4 (&acc)[2][2][4][2], const Unit& u, int wr, int wc, int fr, int fq) const {
        const int col0 = u.pn * BM + wc * 32 + 8 * fq;
#pragma unroll
        for (int ai = 0; ai < 2; ++ai)
#pragma unroll
            for (int m = 0; m < 4; ++m) { const int r = ai * HALF + wr * 64 + m * 16 + fr; long drow; long ldc;
                if (RMODE == 1) { const int ts = 256 * u.x1 + r; drow = (long)(ts >> 6) * 1024 + u.x0 * 64 + (ts & 63); ldc = QLD; }
                float rs = 1.0f;
                if (RMODE == 1) { }
                else { const int qr = 256 * u.pm + r; drow = (long)(qr >> 6) * 2048 + u.x0 * 64 + (qr & 63); ldc = 512; rs = 1.0f / rsum[u.x0 * 1024 + qr]; }
                bf16_t* rowp = O + drow * ldc + col0;
#pragma unroll
                for (int bj = 0; bj < 2; ++bj) { const f32x4 v0 = acc[ai][bj][m][0] * rs, v1 = acc[ai][bj][m][1] * rs;
                    u32x4 w; w.x = cvt_pk_bf16(v0[0], v0[1]); w.y = cvt_pk_bf16(v0[2], v0[3]); w.z = cvt_pk_bf16(v1[0], v1[1]); w.w = cvt_pk_bf16(v1[2], v1[3]);
                    *(u32x4*)(rowp + bj * HALF) = w; } }
    }
};
struct EpiOV {
    static constexpr bool PERM = true;
    bf16_t* O;
    __device__ __forceinline__ void operator()(const f32x4 (&acc)[2][2][4][2], const Unit& u, int wr, int wc, int fr, int fq) const {
#pragma unroll
        for (int ai = 0; ai < 2; ++ai)
#pragma unroll
            for (int m = 0; m < 4; ++m) { const int r = ai * HALF + wr * 64 + m * 16 + fr;
                bf16_t* rowp = O + (long)(TP + 256 * u.x1 + r) * DM + u.x0 * 128 + wc * 32 + 8 * fq;
                const f32x4 v0 = acc[ai][1][m][0], v1 = acc[ai][1][m][1];
                u32x4 w; w.x = cvt_pk_bf16(v0[0], v0[1]); w.y = cvt_pk_bf16(v0[2], v0[3]); w.z = cvt_pk_bf16(v1[0], v1[1]); w.w = cvt_pk_bf16(v1[2], v1[3]);
                *(u32x4*)rowp = w; }
    }
};
struct EpiMix {
    static constexpr bool PERM = true;
    const bf16_t* Y; const bf16_t* YA; bf16_t* MIX;
    __device__ __forceinline__ void operator()(const f32x4 (&acc)[2][2][4][2], const Unit& u, int wr, int wc, int fr, int fq) const {
#pragma unroll
        for (int ai = 0; ai < 2; ++ai)
#pragma unroll
            for (int m = 0; m < 4; ++m) { const long t = (long)u.pm * BM + ai * HALF + wr * 64 + m * 16 + fr;
#pragma unroll
                for (int bj = 0; bj < 2; ++bj) { const int c = u.pn * BM + bj * HALF + wc * 32 + 8 * fq;
                    const u32x4 ga = *(const u32x4*)(Y + t * INWP + C_GA + c), gb = *(const u32x4*)(Y + t * INWP + C_GB + c), ya = *(const u32x4*)(YA + t * DM + c);
                    float fa[8], fb[8], fy[8], o[8]; unpack8(ga, fa); unpack8(gb, fb); unpack8(ya, fy);
                    const f32x4 v0 = acc[ai][bj][m][0], v1 = acc[ai][bj][m][1];
                    const float av[8] = {v0[0], v0[1], v0[2], v0[3], v1[0], v1[1], v1[2], v1[3]};
#pragma unroll
                    for (int j = 0; j < 8; ++j) {
#if defined(DBG_MIX) && DBG_MIX == 1
                        o[j] = sigmoidf_(fb[j]) * av[j];
#elif defined(DBG_MIX) && DBG_MIX == 2
                        o[j] = sigmoidf_(fa[j]) * fy[j];
#else
                        o[j] = sigmoidf_(fa[j]) * fy[j] + sigmoidf_(fb[j]) * av[j];
#endif
                    }
                    *(u32x4*)(MIX + t * DM + c) = pack8(o); } }
    }
};
struct EpiRes {
    static constexpr bool PERM = false;
    float* X; const float* gate;
    const float* XinP; const float* XinS;
    __device__ __forceinline__ void operator()(const f32x4 (&acc)[2][2][4][2], const Unit& u, int wr, int wc, int fr, int fq) const {
#pragma unroll
        for (int ai = 0; ai < 2; ++ai)
#pragma unroll
            for (int m = 0; m < 4; ++m) { const int t = u.pm * BM + ai * HALF + wr * 64 + m * 16 + fr; const float* gr = gate + (long)cond_row(t) * 12288; float* xr = X + (long)t * DM; const float* xi = t < TP ? XinP + (long)t * DM : XinS + (long)(t - TP) * DM;
#pragma unroll
                for (int bj = 0; bj < 2; ++bj)
#pragma unroll
                    for (int n = 0; n < 2; ++n) { const int c = u.pn * BM + bj * HALF + wc * 32 + n * 16 + 4 * fq;
                        const f32x4 gv = *(const f32x4*)(gr + c); const f32x4 xv = *(const f32x4*)(xi + c);
                        *(f32x4*)(xr + c) = xv + gv * acc[ai][bj][m][n]; } }
    }
};

struct EpiQ {
    static constexpr bool PERM = true;
    bf16_t* Q; bf16_t* QL; const float* T64;
    __device__ __forceinline__ void operator()(const f32x4 (&acc)[2][2][4][2], const Unit& u, int wr, int wc, int fr, int fq) const {
        const int grp = u.pn / 3, typ = u.pn - 3 * grp;
        if (typ < 2) {
#pragma unroll
            for (int ai = 0; ai < 2; ++ai)
#pragma unroll
                for (int m = 0; m < 4; ++m) { const long t = (long)u.pm * BM + ai * HALF + wr * 64 + m * 16 + fr;
#pragma unroll
                    for (int bj = 0; bj < 2; ++bj) { const f32x4 v0 = acc[ai][bj][m][0], v1 = acc[ai][bj][m][1];
                        u32x4 w; w.x = cvt_pk_bf16(v0[0], v0[1]); w.y = cvt_pk_bf16(v0[2], v0[3]); w.z = cvt_pk_bf16(v1[0], v1[1]); w.w = cvt_pk_bf16(v1[2], v1[3]);
                        *(u32x4*)(Q + t * 3072 + 768 * grp + 192 * (2 * typ + bj) + wc * 32 + 8 * fq) = w; } }
        } else {
#pragma unroll
            for (int ai = 0; ai < 2; ++ai)
#pragma unroll
                for (int m = 0; m < 4; ++m) { const int t = u.pm * BM + ai * HALF + wr * 64 + m * 16 + fr; const int pos = tok_pos(t);
                    const float* cs = T64 + ((long)pos * 32 + 8 * fq) * 2; float cv[8], sv[8];
#pragma unroll
                    for (int j = 0; j < 4; ++j) { const f32x4 qv = *(const f32x4*)(cs + 4 * j); cv[2 * j] = qv[0]; sv[2 * j] = qv[1]; cv[2 * j + 1] = qv[2]; sv[2 * j + 1] = qv[3]; }
                    const f32x4 a0 = acc[ai][0][m][0], a1 = acc[ai][0][m][1], b0 = acc[ai][1][m][0], b1 = acc[ai][1][m][1];
                    const float x1[8] = {a0[0], a0[1], a0[2], a0[3], a1[0], a1[1], a1[2], a1[3]}, x2[8] = {b0[0], b0[1], b0[2], b0[3], b1[0], b1[1], b1[2], b1[3]};
                    float o1[8], o2[8];
#pragma unroll
                    for (int j = 0; j < 8; ++j) { o1[j] = x1[j] * cv[j] - x2[j] * sv[j]; o2[j] = x1[j] * sv[j] + x2[j] * cv[j]; }
                    const u32x4 w1 = pack8(o1), w2 = pack8(o2); const int hd = 4 * grp + wc;
                    bf16_t* qd = Q + (long)t * 3072 + hd * 192 + 128 + 8 * fq; *(u32x4*)qd = w1; *(u32x4*)(qd + 32) = w2;
                    if (t >= TP) { const int ts = t - TP; bf16_t* d = QL + ((long)(ts >> 6) * 1024 + hd * 64 + (ts & 63)) * QLD + 512 + 8 * fq; *(u32x4*)d = w1; *(u32x4*)(d + 32) = w2; } }
        }
    }
};

struct EpiExp {
    static constexpr bool PERM = true;
    bf16_t* O; float* rsum;
    __device__ __forceinline__ void operator()(const f32x4 (&acc)[2][2][4][2], const Unit& u, int wr, int wc, int fr, int fq) const {
        bf16_t* base = O + (long)u.x0 * 1024 * KPAD + (long)(u.pm * BM + wr * 64 + fr) * KPAD + u.pn * BM + wc * 32 + 8 * fq;
#pragma unroll
        for (int ai = 0; ai < 2; ++ai)
#pragma unroll
            for (int m = 0; m < 4; ++m) { bf16_t* rowp = base + (long)(ai * HALF + m * 16) * KPAD; float part = 0.f;
#pragma unroll
                for (int bj = 0; bj < 2; ++bj) { const int c0 = u.pn * BM + bj * HALF + wc * 32 + 8 * fq; const f32x4 v0 = acc[ai][bj][m][0], v1 = acc[ai][bj][m][1];
                    const float sv[8] = {v0[0], v0[1], v0[2], v0[3], v1[0], v1[1], v1[2], v1[3]}; float e[8];
#pragma unroll
                    for (int j = 0; j < 8; ++j) { e[j] = (c0 + j < KALL) ? __expf(fminf(sv[j] * MLA_SCALE, 60.f)) : 0.f; part += e[j]; }
                    *(u32x4*)(rowp + bj * HALF) = pack8(e); }
                part += sx<16>(part); part += sx<32>(part);
                if (fq == 0) atomicAdd(rsum + u.x0 * 1024 + u.pm * BM + ai * HALF + wr * 64 + m * 16 + fr, part); }
    }
};
}
namespace att {
constexpr int NW = 8, QBLK = 32, KVBLK = 64;
constexpr float SCALE = MLA_SCALE;
constexpr float THR = 8.f;
constexpr int KROW = 384;
constexpr int SHM_V = KVBLK * 128 * 2, SHM_K = KVBLK * KROW;
constexpr int QR_PITCH = 144, SHM_QR = 256 * QR_PITCH;
constexpr int SHM_ATTN = 2 * SHM_V + 2 * SHM_K + NW * 64 * 4 + SHM_QR;
#define KSWZ(row, colB) ((row) * att::KROW + ((colB) ^ (((row) & 7) << 4)))
#define SBAR() __builtin_amdgcn_sched_barrier(0)
__device__ __forceinline__ int crow(int r, int hi) { return (r & 3) + 8 * (r >> 2) + 4 * hi; }

__device__ __forceinline__ void partialSM(f32x16& p0, f32x16& p1, float& m_reg, float& mn, float& alpha) {
  constexpr float C = SCALE * 1.4426950408889634f;
  float pmax = p0[0];
#pragma unroll
  for (int r = 1; r < 16; ++r) pmax = fmaxf(pmax, p0[r]);
#pragma unroll
  for (int r = 0; r < 16; ++r) pmax = fmaxf(pmax, p1[r]);
  { auto rr = __builtin_amdgcn_permlane32_swap(__float_as_uint(pmax), __float_as_uint(pmax), false, false);
    pmax = fmaxf(__uint_as_float(rr[0]), __uint_as_float(rr[1])); }
  if (__builtin_expect(__all(pmax - m_reg <= THR / SCALE), 1)) { mn = m_reg; alpha = 1.f; }
  else { mn = fmaxf(m_reg, pmax); alpha = __builtin_amdgcn_exp2f((m_reg - mn) * C); m_reg = mn; }
  float mnC = -mn * C;
#pragma unroll
  for (int r = 0; r < 16; ++r) p0[r] = fmaf(p0[r], C, mnC);
#pragma unroll
  for (int r = 0; r < 16; ++r) p1[r] = fmaf(p1[r], C, mnC);
#pragma unroll
  for (int r = 0; r < 16; ++r) p0[r] = __builtin_amdgcn_exp2f(p0[r]);
}
__device__ __forceinline__ void finishSM(f32x16& p0, f32x16& p1, float alpha, float& l_reg, bf16x8& pa0, bf16x8& pa1, bf16x8& pa2, bf16x8& pa3) {
#pragma unroll
  for (int r = 0; r < 16; ++r) p1[r] = __builtin_amdgcn_exp2f(p1[r]);
  float ps = 0;
#pragma unroll
  for (int r = 0; r < 16; ++r) ps += p0[r];
#pragma unroll
  for (int r = 0; r < 16; ++r) ps += p1[r];
  { auto rr = __builtin_amdgcn_permlane32_swap(__float_as_uint(ps), __float_as_uint(ps), false, false);
    ps = __uint_as_float(rr[0]) + __uint_as_float(rr[1]); }
  l_reg = l_reg * alpha + ps;
#define PK4(P, BASE, OUT) do { unsigned a0 = cvt_pk_bf16(P[BASE + 0], P[BASE + 1]), a1 = cvt_pk_bf16(P[BASE + 2], P[BASE + 3]);   \
    unsigned b0 = cvt_pk_bf16(P[BASE + 4], P[BASE + 5]), b1 = cvt_pk_bf16(P[BASE + 6], P[BASE + 7]);                              \
    auto r0 = __builtin_amdgcn_permlane32_swap(a0, b0, false, false); auto r1 = __builtin_amdgcn_permlane32_swap(a1, b1, false, false); \
    u32x4 w = {r0[0], r1[0], r0[1], r1[1]}; OUT = *reinterpret_cast<bf16x8*>(&w); } while (0)
  PK4(p0, 0, pa0); PK4(p0, 8, pa1); PK4(p1, 0, pa2); PK4(p1, 8, pa3);
#undef PK4
}
__device__ __forceinline__ void qkt(f32x16& p0, f32x16& p1, const char* Ks, const bf16x8* qr, const char* qrope, const int (&kbase)[4], bool vis) {
  p0 = f32x16{}; p1 = f32x16{};
  if (vis) {
#pragma unroll
  for (int d0 = 0; d0 < 12; ++d0) {
    bf16x8 b0 = *reinterpret_cast<const bf16x8*>(Ks + kbase[d0 & 3] + (d0 >> 2) * 128);
    bf16x8 b1 = *reinterpret_cast<const bf16x8*>(Ks + kbase[d0 & 3] + (d0 >> 2) * 128 + 32 * KROW);
    const bf16x8 qv = d0 < 8 ? qr[d0 < 8 ? d0 : 0] : *reinterpret_cast<const bf16x8*>(qrope + (d0 - 8) * 32);
    p0 = __builtin_amdgcn_mfma_f32_32x32x16_bf16(b0, qv, p0, 0, 0, 0);
    p1 = __builtin_amdgcn_mfma_f32_32x32x16_bf16(b1, qv, p1, 0, 0, 0); }
  }
  if (!vis) {
#pragma unroll
    for (int r = 0; r < 16; ++r) { p0[r] = -1e30f; p1[r] = -1e30f; } }
}
__device__ __forceinline__ int v_st(int k, int c) { const int kk = (k & ~0xC) | ((k & 4) << 1) | ((k & 8) >> 1); return ((kk >> 3) * 4 + (c >> 5)) * 512 + ((kk & 7) * 32 + (c & 31)) * 2; }
__device__ __forceinline__ int v_rd_base(int lane) { return ((lane & 3) << 3) | (((lane >> 2) & 3) << 6) | (((lane >> 4) & 1) << 5) | (((lane >> 5) & 1) << 8); }
constexpr int v_rd_off(int d0, int ks, int half) { return d0 * 512 + ks * 4096 + half * 2048; }
template <int OFF> __device__ __forceinline__ s16x4 tr_read(int vb) {
  s16x4 r; asm volatile("ds_read_b64_tr_b16 %0, %1 offset:%2" : "=&v"(r) : "v"(vb), "i"(OFF) : "memory"); return r;
}
template <int D0> __device__ __forceinline__ void pv_one(f32x16& od, int vb, bf16x8 pa0, bf16x8 pa1, bf16x8 pa2, bf16x8 pa3) {
  const s16x4 l0 = tr_read<v_rd_off(D0, 0, 0)>(vb), h0 = tr_read<v_rd_off(D0, 0, 1)>(vb), l1 = tr_read<v_rd_off(D0, 1, 0)>(vb), h1 = tr_read<v_rd_off(D0, 1, 1)>(vb);
  const s16x4 l2 = tr_read<v_rd_off(D0, 2, 0)>(vb), h2 = tr_read<v_rd_off(D0, 2, 1)>(vb), l3 = tr_read<v_rd_off(D0, 3, 0)>(vb), h3 = tr_read<v_rd_off(D0, 3, 1)>(vb);
  asm volatile("s_waitcnt lgkmcnt(0)" ::: "memory"); SBAR();
#define PK(L, H) (bf16x8){L[0], L[1], L[2], L[3], H[0], H[1], H[2], H[3]}
  od = __builtin_amdgcn_mfma_f32_32x32x16_bf16(pa0, PK(l0, h0), od, 0, 0, 0);
  od = __builtin_amdgcn_mfma_f32_32x32x16_bf16(pa1, PK(l1, h1), od, 0, 0, 0);
  od = __builtin_amdgcn_mfma_f32_32x32x16_bf16(pa2, PK(l2, h2), od, 0, 0, 0);
  od = __builtin_amdgcn_mfma_f32_32x32x16_bf16(pa3, PK(l3, h3), od, 0, 0, 0);
#undef PK
}
__device__ __forceinline__ void pv_d0(f32x16* o, int vb, bf16x8 pa0, bf16x8 pa1, bf16x8 pa2, bf16x8 pa3) {
  pv_one<0>(o[0], vb, pa0, pa1, pa2, pa3); pv_one<1>(o[1], vb, pa0, pa1, pa2, pa3); pv_one<2>(o[2], vb, pa0, pa1, pa2, pa3); pv_one<3>(o[3], vb, pa0, pa1, pa2, pa3);
}

__device__ __forceinline__ void attn_block(const bf16_t* __restrict__ Qb, const bf16_t* __restrict__ Kn, const bf16_t* __restrict__ Kr, const bf16_t* __restrict__ Vh,
                                           bf16_t* __restrict__ Ob, int qb, char* lds) {
  constexpr int LDQ = 3072, LDK = 4096, LDR = 64, LDO = 2048;
  const int tid = otid(), wid = tid >> 6, lane = tid & 63, r32 = lane & 31, hi = lane >> 5;
  char* V_lds = lds; char* K_lds = lds + 2 * SHM_V;
  float* ws = (float*)(lds + 2 * SHM_V + 2 * SHM_K) + wid * 64; float* li_l = ws; float* al_l = ws + 32;
  float m_reg = -1e30f, l_reg = 0; f32x16 o[4] = {}; bf16x8 qr[8];
  const bf16_t* Qw = Qb + (long)(wid * QBLK + r32) * LDQ + hi * 8;
#pragma unroll
  for (int d0 = 0; d0 < 8; ++d0) qr[d0] = *reinterpret_cast<const bf16x8*>(Qw + d0 * 16);
  char* qrope = lds + 2 * SHM_V + 2 * SHM_K + NW * 64 * 4 + (wid * QBLK + r32) * QR_PITCH + hi * 16;
#pragma unroll
  for (int d0 = 8; d0 < 12; ++d0) *reinterpret_cast<bf16x8*>(qrope + (d0 - 8) * 32) = *reinterpret_cast<const bf16x8*>(Qw + d0 * 16);
  asm volatile("s_waitcnt lgkmcnt(0)" ::: "memory");
  const int NT = 4 * qb + 4, jmax = 4 * qb + (wid >> 1);
  int kbase[4];
#pragma unroll
  for (int dl = 0; dl < 4; ++dl) kbase[dl] = r32 * KROW + (((dl << 5) | (hi << 4)) ^ ((r32 & 7) << 4));
  const int sr = tid >> 4, sc = (tid & 15) * 8, vst0 = v_st(sr, sc), vst1 = v_st(32 + sr, sc);
  const int rr = tid >> 3, rc = (tid & 7) * 8;
  const int vb0 = (int)(uintptr_t)V_lds + v_rd_base(lane);
  bf16x8 vs0, vs1, ks0, ks1, kr0;
#define SLOAD(k0) do { vs0 = *reinterpret_cast<const bf16x8*>(&Vh[(long)((k0) + sr) * LDK + sc]); vs1 = *reinterpret_cast<const bf16x8*>(&Vh[(long)((k0) + 32 + sr) * LDK + sc]); \
    ks0 = *reinterpret_cast<const bf16x8*>(&Kn[(long)((k0) + sr) * LDK + sc]); ks1 = *reinterpret_cast<const bf16x8*>(&Kn[(long)((k0) + 32 + sr) * LDK + sc]); \
    kr0 = *reinterpret_cast<const bf16x8*>(&Kr[(long)((k0) + rr) * LDR + rc]); } while (0)
#define SWRITE(b) do { *(bf16x8*)(V_lds + (b) * SHM_V + vst0) = vs0; *(bf16x8*)(V_lds + (b) * SHM_V + vst1) = vs1; int kc = sc * 2; \
    *(bf16x8*)(K_lds + (b) * SHM_K + KSWZ(sr, kc)) = ks0; *(bf16x8*)(K_lds + (b) * SHM_K + KSWZ(32 + sr, kc)) = ks1; \
    *(bf16x8*)(K_lds + (b) * SHM_K + KSWZ(rr, 256 + rc * 2)) = kr0; } while (0)
#define SWAIT() asm volatile("s_waitcnt vmcnt(0)" ::: "memory")
#define RESC(a) do { if (__any((a) < 1.f)) { if (hi == 0) al_l[r32] = (a); asm volatile("s_waitcnt lgkmcnt(0)" ::: "memory"); \
    _Pragma("unroll") for (int d = 0; d < 4; ++d) _Pragma("unroll") for (int r = 0; r < 16; ++r) o[d][r] *= al_l[crow(r, hi)]; } } while (0)
  f32x16 pA0, pA1, pB0, pB1; float mnA, mnB, alA, alB; bf16x8 pa0, pa1, pa2, pa3;
  SLOAD(0); SWAIT(); SWRITE(0); __syncthreads();
  qkt(pA0, pA1, K_lds, qr, qrope, kbase, true); partialSM(pA0, pA1, m_reg, mnA, alA);
  SLOAD(KVBLK);
  SWAIT(); SWRITE(1); __syncthreads();
  for (int j = 1; j + 1 < NT; j += 2) {
    SBAR(); qkt(pB0, pB1, K_lds + SHM_K, qr, qrope, kbase, j <= jmax);
    finishSM(pA0, pA1, alA, l_reg, pa0, pa1, pa2, pa3); SBAR();
    SLOAD((j + 1) * KVBLK); SBAR();
    if (j - 1 <= jmax) pv_d0(o, vb0, pa0, pa1, pa2, pa3);
    partialSM(pB0, pB1, m_reg, mnB, alB);
    __syncthreads(); SWAIT(); SWRITE(0);
    RESC(alB); __syncthreads();
    SBAR(); qkt(pA0, pA1, K_lds, qr, qrope, kbase, j + 1 <= jmax);
    finishSM(pB0, pB1, alB, l_reg, pa0, pa1, pa2, pa3); SBAR();
    SLOAD((j + 2) * KVBLK); SBAR();
    if (j <= jmax) pv_d0(o, vb0 + (int)SHM_V, pa0, pa1, pa2, pa3);
    partialSM(pA0, pA1, m_reg, mnA, alA);
    __syncthreads(); SWAIT(); SWRITE(1);
    RESC(alA); __syncthreads();
  }
  SBAR(); qkt(pB0, pB1, K_lds + SHM_K, qr, qrope, kbase, NT - 1 <= jmax);
  finishSM(pA0, pA1, alA, l_reg, pa0, pa1, pa2, pa3); SBAR();
  if (NT - 2 <= jmax) pv_d0(o, vb0, pa0, pa1, pa2, pa3);
  partialSM(pB0, pB1, m_reg, mnB, alB);
  __syncthreads(); RESC(alB);
  finishSM(pB0, pB1, alB, l_reg, pa0, pa1, pa2, pa3); SBAR();
  if (NT - 1 <= jmax) pv_d0(o, vb0 + (int)SHM_V, pa0, pa1, pa2, pa3);
  if (hi == 0) li_l[r32] = l_reg; asm volatile("s_waitcnt lgkmcnt(0)" ::: "memory");
  float rli[16];
#pragma unroll
  for (int r = 0; r < 16; ++r) rli[r] = __builtin_amdgcn_rcpf(li_l[crow(r, hi)]);
  bf16_t* Ow = Ob + (long)(wid * QBLK) * LDO;
#pragma unroll
  for (int r = 0; r < 16; ++r) { int orow = crow(r, hi);
#pragma unroll
    for (int d0 = 0; d0 < 4; ++d0) Ow[(long)orow * LDO + d0 * 32 + r32] = f2bf(o[d0][r] * rli[r]); }
  __syncthreads();
#undef SLOAD
#undef SWRITE
#undef SWAIT
#undef RESC
}
}
namespace ret {
constexpr int QP_ = 136;
__device__ __forceinline__ bf16x8 ldfrag(const bf16_t* p) { return *reinterpret_cast<const bf16x8*>(p); }
template <int CL> struct Lay {
    static constexpr int IP = CL + 8;
    static constexpr int QS = 0, KS = QS + CL * QP_ * 2, VT = KS + CL * QP_ * 2, VDT = VT + 32 * IP * 2, IN = VDT + 32 * IP * 2, ST = IN + CL * IP * 2, VS = ST + 32 * QP_ * 2, END = VS + CL * 40 * 2;
};
static_assert(Lay<128>::END <= LDS_BARW, "retention LDS");

template <int CL>
__device__ __forceinline__ void run(const bf16_t* __restrict__ Y, bf16_t* __restrict__ OB, const float* __restrict__ sp, float* __restrict__ so, long tok0, int nch, int h, int es, float lg, char* lds, int tid) {
    using L = Lay<CL>; constexpr int IP = L::IP, NQT = CL / 16, NKS = CL / 32, NPC = CL / 32;
    const int wid = __builtin_amdgcn_readfirstlane(tid >> 6), lane = tid & 63, l15 = lane & 15, l4 = lane >> 4;
    bf16_t* Qs = (bf16_t*)(lds + L::QS); bf16_t* Ks = (bf16_t*)(lds + L::KS); bf16_t* Vt = (bf16_t*)(lds + L::VT); bf16_t* Vdt = (bf16_t*)(lds + L::VDT); bf16_t* In = (bf16_t*)(lds + L::IN); bf16_t* St = (bf16_t*)(lds + L::ST); bf16_t* Vs = (bf16_t*)(lds + L::VS);
    const float gCL = __expf((float)CL * lg);
    f32x4 Sacc[2];
    if (sp) {
#pragma unroll
        for (int ej = 0; ej < 2; ++ej)
#pragma unroll
            for (int r = 0; r < 4; ++r) Sacc[ej][r] = sp[(long)(16 * wid + 4 * l4 + r) * RV + 16 * ej + l15];
    } else { Sacc[0] = (f32x4){0.f, 0.f, 0.f, 0.f}; Sacc[1] = (f32x4){0.f, 0.f, 0.f, 0.f}; }
    for (int i = tid; i < CL * IP / 8; i += 512) reinterpret_cast<u32x4*>(In)[i] = (u32x4){0u, 0u, 0u, 0u};
    u32x4 pq[NPC], pk[NPC], pv;
    const int vk = tid >> 2, ve0 = (tid & 3) * 8;
#define RET_LOAD(cc) do { const bf16_t* yrow_ = Y + (tok0 + (long)(cc) * CL) * INWP; \
        _Pragma("unroll") for (int i = 0; i < NPC; ++i) { const int idx = tid + i * 512, k = idx >> 4, d0 = (idx & 15) * 8; \
            pq[i] = *reinterpret_cast<const u32x4*>(yrow_ + (long)k * INWP + C_RQ + h * 128 + d0); pk[i] = *reinterpret_cast<const u32x4*>(yrow_ + (long)k * INWP + C_RK + h * 128 + d0); } \
        if (tid < 4 * CL) pv = *reinterpret_cast<const u32x4*>(yrow_ + (long)vk * INWP + C_RV + h * 256 + es * 32 + ve0); } while (0)
    RET_LOAD(0);
    for (int c = 0; c < nch; ++c) {
#pragma unroll
        for (int ej = 0; ej < 2; ++ej) { u32x2 w; w.x = cvt_pk_bf16(Sacc[ej][0], Sacc[ej][1]); w.y = cvt_pk_bf16(Sacc[ej][2], Sacc[ej][3]);
            *reinterpret_cast<u32x2*>(St + (16 * ej + l15) * QP_ + 16 * wid + 4 * l4) = w; }
#pragma unroll
        for (int i = 0; i < NPC; ++i) { const int idx = tid + i * 512, k = idx >> 4, d0 = (idx & 15) * 8;
            *reinterpret_cast<u32x4*>(Qs + k * QP_ + d0) = pq[i]; *reinterpret_cast<u32x4*>(Ks + k * QP_ + d0) = pk[i]; }
        if (tid < 4 * CL) *reinterpret_cast<u32x4*>(Vs + vk * 40 + ve0) = pv;
        if (c + 1 < nch) RET_LOAD(c + 1);
        __syncthreads();
        if (tid < 4 * CL) { const int e = tid & 31, kg = tid >> 5; float f[8], fd[8];
#pragma unroll
            for (int j = 0; j < 8; ++j) { f[j] = bf2f(Vs[(8 * kg + j) * 40 + e]); fd[j] = f[j] * __expf((float)(CL - 1 - 8 * kg - j) * lg); }
            *reinterpret_cast<u32x4*>(Vt + e * IP + 8 * kg) = pack8(f); *reinterpret_cast<u32x4*>(Vdt + e * IP + 8 * kg) = pack8(fd); }
#pragma unroll
        for (int it_ = 0; it_ < (NQT * (NQT + 1) / 2 + 7) / 8; ++it_) { const int idx = wid + 8 * it_; if (idx >= NQT * (NQT + 1) / 2) break;
            int qi = 0; while ((qi + 1) * (qi + 2) / 2 <= idx) ++qi; const int kj = idx - qi * (qi + 1) / 2;
            f32x4 a = (f32x4){0.f, 0.f, 0.f, 0.f}; const bf16_t* qp = Qs + (16 * qi + l15) * QP_ + 8 * l4; const bf16_t* kp = Ks + (16 * kj + l15) * QP_ + 8 * l4;
#pragma unroll
            for (int ks = 0; ks < 4; ++ks) a = __builtin_amdgcn_mfma_f32_16x16x32_bf16(ldfrag(qp + 32 * ks), ldfrag(kp + 32 * ks), a, 0, 0, 0);
            const int q0 = 16 * qi + 4 * l4, k = 16 * kj + l15;
#pragma unroll
            for (int r = 0; r < 4; ++r) { const int q = q0 + r; const float dm = (q >= k) ? __expf((float)(q - k) * lg) : 0.f;
                In[q * IP + k] = f2bf(a[r] * dm); } }
        __syncthreads();
#pragma unroll
        for (int ot = 0; ot < (2 * NQT) / 8; ++ot) { const int tI = wid + 8 * ot, qi = tI >> 1, ej = tI & 1; f32x4 a = (f32x4){0.f, 0.f, 0.f, 0.f};
#pragma unroll
            for (int ks = 0; ks < 4; ++ks) a = __builtin_amdgcn_mfma_f32_16x16x32_bf16(ldfrag(Qs + (16 * qi + l15) * QP_ + 32 * ks + 8 * l4), ldfrag(St + (16 * ej + l15) * QP_ + 32 * ks + 8 * l4), a, 0, 0, 0);
#pragma unroll
            for (int r = 0; r < 4; ++r) a[r] *= __expf((float)(16 * qi + 4 * l4 + r + 1) * lg);
#pragma unroll
            for (int ks = 0; ks < NKS; ++ks) if (ks <= (qi >> 1)) a = __builtin_amdgcn_mfma_f32_16x16x32_bf16(ldfrag(In + (16 * qi + l15) * IP + 32 * ks + 8 * l4), ldfrag(Vt + (16 * ej + l15) * IP + 32 * ks + 8 * l4), a, 0, 0, 0);
            bf16_t* op = OB + ((long)(h * 8 + es) * T + tok0 + (long)c * CL + 16 * qi + 4 * l4) * 32 + 16 * ej + l15;
#pragma unroll
            for (int r = 0; r < 4; ++r) op[r * 32] = f2bf(a[r]); }
        { f32x4 s0 = Sacc[0] * gCL, s1 = Sacc[1] * gCL;
#pragma unroll
          for (int ks = 0; ks < NKS; ++ks) { bf16x8 af;
#pragma unroll
              for (int j = 0; j < 8; ++j) af[j] = (short)Ks[(32 * ks + 8 * l4 + j) * QP_ + 16 * wid + l15];
              s0 = __builtin_amdgcn_mfma_f32_16x16x32_bf16(af, ldfrag(Vdt + l15 * IP + 32 * ks + 8 * l4), s0, 0, 0, 0);
              s1 = __builtin_amdgcn_mfma_f32_16x16x32_bf16(af, ldfrag(Vdt + (16 + l15) * IP + 32 * ks + 8 * l4), s1, 0, 0, 0); }
          Sacc[0] = s0; Sacc[1] = s1; }
        __syncthreads();
    }
#undef RET_LOAD
#pragma unroll
    for (int ej = 0; ej < 2; ++ej)
#pragma unroll
        for (int r = 0; r < 4; ++r) so[(long)(16 * wid + 4 * l4 + r) * RV + 16 * ej + l15] = Sacc[ej][r];
}

__device__ __forceinline__ void unit(KParams& p, int l, int u, char* lds) {
    const int tid = otid(); unsigned char* ws = optr(gp(p.ws)); const bf16_t* Y = (const bf16_t*)(ws + WS_Y); bf16_t* OB = (bf16_t*)(ws + WS_OB);
    const bool samp = u >= 256; const int v = samp ? u - 256 : u; const int b = v >> 6, h = (v >> 3) & 7, es = v & 7; const float lg = p.lg[h];
    if (samp) run<64>(Y, OB, gp(p.state_ret) + ((((long)l * DB + b) * RH + h) * RQK) * RV + es * 32, gp(p.out) + O_RETS + ((((long)l * DB + b) * RH + h) * RQK) * RV + es * 32, (long)TP + b * 64, 1, h, es, lg, lds, tid);
    else run<64>(Y, OB, nullptr, gp(p.out) + O_RETP + ((((long)l * NB + b) * RH + h) * RQK) * RV + es * 32, (long)b * SEQ, SEQ / 64, h, es, lg, lds, tid);
}
}
namespace peer {
__device__ __forceinline__ void ins16(float (&l)[16], float x) {
#pragma unroll
    for (int j = 0; j < 16; ++j) { const float hi = fmaxf(l[j], x); x = fminf(l[j], x); l[j] = hi; }
}
#define CE_DESC(a, b) do { const float hi_ = fmaxf(a, b), lo_ = fminf(a, b); a = hi_; b = lo_; } while (0)
#define CE_ASC(a, b) do { const float hi_ = fmaxf(a, b), lo_ = fminf(a, b); a = lo_; b = hi_; } while (0)
__device__ __forceinline__ void sort16_desc(float (&v)[16]) {
#pragma unroll
    for (int k = 2; k <= 16; k <<= 1)
#pragma unroll
        for (int j = k >> 1; j >= 1; j >>= 1)
#pragma unroll
            for (int i = 0; i < 16; ++i) { const int l = i ^ j; if (l > i) { if ((i & k) == 0) CE_DESC(v[i], v[l]); else CE_ASC(v[i], v[l]); } }
}
__device__ __forceinline__ void merge16_desc(float (&l)[16], const float (&o)[16]) {
#pragma unroll
    for (int i = 0; i < 16; ++i) l[i] = fmaxf(l[i], o[15 - i]);
#pragma unroll
    for (int j = 8; j >= 1; j >>= 1)
#pragma unroll
        for (int i = 0; i < 16; ++i) { const int m = i ^ j; if (m > i) CE_DESC(l[i], l[m]); }
}
constexpr int KPITCH = 136;
__device__ __forceinline__ void half_top16(const bf16_t* __restrict__ qrow, const bf16_t* __restrict__ keys, int lane, float (&l)[16]) {
    const int r32 = lane & 31, g = lane >> 5;
#pragma unroll
    for (int j = 0; j < 16; ++j) l[j] = -3.0e38f;
    bf16x8 qf[8];
#pragma unroll
    for (int ks = 0; ks < 8; ++ks) qf[ks] = *reinterpret_cast<const bf16x8*>(qrow + 16 * ks + 8 * g);
#pragma unroll 1
    for (int kb = 0; kb < 4; ++kb) { f32x16 a = f32x16{};
#pragma unroll
        for (int ks = 0; ks < 8; ++ks) { const bf16x8 kf = *reinterpret_cast<const bf16x8*>(keys + (32 * kb + r32) * KPITCH + 16 * ks + 8 * g);
            a = __builtin_amdgcn_mfma_f32_32x32x16_bf16(kf, qf[ks], a, 0, 0, 0); }
        float blk[16];
#pragma unroll
        for (int r = 0; r < 16; ++r) { const unsigned key = (unsigned)(32 * kb + (r & 3) + 8 * (r >> 2) + 4 * g);
            blk[r] = __uint_as_float((__float_as_uint(a[r]) & ~0x7Fu) | key); }
        sort16_desc(blk); merge16_desc(l, blk); }
}
__device__ __forceinline__ void merge_lists(float (&l)[16], const float (&o)[16]) { merge16_desc(l, o); }
__device__ __forceinline__ void select_unit(const bf16_t* __restrict__ QP, const bf16_t* __restrict__ k1, const bf16_t* __restrict__ k2, int* __restrict__ PIDX, float* __restrict__ PW,
                                            int t0, int h, int lane, float* lds_lane  ) {
    const int r32 = lane & 31, g = lane >> 5;
    const bf16_t* qrow = QP + (long)(t0 + r32) * DM + h * 256;
    float la[16], lb[16];
    half_top16(qrow, k1, lane, la);
    half_top16(qrow + 128, k2, lane, lb);
    float m0[16], m1[16];
#pragma unroll
    for (int j = 0; j < 16; ++j) { auto rr = __builtin_amdgcn_permlane32_swap(__float_as_uint(la[j]), __float_as_uint(lb[j]), false, false); m0[j] = __uint_as_float(rr[0]); m1[j] = __uint_as_float(rr[1]); }
    merge_lists(m0, m1);
    float L1[16], L2[16];
#pragma unroll
    for (int j = 0; j < 16; ++j) { auto rr = __builtin_amdgcn_permlane32_swap(__float_as_uint(m0[j]), __float_as_uint(m0[j]), false, false);
        L1[j] = __uint_as_float(rr[0]); L2[j] = __uint_as_float(rr[1]); }
#define CAND(i, j) __uint_as_float((__float_as_uint(L1[i] + L2[j]) & ~0xFFu) | (unsigned)((i) * 16 + (j)))
    float best[16], c2[16], c3[16];
#pragma unroll
    for (int j = 0; j < 16; ++j) best[j] = CAND(0, j);
    sort16_desc(best);
    c2[0] = CAND(1, 0); c2[1] = CAND(1, 1); c2[2] = CAND(1, 2); c2[3] = CAND(1, 3); c2[4] = CAND(1, 4); c2[5] = CAND(1, 5); c2[6] = CAND(1, 6); c2[7] = CAND(1, 7);
    c2[8] = CAND(2, 0); c2[9] = CAND(2, 1); c2[10] = CAND(2, 2); c2[11] = CAND(2, 3); c2[12] = CAND(2, 4); c2[13] = CAND(4, 0); c2[14] = CAND(4, 1); c2[15] = CAND(4, 2);
    sort16_desc(c2); merge16_desc(best, c2);
    c3[0] = CAND(3, 0); c3[1] = CAND(3, 1); c3[2] = CAND(3, 2); c3[3] = CAND(3, 3); c3[4] = CAND(5, 0); c3[5] = CAND(5, 1); c3[6] = CAND(6, 0); c3[7] = CAND(6, 1);
    c3[8] = CAND(7, 0); c3[9] = CAND(7, 1); c3[10] = CAND(8, 0); c3[11] = CAND(9, 0); c3[12] = CAND(10, 0); c3[13] = CAND(11, 0); c3[14] = CAND(12, 0); c3[15] = CAND(13, 0);
    sort16_desc(c3); merge16_desc(best, c3);
    ins16(best, CAND(14, 0)); ins16(best, CAND(15, 0));
#undef CAND
#pragma unroll
    for (int j = 0; j < 16; ++j) { lds_lane[j] = __uint_as_float(__float_as_uint(L1[j]) & 0x7Fu); lds_lane[16 + j] = __uint_as_float(__float_as_uint(L2[j]) & 0x7Fu); }
    asm volatile("s_waitcnt lgkmcnt(0)" ::: "memory");
    float wsum = 0.f, w[16]; int ei[16];
    const float mx = best[0];
#pragma unroll
    for (int k = 0; k < 16; ++k) { const unsigned code = __float_as_uint(best[k]) & 0xFFu; const int i = (int)(code >> 4), j = (int)(code & 15u);
        const int i1 = (int)__float_as_uint(lds_lane[i]), i2 = (int)__float_as_uint(lds_lane[16 + j]); ei[k] = i1 * NKEYS + i2;
        w[k] = __expf(best[k] - mx); wsum += w[k]; }
    const float inv = 1.0f / wsum;
    if (g == 0) { int* ip = PIDX + (long)(t0 + r32) * 128 + h * 16; float* wp = PW + (long)(t0 + r32) * 128 + h * 16;
#pragma unroll
        for (int k = 0; k < 16; k += 4) { *reinterpret_cast<int4*>(ip + k) = make_int4(ei[k], ei[k + 1], ei[k + 2], ei[k + 3]);
            *reinterpret_cast<float4*>(wp + k) = make_float4(w[k] * inv, w[k + 1] * inv, w[k + 2] * inv, w[k + 3] * inv); } }
}

__device__ __forceinline__ float gelu_exact(float x) { return 0.5f * x * (1.0f + erff(x * 0.70710678118654752f)); }

__device__ __forceinline__ void dec16(const u32x4 w, f32x2 (&f)[8]) {
    f[0] = __builtin_amdgcn_cvt_pk_f32_fp8((int)w.x, false); f[1] = __builtin_amdgcn_cvt_pk_f32_fp8((int)w.x, true);
    f[2] = __builtin_amdgcn_cvt_pk_f32_fp8((int)w.y, false); f[3] = __builtin_amdgcn_cvt_pk_f32_fp8((int)w.y, true);
    f[4] = __builtin_amdgcn_cvt_pk_f32_fp8((int)w.z, false); f[5] = __builtin_amdgcn_cvt_pk_f32_fp8((int)w.z, true);
    f[6] = __builtin_amdgcn_cvt_pk_f32_fp8((int)w.w, false); f[7] = __builtin_amdgcn_cvt_pk_f32_fp8((int)w.w, true);
}
__device__ __forceinline__ void gather_token(const bf16_t* __restrict__ H, const unsigned char* __restrict__ PU, const unsigned char* __restrict__ PV, const float* __restrict__ SU, const float* __restrict__ SV,
                                             const int* __restrict__ PIDX, const float* __restrict__ PW, float* __restrict__ X, const float* __restrict__ gate  , int t, int lane) {
    f32x2 xf[2][8];
#pragma unroll
    for (int hlf = 0; hlf < 2; ++hlf)
#pragma unroll
        for (int q = 0; q < 2; ++q) { const u32x4 w = *reinterpret_cast<const u32x4*>(H + (long)t * DM + 1024 * hlf + 16 * lane + 8 * q);
            xf[hlf][4 * q + 0] = (f32x2){bflo(w.x), bfhi(w.x)}; xf[hlf][4 * q + 1] = (f32x2){bflo(w.y), bfhi(w.y)}; xf[hlf][4 * q + 2] = (f32x2){bflo(w.z), bfhi(w.z)}; xf[hlf][4 * q + 3] = (f32x2){bflo(w.w), bfhi(w.w)}; }
    f32x2 out[2][8];
#pragma unroll
    for (int hlf = 0; hlf < 2; ++hlf)
#pragma unroll
        for (int i = 0; i < 8; ++i) out[hlf][i] = (f32x2){0.f, 0.f};
    const int myidx0 = PIDX[(long)t * 128 + lane], myidx1 = PIDX[(long)t * 128 + 64 + lane];
    const float myw0 = PW[(long)t * 128 + lane], myw1 = PW[(long)t * 128 + 64 + lane];
    const float msu0 = SU[myidx0], msu1 = SU[myidx1], msv0 = SV[myidx0], msv1 = SV[myidx1];
    for (int hk = 0; hk < 128; hk += 4) {
        const int src = hk & 63; const bool lo = hk < 64;
        const int selidx = lo ? myidx0 : myidx1; const int selw = __float_as_int(lo ? myw0 : myw1), selsu = __float_as_int(lo ? msu0 : msu1), selsv = __float_as_int(lo ? msv0 : msv1);
        int e[4]; float g[4], su[4], sv[4];
#pragma unroll
        for (int k = 0; k < 4; ++k) { e[k] = __builtin_amdgcn_readlane(selidx, src + k); g[k] = __int_as_float(__builtin_amdgcn_readlane(selw, src + k));
            su[k] = __int_as_float(__builtin_amdgcn_readlane(selsu, src + k)); sv[k] = __int_as_float(__builtin_amdgcn_readlane(selsv, src + k)); }
        u32x4 uw[4][2], vw[4][2];
#pragma unroll
        for (int k = 0; k < 4; ++k) { uw[k][0] = *reinterpret_cast<const u32x4*>(PU + ((long)(lane >> 3) * NEXP + e[k]) * 128 + 16 * (lane & 7)); uw[k][1] = *reinterpret_cast<const u32x4*>(PU + ((long)(8 + (lane >> 3)) * NEXP + e[k]) * 128 + 16 * (lane & 7)); }
#pragma unroll
        for (int k = 0; k < 4; ++k) { { const u32x2 a0 = *reinterpret_cast<const u32x2*>(PV + ((long)(2 * lane) * NEXP + e[k]) * 8), a1 = *reinterpret_cast<const u32x2*>(PV + ((long)(2 * lane + 1) * NEXP + e[k]) * 8);
              const u32x2 b0 = *reinterpret_cast<const u32x2*>(PV + ((long)(128 + 2 * lane) * NEXP + e[k]) * 8), b1 = *reinterpret_cast<const u32x2*>(PV + ((long)(129 + 2 * lane) * NEXP + e[k]) * 8);
              vw[k][0] = (u32x4){a0.x, a0.y, a1.x, a1.y}; vw[k][1] = (u32x4){b0.x, b0.y, b1.x, b1.y}; } }
        float a[4];
#pragma unroll
        for (int k = 0; k < 4; ++k) { f32x2 d = (f32x2){0.f, 0.f};
#pragma unroll
            for (int hlf = 0; hlf < 2; ++hlf) { f32x2 f[8]; dec16(uw[k][hlf], f);
#pragma unroll
                for (int i = 0; i < 8; ++i) d = __builtin_elementwise_fma(f[i], xf[hlf][i], d); }
            a[k] = wave_sum(d[0] + d[1]); }
#pragma unroll
        for (int k = 0; k < 4; ++k) { const float ak = g[k] * gelu_exact(a[k] * su[k]) * sv[k]; const f32x2 a2 = (f32x2){ak, ak};
#pragma unroll
            for (int hlf = 0; hlf < 2; ++hlf) { f32x2 f[8]; dec16(vw[k][hlf], f);
#pragma unroll
                for (int i = 0; i < 8; ++i) out[hlf][i] = __builtin_elementwise_fma(f[i], a2, out[hlf][i]); } }
    }
    const float* gr = gate + (long)cond_row(t) * 12288;
#pragma unroll
    for (int hlf = 0; hlf < 2; ++hlf)
#pragma unroll
        for (int q = 0; q < 4; ++q) { const int c = 1024 * hlf + 16 * lane + 4 * q; float* xp = X + (long)t * DM + c;
            const f32x4 gv = *reinterpret_cast<const f32x4*>(gr + c); f32x4 xv = *reinterpret_cast<const f32x4*>(xp);
            xv[0] += gv[0] * out[hlf][2 * q][0]; xv[1] += gv[1] * out[hlf][2 * q][1]; xv[2] += gv[2] * out[hlf][2 * q + 1][0]; xv[3] += gv[3] * out[hlf][2 * q + 1][1];
            *reinterpret_cast<f32x4*>(xp) = xv; }
}

constexpr int SW = 128, NSL = DM / SW;
struct XInfo { int rank, xi, nx, nloc; };
__device__ __forceinline__ void upass(const bf16_t* __restrict__ H, const unsigned char* __restrict__ PU, const int* __restrict__ PIDX, const float* __restrict__ PW, const float* __restrict__ SU, const float* __restrict__ SV,
                                      float* __restrict__ DOTP, unsigned* __restrict__ PACKT, const XInfo xin, int wid, int lane) {
    const int g = lane >> 3, c = lane & 7; const int nwv = xin.nloc * 8;
    const int tlo = (int)((long)T * xin.xi / xin.nx), thi = (int)((long)T * (xin.xi + 1) / xin.nx); const int wv = tlo + xin.rank * 8 + wid;
    float* dp = DOTP;
    for (int s = 0; s < NSL; ++s) { const bool first = (s == 0), lastS = (s == NSL - 1);
        const __amdgpu_buffer_rsrc_t urs = __builtin_amdgcn_make_buffer_rsrc((void*)(PU + (long)s * NEXP * SW), 0, NEXP * SW, 0x00020000);
#define UP_ROW(e_) __builtin_bit_cast(u32x4, __builtin_amdgcn_raw_buffer_load_b128(urs, (e_) * SW + 16 * c, 0, 0))
#define UP_IDX(tt, q4) (*reinterpret_cast<const int4*>(PIDX + (long)(tt) * 128 + 16 * g + 4 * (q4)))
#define UP_X(tt, q2) (*reinterpret_cast<const u32x4*>(H + (long)(tt) * DM + SW * s + 16 * c + 8 * (q2)))
        if (wv >= thi) continue;
        u32x4 A[8], B[8]; int4 en[4]; u32x4 xn[2];
        { int4 e0[4];
#pragma unroll
          for (int q4 = 0; q4 < 4; ++q4) e0[q4] = UP_IDX(wv, q4);
          A[0] = UP_ROW(e0[0].x); A[1] = UP_ROW(e0[0].y); A[2] = UP_ROW(e0[0].z); A[3] = UP_ROW(e0[0].w); A[4] = UP_ROW(e0[1].x); A[5] = UP_ROW(e0[1].y); A[6] = UP_ROW(e0[1].z); A[7] = UP_ROW(e0[1].w);
          B[0] = UP_ROW(e0[2].x); B[1] = UP_ROW(e0[2].y); B[2] = UP_ROW(e0[2].z); B[3] = UP_ROW(e0[2].w); B[4] = UP_ROW(e0[3].x); B[5] = UP_ROW(e0[3].y); B[6] = UP_ROW(e0[3].z); B[7] = UP_ROW(e0[3].w);
          const int t1 = (wv + nwv < thi) ? wv + nwv : wv;
#pragma unroll
          for (int q4 = 0; q4 < 4; ++q4) en[q4] = UP_IDX(t1, q4);
          xn[0] = UP_X(wv, 0); xn[1] = UP_X(wv, 1); }
#pragma unroll 1
        for (int t = wv; t < thi; t += nwv) {
            const int tn = (t + nwv < thi) ? t + nwv : t, tnn = (tn + nwv < thi) ? tn + nwv : tn;
            f32x2 xf[8];
#pragma unroll
            for (int q2 = 0; q2 < 2; ++q2) { const u32x4 hw = xn[q2];
                xf[4 * q2 + 0] = (f32x2){bflo(hw.x), bfhi(hw.x)}; xf[4 * q2 + 1] = (f32x2){bflo(hw.y), bfhi(hw.y)}; xf[4 * q2 + 2] = (f32x2){bflo(hw.z), bfhi(hw.z)}; xf[4 * q2 + 3] = (f32x2){bflo(hw.w), bfhi(hw.w)}; }
            xn[0] = UP_X(tn, 0); xn[1] = UP_X(tn, 1);
            float d[16];
#pragma unroll
            for (int i = 0; i < 8; ++i) { f32x2 f[8]; dec16(A[i], f); f32x2 a = (f32x2){0.f, 0.f};
#pragma unroll
                for (int k = 0; k < 8; ++k) a = __builtin_elementwise_fma(f[k], xf[k], a);
                d[i] = a[0] + a[1]; }
            A[0] = UP_ROW(en[0].x); A[1] = UP_ROW(en[0].y); A[2] = UP_ROW(en[0].z); A[3] = UP_ROW(en[0].w); A[4] = UP_ROW(en[1].x); A[5] = UP_ROW(en[1].y); A[6] = UP_ROW(en[1].z); A[7] = UP_ROW(en[1].w);
#pragma unroll
            for (int i = 0; i < 8; ++i) { f32x2 f[8]; dec16(B[i], f); f32x2 a = (f32x2){0.f, 0.f};
#pragma unroll
                for (int k = 0; k < 8; ++k) a = __builtin_elementwise_fma(f[k], xf[k], a);
                d[8 + i] = a[0] + a[1]; }
            B[0] = UP_ROW(en[2].x); B[1] = UP_ROW(en[2].y); B[2] = UP_ROW(en[2].z); B[3] = UP_ROW(en[2].w); B[4] = UP_ROW(en[3].x); B[5] = UP_ROW(en[3].y); B[6] = UP_ROW(en[3].z); B[7] = UP_ROW(en[3].w);
#pragma unroll
            for (int q4 = 0; q4 < 4; ++q4) en[q4] = UP_IDX(tnn, q4);
            float r8[8], r4[4], r2[2];
#pragma unroll
            for (int k = 0; k < 8; ++k) { const float keep = (c & 4) ? d[k + 8] : d[k], send = (c & 4) ? d[k] : d[k + 8]; r8[k] = keep + sx<4>(send); }
#pragma unroll
            for (int k = 0; k < 4; ++k) { const float keep = (c & 2) ? r8[k + 4] : r8[k], send = (c & 2) ? r8[k] : r8[k + 4]; r4[k] = keep + sx<2>(send); }
#pragma unroll
            for (int k = 0; k < 2; ++k) { const float keep = (c & 1) ? r4[k + 2] : r4[k], send = (c & 1) ? r4[k] : r4[k + 2]; r2[k] = keep + sx<1>(send); }
            float* o = dp + (long)t * 128 + 16 * g + 2 * c;
            f32x2 acc = (f32x2){r2[0], r2[1]};
            if (!first) acc += *reinterpret_cast<const f32x2*>(o);
            if (!lastS) *reinterpret_cast<f32x2*>(o) = acc;
            else {
                const int p0 = 16 * g + 2 * c; const int2 ee = *reinterpret_cast<const int2*>(PIDX + (long)t * 128 + p0); const f32x2 gw = *reinterpret_cast<const f32x2*>(PW + (long)t * 128 + p0);
                const float a0 = gw[0] * gelu_exact(acc[0] * SU[ee.x]) * SV[ee.x], a1 = gw[1] * gelu_exact(acc[1] * SU[ee.y]) * SV[ee.y];
                u32x2 pk; pk.x = (cvt_pk_bf16(0.f, a0) & 0xffff0000u) | (unsigned)ee.x; pk.y = (cvt_pk_bf16(0.f, a1) & 0xffff0000u) | (unsigned)ee.y;
                *reinterpret_cast<u32x2*>(PACKT + ((long)(p0 >> 2) * T + t) * 4 + (p0 & 3)) = pk; }
        }
#undef UP_ROW
#undef UP_IDX
#undef UP_X
    }
}
__device__ __forceinline__ void actpass(const float* __restrict__ DOTP, const int* __restrict__ PIDX, const float* __restrict__ PW, const float* __restrict__ SU, const float* __restrict__ SV, float* __restrict__ ACT, int nx, long gt, long nt) {
    for (long i = gt; i < (long)T * 128; i += nt) { float dsum = 0.f;
        for (int x = 0; x < nx; ++x) dsum += DOTP[(long)x * T * 128 + i];
        const int e = PIDX[i]; const float av = PW[i] * gelu_exact(dsum * SU[e]) * SV[e]; const long t = i >> 7; const int pp = (int)(i & 127);
        reinterpret_cast<unsigned*>(ACT)[((long)(pp >> 2) * T + t) * 4 + (pp & 3)] = (cvt_pk_bf16(0.f, av) & 0xffff0000u) | (unsigned)e; }
}
__device__ __forceinline__ void vpass(const unsigned char* __restrict__ PV, const int* __restrict__ PIDX, const float* __restrict__ ACT, float* __restrict__ X, const float* __restrict__ gate, const XInfo xin, int wid, int lane) {
    const int g = lane >> 3, c = lane & 7; const int wv = xin.rank * 8 + wid, nwv = xin.nloc * 8;
    for (int s = xin.xi; s < NSL; s += xin.nx) {
        int4 en[4]; f32x4 an[4];
#pragma unroll
        for (int q4 = 0; q4 < 4; ++q4) { en[q4] = *reinterpret_cast<const int4*>(PIDX + (long)(wv < T ? wv : 0) * 128 + 16 * g + 4 * q4); an[q4] = *reinterpret_cast<const f32x4*>(ACT + (long)(wv < T ? wv : 0) * 128 + 16 * g + 4 * q4); }
        for (int t = wv; t < T; t += nwv) {
            int e[16]; float a[16];
#pragma unroll
            for (int q4 = 0; q4 < 4; ++q4) { e[4 * q4] = en[q4].x; e[4 * q4 + 1] = en[q4].y; e[4 * q4 + 2] = en[q4].z; e[4 * q4 + 3] = en[q4].w; a[4 * q4] = an[q4][0]; a[4 * q4 + 1] = an[q4][1]; a[4 * q4 + 2] = an[q4][2]; a[4 * q4 + 3] = an[q4][3]; }
            u32x4 w[16];
#pragma unroll
            for (int i = 0; i < 16; ++i) w[i] = *reinterpret_cast<const u32x4*>(PV + ((long)s * NEXP + e[i]) * SW + 16 * c);
            { const int tn = (t + nwv < T) ? t + nwv : t;
#pragma unroll
              for (int q4 = 0; q4 < 4; ++q4) { en[q4] = *reinterpret_cast<const int4*>(PIDX + (long)tn * 128 + 16 * g + 4 * q4); an[q4] = *reinterpret_cast<const f32x4*>(ACT + (long)tn * 128 + 16 * g + 4 * q4); } }
            f32x2 o[8];
#pragma unroll
            for (int k = 0; k < 8; ++k) o[k] = (f32x2){0.f, 0.f};
#pragma unroll
            for (int i = 0; i < 16; ++i) { f32x2 f[8]; dec16(w[i], f); const f32x2 a2 = (f32x2){a[i], a[i]};
#pragma unroll
                for (int k = 0; k < 8; ++k) o[k] = __builtin_elementwise_fma(f[k], a2, o[k]); }
            f32x2 r4[4], r2[2], r1;
#pragma unroll
            for (int k = 0; k < 4; ++k) { const f32x2 keep = (g & 4) ? o[k + 4] : o[k], send = (g & 4) ? o[k] : o[k + 4]; r4[k] = keep + (f32x2){sx<32>(send[0]), sx<32>(send[1])}; }
#pragma unroll
            for (int k = 0; k < 2; ++k) { const f32x2 keep = (g & 2) ? r4[k + 2] : r4[k], send = (g & 2) ? r4[k] : r4[k + 2]; r2[k] = keep + (f32x2){sx<16>(send[0]), sx<16>(send[1])}; }
            { const f32x2 keep = (g & 1) ? r2[1] : r2[0], send = (g & 1) ? r2[0] : r2[1]; r1 = keep + (f32x2){sx<8>(send[0]), sx<8>(send[1])}; }
            const int col = SW * s + 16 * c + 2 * g;
            const f32x2 gv = *reinterpret_cast<const f32x2*>(gate + (long)cond_row(t) * 12288 + col);
            float* xp = X + (long)t * DM + col; f32x2 xv = *reinterpret_cast<const f32x2*>(xp);
            xv += gv * r1; *reinterpret_cast<f32x2*>(xp) = xv;
        }
    }
}

__device__ __forceinline__ void vpass_lds(const unsigned char* __restrict__ PV, const unsigned* __restrict__ PACKT, float* __restrict__ X, const float* __restrict__ gate, char* lds, int bid, int nb, int s_end, int tid) {
    const int wid = tid >> 6, lane = tid & 63;
    for (int s = bid; s < s_end; s += nb) {
        __syncthreads();
        { const u32x4* src = reinterpret_cast<const u32x4*>(PV + (long)s * NEXP * 8); u32x4* dst = reinterpret_cast<u32x4*>(lds);
#pragma unroll 4
          for (int i = tid; i < NEXP * 8 / 16; i += 512) dst[i] = src[i]; }
        __syncthreads();
        u32x4 h0[8], h1[8];
        const __amdgpu_buffer_rsrc_t vrs = __builtin_amdgcn_make_buffer_rsrc((void*)PACKT, 0, (int)((size_t)T * 128 * 4), 0x00020000);
#define VP_LD(k, toff) __builtin_bit_cast(u32x4, __builtin_amdgcn_raw_buffer_load_b128(vrs, (int)(toff), (int)((size_t)(k) * T * 16), 0))
        { const unsigned toff = (unsigned)(wid * 64 + lane) * 16u;
#pragma unroll
          for (int k = 0; k < 8; ++k) h0[k] = VP_LD(k, toff);
#pragma unroll
          for (int k = 0; k < 8; ++k) h1[k] = VP_LD(8 + k, toff); }
#define VP_STEP(HB) do { _Pragma("unroll") for (int kk = 0; kk < 8; kk += 2) { unsigned pw[8]; \
            _Pragma("unroll") for (int k = 0; k < 2; ++k) { pw[4 * k] = HB[kk + k].x; pw[4 * k + 1] = HB[kk + k].y; pw[4 * k + 2] = HB[kk + k].z; pw[4 * k + 3] = HB[kk + k].w; } \
            u32x2 w[8]; \
            _Pragma("unroll") for (int k = 0; k < 8; ++k) w[k] = *reinterpret_cast<const u32x2*>(lds + (pw[k] & 0xffffu) * 8u); \
            _Pragma("unroll") for (int k = 0; k < 8; ++k) { const float a = __uint_as_float(pw[k] & 0xffff0000u); \
                const f32x2 f0 = __builtin_amdgcn_cvt_pk_f32_fp8((int)w[k].x, false), f1 = __builtin_amdgcn_cvt_pk_f32_fp8((int)w[k].x, true), f2 = __builtin_amdgcn_cvt_pk_f32_fp8((int)w[k].y, false), f3 = __builtin_amdgcn_cvt_pk_f32_fp8((int)w[k].y, true); \
                acc[0] = fmaf(a, f0[0], acc[0]); acc[1] = fmaf(a, f0[1], acc[1]); acc[2] = fmaf(a, f1[0], acc[2]); acc[3] = fmaf(a, f1[1], acc[3]); \
                acc[4] = fmaf(a, f2[0], acc[4]); acc[5] = fmaf(a, f2[1], acc[5]); acc[6] = fmaf(a, f3[0], acc[6]); acc[7] = fmaf(a, f3[1], acc[7]); } } } while (0)
#pragma unroll 1
        for (int tg = wid; tg < T / 64; tg += 8) { const int t = tg * 64 + lane; const int tgn = (tg + 8 < T / 64) ? tg + 8 : tg;
            const unsigned toff = (unsigned)t * 16u, toffn = (unsigned)(tgn * 64 + lane) * 16u;
            float acc[8];
#pragma unroll
            for (int j = 0; j < 8; ++j) acc[j] = 0.f;
            VP_STEP(h0);
#pragma unroll
            for (int k = 0; k < 8; ++k) h0[k] = VP_LD(16 + k, toff);
            VP_STEP(h1);
#pragma unroll
            for (int k = 0; k < 8; ++k) h1[k] = VP_LD(24 + k, toff);
            VP_STEP(h0);
#pragma unroll
            for (int k = 0; k < 8; ++k) h0[k] = VP_LD(k, toffn);
            VP_STEP(h1);
#pragma unroll
            for (int k = 0; k < 8; ++k) h1[k] = VP_LD(8 + k, toffn);
            const float* gr = gate + (long)cond_row(t) * 12288 + 8 * s; float* xp = X + (long)t * DM + 8 * s;
            const f32x4 g0 = *reinterpret_cast<const f32x4*>(gr), g1 = *reinterpret_cast<const f32x4*>(gr + 4);
            f32x4 x0 = *reinterpret_cast<const f32x4*>(xp), x1 = *reinterpret_cast<const f32x4*>(xp + 4);
            x0[0] += g0[0] * acc[0]; x0[1] += g0[1] * acc[1]; x0[2] += g0[2] * acc[2]; x0[3] += g0[3] * acc[3];
            x1[0] += g1[0] * acc[4]; x1[1] += g1[1] * acc[5]; x1[2] += g1[2] * acc[6]; x1[3] += g1[3] * acc[7];
            *reinterpret_cast<f32x4*>(xp) = x0; *reinterpret_cast<f32x4*>(xp + 4) = x1; }
#undef VP_STEP
#undef VP_LD
    }
    __syncthreads();
}
}
namespace ph {
__device__ __forceinline__ int gwave() { return obid() * 8 + (otid() >> 6); }
__device__ __forceinline__ int nwaves() { return ogrid() * 8; }
__device__ __forceinline__ long gthread() { return (long)obid() * 512 + otid(); }
__device__ __forceinline__ long nthreads() { return (long)ogrid() * 512; }

__device__ __forceinline__ void transpose_tile(const float* __restrict__ src, int C, int r0, int c0, bf16_t* __restrict__ dst, long dpitch, float* tile) {
    const int tid = otid();
#pragma unroll
    for (int i = 0; i < 8; ++i) { const int idx = tid + 512 * i, r = idx >> 6, c = idx & 63; tile[r * 65 + c] = src[(long)(r0 + r) * C + c0 + c]; }
    __syncthreads();
    { const int c = tid >> 3, rc = (tid & 7) * 8; float f[8];
#pragma unroll
      for (int j = 0; j < 8; ++j) f[j] = tile[(rc + j) * 65 + c];
      *reinterpret_cast<u32x4*>(dst + (long)(c0 + c) * dpitch + r0 + rc) = pack8(f); }
    __syncthreads();
}

__device__ __forceinline__ void zero_chunks(bf16_t* base, long nrows, long rowpitch, int col0, int nchunk) {
    const long total = nrows * nchunk;
    for (long i = gthread(); i < total; i += nthreads()) { const long r = i / nchunk; const int ch = (int)(i % nchunk);
        *reinterpret_cast<u32x4*>(base + r * rowpitch + col0 + ch * 8) = (u32x4){0u, 0u, 0u, 0u}; }
}

__device__ __forceinline__ void prologue(KParams& p, char* lds) {
    unsigned char* ws = optr(gp(p.ws)); const int tid = otid();
    float* tile = (float*)lds;
    { struct TJob { const float* src; bf16_t* dst; int R, C, r0, c0, perm; };
      auto decode = [&](int it) { TJob j; j.perm = 0; const int l = it / 10656; int r = it % 10656;
        if (r < 5664) { j.src = gp(p.w_in) + (long)l * DM * INW; j.R = DM; j.C = INW; j.dst = (bf16_t*)(ws + WS_WIN) + (long)l * INWP * DM; }
        else if (r < 6048) { r -= 5664; j.src = gp(p.w_uq) + (long)l * 512 * 3072; j.R = 512; j.C = 3072; j.dst = (bf16_t*)(ws + WS_WUQ) + (long)l * 3072 * 512; j.perm = 1; }
        else if (r < 6560) { r -= 6048; j.src = gp(p.w_ukv) + (long)l * 512 * 4096; j.R = 512; j.C = 4096; j.dst = (bf16_t*)(ws + WS_WUKV) + (long)l * 4096 * 512; }
        else { r -= 6560; const int m = r >> 10; r &= 1023; j.R = DM; j.C = DM;
            j.src = (m == 0 ? gp(p.w_a) : m == 1 ? gp(p.w_b) : m == 2 ? gp(p.w_o) : gp(p.w_pq)) + (long)l * DM * DM;
            j.dst = (bf16_t*)(ws + (m == 0 ? WS_WA : m == 1 ? WS_WB : m == 2 ? WS_WO : WS_WPQ)) + (long)l * DM * DM; }
        const int ntc = j.C / 64; j.r0 = (r / ntc) * 64; j.c0 = (r % ntc) * 64; return j; };
      const int NTILES = 2 * 10656, G_ = ogrid(); int it = obid(); float v[8]; TJob cur{};
      if (it < NTILES) { cur = decode(it);
#pragma unroll
        for (int i = 0; i < 8; ++i) { const int idx = tid + 512 * i, r = idx >> 6, c = idx & 63; v[i] = cur.src[(long)(cur.r0 + r) * cur.C + cur.c0 + c]; } }
      while (it < NTILES) { const int itn = it + G_; float vn[8]; TJob nxt{};
        if (itn < NTILES) { nxt = decode(itn);
#pragma unroll
            for (int i = 0; i < 8; ++i) { const int idx = tid + 512 * i, r = idx >> 6, c = idx & 63; vn[i] = nxt.src[(long)(nxt.r0 + r) * nxt.C + nxt.c0 + c]; } }
#pragma unroll
        for (int i = 0; i < 8; ++i) { const int idx = tid + 512 * i, r = idx >> 6, c = idx & 63; tile[r * 65 + c] = v[i]; }
        __syncthreads();
        { const int c = tid >> 3, rc = (tid & 7) * 8; float f[8];
#pragma unroll
          for (int jj = 0; jj < 8; ++jj) f[jj] = tile[(rc + jj) * 65 + c];
          int drow = cur.c0 + c;
          if (cur.perm) { const int gq = drow / 768, o = drow - 768 * gq, hh = o / 192, w = o - 192 * hh;
              drow = 768 * gq + (w < 128 ? 128 * hh + w : (w < 160 ? 512 + 32 * hh + (w - 128) : 640 + 32 * hh + (w - 160))); }
          *reinterpret_cast<u32x4*>(cur.dst + (long)drow * cur.R + cur.r0 + rc) = pack8(f); }
        __syncthreads();
#pragma unroll
        for (int i = 0; i < 8; ++i) v[i] = vn[i];
        cur = nxt; it = itn; } }
    for (long i = gthread(); i < 2L * 16 * 512 * 32; i += nthreads()) { const int ch = (int)(i & 31); const long row = i >> 5; const int c = (int)(row & 511), h = (int)((row >> 9) & 15), l = (int)(row >> 13);
        u32x4 w = (u32x4){0u, 0u, 0u, 0u};
        if (ch < 16) { const float* s = gp(p.w_ukv) + (((long)l * 512 + c) * 16 + h) * 256 + ch * 8; float f[8];
#pragma unroll
            for (int j = 0; j < 8; ++j) f[j] = s[j];
            w = pack8(f); }
        *reinterpret_cast<u32x4*>((bf16_t*)(ws + WS_WUK) + row * 256 + ch * 8) = w; }
    for (long i = gthread(); i < 2L * 4096; i += nthreads()) { const bool second = i >= 4096; const long j8 = (second ? i - 4096 : i) * 8; const float* s = (second ? gp(p.peer_k2) : gp(p.peer_k1)) + j8; float f[8];
#pragma unroll
        for (int j = 0; j < 8; ++j) f[j] = s[j];
        *reinterpret_cast<u32x4*>((bf16_t*)(ws + (second ? WS_PK2 : WS_PK1)) + j8) = pack8(f); }
    for (int l = 0; l < 2; ++l) zero_chunks((bf16_t*)(ws + WS_WIN) + ((long)l * INWP + INW) * DM, INWP - INW, DM, 0, DM / 8);
    for (int b = 0; b < DB; ++b) zero_chunks((bf16_t*)(ws + WS_CKA) + ((long)b * KPAD + KALL) * QLD, KPAD - KALL, QLD, 0, QLD / 8);
    zero_chunks((bf16_t*)(ws + WS_CKA), (long)DB * KPAD, QLD, 576, 8);
    zero_chunks((bf16_t*)(ws + WS_CKT), (long)DB * 512, KPAD, KALL, (KPAD - KALL) / 8);
    zero_chunks((bf16_t*)(ws + WS_QL), (long)DB * 1024, QLD, 576, 8);
    for (long i = gthread(); i < 4096L * 96; i += nthreads()) { const int pos = (int)(i / 96), k = (int)(i % 96); const bool big = k >= 32; const int fi = big ? k - 32 : k; const float d = big ? 128.f : 64.f;
        const float inv = __builtin_amdgcn_exp2f(-(2.0f * (float)fi / d) * 13.287712379549449f);
        const float ang = (float)pos * inv; double rv = (double)ang * 0.15915494309189535; rv -= floor(rv); const float fr = (float)rv;
        float* dst = big ? (float*)(ws + WS_TAB128) + ((long)pos * 64 + fi) * 2 : (float*)(ws + WS_TAB64) + ((long)pos * 32 + fi) * 2;
        dst[0] = __builtin_amdgcn_cosf(fr); dst[1] = __builtin_amdgcn_sinf(fr); }
    { float* sc = (float*)lds;
      for (int it = obid(); it < 2 * 12 * 8; it += ogrid()) { const int l = it / 96, cc = (it % 96) / 8, ks = it % 8;
        __syncthreads();
        for (int i = tid; i < NCOND * 256; i += 512) { const int r = i >> 8, k = i & 255; const float c = r < NB ? gp(p.c_prompt)[(long)r * DM + ks * 256 + k] : gp(p.c_sample)[(long)(r - NB) * DM + ks * 256 + k]; sc[i] = siluf_(c); }
        __syncthreads();
        float a0[NCOND], a1[NCOND];
#pragma unroll
        for (int r = 0; r < NCOND; ++r) { a0[r] = 0.f; a1[r] = 0.f; }
        const float* wp = gp(p.w_ada) + ((long)l * DM + ks * 256) * 12288 + cc * 1024 + 2 * tid;
#pragma unroll 1
        for (int k = 0; k < 256; k += 4) { const f32x2 w0 = *reinterpret_cast<const f32x2*>(wp), w1 = *reinterpret_cast<const f32x2*>(wp + 12288), w2 = *reinterpret_cast<const f32x2*>(wp + 2 * 12288), w3 = *reinterpret_cast<const f32x2*>(wp + 3 * 12288);
            wp += 4 * 12288;
#pragma unroll
            for (int r = 0; r < NCOND; ++r) { const f32x4 s = *reinterpret_cast<const f32x4*>(sc + r * 256 + k);
                a0[r] = fmaf(s[0], w0[0], fmaf(s[1], w1[0], fmaf(s[2], w2[0], fmaf(s[3], w3[0], a0[r]))));
                a1[r] = fmaf(s[0], w0[1], fmaf(s[1], w1[1], fmaf(s[2], w2[1], fmaf(s[3], w3[1], a1[r]))));
                if ((r % 6) == 5) __builtin_amdgcn_sched_barrier(0); } }
        float* dst = (float*)(ws + WS_ADAP) + (((long)ks * 2 + l) * NCOND) * 12288 + cc * 1024 + 2 * tid;
#pragma unroll
        for (int r = 0; r < NCOND; ++r) *reinterpret_cast<f32x2*>(dst + (long)r * 12288) = (f32x2){a0[r], a1[r]}; }
      __syncthreads(); }
}

__device__ __forceinline__ void ada_reduce(KParams& p) {
    unsigned char* ws = optr(gp(p.ws)); const float* ap = (const float*)(ws + WS_ADAP); float* ad = (float*)(ws + WS_ADA); const long n = 2L * NCOND * 12288;
    for (long i = gthread(); i < n; i += nthreads()) { const int l = (int)(i / (NCOND * 12288L)); const int j = (int)(i % 12288);
        float s = gp(p.b_ada)[(long)l * 12288 + j];
#pragma unroll
        for (int ks = 0; ks < 8; ++ks) s += ap[(long)ks * n + i];
        ad[i] = s; }
}

__device__ __forceinline__ void modulate(KParams& p, int l, int which) {
    const int lane = otid() & 63; unsigned char* ws = optr(gp(p.ws)); const float* X = gp(p.out); bf16_t* H = (bf16_t*)(ws + WS_H);
    const float* g = (which ? gp(p.g_ffn) : gp(p.g_mix)) + (long)l * DM; const float* ada = (const float*)(ws + WS_ADA) + (long)l * NCOND * 12288 + (which ? 3 : 0) * DM;
    for (int t = gwave(); t < T; t += nwaves()) {
        const float* xr = (l == 0 && which == 0) ? (t < TP ? gp(p.x_prompt) + (long)t * DM : gp(p.x_sample) + (long)(t - TP) * DM) : X + (long)t * DM; f32x4 v[8]; float ss = 0.f;
#pragma unroll
        for (int j = 0; j < 8; ++j) { v[j] = *reinterpret_cast<const f32x4*>(xr + 256 * j + 4 * lane); ss += v[j][0] * v[j][0] + v[j][1] * v[j][1] + v[j][2] * v[j][2] + v[j][3] * v[j][3]; }
        ss = wave_sum(ss); const float rinv = rsqrtf(ss * (1.0f / DM) + EPS);
        const float* sh = ada + (long)cond_row(t) * 12288; const float* sc = sh + DM;
#pragma unroll
        for (int j = 0; j < 8; ++j) { const int c = 256 * j + 4 * lane; const f32x4 gv = *reinterpret_cast<const f32x4*>(g + c), sv = *reinterpret_cast<const f32x4*>(sc + c), hv = *reinterpret_cast<const f32x4*>(sh + c);
            const f32x4 y = v[j] * rinv * gv * (sv + 1.0f) + hv; u32x2 w; w.x = cvt_pk_bf16(y[0], y[1]); w.y = cvt_pk_bf16(y[2], y[3]);
            *reinterpret_cast<u32x2*>(H + (long)t * DM + c) = w; }
    }
}

__device__ __forceinline__ void cache_convert(KParams& p, int l, char* lds, int it0, int it1, int bidx, int nb) {
    const int tid = otid(); unsigned char* ws = optr(gp(p.ws)); float* tile = (float*)lds; bf16_t* CKA = (bf16_t*)(ws + WS_CKA); bf16_t* CKT = (bf16_t*)(ws + WS_CKT);
    { const int NT_ = it1, G_ = nb; int it = it0 + bidx; float v[8];
      const float* cbase = gp(p.cache_ckv) + (long)l * DB * PAST * 512;
#define CC_SRC(itx) (cbase + (((long)((itx) >> 8)) * PAST + (((itx) >> 3) & 31) * 64) * 512 + ((itx) & 7) * 64)
      if (it < NT_) { const float* src = CC_SRC(it);
#pragma unroll
        for (int i = 0; i < 8; ++i) { const int idx = tid + 512 * i, r = idx >> 6, c = idx & 63; v[i] = src[(long)r * 512 + c]; } }
      while (it < NT_) { const int b = it >> 8, kt = (it >> 3) & 31, ct = it & 7; const int itn = it + G_; float vn[8];
        if (itn < NT_) { const float* src = CC_SRC(itn);
#pragma unroll
            for (int i = 0; i < 8; ++i) { const int idx = tid + 512 * i, r = idx >> 6, c = idx & 63; vn[i] = src[(long)r * 512 + c]; } }
#pragma unroll
        for (int i = 0; i < 8; ++i) { const int idx = tid + 512 * i, r = idx >> 6, c = idx & 63; tile[r * 65 + c] = v[i]; }
        __syncthreads();
        { const int r = tid >> 3, cc = (tid & 7) * 8; float f[8];
#pragma unroll
          for (int j = 0; j < 8; ++j) f[j] = tile[r * 65 + cc + j];
          *reinterpret_cast<u32x4*>(CKA + ((long)b * KPAD + kt * 64 + r) * QLD + ct * 64 + cc) = pack8(f);
#pragma unroll
          for (int j = 0; j < 8; ++j) f[j] = tile[(cc + j) * 65 + r];
          *reinterpret_cast<u32x4*>(CKT + ((long)b * 512 + ct * 64 + r) * KPAD + kt * 64 + cc) = pack8(f); }
        __syncthreads();
#pragma unroll
        for (int i = 0; i < 8; ++i) v[i] = vn[i];
        it = itn; }
#undef CC_SRC
    }
    for (long i = (long)it0 * 64 + (long)bidx * 512 + tid; i < (long)it1 * 64; i += (long)nb * 512) { const long row = i >> 3; const int ch = (int)(i & 7); const int b = (int)(row >> 11), k = (int)(row & 2047);
        const float* s = gp(p.cache_krope) + (((long)l * DB + b) * PAST + k) * 64 + ch * 8; float f[8];
#pragma unroll
        for (int j = 0; j < 8; ++j) f[j] = s[j];
        *reinterpret_cast<u32x4*>(CKA + ((long)b * KPAD + k) * QLD + 512 + ch * 8) = pack8(f); }
}

__device__ __forceinline__ void post_win(KParams& p, int l) {
    const int lane = otid() & 63; unsigned char* ws = optr(gp(p.ws));
    bf16_t* Y = (bf16_t*)(ws + WS_Y); bf16_t* CQN = (bf16_t*)(ws + WS_CQN); bf16_t* CKVNP = (bf16_t*)(ws + WS_CKVNP); bf16_t* KRP = (bf16_t*)(ws + WS_KRP); bf16_t* CKA = (bf16_t*)(ws + WS_CKA); bf16_t* CKT = (bf16_t*)(ws + WS_CKT);
    const float* T64 = (const float*)(ws + WS_TAB64); const float* T128 = (const float*)(ws + WS_TAB128);
    for (int t = gwave(); t < T; t += nwaves()) {
        bf16_t* y = Y + (long)t * INWP; const int pos = tok_pos(t); const bool samp = t >= TP; const int ts = t - TP, b = ts >> 6, s = ts & 63;
        { float f[8], o[8]; unpack8(*reinterpret_cast<const u32x4*>(y + C_CQ + 8 * lane), f); float ss = 0.f;
#pragma unroll
          for (int j = 0; j < 8; ++j) ss += f[j] * f[j];
          ss = wave_sum(ss); const float rinv = rsqrtf(ss * (1.0f / 512.f) + EPS); const float* g = gp(p.g_q) + (long)l * 512 + 8 * lane;
#pragma unroll
          for (int j = 0; j < 8; ++j) o[j] = f[j] * rinv * g[j];
          *reinterpret_cast<u32x4*>(CQN + (long)t * 512 + 8 * lane) = pack8(o); }
        { float f[8], o[8]; unpack8(*reinterpret_cast<const u32x4*>(y + C_CKV + 8 * lane), f); float ss = 0.f;
#pragma unroll
          for (int j = 0; j < 8; ++j) ss += f[j] * f[j];
          ss = wave_sum(ss); const float rinv = rsqrtf(ss * (1.0f / 512.f) + EPS); const float* g = gp(p.g_kv) + (long)l * 512 + 8 * lane;
#pragma unroll
          for (int j = 0; j < 8; ++j) o[j] = f[j] * rinv * g[j];
          float* od = gp(p.out) + (samp ? O_CKVS + ((long)l * TS + ts) * 512 : O_CKVP + ((long)l * TP + t) * 512) + 8 * lane;
          *reinterpret_cast<f32x4*>(od) = (f32x4){o[0], o[1], o[2], o[3]}; *reinterpret_cast<f32x4*>(od + 4) = (f32x4){o[4], o[5], o[6], o[7]};
          const u32x4 w = pack8(o);
          if (!samp) *reinterpret_cast<u32x4*>(CKVNP + (long)t * 512 + 8 * lane) = w;
          else { *reinterpret_cast<u32x4*>(CKA + ((long)b * KPAD + PAST + s) * QLD + 8 * lane) = w;
#pragma unroll
              for (int j = 0; j < 8; ++j) CKT[((long)b * 512 + 8 * lane + j) * KPAD + PAST + s] = f2bf(o[j]); } }
        if (lane < 32) { const float x1 = bf2f(y[C_KR + lane]), x2 = bf2f(y[C_KR + 32 + lane]); const float c = T64[((long)pos * 32 + lane) * 2], sn = T64[((long)pos * 32 + lane) * 2 + 1];
            const float o1 = x1 * c - x2 * sn, o2 = x1 * sn + x2 * c;
            float* od = gp(p.out) + (samp ? O_KRS + ((long)l * TS + ts) * 64 : O_KRP + ((long)l * TP + t) * 64); od[lane] = o1; od[32 + lane] = o2;
            if (!samp) { KRP[(long)t * 64 + lane] = f2bf(o1); KRP[(long)t * 64 + 32 + lane] = f2bf(o2); }
            else { bf16_t* d = CKA + ((long)b * KPAD + PAST + s) * QLD + 512; d[lane] = f2bf(o1); d[32 + lane] = f2bf(o2); } }
        { const int hh = lane >> 3, d0 = (lane & 7) * 8; const float* cs = T128 + ((long)pos * 64 + d0) * 2; float cv[8], sv[8];
#pragma unroll
          for (int j = 0; j < 4; ++j) { const f32x4 q = *reinterpret_cast<const f32x4*>(cs + 4 * j); cv[2 * j] = q[0]; sv[2 * j] = q[1]; cv[2 * j + 1] = q[2]; sv[2 * j + 1] = q[3]; }
#pragma unroll
          for (int which = 0; which < 2; ++which) { bf16_t* base = y + (which ? C_RK : C_RQ) + hh * 128 + d0; const float sca = which ? 0.08838834764831845f : 1.0f;
              float a[8], bq[8], o1[8], o2[8]; unpack8(*reinterpret_cast<const u32x4*>(base), a); unpack8(*reinterpret_cast<const u32x4*>(base + 64), bq);
#pragma unroll
              for (int j = 0; j < 8; ++j) { o1[j] = (a[j] * cv[j] - bq[j] * sv[j]) * sca; o2[j] = (a[j] * sv[j] + bq[j] * cv[j]) * sca; }
              *reinterpret_cast<u32x4*>(base) = pack8(o1); *reinterpret_cast<u32x4*>(base + 64) = pack8(o2); } }
    }
}

__device__ __forceinline__ void post_q(KParams& p) {
    const int lane = otid() & 63; unsigned char* ws = optr(gp(p.ws)); bf16_t* Q = (bf16_t*)(ws + WS_Q); bf16_t* QL = (bf16_t*)(ws + WS_QL); const float* T64 = (const float*)(ws + WS_TAB64);
    for (int t = gwave(); t < T; t += nwaves()) { const int pos = tok_pos(t); const int hd = lane >> 2, d0 = (lane & 3) * 8;
        bf16_t* base = Q + (long)t * 3072 + hd * 192 + 128 + d0; const float* cs = T64 + ((long)pos * 32 + d0) * 2; float cv[8], sv[8];
#pragma unroll
        for (int j = 0; j < 4; ++j) { const f32x4 q = *reinterpret_cast<const f32x4*>(cs + 4 * j); cv[2 * j] = q[0]; sv[2 * j] = q[1]; cv[2 * j + 1] = q[2]; sv[2 * j + 1] = q[3]; }
        float a[8], bq[8], o1[8], o2[8]; unpack8(*reinterpret_cast<const u32x4*>(base), a); unpack8(*reinterpret_cast<const u32x4*>(base + 32), bq);
#pragma unroll
        for (int j = 0; j < 8; ++j) { o1[j] = a[j] * cv[j] - bq[j] * sv[j]; o2[j] = a[j] * sv[j] + bq[j] * cv[j]; }
        const u32x4 w1 = pack8(o1), w2 = pack8(o2);
        *reinterpret_cast<u32x4*>(base) = w1; *reinterpret_cast<u32x4*>(base + 32) = w2;
        if (t >= TP) { const int ts = t - TP, b = ts >> 6, s = ts & 63; bf16_t* d = QL + ((long)b * 1024 + hd * 64 + s) * QLD + 512 + d0;
            *reinterpret_cast<u32x4*>(d) = w1; *reinterpret_cast<u32x4*>(d + 32) = w2; } }
}

__device__ __forceinline__ void softmax_rows(KParams& p) {
    const int lane = otid() & 63; unsigned char* ws = optr(gp(p.ws)); bf16_t* SP = (bf16_t*)(ws + WS_SP);
    for (int r = gwave(); r < DB * 1024; r += nwaves()) { bf16_t* row = SP + (long)r * KPAD; float v[5][8]; float mx = -3.0e38f;
#pragma unroll
        for (int j = 0; j < 5; ++j) { const int ch = lane + 64 * j;
            if (ch < KALL / 8) { unpack8(*reinterpret_cast<const u32x4*>(row + ch * 8), v[j]);
#pragma unroll
                for (int i = 0; i < 8; ++i) { v[j][i] *= MLA_SCALE; mx = fmaxf(mx, v[j][i]); } }
            else {
#pragma unroll
                for (int i = 0; i < 8; ++i) v[j][i] = -3.0e38f; } }
        mx = wave_max(mx); float sum = 0.f;
#pragma unroll
        for (int j = 0; j < 5; ++j) { const int ch = lane + 64 * j;
#pragma unroll
            for (int i = 0; i < 8; ++i) { v[j][i] = (ch < KALL / 8) ? __expf(v[j][i] - mx) : 0.f; sum += v[j][i]; } }
        sum = wave_sum(sum); const float inv = 1.0f / sum;
#pragma unroll
        for (int j = 0; j < 5; ++j) { const int ch = lane + 64 * j;
            if (ch < KPAD / 8) { float o[8];
#pragma unroll
                for (int i = 0; i < 8; ++i) o[i] = v[j][i] * inv;
                *reinterpret_cast<u32x4*>(row + ch * 8) = pack8(o); } } }
}

__device__ __forceinline__ void gnorm_gate(KParams& p, int w0, int nw) {
    const int lane = otid() & 63; unsigned char* ws = optr(gp(p.ws)); const bf16_t* OB = (const bf16_t*)(ws + WS_OB); const bf16_t* Y = (const bf16_t*)(ws + WS_Y); bf16_t* BG = (bf16_t*)(ws + WS_BG);
    for (int t = w0; t < T; t += nw) { const int c0 = (lane >> 3) * 256 + (lane & 7) * 32; float x[4][8]; float s = 0.f;
#pragma unroll
        for (int i = 0; i < 4; ++i) { unpack8(*reinterpret_cast<const u32x4*>(OB + ((long)lane * T + t) * 32 + 8 * i), x[i]);
#pragma unroll
            for (int j = 0; j < 8; ++j) s += x[i][j]; }
        s += sx<1>(s); s += sx<2>(s); s += sx<4>(s); const float mu = s * (1.0f / 256.f); float q = 0.f;
#pragma unroll
        for (int i = 0; i < 4; ++i)
#pragma unroll
            for (int j = 0; j < 8; ++j) { const float d = x[i][j] - mu; q += d * d; }
        q += sx<1>(q); q += sx<2>(q); q += sx<4>(q); const float rstd = rsqrtf(q * (1.0f / 256.f) + EPS);
#pragma unroll
        for (int i = 0; i < 4; ++i) { float g[8], o[8]; unpack8(*reinterpret_cast<const u32x4*>(Y + (long)t * INWP + C_RG + c0 + 8 * i), g);
#pragma unroll
            for (int j = 0; j < 8; ++j) o[j] = siluf_(g[j]) * (x[i][j] - mu) * rstd;
            *reinterpret_cast<u32x4*>(BG + (long)t * DM + c0 + 8 * i) = pack8(o); } }
}

__device__ __forceinline__ void peer_convert(KParams& p, int l, int r0, int r1, int w0, int nw) {
    unsigned char* ws = optr(gp(p.ws)); const int lane = otid() & 63;
    const float* su = gp(p.peer_u) + (long)l * NEXP * DM; const float* sv = gp(p.peer_v) + (long)l * NEXP * DM;
    for (int r = r0 + w0; r < r1; r += nw) { const bool second = r >= NEXP; const int row = second ? r - NEXP : r; const float* s = (second ? sv : su) + (long)row * DM;
        f32x4 v[8]; float am = 0.f;
#pragma unroll
        for (int j = 0; j < 8; ++j) { v[j] = *reinterpret_cast<const f32x4*>(s + 512 * (j >> 2) * 2 + 16 * lane + 4 * (j & 3));
            am = fmaxf(am, fmaxf(fmaxf(fabsf(v[j][0]), fabsf(v[j][1])), fmaxf(fabsf(v[j][2]), fabsf(v[j][3])))); }
        am = wave_max(am);
        float sc = 1.0f, isc = 1.0f;
        if (am > 0.f) { const int e = (int)((__float_as_uint(am) >> 23) & 0xffu) - 127;
            int k = 7 - e; k = k > 100 ? 100 : (k < -100 ? -100 : k);
            sc = __uint_as_float((unsigned)(127 + k) << 23); isc = __uint_as_float((unsigned)(127 - k) << 23); }
        unsigned w[8];
#pragma unroll
        for (int j = 0; j < 8; ++j) { int pk = __builtin_amdgcn_cvt_pk_fp8_f32(v[j][0] * sc, v[j][1] * sc, 0, false); pk = __builtin_amdgcn_cvt_pk_fp8_f32(v[j][2] * sc, v[j][3] * sc, pk, true); w[j] = (unsigned)pk; }
        if (!second) {
            unsigned char* dst = ws + WS_PU + ((long)(lane >> 3) * NEXP + row) * 128 + 16 * (lane & 7);
            *reinterpret_cast<u32x4*>(dst) = (u32x4){w[0], w[1], w[2], w[3]};
            *reinterpret_cast<u32x4*>(dst + 8L * NEXP * 128) = (u32x4){w[4], w[5], w[6], w[7]};
        } else {
            unsigned char* dst = ws + WS_PV + ((long)(2 * lane) * NEXP + row) * 8;
            *reinterpret_cast<u32x2*>(dst) = (u32x2){w[0], w[1]}; *reinterpret_cast<u32x2*>(dst + (long)NEXP * 8) = (u32x2){w[2], w[3]};
            *reinterpret_cast<u32x2*>(dst + 128L * NEXP * 8) = (u32x2){w[4], w[5]}; *reinterpret_cast<u32x2*>(dst + 129L * NEXP * 8) = (u32x2){w[6], w[7]}; }
        if (lane == 0) ((float*)(ws + (second ? WS_PSV : WS_PSU)))[row] = isc; }
}

__device__ __forceinline__ void final_norm(KParams& p) {
    const int lane = otid() & 63; float* X = gp(p.out);
    for (int t = gwave(); t < T; t += nwaves()) { float* xr = X + (long)t * DM; f32x4 v[8]; float ss = 0.f;
#pragma unroll
        for (int j = 0; j < 8; ++j) { v[j] = *reinterpret_cast<const f32x4*>(xr + 256 * j + 4 * lane); ss += v[j][0] * v[j][0] + v[j][1] * v[j][1] + v[j][2] * v[j][2] + v[j][3] * v[j][3]; }
        ss = wave_sum(ss); const float rinv = rsqrtf(ss * (1.0f / DM) + EPS);
#pragma unroll
        for (int j = 0; j < 8; ++j) { const int c = 256 * j + 4 * lane; const f32x4 gv = *reinterpret_cast<const f32x4*>(gp(p.g_final) + c); *reinterpret_cast<f32x4*>(xr + c) = v[j] * rinv * gv; } }
}
}
__global__ void __launch_bounds__(512, 2) mega_fwd(Params p_by_value_unused) {
    extern __shared__ __attribute__((aligned(16))) unsigned char shm[];
    LAS unsigned char* lds = (LAS unsigned char*)shm; char* ldsg = (char*)shm;
    if (threadIdx.x < 8) ((LAS unsigned*)(lds + LDS_BARW))[threadIdx.x] = 0u;
    __syncthreads();
    if (threadIdx.x == 0) { unsigned* tk = (unsigned*)(gp(KP.ws) + WS_CTL + CTL_RANK) + 64 * xb_xcc_id(); ((volatile LAS unsigned*)(lds + LDS_BARW))[2] = xb_add(tk, 1u); }
    const XcdBarrier bar = xcd_barrier_post((unsigned*)(gp(KP.ws) + WS_CTL), (volatile LAS unsigned*)(lds + LDS_BARW));
#define GRID_SYNC() xcd_barrier(bar)
#ifndef STOP_AT
#define STOP_AT 0
#endif
#ifdef DBG_DUMP
#define STOPCHK(n) do { if (STOP_AT == (n)) { float* xo = gp(KP.out); const bf16_t* src = (const bf16_t*)(gp(KP.ws) + DBG_DUMP); for (long i = ph::gthread(); i < (long)T * DM; i += ph::nthreads()) xo[i] = bf2f(src[i]); return; } } while (0)
#elif defined(DBG_SANITIZE)
#define STOPCHK(n) do { if (STOP_AT == (n) || (STOP_AT > 100 && l == 1 && STOP_AT - 100 == (n))) { float* xo = gp(KP.out); for (long i = ph::gthread(); i < (long)T * DM; i += ph::nthreads()) { const float v = xo[i]; if (!(v - v == 0.0f)) xo[i] = 7.0f; } return; } } while (0)
#else
#define STOPCHK(n) do { if (STOP_AT == (n) || (STOP_AT > 100 && l == 1 && STOP_AT - 100 == (n))) return; } while (0)
#endif
    using namespace pg8;
#define WSP(off) ((bf16_t*)(optr(gp(KP.ws)) + (off)))
#define H WSP(WS_H)
#define Y WSP(WS_Y)
#define CQN WSP(WS_CQN)
#define CKVNP WSP(WS_CKVNP)
#define KRP WSP(WS_KRP)
#define Q WSP(WS_Q)
#define YA WSP(WS_YA)
#define KV WSP(WS_KV)
#define SP WSP(WS_SP)
#define MIX WSP(WS_MIX)
#define OA WSP(WS_OA)
#define QP WSP(WS_QP)
#define CKA WSP(WS_CKA)
#define CKT WSP(WS_CKT)
#define QL WSP(WS_QL)
#define OL WSP(WS_OL)
#define BG WSP(WS_BG)
    int l = 0;
    ph::prologue(KP, ldsg);
#ifdef DUP_PRO
    ph::prologue(KP, ldsg);
#endif
    GRID_SYNC(); STOPCHK(1);
    if (threadIdx.x == 0) { unsigned* barw = (unsigned*)(gp(KP.ws) + WS_CTL); const unsigned me = xb_xcc_id(); unsigned nx = 0, xi = 0, nloc = 1;
        for (unsigned j = 0; j < 16; ++j) { const unsigned cn = xb_ld(&barw[XB_XCNT(j)]); if (cn) { if (j < me) ++xi; ++nx; } if (j == me) nloc = cn ? cn : 1u; }
        volatile LAS unsigned* iw = (volatile LAS unsigned*)(lds + LDS_BARW); iw[3] = xi; iw[4] = nx; iw[5] = nloc; }
    __syncthreads();
    ph::ada_reduce(KP);
    GRID_SYNC(); STOPCHK(2);
    for (l = 0; l < DEPTH; ++l) {
#define WIN (WSP(WS_WIN) + (long)l * INWP * DM)
#define WUQ (WSP(WS_WUQ) + (long)l * 3072 * 512)
#define WUKV (WSP(WS_WUKV) + (long)l * 4096 * 512)
#define WUK (WSP(WS_WUK) + (long)l * 16 * 512 * 256)
#define WA (WSP(WS_WA) + (long)l * DM * DM)
#define WB (WSP(WS_WB) + (long)l * DM * DM)
#define WO (WSP(WS_WO) + (long)l * DM * DM)
#define WPQ (WSP(WS_WPQ) + (long)l * DM * DM)
#define ADA ((const float*)(optr(gp(KP.ws)) + WS_ADA) + (long)l * NCOND * 12288)
        ph::modulate(KP, l, 0);
        ph::cache_convert(KP, l, ldsg, l == 0 ? 0 : 4096, 8192, obid(), ogrid());
        GRID_SYNC(); STOPCHK(3);
        { Sched<0> S; S.init(T / 256, INWP / 256, (T / 256) * (INWP / 256), DM, DM); gemm_phase(lds, Gemm{H, WIN, DM, DM, DM}, S, EpiBf16{Y, INWP, 0}); }
#ifdef DUP_WIN
        { Sched<0> S; S.init(T / 256, INWP / 256, (T / 256) * (INWP / 256), DM, DM); gemm_phase(lds, Gemm{H, WIN, DM, DM, DM}, S, EpiBf16{Y, INWP, 0}); }
#endif
        GRID_SYNC(); STOPCHK(4);
        ph::post_win(KP, l);
        GRID_SYNC(); STOPCHK(5);
        { Sched<0> S; S.init(T / 256, 3072 / 256, (T / 256) * 12, 512, 512); gemm_phase(lds, Gemm{CQN, WUQ, 512, 512, 512}, S, EpiQ{Q, QL, (const float*)(optr(gp(KP.ws)) + WS_TAB64)}); }
        { Sched<0> S; S.init(TP / 256, 4096 / 256, (TP / 256) * 16, 512, 512); gemm_phase(lds, Gemm{CKVNP, WUKV, 512, 512, 512}, S, EpiBf16{KV, 4096, 0}); }
        GRID_SYNC(); STOPCHK(6);
#ifndef DUP_ATTN
#define DUP_ATTN 1
#endif
#ifndef DUP_RET
#define DUP_RET 1
#endif
#ifndef DUP_GATHER
#define DUP_GATHER 0
#endif
#pragma unroll 1
        for (int rep_ = 0; rep_ < DUP_ATTN; ++rep_)
        { for (int u = obid(); u < 512; u += ogrid()) { const int c = u & 255, i = u >> 8, xcd = c & 7, slot = c >> 3; const int bh = xcd * 4 + (slot >> 3) + 32 * i, pr = slot & 7, b = bh >> 4, h = bh & 15;
#pragma unroll 1
              for (int z = 0; z < 2; ++z) { const int qb = z ? 15 - pr : pr; const long tok0 = (long)b * SEQ + 256 * qb;
                  att::attn_block(Q + tok0 * 3072 + h * 192, KV + (long)b * SEQ * 4096 + h * 256, KRP + (long)b * SEQ * 64, KV + (long)b * SEQ * 4096 + h * 256 + 128, OA + tok0 * DM + h * 128, qb, ldsg); } } }
        { Sched<1> S; S.init(0, 0, 256, 3072, 256); gemm_phase(lds, Gemm{Q, WUK, 256, 3072, 256}, S, EpiRowMap<1>{QL, nullptr}); }
        GRID_SYNC(); STOPCHK(8);
        { Sched<2> S; S.init(0, 0, DB * 36, QLD, QLD); gemm_phase(lds, Gemm{QL, CKA, QLD, QLD, QLD}, S, EpiExp{SP, (float*)(optr(gp(KP.ws)) + WS_CTL + CTL_RSUM) + (long)l * 32768}); }
        GRID_SYNC(); STOPCHK(9);
        { Sched<3> S; S.init(0, 0, 256, KPAD, KPAD); gemm_phase(lds, Gemm{SP, CKT, 2176, KPAD, KPAD}, S, EpiRowMap<3>{OL, (const float*)(optr(gp(KP.ws)) + WS_CTL + CTL_RSUM) + (long)l * 32768}); }
        GRID_SYNC(); STOPCHK(11);
        { Sched<4> S; S.init(0, 0, 128, 512, 512); gemm_phase(lds, Gemm{OL, WUKV, 512, 512, 512}, S, EpiOV{OA}); }
#pragma unroll 1
        for (int rep_ = 0; rep_ < DUP_RET; ++rep_)
        for (int u = obid(); u < 256 + DB * 64; u += ogrid()) ret::unit(KP, l, u, ldsg);
#ifdef DUP_RETP
        for (int u = obid(); u < 256; u += ogrid()) ret::unit(KP, l, u, ldsg);
#endif
        GRID_SYNC(); STOPCHK(12);
        { Sched<0> S; S.init(T / 256, DM / 256, (T / 256) * 8, DM, DM); gemm_phase(lds, Gemm{OA, WA, DM, DM, DM}, S, EpiBf16{YA, DM, 0}); }
        { const int G_ = ogrid(), rem_ = ((T / 256) * 8) % G_; const int b_ = obid();
          if (rem_ == 0) ph::gnorm_gate(KP, ph::gwave(), ph::nwaves());
          else if (b_ >= rem_) ph::gnorm_gate(KP, (b_ - rem_) * 8 + (otid() >> 6), (G_ - rem_) * 8); }
#ifdef DUP_WA
        { Sched<0> S; S.init(T / 256, DM / 256, (T / 256) * 8, DM, DM); gemm_phase(lds, Gemm{OA, WA, DM, DM, DM}, S, EpiBf16{YA, DM, 0}); }
#endif
        GRID_SYNC(); STOPCHK(14);
        { Sched<0> S; S.init(T / 256, DM / 256, (T / 256) * 8, DM, DM); gemm_phase(lds, Gemm{BG, WB, DM, DM, DM}, S, EpiMix{Y, YA, MIX}); }
        { const int G_ = ogrid(), rem_ = ((T / 256) * 8) % G_; const int b_ = obid();
          if (rem_ == 0) ph::peer_convert(KP, l, 0, NEXP, ph::gwave(), ph::nwaves());
          else if (b_ >= rem_) ph::peer_convert(KP, l, 0, NEXP, (b_ - rem_) * 8 + (otid() >> 6), (G_ - rem_) * 8); }
        GRID_SYNC(); STOPCHK(15);
        { Sched<0> S; S.init(T / 256, DM / 256, (T / 256) * 8, DM, DM); gemm_phase(lds, Gemm{MIX, WO, DM, DM, DM}, S, EpiRes{gp(KP.out), ADA + 2 * DM, l == 0 ? gp(KP.x_prompt) : gp(KP.out), l == 0 ? gp(KP.x_sample) : gp(KP.out) + (long)TP * DM}); }
        { const int G_ = ogrid(), rem_ = ((T / 256) * 8) % G_; const int b_ = obid();
          if (rem_ == 0) ph::peer_convert(KP, l, NEXP, 2 * NEXP, ph::gwave(), ph::nwaves());
          else if (b_ >= rem_) ph::peer_convert(KP, l, NEXP, 2 * NEXP, (b_ - rem_) * 8 + (otid() >> 6), (G_ - rem_) * 8); }
        GRID_SYNC(); STOPCHK(16);
        ph::modulate(KP, l, 1);
        GRID_SYNC(); STOPCHK(17);
        { Sched<0> S; S.init(T / 256, DM / 256, (T / 256) * 8, DM, DM); gemm_phase(lds, Gemm{H, WPQ, DM, DM, DM}, S, EpiBf16{QP, DM, 0}); }
        if (l + 1 < DEPTH) { const int G_ = ogrid(), rem_ = ((T / 256) * 8) % G_; const int b_ = obid();
          if (rem_ == 0) ph::cache_convert(KP, l + 1, ldsg, 0, 4096, b_, G_);
          else if (b_ >= rem_) ph::cache_convert(KP, l + 1, ldsg, 0, 4096, b_ - rem_, G_ - rem_); }
        GRID_SYNC(); STOPCHK(18);
        { const int tid_ = otid(); const int lane = tid_ & 63; float* strip = (float*)ldsg + tid_ * 33; unsigned char* ws = optr(gp(KP.ws));
          const bf16_t* k1g = (const bf16_t*)(ws + WS_PK1) + (long)l * 128 * 128; const bf16_t* k2g = (const bf16_t*)(ws + WS_PK2) + (long)l * 128 * 128;
          bf16_t* k1 = (bf16_t*)(ldsg + 512 * 33 * 4 + 64); bf16_t* k2 = k1 + 128 * peer::KPITCH;
          for (int i = tid_; i < 2 * 128 * 16; i += 512) { const int which = i >> 11, r = (i >> 4) & 127, ch = i & 15;
              *reinterpret_cast<u32x4*>((which ? k2 : k1) + r * peer::KPITCH + ch * 8) = *reinterpret_cast<const u32x4*>((which ? k2g : k1g) + r * 128 + ch * 8); }
          __syncthreads();
          for (int wu = ph::gwave(); wu < (T / 32) * PH; wu += ph::nwaves()) peer::select_unit(QP, k1, k2, (int*)(ws + WS_PIDX), (float*)(ws + WS_PW), (wu >> 3) * 32, wu & 7, lane, strip);
#ifdef DUP_SEL
          for (int wu = ph::gwave(); wu < (T / 32) * PH; wu += ph::nwaves()) peer::select_unit(QP, k1, k2, (int*)(ws + WS_PIDX), (float*)(ws + WS_PW), (wu >> 3) * 32, wu & 7, lane, strip);
#endif
        }
        GRID_SYNC(); STOPCHK(19);
        { const int tid_ = otid(); const int lane = tid_ & 63, wid = tid_ >> 6; unsigned char* ws = optr(gp(KP.ws));
          volatile LAS unsigned* iw = (volatile LAS unsigned*)(lds + LDS_BARW); peer::XInfo xin; xin.rank = __builtin_amdgcn_readfirstlane((int)iw[2]); xin.xi = __builtin_amdgcn_readfirstlane((int)iw[3]); xin.nx = __builtin_amdgcn_readfirstlane((int)iw[4]); xin.nloc = __builtin_amdgcn_readfirstlane((int)iw[5]);
          if (xin.nx >= 1 && xin.nx <= 8) {
              peer::upass(H, (const unsigned char*)(ws + WS_PU), (const int*)(ws + WS_PIDX), (const float*)(ws + WS_PW), (const float*)(ws + WS_PSU), (const float*)(ws + WS_PSV), (float*)(ws + WS_DOTP), (unsigned*)(ws + WS_ACT), xin, wid, lane);
              GRID_SYNC();
              int vs0_, vsn_, vse_;
              if ((256 % xin.nx) == 0) { const int spx = 256 / xin.nx; vs0_ = xin.xi * spx + xin.rank; vsn_ = xin.nloc; vse_ = (xin.xi + 1) * spx; }
              else { vs0_ = obid(); vsn_ = ogrid(); vse_ = 256; }
              peer::vpass_lds((const unsigned char*)(ws + WS_PV), (const unsigned*)(ws + WS_ACT), gp(KP.out), ADA + 5 * DM, ldsg, vs0_, vsn_, vse_, tid_);
#ifdef DUP_VP
              peer::vpass_lds((const unsigned char*)(ws + WS_PV), (const unsigned*)(ws + WS_ACT), (float*)(ws + WS_OB), ADA + 5 * DM, ldsg, vs0_, vsn_, vse_, tid_);
#endif
          } else {
              for (int t = ph::gwave(); t < T; t += ph::nwaves()) peer::gather_token(H, (const unsigned char*)(ws + WS_PU), (const unsigned char*)(ws + WS_PV), (const float*)(ws + WS_PSU), (const float*)(ws + WS_PSV), (const int*)(ws + WS_PIDX), (const float*)(ws + WS_PW), gp(KP.out), ADA + 5 * DM, t, lane);
          } }
        GRID_SYNC(); STOPCHK(20);
    }
    ph::final_norm(KP);
}

extern "C" void kernel_launch(void* const* d_in, const int* in_sizes, int n_in, void* d_out, int out_size, void* d_ws, size_t ws_size, hipStream_t stream) {
    static int grid = 0;
    if (grid == 0) {
        if (n_in != 25 || out_size != (int)O_END || ws_size < WS_END) { fprintf(stderr, "kernel_launch: shape mismatch: n_in %d out %d (want %ld) ws %zu (want >= %zu)\n", n_in, out_size, O_END, ws_size, (size_t)WS_END); grid = -1; return; }
        int dev = 0, cus = 0, per_cu = 0;
        if (hipGetDevice(&dev) != hipSuccess || hipDeviceGetAttribute(&cus, hipDeviceAttributeMultiprocessorCount, dev) != hipSuccess) { fprintf(stderr, "kernel_launch: device query failed\n"); grid = -1; return; }
        if (hipFuncSetAttribute((const void*)mega_fwd, hipFuncAttributeMaxDynamicSharedMemorySize, LDS_BYTES) != hipSuccess) { fprintf(stderr, "kernel_launch: hipFuncSetAttribute failed\n"); grid = -1; return; }
        if (hipOccupancyMaxActiveBlocksPerMultiprocessor(&per_cu, (const void*)mega_fwd, 512, LDS_BYTES) != hipSuccess || per_cu < 1) { fprintf(stderr, "kernel_launch: occupancy query says %d blocks per CU\n", per_cu); grid = -1; return; }
        grid = cus;
#ifdef FORCE_GRID
        grid = FORCE_GRID;
#endif
    }
    if (grid < 0) return;
    (void)hipMemsetAsync((char*)d_ws + WS_CTL, 0, CTL_BYTES, stream);
    Params p{};
    const float* const* in = (const float* const*)d_in;
    p.x_prompt = in[0]; p.x_sample = in[1]; p.c_prompt = in[2]; p.c_sample = in[3]; p.cache_ckv = in[4]; p.cache_krope = in[5]; p.state_ret = in[6]; p.w_ada = in[7]; p.b_ada = in[8];
    p.g_mix = in[9]; p.g_ffn = in[10]; p.w_in = in[11]; p.g_q = in[12]; p.w_uq = in[13]; p.g_kv = in[14]; p.w_ukv = in[15]; p.w_a = in[16]; p.w_b = in[17]; p.w_o = in[18]; p.w_pq = in[19];
    p.peer_k1 = in[20]; p.peer_k2 = in[21]; p.peer_u = in[22]; p.peer_v = in[23]; p.g_final = in[24];
    p.out = (float*)d_out; p.ws = (unsigned char*)d_ws;
    for (int h = 0; h < 8; ++h) p.lg[h] = (float)log1p(-pow(2.0, -5.0 - (double)h));
    p.grid = grid; p.pad_ = 0;
    hipLaunchKernelGGL(mega_fwd, dim3(grid), dim3(512), LDS_BYTES, stream, p);
    const hipError_t le = hipGetLastError();
    if (le != hipSuccess) fprintf(stderr, "kernel_launch: launch failed: %s\n", hipGetErrorName(le));
}
```

```cpp
#include <hip/hip_runtime.h>
#include <cstdio>
#include <cstdint>
#include <cmath>

#define LAS __attribute__((address_space(3)))
typedef unsigned short bf16_t;
typedef short bf16x8 __attribute__((ext_vector_type(8)));
typedef float f32x4 __attribute__((ext_vector_type(4)));
typedef float f32x2 __attribute__((ext_vector_type(2)));
typedef float f32x16 __attribute__((ext_vector_type(16)));
typedef unsigned u32x4 __attribute__((ext_vector_type(4)));
typedef unsigned u32x2 __attribute__((ext_vector_type(2)));
typedef short s16x4 __attribute__((ext_vector_type(4)));
typedef int i32x4 __attribute__((ext_vector_type(4)));

constexpr int DM = 2048, NB = 4, SEQ = 4096, DEPTH = 2, DB = 32, DS = 64, PAST = 2048;
constexpr int TP = NB * SEQ, TS = DB * DS, T = TP + TS;
constexpr int NCOND = NB + DB;
constexpr int QLORA = 512, KVLORA = 512, ROPE = 64, NOPE = 128, VD = 128, MH = 16, QKD = 192;
constexpr int RH = 8, RQK = 128, RV = 256;
constexpr int PH = 8, NKEYS = 128, NEXP = 16384, PTOPK = 16;
constexpr int INW = 11328, INWP = 11520;
constexpr int C_CQ = 0, C_CKV = 512, C_KR = 1024, C_RQ = 1088, C_RK = 2112, C_RV = 3136, C_RG = 5184, C_GA = 7232, C_GB = 9280;
constexpr int KALL = PAST + DS;
constexpr int KPAD = 2304;
constexpr int QLD = 640;
constexpr float EPS = 1e-6f;
constexpr float MLA_SCALE = 0.07216878364870322f;

constexpr long O_Y = 0;
constexpr long O_CKVP = (long)T * DM;
constexpr long O_KRP = O_CKVP + 2L * TP * 512;
constexpr long O_RETP = O_KRP + 2L * TP * 64;
constexpr long O_CKVS = O_RETP + 2L * NB * RH * RQK * RV;
constexpr long O_KRS = O_CKVS + 2L * TS * 512;
constexpr long O_RETS = O_KRS + 2L * TS * 64;
constexpr long O_END = O_RETS + 2L * DB * RH * RQK * RV;

constexpr size_t al256(size_t x) { return (x + 255) / 256 * 256; }
constexpr size_t WS_CTL = 0;
constexpr size_t CTL_BYTES = 65536 + 2UL * 32768 * 4;
constexpr size_t CTL_RSUM = 65536;
constexpr size_t WS_TAB64 = WS_CTL + CTL_BYTES;
constexpr size_t WS_TAB128 = WS_TAB64 + 4096UL * 32 * 2 * 4;
constexpr size_t WS_ADA = WS_TAB128 + 4096UL * 64 * 2 * 4;
constexpr size_t WS_ADAP = WS_ADA + 2UL * NCOND * 12288 * 4;
constexpr size_t WS_WIN = WS_ADAP + 8UL * 2 * NCOND * 12288 * 4;
constexpr size_t WS_WUQ = WS_WIN + 2UL * INWP * DM * 2;
constexpr size_t WS_WUKV = WS_WUQ + 2UL * 3072 * 512 * 2;
constexpr size_t WS_WUK = WS_WUKV + 2UL * 4096 * 512 * 2;
constexpr size_t WS_WA = WS_WUK + 2UL * 16 * 512 * 256 * 2;
constexpr size_t WS_WB = WS_WA + 2UL * DM * DM * 2;
constexpr size_t WS_WO = WS_WB + 2UL * DM * DM * 2;
constexpr size_t WS_WPQ = WS_WO + 2UL * DM * DM * 2;
constexpr size_t WS_PK1 = WS_WPQ + 2UL * DM * DM * 2;
constexpr size_t WS_PK2 = WS_PK1 + 2UL * 128 * 128 * 2;
constexpr size_t WS_H = WS_PK2 + 2UL * 128 * 128 * 2;
constexpr size_t WS_Y = WS_H + (size_t)T * DM * 2;
constexpr size_t WS_CQN = WS_Y + (size_t)T * INWP * 2;
constexpr size_t WS_CKVNP = WS_CQN + (size_t)T * 512 * 2;
constexpr size_t WS_KRP = WS_CKVNP + (size_t)TP * 512 * 2;
constexpr size_t WS_Q = WS_KRP + (size_t)TP * 64 * 2;
constexpr size_t WS_YA = WS_Q;
constexpr size_t WS_KV = WS_Q + (size_t)T * 3072 * 2 + 4096;
constexpr size_t WS_SP = WS_KV;
constexpr size_t WS_MIX = WS_KV;
constexpr size_t WS_OA = WS_KV + 32UL * 1024 * KPAD * 2;
constexpr size_t WS_QP = WS_OA;
constexpr size_t WS_CKA = WS_OA + (size_t)T * DM * 2;
constexpr size_t WS_CKT = WS_CKA + 32UL * KPAD * QLD * 2;
constexpr size_t WS_QL = WS_CKT + 32UL * 512 * KPAD * 2;
constexpr size_t WS_OL = WS_QL + 32UL * 1024 * QLD * 2;
constexpr size_t WS_OB = WS_OL + 16UL * 2048 * 512 * 2;
constexpr size_t WS_BG = WS_OB + (size_t)T * DM * 2;
constexpr size_t WS_PIDX = WS_BG + (size_t)T * DM * 2;
constexpr size_t WS_PW = WS_PIDX + (size_t)T * 128 * 4;
constexpr size_t WS_PU = WS_PW + (size_t)T * 128 * 4;
constexpr size_t WS_PV = WS_PU + (size_t)NEXP * DM;
constexpr size_t WS_PSU = WS_PV + (size_t)NEXP * DM;
constexpr size_t WS_PSV = WS_PSU + (size_t)NEXP * 4;
constexpr size_t WS_WPQ8 = WS_PSV + (size_t)NEXP * 4;
constexpr size_t WS_SB8 = WS_WPQ8 + 2UL * DM * DM;
constexpr size_t WS_SA8 = WS_SB8 + 2UL * DM * 4;
constexpr size_t WS_END = WS_SA8 + al256((size_t)T * 4);
constexpr size_t WS_H8 = WS_OB;
static_assert((size_t)TP * 4096 * 2 <= 32UL * 1024 * KPAD * 2, "KV fits in the SP region");
static_assert(WS_END <= 1590000000UL, "workspace map too large");
static_assert(WS_WIN % 256 == 0 && WS_H % 256 == 0 && WS_Y % 256 == 0 && WS_Q % 256 == 0 && WS_KV % 256 == 0 && WS_CKA % 256 == 0, "alignment");

constexpr int LDS_BYTES = 147456;
constexpr int LDS_BARW = LDS_BYTES - 32;
constexpr size_t CTL_RANK = 16384;
constexpr size_t WS_DOTP = WS_Q;
constexpr size_t WS_ACT = WS_DOTP + 8UL * T * 128 * 4;
constexpr size_t WS_PIDXT = WS_ACT + (size_t)T * 128 * 4;
static_assert(WS_PIDXT + (size_t)T * 128 * 4 <= WS_KV, "PEER scratch fits in the Q region");

struct Params {
    const float *x_prompt, *x_sample, *c_prompt, *c_sample, *cache_ckv, *cache_krope, *state_ret, *w_ada, *b_ada, *g_mix, *g_ffn, *w_in, *g_q, *w_uq, *g_kv, *w_ukv,
                *w_a, *w_b, *w_o, *w_pq, *peer_k1, *peer_k2, *peer_u, *peer_v, *g_final;
    float* out; unsigned char* ws;
    float lg[8];
    int grid; int pad_;
};

typedef const __attribute__((address_space(4))) Params KParams;
__device__ __forceinline__ KParams* okarg() {
    const uintptr_t k = (uintptr_t)__builtin_amdgcn_kernarg_segment_ptr();
    unsigned lo = (unsigned)k, hi = (unsigned)(k >> 32);
    asm volatile("" : "+s"(lo), "+s"(hi)); return (KParams*)(((uintptr_t)hi << 32) | lo); }
#define KP (*okarg())
__device__ __forceinline__ int ogrid() { return KP.grid; }
__device__ __forceinline__ int obid() { int b = (int)blockIdx.x; asm volatile("" : "+s"(b) :: "memory"); return b; }
__device__ __forceinline__ int otid() { int t = (int)threadIdx.x; asm volatile("" : "+v"(t) :: "memory"); return t; }
template <class P> __device__ __forceinline__ P* gp(P* p) { return (P*)(__attribute__((address_space(1))) P*)(uintptr_t)p; }
template <class P> __device__ __forceinline__ P* optr(P* p) {
    unsigned lo = __builtin_amdgcn_readfirstlane((unsigned)(uintptr_t)p), hi = __builtin_amdgcn_readfirstlane((unsigned)((uintptr_t)p >> 32));
    asm volatile("" : "+s"(lo), "+s"(hi)); return gp((P*)(((uintptr_t)hi << 32) | lo)); }
typedef __bf16 bf16v2_t __attribute__((ext_vector_type(2)));
__device__ __forceinline__ unsigned cvt_pk_bf16(float lo, float hi) { f32x2 v = {lo, hi}; bf16v2_t r = __builtin_convertvector(v, bf16v2_t); return __builtin_bit_cast(unsigned, r); }
__device__ __forceinline__ bf16_t f2bf(float f) { return (bf16_t)(cvt_pk_bf16(f, 0.f) & 0xffffu); }
__device__ __forceinline__ float bf2f(bf16_t b) { return __uint_as_float(((unsigned)b) << 16); }
__device__ __forceinline__ float bflo(unsigned w) { return __uint_as_float(w << 16); }
__device__ __forceinline__ float bfhi(unsigned w) { return __uint_as_float(w & 0xffff0000u); }
__device__ __forceinline__ void unpack8(const u32x4 w, float (&f)[8]) { f[0] = bflo(w.x); f[1] = bfhi(w.x); f[2] = bflo(w.y); f[3] = bfhi(w.y); f[4] = bflo(w.z); f[5] = bfhi(w.z); f[6] = bflo(w.w); f[7] = bfhi(w.w); }
__device__ __forceinline__ u32x4 pack8(const float (&f)[8]) { u32x4 w; w.x = cvt_pk_bf16(f[0], f[1]); w.y = cvt_pk_bf16(f[2], f[3]); w.z = cvt_pk_bf16(f[4], f[5]); w.w = cvt_pk_bf16(f[6], f[7]); return w; }
template <int K> __device__ __forceinline__ float sx(float v) {
    if constexpr (K == 32) { const auto rr = __builtin_amdgcn_permlane32_swap(__float_as_uint(v), __float_as_uint(v), false, false); return __uint_as_float((otid() & 32) ? rr[0] : rr[1]); }
    else return __int_as_float(__builtin_amdgcn_ds_swizzle(__float_as_int(v), (K << 10) | 0x1F));
}
__device__ __forceinline__ float wave_sum(float v) { v += sx<32>(v); v += sx<16>(v); v += sx<8>(v); v += sx<4>(v); v += sx<2>(v); v += sx<1>(v); return v; }
__device__ __forceinline__ float wave_max(float v) { v = fmaxf(v, sx<32>(v)); v = fmaxf(v, sx<16>(v)); v = fmaxf(v, sx<8>(v)); v = fmaxf(v, sx<4>(v)); v = fmaxf(v, sx<2>(v)); v = fmaxf(v, sx<1>(v)); return v; }
__device__ __forceinline__ float sigmoidf_(float x) { return 1.0f / (1.0f + __expf(-x)); }
__device__ __forceinline__ float siluf_(float x) { return x / (1.0f + __expf(-x)); }
__device__ __forceinline__ int cond_row(int t) { return t < TP ? (t >> 12) : NB + ((t - TP) >> 6); }
__device__ __forceinline__ int tok_pos(int t) { return t < TP ? (t & 4095) : PAST + ((t - TP) & 63); }

#define XB_TMO      128
#define XB_XCNT(j)  (256  + 64 * (j))
#define XB_XSUB(j)  (1280 + 64 * (j))
#define XB_XGEN(j)  (2304 + 64 * (j))
#define XB_TOP      3328
#define XB_TOPGEN   3392
#define XCD_BAR_WORDS 3456
#define XB_SPIN_CAP (1u << 22)
__device__ __forceinline__ unsigned xb_ld(unsigned* p)              { return __hip_atomic_load(p, __ATOMIC_RELAXED, __HIP_MEMORY_SCOPE_AGENT); }
__device__ __forceinline__ unsigned xb_add(unsigned* p, unsigned v) { return __hip_atomic_fetch_add(p, v, __ATOMIC_RELAXED, __HIP_MEMORY_SCOPE_AGENT); }
__device__ __forceinline__ unsigned xb_xcc_id() { return (unsigned)__builtin_amdgcn_s_getreg((3 << 11) | 20) & 0xFu; }
#define XB_SPIN(cond, bar) do { unsigned _sp = 0; while (cond) { __builtin_amdgcn_s_sleep(1); \
    if ((++_sp & 255u) == 0u) { if (xb_ld(&(bar)[XB_TMO])) break; if (_sp > XB_SPIN_CAP) { atomicAdd(&(bar)[XB_TMO], 1u); break; } } } } while (0)
struct XcdBarrier { unsigned* bar; unsigned x; volatile LAS unsigned* st; };
__device__ __forceinline__ XcdBarrier xcd_barrier_post(unsigned* bar, volatile LAS unsigned* st) {
    XcdBarrier b; b.bar = bar; b.x = xb_xcc_id(); b.st = st;
    if (threadIdx.x == 0) (void)xb_add(&bar[XB_XCNT(b.x)], 1u);
    return b;
}
__device__ __forceinline__ void xcd_barrier_complete(unsigned* bar, unsigned x, unsigned& nloc, unsigned& nx) {
    const unsigned G = (unsigned)KP.grid;
    unsigned sum, cnt, mine, sp = 0u;
    for (;;) {
        sum = 0u; cnt = 0u; mine = 0u;
#pragma unroll
        for (unsigned j = 0; j < 16; ++j) { const unsigned c = xb_ld(&bar[XB_XCNT(j)]); sum += c; cnt += (c > 0u) ? 1u : 0u; mine = (j == x) ? c : mine; }
        if (sum == G) break;
        __builtin_amdgcn_s_sleep(1);
        if ((++sp & 255u) == 0u) { if (xb_ld(&bar[XB_TMO])) break; if (sp > XB_SPIN_CAP) { atomicAdd(&bar[XB_TMO], 1u); break; } }
    }
    nloc = mine > 0u ? mine : 1u; nx = cnt > 0u ? cnt : 1u;
}
__device__ __forceinline__ void xcd_barrier(const XcdBarrier& b) {
    asm volatile("s_waitcnt vmcnt(0)" ::: "memory");
    __syncthreads();
    if (otid() == 0) {
        unsigned* bar = (unsigned*)(gp(KP.ws) + WS_CTL);
        unsigned bx = xb_xcc_id(); asm volatile("" : "+s"(bx));
        __builtin_amdgcn_s_waitcnt(0);
        unsigned nloc = b.st[0], nx = b.st[1];
        if (nloc == 0u) { xcd_barrier_complete(bar, bx, nloc, nx); b.st[0] = nloc; b.st[1] = nx; }
        const unsigned old = xb_add(&bar[XB_XSUB(bx)], 1u);
        const unsigned gen = old / nloc;
        if (old + 1u == (gen + 1u) * nloc) {
            __builtin_amdgcn_fence(__ATOMIC_RELEASE, "agent");
            asm volatile("s_waitcnt vmcnt(0)" ::: "memory");
            const unsigned og = xb_add(&bar[XB_TOP], 1u);
            const unsigned tg = og / nx;
            if (og + 1u == (tg + 1u) * nx) xb_add(&bar[XB_TOPGEN], 1u);
            else XB_SPIN(xb_ld(&bar[XB_TOPGEN]) == tg, bar);
            __builtin_amdgcn_fence(__ATOMIC_ACQUIRE, "agent");
            xb_add(&bar[XB_XGEN(bx)], 1u);
            asm volatile("s_waitcnt vmcnt(0)" ::: "memory");
        } else {
            XB_SPIN(xb_ld(&bar[XB_XGEN(bx)]) == gen, bar);
            __builtin_amdgcn_fence(__ATOMIC_ACQUIRE, "agent");
            asm volatile("s_waitcnt vmcnt(0)" ::: "memory");
        }
    }
    __syncthreads();
}
namespace pg8 {
constexpr int BM = 256, BK = 64, HALF = 128, HTB = HALF * BK * 2, STAGE_BYTES = 8 * HTB, NXCD = 8, WGM = 8;
__host__ __device__ __forceinline__ int lds_byte(int r, int c) { const int st = (r >> 4) * 2 + (c >> 5), rr = r & 15, cc = c & 31, ob = rr * 64 + cc * 2; return st * 1024 + (ob ^ (((ob >> 9) & 1) << 5)); }
__host__ __device__ __forceinline__ void stage_rc(int b, int& R, int& C) { const int st = b / 1024, sb = b % 1024, swz = sb ^ (((sb >> 9) & 1) << 5); R = (st >> 1) * 16 + swz / 64; C = (st & 1) * 32 + (swz % 64) / 2; }
__host__ __device__ __forceinline__ int perm32(int rho) { const int n = rho >> 4, i = rho & 15; return 8 * (i >> 2) + 4 * n + (i & 3); }

struct Unit { int pm, pn; long aoff, boff; int x0, x1; };
struct Gemm { const bf16_t* A; const bf16_t* Bt; int K; int lda, ldb; };

template <int MODE> struct Sched {
    int nM, nN, nwg, G, c; long lda, ldb;
    __device__ void init(int nM_, int nN_, int nwg_, long lda_, long ldb_) { nM = nM_; nN = nN_; nwg = nwg_; G = ogrid(); c = obid(); lda = lda_; ldb = ldb_; }
    __device__ bool next(int i, Unit& u) const {
        const long L = (long)i * G + c; if (L >= nwg) return false;
        int wgid = (int)L;
        if (MODE == 0) {
            { const int q = nwg / NXCD, r = nwg % NXCD, xcd = wgid % NXCD, off = wgid / NXCD; wgid = (xcd < r ? xcd * (q + 1) : r * (q + 1) + (xcd - r) * q) + off; }
            const int nig = WGM * nN, gid = wgid / nig, fm = gid * WGM, gsz = (nM - fm) < WGM ? (nM - fm) : WGM;
            u.pm = fm + ((wgid % nig) % gsz); u.pn = (wgid % nig) / gsz; u.x0 = 0; u.x1 = 0;
            u.aoff = (long)u.pm * 256 * lda * 2; u.boff = (long)u.pn * 256 * ldb * 2;
        } else if (MODE == 1) {
            const int h = wgid >> 4, rem = wgid & 15, rt = rem >> 1, pn = rem & 1;
            u.pm = rt; u.pn = pn; u.x0 = h; u.x1 = rt;
            u.aoff = ((long)(TP + 256 * rt) * 3072 + h * 192) * 2; u.boff = ((long)(h * 512 + 256 * pn) * 256) * 2;
        } else if (MODE == 2) {
            const int b = wgid / 36, rem = wgid % 36, pm = rem / 9, pn = rem % 9;
            u.pm = pm; u.pn = pn; u.x0 = b; u.x1 = 0;
            u.aoff = ((long)(b * 1024 + 256 * pm) * QLD) * 2; u.boff = ((long)(b * KPAD + 256 * pn) * QLD) * 2;
        } else if (MODE == 3) {
            const int b = wgid >> 3, pm = (wgid & 7) >> 1, pn = wgid & 1;
            u.pm = pm; u.pn = pn; u.x0 = b; u.x1 = 0;
            u.aoff = ((long)(b * 1024 + 256 * pm) * KPAD) * 2; u.boff = ((long)(b * 512 + 256 * pn) * KPAD) * 2;
        } else {
            const int h = wgid >> 3, rt = wgid & 7;
            u.pm = rt; u.pn = 0; u.x0 = h; u.x1 = rt;
            u.aoff = ((long)(h * 2048 + 256 * rt) * 512) * 2; u.boff = ((long)(h * 256) * 512) * 2;
        }
        return true;
    }
};

template <class Epi, class SchedT, bool I8 = false>
__device__ __forceinline__ void gemm_phase(LAS unsigned char* lds, const Gemm g, const SchedT& S, const Epi& E) {
    const int tid = otid(), wid = __builtin_amdgcn_readfirstlane(tid >> 6), lane = tid & 63, wr = wid >> 2, wc = wid & 3, fr = lane & 15, fq = lane >> 4;
    const int K = g.K, nt = K / BK;
    unsigned voffA[2], voffB[2];
#pragma unroll
    for (int i = 0; i < 2; ++i) { int R, C; stage_rc(tid * 16 + i * 8192, R, C); const int Rb = Epi::PERM ? ((R & ~31) + perm32(R & 31)) : R;
        voffA[i] = (unsigned)(R * g.lda + C) * 2u; voffB[i] = (unsigned)(Rb * g.ldb + C) * 2u; }
    const size_t kstep = (size_t)(BK * 2);
    const size_t hstepA = (size_t)HALF * g.lda * 2, hstepB = (size_t)HALF * g.ldb * 2;
    const unsigned ldsw = (unsigned)wid * 1024u;
    const int aoff = lds_byte(wr * 64 + fr, fq * 8), boff = lds_byte(wc * 32 + fr, fq * 8);
#define PG8_SA(b, h) (((b) * 2 + (h)) * HTB)
#define PG8_SB(b, h) ((4 + (b) * 2 + (h)) * HTB)
#define PG8_STAGE(bufoff, gbase, voff) do { _Pragma("unroll") for (int _i = 0; _i < 2; ++_i) \
        __builtin_amdgcn_global_load_lds((const unsigned*)((const char*)(gbase) + (voff)[_i]), (LAS unsigned*)(lds + (bufoff) + ldsw + _i * 8192), 16, 0, 0); } while (0)
#define PG8_LDA(dst, b, h) do { _Pragma("unroll") for (int m = 0; m < 4; ++m) _Pragma("unroll") for (int k = 0; k < 2; ++k) dst[m][k] = *(const LAS bf16x8*)(lds + PG8_SA(b, h) + aoff + m * 2048 + k * 1024); } while (0)
#define PG8_LDB(dst, b, h) do { _Pragma("unroll") for (int n = 0; n < 2; ++n) _Pragma("unroll") for (int k = 0; k < 2; ++k) dst[n][k] = *(const LAS bf16x8*)(lds + PG8_SB(b, h) + boff + n * 2048 + k * 1024); } while (0)
#define PG8_MMA(ai, bj, At, Bt) do { __builtin_amdgcn_s_setprio(1); _Pragma("unroll") for (int m = 0; m < 4; ++m) _Pragma("unroll") for (int n = 0; n < 2; ++n) _Pragma("unroll") for (int k = 0; k < 2; ++k) \
        { if constexpr (I8) acc[ai][bj][m][n] = __builtin_bit_cast(f32x4, __builtin_amdgcn_mfma_i32_16x16x64_i8(__builtin_bit_cast(i32x4, Bt[n][k]), __builtin_bit_cast(i32x4, At[m][k]), __builtin_bit_cast(i32x4, acc[ai][bj][m][n]), 0, 0, 0)); \
          else acc[ai][bj][m][n] = __builtin_amdgcn_mfma_f32_16x16x32_bf16(Bt[n][k], At[m][k], acc[ai][bj][m][n], 0, 0, 0); } __builtin_amdgcn_s_setprio(0); } while (0)
#define PG8_WAIT_V(n) asm volatile("s_waitcnt vmcnt(" #n ")" ::: "memory")
#define PG8_WAIT_L(n) asm volatile("s_waitcnt lgkmcnt(" #n ")" ::: "memory")
#define PG8_BAR __builtin_amdgcn_s_barrier()
#define PG8_SCHED __builtin_amdgcn_sched_barrier(0)
    Unit cur, nxt; int ui = 0;
    if (!S.next(0, cur)) return;
    f32x4 acc[2][2][4][2];
#pragma unroll
    for (int a = 0; a < 2; ++a)
#pragma unroll
        for (int b = 0; b < 2; ++b)
#pragma unroll
            for (int m = 0; m < 4; ++m)
#pragma unroll
                for (int n = 0; n < 2; ++n) acc[a][b][m][n] = (f32x4){0.f, 0.f, 0.f, 0.f};
    bf16x8 At[4][2], B0[2][2], B1[2][2];
    const char* cA = (const char*)g.A + cur.aoff; const char* cB = (const char*)g.Bt + cur.boff;
    PG8_STAGE(PG8_SB(0, 0), cB, voffB); PG8_STAGE(PG8_SA(0, 0), cA, voffA); PG8_STAGE(PG8_SB(0, 1), cB + hstepB, voffB); PG8_STAGE(PG8_SA(0, 1), cA + hstepA, voffA);
    if (wr == 1) PG8_BAR;
    PG8_WAIT_V(4); PG8_BAR;
    PG8_STAGE(PG8_SB(1, 0), cB + kstep, voffB); PG8_STAGE(PG8_SA(1, 0), cA + kstep, voffA); PG8_STAGE(PG8_SB(1, 1), cB + hstepB + kstep, voffB);
    PG8_WAIT_V(6); PG8_BAR;
    for (;;) {
        const bool has_next = S.next(ui + 1, nxt);
        const char* nA = has_next ? (const char*)g.A + nxt.aoff : cA; const char* nB = has_next ? (const char*)g.Bt + nxt.boff : cB;
        for (int t = 0; t < nt; t += 2) {
            const bool last = (t == nt - 2);
            const char* a1 = cA + (size_t)(t + 1) * kstep;
            const char* a2 = last ? nA : cA + (size_t)(t + 2) * kstep; const char* b2 = last ? nB : cB + (size_t)(t + 2) * kstep;
            const char* a3 = a2 + kstep; const char* b3 = b2 + kstep;
            PG8_LDB(B0, 0, 0); PG8_SCHED; PG8_LDA(At, 0, 0); PG8_STAGE(PG8_SA(1, 1), a1 + hstepA, voffA);
            PG8_WAIT_L(8); PG8_BAR; PG8_WAIT_L(0); PG8_MMA(0, 0, At, B0); PG8_BAR; PG8_SCHED;
            PG8_LDB(B1, 0, 1); PG8_STAGE(PG8_SB(0, 0), b2, voffB);
            PG8_BAR; PG8_WAIT_L(0); PG8_MMA(0, 1, At, B1); PG8_BAR;
            PG8_LDA(At, 0, 1); PG8_STAGE(PG8_SA(0, 0), a2, voffA);
            PG8_BAR; PG8_WAIT_L(0); PG8_MMA(1, 0, At, B0); PG8_BAR; PG8_SCHED;
            PG8_STAGE(PG8_SB(0, 1), b2 + hstepB, voffB);
            PG8_WAIT_V(6); PG8_BAR; PG8_MMA(1, 1, At, B1); PG8_BAR;
            PG8_LDB(B0, 1, 0); PG8_SCHED; PG8_LDA(At, 1, 0); PG8_STAGE(PG8_SA(0, 1), a2 + hstepA, voffA);
            PG8_WAIT_L(8); PG8_BAR; PG8_WAIT_L(0); PG8_MMA(0, 0, At, B0); PG8_BAR; PG8_SCHED;
            PG8_LDB(B1, 1, 1); PG8_STAGE(PG8_SB(1, 0), b3, voffB);
            PG8_BAR; PG8_WAIT_L(0); PG8_MMA(0, 1, At, B1); PG8_BAR;
            PG8_LDA(At, 1, 1); PG8_STAGE(PG8_SA(1, 0), a3, voffA);
            PG8_BAR; PG8_WAIT_L(0); PG8_MMA(1, 0, At, B0); PG8_BAR; PG8_SCHED;
            PG8_STAGE(PG8_SB(1, 1), b3 + hstepB, voffB);
            PG8_WAIT_V(6); PG8_BAR; PG8_MMA(1, 1, At, B1); PG8_BAR;
        }
        if constexpr (I8) {
#pragma unroll
            for (int a = 0; a < 2; ++a)
#pragma unroll
                for (int b = 0; b < 2; ++b)
#pragma unroll
                    for (int m = 0; m < 4; ++m)
#pragma unroll
                        for (int n = 0; n < 2; ++n) { const i32x4 iv = __builtin_bit_cast(i32x4, acc[a][b][m][n]); acc[a][b][m][n] = (f32x4){(float)iv[0], (float)iv[1], (float)iv[2], (float)iv[3]}; } }
        E(acc, cur, wr, wc, fr, fq);
        if (!has_next) break;
#pragma unroll
        for (int a = 0; a < 2; ++a)
#pragma unroll
            for (int b = 0; b < 2; ++b)
#pragma unroll
                for (int m = 0; m < 4; ++m)
#pragma unroll
                    for (int n = 0; n < 2; ++n) acc[a][b][m][n] = (f32x4){0.f, 0.f, 0.f, 0.f};
        cur = nxt; cA = nA; cB = nB; ++ui;
    }
    PG8_WAIT_V(0);
    if (wr == 0) PG8_BAR;
    PG8_BAR;
#undef PG8_SA
#undef PG8_SB
#undef PG8_STAGE
#undef PG8_LDA
#undef PG8_LDB
#undef PG8_MMA
#undef PG8_WAIT_V
#undef PG8_WAIT_L
#undef PG8_BAR
#undef PG8_SCHED
}

struct EpiBf16 {
    static constexpr bool PERM = true;
    bf16_t* O; long ldc; long bstride;
    __device__ __forceinline__ void operator()(const f32x4 (&acc)[2][2][4][2], const Unit& u, int wr, int wc, int fr, int fq) const {
        bf16_t* base = O + (long)u.x0 * bstride + (long)(u.pm * BM + wr * 64 + fr) * ldc + u.pn * BM + wc * 32 + 8 * fq;
#pragma unroll
        for (int ai = 0; ai < 2; ++ai)
#pragma unroll
            for (int m = 0; m < 4; ++m) { bf16_t* rowp = base + (long)(ai * HALF + m * 16) * ldc;
#pragma unroll
                for (int bj = 0; bj < 2; ++bj) { const f32x4 v0 = acc[ai][bj][m][0], v1 = acc[ai][bj][m][1];
                    u32x4 w; w.x = cvt_pk_bf16(v0[0], v0[1]); w.y = cvt_pk_bf16(v0[2], v0[3]); w.z = cvt_pk_bf16(v1[0], v1[1]); w.w = cvt_pk_bf16(v1[2], v1[3]);
                    *(u32x4*)(rowp + bj * HALF) = w; } }
    }
};
template <int RMODE> struct EpiRowMap {
    static constexpr bool PERM = true;
    bf16_t* O; const float* rsum;
    __device__ __forceinline__ void operator()(const f32x4 (&acc)[2][2][4][2], const Unit& u, int wr, int wc, int fr, int fq) const {
        const int col0 = u.pn * BM + wc * 32 + 8 * fq;
#pragma unroll
        for (int ai = 0; ai < 2; ++ai)
#pragma unroll
            for (int m = 0; m < 4; ++m) { const int r = ai * HALF + wr * 64 + m * 16 + fr; long drow; long ldc;
                if (RMODE == 1) { const int ts = 256 * u.x1 + r; drow = (long)(ts >> 6) * 1024 + u.x0 * 64 + (ts & 63); ldc = QLD; }
                float rs = 1.0f;
                if (RMODE == 1) { }
                else { const int qr = 256 * u.pm + r; drow = (long)(qr >> 6) * 2048 + u.x0 * 64 + (qr & 63); ldc = 512; rs = 1.0f / rsum[u.x0 * 1024 + qr]; }
                bf16_t* rowp = O + drow * ldc + col0;
#pragma unroll
                for (int bj = 0; bj < 2; ++bj) { const f32x4 v0 = acc[ai][bj][m][0] * rs, v1 = acc[ai][bj][m][1] * rs;
                    u32x4 w; w.x = cvt_pk_bf16(v0[0], v0[1]); w.y = cvt_pk_bf16(v0[2], v0[3]); w.z = cvt_pk_bf16(v1[0], v1[1]); w.w = cvt_pk_bf16(v1[2], v1[3]);
                    *(u32x4*)(rowp + bj * HALF) = w; } }
    }
};
struct EpiOV {
    static constexpr bool PERM = true;
    bf16_t* O;
    __device__ __forceinline__ void operator()(const f32x4 (&acc)[2][2][4][2], const Unit& u, int wr, int wc, int fr, int fq) const {
#pragma unroll
        for (int ai = 0; ai < 2; ++ai)
#pragma unroll
            for (int m = 0; m < 4; ++m) { const int r = ai * HALF + wr * 64 + m * 16 + fr;
                bf16_t* rowp = O + (long)(TP + 256 * u.x1 + r) * DM + u.x0 * 128 + wc * 32 + 8 * fq;
                const f32x4 v0 = acc[ai][1][m][0], v1 = acc[ai][1][m][1];
                u32x4 w; w.x = cvt_pk_bf16(v0[0], v0[1]); w.y = cvt_pk_bf16(v0[2], v0[3]); w.z = cvt_pk_bf16(v1[0], v1[1]); w.w = cvt_pk_bf16(v1[2], v1[3]);
                *(u32x4*)rowp = w; }
    }
};
struct EpiMix {
    static constexpr bool PERM = true;
    const bf16_t* Y; const bf16_t* YA; bf16_t* MIX;
    __device__ __forceinline__ void operator()(const f32x4 (&acc)[2][2][4][2], const Unit& u, int wr, int wc, int fr, int fq) const {
#pragma unroll
        for (int ai = 0; ai < 2; ++ai)
#pragma unroll
            for (int m = 0; m < 4; ++m) { const long t = (long)u.pm * BM + ai * HALF + wr * 64 + m * 16 + fr;
#pragma unroll
                for (int bj = 0; bj < 2; ++bj) { const int c = u.pn * BM + bj * HALF + wc * 32 + 8 * fq;
                    const u32x4 ga = *(const u32x4*)(Y + t * INWP + C_GA + c), gb = *(const u32x4*)(Y + t * INWP + C_GB + c), ya = *(const u32x4*)(YA + t * DM + c);
                    float fa[8], fb[8], fy[8], o[8]; unpack8(ga, fa); unpack8(gb, fb); unpack8(ya, fy);
                    const f32x4 v0 = acc[ai][bj][m][0], v1 = acc[ai][bj][m][1];
                    const float av[8] = {v0[0], v0[1], v0[2], v0[3], v1[0], v1[1], v1[2], v1[3]};
#pragma unroll
                    for (int j = 0; j < 8; ++j) {
#if defined(DBG_MIX) && DBG_MIX == 1
                        o[j] = sigmoidf_(fb[j]) * av[j];
#elif defined(DBG_MIX) && DBG_MIX == 2
                        o[j] = sigmoidf_(fa[j]) * fy[j];
#else
                        o[j] = sigmoidf_(fa[j]) * fy[j] + sigmoidf_(fb[j]) * av[j];
#endif
                    }
                    *(u32x4*)(MIX + t * DM + c) = pack8(o); } }
    }
};
struct EpiRes {
    static constexpr bool PERM = false;
    float* X; const float* gate;
    const float* XinP; const float* XinS;
    __device__ __forceinline__ void operator()(const f32x4 (&acc)[2][2][4][2], const Unit& u, int wr, int wc, int fr, int fq) const {
#pragma unroll
        for (int ai = 0; ai < 2; ++ai)
#pragma unroll
            for (int m = 0; m < 4; ++m) { const int t = u.pm * BM + ai * HALF + wr * 64 + m * 16 + fr; const float* gr = gate + (long)cond_row(t) * 12288; float* xr = X + (long)t * DM; const float* xi = t < TP ? XinP + (long)t * DM : XinS + (long)(t - TP) * DM;
#pragma unroll
                for (int bj = 0; bj < 2; ++bj)
#pragma unroll
                    for (int n = 0; n < 2; ++n) { const int c = u.pn * BM + bj * HALF + wc * 32 + n * 16 + 4 * fq;
                        const f32x4 gv = *(const f32x4*)(gr + c); const f32x4 xv = *(const f32x4*)(xi + c);
                        *(f32x4*)(xr + c) = xv + gv * acc[ai][bj][m][n]; } }
    }
};

struct EpiQ {
    static constexpr bool PERM = true;
    bf16_t* Q; bf16_t* QL; const float* T64;
    __device__ __forceinline__ void operator()(const f32x4 (&acc)[2][2][4][2], const Unit& u, int wr, int wc, int fr, int fq) const {
        const int grp = u.pn / 3, typ = u.pn - 3 * grp;
        if (typ < 2) {
#pragma unroll
            for (int ai = 0; ai < 2; ++ai)
#pragma unroll
                for (int m = 0; m < 4; ++m) { const long t = (long)u.pm * BM + ai * HALF + wr * 64 + m * 16 + fr;
#pragma unroll
                    for (int bj = 0; bj < 2; ++bj) { const f32x4 v0 = acc[ai][bj][m][0], v1 = acc[ai][bj][m][1];
                        u32x4 w; w.x = cvt_pk_bf16(v0[0], v0[1]); w.y = cvt_pk_bf16(v0[2], v0[3]); w.z = cvt_pk_bf16(v1[0], v1[1]); w.w = cvt_pk_bf16(v1[2], v1[3]);
                        *(u32x4*)(Q + t * 3072 + 768 * grp + 192 * (2 * typ + bj) + wc * 32 + 8 * fq) = w; } }
        } else {
#pragma unroll
            for (int ai = 0; ai < 2; ++ai)
#pragma unroll
                for (int m = 0; m < 4; ++m) { const int t = u.pm * BM + ai * HALF + wr * 64 + m * 16 + fr; const int pos = tok_pos(t);
                    const float* cs = T64 + ((long)pos * 32 + 8 * fq) * 2; float cv[8], sv[8];
#pragma unroll
                    for (int j = 0; j < 4; ++j) { const f32x4 qv = *(const f32x4*)(cs + 4 * j); cv[2 * j] = qv[0]; sv[2 * j] = qv[1]; cv[2 * j + 1] = qv[2]; sv[2 * j + 1] = qv[3]; }
                    const f32x4 a0 = acc[ai][0][m][0], a1 = acc[ai][0][m][1], b0 = acc[ai][1][m][0], b1 = acc[ai][1][m][1];
                    const float x1[8] = {a0[0], a0[1], a0[2], a0[3], a1[0], a1[1], a1[2], a1[3]}, x2[8] = {b0[0], b0[1], b0[2], b0[3], b1[0], b1[1], b1[2], b1[3]};
                    float o1[8], o2[8];
#pragma unroll
                    for (int j = 0; j < 8; ++j) { o1[j] = x1[j] * cv[j] - x2[j] * sv[j]; o2[j] = x1[j] * sv[j] + x2[j] * cv[j]; }
                    const u32x4 w1 = pack8(o1), w2 = pack8(o2); const int hd = 4 * grp + wc;
                    bf16_t* qd = Q + (long)t * 3072 + hd * 192 + 128 + 8 * fq; *(u32x4*)qd = w1; *(u32x4*)(qd + 32) = w2;
                    if (t >= TP) { const int ts = t - TP; bf16_t* d = QL + ((long)(ts >> 6) * 1024 + hd * 64 + (ts & 63)) * QLD + 512 + 8 * fq; *(u32x4*)d = w1; *(u32x4*)(d + 32) = w2; } }
        }
    }
};

struct EpiExp {
    static constexpr bool PERM = true;
    bf16_t* O; float* rsum;
    __device__ __forceinline__ void operator()(const f32x4 (&acc)[2][2][4][2], const Unit& u, int wr, int wc, int fr, int fq) const {
        bf16_t* base = O + (long)u.x0 * 1024 * KPAD + (long)(u.pm * BM + wr * 64 + fr) * KPAD + u.pn * BM + wc * 32 + 8 * fq;
#pragma unroll
        for (int ai = 0; ai < 2; ++ai)
#pragma unroll
            for (int m = 0; m < 4; ++m) { bf16_t* rowp = base + (long)(ai * HALF + m * 16) * KPAD; float part = 0.f;
#pragma unroll
                for (int bj = 0; bj < 2; ++bj) { const int c0 = u.pn * BM + bj * HALF + wc * 32 + 8 * fq; const f32x4 v0 = acc[ai][bj][m][0], v1 = acc[ai][bj][m][1];
                    const float sv[8] = {v0[0], v0[1], v0[2], v0[3], v1[0], v1[1], v1[2], v1[3]}; float e[8];
#pragma unroll
                    for (int j = 0; j < 8; ++j) { e[j] = (c0 + j < KALL) ? __expf(fminf(sv[j] * MLA_SCALE, 60.f)) : 0.f; part += e[j]; }
                    *(u32x4*)(rowp + bj * HALF) = pack8(e); }
                part += sx<16>(part); part += sx<32>(part);
                if (fq == 0) atomicAdd(rsum + u.x0 * 1024 + u.pm * BM + ai * HALF + wr * 64 + m * 16 + fr, part); }
    }
};

struct EpiQ8 {
    static constexpr bool PERM = true;
    bf16_t* O; const float* sa; const float* sb;
    __device__ __forceinline__ void operator()(const f32x4 (&acc)[2][2][4][2], const Unit& u, int wr, int wc, int fr, int fq) const {
        f32x4 sbv[2][2];
#pragma unroll
        for (int bj = 0; bj < 2; ++bj) { const int c = u.pn * BM + bj * HALF + wc * 32 + 8 * fq; sbv[bj][0] = *(const f32x4*)(sb + c); sbv[bj][1] = *(const f32x4*)(sb + c + 4); }
#pragma unroll
        for (int ai = 0; ai < 2; ++ai)
#pragma unroll
            for (int m = 0; m < 4; ++m) { const long t = (long)u.pm * BM + ai * HALF + wr * 64 + m * 16 + fr; const float s = sa[t];
#pragma unroll
                for (int bj = 0; bj < 2; ++bj) { const f32x4 v0 = acc[ai][bj][m][0] * sbv[bj][0] * s, v1 = acc[ai][bj][m][1] * sbv[bj][1] * s;
                    u32x4 w; w.x = cvt_pk_bf16(v0[0], v0[1]); w.y = cvt_pk_bf16(v0[2], v0[3]); w.z = cvt_pk_bf16(v1[0], v1[1]); w.w = cvt_pk_bf16(v1[2], v1[3]);
                    *(u32x4*)(O + t * DM + u.pn * BM + bj * HALF + wc * 32 + 8 * fq) = w; } }
    }
};
}
namespace att {
constexpr int NW = 8, QBLK = 32, KVBLK = 64;
constexpr float SCALE = MLA_SCALE;
constexpr float THR = 8.f;
constexpr int KROW = 384;
constexpr int SHM_V = KVBLK * 128 * 2, SHM_K = KVBLK * KROW;
constexpr int QR_PITCH = 144, SHM_QR = 256 * QR_PITCH;
constexpr int SHM_ATTN = 2 * SHM_V + 2 * SHM_K + NW * 64 * 4 + SHM_QR;
#define KSWZ(row, colB) ((row) * att::KROW + ((colB) ^ (((row) & 7) << 4)))
#define SBAR() __builtin_amdgcn_sched_barrier(0)
__device__ __forceinline__ int crow(int r, int hi) { return (r & 3) + 8 * (r >> 2) + 4 * hi; }

__device__ __forceinline__ void partialSM(f32x16& p0, f32x16& p1, float& m_reg, float& mn, float& alpha) {
  constexpr float C = SCALE * 1.4426950408889634f;
  float pmax = p0[0];
#pragma unroll
  for (int r = 1; r < 16; ++r) pmax = fmaxf(pmax, p0[r]);
#pragma unroll
  for (int r = 0; r < 16; ++r) pmax = fmaxf(pmax, p1[r]);
  { auto rr = __builtin_amdgcn_permlane32_swap(__float_as_uint(pmax), __float_as_uint(pmax), false, false);
    pmax = fmaxf(__uint_as_float(rr[0]), __uint_as_float(rr[1])); }
  if (__builtin_expect(__all(pmax - m_reg <= THR / SCALE), 1)) { mn = m_reg; alpha = 1.f; }
  else { mn = fmaxf(m_reg, pmax); alpha = __builtin_amdgcn_exp2f((m_reg - mn) * C); m_reg = mn; }
  float mnC = -mn * C;
#pragma unroll
  for (int r = 0; r < 16; ++r) p0[r] = fmaf(p0[r], C, mnC);
#pragma unroll
  for (int r = 0; r < 16; ++r) p1[r] = fmaf(p1[r], C, mnC);
#pragma unroll
  for (int r = 0; r < 16; ++r) p0[r] = __builtin_amdgcn_exp2f(p0[r]);
}
__device__ __forceinline__ void finishSM(f32x16& p0, f32x16& p1, float alpha, float& l_reg, bf16x8& pa0, bf16x8& pa1, bf16x8& pa2, bf16x8& pa3) {
#pragma unroll
  for (int r = 0; r < 16; ++r) p1[r] = __builtin_amdgcn_exp2f(p1[r]);
  float ps = 0;
#pragma unroll
  for (int r = 0; r < 16; ++r) ps += p0[r];
#pragma unroll
  for (int r = 0; r < 16; ++r) ps += p1[r];
  { auto rr = __builtin_amdgcn_permlane32_swap(__float_as_uint(ps), __float_as_uint(ps), false, false);
    ps = __uint_as_float(rr[0]) + __uint_as_float(rr[1]); }
  l_reg = l_reg * alpha + ps;
#define PK4(P, BASE, OUT) do { unsigned a0 = cvt_pk_bf16(P[BASE + 0], P[BASE + 1]), a1 = cvt_pk_bf16(P[BASE + 2], P[BASE + 3]);   \
    unsigned b0 = cvt_pk_bf16(P[BASE + 4], P[BASE + 5]), b1 = cvt_pk_bf16(P[BASE + 6], P[BASE + 7]);                              \
    auto r0 = __builtin_amdgcn_permlane32_swap(a0, b0, false, false); auto r1 = __builtin_amdgcn_permlane32_swap(a1, b1, false, false); \
    u32x4 w = {r0[0], r1[0], r0[1], r1[1]}; OUT = *reinterpret_cast<bf16x8*>(&w); } while (0)
  PK4(p0, 0, pa0); PK4(p0, 8, pa1); PK4(p1, 0, pa2); PK4(p1, 8, pa3);
#undef PK4
}
__device__ __forceinline__ void qkt(f32x16& p0, f32x16& p1, const char* Ks, const bf16x8* qr, const char* qrope, const int (&kbase)[4], bool vis) {
  p0 = f32x16{}; p1 = f32x16{};
  if (vis) {
#pragma unroll
  for (int d0 = 0; d0 < 12; ++d0) {
    bf16x8 b0 = *reinterpret_cast<const bf16x8*>(Ks + kbase[d0 & 3] + (d0 >> 2) * 128);
    bf16x8 b1 = *reinterpret_cast<const bf16x8*>(Ks + kbase[d0 & 3] + (d0 >> 2) * 128 + 32 * KROW);
    const bf16x8 qv = d0 < 8 ? qr[d0 < 8 ? d0 : 0] : *reinterpret_cast<const bf16x8*>(qrope + (d0 - 8) * 32);
    p0 = __builtin_amdgcn_mfma_f32_32x32x16_bf16(b0, qv, p0, 0, 0, 0);
    p1 = __builtin_amdgcn_mfma_f32_32x32x16_bf16(b1, qv, p1, 0, 0, 0); }
  }
  if (!vis) {
#pragma unroll
    for (int r = 0; r < 16; ++r) { p0[r] = -1e30f; p1[r] = -1e30f; } }
}
__device__ __forceinline__ int v_st(int k, int c) { const int kk = (k & ~0xC) | ((k & 4) << 1) | ((k & 8) >> 1); return ((kk >> 3) * 4 + (c >> 5)) * 512 + ((kk & 7) * 32 + (c & 31)) * 2; }
__device__ __forceinline__ int v_rd_base(int lane) { return ((lane & 3) << 3) | (((lane >> 2) & 3) << 6) | (((lane >> 4) & 1) << 5) | (((lane >> 5) & 1) << 8); }
constexpr int v_rd_off(int d0, int ks, int half) { return d0 * 512 + ks * 4096 + half * 2048; }
template <int OFF> __device__ __forceinline__ s16x4 tr_read(int vb) {
  s16x4 r; asm volatile("ds_read_b64_tr_b16 %0, %1 offset:%2" : "=&v"(r) : "v"(vb), "i"(OFF) : "memory"); return r;
}
template <int D0> __device__ __forceinline__ void pv_one(f32x16& od, int vb, bf16x8 pa0, bf16x8 pa1, bf16x8 pa2, bf16x8 pa3) {
  const s16x4 l0 = tr_read<v_rd_off(D0, 0, 0)>(vb), h0 = tr_read<v_rd_off(D0, 0, 1)>(vb), l1 = tr_read<v_rd_off(D0, 1, 0)>(vb), h1 = tr_read<v_rd_off(D0, 1, 1)>(vb);
  const s16x4 l2 = tr_read<v_rd_off(D0, 2, 0)>(vb), h2 = tr_read<v_rd_off(D0, 2, 1)>(vb), l3 = tr_read<v_rd_off(D0, 3, 0)>(vb), h3 = tr_read<v_rd_off(D0, 3, 1)>(vb);
  asm volatile("s_waitcnt lgkmcnt(0)" ::: "memory"); SBAR();
#define PK(L, H) (bf16x8){L[0], L[1], L[2], L[3], H[0], H[1], H[2], H[3]}
  od = __builtin_amdgcn_mfma_f32_32x32x16_bf16(pa0, PK(l0, h0), od, 0, 0, 0);
  od = __builtin_amdgcn_mfma_f32_32x32x16_bf16(pa1, PK(l1, h1), od, 0, 0, 0);
  od = __builtin_amdgcn_mfma_f32_32x32x16_bf16(pa2, PK(l2, h2), od, 0, 0, 0);
  od = __builtin_amdgcn_mfma_f32_32x32x16_bf16(pa3, PK(l3, h3), od, 0, 0, 0);
#undef PK
}
__device__ __forceinline__ void pv_d0(f32x16* o, int vb, bf16x8 pa0, bf16x8 pa1, bf16x8 pa2, bf16x8 pa3) {
  pv_one<0>(o[0], vb, pa0, pa1, pa2, pa3); pv_one<1>(o[1], vb, pa0, pa1, pa2, pa3); pv_one<2>(o[2], vb, pa0, pa1, pa2, pa3); pv_one<3>(o[3], vb, pa0, pa1, pa2, pa3);
}

__device__ __forceinline__ void attn_block(const bf16_t* __restrict__ Qb, const bf16_t* __restrict__ Kn, const bf16_t* __restrict__ Kr, const bf16_t* __restrict__ Vh,
                                           bf16_t* __restrict__ Ob, int qb, char* lds) {
  constexpr int LDQ = 3072, LDK = 4096, LDR = 64, LDO = 2048;
  const int tid = otid(), wid = tid >> 6, lane = tid & 63, r32 = lane & 31, hi = lane >> 5;
  char* V_lds = lds; char* K_lds = lds + 2 * SHM_V;
  float* ws = (float*)(lds + 2 * SHM_V + 2 * SHM_K) + wid * 64; float* li_l = ws; float* al_l = ws + 32;
  float m_reg = -1e30f, l_reg = 0; f32x16 o[4] = {}; bf16x8 qr[8];
  const bf16_t* Qw = Qb + (long)(wid * QBLK + r32) * LDQ + hi * 8;
#pragma unroll
  for (int d0 = 0; d0 < 8; ++d0) qr[d0] = *reinterpret_cast<const bf16x8*>(Qw + d0 * 16);
  char* qrope = lds + 2 * SHM_V + 2 * SHM_K + NW * 64 * 4 + (wid * QBLK + r32) * QR_PITCH + hi * 16;
#pragma unroll
  for (int d0 = 8; d0 < 12; ++d0) *reinterpret_cast<bf16x8*>(qrope + (d0 - 8) * 32) = *reinterpret_cast<const bf16x8*>(Qw + d0 * 16);
  asm volatile("s_waitcnt lgkmcnt(0)" ::: "memory");
  const int NT = 4 * qb + 4, jmax = 4 * qb + (wid >> 1);
  int kbase[4];
#pragma unroll
  for (int dl = 0; dl < 4; ++dl) kbase[dl] = r32 * KROW + (((dl << 5) | (hi << 4)) ^ ((r32 & 7) << 4));
  const int sr = tid >> 4, sc = (tid & 15) * 8, vst0 = v_st(sr, sc), vst1 = v_st(32 + sr, sc);
  const int rr = tid >> 3, rc = (tid & 7) * 8;
  const int vb0 = (int)(uintptr_t)V_lds + v_rd_base(lane);
  bf16x8 vs0, vs1, ks0, ks1, kr0;
#define SLOAD(k0) do { vs0 = *reinterpret_cast<const bf16x8*>(&Vh[(long)((k0) + sr) * LDK + sc]); vs1 = *reinterpret_cast<const bf16x8*>(&Vh[(long)((k0) + 32 + sr) * LDK + sc]); \
    ks0 = *reinterpret_cast<const bf16x8*>(&Kn[(long)((k0) + sr) * LDK + sc]); ks1 = *reinterpret_cast<const bf16x8*>(&Kn[(long)((k0) + 32 + sr) * LDK + sc]); \
    kr0 = *reinterpret_cast<const bf16x8*>(&Kr[(long)((k0) + rr) * LDR + rc]); } while (0)
#define SWRITE(b) do { *(bf16x8*)(V_lds + (b) * SHM_V + vst0) = vs0; *(bf16x8*)(V_lds + (b) * SHM_V + vst1) = vs1; int kc = sc * 2; \
    *(bf16x8*)(K_lds + (b) * SHM_K + KSWZ(sr, kc)) = ks0; *(bf16x8*)(K_lds + (b) * SHM_K + KSWZ(32 + sr, kc)) = ks1; \
    *(bf16x8*)(K_lds + (b) * SHM_K + KSWZ(rr, 256 + rc * 2)) = kr0; } while (0)
#define SWAIT() asm volatile("s_waitcnt vmcnt(0)" ::: "memory")
#define RESC(a) do { if (__any((a) < 1.f)) { if (hi == 0) al_l[r32] = (a); asm volatile("s_waitcnt lgkmcnt(0)" ::: "memory"); \
    _Pragma("unroll") for (int d = 0; d < 4; ++d) _Pragma("unroll") for (int r = 0; r < 16; ++r) o[d][r] *= al_l[crow(r, hi)]; } } while (0)
  f32x16 pA0, pA1, pB0, pB1; float mnA, mnB, alA, alB; bf16x8 pa0, pa1, pa2, pa3;
  SLOAD(0); SWAIT(); SWRITE(0); __syncthreads();
  qkt(pA0, pA1, K_lds, qr, qrope, kbase, true); partialSM(pA0, pA1, m_reg, mnA, alA);
  SLOAD(KVBLK);
  SWAIT(); SWRITE(1); __syncthreads();
  for (int j = 1; j + 1 < NT; j += 2) {
    SBAR(); qkt(pB0, pB1, K_lds + SHM_K, qr, qrope, kbase, j <= jmax);
    finishSM(pA0, pA1, alA, l_reg, pa0, pa1, pa2, pa3); SBAR();
    SLOAD((j + 1) * KVBLK); SBAR();
    if (j - 1 <= jmax) pv_d0(o, vb0, pa0, pa1, pa2, pa3);
    partialSM(pB0, pB1, m_reg, mnB, alB);
    __syncthreads(); SWAIT(); SWRITE(0);
    RESC(alB); __syncthreads();
    SBAR(); qkt(pA0, pA1, K_lds, qr, qrope, kbase, j + 1 <= jmax);
    finishSM(pB0, pB1, alB, l_reg, pa0, pa1, pa2, pa3); SBAR();
    SLOAD((j + 2) * KVBLK); SBAR();
    if (j <= jmax) pv_d0(o, vb0 + (int)SHM_V, pa0, pa1, pa2, pa3);
    partialSM(pA0, pA1, m_reg, mnA, alA);
    __syncthreads(); SWAIT(); SWRITE(1);
    RESC(alA); __syncthreads();
  }
  SBAR(); qkt(pB0, pB1, K_lds + SHM_K, qr, qrope, kbase, NT - 1 <= jmax);
  finishSM(pA0, pA1, alA, l_reg, pa0, pa1, pa2, pa3); SBAR();
  if (NT - 2 <= jmax) pv_d0(o, vb0, pa0, pa1, pa2, pa3);
  partialSM(pB0, pB1, m_reg, mnB, alB);
  __syncthreads(); RESC(alB);
  finishSM(pB0, pB1, alB, l_reg, pa0, pa1, pa2, pa3); SBAR();
  if (NT - 1 <= jmax) pv_d0(o, vb0 + (int)SHM_V, pa0, pa1, pa2, pa3);
  if (hi == 0) li_l[r32] = l_reg; asm volatile("s_waitcnt lgkmcnt(0)" ::: "memory");
  float rli[16];
#pragma unroll
  for (int r = 0; r < 16; ++r) rli[r] = __builtin_amdgcn_rcpf(li_l[crow(r, hi)]);
  bf16_t* Ow = Ob + (long)(wid * QBLK) * LDO;
#pragma unroll
  for (int r = 0; r < 16; ++r) { int orow = crow(r, hi);
#pragma unroll
    for (int d0 = 0; d0 < 4; ++d0) Ow[(long)orow * LDO + d0 * 32 + r32] = f2bf(o[d0][r] * rli[r]); }
  __syncthreads();
#undef SLOAD
#undef SWRITE
#undef SWAIT
#undef RESC
}
}
namespace ret {
constexpr int QP_ = 136;
__device__ __forceinline__ bf16x8 ldfrag(const bf16_t* p) { return *reinterpret_cast<const bf16x8*>(p); }
template <int CL> struct Lay {
    static constexpr int IP = CL + 8;
    static constexpr int QS = 0, KS = QS + CL * QP_ * 2, VT = KS + CL * QP_ * 2, VDT = VT + 32 * IP * 2, IN = VDT + 32 * IP * 2, ST = IN + CL * IP * 2, VS = ST + 32 * QP_ * 2, END = VS + CL * 40 * 2;
};
static_assert(Lay<128>::END <= LDS_BARW, "retention LDS");

template <int CL>
__device__ __forceinline__ void run(const bf16_t* __restrict__ Y, bf16_t* __restrict__ OB, const float* __restrict__ sp, float* __restrict__ so, long tok0, int nch, int h, int es, float lg, char* lds, int tid) {
    using L = Lay<CL>; constexpr int IP = L::IP, NQT = CL / 16, NKS = CL / 32, NPC = CL / 32;
    const int wid = __builtin_amdgcn_readfirstlane(tid >> 6), lane = tid & 63, l15 = lane & 15, l4 = lane >> 4;
    bf16_t* Qs = (bf16_t*)(lds + L::QS); bf16_t* Ks = (bf16_t*)(lds + L::KS); bf16_t* Vt = (bf16_t*)(lds + L::VT); bf16_t* Vdt = (bf16_t*)(lds + L::VDT); bf16_t* In = (bf16_t*)(lds + L::IN); bf16_t* St = (bf16_t*)(lds + L::ST); bf16_t* Vs = (bf16_t*)(lds + L::VS);
    const float gCL = __expf((float)CL * lg);
    f32x4 Sacc[2];
    if (sp) {
#pragma unroll
        for (int ej = 0; ej < 2; ++ej)
#pragma unroll
            for (int r = 0; r < 4; ++r) Sacc[ej][r] = sp[(long)(16 * wid + 4 * l4 + r) * RV + 16 * ej + l15];
    } else { Sacc[0] = (f32x4){0.f, 0.f, 0.f, 0.f}; Sacc[1] = (f32x4){0.f, 0.f, 0.f, 0.f}; }
    for (int i = tid; i < CL * IP / 8; i += 512) reinterpret_cast<u32x4*>(In)[i] = (u32x4){0u, 0u, 0u, 0u};
    u32x4 pq[NPC], pk[NPC], pv;
    const int vk = tid >> 2, ve0 = (tid & 3) * 8;
#define RET_LOAD(cc) do { const bf16_t* yrow_ = Y + (tok0 + (long)(cc) * CL) * INWP; \
        _Pragma("unroll") for (int i = 0; i < NPC; ++i) { const int idx = tid + i * 512, k = idx >> 4, d0 = (idx & 15) * 8; \
            pq[i] = *reinterpret_cast<const u32x4*>(yrow_ + (long)k * INWP + C_RQ + h * 128 + d0); pk[i] = *reinterpret_cast<const u32x4*>(yrow_ + (long)k * INWP + C_RK + h * 128 + d0); } \
        if (tid < 4 * CL) pv = *reinterpret_cast<const u32x4*>(yrow_ + (long)vk * INWP + C_RV + h * 256 + es * 32 + ve0); } while (0)
    RET_LOAD(0);
    for (int c = 0; c < nch; ++c) {
#pragma unroll
        for (int ej = 0; ej < 2; ++ej) { u32x2 w; w.x = cvt_pk_bf16(Sacc[ej][0], Sacc[ej][1]); w.y = cvt_pk_bf16(Sacc[ej][2], Sacc[ej][3]);
            *reinterpret_cast<u32x2*>(St + (16 * ej + l15) * QP_ + 16 * wid + 4 * l4) = w; }
#pragma unroll
        for (int i = 0; i < NPC; ++i) { const int idx = tid + i * 512, k = idx >> 4, d0 = (idx & 15) * 8;
            *reinterpret_cast<u32x4*>(Qs + k * QP_ + d0) = pq[i]; *reinterpret_cast<u32x4*>(Ks + k * QP_ + d0) = pk[i]; }
        if (tid < 4 * CL) *reinterpret_cast<u32x4*>(Vs + vk * 40 + ve0) = pv;
        if (c + 1 < nch) RET_LOAD(c + 1);
        __syncthreads();
        if (tid < 4 * CL) { const int e = tid & 31, kg = tid >> 5; float f[8], fd[8];
#pragma unroll
            for (int j = 0; j < 8; ++j) { f[j] = bf2f(Vs[(8 * kg + j) * 40 + e]); fd[j] = f[j] * __expf((float)(CL - 1 - 8 * kg - j) * lg); }
            *reinterpret_cast<u32x4*>(Vt + e * IP + 8 * kg) = pack8(f); *reinterpret_cast<u32x4*>(Vdt + e * IP + 8 * kg) = pack8(fd); }
#pragma unroll
        for (int it_ = 0; it_ < (NQT * (NQT + 1) / 2 + 7) / 8; ++it_) { const int idx = wid + 8 * it_; if (idx >= NQT * (NQT + 1) / 2) break;
            int qi = 0; while ((qi + 1) * (qi + 2) / 2 <= idx) ++qi; const int kj = idx - qi * (qi + 1) / 2;
            f32x4 a = (f32x4){0.f, 0.f, 0.f, 0.f}; const bf16_t* qp = Qs + (16 * qi + l15) * QP_ + 8 * l4; const bf16_t* kp = Ks + (16 * kj + l15) * QP_ + 8 * l4;
#pragma unroll
            for (int ks = 0; ks < 4; ++ks) a = __builtin_amdgcn_mfma_f32_16x16x32_bf16(ldfrag(qp + 32 * ks), ldfrag(kp + 32 * ks), a, 0, 0, 0);
            const int q0 = 16 * qi + 4 * l4, k = 16 * kj + l15;
#pragma unroll
            for (int r = 0; r < 4; ++r) { const int q = q0 + r; const float dm = (q >= k) ? __expf((float)(q - k) * lg) : 0.f;
                In[q * IP + k] = f2bf(a[r] * dm); } }
        __syncthreads();
#pragma unroll
        for (int ot = 0; ot < (2 * NQT) / 8; ++ot) { const int tI = wid + 8 * ot, qi = tI >> 1, ej = tI & 1; f32x4 a = (f32x4){0.f, 0.f, 0.f, 0.f};
#pragma unroll
            for (int ks = 0; ks < 4; ++ks) a = __builtin_amdgcn_mfma_f32_16x16x32_bf16(ldfrag(Qs + (16 * qi + l15) * QP_ + 32 * ks + 8 * l4), ldfrag(St + (16 * ej + l15) * QP_ + 32 * ks + 8 * l4), a, 0, 0, 0);
#pragma unroll
            for (int r = 0; r < 4; ++r) a[r] *= __expf((float)(16 * qi + 4 * l4 + r + 1) * lg);
#pragma unroll
            for (int ks = 0; ks < NKS; ++ks) if (ks <= (qi >> 1)) a = __builtin_amdgcn_mfma_f32_16x16x32_bf16(ldfrag(In + (16 * qi + l15) * IP + 32 * ks + 8 * l4), ldfrag(Vt + (16 * ej + l15) * IP + 32 * ks + 8 * l4), a, 0, 0, 0);
            bf16_t* op = OB + ((long)(h * 8 + es) * T + tok0 + (long)c * CL + 16 * qi + 4 * l4) * 32 + 16 * ej + l15;
#pragma unroll
            for (int r = 0; r < 4; ++r) op[r * 32] = f2bf(a[r]); }
        { f32x4 s0 = Sacc[0] * gCL, s1 = Sacc[1] * gCL;
#pragma unroll
          for (int ks = 0; ks < NKS; ++ks) { bf16x8 af;
#pragma unroll
              for (int j = 0; j < 8; ++j) af[j] = (short)Ks[(32 * ks + 8 * l4 + j) * QP_ + 16 * wid + l15];
              s0 = __builtin_amdgcn_mfma_f32_16x16x32_bf16(af, ldfrag(Vdt + l15 * IP + 32 * ks + 8 * l4), s0, 0, 0, 0);
              s1 = __builtin_amdgcn_mfma_f32_16x16x32_bf16(af, ldfrag(Vdt + (16 + l15) * IP + 32 * ks + 8 * l4), s1, 0, 0, 0); }
          Sacc[0] = s0; Sacc[1] = s1; }
        __syncthreads();
    }
#undef RET_LOAD
#pragma unroll
    for (int ej = 0; ej < 2; ++ej)
#pragma unroll
        for (int r = 0; r < 4; ++r) so[(long)(16 * wid + 4 * l4 + r) * RV + 16 * ej + l15] = Sacc[ej][r];
}

__device__ __forceinline__ void unit(KParams& p, int l, int u, char* lds) {
    const int tid = otid(); unsigned char* ws = optr(gp(p.ws)); const bf16_t* Y = (const bf16_t*)(ws + WS_Y); bf16_t* OB = (bf16_t*)(ws + WS_OB);
    const bool samp = u >= 256; const int v = samp ? u - 256 : u; const int b = v >> 6, h = (v >> 3) & 7, es = v & 7; const float lg = p.lg[h];
    if (samp) run<64>(Y, OB, gp(p.state_ret) + ((((long)l * DB + b) * RH + h) * RQK) * RV + es * 32, gp(p.out) + O_RETS + ((((long)l * DB + b) * RH + h) * RQK) * RV + es * 32, (long)TP + b * 64, 1, h, es, lg, lds, tid);
    else run<64>(Y, OB, nullptr, gp(p.out) + O_RETP + ((((long)l * NB + b) * RH + h) * RQK) * RV + es * 32, (long)b * SEQ, SEQ / 64, h, es, lg, lds, tid);
}
}
namespace peer {
__device__ __forceinline__ void ins16(float (&l)[16], float x) {
#pragma unroll
    for (int j = 0; j < 16; ++j) { const float hi = fmaxf(l[j], x); x = fminf(l[j], x); l[j] = hi; }
}
#define CE_DESC(a, b) do { const float hi_ = fmaxf(a, b), lo_ = fminf(a, b); a = hi_; b = lo_; } while (0)
#define CE_ASC(a, b) do { const float hi_ = fmaxf(a, b), lo_ = fminf(a, b); a = lo_; b = hi_; } while (0)
__device__ __forceinline__ void sort16_desc(float (&v)[16]) {
#pragma unroll
    for (int k = 2; k <= 16; k <<= 1)
#pragma unroll
        for (int j = k >> 1; j >= 1; j >>= 1)
#pragma unroll
            for (int i = 0; i < 16; ++i) { const int l = i ^ j; if (l > i) { if ((i & k) == 0) CE_DESC(v[i], v[l]); else CE_ASC(v[i], v[l]); } }
}
__device__ __forceinline__ void merge16_desc(float (&l)[16], const float (&o)[16]) {
#pragma unroll
    for (int i = 0; i < 16; ++i) l[i] = fmaxf(l[i], o[15 - i]);
#pragma unroll
    for (int j = 8; j >= 1; j >>= 1)
#pragma unroll
        for (int i = 0; i < 16; ++i) { const int m = i ^ j; if (m > i) CE_DESC(l[i], l[m]); }
}
constexpr int KPITCH = 136;
__device__ __forceinline__ void half_top16(const bf16_t* __restrict__ qrow, const bf16_t* __restrict__ keys, int lane, float (&l)[16]) {
    const int r32 = lane & 31, g = lane >> 5;
#pragma unroll
    for (int j = 0; j < 16; ++j) l[j] = -3.0e38f;
    bf16x8 qf[8];
#pragma unroll
    for (int ks = 0; ks < 8; ++ks) qf[ks] = *reinterpret_cast<const bf16x8*>(qrow + 16 * ks + 8 * g);
#pragma unroll 1
    for (int kb = 0; kb < 4; ++kb) { f32x16 a = f32x16{};
#pragma unroll
        for (int ks = 0; ks < 8; ++ks) { const bf16x8 kf = *reinterpret_cast<const bf16x8*>(keys + (32 * kb + r32) * KPITCH + 16 * ks + 8 * g);
            a = __builtin_amdgcn_mfma_f32_32x32x16_bf16(kf, qf[ks], a, 0, 0, 0); }
        float blk[16];
#pragma unroll
        for (int r = 0; r < 16; ++r) { const unsigned key = (unsigned)(32 * kb + (r & 3) + 8 * (r >> 2) + 4 * g);
            blk[r] = __uint_as_float((__float_as_uint(a[r]) & ~0x7Fu) | key); }
        sort16_desc(blk); merge16_desc(l, blk); }
}
__device__ __forceinline__ void merge_lists(float (&l)[16], const float (&o)[16]) { merge16_desc(l, o); }
__device__ __forceinline__ void select_unit(const bf16_t* __restrict__ QP, const bf16_t* __restrict__ k1, const bf16_t* __restrict__ k2, int* __restrict__ PIDX, float* __restrict__ PW,
                                            int t0, int h, int lane, float* lds_lane  ) {
    const int r32 = lane & 31, g = lane >> 5;
    const bf16_t* qrow = QP + (long)(t0 + r32) * DM + h * 256;
    float la[16], lb[16];
    half_top16(qrow, k1, lane, la);
    half_top16(qrow + 128, k2, lane, lb);
    float m0[16], m1[16];
#pragma unroll
    for (int j = 0; j < 16; ++j) { auto rr = __builtin_amdgcn_permlane32_swap(__float_as_uint(la[j]), __float_as_uint(lb[j]), false, false); m0[j] = __uint_as_float(rr[0]); m1[j] = __uint_as_float(rr[1]); }
    merge_lists(m0, m1);
    float L1[16], L2[16];
#pragma unroll
    for (int j = 0; j < 16; ++j) { auto rr = __builtin_amdgcn_permlane32_swap(__float_as_uint(m0[j]), __float_as_uint(m0[j]), false, false);
        L1[j] = __uint_as_float(rr[0]); L2[j] = __uint_as_float(rr[1]); }
#define CAND(i, j) __uint_as_float((__float_as_uint(L1[i] + L2[j]) & ~0xFFu) | (unsigned)((i) * 16 + (j)))
    float best[16], c2[16], c3[16];
#pragma unroll
    for (int j = 0; j < 16; ++j) best[j] = CAND(0, j);
    sort16_desc(best);
    c2[0] = CAND(1, 0); c2[1] = CAND(1, 1); c2[2] = CAND(1, 2); c2[3] = CAND(1, 3); c2[4] = CAND(1, 4); c2[5] = CAND(1, 5); c2[6] = CAND(1, 6); c2[7] = CAND(1, 7);
    c2[8] = CAND(2, 0); c2[9] = CAND(2, 1); c2[10] = CAND(2, 2); c2[11] = CAND(2, 3); c2[12] = CAND(2, 4); c2[13] = CAND(4, 0); c2[14] = CAND(4, 1); c2[15] = CAND(4, 2);
    sort16_desc(c2); merge16_desc(best, c2);
    c3[0] = CAND(3, 0); c3[1] = CAND(3, 1); c3[2] = CAND(3, 2); c3[3] = CAND(3, 3); c3[4] = CAND(5, 0); c3[5] = CAND(5, 1); c3[6] = CAND(6, 0); c3[7] = CAND(6, 1);
    c3[8] = CAND(7, 0); c3[9] = CAND(7, 1); c3[10] = CAND(8, 0); c3[11] = CAND(9, 0); c3[12] = CAND(10, 0); c3[13] = CAND(11, 0); c3[14] = CAND(12, 0); c3[15] = CAND(13, 0);
    sort16_desc(c3); merge16_desc(best, c3);
    ins16(best, CAND(14, 0)); ins16(best, CAND(15, 0));
#undef CAND
#pragma unroll
    for (int j = 0; j < 16; ++j) { lds_lane[j] = __uint_as_float(__float_as_uint(L1[j]) & 0x7Fu); lds_lane[16 + j] = __uint_as_float(__float_as_uint(L2[j]) & 0x7Fu); }
    asm volatile("s_waitcnt lgkmcnt(0)" ::: "memory");
    float wsum = 0.f, w[16]; int ei[16];
    const float mx = best[0];
#pragma unroll
    for (int k = 0; k < 16; ++k) { const unsigned code = __float_as_uint(best[k]) & 0xFFu; const int i = (int)(code >> 4), j = (int)(code & 15u);
        const int i1 = (int)__float_as_uint(lds_lane[i]), i2 = (int)__float_as_uint(lds_lane[16 + j]); ei[k] = i1 * NKEYS + i2;
        w[k] = __expf(best[k] - mx); wsum += w[k]; }
    const float inv = 1.0f / wsum;
    if (g == 0) { int* ip = PIDX + (long)(t0 + r32) * 128 + h * 16; float* wp = PW + (long)(t0 + r32) * 128 + h * 16;
#pragma unroll
        for (int k = 0; k < 16; k += 4) { *reinterpret_cast<int4*>(ip + k) = make_int4(ei[k], ei[k + 1], ei[k + 2], ei[k + 3]);
            *reinterpret_cast<float4*>(wp + k) = make_float4(w[k] * inv, w[k + 1] * inv, w[k + 2] * inv, w[k + 3] * inv); } }
}

__device__ __forceinline__ float gelu_exact(float x) { return 0.5f * x * (1.0f + erff(x * 0.70710678118654752f)); }

__device__ __forceinline__ void dec16(const u32x4 w, f32x2 (&f)[8]) {
    f[0] = __builtin_amdgcn_cvt_pk_f32_fp8((int)w.x, false); f[1] = __builtin_amdgcn_cvt_pk_f32_fp8((int)w.x, true);
    f[2] = __builtin_amdgcn_cvt_pk_f32_fp8((int)w.y, false); f[3] = __builtin_amdgcn_cvt_pk_f32_fp8((int)w.y, true);
    f[4] = __builtin_amdgcn_cvt_pk_f32_fp8((int)w.z, false); f[5] = __builtin_amdgcn_cvt_pk_f32_fp8((int)w.z, true);
    f[6] = __builtin_amdgcn_cvt_pk_f32_fp8((int)w.w, false); f[7] = __builtin_amdgcn_cvt_pk_f32_fp8((int)w.w, true);
}
__device__ __forceinline__ void gather_token(const bf16_t* __restrict__ H, const unsigned char* __restrict__ PU, const unsigned char* __restrict__ PV, const float* __restrict__ SU, const float* __restrict__ SV,
                                             const int* __restrict__ PIDX, const float* __restrict__ PW, float* __restrict__ X, const float* __restrict__ gate  , int t, int lane) {
    f32x2 xf[2][8];
#pragma unroll
    for (int hlf = 0; hlf < 2; ++hlf)
#pragma unroll
        for (int q = 0; q < 2; ++q) { const u32x4 w = *reinterpret_cast<const u32x4*>(H + (long)t * DM + 1024 * hlf + 16 * lane + 8 * q);
            xf[hlf][4 * q + 0] = (f32x2){bflo(w.x), bfhi(w.x)}; xf[hlf][4 * q + 1] = (f32x2){bflo(w.y), bfhi(w.y)}; xf[hlf][4 * q + 2] = (f32x2){bflo(w.z), bfhi(w.z)}; xf[hlf][4 * q + 3] = (f32x2){bflo(w.w), bfhi(w.w)}; }
    f32x2 out[2][8];
#pragma unroll
    for (int hlf = 0; hlf < 2; ++hlf)
#pragma unroll
        for (int i = 0; i < 8; ++i) out[hlf][i] = (f32x2){0.f, 0.f};
    const int myidx0 = PIDX[(long)t * 128 + lane], myidx1 = PIDX[(long)t * 128 + 64 + lane];
    const float myw0 = PW[(long)t * 128 + lane], myw1 = PW[(long)t * 128 + 64 + lane];
    const float msu0 = SU[myidx0], msu1 = SU[myidx1], msv0 = SV[myidx0], msv1 = SV[myidx1];
    for (int hk = 0; hk < 128; hk += 4) {
        const int src = hk & 63; const bool lo = hk < 64;
        const int selidx = lo ? myidx0 : myidx1; const int selw = __float_as_int(lo ? myw0 : myw1), selsu = __float_as_int(lo ? msu0 : msu1), selsv = __float_as_int(lo ? msv0 : msv1);
        int e[4]; float g[4], su[4], sv[4];
#pragma unroll
        for (int k = 0; k < 4; ++k) { e[k] = __builtin_amdgcn_readlane(selidx, src + k); g[k] = __int_as_float(__builtin_amdgcn_readlane(selw, src + k));
            su[k] = __int_as_float(__builtin_amdgcn_readlane(selsu, src + k)); sv[k] = __int_as_float(__builtin_amdgcn_readlane(selsv, src + k)); }
        u32x4 uw[4][2], vw[4][2];
#pragma unroll
        for (int k = 0; k < 4; ++k) { uw[k][0] = *reinterpret_cast<const u32x4*>(PU + ((long)(lane >> 3) * NEXP + e[k]) * 128 + 16 * (lane & 7)); uw[k][1] = *reinterpret_cast<const u32x4*>(PU + ((long)(8 + (lane >> 3)) * NEXP + e[k]) * 128 + 16 * (lane & 7)); }
#pragma unroll
        for (int k = 0; k < 4; ++k) { { const u32x2 a0 = *reinterpret_cast<const u32x2*>(PV + ((long)(2 * lane) * NEXP + e[k]) * 8), a1 = *reinterpret_cast<const u32x2*>(PV + ((long)(2 * lane + 1) * NEXP + e[k]) * 8);
              const u32x2 b0 = *reinterpret_cast<const u32x2*>(PV + ((long)(128 + 2 * lane) * NEXP + e[k]) * 8), b1 = *reinterpret_cast<const u32x2*>(PV + ((long)(129 + 2 * lane) * NEXP + e[k]) * 8);
              vw[k][0] = (u32x4){a0.x, a0.y, a1.x, a1.y}; vw[k][1] = (u32x4){b0.x, b0.y, b1.x, b1.y}; } }
        float a[4];
#pragma unroll
        for (int k = 0; k < 4; ++k) { f32x2 d = (f32x2){0.f, 0.f};
#pragma unroll
            for (int hlf = 0; hlf < 2; ++hlf) { f32x2 f[8]; dec16(uw[k][hlf], f);
#pragma unroll
                for (int i = 0; i < 8; ++i) d = __builtin_elementwise_fma(f[i], xf[hlf][i], d); }
            a[k] = wave_sum(d[0] + d[1]); }
#pragma unroll
        for (int k = 0; k < 4; ++k) { const float ak = g[k] * gelu_exact(a[k] * su[k]) * sv[k]; const f32x2 a2 = (f32x2){ak, ak};
#pragma unroll
            for (int hlf = 0; hlf < 2; ++hlf) { f32x2 f[8]; dec16(vw[k][hlf], f);
#pragma unroll
                for (int i = 0; i < 8; ++i) out[hlf][i] = __builtin_elementwise_fma(f[i], a2, out[hlf][i]); } }
    }
    const float* gr = gate + (long)cond_row(t) * 12288;
#pragma unroll
    for (int hlf = 0; hlf < 2; ++hlf)
#pragma unroll
        for (int q = 0; q < 4; ++q) { const int c = 1024 * hlf + 16 * lane + 4 * q; float* xp = X + (long)t * DM + c;
            const f32x4 gv = *reinterpret_cast<const f32x4*>(gr + c); f32x4 xv = *reinterpret_cast<const f32x4*>(xp);
            xv[0] += gv[0] * out[hlf][2 * q][0]; xv[1] += gv[1] * out[hlf][2 * q][1]; xv[2] += gv[2] * out[hlf][2 * q + 1][0]; xv[3] += gv[3] * out[hlf][2 * q + 1][1];
            *reinterpret_cast<f32x4*>(xp) = xv; }
}

constexpr int SW = 128, NSL = DM / SW;
struct XInfo { int rank, xi, nx, nloc; };
__device__ __forceinline__ void upass(const bf16_t* __restrict__ H, const unsigned char* __restrict__ PU, const int* __restrict__ PIDX, const float* __restrict__ PW, const float* __restrict__ SU, const float* __restrict__ SV,
                                      float* __restrict__ DOTP, unsigned* __restrict__ PACKT, const XInfo xin, int wid, int lane) {
    const int g = lane >> 3, c = lane & 7; const int nwv = xin.nloc * 8;
    const int tlo = (int)((long)T * xin.xi / xin.nx), thi = (int)((long)T * (xin.xi + 1) / xin.nx); const int wv = tlo + xin.rank * 8 + wid;
    float* dp = DOTP;
    for (int s = 0; s < NSL; ++s) { const bool first = (s == 0), lastS = (s == NSL - 1);
        const __amdgpu_buffer_rsrc_t urs = __builtin_amdgcn_make_buffer_rsrc((void*)(PU + (long)s * NEXP * SW), 0, NEXP * SW, 0x00020000);
#define UP_ROW(e_) __builtin_bit_cast(u32x4, __builtin_amdgcn_raw_buffer_load_b128(urs, (e_) * SW + 16 * c, 0, 0))
#define UP_IDX(tt, q4) (*reinterpret_cast<const int4*>(PIDX + (long)(tt) * 128 + 16 * g + 4 * (q4)))
#define UP_X(tt, q2) (*reinterpret_cast<const u32x4*>(H + (long)(tt) * DM + SW * s + 16 * c + 8 * (q2)))
        if (wv >= thi) continue;
        u32x4 A[8], B[8]; int4 en[4]; u32x4 xn[2];
        { int4 e0[4];
#pragma unroll
          for (int q4 = 0; q4 < 4; ++q4) e0[q4] = UP_IDX(wv, q4);
          A[0] = UP_ROW(e0[0].x); A[1] = UP_ROW(e0[0].y); A[2] = UP_ROW(e0[0].z); A[3] = UP_ROW(e0[0].w); A[4] = UP_ROW(e0[1].x); A[5] = UP_ROW(e0[1].y); A[6] = UP_ROW(e0[1].z); A[7] = UP_ROW(e0[1].w);
          B[0] = UP_ROW(e0[2].x); B[1] = UP_ROW(e0[2].y); B[2] = UP_ROW(e0[2].z); B[3] = UP_ROW(e0[2].w); B[4] = UP_ROW(e0[3].x); B[5] = UP_ROW(e0[3].y); B[6] = UP_ROW(e0[3].z); B[7] = UP_ROW(e0[3].w);
          const int t1 = (wv + nwv < thi) ? wv + nwv : wv;
#pragma unroll
          for (int q4 = 0; q4 < 4; ++q4) en[q4] = UP_IDX(t1, q4);
          xn[0] = UP_X(wv, 0); xn[1] = UP_X(wv, 1); }
#pragma unroll 1
        for (int t = wv; t < thi; t += nwv) {
            const int tn = (t + nwv < thi) ? t + nwv : t, tnn = (tn + nwv < thi) ? tn + nwv : tn;
            f32x2 xf[8];
#pragma unroll
            for (int q2 = 0; q2 < 2; ++q2) { const u32x4 hw = xn[q2];
                xf[4 * q2 + 0] = (f32x2){bflo(hw.x), bfhi(hw.x)}; xf[4 * q2 + 1] = (f32x2){bflo(hw.y), bfhi(hw.y)}; xf[4 * q2 + 2] = (f32x2){bflo(hw.z), bfhi(hw.z)}; xf[4 * q2 + 3] = (f32x2){bflo(hw.w), bfhi(hw.w)}; }
            xn[0] = UP_X(tn, 0); xn[1] = UP_X(tn, 1);
            float d[16];
#pragma unroll
            for (int i = 0; i < 8; ++i) { f32x2 f[8]; dec16(A[i], f); f32x2 a = (f32x2){0.f, 0.f};
#pragma unroll
                for (int k = 0; k < 8; ++k) a = __builtin_elementwise_fma(f[k], xf[k], a);
                d[i] = a[0] + a[1]; }
            A[0] = UP_ROW(en[0].x); A[1] = UP_ROW(en[0].y); A[2] = UP_ROW(en[0].z); A[3] = UP_ROW(en[0].w); A[4] = UP_ROW(en[1].x); A[5] = UP_ROW(en[1].y); A[6] = UP_ROW(en[1].z); A[7] = UP_ROW(en[1].w);
#pragma unroll
            for (int i = 0; i < 8; ++i) { f32x2 f[8]; dec16(B[i], f); f32x2 a = (f32x2){0.f, 0.f};
#pragma unroll
                for (int k = 0; k < 8; ++k) a = __builtin_elementwise_fma(f[k], xf[k], a);
                d[8 + i] = a[0] + a[1]; }
            B[0] = UP_ROW(en[2].x); B[1] = UP_ROW(en[2].y); B[2] = UP_ROW(en[2].z); B[3] = UP_ROW(en[2].w); B[4] = UP_ROW(en[3].x); B[5] = UP_ROW(en[3].y); B[6] = UP_ROW(en[3].z); B[7] = UP_ROW(en[3].w);
#pragma unroll
            for (int q4 = 0; q4 < 4; ++q4) en[q4] = UP_IDX(tnn, q4);
            float r8[8], r4[4], r2[2];
#pragma unroll
            for (int k = 0; k < 8; ++k) { const float keep = (c & 4) ? d[k + 8] : d[k], send = (c & 4) ? d[k] : d[k + 8]; r8[k] = keep + sx<4>(send); }
#pragma unroll
            for (int k = 0; k < 4; ++k) { const float keep = (c & 2) ? r8[k + 4] : r8[k], send = (c & 2) ? r8[k] : r8[k + 4]; r4[k] = keep + sx<2>(send); }
#pragma unroll
            for (int k = 0; k < 2; ++k) { const float keep = (c & 1) ? r4[k + 2] : r4[k], send = (c & 1) ? r4[k] : r4[k + 2]; r2[k] = keep + sx<1>(send); }
            float* o = dp + (long)t * 128 + 16 * g + 2 * c;
            f32x2 acc = (f32x2){r2[0], r2[1]};
            if (!first) acc += *reinterpret_cast<const f32x2*>(o);
            if (!lastS) *reinterpret_cast<f32x2*>(o) = acc;
            else {
                const int p0 = 16 * g + 2 * c; const int2 ee = *reinterpret_cast<const int2*>(PIDX + (long)t * 128 + p0); const f32x2 gw = *reinterpret_cast<const f32x2*>(PW + (long)t * 128 + p0);
                const float a0 = gw[0] * gelu_exact(acc[0] * SU[ee.x]) * SV[ee.x], a1 = gw[1] * gelu_exact(acc[1] * SU[ee.y]) * SV[ee.y];
                u32x2 pk; pk.x = (cvt_pk_bf16(0.f, a0) & 0xffff0000u) | (unsigned)ee.x; pk.y = (cvt_pk_bf16(0.f, a1) & 0xffff0000u) | (unsigned)ee.y;
                *reinterpret_cast<u32x2*>(PACKT + ((long)(p0 >> 2) * T + t) * 4 + (p0 & 3)) = pk; }
        }
#undef UP_ROW
#undef UP_IDX
#undef UP_X
    }
}
__device__ __forceinline__ void actpass(const float* __restrict__ DOTP, const int* __restrict__ PIDX, const float* __restrict__ PW, const float* __restrict__ SU, const float* __restrict__ SV, float* __restrict__ ACT, int nx, long gt, long nt) {
    for (long i = gt; i < (long)T * 128; i += nt) { float dsum = 0.f;
        for (int x = 0; x < nx; ++x) dsum += DOTP[(long)x * T * 128 + i];
        const int e = PIDX[i]; const float av = PW[i] * gelu_exact(dsum * SU[e]) * SV[e]; const long t = i >> 7; const int pp = (int)(i & 127);
        reinterpret_cast<unsigned*>(ACT)[((long)(pp >> 2) * T + t) * 4 + (pp & 3)] = (cvt_pk_bf16(0.f, av) & 0xffff0000u) | (unsigned)e; }
}
__device__ __forceinline__ void vpass(const unsigned char* __restrict__ PV, const int* __restrict__ PIDX, const float* __restrict__ ACT, float* __restrict__ X, const float* __restrict__ gate, const XInfo xin, int wid, int lane) {
    const int g = lane >> 3, c = lane & 7; const int wv = xin.rank * 8 + wid, nwv = xin.nloc * 8;
    for (int s = xin.xi; s < NSL; s += xin.nx) {
        int4 en[4]; f32x4 an[4];
#pragma unroll
        for (int q4 = 0; q4 < 4; ++q4) { en[q4] = *reinterpret_cast<const int4*>(PIDX + (long)(wv < T ? wv : 0) * 128 + 16 * g + 4 * q4); an[q4] = *reinterpret_cast<const f32x4*>(ACT + (long)(wv < T ? wv : 0) * 128 + 16 * g + 4 * q4); }
        for (int t = wv; t < T; t += nwv) {
            int e[16]; float a[16];
#pragma unroll
            for (int q4 = 0; q4 < 4; ++q4) { e[4 * q4] = en[q4].x; e[4 * q4 + 1] = en[q4].y; e[4 * q4 + 2] = en[q4].z; e[4 * q4 + 3] = en[q4].w; a[4 * q4] = an[q4][0]; a[4 * q4 + 1] = an[q4][1]; a[4 * q4 + 2] = an[q4][2]; a[4 * q4 + 3] = an[q4][3]; }
            u32x4 w[16];
#pragma unroll
            for (int i = 0; i < 16; ++i) w[i] = *reinterpret_cast<const u32x4*>(PV + ((long)s * NEXP + e[i]) * SW + 16 * c);
            { const int tn = (t + nwv < T) ? t + nwv : t;
#pragma unroll
              for (int q4 = 0; q4 < 4; ++q4) { en[q4] = *reinterpret_cast<const int4*>(PIDX + (long)tn * 128 + 16 * g + 4 * q4); an[q4] = *reinterpret_cast<const f32x4*>(ACT + (long)tn * 128 + 16 * g + 4 * q4); } }
            f32x2 o[8];
#pragma unroll
            for (int k = 0; k < 8; ++k) o[k] = (f32x2){0.f, 0.f};
#pragma unroll
            for (int i = 0; i < 16; ++i) { f32x2 f[8]; dec16(w[i], f); const f32x2 a2 = (f32x2){a[i], a[i]};
#pragma unroll
                for (int k = 0; k < 8; ++k) o[k] = __builtin_elementwise_fma(f[k], a2, o[k]); }
            f32x2 r4[4], r2[2], r1;
#pragma unroll
            for (int k = 0; k < 4; ++k) { const f32x2 keep = (g & 4) ? o[k + 4] : o[k], send = (g & 4) ? o[k] : o[k + 4]; r4[k] = keep + (f32x2){sx<32>(send[0]), sx<32>(send[1])}; }
#pragma unroll
            for (int k = 0; k < 2; ++k) { const f32x2 keep = (g & 2) ? r4[k + 2] : r4[k], send = (g & 2) ? r4[k] : r4[k + 2]; r2[k] = keep + (f32x2){sx<16>(send[0]), sx<16>(send[1])}; }
            { const f32x2 keep = (g & 1) ? r2[1] : r2[0], send = (g & 1) ? r2[0] : r2[1]; r1 = keep + (f32x2){sx<8>(send[0]), sx<8>(send[1])}; }
            const int col = SW * s + 16 * c + 2 * g;
            const f32x2 gv = *reinterpret_cast<const f32x2*>(gate + (long)cond_row(t) * 12288 + col);
            float* xp = X + (long)t * DM + col; f32x2 xv = *reinterpret_cast<const f32x2*>(xp);
            xv += gv * r1; *reinterpret_cast<f32x2*>(xp) = xv;
        }
    }
}

__device__ __forceinline__ void vpass_lds(const unsigned char* __restrict__ PV, const unsigned* __restrict__ PACKT, float* __restrict__ X, const float* __restrict__ gate, char* lds, int bid, int nb, int s_end, int tid) {
    const int wid = tid >> 6, lane = tid & 63;
    for (int s = bid; s < s_end; s += nb) {
        __syncthreads();
        { const u32x4* src = reinterpret_cast<const u32x4*>(PV + (long)s * NEXP * 8); u32x4* dst = reinterpret_cast<u32x4*>(lds);
#pragma unroll 4
          for (int i = tid; i < NEXP * 8 / 16; i += 512) dst[i] = src[i]; }
        __syncthreads();
        u32x4 h0[8], h1[8];
        const __amdgpu_buffer_rsrc_t vrs = __builtin_amdgcn_make_buffer_rsrc((void*)PACKT, 0, (int)((size_t)T * 128 * 4), 0x00020000);
#define VP_LD(k, toff) __builtin_bit_cast(u32x4, __builtin_amdgcn_raw_buffer_load_b128(vrs, (int)(toff), (int)((size_t)(k) * T * 16), 0))
        { const unsigned toff = (unsigned)(wid * 64 + lane) * 16u;
#pragma unroll
          for (int k = 0; k < 8; ++k) h0[k] = VP_LD(k, toff);
#pragma unroll
          for (int k = 0; k < 8; ++k) h1[k] = VP_LD(8 + k, toff); }
#define VP_STEP(HB) do { _Pragma("unroll") for (int kk = 0; kk < 8; kk += 2) { unsigned pw[8]; \
            _Pragma("unroll") for (int k = 0; k < 2; ++k) { pw[4 * k] = HB[kk + k].x; pw[4 * k + 1] = HB[kk + k].y; pw[4 * k + 2] = HB[kk + k].z; pw[4 * k + 3] = HB[kk + k].w; } \
            u32x2 w[8]; \
            _Pragma("unroll") for (int k = 0; k < 8; ++k) w[k] = *reinterpret_cast<const u32x2*>(lds + (pw[k] & 0xffffu) * 8u); \
            _Pragma("unroll") for (int k = 0; k < 8; ++k) { const float a = __uint_as_float(pw[k] & 0xffff0000u); \
                const f32x2 f0 = __builtin_amdgcn_cvt_pk_f32_fp8((int)w[k].x, false), f1 = __builtin_amdgcn_cvt_pk_f32_fp8((int)w[k].x, true), f2 = __builtin_amdgcn_cvt_pk_f32_fp8((int)w[k].y, false), f3 = __builtin_amdgcn_cvt_pk_f32_fp8((int)w[k].y, true); \
                acc[0] = fmaf(a, f0[0], acc[0]); acc[1] = fmaf(a, f0[1], acc[1]); acc[2] = fmaf(a, f1[0], acc[2]); acc[3] = fmaf(a, f1[1], acc[3]); \
                acc[4] = fmaf(a, f2[0], acc[4]); acc[5] = fmaf(a, f2[1], acc[5]); acc[6] = fmaf(a, f3[0], acc[6]); acc[7] = fmaf(a, f3[1], acc[7]); } } } while (0)
#pragma unroll 1
        for (int tg = wid; tg < T / 64; tg += 8) { const int t = tg * 64 + lane; const int tgn = (tg + 8 < T / 64) ? tg + 8 : tg;
            const unsigned toff = (unsigned)t * 16u, toffn = (unsigned)(tgn * 64 + lane) * 16u;
            float acc[8];
#pragma unroll
            for (int j = 0; j < 8; ++j) acc[j] = 0.f;
            VP_STEP(h0);
#pragma unroll
            for (int k = 0; k < 8; ++k) h0[k] = VP_LD(16 + k, toff);
            VP_STEP(h1);
#pragma unroll
            for (int k = 0; k < 8; ++k) h1[k] = VP_LD(24 + k, toff);
            VP_STEP(h0);
#pragma unroll
            for (int k = 0; k < 8; ++k) h0[k] = VP_LD(k, toffn);
            VP_STEP(h1);
#pragma unroll
            for (int k = 0; k < 8; ++k) h1[k] = VP_LD(8 + k, toffn);
            const float* gr = gate + (long)cond_row(t) * 12288 + 8 * s; float* xp = X + (long)t * DM + 8 * s;
            const f32x4 g0 = *reinterpret_cast<const f32x4*>(gr), g1 = *reinterpret_cast<const f32x4*>(gr + 4);
            f32x4 x0 = *reinterpret_cast<const f32x4*>(xp), x1 = *reinterpret_cast<const f32x4*>(xp + 4);
            x0[0] += g0[0] * acc[0]; x0[1] += g0[1] * acc[1]; x0[2] += g0[2] * acc[2]; x0[3] += g0[3] * acc[3];
            x1[0] += g1[0] * acc[4]; x1[1] += g1[1] * acc[5]; x1[2] += g1[2] * acc[6]; x1[3] += g1[3] * acc[7];
            *reinterpret_cast<f32x4*>(xp) = x0; *reinterpret_cast<f32x4*>(xp + 4) = x1; }
#undef VP_STEP
#undef VP_LD
    }
    __syncthreads();
}
}
namespace ph {
__device__ __forceinline__ int gwave() { return obid() * 8 + (otid() >> 6); }
__device__ __forceinline__ int nwaves() { return ogrid() * 8; }
__device__ __forceinline__ long gthread() { return (long)obid() * 512 + otid(); }
__device__ __forceinline__ long nthreads() { return (long)ogrid() * 512; }

__device__ __forceinline__ void transpose_tile(const float* __restrict__ src, int C, int r0, int c0, bf16_t* __restrict__ dst, long dpitch, float* tile) {
    const int tid = otid();
#pragma unroll
    for (int i = 0; i < 8; ++i) { const int idx = tid + 512 * i, r = idx >> 6, c = idx & 63; tile[r * 65 + c] = src[(long)(r0 + r) * C + c0 + c]; }
    __syncthreads();
    { const int c = tid >> 3, rc = (tid & 7) * 8; float f[8];
#pragma unroll
      for (int j = 0; j < 8; ++j) f[j] = tile[(rc + j) * 65 + c];
      *reinterpret_cast<u32x4*>(dst + (long)(c0 + c) * dpitch + r0 + rc) = pack8(f); }
    __syncthreads();
}

__device__ __forceinline__ void zero_chunks(bf16_t* base, long nrows, long rowpitch, int col0, int nchunk) {
    const long total = nrows * nchunk;
    for (long i = gthread(); i < total; i += nthreads()) { const long r = i / nchunk; const int ch = (int)(i % nchunk);
        *reinterpret_cast<u32x4*>(base + r * rowpitch + col0 + ch * 8) = (u32x4){0u, 0u, 0u, 0u}; }
}

__device__ __forceinline__ void prologue(KParams& p, char* lds) {
    unsigned char* ws = optr(gp(p.ws)); const int tid = otid();
    float* tile = (float*)lds;
    { struct TJob { const float* src; bf16_t* dst; int R, C, r0, c0, perm; };
      auto decode = [&](int it) { TJob j; j.perm = 0; const int l = it / 10656; int r = it % 10656;
        if (r < 5664) { j.src = gp(p.w_in) + (long)l * DM * INW; j.R = DM; j.C = INW; j.dst = (bf16_t*)(ws + WS_WIN) + (long)l * INWP * DM; }
        else if (r < 6048) { r -= 5664; j.src = gp(p.w_uq) + (long)l * 512 * 3072; j.R = 512; j.C = 3072; j.dst = (bf16_t*)(ws + WS_WUQ) + (long)l * 3072 * 512; j.perm = 1; }
        else if (r < 6560) { r -= 6048; j.src = gp(p.w_ukv) + (long)l * 512 * 4096; j.R = 512; j.C = 4096; j.dst = (bf16_t*)(ws + WS_WUKV) + (long)l * 4096 * 512; }
        else { r -= 6560; const int m = r >> 10; r &= 1023; j.R = DM; j.C = DM;
            j.src = (m == 0 ? gp(p.w_a) : m == 1 ? gp(p.w_b) : m == 2 ? gp(p.w_o) : gp(p.w_pq)) + (long)l * DM * DM;
            j.dst = (bf16_t*)(ws + (m == 0 ? WS_WA : m == 1 ? WS_WB : m == 2 ? WS_WO : WS_WPQ)) + (long)l * DM * DM; }
        const int ntc = j.C / 64; j.r0 = (r / ntc) * 64; j.c0 = (r % ntc) * 64; return j; };
      const int NTILES = 2 * 10656, G_ = ogrid(); int it = obid(); float v[8]; TJob cur{};
      if (it < NTILES) { cur = decode(it);
#pragma unroll
        for (int i = 0; i < 8; ++i) { const int idx = tid + 512 * i, r = idx >> 6, c = idx & 63; v[i] = cur.src[(long)(cur.r0 + r) * cur.C + cur.c0 + c]; } }
      while (it < NTILES) { const int itn = it + G_; float vn[8]; TJob nxt{};
        if (itn < NTILES) { nxt = decode(itn);
#pragma unroll
            for (int i = 0; i < 8; ++i) { const int idx = tid + 512 * i, r = idx >> 6, c = idx & 63; vn[i] = nxt.src[(long)(nxt.r0 + r) * nxt.C + nxt.c0 + c]; } }
#pragma unroll
        for (int i = 0; i < 8; ++i) { const int idx = tid + 512 * i, r = idx >> 6, c = idx & 63; tile[r * 65 + c] = v[i]; }
        __syncthreads();
        { const int c = tid >> 3, rc = (tid & 7) * 8; float f[8];
#pragma unroll
          for (int jj = 0; jj < 8; ++jj) f[jj] = tile[(rc + jj) * 65 + c];
          int drow = cur.c0 + c;
          if (cur.perm) { const int gq = drow / 768, o = drow - 768 * gq, hh = o / 192, w = o - 192 * hh;
              drow = 768 * gq + (w < 128 ? 128 * hh + w : (w < 160 ? 512 + 32 * hh + (w - 128) : 640 + 32 * hh + (w - 160))); }
          *reinterpret_cast<u32x4*>(cur.dst + (long)drow * cur.R + cur.r0 + rc) = pack8(f); }
        __syncthreads();
#pragma unroll
        for (int i = 0; i < 8; ++i) v[i] = vn[i];
        cur = nxt; it = itn; } }
    for (long i = gthread(); i < 2L * 16 * 512 * 32; i += nthreads()) { const int ch = (int)(i & 31); const long row = i >> 5; const int c = (int)(row & 511), h = (int)((row >> 9) & 15), l = (int)(row >> 13);
        u32x4 w = (u32x4){0u, 0u, 0u, 0u};
        if (ch < 16) { const float* s = gp(p.w_ukv) + (((long)l * 512 + c) * 16 + h) * 256 + ch * 8; float f[8];
#pragma unroll
            for (int j = 0; j < 8; ++j) f[j] = s[j];
            w = pack8(f); }
        *reinterpret_cast<u32x4*>((bf16_t*)(ws + WS_WUK) + row * 256 + ch * 8) = w; }
    for (long i = gthread(); i < 2L * 4096; i += nthreads()) { const bool second = i >= 4096; const long j8 = (second ? i - 4096 : i) * 8; const float* s = (second ? gp(p.peer_k2) : gp(p.peer_k1)) + j8; float f[8];
#pragma unroll
        for (int j = 0; j < 8; ++j) f[j] = s[j];
        *reinterpret_cast<u32x4*>((bf16_t*)(ws + (second ? WS_PK2 : WS_PK1)) + j8) = pack8(f); }
    for (int l = 0; l < 2; ++l) zero_chunks((bf16_t*)(ws + WS_WIN) + ((long)l * INWP + INW) * DM, INWP - INW, DM, 0, DM / 8);
    for (int b = 0; b < DB; ++b) zero_chunks((bf16_t*)(ws + WS_CKA) + ((long)b * KPAD + KALL) * QLD, KPAD - KALL, QLD, 0, QLD / 8);
    zero_chunks((bf16_t*)(ws + WS_CKA), (long)DB * KPAD, QLD, 576, 8);
    zero_chunks((bf16_t*)(ws + WS_CKT), (long)DB * 512, KPAD, KALL, (KPAD - KALL) / 8);
    zero_chunks((bf16_t*)(ws + WS_QL), (long)DB * 1024, QLD, 576, 8);
    for (long i = gthread(); i < 4096L * 96; i += nthreads()) { const int pos = (int)(i / 96), k = (int)(i % 96); const bool big = k >= 32; const int fi = big ? k - 32 : k; const float d = big ? 128.f : 64.f;
        const float inv = __builtin_amdgcn_exp2f(-(2.0f * (float)fi / d) * 13.287712379549449f);
        const float ang = (float)pos * inv; double rv = (double)ang * 0.15915494309189535; rv -= floor(rv); const float fr = (float)rv;
        float* dst = big ? (float*)(ws + WS_TAB128) + ((long)pos * 64 + fi) * 2 : (float*)(ws + WS_TAB64) + ((long)pos * 32 + fi) * 2;
        dst[0] = __builtin_amdgcn_cosf(fr); dst[1] = __builtin_amdgcn_sinf(fr); }
    { float* sc = (float*)lds;
      for (int it = obid(); it < 2 * 12 * 8; it += ogrid()) { const int l = it / 96, cc = (it % 96) / 8, ks = it % 8;
        __syncthreads();
        for (int i = tid; i < NCOND * 256; i += 512) { const int r = i >> 8, k = i & 255; const float c = r < NB ? gp(p.c_prompt)[(long)r * DM + ks * 256 + k] : gp(p.c_sample)[(long)(r - NB) * DM + ks * 256 + k]; sc[i] = siluf_(c); }
        __syncthreads();
        float a0[NCOND], a1[NCOND];
#pragma unroll
        for (int r = 0; r < NCOND; ++r) { a0[r] = 0.f; a1[r] = 0.f; }
        const float* wp = gp(p.w_ada) + ((long)l * DM + ks * 256) * 12288 + cc * 1024 + 2 * tid;
#pragma unroll 1
        for (int k = 0; k < 256; k += 4) { const f32x2 w0 = *reinterpret_cast<const f32x2*>(wp), w1 = *reinterpret_cast<const f32x2*>(wp + 12288), w2 = *reinterpret_cast<const f32x2*>(wp + 2 * 12288), w3 = *reinterpret_cast<const f32x2*>(wp + 3 * 12288);
            wp += 4 * 12288;
#pragma unroll
            for (int r = 0; r < NCOND; ++r) { const f32x4 s = *reinterpret_cast<const f32x4*>(sc + r * 256 + k);
                a0[r] = fmaf(s[0], w0[0], fmaf(s[1], w1[0], fmaf(s[2], w2[0], fmaf(s[3], w3[0], a0[r]))));
                a1[r] = fmaf(s[0], w0[1], fmaf(s[1], w1[1], fmaf(s[2], w2[1], fmaf(s[3], w3[1], a1[r]))));
                if ((r % 6) == 5) __builtin_amdgcn_sched_barrier(0); } }
        float* dst = (float*)(ws + WS_ADAP) + (((long)ks * 2 + l) * NCOND) * 12288 + cc * 1024 + 2 * tid;
#pragma unroll
        for (int r = 0; r < NCOND; ++r) *reinterpret_cast<f32x2*>(dst + (long)r * 12288) = (f32x2){a0[r], a1[r]}; }
      __syncthreads(); }
}

__device__ __forceinline__ void wpq_int8(KParams& p) {
    unsigned char* ws = optr(gp(p.ws)); const int lane = otid() & 63;
    for (int r = gwave(); r < 2 * DM; r += nwaves()) { const bf16_t* src = (const bf16_t*)(ws + WS_WPQ) + (long)r * DM; float f[4][8]; float am = 0.f;
#pragma unroll
        for (int j = 0; j < 4; ++j) { unpack8(*reinterpret_cast<const u32x4*>(src + 512 * j + 8 * lane), f[j]);
#pragma unroll
            for (int i = 0; i < 8; ++i) am = fmaxf(am, fabsf(f[j][i])); }
        am = wave_max(am); const float qs = am > 0.f ? 127.0f / am : 0.f;
#pragma unroll
        for (int j = 0; j < 4; ++j) { unsigned w2[2];
#pragma unroll
            for (int hh = 0; hh < 2; ++hh) { unsigned w = 0u;
#pragma unroll
                for (int i = 0; i < 4; ++i) w |= ((unsigned)((int)__builtin_rintf(f[j][4 * hh + i] * qs) & 0xff)) << (8 * i);
                w2[hh] = w; }
            *reinterpret_cast<u32x2*>(ws + WS_WPQ8 + (long)r * DM + 512 * j + 8 * lane) = (u32x2){w2[0], w2[1]}; }
        if (lane == 0) ((float*)(ws + WS_SB8))[r] = am * (1.0f / 127.0f); }
}

__device__ __forceinline__ void ada_reduce(KParams& p) {
    unsigned char* ws = optr(gp(p.ws)); const float* ap = (const float*)(ws + WS_ADAP); float* ad = (float*)(ws + WS_ADA); const long n = 2L * NCOND * 12288;
    for (long i = gthread(); i < n; i += nthreads()) { const int l = (int)(i / (NCOND * 12288L)); const int j = (int)(i % 12288);
        float s = gp(p.b_ada)[(long)l * 12288 + j];
#pragma unroll
        for (int ks = 0; ks < 8; ++ks) s += ap[(long)ks * n + i];
        ad[i] = s; }
}

__device__ __forceinline__ void modulate(KParams& p, int l, int which) {
    const int lane = otid() & 63; unsigned char* ws = optr(gp(p.ws)); const float* X = gp(p.out); bf16_t* H = (bf16_t*)(ws + WS_H);
    const float* g = (which ? gp(p.g_ffn) : gp(p.g_mix)) + (long)l * DM; const float* ada = (const float*)(ws + WS_ADA) + (long)l * NCOND * 12288 + (which ? 3 : 0) * DM;
    for (int t = gwave(); t < T; t += nwaves()) {
        const float* xr = (l == 0 && which == 0) ? (t < TP ? gp(p.x_prompt) + (long)t * DM : gp(p.x_sample) + (long)(t - TP) * DM) : X + (long)t * DM; f32x4 v[8]; float ss = 0.f;
#pragma unroll
        for (int j = 0; j < 8; ++j) { v[j] = *reinterpret_cast<const f32x4*>(xr + 256 * j + 4 * lane); ss += v[j][0] * v[j][0] + v[j][1] * v[j][1] + v[j][2] * v[j][2] + v[j][3] * v[j][3]; }
        ss = wave_sum(ss); const float rinv = rsqrtf(ss * (1.0f / DM) + EPS);
        const float* sh = ada + (long)cond_row(t) * 12288; const float* sc = sh + DM;
#pragma unroll
        for (int j = 0; j < 8; ++j) { const int c = 256 * j + 4 * lane; const f32x4 gv = *reinterpret_cast<const f32x4*>(g + c), sv = *reinterpret_cast<const f32x4*>(sc + c), hv = *reinterpret_cast<const f32x4*>(sh + c);
            const f32x4 y = v[j] * rinv * gv * (sv + 1.0f) + hv; u32x2 w; w.x = cvt_pk_bf16(y[0], y[1]); w.y = cvt_pk_bf16(y[2], y[3]);
            *reinterpret_cast<u32x2*>(H + (long)t * DM + c) = w; v[j] = y; }
        if (which) {
            float am = 0.f;
#pragma unroll
            for (int j = 0; j < 8; ++j) am = fmaxf(am, fmaxf(fmaxf(fabsf(v[j][0]), fabsf(v[j][1])), fmaxf(fabsf(v[j][2]), fabsf(v[j][3]))));
            am = wave_max(am); const float qs = am > 0.f ? 127.0f / am : 0.f;
#pragma unroll
            for (int j = 0; j < 8; ++j) { const int c = 256 * j + 4 * lane;
                const int q0 = (int)__builtin_rintf(v[j][0] * qs), q1 = (int)__builtin_rintf(v[j][1] * qs), q2 = (int)__builtin_rintf(v[j][2] * qs), q3 = (int)__builtin_rintf(v[j][3] * qs);
                *reinterpret_cast<unsigned*>(ws + WS_H8 + (long)t * DM + c) = (unsigned)(q0 & 0xff) | ((unsigned)(q1 & 0xff) << 8) | ((unsigned)(q2 & 0xff) << 16) | ((unsigned)(q3 & 0xff) << 24); }
            if (lane == 0) ((float*)(ws + WS_SA8))[t] = am * (1.0f / 127.0f); }
    }
}

__device__ __forceinline__ void cache_convert(KParams& p, int l, char* lds, int it0, int it1, int bidx, int nb) {
    const int tid = otid(); unsigned char* ws = optr(gp(p.ws)); float* tile = (float*)lds; bf16_t* CKA = (bf16_t*)(ws + WS_CKA); bf16_t* CKT = (bf16_t*)(ws + WS_CKT);
    { const int NT_ = it1, G_ = nb; int it = it0 + bidx; float v[8];
      const float* cbase = gp(p.cache_ckv) + (long)l * DB * PAST * 512;
#define CC_SRC(itx) (cbase + (((long)((itx) >> 8)) * PAST + (((itx) >> 3) & 31) * 64) * 512 + ((itx) & 7) * 64)
      if (it < NT_) { const float* src = CC_SRC(it);
#pragma unroll
        for (int i = 0; i < 8; ++i) { const int idx = tid + 512 * i, r = idx >> 6, c = idx & 63; v[i] = src[(long)r * 512 + c]; } }
      while (it < NT_) { const int b = it >> 8, kt = (it >> 3) & 31, ct = it & 7; const int itn = it + G_; float vn[8];
        if (itn < NT_) { const float* src = CC_SRC(itn);
#pragma unroll
            for (int i = 0; i < 8; ++i) { const int idx = tid + 512 * i, r = idx >> 6, c = idx & 63; vn[i] = src[(long)r * 512 + c]; } }
#pragma unroll
        for (int i = 0; i < 8; ++i) { const int idx = tid + 512 * i, r = idx >> 6, c = idx & 63; tile[r * 65 + c] = v[i]; }
        __syncthreads();
        { const int r = tid >> 3, cc = (tid & 7) * 8; float f[8];
#pragma unroll
          for (int j = 0; j < 8; ++j) f[j] = tile[r * 65 + cc + j];
          *reinterpret_cast<u32x4*>(CKA + ((long)b * KPAD + kt * 64 + r) * QLD + ct * 64 + cc) = pack8(f);
#pragma unroll
          for (int j = 0; j < 8; ++j) f[j] = tile[(cc + j) * 65 + r];
          *reinterpret_cast<u32x4*>(CKT + ((long)b * 512 + ct * 64 + r) * KPAD + kt * 64 + cc) = pack8(f); }
        __syncthreads();
#pragma unroll
        for (int i = 0; i < 8; ++i) v[i] = vn[i];
        it = itn; }
#undef CC_SRC
    }
    for (long i = (long)it0 * 64 + (long)bidx * 512 + tid; i < (long)it1 * 64; i += (long)nb * 512) { const long row = i >> 3; const int ch = (int)(i & 7); const int b = (int)(row >> 11), k = (int)(row & 2047);
        const float* s = gp(p.cache_krope) + (((long)l * DB + b) * PAST + k) * 64 + ch * 8; float f[8];
#pragma unroll
        for (int j = 0; j < 8; ++j) f[j] = s[j];
        *reinterpret_cast<u32x4*>(CKA + ((long)b * KPAD + k) * QLD + 512 + ch * 8) = pack8(f); }
}

__device__ __forceinline__ void post_win(KParams& p, int l) {
    const int lane = otid() & 63; unsigned char* ws = optr(gp(p.ws));
    bf16_t* Y = (bf16_t*)(ws + WS_Y); bf16_t* CQN = (bf16_t*)(ws + WS_CQN); bf16_t* CKVNP = (bf16_t*)(ws + WS_CKVNP); bf16_t* KRP = (bf16_t*)(ws + WS_KRP); bf16_t* CKA = (bf16_t*)(ws + WS_CKA); bf16_t* CKT = (bf16_t*)(ws + WS_CKT);
    const float* T64 = (const float*)(ws + WS_TAB64); const float* T128 = (const float*)(ws + WS_TAB128);
    for (int t = gwave(); t < T; t += nwaves()) {
        bf16_t* y = Y + (long)t * INWP; const int pos = tok_pos(t); const bool samp = t >= TP; const int ts = t - TP, b = ts >> 6, s = ts & 63;
        { float f[8], o[8]; unpack8(*reinterpret_cast<const u32x4*>(y + C_CQ + 8 * lane), f); float ss = 0.f;
#pragma unroll
          for (int j = 0; j < 8; ++j) ss += f[j] * f[j];
          ss = wave_sum(ss); const float rinv = rsqrtf(ss * (1.0f / 512.f) + EPS); const float* g = gp(p.g_q) + (long)l * 512 + 8 * lane;
#pragma unroll
          for (int j = 0; j < 8; ++j) o[j] = f[j] * rinv * g[j];
          *reinterpret_cast<u32x4*>(CQN + (long)t * 512 + 8 * lane) = pack8(o); }
        { float f[8], o[8]; unpack8(*reinterpret_cast<const u32x4*>(y + C_CKV + 8 * lane), f); float ss = 0.f;
#pragma unroll
          for (int j = 0; j < 8; ++j) ss += f[j] * f[j];
          ss = wave_sum(ss); const float rinv = rsqrtf(ss * (1.0f / 512.f) + EPS); const float* g = gp(p.g_kv) + (long)l * 512 + 8 * lane;
#pragma unroll
          for (int j = 0; j < 8; ++j) o[j] = f[j] * rinv * g[j];
          float* od = gp(p.out) + (samp ? O_CKVS + ((long)l * TS + ts) * 512 : O_CKVP + ((long)l * TP + t) * 512) + 8 * lane;
          *reinterpret_cast<f32x4*>(od) = (f32x4){o[0], o[1], o[2], o[3]}; *reinterpret_cast<f32x4*>(od + 4) = (f32x4){o[4], o[5], o[6], o[7]};
          const u32x4 w = pack8(o);
          if (!samp) *reinterpret_cast<u32x4*>(CKVNP + (long)t * 512 + 8 * lane) = w;
          else { *reinterpret_cast<u32x4*>(CKA + ((long)b * KPAD + PAST + s) * QLD + 8 * lane) = w;
#pragma unroll
              for (int j = 0; j < 8; ++j) CKT[((long)b * 512 + 8 * lane + j) * KPAD + PAST + s] = f2bf(o[j]); } }
        if (lane < 32) { const float x1 = bf2f(y[C_KR + lane]), x2 = bf2f(y[C_KR + 32 + lane]); const float c = T64[((long)pos * 32 + lane) * 2], sn = T64[((long)pos * 32 + lane) * 2 + 1];
            const float o1 = x1 * c - x2 * sn, o2 = x1 * sn + x2 * c;
            float* od = gp(p.out) + (samp ? O_KRS + ((long)l * TS + ts) * 64 : O_KRP + ((long)l * TP + t) * 64); od[lane] = o1; od[32 + lane] = o2;
            if (!samp) { KRP[(long)t * 64 + lane] = f2bf(o1); KRP[(long)t * 64 + 32 + lane] = f2bf(o2); }
            else { bf16_t* d = CKA + ((long)b * KPAD + PAST + s) * QLD + 512; d[lane] = f2bf(o1); d[32 + lane] = f2bf(o2); } }
        { const int hh = lane >> 3, d0 = (lane & 7) * 8; const float* cs = T128 + ((long)pos * 64 + d0) * 2; float cv[8], sv[8];
#pragma unroll
          for (int j = 0; j < 4; ++j) { const f32x4 q = *reinterpret_cast<const f32x4*>(cs + 4 * j); cv[2 * j] = q[0]; sv[2 * j] = q[1]; cv[2 * j + 1] = q[2]; sv[2 * j + 1] = q[3]; }
#pragma unroll
          for (int which = 0; which < 2; ++which) { bf16_t* base = y + (which ? C_RK : C_RQ) + hh * 128 + d0; const float sca = which ? 0.08838834764831845f : 1.0f;
              float a[8], bq[8], o1[8], o2[8]; unpack8(*reinterpret_cast<const u32x4*>(base), a); unpack8(*reinterpret_cast<const u32x4*>(base + 64), bq);
#pragma unroll
              for (int j = 0; j < 8; ++j) { o1[j] = (a[j] * cv[j] - bq[j] * sv[j]) * sca; o2[j] = (a[j] * sv[j] + bq[j] * cv[j]) * sca; }
              *reinterpret_cast<u32x4*>(base) = pack8(o1); *reinterpret_cast<u32x4*>(base + 64) = pack8(o2); } }
    }
}

__device__ __forceinline__ void post_q(KParams& p) {
    const int lane = otid() & 63; unsigned char* ws = optr(gp(p.ws)); bf16_t* Q = (bf16_t*)(ws + WS_Q); bf16_t* QL = (bf16_t*)(ws + WS_QL); const float* T64 = (const float*)(ws + WS_TAB64);
    for (int t = gwave(); t < T; t += nwaves()) { const int pos = tok_pos(t); const int hd = lane >> 2, d0 = (lane & 3) * 8;
        bf16_t* base = Q + (long)t * 3072 + hd * 192 + 128 + d0; const float* cs = T64 + ((long)pos * 32 + d0) * 2; float cv[8], sv[8];
#pragma unroll
        for (int j = 0; j < 4; ++j) { const f32x4 q = *reinterpret_cast<const f32x4*>(cs + 4 * j); cv[2 * j] = q[0]; sv[2 * j] = q[1]; cv[2 * j + 1] = q[2]; sv[2 * j + 1] = q[3]; }
        float a[8], bq[8], o1[8], o2[8]; unpack8(*reinterpret_cast<const u32x4*>(base), a); unpack8(*reinterpret_cast<const u32x4*>(base + 32), bq);
#pragma unroll
        for (int j = 0; j < 8; ++j) { o1[j] = a[j] * cv[j] - bq[j] * sv[j]; o2[j] = a[j] * sv[j] + bq[j] * cv[j]; }
        const u32x4 w1 = pack8(o1), w2 = pack8(o2);
        *reinterpret_cast<u32x4*>(base) = w1; *reinterpret_cast<u32x4*>(base + 32) = w2;
        if (t >= TP) { const int ts = t - TP, b = ts >> 6, s = ts & 63; bf16_t* d = QL + ((long)b * 1024 + hd * 64 + s) * QLD + 512 + d0;
            *reinterpret_cast<u32x4*>(d) = w1; *reinterpret_cast<u32x4*>(d + 32) = w2; } }
}

__device__ __forceinline__ void softmax_rows(KParams& p) {
    const int lane = otid() & 63; unsigned char* ws = optr(gp(p.ws)); bf16_t* SP = (bf16_t*)(ws + WS_SP);
    for (int r = gwave(); r < DB * 1024; r += nwaves()) { bf16_t* row = SP + (long)r * KPAD; float v[5][8]; float mx = -3.0e38f;
#pragma unroll
        for (int j = 0; j < 5; ++j) { const int ch = lane + 64 * j;
            if (ch < KALL / 8) { unpack8(*reinterpret_cast<const u32x4*>(row + ch * 8), v[j]);
#pragma unroll
                for (int i = 0; i < 8; ++i) { v[j][i] *= MLA_SCALE; mx = fmaxf(mx, v[j][i]); } }
            else {
#pragma unroll
                for (int i = 0; i < 8; ++i) v[j][i] = -3.0e38f; } }
        mx = wave_max(mx); float sum = 0.f;
#pragma unroll
        for (int j = 0; j < 5; ++j) { const int ch = lane + 64 * j;
#pragma unroll
            for (int i = 0; i < 8; ++i) { v[j][i] = (ch < KALL / 8) ? __expf(v[j][i] - mx) : 0.f; sum += v[j][i]; } }
        sum = wave_sum(sum); const float inv = 1.0f / sum;
#pragma unroll
        for (int j = 0; j < 5; ++j) { const int ch = lane + 64 * j;
            if (ch < KPAD / 8) { float o[8];
#pragma unroll
                for (int i = 0; i < 8; ++i) o[i] = v[j][i] * inv;
                *reinterpret_cast<u32x4*>(row + ch * 8) = pack8(o); } } }
}

__device__ __forceinline__ void gnorm_gate(KParams& p, int w0, int nw) {
    const int lane = otid() & 63; unsigned char* ws = optr(gp(p.ws)); const bf16_t* OB = (const bf16_t*)(ws + WS_OB); const bf16_t* Y = (const bf16_t*)(ws + WS_Y); bf16_t* BG = (bf16_t*)(ws + WS_BG);
    for (int t = w0; t < T; t += nw) { const int c0 = (lane >> 3) * 256 + (lane & 7) * 32; float x[4][8]; float s = 0.f;
#pragma unroll
        for (int i = 0; i < 4; ++i) { unpack8(*reinterpret_cast<const u32x4*>(OB + ((long)lane * T + t) * 32 + 8 * i), x[i]);
#pragma unroll
            for (int j = 0; j < 8; ++j) s += x[i][j]; }
        s += sx<1>(s); s += sx<2>(s); s += sx<4>(s); const float mu = s * (1.0f / 256.f); float q = 0.f;
#pragma unroll
        for (int i = 0; i < 4; ++i)
#pragma unroll
            for (int j = 0; j < 8; ++j) { const float d = x[i][j] - mu; q += d * d; }
        q += sx<1>(q); q += sx<2>(q); q += sx<4>(q); const float rstd = rsqrtf(q * (1.0f / 256.f) + EPS);
#pragma unroll
        for (int i = 0; i < 4; ++i) { float g[8], o[8]; unpack8(*reinterpret_cast<const u32x4*>(Y + (long)t * INWP + C_RG + c0 + 8 * i), g);
#pragma unroll
            for (int j = 0; j < 8; ++j) o[j] = siluf_(g[j]) * (x[i][j] - mu) * rstd;
            *reinterpret_cast<u32x4*>(BG + (long)t * DM + c0 + 8 * i) = pack8(o); } }
}

__device__ __forceinline__ void peer_convert(KParams& p, int l, int r0, int r1, int w0, int nw) {
    unsigned char* ws = optr(gp(p.ws)); const int lane = otid() & 63;
    const float* su = gp(p.peer_u) + (long)l * NEXP * DM; const float* sv = gp(p.peer_v) + (long)l * NEXP * DM;
    for (int r = r0 + w0; r < r1; r += nw) { const bool second = r >= NEXP; const int row = second ? r - NEXP : r; const float* s = (second ? sv : su) + (long)row * DM;
        f32x4 v[8]; float am = 0.f;
#pragma unroll
        for (int j = 0; j < 8; ++j) { v[j] = *reinterpret_cast<const f32x4*>(s + 512 * (j >> 2) * 2 + 16 * lane + 4 * (j & 3));
            am = fmaxf(am, fmaxf(fmaxf(fabsf(v[j][0]), fabsf(v[j][1])), fmaxf(fabsf(v[j][2]), fabsf(v[j][3])))); }
        am = wave_max(am);
        float sc = 1.0f, isc = 1.0f;
        if (am > 0.f) { const int e = (int)((__float_as_uint(am) >> 23) & 0xffu) - 127;
            int k = 7 - e; k = k > 100 ? 100 : (k < -100 ? -100 : k);
            sc = __uint_as_float((unsigned)(127 + k) << 23); isc = __uint_as_float((unsigned)(127 - k) << 23); }
        unsigned w[8];
#pragma unroll
        for (int j = 0; j < 8; ++j) { int pk = __builtin_amdgcn_cvt_pk_fp8_f32(v[j][0] * sc, v[j][1] * sc, 0, false); pk = __builtin_amdgcn_cvt_pk_fp8_f32(v[j][2] * sc, v[j][3] * sc, pk, true); w[j] = (unsigned)pk; }
        if (!second) {
            unsigned char* dst = ws + WS_PU + ((long)(lane >> 3) * NEXP + row) * 128 + 16 * (lane & 7);
            *reinterpret_cast<u32x4*>(dst) = (u32x4){w[0], w[1], w[2], w[3]};
            *reinterpret_cast<u32x4*>(dst + 8L * NEXP * 128) = (u32x4){w[4], w[5], w[6], w[7]};
        } else {
            unsigned char* dst = ws + WS_PV + ((long)(2 * lane) * NEXP + row) * 8;
            *reinterpret_cast<u32x2*>(dst) = (u32x2){w[0], w[1]}; *reinterpret_cast<u32x2*>(dst + (long)NEXP * 8) = (u32x2){w[2], w[3]};
            *reinterpret_cast<u32x2*>(dst + 128L * NEXP * 8) = (u32x2){w[4], w[5]}; *reinterpret_cast<u32x2*>(dst + 129L * NEXP * 8) = (u32x2){w[6], w[7]}; }
        if (lane == 0) ((float*)(ws + (second ? WS_PSV : WS_PSU)))[row] = isc; }
}

__device__ __forceinline__ void final_norm(KParams& p) {
    const int lane = otid() & 63; float* X = gp(p.out);
    for (int t = gwave(); t < T; t += nwaves()) { float* xr = X + (long)t * DM; f32x4 v[8]; float ss = 0.f;
#pragma unroll
        for (int j = 0; j < 8; ++j) { v[j] = *reinterpret_cast<const f32x4*>(xr + 256 * j + 4 * lane); ss += v[j][0] * v[j][0] + v[j][1] * v[j][1] + v[j][2] * v[j][2] + v[j][3] * v[j][3]; }
        ss = wave_sum(ss); const float rinv = rsqrtf(ss * (1.0f / DM) + EPS);
#pragma unroll
        for (int j = 0; j < 8; ++j) { const int c = 256 * j + 4 * lane; const f32x4 gv = *reinterpret_cast<const f32x4*>(gp(p.g_final) + c); *reinterpret_cast<f32x4*>(xr + c) = v[j] * rinv * gv; } }
}
}
__global__ void __launch_bounds__(512, 2) mega_fwd(Params p_by_value_unused) {
    extern __shared__ __attribute__((aligned(16))) unsigned char shm[];
    LAS unsigned char* lds = (LAS unsigned char*)shm; char* ldsg = (char*)shm;
    if (threadIdx.x < 8) ((LAS unsigned*)(lds + LDS_BARW))[threadIdx.x] = 0u;
    __syncthreads();
    if (threadIdx.x == 0) { unsigned* tk = (unsigned*)(gp(KP.ws) + WS_CTL + CTL_RANK) + 64 * xb_xcc_id(); ((volatile LAS unsigned*)(lds + LDS_BARW))[2] = xb_add(tk, 1u); }
    const XcdBarrier bar = xcd_barrier_post((unsigned*)(gp(KP.ws) + WS_CTL), (volatile LAS unsigned*)(lds + LDS_BARW));
#define GRID_SYNC() xcd_barrier(bar)
#ifndef STOP_AT
#define STOP_AT 0
#endif
#ifdef DBG_DUMP
#define STOPCHK(n) do { if (STOP_AT == (n)) { float* xo = gp(KP.out); const bf16_t* src = (const bf16_t*)(gp(KP.ws) + DBG_DUMP); for (long i = ph::gthread(); i < (long)T * DM; i += ph::nthreads()) xo[i] = bf2f(src[i]); return; } } while (0)
#elif defined(DBG_SANITIZE)
#define STOPCHK(n) do { if (STOP_AT == (n) || (STOP_AT > 100 && l == 1 && STOP_AT - 100 == (n))) { float* xo = gp(KP.out); for (long i = ph::gthread(); i < (long)T * DM; i += ph::nthreads()) { const float v = xo[i]; if (!(v - v == 0.0f)) xo[i] = 7.0f; } return; } } while (0)
#else
#define STOPCHK(n) do { if (STOP_AT == (n) || (STOP_AT > 100 && l == 1 && STOP_AT - 100 == (n))) return; } while (0)
#endif
    using namespace pg8;
#define WSP(off) ((bf16_t*)(optr(gp(KP.ws)) + (off)))
#define H WSP(WS_H)
#define Y WSP(WS_Y)
#define CQN WSP(WS_CQN)
#define CKVNP WSP(WS_CKVNP)
#define KRP WSP(WS_KRP)
#define Q WSP(WS_Q)
#define YA WSP(WS_YA)
#define KV WSP(WS_KV)
#define SP WSP(WS_SP)
#define MIX WSP(WS_MIX)
#define OA WSP(WS_OA)
#define QP WSP(WS_QP)
#define CKA WSP(WS_CKA)
#define CKT WSP(WS_CKT)
#define QL WSP(WS_QL)
#define OL WSP(WS_OL)
#define BG WSP(WS_BG)
    int l = 0;
    ph::prologue(KP, ldsg);
#ifdef DUP_PRO
    ph::prologue(KP, ldsg);
#endif
    GRID_SYNC(); STOPCHK(1);
    if (threadIdx.x == 0) { unsigned* barw = (unsigned*)(gp(KP.ws) + WS_CTL); const unsigned me = xb_xcc_id(); unsigned nx = 0, xi = 0, nloc = 1;
        for (unsigned j = 0; j < 16; ++j) { const unsigned cn = xb_ld(&barw[XB_XCNT(j)]); if (cn) { if (j < me) ++xi; ++nx; } if (j == me) nloc = cn ? cn : 1u; }
        volatile LAS unsigned* iw = (volatile LAS unsigned*)(lds + LDS_BARW); iw[3] = xi; iw[4] = nx; iw[5] = nloc; }
    __syncthreads();
    ph::ada_reduce(KP);
    ph::wpq_int8(KP);
    GRID_SYNC(); STOPCHK(2);
    for (l = 0; l < DEPTH; ++l) {
#define WIN (WSP(WS_WIN) + (long)l * INWP * DM)
#define WUQ (WSP(WS_WUQ) + (long)l * 3072 * 512)
#define WUKV (WSP(WS_WUKV) + (long)l * 4096 * 512)
#define WUK (WSP(WS_WUK) + (long)l * 16 * 512 * 256)
#define WA (WSP(WS_WA) + (long)l * DM * DM)
#define WB (WSP(WS_WB) + (long)l * DM * DM)
#define WO (WSP(WS_WO) + (long)l * DM * DM)
#define WPQ (WSP(WS_WPQ) + (long)l * DM * DM)
#define ADA ((const float*)(optr(gp(KP.ws)) + WS_ADA) + (long)l * NCOND * 12288)
        ph::modulate(KP, l, 0);
        ph::cache_convert(KP, l, ldsg, l == 0 ? 0 : 4096, 8192, obid(), ogrid());
        GRID_SYNC(); STOPCHK(3);
        { Sched<0> S; S.init(T / 256, INWP / 256, (T / 256) * (INWP / 256), DM, DM); gemm_phase(lds, Gemm{H, WIN, DM, DM, DM}, S, EpiBf16{Y, INWP, 0}); }
#ifdef DUP_WIN
        { Sched<0> S; S.init(T / 256, INWP / 256, (T / 256) * (INWP / 256), DM, DM); gemm_phase(lds, Gemm{H, WIN, DM, DM, DM}, S, EpiBf16{Y, INWP, 0}); }
#endif
        GRID_SYNC(); STOPCHK(4);
        ph::post_win(KP, l);
        GRID_SYNC(); STOPCHK(5);
        { Sched<0> S; S.init(T / 256, 3072 / 256, (T / 256) * 12, 512, 512); gemm_phase(lds, Gemm{CQN, WUQ, 512, 512, 512}, S, EpiQ{Q, QL, (const float*)(optr(gp(KP.ws)) + WS_TAB64)}); }
        { Sched<0> S; S.init(TP / 256, 4096 / 256, (TP / 256) * 16, 512, 512); gemm_phase(lds, Gemm{CKVNP, WUKV, 512, 512, 512}, S, EpiBf16{KV, 4096, 0}); }
        GRID_SYNC(); STOPCHK(6);
#ifndef DUP_ATTN
#define DUP_ATTN 1
#endif
#ifndef DUP_RET
#define DUP_RET 1
#endif
#ifndef DUP_GATHER
#define DUP_GATHER 0
#endif
#pragma unroll 1
        for (int rep_ = 0; rep_ < DUP_ATTN; ++rep_)
        { for (int u = obid(); u < 512; u += ogrid()) { const int c = u & 255, i = u >> 8, xcd = c & 7, slot = c >> 3; const int bh = xcd * 4 + (slot >> 3) + 32 * i, pr = slot & 7, b = bh >> 4, h = bh & 15;
#pragma unroll 1
              for (int z = 0; z < 2; ++z) { const int qb = z ? 15 - pr : pr; const long tok0 = (long)b * SEQ + 256 * qb;
                  att::attn_block(Q + tok0 * 3072 + h * 192, KV + (long)b * SEQ * 4096 + h * 256, KRP + (long)b * SEQ * 64, KV + (long)b * SEQ * 4096 + h * 256 + 128, OA + tok0 * DM + h * 128, qb, ldsg); } } }
        { Sched<1> S; S.init(0, 0, 256, 3072, 256); gemm_phase(lds, Gemm{Q, WUK, 256, 3072, 256}, S, EpiRowMap<1>{QL, nullptr}); }
        GRID_SYNC(); STOPCHK(8);
        { Sched<2> S; S.init(0, 0, DB * 36, QLD, QLD); gemm_phase(lds, Gemm{QL, CKA, QLD, QLD, QLD}, S, EpiExp{SP, (float*)(optr(gp(KP.ws)) + WS_CTL + CTL_RSUM) + (long)l * 32768}); }
        GRID_SYNC(); STOPCHK(9);
        { Sched<3> S; S.init(0, 0, 256, KPAD, KPAD); gemm_phase(lds, Gemm{SP, CKT, 2176, KPAD, KPAD}, S, EpiRowMap<3>{OL, (const float*)(optr(gp(KP.ws)) + WS_CTL + CTL_RSUM) + (long)l * 32768}); }
        GRID_SYNC(); STOPCHK(11);
        { Sched<4> S; S.init(0, 0, 128, 512, 512); gemm_phase(lds, Gemm{OL, WUKV, 512, 512, 512}, S, EpiOV{OA}); }
#pragma unroll 1
        for (int rep_ = 0; rep_ < DUP_RET; ++rep_)
        for (int u = obid(); u < 256 + DB * 64; u += ogrid()) ret::unit(KP, l, u, ldsg);
#ifdef DUP_RETP
        for (int u = obid(); u < 256; u += ogrid()) ret::unit(KP, l, u, ldsg);
#endif
        GRID_SYNC(); STOPCHK(12);
        { Sched<0> S; S.init(T / 256, DM / 256, (T / 256) * 8, DM, DM); gemm_phase(lds, Gemm{OA, WA, DM, DM, DM}, S, EpiBf16{YA, DM, 0}); }
        { const int G_ = ogrid(), rem_ = ((T / 256) * 8) % G_; const int b_ = obid();
          if (rem_ == 0) ph::gnorm_gate(KP, ph::gwave(), ph::nwaves());
          else if (b_ >= rem_) ph::gnorm_gate(KP, (b_ - rem_) * 8 + (otid() >> 6), (G_ - rem_) * 8); }
#ifdef DUP_WA
        { Sched<0> S; S.init(T / 256, DM / 256, (T / 256) * 8, DM, DM); gemm_phase(lds, Gemm{OA, WA, DM, DM, DM}, S, EpiBf16{YA, DM, 0}); }
#endif
        GRID_SYNC(); STOPCHK(14);
        { Sched<0> S; S.init(T / 256, DM / 256, (T / 256) * 8, DM, DM); gemm_phase(lds, Gemm{BG, WB, DM, DM, DM}, S, EpiMix{Y, YA, MIX}); }
        { const int G_ = ogrid(), rem_ = ((T / 256) * 8) % G_; const int b_ = obid();
          if (rem_ == 0) ph::peer_convert(KP, l, 0, NEXP, ph::gwave(), ph::nwaves());
          else if (b_ >= rem_) ph::peer_convert(KP, l, 0, NEXP, (b_ - rem_) * 8 + (otid() >> 6), (G_ - rem_) * 8); }
        GRID_SYNC(); STOPCHK(15);
        { Sched<0> S; S.init(T / 256, DM / 256, (T / 256) * 8, DM, DM); gemm_phase(lds, Gemm{MIX, WO, DM, DM, DM}, S, EpiRes{gp(KP.out), ADA + 2 * DM, l == 0 ? gp(KP.x_prompt) : gp(KP.out), l == 0 ? gp(KP.x_sample) : gp(KP.out) + (long)TP * DM}); }
        { const int G_ = ogrid(), rem_ = ((T / 256) * 8) % G_; const int b_ = obid();
          if (rem_ == 0) ph::peer_convert(KP, l, NEXP, 2 * NEXP, ph::gwave(), ph::nwaves());
          else if (b_ >= rem_) ph::peer_convert(KP, l, NEXP, 2 * NEXP, (b_ - rem_) * 8 + (otid() >> 6), (G_ - rem_) * 8); }
        GRID_SYNC(); STOPCHK(16);
        ph::modulate(KP, l, 1);
        GRID_SYNC(); STOPCHK(17);
        { Sched<0> S; S.init(T / 256, DM / 256, (T / 256) * 8, DM / 2, DM / 2);
          unsigned char* ws8 = optr(gp(KP.ws));
          gemm_phase<EpiQ8, Sched<0>, true>(lds, Gemm{(const bf16_t*)(ws8 + WS_H8), (const bf16_t*)(ws8 + WS_WPQ8 + (long)l * DM * DM), DM / 2, DM / 2, DM / 2}, S, EpiQ8{QP, (const float*)(ws8 + WS_SA8), (const float*)(ws8 + WS_SB8) + (long)l * DM}); }
        if (l + 1 < DEPTH) { const int G_ = ogrid(), rem_ = ((T / 256) * 8) % G_; const int b_ = obid();
          if (rem_ == 0) ph::cache_convert(KP, l + 1, ldsg, 0, 4096, b_, G_);
          else if (b_ >= rem_) ph::cache_convert(KP, l + 1, ldsg, 0, 4096, b_ - rem_, G_ - rem_); }
        GRID_SYNC(); STOPCHK(18);
        { const int tid_ = otid(); const int lane = tid_ & 63; float* strip = (float*)ldsg + tid_ * 33; unsigned char* ws = optr(gp(KP.ws));
          const bf16_t* k1g = (const bf16_t*)(ws + WS_PK1) + (long)l * 128 * 128; const bf16_t* k2g = (const bf16_t*)(ws + WS_PK2) + (long)l * 128 * 128;
          bf16_t* k1 = (bf16_t*)(ldsg + 512 * 33 * 4 + 64); bf16_t* k2 = k1 + 128 * peer::KPITCH;
          for (int i = tid_; i < 2 * 128 * 16; i += 512) { const int which = i >> 11, r = (i >> 4) & 127, ch = i & 15;
              *reinterpret_cast<u32x4*>((which ? k2 : k1) + r * peer::KPITCH + ch * 8) = *reinterpret_cast<const u32x4*>((which ? k2g : k1g) + r * 128 + ch * 8); }
          __syncthreads();
          for (int wu = ph::gwave(); wu < (T / 32) * PH; wu += ph::nwaves()) peer::select_unit(QP, k1, k2, (int*)(ws + WS_PIDX), (float*)(ws + WS_PW), (wu >> 3) * 32, wu & 7, lane, strip);
#ifdef DUP_SEL
          for (int wu = ph::gwave(); wu < (T / 32) * PH; wu += ph::nwaves()) peer::select_unit(QP, k1, k2, (int*)(ws + WS_PIDX), (float*)(ws + WS_PW), (wu >> 3) * 32, wu & 7, lane, strip);
#endif
        }
        GRID_SYNC(); STOPCHK(19);
        { const int tid_ = otid(); const int lane = tid_ & 63, wid = tid_ >> 6; unsigned char* ws = optr(gp(KP.ws));
          volatile LAS unsigned* iw = (volatile LAS unsigned*)(lds + LDS_BARW); peer::XInfo xin; xin.rank = __builtin_amdgcn_readfirstlane((int)iw[2]); xin.xi = __builtin_amdgcn_readfirstlane((int)iw[3]); xin.nx = __builtin_amdgcn_readfirstlane((int)iw[4]); xin.nloc = __builtin_amdgcn_readfirstlane((int)iw[5]);
          if (xin.nx >= 1 && xin.nx <= 8) {
              peer::upass(H, (const unsigned char*)(ws + WS_PU), (const int*)(ws + WS_PIDX), (const float*)(ws + WS_PW), (const float*)(ws + WS_PSU), (const float*)(ws + WS_PSV), (float*)(ws + WS_DOTP), (unsigned*)(ws + WS_ACT), xin, wid, lane);
              GRID_SYNC();
              int vs0_, vsn_, vse_;
              if ((256 % xin.nx) == 0) { const int spx = 256 / xin.nx; vs0_ = xin.xi * spx + xin.rank; vsn_ = xin.nloc; vse_ = (xin.xi + 1) * spx; }
              else { vs0_ = obid(); vsn_ = ogrid(); vse_ = 256; }
              peer::vpass_lds((const unsigned char*)(ws + WS_PV), (const unsigned*)(ws + WS_ACT), gp(KP.out), ADA + 5 * DM, ldsg, vs0_, vsn_, vse_, tid_);
#ifdef DUP_VP
              peer::vpass_lds((const unsigned char*)(ws + WS_PV), (const unsigned*)(ws + WS_ACT), (float*)(ws + WS_OB), ADA + 5 * DM, ldsg, vs0_, vsn_, vse_, tid_);
#endif
          } else {
              for (int t = ph::gwave(); t < T; t += ph::nwaves()) peer::gather_token(H, (const unsigned char*)(ws + WS_PU), (const unsigned char*)(ws + WS_PV), (const float*)(ws + WS_PSU), (const float*)(ws + WS_PSV), (const int*)(ws + WS_PIDX), (const float*)(ws + WS_PW), gp(KP.out), ADA + 5 * DM, t, lane);
          } }
        GRID_SYNC(); STOPCHK(20);
    }
    ph::final_norm(KP);
}

extern "C" void kernel_launch(void* const* d_in, const int* in_sizes, int n_in, void* d_out, int out_size, void* d_ws, size_t ws_size, hipStream_t stream) {
    static int grid = 0;
    if (grid == 0) {
        if (n_in != 25 || out_size != (int)O_END || ws_size < WS_END) { fprintf(stderr, "kernel_launch: shape mismatch: n_in %d out %d (want %ld) ws %zu (want >= %zu)\n", n_in, out_size, O_END, ws_size, (size_t)WS_END); grid = -1; return; }
        int dev = 0, cus = 0, per_cu = 0;
        if (hipGetDevice(&dev) != hipSuccess || hipDeviceGetAttribute(&cus, hipDeviceAttributeMultiprocessorCount, dev) != hipSuccess) { fprintf(stderr, "kernel_launch: device query failed\n"); grid = -1; return; }
        if (hipFuncSetAttribute((const void*)mega_fwd, hipFuncAttributeMaxDynamicSharedMemorySize, LDS_BYTES) != hipSuccess) { fprintf(stderr, "kernel_launch: hipFuncSetAttribute failed\n"); grid = -1; return; }
        if (hipOccupancyMaxActiveBlocksPerMultiprocessor(&per_cu, (const void*)mega_fwd, 512, LDS_BYTES) != hipSuccess || per_cu < 1) { fprintf(stderr, "kernel_launch: occupancy query says %d blocks per CU\n", per_cu); grid = -1; return; }
        grid = cus;
#ifdef FORCE_GRID
        grid = FORCE_GRID;
#endif
    }
    if (grid < 0) return;
    (void)hipMemsetAsync((char*)d_ws + WS_CTL, 0, CTL_BYTES, stream);
    Params p{};
    const float* const* in = (const float* const*)d_in;
    p.x_prompt = in[0]; p.x_sample = in[1]; p.c_prompt = in[2]; p.c_sample = in[3]; p.cache_ckv = in[4]; p.cache_krope = in[5]; p.state_ret = in[6]; p.w_ada = in[7]; p.b_ada = in[8];
    p.g_mix = in[9]; p.g_ffn = in[10]; p.w_in = in[11]; p.g_q = in[12]; p.w_uq = in[13]; p.g_kv = in[14]; p.w_ukv = in[15]; p.w_a = in[16]; p.w_b = in[17]; p.w_o = in[18]; p.w_pq = in[19];
    p.peer_k1 = in[20]; p.peer_k2 = in[21]; p.peer_u = in[22]; p.peer_v = in[23]; p.g_final = in[24];
    p.out = (float*)d_out; p.ws = (unsigned char*)d_ws;
    for (int h = 0; h < 8; ++h) p.lg[h] = (float)log1p(-pow(2.0, -5.0 - (double)h));
    p.grid = grid; p.pad_ = 0;
    hipLaunchKernelGGL(mega_fwd, dim3(grid), dim3(512), LDS_BYTES, stream, p);
    const hipError_t le = hipGetLastError();
    if (le != hipSuccess) fprintf(stderr, "kernel_launch: launch failed: %s\n", hipGetErrorName(le));
}
```

```cpp
#include <hip/hip_runtime.h>
#include <cstdio>
#include <cstdint>
#include <cmath>

#define LAS __attribute__((address_space(3)))
typedef unsigned short bf16_t;
typedef short bf16x8 __attribute__((ext_vector_type(8)));
typedef float f32x4 __attribute__((ext_vector_type(4)));
typedef float f32x2 __attribute__((ext_vector_type(2)));
typedef float f32x16 __attribute__((ext_vector_type(16)));
typedef unsigned u32x4 __attribute__((ext_vector_type(4)));
typedef unsigned u32x2 __attribute__((ext_vector_type(2)));
typedef short s16x4 __attribute__((ext_vector_type(4)));
typedef int i32x4 __attribute__((ext_vector_type(4)));

constexpr int DM = 2048, NB = 4, SEQ = 4096, DEPTH = 2, DB = 32, DS = 64, PAST = 2048;
constexpr int TP = NB * SEQ, TS = DB * DS, T = TP + TS;
constexpr int NCOND = NB + DB;
constexpr int QLORA = 512, KVLORA = 512, ROPE = 64, NOPE = 128, VD = 128, MH = 16, QKD = 192;
constexpr int RH = 8, RQK = 128, RV = 256;
constexpr int PH = 8, NKEYS = 128, NEXP = 16384, PTOPK = 16;
constexpr int INW = 11328, INWP = 11520;
constexpr int C_CQ = 0, C_CKV = 512, C_KR = 1024, C_RQ = 1088, C_RK = 2112, C_RV = 3136, C_RG = 5184, C_GA = 7232, C_GB = 9280;
constexpr int KALL = PAST + DS;
constexpr int KPAD = 2304;
constexpr int QLD = 640;
constexpr float EPS = 1e-6f;
constexpr float MLA_SCALE = 0.07216878364870322f;

constexpr long O_Y = 0;
constexpr long O_CKVP = (long)T * DM;
constexpr long O_KRP = O_CKVP + 2L * TP * 512;
constexpr long O_RETP = O_KRP + 2L * TP * 64;
constexpr long O_CKVS = O_RETP + 2L * NB * RH * RQK * RV;
constexpr long O_KRS = O_CKVS + 2L * TS * 512;
constexpr long O_RETS = O_KRS + 2L * TS * 64;
constexpr long O_END = O_RETS + 2L * DB * RH * RQK * RV;

constexpr size_t al256(size_t x) { return (x + 255) / 256 * 256; }
constexpr size_t WS_CTL = 0;
constexpr size_t CTL_BYTES = 65536 + 2UL * 32768 * 4;
constexpr size_t CTL_RSUM = 65536;
constexpr size_t WS_TAB64 = WS_CTL + CTL_BYTES;
constexpr size_t WS_TAB128 = WS_TAB64 + 4096UL * 32 * 2 * 4;
constexpr size_t WS_ADA = WS_TAB128 + 4096UL * 64 * 2 * 4;
constexpr size_t WS_ADAP = WS_ADA + 2UL * NCOND * 12288 * 4;
constexpr size_t WS_WIN = WS_ADAP + 8UL * 2 * NCOND * 12288 * 4;
constexpr size_t WS_WUQ = WS_WIN + 2UL * INWP * DM * 2;
constexpr size_t WS_WUKV = WS_WUQ + 2UL * 3072 * 512 * 2;
constexpr size_t WS_WUK = WS_WUKV + 2UL * 4096 * 512 * 2;
constexpr size_t WS_WA = WS_WUK + 2UL * 16 * 512 * 256 * 2;
constexpr size_t WS_WB = WS_WA + 2UL * DM * DM * 2;
constexpr size_t WS_WO = WS_WB + 2UL * DM * DM * 2;
constexpr size_t WS_WPQ = WS_WO + 2UL * DM * DM * 2;
constexpr size_t WS_PK1 = WS_WPQ + 2UL * DM * DM * 2;
constexpr size_t WS_PK2 = WS_PK1 + 2UL * 128 * 128 * 2;
constexpr size_t WS_H = WS_PK2 + 2UL * 128 * 128 * 2;
constexpr size_t WS_Y = WS_H + (size_t)T * DM * 2;
constexpr size_t WS_CQN = WS_Y + (size_t)T * INWP * 2;
constexpr size_t WS_CKVNP = WS_CQN + (size_t)T * 512 * 2;
constexpr size_t WS_KRP = WS_CKVNP + (size_t)TP * 512 * 2;
constexpr size_t WS_Q = WS_KRP + (size_t)TP * 64 * 2;
constexpr size_t WS_YA = WS_Q;
constexpr size_t WS_KV = WS_Q + (size_t)T * 3072 * 2 + 4096;
constexpr size_t WS_SP = WS_KV;
constexpr size_t WS_MIX = WS_KV;
constexpr size_t WS_OA = WS_KV + 32UL * 1024 * KPAD * 2;
constexpr size_t WS_QP = WS_OA;
constexpr size_t WS_CKA = WS_OA + (size_t)T * DM * 2;
constexpr size_t WS_CKT = WS_CKA + 32UL * KPAD * QLD * 2;
constexpr size_t WS_QL = WS_CKT + 32UL * 512 * KPAD * 2;
constexpr size_t WS_OL = WS_QL + 32UL * 1024 * QLD * 2;
constexpr size_t WS_OB = WS_OL + 16UL * 2048 * 512 * 2;
constexpr size_t WS_BG = WS_OB + (size_t)T * DM * 2;
constexpr size_t WS_PIDX = WS_BG + (size_t)T * DM * 2;
constexpr size_t WS_PW = WS_PIDX + (size_t)T * 128 * 4;
constexpr size_t WS_PU = WS_PW + (size_t)T * 128 * 4;
constexpr size_t WS_PV = WS_PU + (size_t)NEXP * DM;
constexpr size_t WS_PSU = WS_PV + (size_t)NEXP * DM;
constexpr size_t WS_PSV = WS_PSU + (size_t)NEXP * 4;
constexpr size_t WS_WPQ8 = WS_PSV + (size_t)NEXP * 4;
constexpr size_t WS_SB8 = WS_WPQ8 + 2UL * DM * DM;
constexpr size_t WS_SA8 = WS_SB8 + 2UL * DM * 4;
constexpr int NB8 = 27;
constexpr size_t WS_WIN8 = WS_SA8 + al256((size_t)T * 4);
constexpr size_t WS_SBW = WS_WIN8 + (size_t)NB8 * 256 * DM;
constexpr size_t WS_END = WS_SBW + al256((size_t)INWP * 4);
constexpr size_t WS_H8 = WS_OB;
static_assert((size_t)TP * 4096 * 2 <= 32UL * 1024 * KPAD * 2, "KV fits in the SP region");
static_assert(WS_END <= 1608000000UL, "workspace map too large");
static_assert(WS_WIN % 256 == 0 && WS_H % 256 == 0 && WS_Y % 256 == 0 && WS_Q % 256 == 0 && WS_KV % 256 == 0 && WS_CKA % 256 == 0, "alignment");

constexpr int LDS_BYTES = 147456;
constexpr int LDS_BARW = LDS_BYTES - 32;
constexpr size_t CTL_RANK = 16384;
constexpr size_t WS_DOTP = WS_Q;
constexpr size_t WS_ACT = WS_DOTP + 8UL * T * 128 * 4;
constexpr size_t WS_PIDXT = WS_ACT + (size_t)T * 128 * 4;
static_assert(WS_PIDXT + (size_t)T * 128 * 4 <= WS_KV, "PEER scratch fits in the Q region");

struct Params {
    const float *x_prompt, *x_sample, *c_prompt, *c_sample, *cache_ckv, *cache_krope, *state_ret, *w_ada, *b_ada, *g_mix, *g_ffn, *w_in, *g_q, *w_uq, *g_kv, *w_ukv,
                *w_a, *w_b, *w_o, *w_pq, *peer_k1, *peer_k2, *peer_u, *peer_v, *g_final;
    float* out; unsigned char* ws;
    float lg[8];
    int grid; int pad_;
};

typedef const __attribute__((address_space(4))) Params KParams;
__device__ __forceinline__ KParams* okarg() {
    const uintptr_t k = (uintptr_t)__builtin_amdgcn_kernarg_segment_ptr();
    unsigned lo = (unsigned)k, hi = (unsigned)(k >> 32);
    asm volatile("" : "+s"(lo), "+s"(hi)); return (KParams*)(((uintptr_t)hi << 32) | lo); }
#define KP (*okarg())
__device__ __forceinline__ int ogrid() { return KP.grid; }
__device__ __forceinline__ int obid() { int b = (int)blockIdx.x; asm volatile("" : "+s"(b) :: "memory"); return b; }
__device__ __forceinline__ int otid() { int t = (int)threadIdx.x; asm volatile("" : "+v"(t) :: "memory"); return t; }
template <class P> __device__ __forceinline__ P* gp(P* p) { return (P*)(__attribute__((address_space(1))) P*)(uintptr_t)p; }
template <class P> __device__ __forceinline__ P* optr(P* p) {
    unsigned lo = __builtin_amdgcn_readfirstlane((unsigned)(uintptr_t)p), hi = __builtin_amdgcn_readfirstlane((unsigned)((uintptr_t)p >> 32));
    asm volatile("" : "+s"(lo), "+s"(hi)); return gp((P*)(((uintptr_t)hi << 32) | lo)); }
typedef __bf16 bf16v2_t __attribute__((ext_vector_type(2)));
__device__ __forceinline__ unsigned cvt_pk_bf16(float lo, float hi) { f32x2 v = {lo, hi}; bf16v2_t r = __builtin_convertvector(v, bf16v2_t); return __builtin_bit_cast(unsigned, r); }
__device__ __forceinline__ bf16_t f2bf(float f) { return (bf16_t)(cvt_pk_bf16(f, 0.f) & 0xffffu); }
__device__ __forceinline__ float bf2f(bf16_t b) { return __uint_as_float(((unsigned)b) << 16); }
__device__ __forceinline__ float bflo(unsigned w) { return __uint_as_float(w << 16); }
__device__ __forceinline__ float bfhi(unsigned w) { return __uint_as_float(w & 0xffff0000u); }
__device__ __forceinline__ void unpack8(const u32x4 w, float (&f)[8]) { f[0] = bflo(w.x); f[1] = bfhi(w.x); f[2] = bflo(w.y); f[3] = bfhi(w.y); f[4] = bflo(w.z); f[5] = bfhi(w.z); f[6] = bflo(w.w); f[7] = bfhi(w.w); }
__device__ __forceinline__ u32x4 pack8(const float (&f)[8]) { u32x4 w; w.x = cvt_pk_bf16(f[0], f[1]); w.y = cvt_pk_bf16(f[2], f[3]); w.z = cvt_pk_bf16(f[4], f[5]); w.w = cvt_pk_bf16(f[6], f[7]); return w; }
template <int K> __device__ __forceinline__ float sx(float v) {
    if constexpr (K == 32) { const auto rr = __builtin_amdgcn_permlane32_swap(__float_as_uint(v), __float_as_uint(v), false, false); return __uint_as_float((otid() & 32) ? rr[0] : rr[1]); }
    else return __int_as_float(__builtin_amdgcn_ds_swizzle(__float_as_int(v), (K << 10) | 0x1F));
}
__device__ __forceinline__ float wave_sum(float v) { v += sx<32>(v); v += sx<16>(v); v += sx<8>(v); v += sx<4>(v); v += sx<2>(v); v += sx<1>(v); return v; }
__device__ __forceinline__ float wave_max(float v) { v = fmaxf(v, sx<32>(v)); v = fmaxf(v, sx<16>(v)); v = fmaxf(v, sx<8>(v)); v = fmaxf(v, sx<4>(v)); v = fmaxf(v, sx<2>(v)); v = fmaxf(v, sx<1>(v)); return v; }
__device__ __forceinline__ float sigmoidf_(float x) { return 1.0f / (1.0f + __expf(-x)); }
__device__ __forceinline__ float siluf_(float x) { return x / (1.0f + __expf(-x)); }
__device__ __forceinline__ int cond_row(int t) { return t < TP ? (t >> 12) : NB + ((t - TP) >> 6); }
__device__ __forceinline__ int tok_pos(int t) { return t < TP ? (t & 4095) : PAST + ((t - TP) & 63); }

#define XB_TMO      128
#define XB_XCNT(j)  (256  + 64 * (j))
#define XB_XSUB(j)  (1280 + 64 * (j))
#define XB_XGEN(j)  (2304 + 64 * (j))
#define XB_TOP      3328
#define XB_TOPGEN   3392
#define XCD_BAR_WORDS 3456
#define XB_SPIN_CAP (1u << 22)
__device__ __forceinline__ unsigned xb_ld(unsigned* p)              { return __hip_atomic_load(p, __ATOMIC_RELAXED, __HIP_MEMORY_SCOPE_AGENT); }
__device__ __forceinline__ unsigned xb_add(unsigned* p, unsigned v) { return __hip_atomic_fetch_add(p, v, __ATOMIC_RELAXED, __HIP_MEMORY_SCOPE_AGENT); }
__device__ __forceinline__ unsigned xb_xcc_id() { return (unsigned)__builtin_amdgcn_s_getreg((3 << 11) | 20) & 0xFu; }
#define XB_SPIN(cond, bar) do { unsigned _sp = 0; while (cond) { __builtin_amdgcn_s_sleep(1); \
    if ((++_sp & 255u) == 0u) { if (xb_ld(&(bar)[XB_TMO])) break; if (_sp > XB_SPIN_CAP) { atomicAdd(&(bar)[XB_TMO], 1u); break; } } } } while (0)
struct XcdBarrier { unsigned* bar; unsigned x; volatile LAS unsigned* st; };
__device__ __forceinline__ XcdBarrier xcd_barrier_post(unsigned* bar, volatile LAS unsigned* st) {
    XcdBarrier b; b.bar = bar; b.x = xb_xcc_id(); b.st = st;
    if (threadIdx.x == 0) (void)xb_add(&bar[XB_XCNT(b.x)], 1u);
    return b;
}
__device__ __forceinline__ void xcd_barrier_complete(unsigned* bar, unsigned x, unsigned& nloc, unsigned& nx) {
    const unsigned G = (unsigned)KP.grid;
    unsigned sum, cnt, mine, sp = 0u;
    for (;;) {
        sum = 0u; cnt = 0u; mine = 0u;
#pragma unroll
        for (unsigned j = 0; j < 16; ++j) { const unsigned c = xb_ld(&bar[XB_XCNT(j)]); sum += c; cnt += (c > 0u) ? 1u : 0u; mine = (j == x) ? c : mine; }
        if (sum == G) break;
        __builtin_amdgcn_s_sleep(1);
        if ((++sp & 255u) == 0u) { if (xb_ld(&bar[XB_TMO])) break; if (sp > XB_SPIN_CAP) { atomicAdd(&bar[XB_TMO], 1u); break; } }
    }
    nloc = mine > 0u ? mine : 1u; nx = cnt > 0u ? cnt : 1u;
}
__device__ __forceinline__ void xcd_barrier(const XcdBarrier& b) {
    asm volatile("s_waitcnt vmcnt(0)" ::: "memory");
    __syncthreads();
    if (otid() == 0) {
        unsigned* bar = (unsigned*)(gp(KP.ws) + WS_CTL);
        unsigned bx = xb_xcc_id(); asm volatile("" : "+s"(bx));
        __builtin_amdgcn_s_waitcnt(0);
        unsigned nloc = b.st[0], nx = b.st[1];
        if (nloc == 0u) { xcd_barrier_complete(bar, bx, nloc, nx); b.st[0] = nloc; b.st[1] = nx; }
        const unsigned old = xb_add(&bar[XB_XSUB(bx)], 1u);
        const unsigned gen = old / nloc;
        if (old + 1u == (gen + 1u) * nloc) {
            __builtin_amdgcn_fence(__ATOMIC_RELEASE, "agent");
            asm volatile("s_waitcnt vmcnt(0)" ::: "memory");
            const unsigned og = xb_add(&bar[XB_TOP], 1u);
            const unsigned tg = og / nx;
            if (og + 1u == (tg + 1u) * nx) xb_add(&bar[XB_TOPGEN], 1u);
            else XB_SPIN(xb_ld(&bar[XB_TOPGEN]) == tg, bar);
            __builtin_amdgcn_fence(__ATOMIC_ACQUIRE, "agent");
            xb_add(&bar[XB_XGEN(bx)], 1u);
            asm volatile("s_waitcnt vmcnt(0)" ::: "memory");
        } else {
            XB_SPIN(xb_ld(&bar[XB_XGEN(bx)]) == gen, bar);
            __builtin_amdgcn_fence(__ATOMIC_ACQUIRE, "agent");
            asm volatile("s_waitcnt vmcnt(0)" ::: "memory");
        }
    }
    __syncthreads();
}
namespace pg8 {
constexpr int BM = 256, BK = 64, HALF = 128, HTB = HALF * BK * 2, STAGE_BYTES = 8 * HTB, NXCD = 8, WGM = 8;
__host__ __device__ __forceinline__ int lds_byte(int r, int c) { const int st = (r >> 4) * 2 + (c >> 5), rr = r & 15, cc = c & 31, ob = rr * 64 + cc * 2; return st * 1024 + (ob ^ (((ob >> 9) & 1) << 5)); }
__host__ __device__ __forceinline__ void stage_rc(int b, int& R, int& C) { const int st = b / 1024, sb = b % 1024, swz = sb ^ (((sb >> 9) & 1) << 5); R = (st >> 1) * 16 + swz / 64; C = (st & 1) * 32 + (swz % 64) / 2; }
__host__ __device__ __forceinline__ int perm32(int rho) { const int n = rho >> 4, i = rho & 15; return 8 * (i >> 2) + 4 * n + (i & 3); }

struct Unit { int pm, pn; long aoff, boff; int x0, x1; };
struct Gemm { const bf16_t* A; const bf16_t* Bt; int K; int lda, ldb; };

template <int MODE> struct Sched {
    int nM, nN, nwg, G, c; long lda, ldb; int nsplit, add0, add1, bcompact;
    __device__ void init(int nM_, int nN_, int nwg_, long lda_, long ldb_) { nM = nM_; nN = nN_; nwg = nwg_; G = ogrid(); c = obid(); lda = lda_; ldb = ldb_; nsplit = 1 << 30; add0 = 0; add1 = 0; bcompact = 0; }
    __device__ void remap(int nsplit_, int add0_, int add1_, int bcompact_) { nsplit = nsplit_; add0 = add0_; add1 = add1_; bcompact = bcompact_; }
    __device__ void rotate(int r) { c = (c + r) % G; }
    __device__ bool next(int i, Unit& u) const {
        const long L = (long)i * G + c; if (L >= nwg) return false;
        int wgid = (int)L;
        if (MODE == 0) {
            { const int q = nwg / NXCD, r = nwg % NXCD, xcd = wgid % NXCD, off = wgid / NXCD; wgid = (xcd < r ? xcd * (q + 1) : r * (q + 1) + (xcd - r) * q) + off; }
            const int nig = WGM * nN, gid = wgid / nig, fm = gid * WGM, gsz = (nM - fm) < WGM ? (nM - fm) : WGM;
            u.pm = fm + ((wgid % nig) % gsz); u.pn = (wgid % nig) / gsz; u.x0 = 0; u.x1 = 0;
            { const int pl = u.pn; u.pn += pl < nsplit ? add0 : add1; u.aoff = (long)u.pm * 256 * lda * 2; u.boff = (long)(bcompact ? pl : u.pn) * 256 * ldb * 2; }
        } else if (MODE == 1) {
            const int h = wgid >> 4, rem = wgid & 15, rt = rem >> 1, pn = rem & 1;
            u.pm = rt; u.pn = pn; u.x0 = h; u.x1 = rt;
            u.aoff = ((long)(TP + 256 * rt) * 3072 + h * 192) * 2; u.boff = ((long)(h * 512 + 256 * pn) * 256) * 2;
        } else if (MODE == 2) {
            const int b = wgid / 36, rem = wgid % 36, pm = rem / 9, pn = rem % 9;
            u.pm = pm; u.pn = pn; u.x0 = b; u.x1 = 0;
            u.aoff = ((long)(b * 1024 + 256 * pm) * QLD) * 2; u.boff = ((long)(b * KPAD + 256 * pn) * QLD) * 2;
        } else if (MODE == 3) {
            const int b = wgid >> 3, pm = (wgid & 7) >> 1, pn = wgid & 1;
            u.pm = pm; u.pn = pn; u.x0 = b; u.x1 = 0;
            u.aoff = ((long)(b * 1024 + 256 * pm) * KPAD) * 2; u.boff = ((long)(b * 512 + 256 * pn) * KPAD) * 2;
        } else {
            const int h = wgid >> 3, rt = wgid & 7;
            u.pm = rt; u.pn = 0; u.x0 = h; u.x1 = rt;
            u.aoff = ((long)(h * 2048 + 256 * rt) * 512) * 2; u.boff = ((long)(h * 256) * 512) * 2;
        }
        return true;
    }
};

template <class Epi, class SchedT, bool I8 = false>
__device__ __forceinline__ void gemm_phase(LAS unsigned char* lds, const Gemm g, const SchedT& S, const Epi& E) {
    const int tid = otid(), wid = __builtin_amdgcn_readfirstlane(tid >> 6), lane = tid & 63, wr = wid >> 2, wc = wid & 3, fr = lane & 15, fq = lane >> 4;
    const int K = g.K, nt = K / BK;
    unsigned voffA[2], voffB[2];
#pragma unroll
    for (int i = 0; i < 2; ++i) { int R, C; stage_rc(tid * 16 + i * 8192, R, C); const int Rb = Epi::PERM ? ((R & ~31) + perm32(R & 31)) : R;
        voffA[i] = (unsigned)(R * g.lda + C) * 2u; voffB[i] = (unsigned)(Rb * g.ldb + C) * 2u; }
    const size_t kstep = (size_t)(BK * 2);
    const size_t hstepA = (size_t)HALF * g.lda * 2, hstepB = (size_t)HALF * g.ldb * 2;
    const unsigned ldsw = (unsigned)wid * 1024u;
    const int aoff = lds_byte(wr * 64 + fr, fq * 8), boff = lds_byte(wc * 32 + fr, fq * 8);
#define PG8_SA(b, h) (((b) * 2 + (h)) * HTB)
#define PG8_SB(b, h) ((4 + (b) * 2 + (h)) * HTB)
#define PG8_STAGE(bufoff, gbase, voff) do { _Pragma("unroll") for (int _i = 0; _i < 2; ++_i) \
        __builtin_amdgcn_global_load_lds((const unsigned*)((const char*)(gbase) + (voff)[_i]), (LAS unsigned*)(lds + (bufoff) + ldsw + _i * 8192), 16, 0, 0); } while (0)
#define PG8_LDA(dst, b, h) do { _Pragma("unroll") for (int m = 0; m < 4; ++m) _Pragma("unroll") for (int k = 0; k < 2; ++k) dst[m][k] = *(const LAS bf16x8*)(lds + PG8_SA(b, h) + aoff + m * 2048 + k * 1024); } while (0)
#define PG8_LDB(dst, b, h) do { _Pragma("unroll") for (int n = 0; n < 2; ++n) _Pragma("unroll") for (int k = 0; k < 2; ++k) dst[n][k] = *(const LAS bf16x8*)(lds + PG8_SB(b, h) + boff + n * 2048 + k * 1024); } while (0)
#define PG8_MMA(ai, bj, At, Bt) do { __builtin_amdgcn_s_setprio(1); _Pragma("unroll") for (int m = 0; m < 4; ++m) _Pragma("unroll") for (int n = 0; n < 2; ++n) _Pragma("unroll") for (int k = 0; k < 2; ++k) \
        { if constexpr (I8) acc[ai][bj][m][n] = __builtin_bit_cast(f32x4, __builtin_amdgcn_mfma_i32_16x16x64_i8(__builtin_bit_cast(i32x4, Bt[n][k]), __builtin_bit_cast(i32x4, At[m][k]), __builtin_bit_cast(i32x4, acc[ai][bj][m][n]), 0, 0, 0)); \
          else acc[ai][bj][m][n] = __builtin_amdgcn_mfma_f32_16x16x32_bf16(Bt[n][k], At[m][k], acc[ai][bj][m][n], 0, 0, 0); } __builtin_amdgcn_s_setprio(0); } while (0)
#define PG8_WAIT_V(n) asm volatile("s_waitcnt vmcnt(" #n ")" ::: "memory")
#define PG8_WAIT_L(n) asm volatile("s_waitcnt lgkmcnt(" #n ")" ::: "memory")
#define PG8_BAR __builtin_amdgcn_s_barrier()
#define PG8_SCHED __builtin_amdgcn_sched_barrier(0)
    Unit cur, nxt; int ui = 0;
    if (!S.next(0, cur)) return;
    f32x4 acc[2][2][4][2];
#pragma unroll
    for (int a = 0; a < 2; ++a)
#pragma unroll
        for (int b = 0; b < 2; ++b)
#pragma unroll
            for (int m = 0; m < 4; ++m)
#pragma unroll
                for (int n = 0; n < 2; ++n) acc[a][b][m][n] = (f32x4){0.f, 0.f, 0.f, 0.f};
    bf16x8 At[4][2], B0[2][2], B1[2][2];
    const char* cA = (const char*)g.A + cur.aoff; const char* cB = (const char*)g.Bt + cur.boff;
    PG8_STAGE(PG8_SB(0, 0), cB, voffB); PG8_STAGE(PG8_SA(0, 0), cA, voffA); PG8_STAGE(PG8_SB(0, 1), cB + hstepB, voffB); PG8_STAGE(PG8_SA(0, 1), cA + hstepA, voffA);
    if (wr == 1) PG8_BAR;
    PG8_WAIT_V(4); PG8_BAR;
    PG8_STAGE(PG8_SB(1, 0), cB + kstep, voffB); PG8_STAGE(PG8_SA(1, 0), cA + kstep, voffA); PG8_STAGE(PG8_SB(1, 1), cB + hstepB + kstep, voffB);
    PG8_WAIT_V(6); PG8_BAR;
    for (;;) {
        const bool has_next = S.next(ui + 1, nxt);
        const char* nA = has_next ? (const char*)g.A + nxt.aoff : cA; const char* nB = has_next ? (const char*)g.Bt + nxt.boff : cB;
        for (int t = 0; t < nt; t += 2) {
            const bool last = (t == nt - 2);
            const char* a1 = cA + (size_t)(t + 1) * kstep;
            const char* a2 = last ? nA : cA + (size_t)(t + 2) * kstep; const char* b2 = last ? nB : cB + (size_t)(t + 2) * kstep;
            const char* a3 = a2 + kstep; const char* b3 = b2 + kstep;
            PG8_LDB(B0, 0, 0); PG8_SCHED; PG8_LDA(At, 0, 0); PG8_STAGE(PG8_SA(1, 1), a1 + hstepA, voffA);
            PG8_WAIT_L(8); PG8_BAR; PG8_WAIT_L(0); PG8_MMA(0, 0, At, B0); PG8_BAR; PG8_SCHED;
            PG8_LDB(B1, 0, 1); PG8_STAGE(PG8_SB(0, 0), b2, voffB);
            PG8_BAR; PG8_WAIT_L(0); PG8_MMA(0, 1, At, B1); PG8_BAR;
            PG8_LDA(At, 0, 1); PG8_STAGE(PG8_SA(0, 0), a2, voffA);
            PG8_BAR; PG8_WAIT_L(0); PG8_MMA(1, 0, At, B0); PG8_BAR; PG8_SCHED;
            PG8_STAGE(PG8_SB(0, 1), b2 + hstepB, voffB);
            PG8_WAIT_V(6); PG8_BAR; PG8_MMA(1, 1, At, B1); PG8_BAR;
            PG8_LDB(B0, 1, 0); PG8_SCHED; PG8_LDA(At, 1, 0); PG8_STAGE(PG8_SA(0, 1), a2 + hstepA, voffA);
            PG8_WAIT_L(8); PG8_BAR; PG8_WAIT_L(0); PG8_MMA(0, 0, At, B0); PG8_BAR; PG8_SCHED;
            PG8_LDB(B1, 1, 1); PG8_STAGE(PG8_SB(1, 0), b3, voffB);
            PG8_BAR; PG8_WAIT_L(0); PG8_MMA(0, 1, At, B1); PG8_BAR;
            PG8_LDA(At, 1, 1); PG8_STAGE(PG8_SA(1, 0), a3, voffA);
            PG8_BAR; PG8_WAIT_L(0); PG8_MMA(1, 0, At, B0); PG8_BAR; PG8_SCHED;
            PG8_STAGE(PG8_SB(1, 1), b3 + hstepB, voffB);
            PG8_WAIT_V(6); PG8_BAR; PG8_MMA(1, 1, At, B1); PG8_BAR;
        }
        if constexpr (I8) {
#pragma unroll
            for (int a = 0; a < 2; ++a)
#pragma unroll
                for (int b = 0; b < 2; ++b)
#pragma unroll
                    for (int m = 0; m < 4; ++m)
#pragma unroll
                        for (int n = 0; n < 2; ++n) { const i32x4 iv = __builtin_bit_cast(i32x4, acc[a][b][m][n]); acc[a][b][m][n] = (f32x4){(float)iv[0], (float)iv[1], (float)iv[2], (float)iv[3]}; } }
        E(acc, cur, wr, wc, fr, fq);
        if (!has_next) break;
#pragma unroll
        for (int a = 0; a < 2; ++a)
#pragma unroll
            for (int b = 0; b < 2; ++b)
#pragma unroll
                for (int m = 0; m < 4; ++m)
#pragma unroll
                    for (int n = 0; n < 2; ++n) acc[a][b][m][n] = (f32x4){0.f, 0.f, 0.f, 0.f};
        cur = nxt; cA = nA; cB = nB; ++ui;
    }
    PG8_WAIT_V(0);
    if (wr == 0) PG8_BAR;
    PG8_BAR;
#undef PG8_SA
#undef PG8_SB
#undef PG8_STAGE
#undef PG8_LDA
#undef PG8_LDB
#undef PG8_MMA
#undef PG8_WAIT_V
#undef PG8_WAIT_L
#undef PG8_BAR
#undef PG8_SCHED
}

struct EpiBf16 {
    static constexpr bool PERM = true;
    bf16_t* O; long ldc; long bstride;
    __device__ __forceinline__ void operator()(const f32x4 (&acc)[2][2][4][2], const Unit& u, int wr, int wc, int fr, int fq) const {
        bf16_t* base = O + (long)u.x0 * bstride + (long)(u.pm * BM + wr * 64 + fr) * ldc + u.pn * BM + wc * 32 + 8 * fq;
#pragma unroll
        for (int ai = 0; ai < 2; ++ai)
#pragma unroll
            for (int m = 0; m < 4; ++m) { bf16_t* rowp = base + (long)(ai * HALF + m * 16) * ldc;
#pragma unroll
                for (int bj = 0; bj < 2; ++bj) { const f32x4 v0 = acc[ai][bj][m][0], v1 = acc[ai][bj][m][1];
                    u32x4 w; w.x = cvt_pk_bf16(v0[0], v0[1]); w.y = cvt_pk_bf16(v0[2], v0[3]); w.z = cvt_pk_bf16(v1[0], v1[1]); w.w = cvt_pk_bf16(v1[2], v1[3]);
                    *(u32x4*)(rowp + bj * HALF) = w; } }
    }
};
template <int RMODE> struct EpiRowMap {
    static constexpr bool PERM = true;
    bf16_t* O; const float* rsum;
    __device__ __forceinline__ void operator()(const f32x4 (&acc)[2][2][4][2], const Unit& u, int wr, int wc, int fr, int fq) const {
        const int col0 = u.pn * BM + wc * 32 + 8 * fq;
#pragma unroll
        for (int ai = 0; ai < 2; ++ai)
#pragma unroll
            for (int m = 0; m < 4; ++m) { const int r = ai * HALF + wr * 64 + m * 16 + fr; long drow; long ldc;
                if (RMODE == 1) { const int ts = 256 * u.x1 + r; drow = (long)(ts >> 6) * 1024 + u.x0 * 64 + (ts & 63); ldc = QLD; }
                float rs = 1.0f;
                if (RMODE == 1) { }
                else { const int qr = 256 * u.pm + r; drow = (long)(qr >> 6) * 2048 + u.x0 * 64 + (qr & 63); ldc = 512; rs = 1.0f / rsum[u.x0 * 1024 + qr]; }
                bf16_t* rowp = O + drow * ldc + col0;
#pragma unroll
                for (int bj = 0; bj < 2; ++bj) { const f32x4 v0 = acc[ai][bj][m][0] * rs, v1 = acc[ai][bj][m][1] * rs;
                    u32x4 w; w.x = cvt_pk_bf16(v0[0], v0[1]); w.y = cvt_pk_bf16(v0[2], v0[3]); w.z = cvt_pk_bf16(v1[0], v1[1]); w.w = cvt_pk_bf16(v1[2], v1[3]);
                    *(u32x4*)(rowp + bj * HALF) = w; } }
    }
};
struct EpiOV {
    static constexpr bool PERM = true;
    bf16_t* O;
    __device__ __forceinline__ void operator()(const f32x4 (&acc)[2][2][4][2], const Unit& u, int wr, int wc, int fr, int fq) const {
#pragma unroll
        for (int ai = 0; ai < 2; ++ai)
#pragma unroll
            for (int m = 0; m < 4; ++m) { const int r = ai * HALF + wr * 64 + m * 16 + fr;
                bf16_t* rowp = O + (long)(TP + 256 * u.x1 + r) * DM + u.x0 * 128 + wc * 32 + 8 * fq;
                const f32x4 v0 = acc[ai][1][m][0], v1 = acc[ai][1][m][1];
                u32x4 w; w.x = cvt_pk_bf16(v0[0], v0[1]); w.y = cvt_pk_bf16(v0[2], v0[3]); w.z = cvt_pk_bf16(v1[0], v1[1]); w.w = cvt_pk_bf16(v1[2], v1[3]);
                *(u32x4*)rowp = w; }
    }
};
struct EpiMix {
    static constexpr bool PERM = true;
    const bf16_t* Y; const bf16_t* YA; bf16_t* MIX;
    __device__ __forceinline__ void operator()(const f32x4 (&acc)[2][2][4][2], const Unit& u, int wr, int wc, int fr, int fq) const {
#pragma unroll
        for (int ai = 0; ai < 2; ++ai)
#pragma unroll
            for (int m = 0; m < 4; ++m) { const long t = (long)u.pm * BM + ai * HALF + wr * 64 + m * 16 + fr;
#pragma unroll
                for (int bj = 0; bj < 2; ++bj) { const int c = u.pn * BM + bj * HALF + wc * 32 + 8 * fq;
                    const u32x4 ga = *(const u32x4*)(Y + t * INWP + C_GA + c), gb = *(const u32x4*)(Y + t * INWP + C_GB + c), ya = *(const u32x4*)(YA + t * DM + c);
                    float fa[8], fb[8], fy[8], o[8]; unpack8(ga, fa); unpack8(gb, fb); unpack8(ya, fy);
                    const f32x4 v0 = acc[ai][bj][m][0], v1 = acc[ai][bj][m][1];
                    const float av[8] = {v0[0], v0[1], v0[2], v0[3], v1[0], v1[1], v1[2], v1[3]};
#pragma unroll
                    for (int j = 0; j < 8; ++j) {
#if defined(DBG_MIX) && DBG_MIX == 1
                        o[j] = sigmoidf_(fb[j]) * av[j];
#elif defined(DBG_MIX) && DBG_MIX == 2
                        o[j] = sigmoidf_(fa[j]) * fy[j];
#else
                        o[j] = sigmoidf_(fa[j]) * fy[j] + sigmoidf_(fb[j]) * av[j];
#endif
                    }
                    *(u32x4*)(MIX + t * DM + c) = pack8(o); } }
    }
};
struct EpiRes {
    static constexpr bool PERM = false;
    float* X; const float* gate;
    const float* XinP; const float* XinS;
    __device__ __forceinline__ void operator()(const f32x4 (&acc)[2][2][4][2], const Unit& u, int wr, int wc, int fr, int fq) const {
#pragma unroll
        for (int ai = 0; ai < 2; ++ai)
#pragma unroll
            for (int m = 0; m < 4; ++m) { const int t = u.pm * BM + ai * HALF + wr * 64 + m * 16 + fr; const float* gr = gate + (long)cond_row(t) * 12288; float* xr = X + (long)t * DM; const float* xi = t < TP ? XinP + (long)t * DM : XinS + (long)(t - TP) * DM;
#pragma unroll
                for (int bj = 0; bj < 2; ++bj)
#pragma unroll
                    for (int n = 0; n < 2; ++n) { const int c = u.pn * BM + bj * HALF + wc * 32 + n * 16 + 4 * fq;
                        const f32x4 gv = *(const f32x4*)(gr + c); const f32x4 xv = *(const f32x4*)(xi + c);
                        *(f32x4*)(xr + c) = xv + gv * acc[ai][bj][m][n]; } }
    }
};

struct EpiQ {
    static constexpr bool PERM = true;
    bf16_t* Q; bf16_t* QL; const float* T64;
    __device__ __forceinline__ void operator()(const f32x4 (&acc)[2][2][4][2], const Unit& u, int wr, int wc, int fr, int fq) const {
        const int grp = u.pn / 3, typ = u.pn - 3 * grp;
        if (typ < 2) {
#pragma unroll
            for (int ai = 0; ai < 2; ++ai)
#pragma unroll
                for (int m = 0; m < 4; ++m) { const long t = (long)u.pm * BM + ai * HALF + wr * 64 + m * 16 + fr;
#pragma unroll
                    for (int bj = 0; bj < 2; ++bj) { const f32x4 v0 = acc[ai][bj][m][0], v1 = acc[ai][bj][m][1];
                        u32x4 w; w.x = cvt_pk_bf16(v0[0], v0[1]); w.y = cvt_pk_bf16(v0[2], v0[3]); w.z = cvt_pk_bf16(v1[0], v1[1]); w.w = cvt_pk_bf16(v1[2], v1[3]);
                        *(u32x4*)(Q + t * 3072 + 768 * grp + 192 * (2 * typ + bj) + wc * 32 + 8 * fq) = w; } }
        } else {
#pragma unroll
            for (int ai = 0; ai < 2; ++ai)
#pragma unroll
                for (int m = 0; m < 4; ++m) { const int t = u.pm * BM + ai * HALF + wr * 64 + m * 16 + fr; const int pos = tok_pos(t);
                    const float* cs = T64 + ((long)pos * 32 + 8 * fq) * 2; float cv[8], sv[8];
#pragma unroll
                    for (int j = 0; j < 4; ++j) { const f32x4 qv = *(const f32x4*)(cs + 4 * j); cv[2 * j] = qv[0]; sv[2 * j] = qv[1]; cv[2 * j + 1] = qv[2]; sv[2 * j + 1] = qv[3]; }
                    const f32x4 a0 = acc[ai][0][m][0], a1 = acc[ai][0][m][1], b0 = acc[ai][1][m][0], b1 = acc[ai][1][m][1];
                    const float x1[8] = {a0[0], a0[1], a0[2], a0[3], a1[0], a1[1], a1[2], a1[3]}, x2[8] = {b0[0], b0[1], b0[2], b0[3], b1[0], b1[1], b1[2], b1[3]};
                    float o1[8], o2[8];
#pragma unroll
                    for (int j = 0; j < 8; ++j) { o1[j] = x1[j] * cv[j] - x2[j] * sv[j]; o2[j] = x1[j] * sv[j] + x2[j] * cv[j]; }
                    const u32x4 w1 = pack8(o1), w2 = pack8(o2); const int hd = 4 * grp + wc;
                    bf16_t* qd = Q + (long)t * 3072 + hd * 192 + 128 + 8 * fq; *(u32x4*)qd = w1; *(u32x4*)(qd + 32) = w2;
                    if (t >= TP) { const int ts = t - TP; bf16_t* d = QL + ((long)(ts >> 6) * 1024 + hd * 64 + (ts & 63)) * QLD + 512 + 8 * fq; *(u32x4*)d = w1; *(u32x4*)(d + 32) = w2; } }
        }
    }
};

struct EpiExp {
    static constexpr bool PERM = true;
    bf16_t* O; float* rsum;
    __device__ __forceinline__ void operator()(const f32x4 (&acc)[2][2][4][2], const Unit& u, int wr, int wc, int fr, int fq) const {
        bf16_t* base = O + (long)u.x0 * 1024 * KPAD + (long)(u.pm * BM + wr * 64 + fr) * KPAD + u.pn * BM + wc * 32 + 8 * fq;
#pragma unroll
        for (int ai = 0; ai < 2; ++ai)
#pragma unroll
            for (int m = 0; m < 4; ++m) { bf16_t* rowp = base + (long)(ai * HALF + m * 16) * KPAD; float part = 0.f;
#pragma unroll
                for (int bj = 0; bj < 2; ++bj) { const int c0 = u.pn * BM + bj * HALF + wc * 32 + 8 * fq; const f32x4 v0 = acc[ai][bj][m][0], v1 = acc[ai][bj][m][1];
                    const float sv[8] = {v0[0], v0[1], v0[2], v0[3], v1[0], v1[1], v1[2], v1[3]}; float e[8];
#pragma unroll
                    for (int j = 0; j < 8; ++j) { e[j] = (c0 + j < KALL) ? __expf(fminf(sv[j] * MLA_SCALE, 60.f)) : 0.f; part += e[j]; }
                    *(u32x4*)(rowp + bj * HALF) = pack8(e); }
                part += sx<16>(part); part += sx<32>(part);
                if (fq == 0) atomicAdd(rsum + u.x0 * 1024 + u.pm * BM + ai * HALF + wr * 64 + m * 16 + fr, part); }
    }
};

struct EpiQ8 {
    static constexpr bool PERM = true;
    bf16_t* O; long ldc; const float* sa; const float* sb;
    __device__ __forceinline__ void operator()(const f32x4 (&acc)[2][2][4][2], const Unit& u, int wr, int wc, int fr, int fq) const {
        f32x4 sbv[2][2];
#pragma unroll
        for (int bj = 0; bj < 2; ++bj) { const int c = u.pn * BM + bj * HALF + wc * 32 + 8 * fq; sbv[bj][0] = *(const f32x4*)(sb + c); sbv[bj][1] = *(const f32x4*)(sb + c + 4); }
#pragma unroll
        for (int ai = 0; ai < 2; ++ai)
#pragma unroll
            for (int m = 0; m < 4; ++m) { const long t = (long)u.pm * BM + ai * HALF + wr * 64 + m * 16 + fr; const float s = sa[t];
#pragma unroll
                for (int bj = 0; bj < 2; ++bj) { const f32x4 v0 = acc[ai][bj][m][0] * sbv[bj][0] * s, v1 = acc[ai][bj][m][1] * sbv[bj][1] * s;
                    u32x4 w; w.x = cvt_pk_bf16(v0[0], v0[1]); w.y = cvt_pk_bf16(v0[2], v0[3]); w.z = cvt_pk_bf16(v1[0], v1[1]); w.w = cvt_pk_bf16(v1[2], v1[3]);
                    *(u32x4*)(O + t * ldc + u.pn * BM + bj * HALF + wc * 32 + 8 * fq) = w; } }
    }
};
}
namespace att {
constexpr int NW = 8, QBLK = 32, KVBLK = 64;
constexpr float SCALE = MLA_SCALE;
constexpr float THR = 8.f;
constexpr int KROW = 384;
constexpr int SHM_V = KVBLK * 128 * 2, SHM_K = KVBLK * KROW;
constexpr int QR_PITCH = 144, SHM_QR = 256 * QR_PITCH;
constexpr int SHM_ATTN = 2 * SHM_V + 2 * SHM_K + NW * 64 * 4 + SHM_QR;
#define KSWZ(row, colB) ((row) * att::KROW + ((colB) ^ (((row) & 7) << 4)))
#define SBAR() __builtin_amdgcn_sched_barrier(0)
__device__ __forceinline__ int crow(int r, int hi) { return (r & 3) + 8 * (r >> 2) + 4 * hi; }

__device__ __forceinline__ void partialSM(f32x16& p0, f32x16& p1, float& m_reg, float& mn, float& alpha) {
  constexpr float C = SCALE * 1.4426950408889634f;
  float pmax = p0[0];
#pragma unroll
  for (int r = 1; r < 16; ++r) pmax = fmaxf(pmax, p0[r]);
#pragma unroll
  for (int r = 0; r < 16; ++r) pmax = fmaxf(pmax, p1[r]);
  { auto rr = __builtin_amdgcn_permlane32_swap(__float_as_uint(pmax), __float_as_uint(pmax), false, false);
    pmax = fmaxf(__uint_as_float(rr[0]), __uint_as_float(rr[1])); }
  if (__builtin_expect(__all(pmax - m_reg <= THR / SCALE), 1)) { mn = m_reg; alpha = 1.f; }
  else { mn = fmaxf(m_reg, pmax); alpha = __builtin_amdgcn_exp2f((m_reg - mn) * C); m_reg = mn; }
  float mnC = -mn * C;
#pragma unroll
  for (int r = 0; r < 16; ++r) p0[r] = fmaf(p0[r], C, mnC);
#pragma unroll
  for (int r = 0; r < 16; ++r) p1[r] = fmaf(p1[r], C, mnC);
#pragma unroll
  for (int r = 0; r < 16; ++r) p0[r] = __builtin_amdgcn_exp2f(p0[r]);
}
__device__ __forceinline__ void finishSM(f32x16& p0, f32x16& p1, float alpha, float& l_reg, bf16x8& pa0, bf16x8& pa1, bf16x8& pa2, bf16x8& pa3) {
#pragma unroll
  for (int r = 0; r < 16; ++r) p1[r] = __builtin_amdgcn_exp2f(p1[r]);
  float ps = 0;
#pragma unroll
  for (int r = 0; r < 16; ++r) ps += p0[r];
#pragma unroll
  for (int r = 0; r < 16; ++r) ps += p1[r];
  { auto rr = __builtin_amdgcn_permlane32_swap(__float_as_uint(ps), __float_as_uint(ps), false, false);
    ps = __uint_as_float(rr[0]) + __uint_as_float(rr[1]); }
  l_reg = l_reg * alpha + ps;
#define PK4(P, BASE, OUT) do { unsigned a0 = cvt_pk_bf16(P[BASE + 0], P[BASE + 1]), a1 = cvt_pk_bf16(P[BASE + 2], P[BASE + 3]);   \
    unsigned b0 = cvt_pk_bf16(P[BASE + 4], P[BASE + 5]), b1 = cvt_pk_bf16(P[BASE + 6], P[BASE + 7]);                              \
    auto r0 = __builtin_amdgcn_permlane32_swap(a0, b0, false, false); auto r1 = __builtin_amdgcn_permlane32_swap(a1, b1, false, false); \
    u32x4 w = {r0[0], r1[0], r0[1], r1[1]}; OUT = *reinterpret_cast<bf16x8*>(&w); } while (0)
  PK4(p0, 0, pa0); PK4(p0, 8, pa1); PK4(p1, 0, pa2); PK4(p1, 8, pa3);
#undef PK4
}
__device__ __forceinline__ void qkt(f32x16& p0, f32x16& p1, const char* Ks, const bf16x8* qr, const char* qrope, const int (&kbase)[4], bool vis) {
  p0 = f32x16{}; p1 = f32x16{};
  if (vis) {
#pragma unroll
  for (int d0 = 0; d0 < 12; ++d0) {
    bf16x8 b0 = *reinterpret_cast<const bf16x8*>(Ks + kbase[d0 & 3] + (d0 >> 2) * 128);
    bf16x8 b1 = *reinterpret_cast<const bf16x8*>(Ks + kbase[d0 & 3] + (d0 >> 2) * 128 + 32 * KROW);
    const bf16x8 qv = d0 < 8 ? qr[d0 < 8 ? d0 : 0] : *reinterpret_cast<const bf16x8*>(qrope + (d0 - 8) * 32);
    p0 = __builtin_amdgcn_mfma_f32_32x32x16_bf16(b0, qv, p0, 0, 0, 0);
    p1 = __builtin_amdgcn_mfma_f32_32x32x16_bf16(b1, qv, p1, 0, 0, 0); }
  }
  if (!vis) {
#pragma unroll
    for (int r = 0; r < 16; ++r) { p0[r] = -1e30f; p1[r] = -1e30f; } }
}
__device__ __forceinline__ int v_st(int k, int c) { const int kk = (k & ~0xC) | ((k & 4) << 1) | ((k & 8) >> 1); return ((kk >> 3) * 4 + (c >> 5)) * 512 + ((kk & 7) * 32 + (c & 31)) * 2; }
__device__ __forceinline__ int v_rd_base(int lane) { return ((lane & 3) << 3) | (((lane >> 2) & 3) << 6) | (((lane >> 4) & 1) << 5) | (((lane >> 5) & 1) << 8); }
constexpr int v_rd_off(int d0, int ks, int half) { return d0 * 512 + ks * 4096 + half * 2048; }
template <int OFF> __device__ __forceinline__ s16x4 tr_read(int vb) {
  s16x4 r; asm volatile("ds_read_b64_tr_b16 %0, %1 offset:%2" : "=&v"(r) : "v"(vb), "i"(OFF) : "memory"); return r;
}
template <int D0> __device__ __forceinline__ void pv_one(f32x16& od, int vb, bf16x8 pa0, bf16x8 pa1, bf16x8 pa2, bf16x8 pa3) {
  const s16x4 l0 = tr_read<v_rd_off(D0, 0, 0)>(vb), h0 = tr_read<v_rd_off(D0, 0, 1)>(vb), l1 = tr_read<v_rd_off(D0, 1, 0)>(vb), h1 = tr_read<v_rd_off(D0, 1, 1)>(vb);
  const s16x4 l2 = tr_read<v_rd_off(D0, 2, 0)>(vb), h2 = tr_read<v_rd_off(D0, 2, 1)>(vb), l3 = tr_read<v_rd_off(D0, 3, 0)>(vb), h3 = tr_read<v_rd_off(D0, 3, 1)>(vb);
  asm volatile("s_waitcnt lgkmcnt(0)" ::: "memory"); SBAR();
#define PK(L, H) (bf16x8){L[0], L[1], L[2], L[3], H[0], H[1], H[2], H[3]}
  od = __builtin_amdgcn_mfma_f32_32x32x16_bf16(pa0, PK(l0, h0), od, 0, 0, 0);
  od = __builtin_amdgcn_mfma_f32_32x32x16_bf16(pa1, PK(l1, h1), od, 0, 0, 0);
  od = __builtin_amdgcn_mfma_f32_32x32x16_bf16(pa2, PK(l2, h2), od, 0, 0, 0);
  od = __builtin_amdgcn_mfma_f32_32x32x16_bf16(pa3, PK(l3, h3), od, 0, 0, 0);
#undef PK
}
__device__ __forceinline__ void pv_d0(f32x16* o, int vb, bf16x8 pa0, bf16x8 pa1, bf16x8 pa2, bf16x8 pa3) {
  pv_one<0>(o[0], vb, pa0, pa1, pa2, pa3); pv_one<1>(o[1], vb, pa0, pa1, pa2, pa3); pv_one<2>(o[2], vb, pa0, pa1, pa2, pa3); pv_one<3>(o[3], vb, pa0, pa1, pa2, pa3);
}

__device__ __forceinline__ void attn_block(const bf16_t* __restrict__ Qb, const bf16_t* __restrict__ Kn, const bf16_t* __restrict__ Kr, const bf16_t* __restrict__ Vh,
                                           bf16_t* __restrict__ Ob, int qb, char* lds) {
  constexpr int LDQ = 3072, LDK = 4096, LDR = 64, LDO = 2048;
  const int tid = otid(), wid = tid >> 6, lane = tid & 63, r32 = lane & 31, hi = lane >> 5;
  char* V_lds = lds; char* K_lds = lds + 2 * SHM_V;
  float* ws = (float*)(lds + 2 * SHM_V + 2 * SHM_K) + wid * 64; float* li_l = ws; float* al_l = ws + 32;
  float m_reg = -1e30f, l_reg = 0; f32x16 o[4] = {}; bf16x8 qr[8];
  const bf16_t* Qw = Qb + (long)(wid * QBLK + r32) * LDQ + hi * 8;
#pragma unroll
  for (int d0 = 0; d0 < 8; ++d0) qr[d0] = *reinterpret_cast<const bf16x8*>(Qw + d0 * 16);
  char* qrope = lds + 2 * SHM_V + 2 * SHM_K + NW * 64 * 4 + (wid * QBLK + r32) * QR_PITCH + hi * 16;
#pragma unroll
  for (int d0 = 8; d0 < 12; ++d0) *reinterpret_cast<bf16x8*>(qrope + (d0 - 8) * 32) = *reinterpret_cast<const bf16x8*>(Qw + d0 * 16);
  asm volatile("s_waitcnt lgkmcnt(0)" ::: "memory");
  const int NT = 4 * qb + 4, jmax = 4 * qb + (wid >> 1);
  int kbase[4];
#pragma unroll
  for (int dl = 0; dl < 4; ++dl) kbase[dl] = r32 * KROW + (((dl << 5) | (hi << 4)) ^ ((r32 & 7) << 4));
  const int sr = tid >> 4, sc = (tid & 15) * 8, vst0 = v_st(sr, sc), vst1 = v_st(32 + sr, sc);
  const int rr = tid >> 3, rc = (tid & 7) * 8;
  const int vb0 = (int)(uintptr_t)V_lds + v_rd_base(lane);
  bf16x8 vs0, vs1, ks0, ks1, kr0;
#define SLOAD(k0) do { vs0 = *reinterpret_cast<const bf16x8*>(&Vh[(long)((k0) + sr) * LDK + sc]); vs1 = *reinterpret_cast<const bf16x8*>(&Vh[(long)((k0) + 32 + sr) * LDK + sc]); \
    ks0 = *reinterpret_cast<const bf16x8*>(&Kn[(long)((k0) + sr) * LDK + sc]); ks1 = *reinterpret_cast<const bf16x8*>(&Kn[(long)((k0) + 32 + sr) * LDK + sc]); \
    kr0 = *reinterpret_cast<const bf16x8*>(&Kr[(long)((k0) + rr) * LDR + rc]); } while (0)
#define SWRITE(b) do { *(bf16x8*)(V_lds + (b) * SHM_V + vst0) = vs0; *(bf16x8*)(V_lds + (b) * SHM_V + vst1) = vs1; int kc = sc * 2; \
    *(bf16x8*)(K_lds + (b) * SHM_K + KSWZ(sr, kc)) = ks0; *(bf16x8*)(K_lds + (b) * SHM_K + KSWZ(32 + sr, kc)) = ks1; \
    *(bf16x8*)(K_lds + (b) * SHM_K + KSWZ(rr, 256 + rc * 2)) = kr0; } while (0)
#define SWAIT() asm volatile("s_waitcnt vmcnt(0)" ::: "memory")
#define RESC(a) do { if (__any((a) < 1.f)) { if (hi == 0) al_l[r32] = (a); asm volatile("s_waitcnt lgkmcnt(0)" ::: "memory"); \
    _Pragma("unroll") for (int d = 0; d < 4; ++d) _Pragma("unroll") for (int r = 0; r < 16; ++r) o[d][r] *= al_l[crow(r, hi)]; } } while (0)
  f32x16 pA0, pA1, pB0, pB1; float mnA, mnB, alA, alB; bf16x8 pa0, pa1, pa2, pa3;
  SLOAD(0); SWAIT(); SWRITE(0); __syncthreads();
  qkt(pA0, pA1, K_lds, qr, qrope, kbase, true); partialSM(pA0, pA1, m_reg, mnA, alA);
  SLOAD(KVBLK);
  SWAIT(); SWRITE(1); __syncthreads();
  for (int j = 1; j + 1 < NT; j += 2) {
    SBAR(); qkt(pB0, pB1, K_lds + SHM_K, qr, qrope, kbase, j <= jmax);
    finishSM(pA0, pA1, alA, l_reg, pa0, pa1, pa2, pa3); SBAR();
    SLOAD((j + 1) * KVBLK); SBAR();
    if (j - 1 <= jmax) pv_d0(o, vb0, pa0, pa1, pa2, pa3);
    partialSM(pB0, pB1, m_reg, mnB, alB);
    __syncthreads(); SWAIT(); SWRITE(0);
    RESC(alB); __syncthreads();
    SBAR(); qkt(pA0, pA1, K_lds, qr, qrope, kbase, j + 1 <= jmax);
    finishSM(pB0, pB1, alB, l_reg, pa0, pa1, pa2, pa3); SBAR();
    SLOAD((j + 2) * KVBLK); SBAR();
    if (j <= jmax) pv_d0(o, vb0 + (int)SHM_V, pa0, pa1, pa2, pa3);
    partialSM(pA0, pA1, m_reg, mnA, alA);
    __syncthreads(); SWAIT(); SWRITE(1);
    RESC(alA); __syncthreads();
  }
  SBAR(); qkt(pB0, pB1, K_lds + SHM_K, qr, qrope, kbase, NT - 1 <= jmax);
  finishSM(pA0, pA1, alA, l_reg, pa0, pa1, pa2, pa3); SBAR();
  if (NT - 2 <= jmax) pv_d0(o, vb0, pa0, pa1, pa2, pa3);
  partialSM(pB0, pB1, m_reg, mnB, alB);
  __syncthreads(); RESC(alB);
  finishSM(pB0, pB1, alB, l_reg, pa0, pa1, pa2, pa3); SBAR();
  if (NT - 1 <= jmax) pv_d0(o, vb0 + (int)SHM_V, pa0, pa1, pa2, pa3);
  if (hi == 0) li_l[r32] = l_reg; asm volatile("s_waitcnt lgkmcnt(0)" ::: "memory");
  float rli[16];
#pragma unroll
  for (int r = 0; r < 16; ++r) rli[r] = __builtin_amdgcn_rcpf(li_l[crow(r, hi)]);
  bf16_t* Ow = Ob + (long)(wid * QBLK) * LDO;
#pragma unroll
  for (int r = 0; r < 16; ++r) { int orow = crow(r, hi);
#pragma unroll
    for (int d0 = 0; d0 < 4; ++d0) Ow[(long)orow * LDO + d0 * 32 + r32] = f2bf(o[d0][r] * rli[r]); }
  __syncthreads();
#undef SLOAD
#undef SWRITE
#undef SWAIT
#undef RESC
}
}
namespace ret {
constexpr int QP_ = 136;
__device__ __forceinline__ bf16x8 ldfrag(const bf16_t* p) { return *reinterpret_cast<const bf16x8*>(p); }
template <int CL> struct Lay {
    static constexpr int IP = CL + 8;
    static constexpr int QS = 0, KS = QS + CL * QP_ * 2, VT = KS + CL * QP_ * 2, VDT = VT + 32 * IP * 2, IN = VDT + 32 * IP * 2, ST = IN + CL * IP * 2, VS = ST + 32 * QP_ * 2, END = VS + CL * 40 * 2;
};
static_assert(Lay<128>::END <= LDS_BARW, "retention LDS");

template <int CL>
__device__ __forceinline__ void run(const bf16_t* __restrict__ Y, bf16_t* __restrict__ OB, const float* __restrict__ sp, float* __restrict__ so, long tok0, int nch, int h, int es, float lg, char* lds, int tid) {
    using L = Lay<CL>; constexpr int IP = L::IP, NQT = CL / 16, NKS = CL / 32, NPC = CL / 32;
    const int wid = __builtin_amdgcn_readfirstlane(tid >> 6), lane = tid & 63, l15 = lane & 15, l4 = lane >> 4;
    bf16_t* Qs = (bf16_t*)(lds + L::QS); bf16_t* Ks = (bf16_t*)(lds + L::KS); bf16_t* Vt = (bf16_t*)(lds + L::VT); bf16_t* Vdt = (bf16_t*)(lds + L::VDT); bf16_t* In = (bf16_t*)(lds + L::IN); bf16_t* St = (bf16_t*)(lds + L::ST); bf16_t* Vs = (bf16_t*)(lds + L::VS);
    const float gCL = __expf((float)CL * lg);
    f32x4 Sacc[2];
    if (sp) {
#pragma unroll
        for (int ej = 0; ej < 2; ++ej)
#pragma unroll
            for (int r = 0; r < 4; ++r) Sacc[ej][r] = sp[(long)(16 * wid + 4 * l4 + r) * RV + 16 * ej + l15];
    } else { Sacc[0] = (f32x4){0.f, 0.f, 0.f, 0.f}; Sacc[1] = (f32x4){0.f, 0.f, 0.f, 0.f}; }
    for (int i = tid; i < CL * IP / 8; i += 512) reinterpret_cast<u32x4*>(In)[i] = (u32x4){0u, 0u, 0u, 0u};
    u32x4 pq[NPC], pk[NPC], pv;
    const int vk = tid >> 2, ve0 = (tid & 3) * 8;
#define RET_LOAD(cc) do { const bf16_t* yrow_ = Y + (tok0 + (long)(cc) * CL) * INWP; \
        _Pragma("unroll") for (int i = 0; i < NPC; ++i) { const int idx = tid + i * 512, k = idx >> 4, d0 = (idx & 15) * 8; \
            pq[i] = *reinterpret_cast<const u32x4*>(yrow_ + (long)k * INWP + C_RQ + h * 128 + d0); pk[i] = *reinterpret_cast<const u32x4*>(yrow_ + (long)k * INWP + C_RK + h * 128 + d0); } \
        if (tid < 4 * CL) pv = *reinterpret_cast<const u32x4*>(yrow_ + (long)vk * INWP + C_RV + h * 256 + es * 32 + ve0); } while (0)
    RET_LOAD(0);
    for (int c = 0; c < nch; ++c) {
#pragma unroll
        for (int ej = 0; ej < 2; ++ej) { u32x2 w; w.x = cvt_pk_bf16(Sacc[ej][0], Sacc[ej][1]); w.y = cvt_pk_bf16(Sacc[ej][2], Sacc[ej][3]);
            *reinterpret_cast<u32x2*>(St + (16 * ej + l15) * QP_ + 16 * wid + 4 * l4) = w; }
#pragma unroll
        for (int i = 0; i < NPC; ++i) { const int idx = tid + i * 512, k = idx >> 4, d0 = (idx & 15) * 8;
            *reinterpret_cast<u32x4*>(Qs + k * QP_ + d0) = pq[i]; *reinterpret_cast<u32x4*>(Ks + k * QP_ + d0) = pk[i]; }
        if (tid < 4 * CL) *reinterpret_cast<u32x4*>(Vs + vk * 40 + ve0) = pv;
        if (c + 1 < nch) RET_LOAD(c + 1);
        __syncthreads();
        if (tid < 4 * CL) { const int e = tid & 31, kg = tid >> 5; float f[8], fd[8];
#pragma unroll
            for (int j = 0; j < 8; ++j) { f[j] = bf2f(Vs[(8 * kg + j) * 40 + e]); fd[j] = f[j] * __expf((float)(CL - 1 - 8 * kg - j) * lg); }
            *reinterpret_cast<u32x4*>(Vt + e * IP + 8 * kg) = pack8(f); *reinterpret_cast<u32x4*>(Vdt + e * IP + 8 * kg) = pack8(fd); }
#pragma unroll
        for (int it_ = 0; it_ < (NQT * (NQT + 1) / 2 + 7) / 8; ++it_) { const int idx = wid + 8 * it_; if (idx >= NQT * (NQT + 1) / 2) break;
            int qi = 0; while ((qi + 1) * (qi + 2) / 2 <= idx) ++qi; const int kj = idx - qi * (qi + 1) / 2;
            f32x4 a = (f32x4){0.f, 0.f, 0.f, 0.f}; const bf16_t* qp = Qs + (16 * qi + l15) * QP_ + 8 * l4; const bf16_t* kp = Ks + (16 * kj + l15) * QP_ + 8 * l4;
#pragma unroll
            for (int ks = 0; ks < 4; ++ks) a = __builtin_amdgcn_mfma_f32_16x16x32_bf16(ldfrag(qp + 32 * ks), ldfrag(kp + 32 * ks), a, 0, 0, 0);
            const int q0 = 16 * qi + 4 * l4, k = 16 * kj + l15;
#pragma unroll
            for (int r = 0; r < 4; ++r) { const int q = q0 + r; const float dm = (q >= k) ? __expf((float)(q - k) * lg) : 0.f;
                In[q * IP + k] = f2bf(a[r] * dm); } }
        __syncthreads();
#pragma unroll
        for (int ot = 0; ot < (2 * NQT) / 8; ++ot) { const int tI = wid + 8 * ot, qi = tI >> 1, ej = tI & 1; f32x4 a = (f32x4){0.f, 0.f, 0.f, 0.f};
#pragma unroll
            for (int ks = 0; ks < 4; ++ks) a = __builtin_amdgcn_mfma_f32_16x16x32_bf16(ldfrag(Qs + (16 * qi + l15) * QP_ + 32 * ks + 8 * l4), ldfrag(St + (16 * ej + l15) * QP_ + 32 * ks + 8 * l4), a, 0, 0, 0);
#pragma unroll
            for (int r = 0; r < 4; ++r) a[r] *= __expf((float)(16 * qi + 4 * l4 + r + 1) * lg);
#pragma unroll
            for (int ks = 0; ks < NKS; ++ks) if (ks <= (qi >> 1)) a = __builtin_amdgcn_mfma_f32_16x16x32_bf16(ldfrag(In + (16 * qi + l15) * IP + 32 * ks + 8 * l4), ldfrag(Vt + (16 * ej + l15) * IP + 32 * ks + 8 * l4), a, 0, 0, 0);
            bf16_t* op = OB + ((long)(h * 8 + es) * T + tok0 + (long)c * CL + 16 * qi + 4 * l4) * 32 + 16 * ej + l15;
#pragma unroll
            for (int r = 0; r < 4; ++r) op[r * 32] = f2bf(a[r]); }
        { f32x4 s0 = Sacc[0] * gCL, s1 = Sacc[1] * gCL;
#pragma unroll
          for (int ks = 0; ks < NKS; ++ks) { bf16x8 af;
#pragma unroll
              for (int j = 0; j < 8; ++j) af[j] = (short)Ks[(32 * ks + 8 * l4 + j) * QP_ + 16 * wid + l15];
              s0 = __builtin_amdgcn_mfma_f32_16x16x32_bf16(af, ldfrag(Vdt + l15 * IP + 32 * ks + 8 * l4), s0, 0, 0, 0);
              s1 = __builtin_amdgcn_mfma_f32_16x16x32_bf16(af, ldfrag(Vdt + (16 + l15) * IP + 32 * ks + 8 * l4), s1, 0, 0, 0); }
          Sacc[0] = s0; Sacc[1] = s1; }
        __syncthreads();
    }
#undef RET_LOAD
#pragma unroll
    for (int ej = 0; ej < 2; ++ej)
#pragma unroll
        for (int r = 0; r < 4; ++r) so[(long)(16 * wid + 4 * l4 + r) * RV + 16 * ej + l15] = Sacc[ej][r];
}

__device__ __forceinline__ void unit(KParams& p, int l, int u, char* lds) {
    const int tid = otid(); unsigned char* ws = optr(gp(p.ws)); const bf16_t* Y = (const bf16_t*)(ws + WS_Y); bf16_t* OB = (bf16_t*)(ws + WS_OB);
    const bool samp = u >= 256; const int v = samp ? u - 256 : u; const int b = v >> 6, h = (v >> 3) & 7, es = v & 7; const float lg = p.lg[h];
    if (samp) run<64>(Y, OB, gp(p.state_ret) + ((((long)l * DB + b) * RH + h) * RQK) * RV + es * 32, gp(p.out) + O_RETS + ((((long)l * DB + b) * RH + h) * RQK) * RV + es * 32, (long)TP + b * 64, 1, h, es, lg, lds, tid);
    else run<64>(Y, OB, nullptr, gp(p.out) + O_RETP + ((((long)l * NB + b) * RH + h) * RQK) * RV + es * 32, (long)b * SEQ, SEQ / 64, h, es, lg, lds, tid);
}
}
namespace peer {
__device__ __forceinline__ void ins16(float (&l)[16], float x) {
#pragma unroll
    for (int j = 0; j < 16; ++j) { const float hi = fmaxf(l[j], x); x = fminf(l[j], x); l[j] = hi; }
}
#define CE_DESC(a, b) do { const float hi_ = fmaxf(a, b), lo_ = fminf(a, b); a = hi_; b = lo_; } while (0)
#define CE_ASC(a, b) do { const float hi_ = fmaxf(a, b), lo_ = fminf(a, b); a = lo_; b = hi_; } while (0)
__device__ __forceinline__ void sort16_desc(float (&v)[16]) {
#pragma unroll
    for (int k = 2; k <= 16; k <<= 1)
#pragma unroll
        for (int j = k >> 1; j >= 1; j >>= 1)
#pragma unroll
            for (int i = 0; i < 16; ++i) { const int l = i ^ j; if (l > i) { if ((i & k) == 0) CE_DESC(v[i], v[l]); else CE_ASC(v[i], v[l]); } }
}
__device__ __forceinline__ void merge16_desc(float (&l)[16], const float (&o)[16]) {
#pragma unroll
    for (int i = 0; i < 16; ++i) l[i] = fmaxf(l[i], o[15 - i]);
#pragma unroll
    for (int j = 8; j >= 1; j >>= 1)
#pragma unroll
        for (int i = 0; i < 16; ++i) { const int m = i ^ j; if (m > i) CE_DESC(l[i], l[m]); }
}
constexpr int KPITCH = 136;
__device__ __forceinline__ void half_top16(const bf16_t* __restrict__ qrow, const bf16_t* __restrict__ keys, int lane, float (&l)[16]) {
    const int r32 = lane & 31, g = lane >> 5;
#pragma unroll
    for (int j = 0; j < 16; ++j) l[j] = -3.0e38f;
    bf16x8 qf[8];
#pragma unroll
    for (int ks = 0; ks < 8; ++ks) qf[ks] = *reinterpret_cast<const bf16x8*>(qrow + 16 * ks + 8 * g);
#pragma unroll 1
    for (int kb = 0; kb < 4; ++kb) { f32x16 a = f32x16{};
#pragma unroll
        for (int ks = 0; ks < 8; ++ks) { const bf16x8 kf = *reinterpret_cast<const bf16x8*>(keys + (32 * kb + r32) * KPITCH + 16 * ks + 8 * g);
            a = __builtin_amdgcn_mfma_f32_32x32x16_bf16(kf, qf[ks], a, 0, 0, 0); }
        float blk[16];
#pragma unroll
        for (int r = 0; r < 16; ++r) { const unsigned key = (unsigned)(32 * kb + (r & 3) + 8 * (r >> 2) + 4 * g);
            blk[r] = __uint_as_float((__float_as_uint(a[r]) & ~0x7Fu) | key); }
        sort16_desc(blk); merge16_desc(l, blk); }
}
__device__ __forceinline__ void merge_lists(float (&l)[16], const float (&o)[16]) { merge16_desc(l, o); }
__device__ __forceinline__ void select_unit(const bf16_t* __restrict__ QP, const bf16_t* __restrict__ k1, const bf16_t* __restrict__ k2, int* __restrict__ PIDX, float* __restrict__ PW,
                                            int t0, int h, int lane, float* lds_lane  ) {
    const int r32 = lane & 31, g = lane >> 5;
    const bf16_t* qrow = QP + (long)(t0 + r32) * DM + h * 256;
    float la[16], lb[16];
    half_top16(qrow, k1, lane, la);
    half_top16(qrow + 128, k2, lane, lb);
    float m0[16], m1[16];
#pragma unroll
    for (int j = 0; j < 16; ++j) { auto rr = __builtin_amdgcn_permlane32_swap(__float_as_uint(la[j]), __float_as_uint(lb[j]), false, false); m0[j] = __uint_as_float(rr[0]); m1[j] = __uint_as_float(rr[1]); }
    merge_lists(m0, m1);
    float L1[16], L2[16];
#pragma unroll
    for (int j = 0; j < 16; ++j) { auto rr = __builtin_amdgcn_permlane32_swap(__float_as_uint(m0[j]), __float_as_uint(m0[j]), false, false);
        L1[j] = __uint_as_float(rr[0]); L2[j] = __uint_as_float(rr[1]); }
#define CAND(i, j) __uint_as_float((__float_as_uint(L1[i] + L2[j]) & ~0xFFu) | (unsigned)((i) * 16 + (j)))
    float best[16], c2[16], c3[16];
#pragma unroll
    for (int j = 0; j < 16; ++j) best[j] = CAND(0, j);
    sort16_desc(best);
    c2[0] = CAND(1, 0); c2[1] = CAND(1, 1); c2[2] = CAND(1, 2); c2[3] = CAND(1, 3); c2[4] = CAND(1, 4); c2[5] = CAND(1, 5); c2[6] = CAND(1, 6); c2[7] = CAND(1, 7);
    c2[8] = CAND(2, 0); c2[9] = CAND(2, 1); c2[10] = CAND(2, 2); c2[11] = CAND(2, 3); c2[12] = CAND(2, 4); c2[13] = CAND(4, 0); c2[14] = CAND(4, 1); c2[15] = CAND(4, 2);
    sort16_desc(c2); merge16_desc(best, c2);
    c3[0] = CAND(3, 0); c3[1] = CAND(3, 1); c3[2] = CAND(3, 2); c3[3] = CAND(3, 3); c3[4] = CAND(5, 0); c3[5] = CAND(5, 1); c3[6] = CAND(6, 0); c3[7] = CAND(6, 1);
    c3[8] = CAND(7, 0); c3[9] = CAND(7, 1); c3[10] = CAND(8, 0); c3[11] = CAND(9, 0); c3[12] = CAND(10, 0); c3[13] = CAND(11, 0); c3[14] = CAND(12, 0); c3[15] = CAND(13, 0);
    sort16_desc(c3); merge16_desc(best, c3);
    ins16(best, CAND(14, 0)); ins16(best, CAND(15, 0));
#undef CAND
#pragma unroll
    for (int j = 0; j < 16; ++j) { lds_lane[j] = __uint_as_float(__float_as_uint(L1[j]) & 0x7Fu); lds_lane[16 + j] = __uint_as_float(__float_as_uint(L2[j]) & 0x7Fu); }
    asm volatile("s_waitcnt lgkmcnt(0)" ::: "memory");
    float wsum = 0.f, w[16]; int ei[16];
    const float mx = best[0];
#pragma unroll
    for (int k = 0; k < 16; ++k) { const unsigned code = __float_as_uint(best[k]) & 0xFFu; const int i = (int)(code >> 4), j = (int)(code & 15u);
        const int i1 = (int)__float_as_uint(lds_lane[i]), i2 = (int)__float_as_uint(lds_lane[16 + j]); ei[k] = i1 * NKEYS + i2;
        w[k] = __expf(best[k] - mx); wsum += w[k]; }
    const float inv = 1.0f / wsum;
    if (g == 0) { int* ip = PIDX + (long)(t0 + r32) * 128 + h * 16; float* wp = PW + (long)(t0 + r32) * 128 + h * 16;
#pragma unroll
        for (int k = 0; k < 16; k += 4) { *reinterpret_cast<int4*>(ip + k) = make_int4(ei[k], ei[k + 1], ei[k + 2], ei[k + 3]);
            *reinterpret_cast<float4*>(wp + k) = make_float4(w[k] * inv, w[k + 1] * inv, w[k + 2] * inv, w[k + 3] * inv); } }
}

__device__ __forceinline__ float gelu_exact(float x) { return 0.5f * x * (1.0f + erff(x * 0.70710678118654752f)); }

__device__ __forceinline__ void dec16(const u32x4 w, f32x2 (&f)[8]) {
    f[0] = __builtin_amdgcn_cvt_pk_f32_fp8((int)w.x, false); f[1] = __builtin_amdgcn_cvt_pk_f32_fp8((int)w.x, true);
    f[2] = __builtin_amdgcn_cvt_pk_f32_fp8((int)w.y, false); f[3] = __builtin_amdgcn_cvt_pk_f32_fp8((int)w.y, true);
    f[4] = __builtin_amdgcn_cvt_pk_f32_fp8((int)w.z, false); f[5] = __builtin_amdgcn_cvt_pk_f32_fp8((int)w.z, true);
    f[6] = __builtin_amdgcn_cvt_pk_f32_fp8((int)w.w, false); f[7] = __builtin_amdgcn_cvt_pk_f32_fp8((int)w.w, true);
}
__device__ __forceinline__ void gather_token(const bf16_t* __restrict__ H, const unsigned char* __restrict__ PU, const unsigned char* __restrict__ PV, const float* __restrict__ SU, const float* __restrict__ SV,
                                             const int* __restrict__ PIDX, const float* __restrict__ PW, float* __restrict__ X, const float* __restrict__ gate  , int t, int lane) {
    f32x2 xf[2][8];
#pragma unroll
    for (int hlf = 0; hlf < 2; ++hlf)
#pragma unroll
        for (int q = 0; q < 2; ++q) { const u32x4 w = *reinterpret_cast<const u32x4*>(H + (long)t * DM + 1024 * hlf + 16 * lane + 8 * q);
            xf[hlf][4 * q + 0] = (f32x2){bflo(w.x), bfhi(w.x)}; xf[hlf][4 * q + 1] = (f32x2){bflo(w.y), bfhi(w.y)}; xf[hlf][4 * q + 2] = (f32x2){bflo(w.z), bfhi(w.z)}; xf[hlf][4 * q + 3] = (f32x2){bflo(w.w), bfhi(w.w)}; }
    f32x2 out[2][8];
#pragma unroll
    for (int hlf = 0; hlf < 2; ++hlf)
#pragma unroll
        for (int i = 0; i < 8; ++i) out[hlf][i] = (f32x2){0.f, 0.f};
    const int myidx0 = PIDX[(long)t * 128 + lane], myidx1 = PIDX[(long)t * 128 + 64 + lane];
    const float myw0 = PW[(long)t * 128 + lane], myw1 = PW[(long)t * 128 + 64 + lane];
    const float msu0 = SU[myidx0], msu1 = SU[myidx1], msv0 = SV[myidx0], msv1 = SV[myidx1];
    for (int hk = 0; hk < 128; hk += 4) {
        const int src = hk & 63; const bool lo = hk < 64;
        const int selidx = lo ? myidx0 : myidx1; const int selw = __float_as_int(lo ? myw0 : myw1), selsu = __float_as_int(lo ? msu0 : msu1), selsv = __float_as_int(lo ? msv0 : msv1);
        int e[4]; float g[4], su[4], sv[4];
#pragma unroll
        for (int k = 0; k < 4; ++k) { e[k] = __builtin_amdgcn_readlane(selidx, src + k); g[k] = __int_as_float(__builtin_amdgcn_readlane(selw, src + k));
            su[k] = __int_as_float(__builtin_amdgcn_readlane(selsu, src + k)); sv[k] = __int_as_float(__builtin_amdgcn_readlane(selsv, src + k)); }
        u32x4 uw[4][2], vw[4][2];
#pragma unroll
        for (int k = 0; k < 4; ++k) { uw[k][0] = *reinterpret_cast<const u32x4*>(PU + ((long)(lane >> 3) * NEXP + e[k]) * 128 + 16 * (lane & 7)); uw[k][1] = *reinterpret_cast<const u32x4*>(PU + ((long)(8 + (lane >> 3)) * NEXP + e[k]) * 128 + 16 * (lane & 7)); }
#pragma unroll
        for (int k = 0; k < 4; ++k) { { const u32x2 a0 = *reinterpret_cast<const u32x2*>(PV + ((long)(2 * lane) * NEXP + e[k]) * 8), a1 = *reinterpret_cast<const u32x2*>(PV + ((long)(2 * lane + 1) * NEXP + e[k]) * 8);
              const u32x2 b0 = *reinterpret_cast<const u32x2*>(PV + ((long)(128 + 2 * lane) * NEXP + e[k]) * 8), b1 = *reinterpret_cast<const u32x2*>(PV + ((long)(129 + 2 * lane) * NEXP + e[k]) * 8);
              vw[k][0] = (u32x4){a0.x, a0.y, a1.x, a1.y}; vw[k][1] = (u32x4){b0.x, b0.y, b1.x, b1.y}; } }
        float a[4];
#pragma unroll
        for (int k = 0; k < 4; ++k) { f32x2 d = (f32x2){0.f, 0.f};
#pragma unroll
            for (int hlf = 0; hlf < 2; ++hlf) { f32x2 f[8]; dec16(uw[k][hlf], f);
#pragma unroll
                for (int i = 0; i < 8; ++i) d = __builtin_elementwise_fma(f[i], xf[hlf][i], d); }
            a[k] = wave_sum(d[0] + d[1]); }
#pragma unroll
        for (int k = 0; k < 4; ++k) { const float ak = g[k] * gelu_exact(a[k] * su[k]) * sv[k]; const f32x2 a2 = (f32x2){ak, ak};
#pragma unroll
            for (int hlf = 0; hlf < 2; ++hlf) { f32x2 f[8]; dec16(vw[k][hlf], f);
#pragma unroll
                for (int i = 0; i < 8; ++i) out[hlf][i] = __builtin_elementwise_fma(f[i], a2, out[hlf][i]); } }
    }
    const float* gr = gate + (long)cond_row(t) * 12288;
#pragma unroll
    for (int hlf = 0; hlf < 2; ++hlf)
#pragma unroll
        for (int q = 0; q < 4; ++q) { const int c = 1024 * hlf + 16 * lane + 4 * q; float* xp = X + (long)t * DM + c;
            const f32x4 gv = *reinterpret_cast<const f32x4*>(gr + c); f32x4 xv = *reinterpret_cast<const f32x4*>(xp);
            xv[0] += gv[0] * out[hlf][2 * q][0]; xv[1] += gv[1] * out[hlf][2 * q][1]; xv[2] += gv[2] * out[hlf][2 * q + 1][0]; xv[3] += gv[3] * out[hlf][2 * q + 1][1];
            *reinterpret_cast<f32x4*>(xp) = xv; }
}

constexpr int SW = 128, NSL = DM / SW;
struct XInfo { int rank, xi, nx, nloc; };
__device__ __forceinline__ void upass(const bf16_t* __restrict__ H, const unsigned char* __restrict__ PU, const int* __restrict__ PIDX, const float* __restrict__ PW, const float* __restrict__ SU, const float* __restrict__ SV,
                                      float* __restrict__ DOTP, unsigned* __restrict__ PACKT, const XInfo xin, int wid, int lane) {
    const int g = lane >> 3, c = lane & 7; const int nwv = xin.nloc * 8;
    const int tlo = (int)((long)T * xin.xi / xin.nx), thi = (int)((long)T * (xin.xi + 1) / xin.nx); const int wv = tlo + xin.rank * 8 + wid;
    float* dp = DOTP;
    for (int s = 0; s < NSL; ++s) { const bool first = (s == 0), lastS = (s == NSL - 1);
        const __amdgpu_buffer_rsrc_t urs = __builtin_amdgcn_make_buffer_rsrc((void*)(PU + (long)s * NEXP * SW), 0, NEXP * SW, 0x00020000);
#define UP_ROW(e_) __builtin_bit_cast(u32x4, __builtin_amdgcn_raw_buffer_load_b128(urs, (e_) * SW + 16 * c, 0, 0))
#define UP_IDX(tt, q4) (*reinterpret_cast<const int4*>(PIDX + (long)(tt) * 128 + 16 * g + 4 * (q4)))
#define UP_X(tt, q2) (*reinterpret_cast<const u32x4*>(H + (long)(tt) * DM + SW * s + 16 * c + 8 * (q2)))
        if (wv >= thi) continue;
        u32x4 A[8], B[8]; int4 en[4]; u32x4 xn[2];
        { int4 e0[4];
#pragma unroll
          for (int q4 = 0; q4 < 4; ++q4) e0[q4] = UP_IDX(wv, q4);
          A[0] = UP_ROW(e0[0].x); A[1] = UP_ROW(e0[0].y); A[2] = UP_ROW(e0[0].z); A[3] = UP_ROW(e0[0].w); A[4] = UP_ROW(e0[1].x); A[5] = UP_ROW(e0[1].y); A[6] = UP_ROW(e0[1].z); A[7] = UP_ROW(e0[1].w);
          B[0] = UP_ROW(e0[2].x); B[1] = UP_ROW(e0[2].y); B[2] = UP_ROW(e0[2].z); B[3] = UP_ROW(e0[2].w); B[4] = UP_ROW(e0[3].x); B[5] = UP_ROW(e0[3].y); B[6] = UP_ROW(e0[3].z); B[7] = UP_ROW(e0[3].w);
          const int t1 = (wv + nwv < thi) ? wv + nwv : wv;
#pragma unroll
          for (int q4 = 0; q4 < 4; ++q4) en[q4] = UP_IDX(t1, q4);
          xn[0] = UP_X(wv, 0); xn[1] = UP_X(wv, 1); }
#pragma unroll 1
        for (int t = wv; t < thi; t += nwv) {
            const int tn = (t + nwv < thi) ? t + nwv : t, tnn = (tn + nwv < thi) ? tn + nwv : tn;
            f32x2 xf[8];
#pragma unroll
            for (int q2 = 0; q2 < 2; ++q2) { const u32x4 hw = xn[q2];
                xf[4 * q2 + 0] = (f32x2){bflo(hw.x), bfhi(hw.x)}; xf[4 * q2 + 1] = (f32x2){bflo(hw.y), bfhi(hw.y)}; xf[4 * q2 + 2] = (f32x2){bflo(hw.z), bfhi(hw.z)}; xf[4 * q2 + 3] = (f32x2){bflo(hw.w), bfhi(hw.w)}; }
            xn[0] = UP_X(tn, 0); xn[1] = UP_X(tn, 1);
            float d[16];
#pragma unroll
            for (int i = 0; i < 8; ++i) { f32x2 f[8]; dec16(A[i], f); f32x2 a = (f32x2){0.f, 0.f};
#pragma unroll
                for (int k = 0; k < 8; ++k) a = __builtin_elementwise_fma(f[k], xf[k], a);
                d[i] = a[0] + a[1]; }
            A[0] = UP_ROW(en[0].x); A[1] = UP_ROW(en[0].y); A[2] = UP_ROW(en[0].z); A[3] = UP_ROW(en[0].w); A[4] = UP_ROW(en[1].x); A[5] = UP_ROW(en[1].y); A[6] = UP_ROW(en[1].z); A[7] = UP_ROW(en[1].w);
#pragma unroll
            for (int i = 0; i < 8; ++i) { f32x2 f[8]; dec16(B[i], f); f32x2 a = (f32x2){0.f, 0.f};
#pragma unroll
                for (int k = 0; k < 8; ++k) a = __builtin_elementwise_fma(f[k], xf[k], a);
                d[8 + i] = a[0] + a[1]; }
            B[0] = UP_ROW(en[2].x); B[1] = UP_ROW(en[2].y); B[2] = UP_ROW(en[2].z); B[3] = UP_ROW(en[2].w); B[4] = UP_ROW(en[3].x); B[5] = UP_ROW(en[3].y); B[6] = UP_ROW(en[3].z); B[7] = UP_ROW(en[3].w);
#pragma unroll
            for (int q4 = 0; q4 < 4; ++q4) en[q4] = UP_IDX(tnn, q4);
            float r8[8], r4[4], r2[2];
#pragma unroll
            for (int k = 0; k < 8; ++k) { const float keep = (c & 4) ? d[k + 8] : d[k], send = (c & 4) ? d[k] : d[k + 8]; r8[k] = keep + sx<4>(send); }
#pragma unroll
            for (int k = 0; k < 4; ++k) { const float keep = (c & 2) ? r8[k + 4] : r8[k], send = (c & 2) ? r8[k] : r8[k + 4]; r4[k] = keep + sx<2>(send); }
#pragma unroll
            for (int k = 0; k < 2; ++k) { const float keep = (c & 1) ? r4[k + 2] : r4[k], send = (c & 1) ? r4[k] : r4[k + 2]; r2[k] = keep + sx<1>(send); }
            float* o = dp + (long)t * 128 + 16 * g + 2 * c;
            f32x2 acc = (f32x2){r2[0], r2[1]};
            if (!first) acc += *reinterpret_cast<const f32x2*>(o);
            if (!lastS) *reinterpret_cast<f32x2*>(o) = acc;
            else {
                const int p0 = 16 * g + 2 * c; const int2 ee = *reinterpret_cast<const int2*>(PIDX + (long)t * 128 + p0); const f32x2 gw = *reinterpret_cast<const f32x2*>(PW + (long)t * 128 + p0);
                const float a0 = gw[0] * gelu_exact(acc[0] * SU[ee.x]) * SV[ee.x], a1 = gw[1] * gelu_exact(acc[1] * SU[ee.y]) * SV[ee.y];
                u32x2 pk; pk.x = (cvt_pk_bf16(0.f, a0) & 0xffff0000u) | (unsigned)ee.x; pk.y = (cvt_pk_bf16(0.f, a1) & 0xffff0000u) | (unsigned)ee.y;
                *reinterpret_cast<u32x2*>(PACKT + ((long)(p0 >> 2) * T + t) * 4 + (p0 & 3)) = pk; }
        }
#undef UP_ROW
#undef UP_IDX
#undef UP_X
    }
}
__device__ __forceinline__ void actpass(const float* __restrict__ DOTP, const int* __restrict__ PIDX, const float* __restrict__ PW, const float* __restrict__ SU, const float* __restrict__ SV, float* __restrict__ ACT, int nx, long gt, long nt) {
    for (long i = gt; i < (long)T * 128; i += nt) { float dsum = 0.f;
        for (int x = 0; x < nx; ++x) dsum += DOTP[(long)x * T * 128 + i];
        const int e = PIDX[i]; const float av = PW[i] * gelu_exact(dsum * SU[e]) * SV[e]; const long t = i >> 7; const int pp = (int)(i & 127);
        reinterpret_cast<unsigned*>(ACT)[((long)(pp >> 2) * T + t) * 4 + (pp & 3)] = (cvt_pk_bf16(0.f, av) & 0xffff0000u) | (unsigned)e; }
}
__device__ __forceinline__ void vpass(const unsigned char* __restrict__ PV, const int* __restrict__ PIDX, const float* __restrict__ ACT, float* __restrict__ X, const float* __restrict__ gate, const XInfo xin, int wid, int lane) {
    const int g = lane >> 3, c = lane & 7; const int wv = xin.rank * 8 + wid, nwv = xin.nloc * 8;
    for (int s = xin.xi; s < NSL; s += xin.nx) {
        int4 en[4]; f32x4 an[4];
#pragma unroll
        for (int q4 = 0; q4 < 4; ++q4) { en[q4] = *reinterpret_cast<const int4*>(PIDX + (long)(wv < T ? wv : 0) * 128 + 16 * g + 4 * q4); an[q4] = *reinterpret_cast<const f32x4*>(ACT + (long)(wv < T ? wv : 0) * 128 + 16 * g + 4 * q4); }
        for (int t = wv; t < T; t += nwv) {
            int e[16]; float a[16];
#pragma unroll
            for (int q4 = 0; q4 < 4; ++q4) { e[4 * q4] = en[q4].x; e[4 * q4 + 1] = en[q4].y; e[4 * q4 + 2] = en[q4].z; e[4 * q4 + 3] = en[q4].w; a[4 * q4] = an[q4][0]; a[4 * q4 + 1] = an[q4][1]; a[4 * q4 + 2] = an[q4][2]; a[4 * q4 + 3] = an[q4][3]; }
            u32x4 w[16];
#pragma unroll
            for (int i = 0; i < 16; ++i) w[i] = *reinterpret_cast<const u32x4*>(PV + ((long)s * NEXP + e[i]) * SW + 16 * c);
            { const int tn = (t + nwv < T) ? t + nwv : t;
#pragma unroll
              for (int q4 = 0; q4 < 4; ++q4) { en[q4] = *reinterpret_cast<const int4*>(PIDX + (long)tn * 128 + 16 * g + 4 * q4); an[q4] = *reinterpret_cast<const f32x4*>(ACT + (long)tn * 128 + 16 * g + 4 * q4); } }
            f32x2 o[8];
#pragma unroll
            for (int k = 0; k < 8; ++k) o[k] = (f32x2){0.f, 0.f};
#pragma unroll
            for (int i = 0; i < 16; ++i) { f32x2 f[8]; dec16(w[i], f); const f32x2 a2 = (f32x2){a[i], a[i]};
#pragma unroll
                for (int k = 0; k < 8; ++k) o[k] = __builtin_elementwise_fma(f[k], a2, o[k]); }
            f32x2 r4[4], r2[2], r1;
#pragma unroll
            for (int k = 0; k < 4; ++k) { const f32x2 keep = (g & 4) ? o[k + 4] : o[k], send = (g & 4) ? o[k] : o[k + 4]; r4[k] = keep + (f32x2){sx<32>(send[0]), sx<32>(send[1])}; }
#pragma unroll
            for (int k = 0; k < 2; ++k) { const f32x2 keep = (g & 2) ? r4[k + 2] : r4[k], send = (g & 2) ? r4[k] : r4[k + 2]; r2[k] = keep + (f32x2){sx<16>(send[0]), sx<16>(send[1])}; }
            { const f32x2 keep = (g & 1) ? r2[1] : r2[0], send = (g & 1) ? r2[0] : r2[1]; r1 = keep + (f32x2){sx<8>(send[0]), sx<8>(send[1])}; }
            const int col = SW * s + 16 * c + 2 * g;
            const f32x2 gv = *reinterpret_cast<const f32x2*>(gate + (long)cond_row(t) * 12288 + col);
            float* xp = X + (long)t * DM + col; f32x2 xv = *reinterpret_cast<const f32x2*>(xp);
            xv += gv * r1; *reinterpret_cast<f32x2*>(xp) = xv;
        }
    }
}

__device__ __forceinline__ void vpass_lds(const unsigned char* __restrict__ PV, const unsigned* __restrict__ PACKT, float* __restrict__ X, const float* __restrict__ gate, char* lds, int bid, int nb, int s_end, int tid) {
    const int wid = tid >> 6, lane = tid & 63;
    for (int s = bid; s < s_end; s += nb) {
        __syncthreads();
        { const u32x4* src = reinterpret_cast<const u32x4*>(PV + (long)s * NEXP * 8); u32x4* dst = reinterpret_cast<u32x4*>(lds);
#pragma unroll 4
          for (int i = tid; i < NEXP * 8 / 16; i += 512) dst[i] = src[i]; }
        __syncthreads();
        u32x4 h0[8], h1[8];
        const __amdgpu_buffer_rsrc_t vrs = __builtin_amdgcn_make_buffer_rsrc((void*)PACKT, 0, (int)((size_t)T * 128 * 4), 0x00020000);
#define VP_LD(k, toff) __builtin_bit_cast(u32x4, __builtin_amdgcn_raw_buffer_load_b128(vrs, (int)(toff), (int)((size_t)(k) * T * 16), 0))
        { const unsigned toff = (unsigned)(wid * 64 + lane) * 16u;
#pragma unroll
          for (int k = 0; k < 8; ++k) h0[k] = VP_LD(k, toff);
#pragma unroll
          for (int k = 0; k < 8; ++k) h1[k] = VP_LD(8 + k, toff); }
#define VP_STEP(HB) do { _Pragma("unroll") for (int kk = 0; kk < 8; kk += 2) { unsigned pw[8]; \
            _Pragma("unroll") for (int k = 0; k < 2; ++k) { pw[4 * k] = HB[kk + k].x; pw[4 * k + 1] = HB[kk + k].y; pw[4 * k + 2] = HB[kk + k].z; pw[4 * k + 3] = HB[kk + k].w; } \
            u32x2 w[8]; \
            _Pragma("unroll") for (int k = 0; k < 8; ++k) w[k] = *reinterpret_cast<const u32x2*>(lds + (pw[k] & 0xffffu) * 8u); \
            _Pragma("unroll") for (int k = 0; k < 8; ++k) { const float a = __uint_as_float(pw[k] & 0xffff0000u); \
                const f32x2 f0 = __builtin_amdgcn_cvt_pk_f32_fp8((int)w[k].x, false), f1 = __builtin_amdgcn_cvt_pk_f32_fp8((int)w[k].x, true), f2 = __builtin_amdgcn_cvt_pk_f32_fp8((int)w[k].y, false), f3 = __builtin_amdgcn_cvt_pk_f32_fp8((int)w[k].y, true); \
                acc[0] = fmaf(a, f0[0], acc[0]); acc[1] = fmaf(a, f0[1], acc[1]); acc[2] = fmaf(a, f1[0], acc[2]); acc[3] = fmaf(a, f1[1], acc[3]); \
                acc[4] = fmaf(a, f2[0], acc[4]); acc[5] = fmaf(a, f2[1], acc[5]); acc[6] = fmaf(a, f3[0], acc[6]); acc[7] = fmaf(a, f3[1], acc[7]); } } } while (0)
#pragma unroll 1
        for (int tg = wid; tg < T / 64; tg += 8) { const int t = tg * 64 + lane; const int tgn = (tg + 8 < T / 64) ? tg + 8 : tg;
            const unsigned toff = (unsigned)t * 16u, toffn = (unsigned)(tgn * 64 + lane) * 16u;
            float acc[8];
#pragma unroll
            for (int j = 0; j < 8; ++j) acc[j] = 0.f;
            VP_STEP(h0);
#pragma unroll
            for (int k = 0; k < 8; ++k) h0[k] = VP_LD(16 + k, toff);
            VP_STEP(h1);
#pragma unroll
            for (int k = 0; k < 8; ++k) h1[k] = VP_LD(24 + k, toff);
            VP_STEP(h0);
#pragma unroll
            for (int k = 0; k < 8; ++k) h0[k] = VP_LD(k, toffn);
            VP_STEP(h1);
#pragma unroll
            for (int k = 0; k < 8; ++k) h1[k] = VP_LD(8 + k, toffn);
            const float* gr = gate + (long)cond_row(t) * 12288 + 8 * s; float* xp = X + (long)t * DM + 8 * s;
            const f32x4 g0 = *reinterpret_cast<const f32x4*>(gr), g1 = *reinterpret_cast<const f32x4*>(gr + 4);
            f32x4 x0 = *reinterpret_cast<const f32x4*>(xp), x1 = *reinterpret_cast<const f32x4*>(xp + 4);
            x0[0] += g0[0] * acc[0]; x0[1] += g0[1] * acc[1]; x0[2] += g0[2] * acc[2]; x0[3] += g0[3] * acc[3];
            x1[0] += g1[0] * acc[4]; x1[1] += g1[1] * acc[5]; x1[2] += g1[2] * acc[6]; x1[3] += g1[3] * acc[7];
            *reinterpret_cast<f32x4*>(xp) = x0; *reinterpret_cast<f32x4*>(xp + 4) = x1; }
#undef VP_STEP
#undef VP_LD
    }
    __syncthreads();
}
}
namespace ph {
__device__ __forceinline__ int gwave() { return obid() * 8 + (otid() >> 6); }
__device__ __forceinline__ int nwaves() { return ogrid() * 8; }
__device__ __forceinline__ long gthread() { return (long)obid() * 512 + otid(); }
__device__ __forceinline__ long nthreads() { return (long)ogrid() * 512; }

__device__ __forceinline__ void transpose_tile(const float* __restrict__ src, int C, int r0, int c0, bf16_t* __restrict__ dst, long dpitch, float* tile) {
    const int tid = otid();
#pragma unroll
    for (int i = 0; i < 8; ++i) { const int idx = tid + 512 * i, r = idx >> 6, c = idx & 63; tile[r * 65 + c] = src[(long)(r0 + r) * C + c0 + c]; }
    __syncthreads();
    { const int c = tid >> 3, rc = (tid & 7) * 8; float f[8];
#pragma unroll
      for (int j = 0; j < 8; ++j) f[j] = tile[(rc + j) * 65 + c];
      *reinterpret_cast<u32x4*>(dst + (long)(c0 + c) * dpitch + r0 + rc) = pack8(f); }
    __syncthreads();
}

__device__ __forceinline__ void zero_chunks(bf16_t* base, long nrows, long rowpitch, int col0, int nchunk) {
    const long total = nrows * nchunk;
    for (long i = gthread(); i < total; i += nthreads()) { const long r = i / nchunk; const int ch = (int)(i % nchunk);
        *reinterpret_cast<u32x4*>(base + r * rowpitch + col0 + ch * 8) = (u32x4){0u, 0u, 0u, 0u}; }
}

__device__ __forceinline__ void prologue(KParams& p, char* lds) {
    unsigned char* ws = optr(gp(p.ws)); const int tid = otid();
    float* tile = (float*)lds;
    { struct TJob { const float* src; bf16_t* dst; int R, C, r0, c0, perm; };
      auto decode = [&](int it) { TJob j; j.perm = 0; const int l = it / 10656; int r = it % 10656;
        if (r < 5664) { j.src = gp(p.w_in) + (long)l * DM * INW; j.R = DM; j.C = INW; j.dst = (bf16_t*)(ws + WS_WIN) + (long)l * INWP * DM; }
        else if (r < 6048) { r -= 5664; j.src = gp(p.w_uq) + (long)l * 512 * 3072; j.R = 512; j.C = 3072; j.dst = (bf16_t*)(ws + WS_WUQ) + (long)l * 3072 * 512; j.perm = 1; }
        else if (r < 6560) { r -= 6048; j.src = gp(p.w_ukv) + (long)l * 512 * 4096; j.R = 512; j.C = 4096; j.dst = (bf16_t*)(ws + WS_WUKV) + (long)l * 4096 * 512; }
        else { r -= 6560; const int m = r >> 10; r &= 1023; j.R = DM; j.C = DM;
            j.src = (m == 0 ? gp(p.w_a) : m == 1 ? gp(p.w_b) : m == 2 ? gp(p.w_o) : gp(p.w_pq)) + (long)l * DM * DM;
            j.dst = (bf16_t*)(ws + (m == 0 ? WS_WA : m == 1 ? WS_WB : m == 2 ? WS_WO : WS_WPQ)) + (long)l * DM * DM; }
        const int ntc = j.C / 64; j.r0 = (r / ntc) * 64; j.c0 = (r % ntc) * 64; return j; };
      const int NTILES = 2 * 10656, G_ = ogrid(); int it = obid(); float v[8]; TJob cur{};
      if (it < NTILES) { cur = decode(it);
#pragma unroll
        for (int i = 0; i < 8; ++i) { const int idx = tid + 512 * i, r = idx >> 6, c = idx & 63; v[i] = cur.src[(long)(cur.r0 + r) * cur.C + cur.c0 + c]; } }
      while (it < NTILES) { const int itn = it + G_; float vn[8]; TJob nxt{};
        if (itn < NTILES) { nxt = decode(itn);
#pragma unroll
            for (int i = 0; i < 8; ++i) { const int idx = tid + 512 * i, r = idx >> 6, c = idx & 63; vn[i] = nxt.src[(long)(nxt.r0 + r) * nxt.C + nxt.c0 + c]; } }
#pragma unroll
        for (int i = 0; i < 8; ++i) { const int idx = tid + 512 * i, r = idx >> 6, c = idx & 63; tile[r * 65 + c] = v[i]; }
        __syncthreads();
        { const int c = tid >> 3, rc = (tid & 7) * 8; float f[8];
#pragma unroll
          for (int jj = 0; jj < 8; ++jj) f[jj] = tile[(rc + jj) * 65 + c];
          int drow = cur.c0 + c;
          if (cur.perm) { const int gq = drow / 768, o = drow - 768 * gq, hh = o / 192, w = o - 192 * hh;
              drow = 768 * gq + (w < 128 ? 128 * hh + w : (w < 160 ? 512 + 32 * hh + (w - 128) : 640 + 32 * hh + (w - 160))); }
          *reinterpret_cast<u32x4*>(cur.dst + (long)drow * cur.R + cur.r0 + rc) = pack8(f); }
        __syncthreads();
#pragma unroll
        for (int i = 0; i < 8; ++i) v[i] = vn[i];
        cur = nxt; it = itn; } }
    for (long i = gthread(); i < 2L * 16 * 512 * 32; i += nthreads()) { const int ch = (int)(i & 31); const long row = i >> 5; const int c = (int)(row & 511), h = (int)((row >> 9) & 15), l = (int)(row >> 13);
        u32x4 w = (u32x4){0u, 0u, 0u, 0u};
        if (ch < 16) { const float* s = gp(p.w_ukv) + (((long)l * 512 + c) * 16 + h) * 256 + ch * 8; float f[8];
#pragma unroll
            for (int j = 0; j < 8; ++j) f[j] = s[j];
            w = pack8(f); }
        *reinterpret_cast<u32x4*>((bf16_t*)(ws + WS_WUK) + row * 256 + ch * 8) = w; }
    for (long i = gthread(); i < 2L * 4096; i += nthreads()) { const bool second = i >= 4096; const long j8 = (second ? i - 4096 : i) * 8; const float* s = (second ? gp(p.peer_k2) : gp(p.peer_k1)) + j8; float f[8];
#pragma unroll
        for (int j = 0; j < 8; ++j) f[j] = s[j];
        *reinterpret_cast<u32x4*>((bf16_t*)(ws + (second ? WS_PK2 : WS_PK1)) + j8) = pack8(f); }
    for (int l = 0; l < 2; ++l) zero_chunks((bf16_t*)(ws + WS_WIN) + ((long)l * INWP + INW) * DM, INWP - INW, DM, 0, DM / 8);
    for (int b = 0; b < DB; ++b) zero_chunks((bf16_t*)(ws + WS_CKA) + ((long)b * KPAD + KALL) * QLD, KPAD - KALL, QLD, 0, QLD / 8);
    zero_chunks((bf16_t*)(ws + WS_CKA), (long)DB * KPAD, QLD, 576, 8);
    zero_chunks((bf16_t*)(ws + WS_CKT), (long)DB * 512, KPAD, KALL, (KPAD - KALL) / 8);
    zero_chunks((bf16_t*)(ws + WS_QL), (long)DB * 1024, QLD, 576, 8);
    for (long i = gthread(); i < 4096L * 96; i += nthreads()) { const int pos = (int)(i / 96), k = (int)(i % 96); const bool big = k >= 32; const int fi = big ? k - 32 : k; const float d = big ? 128.f : 64.f;
        const float inv = __builtin_amdgcn_exp2f(-(2.0f * (float)fi / d) * 13.287712379549449f);
        const float ang = (float)pos * inv; double rv = (double)ang * 0.15915494309189535; rv -= floor(rv); const float fr = (float)rv;
        float* dst = big ? (float*)(ws + WS_TAB128) + ((long)pos * 64 + fi) * 2 : (float*)(ws + WS_TAB64) + ((long)pos * 32 + fi) * 2;
        dst[0] = __builtin_amdgcn_cosf(fr); dst[1] = __builtin_amdgcn_sinf(fr); }
    { float* sc = (float*)lds;
      for (int it = obid(); it < 2 * 12 * 8; it += ogrid()) { const int l = it / 96, cc = (it % 96) / 8, ks = it % 8;
        __syncthreads();
        for (int i = tid; i < NCOND * 256; i += 512) { const int r = i >> 8, k = i & 255; const float c = r < NB ? gp(p.c_prompt)[(long)r * DM + ks * 256 + k] : gp(p.c_sample)[(long)(r - NB) * DM + ks * 256 + k]; sc[i] = siluf_(c); }
        __syncthreads();
        float a0[NCOND], a1[NCOND];
#pragma unroll
        for (int r = 0; r < NCOND; ++r) { a0[r] = 0.f; a1[r] = 0.f; }
        const float* wp = gp(p.w_ada) + ((long)l * DM + ks * 256) * 12288 + cc * 1024 + 2 * tid;
#pragma unroll 1
        for (int k = 0; k < 256; k += 4) { const f32x2 w0 = *reinterpret_cast<const f32x2*>(wp), w1 = *reinterpret_cast<const f32x2*>(wp + 12288), w2 = *reinterpret_cast<const f32x2*>(wp + 2 * 12288), w3 = *reinterpret_cast<const f32x2*>(wp + 3 * 12288);
            wp += 4 * 12288;
#pragma unroll
            for (int r = 0; r < NCOND; ++r) { const f32x4 s = *reinterpret_cast<const f32x4*>(sc + r * 256 + k);
                a0[r] = fmaf(s[0], w0[0], fmaf(s[1], w1[0], fmaf(s[2], w2[0], fmaf(s[3], w3[0], a0[r]))));
                a1[r] = fmaf(s[0], w0[1], fmaf(s[1], w1[1], fmaf(s[2], w2[1], fmaf(s[3], w3[1], a1[r]))));
                if ((r % 6) == 5) __builtin_amdgcn_sched_barrier(0); } }
        float* dst = (float*)(ws + WS_ADAP) + (((long)ks * 2 + l) * NCOND) * 12288 + cc * 1024 + 2 * tid;
#pragma unroll
        for (int r = 0; r < NCOND; ++r) *reinterpret_cast<f32x2*>(dst + (long)r * 12288) = (f32x2){a0[r], a1[r]}; }
      __syncthreads(); }
}

__device__ __forceinline__ void wpq_int8(KParams& p) {
    unsigned char* ws = optr(gp(p.ws)); const int lane = otid() & 63;
    for (int r = gwave(); r < 2 * DM; r += nwaves()) { const bf16_t* src = (const bf16_t*)(ws + WS_WPQ) + (long)r * DM; float f[4][8]; float am = 0.f;
#pragma unroll
        for (int j = 0; j < 4; ++j) { unpack8(*reinterpret_cast<const u32x4*>(src + 512 * j + 8 * lane), f[j]);
#pragma unroll
            for (int i = 0; i < 8; ++i) am = fmaxf(am, fabsf(f[j][i])); }
        am = wave_max(am); const float qs = am > 0.f ? 127.0f / am : 0.f;
#pragma unroll
        for (int j = 0; j < 4; ++j) { unsigned w2[2];
#pragma unroll
            for (int hh = 0; hh < 2; ++hh) { unsigned w = 0u;
#pragma unroll
                for (int i = 0; i < 4; ++i) w |= ((unsigned)((int)__builtin_rintf(f[j][4 * hh + i] * qs) & 0xff)) << (8 * i);
                w2[hh] = w; }
            *reinterpret_cast<u32x2*>(ws + WS_WPQ8 + (long)r * DM + 512 * j + 8 * lane) = (u32x2){w2[0], w2[1]}; }
        if (lane == 0) ((float*)(ws + WS_SB8))[r] = am * (1.0f / 127.0f); }
}

__device__ __forceinline__ void win_int8(KParams& p, int l) {
    unsigned char* ws = optr(gp(p.ws)); const int lane = otid() & 63;
    for (int jr = gwave(); jr < NB8 * 256; jr += nwaves()) { const int blk = jr >> 8, n = (blk < 3 ? blk + 5 : blk + 18) * 256 + (jr & 255);
        const bf16_t* src = (const bf16_t*)(ws + WS_WIN) + ((long)l * INWP + n) * DM; float f[4][8]; float am = 0.f;
#pragma unroll
        for (int j = 0; j < 4; ++j) { unpack8(*reinterpret_cast<const u32x4*>(src + 512 * j + 8 * lane), f[j]);
#pragma unroll
            for (int i = 0; i < 8; ++i) am = fmaxf(am, fabsf(f[j][i])); }
        am = wave_max(am); const float qs = am > 0.f ? 127.0f / am : 0.f;
#pragma unroll
        for (int j = 0; j < 4; ++j) { unsigned w2[2];
#pragma unroll
            for (int hh = 0; hh < 2; ++hh) { unsigned w = 0u;
#pragma unroll
                for (int i = 0; i < 4; ++i) w |= ((unsigned)((int)__builtin_rintf(f[j][4 * hh + i] * qs) & 0xff)) << (8 * i);
                w2[hh] = w; }
            *reinterpret_cast<u32x2*>(ws + WS_WIN8 + (long)jr * DM + 512 * j + 8 * lane) = (u32x2){w2[0], w2[1]}; }
        if (lane == 0) ((float*)(ws + WS_SBW))[n] = am * (1.0f / 127.0f); }
}

__device__ __forceinline__ void ada_reduce(KParams& p) {
    unsigned char* ws = optr(gp(p.ws)); const float* ap = (const float*)(ws + WS_ADAP); float* ad = (float*)(ws + WS_ADA); const long n = 2L * NCOND * 12288;
    for (long i = gthread(); i < n; i += nthreads()) { const int l = (int)(i / (NCOND * 12288L)); const int j = (int)(i % 12288);
        float s = gp(p.b_ada)[(long)l * 12288 + j];
#pragma unroll
        for (int ks = 0; ks < 8; ++ks) s += ap[(long)ks * n + i];
        ad[i] = s; }
}

__device__ __forceinline__ void modulate(KParams& p, int l, int which) {
    const int lane = otid() & 63; unsigned char* ws = optr(gp(p.ws)); const float* X = gp(p.out); bf16_t* H = (bf16_t*)(ws + WS_H);
    const float* g = (which ? gp(p.g_ffn) : gp(p.g_mix)) + (long)l * DM; const float* ada = (const float*)(ws + WS_ADA) + (long)l * NCOND * 12288 + (which ? 3 : 0) * DM;
    for (int t = gwave(); t < T; t += nwaves()) {
        const float* xr = (l == 0 && which == 0) ? (t < TP ? gp(p.x_prompt) + (long)t * DM : gp(p.x_sample) + (long)(t - TP) * DM) : X + (long)t * DM; f32x4 v[8]; float ss = 0.f;
#pragma unroll
        for (int j = 0; j < 8; ++j) { v[j] = *reinterpret_cast<const f32x4*>(xr + 256 * j + 4 * lane); ss += v[j][0] * v[j][0] + v[j][1] * v[j][1] + v[j][2] * v[j][2] + v[j][3] * v[j][3]; }
        ss = wave_sum(ss); const float rinv = rsqrtf(ss * (1.0f / DM) + EPS);
        const float* sh = ada + (long)cond_row(t) * 12288; const float* sc = sh + DM;
#pragma unroll
        for (int j = 0; j < 8; ++j) { const int c = 256 * j + 4 * lane; const f32x4 gv = *reinterpret_cast<const f32x4*>(g + c), sv = *reinterpret_cast<const f32x4*>(sc + c), hv = *reinterpret_cast<const f32x4*>(sh + c);
            const f32x4 y = v[j] * rinv * gv * (sv + 1.0f) + hv; u32x2 w; w.x = cvt_pk_bf16(y[0], y[1]); w.y = cvt_pk_bf16(y[2], y[3]);
            *reinterpret_cast<u32x2*>(H + (long)t * DM + c) = w; v[j] = y; }
        {
            float am = 0.f;
#pragma unroll
            for (int j = 0; j < 8; ++j) am = fmaxf(am, fmaxf(fmaxf(fabsf(v[j][0]), fabsf(v[j][1])), fmaxf(fabsf(v[j][2]), fabsf(v[j][3]))));
            am = wave_max(am); const float qs = am > 0.f ? 127.0f / am : 0.f;
#pragma unroll
            for (int j = 0; j < 8; ++j) { const int c = 256 * j + 4 * lane;
                const int q0 = (int)__builtin_rintf(v[j][0] * qs), q1 = (int)__builtin_rintf(v[j][1] * qs), q2 = (int)__builtin_rintf(v[j][2] * qs), q3 = (int)__builtin_rintf(v[j][3] * qs);
                *reinterpret_cast<unsigned*>(ws + WS_H8 + (long)t * DM + c) = (unsigned)(q0 & 0xff) | ((unsigned)(q1 & 0xff) << 8) | ((unsigned)(q2 & 0xff) << 16) | ((unsigned)(q3 & 0xff) << 24); }
            if (lane == 0) ((float*)(ws + WS_SA8))[t] = am * (1.0f / 127.0f); }
    }
}

__device__ __forceinline__ void cache_convert(KParams& p, int l, char* lds, int it0, int it1, int bidx, int nb) {
    const int tid = otid(); unsigned char* ws = optr(gp(p.ws)); float* tile = (float*)lds; bf16_t* CKA = (bf16_t*)(ws + WS_CKA); bf16_t* CKT = (bf16_t*)(ws + WS_CKT);
    { const int NT_ = it1, G_ = nb; int it = it0 + bidx; float v[8];
      const float* cbase = gp(p.cache_ckv) + (long)l * DB * PAST * 512;
#define CC_SRC(itx) (cbase + (((long)((itx) >> 8)) * PAST + (((itx) >> 3) & 31) * 64) * 512 + ((itx) & 7) * 64)
      if (it < NT_) { const float* src = CC_SRC(it);
#pragma unroll
        for (int i = 0; i < 8; ++i) { const int idx = tid + 512 * i, r = idx >> 6, c = idx & 63; v[i] = src[(long)r * 512 + c]; } }
      while (it < NT_) { const int b = it >> 8, kt = (it >> 3) & 31, ct = it & 7; const int itn = it + G_; float vn[8];
        if (itn < NT_) { const float* src = CC_SRC(itn);
#pragma unroll
            for (int i = 0; i < 8; ++i) { const int idx = tid + 512 * i, r = idx >> 6, c = idx & 63; vn[i] = src[(long)r * 512 + c]; } }
#pragma unroll
        for (int i = 0; i < 8; ++i) { const int idx = tid + 512 * i, r = idx >> 6, c = idx & 63; tile[r * 65 + c] = v[i]; }
        __syncthreads();
        { const int r = tid >> 3, cc = (tid & 7) * 8; float f[8];
#pragma unroll
          for (int j = 0; j < 8; ++j) f[j] = tile[r * 65 + cc + j];
          *reinterpret_cast<u32x4*>(CKA + ((long)b * KPAD + kt * 64 + r) * QLD + ct * 64 + cc) = pack8(f);
#pragma unroll
          for (int j = 0; j < 8; ++j) f[j] = tile[(cc + j) * 65 + r];
          *reinterpret_cast<u32x4*>(CKT + ((long)b * 512 + ct * 64 + r) * KPAD + kt * 64 + cc) = pack8(f); }
        __syncthreads();
#pragma unroll
        for (int i = 0; i < 8; ++i) v[i] = vn[i];
        it = itn; }
#undef CC_SRC
    }
    for (long i = (long)it0 * 64 + (long)bidx * 512 + tid; i < (long)it1 * 64; i += (long)nb * 512) { const long row = i >> 3; const int ch = (int)(i & 7); const int b = (int)(row >> 11), k = (int)(row & 2047);
        const float* s = gp(p.cache_krope) + (((long)l * DB + b) * PAST + k) * 64 + ch * 8; float f[8];
#pragma unroll
        for (int j = 0; j < 8; ++j) f[j] = s[j];
        *reinterpret_cast<u32x4*>(CKA + ((long)b * KPAD + k) * QLD + 512 + ch * 8) = pack8(f); }
}

__device__ __forceinline__ void post_win(KParams& p, int l) {
    const int lane = otid() & 63; unsigned char* ws = optr(gp(p.ws));
    bf16_t* Y = (bf16_t*)(ws + WS_Y); bf16_t* CQN = (bf16_t*)(ws + WS_CQN); bf16_t* CKVNP = (bf16_t*)(ws + WS_CKVNP); bf16_t* KRP = (bf16_t*)(ws + WS_KRP); bf16_t* CKA = (bf16_t*)(ws + WS_CKA); bf16_t* CKT = (bf16_t*)(ws + WS_CKT);
    const float* T64 = (const float*)(ws + WS_TAB64); const float* T128 = (const float*)(ws + WS_TAB128);
    for (int t = gwave(); t < T; t += nwaves()) {
        bf16_t* y = Y + (long)t * INWP; const int pos = tok_pos(t); const bool samp = t >= TP; const int ts = t - TP, b = ts >> 6, s = ts & 63;
        { float f[8], o[8]; unpack8(*reinterpret_cast<const u32x4*>(y + C_CQ + 8 * lane), f); float ss = 0.f;
#pragma unroll
          for (int j = 0; j < 8; ++j) ss += f[j] * f[j];
          ss = wave_sum(ss); const float rinv = rsqrtf(ss * (1.0f / 512.f) + EPS); const float* g = gp(p.g_q) + (long)l * 512 + 8 * lane;
#pragma unroll
          for (int j = 0; j < 8; ++j) o[j] = f[j] * rinv * g[j];
          *reinterpret_cast<u32x4*>(CQN + (long)t * 512 + 8 * lane) = pack8(o); }
        { float f[8], o[8]; unpack8(*reinterpret_cast<const u32x4*>(y + C_CKV + 8 * lane), f); float ss = 0.f;
#pragma unroll
          for (int j = 0; j < 8; ++j) ss += f[j] * f[j];
          ss = wave_sum(ss); const float rinv = rsqrtf(ss * (1.0f / 512.f) + EPS); const float* g = gp(p.g_kv) + (long)l * 512 + 8 * lane;
#pragma unroll
          for (int j = 0; j < 8; ++j) o[j] = f[j] * rinv * g[j];
          float* od = gp(p.out) + (samp ? O_CKVS + ((long)l * TS + ts) * 512 : O_CKVP + ((long)l * TP + t) * 512) + 8 * lane;
          *reinterpret_cast<f32x4*>(od) = (f32x4){o[0], o[1], o[2], o[3]}; *reinterpret_cast<f32x4*>(od + 4) = (f32x4){o[4], o[5], o[6], o[7]};
          const u32x4 w = pack8(o);
          if (!samp) *reinterpret_cast<u32x4*>(CKVNP + (long)t * 512 + 8 * lane) = w;
          else { *reinterpret_cast<u32x4*>(CKA + ((long)b * KPAD + PAST + s) * QLD + 8 * lane) = w;
#pragma unroll
              for (int j = 0; j < 8; ++j) CKT[((long)b * 512 + 8 * lane + j) * KPAD + PAST + s] = f2bf(o[j]); } }
        if (lane < 32) { const float x1 = bf2f(y[C_KR + lane]), x2 = bf2f(y[C_KR + 32 + lane]); const float c = T64[((long)pos * 32 + lane) * 2], sn = T64[((long)pos * 32 + lane) * 2 + 1];
            const float o1 = x1 * c - x2 * sn, o2 = x1 * sn + x2 * c;
            float* od = gp(p.out) + (samp ? O_KRS + ((long)l * TS + ts) * 64 : O_KRP + ((long)l * TP + t) * 64); od[lane] = o1; od[32 + lane] = o2;
            if (!samp) { KRP[(long)t * 64 + lane] = f2bf(o1); KRP[(long)t * 64 + 32 + lane] = f2bf(o2); }
            else { bf16_t* d = CKA + ((long)b * KPAD + PAST + s) * QLD + 512; d[lane] = f2bf(o1); d[32 + lane] = f2bf(o2); } }
        { const int hh = lane >> 3, d0 = (lane & 7) * 8; const float* cs = T128 + ((long)pos * 64 + d0) * 2; float cv[8], sv[8];
#pragma unroll
          for (int j = 0; j < 4; ++j) { const f32x4 q = *reinterpret_cast<const f32x4*>(cs + 4 * j); cv[2 * j] = q[0]; sv[2 * j] = q[1]; cv[2 * j + 1] = q[2]; sv[2 * j + 1] = q[3]; }
#pragma unroll
          for (int which = 0; which < 2; ++which) { bf16_t* base = y + (which ? C_RK : C_RQ) + hh * 128 + d0; const float sca = which ? 0.08838834764831845f : 1.0f;
              float a[8], bq[8], o1[8], o2[8]; unpack8(*reinterpret_cast<const u32x4*>(base), a); unpack8(*reinterpret_cast<const u32x4*>(base + 64), bq);
#pragma unroll
              for (int j = 0; j < 8; ++j) { o1[j] = (a[j] * cv[j] - bq[j] * sv[j]) * sca; o2[j] = (a[j] * sv[j] + bq[j] * cv[j]) * sca; }
              *reinterpret_cast<u32x4*>(base) = pack8(o1); *reinterpret_cast<u32x4*>(base + 64) = pack8(o2); } }
    }
}

__device__ __forceinline__ void post_q(KParams& p) {
    const int lane = otid() & 63; unsigned char* ws = optr(gp(p.ws)); bf16_t* Q = (bf16_t*)(ws + WS_Q); bf16_t* QL = (bf16_t*)(ws + WS_QL); const float* T64 = (const float*)(ws + WS_TAB64);
    for (int t = gwave(); t < T; t += nwaves()) { const int pos = tok_pos(t); const int hd = lane >> 2, d0 = (lane & 3) * 8;
        bf16_t* base = Q + (long)t * 3072 + hd * 192 + 128 + d0; const float* cs = T64 + ((long)pos * 32 + d0) * 2; float cv[8], sv[8];
#pragma unroll
        for (int j = 0; j < 4; ++j) { const f32x4 q = *reinterpret_cast<const f32x4*>(cs + 4 * j); cv[2 * j] = q[0]; sv[2 * j] = q[1]; cv[2 * j + 1] = q[2]; sv[2 * j + 1] = q[3]; }
        float a[8], bq[8], o1[8], o2[8]; unpack8(*reinterpret_cast<const u32x4*>(base), a); unpack8(*reinterpret_cast<const u32x4*>(base + 32), bq);
#pragma unroll
        for (int j = 0; j < 8; ++j) { o1[j] = a[j] * cv[j] - bq[j] * sv[j]; o2[j] = a[j] * sv[j] + bq[j] * cv[j]; }
        const u32x4 w1 = pack8(o1), w2 = pack8(o2);
        *reinterpret_cast<u32x4*>(base) = w1; *reinterpret_cast<u32x4*>(base + 32) = w2;
        if (t >= TP) { const int ts = t - TP, b = ts >> 6, s = ts & 63; bf16_t* d = QL + ((long)b * 1024 + hd * 64 + s) * QLD + 512 + d0;
            *reinterpret_cast<u32x4*>(d) = w1; *reinterpret_cast<u32x4*>(d + 32) = w2; } }
}

__device__ __forceinline__ void softmax_rows(KParams& p) {
    const int lane = otid() & 63; unsigned char* ws = optr(gp(p.ws)); bf16_t* SP = (bf16_t*)(ws + WS_SP);
    for (int r = gwave(); r < DB * 1024; r += nwaves()) { bf16_t* row = SP + (long)r * KPAD; float v[5][8]; float mx = -3.0e38f;
#pragma unroll
        for (int j = 0; j < 5; ++j) { const int ch = lane + 64 * j;
            if (ch < KALL / 8) { unpack8(*reinterpret_cast<const u32x4*>(row + ch * 8), v[j]);
#pragma unroll
                for (int i = 0; i < 8; ++i) { v[j][i] *= MLA_SCALE; mx = fmaxf(mx, v[j][i]); } }
            else {
#pragma unroll
                for (int i = 0; i < 8; ++i) v[j][i] = -3.0e38f; } }
        mx = wave_max(mx); float sum = 0.f;
#pragma unroll
        for (int j = 0; j < 5; ++j) { const int ch = lane + 64 * j;
#pragma unroll
            for (int i = 0; i < 8; ++i) { v[j][i] = (ch < KALL / 8) ? __expf(v[j][i] - mx) : 0.f; sum += v[j][i]; } }
        sum = wave_sum(sum); const float inv = 1.0f / sum;
#pragma unroll
        for (int j = 0; j < 5; ++j) { const int ch = lane + 64 * j;
            if (ch < KPAD / 8) { float o[8];
#pragma unroll
                for (int i = 0; i < 8; ++i) o[i] = v[j][i] * inv;
                *reinterpret_cast<u32x4*>(row + ch * 8) = pack8(o); } } }
}

__device__ __forceinline__ void gnorm_gate(KParams& p, int w0, int nw) {
    const int lane = otid() & 63; unsigned char* ws = optr(gp(p.ws)); const bf16_t* OB = (const bf16_t*)(ws + WS_OB); const bf16_t* Y = (const bf16_t*)(ws + WS_Y); bf16_t* BG = (bf16_t*)(ws + WS_BG);
    for (int t = w0; t < T; t += nw) { const int c0 = (lane >> 3) * 256 + (lane & 7) * 32; float x[4][8]; float s = 0.f;
#pragma unroll
        for (int i = 0; i < 4; ++i) { unpack8(*reinterpret_cast<const u32x4*>(OB + ((long)lane * T + t) * 32 + 8 * i), x[i]);
#pragma unroll
            for (int j = 0; j < 8; ++j) s += x[i][j]; }
        s += sx<1>(s); s += sx<2>(s); s += sx<4>(s); const float mu = s * (1.0f / 256.f); float q = 0.f;
#pragma unroll
        for (int i = 0; i < 4; ++i)
#pragma unroll
            for (int j = 0; j < 8; ++j) { const float d = x[i][j] - mu; q += d * d; }
        q += sx<1>(q); q += sx<2>(q); q += sx<4>(q); const float rstd = rsqrtf(q * (1.0f / 256.f) + EPS);
#pragma unroll
        for (int i = 0; i < 4; ++i) { float g[8], o[8]; unpack8(*reinterpret_cast<const u32x4*>(Y + (long)t * INWP + C_RG + c0 + 8 * i), g);
#pragma unroll
            for (int j = 0; j < 8; ++j) o[j] = siluf_(g[j]) * (x[i][j] - mu) * rstd;
            *reinterpret_cast<u32x4*>(BG + (long)t * DM + c0 + 8 * i) = pack8(o); } }
}

__device__ __forceinline__ void peer_convert(KParams& p, int l, int r0, int r1, int w0, int nw) {
    unsigned char* ws = optr(gp(p.ws)); const int lane = otid() & 63;
    const float* su = gp(p.peer_u) + (long)l * NEXP * DM; const float* sv = gp(p.peer_v) + (long)l * NEXP * DM;
    for (int r = r0 + w0; r < r1; r += nw) { const bool second = r >= NEXP; const int row = second ? r - NEXP : r; const float* s = (second ? sv : su) + (long)row * DM;
        f32x4 v[8]; float am = 0.f;
#pragma unroll
        for (int j = 0; j < 8; ++j) { v[j] = *reinterpret_cast<const f32x4*>(s + 512 * (j >> 2) * 2 + 16 * lane + 4 * (j & 3));
            am = fmaxf(am, fmaxf(fmaxf(fabsf(v[j][0]), fabsf(v[j][1])), fmaxf(fabsf(v[j][2]), fabsf(v[j][3])))); }
        am = wave_max(am);
        float sc = 1.0f, isc = 1.0f;
        if (am > 0.f) { const int e = (int)((__float_as_uint(am) >> 23) & 0xffu) - 127;
            int k = 7 - e; k = k > 100 ? 100 : (k < -100 ? -100 : k);
            sc = __uint_as_float((unsigned)(127 + k) << 23); isc = __uint_as_float((unsigned)(127 - k) << 23); }
        unsigned w[8];
#pragma unroll
        for (int j = 0; j < 8; ++j) { int pk = __builtin_amdgcn_cvt_pk_fp8_f32(v[j][0] * sc, v[j][1] * sc, 0, false); pk = __builtin_amdgcn_cvt_pk_fp8_f32(v[j][2] * sc, v[j][3] * sc, pk, true); w[j] = (unsigned)pk; }
        if (!second) {
            unsigned char* dst = ws + WS_PU + ((long)(lane >> 3) * NEXP + row) * 128 + 16 * (lane & 7);
            *reinterpret_cast<u32x4*>(dst) = (u32x4){w[0], w[1], w[2], w[3]};
            *reinterpret_cast<u32x4*>(dst + 8L * NEXP * 128) = (u32x4){w[4], w[5], w[6], w[7]};
        } else {
            unsigned char* dst = ws + WS_PV + ((long)(2 * lane) * NEXP + row) * 8;
            *reinterpret_cast<u32x2*>(dst) = (u32x2){w[0], w[1]}; *reinterpret_cast<u32x2*>(dst + (long)NEXP * 8) = (u32x2){w[2], w[3]};
            *reinterpret_cast<u32x2*>(dst + 128L * NEXP * 8) = (u32x2){w[4], w[5]}; *reinterpret_cast<u32x2*>(dst + 129L * NEXP * 8) = (u32x2){w[6], w[7]}; }
        if (lane == 0) ((float*)(ws + (second ? WS_PSV : WS_PSU)))[row] = isc; }
}

__device__ __forceinline__ void final_norm(KParams& p) {
    const int lane = otid() & 63; float* X = gp(p.out);
    for (int t = gwave(); t < T; t += nwaves()) { float* xr = X + (long)t * DM; f32x4 v[8]; float ss = 0.f;
#pragma unroll
        for (int j = 0; j < 8; ++j) { v[j] = *reinterpret_cast<const f32x4*>(xr + 256 * j + 4 * lane); ss += v[j][0] * v[j][0] + v[j][1] * v[j][1] + v[j][2] * v[j][2] + v[j][3] * v[j][3]; }
        ss = wave_sum(ss); const float rinv = rsqrtf(ss * (1.0f / DM) + EPS);
#pragma unroll
        for (int j = 0; j < 8; ++j) { const int c = 256 * j + 4 * lane; const f32x4 gv = *reinterpret_cast<const f32x4*>(gp(p.g_final) + c); *reinterpret_cast<f32x4*>(xr + c) = v[j] * rinv * gv; } }
}
}
__global__ void __launch_bounds__(512, 2) mega_fwd(Params p_by_value_unused) {
    extern __shared__ __attribute__((aligned(16))) unsigned char shm[];
    LAS unsigned char* lds = (LAS unsigned char*)shm; char* ldsg = (char*)shm;
    if (threadIdx.x < 8) ((LAS unsigned*)(lds + LDS_BARW))[threadIdx.x] = 0u;
    __syncthreads();
    if (threadIdx.x == 0) { unsigned* tk = (unsigned*)(gp(KP.ws) + WS_CTL + CTL_RANK) + 64 * xb_xcc_id(); ((volatile LAS unsigned*)(lds + LDS_BARW))[2] = xb_add(tk, 1u); }
    const XcdBarrier bar = xcd_barrier_post((unsigned*)(gp(KP.ws) + WS_CTL), (volatile LAS unsigned*)(lds + LDS_BARW));
#define GRID_SYNC() xcd_barrier(bar)
#ifndef STOP_AT
#define STOP_AT 0
#endif
#ifdef DBG_DUMP
#define STOPCHK(n) do { if (STOP_AT == (n)) { float* xo = gp(KP.out); const bf16_t* src = (const bf16_t*)(gp(KP.ws) + DBG_DUMP); for (long i = ph::gthread(); i < (long)T * DM; i += ph::nthreads()) xo[i] = bf2f(src[i]); return; } } while (0)
#elif defined(DBG_SANITIZE)
#define STOPCHK(n) do { if (STOP_AT == (n) || (STOP_AT > 100 && l == 1 && STOP_AT - 100 == (n))) { float* xo = gp(KP.out); for (long i = ph::gthread(); i < (long)T * DM; i += ph::nthreads()) { const float v = xo[i]; if (!(v - v == 0.0f)) xo[i] = 7.0f; } return; } } while (0)
#else
#define STOPCHK(n) do { if (STOP_AT == (n) || (STOP_AT > 100 && l == 1 && STOP_AT - 100 == (n))) return; } while (0)
#endif
    using namespace pg8;
#define WSP(off) ((bf16_t*)(optr(gp(KP.ws)) + (off)))
#define H WSP(WS_H)
#define Y WSP(WS_Y)
#define CQN WSP(WS_CQN)
#define CKVNP WSP(WS_CKVNP)
#define KRP WSP(WS_KRP)
#define Q WSP(WS_Q)
#define YA WSP(WS_YA)
#define KV WSP(WS_KV)
#define SP WSP(WS_SP)
#define MIX WSP(WS_MIX)
#define OA WSP(WS_OA)
#define QP WSP(WS_QP)
#define CKA WSP(WS_CKA)
#define CKT WSP(WS_CKT)
#define QL WSP(WS_QL)
#define OL WSP(WS_OL)
#define BG WSP(WS_BG)
    int l = 0;
    ph::prologue(KP, ldsg);
#ifdef DUP_PRO
    ph::prologue(KP, ldsg);
#endif
    GRID_SYNC(); STOPCHK(1);
    if (threadIdx.x == 0) { unsigned* barw = (unsigned*)(gp(KP.ws) + WS_CTL); const unsigned me = xb_xcc_id(); unsigned nx = 0, xi = 0, nloc = 1;
        for (unsigned j = 0; j < 16; ++j) { const unsigned cn = xb_ld(&barw[XB_XCNT(j)]); if (cn) { if (j < me) ++xi; ++nx; } if (j == me) nloc = cn ? cn : 1u; }
        volatile LAS unsigned* iw = (volatile LAS unsigned*)(lds + LDS_BARW); iw[3] = xi; iw[4] = nx; iw[5] = nloc; }
    __syncthreads();
    ph::ada_reduce(KP);
    ph::wpq_int8(KP);
    GRID_SYNC(); STOPCHK(2);
    for (l = 0; l < DEPTH; ++l) {
#define WIN (WSP(WS_WIN) + (long)l * INWP * DM)
#define WUQ (WSP(WS_WUQ) + (long)l * 3072 * 512)
#define WUKV (WSP(WS_WUKV) + (long)l * 4096 * 512)
#define WUK (WSP(WS_WUK) + (long)l * 16 * 512 * 256)
#define WA (WSP(WS_WA) + (long)l * DM * DM)
#define WB (WSP(WS_WB) + (long)l * DM * DM)
#define WO (WSP(WS_WO) + (long)l * DM * DM)
#define WPQ (WSP(WS_WPQ) + (long)l * DM * DM)
#define ADA ((const float*)(optr(gp(KP.ws)) + WS_ADA) + (long)l * NCOND * 12288)
        ph::modulate(KP, l, 0);
        ph::win_int8(KP, l);
        ph::cache_convert(KP, l, ldsg, l == 0 ? 0 : 4096, 8192, obid(), ogrid());
        GRID_SYNC(); STOPCHK(3);
        { Sched<0> S; S.init(T / 256, 18, (T / 256) * 18, DM, DM); S.remap(5, 0, 3, 0); gemm_phase(lds, Gemm{H, WIN, DM, DM, DM}, S, EpiBf16{Y, INWP, 0}); }
        { Sched<0> S; S.init(T / 256, NB8, (T / 256) * NB8, DM / 2, DM / 2); S.remap(3, 5, 18, 1);
          { const int G_ = ogrid(); S.rotate((((((T / 256) * NB8) % G_) + 7) & ~7) % G_); }
          unsigned char* ws8 = optr(gp(KP.ws));
          gemm_phase<EpiQ8, Sched<0>, true>(lds, Gemm{(const bf16_t*)(ws8 + WS_H8), (const bf16_t*)(ws8 + WS_WIN8), DM / 2, DM / 2, DM / 2}, S, EpiQ8{Y, INWP, (const float*)(ws8 + WS_SA8), (const float*)(ws8 + WS_SBW)}); }
#ifdef DUP_WIN
        { Sched<0> S; S.init(T / 256, INWP / 256, (T / 256) * (INWP / 256), DM, DM); gemm_phase(lds, Gemm{H, WIN, DM, DM, DM}, S, EpiBf16{Y, INWP, 0}); }
#endif
        GRID_SYNC(); STOPCHK(4);
        ph::post_win(KP, l);
        GRID_SYNC(); STOPCHK(5);
        { Sched<0> S; S.init(T / 256, 3072 / 256, (T / 256) * 12, 512, 512); gemm_phase(lds, Gemm{CQN, WUQ, 512, 512, 512}, S, EpiQ{Q, QL, (const float*)(optr(gp(KP.ws)) + WS_TAB64)}); }
        { Sched<0> S; S.init(TP / 256, 4096 / 256, (TP / 256) * 16, 512, 512); gemm_phase(lds, Gemm{CKVNP, WUKV, 512, 512, 512}, S, EpiBf16{KV, 4096, 0}); }
        GRID_SYNC(); STOPCHK(6);
#ifndef DUP_ATTN
#define DUP_ATTN 1
#endif
#ifndef DUP_RET
#define DUP_RET 1
#endif
#ifndef DUP_GATHER
#define DUP_GATHER 0
#endif
#pragma unroll 1
        for (int rep_ = 0; rep_ < DUP_ATTN; ++rep_)
        { for (int u = obid(); u < 512; u += ogrid()) { const int c = u & 255, i = u >> 8, xcd = c & 7, slot = c >> 3; const int bh = xcd * 4 + (slot >> 3) + 32 * i, pr = slot & 7, b = bh >> 4, h = bh & 15;
#pragma unroll 1
              for (int z = 0; z < 2; ++z) { const int qb = z ? 15 - pr : pr; const long tok0 = (long)b * SEQ + 256 * qb;
                  att::attn_block(Q + tok0 * 3072 + h * 192, KV + (long)b * SEQ * 4096 + h * 256, KRP + (long)b * SEQ * 64, KV + (long)b * SEQ * 4096 + h * 256 + 128, OA + tok0 * DM + h * 128, qb, ldsg); } } }
        { Sched<1> S; S.init(0, 0, 256, 3072, 256); gemm_phase(lds, Gemm{Q, WUK, 256, 3072, 256}, S, EpiRowMap<1>{QL, nullptr}); }
        GRID_SYNC(); STOPCHK(8);
        { Sched<2> S; S.init(0, 0, DB * 36, QLD, QLD); gemm_phase(lds, Gemm{QL, CKA, QLD, QLD, QLD}, S, EpiExp{SP, (float*)(optr(gp(KP.ws)) + WS_CTL + CTL_RSUM) + (long)l * 32768}); }
        GRID_SYNC(); STOPCHK(9);
        { Sched<3> S; S.init(0, 0, 256, KPAD, KPAD); gemm_phase(lds, Gemm{SP, CKT, 2176, KPAD, KPAD}, S, EpiRowMap<3>{OL, (const float*)(optr(gp(KP.ws)) + WS_CTL + CTL_RSUM) + (long)l * 32768}); }
        GRID_SYNC(); STOPCHK(11);
        { Sched<4> S; S.init(0, 0, 128, 512, 512); gemm_phase(lds, Gemm{OL, WUKV, 512, 512, 512}, S, EpiOV{OA}); }
#pragma unroll 1
        for (int rep_ = 0; rep_ < DUP_RET; ++rep_)
        for (int u = obid(); u < 256 + DB * 64; u += ogrid()) ret::unit(KP, l, u, ldsg);
#ifdef DUP_RETP
        for (int u = obid(); u < 256; u += ogrid()) ret::unit(KP, l, u, ldsg);
#endif
        GRID_SYNC(); STOPCHK(12);
        { Sched<0> S; S.init(T / 256, DM / 256, (T / 256) * 8, DM, DM); gemm_phase(lds, Gemm{OA, WA, DM, DM, DM}, S, EpiBf16{YA, DM, 0}); }
        { const int G_ = ogrid(), rem_ = ((T / 256) * 8) % G_; const int b_ = obid();
          if (rem_ == 0) ph::gnorm_gate(KP, ph::gwave(), ph::nwaves());
          else if (b_ >= rem_) ph::gnorm_gate(KP, (b_ - rem_) * 8 + (otid() >> 6), (G_ - rem_) * 8); }
#ifdef DUP_WA
#pragma unroll 1
        for (int rep_ = 0; rep_ < DUP_WA; ++rep_)
        { Sched<0> S; S.init(T / 256, DM / 256, (T / 256) * 8, DM, DM); gemm_phase(lds, Gemm{OA, WA, DM, DM, DM}, S, EpiBf16{YA, DM, 0}); }
#endif
        GRID_SYNC(); STOPCHK(14);
        { Sched<0> S; S.init(T / 256, DM / 256, (T / 256) * 8, DM, DM); gemm_phase(lds, Gemm{BG, WB, DM, DM, DM}, S, EpiMix{Y, YA, MIX}); }
        { const int G_ = ogrid(), rem_ = ((T / 256) * 8) % G_; const int b_ = obid();
          if (rem_ == 0) ph::peer_convert(KP, l, 0, NEXP, ph::gwave(), ph::nwaves());
          else if (b_ >= rem_) ph::peer_convert(KP, l, 0, NEXP, (b_ - rem_) * 8 + (otid() >> 6), (G_ - rem_) * 8); }
        GRID_SYNC(); STOPCHK(15);
        { Sched<0> S; S.init(T / 256, DM / 256, (T / 256) * 8, DM, DM); gemm_phase(lds, Gemm{MIX, WO, DM, DM, DM}, S, EpiRes{gp(KP.out), ADA + 2 * DM, l == 0 ? gp(KP.x_prompt) : gp(KP.out), l == 0 ? gp(KP.x_sample) : gp(KP.out) + (long)TP * DM}); }
        { const int G_ = ogrid(), rem_ = ((T / 256) * 8) % G_; const int b_ = obid();
          if (rem_ == 0) ph::peer_convert(KP, l, NEXP, 2 * NEXP, ph::gwave(), ph::nwaves());
          else if (b_ >= rem_) ph::peer_convert(KP, l, NEXP, 2 * NEXP, (b_ - rem_) * 8 + (otid() >> 6), (G_ - rem_) * 8); }
        GRID_SYNC(); STOPCHK(16);
        ph::modulate(KP, l, 1);
        GRID_SYNC(); STOPCHK(17);
        { Sched<0> S; S.init(T / 256, DM / 256, (T / 256) * 8, DM / 2, DM / 2);
          unsigned char* ws8 = optr(gp(KP.ws));
          gemm_phase<EpiQ8, Sched<0>, true>(lds, Gemm{(const bf16_t*)(ws8 + WS_H8), (const bf16_t*)(ws8 + WS_WPQ8 + (long)l * DM * DM), DM / 2, DM / 2, DM / 2}, S, EpiQ8{QP, DM, (const float*)(ws8 + WS_SA8), (const float*)(ws8 + WS_SB8) + (long)l * DM});
#ifdef DUP_WPQ
          gemm_phase<EpiQ8, Sched<0>, true>(lds, Gemm{(const bf16_t*)(ws8 + WS_H8), (const bf16_t*)(ws8 + WS_WPQ8 + (long)l * DM * DM), DM / 2, DM / 2, DM / 2}, S, EpiQ8{QP, DM, (const float*)(ws8 + WS_SA8), (const float*)(ws8 + WS_SB8) + (long)l * DM});
#endif
        }
        if (l + 1 < DEPTH) { const int G_ = ogrid(), rem_ = ((T / 256) * 8) % G_; const int b_ = obid();
          if (rem_ == 0) ph::cache_convert(KP, l + 1, ldsg, 0, 4096, b_, G_);
          else if (b_ >= rem_) ph::cache_convert(KP, l + 1, ldsg, 0, 4096, b_ - rem_, G_ - rem_); }
        GRID_SYNC(); STOPCHK(18);
        { const int tid_ = otid(); const int lane = tid_ & 63; float* strip = (float*)ldsg + tid_ * 33; unsigned char* ws = optr(gp(KP.ws));
          const bf16_t* k1g = (const bf16_t*)(ws + WS_PK1) + (long)l * 128 * 128; const bf16_t* k2g = (const bf16_t*)(ws + WS_PK2) + (long)l * 128 * 128;
          bf16_t* k1 = (bf16_t*)(ldsg + 512 * 33 * 4 + 64); bf16_t* k2 = k1 + 128 * peer::KPITCH;
          for (int i = tid_; i < 2 * 128 * 16; i += 512) { const int which = i >> 11, r = (i >> 4) & 127, ch = i & 15;
              *reinterpret_cast<u32x4*>((which ? k2 : k1) + r * peer::KPITCH + ch * 8) = *reinterpret_cast<const u32x4*>((which ? k2g : k1g) + r * 128 + ch * 8); }
          __syncthreads();
          for (int wu = ph::gwave(); wu < (T / 32) * PH; wu += ph::nwaves()) peer::select_unit(QP, k1, k2, (int*)(ws + WS_PIDX), (float*)(ws + WS_PW), (wu >> 3) * 32, wu & 7, lane, strip);
#ifdef DUP_SEL
          for (int wu = ph::gwave(); wu < (T / 32) * PH; wu += ph::nwaves()) peer::select_unit(QP, k1, k2, (int*)(ws + WS_PIDX), (float*)(ws + WS_PW), (wu >> 3) * 32, wu & 7, lane, strip);
#endif
        }
        GRID_SYNC(); STOPCHK(19);
        { const int tid_ = otid(); const int lane = tid_ & 63, wid = tid_ >> 6; unsigned char* ws = optr(gp(KP.ws));
          volatile LAS unsigned* iw = (volatile LAS unsigned*)(lds + LDS_BARW); peer::XInfo xin; xin.rank = __builtin_amdgcn_readfirstlane((int)iw[2]); xin.xi = __builtin_amdgcn_readfirstlane((int)iw[3]); xin.nx = __builtin_amdgcn_readfirstlane((int)iw[4]); xin.nloc = __builtin_amdgcn_readfirstlane((int)iw[5]);
          if (xin.nx >= 1 && xin.nx <= 8) {
              peer::upass(H, (const unsigned char*)(ws + WS_PU), (const int*)(ws + WS_PIDX), (const float*)(ws + WS_PW), (const float*)(ws + WS_PSU), (const float*)(ws + WS_PSV), (float*)(ws + WS_DOTP), (unsigned*)(ws + WS_ACT), xin, wid, lane);
              GRID_SYNC();
              int vs0_, vsn_, vse_;
              if ((256 % xin.nx) == 0) { const int spx = 256 / xin.nx; vs0_ = xin.xi * spx + xin.rank; vsn_ = xin.nloc; vse_ = (xin.xi + 1) * spx; }
              else { vs0_ = obid(); vsn_ = ogrid(); vse_ = 256; }
              peer::vpass_lds((const unsigned char*)(ws + WS_PV), (const unsigned*)(ws + WS_ACT), gp(KP.out), ADA + 5 * DM, ldsg, vs0_, vsn_, vse_, tid_);
#ifdef DUP_VP
              peer::vpass_lds((const unsigned char*)(ws + WS_PV), (const unsigned*)(ws + WS_ACT), (float*)(ws + WS_OB), ADA + 5 * DM, ldsg, vs0_, vsn_, vse_, tid_);
#endif
          } else {
              for (int t = ph::gwave(); t < T; t += ph::nwaves()) peer::gather_token(H, (const unsigned char*)(ws + WS_PU), (const unsigned char*)(ws + WS_PV), (const float*)(ws + WS_PSU), (const float*)(ws + WS_PSV), (const int*)(ws + WS_PIDX), (const float*)(ws + WS_PW), gp(KP.out), ADA + 5 * DM, t, lane);
          } }
        GRID_SYNC(); STOPCHK(20);
    }
    ph::final_norm(KP);
}

extern "C" void kernel_launch(void* const* d_in, const int* in_sizes, int n_in, void* d_out, int out_size, void* d_ws, size_t ws_size, hipStream_t stream) {
    static int grid = 0;
    if (grid == 0) {
        if (n_in != 25 || out_size != (int)O_END || ws_size < WS_END) { fprintf(stderr, "kernel_launch: shape mismatch: n_in %d out %d (want %ld) ws %zu (want >= %zu)\n", n_in, out_size, O_END, ws_size, (size_t)WS_END); grid = -1; return; }
        int dev = 0, cus = 0, per_cu = 0;
        if (hipGetDevice(&dev) != hipSuccess || hipDeviceGetAttribute(&cus, hipDeviceAttributeMultiprocessorCount, dev) != hipSuccess) { fprintf(stderr, "kernel_launch: device query failed\n"); grid = -1; return; }
        if (hipFuncSetAttribute((const void*)mega_fwd, hipFuncAttributeMaxDynamicSharedMemorySize, LDS_BYTES) != hipSuccess) { fprintf(stderr, "kernel_launch: hipFuncSetAttribute failed\n"); grid = -1; return; }
        if (hipOccupancyMaxActiveBlocksPerMultiprocessor(&per_cu, (const void*)mega_fwd, 512, LDS_BYTES) != hipSuccess || per_cu < 1) { fprintf(stderr, "kernel_launch: occupancy query says %d blocks per CU\n", per_cu); grid = -1; return; }
        grid = cus;
#ifdef FORCE_GRID
        grid = FORCE_GRID;
#endif
    }
    if (grid < 0) return;
    (void)hipMemsetAsync((char*)d_ws + WS_CTL, 0, CTL_BYTES, stream);
    Params p{};
    const float* const* in = (const float* const*)d_in;
    p.x_prompt = in[0]; p.x_sample = in[1]; p.c_prompt = in[2]; p.c_sample = in[3]; p.cache_ckv = in[4]; p.cache_krope = in[5]; p.state_ret = in[6]; p.w_ada = in[7]; p.b_ada = in[8];
    p.g_mix = in[9]; p.g_ffn = in[10]; p.w_in = in[11]; p.g_q = in[12]; p.w_uq = in[13]; p.g_kv = in[14]; p.w_ukv = in[15]; p.w_a = in[16]; p.w_b = in[17]; p.w_o = in[18]; p.w_pq = in[19];
    p.peer_k1 = in[20]; p.peer_k2 = in[21]; p.peer_u = in[22]; p.peer_v = in[23]; p.g_final = in[24];
    p.out = (float*)d_out; p.ws = (unsigned char*)d_ws;
    for (int h = 0; h < 8; ++h) p.lg[h] = (float)log1p(-pow(2.0, -5.0 - (double)h));
    p.grid = grid; p.pad_ = 0;
    hipLaunchKernelGGL(mega_fwd, dim3(grid), dim3(512), LDS_BYTES, stream, p);
    const hipError_t le = hipGetLastError();
    if (le != hipSuccess) fprintf(stderr, "kernel_launch: launch failed: %s\n", hipGetErrorName(le));
}
```

```cpp
#include <hip/hip_runtime.h>
#include <cstdio>
#include <cstdint>
#include <cmath>

#define LAS __attribute__((address_space(3)))
typedef unsigned short bf16_t;
typedef short bf16x8 __attribute__((ext_vector_type(8)));
typedef float f32x4 __attribute__((ext_vector_type(4)));
typedef float f32x2 __attribute__((ext_vector_type(2)));
typedef float f32x16 __attribute__((ext_vector_type(16)));
typedef unsigned u32x4 __attribute__((ext_vector_type(4)));
typedef unsigned u32x2 __attribute__((ext_vector_type(2)));
typedef short s16x4 __attribute__((ext_vector_type(4)));
typedef int i32x4 __attribute__((ext_vector_type(4)));

constexpr int DM = 2048, NB = 4, SEQ = 4096, DEPTH = 2, DB = 32, DS = 64, PAST = 2048;
constexpr int TP = NB * SEQ, TS = DB * DS, T = TP + TS;
constexpr int NCOND = NB + DB;
constexpr int QLORA = 512, KVLORA = 512, ROPE = 64, NOPE = 128, VD = 128, MH = 16, QKD = 192;
constexpr int RH = 8, RQK = 128, RV = 256;
constexpr int PH = 8, NKEYS = 128, NEXP = 16384, PTOPK = 16;
constexpr int INW = 11328, INWP = 11520;
constexpr int C_CQ = 0, C_CKV = 512, C_KR = 1024, C_RQ = 1088, C_RK = 2112, C_RV = 3136, C_RG = 5184, C_GA = 7232, C_GB = 9280;
constexpr int KALL = PAST + DS;
constexpr int KPAD = 2304;
constexpr int QLD = 640;
constexpr float EPS = 1e-6f;
constexpr float MLA_SCALE = 0.07216878364870322f;

constexpr long O_Y = 0;
constexpr long O_CKVP = (long)T * DM;
constexpr long O_KRP = O_CKVP + 2L * TP * 512;
constexpr long O_RETP = O_KRP + 2L * TP * 64;
constexpr long O_CKVS = O_RETP + 2L * NB * RH * RQK * RV;
constexpr long O_KRS = O_CKVS + 2L * TS * 512;
constexpr long O_RETS = O_KRS + 2L * TS * 64;
constexpr long O_END = O_RETS + 2L * DB * RH * RQK * RV;

constexpr size_t al256(size_t x) { return (x + 255) / 256 * 256; }
constexpr size_t WS_CTL = 0;
constexpr size_t CTL_BYTES = 65536 + 2UL * 32768 * 4;
constexpr size_t CTL_RSUM = 65536;
constexpr size_t WS_TAB64 = WS_CTL + CTL_BYTES;
constexpr size_t WS_TAB128 = WS_TAB64 + 4096UL * 32 * 2 * 4;
constexpr size_t WS_ADA = WS_TAB128 + 4096UL * 64 * 2 * 4;
constexpr size_t WS_ADAP = WS_ADA + 2UL * NCOND * 12288 * 4;
constexpr size_t WS_WIN = WS_ADAP + 8UL * 2 * NCOND * 12288 * 4;
constexpr size_t WS_WUQ = WS_WIN + 2UL * INWP * DM * 2;
constexpr size_t WS_WUKV = WS_WUQ + 2UL * 3072 * 512 * 2;
constexpr size_t WS_WUK = WS_WUKV + 2UL * 4096 * 512 * 2;
constexpr size_t WS_WA = WS_WUK + 2UL * 16 * 512 * 256 * 2;
constexpr size_t WS_WB = WS_WA + 2UL * DM * DM * 2;
constexpr size_t WS_WO = WS_WB + 2UL * DM * DM * 2;
constexpr size_t WS_WPQ = WS_WO + 2UL * DM * DM * 2;
constexpr size_t WS_PK1 = WS_WPQ + 2UL * DM * DM * 2;
constexpr size_t WS_PK2 = WS_PK1 + 2UL * 128 * 128 * 2;
constexpr size_t WS_H = WS_PK2 + 2UL * 128 * 128 * 2;
constexpr size_t WS_Y = WS_H + (size_t)T * DM * 2;
constexpr size_t WS_CQN = WS_Y + (size_t)T * INWP * 2;
constexpr size_t WS_CKVNP = WS_CQN + (size_t)T * 512 * 2;
constexpr size_t WS_KRP = WS_CKVNP + (size_t)TP * 512 * 2;
constexpr size_t WS_Q = WS_KRP + (size_t)TP * 64 * 2;
constexpr size_t WS_YA = WS_Q;
constexpr size_t WS_KV = WS_Q + (size_t)T * 3072 * 2 + 4096;
constexpr size_t WS_SP = WS_KV;
constexpr size_t WS_MIX = WS_KV;
constexpr size_t WS_OA = WS_KV + 32UL * 1024 * KPAD * 2;
constexpr size_t WS_QP = WS_OA;
constexpr size_t WS_CKA = WS_OA + (size_t)T * DM * 2;
constexpr size_t WS_CKT = WS_CKA + 32UL * KPAD * QLD * 2;
constexpr size_t WS_QL = WS_CKT + 32UL * 512 * KPAD * 2;
constexpr size_t WS_OL = WS_QL + 32UL * 1024 * QLD * 2;
constexpr size_t WS_OB = WS_OL + 16UL * 2048 * 512 * 2;
constexpr size_t WS_BG = WS_OB + (size_t)T * DM * 2;
constexpr size_t WS_PIDX = WS_BG + (size_t)T * DM * 2;
constexpr size_t WS_PW = WS_PIDX + (size_t)T * 128 * 4;
constexpr size_t WS_PU = WS_PW + (size_t)T * 128 * 4;
constexpr size_t WS_PV = WS_PU + (size_t)NEXP * DM;
constexpr size_t WS_PSU = WS_PV + (size_t)NEXP * DM;
constexpr size_t WS_PSV = WS_PSU + (size_t)NEXP * 4;
constexpr size_t WS_WPQ8 = WS_PSV + (size_t)NEXP * 4;
constexpr size_t WS_SB8 = WS_WPQ8 + 2UL * DM * DM;
constexpr size_t WS_SA8 = WS_SB8 + 2UL * DM * 4;
constexpr int NB8 = 27;
constexpr size_t WS_WIN8 = WS_SA8 + al256((size_t)T * 4);
constexpr size_t WS_SBW = WS_WIN8 + (size_t)NB8 * 256 * DM;
constexpr size_t WS_WB8 = WS_SBW + al256((size_t)INWP * 4);
constexpr size_t WS_SBB = WS_WB8 + (size_t)DM * DM;
constexpr size_t WS_END = WS_SBB + (size_t)DM * 4;
constexpr size_t WS_H8 = WS_OB;
static_assert((size_t)TP * 4096 * 2 <= 32UL * 1024 * KPAD * 2, "KV fits in the SP region");
static_assert(WS_END <= 1608000000UL, "workspace map too large");
static_assert(WS_WIN % 256 == 0 && WS_H % 256 == 0 && WS_Y % 256 == 0 && WS_Q % 256 == 0 && WS_KV % 256 == 0 && WS_CKA % 256 == 0, "alignment");

constexpr int LDS_BYTES = 147456;
constexpr int LDS_BARW = LDS_BYTES - 32;
constexpr size_t CTL_RANK = 16384;
constexpr size_t WS_DOTP = WS_Q;
constexpr size_t WS_ACT = WS_DOTP + 8UL * T * 128 * 4;
constexpr size_t WS_PIDXT = WS_ACT + (size_t)T * 128 * 4;
static_assert(WS_PIDXT + (size_t)T * 128 * 4 <= WS_KV, "PEER scratch fits in the Q region");

struct Params {
    const float *x_prompt, *x_sample, *c_prompt, *c_sample, *cache_ckv, *cache_krope, *state_ret, *w_ada, *b_ada, *g_mix, *g_ffn, *w_in, *g_q, *w_uq, *g_kv, *w_ukv,
                *w_a, *w_b, *w_o, *w_pq, *peer_k1, *peer_k2, *peer_u, *peer_v, *g_final;
    float* out; unsigned char* ws;
    float lg[8];
    int grid; int pad_;
};

typedef const __attribute__((address_space(4))) Params KParams;
__device__ __forceinline__ KParams* okarg() {
    const uintptr_t k = (uintptr_t)__builtin_amdgcn_kernarg_segment_ptr();
    unsigned lo = (unsigned)k, hi = (unsigned)(k >> 32);
    asm volatile("" : "+s"(lo), "+s"(hi)); return (KParams*)(((uintptr_t)hi << 32) | lo); }
#define KP (*okarg())
__device__ __forceinline__ int ogrid() { return KP.grid; }
__device__ __forceinline__ int obid() { int b = (int)blockIdx.x; asm volatile("" : "+s"(b) :: "memory"); return b; }
__device__ __forceinline__ int otid() { int t = (int)threadIdx.x; asm volatile("" : "+v"(t) :: "memory"); return t; }
template <class P> __device__ __forceinline__ P* gp(P* p) { return (P*)(__attribute__((address_space(1))) P*)(uintptr_t)p; }
template <class P> __device__ __forceinline__ P* optr(P* p) {
    unsigned lo = __builtin_amdgcn_readfirstlane((unsigned)(uintptr_t)p), hi = __builtin_amdgcn_readfirstlane((unsigned)((uintptr_t)p >> 32));
    asm volatile("" : "+s"(lo), "+s"(hi)); return gp((P*)(((uintptr_t)hi << 32) | lo)); }
typedef __bf16 bf16v2_t __attribute__((ext_vector_type(2)));
__device__ __forceinline__ unsigned cvt_pk_bf16(float lo, float hi) { f32x2 v = {lo, hi}; bf16v2_t r = __builtin_convertvector(v, bf16v2_t); return __builtin_bit_cast(unsigned, r); }
__device__ __forceinline__ bf16_t f2bf(float f) { return (bf16_t)(cvt_pk_bf16(f, 0.f) & 0xffffu); }
__device__ __forceinline__ float bf2f(bf16_t b) { return __uint_as_float(((unsigned)b) << 16); }
__device__ __forceinline__ float bflo(unsigned w) { return __uint_as_float(w << 16); }
__device__ __forceinline__ float bfhi(unsigned w) { return __uint_as_float(w & 0xffff0000u); }
__device__ __forceinline__ void unpack8(const u32x4 w, float (&f)[8]) { f[0] = bflo(w.x); f[1] = bfhi(w.x); f[2] = bflo(w.y); f[3] = bfhi(w.y); f[4] = bflo(w.z); f[5] = bfhi(w.z); f[6] = bflo(w.w); f[7] = bfhi(w.w); }
__device__ __forceinline__ u32x4 pack8(const float (&f)[8]) { u32x4 w; w.x = cvt_pk_bf16(f[0], f[1]); w.y = cvt_pk_bf16(f[2], f[3]); w.z = cvt_pk_bf16(f[4], f[5]); w.w = cvt_pk_bf16(f[6], f[7]); return w; }
template <int K> __device__ __forceinline__ float sx(float v) {
    if constexpr (K == 32) { const auto rr = __builtin_amdgcn_permlane32_swap(__float_as_uint(v), __float_as_uint(v), false, false); return __uint_as_float((otid() & 32) ? rr[0] : rr[1]); }
    else return __int_as_float(__builtin_amdgcn_ds_swizzle(__float_as_int(v), (K << 10) | 0x1F));
}
__device__ __forceinline__ float wave_sum(float v) { v += sx<32>(v); v += sx<16>(v); v += sx<8>(v); v += sx<4>(v); v += sx<2>(v); v += sx<1>(v); return v; }
__device__ __forceinline__ float wave_max(float v) { v = fmaxf(v, sx<32>(v)); v = fmaxf(v, sx<16>(v)); v = fmaxf(v, sx<8>(v)); v = fmaxf(v, sx<4>(v)); v = fmaxf(v, sx<2>(v)); v = fmaxf(v, sx<1>(v)); return v; }
__device__ __forceinline__ float sigmoidf_(float x) { return 1.0f / (1.0f + __expf(-x)); }
__device__ __forceinline__ float siluf_(float x) { return x / (1.0f + __expf(-x)); }
__device__ __forceinline__ int cond_row(int t) { return t < TP ? (t >> 12) : NB + ((t - TP) >> 6); }
__device__ __forceinline__ int tok_pos(int t) { return t < TP ? (t & 4095) : PAST + ((t - TP) & 63); }

#define XB_TMO      128
#define XB_XCNT(j)  (256  + 64 * (j))
#define XB_XSUB(j)  (1280 + 64 * (j))
#define XB_XGEN(j)  (2304 + 64 * (j))
#define XB_TOP      3328
#define XB_TOPGEN   3392
#define XCD_BAR_WORDS 3456
#define XB_SPIN_CAP (1u << 22)
__device__ __forceinline__ unsigned xb_ld(unsigned* p)              { return __hip_atomic_load(p, __ATOMIC_RELAXED, __HIP_MEMORY_SCOPE_AGENT); }
__device__ __forceinline__ unsigned xb_add(unsigned* p, unsigned v) { return __hip_atomic_fetch_add(p, v, __ATOMIC_RELAXED, __HIP_MEMORY_SCOPE_AGENT); }
__device__ __forceinline__ unsigned xb_xcc_id() { return (unsigned)__builtin_amdgcn_s_getreg((3 << 11) | 20) & 0xFu; }
#define XB_SPIN(cond, bar) do { unsigned _sp = 0; while (cond) { __builtin_amdgcn_s_sleep(1); \
    if ((++_sp & 255u) == 0u) { if (xb_ld(&(bar)[XB_TMO])) break; if (_sp > XB_SPIN_CAP) { atomicAdd(&(bar)[XB_TMO], 1u); break; } } } } while (0)
struct XcdBarrier { unsigned* bar; unsigned x; volatile LAS unsigned* st; };
__device__ __forceinline__ XcdBarrier xcd_barrier_post(unsigned* bar, volatile LAS unsigned* st) {
    XcdBarrier b; b.bar = bar; b.x = xb_xcc_id(); b.st = st;
    if (threadIdx.x == 0) (void)xb_add(&bar[XB_XCNT(b.x)], 1u);
    return b;
}
__device__ __forceinline__ void xcd_barrier_complete(unsigned* bar, unsigned x, unsigned& nloc, unsigned& nx) {
    const unsigned G = (unsigned)KP.grid;
    unsigned sum, cnt, mine, sp = 0u;
    for (;;) {
        sum = 0u; cnt = 0u; mine = 0u;
#pragma unroll
        for (unsigned j = 0; j < 16; ++j) { const unsigned c = xb_ld(&bar[XB_XCNT(j)]); sum += c; cnt += (c > 0u) ? 1u : 0u; mine = (j == x) ? c : mine; }
        if (sum == G) break;
        __builtin_amdgcn_s_sleep(1);
        if ((++sp & 255u) == 0u) { if (xb_ld(&bar[XB_TMO])) break; if (sp > XB_SPIN_CAP) { atomicAdd(&bar[XB_TMO], 1u); break; } }
    }
    nloc = mine > 0u ? mine : 1u; nx = cnt > 0u ? cnt : 1u;
}
__device__ __forceinline__ void xcd_barrier(const XcdBarrier& b) {
    asm volatile("s_waitcnt vmcnt(0)" ::: "memory");
    __syncthreads();
    if (otid() == 0) {
        unsigned* bar = (unsigned*)(gp(KP.ws) + WS_CTL);
        unsigned bx = xb_xcc_id(); asm volatile("" : "+s"(bx));
        __builtin_amdgcn_s_waitcnt(0);
        unsigned nloc = b.st[0], nx = b.st[1];
        if (nloc == 0u) { xcd_barrier_complete(bar, bx, nloc, nx); b.st[0] = nloc; b.st[1] = nx; }
        const unsigned old = xb_add(&bar[XB_XSUB(bx)], 1u);
        const unsigned gen = old / nloc;
        if (old + 1u == (gen + 1u) * nloc) {
            __builtin_amdgcn_fence(__ATOMIC_RELEASE, "agent");
            asm volatile("s_waitcnt vmcnt(0)" ::: "memory");
            const unsigned og = xb_add(&bar[XB_TOP], 1u);
            const unsigned tg = og / nx;
            if (og + 1u == (tg + 1u) * nx) xb_add(&bar[XB_TOPGEN], 1u);
            else XB_SPIN(xb_ld(&bar[XB_TOPGEN]) == tg, bar);
            __builtin_amdgcn_fence(__ATOMIC_ACQUIRE, "agent");
            xb_add(&bar[XB_XGEN(bx)], 1u);
            asm volatile("s_waitcnt vmcnt(0)" ::: "memory");
        } else {
            XB_SPIN(xb_ld(&bar[XB_XGEN(bx)]) == gen, bar);
            __builtin_amdgcn_fence(__ATOMIC_ACQUIRE, "agent");
            asm volatile("s_waitcnt vmcnt(0)" ::: "memory");
        }
    }
    __syncthreads();
}
namespace pg8 {
constexpr int BM = 256, BK = 64, HALF = 128, HTB = HALF * BK * 2, STAGE_BYTES = 8 * HTB, NXCD = 8, WGM = 8;
__host__ __device__ __forceinline__ int lds_byte(int r, int c) { const int st = (r >> 4) * 2 + (c >> 5), rr = r & 15, cc = c & 31, ob = rr * 64 + cc * 2; return st * 1024 + (ob ^ (((ob >> 9) & 1) << 5)); }
__host__ __device__ __forceinline__ void stage_rc(int b, int& R, int& C) { const int st = b / 1024, sb = b % 1024, swz = sb ^ (((sb >> 9) & 1) << 5); R = (st >> 1) * 16 + swz / 64; C = (st & 1) * 32 + (swz % 64) / 2; }
__host__ __device__ __forceinline__ int perm32(int rho) { const int n = rho >> 4, i = rho & 15; return 8 * (i >> 2) + 4 * n + (i & 3); }

struct Unit { int pm, pn; long aoff, boff; int x0, x1; };
struct Gemm { const bf16_t* A; const bf16_t* Bt; int K; int lda, ldb; };

template <int MODE> struct Sched {
    int nM, nN, nwg, G, c; long lda, ldb; int nsplit, add0, add1, bcompact;
    __device__ void init(int nM_, int nN_, int nwg_, long lda_, long ldb_) { nM = nM_; nN = nN_; nwg = nwg_; G = ogrid(); c = obid(); lda = lda_; ldb = ldb_; nsplit = 1 << 30; add0 = 0; add1 = 0; bcompact = 0; }
    __device__ void remap(int nsplit_, int add0_, int add1_, int bcompact_) { nsplit = nsplit_; add0 = add0_; add1 = add1_; bcompact = bcompact_; }
    __device__ void rotate(int r) { c = (c + r) % G; }
    __device__ bool next(int i, Unit& u) const {
        const long L = (long)i * G + c; if (L >= nwg) return false;
        int wgid = (int)L;
        if (MODE == 0) {
            { const int q = nwg / NXCD, r = nwg % NXCD, xcd = wgid % NXCD, off = wgid / NXCD; wgid = (xcd < r ? xcd * (q + 1) : r * (q + 1) + (xcd - r) * q) + off; }
            const int nig = WGM * nN, gid = wgid / nig, fm = gid * WGM, gsz = (nM - fm) < WGM ? (nM - fm) : WGM;
            u.pm = fm + ((wgid % nig) % gsz); u.pn = (wgid % nig) / gsz; u.x0 = 0; u.x1 = 0;
            { const int pl = u.pn; u.pn += pl < nsplit ? add0 : add1; u.aoff = (long)u.pm * 256 * lda * 2; u.boff = (long)(bcompact ? pl : u.pn) * 256 * ldb * 2; }
        } else if (MODE == 1) {
            const int h = wgid >> 4, rem = wgid & 15, rt = rem >> 1, pn = rem & 1;
            u.pm = rt; u.pn = pn; u.x0 = h; u.x1 = rt;
            u.aoff = ((long)(TP + 256 * rt) * 3072 + h * 192) * 2; u.boff = ((long)(h * 512 + 256 * pn) * 256) * 2;
        } else if (MODE == 2) {
            const int b = wgid / 36, rem = wgid % 36, pm = rem / 9, pn = rem % 9;
            u.pm = pm; u.pn = pn; u.x0 = b; u.x1 = 0;
            u.aoff = ((long)(b * 1024 + 256 * pm) * QLD) * 2; u.boff = ((long)(b * KPAD + 256 * pn) * QLD) * 2;
        } else if (MODE == 3) {
            const int b = wgid >> 3, pm = (wgid & 7) >> 1, pn = wgid & 1;
            u.pm = pm; u.pn = pn; u.x0 = b; u.x1 = 0;
            u.aoff = ((long)(b * 1024 + 256 * pm) * KPAD) * 2; u.boff = ((long)(b * 512 + 256 * pn) * KPAD) * 2;
        } else {
            const int h = wgid >> 3, rt = wgid & 7;
            u.pm = rt; u.pn = 0; u.x0 = h; u.x1 = rt;
            u.aoff = ((long)(h * 2048 + 256 * rt) * 512) * 2; u.boff = ((long)(h * 256) * 512) * 2;
        }
        return true;
    }
};

template <class Epi, class SchedT, bool I8 = false>
__device__ __forceinline__ void gemm_phase(LAS unsigned char* lds, const Gemm g, const SchedT& S, const Epi& E) {
    const int tid = otid(), wid = __builtin_amdgcn_readfirstlane(tid >> 6), lane = tid & 63, wr = wid >> 2, wc = wid & 3, fr = lane & 15, fq = lane >> 4;
    const int K = g.K, nt = K / BK;
    unsigned voffA[2], voffB[2];
#pragma unroll
    for (int i = 0; i < 2; ++i) { int R, C; stage_rc(tid * 16 + i * 8192, R, C); const int Rb = Epi::PERM ? ((R & ~31) + perm32(R & 31)) : R;
        voffA[i] = (unsigned)(R * g.lda + C) * 2u; voffB[i] = (unsigned)(Rb * g.ldb + C) * 2u; }
    const size_t kstep = (size_t)(BK * 2);
    const size_t hstepA = (size_t)HALF * g.lda * 2, hstepB = (size_t)HALF * g.ldb * 2;
    const unsigned ldsw = (unsigned)wid * 1024u;
    const int aoff = lds_byte(wr * 64 + fr, fq * 8), boff = lds_byte(wc * 32 + fr, fq * 8);
#define PG8_SA(b, h) (((b) * 2 + (h)) * HTB)
#define PG8_SB(b, h) ((4 + (b) * 2 + (h)) * HTB)
#define PG8_STAGE(bufoff, gbase, voff) do { _Pragma("unroll") for (int _i = 0; _i < 2; ++_i) \
        __builtin_amdgcn_global_load_lds((const unsigned*)((const char*)(gbase) + (voff)[_i]), (LAS unsigned*)(lds + (bufoff) + ldsw + _i * 8192), 16, 0, 0); } while (0)
#define PG8_LDA(dst, b, h) do { _Pragma("unroll") for (int m = 0; m < 4; ++m) _Pragma("unroll") for (int k = 0; k < 2; ++k) dst[m][k] = *(const LAS bf16x8*)(lds + PG8_SA(b, h) + aoff + m * 2048 + k * 1024); } while (0)
#define PG8_LDB(dst, b, h) do { _Pragma("unroll") for (int n = 0; n < 2; ++n) _Pragma("unroll") for (int k = 0; k < 2; ++k) dst[n][k] = *(const LAS bf16x8*)(lds + PG8_SB(b, h) + boff + n * 2048 + k * 1024); } while (0)
#define PG8_MMA(ai, bj, At, Bt) do { __builtin_amdgcn_s_setprio(1); _Pragma("unroll") for (int m = 0; m < 4; ++m) _Pragma("unroll") for (int n = 0; n < 2; ++n) _Pragma("unroll") for (int k = 0; k < 2; ++k) \
        { if constexpr (I8) acc[ai][bj][m][n] = __builtin_bit_cast(f32x4, __builtin_amdgcn_mfma_i32_16x16x64_i8(__builtin_bit_cast(i32x4, Bt[n][k]), __builtin_bit_cast(i32x4, At[m][k]), __builtin_bit_cast(i32x4, acc[ai][bj][m][n]), 0, 0, 0)); \
          else acc[ai][bj][m][n] = __builtin_amdgcn_mfma_f32_16x16x32_bf16(Bt[n][k], At[m][k], acc[ai][bj][m][n], 0, 0, 0); } __builtin_amdgcn_s_setprio(0); } while (0)
#define PG8_WAIT_V(n) asm volatile("s_waitcnt vmcnt(" #n ")" ::: "memory")
#define PG8_WAIT_L(n) asm volatile("s_waitcnt lgkmcnt(" #n ")" ::: "memory")
#define PG8_BAR __builtin_amdgcn_s_barrier()
#define PG8_SCHED __builtin_amdgcn_sched_barrier(0)
    Unit cur, nxt; int ui = 0;
    if (!S.next(0, cur)) return;
    f32x4 acc[2][2][4][2];
#pragma unroll
    for (int a = 0; a < 2; ++a)
#pragma unroll
        for (int b = 0; b < 2; ++b)
#pragma unroll
            for (int m = 0; m < 4; ++m)
#pragma unroll
                for (int n = 0; n < 2; ++n) acc[a][b][m][n] = (f32x4){0.f, 0.f, 0.f, 0.f};
    bf16x8 At[4][2], B0[2][2], B1[2][2];
    const char* cA = (const char*)g.A + cur.aoff; const char* cB = (const char*)g.Bt + cur.boff;
    PG8_STAGE(PG8_SB(0, 0), cB, voffB); PG8_STAGE(PG8_SA(0, 0), cA, voffA); PG8_STAGE(PG8_SB(0, 1), cB + hstepB, voffB); PG8_STAGE(PG8_SA(0, 1), cA + hstepA, voffA);
    if (wr == 1) PG8_BAR;
    PG8_WAIT_V(4); PG8_BAR;
    PG8_STAGE(PG8_SB(1, 0), cB + kstep, voffB); PG8_STAGE(PG8_SA(1, 0), cA + kstep, voffA); PG8_STAGE(PG8_SB(1, 1), cB + hstepB + kstep, voffB);
    PG8_WAIT_V(6); PG8_BAR;
    for (;;) {
        const bool has_next = S.next(ui + 1, nxt);
        const char* nA = has_next ? (const char*)g.A + nxt.aoff : cA; const char* nB = has_next ? (const char*)g.Bt + nxt.boff : cB;
        for (int t = 0; t < nt; t += 2) {
            const bool last = (t == nt - 2);
            const char* a1 = cA + (size_t)(t + 1) * kstep;
            const char* a2 = last ? nA : cA + (size_t)(t + 2) * kstep; const char* b2 = last ? nB : cB + (size_t)(t + 2) * kstep;
            const char* a3 = a2 + kstep; const char* b3 = b2 + kstep;
            PG8_LDB(B0, 0, 0); PG8_SCHED; PG8_LDA(At, 0, 0); PG8_STAGE(PG8_SA(1, 1), a1 + hstepA, voffA);
            PG8_WAIT_L(8); PG8_BAR; PG8_WAIT_L(0); PG8_MMA(0, 0, At, B0); PG8_BAR; PG8_SCHED;
            PG8_LDB(B1, 0, 1); PG8_STAGE(PG8_SB(0, 0), b2, voffB);
            PG8_BAR; PG8_WAIT_L(0); PG8_MMA(0, 1, At, B1); PG8_BAR;
            PG8_LDA(At, 0, 1); PG8_STAGE(PG8_SA(0, 0), a2, voffA);
            PG8_BAR; PG8_WAIT_L(0); PG8_MMA(1, 0, At, B0); PG8_BAR; PG8_SCHED;
            PG8_STAGE(PG8_SB(0, 1), b2 + hstepB, voffB);
            PG8_WAIT_V(6); PG8_BAR; PG8_MMA(1, 1, At, B1); PG8_BAR;
            PG8_LDB(B0, 1, 0); PG8_SCHED; PG8_LDA(At, 1, 0); PG8_STAGE(PG8_SA(0, 1), a2 + hstepA, voffA);
            PG8_WAIT_L(8); PG8_BAR; PG8_WAIT_L(0); PG8_MMA(0, 0, At, B0); PG8_BAR; PG8_SCHED;
            PG8_LDB(B1, 1, 1); PG8_STAGE(PG8_SB(1, 0), b3, voffB);
            PG8_BAR; PG8_WAIT_L(0); PG8_MMA(0, 1, At, B1); PG8_BAR;
            PG8_LDA(At, 1, 1); PG8_STAGE(PG8_SA(1, 0), a3, voffA);
            PG8_BAR; PG8_WAIT_L(0); PG8_MMA(1, 0, At, B0); PG8_BAR; PG8_SCHED;
            PG8_STAGE(PG8_SB(1, 1), b3 + hstepB, voffB);
            PG8_WAIT_V(6); PG8_BAR; PG8_MMA(1, 1, At, B1); PG8_BAR;
        }
        if constexpr (I8) {
#pragma unroll
            for (int a = 0; a < 2; ++a)
#pragma unroll
                for (int b = 0; b < 2; ++b)
#pragma unroll
                    for (int m = 0; m < 4; ++m)
#pragma unroll
                        for (int n = 0; n < 2; ++n) { const i32x4 iv = __builtin_bit_cast(i32x4, acc[a][b][m][n]); acc[a][b][m][n] = (f32x4){(float)iv[0], (float)iv[1], (float)iv[2], (float)iv[3]}; } }
        E(acc, cur, wr, wc, fr, fq);
        if (!has_next) break;
#pragma unroll
        for (int a = 0; a < 2; ++a)
#pragma unroll
            for (int b = 0; b < 2; ++b)
#pragma unroll
                for (int m = 0; m < 4; ++m)
#pragma unroll
                    for (int n = 0; n < 2; ++n) acc[a][b][m][n] = (f32x4){0.f, 0.f, 0.f, 0.f};
        cur = nxt; cA = nA; cB = nB; ++ui;
    }
    PG8_WAIT_V(0);
    if (wr == 0) PG8_BAR;
    PG8_BAR;
#undef PG8_SA
#undef PG8_SB
#undef PG8_STAGE
#undef PG8_LDA
#undef PG8_LDB
#undef PG8_MMA
#undef PG8_WAIT_V
#undef PG8_WAIT_L
#undef PG8_BAR
#undef PG8_SCHED
}

struct EpiBf16 {
    static constexpr bool PERM = true;
    bf16_t* O; long ldc; long bstride;
    __device__ __forceinline__ void operator()(const f32x4 (&acc)[2][2][4][2], const Unit& u, int wr, int wc, int fr, int fq) const {
        bf16_t* base = O + (long)u.x0 * bstride + (long)(u.pm * BM + wr * 64 + fr) * ldc + u.pn * BM + wc * 32 + 8 * fq;
#pragma unroll
        for (int ai = 0; ai < 2; ++ai)
#pragma unroll
            for (int m = 0; m < 4; ++m) { bf16_t* rowp = base + (long)(ai * HALF + m * 16) * ldc;
#pragma unroll
                for (int bj = 0; bj < 2; ++bj) { const f32x4 v0 = acc[ai][bj][m][0], v1 = acc[ai][bj][m][1];
                    u32x4 w; w.x = cvt_pk_bf16(v0[0], v0[1]); w.y = cvt_pk_bf16(v0[2], v0[3]); w.z = cvt_pk_bf16(v1[0], v1[1]); w.w = cvt_pk_bf16(v1[2], v1[3]);
                    *(u32x4*)(rowp + bj * HALF) = w; } }
    }
};
template <int RMODE> struct EpiRowMap {
    static constexpr bool PERM = true;
    bf16_t* O; const float* rsum;
    __device__ __forceinline__ void operator()(const f32x4 (&acc)[2][2][4][2], const Unit& u, int wr, int wc, int fr, int fq) const {
        const int col0 = u.pn * BM + wc * 32 + 8 * fq;
#pragma unroll
        for (int ai = 0; ai < 2; ++ai)
#pragma unroll
            for (int m = 0; m < 4; ++m) { const int r = ai * HALF + wr * 64 + m * 16 + fr; long drow; long ldc;
                if (RMODE == 1) { const int ts = 256 * u.x1 + r; drow = (long)(ts >> 6) * 1024 + u.x0 * 64 + (ts & 63); ldc = QLD; }
                float rs = 1.0f;
                if (RMODE == 1) { }
                else { const int qr = 256 * u.pm + r; drow = (long)(qr >> 6) * 2048 + u.x0 * 64 + (qr & 63); ldc = 512; rs = 1.0f / rsum[u.x0 * 1024 + qr]; }
                bf16_t* rowp = O + drow * ldc + col0;
#pragma unroll
                for (int bj = 0; bj < 2; ++bj) { const f32x4 v0 = acc[ai][bj][m][0] * rs, v1 = acc[ai][bj][m][1] * rs;
                    u32x4 w; w.x = cvt_pk_bf16(v0[0], v0[1]); w.y = cvt_pk_bf16(v0[2], v0[3]); w.z = cvt_pk_bf16(v1[0], v1[1]); w.w = cvt_pk_bf16(v1[2], v1[3]);
                    *(u32x4*)(rowp + bj * HALF) = w; } }
    }
};
struct EpiOV {
    static constexpr bool PERM = true;
    bf16_t* O;
    __device__ __forceinline__ void operator()(const f32x4 (&acc)[2][2][4][2], const Unit& u, int wr, int wc, int fr, int fq) const {
#pragma unroll
        for (int ai = 0; ai < 2; ++ai)
#pragma unroll
            for (int m = 0; m < 4; ++m) { const int r = ai * HALF + wr * 64 + m * 16 + fr;
                bf16_t* rowp = O + (long)(TP + 256 * u.x1 + r) * DM + u.x0 * 128 + wc * 32 + 8 * fq;
                const f32x4 v0 = acc[ai][1][m][0], v1 = acc[ai][1][m][1];
                u32x4 w; w.x = cvt_pk_bf16(v0[0], v0[1]); w.y = cvt_pk_bf16(v0[2], v0[3]); w.z = cvt_pk_bf16(v1[0], v1[1]); w.w = cvt_pk_bf16(v1[2], v1[3]);
                *(u32x4*)rowp = w; }
    }
};
struct EpiMix {
    static constexpr bool PERM = true;
    const bf16_t* Y; const bf16_t* YA; bf16_t* MIX; const float* sa; const float* sb;
    __device__ __forceinline__ void operator()(const f32x4 (&acc)[2][2][4][2], const Unit& u, int wr, int wc, int fr, int fq) const {
#pragma unroll
        for (int ai = 0; ai < 2; ++ai)
#pragma unroll
            for (int m = 0; m < 4; ++m) { const long t = (long)u.pm * BM + ai * HALF + wr * 64 + m * 16 + fr; const float s_ = sa[t];
#pragma unroll
                for (int bj = 0; bj < 2; ++bj) { const int c = u.pn * BM + bj * HALF + wc * 32 + 8 * fq;
                    const u32x4 ga = *(const u32x4*)(Y + t * INWP + C_GA + c), gb = *(const u32x4*)(Y + t * INWP + C_GB + c), ya = *(const u32x4*)(YA + t * DM + c);
                    float fa[8], fb[8], fy[8], o[8]; unpack8(ga, fa); unpack8(gb, fb); unpack8(ya, fy);
                    const f32x4 v0 = acc[ai][bj][m][0] * *(const f32x4*)(sb + c) * s_, v1 = acc[ai][bj][m][1] * *(const f32x4*)(sb + c + 4) * s_;
                    const float av[8] = {v0[0], v0[1], v0[2], v0[3], v1[0], v1[1], v1[2], v1[3]};
#pragma unroll
                    for (int j = 0; j < 8; ++j) {
#if defined(DBG_MIX) && DBG_MIX == 1
                        o[j] = sigmoidf_(fb[j]) * av[j];
#elif defined(DBG_MIX) && DBG_MIX == 2
                        o[j] = sigmoidf_(fa[j]) * fy[j];
#else
                        o[j] = sigmoidf_(fa[j]) * fy[j] + sigmoidf_(fb[j]) * av[j];
#endif
                    }
                    *(u32x4*)(MIX + t * DM + c) = pack8(o); } }
    }
};
struct EpiRes {
    static constexpr bool PERM = false;
    float* X; const float* gate;
    const float* XinP; const float* XinS;
    __device__ __forceinline__ void operator()(const f32x4 (&acc)[2][2][4][2], const Unit& u, int wr, int wc, int fr, int fq) const {
#pragma unroll
        for (int ai = 0; ai < 2; ++ai)
#pragma unroll
            for (int m = 0; m < 4; ++m) { const int t = u.pm * BM + ai * HALF + wr * 64 + m * 16 + fr; const float* gr = gate + (long)cond_row(t) * 12288; float* xr = X + (long)t * DM; const float* xi = t < TP ? XinP + (long)t * DM : XinS + (long)(t - TP) * DM;
#pragma unroll
                for (int bj = 0; bj < 2; ++bj)
#pragma unroll
                    for (int n = 0; n < 2; ++n) { const int c = u.pn * BM + bj * HALF + wc * 32 + n * 16 + 4 * fq;
                        const f32x4 gv = *(const f32x4*)(gr + c); const f32x4 xv = *(const f32x4*)(xi + c);
                        *(f32x4*)(xr + c) = xv + gv * acc[ai][bj][m][n]; } }
    }
};

struct EpiQ {
    static constexpr bool PERM = true;
    bf16_t* Q; bf16_t* QL; const float* T64;
    __device__ __forceinline__ void operator()(const f32x4 (&acc)[2][2][4][2], const Unit& u, int wr, int wc, int fr, int fq) const {
        const int grp = u.pn / 3, typ = u.pn - 3 * grp;
        if (typ < 2) {
#pragma unroll
            for (int ai = 0; ai < 2; ++ai)
#pragma unroll
                for (int m = 0; m < 4; ++m) { const long t = (long)u.pm * BM + ai * HALF + wr * 64 + m * 16 + fr;
#pragma unroll
                    for (int bj = 0; bj < 2; ++bj) { const f32x4 v0 = acc[ai][bj][m][0], v1 = acc[ai][bj][m][1];
                        u32x4 w; w.x = cvt_pk_bf16(v0[0], v0[1]); w.y = cvt_pk_bf16(v0[2], v0[3]); w.z = cvt_pk_bf16(v1[0], v1[1]); w.w = cvt_pk_bf16(v1[2], v1[3]);
                        *(u32x4*)(Q + t * 3072 + 768 * grp + 192 * (2 * typ + bj) + wc * 32 + 8 * fq) = w; } }
        } else {
#pragma unroll
            for (int ai = 0; ai < 2; ++ai)
#pragma unroll
                for (int m = 0; m < 4; ++m) { const int t = u.pm * BM + ai * HALF + wr * 64 + m * 16 + fr; const int pos = tok_pos(t);
                    const float* cs = T64 + ((long)pos * 32 + 8 * fq) * 2; float cv[8], sv[8];
#pragma unroll
                    for (int j = 0; j < 4; ++j) { const f32x4 qv = *(const f32x4*)(cs + 4 * j); cv[2 * j] = qv[0]; sv[2 * j] = qv[1]; cv[2 * j + 1] = qv[2]; sv[2 * j + 1] = qv[3]; }
                    const f32x4 a0 = acc[ai][0][m][0], a1 = acc[ai][0][m][1], b0 = acc[ai][1][m][0], b1 = acc[ai][1][m][1];
                    const float x1[8] = {a0[0], a0[1], a0[2], a0[3], a1[0], a1[1], a1[2], a1[3]}, x2[8] = {b0[0], b0[1], b0[2], b0[3], b1[0], b1[1], b1[2], b1[3]};
                    float o1[8], o2[8];
#pragma unroll
                    for (int j = 0; j < 8; ++j) { o1[j] = x1[j] * cv[j] - x2[j] * sv[j]; o2[j] = x1[j] * sv[j] + x2[j] * cv[j]; }
                    const u32x4 w1 = pack8(o1), w2 = pack8(o2); const int hd = 4 * grp + wc;
                    bf16_t* qd = Q + (long)t * 3072 + hd * 192 + 128 + 8 * fq; *(u32x4*)qd = w1; *(u32x4*)(qd + 32) = w2;
                    if (t >= TP) { const int ts = t - TP; bf16_t* d = QL + ((long)(ts >> 6) * 1024 + hd * 64 + (ts & 63)) * QLD + 512 + 8 * fq; *(u32x4*)d = w1; *(u32x4*)(d + 32) = w2; } }
        }
    }
};

struct EpiExp {
    static constexpr bool PERM = true;
    bf16_t* O; float* rsum;
    __device__ __forceinline__ void operator()(const f32x4 (&acc)[2][2][4][2], const Unit& u, int wr, int wc, int fr, int fq) const {
        bf16_t* base = O + (long)u.x0 * 1024 * KPAD + (long)(u.pm * BM + wr * 64 + fr) * KPAD + u.pn * BM + wc * 32 + 8 * fq;
#pragma unroll
        for (int ai = 0; ai < 2; ++ai)
#pragma unroll
            for (int m = 0; m < 4; ++m) { bf16_t* rowp = base + (long)(ai * HALF + m * 16) * KPAD; float part = 0.f;
#pragma unroll
                for (int bj = 0; bj < 2; ++bj) { const int c0 = u.pn * BM + bj * HALF + wc * 32 + 8 * fq; const f32x4 v0 = acc[ai][bj][m][0], v1 = acc[ai][bj][m][1];
                    const float sv[8] = {v0[0], v0[1], v0[2], v0[3], v1[0], v1[1], v1[2], v1[3]}; float e[8];
#pragma unroll
                    for (int j = 0; j < 8; ++j) { e[j] = (c0 + j < KALL) ? __expf(fminf(sv[j] * MLA_SCALE, 60.f)) : 0.f; part += e[j]; }
                    *(u32x4*)(rowp + bj * HALF) = pack8(e); }
                part += sx<16>(part); part += sx<32>(part);
                if (fq == 0) atomicAdd(rsum + u.x0 * 1024 + u.pm * BM + ai * HALF + wr * 64 + m * 16 + fr, part); }
    }
};

struct EpiQ8 {
    static constexpr bool PERM = true;
    bf16_t* O; long ldc; const float* sa; const float* sb;
    __device__ __forceinline__ void operator()(const f32x4 (&acc)[2][2][4][2], const Unit& u, int wr, int wc, int fr, int fq) const {
        f32x4 sbv[2][2];
#pragma unroll
        for (int bj = 0; bj < 2; ++bj) { const int c = u.pn * BM + bj * HALF + wc * 32 + 8 * fq; sbv[bj][0] = *(const f32x4*)(sb + c); sbv[bj][1] = *(const f32x4*)(sb + c + 4); }
#pragma unroll
        for (int ai = 0; ai < 2; ++ai)
#pragma unroll
            for (int m = 0; m < 4; ++m) { const long t = (long)u.pm * BM + ai * HALF + wr * 64 + m * 16 + fr; const float s = sa[t];
#pragma unroll
                for (int bj = 0; bj < 2; ++bj) { const f32x4 v0 = acc[ai][bj][m][0] * sbv[bj][0] * s, v1 = acc[ai][bj][m][1] * sbv[bj][1] * s;
                    u32x4 w; w.x = cvt_pk_bf16(v0[0], v0[1]); w.y = cvt_pk_bf16(v0[2], v0[3]); w.z = cvt_pk_bf16(v1[0], v1[1]); w.w = cvt_pk_bf16(v1[2], v1[3]);
                    *(u32x4*)(O + t * ldc + u.pn * BM + bj * HALF + wc * 32 + 8 * fq) = w; } }
    }
};
}
namespace att {
constexpr int NW = 8, QBLK = 32, KVBLK = 64;
constexpr float SCALE = MLA_SCALE;
constexpr float THR = 8.f;
constexpr int KROW = 384;
constexpr int SHM_V = KVBLK * 128 * 2, SHM_K = KVBLK * KROW;
constexpr int QR_PITCH = 144, SHM_QR = 256 * QR_PITCH;
constexpr int SHM_ATTN = 2 * SHM_V + 2 * SHM_K + NW * 64 * 4 + SHM_QR;
#define KSWZ(row, colB) ((row) * att::KROW + ((colB) ^ (((row) & 7) << 4)))
#define SBAR() __builtin_amdgcn_sched_barrier(0)
__device__ __forceinline__ int crow(int r, int hi) { return (r & 3) + 8 * (r >> 2) + 4 * hi; }

__device__ __forceinline__ void partialSM(f32x16& p0, f32x16& p1, float& m_reg, float& mn, float& alpha) {
  constexpr float C = SCALE * 1.4426950408889634f;
  float pmax = p0[0];
#pragma unroll
  for (int r = 1; r < 16; ++r) pmax = fmaxf(pmax, p0[r]);
#pragma unroll
  for (int r = 0; r < 16; ++r) pmax = fmaxf(pmax, p1[r]);
  { auto rr = __builtin_amdgcn_permlane32_swap(__float_as_uint(pmax), __float_as_uint(pmax), false, false);
    pmax = fmaxf(__uint_as_float(rr[0]), __uint_as_float(rr[1])); }
  if (__builtin_expect(__all(pmax - m_reg <= THR / SCALE), 1)) { mn = m_reg; alpha = 1.f; }
  else { mn = fmaxf(m_reg, pmax); alpha = __builtin_amdgcn_exp2f((m_reg - mn) * C); m_reg = mn; }
  float mnC = -mn * C;
#pragma unroll
  for (int r = 0; r < 16; ++r) p0[r] = fmaf(p0[r], C, mnC);
#pragma unroll
  for (int r = 0; r < 16; ++r) p1[r] = fmaf(p1[r], C, mnC);
#pragma unroll
  for (int r = 0; r < 16; ++r) p0[r] = __builtin_amdgcn_exp2f(p0[r]);
}
__device__ __forceinline__ void finishSM(f32x16& p0, f32x16& p1, float alpha, float& l_reg, bf16x8& pa0, bf16x8& pa1, bf16x8& pa2, bf16x8& pa3) {
#pragma unroll
  for (int r = 0; r < 16; ++r) p1[r] = __builtin_amdgcn_exp2f(p1[r]);
  float ps = 0;
#pragma unroll
  for (int r = 0; r < 16; ++r) ps += p0[r];
#pragma unroll
  for (int r = 0; r < 16; ++r) ps += p1[r];
  { auto rr = __builtin_amdgcn_permlane32_swap(__float_as_uint(ps), __float_as_uint(ps), false, false);
    ps = __uint_as_float(rr[0]) + __uint_as_float(rr[1]); }
  l_reg = l_reg * alpha + ps;
#define PK4(P, BASE, OUT) do { unsigned a0 = cvt_pk_bf16(P[BASE + 0], P[BASE + 1]), a1 = cvt_pk_bf16(P[BASE + 2], P[BASE + 3]);   \
    unsigned b0 = cvt_pk_bf16(P[BASE + 4], P[BASE + 5]), b1 = cvt_pk_bf16(P[BASE + 6], P[BASE + 7]);                              \
    auto r0 = __builtin_amdgcn_permlane32_swap(a0, b0, false, false); auto r1 = __builtin_amdgcn_permlane32_swap(a1, b1, false, false); \
    u32x4 w = {r0[0], r1[0], r0[1], r1[1]}; OUT = *reinterpret_cast<bf16x8*>(&w); } while (0)
  PK4(p0, 0, pa0); PK4(p0, 8, pa1); PK4(p1, 0, pa2); PK4(p1, 8, pa3);
#undef PK4
}
__device__ __forceinline__ void qkt(f32x16& p0, f32x16& p1, const char* Ks, const bf16x8* qr, const char* qrope, const int (&kbase)[4], bool vis) {
  p0 = f32x16{}; p1 = f32x16{};
  if (vis) {
#pragma unroll
  for (int d0 = 0; d0 < 12; ++d0) {
    bf16x8 b0 = *reinterpret_cast<const bf16x8*>(Ks + kbase[d0 & 3] + (d0 >> 2) * 128);
    bf16x8 b1 = *reinterpret_cast<const bf16x8*>(Ks + kbase[d0 & 3] + (d0 >> 2) * 128 + 32 * KROW);
    const bf16x8 qv = d0 < 8 ? qr[d0 < 8 ? d0 : 0] : *reinterpret_cast<const bf16x8*>(qrope + (d0 - 8) * 32);
    p0 = __builtin_amdgcn_mfma_f32_32x32x16_bf16(b0, qv, p0, 0, 0, 0);
    p1 = __builtin_amdgcn_mfma_f32_32x32x16_bf16(b1, qv, p1, 0, 0, 0); }
  }
  if (!vis) {
#pragma unroll
    for (int r = 0; r < 16; ++r) { p0[r] = -1e30f; p1[r] = -1e30f; } }
}
__device__ __forceinline__ int v_st(int k, int c) { const int kk = (k & ~0xC) | ((k & 4) << 1) | ((k & 8) >> 1); return ((kk >> 3) * 4 + (c >> 5)) * 512 + ((kk & 7) * 32 + (c & 31)) * 2; }
__device__ __forceinline__ int v_rd_base(int lane) { return ((lane & 3) << 3) | (((lane >> 2) & 3) << 6) | (((lane >> 4) & 1) << 5) | (((lane >> 5) & 1) << 8); }
constexpr int v_rd_off(int d0, int ks, int half) { return d0 * 512 + ks * 4096 + half * 2048; }
template <int OFF> __device__ __forceinline__ s16x4 tr_read(int vb) {
  s16x4 r; asm volatile("ds_read_b64_tr_b16 %0, %1 offset:%2" : "=&v"(r) : "v"(vb), "i"(OFF) : "memory"); return r;
}
template <int D0> __device__ __forceinline__ void pv_one(f32x16& od, int vb, bf16x8 pa0, bf16x8 pa1, bf16x8 pa2, bf16x8 pa3) {
  const s16x4 l0 = tr_read<v_rd_off(D0, 0, 0)>(vb), h0 = tr_read<v_rd_off(D0, 0, 1)>(vb), l1 = tr_read<v_rd_off(D0, 1, 0)>(vb), h1 = tr_read<v_rd_off(D0, 1, 1)>(vb);
  const s16x4 l2 = tr_read<v_rd_off(D0, 2, 0)>(vb), h2 = tr_read<v_rd_off(D0, 2, 1)>(vb), l3 = tr_read<v_rd_off(D0, 3, 0)>(vb), h3 = tr_read<v_rd_off(D0, 3, 1)>(vb);
  asm volatile("s_waitcnt lgkmcnt(0)" ::: "memory"); SBAR();
#define PK(L, H) (bf16x8){L[0], L[1], L[2], L[3], H[0], H[1], H[2], H[3]}
  od = __builtin_amdgcn_mfma_f32_32x32x16_bf16(pa0, PK(l0, h0), od, 0, 0, 0);
  od = __builtin_amdgcn_mfma_f32_32x32x16_bf16(pa1, PK(l1, h1), od, 0, 0, 0);
  od = __builtin_amdgcn_mfma_f32_32x32x16_bf16(pa2, PK(l2, h2), od, 0, 0, 0);
  od = __builtin_amdgcn_mfma_f32_32x32x16_bf16(pa3, PK(l3, h3), od, 0, 0, 0);
#undef PK
}
__device__ __forceinline__ void pv_d0(f32x16* o, int vb, bf16x8 pa0, bf16x8 pa1, bf16x8 pa2, bf16x8 pa3) {
  pv_one<0>(o[0], vb, pa0, pa1, pa2, pa3); pv_one<1>(o[1], vb, pa0, pa1, pa2, pa3); pv_one<2>(o[2], vb, pa0, pa1, pa2, pa3); pv_one<3>(o[3], vb, pa0, pa1, pa2, pa3);
}

__device__ __forceinline__ void attn_block(const bf16_t* __restrict__ Qb, const bf16_t* __restrict__ Kn, const bf16_t* __restrict__ Kr, const bf16_t* __restrict__ Vh,
                                           bf16_t* __restrict__ Ob, int qb, char* lds) {
  constexpr int LDQ = 3072, LDK = 4096, LDR = 64, LDO = 2048;
  const int tid = otid(), wid = tid >> 6, lane = tid & 63, r32 = lane & 31, hi = lane >> 5;
  char* V_lds = lds; char* K_lds = lds + 2 * SHM_V;
  float* ws = (float*)(lds + 2 * SHM_V + 2 * SHM_K) + wid * 64; float* li_l = ws; float* al_l = ws + 32;
  float m_reg = -1e30f, l_reg = 0; f32x16 o[4] = {}; bf16x8 qr[8];
  const bf16_t* Qw = Qb + (long)(wid * QBLK + r32) * LDQ + hi * 8;
#pragma unroll
  for (int d0 = 0; d0 < 8; ++d0) qr[d0] = *reinterpret_cast<const bf16x8*>(Qw + d0 * 16);
  char* qrope = lds + 2 * SHM_V + 2 * SHM_K + NW * 64 * 4 + (wid * QBLK + r32) * QR_PITCH + hi * 16;
#pragma unroll
  for (int d0 = 8; d0 < 12; ++d0) *reinterpret_cast<bf16x8*>(qrope + (d0 - 8) * 32) = *reinterpret_cast<const bf16x8*>(Qw + d0 * 16);
  asm volatile("s_waitcnt lgkmcnt(0)" ::: "memory");
  const int NT = 4 * qb + 4, jmax = 4 * qb + (wid >> 1);
  int kbase[4];
#pragma unroll
  for (int dl = 0; dl < 4; ++dl) kbase[dl] = r32 * KROW + (((dl << 5) | (hi << 4)) ^ ((r32 & 7) << 4));
  const int sr = tid >> 4, sc = (tid & 15) * 8, vst0 = v_st(sr, sc), vst1 = v_st(32 + sr, sc);
  const int rr = tid >> 3, rc = (tid & 7) * 8;
  const int vb0 = (int)(uintptr_t)V_lds + v_rd_base(lane);
  bf16x8 vs0, vs1, ks0, ks1, kr0;
#define SLOAD(k0) do { vs0 = *reinterpret_cast<const bf16x8*>(&Vh[(long)((k0) + sr) * LDK + sc]); vs1 = *reinterpret_cast<const bf16x8*>(&Vh[(long)((k0) + 32 + sr) * LDK + sc]); \
    ks0 = *reinterpret_cast<const bf16x8*>(&Kn[(long)((k0) + sr) * LDK + sc]); ks1 = *reinterpret_cast<const bf16x8*>(&Kn[(long)((k0) + 32 + sr) * LDK + sc]); \
    kr0 = *reinterpret_cast<const bf16x8*>(&Kr[(long)((k0) + rr) * LDR + rc]); } while (0)
#define SWRITE(b) do { *(bf16x8*)(V_lds + (b) * SHM_V + vst0) = vs0; *(bf16x8*)(V_lds + (b) * SHM_V + vst1) = vs1; int kc = sc * 2; \
    *(bf16x8*)(K_lds + (b) * SHM_K + KSWZ(sr, kc)) = ks0; *(bf16x8*)(K_lds + (b) * SHM_K + KSWZ(32 + sr, kc)) = ks1; \
    *(bf16x8*)(K_lds + (b) * SHM_K + KSWZ(rr, 256 + rc * 2)) = kr0; } while (0)
#define SWAIT() asm volatile("s_waitcnt vmcnt(0)" ::: "memory")
#define RESC(a) do { if (__any((a) < 1.f)) { if (hi == 0) al_l[r32] = (a); asm volatile("s_waitcnt lgkmcnt(0)" ::: "memory"); \
    _Pragma("unroll") for (int d = 0; d < 4; ++d) _Pragma("unroll") for (int r = 0; r < 16; ++r) o[d][r] *= al_l[crow(r, hi)]; } } while (0)
  f32x16 pA0, pA1, pB0, pB1; float mnA, mnB, alA, alB; bf16x8 pa0, pa1, pa2, pa3;
  SLOAD(0); SWAIT(); SWRITE(0); __syncthreads();
  qkt(pA0, pA1, K_lds, qr, qrope, kbase, true); partialSM(pA0, pA1, m_reg, mnA, alA);
  SLOAD(KVBLK);
  SWAIT(); SWRITE(1); __syncthreads();
  for (int j = 1; j + 1 < NT; j += 2) {
    SBAR(); qkt(pB0, pB1, K_lds + SHM_K, qr, qrope, kbase, j <= jmax);
    finishSM(pA0, pA1, alA, l_reg, pa0, pa1, pa2, pa3); SBAR();
    SLOAD((j + 1) * KVBLK); SBAR();
    if (j - 1 <= jmax) pv_d0(o, vb0, pa0, pa1, pa2, pa3);
    partialSM(pB0, pB1, m_reg, mnB, alB);
    __syncthreads(); SWAIT(); SWRITE(0);
    RESC(alB); __syncthreads();
    SBAR(); qkt(pA0, pA1, K_lds, qr, qrope, kbase, j + 1 <= jmax);
    finishSM(pB0, pB1, alB, l_reg, pa0, pa1, pa2, pa3); SBAR();
    SLOAD((j + 2) * KVBLK); SBAR();
    if (j <= jmax) pv_d0(o, vb0 + (int)SHM_V, pa0, pa1, pa2, pa3);
    partialSM(pA0, pA1, m_reg, mnA, alA);
    __syncthreads(); SWAIT(); SWRITE(1);
    RESC(alA); __syncthreads();
  }
  SBAR(); qkt(pB0, pB1, K_lds + SHM_K, qr, qrope, kbase, NT - 1 <= jmax);
  finishSM(pA0, pA1, alA, l_reg, pa0, pa1, pa2, pa3); SBAR();
  if (NT - 2 <= jmax) pv_d0(o, vb0, pa0, pa1, pa2, pa3);
  partialSM(pB0, pB1, m_reg, mnB, alB);
  __syncthreads(); RESC(alB);
  finishSM(pB0, pB1, alB, l_reg, pa0, pa1, pa2, pa3); SBAR();
  if (NT - 1 <= jmax) pv_d0(o, vb0 + (int)SHM_V, pa0, pa1, pa2, pa3);
  if (hi == 0) li_l[r32] = l_reg; asm volatile("s_waitcnt lgkmcnt(0)" ::: "memory");
  float rli[16];
#pragma unroll
  for (int r = 0; r < 16; ++r) rli[r] = __builtin_amdgcn_rcpf(li_l[crow(r, hi)]);
  bf16_t* Ow = Ob + (long)(wid * QBLK) * LDO;
#pragma unroll
  for (int r = 0; r < 16; ++r) { int orow = crow(r, hi);
#pragma unroll
    for (int d0 = 0; d0 < 4; ++d0) Ow[(long)orow * LDO + d0 * 32 + r32] = f2bf(o[d0][r] * rli[r]); }
  __syncthreads();
#undef SLOAD
#undef SWRITE
#undef SWAIT
#undef RESC
}
}
namespace ret {
constexpr int QP_ = 136;
__device__ __forceinline__ bf16x8 ldfrag(const bf16_t* p) { return *reinterpret_cast<const bf16x8*>(p); }
template <int CL> struct Lay {
    static constexpr int IP = CL + 8;
    static constexpr int QS = 0, KS = QS + CL * QP_ * 2, VT = KS + CL * QP_ * 2, VDT = VT + 32 * IP * 2, IN = VDT + 32 * IP * 2, ST = IN + CL * IP * 2, VS = ST + 32 * QP_ * 2, END = VS + CL * 40 * 2;
};
static_assert(Lay<128>::END <= LDS_BARW, "retention LDS");

template <int CL>
__device__ __forceinline__ void run(const bf16_t* __restrict__ Y, bf16_t* __restrict__ OB, const float* __restrict__ sp, float* __restrict__ so, long tok0, int nch, int h, int es, float lg, char* lds, int tid) {
    using L = Lay<CL>; constexpr int IP = L::IP, NQT = CL / 16, NKS = CL / 32, NPC = CL / 32;
    const int wid = __builtin_amdgcn_readfirstlane(tid >> 6), lane = tid & 63, l15 = lane & 15, l4 = lane >> 4;
    bf16_t* Qs = (bf16_t*)(lds + L::QS); bf16_t* Ks = (bf16_t*)(lds + L::KS); bf16_t* Vt = (bf16_t*)(lds + L::VT); bf16_t* Vdt = (bf16_t*)(lds + L::VDT); bf16_t* In = (bf16_t*)(lds + L::IN); bf16_t* St = (bf16_t*)(lds + L::ST); bf16_t* Vs = (bf16_t*)(lds + L::VS);
    const float gCL = __expf((float)CL * lg);
    f32x4 Sacc[2];
    if (sp) {
#pragma unroll
        for (int ej = 0; ej < 2; ++ej)
#pragma unroll
            for (int r = 0; r < 4; ++r) Sacc[ej][r] = sp[(long)(16 * wid + 4 * l4 + r) * RV + 16 * ej + l15];
    } else { Sacc[0] = (f32x4){0.f, 0.f, 0.f, 0.f}; Sacc[1] = (f32x4){0.f, 0.f, 0.f, 0.f}; }
    for (int i = tid; i < CL * IP / 8; i += 512) reinterpret_cast<u32x4*>(In)[i] = (u32x4){0u, 0u, 0u, 0u};
    u32x4 pq[NPC], pk[NPC], pv;
    const int vk = tid >> 2, ve0 = (tid & 3) * 8;
#define RET_LOAD(cc) do { const bf16_t* yrow_ = Y + (tok0 + (long)(cc) * CL) * INWP; \
        _Pragma("unroll") for (int i = 0; i < NPC; ++i) { const int idx = tid + i * 512, k = idx >> 4, d0 = (idx & 15) * 8; \
            pq[i] = *reinterpret_cast<const u32x4*>(yrow_ + (long)k * INWP + C_RQ + h * 128 + d0); pk[i] = *reinterpret_cast<const u32x4*>(yrow_ + (long)k * INWP + C_RK + h * 128 + d0); } \
        if (tid < 4 * CL) pv = *reinterpret_cast<const u32x4*>(yrow_ + (long)vk * INWP + C_RV + h * 256 + es * 32 + ve0); } while (0)
    RET_LOAD(0);
    for (int c = 0; c < nch; ++c) {
#pragma unroll
        for (int ej = 0; ej < 2; ++ej) { u32x2 w; w.x = cvt_pk_bf16(Sacc[ej][0], Sacc[ej][1]); w.y = cvt_pk_bf16(Sacc[ej][2], Sacc[ej][3]);
            *reinterpret_cast<u32x2*>(St + (16 * ej + l15) * QP_ + 16 * wid + 4 * l4) = w; }
#pragma unroll
        for (int i = 0; i < NPC; ++i) { const int idx = tid + i * 512, k = idx >> 4, d0 = (idx & 15) * 8;
            *reinterpret_cast<u32x4*>(Qs + k * QP_ + d0) = pq[i]; *reinterpret_cast<u32x4*>(Ks + k * QP_ + d0) = pk[i]; }
        if (tid < 4 * CL) *reinterpret_cast<u32x4*>(Vs + vk * 40 + ve0) = pv;
        if (c + 1 < nch) RET_LOAD(c + 1);
        __syncthreads();
        if (tid < 4 * CL) { const int e = tid & 31, kg = tid >> 5; float f[8], fd[8];
#pragma unroll
            for (int j = 0; j < 8; ++j) { f[j] = bf2f(Vs[(8 * kg + j) * 40 + e]); fd[j] = f[j] * __expf((float)(CL - 1 - 8 * kg - j) * lg); }
            *reinterpret_cast<u32x4*>(Vt + e * IP + 8 * kg) = pack8(f); *reinterpret_cast<u32x4*>(Vdt + e * IP + 8 * kg) = pack8(fd); }
#pragma unroll
        for (int it_ = 0; it_ < (NQT * (NQT + 1) / 2 + 7) / 8; ++it_) { const int idx = wid + 8 * it_; if (idx >= NQT * (NQT + 1) / 2) break;
            int qi = 0; while ((qi + 1) * (qi + 2) / 2 <= idx) ++qi; const int kj = idx - qi * (qi + 1) / 2;
            f32x4 a = (f32x4){0.f, 0.f, 0.f, 0.f}; const bf16_t* qp = Qs + (16 * qi + l15) * QP_ + 8 * l4; const bf16_t* kp = Ks + (16 * kj + l15) * QP_ + 8 * l4;
#pragma unroll
            for (int ks = 0; ks < 4; ++ks) a = __builtin_amdgcn_mfma_f32_16x16x32_bf16(ldfrag(qp + 32 * ks), ldfrag(kp + 32 * ks), a, 0, 0, 0);
            const int q0 = 16 * qi + 4 * l4, k = 16 * kj + l15;
#pragma unroll
            for (int r = 0; r < 4; ++r) { const int q = q0 + r; const float dm = (q >= k) ? __expf((float)(q - k) * lg) : 0.f;
                In[q * IP + k] = f2bf(a[r] * dm); } }
        __syncthreads();
#pragma unroll
        for (int ot = 0; ot < (2 * NQT) / 8; ++ot) { const int tI = wid + 8 * ot, qi = tI >> 1, ej = tI & 1; f32x4 a = (f32x4){0.f, 0.f, 0.f, 0.f};
#pragma unroll
            for (int ks = 0; ks < 4; ++ks) a = __builtin_amdgcn_mfma_f32_16x16x32_bf16(ldfrag(Qs + (16 * qi + l15) * QP_ + 32 * ks + 8 * l4), ldfrag(St + (16 * ej + l15) * QP_ + 32 * ks + 8 * l4), a, 0, 0, 0);
#pragma unroll
            for (int r = 0; r < 4; ++r) a[r] *= __expf((float)(16 * qi + 4 * l4 + r + 1) * lg);
#pragma unroll
            for (int ks = 0; ks < NKS; ++ks) if (ks <= (qi >> 1)) a = __builtin_amdgcn_mfma_f32_16x16x32_bf16(ldfrag(In + (16 * qi + l15) * IP + 32 * ks + 8 * l4), ldfrag(Vt + (16 * ej + l15) * IP + 32 * ks + 8 * l4), a, 0, 0, 0);
            bf16_t* op = OB + ((long)(h * 8 + es) * T + tok0 + (long)c * CL + 16 * qi + 4 * l4) * 32 + 16 * ej + l15;
#pragma unroll
            for (int r = 0; r < 4; ++r) op[r * 32] = f2bf(a[r]); }
        { f32x4 s0 = Sacc[0] * gCL, s1 = Sacc[1] * gCL;
#pragma unroll
          for (int ks = 0; ks < NKS; ++ks) { bf16x8 af;
#pragma unroll
              for (int j = 0; j < 8; ++j) af[j] = (short)Ks[(32 * ks + 8 * l4 + j) * QP_ + 16 * wid + l15];
              s0 = __builtin_amdgcn_mfma_f32_16x16x32_bf16(af, ldfrag(Vdt + l15 * IP + 32 * ks + 8 * l4), s0, 0, 0, 0);
              s1 = __builtin_amdgcn_mfma_f32_16x16x32_bf16(af, ldfrag(Vdt + (16 + l15) * IP + 32 * ks + 8 * l4), s1, 0, 0, 0); }
          Sacc[0] = s0; Sacc[1] = s1; }
        __syncthreads();
    }
#undef RET_LOAD
#pragma unroll
    for (int ej = 0; ej < 2; ++ej)
#pragma unroll
        for (int r = 0; r < 4; ++r) so[(long)(16 * wid + 4 * l4 + r) * RV + 16 * ej + l15] = Sacc[ej][r];
}

__device__ __forceinline__ void unit(KParams& p, int l, int u, char* lds) {
    const int tid = otid(); unsigned char* ws = optr(gp(p.ws)); const bf16_t* Y = (const bf16_t*)(ws + WS_Y); bf16_t* OB = (bf16_t*)(ws + WS_OB);
    const bool samp = u >= 256; const int v = samp ? u - 256 : u; const int b = v >> 6, h = (v >> 3) & 7, es = v & 7; const float lg = p.lg[h];
    if (samp) run<64>(Y, OB, gp(p.state_ret) + ((((long)l * DB + b) * RH + h) * RQK) * RV + es * 32, gp(p.out) + O_RETS + ((((long)l * DB + b) * RH + h) * RQK) * RV + es * 32, (long)TP + b * 64, 1, h, es, lg, lds, tid);
    else run<64>(Y, OB, nullptr, gp(p.out) + O_RETP + ((((long)l * NB + b) * RH + h) * RQK) * RV + es * 32, (long)b * SEQ, SEQ / 64, h, es, lg, lds, tid);
}
}
namespace peer {
__device__ __forceinline__ void ins16(float (&l)[16], float x) {
#pragma unroll
    for (int j = 0; j < 16; ++j) { const float hi = fmaxf(l[j], x); x = fminf(l[j], x); l[j] = hi; }
}
#define CE_DESC(a, b) do { const float hi_ = fmaxf(a, b), lo_ = fminf(a, b); a = hi_; b = lo_; } while (0)
#define CE_ASC(a, b) do { const float hi_ = fmaxf(a, b), lo_ = fminf(a, b); a = lo_; b = hi_; } while (0)
__device__ __forceinline__ void sort16_desc(float (&v)[16]) {
#pragma unroll
    for (int k = 2; k <= 16; k <<= 1)
#pragma unroll
        for (int j = k >> 1; j >= 1; j >>= 1)
#pragma unroll
            for (int i = 0; i < 16; ++i) { const int l = i ^ j; if (l > i) { if ((i & k) == 0) CE_DESC(v[i], v[l]); else CE_ASC(v[i], v[l]); } }
}
__device__ __forceinline__ void merge16_desc(float (&l)[16], const float (&o)[16]) {
#pragma unroll
    for (int i = 0; i < 16; ++i) l[i] = fmaxf(l[i], o[15 - i]);
#pragma unroll
    for (int j = 8; j >= 1; j >>= 1)
#pragma unroll
        for (int i = 0; i < 16; ++i) { const int m = i ^ j; if (m > i) CE_DESC(l[i], l[m]); }
}
constexpr int KPITCH = 136;
__device__ __forceinline__ void half_top16(const bf16_t* __restrict__ qrow, const bf16_t* __restrict__ keys, int lane, float (&l)[16]) {
    const int r32 = lane & 31, g = lane >> 5;
#pragma unroll
    for (int j = 0; j < 16; ++j) l[j] = -3.0e38f;
    bf16x8 qf[8];
#pragma unroll
    for (int ks = 0; ks < 8; ++ks) qf[ks] = *reinterpret_cast<const bf16x8*>(qrow + 16 * ks + 8 * g);
#pragma unroll 1
    for (int kb = 0; kb < 4; ++kb) { f32x16 a = f32x16{};
#pragma unroll
        for (int ks = 0; ks < 8; ++ks) { const bf16x8 kf = *reinterpret_cast<const bf16x8*>(keys + (32 * kb + r32) * KPITCH + 16 * ks + 8 * g);
            a = __builtin_amdgcn_mfma_f32_32x32x16_bf16(kf, qf[ks], a, 0, 0, 0); }
        float blk[16];
#pragma unroll
        for (int r = 0; r < 16; ++r) { const unsigned key = (unsigned)(32 * kb + (r & 3) + 8 * (r >> 2) + 4 * g);
            blk[r] = __uint_as_float((__float_as_uint(a[r]) & ~0x7Fu) | key); }
        sort16_desc(blk); merge16_desc(l, blk); }
}
__device__ __forceinline__ void merge_lists(float (&l)[16], const float (&o)[16]) { merge16_desc(l, o); }
__device__ __forceinline__ void select_unit(const bf16_t* __restrict__ QP, const bf16_t* __restrict__ k1, const bf16_t* __restrict__ k2, int* __restrict__ PIDX, float* __restrict__ PW,
                                            int t0, int h, int lane, float* lds_lane  ) {
    const int r32 = lane & 31, g = lane >> 5;
    const bf16_t* qrow = QP + (long)(t0 + r32) * DM + h * 256;
    float la[16], lb[16];
    half_top16(qrow, k1, lane, la);
    half_top16(qrow + 128, k2, lane, lb);
    float m0[16], m1[16];
#pragma unroll
    for (int j = 0; j < 16; ++j) { auto rr = __builtin_amdgcn_permlane32_swap(__float_as_uint(la[j]), __float_as_uint(lb[j]), false, false); m0[j] = __uint_as_float(rr[0]); m1[j] = __uint_as_float(rr[1]); }
    merge_lists(m0, m1);
    float L1[16], L2[16];
#pragma unroll
    for (int j = 0; j < 16; ++j) { auto rr = __builtin_amdgcn_permlane32_swap(__float_as_uint(m0[j]), __float_as_uint(m0[j]), false, false);
        L1[j] = __uint_as_float(rr[0]); L2[j] = __uint_as_float(rr[1]); }
#define CAND(i, j) __uint_as_float((__float_as_uint(L1[i] + L2[j]) & ~0xFFu) | (unsigned)((i) * 16 + (j)))
    float best[16], c2[16], c3[16];
#pragma unroll
    for (int j = 0; j < 16; ++j) best[j] = CAND(0, j);
    sort16_desc(best);
    c2[0] = CAND(1, 0); c2[1] = CAND(1, 1); c2[2] = CAND(1, 2); c2[3] = CAND(1, 3); c2[4] = CAND(1, 4); c2[5] = CAND(1, 5); c2[6] = CAND(1, 6); c2[7] = CAND(1, 7);
    c2[8] = CAND(2, 0); c2[9] = CAND(2, 1); c2[10] = CAND(2, 2); c2[11] = CAND(2, 3); c2[12] = CAND(2, 4); c2[13] = CAND(4, 0); c2[14] = CAND(4, 1); c2[15] = CAND(4, 2);
    sort16_desc(c2); merge16_desc(best, c2);
    c3[0] = CAND(3, 0); c3[1] = CAND(3, 1); c3[2] = CAND(3, 2); c3[3] = CAND(3, 3); c3[4] = CAND(5, 0); c3[5] = CAND(5, 1); c3[6] = CAND(6, 0); c3[7] = CAND(6, 1);
    c3[8] = CAND(7, 0); c3[9] = CAND(7, 1); c3[10] = CAND(8, 0); c3[11] = CAND(9, 0); c3[12] = CAND(10, 0); c3[13] = CAND(11, 0); c3[14] = CAND(12, 0); c3[15] = CAND(13, 0);
    sort16_desc(c3); merge16_desc(best, c3);
    ins16(best, CAND(14, 0)); ins16(best, CAND(15, 0));
#undef CAND
#pragma unroll
    for (int j = 0; j < 16; ++j) { lds_lane[j] = __uint_as_float(__float_as_uint(L1[j]) & 0x7Fu); lds_lane[16 + j] = __uint_as_float(__float_as_uint(L2[j]) & 0x7Fu); }
    asm volatile("s_waitcnt lgkmcnt(0)" ::: "memory");
    float wsum = 0.f, w[16]; int ei[16];
    const float mx = best[0];
#pragma unroll
    for (int k = 0; k < 16; ++k) { const unsigned code = __float_as_uint(best[k]) & 0xFFu; const int i = (int)(code >> 4), j = (int)(code & 15u);
        const int i1 = (int)__float_as_uint(lds_lane[i]), i2 = (int)__float_as_uint(lds_lane[16 + j]); ei[k] = i1 * NKEYS + i2;
        w[k] = __expf(best[k] - mx); wsum += w[k]; }
    const float inv = 1.0f / wsum;
    if (g == 0) { int* ip = PIDX + (long)(t0 + r32) * 128 + h * 16; float* wp = PW + (long)(t0 + r32) * 128 + h * 16;
#pragma unroll
        for (int k = 0; k < 16; k += 4) { *reinterpret_cast<int4*>(ip + k) = make_int4(ei[k], ei[k + 1], ei[k + 2], ei[k + 3]);
            *reinterpret_cast<float4*>(wp + k) = make_float4(w[k] * inv, w[k + 1] * inv, w[k + 2] * inv, w[k + 3] * inv); } }
}

__device__ __forceinline__ float gelu_exact(float x) { return 0.5f * x * (1.0f + erff(x * 0.70710678118654752f)); }

__device__ __forceinline__ void dec16(const u32x4 w, f32x2 (&f)[8]) {
    f[0] = __builtin_amdgcn_cvt_pk_f32_fp8((int)w.x, false); f[1] = __builtin_amdgcn_cvt_pk_f32_fp8((int)w.x, true);
    f[2] = __builtin_amdgcn_cvt_pk_f32_fp8((int)w.y, false); f[3] = __builtin_amdgcn_cvt_pk_f32_fp8((int)w.y, true);
    f[4] = __builtin_amdgcn_cvt_pk_f32_fp8((int)w.z, false); f[5] = __builtin_amdgcn_cvt_pk_f32_fp8((int)w.z, true);
    f[6] = __builtin_amdgcn_cvt_pk_f32_fp8((int)w.w, false); f[7] = __builtin_amdgcn_cvt_pk_f32_fp8((int)w.w, true);
}
__device__ __forceinline__ void gather_token(const bf16_t* __restrict__ H, const unsigned char* __restrict__ PU, const unsigned char* __restrict__ PV, const float* __restrict__ SU, const float* __restrict__ SV,
                                             const int* __restrict__ PIDX, const float* __restrict__ PW, float* __restrict__ X, const float* __restrict__ gate  , int t, int lane) {
    f32x2 xf[2][8];
#pragma unroll
    for (int hlf = 0; hlf < 2; ++hlf)
#pragma unroll
        for (int q = 0; q < 2; ++q) { const u32x4 w = *reinterpret_cast<const u32x4*>(H + (long)t * DM + 1024 * hlf + 16 * lane + 8 * q);
            xf[hlf][4 * q + 0] = (f32x2){bflo(w.x), bfhi(w.x)}; xf[hlf][4 * q + 1] = (f32x2){bflo(w.y), bfhi(w.y)}; xf[hlf][4 * q + 2] = (f32x2){bflo(w.z), bfhi(w.z)}; xf[hlf][4 * q + 3] = (f32x2){bflo(w.w), bfhi(w.w)}; }
    f32x2 out[2][8];
#pragma unroll
    for (int hlf = 0; hlf < 2; ++hlf)
#pragma unroll
        for (int i = 0; i < 8; ++i) out[hlf][i] = (f32x2){0.f, 0.f};
    const int myidx0 = PIDX[(long)t * 128 + lane], myidx1 = PIDX[(long)t * 128 + 64 + lane];
    const float myw0 = PW[(long)t * 128 + lane], myw1 = PW[(long)t * 128 + 64 + lane];
    const float msu0 = SU[myidx0], msu1 = SU[myidx1], msv0 = SV[myidx0], msv1 = SV[myidx1];
    for (int hk = 0; hk < 128; hk += 4) {
        const int src = hk & 63; const bool lo = hk < 64;
        const int selidx = lo ? myidx0 : myidx1; const int selw = __float_as_int(lo ? myw0 : myw1), selsu = __float_as_int(lo ? msu0 : msu1), selsv = __float_as_int(lo ? msv0 : msv1);
        int e[4]; float g[4], su[4], sv[4];
#pragma unroll
        for (int k = 0; k < 4; ++k) { e[k] = __builtin_amdgcn_readlane(selidx, src + k); g[k] = __int_as_float(__builtin_amdgcn_readlane(selw, src + k));
            su[k] = __int_as_float(__builtin_amdgcn_readlane(selsu, src + k)); sv[k] = __int_as_float(__builtin_amdgcn_readlane(selsv, src + k)); }
        u32x4 uw[4][2], vw[4][2];
#pragma unroll
        for (int k = 0; k < 4; ++k) { uw[k][0] = *reinterpret_cast<const u32x4*>(PU + ((long)(lane >> 3) * NEXP + e[k]) * 128 + 16 * (lane & 7)); uw[k][1] = *reinterpret_cast<const u32x4*>(PU + ((long)(8 + (lane >> 3)) * NEXP + e[k]) * 128 + 16 * (lane & 7)); }
#pragma unroll
        for (int k = 0; k < 4; ++k) { { const u32x2 a0 = *reinterpret_cast<const u32x2*>(PV + ((long)(2 * lane) * NEXP + e[k]) * 8), a1 = *reinterpret_cast<const u32x2*>(PV + ((long)(2 * lane + 1) * NEXP + e[k]) * 8);
              const u32x2 b0 = *reinterpret_cast<const u32x2*>(PV + ((long)(128 + 2 * lane) * NEXP + e[k]) * 8), b1 = *reinterpret_cast<const u32x2*>(PV + ((long)(129 + 2 * lane) * NEXP + e[k]) * 8);
              vw[k][0] = (u32x4){a0.x, a0.y, a1.x, a1.y}; vw[k][1] = (u32x4){b0.x, b0.y, b1.x, b1.y}; } }
        float a[4];
#pragma unroll
        for (int k = 0; k < 4; ++k) { f32x2 d = (f32x2){0.f, 0.f};
#pragma unroll
            for (int hlf = 0; hlf < 2; ++hlf) { f32x2 f[8]; dec16(uw[k][hlf], f);
#pragma unroll
                for (int i = 0; i < 8; ++i) d = __builtin_elementwise_fma(f[i], xf[hlf][i], d); }
            a[k] = wave_sum(d[0] + d[1]); }
#pragma unroll
        for (int k = 0; k < 4; ++k) { const float ak = g[k] * gelu_exact(a[k] * su[k]) * sv[k]; const f32x2 a2 = (f32x2){ak, ak};
#pragma unroll
            for (int hlf = 0; hlf < 2; ++hlf) { f32x2 f[8]; dec16(vw[k][hlf], f);
#pragma unroll
                for (int i = 0; i < 8; ++i) out[hlf][i] = __builtin_elementwise_fma(f[i], a2, out[hlf][i]); } }
    }
    const float* gr = gate + (long)cond_row(t) * 12288;
#pragma unroll
    for (int hlf = 0; hlf < 2; ++hlf)
#pragma unroll
        for (int q = 0; q < 4; ++q) { const int c = 1024 * hlf + 16 * lane + 4 * q; float* xp = X + (long)t * DM + c;
            const f32x4 gv = *reinterpret_cast<const f32x4*>(gr + c); f32x4 xv = *reinterpret_cast<const f32x4*>(xp);
            xv[0] += gv[0] * out[hlf][2 * q][0]; xv[1] += gv[1] * out[hlf][2 * q][1]; xv[2] += gv[2] * out[hlf][2 * q + 1][0]; xv[3] += gv[3] * out[hlf][2 * q + 1][1];
            *reinterpret_cast<f32x4*>(xp) = xv; }
}

constexpr int SW = 128, NSL = DM / SW;
struct XInfo { int rank, xi, nx, nloc; };
__device__ __forceinline__ void upass(const bf16_t* __restrict__ H, const unsigned char* __restrict__ PU, const int* __restrict__ PIDX, const float* __restrict__ PW, const float* __restrict__ SU, const float* __restrict__ SV,
                                      float* __restrict__ DOTP, unsigned* __restrict__ PACKT, const XInfo xin, int wid, int lane) {
    const int g = lane >> 3, c = lane & 7; const int nwv = xin.nloc * 8;
    const int tlo = (int)((long)T * xin.xi / xin.nx), thi = (int)((long)T * (xin.xi + 1) / xin.nx); const int wv = tlo + xin.rank * 8 + wid;
    float* dp = DOTP;
    for (int s = 0; s < NSL; ++s) { const bool first = (s == 0), lastS = (s == NSL - 1);
        const __amdgpu_buffer_rsrc_t urs = __builtin_amdgcn_make_buffer_rsrc((void*)(PU + (long)s * NEXP * SW), 0, NEXP * SW, 0x00020000);
#define UP_ROW(e_) __builtin_bit_cast(u32x4, __builtin_amdgcn_raw_buffer_load_b128(urs, (e_) * SW + 16 * c, 0, 0))
#define UP_IDX(tt, q4) (*reinterpret_cast<const int4*>(PIDX + (long)(tt) * 128 + 16 * g + 4 * (q4)))
#define UP_X(tt, q2) (*reinterpret_cast<const u32x4*>(H + (long)(tt) * DM + SW * s + 16 * c + 8 * (q2)))
        if (wv >= thi) continue;
        u32x4 A[8], B[8]; int4 en[4]; u32x4 xn[2];
        { int4 e0[4];
#pragma unroll
          for (int q4 = 0; q4 < 4; ++q4) e0[q4] = UP_IDX(wv, q4);
          A[0] = UP_ROW(e0[0].x); A[1] = UP_ROW(e0[0].y); A[2] = UP_ROW(e0[0].z); A[3] = UP_ROW(e0[0].w); A[4] = UP_ROW(e0[1].x); A[5] = UP_ROW(e0[1].y); A[6] = UP_ROW(e0[1].z); A[7] = UP_ROW(e0[1].w);
          B[0] = UP_ROW(e0[2].x); B[1] = UP_ROW(e0[2].y); B[2] = UP_ROW(e0[2].z); B[3] = UP_ROW(e0[2].w); B[4] = UP_ROW(e0[3].x); B[5] = UP_ROW(e0[3].y); B[6] = UP_ROW(e0[3].z); B[7] = UP_ROW(e0[3].w);
          const int t1 = (wv + nwv < thi) ? wv + nwv : wv;
#pragma unroll
          for (int q4 = 0; q4 < 4; ++q4) en[q4] = UP_IDX(t1, q4);
          xn[0] = UP_X(wv, 0); xn[1] = UP_X(wv, 1); }
#pragma unroll 1
        for (int t = wv; t < thi; t += nwv) {
            const int tn = (t + nwv < thi) ? t + nwv : t, tnn = (tn + nwv < thi) ? tn + nwv : tn;
            f32x2 xf[8];
#pragma unroll
            for (int q2 = 0; q2 < 2; ++q2) { const u32x4 hw = xn[q2];
                xf[4 * q2 + 0] = (f32x2){bflo(hw.x), bfhi(hw.x)}; xf[4 * q2 + 1] = (f32x2){bflo(hw.y), bfhi(hw.y)}; xf[4 * q2 + 2] = (f32x2){bflo(hw.z), bfhi(hw.z)}; xf[4 * q2 + 3] = (f32x2){bflo(hw.w), bfhi(hw.w)}; }
            xn[0] = UP_X(tn, 0); xn[1] = UP_X(tn, 1);
            float d[16];
#pragma unroll
            for (int i = 0; i < 8; ++i) { f32x2 f[8]; dec16(A[i], f); f32x2 a = (f32x2){0.f, 0.f};
#pragma unroll
                for (int k = 0; k < 8; ++k) a = __builtin_elementwise_fma(f[k], xf[k], a);
                d[i] = a[0] + a[1]; }
            A[0] = UP_ROW(en[0].x); A[1] = UP_ROW(en[0].y); A[2] = UP_ROW(en[0].z); A[3] = UP_ROW(en[0].w); A[4] = UP_ROW(en[1].x); A[5] = UP_ROW(en[1].y); A[6] = UP_ROW(en[1].z); A[7] = UP_ROW(en[1].w);
#pragma unroll
            for (int i = 0; i < 8; ++i) { f32x2 f[8]; dec16(B[i], f); f32x2 a = (f32x2){0.f, 0.f};
#pragma unroll
                for (int k = 0; k < 8; ++k) a = __builtin_elementwise_fma(f[k], xf[k], a);
                d[8 + i] = a[0] + a[1]; }
            B[0] = UP_ROW(en[2].x); B[1] = UP_ROW(en[2].y); B[2] = UP_ROW(en[2].z); B[3] = UP_ROW(en[2].w); B[4] = UP_ROW(en[3].x); B[5] = UP_ROW(en[3].y); B[6] = UP_ROW(en[3].z); B[7] = UP_ROW(en[3].w);
#pragma unroll
            for (int q4 = 0; q4 < 4; ++q4) en[q4] = UP_IDX(tnn, q4);
            float r8[8], r4[4], r2[2];
#pragma unroll
            for (int k = 0; k < 8; ++k) { const float keep = (c & 4) ? d[k + 8] : d[k], send = (c & 4) ? d[k] : d[k + 8]; r8[k] = keep + sx<4>(send); }
#pragma unroll
            for (int k = 0; k < 4; ++k) { const float keep = (c & 2) ? r8[k + 4] : r8[k], send = (c & 2) ? r8[k] : r8[k + 4]; r4[k] = keep + sx<2>(send); }
#pragma unroll
            for (int k = 0; k < 2; ++k) { const float keep = (c & 1) ? r4[k + 2] : r4[k], send = (c & 1) ? r4[k] : r4[k + 2]; r2[k] = keep + sx<1>(send); }
            float* o = dp + (long)t * 128 + 16 * g + 2 * c;
            f32x2 acc = (f32x2){r2[0], r2[1]};
            if (!first) acc += *reinterpret_cast<const f32x2*>(o);
            if (!lastS) *reinterpret_cast<f32x2*>(o) = acc;
            else {
                const int p0 = 16 * g + 2 * c; const int2 ee = *reinterpret_cast<const int2*>(PIDX + (long)t * 128 + p0); const f32x2 gw = *reinterpret_cast<const f32x2*>(PW + (long)t * 128 + p0);
                const float a0 = gw[0] * gelu_exact(acc[0] * SU[ee.x]) * SV[ee.x], a1 = gw[1] * gelu_exact(acc[1] * SU[ee.y]) * SV[ee.y];
                u32x2 pk; pk.x = (cvt_pk_bf16(0.f, a0) & 0xffff0000u) | (unsigned)ee.x; pk.y = (cvt_pk_bf16(0.f, a1) & 0xffff0000u) | (unsigned)ee.y;
                *reinterpret_cast<u32x2*>(PACKT + ((long)(p0 >> 2) * T + t) * 4 + (p0 & 3)) = pk; }
        }
#undef UP_ROW
#undef UP_IDX
#undef UP_X
    }
}
__device__ __forceinline__ void actpass(const float* __restrict__ DOTP, const int* __restrict__ PIDX, const float* __restrict__ PW, const float* __restrict__ SU, const float* __restrict__ SV, float* __restrict__ ACT, int nx, long gt, long nt) {
    for (long i = gt; i < (long)T * 128; i += nt) { float dsum = 0.f;
        for (int x = 0; x < nx; ++x) dsum += DOTP[(long)x * T * 128 + i];
        const int e = PIDX[i]; const float av = PW[i] * gelu_exact(dsum * SU[e]) * SV[e]; const long t = i >> 7; const int pp = (int)(i & 127);
        reinterpret_cast<unsigned*>(ACT)[((long)(pp >> 2) * T + t) * 4 + (pp & 3)] = (cvt_pk_bf16(0.f, av) & 0xffff0000u) | (unsigned)e; }
}
__device__ __forceinline__ void vpass(const unsigned char* __restrict__ PV, const int* __restrict__ PIDX, const float* __restrict__ ACT, float* __restrict__ X, const float* __restrict__ gate, const XInfo xin, int wid, int lane) {
    const int g = lane >> 3, c = lane & 7; const int wv = xin.rank * 8 + wid, nwv = xin.nloc * 8;
    for (int s = xin.xi; s < NSL; s += xin.nx) {
        int4 en[4]; f32x4 an[4];
#pragma unroll
        for (int q4 = 0; q4 < 4; ++q4) { en[q4] = *reinterpret_cast<const int4*>(PIDX + (long)(wv < T ? wv : 0) * 128 + 16 * g + 4 * q4); an[q4] = *reinterpret_cast<const f32x4*>(ACT + (long)(wv < T ? wv : 0) * 128 + 16 * g + 4 * q4); }
        for (int t = wv; t < T; t += nwv) {
            int e[16]; float a[16];
#pragma unroll
            for (int q4 = 0; q4 < 4; ++q4) { e[4 * q4] = en[q4].x; e[4 * q4 + 1] = en[q4].y; e[4 * q4 + 2] = en[q4].z; e[4 * q4 + 3] = en[q4].w; a[4 * q4] = an[q4][0]; a[4 * q4 + 1] = an[q4][1]; a[4 * q4 + 2] = an[q4][2]; a[4 * q4 + 3] = an[q4][3]; }
            u32x4 w[16];
#pragma unroll
            for (int i = 0; i < 16; ++i) w[i] = *reinterpret_cast<const u32x4*>(PV + ((long)s * NEXP + e[i]) * SW + 16 * c);
            { const int tn = (t + nwv < T) ? t + nwv : t;
#pragma unroll
              for (int q4 = 0; q4 < 4; ++q4) { en[q4] = *reinterpret_cast<const int4*>(PIDX + (long)tn * 128 + 16 * g + 4 * q4); an[q4] = *reinterpret_cast<const f32x4*>(ACT + (long)tn * 128 + 16 * g + 4 * q4); } }
            f32x2 o[8];
#pragma unroll
            for (int k = 0; k < 8; ++k) o[k] = (f32x2){0.f, 0.f};
#pragma unroll
            for (int i = 0; i < 16; ++i) { f32x2 f[8]; dec16(w[i], f); const f32x2 a2 = (f32x2){a[i], a[i]};
#pragma unroll
                for (int k = 0; k < 8; ++k) o[k] = __builtin_elementwise_fma(f[k], a2, o[k]); }
            f32x2 r4[4], r2[2], r1;
#pragma unroll
            for (int k = 0; k < 4; ++k) { const f32x2 keep = (g & 4) ? o[k + 4] : o[k], send = (g & 4) ? o[k] : o[k + 4]; r4[k] = keep + (f32x2){sx<32>(send[0]), sx<32>(send[1])}; }
#pragma unroll
            for (int k = 0; k < 2; ++k) { const f32x2 keep = (g & 2) ? r4[k + 2] : r4[k], send = (g & 2) ? r4[k] : r4[k + 2]; r2[k] = keep + (f32x2){sx<16>(send[0]), sx<16>(send[1])}; }
            { const f32x2 keep = (g & 1) ? r2[1] : r2[0], send = (g & 1) ? r2[0] : r2[1]; r1 = keep + (f32x2){sx<8>(send[0]), sx<8>(send[1])}; }
            const int col = SW * s + 16 * c + 2 * g;
            const f32x2 gv = *reinterpret_cast<const f32x2*>(gate + (long)cond_row(t) * 12288 + col);
            float* xp = X + (long)t * DM + col; f32x2 xv = *reinterpret_cast<const f32x2*>(xp);
            xv += gv * r1; *reinterpret_cast<f32x2*>(xp) = xv;
        }
    }
}

__device__ __forceinline__ void vpass_lds(const unsigned char* __restrict__ PV, const unsigned* __restrict__ PACKT, float* __restrict__ X, const float* __restrict__ gate, char* lds, int bid, int nb, int s_end, int tid) {
    const int wid = tid >> 6, lane = tid & 63;
    for (int s = bid; s < s_end; s += nb) {
        __syncthreads();
        { const u32x4* src = reinterpret_cast<const u32x4*>(PV + (long)s * NEXP * 8); u32x4* dst = reinterpret_cast<u32x4*>(lds);
#pragma unroll 4
          for (int i = tid; i < NEXP * 8 / 16; i += 512) dst[i] = src[i]; }
        __syncthreads();
        u32x4 h0[8], h1[8];
        const __amdgpu_buffer_rsrc_t vrs = __builtin_amdgcn_make_buffer_rsrc((void*)PACKT, 0, (int)((size_t)T * 128 * 4), 0x00020000);
#define VP_LD(k, toff) __builtin_bit_cast(u32x4, __builtin_amdgcn_raw_buffer_load_b128(vrs, (int)(toff), (int)((size_t)(k) * T * 16), 0))
        { const unsigned toff = (unsigned)(wid * 64 + lane) * 16u;
#pragma unroll
          for (int k = 0; k < 8; ++k) h0[k] = VP_LD(k, toff);
#pragma unroll
          for (int k = 0; k < 8; ++k) h1[k] = VP_LD(8 + k, toff); }
#define VP_STEP(HB) do { _Pragma("unroll") for (int kk = 0; kk < 8; kk += 2) { unsigned pw[8]; \
            _Pragma("unroll") for (int k = 0; k < 2; ++k) { pw[4 * k] = HB[kk + k].x; pw[4 * k + 1] = HB[kk + k].y; pw[4 * k + 2] = HB[kk + k].z; pw[4 * k + 3] = HB[kk + k].w; } \
            u32x2 w[8]; \
            _Pragma("unroll") for (int k = 0; k < 8; ++k) w[k] = *reinterpret_cast<const u32x2*>(lds + (pw[k] & 0xffffu) * 8u); \
            _Pragma("unroll") for (int k = 0; k < 8; ++k) { const float a = __uint_as_float(pw[k] & 0xffff0000u); \
                const f32x2 f0 = __builtin_amdgcn_cvt_pk_f32_fp8((int)w[k].x, false), f1 = __builtin_amdgcn_cvt_pk_f32_fp8((int)w[k].x, true), f2 = __builtin_amdgcn_cvt_pk_f32_fp8((int)w[k].y, false), f3 = __builtin_amdgcn_cvt_pk_f32_fp8((int)w[k].y, true); \
                acc[0] = fmaf(a, f0[0], acc[0]); acc[1] = fmaf(a, f0[1], acc[1]); acc[2] = fmaf(a, f1[0], acc[2]); acc[3] = fmaf(a, f1[1], acc[3]); \
                acc[4] = fmaf(a, f2[0], acc[4]); acc[5] = fmaf(a, f2[1], acc[5]); acc[6] = fmaf(a, f3[0], acc[6]); acc[7] = fmaf(a, f3[1], acc[7]); } } } while (0)
#pragma unroll 1
        for (int tg = wid; tg < T / 64; tg += 8) { const int t = tg * 64 + lane; const int tgn = (tg + 8 < T / 64) ? tg + 8 : tg;
            const unsigned toff = (unsigned)t * 16u, toffn = (unsigned)(tgn * 64 + lane) * 16u;
            float acc[8];
#pragma unroll
            for (int j = 0; j < 8; ++j) acc[j] = 0.f;
            VP_STEP(h0);
#pragma unroll
            for (int k = 0; k < 8; ++k) h0[k] = VP_LD(16 + k, toff);
            VP_STEP(h1);
#pragma unroll
            for (int k = 0; k < 8; ++k) h1[k] = VP_LD(24 + k, toff);
            VP_STEP(h0);
#pragma unroll
            for (int k = 0; k < 8; ++k) h0[k] = VP_LD(k, toffn);
            VP_STEP(h1);
#pragma unroll
            for (int k = 0; k < 8; ++k) h1[k] = VP_LD(8 + k, toffn);
            const float* gr = gate + (long)cond_row(t) * 12288 + 8 * s; float* xp = X + (long)t * DM + 8 * s;
            const f32x4 g0 = *reinterpret_cast<const f32x4*>(gr), g1 = *reinterpret_cast<const f32x4*>(gr + 4);
            f32x4 x0 = *reinterpret_cast<const f32x4*>(xp), x1 = *reinterpret_cast<const f32x4*>(xp + 4);
            x0[0] += g0[0] * acc[0]; x0[1] += g0[1] * acc[1]; x0[2] += g0[2] * acc[2]; x0[3] += g0[3] * acc[3];
            x1[0] += g1[0] * acc[4]; x1[1] += g1[1] * acc[5]; x1[2] += g1[2] * acc[6]; x1[3] += g1[3] * acc[7];
            *reinterpret_cast<f32x4*>(xp) = x0; *reinterpret_cast<f32x4*>(xp + 4) = x1; }
#undef VP_STEP
#undef VP_LD
    }
    __syncthreads();
}
}
namespace ph {
__device__ __forceinline__ int gwave() { return obid() * 8 + (otid() >> 6); }
__device__ __forceinline__ int nwaves() { return ogrid() * 8; }
__device__ __forceinline__ long gthread() { return (long)obid() * 512 + otid(); }
__device__ __forceinline__ long nthreads() { return (long)ogrid() * 512; }

__device__ __forceinline__ void transpose_tile(const float* __restrict__ src, int C, int r0, int c0, bf16_t* __restrict__ dst, long dpitch, float* tile) {
    const int tid = otid();
#pragma unroll
    for (int i = 0; i < 8; ++i) { const int idx = tid + 512 * i, r = idx >> 6, c = idx & 63; tile[r * 65 + c] = src[(long)(r0 + r) * C + c0 + c]; }
    __syncthreads();
    { const int c = tid >> 3, rc = (tid & 7) * 8; float f[8];
#pragma unroll
      for (int j = 0; j < 8; ++j) f[j] = tile[(rc + j) * 65 + c];
      *reinterpret_cast<u32x4*>(dst + (long)(c0 + c) * dpitch + r0 + rc) = pack8(f); }
    __syncthreads();
}

__device__ __forceinline__ void zero_chunks(bf16_t* base, long nrows, long rowpitch, int col0, int nchunk) {
    const long total = nrows * nchunk;
    for (long i = gthread(); i < total; i += nthreads()) { const long r = i / nchunk; const int ch = (int)(i % nchunk);
        *reinterpret_cast<u32x4*>(base + r * rowpitch + col0 + ch * 8) = (u32x4){0u, 0u, 0u, 0u}; }
}

__device__ __forceinline__ void prologue(KParams& p, char* lds) {
    unsigned char* ws = optr(gp(p.ws)); const int tid = otid();
    float* tile = (float*)lds;
    { struct TJob { const float* src; bf16_t* dst; int R, C, r0, c0, perm; };
      auto decode = [&](int it) { TJob j; j.perm = 0; const int l = it / 10656; int r = it % 10656;
        if (r < 5664) { j.src = gp(p.w_in) + (long)l * DM * INW; j.R = DM; j.C = INW; j.dst = (bf16_t*)(ws + WS_WIN) + (long)l * INWP * DM; }
        else if (r < 6048) { r -= 5664; j.src = gp(p.w_uq) + (long)l * 512 * 3072; j.R = 512; j.C = 3072; j.dst = (bf16_t*)(ws + WS_WUQ) + (long)l * 3072 * 512; j.perm = 1; }
        else if (r < 6560) { r -= 6048; j.src = gp(p.w_ukv) + (long)l * 512 * 4096; j.R = 512; j.C = 4096; j.dst = (bf16_t*)(ws + WS_WUKV) + (long)l * 4096 * 512; }
        else { r -= 6560; const int m = r >> 10; r &= 1023; j.R = DM; j.C = DM;
            j.src = (m == 0 ? gp(p.w_a) : m == 1 ? gp(p.w_b) : m == 2 ? gp(p.w_o) : gp(p.w_pq)) + (long)l * DM * DM;
            j.dst = (bf16_t*)(ws + (m == 0 ? WS_WA : m == 1 ? WS_WB : m == 2 ? WS_WO : WS_WPQ)) + (long)l * DM * DM; }
        const int ntc = j.C / 64; j.r0 = (r / ntc) * 64; j.c0 = (r % ntc) * 64; return j; };
      const int NTILES = 2 * 10656, G_ = ogrid(); int it = obid(); float v[8]; TJob cur{};
      if (it < NTILES) { cur = decode(it);
#pragma unroll
        for (int i = 0; i < 8; ++i) { const int idx = tid + 512 * i, r = idx >> 6, c = idx & 63; v[i] = cur.src[(long)(cur.r0 + r) * cur.C + cur.c0 + c]; } }
      while (it < NTILES) { const int itn = it + G_; float vn[8]; TJob nxt{};
        if (itn < NTILES) { nxt = decode(itn);
#pragma unroll
            for (int i = 0; i < 8; ++i) { const int idx = tid + 512 * i, r = idx >> 6, c = idx & 63; vn[i] = nxt.src[(long)(nxt.r0 + r) * nxt.C + nxt.c0 + c]; } }
#pragma unroll
        for (int i = 0; i < 8; ++i) { const int idx = tid + 512 * i, r = idx >> 6, c = idx & 63; tile[r * 65 + c] = v[i]; }
        __syncthreads();
        { const int c = tid >> 3, rc = (tid & 7) * 8; float f[8];
#pragma unroll
          for (int jj = 0; jj < 8; ++jj) f[jj] = tile[(rc + jj) * 65 + c];
          int drow = cur.c0 + c;
          if (cur.perm) { const int gq = drow / 768, o = drow - 768 * gq, hh = o / 192, w = o - 192 * hh;
              drow = 768 * gq + (w < 128 ? 128 * hh + w : (w < 160 ? 512 + 32 * hh + (w - 128) : 640 + 32 * hh + (w - 160))); }
          *reinterpret_cast<u32x4*>(cur.dst + (long)drow * cur.R + cur.r0 + rc) = pack8(f); }
        __syncthreads();
#pragma unroll
        for (int i = 0; i < 8; ++i) v[i] = vn[i];
        cur = nxt; it = itn; } }
    for (long i = gthread(); i < 2L * 16 * 512 * 32; i += nthreads()) { const int ch = (int)(i & 31); const long row = i >> 5; const int c = (int)(row & 511), h = (int)((row >> 9) & 15), l = (int)(row >> 13);
        u32x4 w = (u32x4){0u, 0u, 0u, 0u};
        if (ch < 16) { const float* s = gp(p.w_ukv) + (((long)l * 512 + c) * 16 + h) * 256 + ch * 8; float f[8];
#pragma unroll
            for (int j = 0; j < 8; ++j) f[j] = s[j];
            w = pack8(f); }
        *reinterpret_cast<u32x4*>((bf16_t*)(ws + WS_WUK) + row * 256 + ch * 8) = w; }
    for (long i = gthread(); i < 2L * 4096; i += nthreads()) { const bool second = i >= 4096; const long j8 = (second ? i - 4096 : i) * 8; const float* s = (second ? gp(p.peer_k2) : gp(p.peer_k1)) + j8; float f[8];
#pragma unroll
        for (int j = 0; j < 8; ++j) f[j] = s[j];
        *reinterpret_cast<u32x4*>((bf16_t*)(ws + (second ? WS_PK2 : WS_PK1)) + j8) = pack8(f); }
    for (int l = 0; l < 2; ++l) zero_chunks((bf16_t*)(ws + WS_WIN) + ((long)l * INWP + INW) * DM, INWP - INW, DM, 0, DM / 8);
    for (int b = 0; b < DB; ++b) zero_chunks((bf16_t*)(ws + WS_CKA) + ((long)b * KPAD + KALL) * QLD, KPAD - KALL, QLD, 0, QLD / 8);
    zero_chunks((bf16_t*)(ws + WS_CKA), (long)DB * KPAD, QLD, 576, 8);
    zero_chunks((bf16_t*)(ws + WS_CKT), (long)DB * 512, KPAD, KALL, (KPAD - KALL) / 8);
    zero_chunks((bf16_t*)(ws + WS_QL), (long)DB * 1024, QLD, 576, 8);
    for (long i = gthread(); i < 4096L * 96; i += nthreads()) { const int pos = (int)(i / 96), k = (int)(i % 96); const bool big = k >= 32; const int fi = big ? k - 32 : k; const float d = big ? 128.f : 64.f;
        const float inv = __builtin_amdgcn_exp2f(-(2.0f * (float)fi / d) * 13.287712379549449f);
        const float ang = (float)pos * inv; double rv = (double)ang * 0.15915494309189535; rv -= floor(rv); const float fr = (float)rv;
        float* dst = big ? (float*)(ws + WS_TAB128) + ((long)pos * 64 + fi) * 2 : (float*)(ws + WS_TAB64) + ((long)pos * 32 + fi) * 2;
        dst[0] = __builtin_amdgcn_cosf(fr); dst[1] = __builtin_amdgcn_sinf(fr); }
    { float* sc = (float*)lds;
      for (int it = obid(); it < 2 * 12 * 8; it += ogrid()) { const int l = it / 96, cc = (it % 96) / 8, ks = it % 8;
        __syncthreads();
        for (int i = tid; i < NCOND * 256; i += 512) { const int r = i >> 8, k = i & 255; const float c = r < NB ? gp(p.c_prompt)[(long)r * DM + ks * 256 + k] : gp(p.c_sample)[(long)(r - NB) * DM + ks * 256 + k]; sc[i] = siluf_(c); }
        __syncthreads();
        float a0[NCOND], a1[NCOND];
#pragma unroll
        for (int r = 0; r < NCOND; ++r) { a0[r] = 0.f; a1[r] = 0.f; }
        const float* wp = gp(p.w_ada) + ((long)l * DM + ks * 256) * 12288 + cc * 1024 + 2 * tid;
#pragma unroll 1
        for (int k = 0; k < 256; k += 4) { const f32x2 w0 = *reinterpret_cast<const f32x2*>(wp), w1 = *reinterpret_cast<const f32x2*>(wp + 12288), w2 = *reinterpret_cast<const f32x2*>(wp + 2 * 12288), w3 = *reinterpret_cast<const f32x2*>(wp + 3 * 12288);
            wp += 4 * 12288;
#pragma unroll
            for (int r = 0; r < NCOND; ++r) { const f32x4 s = *reinterpret_cast<const f32x4*>(sc + r * 256 + k);
                a0[r] = fmaf(s[0], w0[0], fmaf(s[1], w1[0], fmaf(s[2], w2[0], fmaf(s[3], w3[0], a0[r]))));
                a1[r] = fmaf(s[0], w0[1], fmaf(s[1], w1[1], fmaf(s[2], w2[1], fmaf(s[3], w3[1], a1[r]))));
                if ((r % 6) == 5) __builtin_amdgcn_sched_barrier(0); } }
        float* dst = (float*)(ws + WS_ADAP) + (((long)ks * 2 + l) * NCOND) * 12288 + cc * 1024 + 2 * tid;
#pragma unroll
        for (int r = 0; r < NCOND; ++r) *reinterpret_cast<f32x2*>(dst + (long)r * 12288) = (f32x2){a0[r], a1[r]}; }
      __syncthreads(); }
}

__device__ __forceinline__ void wpq_int8(KParams& p) {
    unsigned char* ws = optr(gp(p.ws)); const int lane = otid() & 63;
    for (int r = gwave(); r < 2 * DM; r += nwaves()) { const bf16_t* src = (const bf16_t*)(ws + WS_WPQ) + (long)r * DM; float f[4][8]; float am = 0.f;
#pragma unroll
        for (int j = 0; j < 4; ++j) { unpack8(*reinterpret_cast<const u32x4*>(src + 512 * j + 8 * lane), f[j]);
#pragma unroll
            for (int i = 0; i < 8; ++i) am = fmaxf(am, fabsf(f[j][i])); }
        am = wave_max(am); const float qs = am > 0.f ? 127.0f / am : 0.f;
#pragma unroll
        for (int j = 0; j < 4; ++j) { unsigned w2[2];
#pragma unroll
            for (int hh = 0; hh < 2; ++hh) { unsigned w = 0u;
#pragma unroll
                for (int i = 0; i < 4; ++i) w |= ((unsigned)((int)__builtin_rintf(f[j][4 * hh + i] * qs) & 0xff)) << (8 * i);
                w2[hh] = w; }
            *reinterpret_cast<u32x2*>(ws + WS_WPQ8 + (long)r * DM + 512 * j + 8 * lane) = (u32x2){w2[0], w2[1]}; }
        if (lane == 0) ((float*)(ws + WS_SB8))[r] = am * (1.0f / 127.0f); }
}

__device__ __forceinline__ void wb_int8(KParams& p, int l) {
    unsigned char* ws = optr(gp(p.ws)); const int lane = otid() & 63;
    for (int r = gwave(); r < DM; r += nwaves()) { const bf16_t* src = (const bf16_t*)(ws + WS_WB) + ((long)l * DM + r) * DM; float f[4][8]; float am = 0.f;
#pragma unroll
        for (int j = 0; j < 4; ++j) { unpack8(*reinterpret_cast<const u32x4*>(src + 512 * j + 8 * lane), f[j]);
#pragma unroll
            for (int i = 0; i < 8; ++i) am = fmaxf(am, fabsf(f[j][i])); }
        am = wave_max(am); const float qs = am > 0.f ? 127.0f / am : 0.f;
#pragma unroll
        for (int j = 0; j < 4; ++j) { unsigned w2[2];
#pragma unroll
            for (int hh = 0; hh < 2; ++hh) { unsigned w = 0u;
#pragma unroll
                for (int i = 0; i < 4; ++i) w |= ((unsigned)((int)__builtin_rintf(f[j][4 * hh + i] * qs) & 0xff)) << (8 * i);
                w2[hh] = w; }
            *reinterpret_cast<u32x2*>(ws + WS_WB8 + (long)r * DM + 512 * j + 8 * lane) = (u32x2){w2[0], w2[1]}; }
        if (lane == 0) ((float*)(ws + WS_SBB))[r] = am * (1.0f / 127.0f); }
}

__device__ __forceinline__ void win_int8(KParams& p, int l) {
    unsigned char* ws = optr(gp(p.ws)); const int lane = otid() & 63;
    for (int jr = gwave(); jr < NB8 * 256; jr += nwaves()) { const int blk = jr >> 8, n = (blk < 3 ? blk + 5 : blk + 18) * 256 + (jr & 255);
        const bf16_t* src = (const bf16_t*)(ws + WS_WIN) + ((long)l * INWP + n) * DM; float f[4][8]; float am = 0.f;
#pragma unroll
        for (int j = 0; j < 4; ++j) { unpack8(*reinterpret_cast<const u32x4*>(src + 512 * j + 8 * lane), f[j]);
#pragma unroll
            for (int i = 0; i < 8; ++i) am = fmaxf(am, fabsf(f[j][i])); }
        am = wave_max(am); const float qs = am > 0.f ? 127.0f / am : 0.f;
#pragma unroll
        for (int j = 0; j < 4; ++j) { unsigned w2[2];
#pragma unroll
            for (int hh = 0; hh < 2; ++hh) { unsigned w = 0u;
#pragma unroll
                for (int i = 0; i < 4; ++i) w |= ((unsigned)((int)__builtin_rintf(f[j][4 * hh + i] * qs) & 0xff)) << (8 * i);
                w2[hh] = w; }
            *reinterpret_cast<u32x2*>(ws + WS_WIN8 + (long)jr * DM + 512 * j + 8 * lane) = (u32x2){w2[0], w2[1]}; }
        if (lane == 0) ((float*)(ws + WS_SBW))[n] = am * (1.0f / 127.0f); }
}

__device__ __forceinline__ void ada_reduce(KParams& p) {
    unsigned char* ws = optr(gp(p.ws)); const float* ap = (const float*)(ws + WS_ADAP); float* ad = (float*)(ws + WS_ADA); const long n = 2L * NCOND * 12288;
    for (long i = gthread(); i < n; i += nthreads()) { const int l = (int)(i / (NCOND * 12288L)); const int j = (int)(i % 12288);
        float s = gp(p.b_ada)[(long)l * 12288 + j];
#pragma unroll
        for (int ks = 0; ks < 8; ++ks) s += ap[(long)ks * n + i];
        ad[i] = s; }
}

__device__ __forceinline__ void modulate(KParams& p, int l, int which) {
    const int lane = otid() & 63; unsigned char* ws = optr(gp(p.ws)); const float* X = gp(p.out); bf16_t* H = (bf16_t*)(ws + WS_H);
    const float* g = (which ? gp(p.g_ffn) : gp(p.g_mix)) + (long)l * DM; const float* ada = (const float*)(ws + WS_ADA) + (long)l * NCOND * 12288 + (which ? 3 : 0) * DM;
    for (int t = gwave(); t < T; t += nwaves()) {
        const float* xr = (l == 0 && which == 0) ? (t < TP ? gp(p.x_prompt) + (long)t * DM : gp(p.x_sample) + (long)(t - TP) * DM) : X + (long)t * DM; f32x4 v[8]; float ss = 0.f;
#pragma unroll
        for (int j = 0; j < 8; ++j) { v[j] = *reinterpret_cast<const f32x4*>(xr + 256 * j + 4 * lane); ss += v[j][0] * v[j][0] + v[j][1] * v[j][1] + v[j][2] * v[j][2] + v[j][3] * v[j][3]; }
        ss = wave_sum(ss); const float rinv = rsqrtf(ss * (1.0f / DM) + EPS);
        const float* sh = ada + (long)cond_row(t) * 12288; const float* sc = sh + DM;
#pragma unroll
        for (int j = 0; j < 8; ++j) { const int c = 256 * j + 4 * lane; const f32x4 gv = *reinterpret_cast<const f32x4*>(g + c), sv = *reinterpret_cast<const f32x4*>(sc + c), hv = *reinterpret_cast<const f32x4*>(sh + c);
            const f32x4 y = v[j] * rinv * gv * (sv + 1.0f) + hv; u32x2 w; w.x = cvt_pk_bf16(y[0], y[1]); w.y = cvt_pk_bf16(y[2], y[3]);
            *reinterpret_cast<u32x2*>(H + (long)t * DM + c) = w; v[j] = y; }
        {
            float am = 0.f;
#pragma unroll
            for (int j = 0; j < 8; ++j) am = fmaxf(am, fmaxf(fmaxf(fabsf(v[j][0]), fabsf(v[j][1])), fmaxf(fabsf(v[j][2]), fabsf(v[j][3]))));
            am = wave_max(am); const float qs = am > 0.f ? 127.0f / am : 0.f;
#pragma unroll
            for (int j = 0; j < 8; ++j) { const int c = 256 * j + 4 * lane;
                const int q0 = (int)__builtin_rintf(v[j][0] * qs), q1 = (int)__builtin_rintf(v[j][1] * qs), q2 = (int)__builtin_rintf(v[j][2] * qs), q3 = (int)__builtin_rintf(v[j][3] * qs);
                *reinterpret_cast<unsigned*>(ws + WS_H8 + (long)t * DM + c) = (unsigned)(q0 & 0xff) | ((unsigned)(q1 & 0xff) << 8) | ((unsigned)(q2 & 0xff) << 16) | ((unsigned)(q3 & 0xff) << 24); }
            if (lane == 0) ((float*)(ws + WS_SA8))[t] = am * (1.0f / 127.0f); }
    }
}

__device__ __forceinline__ void cache_convert(KParams& p, int l, char* lds, int it0, int it1, int bidx, int nb) {
    const int tid = otid(); unsigned char* ws = optr(gp(p.ws)); float* tile = (float*)lds; bf16_t* CKA = (bf16_t*)(ws + WS_CKA); bf16_t* CKT = (bf16_t*)(ws + WS_CKT);
    { const int NT_ = it1, G_ = nb; int it = it0 + bidx; float v[8];
      const float* cbase = gp(p.cache_ckv) + (long)l * DB * PAST * 512;
#define CC_SRC(itx) (cbase + (((long)((itx) >> 8)) * PAST + (((itx) >> 3) & 31) * 64) * 512 + ((itx) & 7) * 64)
      if (it < NT_) { const float* src = CC_SRC(it);
#pragma unroll
        for (int i = 0; i < 8; ++i) { const int idx = tid + 512 * i, r = idx >> 6, c = idx & 63; v[i] = src[(long)r * 512 + c]; } }
      while (it < NT_) { const int b = it >> 8, kt = (it >> 3) & 31, ct = it & 7; const int itn = it + G_; float vn[8];
        if (itn < NT_) { const float* src = CC_SRC(itn);
#pragma unroll
            for (int i = 0; i < 8; ++i) { const int idx = tid + 512 * i, r = idx >> 6, c = idx & 63; vn[i] = src[(long)r * 512 + c]; } }
#pragma unroll
        for (int i = 0; i < 8; ++i) { const int idx = tid + 512 * i, r = idx >> 6, c = idx & 63; tile[r * 65 + c] = v[i]; }
        __syncthreads();
        { const int r = tid >> 3, cc = (tid & 7) * 8; float f[8];
#pragma unroll
          for (int j = 0; j < 8; ++j) f[j] = tile[r * 65 + cc + j];
          *reinterpret_cast<u32x4*>(CKA + ((long)b * KPAD + kt * 64 + r) * QLD + ct * 64 + cc) = pack8(f);
#pragma unroll
          for (int j = 0; j < 8; ++j) f[j] = tile[(cc + j) * 65 + r];
          *reinterpret_cast<u32x4*>(CKT + ((long)b * 512 + ct * 64 + r) * KPAD + kt * 64 + cc) = pack8(f); }
        __syncthreads();
#pragma unroll
        for (int i = 0; i < 8; ++i) v[i] = vn[i];
        it = itn; }
#undef CC_SRC
    }
    for (long i = (long)it0 * 64 + (long)bidx * 512 + tid; i < (long)it1 * 64; i += (long)nb * 512) { const long row = i >> 3; const int ch = (int)(i & 7); const int b = (int)(row >> 11), k = (int)(row & 2047);
        const float* s = gp(p.cache_krope) + (((long)l * DB + b) * PAST + k) * 64 + ch * 8; float f[8];
#pragma unroll
        for (int j = 0; j < 8; ++j) f[j] = s[j];
        *reinterpret_cast<u32x4*>(CKA + ((long)b * KPAD + k) * QLD + 512 + ch * 8) = pack8(f); }
}

__device__ __forceinline__ void post_win(KParams& p, int l) {
    const int lane = otid() & 63; unsigned char* ws = optr(gp(p.ws));
    bf16_t* Y = (bf16_t*)(ws + WS_Y); bf16_t* CQN = (bf16_t*)(ws + WS_CQN); bf16_t* CKVNP = (bf16_t*)(ws + WS_CKVNP); bf16_t* KRP = (bf16_t*)(ws + WS_KRP); bf16_t* CKA = (bf16_t*)(ws + WS_CKA); bf16_t* CKT = (bf16_t*)(ws + WS_CKT);
    const float* T64 = (const float*)(ws + WS_TAB64); const float* T128 = (const float*)(ws + WS_TAB128);
    for (int t = gwave(); t < T; t += nwaves()) {
        bf16_t* y = Y + (long)t * INWP; const int pos = tok_pos(t); const bool samp = t >= TP; const int ts = t - TP, b = ts >> 6, s = ts & 63;
        { float f[8], o[8]; unpack8(*reinterpret_cast<const u32x4*>(y + C_CQ + 8 * lane), f); float ss = 0.f;
#pragma unroll
          for (int j = 0; j < 8; ++j) ss += f[j] * f[j];
          ss = wave_sum(ss); const float rinv = rsqrtf(ss * (1.0f / 512.f) + EPS); const float* g = gp(p.g_q) + (long)l * 512 + 8 * lane;
#pragma unroll
          for (int j = 0; j < 8; ++j) o[j] = f[j] * rinv * g[j];
          *reinterpret_cast<u32x4*>(CQN + (long)t * 512 + 8 * lane) = pack8(o); }
        { float f[8], o[8]; unpack8(*reinterpret_cast<const u32x4*>(y + C_CKV + 8 * lane), f); float ss = 0.f;
#pragma unroll
          for (int j = 0; j < 8; ++j) ss += f[j] * f[j];
          ss = wave_sum(ss); const float rinv = rsqrtf(ss * (1.0f / 512.f) + EPS); const float* g = gp(p.g_kv) + (long)l * 512 + 8 * lane;
#pragma unroll
          for (int j = 0; j < 8; ++j) o[j] = f[j] * rinv * g[j];
          float* od = gp(p.out) + (samp ? O_CKVS + ((long)l * TS + ts) * 512 : O_CKVP + ((long)l * TP + t) * 512) + 8 * lane;
          *reinterpret_cast<f32x4*>(od) = (f32x4){o[0], o[1], o[2], o[3]}; *reinterpret_cast<f32x4*>(od + 4) = (f32x4){o[4], o[5], o[6], o[7]};
          const u32x4 w = pack8(o);
          if (!samp) *reinterpret_cast<u32x4*>(CKVNP + (long)t * 512 + 8 * lane) = w;
          else { *reinterpret_cast<u32x4*>(CKA + ((long)b * KPAD + PAST + s) * QLD + 8 * lane) = w;
#pragma unroll
              for (int j = 0; j < 8; ++j) CKT[((long)b * 512 + 8 * lane + j) * KPAD + PAST + s] = f2bf(o[j]); } }
        if (lane < 32) { const float x1 = bf2f(y[C_KR + lane]), x2 = bf2f(y[C_KR + 32 + lane]); const float c = T64[((long)pos * 32 + lane) * 2], sn = T64[((long)pos * 32 + lane) * 2 + 1];
            const float o1 = x1 * c - x2 * sn, o2 = x1 * sn + x2 * c;
            float* od = gp(p.out) + (samp ? O_KRS + ((long)l * TS + ts) * 64 : O_KRP + ((long)l * TP + t) * 64); od[lane] = o1; od[32 + lane] = o2;
            if (!samp) { KRP[(long)t * 64 + lane] = f2bf(o1); KRP[(long)t * 64 + 32 + lane] = f2bf(o2); }
            else { bf16_t* d = CKA + ((long)b * KPAD + PAST + s) * QLD + 512; d[lane] = f2bf(o1); d[32 + lane] = f2bf(o2); } }
        { const int hh = lane >> 3, d0 = (lane & 7) * 8; const float* cs = T128 + ((long)pos * 64 + d0) * 2; float cv[8], sv[8];
#pragma unroll
          for (int j = 0; j < 4; ++j) { const f32x4 q = *reinterpret_cast<const f32x4*>(cs + 4 * j); cv[2 * j] = q[0]; sv[2 * j] = q[1]; cv[2 * j + 1] = q[2]; sv[2 * j + 1] = q[3]; }
#pragma unroll
          for (int which = 0; which < 2; ++which) { bf16_t* base = y + (which ? C_RK : C_RQ) + hh * 128 + d0; const float sca = which ? 0.08838834764831845f : 1.0f;
              float a[8], bq[8], o1[8], o2[8]; unpack8(*reinterpret_cast<const u32x4*>(base), a); unpack8(*reinterpret_cast<const u32x4*>(base + 64), bq);
#pragma unroll
              for (int j = 0; j < 8; ++j) { o1[j] = (a[j] * cv[j] - bq[j] * sv[j]) * sca; o2[j] = (a[j] * sv[j] + bq[j] * cv[j]) * sca; }
              *reinterpret_cast<u32x4*>(base) = pack8(o1); *reinterpret_cast<u32x4*>(base + 64) = pack8(o2); } }
    }
}

__device__ __forceinline__ void post_q(KParams& p) {
    const int lane = otid() & 63; unsigned char* ws = optr(gp(p.ws)); bf16_t* Q = (bf16_t*)(ws + WS_Q); bf16_t* QL = (bf16_t*)(ws + WS_QL); const float* T64 = (const float*)(ws + WS_TAB64);
    for (int t = gwave(); t < T; t += nwaves()) { const int pos = tok_pos(t); const int hd = lane >> 2, d0 = (lane & 3) * 8;
        bf16_t* base = Q + (long)t * 3072 + hd * 192 + 128 + d0; const float* cs = T64 + ((long)pos * 32 + d0) * 2; float cv[8], sv[8];
#pragma unroll
        for (int j = 0; j < 4; ++j) { const f32x4 q = *reinterpret_cast<const f32x4*>(cs + 4 * j); cv[2 * j] = q[0]; sv[2 * j] = q[1]; cv[2 * j + 1] = q[2]; sv[2 * j + 1] = q[3]; }
        float a[8], bq[8], o1[8], o2[8]; unpack8(*reinterpret_cast<const u32x4*>(base), a); unpack8(*reinterpret_cast<const u32x4*>(base + 32), bq);
#pragma unroll
        for (int j = 0; j < 8; ++j) { o1[j] = a[j] * cv[j] - bq[j] * sv[j]; o2[j] = a[j] * sv[j] + bq[j] * cv[j]; }
        const u32x4 w1 = pack8(o1), w2 = pack8(o2);
        *reinterpret_cast<u32x4*>(base) = w1; *reinterpret_cast<u32x4*>(base + 32) = w2;
        if (t >= TP) { const int ts = t - TP, b = ts >> 6, s = ts & 63; bf16_t* d = QL + ((long)b * 1024 + hd * 64 + s) * QLD + 512 + d0;
            *reinterpret_cast<u32x4*>(d) = w1; *reinterpret_cast<u32x4*>(d + 32) = w2; } }
}

__device__ __forceinline__ void softmax_rows(KParams& p) {
    const int lane = otid() & 63; unsigned char* ws = optr(gp(p.ws)); bf16_t* SP = (bf16_t*)(ws + WS_SP);
    for (int r = gwave(); r < DB * 1024; r += nwaves()) { bf16_t* row = SP + (long)r * KPAD; float v[5][8]; float mx = -3.0e38f;
#pragma unroll
        for (int j = 0; j < 5; ++j) { const int ch = lane + 64 * j;
            if (ch < KALL / 8) { unpack8(*reinterpret_cast<const u32x4*>(row + ch * 8), v[j]);
#pragma unroll
                for (int i = 0; i < 8; ++i) { v[j][i] *= MLA_SCALE; mx = fmaxf(mx, v[j][i]); } }
            else {
#pragma unroll
                for (int i = 0; i < 8; ++i) v[j][i] = -3.0e38f; } }
        mx = wave_max(mx); float sum = 0.f;
#pragma unroll
        for (int j = 0; j < 5; ++j) { const int ch = lane + 64 * j;
#pragma unroll
            for (int i = 0; i < 8; ++i) { v[j][i] = (ch < KALL / 8) ? __expf(v[j][i] - mx) : 0.f; sum += v[j][i]; } }
        sum = wave_sum(sum); const float inv = 1.0f / sum;
#pragma unroll
        for (int j = 0; j < 5; ++j) { const int ch = lane + 64 * j;
            if (ch < KPAD / 8) { float o[8];
#pragma unroll
                for (int i = 0; i < 8; ++i) o[i] = v[j][i] * inv;
                *reinterpret_cast<u32x4*>(row + ch * 8) = pack8(o); } } }
}

__device__ __forceinline__ void gnorm_gate(KParams& p, int w0, int nw) {
    const int lane = otid() & 63; unsigned char* ws = optr(gp(p.ws)); const bf16_t* OB = (const bf16_t*)(ws + WS_OB); const bf16_t* Y = (const bf16_t*)(ws + WS_Y);
    for (int t = w0; t < T; t += nw) { const int c0 = (lane >> 3) * 256 + (lane & 7) * 32; float x[4][8]; float s = 0.f;
#pragma unroll
        for (int i = 0; i < 4; ++i) { unpack8(*reinterpret_cast<const u32x4*>(OB + ((long)lane * T + t) * 32 + 8 * i), x[i]);
#pragma unroll
            for (int j = 0; j < 8; ++j) s += x[i][j]; }
        s += sx<1>(s); s += sx<2>(s); s += sx<4>(s); const float mu = s * (1.0f / 256.f); float q = 0.f;
#pragma unroll
        for (int i = 0; i < 4; ++i)
#pragma unroll
            for (int j = 0; j < 8; ++j) { const float d = x[i][j] - mu; q += d * d; }
        q += sx<1>(q); q += sx<2>(q); q += sx<4>(q); const float rstd = rsqrtf(q * (1.0f / 256.f) + EPS);
        float am = 0.f;
#pragma unroll
        for (int i = 0; i < 4; ++i) { float g[8]; unpack8(*reinterpret_cast<const u32x4*>(Y + (long)t * INWP + C_RG + c0 + 8 * i), g);
#pragma unroll
            for (int j = 0; j < 8; ++j) { x[i][j] = siluf_(g[j]) * (x[i][j] - mu) * rstd; am = fmaxf(am, fabsf(x[i][j])); } }
        am = wave_max(am); const float qs = am > 0.f ? 127.0f / am : 0.f; unsigned w[8];
#pragma unroll
        for (int i = 0; i < 4; ++i)
#pragma unroll
            for (int hh = 0; hh < 2; ++hh) { unsigned v = 0u;
#pragma unroll
                for (int j = 0; j < 4; ++j) v |= ((unsigned)((int)__builtin_rintf(x[i][4 * hh + j] * qs) & 0xff)) << (8 * j);
                w[2 * i + hh] = v; }
        *reinterpret_cast<u32x4*>(ws + WS_BG + (long)t * DM + c0) = (u32x4){w[0], w[1], w[2], w[3]};
        *reinterpret_cast<u32x4*>(ws + WS_BG + (long)t * DM + c0 + 16) = (u32x4){w[4], w[5], w[6], w[7]};
        if (lane == 0) ((float*)(ws + WS_SA8))[t] = am * (1.0f / 127.0f); }
}

__device__ __forceinline__ void peer_convert(KParams& p, int l, int r0, int r1, int w0, int nw) {
    unsigned char* ws = optr(gp(p.ws)); const int lane = otid() & 63;
    const float* su = gp(p.peer_u) + (long)l * NEXP * DM; const float* sv = gp(p.peer_v) + (long)l * NEXP * DM;
    for (int r = r0 + w0; r < r1; r += nw) { const bool second = r >= NEXP; const int row = second ? r - NEXP : r; const float* s = (second ? sv : su) + (long)row * DM;
        f32x4 v[8]; float am = 0.f;
#pragma unroll
        for (int j = 0; j < 8; ++j) { v[j] = *reinterpret_cast<const f32x4*>(s + 512 * (j >> 2) * 2 + 16 * lane + 4 * (j & 3));
            am = fmaxf(am, fmaxf(fmaxf(fabsf(v[j][0]), fabsf(v[j][1])), fmaxf(fabsf(v[j][2]), fabsf(v[j][3])))); }
        am = wave_max(am);
        float sc = 1.0f, isc = 1.0f;
        if (am > 0.f) { const int e = (int)((__float_as_uint(am) >> 23) & 0xffu) - 127;
            int k = 7 - e; k = k > 100 ? 100 : (k < -100 ? -100 : k);
            sc = __uint_as_float((unsigned)(127 + k) << 23); isc = __uint_as_float((unsigned)(127 - k) << 23); }
        unsigned w[8];
#pragma unroll
        for (int j = 0; j < 8; ++j) { int pk = __builtin_amdgcn_cvt_pk_fp8_f32(v[j][0] * sc, v[j][1] * sc, 0, false); pk = __builtin_amdgcn_cvt_pk_fp8_f32(v[j][2] * sc, v[j][3] * sc, pk, true); w[j] = (unsigned)pk; }
        if (!second) {
            unsigned char* dst = ws + WS_PU + ((long)(lane >> 3) * NEXP + row) * 128 + 16 * (lane & 7);
            *reinterpret_cast<u32x4*>(dst) = (u32x4){w[0], w[1], w[2], w[3]};
            *reinterpret_cast<u32x4*>(dst + 8L * NEXP * 128) = (u32x4){w[4], w[5], w[6], w[7]};
        } else {
            unsigned char* dst = ws + WS_PV + ((long)(2 * lane) * NEXP + row) * 8;
            *reinterpret_cast<u32x2*>(dst) = (u32x2){w[0], w[1]}; *reinterpret_cast<u32x2*>(dst + (long)NEXP * 8) = (u32x2){w[2], w[3]};
            *reinterpret_cast<u32x2*>(dst + 128L * NEXP * 8) = (u32x2){w[4], w[5]}; *reinterpret_cast<u32x2*>(dst + 129L * NEXP * 8) = (u32x2){w[6], w[7]}; }
        if (lane == 0) ((float*)(ws + (second ? WS_PSV : WS_PSU)))[row] = isc; }
}

__device__ __forceinline__ void final_norm(KParams& p) {
    const int lane = otid() & 63; float* X = gp(p.out);
    for (int t = gwave(); t < T; t += nwaves()) { float* xr = X + (long)t * DM; f32x4 v[8]; float ss = 0.f;
#pragma unroll
        for (int j = 0; j < 8; ++j) { v[j] = *reinterpret_cast<const f32x4*>(xr + 256 * j + 4 * lane); ss += v[j][0] * v[j][0] + v[j][1] * v[j][1] + v[j][2] * v[j][2] + v[j][3] * v[j][3]; }
        ss = wave_sum(ss); const float rinv = rsqrtf(ss * (1.0f / DM) + EPS);
#pragma unroll
        for (int j = 0; j < 8; ++j) { const int c = 256 * j + 4 * lane; const f32x4 gv = *reinterpret_cast<const f32x4*>(gp(p.g_final) + c); *reinterpret_cast<f32x4*>(xr + c) = v[j] * rinv * gv; } }
}
}
__global__ void __launch_bounds__(512, 2) mega_fwd(Params p_by_value_unused) {
    extern __shared__ __attribute__((aligned(16))) unsigned char shm[];
    LAS unsigned char* lds = (LAS unsigned char*)shm; char* ldsg = (char*)shm;
    if (threadIdx.x < 8) ((LAS unsigned*)(lds + LDS_BARW))[threadIdx.x] = 0u;
    __syncthreads();
    if (threadIdx.x == 0) { unsigned* tk = (unsigned*)(gp(KP.ws) + WS_CTL + CTL_RANK) + 64 * xb_xcc_id(); ((volatile LAS unsigned*)(lds + LDS_BARW))[2] = xb_add(tk, 1u); }
    const XcdBarrier bar = xcd_barrier_post((unsigned*)(gp(KP.ws) + WS_CTL), (volatile LAS unsigned*)(lds + LDS_BARW));
#define GRID_SYNC() xcd_barrier(bar)
#ifndef STOP_AT
#define STOP_AT 0
#endif
#ifdef DBG_DUMP
#define STOPCHK(n) do { if (STOP_AT == (n)) { float* xo = gp(KP.out); const bf16_t* src = (const bf16_t*)(gp(KP.ws) + DBG_DUMP); for (long i = ph::gthread(); i < (long)T * DM; i += ph::nthreads()) xo[i] = bf2f(src[i]); return; } } while (0)
#elif defined(DBG_SANITIZE)
#define STOPCHK(n) do { if (STOP_AT == (n) || (STOP_AT > 100 && l == 1 && STOP_AT - 100 == (n))) { float* xo = gp(KP.out); for (long i = ph::gthread(); i < (long)T * DM; i += ph::nthreads()) { const float v = xo[i]; if (!(v - v == 0.0f)) xo[i] = 7.0f; } return; } } while (0)
#else
#define STOPCHK(n) do { if (STOP_AT == (n) || (STOP_AT > 100 && l == 1 && STOP_AT - 100 == (n))) return; } while (0)
#endif
    using namespace pg8;
#define WSP(off) ((bf16_t*)(optr(gp(KP.ws)) + (off)))
#define H WSP(WS_H)
#define Y WSP(WS_Y)
#define CQN WSP(WS_CQN)
#define CKVNP WSP(WS_CKVNP)
#define KRP WSP(WS_KRP)
#define Q WSP(WS_Q)
#define YA WSP(WS_YA)
#define KV WSP(WS_KV)
#define SP WSP(WS_SP)
#define MIX WSP(WS_MIX)
#define OA WSP(WS_OA)
#define QP WSP(WS_QP)
#define CKA WSP(WS_CKA)
#define CKT WSP(WS_CKT)
#define QL WSP(WS_QL)
#define OL WSP(WS_OL)
#define BG WSP(WS_BG)
    int l = 0;
    ph::prologue(KP, ldsg);
#ifdef DUP_PRO
    ph::prologue(KP, ldsg);
#endif
    GRID_SYNC(); STOPCHK(1);
    if (threadIdx.x == 0) { unsigned* barw = (unsigned*)(gp(KP.ws) + WS_CTL); const unsigned me = xb_xcc_id(); unsigned nx = 0, xi = 0, nloc = 1;
        for (unsigned j = 0; j < 16; ++j) { const unsigned cn = xb_ld(&barw[XB_XCNT(j)]); if (cn) { if (j < me) ++xi; ++nx; } if (j == me) nloc = cn ? cn : 1u; }
        volatile LAS unsigned* iw = (volatile LAS unsigned*)(lds + LDS_BARW); iw[3] = xi; iw[4] = nx; iw[5] = nloc; }
    __syncthreads();
    ph::ada_reduce(KP);
    ph::wpq_int8(KP);
    GRID_SYNC(); STOPCHK(2);
    for (l = 0; l < DEPTH; ++l) {
#define WIN (WSP(WS_WIN) + (long)l * INWP * DM)
#define WUQ (WSP(WS_WUQ) + (long)l * 3072 * 512)
#define WUKV (WSP(WS_WUKV) + (long)l * 4096 * 512)
#define WUK (WSP(WS_WUK) + (long)l * 16 * 512 * 256)
#define WA (WSP(WS_WA) + (long)l * DM * DM)
#define WB (WSP(WS_WB) + (long)l * DM * DM)
#define WO (WSP(WS_WO) + (long)l * DM * DM)
#define WPQ (WSP(WS_WPQ) + (long)l * DM * DM)
#define ADA ((const float*)(optr(gp(KP.ws)) + WS_ADA) + (long)l * NCOND * 12288)
        ph::modulate(KP, l, 0);
        ph::win_int8(KP, l);
        ph::wb_int8(KP, l);
        ph::cache_convert(KP, l, ldsg, l == 0 ? 0 : 4096, 8192, obid(), ogrid());
        GRID_SYNC(); STOPCHK(3);
        { Sched<0> S; S.init(T / 256, 18, (T / 256) * 18, DM, DM); S.remap(5, 0, 3, 0); gemm_phase(lds, Gemm{H, WIN, DM, DM, DM}, S, EpiBf16{Y, INWP, 0}); }
        { Sched<0> S; S.init(T / 256, NB8, (T / 256) * NB8, DM / 2, DM / 2); S.remap(3, 5, 18, 1);
          { const int G_ = ogrid(); S.rotate((((((T / 256) * NB8) % G_) + 7) & ~7) % G_); }
          unsigned char* ws8 = optr(gp(KP.ws));
          gemm_phase<EpiQ8, Sched<0>, true>(lds, Gemm{(const bf16_t*)(ws8 + WS_H8), (const bf16_t*)(ws8 + WS_WIN8), DM / 2, DM / 2, DM / 2}, S, EpiQ8{Y, INWP, (const float*)(ws8 + WS_SA8), (const float*)(ws8 + WS_SBW)}); }
#ifdef DUP_WIN
        { Sched<0> S; S.init(T / 256, INWP / 256, (T / 256) * (INWP / 256), DM, DM); gemm_phase(lds, Gemm{H, WIN, DM, DM, DM}, S, EpiBf16{Y, INWP, 0}); }
#endif
        GRID_SYNC(); STOPCHK(4);
        ph::post_win(KP, l);
        GRID_SYNC(); STOPCHK(5);
        { Sched<0> S; S.init(T / 256, 3072 / 256, (T / 256) * 12, 512, 512); gemm_phase(lds, Gemm{CQN, WUQ, 512, 512, 512}, S, EpiQ{Q, QL, (const float*)(optr(gp(KP.ws)) + WS_TAB64)}); }
        { Sched<0> S; S.init(TP / 256, 4096 / 256, (TP / 256) * 16, 512, 512); gemm_phase(lds, Gemm{CKVNP, WUKV, 512, 512, 512}, S, EpiBf16{KV, 4096, 0}); }
        GRID_SYNC(); STOPCHK(6);
#ifndef DUP_ATTN
#define DUP_ATTN 1
#endif
#ifndef DUP_RET
#define DUP_RET 1
#endif
#ifndef DUP_GATHER
#define DUP_GATHER 0
#endif
#pragma unroll 1
        for (int rep_ = 0; rep_ < DUP_ATTN; ++rep_)
        { for (int u = obid(); u < 512; u += ogrid()) { const int c = u & 255, i = u >> 8, xcd = c & 7, slot = c >> 3; const int bh = xcd * 4 + (slot >> 3) + 32 * i, pr = slot & 7, b = bh >> 4, h = bh & 15;
#pragma unroll 1
              for (int z = 0; z < 2; ++z) { const int qb = z ? 15 - pr : pr; const long tok0 = (long)b * SEQ + 256 * qb;
                  att::attn_block(Q + tok0 * 3072 + h * 192, KV + (long)b * SEQ * 4096 + h * 256, KRP + (long)b * SEQ * 64, KV + (long)b * SEQ * 4096 + h * 256 + 128, OA + tok0 * DM + h * 128, qb, ldsg); } } }
        { Sched<1> S; S.init(0, 0, 256, 3072, 256); gemm_phase(lds, Gemm{Q, WUK, 256, 3072, 256}, S, EpiRowMap<1>{QL, nullptr}); }
        GRID_SYNC(); STOPCHK(8);
        { Sched<2> S; S.init(0, 0, DB * 36, QLD, QLD); gemm_phase(lds, Gemm{QL, CKA, QLD, QLD, QLD}, S, EpiExp{SP, (float*)(optr(gp(KP.ws)) + WS_CTL + CTL_RSUM) + (long)l * 32768}); }
        GRID_SYNC(); STOPCHK(9);
        { Sched<3> S; S.init(0, 0, 256, KPAD, KPAD); gemm_phase(lds, Gemm{SP, CKT, 2176, KPAD, KPAD}, S, EpiRowMap<3>{OL, (const float*)(optr(gp(KP.ws)) + WS_CTL + CTL_RSUM) + (long)l * 32768}); }
        GRID_SYNC(); STOPCHK(11);
        { Sched<4> S; S.init(0, 0, 128, 512, 512); gemm_phase(lds, Gemm{OL, WUKV, 512, 512, 512}, S, EpiOV{OA}); }
#pragma unroll 1
        for (int rep_ = 0; rep_ < DUP_RET; ++rep_)
        for (int u = obid(); u < 256 + DB * 64; u += ogrid()) ret::unit(KP, l, u, ldsg);
#ifdef DUP_RETP
        for (int u = obid(); u < 256; u += ogrid()) ret::unit(KP, l, u, ldsg);
#endif
        GRID_SYNC(); STOPCHK(12);
        { Sched<0> S; S.init(T / 256, DM / 256, (T / 256) * 8, DM, DM); gemm_phase(lds, Gemm{OA, WA, DM, DM, DM}, S, EpiBf16{YA, DM, 0}); }
        { const int G_ = ogrid(), rem_ = ((T / 256) * 8) % G_; const int b_ = obid();
          if (rem_ == 0) ph::gnorm_gate(KP, ph::gwave(), ph::nwaves());
          else if (b_ >= rem_) ph::gnorm_gate(KP, (b_ - rem_) * 8 + (otid() >> 6), (G_ - rem_) * 8); }
#ifdef DUP_WA
#pragma unroll 1
        for (int rep_ = 0; rep_ < DUP_WA; ++rep_)
        { Sched<0> S; S.init(T / 256, DM / 256, (T / 256) * 8, DM, DM); gemm_phase(lds, Gemm{OA, WA, DM, DM, DM}, S, EpiBf16{YA, DM, 0}); }
#endif
        GRID_SYNC(); STOPCHK(14);
        { Sched<0> S; S.init(T / 256, DM / 256, (T / 256) * 8, DM / 2, DM / 2); unsigned char* ws8 = optr(gp(KP.ws));
          gemm_phase<EpiMix, Sched<0>, true>(lds, Gemm{(const bf16_t*)(ws8 + WS_BG), (const bf16_t*)(ws8 + WS_WB8), DM / 2, DM / 2, DM / 2}, S, EpiMix{Y, YA, MIX, (const float*)(ws8 + WS_SA8), (const float*)(ws8 + WS_SBB)}); }
        { const int G_ = ogrid(), rem_ = ((T / 256) * 8) % G_; const int b_ = obid();
          if (rem_ == 0) ph::peer_convert(KP, l, 0, NEXP, ph::gwave(), ph::nwaves());
          else if (b_ >= rem_) ph::peer_convert(KP, l, 0, NEXP, (b_ - rem_) * 8 + (otid() >> 6), (G_ - rem_) * 8); }
        GRID_SYNC(); STOPCHK(15);
        { Sched<0> S; S.init(T / 256, DM / 256, (T / 256) * 8, DM, DM); gemm_phase(lds, Gemm{MIX, WO, DM, DM, DM}, S, EpiRes{gp(KP.out), ADA + 2 * DM, l == 0 ? gp(KP.x_prompt) : gp(KP.out), l == 0 ? gp(KP.x_sample) : gp(KP.out) + (long)TP * DM}); }
        { const int G_ = ogrid(), rem_ = ((T / 256) * 8) % G_; const int b_ = obid();
          if (rem_ == 0) ph::peer_convert(KP, l, NEXP, 2 * NEXP, ph::gwave(), ph::nwaves());
          else if (b_ >= rem_) ph::peer_convert(KP, l, NEXP, 2 * NEXP, (b_ - rem_) * 8 + (otid() >> 6), (G_ - rem_) * 8); }
        GRID_SYNC(); STOPCHK(16);
        ph::modulate(KP, l, 1);
        GRID_SYNC(); STOPCHK(17);
        { Sched<0> S; S.init(T / 256, DM / 256, (T / 256) * 8, DM / 2, DM / 2);
          unsigned char* ws8 = optr(gp(KP.ws));
          gemm_phase<EpiQ8, Sched<0>, true>(lds, Gemm{(const bf16_t*)(ws8 + WS_H8), (const bf16_t*)(ws8 + WS_WPQ8 + (long)l * DM * DM), DM / 2, DM / 2, DM / 2}, S, EpiQ8{QP, DM, (const float*)(ws8 + WS_SA8), (const float*)(ws8 + WS_SB8) + (long)l * DM});
#ifdef DUP_WPQ
          gemm_phase<EpiQ8, Sched<0>, true>(lds, Gemm{(const bf16_t*)(ws8 + WS_H8), (const bf16_t*)(ws8 + WS_WPQ8 + (long)l * DM * DM), DM / 2, DM / 2, DM / 2}, S, EpiQ8{QP, DM, (const float*)(ws8 + WS_SA8), (const float*)(ws8 + WS_SB8) + (long)l * DM});
#endif
        }
        if (l + 1 < DEPTH) { const int G_ = ogrid(), rem_ = ((T / 256) * 8) % G_; const int b_ = obid();
          if (rem_ == 0) ph::cache_convert(KP, l + 1, ldsg, 0, 4096, b_, G_);
          else if (b_ >= rem_) ph::cache_convert(KP, l + 1, ldsg, 0, 4096, b_ - rem_, G_ - rem_); }
        GRID_SYNC(); STOPCHK(18);
        { const int tid_ = otid(); const int lane = tid_ & 63; float* strip = (float*)ldsg + tid_ * 33; unsigned char* ws = optr(gp(KP.ws));
          const bf16_t* k1g = (const bf16_t*)(ws + WS_PK1) + (long)l * 128 * 128; const bf16_t* k2g = (const bf16_t*)(ws + WS_PK2) + (long)l * 128 * 128;
          bf16_t* k1 = (bf16_t*)(ldsg + 512 * 33 * 4 + 64); bf16_t* k2 = k1 + 128 * peer::KPITCH;
          for (int i = tid_; i < 2 * 128 * 16; i += 512) { const int which = i >> 11, r = (i >> 4) & 127, ch = i & 15;
              *reinterpret_cast<u32x4*>((which ? k2 : k1) + r * peer::KPITCH + ch * 8) = *reinterpret_cast<const u32x4*>((which ? k2g : k1g) + r * 128 + ch * 8); }
          __syncthreads();
          for (int wu = ph::gwave(); wu < (T / 32) * PH; wu += ph::nwaves()) peer::select_unit(QP, k1, k2, (int*)(ws + WS_PIDX), (float*)(ws + WS_PW), (wu >> 3) * 32, wu & 7, lane, strip);
#ifdef DUP_SEL
          for (int wu = ph::gwave(); wu < (T / 32) * PH; wu += ph::nwaves()) peer::select_unit(QP, k1, k2, (int*)(ws + WS_PIDX), (float*)(ws + WS_PW), (wu >> 3) * 32, wu & 7, lane, strip);
#endif
        }
        GRID_SYNC(); STOPCHK(19);
        { const int tid_ = otid(); const int lane = tid_ & 63, wid = tid_ >> 6; unsigned char* ws = optr(gp(KP.ws));
          volatile LAS unsigned* iw = (volatile LAS unsigned*)(lds + LDS_BARW); peer::XInfo xin; xin.rank = __builtin_amdgcn_readfirstlane((int)iw[2]); xin.xi = __builtin_amdgcn_readfirstlane((int)iw[3]); xin.nx = __builtin_amdgcn_readfirstlane((int)iw[4]); xin.nloc = __builtin_amdgcn_readfirstlane((int)iw[5]);
          if (xin.nx >= 1 && xin.nx <= 8) {
              peer::upass(H, (const unsigned char*)(ws + WS_PU), (const int*)(ws + WS_PIDX), (const float*)(ws + WS_PW), (const float*)(ws + WS_PSU), (const float*)(ws + WS_PSV), (float*)(ws + WS_DOTP), (unsigned*)(ws + WS_ACT), xin, wid, lane);
              GRID_SYNC();
              int vs0_, vsn_, vse_;
              if ((256 % xin.nx) == 0) { const int spx = 256 / xin.nx; vs0_ = xin.xi * spx + xin.rank; vsn_ = xin.nloc; vse_ = (xin.xi + 1) * spx; }
              else { vs0_ = obid(); vsn_ = ogrid(); vse_ = 256; }
              peer::vpass_lds((const unsigned char*)(ws + WS_PV), (const unsigned*)(ws + WS_ACT), gp(KP.out), ADA + 5 * DM, ldsg, vs0_, vsn_, vse_, tid_);
#ifdef DUP_VP
              peer::vpass_lds((const unsigned char*)(ws + WS_PV), (const unsigned*)(ws + WS_ACT), (float*)(ws + WS_OB), ADA + 5 * DM, ldsg, vs0_, vsn_, vse_, tid_);
#endif
          } else {
              for (int t = ph::gwave(); t < T; t += ph::nwaves()) peer::gather_token(H, (const unsigned char*)(ws + WS_PU), (const unsigned char*)(ws + WS_PV), (const float*)(ws + WS_PSU), (const float*)(ws + WS_PSV), (const int*)(ws + WS_PIDX), (const float*)(ws + WS_PW), gp(KP.out), ADA + 5 * DM, t, lane);
          } }
        GRID_SYNC(); STOPCHK(20);
    }
    ph::final_norm(KP);
}

extern "C" void kernel_launch(void* const* d_in, const int* in_sizes, int n_in, void* d_out, int out_size, void* d_ws, size_t ws_size, hipStream_t stream) {
    static int grid = 0;
    if (grid == 0) {
        if (n_in != 25 || out_size != (int)O_END || ws_size < WS_END) { fprintf(stderr, "kernel_launch: shape mismatch: n_in %d out %d (want %ld) ws %zu (want >= %zu)\n", n_in, out_size, O_END, ws_size, (size_t)WS_END); grid = -1; return; }
        int dev = 0, cus = 0, per_cu = 0;
        if (hipGetDevice(&dev) != hipSuccess || hipDeviceGetAttribute(&cus, hipDeviceAttributeMultiprocessorCount, dev) != hipSuccess) { fprintf(stderr, "kernel_launch: device query failed\n"); grid = -1; return; }
        if (hipFuncSetAttribute((const void*)mega_fwd, hipFuncAttributeMaxDynamicSharedMemorySize, LDS_BYTES) != hipSuccess) { fprintf(stderr, "kernel_launch: hipFuncSetAttribute failed\n"); grid = -1; return; }
        if (hipOccupancyMaxActiveBlocksPerMultiprocessor(&per_cu, (const void*)mega_fwd, 512, LDS_BYTES) != hipSuccess || per_cu < 1) { fprintf(stderr, "kernel_launch: occupancy query says %d blocks per CU\n", per_cu); grid = -1; return; }
        grid = cus;
#ifdef FORCE_GRID
        grid = FORCE_GRID;
#endif
    }
    if (grid < 0) return;
    (void)hipMemsetAsync((char*)d_ws + WS_CTL, 0, CTL_BYTES, stream);
    Params p{};
    const float* const* in = (const float* const*)d_in;
    p.x_prompt = in[0]; p.x_sample = in[1]; p.c_prompt = in[2]; p.c_sample = in[3]; p.cache_ckv = in[4]; p.cache_krope = in[5]; p.state_ret = in[6]; p.w_ada = in[7]; p.b_ada = in[8];
    p.g_mix = in[9]; p.g_ffn = in[10]; p.w_in = in[11]; p.g_q = in[12]; p.w_uq = in[13]; p.g_kv = in[14]; p.w_ukv = in[15]; p.w_a = in[16]; p.w_b = in[17]; p.w_o = in[18]; p.w_pq = in[19];
    p.peer_k1 = in[20]; p.peer_k2 = in[21]; p.peer_u = in[22]; p.peer_v = in[23]; p.g_final = in[24];
    p.out = (float*)d_out; p.ws = (unsigned char*)d_ws;
    for (int h = 0; h < 8; ++h) p.lg[h] = (float)log1p(-pow(2.0, -5.0 - (double)h));
    p.grid = grid; p.pad_ = 0;
    hipLaunchKernelGGL(mega_fwd, dim3(grid), dim3(512), LDS_BYTES, stream, p);
    const hipError_t le = hipGetLastError();
    if (le != hipSuccess) fprintf(stderr, "kernel_launch: launch failed: %s\n", hipGetErrorName(le));
}
```

```cpp
#include <hip/hip_runtime.h>
#include <cstdio>
#include <cstdint>
#include <cmath>

#define LAS __attribute__((address_space(3)))
typedef unsigned short bf16_t;
typedef short bf16x8 __attribute__((ext_vector_type(8)));
typedef float f32x4 __attribute__((ext_vector_type(4)));
typedef float f32x2 __attribute__((ext_vector_type(2)));
typedef float f32x16 __attribute__((ext_vector_type(16)));
typedef unsigned u32x4 __attribute__((ext_vector_type(4)));
typedef unsigned u32x2 __attribute__((ext_vector_type(2)));
typedef short s16x4 __attribute__((ext_vector_type(4)));
typedef int i32x4 __attribute__((ext_vector_type(4)));

constexpr int DM = 2048, NB = 4, SEQ = 4096, DEPTH = 2, DB = 32, DS = 64, PAST = 2048;
constexpr int TP = NB * SEQ, TS = DB * DS, T = TP + TS;
constexpr int NCOND = NB + DB;
constexpr int QLORA = 512, KVLORA = 512, ROPE = 64, NOPE = 128, VD = 128, MH = 16, QKD = 192;
constexpr int RH = 8, RQK = 128, RV = 256;
constexpr int PH = 8, NKEYS = 128, NEXP = 16384, PTOPK = 16;
constexpr int INW = 11328, INWP = 11520;
constexpr int C_CQ = 0, C_CKV = 512, C_KR = 1024, C_RQ = 1088, C_RK = 2112, C_RV = 3136, C_RG = 5184, C_GA = 7232, C_GB = 9280;
constexpr int KALL = PAST + DS;
constexpr int KPAD = 2304;
constexpr int QLD = 640;
constexpr float EPS = 1e-6f;
constexpr float MLA_SCALE = 0.07216878364870322f;

constexpr long O_Y = 0;
constexpr long O_CKVP = (long)T * DM;
constexpr long O_KRP = O_CKVP + 2L * TP * 512;
constexpr long O_RETP = O_KRP + 2L * TP * 64;
constexpr long O_CKVS = O_RETP + 2L * NB * RH * RQK * RV;
constexpr long O_KRS = O_CKVS + 2L * TS * 512;
constexpr long O_RETS = O_KRS + 2L * TS * 64;
constexpr long O_END = O_RETS + 2L * DB * RH * RQK * RV;

constexpr size_t al256(size_t x) { return (x + 255) / 256 * 256; }
constexpr size_t WS_CTL = 0;
constexpr size_t CTL_BYTES = 65536 + 2UL * 32768 * 4;
constexpr size_t CTL_RSUM = 65536;
constexpr size_t WS_TAB64 = WS_CTL + CTL_BYTES;
constexpr size_t WS_TAB128 = WS_TAB64 + 4096UL * 32 * 2 * 4;
constexpr size_t WS_ADA = WS_TAB128 + 4096UL * 64 * 2 * 4;
constexpr size_t WS_ADAP = WS_ADA + 2UL * NCOND * 12288 * 4;
constexpr size_t WS_WIN = WS_ADAP + 8UL * 2 * NCOND * 12288 * 4;
constexpr size_t WS_WUQ = WS_WIN + 2UL * INWP * DM * 2;
constexpr size_t WS_WUKV = WS_WUQ + 2UL * 3072 * 512 * 2;
constexpr size_t WS_WUK = WS_WUKV + 2UL * 4096 * 512 * 2;
constexpr size_t WS_WA = WS_WUK + 2UL * 16 * 512 * 256 * 2;
constexpr size_t WS_WB = WS_WA + 2UL * DM * DM * 2;
constexpr size_t WS_WO = WS_WB + 2UL * DM * DM * 2;
constexpr size_t WS_WPQ = WS_WO + 2UL * DM * DM * 2;
constexpr size_t WS_PK1 = WS_WPQ + 2UL * DM * DM * 2;
constexpr size_t WS_PK2 = WS_PK1 + 2UL * 128 * 128 * 2;
constexpr size_t WS_H = WS_PK2 + 2UL * 128 * 128 * 2;
constexpr size_t WS_Y = WS_H + (size_t)T * DM * 2;
constexpr size_t WS_CQN = WS_Y + (size_t)T * INWP * 2;
constexpr size_t WS_CKVNP = WS_CQN + (size_t)T * 512 * 2;
constexpr size_t WS_KRP = WS_CKVNP + (size_t)TP * 512 * 2;
constexpr size_t WS_Q = WS_KRP + (size_t)TP * 64 * 2;
constexpr size_t WS_YA = WS_Q;
constexpr size_t WS_KV = WS_Q + (size_t)T * 3072 * 2 + 4096;
constexpr size_t WS_SP = WS_KV;
constexpr size_t WS_MIX = WS_KV;
constexpr size_t WS_OA = WS_KV + 32UL * 1024 * KPAD * 2;
constexpr size_t WS_QP = WS_OA;
constexpr size_t WS_CKA = WS_OA + (size_t)T * DM * 2;
constexpr size_t WS_CKT = WS_CKA + 32UL * KPAD * QLD * 2;
constexpr size_t WS_QL = WS_CKT + 32UL * 512 * KPAD * 2;
constexpr size_t WS_OL = WS_QL + 32UL * 1024 * QLD * 2;
constexpr size_t WS_OB = WS_OL + 16UL * 2048 * 512 * 2;
constexpr size_t WS_BG = WS_OB + (size_t)T * DM * 2;
constexpr size_t WS_PIDX = WS_BG + (size_t)T * DM * 2;
constexpr size_t WS_PW = WS_PIDX + (size_t)T * 128 * 4;
constexpr size_t WS_PU = WS_PW + (size_t)T * 128 * 4;
constexpr size_t WS_PV = WS_PU + (size_t)NEXP * DM;
constexpr size_t WS_PSU = WS_PV + (size_t)NEXP * DM;
constexpr size_t WS_PSV = WS_PSU + (size_t)NEXP * 4;
constexpr size_t WS_WPQ8 = WS_PSV + (size_t)NEXP * 4;
constexpr size_t WS_SB8 = WS_WPQ8 + 2UL * DM * DM;
constexpr size_t WS_SA8 = WS_SB8 + 2UL * DM * 4;
constexpr int NB8 = 29;
constexpr size_t WS_WIN8 = WS_BG + (size_t)T * DM;
constexpr size_t WS_WB8 = WS_WIN8 + (size_t)NB8 * 256 * DM;
static_assert(WS_WB8 + (size_t)DM * DM <= WS_BG + (size_t)T * DM * 2, "int8 weights overflow the BG region");
constexpr size_t WS_SBW = WS_SA8 + al256((size_t)T * 4);
constexpr size_t WS_SBB = WS_SBW + al256((size_t)INWP * 4);
constexpr size_t WS_END = WS_SBB + (size_t)DM * 4;
constexpr size_t WS_H8 = WS_OB;
static_assert((size_t)TP * 4096 * 2 <= 32UL * 1024 * KPAD * 2, "KV fits in the SP region");
static_assert(WS_END <= 1608000000UL, "workspace map too large");
static_assert(WS_WIN % 256 == 0 && WS_H % 256 == 0 && WS_Y % 256 == 0 && WS_Q % 256 == 0 && WS_KV % 256 == 0 && WS_CKA % 256 == 0, "alignment");

constexpr int LDS_BYTES = 147456;
constexpr int LDS_BARW = LDS_BYTES - 32;
constexpr size_t CTL_RANK = 16384;
constexpr size_t WS_DOTP = WS_Q;
constexpr size_t WS_ACT = WS_DOTP + 8UL * T * 128 * 4;
constexpr size_t WS_PIDXT = WS_ACT + (size_t)T * 128 * 4;
static_assert(WS_PIDXT + (size_t)T * 128 * 4 <= WS_KV, "PEER scratch fits in the Q region");

struct Params {
    const float *x_prompt, *x_sample, *c_prompt, *c_sample, *cache_ckv, *cache_krope, *state_ret, *w_ada, *b_ada, *g_mix, *g_ffn, *w_in, *g_q, *w_uq, *g_kv, *w_ukv,
                *w_a, *w_b, *w_o, *w_pq, *peer_k1, *peer_k2, *peer_u, *peer_v, *g_final;
    float* out; unsigned char* ws;
    float lg[8];
    int grid; int pad_;
};

typedef const __attribute__((address_space(4))) Params KParams;
__device__ __forceinline__ KParams* okarg() {
    const uintptr_t k = (uintptr_t)__builtin_amdgcn_kernarg_segment_ptr();
    unsigned lo = (unsigned)k, hi = (unsigned)(k >> 32);
    asm volatile("" : "+s"(lo), "+s"(hi)); return (KParams*)(((uintptr_t)hi << 32) | lo); }
#define KP (*okarg())
__device__ __forceinline__ int ogrid() { return KP.grid; }
__device__ __forceinline__ int obid() { int b = (int)blockIdx.x; asm volatile("" : "+s"(b) :: "memory"); return b; }
__device__ __forceinline__ int otid() { int t = (int)threadIdx.x; asm volatile("" : "+v"(t) :: "memory"); return t; }
template <class P> __device__ __forceinline__ P* gp(P* p) { return (P*)(__attribute__((address_space(1))) P*)(uintptr_t)p; }
template <class P> __device__ __forceinline__ P* optr(P* p) {
    unsigned lo = __builtin_amdgcn_readfirstlane((unsigned)(uintptr_t)p), hi = __builtin_amdgcn_readfirstlane((unsigned)((uintptr_t)p >> 32));
    asm volatile("" : "+s"(lo), "+s"(hi)); return gp((P*)(((uintptr_t)hi << 32) | lo)); }
typedef __bf16 bf16v2_t __attribute__((ext_vector_type(2)));
__device__ __forceinline__ unsigned cvt_pk_bf16(float lo, float hi) { f32x2 v = {lo, hi}; bf16v2_t r = __builtin_convertvector(v, bf16v2_t); return __builtin_bit_cast(unsigned, r); }
__device__ __forceinline__ bf16_t f2bf(float f) { return (bf16_t)(cvt_pk_bf16(f, 0.f) & 0xffffu); }
__device__ __forceinline__ float bf2f(bf16_t b) { return __uint_as_float(((unsigned)b) << 16); }
__device__ __forceinline__ float bflo(unsigned w) { return __uint_as_float(w << 16); }
__device__ __forceinline__ float bfhi(unsigned w) { return __uint_as_float(w & 0xffff0000u); }
__device__ __forceinline__ void unpack8(const u32x4 w, float (&f)[8]) { f[0] = bflo(w.x); f[1] = bfhi(w.x); f[2] = bflo(w.y); f[3] = bfhi(w.y); f[4] = bflo(w.z); f[5] = bfhi(w.z); f[6] = bflo(w.w); f[7] = bfhi(w.w); }
__device__ __forceinline__ u32x4 pack8(const float (&f)[8]) { u32x4 w; w.x = cvt_pk_bf16(f[0], f[1]); w.y = cvt_pk_bf16(f[2], f[3]); w.z = cvt_pk_bf16(f[4], f[5]); w.w = cvt_pk_bf16(f[6], f[7]); return w; }
template <int K> __device__ __forceinline__ float sx(float v) {
    if constexpr (K == 32) { const auto rr = __builtin_amdgcn_permlane32_swap(__float_as_uint(v), __float_as_uint(v), false, false); return __uint_as_float((otid() & 32) ? rr[0] : rr[1]); }
    else return __int_as_float(__builtin_amdgcn_ds_swizzle(__float_as_int(v), (K << 10) | 0x1F));
}
__device__ __forceinline__ float wave_sum(float v) { v += sx<32>(v); v += sx<16>(v); v += sx<8>(v); v += sx<4>(v); v += sx<2>(v); v += sx<1>(v); return v; }
__device__ __forceinline__ float wave_max(float v) { v = fmaxf(v, sx<32>(v)); v = fmaxf(v, sx<16>(v)); v = fmaxf(v, sx<8>(v)); v = fmaxf(v, sx<4>(v)); v = fmaxf(v, sx<2>(v)); v = fmaxf(v, sx<1>(v)); return v; }
__device__ __forceinline__ float sigmoidf_(float x) { return 1.0f / (1.0f + __expf(-x)); }
__device__ __forceinline__ float siluf_(float x) { return x / (1.0f + __expf(-x)); }
__device__ __forceinline__ int cond_row(int t) { return t < TP ? (t >> 12) : NB + ((t - TP) >> 6); }
__device__ __forceinline__ int tok_pos(int t) { return t < TP ? (t & 4095) : PAST + ((t - TP) & 63); }

#define XB_TMO      128
#define XB_XCNT(j)  (256  + 64 * (j))
#define XB_XSUB(j)  (1280 + 64 * (j))
#define XB_XGEN(j)  (2304 + 64 * (j))
#define XB_TOP      3328
#define XB_TOPGEN   3392
#define XCD_BAR_WORDS 3456
#define XB_SPIN_CAP (1u << 22)
__device__ __forceinline__ unsigned xb_ld(unsigned* p)              { return __hip_atomic_load(p, __ATOMIC_RELAXED, __HIP_MEMORY_SCOPE_AGENT); }
__device__ __forceinline__ unsigned xb_add(unsigned* p, unsigned v) { return __hip_atomic_fetch_add(p, v, __ATOMIC_RELAXED, __HIP_MEMORY_SCOPE_AGENT); }
__device__ __forceinline__ unsigned xb_xcc_id() { return (unsigned)__builtin_amdgcn_s_getreg((3 << 11) | 20) & 0xFu; }
#define XB_SPIN(cond, bar) do { unsigned _sp = 0; while (cond) { __builtin_amdgcn_s_sleep(1); \
    if ((++_sp & 255u) == 0u) { if (xb_ld(&(bar)[XB_TMO])) break; if (_sp > XB_SPIN_CAP) { atomicAdd(&(bar)[XB_TMO], 1u); break; } } } } while (0)
struct XcdBarrier { unsigned* bar; unsigned x; volatile LAS unsigned* st; };
__device__ __forceinline__ XcdBarrier xcd_barrier_post(unsigned* bar, volatile LAS unsigned* st) {
    XcdBarrier b; b.bar = bar; b.x = xb_xcc_id(); b.st = st;
    if (threadIdx.x == 0) (void)xb_add(&bar[XB_XCNT(b.x)], 1u);
    return b;
}
__device__ __forceinline__ void xcd_barrier_complete(unsigned* bar, unsigned x, unsigned& nloc, unsigned& nx) {
    const unsigned G = (unsigned)KP.grid;
    unsigned sum, cnt, mine, sp = 0u;
    for (;;) {
        sum = 0u; cnt = 0u; mine = 0u;
#pragma unroll
        for (unsigned j = 0; j < 16; ++j) { const unsigned c = xb_ld(&bar[XB_XCNT(j)]); sum += c; cnt += (c > 0u) ? 1u : 0u; mine = (j == x) ? c : mine; }
        if (sum == G) break;
        __builtin_amdgcn_s_sleep(1);
        if ((++sp & 255u) == 0u) { if (xb_ld(&bar[XB_TMO])) break; if (sp > XB_SPIN_CAP) { atomicAdd(&bar[XB_TMO], 1u); break; } }
    }
    nloc = mine > 0u ? mine : 1u; nx = cnt > 0u ? cnt : 1u;
}
__device__ __forceinline__ void xcd_barrier(const XcdBarrier& b) {
    asm volatile("s_waitcnt vmcnt(0)" ::: "memory");
    __syncthreads();
    if (otid() == 0) {
        unsigned* bar = (unsigned*)(gp(KP.ws) + WS_CTL);
        unsigned bx = xb_xcc_id(); asm volatile("" : "+s"(bx));
        __builtin_amdgcn_s_waitcnt(0);
        unsigned nloc = b.st[0], nx = b.st[1];
        if (nloc == 0u) { xcd_barrier_complete(bar, bx, nloc, nx); b.st[0] = nloc; b.st[1] = nx; }
        const unsigned old = xb_add(&bar[XB_XSUB(bx)], 1u);
        const unsigned gen = old / nloc;
        if (old + 1u == (gen + 1u) * nloc) {
            __builtin_amdgcn_fence(__ATOMIC_RELEASE, "agent");
            asm volatile("s_waitcnt vmcnt(0)" ::: "memory");
            const unsigned og = xb_add(&bar[XB_TOP], 1u);
            const unsigned tg = og / nx;
            if (og + 1u == (tg + 1u) * nx) xb_add(&bar[XB_TOPGEN], 1u);
            else XB_SPIN(xb_ld(&bar[XB_TOPGEN]) == tg, bar);
            __builtin_amdgcn_fence(__ATOMIC_ACQUIRE, "agent");
            xb_add(&bar[XB_XGEN(bx)], 1u);
            asm volatile("s_waitcnt vmcnt(0)" ::: "memory");
        } else {
            XB_SPIN(xb_ld(&bar[XB_XGEN(bx)]) == gen, bar);
            __builtin_amdgcn_fence(__ATOMIC_ACQUIRE, "agent");
            asm volatile("s_waitcnt vmcnt(0)" ::: "memory");
        }
    }
    __syncthreads();
}
namespace pg8 {
constexpr int BM = 256, BK = 64, HALF = 128, HTB = HALF * BK * 2, STAGE_BYTES = 8 * HTB, NXCD = 8, WGM = 8;
__host__ __device__ __forceinline__ int lds_byte(int r, int c) { const int st = (r >> 4) * 2 + (c >> 5), rr = r & 15, cc = c & 31, ob = rr * 64 + cc * 2; return st * 1024 + (ob ^ (((ob >> 9) & 1) << 5)); }
__host__ __device__ __forceinline__ void stage_rc(int b, int& R, int& C) { const int st = b / 1024, sb = b % 1024, swz = sb ^ (((sb >> 9) & 1) << 5); R = (st >> 1) * 16 + swz / 64; C = (st & 1) * 32 + (swz % 64) / 2; }
__host__ __device__ __forceinline__ int perm32(int rho) { const int n = rho >> 4, i = rho & 15; return 8 * (i >> 2) + 4 * n + (i & 3); }

struct Unit { int pm, pn; long aoff, boff; int x0, x1; };
struct Gemm { const bf16_t* A; const bf16_t* Bt; int K; int lda, ldb; };

template <int MODE> struct Sched {
    int nM, nN, nwg, G, c; long lda, ldb;
    __device__ void init(int nM_, int nN_, int nwg_, long lda_, long ldb_) { nM = nM_; nN = nN_; nwg = nwg_; G = ogrid(); c = obid(); lda = lda_; ldb = ldb_; }
    __device__ void rotate(int r) { c = (c + r) % G; }
    __device__ bool next(int i, Unit& u) const {
        const long L = (long)i * G + c; if (L >= nwg) return false;
        int wgid = (int)L;
        if (MODE == 0 || MODE == 5 || MODE == 6) {
            { const int q = nwg / NXCD, r = nwg % NXCD, xcd = wgid % NXCD, off = wgid / NXCD; wgid = (xcd < r ? xcd * (q + 1) : r * (q + 1) + (xcd - r) * q) + off; }
            const int nig = WGM * nN, gid = wgid / nig, fm = gid * WGM, gsz = (nM - fm) < WGM ? (nM - fm) : WGM;
            u.pm = fm + ((wgid % nig) % gsz); u.pn = (wgid % nig) / gsz; u.x0 = 0; u.x1 = 0;
            { const int pl = u.pn;
              if (MODE == 5) u.pn = pl < 3 ? pl + 2 : pl + 5;
              if (MODE == 6) u.pn = pl < 2 ? pl : (pl < 5 ? pl + 3 : pl + 16);
              u.aoff = (long)u.pm * 256 * lda * 2; u.boff = (long)(MODE == 6 ? pl : u.pn) * 256 * ldb * 2; }
        } else if (MODE == 1) {
            const int h = wgid >> 4, rem = wgid & 15, rt = rem >> 1, pn = rem & 1;
            u.pm = rt; u.pn = pn; u.x0 = h; u.x1 = rt;
            u.aoff = ((long)(TP + 256 * rt) * 3072 + h * 192) * 2; u.boff = ((long)(h * 512 + 256 * pn) * 256) * 2;
        } else if (MODE == 2) {
            const int b = wgid / 36, rem = wgid % 36, pm = rem / 9, pn = rem % 9;
            u.pm = pm; u.pn = pn; u.x0 = b; u.x1 = 0;
            u.aoff = ((long)(b * 1024 + 256 * pm) * QLD) * 2; u.boff = ((long)(b * KPAD + 256 * pn) * QLD) * 2;
        } else if (MODE == 3) {
            const int b = wgid >> 3, pm = (wgid & 7) >> 1, pn = wgid & 1;
            u.pm = pm; u.pn = pn; u.x0 = b; u.x1 = 0;
            u.aoff = ((long)(b * 1024 + 256 * pm) * KPAD) * 2; u.boff = ((long)(b * 512 + 256 * pn) * KPAD) * 2;
        } else {
            const int h = wgid >> 3, rt = wgid & 7;
            u.pm = rt; u.pn = 0; u.x0 = h; u.x1 = rt;
            u.aoff = ((long)(h * 2048 + 256 * rt) * 512) * 2; u.boff = ((long)(h * 256) * 512) * 2;
        }
        return true;
    }
};

template <class Epi, class SchedT, bool I8 = false>
__device__ __forceinline__ void gemm_phase(LAS unsigned char* lds, const Gemm g, const SchedT& S, const Epi& E) {
    const int tid = otid(), wid = __builtin_amdgcn_readfirstlane(tid >> 6), lane = tid & 63, wr = wid >> 2, wc = wid & 3, fr = lane & 15, fq = lane >> 4;
    const int K = g.K, nt = K / BK;
    unsigned voffA[2], voffB[2];
#pragma unroll
    for (int i = 0; i < 2; ++i) { int R, C; stage_rc(tid * 16 + i * 8192, R, C); const int Rb = Epi::PERM ? ((R & ~31) + perm32(R & 31)) : R;
        voffA[i] = (unsigned)(R * g.lda + C) * 2u; voffB[i] = (unsigned)(Rb * g.ldb + C) * 2u; }
    const size_t kstep = (size_t)(BK * 2);
    const size_t hstepA = (size_t)HALF * g.lda * 2, hstepB = (size_t)HALF * g.ldb * 2;
    const unsigned ldsw = (unsigned)wid * 1024u;
    const int aoff = lds_byte(wr * 64 + fr, fq * 8), boff = lds_byte(wc * 32 + fr, fq * 8);
#define PG8_SA(b, h) (((b) * 2 + (h)) * HTB)
#define PG8_SB(b, h) ((4 + (b) * 2 + (h)) * HTB)
#define PG8_STAGE(bufoff, gbase, voff) do { _Pragma("unroll") for (int _i = 0; _i < 2; ++_i) \
        __builtin_amdgcn_global_load_lds((const unsigned*)((const char*)(gbase) + (voff)[_i]), (LAS unsigned*)(lds + (bufoff) + ldsw + _i * 8192), 16, 0, 0); } while (0)
#define PG8_LDA(dst, b, h) do { _Pragma("unroll") for (int m = 0; m < 4; ++m) _Pragma("unroll") for (int k = 0; k < 2; ++k) dst[m][k] = *(const LAS bf16x8*)(lds + PG8_SA(b, h) + aoff + m * 2048 + k * 1024); } while (0)
#define PG8_LDB(dst, b, h) do { _Pragma("unroll") for (int n = 0; n < 2; ++n) _Pragma("unroll") for (int k = 0; k < 2; ++k) dst[n][k] = *(const LAS bf16x8*)(lds + PG8_SB(b, h) + boff + n * 2048 + k * 1024); } while (0)
#define PG8_MMA(ai, bj, At, Bt) do { __builtin_amdgcn_s_setprio(1); _Pragma("unroll") for (int m = 0; m < 4; ++m) _Pragma("unroll") for (int n = 0; n < 2; ++n) _Pragma("unroll") for (int k = 0; k < 2; ++k) \
        { if constexpr (I8) acc[ai][bj][m][n] = __builtin_bit_cast(f32x4, __builtin_amdgcn_mfma_i32_16x16x64_i8(__builtin_bit_cast(i32x4, Bt[n][k]), __builtin_bit_cast(i32x4, At[m][k]), __builtin_bit_cast(i32x4, acc[ai][bj][m][n]), 0, 0, 0)); \
          else acc[ai][bj][m][n] = __builtin_amdgcn_mfma_f32_16x16x32_bf16(Bt[n][k], At[m][k], acc[ai][bj][m][n], 0, 0, 0); } __builtin_amdgcn_s_setprio(0); } while (0)
#define PG8_WAIT_V(n) asm volatile("s_waitcnt vmcnt(" #n ")" ::: "memory")
#define PG8_WAIT_L(n) asm volatile("s_waitcnt lgkmcnt(" #n ")" ::: "memory")
#define PG8_BAR __builtin_amdgcn_s_barrier()
#define PG8_SCHED __builtin_amdgcn_sched_barrier(0)
    Unit cur, nxt; int ui = 0;
    if (!S.next(0, cur)) return;
    f32x4 acc[2][2][4][2];
#pragma unroll
    for (int a = 0; a < 2; ++a)
#pragma unroll
        for (int b = 0; b < 2; ++b)
#pragma unroll
            for (int m = 0; m < 4; ++m)
#pragma unroll
                for (int n = 0; n < 2; ++n) acc[a][b][m][n] = (f32x4){0.f, 0.f, 0.f, 0.f};
    bf16x8 At[4][2], B0[2][2], B1[2][2];
    const char* cA = (const char*)g.A + cur.aoff; const char* cB = (const char*)g.Bt + cur.boff;
    PG8_STAGE(PG8_SB(0, 0), cB, voffB); PG8_STAGE(PG8_SA(0, 0), cA, voffA); PG8_STAGE(PG8_SB(0, 1), cB + hstepB, voffB); PG8_STAGE(PG8_SA(0, 1), cA + hstepA, voffA);
    if (wr == 1) PG8_BAR;
    PG8_WAIT_V(4); PG8_BAR;
    PG8_STAGE(PG8_SB(1, 0), cB + kstep, voffB); PG8_STAGE(PG8_SA(1, 0), cA + kstep, voffA); PG8_STAGE(PG8_SB(1, 1), cB + hstepB + kstep, voffB);
    PG8_WAIT_V(6); PG8_BAR;
    for (;;) {
        const bool has_next = S.next(ui + 1, nxt);
        const char* nA = has_next ? (const char*)g.A + nxt.aoff : cA; const char* nB = has_next ? (const char*)g.Bt + nxt.boff : cB;
        for (int t = 0; t < nt; t += 2) {
            const bool last = (t == nt - 2);
            const char* a1 = cA + (size_t)(t + 1) * kstep;
            const char* a2 = last ? nA : cA + (size_t)(t + 2) * kstep; const char* b2 = last ? nB : cB + (size_t)(t + 2) * kstep;
            const char* a3 = a2 + kstep; const char* b3 = b2 + kstep;
            PG8_LDB(B0, 0, 0); PG8_SCHED; PG8_LDA(At, 0, 0); PG8_STAGE(PG8_SA(1, 1), a1 + hstepA, voffA);
            PG8_WAIT_L(8); PG8_BAR; PG8_WAIT_L(0); PG8_MMA(0, 0, At, B0); PG8_BAR; PG8_SCHED;
            PG8_LDB(B1, 0, 1); PG8_STAGE(PG8_SB(0, 0), b2, voffB);
            PG8_BAR; PG8_WAIT_L(0); PG8_MMA(0, 1, At, B1); PG8_BAR;
            PG8_LDA(At, 0, 1); PG8_STAGE(PG8_SA(0, 0), a2, voffA);
            PG8_BAR; PG8_WAIT_L(0); PG8_MMA(1, 0, At, B0); PG8_BAR; PG8_SCHED;
            PG8_STAGE(PG8_SB(0, 1), b2 + hstepB, voffB);
            PG8_WAIT_V(6); PG8_BAR; PG8_MMA(1, 1, At, B1); PG8_BAR;
            PG8_LDB(B0, 1, 0); PG8_SCHED; PG8_LDA(At, 1, 0); PG8_STAGE(PG8_SA(0, 1), a2 + hstepA, voffA);
            PG8_WAIT_L(8); PG8_BAR; PG8_WAIT_L(0); PG8_MMA(0, 0, At, B0); PG8_BAR; PG8_SCHED;
            PG8_LDB(B1, 1, 1); PG8_STAGE(PG8_SB(1, 0), b3, voffB);
            PG8_BAR; PG8_WAIT_L(0); PG8_MMA(0, 1, At, B1); PG8_BAR;
            PG8_LDA(At, 1, 1); PG8_STAGE(PG8_SA(1, 0), a3, voffA);
            PG8_BAR; PG8_WAIT_L(0); PG8_MMA(1, 0, At, B0); PG8_BAR; PG8_SCHED;
            PG8_STAGE(PG8_SB(1, 1), b3 + hstepB, voffB);
            PG8_WAIT_V(6); PG8_BAR; PG8_MMA(1, 1, At, B1); PG8_BAR;
        }
        if constexpr (I8) {
#pragma unroll
            for (int a = 0; a < 2; ++a)
#pragma unroll
                for (int b = 0; b < 2; ++b)
#pragma unroll
                    for (int m = 0; m < 4; ++m)
#pragma unroll
                        for (int n = 0; n < 2; ++n) { const i32x4 iv = __builtin_bit_cast(i32x4, acc[a][b][m][n]); acc[a][b][m][n] = (f32x4){(float)iv[0], (float)iv[1], (float)iv[2], (float)iv[3]}; } }
        E(acc, cur, wr, wc, fr, fq);
        if (!has_next) break;
#pragma unroll
        for (int a = 0; a < 2; ++a)
#pragma unroll
            for (int b = 0; b < 2; ++b)
#pragma unroll
                for (int m = 0; m < 4; ++m)
#pragma unroll
                    for (int n = 0; n < 2; ++n) acc[a][b][m][n] = (f32x4){0.f, 0.f, 0.f, 0.f};
        cur = nxt; cA = nA; cB = nB; ++ui;
    }
    PG8_WAIT_V(0);
    if (wr == 0) PG8_BAR;
    PG8_BAR;
#undef PG8_SA
#undef PG8_SB
#undef PG8_STAGE
#undef PG8_LDA
#undef PG8_LDB
#undef PG8_MMA
#undef PG8_WAIT_V
#undef PG8_WAIT_L
#undef PG8_BAR
#undef PG8_SCHED
}

struct EpiBf16 {
    static constexpr bool PERM = true;
    bf16_t* O; long ldc; long bstride;
    __device__ __forceinline__ void operator()(const f32x4 (&acc)[2][2][4][2], const Unit& u, int wr, int wc, int fr, int fq) const {
        bf16_t* base = O + (long)u.x0 * bstride + (long)(u.pm * BM + wr * 64 + fr) * ldc + u.pn * BM + wc * 32 + 8 * fq;
#pragma unroll
        for (int ai = 0; ai < 2; ++ai)
#pragma unroll
            for (int m = 0; m < 4; ++m) { bf16_t* rowp = base + (long)(ai * HALF + m * 16) * ldc;
#pragma unroll
                for (int bj = 0; bj < 2; ++bj) { const f32x4 v0 = acc[ai][bj][m][0], v1 = acc[ai][bj][m][1];
                    u32x4 w; w.x = cvt_pk_bf16(v0[0], v0[1]); w.y = cvt_pk_bf16(v0[2], v0[3]); w.z = cvt_pk_bf16(v1[0], v1[1]); w.w = cvt_pk_bf16(v1[2], v1[3]);
                    *(u32x4*)(rowp + bj * HALF) = w; } }
    }
};
template <int RMODE> struct EpiRowMap {
    static constexpr bool PERM = true;
    bf16_t* O; const float* rsum;
    __device__ __forceinline__ void operator()(const f32x4 (&acc)[2][2][4][2], const Unit& u, int wr, int wc, int fr, int fq) const {
        const int col0 = u.pn * BM + wc * 32 + 8 * fq;
#pragma unroll
        for (int ai = 0; ai < 2; ++ai)
#pragma unroll
            for (int m = 0; m < 4; ++m) { const int r = ai * HALF + wr * 64 + m * 16 + fr; long drow; long ldc;
                if (RMODE == 1) { const int ts = 256 * u.x1 + r; drow = (long)(ts >> 6) * 1024 + u.x0 * 64 + (ts & 63); ldc = QLD; }
                float rs = 1.0f;
                if (RMODE == 1) { }
                else { const int qr = 256 * u.pm + r; drow = (long)(qr >> 6) * 2048 + u.x0 * 64 + (qr & 63); ldc = 512; rs = 1.0f / rsum[u.x0 * 1024 + qr]; }
                bf16_t* rowp = O + drow * ldc + col0;
#pragma unroll
                for (int bj = 0; bj < 2; ++bj) { const f32x4 v0 = acc[ai][bj][m][0] * rs, v1 = acc[ai][bj][m][1] * rs;
                    u32x4 w; w.x = cvt_pk_bf16(v0[0], v0[1]); w.y = cvt_pk_bf16(v0[2], v0[3]); w.z = cvt_pk_bf16(v1[0], v1[1]); w.w = cvt_pk_bf16(v1[2], v1[3]);
                    *(u32x4*)(rowp + bj * HALF) = w; } }
    }
};
struct EpiOV {
    static constexpr bool PERM = true;
    bf16_t* O;
    __device__ __forceinline__ void operator()(const f32x4 (&acc)[2][2][4][2], const Unit& u, int wr, int wc, int fr, int fq) const {
#pragma unroll
        for (int ai = 0; ai < 2; ++ai)
#pragma unroll
            for (int m = 0; m < 4; ++m) { const int r = ai * HALF + wr * 64 + m * 16 + fr;
                bf16_t* rowp = O + (long)(TP + 256 * u.x1 + r) * DM + u.x0 * 128 + wc * 32 + 8 * fq;
                const f32x4 v0 = acc[ai][1][m][0], v1 = acc[ai][1][m][1];
                u32x4 w; w.x = cvt_pk_bf16(v0[0], v0[1]); w.y = cvt_pk_bf16(v0[2], v0[3]); w.z = cvt_pk_bf16(v1[0], v1[1]); w.w = cvt_pk_bf16(v1[2], v1[3]);
                *(u32x4*)rowp = w; }
    }
};
struct EpiMix {
    static constexpr bool PERM = true;
    const bf16_t* Y; const bf16_t* YA; bf16_t* MIX; const float* sa; const float* sb;
    __device__ __forceinline__ void operator()(const f32x4 (&acc)[2][2][4][2], const Unit& u, int wr, int wc, int fr, int fq) const {
#pragma unroll
        for (int ai = 0; ai < 2; ++ai)
#pragma unroll
            for (int m = 0; m < 4; ++m) { const long t = (long)u.pm * BM + ai * HALF + wr * 64 + m * 16 + fr; const float s_ = sa[t];
#pragma unroll
                for (int bj = 0; bj < 2; ++bj) { const int c = u.pn * BM + bj * HALF + wc * 32 + 8 * fq;
                    const u32x4 ga = *(const u32x4*)(Y + t * INWP + C_GA + c), gb = *(const u32x4*)(Y + t * INWP + C_GB + c), ya = *(const u32x4*)(YA + t * DM + c);
                    float fa[8], fb[8], fy[8], o[8]; unpack8(ga, fa); unpack8(gb, fb); unpack8(ya, fy);
                    const f32x4 v0 = acc[ai][bj][m][0] * *(const f32x4*)(sb + c) * s_, v1 = acc[ai][bj][m][1] * *(const f32x4*)(sb + c + 4) * s_;
                    const float av[8] = {v0[0], v0[1], v0[2], v0[3], v1[0], v1[1], v1[2], v1[3]};
#pragma unroll
                    for (int j = 0; j < 8; ++j) {
#if defined(DBG_MIX) && DBG_MIX == 1
                        o[j] = sigmoidf_(fb[j]) * av[j];
#elif defined(DBG_MIX) && DBG_MIX == 2
                        o[j] = sigmoidf_(fa[j]) * fy[j];
#else
                        o[j] = sigmoidf_(fa[j]) * fy[j] + sigmoidf_(fb[j]) * av[j];
#endif
                    }
                    *(u32x4*)(MIX + t * DM + c) = pack8(o); } }
    }
};
struct EpiRes {
    static constexpr bool PERM = false;
    float* X; const float* gate;
    const float* XinP; const float* XinS;
    __device__ __forceinline__ void operator()(const f32x4 (&acc)[2][2][4][2], const Unit& u, int wr, int wc, int fr, int fq) const {
#pragma unroll
        for (int ai = 0; ai < 2; ++ai)
#pragma unroll
            for (int m = 0; m < 4; ++m) { const int t = u.pm * BM + ai * HALF + wr * 64 + m * 16 + fr; const float* gr = gate + (long)cond_row(t) * 12288; float* xr = X + (long)t * DM; const float* xi = t < TP ? XinP + (long)t * DM : XinS + (long)(t - TP) * DM;
#pragma unroll
                for (int bj = 0; bj < 2; ++bj)
#pragma unroll
                    for (int n = 0; n < 2; ++n) { const int c = u.pn * BM + bj * HALF + wc * 32 + n * 16 + 4 * fq;
                        const f32x4 gv = *(const f32x4*)(gr + c); const f32x4 xv = *(const f32x4*)(xi + c);
                        *(f32x4*)(xr + c) = xv + gv * acc[ai][bj][m][n]; } }
    }
};

struct EpiQ {
    static constexpr bool PERM = true;
    bf16_t* Q; bf16_t* QL; const float* T64;
    __device__ __forceinline__ void operator()(const f32x4 (&acc)[2][2][4][2], const Unit& u, int wr, int wc, int fr, int fq) const {
        const int grp = u.pn / 3, typ = u.pn - 3 * grp;
        if (typ < 2) {
#pragma unroll
            for (int ai = 0; ai < 2; ++ai)
#pragma unroll
                for (int m = 0; m < 4; ++m) { const long t = (long)u.pm * BM + ai * HALF + wr * 64 + m * 16 + fr;
#pragma unroll
                    for (int bj = 0; bj < 2; ++bj) { const f32x4 v0 = acc[ai][bj][m][0], v1 = acc[ai][bj][m][1];
                        u32x4 w; w.x = cvt_pk_bf16(v0[0], v0[1]); w.y = cvt_pk_bf16(v0[2], v0[3]); w.z = cvt_pk_bf16(v1[0], v1[1]); w.w = cvt_pk_bf16(v1[2], v1[3]);
                        *(u32x4*)(Q + t * 3072 + 768 * grp + 192 * (2 * typ + bj) + wc * 32 + 8 * fq) = w; } }
        } else {
#pragma unroll
            for (int ai = 0; ai < 2; ++ai)
#pragma unroll
                for (int m = 0; m < 4; ++m) { const int t = u.pm * BM + ai * HALF + wr * 64 + m * 16 + fr; const int pos = tok_pos(t);
                    const float* cs = T64 + ((long)pos * 32 + 8 * fq) * 2; float cv[8], sv[8];
#pragma unroll
                    for (int j = 0; j < 4; ++j) { const f32x4 qv = *(const f32x4*)(cs + 4 * j); cv[2 * j] = qv[0]; sv[2 * j] = qv[1]; cv[2 * j + 1] = qv[2]; sv[2 * j + 1] = qv[3]; }
                    const f32x4 a0 = acc[ai][0][m][0], a1 = acc[ai][0][m][1], b0 = acc[ai][1][m][0], b1 = acc[ai][1][m][1];
                    const float x1[8] = {a0[0], a0[1], a0[2], a0[3], a1[0], a1[1], a1[2], a1[3]}, x2[8] = {b0[0], b0[1], b0[2], b0[3], b1[0], b1[1], b1[2], b1[3]};
                    float o1[8], o2[8];
#pragma unroll
                    for (int j = 0; j < 8; ++j) { o1[j] = x1[j] * cv[j] - x2[j] * sv[j]; o2[j] = x1[j] * sv[j] + x2[j] * cv[j]; }
                    const u32x4 w1 = pack8(o1), w2 = pack8(o2); const int hd = 4 * grp + wc;
                    bf16_t* qd = Q + (long)t * 3072 + hd * 192 + 128 + 8 * fq; *(u32x4*)qd = w1; *(u32x4*)(qd + 32) = w2;
                    if (t >= TP) { const int ts = t - TP; bf16_t* d = QL + ((long)(ts >> 6) * 1024 + hd * 64 + (ts & 63)) * QLD + 512 + 8 * fq; *(u32x4*)d = w1; *(u32x4*)(d + 32) = w2; } }
        }
    }
};

struct EpiExp {
    static constexpr bool PERM = true;
    bf16_t* O; float* rsum;
    __device__ __forceinline__ void operator()(const f32x4 (&acc)[2][2][4][2], const Unit& u, int wr, int wc, int fr, int fq) const {
        bf16_t* base = O + (long)u.x0 * 1024 * KPAD + (long)(u.pm * BM + wr * 64 + fr) * KPAD + u.pn * BM + wc * 32 + 8 * fq;
#pragma unroll
        for (int ai = 0; ai < 2; ++ai)
#pragma unroll
            for (int m = 0; m < 4; ++m) { bf16_t* rowp = base + (long)(ai * HALF + m * 16) * KPAD; float part = 0.f;
#pragma unroll
                for (int bj = 0; bj < 2; ++bj) { const int c0 = u.pn * BM + bj * HALF + wc * 32 + 8 * fq; const f32x4 v0 = acc[ai][bj][m][0], v1 = acc[ai][bj][m][1];
                    const float sv[8] = {v0[0], v0[1], v0[2], v0[3], v1[0], v1[1], v1[2], v1[3]}; float e[8];
#pragma unroll
                    for (int j = 0; j < 8; ++j) { e[j] = (c0 + j < KALL) ? __expf(fminf(sv[j] * MLA_SCALE, 60.f)) : 0.f; part += e[j]; }
                    *(u32x4*)(rowp + bj * HALF) = pack8(e); }
                part += sx<16>(part); part += sx<32>(part);
                if (fq == 0) atomicAdd(rsum + u.x0 * 1024 + u.pm * BM + ai * HALF + wr * 64 + m * 16 + fr, part); }
    }
};

struct EpiQ8 {
    static constexpr bool PERM = true;
    bf16_t* O; long ldc; const float* sa; const float* sb;
    __device__ __forceinline__ void operator()(const f32x4 (&acc)[2][2][4][2], const Unit& u, int wr, int wc, int fr, int fq) const {
        f32x4 sbv[2][2];
#pragma unroll
        for (int bj = 0; bj < 2; ++bj) { const int c = u.pn * BM + bj * HALF + wc * 32 + 8 * fq; sbv[bj][0] = *(const f32x4*)(sb + c); sbv[bj][1] = *(const f32x4*)(sb + c + 4); }
#pragma unroll
        for (int ai = 0; ai < 2; ++ai)
#pragma unroll
            for (int m = 0; m < 4; ++m) { const long t = (long)u.pm * BM + ai * HALF + wr * 64 + m * 16 + fr; const float s = sa[t];
#pragma unroll
                for (int bj = 0; bj < 2; ++bj) { const f32x4 v0 = acc[ai][bj][m][0] * sbv[bj][0] * s, v1 = acc[ai][bj][m][1] * sbv[bj][1] * s;
                    u32x4 w; w.x = cvt_pk_bf16(v0[0], v0[1]); w.y = cvt_pk_bf16(v0[2], v0[3]); w.z = cvt_pk_bf16(v1[0], v1[1]); w.w = cvt_pk_bf16(v1[2], v1[3]);
                    *(u32x4*)(O + t * ldc + u.pn * BM + bj * HALF + wc * 32 + 8 * fq) = w; } }
    }
};
}
namespace att {
constexpr int NW = 8, QBLK = 32, KVBLK = 64;
constexpr float SCALE = MLA_SCALE;
constexpr float THR = 8.f;
constexpr int KROW = 384;
constexpr int SHM_V = KVBLK * 128 * 2, SHM_K = KVBLK * KROW;
constexpr int QR_PITCH = 144, SHM_QR = 256 * QR_PITCH;
constexpr int SHM_ATTN = 2 * SHM_V + 2 * SHM_K + NW * 64 * 4 + SHM_QR;
#define KSWZ(row, colB) ((row) * att::KROW + ((colB) ^ (((row) & 7) << 4)))
#define SBAR() __builtin_amdgcn_sched_barrier(0)
__device__ __forceinline__ int crow(int r, int hi) { return (r & 3) + 8 * (r >> 2) + 4 * hi; }

__device__ __forceinline__ void partialSM(f32x16& p0, f32x16& p1, float& m_reg, float& mn, float& alpha) {
  constexpr float C = SCALE * 1.4426950408889634f;
  float pmax = p0[0];
#pragma unroll
  for (int r = 1; r < 16; ++r) pmax = fmaxf(pmax, p0[r]);
#pragma unroll
  for (int r = 0; r < 16; ++r) pmax = fmaxf(pmax, p1[r]);
  { auto rr = __builtin_amdgcn_permlane32_swap(__float_as_uint(pmax), __float_as_uint(pmax), false, false);
    pmax = fmaxf(__uint_as_float(rr[0]), __uint_as_float(rr[1])); }
  if (__builtin_expect(__all(pmax - m_reg <= THR / SCALE), 1)) { mn = m_reg; alpha = 1.f; }
  else { mn = fmaxf(m_reg, pmax); alpha = __builtin_amdgcn_exp2f((m_reg - mn) * C); m_reg = mn; }
  float mnC = -mn * C;
#pragma unroll
  for (int r = 0; r < 16; ++r) p0[r] = fmaf(p0[r], C, mnC);
#pragma unroll
  for (int r = 0; r < 16; ++r) p1[r] = fmaf(p1[r], C, mnC);
#pragma unroll
  for (int r = 0; r < 16; ++r) p0[r] = __builtin_amdgcn_exp2f(p0[r]);
}
__device__ __forceinline__ void finishSM(f32x16& p0, f32x16& p1, float alpha, float& l_reg, bf16x8& pa0, bf16x8& pa1, bf16x8& pa2, bf16x8& pa3) {
#pragma unroll
  for (int r = 0; r < 16; ++r) p1[r] = __builtin_amdgcn_exp2f(p1[r]);
  float ps = 0;
#pragma unroll
  for (int r = 0; r < 16; ++r) ps += p0[r];
#pragma unroll
  for (int r = 0; r < 16; ++r) ps += p1[r];
  { auto rr = __builtin_amdgcn_permlane32_swap(__float_as_uint(ps), __float_as_uint(ps), false, false);
    ps = __uint_as_float(rr[0]) + __uint_as_float(rr[1]); }
  l_reg = l_reg * alpha + ps;
#define PK4(P, BASE, OUT) do { unsigned a0 = cvt_pk_bf16(P[BASE + 0], P[BASE + 1]), a1 = cvt_pk_bf16(P[BASE + 2], P[BASE + 3]);   \
    unsigned b0 = cvt_pk_bf16(P[BASE + 4], P[BASE + 5]), b1 = cvt_pk_bf16(P[BASE + 6], P[BASE + 7]);                              \
    auto r0 = __builtin_amdgcn_permlane32_swap(a0, b0, false, false); auto r1 = __builtin_amdgcn_permlane32_swap(a1, b1, false, false); \
    u32x4 w = {r0[0], r1[0], r0[1], r1[1]}; OUT = *reinterpret_cast<bf16x8*>(&w); } while (0)
  PK4(p0, 0, pa0); PK4(p0, 8, pa1); PK4(p1, 0, pa2); PK4(p1, 8, pa3);
#undef PK4
}
__device__ __forceinline__ void qkt(f32x16& p0, f32x16& p1, const char* Ks, const bf16x8* qr, const char* qrope, const int (&kbase)[4], bool vis) {
  p0 = f32x16{}; p1 = f32x16{};
  if (vis) {
#pragma unroll
  for (int d0 = 0; d0 < 12; ++d0) {
    bf16x8 b0 = *reinterpret_cast<const bf16x8*>(Ks + kbase[d0 & 3] + (d0 >> 2) * 128);
    bf16x8 b1 = *reinterpret_cast<const bf16x8*>(Ks + kbase[d0 & 3] + (d0 >> 2) * 128 + 32 * KROW);
    const bf16x8 qv = d0 < 8 ? qr[d0 < 8 ? d0 : 0] : *reinterpret_cast<const bf16x8*>(qrope + (d0 - 8) * 32);
    p0 = __builtin_amdgcn_mfma_f32_32x32x16_bf16(b0, qv, p0, 0, 0, 0);
    p1 = __builtin_amdgcn_mfma_f32_32x32x16_bf16(b1, qv, p1, 0, 0, 0); }
  }
  if (!vis) {
#pragma unroll
    for (int r = 0; r < 16; ++r) { p0[r] = -1e30f; p1[r] = -1e30f; } }
}
__device__ __forceinline__ int v_st(int k, int c) { const int kk = (k & ~0xC) | ((k & 4) << 1) | ((k & 8) >> 1); return ((kk >> 3) * 4 + (c >> 5)) * 512 + ((kk & 7) * 32 + (c & 31)) * 2; }
__device__ __forceinline__ int v_rd_base(int lane) { return ((lane & 3) << 3) | (((lane >> 2) & 3) << 6) | (((lane >> 4) & 1) << 5) | (((lane >> 5) & 1) << 8); }
constexpr int v_rd_off(int d0, int ks, int half) { return d0 * 512 + ks * 4096 + half * 2048; }
template <int OFF> __device__ __forceinline__ s16x4 tr_read(int vb) {
  s16x4 r; asm volatile("ds_read_b64_tr_b16 %0, %1 offset:%2" : "=&v"(r) : "v"(vb), "i"(OFF) : "memory"); return r;
}
template <int D0> __device__ __forceinline__ void pv_one(f32x16& od, int vb, bf16x8 pa0, bf16x8 pa1, bf16x8 pa2, bf16x8 pa3) {
  const s16x4 l0 = tr_read<v_rd_off(D0, 0, 0)>(vb), h0 = tr_read<v_rd_off(D0, 0, 1)>(vb), l1 = tr_read<v_rd_off(D0, 1, 0)>(vb), h1 = tr_read<v_rd_off(D0, 1, 1)>(vb);
  const s16x4 l2 = tr_read<v_rd_off(D0, 2, 0)>(vb), h2 = tr_read<v_rd_off(D0, 2, 1)>(vb), l3 = tr_read<v_rd_off(D0, 3, 0)>(vb), h3 = tr_read<v_rd_off(D0, 3, 1)>(vb);
  asm volatile("s_waitcnt lgkmcnt(0)" ::: "memory"); SBAR();
#define PK(L, H) (bf16x8){L[0], L[1], L[2], L[3], H[0], H[1], H[2], H[3]}
  od = __builtin_amdgcn_mfma_f32_32x32x16_bf16(pa0, PK(l0, h0), od, 0, 0, 0);
  od = __builtin_amdgcn_mfma_f32_32x32x16_bf16(pa1, PK(l1, h1), od, 0, 0, 0);
  od = __builtin_amdgcn_mfma_f32_32x32x16_bf16(pa2, PK(l2, h2), od, 0, 0, 0);
  od = __builtin_amdgcn_mfma_f32_32x32x16_bf16(pa3, PK(l3, h3), od, 0, 0, 0);
#undef PK
}
__device__ __forceinline__ void pv_d0(f32x16* o, int vb, bf16x8 pa0, bf16x8 pa1, bf16x8 pa2, bf16x8 pa3) {
  pv_one<0>(o[0], vb, pa0, pa1, pa2, pa3); pv_one<1>(o[1], vb, pa0, pa1, pa2, pa3); pv_one<2>(o[2], vb, pa0, pa1, pa2, pa3); pv_one<3>(o[3], vb, pa0, pa1, pa2, pa3);
}

__device__ __forceinline__ void attn_block(const bf16_t* __restrict__ Qb, const bf16_t* __restrict__ Kn, const bf16_t* __restrict__ Kr, const bf16_t* __restrict__ Vh,
                                           bf16_t* __restrict__ Ob, int qb, char* lds) {
  constexpr int LDQ = 3072, LDK = 4096, LDR = 64, LDO = 2048;
  const int tid = otid(), wid = tid >> 6, lane = tid & 63, r32 = lane & 31, hi = lane >> 5;
  char* V_lds = lds; char* K_lds = lds + 2 * SHM_V;
  float* ws = (float*)(lds + 2 * SHM_V + 2 * SHM_K) + wid * 64; float* li_l = ws; float* al_l = ws + 32;
  float m_reg = -1e30f, l_reg = 0; f32x16 o[4] = {}; bf16x8 qr[8];
  const bf16_t* Qw = Qb + (long)(wid * QBLK + r32) * LDQ + hi * 8;
#pragma unroll
  for (int d0 = 0; d0 < 8; ++d0) qr[d0] = *reinterpret_cast<const bf16x8*>(Qw + d0 * 16);
  char* qrope = lds + 2 * SHM_V + 2 * SHM_K + NW * 64 * 4 + (wid * QBLK + r32) * QR_PITCH + hi * 16;
#pragma unroll
  for (int d0 = 8; d0 < 12; ++d0) *reinterpret_cast<bf16x8*>(qrope + (d0 - 8) * 32) = *reinterpret_cast<const bf16x8*>(Qw + d0 * 16);
  asm volatile("s_waitcnt lgkmcnt(0)" ::: "memory");
  const int NT = 4 * qb + 4, jmax = 4 * qb + (wid >> 1);
  int kbase[4];
#pragma unroll
  for (int dl = 0; dl < 4; ++dl) kbase[dl] = r32 * KROW + (((dl << 5) | (hi << 4)) ^ ((r32 & 7) << 4));
  const int sr = tid >> 4, sc = (tid & 15) * 8, vst0 = v_st(sr, sc), vst1 = v_st(32 + sr, sc);
  const int rr = tid >> 3, rc = (tid & 7) * 8;
  const int vb0 = (int)(uintptr_t)V_lds + v_rd_base(lane);
  bf16x8 vs0, vs1, ks0, ks1, kr0;
#define SLOAD(k0) do { vs0 = *reinterpret_cast<const bf16x8*>(&Vh[(long)((k0) + sr) * LDK + sc]); vs1 = *reinterpret_cast<const bf16x8*>(&Vh[(long)((k0) + 32 + sr) * LDK + sc]); \
    ks0 = *reinterpret_cast<const bf16x8*>(&Kn[(long)((k0) + sr) * LDK + sc]); ks1 = *reinterpret_cast<const bf16x8*>(&Kn[(long)((k0) + 32 + sr) * LDK + sc]); \
    kr0 = *reinterpret_cast<const bf16x8*>(&Kr[(long)((k0) + rr) * LDR + rc]); } while (0)
#define SWRITE(b) do { *(bf16x8*)(V_lds + (b) * SHM_V + vst0) = vs0; *(bf16x8*)(V_lds + (b) * SHM_V + vst1) = vs1; int kc = sc * 2; \
    *(bf16x8*)(K_lds + (b) * SHM_K + KSWZ(sr, kc)) = ks0; *(bf16x8*)(K_lds + (b) * SHM_K + KSWZ(32 + sr, kc)) = ks1; \
    *(bf16x8*)(K_lds + (b) * SHM_K + KSWZ(rr, 256 + rc * 2)) = kr0; } while (0)
#define SWAIT() asm volatile("s_waitcnt vmcnt(0)" ::: "memory")
#define RESC(a) do { if (__any((a) < 1.f)) { if (hi == 0) al_l[r32] = (a); asm volatile("s_waitcnt lgkmcnt(0)" ::: "memory"); \
    _Pragma("unroll") for (int d = 0; d < 4; ++d) _Pragma("unroll") for (int r = 0; r < 16; ++r) o[d][r] *= al_l[crow(r, hi)]; } } while (0)
  f32x16 pA0, pA1, pB0, pB1; float mnA, mnB, alA, alB; bf16x8 pa0, pa1, pa2, pa3;
  SLOAD(0); SWAIT(); SWRITE(0); __syncthreads();
  qkt(pA0, pA1, K_lds, qr, qrope, kbase, true); partialSM(pA0, pA1, m_reg, mnA, alA);
  SLOAD(KVBLK);
  SWAIT(); SWRITE(1); __syncthreads();
  for (int j = 1; j + 1 < NT; j += 2) {
    SBAR(); qkt(pB0, pB1, K_lds + SHM_K, qr, qrope, kbase, j <= jmax);
    finishSM(pA0, pA1, alA, l_reg, pa0, pa1, pa2, pa3); SBAR();
    SLOAD((j + 1) * KVBLK); SBAR();
    if (j - 1 <= jmax) pv_d0(o, vb0, pa0, pa1, pa2, pa3);
    partialSM(pB0, pB1, m_reg, mnB, alB);
    __syncthreads(); SWAIT(); SWRITE(0);
    RESC(alB); __syncthreads();
    SBAR(); qkt(pA0, pA1, K_lds, qr, qrope, kbase, j + 1 <= jmax);
    finishSM(pB0, pB1, alB, l_reg, pa0, pa1, pa2, pa3); SBAR();
    SLOAD((j + 2) * KVBLK); SBAR();
    if (j <= jmax) pv_d0(o, vb0 + (int)SHM_V, pa0, pa1, pa2, pa3);
    partialSM(pA0, pA1, m_reg, mnA, alA);
    __syncthreads(); SWAIT(); SWRITE(1);
    RESC(alA); __syncthreads();
  }
  SBAR(); qkt(pB0, pB1, K_lds + SHM_K, qr, qrope, kbase, NT - 1 <= jmax);
  finishSM(pA0, pA1, alA, l_reg, pa0, pa1, pa2, pa3); SBAR();
  if (NT - 2 <= jmax) pv_d0(o, vb0, pa0, pa1, pa2, pa3);
  partialSM(pB0, pB1, m_reg, mnB, alB);
  __syncthreads(); RESC(alB);
  finishSM(pB0, pB1, alB, l_reg, pa0, pa1, pa2, pa3); SBAR();
  if (NT - 1 <= jmax) pv_d0(o, vb0 + (int)SHM_V, pa0, pa1, pa2, pa3);
  if (hi == 0) li_l[r32] = l_reg; asm volatile("s_waitcnt lgkmcnt(0)" ::: "memory");
  float rli[16];
#pragma unroll
  for (int r = 0; r < 16; ++r) rli[r] = __builtin_amdgcn_rcpf(li_l[crow(r, hi)]);
  bf16_t* Ow = Ob + (long)(wid * QBLK) * LDO;
#pragma unroll
  for (int r = 0; r < 16; ++r) { int orow = crow(r, hi);
#pragma unroll
    for (int d0 = 0; d0 < 4; ++d0) Ow[(long)orow * LDO + d0 * 32 + r32] = f2bf(o[d0][r] * rli[r]); }
  __syncthreads();
#undef SLOAD
#undef SWRITE
#undef SWAIT
#undef RESC
}
}
namespace ret {
constexpr int QP_ = 136;
__device__ __forceinline__ bf16x8 ldfrag(const bf16_t* p) { return *reinterpret_cast<const bf16x8*>(p); }
template <int CL> struct Lay {
    static constexpr int IP = CL + 8;
    static constexpr int QS = 0, KS = QS + CL * QP_ * 2, VT = KS + CL * QP_ * 2, VDT = VT + 32 * IP * 2, IN = VDT + 32 * IP * 2, ST = IN + CL * IP * 2, VS = ST + 32 * QP_ * 2, END = VS + CL * 40 * 2;
};
static_assert(Lay<128>::END <= LDS_BARW, "retention LDS");

template <int CL>
__device__ __forceinline__ void run(const bf16_t* __restrict__ Y, bf16_t* __restrict__ OB, const float* __restrict__ sp, float* __restrict__ so, long tok0, int nch, int h, int es, float lg, char* lds, int tid) {
    using L = Lay<CL>; constexpr int IP = L::IP, NQT = CL / 16, NKS = CL / 32, NPC = CL / 32;
    const int wid = __builtin_amdgcn_readfirstlane(tid >> 6), lane = tid & 63, l15 = lane & 15, l4 = lane >> 4;
    bf16_t* Qs = (bf16_t*)(lds + L::QS); bf16_t* Ks = (bf16_t*)(lds + L::KS); bf16_t* Vt = (bf16_t*)(lds + L::VT); bf16_t* Vdt = (bf16_t*)(lds + L::VDT); bf16_t* In = (bf16_t*)(lds + L::IN); bf16_t* St = (bf16_t*)(lds + L::ST); bf16_t* Vs = (bf16_t*)(lds + L::VS);
    const float gCL = __expf((float)CL * lg);
    f32x4 Sacc[2];
    if (sp) {
#pragma unroll
        for (int ej = 0; ej < 2; ++ej)
#pragma unroll
            for (int r = 0; r < 4; ++r) Sacc[ej][r] = sp[(long)(16 * wid + 4 * l4 + r) * RV + 16 * ej + l15];
    } else { Sacc[0] = (f32x4){0.f, 0.f, 0.f, 0.f}; Sacc[1] = (f32x4){0.f, 0.f, 0.f, 0.f}; }
    for (int i = tid; i < CL * IP / 8; i += 512) reinterpret_cast<u32x4*>(In)[i] = (u32x4){0u, 0u, 0u, 0u};
    u32x4 pq[NPC], pk[NPC], pv;
    const int vk = tid >> 2, ve0 = (tid & 3) * 8;
#define RET_LOAD(cc) do { const bf16_t* yrow_ = Y + (tok0 + (long)(cc) * CL) * INWP; \
        _Pragma("unroll") for (int i = 0; i < NPC; ++i) { const int idx = tid + i * 512, k = idx >> 4, d0 = (idx & 15) * 8; \
            pq[i] = *reinterpret_cast<const u32x4*>(yrow_ + (long)k * INWP + C_RQ + h * 128 + d0); pk[i] = *reinterpret_cast<const u32x4*>(yrow_ + (long)k * INWP + C_RK + h * 128 + d0); } \
        if (tid < 4 * CL) pv = *reinterpret_cast<const u32x4*>(yrow_ + (long)vk * INWP + C_RV + h * 256 + es * 32 + ve0); } while (0)
    RET_LOAD(0);
    for (int c = 0; c < nch; ++c) {
#pragma unroll
        for (int ej = 0; ej < 2; ++ej) { u32x2 w; w.x = cvt_pk_bf16(Sacc[ej][0], Sacc[ej][1]); w.y = cvt_pk_bf16(Sacc[ej][2], Sacc[ej][3]);
            *reinterpret_cast<u32x2*>(St + (16 * ej + l15) * QP_ + 16 * wid + 4 * l4) = w; }
#pragma unroll
        for (int i = 0; i < NPC; ++i) { const int idx = tid + i * 512, k = idx >> 4, d0 = (idx & 15) * 8;
            *reinterpret_cast<u32x4*>(Qs + k * QP_ + d0) = pq[i]; *reinterpret_cast<u32x4*>(Ks + k * QP_ + d0) = pk[i]; }
        if (tid < 4 * CL) *reinterpret_cast<u32x4*>(Vs + vk * 40 + ve0) = pv;
        if (c + 1 < nch) RET_LOAD(c + 1);
        __syncthreads();
        if (tid < 4 * CL) { const int e = tid & 31, kg = tid >> 5; float f[8], fd[8];
#pragma unroll
            for (int j = 0; j < 8; ++j) { f[j] = bf2f(Vs[(8 * kg + j) * 40 + e]); fd[j] = f[j] * __expf((float)(CL - 1 - 8 * kg - j) * lg); }
            *reinterpret_cast<u32x4*>(Vt + e * IP + 8 * kg) = pack8(f); *reinterpret_cast<u32x4*>(Vdt + e * IP + 8 * kg) = pack8(fd); }
#pragma unroll
        for (int it_ = 0; it_ < (NQT * (NQT + 1) / 2 + 7) / 8; ++it_) { const int idx = wid + 8 * it_; if (idx >= NQT * (NQT + 1) / 2) break;
            int qi = 0; while ((qi + 1) * (qi + 2) / 2 <= idx) ++qi; const int kj = idx - qi * (qi + 1) / 2;
            f32x4 a = (f32x4){0.f, 0.f, 0.f, 0.f}; const bf16_t* qp = Qs + (16 * qi + l15) * QP_ + 8 * l4; const bf16_t* kp = Ks + (16 * kj + l15) * QP_ + 8 * l4;
#pragma unroll
            for (int ks = 0; ks < 4; ++ks) a = __builtin_amdgcn_mfma_f32_16x16x32_bf16(ldfrag(qp + 32 * ks), ldfrag(kp + 32 * ks), a, 0, 0, 0);
            const int q0 = 16 * qi + 4 * l4, k = 16 * kj + l15;
#pragma unroll
            for (int r = 0; r < 4; ++r) { const int q = q0 + r; const float dm = (q >= k) ? __expf((float)(q - k) * lg) : 0.f;
                In[q * IP + k] = f2bf(a[r] * dm); } }
        __syncthreads();
#pragma unroll
        for (int ot = 0; ot < (2 * NQT) / 8; ++ot) { const int tI = wid + 8 * ot, qi = tI >> 1, ej = tI & 1; f32x4 a = (f32x4){0.f, 0.f, 0.f, 0.f};
#pragma unroll
            for (int ks = 0; ks < 4; ++ks) a = __builtin_amdgcn_mfma_f32_16x16x32_bf16(ldfrag(Qs + (16 * qi + l15) * QP_ + 32 * ks + 8 * l4), ldfrag(St + (16 * ej + l15) * QP_ + 32 * ks + 8 * l4), a, 0, 0, 0);
#pragma unroll
            for (int r = 0; r < 4; ++r) a[r] *= __expf((float)(16 * qi + 4 * l4 + r + 1) * lg);
#pragma unroll
            for (int ks = 0; ks < NKS; ++ks) if (ks <= (qi >> 1)) a = __builtin_amdgcn_mfma_f32_16x16x32_bf16(ldfrag(In + (16 * qi + l15) * IP + 32 * ks + 8 * l4), ldfrag(Vt + (16 * ej + l15) * IP + 32 * ks + 8 * l4), a, 0, 0, 0);
            bf16_t* op = OB + ((long)(h * 8 + es) * T + tok0 + (long)c * CL + 16 * qi + 4 * l4) * 32 + 16 * ej + l15;
#pragma unroll
            for (int r = 0; r < 4; ++r) op[r * 32] = f2bf(a[r]); }
        { f32x4 s0 = Sacc[0] * gCL, s1 = Sacc[1] * gCL;
#pragma unroll
          for (int ks = 0; ks < NKS; ++ks) { bf16x8 af;
#pragma unroll
              for (int j = 0; j < 8; ++j) af[j] = (short)Ks[(32 * ks + 8 * l4 + j) * QP_ + 16 * wid + l15];
              s0 = __builtin_amdgcn_mfma_f32_16x16x32_bf16(af, ldfrag(Vdt + l15 * IP + 32 * ks + 8 * l4), s0, 0, 0, 0);
              s1 = __builtin_amdgcn_mfma_f32_16x16x32_bf16(af, ldfrag(Vdt + (16 + l15) * IP + 32 * ks + 8 * l4), s1, 0, 0, 0); }
          Sacc[0] = s0; Sacc[1] = s1; }
        __syncthreads();
    }
#undef RET_LOAD
#pragma unroll
    for (int ej = 0; ej < 2; ++ej)
#pragma unroll
        for (int r = 0; r < 4; ++r) so[(long)(16 * wid + 4 * l4 + r) * RV + 16 * ej + l15] = Sacc[ej][r];
}

__device__ __forceinline__ void unit(KParams& p, int l, int u, char* lds) {
    const int tid = otid(); unsigned char* ws = optr(gp(p.ws)); const bf16_t* Y = (const bf16_t*)(ws + WS_Y); bf16_t* OB = (bf16_t*)(ws + WS_OB);
    const bool samp = u >= 256; const int v = samp ? u - 256 : u; const int b = v >> 6, h = (v >> 3) & 7, es = v & 7; const float lg = p.lg[h];
    if (samp) run<64>(Y, OB, gp(p.state_ret) + ((((long)l * DB + b) * RH + h) * RQK) * RV + es * 32, gp(p.out) + O_RETS + ((((long)l * DB + b) * RH + h) * RQK) * RV + es * 32, (long)TP + b * 64, 1, h, es, lg, lds, tid);
    else run<64>(Y, OB, nullptr, gp(p.out) + O_RETP + ((((long)l * NB + b) * RH + h) * RQK) * RV + es * 32, (long)b * SEQ, SEQ / 64, h, es, lg, lds, tid);
}
}
namespace peer {
__device__ __forceinline__ void ins16(float (&l)[16], float x) {
#pragma unroll
    for (int j = 0; j < 16; ++j) { const float hi = fmaxf(l[j], x); x = fminf(l[j], x); l[j] = hi; }
}
#define CE_DESC(a, b) do { const float hi_ = fmaxf(a, b), lo_ = fminf(a, b); a = hi_; b = lo_; } while (0)
#define CE_ASC(a, b) do { const float hi_ = fmaxf(a, b), lo_ = fminf(a, b); a = lo_; b = hi_; } while (0)
__device__ __forceinline__ void sort16_desc(float (&v)[16]) {
#pragma unroll
    for (int k = 2; k <= 16; k <<= 1)
#pragma unroll
        for (int j = k >> 1; j >= 1; j >>= 1)
#pragma unroll
            for (int i = 0; i < 16; ++i) { const int l = i ^ j; if (l > i) { if ((i & k) == 0) CE_DESC(v[i], v[l]); else CE_ASC(v[i], v[l]); } }
}
__device__ __forceinline__ void merge16_desc(float (&l)[16], const float (&o)[16]) {
#pragma unroll
    for (int i = 0; i < 16; ++i) l[i] = fmaxf(l[i], o[15 - i]);
#pragma unroll
    for (int j = 8; j >= 1; j >>= 1)
#pragma unroll
        for (int i = 0; i < 16; ++i) { const int m = i ^ j; if (m > i) CE_DESC(l[i], l[m]); }
}
constexpr int KPITCH = 136;
__device__ __forceinline__ void half_top16(const bf16_t* __restrict__ qrow, const bf16_t* __restrict__ keys, int lane, float (&l)[16]) {
    const int r32 = lane & 31, g = lane >> 5;
#pragma unroll
    for (int j = 0; j < 16; ++j) l[j] = -3.0e38f;
    bf16x8 qf[8];
#pragma unroll
    for (int ks = 0; ks < 8; ++ks) qf[ks] = *reinterpret_cast<const bf16x8*>(qrow + 16 * ks + 8 * g);
#pragma unroll 1
    for (int kb = 0; kb < 4; ++kb) { f32x16 a = f32x16{};
#pragma unroll
        for (int ks = 0; ks < 8; ++ks) { const bf16x8 kf = *reinterpret_cast<const bf16x8*>(keys + (32 * kb + r32) * KPITCH + 16 * ks + 8 * g);
            a = __builtin_amdgcn_mfma_f32_32x32x16_bf16(kf, qf[ks], a, 0, 0, 0); }
        float blk[16];
#pragma unroll
        for (int r = 0; r < 16; ++r) { const unsigned key = (unsigned)(32 * kb + (r & 3) + 8 * (r >> 2) + 4 * g);
            blk[r] = __uint_as_float((__float_as_uint(a[r]) & ~0x7Fu) | key); }
        sort16_desc(blk); merge16_desc(l, blk); }
}
__device__ __forceinline__ void merge_lists(float (&l)[16], const float (&o)[16]) { merge16_desc(l, o); }
__device__ __forceinline__ void select_unit(const bf16_t* __restrict__ QP, const bf16_t* __restrict__ k1, const bf16_t* __restrict__ k2, int* __restrict__ PIDX, float* __restrict__ PW,
                                            int t0, int h, int lane, float* lds_lane  ) {
    const int r32 = lane & 31, g = lane >> 5;
    const bf16_t* qrow = QP + (long)(t0 + r32) * DM + h * 256;
    float la[16], lb[16];
    half_top16(qrow, k1, lane, la);
    half_top16(qrow + 128, k2, lane, lb);
    float m0[16], m1[16];
#pragma unroll
    for (int j = 0; j < 16; ++j) { auto rr = __builtin_amdgcn_permlane32_swap(__float_as_uint(la[j]), __float_as_uint(lb[j]), false, false); m0[j] = __uint_as_float(rr[0]); m1[j] = __uint_as_float(rr[1]); }
    merge_lists(m0, m1);
    float L1[16], L2[16];
#pragma unroll
    for (int j = 0; j < 16; ++j) { auto rr = __builtin_amdgcn_permlane32_swap(__float_as_uint(m0[j]), __float_as_uint(m0[j]), false, false);
        L1[j] = __uint_as_float(rr[0]); L2[j] = __uint_as_float(rr[1]); }
#define CAND(i, j) __uint_as_float((__float_as_uint(L1[i] + L2[j]) & ~0xFFu) | (unsigned)((i) * 16 + (j)))
    float best[16], c2[16], c3[16];
#pragma unroll
    for (int j = 0; j < 16; ++j) best[j] = CAND(0, j);
    sort16_desc(best);
    c2[0] = CAND(1, 0); c2[1] = CAND(1, 1); c2[2] = CAND(1, 2); c2[3] = CAND(1, 3); c2[4] = CAND(1, 4); c2[5] = CAND(1, 5); c2[6] = CAND(1, 6); c2[7] = CAND(1, 7);
    c2[8] = CAND(2, 0); c2[9] = CAND(2, 1); c2[10] = CAND(2, 2); c2[11] = CAND(2, 3); c2[12] = CAND(2, 4); c2[13] = CAND(4, 0); c2[14] = CAND(4, 1); c2[15] = CAND(4, 2);
    sort16_desc(c2); merge16_desc(best, c2);
    c3[0] = CAND(3, 0); c3[1] = CAND(3, 1); c3[2] = CAND(3, 2); c3[3] = CAND(3, 3); c3[4] = CAND(5, 0); c3[5] = CAND(5, 1); c3[6] = CAND(6, 0); c3[7] = CAND(6, 1);
    c3[8] = CAND(7, 0); c3[9] = CAND(7, 1); c3[10] = CAND(8, 0); c3[11] = CAND(9, 0); c3[12] = CAND(10, 0); c3[13] = CAND(11, 0); c3[14] = CAND(12, 0); c3[15] = CAND(13, 0);
    sort16_desc(c3); merge16_desc(best, c3);
    ins16(best, CAND(14, 0)); ins16(best, CAND(15, 0));
#undef CAND
#pragma unroll
    for (int j = 0; j < 16; ++j) { lds_lane[j] = __uint_as_float(__float_as_uint(L1[j]) & 0x7Fu); lds_lane[16 + j] = __uint_as_float(__float_as_uint(L2[j]) & 0x7Fu); }
    asm volatile("s_waitcnt lgkmcnt(0)" ::: "memory");
    float wsum = 0.f, w[16]; int ei[16];
    const float mx = best[0];
#pragma unroll
    for (int k = 0; k < 16; ++k) { const unsigned code = __float_as_uint(best[k]) & 0xFFu; const int i = (int)(code >> 4), j = (int)(code & 15u);
        const int i1 = (int)__float_as_uint(lds_lane[i]), i2 = (int)__float_as_uint(lds_lane[16 + j]); ei[k] = i1 * NKEYS + i2;
        w[k] = __expf(best[k] - mx); wsum += w[k]; }
    const float inv = 1.0f / wsum;
    if (g == 0) { int* ip = PIDX + (long)(t0 + r32) * 128 + h * 16; float* wp = PW + (long)(t0 + r32) * 128 + h * 16;
#pragma unroll
        for (int k = 0; k < 16; k += 4) { *reinterpret_cast<int4*>(ip + k) = make_int4(ei[k], ei[k + 1], ei[k + 2], ei[k + 3]);
            *reinterpret_cast<float4*>(wp + k) = make_float4(w[k] * inv, w[k + 1] * inv, w[k + 2] * inv, w[k + 3] * inv); } }
}

__device__ __forceinline__ float gelu_exact(float x) { return 0.5f * x * (1.0f + erff(x * 0.70710678118654752f)); }

__device__ __forceinline__ void dec16(const u32x4 w, f32x2 (&f)[8]) {
    f[0] = __builtin_amdgcn_cvt_pk_f32_fp8((int)w.x, false); f[1] = __builtin_amdgcn_cvt_pk_f32_fp8((int)w.x, true);
    f[2] = __builtin_amdgcn_cvt_pk_f32_fp8((int)w.y, false); f[3] = __builtin_amdgcn_cvt_pk_f32_fp8((int)w.y, true);
    f[4] = __builtin_amdgcn_cvt_pk_f32_fp8((int)w.z, false); f[5] = __builtin_amdgcn_cvt_pk_f32_fp8((int)w.z, true);
    f[6] = __builtin_amdgcn_cvt_pk_f32_fp8((int)w.w, false); f[7] = __builtin_amdgcn_cvt_pk_f32_fp8((int)w.w, true);
}
__device__ __forceinline__ void gather_token(const bf16_t* __restrict__ H, const unsigned char* __restrict__ PU, const unsigned char* __restrict__ PV, const float* __restrict__ SU, const float* __restrict__ SV,
                                             const int* __restrict__ PIDX, const float* __restrict__ PW, float* __restrict__ X, const float* __restrict__ gate  , int t, int lane) {
    f32x2 xf[2][8];
#pragma unroll
    for (int hlf = 0; hlf < 2; ++hlf)
#pragma unroll
        for (int q = 0; q < 2; ++q) { const u32x4 w = *reinterpret_cast<const u32x4*>(H + (long)t * DM + 1024 * hlf + 16 * lane + 8 * q);
            xf[hlf][4 * q + 0] = (f32x2){bflo(w.x), bfhi(w.x)}; xf[hlf][4 * q + 1] = (f32x2){bflo(w.y), bfhi(w.y)}; xf[hlf][4 * q + 2] = (f32x2){bflo(w.z), bfhi(w.z)}; xf[hlf][4 * q + 3] = (f32x2){bflo(w.w), bfhi(w.w)}; }
    f32x2 out[2][8];
#pragma unroll
    for (int hlf = 0; hlf < 2; ++hlf)
#pragma unroll
        for (int i = 0; i < 8; ++i) out[hlf][i] = (f32x2){0.f, 0.f};
    const int myidx0 = PIDX[(long)t * 128 + lane], myidx1 = PIDX[(long)t * 128 + 64 + lane];
    const float myw0 = PW[(long)t * 128 + lane], myw1 = PW[(long)t * 128 + 64 + lane];
    const float msu0 = SU[myidx0], msu1 = SU[myidx1], msv0 = SV[myidx0], msv1 = SV[myidx1];
    for (int hk = 0; hk < 128; hk += 4) {
        const int src = hk & 63; const bool lo = hk < 64;
        const int selidx = lo ? myidx0 : myidx1; const int selw = __float_as_int(lo ? myw0 : myw1), selsu = __float_as_int(lo ? msu0 : msu1), selsv = __float_as_int(lo ? msv0 : msv1);
        int e[4]; float g[4], su[4], sv[4];
#pragma unroll
        for (int k = 0; k < 4; ++k) { e[k] = __builtin_amdgcn_readlane(selidx, src + k); g[k] = __int_as_float(__builtin_amdgcn_readlane(selw, src + k));
            su[k] = __int_as_float(__builtin_amdgcn_readlane(selsu, src + k)); sv[k] = __int_as_float(__builtin_amdgcn_readlane(selsv, src + k)); }
        u32x4 uw[4][2], vw[4][2];
#pragma unroll
        for (int k = 0; k < 4; ++k) { uw[k][0] = *reinterpret_cast<const u32x4*>(PU + ((long)(lane >> 3) * NEXP + e[k]) * 128 + 16 * (lane & 7)); uw[k][1] = *reinterpret_cast<const u32x4*>(PU + ((long)(8 + (lane >> 3)) * NEXP + e[k]) * 128 + 16 * (lane & 7)); }
#pragma unroll
        for (int k = 0; k < 4; ++k) { { const u32x2 a0 = *reinterpret_cast<const u32x2*>(PV + ((long)(2 * lane) * NEXP + e[k]) * 8), a1 = *reinterpret_cast<const u32x2*>(PV + ((long)(2 * lane + 1) * NEXP + e[k]) * 8);
              const u32x2 b0 = *reinterpret_cast<const u32x2*>(PV + ((long)(128 + 2 * lane) * NEXP + e[k]) * 8), b1 = *reinterpret_cast<const u32x2*>(PV + ((long)(129 + 2 * lane) * NEXP + e[k]) * 8);
              vw[k][0] = (u32x4){a0.x, a0.y, a1.x, a1.y}; vw[k][1] = (u32x4){b0.x, b0.y, b1.x, b1.y}; } }
        float a[4];
#pragma unroll
        for (int k = 0; k < 4; ++k) { f32x2 d = (f32x2){0.f, 0.f};
#pragma unroll
            for (int hlf = 0; hlf < 2; ++hlf) { f32x2 f[8]; dec16(uw[k][hlf], f);
#pragma unroll
                for (int i = 0; i < 8; ++i) d = __builtin_elementwise_fma(f[i], xf[hlf][i], d); }
            a[k] = wave_sum(d[0] + d[1]); }
#pragma unroll
        for (int k = 0; k < 4; ++k) { const float ak = g[k] * gelu_exact(a[k] * su[k]) * sv[k]; const f32x2 a2 = (f32x2){ak, ak};
#pragma unroll
            for (int hlf = 0; hlf < 2; ++hlf) { f32x2 f[8]; dec16(vw[k][hlf], f);
#pragma unroll
                for (int i = 0; i < 8; ++i) out[hlf][i] = __builtin_elementwise_fma(f[i], a2, out[hlf][i]); } }
    }
    const float* gr = gate + (long)cond_row(t) * 12288;
#pragma unroll
    for (int hlf = 0; hlf < 2; ++hlf)
#pragma unroll
        for (int q = 0; q < 4; ++q) { const int c = 1024 * hlf + 16 * lane + 4 * q; float* xp = X + (long)t * DM + c;
            const f32x4 gv = *reinterpret_cast<const f32x4*>(gr + c); f32x4 xv = *reinterpret_cast<const f32x4*>(xp);
            xv[0] += gv[0] * out[hlf][2 * q][0]; xv[1] += gv[1] * out[hlf][2 * q][1]; xv[2] += gv[2] * out[hlf][2 * q + 1][0]; xv[3] += gv[3] * out[hlf][2 * q + 1][1];
            *reinterpret_cast<f32x4*>(xp) = xv; }
}

constexpr int SW = 128, NSL = DM / SW;
struct XInfo { int rank, xi, nx, nloc; };
__device__ __forceinline__ void upass(const bf16_t* __restrict__ H, const unsigned char* __restrict__ PU, const int* __restrict__ PIDX, const float* __restrict__ PW, const float* __restrict__ SU, const float* __restrict__ SV,
                                      float* __restrict__ DOTP, unsigned* __restrict__ PACKT, const XInfo xin, int wid, int lane) {
    const int g = lane >> 3, c = lane & 7; const int nwv = xin.nloc * 8;
    const int tlo = (int)((long)T * xin.xi / xin.nx), thi = (int)((long)T * (xin.xi + 1) / xin.nx); const int wv = tlo + xin.rank * 8 + wid;
    float* dp = DOTP;
    for (int s = 0; s < NSL; ++s) { const bool first = (s == 0), lastS = (s == NSL - 1);
        const __amdgpu_buffer_rsrc_t urs = __builtin_amdgcn_make_buffer_rsrc((void*)(PU + (long)s * NEXP * SW), 0, NEXP * SW, 0x00020000);
#define UP_ROW(e_) __builtin_bit_cast(u32x4, __builtin_amdgcn_raw_buffer_load_b128(urs, (e_) * SW + 16 * c, 0, 0))
#define UP_IDX(tt, q4) (*reinterpret_cast<const int4*>(PIDX + (long)(tt) * 128 + 16 * g + 4 * (q4)))
#define UP_X(tt, q2) (*reinterpret_cast<const u32x4*>(H + (long)(tt) * DM + SW * s + 16 * c + 8 * (q2)))
        if (wv >= thi) continue;
        u32x4 A[8], B[8]; int4 en[4]; u32x4 xn[2];
        { int4 e0[4];
#pragma unroll
          for (int q4 = 0; q4 < 4; ++q4) e0[q4] = UP_IDX(wv, q4);
          A[0] = UP_ROW(e0[0].x); A[1] = UP_ROW(e0[0].y); A[2] = UP_ROW(e0[0].z); A[3] = UP_ROW(e0[0].w); A[4] = UP_ROW(e0[1].x); A[5] = UP_ROW(e0[1].y); A[6] = UP_ROW(e0[1].z); A[7] = UP_ROW(e0[1].w);
          B[0] = UP_ROW(e0[2].x); B[1] = UP_ROW(e0[2].y); B[2] = UP_ROW(e0[2].z); B[3] = UP_ROW(e0[2].w); B[4] = UP_ROW(e0[3].x); B[5] = UP_ROW(e0[3].y); B[6] = UP_ROW(e0[3].z); B[7] = UP_ROW(e0[3].w);
          const int t1 = (wv + nwv < thi) ? wv + nwv : wv;
#pragma unroll
          for (int q4 = 0; q4 < 4; ++q4) en[q4] = UP_IDX(t1, q4);
          xn[0] = UP_X(wv, 0); xn[1] = UP_X(wv, 1); }
#pragma unroll 1
        for (int t = wv; t < thi; t += nwv) {
            const int tn = (t + nwv < thi) ? t + nwv : t, tnn = (tn + nwv < thi) ? tn + nwv : tn;
            f32x2 xf[8];
#pragma unroll
            for (int q2 = 0; q2 < 2; ++q2) { const u32x4 hw = xn[q2];
                xf[4 * q2 + 0] = (f32x2){bflo(hw.x), bfhi(hw.x)}; xf[4 * q2 + 1] = (f32x2){bflo(hw.y), bfhi(hw.y)}; xf[4 * q2 + 2] = (f32x2){bflo(hw.z), bfhi(hw.z)}; xf[4 * q2 + 3] = (f32x2){bflo(hw.w), bfhi(hw.w)}; }
            xn[0] = UP_X(tn, 0); xn[1] = UP_X(tn, 1);
            float d[16];
#pragma unroll
            for (int i = 0; i < 8; ++i) { f32x2 f[8]; dec16(A[i], f); f32x2 a = (f32x2){0.f, 0.f};
#pragma unroll
                for (int k = 0; k < 8; ++k) a = __builtin_elementwise_fma(f[k], xf[k], a);
                d[i] = a[0] + a[1]; }
            A[0] = UP_ROW(en[0].x); A[1] = UP_ROW(en[0].y); A[2] = UP_ROW(en[0].z); A[3] = UP_ROW(en[0].w); A[4] = UP_ROW(en[1].x); A[5] = UP_ROW(en[1].y); A[6] = UP_ROW(en[1].z); A[7] = UP_ROW(en[1].w);
#pragma unroll
            for (int i = 0; i < 8; ++i) { f32x2 f[8]; dec16(B[i], f); f32x2 a = (f32x2){0.f, 0.f};
#pragma unroll
                for (int k = 0; k < 8; ++k) a = __builtin_elementwise_fma(f[k], xf[k], a);
                d[8 + i] = a[0] + a[1]; }
            B[0] = UP_ROW(en[2].x); B[1] = UP_ROW(en[2].y); B[2] = UP_ROW(en[2].z); B[3] = UP_ROW(en[2].w); B[4] = UP_ROW(en[3].x); B[5] = UP_ROW(en[3].y); B[6] = UP_ROW(en[3].z); B[7] = UP_ROW(en[3].w);
#pragma unroll
            for (int q4 = 0; q4 < 4; ++q4) en[q4] = UP_IDX(tnn, q4);
            float r8[8], r4[4], r2[2];
#pragma unroll
            for (int k = 0; k < 8; ++k) { const float keep = (c & 4) ? d[k + 8] : d[k], send = (c & 4) ? d[k] : d[k + 8]; r8[k] = keep + sx<4>(send); }
#pragma unroll
            for (int k = 0; k < 4; ++k) { const float keep = (c & 2) ? r8[k + 4] : r8[k], send = (c & 2) ? r8[k] : r8[k + 4]; r4[k] = keep + sx<2>(send); }
#pragma unroll
            for (int k = 0; k < 2; ++k) { const float keep = (c & 1) ? r4[k + 2] : r4[k], send = (c & 1) ? r4[k] : r4[k + 2]; r2[k] = keep + sx<1>(send); }
            float* o = dp + (long)t * 128 + 16 * g + 2 * c;
            f32x2 acc = (f32x2){r2[0], r2[1]};
            if (!first) acc += *reinterpret_cast<const f32x2*>(o);
            if (!lastS) *reinterpret_cast<f32x2*>(o) = acc;
            else {
                const int p0 = 16 * g + 2 * c; const int2 ee = *reinterpret_cast<const int2*>(PIDX + (long)t * 128 + p0); const f32x2 gw = *reinterpret_cast<const f32x2*>(PW + (long)t * 128 + p0);
                const float a0 = gw[0] * gelu_exact(acc[0] * SU[ee.x]) * SV[ee.x], a1 = gw[1] * gelu_exact(acc[1] * SU[ee.y]) * SV[ee.y];
                u32x2 pk; pk.x = (cvt_pk_bf16(0.f, a0) & 0xffff0000u) | (unsigned)ee.x; pk.y = (cvt_pk_bf16(0.f, a1) & 0xffff0000u) | (unsigned)ee.y;
                *reinterpret_cast<u32x2*>(PACKT + ((long)(p0 >> 2) * T + t) * 4 + (p0 & 3)) = pk; }
        }
#undef UP_ROW
#undef UP_IDX
#undef UP_X
    }
}
__device__ __forceinline__ void actpass(const float* __restrict__ DOTP, const int* __restrict__ PIDX, const float* __restrict__ PW, const float* __restrict__ SU, const float* __restrict__ SV, float* __restrict__ ACT, int nx, long gt, long nt) {
    for (long i = gt; i < (long)T * 128; i += nt) { float dsum = 0.f;
        for (int x = 0; x < nx; ++x) dsum += DOTP[(long)x * T * 128 + i];
        const int e = PIDX[i]; const float av = PW[i] * gelu_exact(dsum * SU[e]) * SV[e]; const long t = i >> 7; const int pp = (int)(i & 127);
        reinterpret_cast<unsigned*>(ACT)[((long)(pp >> 2) * T + t) * 4 + (pp & 3)] = (cvt_pk_bf16(0.f, av) & 0xffff0000u) | (unsigned)e; }
}
__device__ __forceinline__ void vpass(const unsigned char* __restrict__ PV, const int* __restrict__ PIDX, const float* __restrict__ ACT, float* __restrict__ X, const float* __restrict__ gate, const XInfo xin, int wid, int lane) {
    const int g = lane >> 3, c = lane & 7; const int wv = xin.rank * 8 + wid, nwv = xin.nloc * 8;
    for (int s = xin.xi; s < NSL; s += xin.nx) {
        int4 en[4]; f32x4 an[4];
#pragma unroll
        for (int q4 = 0; q4 < 4; ++q4) { en[q4] = *reinterpret_cast<const int4*>(PIDX + (long)(wv < T ? wv : 0) * 128 + 16 * g + 4 * q4); an[q4] = *reinterpret_cast<const f32x4*>(ACT + (long)(wv < T ? wv : 0) * 128 + 16 * g + 4 * q4); }
        for (int t = wv; t < T; t += nwv) {
            int e[16]; float a[16];
#pragma unroll
            for (int q4 = 0; q4 < 4; ++q4) { e[4 * q4] = en[q4].x; e[4 * q4 + 1] = en[q4].y; e[4 * q4 + 2] = en[q4].z; e[4 * q4 + 3] = en[q4].w; a[4 * q4] = an[q4][0]; a[4 * q4 + 1] = an[q4][1]; a[4 * q4 + 2] = an[q4][2]; a[4 * q4 + 3] = an[q4][3]; }
            u32x4 w[16];
#pragma unroll
            for (int i = 0; i < 16; ++i) w[i] = *reinterpret_cast<const u32x4*>(PV + ((long)s * NEXP + e[i]) * SW + 16 * c);
            { const int tn = (t + nwv < T) ? t + nwv : t;
#pragma unroll
              for (int q4 = 0; q4 < 4; ++q4) { en[q4] = *reinterpret_cast<const int4*>(PIDX + (long)tn * 128 + 16 * g + 4 * q4); an[q4] = *reinterpret_cast<const f32x4*>(ACT + (long)tn * 128 + 16 * g + 4 * q4); } }
            f32x2 o[8];
#pragma unroll
            for (int k = 0; k < 8; ++k) o[k] = (f32x2){0.f, 0.f};
#pragma unroll
            for (int i = 0; i < 16; ++i) { f32x2 f[8]; dec16(w[i], f); const f32x2 a2 = (f32x2){a[i], a[i]};
#pragma unroll
                for (int k = 0; k < 8; ++k) o[k] = __builtin_elementwise_fma(f[k], a2, o[k]); }
            f32x2 r4[4], r2[2], r1;
#pragma unroll
            for (int k = 0; k < 4; ++k) { const f32x2 keep = (g & 4) ? o[k + 4] : o[k], send = (g & 4) ? o[k] : o[k + 4]; r4[k] = keep + (f32x2){sx<32>(send[0]), sx<32>(send[1])}; }
#pragma unroll
            for (int k = 0; k < 2; ++k) { const f32x2 keep = (g & 2) ? r4[k + 2] : r4[k], send = (g & 2) ? r4[k] : r4[k + 2]; r2[k] = keep + (f32x2){sx<16>(send[0]), sx<16>(send[1])}; }
            { const f32x2 keep = (g & 1) ? r2[1] : r2[0], send = (g & 1) ? r2[0] : r2[1]; r1 = keep + (f32x2){sx<8>(send[0]), sx<8>(send[1])}; }
            const int col = SW * s + 16 * c + 2 * g;
            const f32x2 gv = *reinterpret_cast<const f32x2*>(gate + (long)cond_row(t) * 12288 + col);
            float* xp = X + (long)t * DM + col; f32x2 xv = *reinterpret_cast<const f32x2*>(xp);
            xv += gv * r1; *reinterpret_cast<f32x2*>(xp) = xv;
        }
    }
}

__device__ __forceinline__ void vpass_lds(const unsigned char* __restrict__ PV, const unsigned* __restrict__ PACKT, float* __restrict__ X, const float* __restrict__ gate, char* lds, int bid, int nb, int s_end, int tid) {
    const int wid = tid >> 6, lane = tid & 63;
    for (int s = bid; s < s_end; s += nb) {
        __syncthreads();
        { const u32x4* src = reinterpret_cast<const u32x4*>(PV + (long)s * NEXP * 8); u32x4* dst = reinterpret_cast<u32x4*>(lds);
#pragma unroll 4
          for (int i = tid; i < NEXP * 8 / 16; i += 512) dst[i] = src[i]; }
        __syncthreads();
        u32x4 h0[8], h1[8];
        const __amdgpu_buffer_rsrc_t vrs = __builtin_amdgcn_make_buffer_rsrc((void*)PACKT, 0, (int)((size_t)T * 128 * 4), 0x00020000);
#define VP_LD(k, toff) __builtin_bit_cast(u32x4, __builtin_amdgcn_raw_buffer_load_b128(vrs, (int)(toff), (int)((size_t)(k) * T * 16), 0))
        { const unsigned toff = (unsigned)(wid * 64 + lane) * 16u;
#pragma unroll
          for (int k = 0; k < 8; ++k) h0[k] = VP_LD(k, toff);
#pragma unroll
          for (int k = 0; k < 8; ++k) h1[k] = VP_LD(8 + k, toff); }
#define VP_STEP(HB) do { _Pragma("unroll") for (int kk = 0; kk < 8; kk += 2) { unsigned pw[8]; \
            _Pragma("unroll") for (int k = 0; k < 2; ++k) { pw[4 * k] = HB[kk + k].x; pw[4 * k + 1] = HB[kk + k].y; pw[4 * k + 2] = HB[kk + k].z; pw[4 * k + 3] = HB[kk + k].w; } \
            u32x2 w[8]; \
            _Pragma("unroll") for (int k = 0; k < 8; ++k) w[k] = *reinterpret_cast<const u32x2*>(lds + (pw[k] & 0xffffu) * 8u); \
            _Pragma("unroll") for (int k = 0; k < 8; ++k) { const float a = __uint_as_float(pw[k] & 0xffff0000u); \
                const f32x2 f0 = __builtin_amdgcn_cvt_pk_f32_fp8((int)w[k].x, false), f1 = __builtin_amdgcn_cvt_pk_f32_fp8((int)w[k].x, true), f2 = __builtin_amdgcn_cvt_pk_f32_fp8((int)w[k].y, false), f3 = __builtin_amdgcn_cvt_pk_f32_fp8((int)w[k].y, true); \
                acc[0] = fmaf(a, f0[0], acc[0]); acc[1] = fmaf(a, f0[1], acc[1]); acc[2] = fmaf(a, f1[0], acc[2]); acc[3] = fmaf(a, f1[1], acc[3]); \
                acc[4] = fmaf(a, f2[0], acc[4]); acc[5] = fmaf(a, f2[1], acc[5]); acc[6] = fmaf(a, f3[0], acc[6]); acc[7] = fmaf(a, f3[1], acc[7]); } } } while (0)
#pragma unroll 1
        for (int tg = wid; tg < T / 64; tg += 8) { const int t = tg * 64 + lane; const int tgn = (tg + 8 < T / 64) ? tg + 8 : tg;
            const unsigned toff = (unsigned)t * 16u, toffn = (unsigned)(tgn * 64 + lane) * 16u;
            float acc[8];
#pragma unroll
            for (int j = 0; j < 8; ++j) acc[j] = 0.f;
            VP_STEP(h0);
#pragma unroll
            for (int k = 0; k < 8; ++k) h0[k] = VP_LD(16 + k, toff);
            VP_STEP(h1);
#pragma unroll
            for (int k = 0; k < 8; ++k) h1[k] = VP_LD(24 + k, toff);
            VP_STEP(h0);
#pragma unroll
            for (int k = 0; k < 8; ++k) h0[k] = VP_LD(k, toffn);
            VP_STEP(h1);
#pragma unroll
            for (int k = 0; k < 8; ++k) h1[k] = VP_LD(8 + k, toffn);
            const float* gr = gate + (long)cond_row(t) * 12288 + 8 * s; float* xp = X + (long)t * DM + 8 * s;
            const f32x4 g0 = *reinterpret_cast<const f32x4*>(gr), g1 = *reinterpret_cast<const f32x4*>(gr + 4);
            f32x4 x0 = *reinterpret_cast<const f32x4*>(xp), x1 = *reinterpret_cast<const f32x4*>(xp + 4);
            x0[0] += g0[0] * acc[0]; x0[1] += g0[1] * acc[1]; x0[2] += g0[2] * acc[2]; x0[3] += g0[3] * acc[3];
            x1[0] += g1[0] * acc[4]; x1[1] += g1[1] * acc[5]; x1[2] += g1[2] * acc[6]; x1[3] += g1[3] * acc[7];
            *reinterpret_cast<f32x4*>(xp) = x0; *reinterpret_cast<f32x4*>(xp + 4) = x1; }
#undef VP_STEP
#undef VP_LD
    }
    __syncthreads();
}
}
namespace ph {
__device__ __forceinline__ int gwave() { return obid() * 8 + (otid() >> 6); }
__device__ __forceinline__ int nwaves() { return ogrid() * 8; }
__device__ __forceinline__ long gthread() { return (long)obid() * 512 + otid(); }
__device__ __forceinline__ long nthreads() { return (long)ogrid() * 512; }

__device__ __forceinline__ void transpose_tile(const float* __restrict__ src, int C, int r0, int c0, bf16_t* __restrict__ dst, long dpitch, float* tile) {
    const int tid = otid();
#pragma unroll
    for (int i = 0; i < 8; ++i) { const int idx = tid + 512 * i, r = idx >> 6, c = idx & 63; tile[r * 65 + c] = src[(long)(r0 + r) * C + c0 + c]; }
    __syncthreads();
    { const int c = tid >> 3, rc = (tid & 7) * 8; float f[8];
#pragma unroll
      for (int j = 0; j < 8; ++j) f[j] = tile[(rc + j) * 65 + c];
      *reinterpret_cast<u32x4*>(dst + (long)(c0 + c) * dpitch + r0 + rc) = pack8(f); }
    __syncthreads();
}

__device__ __forceinline__ void zero_chunks(bf16_t* base, long nrows, long rowpitch, int col0, int nchunk) {
    const long total = nrows * nchunk;
    for (long i = gthread(); i < total; i += nthreads()) { const long r = i / nchunk; const int ch = (int)(i % nchunk);
        *reinterpret_cast<u32x4*>(base + r * rowpitch + col0 + ch * 8) = (u32x4){0u, 0u, 0u, 0u}; }
}

__device__ __forceinline__ void prologue(KParams& p, char* lds) {
    unsigned char* ws = optr(gp(p.ws)); const int tid = otid();
    float* tile = (float*)lds;
    { struct TJob { const float* src; bf16_t* dst; int R, C, r0, c0, perm; };
      auto decode = [&](int it) { TJob j; j.perm = 0; const int l = it / 10656; int r = it % 10656;
        if (r < 5664) { j.src = gp(p.w_in) + (long)l * DM * INW; j.R = DM; j.C = INW; j.dst = (bf16_t*)(ws + WS_WIN) + (long)l * INWP * DM; }
        else if (r < 6048) { r -= 5664; j.src = gp(p.w_uq) + (long)l * 512 * 3072; j.R = 512; j.C = 3072; j.dst = (bf16_t*)(ws + WS_WUQ) + (long)l * 3072 * 512; j.perm = 1; }
        else if (r < 6560) { r -= 6048; j.src = gp(p.w_ukv) + (long)l * 512 * 4096; j.R = 512; j.C = 4096; j.dst = (bf16_t*)(ws + WS_WUKV) + (long)l * 4096 * 512; }
        else { r -= 6560; const int m = r >> 10; r &= 1023; j.R = DM; j.C = DM;
            j.src = (m == 0 ? gp(p.w_a) : m == 1 ? gp(p.w_b) : m == 2 ? gp(p.w_o) : gp(p.w_pq)) + (long)l * DM * DM;
            j.dst = (bf16_t*)(ws + (m == 0 ? WS_WA : m == 1 ? WS_WB : m == 2 ? WS_WO : WS_WPQ)) + (long)l * DM * DM; }
        const int ntc = j.C / 64; j.r0 = (r / ntc) * 64; j.c0 = (r % ntc) * 64; return j; };
      const int NTILES = 2 * 10656, G_ = ogrid(); int it = obid(); float v[8]; TJob cur{};
      if (it < NTILES) { cur = decode(it);
#pragma unroll
        for (int i = 0; i < 8; ++i) { const int idx = tid + 512 * i, r = idx >> 6, c = idx & 63; v[i] = cur.src[(long)(cur.r0 + r) * cur.C + cur.c0 + c]; } }
      while (it < NTILES) { const int itn = it + G_; float vn[8]; TJob nxt{};
        if (itn < NTILES) { nxt = decode(itn);
#pragma unroll
            for (int i = 0; i < 8; ++i) { const int idx = tid + 512 * i, r = idx >> 6, c = idx & 63; vn[i] = nxt.src[(long)(nxt.r0 + r) * nxt.C + nxt.c0 + c]; } }
#pragma unroll
        for (int i = 0; i < 8; ++i) { const int idx = tid + 512 * i, r = idx >> 6, c = idx & 63; tile[r * 65 + c] = v[i]; }
        __syncthreads();
        { const int c = tid >> 3, rc = (tid & 7) * 8; float f[8];
#pragma unroll
          for (int jj = 0; jj < 8; ++jj) f[jj] = tile[(rc + jj) * 65 + c];
          int drow = cur.c0 + c;
          if (cur.perm) { const int gq = drow / 768, o = drow - 768 * gq, hh = o / 192, w = o - 192 * hh;
              drow = 768 * gq + (w < 128 ? 128 * hh + w : (w < 160 ? 512 + 32 * hh + (w - 128) : 640 + 32 * hh + (w - 160))); }
          *reinterpret_cast<u32x4*>(cur.dst + (long)drow * cur.R + cur.r0 + rc) = pack8(f); }
        __syncthreads();
#pragma unroll
        for (int i = 0; i < 8; ++i) v[i] = vn[i];
        cur = nxt; it = itn; } }
    for (long i = gthread(); i < 2L * 16 * 512 * 32; i += nthreads()) { const int ch = (int)(i & 31); const long row = i >> 5; const int c = (int)(row & 511), h = (int)((row >> 9) & 15), l = (int)(row >> 13);
        u32x4 w = (u32x4){0u, 0u, 0u, 0u};
        if (ch < 16) { const float* s = gp(p.w_ukv) + (((long)l * 512 + c) * 16 + h) * 256 + ch * 8; float f[8];
#pragma unroll
            for (int j = 0; j < 8; ++j) f[j] = s[j];
            w = pack8(f); }
        *reinterpret_cast<u32x4*>((bf16_t*)(ws + WS_WUK) + row * 256 + ch * 8) = w; }
    for (long i = gthread(); i < 2L * 4096; i += nthreads()) { const bool second = i >= 4096; const long j8 = (second ? i - 4096 : i) * 8; const float* s = (second ? gp(p.peer_k2) : gp(p.peer_k1)) + j8; float f[8];
#pragma unroll
        for (int j = 0; j < 8; ++j) f[j] = s[j];
        *reinterpret_cast<u32x4*>((bf16_t*)(ws + (second ? WS_PK2 : WS_PK1)) + j8) = pack8(f); }
    for (int l = 0; l < 2; ++l) zero_chunks((bf16_t*)(ws + WS_WIN) + ((long)l * INWP + INW) * DM, INWP - INW, DM, 0, DM / 8);
    for (int b = 0; b < DB; ++b) zero_chunks((bf16_t*)(ws + WS_CKA) + ((long)b * KPAD + KALL) * QLD, KPAD - KALL, QLD, 0, QLD / 8);
    zero_chunks((bf16_t*)(ws + WS_CKA), (long)DB * KPAD, QLD, 576, 8);
    zero_chunks((bf16_t*)(ws + WS_CKT), (long)DB * 512, KPAD, KALL, (KPAD - KALL) / 8);
    zero_chunks((bf16_t*)(ws + WS_QL), (long)DB * 1024, QLD, 576, 8);
    for (long i = gthread(); i < 4096L * 96; i += nthreads()) { const int pos = (int)(i / 96), k = (int)(i % 96); const bool big = k >= 32; const int fi = big ? k - 32 : k; const float d = big ? 128.f : 64.f;
        const float inv = __builtin_amdgcn_exp2f(-(2.0f * (float)fi / d) * 13.287712379549449f);
        const float ang = (float)pos * inv; double rv = (double)ang * 0.15915494309189535; rv -= floor(rv); const float fr = (float)rv;
        float* dst = big ? (float*)(ws + WS_TAB128) + ((long)pos * 64 + fi) * 2 : (float*)(ws + WS_TAB64) + ((long)pos * 32 + fi) * 2;
        dst[0] = __builtin_amdgcn_cosf(fr); dst[1] = __builtin_amdgcn_sinf(fr); }
    { float* sc = (float*)lds;
      for (int it = obid(); it < 2 * 12 * 8; it += ogrid()) { const int l = it / 96, cc = (it % 96) / 8, ks = it % 8;
        __syncthreads();
        for (int i = tid; i < NCOND * 256; i += 512) { const int r = i >> 8, k = i & 255; const float c = r < NB ? gp(p.c_prompt)[(long)r * DM + ks * 256 + k] : gp(p.c_sample)[(long)(r - NB) * DM + ks * 256 + k]; sc[i] = siluf_(c); }
        __syncthreads();
        float a0[NCOND], a1[NCOND];
#pragma unroll
        for (int r = 0; r < NCOND; ++r) { a0[r] = 0.f; a1[r] = 0.f; }
        const float* wp = gp(p.w_ada) + ((long)l * DM + ks * 256) * 12288 + cc * 1024 + 2 * tid;
#pragma unroll 1
        for (int k = 0; k < 256; k += 4) { const f32x2 w0 = *reinterpret_cast<const f32x2*>(wp), w1 = *reinterpret_cast<const f32x2*>(wp + 12288), w2 = *reinterpret_cast<const f32x2*>(wp + 2 * 12288), w3 = *reinterpret_cast<const f32x2*>(wp + 3 * 12288);
            wp += 4 * 12288;
#pragma unroll
            for (int r = 0; r < NCOND; ++r) { const f32x4 s = *reinterpret_cast<const f32x4*>(sc + r * 256 + k);
                a0[r] = fmaf(s[0], w0[0], fmaf(s[1], w1[0], fmaf(s[2], w2[0], fmaf(s[3], w3[0], a0[r]))));
                a1[r] = fmaf(s[0], w0[1], fmaf(s[1], w1[1], fmaf(s[2], w2[1], fmaf(s[3], w3[1], a1[r]))));
                if ((r % 6) == 5) __builtin_amdgcn_sched_barrier(0); } }
        float* dst = (float*)(ws + WS_ADAP) + (((long)ks * 2 + l) * NCOND) * 12288 + cc * 1024 + 2 * tid;
#pragma unroll
        for (int r = 0; r < NCOND; ++r) *reinterpret_cast<f32x2*>(dst + (long)r * 12288) = (f32x2){a0[r], a1[r]}; }
      __syncthreads(); }
}

__device__ __forceinline__ void wpq_int8(KParams& p) {
    unsigned char* ws = optr(gp(p.ws)); const int lane = otid() & 63;
    for (int r = gwave(); r < 2 * DM; r += nwaves()) { const bf16_t* src = (const bf16_t*)(ws + WS_WPQ) + (long)r * DM; float f[4][8]; float am = 0.f;
#pragma unroll
        for (int j = 0; j < 4; ++j) { unpack8(*reinterpret_cast<const u32x4*>(src + 512 * j + 8 * lane), f[j]);
#pragma unroll
            for (int i = 0; i < 8; ++i) am = fmaxf(am, fabsf(f[j][i])); }
        am = wave_max(am); const float qs = am > 0.f ? 127.0f / am : 0.f;
#pragma unroll
        for (int j = 0; j < 4; ++j) { unsigned w2[2];
#pragma unroll
            for (int hh = 0; hh < 2; ++hh) { unsigned w = 0u;
#pragma unroll
                for (int i = 0; i < 4; ++i) w |= ((unsigned)((int)__builtin_rintf(f[j][4 * hh + i] * qs) & 0xff)) << (8 * i);
                w2[hh] = w; }
            *reinterpret_cast<u32x2*>(ws + WS_WPQ8 + (long)r * DM + 512 * j + 8 * lane) = (u32x2){w2[0], w2[1]}; }
        if (lane == 0) ((float*)(ws + WS_SB8))[r] = am * (1.0f / 127.0f); }
}

__device__ __forceinline__ void wb_int8(KParams& p, int l) {
    unsigned char* ws = optr(gp(p.ws)); const int lane = otid() & 63;
    for (int r = gwave(); r < DM; r += nwaves()) { const bf16_t* src = (const bf16_t*)(ws + WS_WB) + ((long)l * DM + r) * DM; float f[4][8]; float am = 0.f;
#pragma unroll
        for (int j = 0; j < 4; ++j) { unpack8(*reinterpret_cast<const u32x4*>(src + 512 * j + 8 * lane), f[j]);
#pragma unroll
            for (int i = 0; i < 8; ++i) am = fmaxf(am, fabsf(f[j][i])); }
        am = wave_max(am); const float qs = am > 0.f ? 127.0f / am : 0.f;
#pragma unroll
        for (int j = 0; j < 4; ++j) { unsigned w2[2];
#pragma unroll
            for (int hh = 0; hh < 2; ++hh) { unsigned w = 0u;
#pragma unroll
                for (int i = 0; i < 4; ++i) w |= ((unsigned)((int)__builtin_rintf(f[j][4 * hh + i] * qs) & 0xff)) << (8 * i);
                w2[hh] = w; }
            *reinterpret_cast<u32x2*>(ws + WS_WB8 + (long)r * DM + 512 * j + 8 * lane) = (u32x2){w2[0], w2[1]}; }
        if (lane == 0) ((float*)(ws + WS_SBB))[r] = am * (1.0f / 127.0f); }
}

__device__ __forceinline__ void win_int8(KParams& p, int l) {
    unsigned char* ws = optr(gp(p.ws)); const int lane = otid() & 63;
    for (int jr = gwave(); jr < NB8 * 256; jr += nwaves()) { const int blk = jr >> 8, n = (blk < 2 ? blk : (blk < 5 ? blk + 3 : blk + 16)) * 256 + (jr & 255);
        const bf16_t* src = (const bf16_t*)(ws + WS_WIN) + ((long)l * INWP + n) * DM; float f[4][8]; float am = 0.f;
#pragma unroll
        for (int j = 0; j < 4; ++j) { unpack8(*reinterpret_cast<const u32x4*>(src + 512 * j + 8 * lane), f[j]);
#pragma unroll
            for (int i = 0; i < 8; ++i) am = fmaxf(am, fabsf(f[j][i])); }
        am = wave_max(am); const float qs = am > 0.f ? 127.0f / am : 0.f;
#pragma unroll
        for (int j = 0; j < 4; ++j) { unsigned w2[2];
#pragma unroll
            for (int hh = 0; hh < 2; ++hh) { unsigned w = 0u;
#pragma unroll
                for (int i = 0; i < 4; ++i) w |= ((unsigned)((int)__builtin_rintf(f[j][4 * hh + i] * qs) & 0xff)) << (8 * i);
                w2[hh] = w; }
            *reinterpret_cast<u32x2*>(ws + WS_WIN8 + (long)jr * DM + 512 * j + 8 * lane) = (u32x2){w2[0], w2[1]}; }
        if (lane == 0) ((float*)(ws + WS_SBW))[n] = am * (1.0f / 127.0f); }
}

__device__ __forceinline__ void ada_reduce(KParams& p) {
    unsigned char* ws = optr(gp(p.ws)); const float* ap = (const float*)(ws + WS_ADAP); float* ad = (float*)(ws + WS_ADA); const long n = 2L * NCOND * 12288;
    for (long i = gthread(); i < n; i += nthreads()) { const int l = (int)(i / (NCOND * 12288L)); const int j = (int)(i % 12288);
        float s = gp(p.b_ada)[(long)l * 12288 + j];
#pragma unroll
        for (int ks = 0; ks < 8; ++ks) s += ap[(long)ks * n + i];
        ad[i] = s; }
}

__device__ __forceinline__ void modulate(KParams& p, int l, int which) {
    const int lane = otid() & 63; unsigned char* ws = optr(gp(p.ws)); const float* X = gp(p.out); bf16_t* H = (bf16_t*)(ws + WS_H);
    const float* g = (which ? gp(p.g_ffn) : gp(p.g_mix)) + (long)l * DM; const float* ada = (const float*)(ws + WS_ADA) + (long)l * NCOND * 12288 + (which ? 3 : 0) * DM;
    for (int t = gwave(); t < T; t += nwaves()) {
        const float* xr = (l == 0 && which == 0) ? (t < TP ? gp(p.x_prompt) + (long)t * DM : gp(p.x_sample) + (long)(t - TP) * DM) : X + (long)t * DM; f32x4 v[8]; float ss = 0.f;
#pragma unroll
        for (int j = 0; j < 8; ++j) { v[j] = *reinterpret_cast<const f32x4*>(xr + 256 * j + 4 * lane); ss += v[j][0] * v[j][0] + v[j][1] * v[j][1] + v[j][2] * v[j][2] + v[j][3] * v[j][3]; }
        ss = wave_sum(ss); const float rinv = rsqrtf(ss * (1.0f / DM) + EPS);
        const float* sh = ada + (long)cond_row(t) * 12288; const float* sc = sh + DM;
#pragma unroll
        for (int j = 0; j < 8; ++j) { const int c = 256 * j + 4 * lane; const f32x4 gv = *reinterpret_cast<const f32x4*>(g + c), sv = *reinterpret_cast<const f32x4*>(sc + c), hv = *reinterpret_cast<const f32x4*>(sh + c);
            const f32x4 y = v[j] * rinv * gv * (sv + 1.0f) + hv; u32x2 w; w.x = cvt_pk_bf16(y[0], y[1]); w.y = cvt_pk_bf16(y[2], y[3]);
            *reinterpret_cast<u32x2*>(H + (long)t * DM + c) = w; v[j] = y; }
        {
            float am = 0.f;
#pragma unroll
            for (int j = 0; j < 8; ++j) am = fmaxf(am, fmaxf(fmaxf(fabsf(v[j][0]), fabsf(v[j][1])), fmaxf(fabsf(v[j][2]), fabsf(v[j][3]))));
            am = wave_max(am); const float qs = am > 0.f ? 127.0f / am : 0.f;
#pragma unroll
            for (int j = 0; j < 8; ++j) { const int c = 256 * j + 4 * lane;
                const int q0 = (int)__builtin_rintf(v[j][0] * qs), q1 = (int)__builtin_rintf(v[j][1] * qs), q2 = (int)__builtin_rintf(v[j][2] * qs), q3 = (int)__builtin_rintf(v[j][3] * qs);
                *reinterpret_cast<unsigned*>(ws + WS_H8 + (long)t * DM + c) = (unsigned)(q0 & 0xff) | ((unsigned)(q1 & 0xff) << 8) | ((unsigned)(q2 & 0xff) << 16) | ((unsigned)(q3 & 0xff) << 24); }
            if (lane == 0) ((float*)(ws + WS_SA8))[t] = am * (1.0f / 127.0f); }
    }
}

__device__ __forceinline__ void cache_convert(KParams& p, int l, char* lds, int it0, int it1, int bidx, int nb) {
    const int tid = otid(); unsigned char* ws = optr(gp(p.ws)); float* tile = (float*)lds; bf16_t* CKA = (bf16_t*)(ws + WS_CKA); bf16_t* CKT = (bf16_t*)(ws + WS_CKT);
    { const int NT_ = it1, G_ = nb; int it = it0 + bidx; float v[8];
      const float* cbase = gp(p.cache_ckv) + (long)l * DB * PAST * 512;
#define CC_SRC(itx) (cbase + (((long)((itx) >> 8)) * PAST + (((itx) >> 3) & 31) * 64) * 512 + ((itx) & 7) * 64)
      if (it < NT_) { const float* src = CC_SRC(it);
#pragma unroll
        for (int i = 0; i < 8; ++i) { const int idx = tid + 512 * i, r = idx >> 6, c = idx & 63; v[i] = src[(long)r * 512 + c]; } }
      while (it < NT_) { const int b = it >> 8, kt = (it >> 3) & 31, ct = it & 7; const int itn = it + G_; float vn[8];
        if (itn < NT_) { const float* src = CC_SRC(itn);
#pragma unroll
            for (int i = 0; i < 8; ++i) { const int idx = tid + 512 * i, r = idx >> 6, c = idx & 63; vn[i] = src[(long)r * 512 + c]; } }
#pragma unroll
        for (int i = 0; i < 8; ++i) { const int idx = tid + 512 * i, r = idx >> 6, c = idx & 63; tile[r * 65 + c] = v[i]; }
        __syncthreads();
        { const int r = tid >> 3, cc = (tid & 7) * 8; float f[8];
#pragma unroll
          for (int j = 0; j < 8; ++j) f[j] = tile[r * 65 + cc + j];
          *reinterpret_cast<u32x4*>(CKA + ((long)b * KPAD + kt * 64 + r) * QLD + ct * 64 + cc) = pack8(f);
#pragma unroll
          for (int j = 0; j < 8; ++j) f[j] = tile[(cc + j) * 65 + r];
          *reinterpret_cast<u32x4*>(CKT + ((long)b * 512 + ct * 64 + r) * KPAD + kt * 64 + cc) = pack8(f); }
        __syncthreads();
#pragma unroll
        for (int i = 0; i < 8; ++i) v[i] = vn[i];
        it = itn; }
#undef CC_SRC
    }
    for (long i = (long)it0 * 64 + (long)bidx * 512 + tid; i < (long)it1 * 64; i += (long)nb * 512) { const long row = i >> 3; const int ch = (int)(i & 7); const int b = (int)(row >> 11), k = (int)(row & 2047);
        const float* s = gp(p.cache_krope) + (((long)l * DB + b) * PAST + k) * 64 + ch * 8; float f[8];
#pragma unroll
        for (int j = 0; j < 8; ++j) f[j] = s[j];
        *reinterpret_cast<u32x4*>(CKA + ((long)b * KPAD + k) * QLD + 512 + ch * 8) = pack8(f); }
}

__device__ __forceinline__ void post_win(KParams& p, int l) {
    const int lane = otid() & 63; unsigned char* ws = optr(gp(p.ws));
    bf16_t* Y = (bf16_t*)(ws + WS_Y); bf16_t* CQN = (bf16_t*)(ws + WS_CQN); bf16_t* CKVNP = (bf16_t*)(ws + WS_CKVNP); bf16_t* KRP = (bf16_t*)(ws + WS_KRP); bf16_t* CKA = (bf16_t*)(ws + WS_CKA); bf16_t* CKT = (bf16_t*)(ws + WS_CKT);
    const float* T64 = (const float*)(ws + WS_TAB64); const float* T128 = (const float*)(ws + WS_TAB128);
    for (int t = gwave(); t < T; t += nwaves()) {
        bf16_t* y = Y + (long)t * INWP; const int pos = tok_pos(t); const bool samp = t >= TP; const int ts = t - TP, b = ts >> 6, s = ts & 63;
        { float f[8], o[8]; unpack8(*reinterpret_cast<const u32x4*>(y + C_CQ + 8 * lane), f); float ss = 0.f;
#pragma unroll
          for (int j = 0; j < 8; ++j) ss += f[j] * f[j];
          ss = wave_sum(ss); const float rinv = rsqrtf(ss * (1.0f / 512.f) + EPS); const float* g = gp(p.g_q) + (long)l * 512 + 8 * lane;
#pragma unroll
          for (int j = 0; j < 8; ++j) o[j] = f[j] * rinv * g[j];
          *reinterpret_cast<u32x4*>(CQN + (long)t * 512 + 8 * lane) = pack8(o); }
        { float f[8], o[8]; unpack8(*reinterpret_cast<const u32x4*>(y + C_CKV + 8 * lane), f); float ss = 0.f;
#pragma unroll
          for (int j = 0; j < 8; ++j) ss += f[j] * f[j];
          ss = wave_sum(ss); const float rinv = rsqrtf(ss * (1.0f / 512.f) + EPS); const float* g = gp(p.g_kv) + (long)l * 512 + 8 * lane;
#pragma unroll
          for (int j = 0; j < 8; ++j) o[j] = f[j] * rinv * g[j];
          float* od = gp(p.out) + (samp ? O_CKVS + ((long)l * TS + ts) * 512 : O_CKVP + ((long)l * TP + t) * 512) + 8 * lane;
          *reinterpret_cast<f32x4*>(od) = (f32x4){o[0], o[1], o[2], o[3]}; *reinterpret_cast<f32x4*>(od + 4) = (f32x4){o[4], o[5], o[6], o[7]};
          const u32x4 w = pack8(o);
          if (!samp) *reinterpret_cast<u32x4*>(CKVNP + (long)t * 512 + 8 * lane) = w;
          else { *reinterpret_cast<u32x4*>(CKA + ((long)b * KPAD + PAST + s) * QLD + 8 * lane) = w;
#pragma unroll
              for (int j = 0; j < 8; ++j) CKT[((long)b * 512 + 8 * lane + j) * KPAD + PAST + s] = f2bf(o[j]); } }
        if (lane < 32) { const float x1 = bf2f(y[C_KR + lane]), x2 = bf2f(y[C_KR + 32 + lane]); const float c = T64[((long)pos * 32 + lane) * 2], sn = T64[((long)pos * 32 + lane) * 2 + 1];
            const float o1 = x1 * c - x2 * sn, o2 = x1 * sn + x2 * c;
            float* od = gp(p.out) + (samp ? O_KRS + ((long)l * TS + ts) * 64 : O_KRP + ((long)l * TP + t) * 64); od[lane] = o1; od[32 + lane] = o2;
            if (!samp) { KRP[(long)t * 64 + lane] = f2bf(o1); KRP[(long)t * 64 + 32 + lane] = f2bf(o2); }
            else { bf16_t* d = CKA + ((long)b * KPAD + PAST + s) * QLD + 512; d[lane] = f2bf(o1); d[32 + lane] = f2bf(o2); } }
        { const int hh = lane >> 3, d0 = (lane & 7) * 8; const float* cs = T128 + ((long)pos * 64 + d0) * 2; float cv[8], sv[8];
#pragma unroll
          for (int j = 0; j < 4; ++j) { const f32x4 q = *reinterpret_cast<const f32x4*>(cs + 4 * j); cv[2 * j] = q[0]; sv[2 * j] = q[1]; cv[2 * j + 1] = q[2]; sv[2 * j + 1] = q[3]; }
#pragma unroll
          for (int which = 0; which < 2; ++which) { bf16_t* base = y + (which ? C_RK : C_RQ) + hh * 128 + d0; const float sca = which ? 0.08838834764831845f : 1.0f;
              float a[8], bq[8], o1[8], o2[8]; unpack8(*reinterpret_cast<const u32x4*>(base), a); unpack8(*reinterpret_cast<const u32x4*>(base + 64), bq);
#pragma unroll
              for (int j = 0; j < 8; ++j) { o1[j] = (a[j] * cv[j] - bq[j] * sv[j]) * sca; o2[j] = (a[j] * sv[j] + bq[j] * cv[j]) * sca; }
              *reinterpret_cast<u32x4*>(base) = pack8(o1); *reinterpret_cast<u32x4*>(base + 64) = pack8(o2); } }
    }
}

__device__ __forceinline__ void post_q(KParams& p) {
    const int lane = otid() & 63; unsigned char* ws = optr(gp(p.ws)); bf16_t* Q = (bf16_t*)(ws + WS_Q); bf16_t* QL = (bf16_t*)(ws + WS_QL); const float* T64 = (const float*)(ws + WS_TAB64);
    for (int t = gwave(); t < T; t += nwaves()) { const int pos = tok_pos(t); const int hd = lane >> 2, d0 = (lane & 3) * 8;
        bf16_t* base = Q + (long)t * 3072 + hd * 192 + 128 + d0; const float* cs = T64 + ((long)pos * 32 + d0) * 2; float cv[8], sv[8];
#pragma unroll
        for (int j = 0; j < 4; ++j) { const f32x4 q = *reinterpret_cast<const f32x4*>(cs + 4 * j); cv[2 * j] = q[0]; sv[2 * j] = q[1]; cv[2 * j + 1] = q[2]; sv[2 * j + 1] = q[3]; }
        float a[8], bq[8], o1[8], o2[8]; unpack8(*reinterpret_cast<const u32x4*>(base), a); unpack8(*reinterpret_cast<const u32x4*>(base + 32), bq);
#pragma unroll
        for (int j = 0; j < 8; ++j) { o1[j] = a[j] * cv[j] - bq[j] * sv[j]; o2[j] = a[j] * sv[j] + bq[j] * cv[j]; }
        const u32x4 w1 = pack8(o1), w2 = pack8(o2);
        *reinterpret_cast<u32x4*>(base) = w1; *reinterpret_cast<u32x4*>(base + 32) = w2;
        if (t >= TP) { const int ts = t - TP, b = ts >> 6, s = ts & 63; bf16_t* d = QL + ((long)b * 1024 + hd * 64 + s) * QLD + 512 + d0;
            *reinterpret_cast<u32x4*>(d) = w1; *reinterpret_cast<u32x4*>(d + 32) = w2; } }
}

__device__ __forceinline__ void softmax_rows(KParams& p) {
    const int lane = otid() & 63; unsigned char* ws = optr(gp(p.ws)); bf16_t* SP = (bf16_t*)(ws + WS_SP);
    for (int r = gwave(); r < DB * 1024; r += nwaves()) { bf16_t* row = SP + (long)r * KPAD; float v[5][8]; float mx = -3.0e38f;
#pragma unroll
        for (int j = 0; j < 5; ++j) { const int ch = lane + 64 * j;
            if (ch < KALL / 8) { unpack8(*reinterpret_cast<const u32x4*>(row + ch * 8), v[j]);
#pragma unroll
                for (int i = 0; i < 8; ++i) { v[j][i] *= MLA_SCALE; mx = fmaxf(mx, v[j][i]); } }
            else {
#pragma unroll
                for (int i = 0; i < 8; ++i) v[j][i] = -3.0e38f; } }
        mx = wave_max(mx); float sum = 0.f;
#pragma unroll
        for (int j = 0; j < 5; ++j) { const int ch = lane + 64 * j;
#pragma unroll
            for (int i = 0; i < 8; ++i) { v[j][i] = (ch < KALL / 8) ? __expf(v[j][i] - mx) : 0.f; sum += v[j][i]; } }
        sum = wave_sum(sum); const float inv = 1.0f / sum;
#pragma unroll
        for (int j = 0; j < 5; ++j) { const int ch = lane + 64 * j;
            if (ch < KPAD / 8) { float o[8];
#pragma unroll
                for (int i = 0; i < 8; ++i) o[i] = v[j][i] * inv;
                *reinterpret_cast<u32x4*>(row + ch * 8) = pack8(o); } } }
}

__device__ __forceinline__ void gnorm_gate(KParams& p, int w0, int nw) {
    const int lane = otid() & 63; unsigned char* ws = optr(gp(p.ws)); const bf16_t* OB = (const bf16_t*)(ws + WS_OB); const bf16_t* Y = (const bf16_t*)(ws + WS_Y);
    for (int t = w0; t < T; t += nw) { const int c0 = (lane >> 3) * 256 + (lane & 7) * 32; float x[4][8]; float s = 0.f;
#pragma unroll
        for (int i = 0; i < 4; ++i) { unpack8(*reinterpret_cast<const u32x4*>(OB + ((long)lane * T + t) * 32 + 8 * i), x[i]);
#pragma unroll
            for (int j = 0; j < 8; ++j) s += x[i][j]; }
        s += sx<1>(s); s += sx<2>(s); s += sx<4>(s); const float mu = s * (1.0f / 256.f); float q = 0.f;
#pragma unroll
        for (int i = 0; i < 4; ++i)
#pragma unroll
            for (int j = 0; j < 8; ++j) { const float d = x[i][j] - mu; q += d * d; }
        q += sx<1>(q); q += sx<2>(q); q += sx<4>(q); const float rstd = rsqrtf(q * (1.0f / 256.f) + EPS);
        float am = 0.f;
#pragma unroll
        for (int i = 0; i < 4; ++i) { float g[8]; unpack8(*reinterpret_cast<const u32x4*>(Y + (long)t * INWP + C_RG + c0 + 8 * i), g);
#pragma unroll
            for (int j = 0; j < 8; ++j) { x[i][j] = siluf_(g[j]) * (x[i][j] - mu) * rstd; am = fmaxf(am, fabsf(x[i][j])); } }
        am = wave_max(am); const float qs = am > 0.f ? 127.0f / am : 0.f; unsigned w[8];
#pragma unroll
        for (int i = 0; i < 4; ++i)
#pragma unroll
            for (int hh = 0; hh < 2; ++hh) { unsigned v = 0u;
#pragma unroll
                for (int j = 0; j < 4; ++j) v |= ((unsigned)((int)__builtin_rintf(x[i][4 * hh + j] * qs) & 0xff)) << (8 * j);
                w[2 * i + hh] = v; }
        *reinterpret_cast<u32x4*>(ws + WS_BG + (long)t * DM + c0) = (u32x4){w[0], w[1], w[2], w[3]};
        *reinterpret_cast<u32x4*>(ws + WS_BG + (long)t * DM + c0 + 16) = (u32x4){w[4], w[5], w[6], w[7]};
        if (lane == 0) ((float*)(ws + WS_SA8))[t] = am * (1.0f / 127.0f); }
}

__device__ __forceinline__ void peer_convert(KParams& p, int l, int r0, int r1, int w0, int nw) {
    unsigned char* ws = optr(gp(p.ws)); const int lane = otid() & 63;
    const float* su = gp(p.peer_u) + (long)l * NEXP * DM; const float* sv = gp(p.peer_v) + (long)l * NEXP * DM;
    for (int r = r0 + w0; r < r1; r += nw) { const bool second = r >= NEXP; const int row = second ? r - NEXP : r; const float* s = (second ? sv : su) + (long)row * DM;
        f32x4 v[8]; float am = 0.f;
#pragma unroll
        for (int j = 0; j < 8; ++j) { v[j] = *reinterpret_cast<const f32x4*>(s + 512 * (j >> 2) * 2 + 16 * lane + 4 * (j & 3));
            am = fmaxf(am, fmaxf(fmaxf(fabsf(v[j][0]), fabsf(v[j][1])), fmaxf(fabsf(v[j][2]), fabsf(v[j][3])))); }
        am = wave_max(am);
        float sc = 1.0f, isc = 1.0f;
        if (am > 0.f) { const int e = (int)((__float_as_uint(am) >> 23) & 0xffu) - 127;
            int k = 7 - e; k = k > 100 ? 100 : (k < -100 ? -100 : k);
            sc = __uint_as_float((unsigned)(127 + k) << 23); isc = __uint_as_float((unsigned)(127 - k) << 23); }
        unsigned w[8];
#pragma unroll
        for (int j = 0; j < 8; ++j) { int pk = __builtin_amdgcn_cvt_pk_fp8_f32(v[j][0] * sc, v[j][1] * sc, 0, false); pk = __builtin_amdgcn_cvt_pk_fp8_f32(v[j][2] * sc, v[j][3] * sc, pk, true); w[j] = (unsigned)pk; }
        if (!second) {
            unsigned char* dst = ws + WS_PU + ((long)(lane >> 3) * NEXP + row) * 128 + 16 * (lane & 7);
            *reinterpret_cast<u32x4*>(dst) = (u32x4){w[0], w[1], w[2], w[3]};
            *reinterpret_cast<u32x4*>(dst + 8L * NEXP * 128) = (u32x4){w[4], w[5], w[6], w[7]};
        } else {
            unsigned char* dst = ws + WS_PV + ((long)(2 * lane) * NEXP + row) * 8;
            *reinterpret_cast<u32x2*>(dst) = (u32x2){w[0], w[1]}; *reinterpret_cast<u32x2*>(dst + (long)NEXP * 8) = (u32x2){w[2], w[3]};
            *reinterpret_cast<u32x2*>(dst + 128L * NEXP * 8) = (u32x2){w[4], w[5]}; *reinterpret_cast<u32x2*>(dst + 129L * NEXP * 8) = (u32x2){w[6], w[7]}; }
        if (lane == 0) ((float*)(ws + (second ? WS_PSV : WS_PSU)))[row] = isc; }
}

__device__ __forceinline__ void final_norm(KParams& p) {
    const int lane = otid() & 63; float* X = gp(p.out);
    for (int t = gwave(); t < T; t += nwaves()) { float* xr = X + (long)t * DM; f32x4 v[8]; float ss = 0.f;
#pragma unroll
        for (int j = 0; j < 8; ++j) { v[j] = *reinterpret_cast<const f32x4*>(xr + 256 * j + 4 * lane); ss += v[j][0] * v[j][0] + v[j][1] * v[j][1] + v[j][2] * v[j][2] + v[j][3] * v[j][3]; }
        ss = wave_sum(ss); const float rinv = rsqrtf(ss * (1.0f / DM) + EPS);
#pragma unroll
        for (int j = 0; j < 8; ++j) { const int c = 256 * j + 4 * lane; const f32x4 gv = *reinterpret_cast<const f32x4*>(gp(p.g_final) + c); *reinterpret_cast<f32x4*>(xr + c) = v[j] * rinv * gv; } }
}
}
__global__ void __launch_bounds__(512, 2) mega_fwd(Params p_by_value_unused) {
    extern __shared__ __attribute__((aligned(16))) unsigned char shm[];
    LAS unsigned char* lds = (LAS unsigned char*)shm; char* ldsg = (char*)shm;
    if (threadIdx.x < 8) ((LAS unsigned*)(lds + LDS_BARW))[threadIdx.x] = 0u;
    __syncthreads();
    if (threadIdx.x == 0) { unsigned* tk = (unsigned*)(gp(KP.ws) + WS_CTL + CTL_RANK) + 64 * xb_xcc_id(); ((volatile LAS unsigned*)(lds + LDS_BARW))[2] = xb_add(tk, 1u); }
    const XcdBarrier bar = xcd_barrier_post((unsigned*)(gp(KP.ws) + WS_CTL), (volatile LAS unsigned*)(lds + LDS_BARW));
#define GRID_SYNC() xcd_barrier(bar)
#ifndef STOP_AT
#define STOP_AT 0
#endif
#ifdef DBG_DUMP
#define STOPCHK(n) do { if (STOP_AT == (n)) { float* xo = gp(KP.out); const bf16_t* src = (const bf16_t*)(gp(KP.ws) + DBG_DUMP); for (long i = ph::gthread(); i < (long)T * DM; i += ph::nthreads()) xo[i] = bf2f(src[i]); return; } } while (0)
#elif defined(DBG_SANITIZE)
#define STOPCHK(n) do { if (STOP_AT == (n) || (STOP_AT > 100 && l == 1 && STOP_AT - 100 == (n))) { float* xo = gp(KP.out); for (long i = ph::gthread(); i < (long)T * DM; i += ph::nthreads()) { const float v = xo[i]; if (!(v - v == 0.0f)) xo[i] = 7.0f; } return; } } while (0)
#else
#define STOPCHK(n) do { if (STOP_AT == (n) || (STOP_AT > 100 && l == 1 && STOP_AT - 100 == (n))) return; } while (0)
#endif
    using namespace pg8;
#define WSP(off) ((bf16_t*)(optr(gp(KP.ws)) + (off)))
#define H WSP(WS_H)
#define Y WSP(WS_Y)
#define CQN WSP(WS_CQN)
#define CKVNP WSP(WS_CKVNP)
#define KRP WSP(WS_KRP)
#define Q WSP(WS_Q)
#define YA WSP(WS_YA)
#define KV WSP(WS_KV)
#define SP WSP(WS_SP)
#define MIX WSP(WS_MIX)
#define OA WSP(WS_OA)
#define QP WSP(WS_QP)
#define CKA WSP(WS_CKA)
#define CKT WSP(WS_CKT)
#define QL WSP(WS_QL)
#define OL WSP(WS_OL)
#define BG WSP(WS_BG)
    int l = 0;
    ph::prologue(KP, ldsg);
#ifdef DUP_PRO
    ph::prologue(KP, ldsg);
#endif
    GRID_SYNC(); STOPCHK(1);
    if (threadIdx.x == 0) { unsigned* barw = (unsigned*)(gp(KP.ws) + WS_CTL); const unsigned me = xb_xcc_id(); unsigned nx = 0, xi = 0, nloc = 1;
        for (unsigned j = 0; j < 16; ++j) { const unsigned cn = xb_ld(&barw[XB_XCNT(j)]); if (cn) { if (j < me) ++xi; ++nx; } if (j == me) nloc = cn ? cn : 1u; }
        volatile LAS unsigned* iw = (volatile LAS unsigned*)(lds + LDS_BARW); iw[3] = xi; iw[4] = nx; iw[5] = nloc; }
    __syncthreads();
    ph::ada_reduce(KP);
    ph::wpq_int8(KP);
    GRID_SYNC(); STOPCHK(2);
    for (l = 0; l < DEPTH; ++l) {
#define WIN (WSP(WS_WIN) + (long)l * INWP * DM)
#define WUQ (WSP(WS_WUQ) + (long)l * 3072 * 512)
#define WUKV (WSP(WS_WUKV) + (long)l * 4096 * 512)
#define WUK (WSP(WS_WUK) + (long)l * 16 * 512 * 256)
#define WA (WSP(WS_WA) + (long)l * DM * DM)
#define WB (WSP(WS_WB) + (long)l * DM * DM)
#define WO (WSP(WS_WO) + (long)l * DM * DM)
#define WPQ (WSP(WS_WPQ) + (long)l * DM * DM)
#define ADA ((const float*)(optr(gp(KP.ws)) + WS_ADA) + (long)l * NCOND * 12288)
        ph::modulate(KP, l, 0);
        ph::win_int8(KP, l);
        ph::wb_int8(KP, l);
        ph::cache_convert(KP, l, ldsg, l == 0 ? 0 : 4096, 8192, obid(), ogrid());
        GRID_SYNC(); STOPCHK(3);
        { Sched<5> S; S.init(T / 256, INWP / 256 - NB8, (T / 256) * (INWP / 256 - NB8), DM, DM); gemm_phase(lds, Gemm{H, WIN, DM, DM, DM}, S, EpiBf16{Y, INWP, 0}); }
        { Sched<6> S; S.init(T / 256, NB8, (T / 256) * NB8, DM / 2, DM / 2);
          { const int G_ = ogrid(); S.rotate((((((T / 256) * NB8) % G_) + 7) & ~7) % G_); }
          unsigned char* ws8 = optr(gp(KP.ws));
          gemm_phase<EpiQ8, Sched<6>, true>(lds, Gemm{(const bf16_t*)(ws8 + WS_H8), (const bf16_t*)(ws8 + WS_WIN8), DM / 2, DM / 2, DM / 2}, S, EpiQ8{Y, INWP, (const float*)(ws8 + WS_SA8), (const float*)(ws8 + WS_SBW)}); }
#ifdef DUP_WIN
        { Sched<0> S; S.init(T / 256, INWP / 256, (T / 256) * (INWP / 256), DM, DM); gemm_phase(lds, Gemm{H, WIN, DM, DM, DM}, S, EpiBf16{Y, INWP, 0}); }
#endif
        GRID_SYNC(); STOPCHK(4);
        ph::post_win(KP, l);
        GRID_SYNC(); STOPCHK(5);
        { Sched<0> S; S.init(T / 256, 3072 / 256, (T / 256) * 12, 512, 512); gemm_phase(lds, Gemm{CQN, WUQ, 512, 512, 512}, S, EpiQ{Q, QL, (const float*)(optr(gp(KP.ws)) + WS_TAB64)}); }
        { Sched<0> S; S.init(TP / 256, 4096 / 256, (TP / 256) * 16, 512, 512); gemm_phase(lds, Gemm{CKVNP, WUKV, 512, 512, 512}, S, EpiBf16{KV, 4096, 0}); }
        GRID_SYNC(); STOPCHK(6);
#ifndef DUP_ATTN
#define DUP_ATTN 1
#endif
#ifndef DUP_RET
#define DUP_RET 1
#endif
#ifndef DUP_GATHER
#define DUP_GATHER 0
#endif
#pragma unroll 1
        for (int rep_ = 0; rep_ < DUP_ATTN; ++rep_)
        { for (int u = obid(); u < 512; u += ogrid()) { const int c = u & 255, i = u >> 8, xcd = c & 7, slot = c >> 3; const int bh = xcd * 4 + (slot >> 3) + 32 * i, pr = slot & 7, b = bh >> 4, h = bh & 15;
#pragma unroll 1
              for (int z = 0; z < 2; ++z) { const int qb = z ? 15 - pr : pr; const long tok0 = (long)b * SEQ + 256 * qb;
                  att::attn_block(Q + tok0 * 3072 + h * 192, KV + (long)b * SEQ * 4096 + h * 256, KRP + (long)b * SEQ * 64, KV + (long)b * SEQ * 4096 + h * 256 + 128, OA + tok0 * DM + h * 128, qb, ldsg); } } }
        { Sched<1> S; S.init(0, 0, 256, 3072, 256); gemm_phase(lds, Gemm{Q, WUK, 256, 3072, 256}, S, EpiRowMap<1>{QL, nullptr}); }
        GRID_SYNC(); STOPCHK(8);
        { Sched<2> S; S.init(0, 0, DB * 36, QLD, QLD); gemm_phase(lds, Gemm{QL, CKA, QLD, QLD, QLD}, S, EpiExp{SP, (float*)(optr(gp(KP.ws)) + WS_CTL + CTL_RSUM) + (long)l * 32768}); }
        GRID_SYNC(); STOPCHK(9);
        { Sched<3> S; S.init(0, 0, 256, KPAD, KPAD); gemm_phase(lds, Gemm{SP, CKT, 2176, KPAD, KPAD}, S, EpiRowMap<3>{OL, (const float*)(optr(gp(KP.ws)) + WS_CTL + CTL_RSUM) + (long)l * 32768}); }
        GRID_SYNC(); STOPCHK(11);
        { Sched<4> S; S.init(0, 0, 128, 512, 512); gemm_phase(lds, Gemm{OL, WUKV, 512, 512, 512}, S, EpiOV{OA}); }
#pragma unroll 1
        for (int rep_ = 0; rep_ < DUP_RET; ++rep_)
        for (int u = obid(); u < 256 + DB * 64; u += ogrid()) ret::unit(KP, l, u, ldsg);
#ifdef DUP_RETP
        for (int u = obid(); u < 256; u += ogrid()) ret::unit(KP, l, u, ldsg);
#endif
        GRID_SYNC(); STOPCHK(12);
        { Sched<0> S; S.init(T / 256, DM / 256, (T / 256) * 8, DM, DM); gemm_phase(lds, Gemm{OA, WA, DM, DM, DM}, S, EpiBf16{YA, DM, 0}); }
        { const int G_ = ogrid(), rem_ = ((T / 256) * 8) % G_; const int b_ = obid();
          if (rem_ == 0) ph::gnorm_gate(KP, ph::gwave(), ph::nwaves());
          else if (b_ >= rem_) ph::gnorm_gate(KP, (b_ - rem_) * 8 + (otid() >> 6), (G_ - rem_) * 8); }
#ifdef DUP_WA
#pragma unroll 1
        for (int rep_ = 0; rep_ < DUP_WA; ++rep_)
        { Sched<0> S; S.init(T / 256, DM / 256, (T / 256) * 8, DM, DM); gemm_phase(lds, Gemm{OA, WA, DM, DM, DM}, S, EpiBf16{YA, DM, 0}); }
#endif
        GRID_SYNC(); STOPCHK(14);
        { Sched<0> S; S.init(T / 256, DM / 256, (T / 256) * 8, DM / 2, DM / 2); unsigned char* ws8 = optr(gp(KP.ws));
          gemm_phase<EpiMix, Sched<0>, true>(lds, Gemm{(const bf16_t*)(ws8 + WS_BG), (const bf16_t*)(ws8 + WS_WB8), DM / 2, DM / 2, DM / 2}, S, EpiMix{Y, YA, MIX, (const float*)(ws8 + WS_SA8), (const float*)(ws8 + WS_SBB)}); }
        { const int G_ = ogrid(), rem_ = ((T / 256) * 8) % G_; const int b_ = obid();
          if (rem_ == 0) ph::peer_convert(KP, l, 0, NEXP, ph::gwave(), ph::nwaves());
          else if (b_ >= rem_) ph::peer_convert(KP, l, 0, NEXP, (b_ - rem_) * 8 + (otid() >> 6), (G_ - rem_) * 8); }
        GRID_SYNC(); STOPCHK(15);
        { Sched<0> S; S.init(T / 256, DM / 256, (T / 256) * 8, DM, DM); gemm_phase(lds, Gemm{MIX, WO, DM, DM, DM}, S, EpiRes{gp(KP.out), ADA + 2 * DM, l == 0 ? gp(KP.x_prompt) : gp(KP.out), l == 0 ? gp(KP.x_sample) : gp(KP.out) + (long)TP * DM}); }
        { const int G_ = ogrid(), rem_ = ((T / 256) * 8) % G_; const int b_ = obid();
          if (rem_ == 0) ph::peer_convert(KP, l, NEXP, 2 * NEXP, ph::gwave(), ph::nwaves());
          else if (b_ >= rem_) ph::peer_convert(KP, l, NEXP, 2 * NEXP, (b_ - rem_) * 8 + (otid() >> 6), (G_ - rem_) * 8); }
        GRID_SYNC(); STOPCHK(16);
        ph::modulate(KP, l, 1);
        GRID_SYNC(); STOPCHK(17);
        { Sched<0> S; S.init(T / 256, DM / 256, (T / 256) * 8, DM / 2, DM / 2);
          unsigned char* ws8 = optr(gp(KP.ws));
          gemm_phase<EpiQ8, Sched<0>, true>(lds, Gemm{(const bf16_t*)(ws8 + WS_H8), (const bf16_t*)(ws8 + WS_WPQ8 + (long)l * DM * DM), DM / 2, DM / 2, DM / 2}, S, EpiQ8{QP, DM, (const float*)(ws8 + WS_SA8), (const float*)(ws8 + WS_SB8) + (long)l * DM});
#ifdef DUP_WPQ
          gemm_phase<EpiQ8, Sched<0>, true>(lds, Gemm{(const bf16_t*)(ws8 + WS_H8), (const bf16_t*)(ws8 + WS_WPQ8 + (long)l * DM * DM), DM / 2, DM / 2, DM / 2}, S, EpiQ8{QP, DM, (const float*)(ws8 + WS_SA8), (const float*)(ws8 + WS_SB8) + (long)l * DM});
#endif
        }
        if (l + 1 < DEPTH) { const int G_ = ogrid(), rem_ = ((T / 256) * 8) % G_; const int b_ = obid();
          if (rem_ == 0) ph::cache_convert(KP, l + 1, ldsg, 0, 4096, b_, G_);
          else if (b_ >= rem_) ph::cache_convert(KP, l + 1, ldsg, 0, 4096, b_ - rem_, G_ - rem_); }
        GRID_SYNC(); STOPCHK(18);
        { const int tid_ = otid(); const int lane = tid_ & 63; float* strip = (float*)ldsg + tid_ * 33; unsigned char* ws = optr(gp(KP.ws));
          const bf16_t* k1g = (const bf16_t*)(ws + WS_PK1) + (long)l * 128 * 128; const bf16_t* k2g = (const bf16_t*)(ws + WS_PK2) + (long)l * 128 * 128;
          bf16_t* k1 = (bf16_t*)(ldsg + 512 * 33 * 4 + 64); bf16_t* k2 = k1 + 128 * peer::KPITCH;
          for (int i = tid_; i < 2 * 128 * 16; i += 512) { const int which = i >> 11, r = (i >> 4) & 127, ch = i & 15;
              *reinterpret_cast<u32x4*>((which ? k2 : k1) + r * peer::KPITCH + ch * 8) = *reinterpret_cast<const u32x4*>((which ? k2g : k1g) + r * 128 + ch * 8); }
          __syncthreads();
          for (int wu = ph::gwave(); wu < (T / 32) * PH; wu += ph::nwaves()) peer::select_unit(QP, k1, k2, (int*)(ws + WS_PIDX), (float*)(ws + WS_PW), (wu >> 3) * 32, wu & 7, lane, strip);
#ifdef DUP_SEL
          for (int wu = ph::gwave(); wu < (T / 32) * PH; wu += ph::nwaves()) peer::select_unit(QP, k1, k2, (int*)(ws + WS_PIDX), (float*)(ws + WS_PW), (wu >> 3) * 32, wu & 7, lane, strip);
#endif
        }
        GRID_SYNC(); STOPCHK(19);
        { const int tid_ = otid(); const int lane = tid_ & 63, wid = tid_ >> 6; unsigned char* ws = optr(gp(KP.ws));
          volatile LAS unsigned* iw = (volatile LAS unsigned*)(lds + LDS_BARW); peer::XInfo xin; xin.rank = __builtin_amdgcn_readfirstlane((int)iw[2]); xin.xi = __builtin_amdgcn_readfirstlane((int)iw[3]); xin.nx = __builtin_amdgcn_readfirstlane((int)iw[4]); xin.nloc = __builtin_amdgcn_readfirstlane((int)iw[5]);
          if (xin.nx >= 1 && xin.nx <= 8) {
              peer::upass(H, (const unsigned char*)(ws + WS_PU), (const int*)(ws + WS_PIDX), (const float*)(ws + WS_PW), (const float*)(ws + WS_PSU), (const float*)(ws + WS_PSV), (float*)(ws + WS_DOTP), (unsigned*)(ws + WS_ACT), xin, wid, lane);
              GRID_SYNC();
              int vs0_, vsn_, vse_;
              if ((256 % xin.nx) == 0) { const int spx = 256 / xin.nx; vs0_ = xin.xi * spx + xin.rank; vsn_ = xin.nloc; vse_ = (xin.xi + 1) * spx; }
              else { vs0_ = obid(); vsn_ = ogrid(); vse_ = 256; }
              peer::vpass_lds((const unsigned char*)(ws + WS_PV), (const unsigned*)(ws + WS_ACT), gp(KP.out), ADA + 5 * DM, ldsg, vs0_, vsn_, vse_, tid_);
#ifdef DUP_VP
              peer::vpass_lds((const unsigned char*)(ws + WS_PV), (const unsigned*)(ws + WS_ACT), (float*)(ws + WS_OB), ADA + 5 * DM, ldsg, vs0_, vsn_, vse_, tid_);
#endif
          } else {
              for (int t = ph::gwave(); t < T; t += ph::nwaves()) peer::gather_token(H, (const unsigned char*)(ws + WS_PU), (const unsigned char*)(ws + WS_PV), (const float*)(ws + WS_PSU), (const float*)(ws + WS_PSV), (const int*)(ws + WS_PIDX), (const float*)(ws + WS_PW), gp(KP.out), ADA + 5 * DM, t, lane);
          } }
        GRID_SYNC(); STOPCHK(20);
    }
    ph::final_norm(KP);
}

extern "C" void kernel_launch(void* const* d_in, const int* in_sizes, int n_in, void* d_out, int out_size, void* d_ws, size_t ws_size, hipStream_t stream) {
    static int grid = 0;
    if (grid == 0) {
        if (n_in != 25 || out_size != (int)O_END || ws_size < WS_END) { fprintf(stderr, "kernel_launch: shape mismatch: n_in %d out %d (want %ld) ws %zu (want >= %zu)\n", n_in, out_size, O_END, ws_size, (size_t)WS_END); grid = -1; return; }
        int dev = 0, cus = 0, per_cu = 0;
        if (hipGetDevice(&dev) != hipSuccess || hipDeviceGetAttribute(&cus, hipDeviceAttributeMultiprocessorCount, dev) != hipSuccess) { fprintf(stderr, "kernel_launch: device query failed\n"); grid = -1; return; }
        if (hipFuncSetAttribute((const void*)mega_fwd, hipFuncAttributeMaxDynamicSharedMemorySize, LDS_BYTES) != hipSuccess) { fprintf(stderr, "kernel_launch: hipFuncSetAttribute failed\n"); grid = -1; return; }
        if (hipOccupancyMaxActiveBlocksPerMultiprocessor(&per_cu, (const void*)mega_fwd, 512, LDS_BYTES) != hipSuccess || per_cu < 1) { fprintf(stderr, "kernel_launch: occupancy query says %d blocks per CU\n", per_cu); grid = -1; return; }
        grid = cus;
#ifdef FORCE_GRID
        grid = FORCE_GRID;
#endif
    }
    if (grid < 0) return;
    (void)hipMemsetAsync((char*)d_ws + WS_CTL, 0, CTL_BYTES, stream);
    Params p{};
    const float* const* in = (const float* const*)d_in;
    p.x_prompt = in[0]; p.x_sample = in[1]; p.c_prompt = in[2]; p.c_sample = in[3]; p.cache_ckv = in[4]; p.cache_krope = in[5]; p.state_ret = in[6]; p.w_ada = in[7]; p.b_ada = in[8];
    p.g_mix = in[9]; p.g_ffn = in[10]; p.w_in = in[11]; p.g_q = in[12]; p.w_uq = in[13]; p.g_kv = in[14]; p.w_ukv = in[15]; p.w_a = in[16]; p.w_b = in[17]; p.w_o = in[18]; p.w_pq = in[19];
    p.peer_k1 = in[20]; p.peer_k2 = in[21]; p.peer_u = in[22]; p.peer_v = in[23]; p.g_final = in[24];
    p.out = (float*)d_out; p.ws = (unsigned char*)d_ws;
    for (int h = 0; h < 8; ++h) p.lg[h] = (float)log1p(-pow(2.0, -5.0 - (double)h));
    p.grid = grid; p.pad_ = 0;
    hipLaunchKernelGGL(mega_fwd, dim3(grid), dim3(512), LDS_BYTES, stream, p);
    const hipError_t le = hipGetLastError();
    if (le != hipSuccess) fprintf(stderr, "kernel_launch: launch failed: %s\n", hipGetErrorName(le));
}
```

```cpp
#include <hip/hip_runtime.h>
#include <cstdio>
#include <cstdint>
#include <cmath>

#define LAS __attribute__((address_space(3)))
typedef unsigned short bf16_t;
typedef short bf16x8 __attribute__((ext_vector_type(8)));
typedef float f32x4 __attribute__((ext_vector_type(4)));
typedef float f32x2 __attribute__((ext_vector_type(2)));
typedef float f32x16 __attribute__((ext_vector_type(16)));
typedef unsigned u32x4 __attribute__((ext_vector_type(4)));
typedef unsigned u32x2 __attribute__((ext_vector_type(2)));
typedef short s16x4 __attribute__((ext_vector_type(4)));
typedef int i32x4 __attribute__((ext_vector_type(4)));

constexpr int DM = 2048, NB = 4, SEQ = 4096, DEPTH = 2, DB = 32, DS = 64, PAST = 2048;
constexpr int TP = NB * SEQ, TS = DB * DS, T = TP + TS;
constexpr int NCOND = NB + DB;
constexpr int QLORA = 512, KVLORA = 512, ROPE = 64, NOPE = 128, VD = 128, MH = 16, QKD = 192;
constexpr int RH = 8, RQK = 128, RV = 256;
constexpr int PH = 8, NKEYS = 128, NEXP = 16384, PTOPK = 16;
constexpr int INW = 11328, INWP = 11520;
constexpr int C_CQ = 0, C_CKV = 512, C_KR = 1024, C_RQ = 1088, C_RK = 2112, C_RV = 3136, C_RG = 5184, C_GA = 7232, C_GB = 9280;
constexpr int KALL = PAST + DS;
constexpr int KPAD = 2304;
constexpr int QLD = 640;
constexpr float EPS = 1e-6f;
constexpr float MLA_SCALE = 0.07216878364870322f;

constexpr long O_Y = 0;
constexpr long O_CKVP = (long)T * DM;
constexpr long O_KRP = O_CKVP + 2L * TP * 512;
constexpr long O_RETP = O_KRP + 2L * TP * 64;
constexpr long O_CKVS = O_RETP + 2L * NB * RH * RQK * RV;
constexpr long O_KRS = O_CKVS + 2L * TS * 512;
constexpr long O_RETS = O_KRS + 2L * TS * 64;
constexpr long O_END = O_RETS + 2L * DB * RH * RQK * RV;

constexpr size_t al256(size_t x) { return (x + 255) / 256 * 256; }
constexpr size_t WS_CTL = 0;
constexpr size_t CTL_BYTES = 65536 + 2UL * 32768 * 4;
constexpr size_t CTL_RSUM = 65536;
constexpr size_t WS_TAB64 = WS_CTL + CTL_BYTES;
constexpr size_t WS_TAB128 = WS_TAB64 + 4096UL * 32 * 2 * 4;
constexpr size_t WS_ADA = WS_TAB128 + 4096UL * 64 * 2 * 4;
constexpr size_t WS_ADAP = WS_ADA + 2UL * NCOND * 12288 * 4;
constexpr size_t WS_WIN = WS_ADAP + 8UL * 2 * NCOND * 12288 * 4;
constexpr size_t WS_WUQ = WS_WIN + 2UL * INWP * DM * 2;
constexpr size_t WS_WUKV = WS_WUQ + 2UL * 3072 * 512 * 2;
constexpr size_t WS_WUK = WS_WUKV + 2UL * 4096 * 512 * 2;
constexpr size_t WS_WA = WS_WUK + 2UL * 16 * 512 * 256 * 2;
constexpr size_t WS_WB = WS_WA + 2UL * DM * DM * 2;
constexpr size_t WS_WO = WS_WB + 2UL * DM * DM * 2;
constexpr size_t WS_WPQ = WS_WO + 2UL * DM * DM * 2;
constexpr size_t WS_PK1 = WS_WPQ + 2UL * DM * DM * 2;
constexpr size_t WS_PK2 = WS_PK1 + 2UL * 128 * 128 * 2;
constexpr size_t WS_H = WS_PK2 + 2UL * 128 * 128 * 2;
constexpr size_t WS_Y = WS_H + (size_t)T * DM * 2;
constexpr size_t WS_CQN = WS_Y + (size_t)T * INWP * 2;
constexpr size_t WS_CKVNP = WS_CQN + (size_t)T * 512 * 2;
constexpr size_t WS_KRP = WS_CKVNP + (size_t)TP * 512 * 2;
constexpr size_t WS_Q = WS_KRP + (size_t)TP * 64 * 2;
constexpr size_t WS_YA = WS_Q;
constexpr size_t WS_KV = WS_Q + (size_t)T * 3072 * 2 + 4096;
constexpr size_t WS_SP = WS_KV;
constexpr size_t WS_MIX = WS_KV;
constexpr size_t WS_OA = WS_KV + 32UL * 1024 * KPAD * 2;
constexpr size_t WS_QP = WS_OA;
constexpr size_t WS_CKA = WS_OA + (size_t)T * DM * 2;
constexpr size_t WS_CKT = WS_CKA + 32UL * KPAD * QLD * 2;
constexpr size_t WS_QL = WS_CKT + 32UL * 512 * KPAD * 2;
constexpr size_t WS_OL = WS_QL + 32UL * 1024 * QLD * 2;
constexpr size_t WS_OB = WS_OL + 16UL * 2048 * 512 * 2;
constexpr size_t WS_BG = WS_OB + (size_t)T * DM * 2;
constexpr size_t WS_PIDX = WS_BG + (size_t)T * DM * 2;
constexpr size_t WS_PW = WS_PIDX + (size_t)T * 128 * 4;
constexpr size_t WS_PU = WS_PW + (size_t)T * 128 * 4;
constexpr size_t WS_PV = WS_PU + (size_t)NEXP * DM;
constexpr size_t WS_PSU = WS_PV + (size_t)NEXP * DM;
constexpr size_t WS_PSV = WS_PSU + (size_t)NEXP * 4;
constexpr size_t WS_WPQ8 = WS_PSV + (size_t)NEXP * 4;
constexpr size_t WS_SB8 = WS_WPQ8 + 2UL * DM * DM;
constexpr size_t WS_SA8 = WS_SB8 + 2UL * DM * 4;
constexpr int NB8 = 29;
constexpr size_t WS_WIN8 = WS_BG + (size_t)T * DM;
constexpr size_t WS_WB8 = WS_WIN8 + (size_t)NB8 * 256 * DM;
constexpr size_t WS_WUQ8 = WS_WB8 + (size_t)DM * DM;
constexpr size_t WS_WUKV8 = WS_WUQ8 + 3072UL * 512;
static_assert(WS_WUKV8 + 4096UL * 512 <= WS_BG + (size_t)T * DM * 2, "int8 weights overflow the BG region");
constexpr size_t WS_SBW = WS_SA8 + al256((size_t)T * 4);
constexpr size_t WS_SBB = WS_SBW + al256((size_t)INWP * 4);
constexpr size_t WS_SBQ = WS_SBB + (size_t)DM * 4;
constexpr size_t WS_SBK = WS_SBQ + 3072UL * 4;
constexpr size_t WS_SAQ = WS_SBK + 4096UL * 4;
constexpr size_t WS_SAK = WS_SAQ + al256((size_t)T * 4);
constexpr size_t WS_END = WS_SAK + al256((size_t)TP * 4);
constexpr size_t WS_H8 = WS_OB;
static_assert((size_t)TP * 4096 * 2 <= 32UL * 1024 * KPAD * 2, "KV fits in the SP region");
static_assert(WS_END <= 1608000000UL, "workspace map too large");
static_assert(WS_WIN % 256 == 0 && WS_H % 256 == 0 && WS_Y % 256 == 0 && WS_Q % 256 == 0 && WS_KV % 256 == 0 && WS_CKA % 256 == 0, "alignment");

constexpr int LDS_BYTES = 147456;
constexpr int LDS_BARW = LDS_BYTES - 32;
constexpr size_t CTL_RANK = 16384;
constexpr size_t WS_DOTP = WS_Q;
constexpr size_t WS_ACT = WS_DOTP + 8UL * T * 128 * 4;
constexpr size_t WS_PIDXT = WS_ACT + (size_t)T * 128 * 4;
static_assert(WS_PIDXT + (size_t)T * 128 * 4 <= WS_KV, "PEER scratch fits in the Q region");

struct Params {
    const float *x_prompt, *x_sample, *c_prompt, *c_sample, *cache_ckv, *cache_krope, *state_ret, *w_ada, *b_ada, *g_mix, *g_ffn, *w_in, *g_q, *w_uq, *g_kv, *w_ukv,
                *w_a, *w_b, *w_o, *w_pq, *peer_k1, *peer_k2, *peer_u, *peer_v, *g_final;
    float* out; unsigned char* ws;
    float lg[8];
    int grid; int pad_;
};

typedef const __attribute__((address_space(4))) Params KParams;
__device__ __forceinline__ KParams* okarg() {
    const uintptr_t k = (uintptr_t)__builtin_amdgcn_kernarg_segment_ptr();
    unsigned lo = (unsigned)k, hi = (unsigned)(k >> 32);
    asm volatile("" : "+s"(lo), "+s"(hi)); return (KParams*)(((uintptr_t)hi << 32) | lo); }
#define KP (*okarg())
__device__ __forceinline__ int ogrid() { return KP.grid; }
__device__ __forceinline__ int obid() { int b = (int)blockIdx.x; asm volatile("" : "+s"(b) :: "memory"); return b; }
__device__ __forceinline__ int otid() { int t = (int)threadIdx.x; asm volatile("" : "+v"(t) :: "memory"); return t; }
template <class P> __device__ __forceinline__ P* gp(P* p) { return (P*)(__attribute__((address_space(1))) P*)(uintptr_t)p; }
template <class P> __device__ __forceinline__ P* optr(P* p) {
    unsigned lo = __builtin_amdgcn_readfirstlane((unsigned)(uintptr_t)p), hi = __builtin_amdgcn_readfirstlane((unsigned)((uintptr_t)p >> 32));
    asm volatile("" : "+s"(lo), "+s"(hi)); return gp((P*)(((uintptr_t)hi << 32) | lo)); }
typedef __bf16 bf16v2_t __attribute__((ext_vector_type(2)));
__device__ __forceinline__ unsigned cvt_pk_bf16(float lo, float hi) { f32x2 v = {lo, hi}; bf16v2_t r = __builtin_convertvector(v, bf16v2_t); return __builtin_bit_cast(unsigned, r); }
__device__ __forceinline__ bf16_t f2bf(float f) { return (bf16_t)(cvt_pk_bf16(f, 0.f) & 0xffffu); }
__device__ __forceinline__ float bf2f(bf16_t b) { return __uint_as_float(((unsigned)b) << 16); }
__device__ __forceinline__ float bflo(unsigned w) { return __uint_as_float(w << 16); }
__device__ __forceinline__ float bfhi(unsigned w) { return __uint_as_float(w & 0xffff0000u); }
__device__ __forceinline__ void unpack8(const u32x4 w, float (&f)[8]) { f[0] = bflo(w.x); f[1] = bfhi(w.x); f[2] = bflo(w.y); f[3] = bfhi(w.y); f[4] = bflo(w.z); f[5] = bfhi(w.z); f[6] = bflo(w.w); f[7] = bfhi(w.w); }
__device__ __forceinline__ u32x4 pack8(const float (&f)[8]) { u32x4 w; w.x = cvt_pk_bf16(f[0], f[1]); w.y = cvt_pk_bf16(f[2], f[3]); w.z = cvt_pk_bf16(f[4], f[5]); w.w = cvt_pk_bf16(f[6], f[7]); return w; }
template <int K> __device__ __forceinline__ float sx(float v) {
    if constexpr (K == 32) { const auto rr = __builtin_amdgcn_permlane32_swap(__float_as_uint(v), __float_as_uint(v), false, false); return __uint_as_float((otid() & 32) ? rr[0] : rr[1]); }
    else return __int_as_float(__builtin_amdgcn_ds_swizzle(__float_as_int(v), (K << 10) | 0x1F));
}
__device__ __forceinline__ float wave_sum(float v) { v += sx<32>(v); v += sx<16>(v); v += sx<8>(v); v += sx<4>(v); v += sx<2>(v); v += sx<1>(v); return v; }
__device__ __forceinline__ float wave_max(float v) { v = fmaxf(v, sx<32>(v)); v = fmaxf(v, sx<16>(v)); v = fmaxf(v, sx<8>(v)); v = fmaxf(v, sx<4>(v)); v = fmaxf(v, sx<2>(v)); v = fmaxf(v, sx<1>(v)); return v; }
__device__ __forceinline__ float sigmoidf_(float x) { return 1.0f / (1.0f + __expf(-x)); }
__device__ __forceinline__ float siluf_(float x) { return x / (1.0f + __expf(-x)); }
__device__ __forceinline__ int cond_row(int t) { return t < TP ? (t >> 12) : NB + ((t - TP) >> 6); }
__device__ __forceinline__ int tok_pos(int t) { return t < TP ? (t & 4095) : PAST + ((t - TP) & 63); }

#define XB_TMO      128
#define XB_XCNT(j)  (256  + 64 * (j))
#define XB_XSUB(j)  (1280 + 64 * (j))
#define XB_XGEN(j)  (2304 + 64 * (j))
#define XB_TOP      3328
#define XB_TOPGEN   3392
#define XCD_BAR_WORDS 3456
#define XB_SPIN_CAP (1u << 22)
__device__ __forceinline__ unsigned xb_ld(unsigned* p)              { return __hip_atomic_load(p, __ATOMIC_RELAXED, __HIP_MEMORY_SCOPE_AGENT); }
__device__ __forceinline__ unsigned xb_add(unsigned* p, unsigned v) { return __hip_atomic_fetch_add(p, v, __ATOMIC_RELAXED, __HIP_MEMORY_SCOPE_AGENT); }
__device__ __forceinline__ unsigned xb_xcc_id() { return (unsigned)__builtin_amdgcn_s_getreg((3 << 11) | 20) & 0xFu; }
#define XB_SPIN(cond, bar) do { unsigned _sp = 0; while (cond) { __builtin_amdgcn_s_sleep(1); \
    if ((++_sp & 255u) == 0u) { if (xb_ld(&(bar)[XB_TMO])) break; if (_sp > XB_SPIN_CAP) { atomicAdd(&(bar)[XB_TMO], 1u); break; } } } } while (0)
struct XcdBarrier { unsigned* bar; unsigned x; volatile LAS unsigned* st; };
__device__ __forceinline__ XcdBarrier xcd_barrier_post(unsigned* bar, volatile LAS unsigned* st) {
    XcdBarrier b; b.bar = bar; b.x = xb_xcc_id(); b.st = st;
    if (threadIdx.x == 0) (void)xb_add(&bar[XB_XCNT(b.x)], 1u);
    return b;
}
__device__ __forceinline__ void xcd_barrier_complete(unsigned* bar, unsigned x, unsigned& nloc, unsigned& nx) {
    const unsigned G = (unsigned)KP.grid;
    unsigned sum, cnt, mine, sp = 0u;
    for (;;) {
        sum = 0u; cnt = 0u; mine = 0u;
#pragma unroll
        for (unsigned j = 0; j < 16; ++j) { const unsigned c = xb_ld(&bar[XB_XCNT(j)]); sum += c; cnt += (c > 0u) ? 1u : 0u; mine = (j == x) ? c : mine; }
        if (sum == G) break;
        __builtin_amdgcn_s_sleep(1);
        if ((++sp & 255u) == 0u) { if (xb_ld(&bar[XB_TMO])) break; if (sp > XB_SPIN_CAP) { atomicAdd(&bar[XB_TMO], 1u); break; } }
    }
    nloc = mine > 0u ? mine : 1u; nx = cnt > 0u ? cnt : 1u;
}
__device__ __forceinline__ void xcd_barrier(const XcdBarrier& b) {
    asm volatile("s_waitcnt vmcnt(0)" ::: "memory");
    __syncthreads();
    if (otid() == 0) {
        unsigned* bar = (unsigned*)(gp(KP.ws) + WS_CTL);
        unsigned bx = xb_xcc_id(); asm volatile("" : "+s"(bx));
        __builtin_amdgcn_s_waitcnt(0);
        unsigned nloc = b.st[0], nx = b.st[1];
        if (nloc == 0u) { xcd_barrier_complete(bar, bx, nloc, nx); b.st[0] = nloc; b.st[1] = nx; }
        const unsigned old = xb_add(&bar[XB_XSUB(bx)], 1u);
        const unsigned gen = old / nloc;
        if (old + 1u == (gen + 1u) * nloc) {
            __builtin_amdgcn_fence(__ATOMIC_RELEASE, "agent");
            asm volatile("s_waitcnt vmcnt(0)" ::: "memory");
            const unsigned og = xb_add(&bar[XB_TOP], 1u);
            const unsigned tg = og / nx;
            if (og + 1u == (tg + 1u) * nx) xb_add(&bar[XB_TOPGEN], 1u);
            else XB_SPIN(xb_ld(&bar[XB_TOPGEN]) == tg, bar);
            __builtin_amdgcn_fence(__ATOMIC_ACQUIRE, "agent");
            xb_add(&bar[XB_XGEN(bx)], 1u);
            asm volatile("s_waitcnt vmcnt(0)" ::: "memory");
        } else {
            XB_SPIN(xb_ld(&bar[XB_XGEN(bx)]) == gen, bar);
            __builtin_amdgcn_fence(__ATOMIC_ACQUIRE, "agent");
            asm volatile("s_waitcnt vmcnt(0)" ::: "memory");
        }
    }
    __syncthreads();
}
namespace pg8 {
constexpr int BM = 256, BK = 64, HALF = 128, HTB = HALF * BK * 2, STAGE_BYTES = 8 * HTB, NXCD = 8, WGM = 8;
__host__ __device__ __forceinline__ int lds_byte(int r, int c) { const int st = (r >> 4) * 2 + (c >> 5), rr = r & 15, cc = c & 31, ob = rr * 64 + cc * 2; return st * 1024 + (ob ^ (((ob >> 9) & 1) << 5)); }
__host__ __device__ __forceinline__ void stage_rc(int b, int& R, int& C) { const int st = b / 1024, sb = b % 1024, swz = sb ^ (((sb >> 9) & 1) << 5); R = (st >> 1) * 16 + swz / 64; C = (st & 1) * 32 + (swz % 64) / 2; }
__host__ __device__ __forceinline__ int perm32(int rho) { const int n = rho >> 4, i = rho & 15; return 8 * (i >> 2) + 4 * n + (i & 3); }

struct Unit { int pm, pn; long aoff, boff; int x0, x1; };
struct Gemm { const bf16_t* A; const bf16_t* Bt; int K; int lda, ldb; const float* sa; const float* sb; };

template <int MODE> struct Sched {
    int nM, nN, nwg, G, c; long lda, ldb;
    __device__ void init(int nM_, int nN_, int nwg_, long lda_, long ldb_) { nM = nM_; nN = nN_; nwg = nwg_; G = ogrid(); c = obid(); lda = lda_; ldb = ldb_; }
    __device__ void rotate(int r) { c = (c + r) % G; }
    __device__ bool next(int i, Unit& u) const {
        const long L = (long)i * G + c; if (L >= nwg) return false;
        int wgid = (int)L;
        if (MODE == 0 || MODE == 5 || MODE == 6) {
            { const int q = nwg / NXCD, r = nwg % NXCD, xcd = wgid % NXCD, off = wgid / NXCD; wgid = (xcd < r ? xcd * (q + 1) : r * (q + 1) + (xcd - r) * q) + off; }
            const int nig = WGM * nN, gid = wgid / nig, fm = gid * WGM, gsz = (nM - fm) < WGM ? (nM - fm) : WGM;
            u.pm = fm + ((wgid % nig) % gsz); u.pn = (wgid % nig) / gsz; u.x0 = 0; u.x1 = 0;
            { const int pl = u.pn;
              if (MODE == 5) u.pn = pl < 3 ? pl + 2 : pl + 5;
              if (MODE == 6) u.pn = pl < 2 ? pl : (pl < 5 ? pl + 3 : pl + 16);
              u.aoff = (long)u.pm * 256 * lda * 2; u.boff = (long)(MODE == 6 ? pl : u.pn) * 256 * ldb * 2; }
        } else if (MODE == 1) {
            const int h = wgid >> 4, rem = wgid & 15, rt = rem >> 1, pn = rem & 1;
            u.pm = rt; u.pn = pn; u.x0 = h; u.x1 = rt;
            u.aoff = ((long)(TP + 256 * rt) * 3072 + h * 192) * 2; u.boff = ((long)(h * 512 + 256 * pn) * 256) * 2;
        } else if (MODE == 2) {
            const int b = wgid / 36, rem = wgid % 36, pm = rem / 9, pn = rem % 9;
            u.pm = pm; u.pn = pn; u.x0 = b; u.x1 = 0;
            u.aoff = ((long)(b * 1024 + 256 * pm) * QLD) * 2; u.boff = ((long)(b * KPAD + 256 * pn) * QLD) * 2;
        } else if (MODE == 3) {
            const int b = wgid >> 3, pm = (wgid & 7) >> 1, pn = wgid & 1;
            u.pm = pm; u.pn = pn; u.x0 = b; u.x1 = 0;
            u.aoff = ((long)(b * 1024 + 256 * pm) * KPAD) * 2; u.boff = ((long)(b * 512 + 256 * pn) * KPAD) * 2;
        } else {
            const int h = wgid >> 3, rt = wgid & 7;
            u.pm = rt; u.pn = 0; u.x0 = h; u.x1 = rt;
            u.aoff = ((long)(h * 2048 + 256 * rt) * 512) * 2; u.boff = ((long)(h * 256) * 512) * 2;
        }
        return true;
    }
};

template <class Epi, class SchedT, int I8 = 0>
__device__ __forceinline__ void gemm_phase(LAS unsigned char* lds, const Gemm g, const SchedT& S, const Epi& E) {
    const int tid = otid(), wid = __builtin_amdgcn_readfirstlane(tid >> 6), lane = tid & 63, wr = wid >> 2, wc = wid & 3, fr = lane & 15, fq = lane >> 4;
    const int K = g.K, nt = K / BK;
    unsigned voffA[2], voffB[2];
#pragma unroll
    for (int i = 0; i < 2; ++i) { int R, C; stage_rc(tid * 16 + i * 8192, R, C); const int Rb = Epi::PERM ? ((R & ~31) + perm32(R & 31)) : R;
        voffA[i] = (unsigned)(R * g.lda + C) * 2u; voffB[i] = (unsigned)(Rb * g.ldb + C) * 2u; }
    const size_t kstep = (size_t)(BK * 2);
    const size_t hstepA = (size_t)HALF * g.lda * 2, hstepB = (size_t)HALF * g.ldb * 2;
    const unsigned ldsw = (unsigned)wid * 1024u;
    const int aoff = lds_byte(wr * 64 + fr, fq * 8), boff = lds_byte(wc * 32 + fr, fq * 8);
#define PG8_SA(b, h) (((b) * 2 + (h)) * HTB)
#define PG8_SB(b, h) ((4 + (b) * 2 + (h)) * HTB)
#define PG8_STAGE(bufoff, gbase, voff) do { _Pragma("unroll") for (int _i = 0; _i < 2; ++_i) \
        __builtin_amdgcn_global_load_lds((const unsigned*)((const char*)(gbase) + (voff)[_i]), (LAS unsigned*)(lds + (bufoff) + ldsw + _i * 8192), 16, 0, 0); } while (0)
#define PG8_LDA(dst, b, h) do { _Pragma("unroll") for (int m = 0; m < 4; ++m) _Pragma("unroll") for (int k = 0; k < 2; ++k) dst[m][k] = *(const LAS bf16x8*)(lds + PG8_SA(b, h) + aoff + m * 2048 + k * 1024); } while (0)
#define PG8_LDB(dst, b, h) do { _Pragma("unroll") for (int n = 0; n < 2; ++n) _Pragma("unroll") for (int k = 0; k < 2; ++k) dst[n][k] = *(const LAS bf16x8*)(lds + PG8_SB(b, h) + boff + n * 2048 + k * 1024); } while (0)
#define PG8_MMA(ai, bj, At, Bt) do { __builtin_amdgcn_s_setprio(1); _Pragma("unroll") for (int m = 0; m < 4; ++m) _Pragma("unroll") for (int n = 0; n < 2; ++n) _Pragma("unroll") for (int k = 0; k < 2; ++k) \
        { if constexpr (I8) acc[ai][bj][m][n] = __builtin_bit_cast(f32x4, __builtin_amdgcn_mfma_i32_16x16x64_i8(__builtin_bit_cast(i32x4, Bt[n][k]), __builtin_bit_cast(i32x4, At[m][k]), __builtin_bit_cast(i32x4, acc[ai][bj][m][n]), 0, 0, 0)); \
          else acc[ai][bj][m][n] = __builtin_amdgcn_mfma_f32_16x16x32_bf16(Bt[n][k], At[m][k], acc[ai][bj][m][n], 0, 0, 0); } __builtin_amdgcn_s_setprio(0); } while (0)
#define PG8_WAIT_V(n) asm volatile("s_waitcnt vmcnt(" #n ")" ::: "memory")
#define PG8_WAIT_L(n) asm volatile("s_waitcnt lgkmcnt(" #n ")" ::: "memory")
#define PG8_BAR __builtin_amdgcn_s_barrier()
#define PG8_SCHED __builtin_amdgcn_sched_barrier(0)
    Unit cur, nxt; int ui = 0;
    if (!S.next(0, cur)) return;
    f32x4 acc[2][2][4][2];
#pragma unroll
    for (int a = 0; a < 2; ++a)
#pragma unroll
        for (int b = 0; b < 2; ++b)
#pragma unroll
            for (int m = 0; m < 4; ++m)
#pragma unroll
                for (int n = 0; n < 2; ++n) acc[a][b][m][n] = (f32x4){0.f, 0.f, 0.f, 0.f};
    bf16x8 At[4][2], B0[2][2], B1[2][2];
    const char* cA = (const char*)g.A + cur.aoff; const char* cB = (const char*)g.Bt + cur.boff;
    PG8_STAGE(PG8_SB(0, 0), cB, voffB); PG8_STAGE(PG8_SA(0, 0), cA, voffA); PG8_STAGE(PG8_SB(0, 1), cB + hstepB, voffB); PG8_STAGE(PG8_SA(0, 1), cA + hstepA, voffA);
    if (wr == 1) PG8_BAR;
    PG8_WAIT_V(4); PG8_BAR;
    PG8_STAGE(PG8_SB(1, 0), cB + kstep, voffB); PG8_STAGE(PG8_SA(1, 0), cA + kstep, voffA); PG8_STAGE(PG8_SB(1, 1), cB + hstepB + kstep, voffB);
    PG8_WAIT_V(6); PG8_BAR;
    for (;;) {
        const bool has_next = S.next(ui + 1, nxt);
        const char* nA = has_next ? (const char*)g.A + nxt.aoff : cA; const char* nB = has_next ? (const char*)g.Bt + nxt.boff : cB;
        for (int t = 0; t < nt; t += 2) {
            const bool last = (t == nt - 2);
            const char* a1 = cA + (size_t)(t + 1) * kstep;
            const char* a2 = last ? nA : cA + (size_t)(t + 2) * kstep; const char* b2 = last ? nB : cB + (size_t)(t + 2) * kstep;
            const char* a3 = a2 + kstep; const char* b3 = b2 + kstep;
            PG8_LDB(B0, 0, 0); PG8_SCHED; PG8_LDA(At, 0, 0); PG8_STAGE(PG8_SA(1, 1), a1 + hstepA, voffA);
            PG8_WAIT_L(8); PG8_BAR; PG8_WAIT_L(0); PG8_MMA(0, 0, At, B0); PG8_BAR; PG8_SCHED;
            PG8_LDB(B1, 0, 1); PG8_STAGE(PG8_SB(0, 0), b2, voffB);
            PG8_BAR; PG8_WAIT_L(0); PG8_MMA(0, 1, At, B1); PG8_BAR;
            PG8_LDA(At, 0, 1); PG8_STAGE(PG8_SA(0, 0), a2, voffA);
            PG8_BAR; PG8_WAIT_L(0); PG8_MMA(1, 0, At, B0); PG8_BAR; PG8_SCHED;
            PG8_STAGE(PG8_SB(0, 1), b2 + hstepB, voffB);
            PG8_WAIT_V(6); PG8_BAR; PG8_MMA(1, 1, At, B1); PG8_BAR;
            PG8_LDB(B0, 1, 0); PG8_SCHED; PG8_LDA(At, 1, 0); PG8_STAGE(PG8_SA(0, 1), a2 + hstepA, voffA);
            PG8_WAIT_L(8); PG8_BAR; PG8_WAIT_L(0); PG8_MMA(0, 0, At, B0); PG8_BAR; PG8_SCHED;
            PG8_LDB(B1, 1, 1); PG8_STAGE(PG8_SB(1, 0), b3, voffB);
            PG8_BAR; PG8_WAIT_L(0); PG8_MMA(0, 1, At, B1); PG8_BAR;
            PG8_LDA(At, 1, 1); PG8_STAGE(PG8_SA(1, 0), a3, voffA);
            PG8_BAR; PG8_WAIT_L(0); PG8_MMA(1, 0, At, B0); PG8_BAR; PG8_SCHED;
            PG8_STAGE(PG8_SB(1, 1), b3 + hstepB, voffB);
            PG8_WAIT_V(6); PG8_BAR; PG8_MMA(1, 1, At, B1); PG8_BAR;
        }
        if constexpr (I8) {
#pragma unroll
            for (int a = 0; a < 2; ++a)
#pragma unroll
                for (int b = 0; b < 2; ++b)
#pragma unroll
                    for (int m = 0; m < 4; ++m)
#pragma unroll
                        for (int n = 0; n < 2; ++n) { const i32x4 iv = __builtin_bit_cast(i32x4, acc[a][b][m][n]); acc[a][b][m][n] = (f32x4){(float)iv[0], (float)iv[1], (float)iv[2], (float)iv[3]}; } }
        if constexpr (I8 == 2) {
            static_assert(Epi::PERM, "I8 == 2 assumes the PERM column layout");
            f32x4 sbv[2][2];
#pragma unroll
            for (int b = 0; b < 2; ++b) { const int c = cur.pn * BM + b * HALF + wc * 32 + 8 * fq; sbv[b][0] = *(const f32x4*)(g.sb + c); sbv[b][1] = *(const f32x4*)(g.sb + c + 4); }
#pragma unroll
            for (int a = 0; a < 2; ++a)
#pragma unroll
                for (int m = 0; m < 4; ++m) { const float s_ = g.sa[(long)cur.pm * BM + a * HALF + wr * 64 + m * 16 + fr];
#pragma unroll
                    for (int b = 0; b < 2; ++b) { acc[a][b][m][0] = acc[a][b][m][0] * sbv[b][0] * s_; acc[a][b][m][1] = acc[a][b][m][1] * sbv[b][1] * s_; } } }
        E(acc, cur, wr, wc, fr, fq);
        if (!has_next) break;
#pragma unroll
        for (int a = 0; a < 2; ++a)
#pragma unroll
            for (int b = 0; b < 2; ++b)
#pragma unroll
                for (int m = 0; m < 4; ++m)
#pragma unroll
                    for (int n = 0; n < 2; ++n) acc[a][b][m][n] = (f32x4){0.f, 0.f, 0.f, 0.f};
        cur = nxt; cA = nA; cB = nB; ++ui;
    }
    PG8_WAIT_V(0);
    if (wr == 0) PG8_BAR;
    PG8_BAR;
#undef PG8_SA
#undef PG8_SB
#undef PG8_STAGE
#undef PG8_LDA
#undef PG8_LDB
#undef PG8_MMA
#undef PG8_WAIT_V
#undef PG8_WAIT_L
#undef PG8_BAR
#undef PG8_SCHED
}

struct EpiBf16 {
    static constexpr bool PERM = true;
    bf16_t* O; long ldc; long bstride;
    __device__ __forceinline__ void operator()(const f32x4 (&acc)[2][2][4][2], const Unit& u, int wr, int wc, int fr, int fq) const {
        bf16_t* base = O + (long)u.x0 * bstride + (long)(u.pm * BM + wr * 64 + fr) * ldc + u.pn * BM + wc * 32 + 8 * fq;
#pragma unroll
        for (int ai = 0; ai < 2; ++ai)
#pragma unroll
            for (int m = 0; m < 4; ++m) { bf16_t* rowp = base + (long)(ai * HALF + m * 16) * ldc;
#pragma unroll
                for (int bj = 0; bj < 2; ++bj) { const f32x4 v0 = acc[ai][bj][m][0], v1 = acc[ai][bj][m][1];
                    u32x4 w; w.x = cvt_pk_bf16(v0[0], v0[1]); w.y = cvt_pk_bf16(v0[2], v0[3]); w.z = cvt_pk_bf16(v1[0], v1[1]); w.w = cvt_pk_bf16(v1[2], v1[3]);
                    *(u32x4*)(rowp + bj * HALF) = w; } }
    }
};
template <int RMODE> struct EpiRowMap {
    static constexpr bool PERM = true;
    bf16_t* O; const float* rsum;
    __device__ __forceinline__ void operator()(const f32x4 (&acc)[2][2][4][2], const Unit& u, int wr, int wc, int fr, int fq) const {
        const int col0 = u.pn * BM + wc * 32 + 8 * fq;
#pragma unroll
        for (int ai = 0; ai < 2; ++ai)
#pragma unroll
            for (int m = 0; m < 4; ++m) { const int r = ai * HALF + wr * 64 + m * 16 + fr; long drow; long ldc;
                if (RMODE == 1) { const int ts = 256 * u.x1 + r; drow = (long)(ts >> 6) * 1024 + u.x0 * 64 + (ts & 63); ldc = QLD; }
                float rs = 1.0f;
                if (RMODE == 1) { }
                else { const int qr = 256 * u.pm + r; drow = (long)(qr >> 6) * 2048 + u.x0 * 64 + (qr & 63); ldc = 512; rs = 1.0f / rsum[u.x0 * 1024 + qr]; }
                bf16_t* rowp = O + drow * ldc + col0;
#pragma unroll
                for (int bj = 0; bj < 2; ++bj) { const f32x4 v0 = acc[ai][bj][m][0] * rs, v1 = acc[ai][bj][m][1] * rs;
                    u32x4 w; w.x = cvt_pk_bf16(v0[0], v0[1]); w.y = cvt_pk_bf16(v0[2], v0[3]); w.z = cvt_pk_bf16(v1[0], v1[1]); w.w = cvt_pk_bf16(v1[2], v1[3]);
                    *(u32x4*)(rowp + bj * HALF) = w; } }
    }
};
struct EpiOV {
    static constexpr bool PERM = true;
    bf16_t* O;
    __device__ __forceinline__ void operator()(const f32x4 (&acc)[2][2][4][2], const Unit& u, int wr, int wc, int fr, int fq) const {
#pragma unroll
        for (int ai = 0; ai < 2; ++ai)
#pragma unroll
            for (int m = 0; m < 4; ++m) { const int r = ai * HALF + wr * 64 + m * 16 + fr;
                bf16_t* rowp = O + (long)(TP + 256 * u.x1 + r) * DM + u.x0 * 128 + wc * 32 + 8 * fq;
                const f32x4 v0 = acc[ai][1][m][0], v1 = acc[ai][1][m][1];
                u32x4 w; w.x = cvt_pk_bf16(v0[0], v0[1]); w.y = cvt_pk_bf16(v0[2], v0[3]); w.z = cvt_pk_bf16(v1[0], v1[1]); w.w = cvt_pk_bf16(v1[2], v1[3]);
                *(u32x4*)rowp = w; }
    }
};
struct EpiMix {
    static constexpr bool PERM = true;
    const bf16_t* Y; const bf16_t* YA; bf16_t* MIX; const float* sa; const float* sb;
    __device__ __forceinline__ void operator()(const f32x4 (&acc)[2][2][4][2], const Unit& u, int wr, int wc, int fr, int fq) const {
#pragma unroll
        for (int ai = 0; ai < 2; ++ai)
#pragma unroll
            for (int m = 0; m < 4; ++m) { const long t = (long)u.pm * BM + ai * HALF + wr * 64 + m * 16 + fr; const float s_ = sa[t];
#pragma unroll
                for (int bj = 0; bj < 2; ++bj) { const int c = u.pn * BM + bj * HALF + wc * 32 + 8 * fq;
                    const u32x4 ga = *(const u32x4*)(Y + t * INWP + C_GA + c), gb = *(const u32x4*)(Y + t * INWP + C_GB + c), ya = *(const u32x4*)(YA + t * DM + c);
                    float fa[8], fb[8], fy[8], o[8]; unpack8(ga, fa); unpack8(gb, fb); unpack8(ya, fy);
                    const f32x4 v0 = acc[ai][bj][m][0] * *(const f32x4*)(sb + c) * s_, v1 = acc[ai][bj][m][1] * *(const f32x4*)(sb + c + 4) * s_;
                    const float av[8] = {v0[0], v0[1], v0[2], v0[3], v1[0], v1[1], v1[2], v1[3]};
#pragma unroll
                    for (int j = 0; j < 8; ++j) {
#if defined(DBG_MIX) && DBG_MIX == 1
                        o[j] = sigmoidf_(fb[j]) * av[j];
#elif defined(DBG_MIX) && DBG_MIX == 2
                        o[j] = sigmoidf_(fa[j]) * fy[j];
#else
                        o[j] = sigmoidf_(fa[j]) * fy[j] + sigmoidf_(fb[j]) * av[j];
#endif
                    }
                    *(u32x4*)(MIX + t * DM + c) = pack8(o); } }
    }
};
struct EpiRes {
    static constexpr bool PERM = false;
    float* X; const float* gate;
    const float* XinP; const float* XinS;
    __device__ __forceinline__ void operator()(const f32x4 (&acc)[2][2][4][2], const Unit& u, int wr, int wc, int fr, int fq) const {
#pragma unroll
        for (int ai = 0; ai < 2; ++ai)
#pragma unroll
            for (int m = 0; m < 4; ++m) { const int t = u.pm * BM + ai * HALF + wr * 64 + m * 16 + fr; const float* gr = gate + (long)cond_row(t) * 12288; float* xr = X + (long)t * DM; const float* xi = t < TP ? XinP + (long)t * DM : XinS + (long)(t - TP) * DM;
#pragma unroll
                for (int bj = 0; bj < 2; ++bj)
#pragma unroll
                    for (int n = 0; n < 2; ++n) { const int c = u.pn * BM + bj * HALF + wc * 32 + n * 16 + 4 * fq;
                        const f32x4 gv = *(const f32x4*)(gr + c); const f32x4 xv = *(const f32x4*)(xi + c);
                        *(f32x4*)(xr + c) = xv + gv * acc[ai][bj][m][n]; } }
    }
};

struct EpiQ {
    static constexpr bool PERM = true;
    bf16_t* Q; bf16_t* QL; const float* T64;
    __device__ __forceinline__ void operator()(const f32x4 (&acc)[2][2][4][2], const Unit& u, int wr, int wc, int fr, int fq) const {
        const int grp = u.pn / 3, typ = u.pn - 3 * grp;
        if (typ < 2) {
#pragma unroll
            for (int ai = 0; ai < 2; ++ai)
#pragma unroll
                for (int m = 0; m < 4; ++m) { const long t = (long)u.pm * BM + ai * HALF + wr * 64 + m * 16 + fr;
#pragma unroll
                    for (int bj = 0; bj < 2; ++bj) { const f32x4 v0 = acc[ai][bj][m][0], v1 = acc[ai][bj][m][1];
                        u32x4 w; w.x = cvt_pk_bf16(v0[0], v0[1]); w.y = cvt_pk_bf16(v0[2], v0[3]); w.z = cvt_pk_bf16(v1[0], v1[1]); w.w = cvt_pk_bf16(v1[2], v1[3]);
                        *(u32x4*)(Q + t * 3072 + 768 * grp + 192 * (2 * typ + bj) + wc * 32 + 8 * fq) = w; } }
        } else {
#pragma unroll
            for (int ai = 0; ai < 2; ++ai)
#pragma unroll
                for (int m = 0; m < 4; ++m) { const int t = u.pm * BM + ai * HALF + wr * 64 + m * 16 + fr; const int pos = tok_pos(t);
                    const float* cs = T64 + ((long)pos * 32 + 8 * fq) * 2; float cv[8], sv[8];
#pragma unroll
                    for (int j = 0; j < 4; ++j) { const f32x4 qv = *(const f32x4*)(cs + 4 * j); cv[2 * j] = qv[0]; sv[2 * j] = qv[1]; cv[2 * j + 1] = qv[2]; sv[2 * j + 1] = qv[3]; }
                    const f32x4 a0 = acc[ai][0][m][0], a1 = acc[ai][0][m][1], b0 = acc[ai][1][m][0], b1 = acc[ai][1][m][1];
                    const float x1[8] = {a0[0], a0[1], a0[2], a0[3], a1[0], a1[1], a1[2], a1[3]}, x2[8] = {b0[0], b0[1], b0[2], b0[3], b1[0], b1[1], b1[2], b1[3]};
                    float o1[8], o2[8];
#pragma unroll
                    for (int j = 0; j < 8; ++j) { o1[j] = x1[j] * cv[j] - x2[j] * sv[j]; o2[j] = x1[j] * sv[j] + x2[j] * cv[j]; }
                    const u32x4 w1 = pack8(o1), w2 = pack8(o2); const int hd = 4 * grp + wc;
                    bf16_t* qd = Q + (long)t * 3072 + hd * 192 + 128 + 8 * fq; *(u32x4*)qd = w1; *(u32x4*)(qd + 32) = w2;
                    if (t >= TP) { const int ts = t - TP; bf16_t* d = QL + ((long)(ts >> 6) * 1024 + hd * 64 + (ts & 63)) * QLD + 512 + 8 * fq; *(u32x4*)d = w1; *(u32x4*)(d + 32) = w2; } }
        }
    }
};

struct EpiExp {
    static constexpr bool PERM = true;
    bf16_t* O; float* rsum;
    __device__ __forceinline__ void operator()(const f32x4 (&acc)[2][2][4][2], const Unit& u, int wr, int wc, int fr, int fq) const {
        bf16_t* base = O + (long)u.x0 * 1024 * KPAD + (long)(u.pm * BM + wr * 64 + fr) * KPAD + u.pn * BM + wc * 32 + 8 * fq;
#pragma unroll
        for (int ai = 0; ai < 2; ++ai)
#pragma unroll
            for (int m = 0; m < 4; ++m) { bf16_t* rowp = base + (long)(ai * HALF + m * 16) * KPAD; float part = 0.f;
#pragma unroll
                for (int bj = 0; bj < 2; ++bj) { const int c0 = u.pn * BM + bj * HALF + wc * 32 + 8 * fq; const f32x4 v0 = acc[ai][bj][m][0], v1 = acc[ai][bj][m][1];
                    const float sv[8] = {v0[0], v0[1], v0[2], v0[3], v1[0], v1[1], v1[2], v1[3]}; float e[8];
#pragma unroll
                    for (int j = 0; j < 8; ++j) { e[j] = (c0 + j < KALL) ? __expf(fminf(sv[j] * MLA_SCALE, 60.f)) : 0.f; part += e[j]; }
                    *(u32x4*)(rowp + bj * HALF) = pack8(e); }
                part += sx<16>(part); part += sx<32>(part);
                if (fq == 0) atomicAdd(rsum + u.x0 * 1024 + u.pm * BM + ai * HALF + wr * 64 + m * 16 + fr, part); }
    }
};

struct EpiQ8 {
    static constexpr bool PERM = true;
    bf16_t* O; long ldc; const float* sa; const float* sb;
    __device__ __forceinline__ void operator()(const f32x4 (&acc)[2][2][4][2], const Unit& u, int wr, int wc, int fr, int fq) const {
        f32x4 sbv[2][2];
#pragma unroll
        for (int bj = 0; bj < 2; ++bj) { const int c = u.pn * BM + bj * HALF + wc * 32 + 8 * fq; sbv[bj][0] = *(const f32x4*)(sb + c); sbv[bj][1] = *(const f32x4*)(sb + c + 4); }
#pragma unroll
        for (int ai = 0; ai < 2; ++ai)
#pragma unroll
            for (int m = 0; m < 4; ++m) { const long t = (long)u.pm * BM + ai * HALF + wr * 64 + m * 16 + fr; const float s = sa[t];
#pragma unroll
                for (int bj = 0; bj < 2; ++bj) { const f32x4 v0 = acc[ai][bj][m][0] * sbv[bj][0] * s, v1 = acc[ai][bj][m][1] * sbv[bj][1] * s;
                    u32x4 w; w.x = cvt_pk_bf16(v0[0], v0[1]); w.y = cvt_pk_bf16(v0[2], v0[3]); w.z = cvt_pk_bf16(v1[0], v1[1]); w.w = cvt_pk_bf16(v1[2], v1[3]);
                    *(u32x4*)(O + t * ldc + u.pn * BM + bj * HALF + wc * 32 + 8 * fq) = w; } }
    }
};
}
namespace att {
constexpr int NW = 8, QBLK = 32, KVBLK = 64;
constexpr float SCALE = MLA_SCALE;
constexpr float THR = 8.f;
constexpr int KROW = 384;
constexpr int SHM_V = KVBLK * 128 * 2, SHM_K = KVBLK * KROW;
constexpr int QR_PITCH = 144, SHM_QR = 256 * QR_PITCH;
constexpr int SHM_ATTN = 2 * SHM_V + 2 * SHM_K + NW * 64 * 4 + SHM_QR;
#define KSWZ(row, colB) ((row) * att::KROW + ((colB) ^ (((row) & 7) << 4)))
#define SBAR() __builtin_amdgcn_sched_barrier(0)
__device__ __forceinline__ int crow(int r, int hi) { return (r & 3) + 8 * (r >> 2) + 4 * hi; }

__device__ __forceinline__ void partialSM(f32x16& p0, f32x16& p1, float& m_reg, float& mn, float& alpha) {
  constexpr float C = SCALE * 1.4426950408889634f;
  float pmax = p0[0];
#pragma unroll
  for (int r = 1; r < 16; ++r) pmax = fmaxf(pmax, p0[r]);
#pragma unroll
  for (int r = 0; r < 16; ++r) pmax = fmaxf(pmax, p1[r]);
  { auto rr = __builtin_amdgcn_permlane32_swap(__float_as_uint(pmax), __float_as_uint(pmax), false, false);
    pmax = fmaxf(__uint_as_float(rr[0]), __uint_as_float(rr[1])); }
  if (__builtin_expect(__all(pmax - m_reg <= THR / SCALE), 1)) { mn = m_reg; alpha = 1.f; }
  else { mn = fmaxf(m_reg, pmax); alpha = __builtin_amdgcn_exp2f((m_reg - mn) * C); m_reg = mn; }
  float mnC = -mn * C;
#pragma unroll
  for (int r = 0; r < 16; ++r) p0[r] = fmaf(p0[r], C, mnC);
#pragma unroll
  for (int r = 0; r < 16; ++r) p1[r] = fmaf(p1[r], C, mnC);
#pragma unroll
  for (int r = 0; r < 16; ++r) p0[r] = __builtin_amdgcn_exp2f(p0[r]);
}
__device__ __forceinline__ void finishSM(f32x16& p0, f32x16& p1, float alpha, float& l_reg, bf16x8& pa0, bf16x8& pa1, bf16x8& pa2, bf16x8& pa3) {
#pragma unroll
  for (int r = 0; r < 16; ++r) p1[r] = __builtin_amdgcn_exp2f(p1[r]);
  float ps = 0;
#pragma unroll
  for (int r = 0; r < 16; ++r) ps += p0[r];
#pragma unroll
  for (int r = 0; r < 16; ++r) ps += p1[r];
  { auto rr = __builtin_amdgcn_permlane32_swap(__float_as_uint(ps), __float_as_uint(ps), false, false);
    ps = __uint_as_float(rr[0]) + __uint_as_float(rr[1]); }
  l_reg = l_reg * alpha + ps;
#define PK4(P, BASE, OUT) do { unsigned a0 = cvt_pk_bf16(P[BASE + 0], P[BASE + 1]), a1 = cvt_pk_bf16(P[BASE + 2], P[BASE + 3]);   \
    unsigned b0 = cvt_pk_bf16(P[BASE + 4], P[BASE + 5]), b1 = cvt_pk_bf16(P[BASE + 6], P[BASE + 7]);                              \
    auto r0 = __builtin_amdgcn_permlane32_swap(a0, b0, false, false); auto r1 = __builtin_amdgcn_permlane32_swap(a1, b1, false, false); \
    u32x4 w = {r0[0], r1[0], r0[1], r1[1]}; OUT = *reinterpret_cast<bf16x8*>(&w); } while (0)
  PK4(p0, 0, pa0); PK4(p0, 8, pa1); PK4(p1, 0, pa2); PK4(p1, 8, pa3);
#undef PK4
}
__device__ __forceinline__ void qkt(f32x16& p0, f32x16& p1, const char* Ks, const bf16x8* qr, const char* qrope, const int (&kbase)[4], bool vis) {
  p0 = f32x16{}; p1 = f32x16{};
  if (vis) {
#pragma unroll
  for (int d0 = 0; d0 < 12; ++d0) {
    bf16x8 b0 = *reinterpret_cast<const bf16x8*>(Ks + kbase[d0 & 3] + (d0 >> 2) * 128);
    bf16x8 b1 = *reinterpret_cast<const bf16x8*>(Ks + kbase[d0 & 3] + (d0 >> 2) * 128 + 32 * KROW);
    const bf16x8 qv = d0 < 8 ? qr[d0 < 8 ? d0 : 0] : *reinterpret_cast<const bf16x8*>(qrope + (d0 - 8) * 32);
    p0 = __builtin_amdgcn_mfma_f32_32x32x16_bf16(b0, qv, p0, 0, 0, 0);
    p1 = __builtin_amdgcn_mfma_f32_32x32x16_bf16(b1, qv, p1, 0, 0, 0); }
  }
  if (!vis) {
#pragma unroll
    for (int r = 0; r < 16; ++r) { p0[r] = -1e30f; p1[r] = -1e30f; } }
}
__device__ __forceinline__ int v_st(int k, int c) { const int kk = (k & ~0xC) | ((k & 4) << 1) | ((k & 8) >> 1); return ((kk >> 3) * 4 + (c >> 5)) * 512 + ((kk & 7) * 32 + (c & 31)) * 2; }
__device__ __forceinline__ int v_rd_base(int lane) { return ((lane & 3) << 3) | (((lane >> 2) & 3) << 6) | (((lane >> 4) & 1) << 5) | (((lane >> 5) & 1) << 8); }
constexpr int v_rd_off(int d0, int ks, int half) { return d0 * 512 + ks * 4096 + half * 2048; }
template <int OFF> __device__ __forceinline__ s16x4 tr_read(int vb) {
  s16x4 r; asm volatile("ds_read_b64_tr_b16 %0, %1 offset:%2" : "=&v"(r) : "v"(vb), "i"(OFF) : "memory"); return r;
}
template <int D0> __device__ __forceinline__ void pv_one(f32x16& od, int vb, bf16x8 pa0, bf16x8 pa1, bf16x8 pa2, bf16x8 pa3) {
  const s16x4 l0 = tr_read<v_rd_off(D0, 0, 0)>(vb), h0 = tr_read<v_rd_off(D0, 0, 1)>(vb), l1 = tr_read<v_rd_off(D0, 1, 0)>(vb), h1 = tr_read<v_rd_off(D0, 1, 1)>(vb);
  const s16x4 l2 = tr_read<v_rd_off(D0, 2, 0)>(vb), h2 = tr_read<v_rd_off(D0, 2, 1)>(vb), l3 = tr_read<v_rd_off(D0, 3, 0)>(vb), h3 = tr_read<v_rd_off(D0, 3, 1)>(vb);
  asm volatile("s_waitcnt lgkmcnt(0)" ::: "memory"); SBAR();
#define PK(L, H) (bf16x8){L[0], L[1], L[2], L[3], H[0], H[1], H[2], H[3]}
  od = __builtin_amdgcn_mfma_f32_32x32x16_bf16(pa0, PK(l0, h0), od, 0, 0, 0);
  od = __builtin_amdgcn_mfma_f32_32x32x16_bf16(pa1, PK(l1, h1), od, 0, 0, 0);
  od = __builtin_amdgcn_mfma_f32_32x32x16_bf16(pa2, PK(l2, h2), od, 0, 0, 0);
  od = __builtin_amdgcn_mfma_f32_32x32x16_bf16(pa3, PK(l3, h3), od, 0, 0, 0);
#undef PK
}
__device__ __forceinline__ void pv_d0(f32x16* o, int vb, bf16x8 pa0, bf16x8 pa1, bf16x8 pa2, bf16x8 pa3) {
  pv_one<0>(o[0], vb, pa0, pa1, pa2, pa3); pv_one<1>(o[1], vb, pa0, pa1, pa2, pa3); pv_one<2>(o[2], vb, pa0, pa1, pa2, pa3); pv_one<3>(o[3], vb, pa0, pa1, pa2, pa3);
}

__device__ __forceinline__ void attn_block(const bf16_t* __restrict__ Qb, const bf16_t* __restrict__ Kn, const bf16_t* __restrict__ Kr, const bf16_t* __restrict__ Vh,
                                           bf16_t* __restrict__ Ob, int qb, char* lds) {
  constexpr int LDQ = 3072, LDK = 4096, LDR = 64, LDO = 2048;
  const int tid = otid(), wid = tid >> 6, lane = tid & 63, r32 = lane & 31, hi = lane >> 5;
  char* V_lds = lds; char* K_lds = lds + 2 * SHM_V;
  float* ws = (float*)(lds + 2 * SHM_V + 2 * SHM_K) + wid * 64; float* li_l = ws; float* al_l = ws + 32;
  float m_reg = -1e30f, l_reg = 0; f32x16 o[4] = {}; bf16x8 qr[8];
  const bf16_t* Qw = Qb + (long)(wid * QBLK + r32) * LDQ + hi * 8;
#pragma unroll
  for (int d0 = 0; d0 < 8; ++d0) qr[d0] = *reinterpret_cast<const bf16x8*>(Qw + d0 * 16);
  char* qrope = lds + 2 * SHM_V + 2 * SHM_K + NW * 64 * 4 + (wid * QBLK + r32) * QR_PITCH + hi * 16;
#pragma unroll
  for (int d0 = 8; d0 < 12; ++d0) *reinterpret_cast<bf16x8*>(qrope + (d0 - 8) * 32) = *reinterpret_cast<const bf16x8*>(Qw + d0 * 16);
  asm volatile("s_waitcnt lgkmcnt(0)" ::: "memory");
  const int NT = 4 * qb + 4, jmax = 4 * qb + (wid >> 1);
  int kbase[4];
#pragma unroll
  for (int dl = 0; dl < 4; ++dl) kbase[dl] = r32 * KROW + (((dl << 5) | (hi << 4)) ^ ((r32 & 7) << 4));
  const int sr = tid >> 4, sc = (tid & 15) * 8, vst0 = v_st(sr, sc), vst1 = v_st(32 + sr, sc);
  const int rr = tid >> 3, rc = (tid & 7) * 8;
  const int vb0 = (int)(uintptr_t)V_lds + v_rd_base(lane);
  bf16x8 vs0, vs1, ks0, ks1, kr0;
#define SLOAD(k0) do { vs0 = *reinterpret_cast<const bf16x8*>(&Vh[(long)((k0) + sr) * LDK + sc]); vs1 = *reinterpret_cast<const bf16x8*>(&Vh[(long)((k0) + 32 + sr) * LDK + sc]); \
    ks0 = *reinterpret_cast<const bf16x8*>(&Kn[(long)((k0) + sr) * LDK + sc]); ks1 = *reinterpret_cast<const bf16x8*>(&Kn[(long)((k0) + 32 + sr) * LDK + sc]); \
    kr0 = *reinterpret_cast<const bf16x8*>(&Kr[(long)((k0) + rr) * LDR + rc]); } while (0)
#define SWRITE(b) do { *(bf16x8*)(V_lds + (b) * SHM_V + vst0) = vs0; *(bf16x8*)(V_lds + (b) * SHM_V + vst1) = vs1; int kc = sc * 2; \
    *(bf16x8*)(K_lds + (b) * SHM_K + KSWZ(sr, kc)) = ks0; *(bf16x8*)(K_lds + (b) * SHM_K + KSWZ(32 + sr, kc)) = ks1; \
    *(bf16x8*)(K_lds + (b) * SHM_K + KSWZ(rr, 256 + rc * 2)) = kr0; } while (0)
#define SWAIT() asm volatile("s_waitcnt vmcnt(0)" ::: "memory")
#define RESC(a) do { if (__any((a) < 1.f)) { if (hi == 0) al_l[r32] = (a); asm volatile("s_waitcnt lgkmcnt(0)" ::: "memory"); \
    _Pragma("unroll") for (int d = 0; d < 4; ++d) _Pragma("unroll") for (int r = 0; r < 16; ++r) o[d][r] *= al_l[crow(r, hi)]; } } while (0)
  f32x16 pA0, pA1, pB0, pB1; float mnA, mnB, alA, alB; bf16x8 pa0, pa1, pa2, pa3;
  SLOAD(0); SWAIT(); SWRITE(0); __syncthreads();
  qkt(pA0, pA1, K_lds, qr, qrope, kbase, true); partialSM(pA0, pA1, m_reg, mnA, alA);
  SLOAD(KVBLK);
  SWAIT(); SWRITE(1); __syncthreads();
  for (int j = 1; j + 1 < NT; j += 2) {
    SBAR(); qkt(pB0, pB1, K_lds + SHM_K, qr, qrope, kbase, j <= jmax);
    finishSM(pA0, pA1, alA, l_reg, pa0, pa1, pa2, pa3); SBAR();
    SLOAD((j + 1) * KVBLK); SBAR();
    if (j - 1 <= jmax) pv_d0(o, vb0, pa0, pa1, pa2, pa3);
    partialSM(pB0, pB1, m_reg, mnB, alB);
    __syncthreads(); SWAIT(); SWRITE(0);
    RESC(alB); __syncthreads();
    SBAR(); qkt(pA0, pA1, K_lds, qr, qrope, kbase, j + 1 <= jmax);
    finishSM(pB0, pB1, alB, l_reg, pa0, pa1, pa2, pa3); SBAR();
    SLOAD((j + 2) * KVBLK); SBAR();
    if (j <= jmax) pv_d0(o, vb0 + (int)SHM_V, pa0, pa1, pa2, pa3);
    partialSM(pA0, pA1, m_reg, mnA, alA);
    __syncthreads(); SWAIT(); SWRITE(1);
    RESC(alA); __syncthreads();
  }
  SBAR(); qkt(pB0, pB1, K_lds + SHM_K, qr, qrope, kbase, NT - 1 <= jmax);
  finishSM(pA0, pA1, alA, l_reg, pa0, pa1, pa2, pa3); SBAR();
  if (NT - 2 <= jmax) pv_d0(o, vb0, pa0, pa1, pa2, pa3);
  partialSM(pB0, pB1, m_reg, mnB, alB);
  __syncthreads(); RESC(alB);
  finishSM(pB0, pB1, alB, l_reg, pa0, pa1, pa2, pa3); SBAR();
  if (NT - 1 <= jmax) pv_d0(o, vb0 + (int)SHM_V, pa0, pa1, pa2, pa3);
  if (hi == 0) li_l[r32] = l_reg; asm volatile("s_waitcnt lgkmcnt(0)" ::: "memory");
  float rli[16];
#pragma unroll
  for (int r = 0; r < 16; ++r) rli[r] = __builtin_amdgcn_rcpf(li_l[crow(r, hi)]);
  bf16_t* Ow = Ob + (long)(wid * QBLK) * LDO;
#pragma unroll
  for (int r = 0; r < 16; ++r) { int orow = crow(r, hi);
#pragma unroll
    for (int d0 = 0; d0 < 4; ++d0) Ow[(long)orow * LDO + d0 * 32 + r32] = f2bf(o[d0][r] * rli[r]); }
  __syncthreads();
#undef SLOAD
#undef SWRITE
#undef SWAIT
#undef RESC
}
}
namespace ret {
constexpr int QP_ = 136;
__device__ __forceinline__ bf16x8 ldfrag(const bf16_t* p) { return *reinterpret_cast<const bf16x8*>(p); }
template <int CL> struct Lay {
    static constexpr int IP = CL + 8;
    static constexpr int QS = 0, KS = QS + CL * QP_ * 2, VT = KS + CL * QP_ * 2, VDT = VT + 32 * IP * 2, IN = VDT + 32 * IP * 2, ST = IN + CL * IP * 2, VS = ST + 32 * QP_ * 2, END = VS + CL * 40 * 2;
};
static_assert(Lay<128>::END <= LDS_BARW, "retention LDS");

template <int CL>
__device__ __forceinline__ void run(const bf16_t* __restrict__ Y, bf16_t* __restrict__ OB, const float* __restrict__ sp, float* __restrict__ so, long tok0, int nch, int h, int es, float lg, char* lds, int tid) {
    using L = Lay<CL>; constexpr int IP = L::IP, NQT = CL / 16, NKS = CL / 32, NPC = CL / 32;
    const int wid = __builtin_amdgcn_readfirstlane(tid >> 6), lane = tid & 63, l15 = lane & 15, l4 = lane >> 4;
    bf16_t* Qs = (bf16_t*)(lds + L::QS); bf16_t* Ks = (bf16_t*)(lds + L::KS); bf16_t* Vt = (bf16_t*)(lds + L::VT); bf16_t* Vdt = (bf16_t*)(lds + L::VDT); bf16_t* In = (bf16_t*)(lds + L::IN); bf16_t* St = (bf16_t*)(lds + L::ST); bf16_t* Vs = (bf16_t*)(lds + L::VS);
    const float gCL = __expf((float)CL * lg);
    f32x4 Sacc[2];
    if (sp) {
#pragma unroll
        for (int ej = 0; ej < 2; ++ej)
#pragma unroll
            for (int r = 0; r < 4; ++r) Sacc[ej][r] = sp[(long)(16 * wid + 4 * l4 + r) * RV + 16 * ej + l15];
    } else { Sacc[0] = (f32x4){0.f, 0.f, 0.f, 0.f}; Sacc[1] = (f32x4){0.f, 0.f, 0.f, 0.f}; }
    for (int i = tid; i < CL * IP / 8; i += 512) reinterpret_cast<u32x4*>(In)[i] = (u32x4){0u, 0u, 0u, 0u};
    u32x4 pq[NPC], pk[NPC], pv;
    const int vk = tid >> 2, ve0 = (tid & 3) * 8;
#define RET_LOAD(cc) do { const bf16_t* yrow_ = Y + (tok0 + (long)(cc) * CL) * INWP; \
        _Pragma("unroll") for (int i = 0; i < NPC; ++i) { const int idx = tid + i * 512, k = idx >> 4, d0 = (idx & 15) * 8; \
            pq[i] = *reinterpret_cast<const u32x4*>(yrow_ + (long)k * INWP + C_RQ + h * 128 + d0); pk[i] = *reinterpret_cast<const u32x4*>(yrow_ + (long)k * INWP + C_RK + h * 128 + d0); } \
        if (tid < 4 * CL) pv = *reinterpret_cast<const u32x4*>(yrow_ + (long)vk * INWP + C_RV + h * 256 + es * 32 + ve0); } while (0)
    RET_LOAD(0);
    for (int c = 0; c < nch; ++c) {
#pragma unroll
        for (int ej = 0; ej < 2; ++ej) { u32x2 w; w.x = cvt_pk_bf16(Sacc[ej][0], Sacc[ej][1]); w.y = cvt_pk_bf16(Sacc[ej][2], Sacc[ej][3]);
            *reinterpret_cast<u32x2*>(St + (16 * ej + l15) * QP_ + 16 * wid + 4 * l4) = w; }
#pragma unroll
        for (int i = 0; i < NPC; ++i) { const int idx = tid + i * 512, k = idx >> 4, d0 = (idx & 15) * 8;
            *reinterpret_cast<u32x4*>(Qs + k * QP_ + d0) = pq[i]; *reinterpret_cast<u32x4*>(Ks + k * QP_ + d0) = pk[i]; }
        if (tid < 4 * CL) *reinterpret_cast<u32x4*>(Vs + vk * 40 + ve0) = pv;
        if (c + 1 < nch) RET_LOAD(c + 1);
        __syncthreads();
        if (tid < 4 * CL) { const int e = tid & 31, kg = tid >> 5; float f[8], fd[8];
#pragma unroll
            for (int j = 0; j < 8; ++j) { f[j] = bf2f(Vs[(8 * kg + j) * 40 + e]); fd[j] = f[j] * __expf((float)(CL - 1 - 8 * kg - j) * lg); }
            *reinterpret_cast<u32x4*>(Vt + e * IP + 8 * kg) = pack8(f); *reinterpret_cast<u32x4*>(Vdt + e * IP + 8 * kg) = pack8(fd); }
#pragma unroll
        for (int it_ = 0; it_ < (NQT * (NQT + 1) / 2 + 7) / 8; ++it_) { const int idx = wid + 8 * it_; if (idx >= NQT * (NQT + 1) / 2) break;
            int qi = 0; while ((qi + 1) * (qi + 2) / 2 <= idx) ++qi; const int kj = idx - qi * (qi + 1) / 2;
            f32x4 a = (f32x4){0.f, 0.f, 0.f, 0.f}; const bf16_t* qp = Qs + (16 * qi + l15) * QP_ + 8 * l4; const bf16_t* kp = Ks + (16 * kj + l15) * QP_ + 8 * l4;
#pragma unroll
            for (int ks = 0; ks < 4; ++ks) a = __builtin_amdgcn_mfma_f32_16x16x32_bf16(ldfrag(qp + 32 * ks), ldfrag(kp + 32 * ks), a, 0, 0, 0);
            const int q0 = 16 * qi + 4 * l4, k = 16 * kj + l15;
#pragma unroll
            for (int r = 0; r < 4; ++r) { const int q = q0 + r; const float dm = (q >= k) ? __expf((float)(q - k) * lg) : 0.f;
                In[q * IP + k] = f2bf(a[r] * dm); } }
        __syncthreads();
#pragma unroll
        for (int ot = 0; ot < (2 * NQT) / 8; ++ot) { const int tI = wid + 8 * ot, qi = tI >> 1, ej = tI & 1; f32x4 a = (f32x4){0.f, 0.f, 0.f, 0.f};
#pragma unroll
            for (int ks = 0; ks < 4; ++ks) a = __builtin_amdgcn_mfma_f32_16x16x32_bf16(ldfrag(Qs + (16 * qi + l15) * QP_ + 32 * ks + 8 * l4), ldfrag(St + (16 * ej + l15) * QP_ + 32 * ks + 8 * l4), a, 0, 0, 0);
#pragma unroll
            for (int r = 0; r < 4; ++r) a[r] *= __expf((float)(16 * qi + 4 * l4 + r + 1) * lg);
#pragma unroll
            for (int ks = 0; ks < NKS; ++ks) if (ks <= (qi >> 1)) a = __builtin_amdgcn_mfma_f32_16x16x32_bf16(ldfrag(In + (16 * qi + l15) * IP + 32 * ks + 8 * l4), ldfrag(Vt + (16 * ej + l15) * IP + 32 * ks + 8 * l4), a, 0, 0, 0);
            bf16_t* op = OB + ((long)(h * 8 + es) * T + tok0 + (long)c * CL + 16 * qi + 4 * l4) * 32 + 16 * ej + l15;
#pragma unroll
            for (int r = 0; r < 4; ++r) op[r * 32] = f2bf(a[r]); }
        { f32x4 s0 = Sacc[0] * gCL, s1 = Sacc[1] * gCL;
#pragma unroll
          for (int ks = 0; ks < NKS; ++ks) { bf16x8 af;
#pragma unroll
              for (int j = 0; j < 8; ++j) af[j] = (short)Ks[(32 * ks + 8 * l4 + j) * QP_ + 16 * wid + l15];
              s0 = __builtin_amdgcn_mfma_f32_16x16x32_bf16(af, ldfrag(Vdt + l15 * IP + 32 * ks + 8 * l4), s0, 0, 0, 0);
              s1 = __builtin_amdgcn_mfma_f32_16x16x32_bf16(af, ldfrag(Vdt + (16 + l15) * IP + 32 * ks + 8 * l4), s1, 0, 0, 0); }
          Sacc[0] = s0; Sacc[1] = s1; }
        __syncthreads();
    }
#undef RET_LOAD
#pragma unroll
    for (int ej = 0; ej < 2; ++ej)
#pragma unroll
        for (int r = 0; r < 4; ++r) so[(long)(16 * wid + 4 * l4 + r) * RV + 16 * ej + l15] = Sacc[ej][r];
}

__device__ __forceinline__ void unit(KParams& p, int l, int u, char* lds) {
    const int tid = otid(); unsigned char* ws = optr(gp(p.ws)); const bf16_t* Y = (const bf16_t*)(ws + WS_Y); bf16_t* OB = (bf16_t*)(ws + WS_OB);
    const bool samp = u >= 256; const int v = samp ? u - 256 : u; const int b = v >> 6, h = (v >> 3) & 7, es = v & 7; const float lg = p.lg[h];
    if (samp) run<64>(Y, OB, gp(p.state_ret) + ((((long)l * DB + b) * RH + h) * RQK) * RV + es * 32, gp(p.out) + O_RETS + ((((long)l * DB + b) * RH + h) * RQK) * RV + es * 32, (long)TP + b * 64, 1, h, es, lg, lds, tid);
    else run<64>(Y, OB, nullptr, gp(p.out) + O_RETP + ((((long)l * NB + b) * RH + h) * RQK) * RV + es * 32, (long)b * SEQ, SEQ / 64, h, es, lg, lds, tid);
}
}
namespace peer {
__device__ __forceinline__ void ins16(float (&l)[16], float x) {
#pragma unroll
    for (int j = 0; j < 16; ++j) { const float hi = fmaxf(l[j], x); x = fminf(l[j], x); l[j] = hi; }
}
#define CE_DESC(a, b) do { const float hi_ = fmaxf(a, b), lo_ = fminf(a, b); a = hi_; b = lo_; } while (0)
#define CE_ASC(a, b) do { const float hi_ = fmaxf(a, b), lo_ = fminf(a, b); a = lo_; b = hi_; } while (0)
__device__ __forceinline__ void sort16_desc(float (&v)[16]) {
#pragma unroll
    for (int k = 2; k <= 16; k <<= 1)
#pragma unroll
        for (int j = k >> 1; j >= 1; j >>= 1)
#pragma unroll
            for (int i = 0; i < 16; ++i) { const int l = i ^ j; if (l > i) { if ((i & k) == 0) CE_DESC(v[i], v[l]); else CE_ASC(v[i], v[l]); } }
}
__device__ __forceinline__ void merge16_desc(float (&l)[16], const float (&o)[16]) {
#pragma unroll
    for (int i = 0; i < 16; ++i) l[i] = fmaxf(l[i], o[15 - i]);
#pragma unroll
    for (int j = 8; j >= 1; j >>= 1)
#pragma unroll
        for (int i = 0; i < 16; ++i) { const int m = i ^ j; if (m > i) CE_DESC(l[i], l[m]); }
}
constexpr int KPITCH = 136;
__device__ __forceinline__ void half_top16(const bf16_t* __restrict__ qrow, const bf16_t* __restrict__ keys, int lane, float (&l)[16]) {
    const int r32 = lane & 31, g = lane >> 5;
#pragma unroll
    for (int j = 0; j < 16; ++j) l[j] = -3.0e38f;
    bf16x8 qf[8];
#pragma unroll
    for (int ks = 0; ks < 8; ++ks) qf[ks] = *reinterpret_cast<const bf16x8*>(qrow + 16 * ks + 8 * g);
#pragma unroll 1
    for (int kb = 0; kb < 4; ++kb) { f32x16 a = f32x16{};
#pragma unroll
        for (int ks = 0; ks < 8; ++ks) { const bf16x8 kf = *reinterpret_cast<const bf16x8*>(keys + (32 * kb + r32) * KPITCH + 16 * ks + 8 * g);
            a = __builtin_amdgcn_mfma_f32_32x32x16_bf16(kf, qf[ks], a, 0, 0, 0); }
        float blk[16];
#pragma unroll
        for (int r = 0; r < 16; ++r) { const unsigned key = (unsigned)(32 * kb + (r & 3) + 8 * (r >> 2) + 4 * g);
            blk[r] = __uint_as_float((__float_as_uint(a[r]) & ~0x7Fu) | key); }
        sort16_desc(blk); merge16_desc(l, blk); }
}
__device__ __forceinline__ void merge_lists(float (&l)[16], const float (&o)[16]) { merge16_desc(l, o); }
__device__ __forceinline__ void select_unit(const bf16_t* __restrict__ QP, const bf16_t* __restrict__ k1, const bf16_t* __restrict__ k2, int* __restrict__ PIDX, float* __restrict__ PW,
                                            int t0, int h, int lane, float* lds_lane  ) {
    const int r32 = lane & 31, g = lane >> 5;
    const bf16_t* qrow = QP + (long)(t0 + r32) * DM + h * 256;
    float la[16], lb[16];
    half_top16(qrow, k1, lane, la);
    half_top16(qrow + 128, k2, lane, lb);
    float m0[16], m1[16];
#pragma unroll
    for (int j = 0; j < 16; ++j) { auto rr = __builtin_amdgcn_permlane32_swap(__float_as_uint(la[j]), __float_as_uint(lb[j]), false, false); m0[j] = __uint_as_float(rr[0]); m1[j] = __uint_as_float(rr[1]); }
    merge_lists(m0, m1);
    float L1[16], L2[16];
#pragma unroll
    for (int j = 0; j < 16; ++j) { auto rr = __builtin_amdgcn_permlane32_swap(__float_as_uint(m0[j]), __float_as_uint(m0[j]), false, false);
        L1[j] = __uint_as_float(rr[0]); L2[j] = __uint_as_float(rr[1]); }
#define CAND(i, j) __uint_as_float((__float_as_uint(L1[i] + L2[j]) & ~0xFFu) | (unsigned)((i) * 16 + (j)))
    float best[16], c2[16], c3[16];
#pragma unroll
    for (int j = 0; j < 16; ++j) best[j] = CAND(0, j);
    sort16_desc(best);
    c2[0] = CAND(1, 0); c2[1] = CAND(1, 1); c2[2] = CAND(1, 2); c2[3] = CAND(1, 3); c2[4] = CAND(1, 4); c2[5] = CAND(1, 5); c2[6] = CAND(1, 6); c2[7] = CAND(1, 7);
    c2[8] = CAND(2, 0); c2[9] = CAND(2, 1); c2[10] = CAND(2, 2); c2[11] = CAND(2, 3); c2[12] = CAND(2, 4); c2[13] = CAND(4, 0); c2[14] = CAND(4, 1); c2[15] = CAND(4, 2);
    sort16_desc(c2); merge16_desc(best, c2);
    c3[0] = CAND(3, 0); c3[1] = CAND(3, 1); c3[2] = CAND(3, 2); c3[3] = CAND(3, 3); c3[4] = CAND(5, 0); c3[5] = CAND(5, 1); c3[6] = CAND(6, 0); c3[7] = CAND(6, 1);
    c3[8] = CAND(7, 0); c3[9] = CAND(7, 1); c3[10] = CAND(8, 0); c3[11] = CAND(9, 0); c3[12] = CAND(10, 0); c3[13] = CAND(11, 0); c3[14] = CAND(12, 0); c3[15] = CAND(13, 0);
    sort16_desc(c3); merge16_desc(best, c3);
    ins16(best, CAND(14, 0)); ins16(best, CAND(15, 0));
#undef CAND
#pragma unroll
    for (int j = 0; j < 16; ++j) { lds_lane[j] = __uint_as_float(__float_as_uint(L1[j]) & 0x7Fu); lds_lane[16 + j] = __uint_as_float(__float_as_uint(L2[j]) & 0x7Fu); }
    asm volatile("s_waitcnt lgkmcnt(0)" ::: "memory");
    float wsum = 0.f, w[16]; int ei[16];
    const float mx = best[0];
#pragma unroll
    for (int k = 0; k < 16; ++k) { const unsigned code = __float_as_uint(best[k]) & 0xFFu; const int i = (int)(code >> 4), j = (int)(code & 15u);
        const int i1 = (int)__float_as_uint(lds_lane[i]), i2 = (int)__float_as_uint(lds_lane[16 + j]); ei[k] = i1 * NKEYS + i2;
        w[k] = __expf(best[k] - mx); wsum += w[k]; }
    const float inv = 1.0f / wsum;
    if (g == 0) { int* ip = PIDX + (long)(t0 + r32) * 128 + h * 16; float* wp = PW + (long)(t0 + r32) * 128 + h * 16;
#pragma unroll
        for (int k = 0; k < 16; k += 4) { *reinterpret_cast<int4*>(ip + k) = make_int4(ei[k], ei[k + 1], ei[k + 2], ei[k + 3]);
            *reinterpret_cast<float4*>(wp + k) = make_float4(w[k] * inv, w[k + 1] * inv, w[k + 2] * inv, w[k + 3] * inv); } }
}

__device__ __forceinline__ float gelu_exact(float x) { return 0.5f * x * (1.0f + erff(x * 0.70710678118654752f)); }

__device__ __forceinline__ void dec16(const u32x4 w, f32x2 (&f)[8]) {
    f[0] = __builtin_amdgcn_cvt_pk_f32_fp8((int)w.x, false); f[1] = __builtin_amdgcn_cvt_pk_f32_fp8((int)w.x, true);
    f[2] = __builtin_amdgcn_cvt_pk_f32_fp8((int)w.y, false); f[3] = __builtin_amdgcn_cvt_pk_f32_fp8((int)w.y, true);
    f[4] = __builtin_amdgcn_cvt_pk_f32_fp8((int)w.z, false); f[5] = __builtin_amdgcn_cvt_pk_f32_fp8((int)w.z, true);
    f[6] = __builtin_amdgcn_cvt_pk_f32_fp8((int)w.w, false); f[7] = __builtin_amdgcn_cvt_pk_f32_fp8((int)w.w, true);
}
__device__ __forceinline__ void gather_token(const bf16_t* __restrict__ H, const unsigned char* __restrict__ PU, const unsigned char* __restrict__ PV, const float* __restrict__ SU, const float* __restrict__ SV,
                                             const int* __restrict__ PIDX, const float* __restrict__ PW, float* __restrict__ X, const float* __restrict__ gate  , int t, int lane) {
    f32x2 xf[2][8];
#pragma unroll
    for (int hlf = 0; hlf < 2; ++hlf)
#pragma unroll
        for (int q = 0; q < 2; ++q) { const u32x4 w = *reinterpret_cast<const u32x4*>(H + (long)t * DM + 1024 * hlf + 16 * lane + 8 * q);
            xf[hlf][4 * q + 0] = (f32x2){bflo(w.x), bfhi(w.x)}; xf[hlf][4 * q + 1] = (f32x2){bflo(w.y), bfhi(w.y)}; xf[hlf][4 * q + 2] = (f32x2){bflo(w.z), bfhi(w.z)}; xf[hlf][4 * q + 3] = (f32x2){bflo(w.w), bfhi(w.w)}; }
    f32x2 out[2][8];
#pragma unroll
    for (int hlf = 0; hlf < 2; ++hlf)
#pragma unroll
        for (int i = 0; i < 8; ++i) out[hlf][i] = (f32x2){0.f, 0.f};
    const int myidx0 = PIDX[(long)t * 128 + lane], myidx1 = PIDX[(long)t * 128 + 64 + lane];
    const float myw0 = PW[(long)t * 128 + lane], myw1 = PW[(long)t * 128 + 64 + lane];
    const float msu0 = SU[myidx0], msu1 = SU[myidx1], msv0 = SV[myidx0], msv1 = SV[myidx1];
    for (int hk = 0; hk < 128; hk += 4) {
        const int src = hk & 63; const bool lo = hk < 64;
        const int selidx = lo ? myidx0 : myidx1; const int selw = __float_as_int(lo ? myw0 : myw1), selsu = __float_as_int(lo ? msu0 : msu1), selsv = __float_as_int(lo ? msv0 : msv1);
        int e[4]; float g[4], su[4], sv[4];
#pragma unroll
        for (int k = 0; k < 4; ++k) { e[k] = __builtin_amdgcn_readlane(selidx, src + k); g[k] = __int_as_float(__builtin_amdgcn_readlane(selw, src + k));
            su[k] = __int_as_float(__builtin_amdgcn_readlane(selsu, src + k)); sv[k] = __int_as_float(__builtin_amdgcn_readlane(selsv, src + k)); }
        u32x4 uw[4][2], vw[4][2];
#pragma unroll
        for (int k = 0; k < 4; ++k) { uw[k][0] = *reinterpret_cast<const u32x4*>(PU + ((long)(lane >> 3) * NEXP + e[k]) * 128 + 16 * (lane & 7)); uw[k][1] = *reinterpret_cast<const u32x4*>(PU + ((long)(8 + (lane >> 3)) * NEXP + e[k]) * 128 + 16 * (lane & 7)); }
#pragma unroll
        for (int k = 0; k < 4; ++k) { { const u32x2 a0 = *reinterpret_cast<const u32x2*>(PV + ((long)(2 * lane) * NEXP + e[k]) * 8), a1 = *reinterpret_cast<const u32x2*>(PV + ((long)(2 * lane + 1) * NEXP + e[k]) * 8);
              const u32x2 b0 = *reinterpret_cast<const u32x2*>(PV + ((long)(128 + 2 * lane) * NEXP + e[k]) * 8), b1 = *reinterpret_cast<const u32x2*>(PV + ((long)(129 + 2 * lane) * NEXP + e[k]) * 8);
              vw[k][0] = (u32x4){a0.x, a0.y, a1.x, a1.y}; vw[k][1] = (u32x4){b0.x, b0.y, b1.x, b1.y}; } }
        float a[4];
#pragma unroll
        for (int k = 0; k < 4; ++k) { f32x2 d = (f32x2){0.f, 0.f};
#pragma unroll
            for (int hlf = 0; hlf < 2; ++hlf) { f32x2 f[8]; dec16(uw[k][hlf], f);
#pragma unroll
                for (int i = 0; i < 8; ++i) d = __builtin_elementwise_fma(f[i], xf[hlf][i], d); }
            a[k] = wave_sum(d[0] + d[1]); }
#pragma unroll
        for (int k = 0; k < 4; ++k) { const float ak = g[k] * gelu_exact(a[k] * su[k]) * sv[k]; const f32x2 a2 = (f32x2){ak, ak};
#pragma unroll
            for (int hlf = 0; hlf < 2; ++hlf) { f32x2 f[8]; dec16(vw[k][hlf], f);
#pragma unroll
                for (int i = 0; i < 8; ++i) out[hlf][i] = __builtin_elementwise_fma(f[i], a2, out[hlf][i]); } }
    }
    const float* gr = gate + (long)cond_row(t) * 12288;
#pragma unroll
    for (int hlf = 0; hlf < 2; ++hlf)
#pragma unroll
        for (int q = 0; q < 4; ++q) { const int c = 1024 * hlf + 16 * lane + 4 * q; float* xp = X + (long)t * DM + c;
            const f32x4 gv = *reinterpret_cast<const f32x4*>(gr + c); f32x4 xv = *reinterpret_cast<const f32x4*>(xp);
            xv[0] += gv[0] * out[hlf][2 * q][0]; xv[1] += gv[1] * out[hlf][2 * q][1]; xv[2] += gv[2] * out[hlf][2 * q + 1][0]; xv[3] += gv[3] * out[hlf][2 * q + 1][1];
            *reinterpret_cast<f32x4*>(xp) = xv; }
}

constexpr int SW = 128, NSL = DM / SW;
struct XInfo { int rank, xi, nx, nloc; };
__device__ __forceinline__ void upass(const bf16_t* __restrict__ H, const unsigned char* __restrict__ PU, const int* __restrict__ PIDX, const float* __restrict__ PW, const float* __restrict__ SU, const float* __restrict__ SV,
                                      float* __restrict__ DOTP, unsigned* __restrict__ PACKT, const XInfo xin, int wid, int lane) {
    const int g = lane >> 3, c = lane & 7; const int nwv = xin.nloc * 8;
    const int tlo = (int)((long)T * xin.xi / xin.nx), thi = (int)((long)T * (xin.xi + 1) / xin.nx); const int wv = tlo + xin.rank * 8 + wid;
    float* dp = DOTP;
    for (int s = 0; s < NSL; ++s) { const bool first = (s == 0), lastS = (s == NSL - 1);
        const __amdgpu_buffer_rsrc_t urs = __builtin_amdgcn_make_buffer_rsrc((void*)(PU + (long)s * NEXP * SW), 0, NEXP * SW, 0x00020000);
#define UP_ROW(e_) __builtin_bit_cast(u32x4, __builtin_amdgcn_raw_buffer_load_b128(urs, (e_) * SW + 16 * c, 0, 0))
#define UP_IDX(tt, q4) (*reinterpret_cast<const int4*>(PIDX + (long)(tt) * 128 + 16 * g + 4 * (q4)))
#define UP_X(tt, q2) (*reinterpret_cast<const u32x4*>(H + (long)(tt) * DM + SW * s + 16 * c + 8 * (q2)))
        if (wv >= thi) continue;
        u32x4 A[8], B[8]; int4 en[4]; u32x4 xn[2];
        { int4 e0[4];
#pragma unroll
          for (int q4 = 0; q4 < 4; ++q4) e0[q4] = UP_IDX(wv, q4);
          A[0] = UP_ROW(e0[0].x); A[1] = UP_ROW(e0[0].y); A[2] = UP_ROW(e0[0].z); A[3] = UP_ROW(e0[0].w); A[4] = UP_ROW(e0[1].x); A[5] = UP_ROW(e0[1].y); A[6] = UP_ROW(e0[1].z); A[7] = UP_ROW(e0[1].w);
          B[0] = UP_ROW(e0[2].x); B[1] = UP_ROW(e0[2].y); B[2] = UP_ROW(e0[2].z); B[3] = UP_ROW(e0[2].w); B[4] = UP_ROW(e0[3].x); B[5] = UP_ROW(e0[3].y); B[6] = UP_ROW(e0[3].z); B[7] = UP_ROW(e0[3].w);
          const int t1 = (wv + nwv < thi) ? wv + nwv : wv;
#pragma unroll
          for (int q4 = 0; q4 < 4; ++q4) en[q4] = UP_IDX(t1, q4);
          xn[0] = UP_X(wv, 0); xn[1] = UP_X(wv, 1); }
#pragma unroll 1
        for (int t = wv; t < thi; t += nwv) {
            const int tn = (t + nwv < thi) ? t + nwv : t, tnn = (tn + nwv < thi) ? tn + nwv : tn;
            f32x2 xf[8];
#pragma unroll
            for (int q2 = 0; q2 < 2; ++q2) { const u32x4 hw = xn[q2];
                xf[4 * q2 + 0] = (f32x2){bflo(hw.x), bfhi(hw.x)}; xf[4 * q2 + 1] = (f32x2){bflo(hw.y), bfhi(hw.y)}; xf[4 * q2 + 2] = (f32x2){bflo(hw.z), bfhi(hw.z)}; xf[4 * q2 + 3] = (f32x2){bflo(hw.w), bfhi(hw.w)}; }
            xn[0] = UP_X(tn, 0); xn[1] = UP_X(tn, 1);
            float d[16];
#pragma unroll
            for (int i = 0; i < 8; ++i) { f32x2 f[8]; dec16(A[i], f); f32x2 a = (f32x2){0.f, 0.f};
#pragma unroll
                for (int k = 0; k < 8; ++k) a = __builtin_elementwise_fma(f[k], xf[k], a);
                d[i] = a[0] + a[1]; }
            A[0] = UP_ROW(en[0].x); A[1] = UP_ROW(en[0].y); A[2] = UP_ROW(en[0].z); A[3] = UP_ROW(en[0].w); A[4] = UP_ROW(en[1].x); A[5] = UP_ROW(en[1].y); A[6] = UP_ROW(en[1].z); A[7] = UP_ROW(en[1].w);
#pragma unroll
            for (int i = 0; i < 8; ++i) { f32x2 f[8]; dec16(B[i], f); f32x2 a = (f32x2){0.f, 0.f};
#pragma unroll
                for (int k = 0; k < 8; ++k) a = __builtin_elementwise_fma(f[k], xf[k], a);
                d[8 + i] = a[0] + a[1]; }
            B[0] = UP_ROW(en[2].x); B[1] = UP_ROW(en[2].y); B[2] = UP_ROW(en[2].z); B[3] = UP_ROW(en[2].w); B[4] = UP_ROW(en[3].x); B[5] = UP_ROW(en[3].y); B[6] = UP_ROW(en[3].z); B[7] = UP_ROW(en[3].w);
#pragma unroll
            for (int q4 = 0; q4 < 4; ++q4) en[q4] = UP_IDX(tnn, q4);
            float r8[8], r4[4], r2[2];
#pragma unroll
            for (int k = 0; k < 8; ++k) { const float keep = (c & 4) ? d[k + 8] : d[k], send = (c & 4) ? d[k] : d[k + 8]; r8[k] = keep + sx<4>(send); }
#pragma unroll
            for (int k = 0; k < 4; ++k) { const float keep = (c & 2) ? r8[k + 4] : r8[k], send = (c & 2) ? r8[k] : r8[k + 4]; r4[k] = keep + sx<2>(send); }
#pragma unroll
            for (int k = 0; k < 2; ++k) { const float keep = (c & 1) ? r4[k + 2] : r4[k], send = (c & 1) ? r4[k] : r4[k + 2]; r2[k] = keep + sx<1>(send); }
            float* o = dp + (long)t * 128 + 16 * g + 2 * c;
            f32x2 acc = (f32x2){r2[0], r2[1]};
            if (!first) acc += *reinterpret_cast<const f32x2*>(o);
            if (!lastS) *reinterpret_cast<f32x2*>(o) = acc;
            else {
                const int p0 = 16 * g + 2 * c; const int2 ee = *reinterpret_cast<const int2*>(PIDX + (long)t * 128 + p0); const f32x2 gw = *reinterpret_cast<const f32x2*>(PW + (long)t * 128 + p0);
                const float a0 = gw[0] * gelu_exact(acc[0] * SU[ee.x]) * SV[ee.x], a1 = gw[1] * gelu_exact(acc[1] * SU[ee.y]) * SV[ee.y];
                u32x2 pk; pk.x = (cvt_pk_bf16(0.f, a0) & 0xffff0000u) | (unsigned)ee.x; pk.y = (cvt_pk_bf16(0.f, a1) & 0xffff0000u) | (unsigned)ee.y;
                *reinterpret_cast<u32x2*>(PACKT + ((long)(p0 >> 2) * T + t) * 4 + (p0 & 3)) = pk; }
        }
#undef UP_ROW
#undef UP_IDX
#undef UP_X
    }
}
__device__ __forceinline__ void actpass(const float* __restrict__ DOTP, const int* __restrict__ PIDX, const float* __restrict__ PW, const float* __restrict__ SU, const float* __restrict__ SV, float* __restrict__ ACT, int nx, long gt, long nt) {
    for (long i = gt; i < (long)T * 128; i += nt) { float dsum = 0.f;
        for (int x = 0; x < nx; ++x) dsum += DOTP[(long)x * T * 128 + i];
        const int e = PIDX[i]; const float av = PW[i] * gelu_exact(dsum * SU[e]) * SV[e]; const long t = i >> 7; const int pp = (int)(i & 127);
        reinterpret_cast<unsigned*>(ACT)[((long)(pp >> 2) * T + t) * 4 + (pp & 3)] = (cvt_pk_bf16(0.f, av) & 0xffff0000u) | (unsigned)e; }
}
__device__ __forceinline__ void vpass(const unsigned char* __restrict__ PV, const int* __restrict__ PIDX, const float* __restrict__ ACT, float* __restrict__ X, const float* __restrict__ gate, const XInfo xin, int wid, int lane) {
    const int g = lane >> 3, c = lane & 7; const int wv = xin.rank * 8 + wid, nwv = xin.nloc * 8;
    for (int s = xin.xi; s < NSL; s += xin.nx) {
        int4 en[4]; f32x4 an[4];
#pragma unroll
        for (int q4 = 0; q4 < 4; ++q4) { en[q4] = *reinterpret_cast<const int4*>(PIDX + (long)(wv < T ? wv : 0) * 128 + 16 * g + 4 * q4); an[q4] = *reinterpret_cast<const f32x4*>(ACT + (long)(wv < T ? wv : 0) * 128 + 16 * g + 4 * q4); }
        for (int t = wv; t < T; t += nwv) {
            int e[16]; float a[16];
#pragma unroll
            for (int q4 = 0; q4 < 4; ++q4) { e[4 * q4] = en[q4].x; e[4 * q4 + 1] = en[q4].y; e[4 * q4 + 2] = en[q4].z; e[4 * q4 + 3] = en[q4].w; a[4 * q4] = an[q4][0]; a[4 * q4 + 1] = an[q4][1]; a[4 * q4 + 2] = an[q4][2]; a[4 * q4 + 3] = an[q4][3]; }
            u32x4 w[16];
#pragma unroll
            for (int i = 0; i < 16; ++i) w[i] = *reinterpret_cast<const u32x4*>(PV + ((long)s * NEXP + e[i]) * SW + 16 * c);
            { const int tn = (t + nwv < T) ? t + nwv : t;
#pragma unroll
              for (int q4 = 0; q4 < 4; ++q4) { en[q4] = *reinterpret_cast<const int4*>(PIDX + (long)tn * 128 + 16 * g + 4 * q4); an[q4] = *reinterpret_cast<const f32x4*>(ACT + (long)tn * 128 + 16 * g + 4 * q4); } }
            f32x2 o[8];
#pragma unroll
            for (int k = 0; k < 8; ++k) o[k] = (f32x2){0.f, 0.f};
#pragma unroll
            for (int i = 0; i < 16; ++i) { f32x2 f[8]; dec16(w[i], f); const f32x2 a2 = (f32x2){a[i], a[i]};
#pragma unroll
                for (int k = 0; k < 8; ++k) o[k] = __builtin_elementwise_fma(f[k], a2, o[k]); }
            f32x2 r4[4], r2[2], r1;
#pragma unroll
            for (int k = 0; k < 4; ++k) { const f32x2 keep = (g & 4) ? o[k + 4] : o[k], send = (g & 4) ? o[k] : o[k + 4]; r4[k] = keep + (f32x2){sx<32>(send[0]), sx<32>(send[1])}; }
#pragma unroll
            for (int k = 0; k < 2; ++k) { const f32x2 keep = (g & 2) ? r4[k + 2] : r4[k], send = (g & 2) ? r4[k] : r4[k + 2]; r2[k] = keep + (f32x2){sx<16>(send[0]), sx<16>(send[1])}; }
            { const f32x2 keep = (g & 1) ? r2[1] : r2[0], send = (g & 1) ? r2[0] : r2[1]; r1 = keep + (f32x2){sx<8>(send[0]), sx<8>(send[1])}; }
            const int col = SW * s + 16 * c + 2 * g;
            const f32x2 gv = *reinterpret_cast<const f32x2*>(gate + (long)cond_row(t) * 12288 + col);
            float* xp = X + (long)t * DM + col; f32x2 xv = *reinterpret_cast<const f32x2*>(xp);
            xv += gv * r1; *reinterpret_cast<f32x2*>(xp) = xv;
        }
    }
}

__device__ __forceinline__ void vpass_lds(const unsigned char* __restrict__ PV, const unsigned* __restrict__ PACKT, float* __restrict__ X, const float* __restrict__ gate, char* lds, int bid, int nb, int s_end, int tid) {
    const int wid = tid >> 6, lane = tid & 63;
    for (int s = bid; s < s_end; s += nb) {
        __syncthreads();
        { const u32x4* src = reinterpret_cast<const u32x4*>(PV + (long)s * NEXP * 8); u32x4* dst = reinterpret_cast<u32x4*>(lds);
#pragma unroll 4
          for (int i = tid; i < NEXP * 8 / 16; i += 512) dst[i] = src[i]; }
        __syncthreads();
        u32x4 h0[8], h1[8];
        const __amdgpu_buffer_rsrc_t vrs = __builtin_amdgcn_make_buffer_rsrc((void*)PACKT, 0, (int)((size_t)T * 128 * 4), 0x00020000);
#define VP_LD(k, toff) __builtin_bit_cast(u32x4, __builtin_amdgcn_raw_buffer_load_b128(vrs, (int)(toff), (int)((size_t)(k) * T * 16), 0))
        { const unsigned toff = (unsigned)(wid * 64 + lane) * 16u;
#pragma unroll
          for (int k = 0; k < 8; ++k) h0[k] = VP_LD(k, toff);
#pragma unroll
          for (int k = 0; k < 8; ++k) h1[k] = VP_LD(8 + k, toff); }
#define VP_STEP(HB) do { _Pragma("unroll") for (int kk = 0; kk < 8; kk += 2) { unsigned pw[8]; \
            _Pragma("unroll") for (int k = 0; k < 2; ++k) { pw[4 * k] = HB[kk + k].x; pw[4 * k + 1] = HB[kk + k].y; pw[4 * k + 2] = HB[kk + k].z; pw[4 * k + 3] = HB[kk + k].w; } \
            u32x2 w[8]; \
            _Pragma("unroll") for (int k = 0; k < 8; ++k) w[k] = *reinterpret_cast<const u32x2*>(lds + (pw[k] & 0xffffu) * 8u); \
            _Pragma("unroll") for (int k = 0; k < 8; ++k) { const float a = __uint_as_float(pw[k] & 0xffff0000u); \
                const f32x2 f0 = __builtin_amdgcn_cvt_pk_f32_fp8((int)w[k].x, false), f1 = __builtin_amdgcn_cvt_pk_f32_fp8((int)w[k].x, true), f2 = __builtin_amdgcn_cvt_pk_f32_fp8((int)w[k].y, false), f3 = __builtin_amdgcn_cvt_pk_f32_fp8((int)w[k].y, true); \
                acc[0] = fmaf(a, f0[0], acc[0]); acc[1] = fmaf(a, f0[1], acc[1]); acc[2] = fmaf(a, f1[0], acc[2]); acc[3] = fmaf(a, f1[1], acc[3]); \
                acc[4] = fmaf(a, f2[0], acc[4]); acc[5] = fmaf(a, f2[1], acc[5]); acc[6] = fmaf(a, f3[0], acc[6]); acc[7] = fmaf(a, f3[1], acc[7]); } } } while (0)
#pragma unroll 1
        for (int tg = wid; tg < T / 64; tg += 8) { const int t = tg * 64 + lane; const int tgn = (tg + 8 < T / 64) ? tg + 8 : tg;
            const unsigned toff = (unsigned)t * 16u, toffn = (unsigned)(tgn * 64 + lane) * 16u;
            float acc[8];
#pragma unroll
            for (int j = 0; j < 8; ++j) acc[j] = 0.f;
            VP_STEP(h0);
#pragma unroll
            for (int k = 0; k < 8; ++k) h0[k] = VP_LD(16 + k, toff);
            VP_STEP(h1);
#pragma unroll
            for (int k = 0; k < 8; ++k) h1[k] = VP_LD(24 + k, toff);
            VP_STEP(h0);
#pragma unroll
            for (int k = 0; k < 8; ++k) h0[k] = VP_LD(k, toffn);
            VP_STEP(h1);
#pragma unroll
            for (int k = 0; k < 8; ++k) h1[k] = VP_LD(8 + k, toffn);
            const float* gr = gate + (long)cond_row(t) * 12288 + 8 * s; float* xp = X + (long)t * DM + 8 * s;
            const f32x4 g0 = *reinterpret_cast<const f32x4*>(gr), g1 = *reinterpret_cast<const f32x4*>(gr + 4);
            f32x4 x0 = *reinterpret_cast<const f32x4*>(xp), x1 = *reinterpret_cast<const f32x4*>(xp + 4);
            x0[0] += g0[0] * acc[0]; x0[1] += g0[1] * acc[1]; x0[2] += g0[2] * acc[2]; x0[3] += g0[3] * acc[3];
            x1[0] += g1[0] * acc[4]; x1[1] += g1[1] * acc[5]; x1[2] += g1[2] * acc[6]; x1[3] += g1[3] * acc[7];
            *reinterpret_cast<f32x4*>(xp) = x0; *reinterpret_cast<f32x4*>(xp + 4) = x1; }
#undef VP_STEP
#undef VP_LD
    }
    __syncthreads();
}
}
namespace ph {
__device__ __forceinline__ int gwave() { return obid() * 8 + (otid() >> 6); }
__device__ __forceinline__ int nwaves() { return ogrid() * 8; }
__device__ __forceinline__ long gthread() { return (long)obid() * 512 + otid(); }
__device__ __forceinline__ long nthreads() { return (long)ogrid() * 512; }

__device__ __forceinline__ void transpose_tile(const float* __restrict__ src, int C, int r0, int c0, bf16_t* __restrict__ dst, long dpitch, float* tile) {
    const int tid = otid();
#pragma unroll
    for (int i = 0; i < 8; ++i) { const int idx = tid + 512 * i, r = idx >> 6, c = idx & 63; tile[r * 65 + c] = src[(long)(r0 + r) * C + c0 + c]; }
    __syncthreads();
    { const int c = tid >> 3, rc = (tid & 7) * 8; float f[8];
#pragma unroll
      for (int j = 0; j < 8; ++j) f[j] = tile[(rc + j) * 65 + c];
      *reinterpret_cast<u32x4*>(dst + (long)(c0 + c) * dpitch + r0 + rc) = pack8(f); }
    __syncthreads();
}

__device__ __forceinline__ void zero_chunks(bf16_t* base, long nrows, long rowpitch, int col0, int nchunk) {
    const long total = nrows * nchunk;
    for (long i = gthread(); i < total; i += nthreads()) { const long r = i / nchunk; const int ch = (int)(i % nchunk);
        *reinterpret_cast<u32x4*>(base + r * rowpitch + col0 + ch * 8) = (u32x4){0u, 0u, 0u, 0u}; }
}

__device__ __forceinline__ void prologue(KParams& p, char* lds) {
    unsigned char* ws = optr(gp(p.ws)); const int tid = otid();
    float* tile = (float*)lds;
    { struct TJob { const float* src; bf16_t* dst; int R, C, r0, c0, perm; };
      auto decode = [&](int it) { TJob j; j.perm = 0; const int l = it / 10656; int r = it % 10656;
        if (r < 5664) { j.src = gp(p.w_in) + (long)l * DM * INW; j.R = DM; j.C = INW; j.dst = (bf16_t*)(ws + WS_WIN) + (long)l * INWP * DM; }
        else if (r < 6048) { r -= 5664; j.src = gp(p.w_uq) + (long)l * 512 * 3072; j.R = 512; j.C = 3072; j.dst = (bf16_t*)(ws + WS_WUQ) + (long)l * 3072 * 512; j.perm = 1; }
        else if (r < 6560) { r -= 6048; j.src = gp(p.w_ukv) + (long)l * 512 * 4096; j.R = 512; j.C = 4096; j.dst = (bf16_t*)(ws + WS_WUKV) + (long)l * 4096 * 512; }
        else { r -= 6560; const int m = r >> 10; r &= 1023; j.R = DM; j.C = DM;
            j.src = (m == 0 ? gp(p.w_a) : m == 1 ? gp(p.w_b) : m == 2 ? gp(p.w_o) : gp(p.w_pq)) + (long)l * DM * DM;
            j.dst = (bf16_t*)(ws + (m == 0 ? WS_WA : m == 1 ? WS_WB : m == 2 ? WS_WO : WS_WPQ)) + (long)l * DM * DM; }
        const int ntc = j.C / 64; j.r0 = (r / ntc) * 64; j.c0 = (r % ntc) * 64; return j; };
      const int NTILES = 2 * 10656, G_ = ogrid(); int it = obid(); float v[8]; TJob cur{};
      if (it < NTILES) { cur = decode(it);
#pragma unroll
        for (int i = 0; i < 8; ++i) { const int idx = tid + 512 * i, r = idx >> 6, c = idx & 63; v[i] = cur.src[(long)(cur.r0 + r) * cur.C + cur.c0 + c]; } }
      while (it < NTILES) { const int itn = it + G_; float vn[8]; TJob nxt{};
        if (itn < NTILES) { nxt = decode(itn);
#pragma unroll
            for (int i = 0; i < 8; ++i) { const int idx = tid + 512 * i, r = idx >> 6, c = idx & 63; vn[i] = nxt.src[(long)(nxt.r0 + r) * nxt.C + nxt.c0 + c]; } }
#pragma unroll
        for (int i = 0; i < 8; ++i) { const int idx = tid + 512 * i, r = idx >> 6, c = idx & 63; tile[r * 65 + c] = v[i]; }
        __syncthreads();
        { const int c = tid >> 3, rc = (tid & 7) * 8; float f[8];
#pragma unroll
          for (int jj = 0; jj < 8; ++jj) f[jj] = tile[(rc + jj) * 65 + c];
          int drow = cur.c0 + c;
          if (cur.perm) { const int gq = drow / 768, o = drow - 768 * gq, hh = o / 192, w = o - 192 * hh;
              drow = 768 * gq + (w < 128 ? 128 * hh + w : (w < 160 ? 512 + 32 * hh + (w - 128) : 640 + 32 * hh + (w - 160))); }
          *reinterpret_cast<u32x4*>(cur.dst + (long)drow * cur.R + cur.r0 + rc) = pack8(f); }
        __syncthreads();
#pragma unroll
        for (int i = 0; i < 8; ++i) v[i] = vn[i];
        cur = nxt; it = itn; } }
    for (long i = gthread(); i < 2L * 16 * 512 * 32; i += nthreads()) { const int ch = (int)(i & 31); const long row = i >> 5; const int c = (int)(row & 511), h = (int)((row >> 9) & 15), l = (int)(row >> 13);
        u32x4 w = (u32x4){0u, 0u, 0u, 0u};
        if (ch < 16) { const float* s = gp(p.w_ukv) + (((long)l * 512 + c) * 16 + h) * 256 + ch * 8; float f[8];
#pragma unroll
            for (int j = 0; j < 8; ++j) f[j] = s[j];
            w = pack8(f); }
        *reinterpret_cast<u32x4*>((bf16_t*)(ws + WS_WUK) + row * 256 + ch * 8) = w; }
    for (long i = gthread(); i < 2L * 4096; i += nthreads()) { const bool second = i >= 4096; const long j8 = (second ? i - 4096 : i) * 8; const float* s = (second ? gp(p.peer_k2) : gp(p.peer_k1)) + j8; float f[8];
#pragma unroll
        for (int j = 0; j < 8; ++j) f[j] = s[j];
        *reinterpret_cast<u32x4*>((bf16_t*)(ws + (second ? WS_PK2 : WS_PK1)) + j8) = pack8(f); }
    for (int l = 0; l < 2; ++l) zero_chunks((bf16_t*)(ws + WS_WIN) + ((long)l * INWP + INW) * DM, INWP - INW, DM, 0, DM / 8);
    for (int b = 0; b < DB; ++b) zero_chunks((bf16_t*)(ws + WS_CKA) + ((long)b * KPAD + KALL) * QLD, KPAD - KALL, QLD, 0, QLD / 8);
    zero_chunks((bf16_t*)(ws + WS_CKA), (long)DB * KPAD, QLD, 576, 8);
    zero_chunks((bf16_t*)(ws + WS_CKT), (long)DB * 512, KPAD, KALL, (KPAD - KALL) / 8);
    zero_chunks((bf16_t*)(ws + WS_QL), (long)DB * 1024, QLD, 576, 8);
    for (long i = gthread(); i < 4096L * 96; i += nthreads()) { const int pos = (int)(i / 96), k = (int)(i % 96); const bool big = k >= 32; const int fi = big ? k - 32 : k; const float d = big ? 128.f : 64.f;
        const float inv = __builtin_amdgcn_exp2f(-(2.0f * (float)fi / d) * 13.287712379549449f);
        const float ang = (float)pos * inv; double rv = (double)ang * 0.15915494309189535; rv -= floor(rv); const float fr = (float)rv;
        float* dst = big ? (float*)(ws + WS_TAB128) + ((long)pos * 64 + fi) * 2 : (float*)(ws + WS_TAB64) + ((long)pos * 32 + fi) * 2;
        dst[0] = __builtin_amdgcn_cosf(fr); dst[1] = __builtin_amdgcn_sinf(fr); }
    { float* sc = (float*)lds;
      for (int it = obid(); it < 2 * 12 * 8; it += ogrid()) { const int l = it / 96, cc = (it % 96) / 8, ks = it % 8;
        __syncthreads();
        for (int i = tid; i < NCOND * 256; i += 512) { const int r = i >> 8, k = i & 255; const float c = r < NB ? gp(p.c_prompt)[(long)r * DM + ks * 256 + k] : gp(p.c_sample)[(long)(r - NB) * DM + ks * 256 + k]; sc[i] = siluf_(c); }
        __syncthreads();
        float a0[NCOND], a1[NCOND];
#pragma unroll
        for (int r = 0; r < NCOND; ++r) { a0[r] = 0.f; a1[r] = 0.f; }
        const float* wp = gp(p.w_ada) + ((long)l * DM + ks * 256) * 12288 + cc * 1024 + 2 * tid;
#pragma unroll 1
        for (int k = 0; k < 256; k += 4) { const f32x2 w0 = *reinterpret_cast<const f32x2*>(wp), w1 = *reinterpret_cast<const f32x2*>(wp + 12288), w2 = *reinterpret_cast<const f32x2*>(wp + 2 * 12288), w3 = *reinterpret_cast<const f32x2*>(wp + 3 * 12288);
            wp += 4 * 12288;
#pragma unroll
            for (int r = 0; r < NCOND; ++r) { const f32x4 s = *reinterpret_cast<const f32x4*>(sc + r * 256 + k);
                a0[r] = fmaf(s[0], w0[0], fmaf(s[1], w1[0], fmaf(s[2], w2[0], fmaf(s[3], w3[0], a0[r]))));
                a1[r] = fmaf(s[0], w0[1], fmaf(s[1], w1[1], fmaf(s[2], w2[1], fmaf(s[3], w3[1], a1[r]))));
                if ((r % 6) == 5) __builtin_amdgcn_sched_barrier(0); } }
        float* dst = (float*)(ws + WS_ADAP) + (((long)ks * 2 + l) * NCOND) * 12288 + cc * 1024 + 2 * tid;
#pragma unroll
        for (int r = 0; r < NCOND; ++r) *reinterpret_cast<f32x2*>(dst + (long)r * 12288) = (f32x2){a0[r], a1[r]}; }
      __syncthreads(); }
}

__device__ __forceinline__ void wpq_int8(KParams& p) {
    unsigned char* ws = optr(gp(p.ws)); const int lane = otid() & 63;
    for (int r = gwave(); r < 2 * DM; r += nwaves()) { const bf16_t* src = (const bf16_t*)(ws + WS_WPQ) + (long)r * DM; float f[4][8]; float am = 0.f;
#pragma unroll
        for (int j = 0; j < 4; ++j) { unpack8(*reinterpret_cast<const u32x4*>(src + 512 * j + 8 * lane), f[j]);
#pragma unroll
            for (int i = 0; i < 8; ++i) am = fmaxf(am, fabsf(f[j][i])); }
        am = wave_max(am); const float qs = am > 0.f ? 127.0f / am : 0.f;
#pragma unroll
        for (int j = 0; j < 4; ++j) { unsigned w2[2];
#pragma unroll
            for (int hh = 0; hh < 2; ++hh) { unsigned w = 0u;
#pragma unroll
                for (int i = 0; i < 4; ++i) w |= ((unsigned)((int)__builtin_rintf(f[j][4 * hh + i] * qs) & 0xff)) << (8 * i);
                w2[hh] = w; }
            *reinterpret_cast<u32x2*>(ws + WS_WPQ8 + (long)r * DM + 512 * j + 8 * lane) = (u32x2){w2[0], w2[1]}; }
        if (lane == 0) ((float*)(ws + WS_SB8))[r] = am * (1.0f / 127.0f); }
}

__device__ __forceinline__ void wb_int8(KParams& p, int l) {
    unsigned char* ws = optr(gp(p.ws)); const int lane = otid() & 63;
    for (int r = gwave(); r < DM; r += nwaves()) { const bf16_t* src = (const bf16_t*)(ws + WS_WB) + ((long)l * DM + r) * DM; float f[4][8]; float am = 0.f;
#pragma unroll
        for (int j = 0; j < 4; ++j) { unpack8(*reinterpret_cast<const u32x4*>(src + 512 * j + 8 * lane), f[j]);
#pragma unroll
            for (int i = 0; i < 8; ++i) am = fmaxf(am, fabsf(f[j][i])); }
        am = wave_max(am); const float qs = am > 0.f ? 127.0f / am : 0.f;
#pragma unroll
        for (int j = 0; j < 4; ++j) { unsigned w2[2];
#pragma unroll
            for (int hh = 0; hh < 2; ++hh) { unsigned w = 0u;
#pragma unroll
                for (int i = 0; i < 4; ++i) w |= ((unsigned)((int)__builtin_rintf(f[j][4 * hh + i] * qs) & 0xff)) << (8 * i);
                w2[hh] = w; }
            *reinterpret_cast<u32x2*>(ws + WS_WB8 + (long)r * DM + 512 * j + 8 * lane) = (u32x2){w2[0], w2[1]}; }
        if (lane == 0) ((float*)(ws + WS_SBB))[r] = am * (1.0f / 127.0f); }
}

__device__ __forceinline__ void win_int8(KParams& p, int l) {
    unsigned char* ws = optr(gp(p.ws)); const int lane = otid() & 63;
    for (int jr = gwave(); jr < NB8 * 256; jr += nwaves()) { const int blk = jr >> 8, n = (blk < 2 ? blk : (blk < 5 ? blk + 3 : blk + 16)) * 256 + (jr & 255);
        const bf16_t* src = (const bf16_t*)(ws + WS_WIN) + ((long)l * INWP + n) * DM; float f[4][8]; float am = 0.f;
#pragma unroll
        for (int j = 0; j < 4; ++j) { unpack8(*reinterpret_cast<const u32x4*>(src + 512 * j + 8 * lane), f[j]);
#pragma unroll
            for (int i = 0; i < 8; ++i) am = fmaxf(am, fabsf(f[j][i])); }
        am = wave_max(am); const float qs = am > 0.f ? 127.0f / am : 0.f;
#pragma unroll
        for (int j = 0; j < 4; ++j) { unsigned w2[2];
#pragma unroll
            for (int hh = 0; hh < 2; ++hh) { unsigned w = 0u;
#pragma unroll
                for (int i = 0; i < 4; ++i) w |= ((unsigned)((int)__builtin_rintf(f[j][4 * hh + i] * qs) & 0xff)) << (8 * i);
                w2[hh] = w; }
            *reinterpret_cast<u32x2*>(ws + WS_WIN8 + (long)jr * DM + 512 * j + 8 * lane) = (u32x2){w2[0], w2[1]}; }
        if (lane == 0) ((float*)(ws + WS_SBW))[n] = am * (1.0f / 127.0f); }
}

__device__ __forceinline__ void ada_reduce(KParams& p) {
    unsigned char* ws = optr(gp(p.ws)); const float* ap = (const float*)(ws + WS_ADAP); float* ad = (float*)(ws + WS_ADA); const long n = 2L * NCOND * 12288;
    for (long i = gthread(); i < n; i += nthreads()) { const int l = (int)(i / (NCOND * 12288L)); const int j = (int)(i % 12288);
        float s = gp(p.b_ada)[(long)l * 12288 + j];
#pragma unroll
        for (int ks = 0; ks < 8; ++ks) s += ap[(long)ks * n + i];
        ad[i] = s; }
}

__device__ __forceinline__ void modulate(KParams& p, int l, int which) {
    const int lane = otid() & 63; unsigned char* ws = optr(gp(p.ws)); const float* X = gp(p.out); bf16_t* H = (bf16_t*)(ws + WS_H);
    const float* g = (which ? gp(p.g_ffn) : gp(p.g_mix)) + (long)l * DM; const float* ada = (const float*)(ws + WS_ADA) + (long)l * NCOND * 12288 + (which ? 3 : 0) * DM;
    for (int t = gwave(); t < T; t += nwaves()) {
        const float* xr = (l == 0 && which == 0) ? (t < TP ? gp(p.x_prompt) + (long)t * DM : gp(p.x_sample) + (long)(t - TP) * DM) : X + (long)t * DM; f32x4 v[8]; float ss = 0.f;
#pragma unroll
        for (int j = 0; j < 8; ++j) { v[j] = *reinterpret_cast<const f32x4*>(xr + 256 * j + 4 * lane); ss += v[j][0] * v[j][0] + v[j][1] * v[j][1] + v[j][2] * v[j][2] + v[j][3] * v[j][3]; }
        ss = wave_sum(ss); const float rinv = rsqrtf(ss * (1.0f / DM) + EPS);
        const float* sh = ada + (long)cond_row(t) * 12288; const float* sc = sh + DM;
#pragma unroll
        for (int j = 0; j < 8; ++j) { const int c = 256 * j + 4 * lane; const f32x4 gv = *reinterpret_cast<const f32x4*>(g + c), sv = *reinterpret_cast<const f32x4*>(sc + c), hv = *reinterpret_cast<const f32x4*>(sh + c);
            const f32x4 y = v[j] * rinv * gv * (sv + 1.0f) + hv; u32x2 w; w.x = cvt_pk_bf16(y[0], y[1]); w.y = cvt_pk_bf16(y[2], y[3]);
            *reinterpret_cast<u32x2*>(H + (long)t * DM + c) = w; v[j] = y; }
        {
            float am = 0.f;
#pragma unroll
            for (int j = 0; j < 8; ++j) am = fmaxf(am, fmaxf(fmaxf(fabsf(v[j][0]), fabsf(v[j][1])), fmaxf(fabsf(v[j][2]), fabsf(v[j][3]))));
            am = wave_max(am); const float qs = am > 0.f ? 127.0f / am : 0.f;
#pragma unroll
            for (int j = 0; j < 8; ++j) { const int c = 256 * j + 4 * lane;
                const int q0 = (int)__builtin_rintf(v[j][0] * qs), q1 = (int)__builtin_rintf(v[j][1] * qs), q2 = (int)__builtin_rintf(v[j][2] * qs), q3 = (int)__builtin_rintf(v[j][3] * qs);
                *reinterpret_cast<unsigned*>(ws + WS_H8 + (long)t * DM + c) = (unsigned)(q0 & 0xff) | ((unsigned)(q1 & 0xff) << 8) | ((unsigned)(q2 & 0xff) << 16) | ((unsigned)(q3 & 0xff) << 24); }
            if (lane == 0) ((float*)(ws + WS_SA8))[t] = am * (1.0f / 127.0f); }
    }
}

__device__ __forceinline__ void cache_convert(KParams& p, int l, char* lds, int it0, int it1, int bidx, int nb) {
    const int tid = otid(); unsigned char* ws = optr(gp(p.ws)); float* tile = (float*)lds; bf16_t* CKA = (bf16_t*)(ws + WS_CKA); bf16_t* CKT = (bf16_t*)(ws + WS_CKT);
    { const int NT_ = it1, G_ = nb; int it = it0 + bidx; float v[8];
      const float* cbase = gp(p.cache_ckv) + (long)l * DB * PAST * 512;
#define CC_SRC(itx) (cbase + (((long)((itx) >> 8)) * PAST + (((itx) >> 3) & 31) * 64) * 512 + ((itx) & 7) * 64)
      if (it < NT_) { const float* src = CC_SRC(it);
#pragma unroll
        for (int i = 0; i < 8; ++i) { const int idx = tid + 512 * i, r = idx >> 6, c = idx & 63; v[i] = src[(long)r * 512 + c]; } }
      while (it < NT_) { const int b = it >> 8, kt = (it >> 3) & 31, ct = it & 7; const int itn = it + G_; float vn[8];
        if (itn < NT_) { const float* src = CC_SRC(itn);
#pragma unroll
            for (int i = 0; i < 8; ++i) { const int idx = tid + 512 * i, r = idx >> 6, c = idx & 63; vn[i] = src[(long)r * 512 + c]; } }
#pragma unroll
        for (int i = 0; i < 8; ++i) { const int idx = tid + 512 * i, r = idx >> 6, c = idx & 63; tile[r * 65 + c] = v[i]; }
        __syncthreads();
        { const int r = tid >> 3, cc = (tid & 7) * 8; float f[8];
#pragma unroll
          for (int j = 0; j < 8; ++j) f[j] = tile[r * 65 + cc + j];
          *reinterpret_cast<u32x4*>(CKA + ((long)b * KPAD + kt * 64 + r) * QLD + ct * 64 + cc) = pack8(f);
#pragma unroll
          for (int j = 0; j < 8; ++j) f[j] = tile[(cc + j) * 65 + r];
          *reinterpret_cast<u32x4*>(CKT + ((long)b * 512 + ct * 64 + r) * KPAD + kt * 64 + cc) = pack8(f); }
        __syncthreads();
#pragma unroll
        for (int i = 0; i < 8; ++i) v[i] = vn[i];
        it = itn; }
#undef CC_SRC
    }
    for (long i = (long)it0 * 64 + (long)bidx * 512 + tid; i < (long)it1 * 64; i += (long)nb * 512) { const long row = i >> 3; const int ch = (int)(i & 7); const int b = (int)(row >> 11), k = (int)(row & 2047);
        const float* s = gp(p.cache_krope) + (((long)l * DB + b) * PAST + k) * 64 + ch * 8; float f[8];
#pragma unroll
        for (int j = 0; j < 8; ++j) f[j] = s[j];
        *reinterpret_cast<u32x4*>(CKA + ((long)b * KPAD + k) * QLD + 512 + ch * 8) = pack8(f); }
}

__device__ __forceinline__ void quant_row8(const float (&o)[8], unsigned char* dst, float* sc, int lane) {
    float am = 0.f;
#pragma unroll
    for (int j = 0; j < 8; ++j) am = fmaxf(am, fabsf(o[j]));
    am = wave_max(am); const float qs = am > 0.f ? 127.0f / am : 0.f; unsigned w2[2];
#pragma unroll
    for (int hh = 0; hh < 2; ++hh) { unsigned w = 0u;
#pragma unroll
        for (int i = 0; i < 4; ++i) w |= ((unsigned)((int)__builtin_rintf(o[4 * hh + i] * qs) & 0xff)) << (8 * i);
        w2[hh] = w; }
    *reinterpret_cast<u32x2*>(dst) = (u32x2){w2[0], w2[1]};
    if (lane == 0) *sc = am * (1.0f / 127.0f);
}
__device__ __forceinline__ void wu_int8(KParams& p, int l) {
    unsigned char* ws = optr(gp(p.ws)); const int lane = otid() & 63;
    for (int r = gwave(); r < 3072 + 4096; r += nwaves()) { const bool kv = r >= 3072; const int rr = kv ? r - 3072 : r;
        const bf16_t* src = kv ? (const bf16_t*)(ws + WS_WUKV) + ((long)l * 4096 + rr) * 512 : (const bf16_t*)(ws + WS_WUQ) + ((long)l * 3072 + rr) * 512;
        float f[8]; unpack8(*reinterpret_cast<const u32x4*>(src + 8 * lane), f);
        quant_row8(f, ws + (kv ? WS_WUKV8 : WS_WUQ8) + (long)rr * 512 + 8 * lane, (float*)(ws + (kv ? WS_SBK : WS_SBQ)) + rr, lane); }
}

__device__ __forceinline__ void post_win(KParams& p, int l) {
    const int lane = otid() & 63; unsigned char* ws = optr(gp(p.ws));
    bf16_t* Y = (bf16_t*)(ws + WS_Y); bf16_t* CQN = (bf16_t*)(ws + WS_CQN); bf16_t* CKVNP = (bf16_t*)(ws + WS_CKVNP); bf16_t* KRP = (bf16_t*)(ws + WS_KRP); bf16_t* CKA = (bf16_t*)(ws + WS_CKA); bf16_t* CKT = (bf16_t*)(ws + WS_CKT);
    const float* T64 = (const float*)(ws + WS_TAB64); const float* T128 = (const float*)(ws + WS_TAB128);
    for (int t = gwave(); t < T; t += nwaves()) {
        bf16_t* y = Y + (long)t * INWP; const int pos = tok_pos(t); const bool samp = t >= TP; const int ts = t - TP, b = ts >> 6, s = ts & 63;
        { float f[8], o[8]; unpack8(*reinterpret_cast<const u32x4*>(y + C_CQ + 8 * lane), f); float ss = 0.f;
#pragma unroll
          for (int j = 0; j < 8; ++j) ss += f[j] * f[j];
          ss = wave_sum(ss); const float rinv = rsqrtf(ss * (1.0f / 512.f) + EPS); const float* g = gp(p.g_q) + (long)l * 512 + 8 * lane;
#pragma unroll
          for (int j = 0; j < 8; ++j) o[j] = f[j] * rinv * g[j];
          quant_row8(o, (unsigned char*)CQN + (long)t * 512 + 8 * lane, (float*)(ws + WS_SAQ) + t, lane); }
        { float f[8], o[8]; unpack8(*reinterpret_cast<const u32x4*>(y + C_CKV + 8 * lane), f); float ss = 0.f;
#pragma unroll
          for (int j = 0; j < 8; ++j) ss += f[j] * f[j];
          ss = wave_sum(ss); const float rinv = rsqrtf(ss * (1.0f / 512.f) + EPS); const float* g = gp(p.g_kv) + (long)l * 512 + 8 * lane;
#pragma unroll
          for (int j = 0; j < 8; ++j) o[j] = f[j] * rinv * g[j];
          float* od = gp(p.out) + (samp ? O_CKVS + ((long)l * TS + ts) * 512 : O_CKVP + ((long)l * TP + t) * 512) + 8 * lane;
          *reinterpret_cast<f32x4*>(od) = (f32x4){o[0], o[1], o[2], o[3]}; *reinterpret_cast<f32x4*>(od + 4) = (f32x4){o[4], o[5], o[6], o[7]};
          const u32x4 w = pack8(o);
          if (!samp) quant_row8(o, (unsigned char*)CKVNP + (long)t * 512 + 8 * lane, (float*)(ws + WS_SAK) + t, lane);
          else { *reinterpret_cast<u32x4*>(CKA + ((long)b * KPAD + PAST + s) * QLD + 8 * lane) = w;
#pragma unroll
              for (int j = 0; j < 8; ++j) CKT[((long)b * 512 + 8 * lane + j) * KPAD + PAST + s] = f2bf(o[j]); } }
        if (lane < 32) { const float x1 = bf2f(y[C_KR + lane]), x2 = bf2f(y[C_KR + 32 + lane]); const float c = T64[((long)pos * 32 + lane) * 2], sn = T64[((long)pos * 32 + lane) * 2 + 1];
            const float o1 = x1 * c - x2 * sn, o2 = x1 * sn + x2 * c;
            float* od = gp(p.out) + (samp ? O_KRS + ((long)l * TS + ts) * 64 : O_KRP + ((long)l * TP + t) * 64); od[lane] = o1; od[32 + lane] = o2;
            if (!samp) { KRP[(long)t * 64 + lane] = f2bf(o1); KRP[(long)t * 64 + 32 + lane] = f2bf(o2); }
            else { bf16_t* d = CKA + ((long)b * KPAD + PAST + s) * QLD + 512; d[lane] = f2bf(o1); d[32 + lane] = f2bf(o2); } }
        { const int hh = lane >> 3, d0 = (lane & 7) * 8; const float* cs = T128 + ((long)pos * 64 + d0) * 2; float cv[8], sv[8];
#pragma unroll
          for (int j = 0; j < 4; ++j) { const f32x4 q = *reinterpret_cast<const f32x4*>(cs + 4 * j); cv[2 * j] = q[0]; sv[2 * j] = q[1]; cv[2 * j + 1] = q[2]; sv[2 * j + 1] = q[3]; }
#pragma unroll
          for (int which = 0; which < 2; ++which) { bf16_t* base = y + (which ? C_RK : C_RQ) + hh * 128 + d0; const float sca = which ? 0.08838834764831845f : 1.0f;
              float a[8], bq[8], o1[8], o2[8]; unpack8(*reinterpret_cast<const u32x4*>(base), a); unpack8(*reinterpret_cast<const u32x4*>(base + 64), bq);
#pragma unroll
              for (int j = 0; j < 8; ++j) { o1[j] = (a[j] * cv[j] - bq[j] * sv[j]) * sca; o2[j] = (a[j] * sv[j] + bq[j] * cv[j]) * sca; }
              *reinterpret_cast<u32x4*>(base) = pack8(o1); *reinterpret_cast<u32x4*>(base + 64) = pack8(o2); } }
    }
}

__device__ __forceinline__ void post_q(KParams& p) {
    const int lane = otid() & 63; unsigned char* ws = optr(gp(p.ws)); bf16_t* Q = (bf16_t*)(ws + WS_Q); bf16_t* QL = (bf16_t*)(ws + WS_QL); const float* T64 = (const float*)(ws + WS_TAB64);
    for (int t = gwave(); t < T; t += nwaves()) { const int pos = tok_pos(t); const int hd = lane >> 2, d0 = (lane & 3) * 8;
        bf16_t* base = Q + (long)t * 3072 + hd * 192 + 128 + d0; const float* cs = T64 + ((long)pos * 32 + d0) * 2; float cv[8], sv[8];
#pragma unroll
        for (int j = 0; j < 4; ++j) { const f32x4 q = *reinterpret_cast<const f32x4*>(cs + 4 * j); cv[2 * j] = q[0]; sv[2 * j] = q[1]; cv[2 * j + 1] = q[2]; sv[2 * j + 1] = q[3]; }
        float a[8], bq[8], o1[8], o2[8]; unpack8(*reinterpret_cast<const u32x4*>(base), a); unpack8(*reinterpret_cast<const u32x4*>(base + 32), bq);
#pragma unroll
        for (int j = 0; j < 8; ++j) { o1[j] = a[j] * cv[j] - bq[j] * sv[j]; o2[j] = a[j] * sv[j] + bq[j] * cv[j]; }
        const u32x4 w1 = pack8(o1), w2 = pack8(o2);
        *reinterpret_cast<u32x4*>(base) = w1; *reinterpret_cast<u32x4*>(base + 32) = w2;
        if (t >= TP) { const int ts = t - TP, b = ts >> 6, s = ts & 63; bf16_t* d = QL + ((long)b * 1024 + hd * 64 + s) * QLD + 512 + d0;
            *reinterpret_cast<u32x4*>(d) = w1; *reinterpret_cast<u32x4*>(d + 32) = w2; } }
}

__device__ __forceinline__ void softmax_rows(KParams& p) {
    const int lane = otid() & 63; unsigned char* ws = optr(gp(p.ws)); bf16_t* SP = (bf16_t*)(ws + WS_SP);
    for (int r = gwave(); r < DB * 1024; r += nwaves()) { bf16_t* row = SP + (long)r * KPAD; float v[5][8]; float mx = -3.0e38f;
#pragma unroll
        for (int j = 0; j < 5; ++j) { const int ch = lane + 64 * j;
            if (ch < KALL / 8) { unpack8(*reinterpret_cast<const u32x4*>(row + ch * 8), v[j]);
#pragma unroll
                for (int i = 0; i < 8; ++i) { v[j][i] *= MLA_SCALE; mx = fmaxf(mx, v[j][i]); } }
            else {
#pragma unroll
                for (int i = 0; i < 8; ++i) v[j][i] = -3.0e38f; } }
        mx = wave_max(mx); float sum = 0.f;
#pragma unroll
        for (int j = 0; j < 5; ++j) { const int ch = lane + 64 * j;
#pragma unroll
            for (int i = 0; i < 8; ++i) { v[j][i] = (ch < KALL / 8) ? __expf(v[j][i] - mx) : 0.f; sum += v[j][i]; } }
        sum = wave_sum(sum); const float inv = 1.0f / sum;
#pragma unroll
        for (int j = 0; j < 5; ++j) { const int ch = lane + 64 * j;
            if (ch < KPAD / 8) { float o[8];
#pragma unroll
                for (int i = 0; i < 8; ++i) o[i] = v[j][i] * inv;
                *reinterpret_cast<u32x4*>(row + ch * 8) = pack8(o); } } }
}

__device__ __forceinline__ void gnorm_gate(KParams& p, int w0, int nw) {
    const int lane = otid() & 63; unsigned char* ws = optr(gp(p.ws)); const bf16_t* OB = (const bf16_t*)(ws + WS_OB); const bf16_t* Y = (const bf16_t*)(ws + WS_Y);
    for (int t = w0; t < T; t += nw) { const int c0 = (lane >> 3) * 256 + (lane & 7) * 32; float x[4][8]; float s = 0.f;
#pragma unroll
        for (int i = 0; i < 4; ++i) { unpack8(*reinterpret_cast<const u32x4*>(OB + ((long)lane * T + t) * 32 + 8 * i), x[i]);
#pragma unroll
            for (int j = 0; j < 8; ++j) s += x[i][j]; }
        s += sx<1>(s); s += sx<2>(s); s += sx<4>(s); const float mu = s * (1.0f / 256.f); float q = 0.f;
#pragma unroll
        for (int i = 0; i < 4; ++i)
#pragma unroll
            for (int j = 0; j < 8; ++j) { const float d = x[i][j] - mu; q += d * d; }
        q += sx<1>(q); q += sx<2>(q); q += sx<4>(q); const float rstd = rsqrtf(q * (1.0f / 256.f) + EPS);
        float am = 0.f;
#pragma unroll
        for (int i = 0; i < 4; ++i) { float g[8]; unpack8(*reinterpret_cast<const u32x4*>(Y + (long)t * INWP + C_RG + c0 + 8 * i), g);
#pragma unroll
            for (int j = 0; j < 8; ++j) { x[i][j] = siluf_(g[j]) * (x[i][j] - mu) * rstd; am = fmaxf(am, fabsf(x[i][j])); } }
        am = wave_max(am); const float qs = am > 0.f ? 127.0f / am : 0.f; unsigned w[8];
#pragma unroll
        for (int i = 0; i < 4; ++i)
#pragma unroll
            for (int hh = 0; hh < 2; ++hh) { unsigned v = 0u;
#pragma unroll
                for (int j = 0; j < 4; ++j) v |= ((unsigned)((int)__builtin_rintf(x[i][4 * hh + j] * qs) & 0xff)) << (8 * j);
                w[2 * i + hh] = v; }
        *reinterpret_cast<u32x4*>(ws + WS_BG + (long)t * DM + c0) = (u32x4){w[0], w[1], w[2], w[3]};
        *reinterpret_cast<u32x4*>(ws + WS_BG + (long)t * DM + c0 + 16) = (u32x4){w[4], w[5], w[6], w[7]};
        if (lane == 0) ((float*)(ws + WS_SA8))[t] = am * (1.0f / 127.0f); }
}

__device__ __forceinline__ void peer_convert(KParams& p, int l, int r0, int r1, int w0, int nw) {
    unsigned char* ws = optr(gp(p.ws)); const int lane = otid() & 63;
    const float* su = gp(p.peer_u) + (long)l * NEXP * DM; const float* sv = gp(p.peer_v) + (long)l * NEXP * DM;
    for (int r = r0 + w0; r < r1; r += nw) { const bool second = r >= NEXP; const int row = second ? r - NEXP : r; const float* s = (second ? sv : su) + (long)row * DM;
        f32x4 v[8]; float am = 0.f;
#pragma unroll
        for (int j = 0; j < 8; ++j) { v[j] = *reinterpret_cast<const f32x4*>(s + 512 * (j >> 2) * 2 + 16 * lane + 4 * (j & 3));
            am = fmaxf(am, fmaxf(fmaxf(fabsf(v[j][0]), fabsf(v[j][1])), fmaxf(fabsf(v[j][2]), fabsf(v[j][3])))); }
        am = wave_max(am);
        float sc = 1.0f, isc = 1.0f;
        if (am > 0.f) { const int e = (int)((__float_as_uint(am) >> 23) & 0xffu) - 127;
            int k = 7 - e; k = k > 100 ? 100 : (k < -100 ? -100 : k);
            sc = __uint_as_float((unsigned)(127 + k) << 23); isc = __uint_as_float((unsigned)(127 - k) << 23); }
        unsigned w[8];
#pragma unroll
        for (int j = 0; j < 8; ++j) { int pk = __builtin_amdgcn_cvt_pk_fp8_f32(v[j][0] * sc, v[j][1] * sc, 0, false); pk = __builtin_amdgcn_cvt_pk_fp8_f32(v[j][2] * sc, v[j][3] * sc, pk, true); w[j] = (unsigned)pk; }
        if (!second) {
            unsigned char* dst = ws + WS_PU + ((long)(lane >> 3) * NEXP + row) * 128 + 16 * (lane & 7);
            *reinterpret_cast<u32x4*>(dst) = (u32x4){w[0], w[1], w[2], w[3]};
            *reinterpret_cast<u32x4*>(dst + 8L * NEXP * 128) = (u32x4){w[4], w[5], w[6], w[7]};
        } else {
            unsigned char* dst = ws + WS_PV + ((long)(2 * lane) * NEXP + row) * 8;
            *reinterpret_cast<u32x2*>(dst) = (u32x2){w[0], w[1]}; *reinterpret_cast<u32x2*>(dst + (long)NEXP * 8) = (u32x2){w[2], w[3]};
            *reinterpret_cast<u32x2*>(dst + 128L * NEXP * 8) = (u32x2){w[4], w[5]}; *reinterpret_cast<u32x2*>(dst + 129L * NEXP * 8) = (u32x2){w[6], w[7]}; }
        if (lane == 0) ((float*)(ws + (second ? WS_PSV : WS_PSU)))[row] = isc; }
}

__device__ __forceinline__ void final_norm(KParams& p) {
    const int lane = otid() & 63; float* X = gp(p.out);
    for (int t = gwave(); t < T; t += nwaves()) { float* xr = X + (long)t * DM; f32x4 v[8]; float ss = 0.f;
#pragma unroll
        for (int j = 0; j < 8; ++j) { v[j] = *reinterpret_cast<const f32x4*>(xr + 256 * j + 4 * lane); ss += v[j][0] * v[j][0] + v[j][1] * v[j][1] + v[j][2] * v[j][2] + v[j][3] * v[j][3]; }
        ss = wave_sum(ss); const float rinv = rsqrtf(ss * (1.0f / DM) + EPS);
#pragma unroll
        for (int j = 0; j < 8; ++j) { const int c = 256 * j + 4 * lane; const f32x4 gv = *reinterpret_cast<const f32x4*>(gp(p.g_final) + c); *reinterpret_cast<f32x4*>(xr + c) = v[j] * rinv * gv; } }
}
}
__global__ void __launch_bounds__(512, 2) mega_fwd(Params p_by_value_unused) {
    extern __shared__ __attribute__((aligned(16))) unsigned char shm[];
    LAS unsigned char* lds = (LAS unsigned char*)shm; char* ldsg = (char*)shm;
    if (threadIdx.x < 8) ((LAS unsigned*)(lds + LDS_BARW))[threadIdx.x] = 0u;
    __syncthreads();
    if (threadIdx.x == 0) { unsigned* tk = (unsigned*)(gp(KP.ws) + WS_CTL + CTL_RANK) + 64 * xb_xcc_id(); ((volatile LAS unsigned*)(lds + LDS_BARW))[2] = xb_add(tk, 1u); }
    const XcdBarrier bar = xcd_barrier_post((unsigned*)(gp(KP.ws) + WS_CTL), (volatile LAS unsigned*)(lds + LDS_BARW));
#define GRID_SYNC() xcd_barrier(bar)
#ifndef STOP_AT
#define STOP_AT 0
#endif
#ifdef DBG_DUMP
#define STOPCHK(n) do { if (STOP_AT == (n)) { float* xo = gp(KP.out); const bf16_t* src = (const bf16_t*)(gp(KP.ws) + DBG_DUMP); for (long i = ph::gthread(); i < (long)T * DM; i += ph::nthreads()) xo[i] = bf2f(src[i]); return; } } while (0)
#elif defined(DBG_SANITIZE)
#define STOPCHK(n) do { if (STOP_AT == (n) || (STOP_AT > 100 && l == 1 && STOP_AT - 100 == (n))) { float* xo = gp(KP.out); for (long i = ph::gthread(); i < (long)T * DM; i += ph::nthreads()) { const float v = xo[i]; if (!(v - v == 0.0f)) xo[i] = 7.0f; } return; } } while (0)
#else
#define STOPCHK(n) do { if (STOP_AT == (n) || (STOP_AT > 100 && l == 1 && STOP_AT - 100 == (n))) return; } while (0)
#endif
    using namespace pg8;
#define WSP(off) ((bf16_t*)(optr(gp(KP.ws)) + (off)))
#define H WSP(WS_H)
#define Y WSP(WS_Y)
#define CQN WSP(WS_CQN)
#define CKVNP WSP(WS_CKVNP)
#define KRP WSP(WS_KRP)
#define Q WSP(WS_Q)
#define YA WSP(WS_YA)
#define KV WSP(WS_KV)
#define SP WSP(WS_SP)
#define MIX WSP(WS_MIX)
#define OA WSP(WS_OA)
#define QP WSP(WS_QP)
#define CKA WSP(WS_CKA)
#define CKT WSP(WS_CKT)
#define QL WSP(WS_QL)
#define OL WSP(WS_OL)
#define BG WSP(WS_BG)
    int l = 0;
    ph::prologue(KP, ldsg);
#ifdef DUP_PRO
    ph::prologue(KP, ldsg);
#endif
    GRID_SYNC(); STOPCHK(1);
    if (threadIdx.x == 0) { unsigned* barw = (unsigned*)(gp(KP.ws) + WS_CTL); const unsigned me = xb_xcc_id(); unsigned nx = 0, xi = 0, nloc = 1;
        for (unsigned j = 0; j < 16; ++j) { const unsigned cn = xb_ld(&barw[XB_XCNT(j)]); if (cn) { if (j < me) ++xi; ++nx; } if (j == me) nloc = cn ? cn : 1u; }
        volatile LAS unsigned* iw = (volatile LAS unsigned*)(lds + LDS_BARW); iw[3] = xi; iw[4] = nx; iw[5] = nloc; }
    __syncthreads();
    ph::ada_reduce(KP);
    ph::wpq_int8(KP);
    GRID_SYNC(); STOPCHK(2);
    for (l = 0; l < DEPTH; ++l) {
#define WIN (WSP(WS_WIN) + (long)l * INWP * DM)
#define WUQ (WSP(WS_WUQ) + (long)l * 3072 * 512)
#define WUKV (WSP(WS_WUKV) + (long)l * 4096 * 512)
#define WUK (WSP(WS_WUK) + (long)l * 16 * 512 * 256)
#define WA (WSP(WS_WA) + (long)l * DM * DM)
#define WB (WSP(WS_WB) + (long)l * DM * DM)
#define WO (WSP(WS_WO) + (long)l * DM * DM)
#define WPQ (WSP(WS_WPQ) + (long)l * DM * DM)
#define ADA ((const float*)(optr(gp(KP.ws)) + WS_ADA) + (long)l * NCOND * 12288)
        ph::modulate(KP, l, 0);
        ph::win_int8(KP, l);
        ph::wb_int8(KP, l);
        ph::wu_int8(KP, l);
        ph::cache_convert(KP, l, ldsg, l == 0 ? 0 : 4096, 8192, obid(), ogrid());
        GRID_SYNC(); STOPCHK(3);
        { Sched<5> S; S.init(T / 256, INWP / 256 - NB8, (T / 256) * (INWP / 256 - NB8), DM, DM); gemm_phase(lds, Gemm{H, WIN, DM, DM, DM}, S, EpiBf16{Y, INWP, 0}); }
        { Sched<6> S; S.init(T / 256, NB8, (T / 256) * NB8, DM / 2, DM / 2);
          { const int G_ = ogrid(); S.rotate((((((T / 256) * NB8) % G_) + 7) & ~7) % G_); }
          unsigned char* ws8 = optr(gp(KP.ws));
          gemm_phase<EpiQ8, Sched<6>, true>(lds, Gemm{(const bf16_t*)(ws8 + WS_H8), (const bf16_t*)(ws8 + WS_WIN8), DM / 2, DM / 2, DM / 2}, S, EpiQ8{Y, INWP, (const float*)(ws8 + WS_SA8), (const float*)(ws8 + WS_SBW)}); }
#ifdef DUP_WIN
        { Sched<0> S; S.init(T / 256, INWP / 256, (T / 256) * (INWP / 256), DM, DM); gemm_phase(lds, Gemm{H, WIN, DM, DM, DM}, S, EpiBf16{Y, INWP, 0}); }
#endif
        GRID_SYNC(); STOPCHK(4);
        ph::post_win(KP, l);
        GRID_SYNC(); STOPCHK(5);
        { unsigned char* ws8 = optr(gp(KP.ws));
          { Sched<0> S; S.init(T / 256, 3072 / 256, (T / 256) * 12, 256, 256); gemm_phase<EpiQ, Sched<0>, 2>(lds, Gemm{CQN, (const bf16_t*)(ws8 + WS_WUQ8), 256, 256, 256, (const float*)(ws8 + WS_SAQ), (const float*)(ws8 + WS_SBQ)}, S, EpiQ{Q, QL, (const float*)(ws8 + WS_TAB64)}); }
          { Sched<0> S; S.init(TP / 256, 4096 / 256, (TP / 256) * 16, 256, 256); gemm_phase<EpiBf16, Sched<0>, 2>(lds, Gemm{CKVNP, (const bf16_t*)(ws8 + WS_WUKV8), 256, 256, 256, (const float*)(ws8 + WS_SAK), (const float*)(ws8 + WS_SBK)}, S, EpiBf16{KV, 4096, 0}); } }
        GRID_SYNC(); STOPCHK(6);
#ifndef DUP_ATTN
#define DUP_ATTN 1
#endif
#ifndef DUP_RET
#define DUP_RET 1
#endif
#ifndef DUP_GATHER
#define DUP_GATHER 0
#endif
#pragma unroll 1
        for (int rep_ = 0; rep_ < DUP_ATTN; ++rep_)
        { for (int u = obid(); u < 512; u += ogrid()) { const int c = u & 255, i = u >> 8, xcd = c & 7, slot = c >> 3; const int bh = xcd * 4 + (slot >> 3) + 32 * i, pr = slot & 7, b = bh >> 4, h = bh & 15;
#pragma unroll 1
              for (int z = 0; z < 2; ++z) { const int qb = z ? 15 - pr : pr; const long tok0 = (long)b * SEQ + 256 * qb;
                  att::attn_block(Q + tok0 * 3072 + h * 192, KV + (long)b * SEQ * 4096 + h * 256, KRP + (long)b * SEQ * 64, KV + (long)b * SEQ * 4096 + h * 256 + 128, OA + tok0 * DM + h * 128, qb, ldsg); } } }
        { Sched<1> S; S.init(0, 0, 256, 3072, 256); gemm_phase(lds, Gemm{Q, WUK, 256, 3072, 256}, S, EpiRowMap<1>{QL, nullptr}); }
        GRID_SYNC(); STOPCHK(8);
        { Sched<2> S; S.init(0, 0, DB * 36, QLD, QLD); gemm_phase(lds, Gemm{QL, CKA, QLD, QLD, QLD}, S, EpiExp{SP, (float*)(optr(gp(KP.ws)) + WS_CTL + CTL_RSUM) + (long)l * 32768}); }
        GRID_SYNC(); STOPCHK(9);
        { Sched<3> S; S.init(0, 0, 256, KPAD, KPAD); gemm_phase(lds, Gemm{SP, CKT, 2176, KPAD, KPAD}, S, EpiRowMap<3>{OL, (const float*)(optr(gp(KP.ws)) + WS_CTL + CTL_RSUM) + (long)l * 32768}); }
        GRID_SYNC(); STOPCHK(11);
        { Sched<4> S; S.init(0, 0, 128, 512, 512); gemm_phase(lds, Gemm{OL, WUKV, 512, 512, 512}, S, EpiOV{OA}); }
#pragma unroll 1
        for (int rep_ = 0; rep_ < DUP_RET; ++rep_)
        for (int u = obid(); u < 256 + DB * 64; u += ogrid()) ret::unit(KP, l, u, ldsg);
#ifdef DUP_RETP
        for (int u = obid(); u < 256; u += ogrid()) ret::unit(KP, l, u, ldsg);
#endif
        GRID_SYNC(); STOPCHK(12);
        { Sched<0> S; S.init(T / 256, DM / 256, (T / 256) * 8, DM, DM); gemm_phase(lds, Gemm{OA, WA, DM, DM, DM}, S, EpiBf16{YA, DM, 0}); }
        { const int G_ = ogrid(), rem_ = ((T / 256) * 8) % G_; const int b_ = obid();
          if (rem_ == 0) ph::gnorm_gate(KP, ph::gwave(), ph::nwaves());
          else if (b_ >= rem_) ph::gnorm_gate(KP, (b_ - rem_) * 8 + (otid() >> 6), (G_ - rem_) * 8); }
#ifdef DUP_WA
#pragma unroll 1
        for (int rep_ = 0; rep_ < DUP_WA; ++rep_)
        { Sched<0> S; S.init(T / 256, DM / 256, (T / 256) * 8, DM, DM); gemm_phase(lds, Gemm{OA, WA, DM, DM, DM}, S, EpiBf16{YA, DM, 0}); }
#endif
        GRID_SYNC(); STOPCHK(14);
        { Sched<0> S; S.init(T / 256, DM / 256, (T / 256) * 8, DM / 2, DM / 2); unsigned char* ws8 = optr(gp(KP.ws));
          gemm_phase<EpiMix, Sched<0>, true>(lds, Gemm{(const bf16_t*)(ws8 + WS_BG), (const bf16_t*)(ws8 + WS_WB8), DM / 2, DM / 2, DM / 2}, S, EpiMix{Y, YA, MIX, (const float*)(ws8 + WS_SA8), (const float*)(ws8 + WS_SBB)}); }
        { const int G_ = ogrid(), rem_ = ((T / 256) * 8) % G_; const int b_ = obid();
          if (rem_ == 0) ph::peer_convert(KP, l, 0, NEXP, ph::gwave(), ph::nwaves());
          else if (b_ >= rem_) ph::peer_convert(KP, l, 0, NEXP, (b_ - rem_) * 8 + (otid() >> 6), (G_ - rem_) * 8); }
        GRID_SYNC(); STOPCHK(15);
        { Sched<0> S; S.init(T / 256, DM / 256, (T / 256) * 8, DM, DM); gemm_phase(lds, Gemm{MIX, WO, DM, DM, DM}, S, EpiRes{gp(KP.out), ADA + 2 * DM, l == 0 ? gp(KP.x_prompt) : gp(KP.out), l == 0 ? gp(KP.x_sample) : gp(KP.out) + (long)TP * DM}); }
        { const int G_ = ogrid(), rem_ = ((T / 256) * 8) % G_; const int b_ = obid();
          if (rem_ == 0) ph::peer_convert(KP, l, NEXP, 2 * NEXP, ph::gwave(), ph::nwaves());
          else if (b_ >= rem_) ph::peer_convert(KP, l, NEXP, 2 * NEXP, (b_ - rem_) * 8 + (otid() >> 6), (G_ - rem_) * 8); }
        GRID_SYNC(); STOPCHK(16);
        ph::modulate(KP, l, 1);
        GRID_SYNC(); STOPCHK(17);
        { Sched<0> S; S.init(T / 256, DM / 256, (T / 256) * 8, DM / 2, DM / 2);
          unsigned char* ws8 = optr(gp(KP.ws));
          gemm_phase<EpiQ8, Sched<0>, true>(lds, Gemm{(const bf16_t*)(ws8 + WS_H8), (const bf16_t*)(ws8 + WS_WPQ8 + (long)l * DM * DM), DM / 2, DM / 2, DM / 2}, S, EpiQ8{QP, DM, (const float*)(ws8 + WS_SA8), (const float*)(ws8 + WS_SB8) + (long)l * DM});
#ifdef DUP_WPQ
          gemm_phase<EpiQ8, Sched<0>, true>(lds, Gemm{(const bf16_t*)(ws8 + WS_H8), (const bf16_t*)(ws8 + WS_WPQ8 + (long)l * DM * DM), DM / 2, DM / 2, DM / 2}, S, EpiQ8{QP, DM, (const float*)(ws8 + WS_SA8), (const float*)(ws8 + WS_SB8) + (long)l * DM});
#endif
        }
        if (l + 1 < DEPTH) { const int G_ = ogrid(), rem_ = ((T / 256) * 8) % G_; const int b_ = obid();
          if (rem_ == 0) ph::cache_convert(KP, l + 1, ldsg, 0, 4096, b_, G_);
          else if (b_ >= rem_) ph::cache_convert(KP, l + 1, ldsg, 0, 4096, b_ - rem_, G_ - rem_); }
        GRID_SYNC(); STOPCHK(18);
        { const int tid_ = otid(); const int lane = tid_ & 63; float* strip = (float*)ldsg + tid_ * 33; unsigned char* ws = optr(gp(KP.ws));
          const bf16_t* k1g = (const bf16_t*)(ws + WS_PK1) + (long)l * 128 * 128; const bf16_t* k2g = (const bf16_t*)(ws + WS_PK2) + (long)l * 128 * 128;
          bf16_t* k1 = (bf16_t*)(ldsg + 512 * 33 * 4 + 64); bf16_t* k2 = k1 + 128 * peer::KPITCH;
          for (int i = tid_; i < 2 * 128 * 16; i += 512) { const int which = i >> 11, r = (i >> 4) & 127, ch = i & 15;
              *reinterpret_cast<u32x4*>((which ? k2 : k1) + r * peer::KPITCH + ch * 8) = *reinterpret_cast<const u32x4*>((which ? k2g : k1g) + r * 128 + ch * 8); }
          __syncthreads();
          for (int wu = ph::gwave(); wu < (T / 32) * PH; wu += ph::nwaves()) peer::select_unit(QP, k1, k2, (int*)(ws + WS_PIDX), (float*)(ws + WS_PW), (wu >> 3) * 32, wu & 7, lane, strip);
#ifdef DUP_SEL
          for (int wu = ph::gwave(); wu < (T / 32) * PH; wu += ph::nwaves()) peer::select_unit(QP, k1, k2, (int*)(ws + WS_PIDX), (float*)(ws + WS_PW), (wu >> 3) * 32, wu & 7, lane, strip);
#endif
        }
        GRID_SYNC(); STOPCHK(19);
        { const int tid_ = otid(); const int lane = tid_ & 63, wid = tid_ >> 6; unsigned char* ws = optr(gp(KP.ws));
          volatile LAS unsigned* iw = (volatile LAS unsigned*)(lds + LDS_BARW); peer::XInfo xin; xin.rank = __builtin_amdgcn_readfirstlane((int)iw[2]); xin.xi = __builtin_amdgcn_readfirstlane((int)iw[3]); xin.nx = __builtin_amdgcn_readfirstlane((int)iw[4]); xin.nloc = __builtin_amdgcn_readfirstlane((int)iw[5]);
          if (xin.nx >= 1 && xin.nx <= 8) {
              peer::upass(H, (const unsigned char*)(ws + WS_PU), (const int*)(ws + WS_PIDX), (const float*)(ws + WS_PW), (const float*)(ws + WS_PSU), (const float*)(ws + WS_PSV), (float*)(ws + WS_DOTP), (unsigned*)(ws + WS_ACT), xin, wid, lane);
              GRID_SYNC();
              int vs0_, vsn_, vse_;
              if ((256 % xin.nx) == 0) { const int spx = 256 / xin.nx; vs0_ = xin.xi * spx + xin.rank; vsn_ = xin.nloc; vse_ = (xin.xi + 1) * spx; }
              else { vs0_ = obid(); vsn_ = ogrid(); vse_ = 256; }
              peer::vpass_lds((const unsigned char*)(ws + WS_PV), (const unsigned*)(ws + WS_ACT), gp(KP.out), ADA + 5 * DM, ldsg, vs0_, vsn_, vse_, tid_);
#ifdef DUP_VP
              peer::vpass_lds((const unsigned char*)(ws + WS_PV), (const unsigned*)(ws + WS_ACT), (float*)(ws + WS_OB), ADA + 5 * DM, ldsg, vs0_, vsn_, vse_, tid_);
#endif
          } else {
              for (int t = ph::gwave(); t < T; t += ph::nwaves()) peer::gather_token(H, (const unsigned char*)(ws + WS_PU), (const unsigned char*)(ws + WS_PV), (const float*)(ws + WS_PSU), (const float*)(ws + WS_PSV), (const int*)(ws + WS_PIDX), (const float*)(ws + WS_PW), gp(KP.out), ADA + 5 * DM, t, lane);
          } }
        GRID_SYNC(); STOPCHK(20);
    }
    ph::final_norm(KP);
}

extern "C" void kernel_launch(void* const* d_in, const int* in_sizes, int n_in, void* d_out, int out_size, void* d_ws, size_t ws_size, hipStream_t stream) {
    static int grid = 0;
    if (grid == 0) {
        if (n_in != 25 || out_size != (int)O_END || ws_size < WS_END) { fprintf(stderr, "kernel_launch: shape mismatch: n_in %d out %d (want %ld) ws %zu (want >= %zu)\n", n_in, out_size, O_END, ws_size, (size_t)WS_END); grid = -1; return; }
        int dev = 0, cus = 0, per_cu = 0;
        if (hipGetDevice(&dev) != hipSuccess || hipDeviceGetAttribute(&cus, hipDeviceAttributeMultiprocessorCount, dev) != hipSuccess) { fprintf(stderr, "kernel_launch: device query failed\n"); grid = -1; return; }
        if (hipFuncSetAttribute((const void*)mega_fwd, hipFuncAttributeMaxDynamicSharedMemorySize, LDS_BYTES) != hipSuccess) { fprintf(stderr, "kernel_launch: hipFuncSetAttribute failed\n"); grid = -1; return; }
        if (hipOccupancyMaxActiveBlocksPerMultiprocessor(&per_cu, (const void*)mega_fwd, 512, LDS_BYTES) != hipSuccess || per_cu < 1) { fprintf(stderr, "kernel_launch: occupancy query says %d blocks per CU\n", per_cu); grid = -1; return; }
        grid = cus;
#ifdef FORCE_GRID
        grid = FORCE_GRID;
#endif
    }
    if (grid < 0) return;
    (void)hipMemsetAsync((char*)d_ws + WS_CTL, 0, CTL_BYTES, stream);
    Params p{};
    const float* const* in = (const float* const*)d_in;
    p.x_prompt = in[0]; p.x_sample = in[1]; p.c_prompt = in[2]; p.c_sample = in[3]; p.cache_ckv = in[4]; p.cache_krope = in[5]; p.state_ret = in[6]; p.w_ada = in[7]; p.b_ada = in[8];
    p.g_mix = in[9]; p.g_ffn = in[10]; p.w_in = in[11]; p.g_q = in[12]; p.w_uq = in[13]; p.g_kv = in[14]; p.w_ukv = in[15]; p.w_a = in[16]; p.w_b = in[17]; p.w_o = in[18]; p.w_pq = in[19];
    p.peer_k1 = in[20]; p.peer_k2 = in[21]; p.peer_u = in[22]; p.peer_v = in[23]; p.g_final = in[24];
    p.out = (float*)d_out; p.ws = (unsigned char*)d_ws;
    for (int h = 0; h < 8; ++h) p.lg[h] = (float)log1p(-pow(2.0, -5.0 - (double)h));
    p.grid = grid; p.pad_ = 0;
    hipLaunchKernelGGL(mega_fwd, dim3(grid), dim3(512), LDS_BYTES, stream, p);
    const hipError_t le = hipGetLastError();
    if (le != hipSuccess) fprintf(stderr, "kernel_launch: launch failed: %s\n", hipGetErrorName(le));
}
```

```cpp
#include <hip/hip_runtime.h>
#include <cstdio>
#include <cstdint>
#include <cmath>

#define LAS __attribute__((address_space(3)))
typedef unsigned short bf16_t;
typedef short bf16x8 __attribute__((ext_vector_type(8)));
typedef float f32x4 __attribute__((ext_vector_type(4)));
typedef float f32x2 __attribute__((ext_vector_type(2)));
typedef float f32x16 __attribute__((ext_vector_type(16)));
typedef unsigned u32x4 __attribute__((ext_vector_type(4)));
typedef unsigned u32x2 __attribute__((ext_vector_type(2)));
typedef short s16x4 __attribute__((ext_vector_type(4)));
typedef int i32x4 __attribute__((ext_vector_type(4)));

constexpr int DM = 2048, NB = 4, SEQ = 4096, DEPTH = 2, DB = 32, DS = 64, PAST = 2048;
constexpr int TP = NB * SEQ, TS = DB * DS, T = TP + TS;
constexpr int NCOND = NB + DB;
constexpr int QLORA = 512, KVLORA = 512, ROPE = 64, NOPE = 128, VD = 128, MH = 16, QKD = 192;
constexpr int RH = 8, RQK = 128, RV = 256;
constexpr int PH = 8, NKEYS = 128, NEXP = 16384, PTOPK = 16;
constexpr int INW = 11328, INWP = 11520;
constexpr int C_CQ = 0, C_CKV = 512, C_KR = 1024, C_RQ = 1088, C_RK = 2112, C_RV = 3136, C_RG = 5184, C_GA = 7232, C_GB = 9280;
constexpr int KALL = PAST + DS;
constexpr int KPAD = 2304;
constexpr int QLD = 640;
constexpr float EPS = 1e-6f;
constexpr float MLA_SCALE = 0.07216878364870322f;

constexpr long O_Y = 0;
constexpr long O_CKVP = (long)T * DM;
constexpr long O_KRP = O_CKVP + 2L * TP * 512;
constexpr long O_RETP = O_KRP + 2L * TP * 64;
constexpr long O_CKVS = O_RETP + 2L * NB * RH * RQK * RV;
constexpr long O_KRS = O_CKVS + 2L * TS * 512;
constexpr long O_RETS = O_KRS + 2L * TS * 64;
constexpr long O_END = O_RETS + 2L * DB * RH * RQK * RV;

constexpr size_t al256(size_t x) { return (x + 255) / 256 * 256; }
constexpr size_t WS_CTL = 0;
constexpr size_t CTL_BYTES = 65536 + 2UL * 32768 * 4;
constexpr size_t CTL_RSUM = 65536;
constexpr size_t WS_TAB64 = WS_CTL + CTL_BYTES;
constexpr size_t WS_TAB128 = WS_TAB64 + 4096UL * 32 * 2 * 4;
constexpr size_t WS_ADA = WS_TAB128 + 4096UL * 64 * 2 * 4;
constexpr size_t WS_ADAP = WS_ADA + 2UL * NCOND * 12288 * 4;
constexpr size_t WS_WIN = WS_ADAP + 8UL * 2 * NCOND * 12288 * 4;
constexpr size_t WS_WUQ = WS_WIN + 2UL * INWP * DM * 2;
constexpr size_t WS_WUKV = WS_WUQ + 2UL * 3072 * 512 * 2;
constexpr size_t WS_WUK = WS_WUKV + 2UL * 4096 * 512 * 2;
constexpr size_t WS_WA = WS_WUK + 2UL * 16 * 512 * 256 * 2;
constexpr size_t WS_WB = WS_WA + 2UL * DM * DM * 2;
constexpr size_t WS_WO = WS_WB + 2UL * DM * DM * 2;
constexpr size_t WS_WPQ = WS_WO + 2UL * DM * DM * 2;
constexpr size_t WS_PK1 = WS_WPQ + 2UL * DM * DM * 2;
constexpr size_t WS_PK2 = WS_PK1 + 2UL * 128 * 128 * 2;
constexpr size_t WS_H = WS_PK2 + 2UL * 128 * 128 * 2;
constexpr size_t WS_Y = WS_H + (size_t)T * DM * 2;
constexpr size_t WS_CQN = WS_Y + (size_t)T * INWP * 2;
constexpr size_t WS_CKVNP = WS_CQN + (size_t)T * 512 * 2;
constexpr size_t WS_KRP = WS_CKVNP + (size_t)TP * 512 * 2;
constexpr size_t WS_Q = WS_KRP + (size_t)TP * 64 * 2;
constexpr size_t WS_YA = WS_Q;
constexpr size_t WS_KV = WS_Q + (size_t)T * 3072 * 2 + 4096;
constexpr size_t WS_SP = WS_KV;
constexpr size_t WS_MIX = WS_KV;
constexpr size_t WS_OA = WS_KV + 32UL * 1024 * KPAD * 2;
constexpr size_t WS_QP = WS_OA;
constexpr size_t WS_CKA = WS_OA + (size_t)T * DM * 2;
constexpr size_t WS_CKT = WS_CKA + 32UL * KPAD * QLD * 2;
constexpr size_t WS_QL = WS_CKT + 32UL * 512 * KPAD * 2;
constexpr size_t WS_OL = WS_QL + 32UL * 1024 * QLD * 2;
constexpr size_t WS_OB = WS_OL + 16UL * 2048 * 512 * 2;
constexpr size_t WS_BG = WS_OB + (size_t)T * DM * 2;
constexpr size_t WS_PIDX = WS_BG + (size_t)T * DM * 2;
constexpr size_t WS_PW = WS_PIDX + (size_t)T * 128 * 4;
constexpr size_t WS_PU = WS_PW + (size_t)T * 128 * 4;
constexpr size_t WS_PV = WS_PU + (size_t)NEXP * DM;
constexpr size_t WS_PSU = WS_PV + (size_t)NEXP * DM;
constexpr size_t WS_PSV = WS_PSU + (size_t)NEXP * 4;
constexpr size_t WS_WPQ8 = WS_PSV + (size_t)NEXP * 4;
constexpr size_t WS_SB8 = WS_WPQ8 + 2UL * DM * DM;
constexpr size_t WS_SA8 = WS_SB8 + 2UL * DM * 4;
constexpr int NB8 = 29;
constexpr size_t WS_WIN8 = WS_BG + (size_t)T * DM;
constexpr size_t WS_WB8 = WS_WIN8 + (size_t)NB8 * 256 * DM;
constexpr size_t WS_WUQ8 = WS_WB8 + (size_t)DM * DM;
constexpr size_t WS_WUKV8 = WS_WUQ8 + 3072UL * 512;
static_assert(WS_WUKV8 + 4096UL * 512 <= WS_BG + (size_t)T * DM * 2, "int8 weights overflow the BG region");
constexpr size_t WS_SBW = WS_SA8 + al256((size_t)T * 4);
constexpr size_t WS_SBB = WS_SBW + al256((size_t)INWP * 4);
constexpr size_t WS_SBQ = WS_SBB + (size_t)DM * 4;
constexpr size_t WS_SBK = WS_SBQ + 3072UL * 4;
constexpr size_t WS_SAQ = WS_SBK + 4096UL * 4;
constexpr size_t WS_SAK = WS_SAQ + al256((size_t)T * 4);
constexpr size_t WS_END = WS_SAK + al256((size_t)TP * 4);
constexpr size_t WS_H8 = WS_OB;
static_assert((size_t)TP * 4096 * 2 <= 32UL * 1024 * KPAD * 2, "KV fits in the SP region");
static_assert(WS_END <= 1608000000UL, "workspace map too large");
static_assert(WS_WIN % 256 == 0 && WS_H % 256 == 0 && WS_Y % 256 == 0 && WS_Q % 256 == 0 && WS_KV % 256 == 0 && WS_CKA % 256 == 0, "alignment");

constexpr int LDS_BYTES = 147456;
constexpr int LDS_BARW = LDS_BYTES - 32;
constexpr size_t CTL_RANK = 16384;
constexpr size_t WS_DOTP = WS_Q;
constexpr size_t WS_ACT = WS_DOTP + 8UL * T * 128 * 4;
constexpr size_t WS_PIDXT = WS_ACT + (size_t)T * 128 * 4;
static_assert(WS_PIDXT + (size_t)T * 128 * 4 <= WS_KV, "PEER scratch fits in the Q region");

struct Params {
    const float *x_prompt, *x_sample, *c_prompt, *c_sample, *cache_ckv, *cache_krope, *state_ret, *w_ada, *b_ada, *g_mix, *g_ffn, *w_in, *g_q, *w_uq, *g_kv, *w_ukv,
                *w_a, *w_b, *w_o, *w_pq, *peer_k1, *peer_k2, *peer_u, *peer_v, *g_final;
    float* out; unsigned char* ws;
    float lg[8];
    int grid; int pad_;
};

typedef const __attribute__((address_space(4))) Params KParams;
__device__ __forceinline__ KParams* okarg() {
    const uintptr_t k = (uintptr_t)__builtin_amdgcn_kernarg_segment_ptr();
    unsigned lo = (unsigned)k, hi = (unsigned)(k >> 32);
    asm volatile("" : "+s"(lo), "+s"(hi)); return (KParams*)(((uintptr_t)hi << 32) | lo); }
#define KP (*okarg())
__device__ __forceinline__ int ogrid() { return KP.grid; }
__device__ __forceinline__ int obid() { int b = (int)blockIdx.x; asm volatile("" : "+s"(b) :: "memory"); return b; }
__device__ __forceinline__ int otid() { int t = (int)threadIdx.x; asm volatile("" : "+v"(t) :: "memory"); return t; }
template <class P> __device__ __forceinline__ P* gp(P* p) { return (P*)(__attribute__((address_space(1))) P*)(uintptr_t)p; }
template <class P> __device__ __forceinline__ P* optr(P* p) {
    unsigned lo = __builtin_amdgcn_readfirstlane((unsigned)(uintptr_t)p), hi = __builtin_amdgcn_readfirstlane((unsigned)((uintptr_t)p >> 32));
    asm volatile("" : "+s"(lo), "+s"(hi)); return gp((P*)(((uintptr_t)hi << 32) | lo)); }
typedef __bf16 bf16v2_t __attribute__((ext_vector_type(2)));
__device__ __forceinline__ unsigned cvt_pk_bf16(float lo, float hi) { f32x2 v = {lo, hi}; bf16v2_t r = __builtin_convertvector(v, bf16v2_t); return __builtin_bit_cast(unsigned, r); }
__device__ __forceinline__ bf16_t f2bf(float f) { return (bf16_t)(cvt_pk_bf16(f, 0.f) & 0xffffu); }
__device__ __forceinline__ float bf2f(bf16_t b) { return __uint_as_float(((unsigned)b) << 16); }
__device__ __forceinline__ float bflo(unsigned w) { return __uint_as_float(w << 16); }
__device__ __forceinline__ float bfhi(unsigned w) { return __uint_as_float(w & 0xffff0000u); }
__device__ __forceinline__ void unpack8(const u32x4 w, float (&f)[8]) { f[0] = bflo(w.x); f[1] = bfhi(w.x); f[2] = bflo(w.y); f[3] = bfhi(w.y); f[4] = bflo(w.z); f[5] = bfhi(w.z); f[6] = bflo(w.w); f[7] = bfhi(w.w); }
__device__ __forceinline__ u32x4 pack8(const float (&f)[8]) { u32x4 w; w.x = cvt_pk_bf16(f[0], f[1]); w.y = cvt_pk_bf16(f[2], f[3]); w.z = cvt_pk_bf16(f[4], f[5]); w.w = cvt_pk_bf16(f[6], f[7]); return w; }
template <int K> __device__ __forceinline__ float sx(float v) {
    if constexpr (K == 32) { const auto rr = __builtin_amdgcn_permlane32_swap(__float_as_uint(v), __float_as_uint(v), false, false); return __uint_as_float((otid() & 32) ? rr[0] : rr[1]); }
    else return __int_as_float(__builtin_amdgcn_ds_swizzle(__float_as_int(v), (K << 10) | 0x1F));
}
__device__ __forceinline__ float wave_sum(float v) { v += sx<32>(v); v += sx<16>(v); v += sx<8>(v); v += sx<4>(v); v += sx<2>(v); v += sx<1>(v); return v; }
__device__ __forceinline__ float wave_max(float v) { v = fmaxf(v, sx<32>(v)); v = fmaxf(v, sx<16>(v)); v = fmaxf(v, sx<8>(v)); v = fmaxf(v, sx<4>(v)); v = fmaxf(v, sx<2>(v)); v = fmaxf(v, sx<1>(v)); return v; }
__device__ __forceinline__ float sigmoidf_(float x) { return 1.0f / (1.0f + __expf(-x)); }
__device__ __forceinline__ float siluf_(float x) { return x / (1.0f + __expf(-x)); }
__device__ __forceinline__ int cond_row(int t) { return t < TP ? (t >> 12) : NB + ((t - TP) >> 6); }
__device__ __forceinline__ int tok_pos(int t) { return t < TP ? (t & 4095) : PAST + ((t - TP) & 63); }

#define XB_TMO      128
#define XB_XCNT(j)  (256  + 64 * (j))
#define XB_XSUB(j)  (1280 + 64 * (j))
#define XB_XGEN(j)  (2304 + 64 * (j))
#define XB_TOP      3328
#define XB_TOPGEN   3392
#define XCD_BAR_WORDS 3456
#define XB_SPIN_CAP (1u << 22)
__device__ __forceinline__ unsigned xb_ld(unsigned* p)              { return __hip_atomic_load(p, __ATOMIC_RELAXED, __HIP_MEMORY_SCOPE_AGENT); }
__device__ __forceinline__ unsigned xb_add(unsigned* p, unsigned v) { return __hip_atomic_fetch_add(p, v, __ATOMIC_RELAXED, __HIP_MEMORY_SCOPE_AGENT); }
__device__ __forceinline__ unsigned xb_xcc_id() { return (unsigned)__builtin_amdgcn_s_getreg((3 << 11) | 20) & 0xFu; }
#define XB_SPIN(cond, bar) do { unsigned _sp = 0; while (cond) { __builtin_amdgcn_s_sleep(1); \
    if ((++_sp & 255u) == 0u) { if (xb_ld(&(bar)[XB_TMO])) break; if (_sp > XB_SPIN_CAP) { atomicAdd(&(bar)[XB_TMO], 1u); break; } } } } while (0)
struct XcdBarrier { unsigned* bar; unsigned x; volatile LAS unsigned* st; };
__device__ __forceinline__ XcdBarrier xcd_barrier_post(unsigned* bar, volatile LAS unsigned* st) {
    XcdBarrier b; b.bar = bar; b.x = xb_xcc_id(); b.st = st;
    if (threadIdx.x == 0) (void)xb_add(&bar[XB_XCNT(b.x)], 1u);
    return b;
}
__device__ __forceinline__ void xcd_barrier_complete(unsigned* bar, unsigned x, unsigned& nloc, unsigned& nx) {
    const unsigned G = (unsigned)KP.grid;
    unsigned sum, cnt, mine, sp = 0u;
    for (;;) {
        sum = 0u; cnt = 0u; mine = 0u;
#pragma unroll
        for (unsigned j = 0; j < 16; ++j) { const unsigned c = xb_ld(&bar[XB_XCNT(j)]); sum += c; cnt += (c > 0u) ? 1u : 0u; mine = (j == x) ? c : mine; }
        if (sum == G) break;
        __builtin_amdgcn_s_sleep(1);
        if ((++sp & 255u) == 0u) { if (xb_ld(&bar[XB_TMO])) break; if (sp > XB_SPIN_CAP) { atomicAdd(&bar[XB_TMO], 1u); break; } }
    }
    nloc = mine > 0u ? mine : 1u; nx = cnt > 0u ? cnt : 1u;
}
__device__ __forceinline__ void xcd_barrier(const XcdBarrier& b) {
    asm volatile("s_waitcnt vmcnt(0)" ::: "memory");
    __syncthreads();
    if (otid() == 0) {
        unsigned* bar = (unsigned*)(gp(KP.ws) + WS_CTL);
        unsigned bx = xb_xcc_id(); asm volatile("" : "+s"(bx));
        __builtin_amdgcn_s_waitcnt(0);
        unsigned nloc = b.st[0], nx = b.st[1];
        if (nloc == 0u) { xcd_barrier_complete(bar, bx, nloc, nx); b.st[0] = nloc; b.st[1] = nx; }
        const unsigned old = xb_add(&bar[XB_XSUB(bx)], 1u);
        const unsigned gen = old / nloc;
        if (old + 1u == (gen + 1u) * nloc) {
            __builtin_amdgcn_fence(__ATOMIC_RELEASE, "agent");
            asm volatile("s_waitcnt vmcnt(0)" ::: "memory");
            const unsigned og = xb_add(&bar[XB_TOP], 1u);
            const unsigned tg = og / nx;
            if (og + 1u == (tg + 1u) * nx) xb_add(&bar[XB_TOPGEN], 1u);
            else XB_SPIN(xb_ld(&bar[XB_TOPGEN]) == tg, bar);
            __builtin_amdgcn_fence(__ATOMIC_ACQUIRE, "agent");
            xb_add(&bar[XB_XGEN(bx)], 1u);
            asm volatile("s_waitcnt vmcnt(0)" ::: "memory");
        } else {
            XB_SPIN(xb_ld(&bar[XB_XGEN(bx)]) == gen, bar);
            __builtin_amdgcn_fence(__ATOMIC_ACQUIRE, "agent");
            asm volatile("s_waitcnt vmcnt(0)" ::: "memory");
        }
    }
    __syncthreads();
}
namespace pg8 {
constexpr int BM = 256, BK = 64, HALF = 128, HTB = HALF * BK * 2, STAGE_BYTES = 8 * HTB, NXCD = 8, WGM = 8;
__host__ __device__ __forceinline__ int lds_byte(int r, int c) { const int st = (r >> 4) * 2 + (c >> 5), rr = r & 15, cc = c & 31, ob = rr * 64 + cc * 2; return st * 1024 + (ob ^ (((ob >> 9) & 1) << 5)); }
__host__ __device__ __forceinline__ void stage_rc(int b, int& R, int& C) { const int st = b / 1024, sb = b % 1024, swz = sb ^ (((sb >> 9) & 1) << 5); R = (st >> 1) * 16 + swz / 64; C = (st & 1) * 32 + (swz % 64) / 2; }
__host__ __device__ __forceinline__ int perm32(int rho) { const int n = rho >> 4, i = rho & 15; return 8 * (i >> 2) + 4 * n + (i & 3); }

struct Unit { int pm, pn; long aoff, boff; int x0, x1; };
struct Gemm { const bf16_t* A; const bf16_t* Bt; int K; int lda, ldb; const float* sa; const float* sb; };

template <int MODE> struct Sched {
    int nM, nN, nwg, G, c; long lda, ldb;
    __device__ void init(int nM_, int nN_, int nwg_, long lda_, long ldb_) { nM = nM_; nN = nN_; nwg = nwg_; G = ogrid(); c = obid(); lda = lda_; ldb = ldb_; }
    __device__ void rotate(int r) { c = (c + r) % G; }
    __device__ bool next(int i, Unit& u) const {
        const long L = (long)i * G + c; if (L >= nwg) return false;
        int wgid = (int)L;
        if (MODE == 0 || MODE == 5 || MODE == 6) {
            { const int q = nwg / NXCD, r = nwg % NXCD, xcd = wgid % NXCD, off = wgid / NXCD; wgid = (xcd < r ? xcd * (q + 1) : r * (q + 1) + (xcd - r) * q) + off; }
            const int nig = WGM * nN, gid = wgid / nig, fm = gid * WGM, gsz = (nM - fm) < WGM ? (nM - fm) : WGM;
            u.pm = fm + ((wgid % nig) % gsz); u.pn = (wgid % nig) / gsz; u.x0 = 0; u.x1 = 0;
            { const int pl = u.pn;
              if (MODE == 5) u.pn = pl < 3 ? pl + 2 : pl + 5;
              if (MODE == 6) u.pn = pl < 2 ? pl : (pl < 5 ? pl + 3 : pl + 16);
              u.aoff = (long)u.pm * 256 * lda * 2; u.boff = (long)(MODE == 6 ? pl : u.pn) * 256 * ldb * 2; }
        } else if (MODE == 1) {
            const int h = wgid >> 4, rem = wgid & 15, rt = rem >> 1, pn = rem & 1;
            u.pm = rt; u.pn = pn; u.x0 = h; u.x1 = rt;
            u.aoff = ((long)(TP + 256 * rt) * 3072 + h * 192) * 2; u.boff = ((long)(h * 512 + 256 * pn) * 256) * 2;
        } else if (MODE == 2) {
            const int b = wgid / 36, rem = wgid % 36, pm = rem / 9, pn = rem % 9;
            u.pm = pm; u.pn = pn; u.x0 = b; u.x1 = 0;
            u.aoff = ((long)(b * 1024 + 256 * pm) * QLD) * 2; u.boff = ((long)(b * KPAD + 256 * pn) * QLD) * 2;
        } else if (MODE == 3) {
            const int b = wgid >> 3, pm = (wgid & 7) >> 1, pn = wgid & 1;
            u.pm = pm; u.pn = pn; u.x0 = b; u.x1 = 0;
            u.aoff = ((long)(b * 1024 + 256 * pm) * KPAD) * 2; u.boff = ((long)(b * 512 + 256 * pn) * KPAD) * 2;
        } else {
            const int h = wgid >> 3, rt = wgid & 7;
            u.pm = rt; u.pn = 0; u.x0 = h; u.x1 = rt;
            u.aoff = ((long)(h * 2048 + 256 * rt) * 512) * 2; u.boff = ((long)(h * 256) * 512) * 2;
        }
        return true;
    }
};

template <class Epi, class SchedT, int I8 = 0>
__device__ __forceinline__ void gemm_phase(LAS unsigned char* lds, const Gemm g, const SchedT& S, const Epi& E) {
    const int tid = otid(), wid = __builtin_amdgcn_readfirstlane(tid >> 6), lane = tid & 63, wr = wid >> 2, wc = wid & 3, fr = lane & 15, fq = lane >> 4;
    const int K = g.K, nt = K / BK;
    unsigned voffA[2], voffB[2];
#pragma unroll
    for (int i = 0; i < 2; ++i) { int R, C; stage_rc(tid * 16 + i * 8192, R, C); const int Rb = Epi::PERM ? ((R & ~31) + perm32(R & 31)) : R;
        voffA[i] = (unsigned)(R * g.lda + C) * 2u; voffB[i] = (unsigned)(Rb * g.ldb + C) * 2u; }
    const size_t kstep = (size_t)(BK * 2);
    const size_t hstepA = (size_t)HALF * g.lda * 2, hstepB = (size_t)HALF * g.ldb * 2;
    const unsigned ldsw = (unsigned)wid * 1024u;
    const int aoff = lds_byte(wr * 64 + fr, fq * 8), boff = lds_byte(wc * 32 + fr, fq * 8);
#define PG8_SA(b, h) (((b) * 2 + (h)) * HTB)
#define PG8_SB(b, h) ((4 + (b) * 2 + (h)) * HTB)
#define PG8_STAGE(bufoff, gbase, voff) do { _Pragma("unroll") for (int _i = 0; _i < 2; ++_i) \
        __builtin_amdgcn_global_load_lds((const unsigned*)((const char*)(gbase) + (voff)[_i]), (LAS unsigned*)(lds + (bufoff) + ldsw + _i * 8192), 16, 0, 0); } while (0)
#define PG8_LDA(dst, b, h) do { _Pragma("unroll") for (int m = 0; m < 4; ++m) _Pragma("unroll") for (int k = 0; k < 2; ++k) dst[m][k] = *(const LAS bf16x8*)(lds + PG8_SA(b, h) + aoff + m * 2048 + k * 1024); } while (0)
#define PG8_LDB(dst, b, h) do { _Pragma("unroll") for (int n = 0; n < 2; ++n) _Pragma("unroll") for (int k = 0; k < 2; ++k) dst[n][k] = *(const LAS bf16x8*)(lds + PG8_SB(b, h) + boff + n * 2048 + k * 1024); } while (0)
#define PG8_MMA(ai, bj, At, Bt) do { __builtin_amdgcn_s_setprio(1); _Pragma("unroll") for (int m = 0; m < 4; ++m) _Pragma("unroll") for (int n = 0; n < 2; ++n) _Pragma("unroll") for (int k = 0; k < 2; ++k) \
        { if constexpr (I8) acc[ai][bj][m][n] = __builtin_bit_cast(f32x4, __builtin_amdgcn_mfma_i32_16x16x64_i8(__builtin_bit_cast(i32x4, Bt[n][k]), __builtin_bit_cast(i32x4, At[m][k]), __builtin_bit_cast(i32x4, acc[ai][bj][m][n]), 0, 0, 0)); \
          else acc[ai][bj][m][n] = __builtin_amdgcn_mfma_f32_16x16x32_bf16(Bt[n][k], At[m][k], acc[ai][bj][m][n], 0, 0, 0); } __builtin_amdgcn_s_setprio(0); } while (0)
#define PG8_WAIT_V(n) asm volatile("s_waitcnt vmcnt(" #n ")" ::: "memory")
#define PG8_WAIT_L(n) asm volatile("s_waitcnt lgkmcnt(" #n ")" ::: "memory")
#define PG8_BAR __builtin_amdgcn_s_barrier()
#define PG8_SCHED __builtin_amdgcn_sched_barrier(0)
    Unit cur, nxt; int ui = 0;
    if (!S.next(0, cur)) return;
    f32x4 acc[2][2][4][2];
#pragma unroll
    for (int a = 0; a < 2; ++a)
#pragma unroll
        for (int b = 0; b < 2; ++b)
#pragma unroll
            for (int m = 0; m < 4; ++m)
#pragma unroll
                for (int n = 0; n < 2; ++n) acc[a][b][m][n] = (f32x4){0.f, 0.f, 0.f, 0.f};
    bf16x8 At[4][2], B0[2][2], B1[2][2];
    const char* cA = (const char*)g.A + cur.aoff; const char* cB = (const char*)g.Bt + cur.boff;
    PG8_STAGE(PG8_SB(0, 0), cB, voffB); PG8_STAGE(PG8_SA(0, 0), cA, voffA); PG8_STAGE(PG8_SB(0, 1), cB + hstepB, voffB); PG8_STAGE(PG8_SA(0, 1), cA + hstepA, voffA);
    if (wr == 1) PG8_BAR;
    PG8_WAIT_V(4); PG8_BAR;
    PG8_STAGE(PG8_SB(1, 0), cB + kstep, voffB); PG8_STAGE(PG8_SA(1, 0), cA + kstep, voffA); PG8_STAGE(PG8_SB(1, 1), cB + hstepB + kstep, voffB);
    PG8_WAIT_V(6); PG8_BAR;
    for (;;) {
        const bool has_next = S.next(ui + 1, nxt);
        const char* nA = has_next ? (const char*)g.A + nxt.aoff : cA; const char* nB = has_next ? (const char*)g.Bt + nxt.boff : cB;
        for (int t = 0; t < nt; t += 2) {
            const bool last = (t == nt - 2);
            const char* a1 = cA + (size_t)(t + 1) * kstep;
            const char* a2 = last ? nA : cA + (size_t)(t + 2) * kstep; const char* b2 = last ? nB : cB + (size_t)(t + 2) * kstep;
            const char* a3 = a2 + kstep; const char* b3 = b2 + kstep;
            PG8_LDB(B0, 0, 0); PG8_SCHED; PG8_LDA(At, 0, 0); PG8_STAGE(PG8_SA(1, 1), a1 + hstepA, voffA);
            PG8_WAIT_L(8); PG8_BAR; PG8_WAIT_L(0); PG8_MMA(0, 0, At, B0); PG8_BAR; PG8_SCHED;
            PG8_LDB(B1, 0, 1); PG8_STAGE(PG8_SB(0, 0), b2, voffB);
            PG8_BAR; PG8_WAIT_L(0); PG8_MMA(0, 1, At, B1); PG8_BAR;
            PG8_LDA(At, 0, 1); PG8_STAGE(PG8_SA(0, 0), a2, voffA);
            PG8_BAR; PG8_WAIT_L(0); PG8_MMA(1, 0, At, B0); PG8_BAR; PG8_SCHED;
            PG8_STAGE(PG8_SB(0, 1), b2 + hstepB, voffB);
            PG8_WAIT_V(6); PG8_BAR; PG8_MMA(1, 1, At, B1); PG8_BAR;
            PG8_LDB(B0, 1, 0); PG8_SCHED; PG8_LDA(At, 1, 0); PG8_STAGE(PG8_SA(0, 1), a2 + hstepA, voffA);
            PG8_WAIT_L(8); PG8_BAR; PG8_WAIT_L(0); PG8_MMA(0, 0, At, B0); PG8_BAR; PG8_SCHED;
            PG8_LDB(B1, 1, 1); PG8_STAGE(PG8_SB(1, 0), b3, voffB);
            PG8_BAR; PG8_WAIT_L(0); PG8_MMA(0, 1, At, B1); PG8_BAR;
            PG8_LDA(At, 1, 1); PG8_STAGE(PG8_SA(1, 0), a3, voffA);
            PG8_BAR; PG8_WAIT_L(0); PG8_MMA(1, 0, At, B0); PG8_BAR; PG8_SCHED;
            PG8_STAGE(PG8_SB(1, 1), b3 + hstepB, voffB);
            PG8_WAIT_V(6); PG8_BAR; PG8_MMA(1, 1, At, B1); PG8_BAR;
        }
        if constexpr (I8) {
#pragma unroll
            for (int a = 0; a < 2; ++a)
#pragma unroll
                for (int b = 0; b < 2; ++b)
#pragma unroll
                    for (int m = 0; m < 4; ++m)
#pragma unroll
                        for (int n = 0; n < 2; ++n) { const i32x4 iv = __builtin_bit_cast(i32x4, acc[a][b][m][n]); acc[a][b][m][n] = (f32x4){(float)iv[0], (float)iv[1], (float)iv[2], (float)iv[3]}; } }
        if constexpr (I8 == 2) {
            static_assert(Epi::PERM, "I8 == 2 assumes the PERM column layout");
            f32x4 sbv[2][2];
#pragma unroll
            for (int b = 0; b < 2; ++b) { const int c = cur.pn * BM + b * HALF + wc * 32 + 8 * fq; sbv[b][0] = *(const f32x4*)(g.sb + c); sbv[b][1] = *(const f32x4*)(g.sb + c + 4); }
#pragma unroll
            for (int a = 0; a < 2; ++a)
#pragma unroll
                for (int m = 0; m < 4; ++m) { const float s_ = g.sa[(long)cur.pm * BM + a * HALF + wr * 64 + m * 16 + fr];
#pragma unroll
                    for (int b = 0; b < 2; ++b) { acc[a][b][m][0] = acc[a][b][m][0] * sbv[b][0] * s_; acc[a][b][m][1] = acc[a][b][m][1] * sbv[b][1] * s_; } } }
        E(acc, cur, wr, wc, fr, fq);
        if (!has_next) break;
#pragma unroll
        for (int a = 0; a < 2; ++a)
#pragma unroll
            for (int b = 0; b < 2; ++b)
#pragma unroll
                for (int m = 0; m < 4; ++m)
#pragma unroll
                    for (int n = 0; n < 2; ++n) acc[a][b][m][n] = (f32x4){0.f, 0.f, 0.f, 0.f};
        cur = nxt; cA = nA; cB = nB; ++ui;
    }
    PG8_WAIT_V(0);
    if (wr == 0) PG8_BAR;
    PG8_BAR;
#undef PG8_SA
#undef PG8_SB
#undef PG8_STAGE
#undef PG8_LDA
#undef PG8_LDB
#undef PG8_MMA
#undef PG8_WAIT_V
#undef PG8_WAIT_L
#undef PG8_BAR
#undef PG8_SCHED
}

struct EpiBf16 {
    static constexpr bool PERM = true;
    bf16_t* O; long ldc; long bstride;
    __device__ __forceinline__ void operator()(const f32x4 (&acc)[2][2][4][2], const Unit& u, int wr, int wc, int fr, int fq) const {
        bf16_t* base = O + (long)u.x0 * bstride + (long)(u.pm * BM + wr * 64 + fr) * ldc + u.pn * BM + wc * 32 + 8 * fq;
#pragma unroll
        for (int ai = 0; ai < 2; ++ai)
#pragma unroll
            for (int m = 0; m < 4; ++m) { bf16_t* rowp = base + (long)(ai * HALF + m * 16) * ldc;
#pragma unroll
                for (int bj = 0; bj < 2; ++bj) { const f32x4 v0 = acc[ai][bj][m][0], v1 = acc[ai][bj][m][1];
                    u32x4 w; w.x = cvt_pk_bf16(v0[0], v0[1]); w.y = cvt_pk_bf16(v0[2], v0[3]); w.z = cvt_pk_bf16(v1[0], v1[1]); w.w = cvt_pk_bf16(v1[2], v1[3]);
                    *(u32x4*)(rowp + bj * HALF) = w; } }
    }
};
template <int RMODE> struct EpiRowMap {
    static constexpr bool PERM = true;
    bf16_t* O; const float* rsum;
    __device__ __forceinline__ void operator()(const f32x4 (&acc)[2][2][4][2], const Unit& u, int wr, int wc, int fr, int fq) const {
        const int col0 = u.pn * BM + wc * 32 + 8 * fq;
#pragma unroll
        for (int ai = 0; ai < 2; ++ai)
#pragma unroll
            for (int m = 0; m < 4; ++m) { const int r = ai * HALF + wr * 64 + m * 16 + fr; long drow; long ldc;
                if (RMODE == 1) { const int ts = 256 * u.x1 + r; drow = (long)(ts >> 6) * 1024 + u.x0 * 64 + (ts & 63); ldc = QLD; }
                float rs = 1.0f;
                if (RMODE == 1) { }
                else { const int qr = 256 * u.pm + r; drow = (long)(qr >> 6) * 2048 + u.x0 * 64 + (qr & 63); ldc = 512; rs = 1.0f / rsum[u.x0 * 1024 + qr]; }
                bf16_t* rowp = O + drow * ldc + col0;
#pragma unroll
                for (int bj = 0; bj < 2; ++bj) { const f32x4 v0 = acc[ai][bj][m][0] * rs, v1 = acc[ai][bj][m][1] * rs;
                    u32x4 w; w.x = cvt_pk_bf16(v0[0], v0[1]); w.y = cvt_pk_bf16(v0[2], v0[3]); w.z = cvt_pk_bf16(v1[0], v1[1]); w.w = cvt_pk_bf16(v1[2], v1[3]);
                    *(u32x4*)(rowp + bj * HALF) = w; } }
    }
};
struct EpiOV {
    static constexpr bool PERM = true;
    bf16_t* O;
    __device__ __forceinline__ void operator()(const f32x4 (&acc)[2][2][4][2], const Unit& u, int wr, int wc, int fr, int fq) const {
#pragma unroll
        for (int ai = 0; ai < 2; ++ai)
#pragma unroll
            for (int m = 0; m < 4; ++m) { const int r = ai * HALF + wr * 64 + m * 16 + fr;
                bf16_t* rowp = O + (long)(TP + 256 * u.x1 + r) * DM + u.x0 * 128 + wc * 32 + 8 * fq;
                const f32x4 v0 = acc[ai][1][m][0], v1 = acc[ai][1][m][1];
                u32x4 w; w.x = cvt_pk_bf16(v0[0], v0[1]); w.y = cvt_pk_bf16(v0[2], v0[3]); w.z = cvt_pk_bf16(v1[0], v1[1]); w.w = cvt_pk_bf16(v1[2], v1[3]);
                *(u32x4*)rowp = w; }
    }
};
struct EpiMix {
    static constexpr bool PERM = true;
    const bf16_t* Y; const bf16_t* YA; bf16_t* MIX; const float* sa; const float* sb;
    __device__ __forceinline__ void operator()(const f32x4 (&acc)[2][2][4][2], const Unit& u, int wr, int wc, int fr, int fq) const {
#pragma unroll
        for (int ai = 0; ai < 2; ++ai)
#pragma unroll
            for (int m = 0; m < 4; ++m) { const long t = (long)u.pm * BM + ai * HALF + wr * 64 + m * 16 + fr; const float s_ = sa[t];
#pragma unroll
                for (int bj = 0; bj < 2; ++bj) { const int c = u.pn * BM + bj * HALF + wc * 32 + 8 * fq;
                    const u32x4 ga = *(const u32x4*)(Y + t * INWP + C_GA + c), gb = *(const u32x4*)(Y + t * INWP + C_GB + c), ya = *(const u32x4*)(YA + t * DM + c);
                    float fa[8], fb[8], fy[8], o[8]; unpack8(ga, fa); unpack8(gb, fb); unpack8(ya, fy);
                    const f32x4 v0 = acc[ai][bj][m][0] * *(const f32x4*)(sb + c) * s_, v1 = acc[ai][bj][m][1] * *(const f32x4*)(sb + c + 4) * s_;
                    const float av[8] = {v0[0], v0[1], v0[2], v0[3], v1[0], v1[1], v1[2], v1[3]};
#pragma unroll
                    for (int j = 0; j < 8; ++j) {
#if defined(DBG_MIX) && DBG_MIX == 1
                        o[j] = sigmoidf_(fb[j]) * av[j];
#elif defined(DBG_MIX) && DBG_MIX == 2
                        o[j] = sigmoidf_(fa[j]) * fy[j];
#else
                        o[j] = sigmoidf_(fa[j]) * fy[j] + sigmoidf_(fb[j]) * av[j];
#endif
                    }
                    *(u32x4*)(MIX + t * DM + c) = pack8(o); } }
    }
};
struct EpiRes {
    static constexpr bool PERM = false;
    float* X; const float* gate;
    const float* XinP; const float* XinS;
    __device__ __forceinline__ void operator()(const f32x4 (&acc)[2][2][4][2], const Unit& u, int wr, int wc, int fr, int fq) const {
#pragma unroll
        for (int ai = 0; ai < 2; ++ai)
#pragma unroll
            for (int m = 0; m < 4; ++m) { const int t = u.pm * BM + ai * HALF + wr * 64 + m * 16 + fr; const float* gr = gate + (long)cond_row(t) * 12288; float* xr = X + (long)t * DM; const float* xi = t < TP ? XinP + (long)t * DM : XinS + (long)(t - TP) * DM;
#pragma unroll
                for (int bj = 0; bj < 2; ++bj)
#pragma unroll
                    for (int n = 0; n < 2; ++n) { const int c = u.pn * BM + bj * HALF + wc * 32 + n * 16 + 4 * fq;
                        const f32x4 gv = *(const f32x4*)(gr + c); const f32x4 xv = *(const f32x4*)(xi + c);
                        *(f32x4*)(xr + c) = xv + gv * acc[ai][bj][m][n]; } }
    }
};

struct EpiQ {
    static constexpr bool PERM = true;
    bf16_t* Q; bf16_t* QL; const float* T64;
    __device__ __forceinline__ void operator()(const f32x4 (&acc)[2][2][4][2], const Unit& u, int wr, int wc, int fr, int fq) const {
        const int grp = u.pn / 3, typ = u.pn - 3 * grp;
        if (typ < 2) {
#pragma unroll
            for (int ai = 0; ai < 2; ++ai)
#pragma unroll
                for (int m = 0; m < 4; ++m) { const long t = (long)u.pm * BM + ai * HALF + wr * 64 + m * 16 + fr;
#pragma unroll
                    for (int bj = 0; bj < 2; ++bj) { const f32x4 v0 = acc[ai][bj][m][0], v1 = acc[ai][bj][m][1];
                        u32x4 w; w.x = cvt_pk_bf16(v0[0], v0[1]); w.y = cvt_pk_bf16(v0[2], v0[3]); w.z = cvt_pk_bf16(v1[0], v1[1]); w.w = cvt_pk_bf16(v1[2], v1[3]);
                        *(u32x4*)(Q + t * 3072 + 768 * grp + 192 * (2 * typ + bj) + wc * 32 + 8 * fq) = w; } }
        } else {
#pragma unroll
            for (int ai = 0; ai < 2; ++ai)
#pragma unroll
                for (int m = 0; m < 4; ++m) { const int t = u.pm * BM + ai * HALF + wr * 64 + m * 16 + fr; const int pos = tok_pos(t);
                    const float* cs = T64 + ((long)pos * 32 + 8 * fq) * 2; float cv[8], sv[8];
#pragma unroll
                    for (int j = 0; j < 4; ++j) { const f32x4 qv = *(const f32x4*)(cs + 4 * j); cv[2 * j] = qv[0]; sv[2 * j] = qv[1]; cv[2 * j + 1] = qv[2]; sv[2 * j + 1] = qv[3]; }
                    const f32x4 a0 = acc[ai][0][m][0], a1 = acc[ai][0][m][1], b0 = acc[ai][1][m][0], b1 = acc[ai][1][m][1];
                    const float x1[8] = {a0[0], a0[1], a0[2], a0[3], a1[0], a1[1], a1[2], a1[3]}, x2[8] = {b0[0], b0[1], b0[2], b0[3], b1[0], b1[1], b1[2], b1[3]};
                    float o1[8], o2[8];
#pragma unroll
                    for (int j = 0; j < 8; ++j) { o1[j] = x1[j] * cv[j] - x2[j] * sv[j]; o2[j] = x1[j] * sv[j] + x2[j] * cv[j]; }
                    const u32x4 w1 = pack8(o1), w2 = pack8(o2); const int hd = 4 * grp + wc;
                    bf16_t* qd = Q + (long)t * 3072 + hd * 192 + 128 + 8 * fq; *(u32x4*)qd = w1; *(u32x4*)(qd + 32) = w2;
                    if (t >= TP) { const int ts = t - TP; bf16_t* d = QL + ((long)(ts >> 6) * 1024 + hd * 64 + (ts & 63)) * QLD + 512 + 8 * fq; *(u32x4*)d = w1; *(u32x4*)(d + 32) = w2; } }
        }
    }
};

struct EpiExp {
    static constexpr bool PERM = true;
    bf16_t* O; float* rsum;
    __device__ __forceinline__ void operator()(const f32x4 (&acc)[2][2][4][2], const Unit& u, int wr, int wc, int fr, int fq) const {
        bf16_t* base = O + (long)u.x0 * 1024 * KPAD + (long)(u.pm * BM + wr * 64 + fr) * KPAD + u.pn * BM + wc * 32 + 8 * fq;
#pragma unroll
        for (int ai = 0; ai < 2; ++ai)
#pragma unroll
            for (int m = 0; m < 4; ++m) { bf16_t* rowp = base + (long)(ai * HALF + m * 16) * KPAD; float part = 0.f;
#pragma unroll
                for (int bj = 0; bj < 2; ++bj) { const int c0 = u.pn * BM + bj * HALF + wc * 32 + 8 * fq; const f32x4 v0 = acc[ai][bj][m][0], v1 = acc[ai][bj][m][1];
                    const float sv[8] = {v0[0], v0[1], v0[2], v0[3], v1[0], v1[1], v1[2], v1[3]}; float e[8];
#pragma unroll
                    for (int j = 0; j < 8; ++j) { e[j] = (c0 + j < KALL) ? __expf(fminf(sv[j] * MLA_SCALE, 60.f)) : 0.f; part += e[j]; }
                    *(u32x4*)(rowp + bj * HALF) = pack8(e); }
                part += sx<16>(part); part += sx<32>(part);
                if (fq == 0) atomicAdd(rsum + u.x0 * 1024 + u.pm * BM + ai * HALF + wr * 64 + m * 16 + fr, part); }
    }
};

struct EpiQ8 {
    static constexpr bool PERM = true;
    bf16_t* O; long ldc; const float* sa; const float* sb;
    __device__ __forceinline__ void operator()(const f32x4 (&acc)[2][2][4][2], const Unit& u, int wr, int wc, int fr, int fq) const {
        f32x4 sbv[2][2];
#pragma unroll
        for (int bj = 0; bj < 2; ++bj) { const int c = u.pn * BM + bj * HALF + wc * 32 + 8 * fq; sbv[bj][0] = *(const f32x4*)(sb + c); sbv[bj][1] = *(const f32x4*)(sb + c + 4); }
#pragma unroll
        for (int ai = 0; ai < 2; ++ai)
#pragma unroll
            for (int m = 0; m < 4; ++m) { const long t = (long)u.pm * BM + ai * HALF + wr * 64 + m * 16 + fr; const float s = sa[t];
#pragma unroll
                for (int bj = 0; bj < 2; ++bj) { const f32x4 v0 = acc[ai][bj][m][0] * sbv[bj][0] * s, v1 = acc[ai][bj][m][1] * sbv[bj][1] * s;
                    u32x4 w; w.x = cvt_pk_bf16(v0[0], v0[1]); w.y = cvt_pk_bf16(v0[2], v0[3]); w.z = cvt_pk_bf16(v1[0], v1[1]); w.w = cvt_pk_bf16(v1[2], v1[3]);
                    *(u32x4*)(O + t * ldc + u.pn * BM + bj * HALF + wc * 32 + 8 * fq) = w; } }
    }
};
}
namespace att {
constexpr int NW = 8, QBLK = 32, KVBLK = 64;
constexpr float SCALE = MLA_SCALE;
constexpr float THR = 8.f;
constexpr int KROW = 384;
constexpr int SHM_V = KVBLK * 128 * 2, SHM_K = KVBLK * KROW;
constexpr int QR_PITCH = 144, SHM_QR = 256 * QR_PITCH;
constexpr int SHM_ATTN = 2 * SHM_V + 2 * SHM_K + NW * 64 * 4 + SHM_QR;
#define KSWZ(row, colB) ((row) * att::KROW + ((colB) ^ (((row) & 7) << 4)))
#define SBAR() __builtin_amdgcn_sched_barrier(0)
__device__ __forceinline__ int crow(int r, int hi) { return (r & 3) + 8 * (r >> 2) + 4 * hi; }

__device__ __forceinline__ void partialSM(f32x16& p0, f32x16& p1, float& m_reg, float& mn, float& alpha) {
  constexpr float C = SCALE * 1.4426950408889634f;
  float pmax = p0[0];
#pragma unroll
  for (int r = 1; r < 16; ++r) pmax = fmaxf(pmax, p0[r]);
#pragma unroll
  for (int r = 0; r < 16; ++r) pmax = fmaxf(pmax, p1[r]);
  { auto rr = __builtin_amdgcn_permlane32_swap(__float_as_uint(pmax), __float_as_uint(pmax), false, false);
    pmax = fmaxf(__uint_as_float(rr[0]), __uint_as_float(rr[1])); }
  if (__builtin_expect(__all(pmax - m_reg <= THR / SCALE), 1)) { mn = m_reg; alpha = 1.f; }
  else { mn = fmaxf(m_reg, pmax); alpha = __builtin_amdgcn_exp2f((m_reg - mn) * C); m_reg = mn; }
  float mnC = -mn * C;
#pragma unroll
  for (int r = 0; r < 16; ++r) p0[r] = fmaf(p0[r], C, mnC);
#pragma unroll
  for (int r = 0; r < 16; ++r) p1[r] = fmaf(p1[r], C, mnC);
#pragma unroll
  for (int r = 0; r < 16; ++r) p0[r] = __builtin_amdgcn_exp2f(p0[r]);
}
__device__ __forceinline__ void finishSM(f32x16& p0, f32x16& p1, float alpha, float& l_reg, bf16x8& pa0, bf16x8& pa1, bf16x8& pa2, bf16x8& pa3) {
#pragma unroll
  for (int r = 0; r < 16; ++r) p1[r] = __builtin_amdgcn_exp2f(p1[r]);
  float ps = 0;
#pragma unroll
  for (int r = 0; r < 16; ++r) ps += p0[r];
#pragma unroll
  for (int r = 0; r < 16; ++r) ps += p1[r];
  { auto rr = __builtin_amdgcn_permlane32_swap(__float_as_uint(ps), __float_as_uint(ps), false, false);
    ps = __uint_as_float(rr[0]) + __uint_as_float(rr[1]); }
  l_reg = l_reg * alpha + ps;
#define PK4(P, BASE, OUT) do { unsigned a0 = cvt_pk_bf16(P[BASE + 0], P[BASE + 1]), a1 = cvt_pk_bf16(P[BASE + 2], P[BASE + 3]);   \
    unsigned b0 = cvt_pk_bf16(P[BASE + 4], P[BASE + 5]), b1 = cvt_pk_bf16(P[BASE + 6], P[BASE + 7]);                              \
    auto r0 = __builtin_amdgcn_permlane32_swap(a0, b0, false, false); auto r1 = __builtin_amdgcn_permlane32_swap(a1, b1, false, false); \
    u32x4 w = {r0[0], r1[0], r0[1], r1[1]}; OUT = *reinterpret_cast<bf16x8*>(&w); } while (0)
  PK4(p0, 0, pa0); PK4(p0, 8, pa1); PK4(p1, 0, pa2); PK4(p1, 8, pa3);
#undef PK4
}
__device__ __forceinline__ void qkt(f32x16& p0, f32x16& p1, const char* Ks, const bf16x8* qr, const char* qrope, const int (&kbase)[4], bool vis) {
  p0 = f32x16{}; p1 = f32x16{};
  if (vis) {
#pragma unroll
  for (int d0 = 0; d0 < 12; ++d0) {
    bf16x8 b0 = *reinterpret_cast<const bf16x8*>(Ks + kbase[d0 & 3] + (d0 >> 2) * 128);
    bf16x8 b1 = *reinterpret_cast<const bf16x8*>(Ks + kbase[d0 & 3] + (d0 >> 2) * 128 + 32 * KROW);
    const bf16x8 qv = d0 < 8 ? qr[d0 < 8 ? d0 : 0] : *reinterpret_cast<const bf16x8*>(qrope + (d0 - 8) * 32);
    p0 = __builtin_amdgcn_mfma_f32_32x32x16_bf16(b0, qv, p0, 0, 0, 0);
    p1 = __builtin_amdgcn_mfma_f32_32x32x16_bf16(b1, qv, p1, 0, 0, 0); }
  }
  if (!vis) {
#pragma unroll
    for (int r = 0; r < 16; ++r) { p0[r] = -1e30f; p1[r] = -1e30f; } }
}
__device__ __forceinline__ int v_st(int k, int c) { const int kk = (k & ~0xC) | ((k & 4) << 1) | ((k & 8) >> 1); return ((kk >> 3) * 4 + (c >> 5)) * 512 + ((kk & 7) * 32 + (c & 31)) * 2; }
__device__ __forceinline__ int v_rd_base(int lane) { return ((lane & 3) << 3) | (((lane >> 2) & 3) << 6) | (((lane >> 4) & 1) << 5) | (((lane >> 5) & 1) << 8); }
constexpr int v_rd_off(int d0, int ks, int half) { return d0 * 512 + ks * 4096 + half * 2048; }
template <int OFF> __device__ __forceinline__ s16x4 tr_read(int vb) {
  s16x4 r; asm volatile("ds_read_b64_tr_b16 %0, %1 offset:%2" : "=&v"(r) : "v"(vb), "i"(OFF) : "memory"); return r;
}
template <int D0> __device__ __forceinline__ void pv_one(f32x16& od, int vb, bf16x8 pa0, bf16x8 pa1, bf16x8 pa2, bf16x8 pa3) {
  const s16x4 l0 = tr_read<v_rd_off(D0, 0, 0)>(vb), h0 = tr_read<v_rd_off(D0, 0, 1)>(vb), l1 = tr_read<v_rd_off(D0, 1, 0)>(vb), h1 = tr_read<v_rd_off(D0, 1, 1)>(vb);
  const s16x4 l2 = tr_read<v_rd_off(D0, 2, 0)>(vb), h2 = tr_read<v_rd_off(D0, 2, 1)>(vb), l3 = tr_read<v_rd_off(D0, 3, 0)>(vb), h3 = tr_read<v_rd_off(D0, 3, 1)>(vb);
  asm volatile("s_waitcnt lgkmcnt(0)" ::: "memory"); SBAR();
#define PK(L, H) (bf16x8){L[0], L[1], L[2], L[3], H[0], H[1], H[2], H[3]}
  od = __builtin_amdgcn_mfma_f32_32x32x16_bf16(pa0, PK(l0, h0), od, 0, 0, 0);
  od = __builtin_amdgcn_mfma_f32_32x32x16_bf16(pa1, PK(l1, h1), od, 0, 0, 0);
  od = __builtin_amdgcn_mfma_f32_32x32x16_bf16(pa2, PK(l2, h2), od, 0, 0, 0);
  od = __builtin_amdgcn_mfma_f32_32x32x16_bf16(pa3, PK(l3, h3), od, 0, 0, 0);
#undef PK
}
__device__ __forceinline__ void pv_d0(f32x16* o, int vb, bf16x8 pa0, bf16x8 pa1, bf16x8 pa2, bf16x8 pa3) {
  pv_one<0>(o[0], vb, pa0, pa1, pa2, pa3); pv_one<1>(o[1], vb, pa0, pa1, pa2, pa3); pv_one<2>(o[2], vb, pa0, pa1, pa2, pa3); pv_one<3>(o[3], vb, pa0, pa1, pa2, pa3);
}

__device__ __forceinline__ void attn_block(const bf16_t* __restrict__ Qb, const bf16_t* __restrict__ Kn, const bf16_t* __restrict__ Kr, const bf16_t* __restrict__ Vh,
                                           bf16_t* __restrict__ Ob, int qb, char* lds) {
  constexpr int LDQ = 3072, LDK = 4096, LDR = 64, LDO = 2048;
  const int tid = otid(), wid = tid >> 6, lane = tid & 63, r32 = lane & 31, hi = lane >> 5;
  char* V_lds = lds; char* K_lds = lds + 2 * SHM_V;
  float* ws = (float*)(lds + 2 * SHM_V + 2 * SHM_K) + wid * 64; float* li_l = ws; float* al_l = ws + 32;
  float m_reg = -1e30f, l_reg = 0; f32x16 o[4] = {}; bf16x8 qr[8];
  const bf16_t* Qw = Qb + (long)(wid * QBLK + r32) * LDQ + hi * 8;
#pragma unroll
  for (int d0 = 0; d0 < 8; ++d0) qr[d0] = *reinterpret_cast<const bf16x8*>(Qw + d0 * 16);
  char* qrope = lds + 2 * SHM_V + 2 * SHM_K + NW * 64 * 4 + (wid * QBLK + r32) * QR_PITCH + hi * 16;
#pragma unroll
  for (int d0 = 8; d0 < 12; ++d0) *reinterpret_cast<bf16x8*>(qrope + (d0 - 8) * 32) = *reinterpret_cast<const bf16x8*>(Qw + d0 * 16);
  asm volatile("s_waitcnt lgkmcnt(0)" ::: "memory");
  const int NT = 4 * qb + 4, jmax = 4 * qb + (wid >> 1);
  int kbase[4];
#pragma unroll
  for (int dl = 0; dl < 4; ++dl) kbase[dl] = r32 * KROW + (((dl << 5) | (hi << 4)) ^ ((r32 & 7) << 4));
  const int sr = tid >> 4, sc = (tid & 15) * 8, vst0 = v_st(sr, sc), vst1 = v_st(32 + sr, sc);
  const int rr = tid >> 3, rc = (tid & 7) * 8;
  const int vb0 = (int)(uintptr_t)V_lds + v_rd_base(lane);
  bf16x8 vs0, vs1, ks0, ks1, kr0;
#define SLOAD(k0) do { vs0 = *reinterpret_cast<const bf16x8*>(&Vh[(long)((k0) + sr) * LDK + sc]); vs1 = *reinterpret_cast<const bf16x8*>(&Vh[(long)((k0) + 32 + sr) * LDK + sc]); \
    ks0 = *reinterpret_cast<const bf16x8*>(&Kn[(long)((k0) + sr) * LDK + sc]); ks1 = *reinterpret_cast<const bf16x8*>(&Kn[(long)((k0) + 32 + sr) * LDK + sc]); \
    kr0 = *reinterpret_cast<const bf16x8*>(&Kr[(long)((k0) + rr) * LDR + rc]); } while (0)
#define SWRITE(b) do { *(bf16x8*)(V_lds + (b) * SHM_V + vst0) = vs0; *(bf16x8*)(V_lds + (b) * SHM_V + vst1) = vs1; int kc = sc * 2; \
    *(bf16x8*)(K_lds + (b) * SHM_K + KSWZ(sr, kc)) = ks0; *(bf16x8*)(K_lds + (b) * SHM_K + KSWZ(32 + sr, kc)) = ks1; \
    *(bf16x8*)(K_lds + (b) * SHM_K + KSWZ(rr, 256 + rc * 2)) = kr0; } while (0)
#define SWAIT() asm volatile("s_waitcnt vmcnt(0)" ::: "memory")
#define RESC(a) do { if (__any((a) < 1.f)) { if (hi == 0) al_l[r32] = (a); asm volatile("s_waitcnt lgkmcnt(0)" ::: "memory"); \
    _Pragma("unroll") for (int d = 0; d < 4; ++d) _Pragma("unroll") for (int r = 0; r < 16; ++r) o[d][r] *= al_l[crow(r, hi)]; } } while (0)
  f32x16 pA0, pA1, pB0, pB1; float mnA, mnB, alA, alB; bf16x8 pa0, pa1, pa2, pa3;
  SLOAD(0); SWAIT(); SWRITE(0); __syncthreads();
  qkt(pA0, pA1, K_lds, qr, qrope, kbase, true); partialSM(pA0, pA1, m_reg, mnA, alA);
  SLOAD(KVBLK);
  SWAIT(); SWRITE(1); __syncthreads();
  for (int j = 1; j + 1 < NT; j += 2) {
    SBAR(); qkt(pB0, pB1, K_lds + SHM_K, qr, qrope, kbase, j <= jmax);
    finishSM(pA0, pA1, alA, l_reg, pa0, pa1, pa2, pa3); SBAR();
    SLOAD((j + 1) * KVBLK); SBAR();
    if (j - 1 <= jmax) pv_d0(o, vb0, pa0, pa1, pa2, pa3);
    partialSM(pB0, pB1, m_reg, mnB, alB);
    __syncthreads(); SWAIT(); SWRITE(0);
    RESC(alB); __syncthreads();
    SBAR(); qkt(pA0, pA1, K_lds, qr, qrope, kbase, j + 1 <= jmax);
    finishSM(pB0, pB1, alB, l_reg, pa0, pa1, pa2, pa3); SBAR();
    SLOAD((j + 2) * KVBLK); SBAR();
    if (j <= jmax) pv_d0(o, vb0 + (int)SHM_V, pa0, pa1, pa2, pa3);
    partialSM(pA0, pA1, m_reg, mnA, alA);
    __syncthreads(); SWAIT(); SWRITE(1);
    RESC(alA); __syncthreads();
  }
  SBAR(); qkt(pB0, pB1, K_lds + SHM_K, qr, qrope, kbase, NT - 1 <= jmax);
  finishSM(pA0, pA1, alA, l_reg, pa0, pa1, pa2, pa3); SBAR();
  if (NT - 2 <= jmax) pv_d0(o, vb0, pa0, pa1, pa2, pa3);
  partialSM(pB0, pB1, m_reg, mnB, alB);
  __syncthreads(); RESC(alB);
  finishSM(pB0, pB1, alB, l_reg, pa0, pa1, pa2, pa3); SBAR();
  if (NT - 1 <= jmax) pv_d0(o, vb0 + (int)SHM_V, pa0, pa1, pa2, pa3);
  if (hi == 0) li_l[r32] = l_reg; asm volatile("s_waitcnt lgkmcnt(0)" ::: "memory");
  float rli[16];
#pragma unroll
  for (int r = 0; r < 16; ++r) rli[r] = __builtin_amdgcn_rcpf(li_l[crow(r, hi)]);
  bf16_t* Ow = Ob + (long)(wid * QBLK) * LDO;
#pragma unroll
  for (int r = 0; r < 16; ++r) { int orow = crow(r, hi);
#pragma unroll
    for (int d0 = 0; d0 < 4; ++d0) Ow[(long)orow * LDO + d0 * 32 + r32] = f2bf(o[d0][r] * rli[r]); }
  __syncthreads();
#undef SLOAD
#undef SWRITE
#undef SWAIT
#undef RESC
}
}
namespace ret {
constexpr int QP_ = 136;
__device__ __forceinline__ bf16x8 ldfrag(const bf16_t* p) { return *reinterpret_cast<const bf16x8*>(p); }
template <int CL> struct Lay {
    static constexpr int IP = CL + 8;
    static constexpr int QS = 0, KS = QS + CL * QP_ * 2, VT = KS + CL * QP_ * 2, VDT = VT + 32 * IP * 2, IN = VDT + 32 * IP * 2, ST = IN + CL * IP * 2, VS = ST + 32 * QP_ * 2, END = VS + CL * 40 * 2;
};
static_assert(Lay<128>::END <= LDS_BARW, "retention LDS");

template <int CL>
__device__ __forceinline__ void run(const bf16_t* __restrict__ Y, bf16_t* __restrict__ OB, const float* __restrict__ sp, float* __restrict__ so, long tok0, int nch, int h, int es, float lg, char* lds, int tid) {
    using L = Lay<CL>; constexpr int IP = L::IP, NQT = CL / 16, NKS = CL / 32, NPC = CL / 32;
    const int wid = __builtin_amdgcn_readfirstlane(tid >> 6), lane = tid & 63, l15 = lane & 15, l4 = lane >> 4;
    bf16_t* Qs = (bf16_t*)(lds + L::QS); bf16_t* Ks = (bf16_t*)(lds + L::KS); bf16_t* Vt = (bf16_t*)(lds + L::VT); bf16_t* Vdt = (bf16_t*)(lds + L::VDT); bf16_t* In = (bf16_t*)(lds + L::IN); bf16_t* St = (bf16_t*)(lds + L::ST); bf16_t* Vs = (bf16_t*)(lds + L::VS);
    const float gCL = __expf((float)CL * lg);
    f32x4 Sacc[2];
    if (sp) {
#pragma unroll
        for (int ej = 0; ej < 2; ++ej)
#pragma unroll
            for (int r = 0; r < 4; ++r) Sacc[ej][r] = sp[(long)(16 * wid + 4 * l4 + r) * RV + 16 * ej + l15];
    } else { Sacc[0] = (f32x4){0.f, 0.f, 0.f, 0.f}; Sacc[1] = (f32x4){0.f, 0.f, 0.f, 0.f}; }
    for (int i = tid; i < CL * IP / 8; i += 512) reinterpret_cast<u32x4*>(In)[i] = (u32x4){0u, 0u, 0u, 0u};
    u32x4 pq[NPC], pk[NPC], pv;
    const int vk = tid >> 2, ve0 = (tid & 3) * 8;
#define RET_LOAD(cc) do { const bf16_t* yrow_ = Y + (tok0 + (long)(cc) * CL) * INWP; \
        _Pragma("unroll") for (int i = 0; i < NPC; ++i) { const int idx = tid + i * 512, k = idx >> 4, d0 = (idx & 15) * 8; \
            pq[i] = *reinterpret_cast<const u32x4*>(yrow_ + (long)k * INWP + C_RQ + h * 128 + d0); pk[i] = *reinterpret_cast<const u32x4*>(yrow_ + (long)k * INWP + C_RK + h * 128 + d0); } \
        if (tid < 4 * CL) pv = *reinterpret_cast<const u32x4*>(yrow_ + (long)vk * INWP + C_RV + h * 256 + es * 32 + ve0); } while (0)
    RET_LOAD(0);
    for (int c = 0; c < nch; ++c) {
#pragma unroll
        for (int ej = 0; ej < 2; ++ej) { u32x2 w; w.x = cvt_pk_bf16(Sacc[ej][0], Sacc[ej][1]); w.y = cvt_pk_bf16(Sacc[ej][2], Sacc[ej][3]);
            *reinterpret_cast<u32x2*>(St + (16 * ej + l15) * QP_ + 16 * wid + 4 * l4) = w; }
#pragma unroll
        for (int i = 0; i < NPC; ++i) { const int idx = tid + i * 512, k = idx >> 4, d0 = (idx & 15) * 8;
            *reinterpret_cast<u32x4*>(Qs + k * QP_ + d0) = pq[i]; *reinterpret_cast<u32x4*>(Ks + k * QP_ + d0) = pk[i]; }
        if (tid < 4 * CL) *reinterpret_cast<u32x4*>(Vs + vk * 40 + ve0) = pv;
        if (c + 1 < nch) RET_LOAD(c + 1);
        __syncthreads();
        if (tid < 4 * CL) { const int e = tid & 31, kg = tid >> 5; float f[8], fd[8];
#pragma unroll
            for (int j = 0; j < 8; ++j) { f[j] = bf2f(Vs[(8 * kg + j) * 40 + e]); fd[j] = f[j] * __expf((float)(CL - 1 - 8 * kg - j) * lg); }
            *reinterpret_cast<u32x4*>(Vt + e * IP + 8 * kg) = pack8(f); *reinterpret_cast<u32x4*>(Vdt + e * IP + 8 * kg) = pack8(fd); }
#pragma unroll
        for (int it_ = 0; it_ < (NQT * (NQT + 1) / 2 + 7) / 8; ++it_) { const int idx = wid + 8 * it_; if (idx >= NQT * (NQT + 1) / 2) break;
            int qi = 0; while ((qi + 1) * (qi + 2) / 2 <= idx) ++qi; const int kj = idx - qi * (qi + 1) / 2;
            f32x4 a = (f32x4){0.f, 0.f, 0.f, 0.f}; const bf16_t* qp = Qs + (16 * qi + l15) * QP_ + 8 * l4; const bf16_t* kp = Ks + (16 * kj + l15) * QP_ + 8 * l4;
#pragma unroll
            for (int ks = 0; ks < 4; ++ks) a = __builtin_amdgcn_mfma_f32_16x16x32_bf16(ldfrag(qp + 32 * ks), ldfrag(kp + 32 * ks), a, 0, 0, 0);
            const int q0 = 16 * qi + 4 * l4, k = 16 * kj + l15;
#pragma unroll
            for (int r = 0; r < 4; ++r) { const int q = q0 + r; const float dm = (q >= k) ? __expf((float)(q - k) * lg) : 0.f;
                In[q * IP + k] = f2bf(a[r] * dm); } }
        __syncthreads();
#pragma unroll
        for (int ot = 0; ot < (2 * NQT) / 8; ++ot) { const int tI = wid + 8 * ot, qi = tI >> 1, ej = tI & 1; f32x4 a = (f32x4){0.f, 0.f, 0.f, 0.f};
#pragma unroll
            for (int ks = 0; ks < 4; ++ks) a = __builtin_amdgcn_mfma_f32_16x16x32_bf16(ldfrag(Qs + (16 * qi + l15) * QP_ + 32 * ks + 8 * l4), ldfrag(St + (16 * ej + l15) * QP_ + 32 * ks + 8 * l4), a, 0, 0, 0);
#pragma unroll
            for (int r = 0; r < 4; ++r) a[r] *= __expf((float)(16 * qi + 4 * l4 + r + 1) * lg);
#pragma unroll
            for (int ks = 0; ks < NKS; ++ks) if (ks <= (qi >> 1)) a = __builtin_amdgcn_mfma_f32_16x16x32_bf16(ldfrag(In + (16 * qi + l15) * IP + 32 * ks + 8 * l4), ldfrag(Vt + (16 * ej + l15) * IP + 32 * ks + 8 * l4), a, 0, 0, 0);
            bf16_t* op = OB + ((long)(h * 8 + es) * T + tok0 + (long)c * CL + 16 * qi + 4 * l4) * 32 + 16 * ej + l15;
#pragma unroll
            for (int r = 0; r < 4; ++r) op[r * 32] = f2bf(a[r]); }
        { f32x4 s0 = Sacc[0] * gCL, s1 = Sacc[1] * gCL;
#pragma unroll
          for (int ks = 0; ks < NKS; ++ks) { bf16x8 af;
#pragma unroll
              for (int j = 0; j < 8; ++j) af[j] = (short)Ks[(32 * ks + 8 * l4 + j) * QP_ + 16 * wid + l15];
              s0 = __builtin_amdgcn_mfma_f32_16x16x32_bf16(af, ldfrag(Vdt + l15 * IP + 32 * ks + 8 * l4), s0, 0, 0, 0);
              s1 = __builtin_amdgcn_mfma_f32_16x16x32_bf16(af, ldfrag(Vdt + (16 + l15) * IP + 32 * ks + 8 * l4), s1, 0, 0, 0); }
          Sacc[0] = s0; Sacc[1] = s1; }
        __syncthreads();
    }
#undef RET_LOAD
#pragma unroll
    for (int ej = 0; ej < 2; ++ej)
#pragma unroll
        for (int r = 0; r < 4; ++r) so[(long)(16 * wid + 4 * l4 + r) * RV + 16 * ej + l15] = Sacc[ej][r];
}

__device__ __forceinline__ void unit(KParams& p, int l, int u, char* lds) {
    const int tid = otid(); unsigned char* ws = optr(gp(p.ws)); const bf16_t* Y = (const bf16_t*)(ws + WS_Y); bf16_t* OB = (bf16_t*)(ws + WS_OB);
    const bool samp = u >= 256; const int v = samp ? u - 256 : u; const int b = v >> 6, h = (v >> 3) & 7, es = v & 7; const float lg = p.lg[h];
    if (samp) run<64>(Y, OB, gp(p.state_ret) + ((((long)l * DB + b) * RH + h) * RQK) * RV + es * 32, gp(p.out) + O_RETS + ((((long)l * DB + b) * RH + h) * RQK) * RV + es * 32, (long)TP + b * 64, 1, h, es, lg, lds, tid);
    else run<64>(Y, OB, nullptr, gp(p.out) + O_RETP + ((((long)l * NB + b) * RH + h) * RQK) * RV + es * 32, (long)b * SEQ, SEQ / 64, h, es, lg, lds, tid);
}
}
namespace peer {
__device__ __forceinline__ void ins16(float (&l)[16], float x) {
#pragma unroll
    for (int j = 0; j < 16; ++j) { const float hi = fmaxf(l[j], x); x = fminf(l[j], x); l[j] = hi; }
}
#define CE_DESC(a, b) do { const float hi_ = fmaxf(a, b), lo_ = fminf(a, b); a = hi_; b = lo_; } while (0)
#define CE_ASC(a, b) do { const float hi_ = fmaxf(a, b), lo_ = fminf(a, b); a = lo_; b = hi_; } while (0)
__device__ __forceinline__ void sort16_desc(float (&v)[16]) {
#pragma unroll
    for (int k = 2; k <= 16; k <<= 1)
#pragma unroll
        for (int j = k >> 1; j >= 1; j >>= 1)
#pragma unroll
            for (int i = 0; i < 16; ++i) { const int l = i ^ j; if (l > i) { if ((i & k) == 0) CE_DESC(v[i], v[l]); else CE_ASC(v[i], v[l]); } }
}
__device__ __forceinline__ void merge16_desc(float (&l)[16], const float (&o)[16]) {
#pragma unroll
    for (int i = 0; i < 16; ++i) l[i] = fmaxf(l[i], o[15 - i]);
#pragma unroll
    for (int j = 8; j >= 1; j >>= 1)
#pragma unroll
        for (int i = 0; i < 16; ++i) { const int m = i ^ j; if (m > i) CE_DESC(l[i], l[m]); }
}
constexpr int KPITCH = 136;
__device__ __forceinline__ void half_top16(const bf16_t* __restrict__ qrow, const bf16_t* __restrict__ keys, int lane, float (&l)[16]) {
    const int r32 = lane & 31, g = lane >> 5;
#pragma unroll
    for (int j = 0; j < 16; ++j) l[j] = -3.0e38f;
    bf16x8 qf[8];
#pragma unroll
    for (int ks = 0; ks < 8; ++ks) qf[ks] = *reinterpret_cast<const bf16x8*>(qrow + 16 * ks + 8 * g);
#pragma unroll 1
    for (int kb = 0; kb < 4; ++kb) { f32x16 a = f32x16{};
#pragma unroll
        for (int ks = 0; ks < 8; ++ks) { const bf16x8 kf = *reinterpret_cast<const bf16x8*>(keys + (32 * kb + r32) * KPITCH + 16 * ks + 8 * g);
            a = __builtin_amdgcn_mfma_f32_32x32x16_bf16(kf, qf[ks], a, 0, 0, 0); }
        float blk[16];
#pragma unroll
        for (int r = 0; r < 16; ++r) { const unsigned key = (unsigned)(32 * kb + (r & 3) + 8 * (r >> 2) + 4 * g);
            blk[r] = __uint_as_float((__float_as_uint(a[r]) & ~0x7Fu) | key); }
        sort16_desc(blk); merge16_desc(l, blk); }
}
__device__ __forceinline__ void merge_lists(float (&l)[16], const float (&o)[16]) { merge16_desc(l, o); }
__device__ __forceinline__ void select_unit(const bf16_t* __restrict__ QP, const bf16_t* __restrict__ k1, const bf16_t* __restrict__ k2, int* __restrict__ PIDX, float* __restrict__ PW,
                                            int t0, int h, int lane, float* lds_lane  ) {
    const int r32 = lane & 31, g = lane >> 5;
    const bf16_t* qrow = QP + (long)(t0 + r32) * DM + h * 256;
    float la[16], lb[16];
    half_top16(qrow, k1, lane, la);
    half_top16(qrow + 128, k2, lane, lb);
    float m0[16], m1[16];
#pragma unroll
    for (int j = 0; j < 16; ++j) { auto rr = __builtin_amdgcn_permlane32_swap(__float_as_uint(la[j]), __float_as_uint(lb[j]), false, false); m0[j] = __uint_as_float(rr[0]); m1[j] = __uint_as_float(rr[1]); }
    merge_lists(m0, m1);
    float L1[16], L2[16];
#pragma unroll
    for (int j = 0; j < 16; ++j) { auto rr = __builtin_amdgcn_permlane32_swap(__float_as_uint(m0[j]), __float_as_uint(m0[j]), false, false);
        L1[j] = __uint_as_float(rr[0]); L2[j] = __uint_as_float(rr[1]); }
#define CAND(i, j) __uint_as_float((__float_as_uint(L1[i] + L2[j]) & ~0xFFu) | (unsigned)((i) * 16 + (j)))
    float best[16], c2[16], c3[16];
#pragma unroll
    for (int j = 0; j < 16; ++j) best[j] = CAND(0, j);
    sort16_desc(best);
    c2[0] = CAND(1, 0); c2[1] = CAND(1, 1); c2[2] = CAND(1, 2); c2[3] = CAND(1, 3); c2[4] = CAND(1, 4); c2[5] = CAND(1, 5); c2[6] = CAND(1, 6); c2[7] = CAND(1, 7);
    c2[8] = CAND(2, 0); c2[9] = CAND(2, 1); c2[10] = CAND(2, 2); c2[11] = CAND(2, 3); c2[12] = CAND(2, 4); c2[13] = CAND(4, 0); c2[14] = CAND(4, 1); c2[15] = CAND(4, 2);
    sort16_desc(c2); merge16_desc(best, c2);
    c3[0] = CAND(3, 0); c3[1] = CAND(3, 1); c3[2] = CAND(3, 2); c3[3] = CAND(3, 3); c3[4] = CAND(5, 0); c3[5] = CAND(5, 1); c3[6] = CAND(6, 0); c3[7] = CAND(6, 1);
    c3[8] = CAND(7, 0); c3[9] = CAND(7, 1); c3[10] = CAND(8, 0); c3[11] = CAND(9, 0); c3[12] = CAND(10, 0); c3[13] = CAND(11, 0); c3[14] = CAND(12, 0); c3[15] = CAND(13, 0);
    sort16_desc(c3); merge16_desc(best, c3);
    ins16(best, CAND(14, 0)); ins16(best, CAND(15, 0));
#undef CAND
#pragma unroll
    for (int j = 0; j < 16; ++j) { lds_lane[j] = __uint_as_float(__float_as_uint(L1[j]) & 0x7Fu); lds_lane[16 + j] = __uint_as_float(__float_as_uint(L2[j]) & 0x7Fu); }
    asm volatile("s_waitcnt lgkmcnt(0)" ::: "memory");
    float wsum = 0.f, w[16]; int ei[16];
    const float mx = best[0];
#pragma unroll
    for (int k = 0; k < 16; ++k) { const unsigned code = __float_as_uint(best[k]) & 0xFFu; const int i = (int)(code >> 4), j = (int)(code & 15u);
        const int i1 = (int)__float_as_uint(lds_lane[i]), i2 = (int)__float_as_uint(lds_lane[16 + j]); ei[k] = i1 * NKEYS + i2;
        w[k] = __expf(best[k] - mx); wsum += w[k]; }
    const float inv = 1.0f / wsum;
    if (g == 0) { int* ip = PIDX + (long)(t0 + r32) * 128 + h * 16; float* wp = PW + (long)(t0 + r32) * 128 + h * 16;
#pragma unroll
        for (int k = 0; k < 16; k += 4) { *reinterpret_cast<int4*>(ip + k) = make_int4(ei[k], ei[k + 1], ei[k + 2], ei[k + 3]);
            *reinterpret_cast<float4*>(wp + k) = make_float4(w[k] * inv, w[k + 1] * inv, w[k + 2] * inv, w[k + 3] * inv); } }
}

__device__ __forceinline__ float gelu_exact(float x) { return 0.5f * x * (1.0f + erff(x * 0.70710678118654752f)); }

__device__ __forceinline__ void dec16(const u32x4 w, f32x2 (&f)[8]) {
    f[0] = __builtin_amdgcn_cvt_pk_f32_fp8((int)w.x, false); f[1] = __builtin_amdgcn_cvt_pk_f32_fp8((int)w.x, true);
    f[2] = __builtin_amdgcn_cvt_pk_f32_fp8((int)w.y, false); f[3] = __builtin_amdgcn_cvt_pk_f32_fp8((int)w.y, true);
    f[4] = __builtin_amdgcn_cvt_pk_f32_fp8((int)w.z, false); f[5] = __builtin_amdgcn_cvt_pk_f32_fp8((int)w.z, true);
    f[6] = __builtin_amdgcn_cvt_pk_f32_fp8((int)w.w, false); f[7] = __builtin_amdgcn_cvt_pk_f32_fp8((int)w.w, true);
}
__device__ __forceinline__ void gather_token(const bf16_t* __restrict__ H, const unsigned char* __restrict__ PU, const unsigned char* __restrict__ PV, const float* __restrict__ SU, const float* __restrict__ SV,
                                             const int* __restrict__ PIDX, const float* __restrict__ PW, float* __restrict__ X, const float* __restrict__ gate  , int t, int lane) {
    f32x2 xf[2][8];
#pragma unroll
    for (int hlf = 0; hlf < 2; ++hlf)
#pragma unroll
        for (int q = 0; q < 2; ++q) { const u32x4 w = *reinterpret_cast<const u32x4*>(H + (long)t * DM + 1024 * hlf + 16 * lane + 8 * q);
            xf[hlf][4 * q + 0] = (f32x2){bflo(w.x), bfhi(w.x)}; xf[hlf][4 * q + 1] = (f32x2){bflo(w.y), bfhi(w.y)}; xf[hlf][4 * q + 2] = (f32x2){bflo(w.z), bfhi(w.z)}; xf[hlf][4 * q + 3] = (f32x2){bflo(w.w), bfhi(w.w)}; }
    f32x2 out[2][8];
#pragma unroll
    for (int hlf = 0; hlf < 2; ++hlf)
#pragma unroll
        for (int i = 0; i < 8; ++i) out[hlf][i] = (f32x2){0.f, 0.f};
    const int myidx0 = PIDX[(long)t * 128 + lane], myidx1 = PIDX[(long)t * 128 + 64 + lane];
    const float myw0 = PW[(long)t * 128 + lane], myw1 = PW[(long)t * 128 + 64 + lane];
    const float msu0 = SU[myidx0], msu1 = SU[myidx1], msv0 = SV[myidx0], msv1 = SV[myidx1];
    for (int hk = 0; hk < 128; hk += 4) {
        const int src = hk & 63; const bool lo = hk < 64;
        const int selidx = lo ? myidx0 : myidx1; const int selw = __float_as_int(lo ? myw0 : myw1), selsu = __float_as_int(lo ? msu0 : msu1), selsv = __float_as_int(lo ? msv0 : msv1);
        int e[4]; float g[4], su[4], sv[4];
#pragma unroll
        for (int k = 0; k < 4; ++k) { e[k] = __builtin_amdgcn_readlane(selidx, src + k); g[k] = __int_as_float(__builtin_amdgcn_readlane(selw, src + k));
            su[k] = __int_as_float(__builtin_amdgcn_readlane(selsu, src + k)); sv[k] = __int_as_float(__builtin_amdgcn_readlane(selsv, src + k)); }
        u32x4 uw[4][2], vw[4][2];
#pragma unroll
        for (int k = 0; k < 4; ++k) { uw[k][0] = *reinterpret_cast<const u32x4*>(PU + ((long)(lane >> 3) * NEXP + e[k]) * 128 + 16 * (lane & 7)); uw[k][1] = *reinterpret_cast<const u32x4*>(PU + ((long)(8 + (lane >> 3)) * NEXP + e[k]) * 128 + 16 * (lane & 7)); }
#pragma unroll
        for (int k = 0; k < 4; ++k) { { const u32x2 a0 = *reinterpret_cast<const u32x2*>(PV + ((long)(2 * lane) * NEXP + e[k]) * 8), a1 = *reinterpret_cast<const u32x2*>(PV + ((long)(2 * lane + 1) * NEXP + e[k]) * 8);
              const u32x2 b0 = *reinterpret_cast<const u32x2*>(PV + ((long)(128 + 2 * lane) * NEXP + e[k]) * 8), b1 = *reinterpret_cast<const u32x2*>(PV + ((long)(129 + 2 * lane) * NEXP + e[k]) * 8);
              vw[k][0] = (u32x4){a0.x, a0.y, a1.x, a1.y}; vw[k][1] = (u32x4){b0.x, b0.y, b1.x, b1.y}; } }
        float a[4];
#pragma unroll
        for (int k = 0; k < 4; ++k) { f32x2 d = (f32x2){0.f, 0.f};
#pragma unroll
            for (int hlf = 0; hlf < 2; ++hlf) { f32x2 f[8]; dec16(uw[k][hlf], f);
#pragma unroll
                for (int i = 0; i < 8; ++i) d = __builtin_elementwise_fma(f[i], xf[hlf][i], d); }
            a[k] = wave_sum(d[0] + d[1]); }
#pragma unroll
        for (int k = 0; k < 4; ++k) { const float ak = g[k] * gelu_exact(a[k] * su[k]) * sv[k]; const f32x2 a2 = (f32x2){ak, ak};
#pragma unroll
            for (int hlf = 0; hlf < 2; ++hlf) { f32x2 f[8]; dec16(vw[k][hlf], f);
#pragma unroll
                for (int i = 0; i < 8; ++i) out[hlf][i] = __builtin_elementwise_fma(f[i], a2, out[hlf][i]); } }
    }
    const float* gr = gate + (long)cond_row(t) * 12288;
#pragma unroll
    for (int hlf = 0; hlf < 2; ++hlf)
#pragma unroll
        for (int q = 0; q < 4; ++q) { const int c = 1024 * hlf + 16 * lane + 4 * q; float* xp = X + (long)t * DM + c;
            const f32x4 gv = *reinterpret_cast<const f32x4*>(gr + c); f32x4 xv = *reinterpret_cast<const f32x4*>(xp);
            xv[0] += gv[0] * out[hlf][2 * q][0]; xv[1] += gv[1] * out[hlf][2 * q][1]; xv[2] += gv[2] * out[hlf][2 * q + 1][0]; xv[3] += gv[3] * out[hlf][2 * q + 1][1];
            *reinterpret_cast<f32x4*>(xp) = xv; }
}

constexpr int SW = 128, NSL = DM / SW;
struct XInfo { int rank, xi, nx, nloc; };
__device__ __forceinline__ void upass(const bf16_t* __restrict__ H, const unsigned char* __restrict__ PU, const int* __restrict__ PIDX, const float* __restrict__ PW, const float* __restrict__ SU, const float* __restrict__ SV,
                                      float* __restrict__ DOTP, unsigned* __restrict__ PACKT, const XInfo xin, int wid, int lane) {
    const int g = lane >> 3, c = lane & 7; const int nwv = xin.nloc * 8;
    const int tlo = (int)((long)T * xin.xi / xin.nx), thi = (int)((long)T * (xin.xi + 1) / xin.nx); const int wv = tlo + xin.rank * 8 + wid;
    float* dp = DOTP;
    for (int s = 0; s < NSL; ++s) { const bool first = (s == 0), lastS = (s == NSL - 1);
        const __amdgpu_buffer_rsrc_t urs = __builtin_amdgcn_make_buffer_rsrc((void*)(PU + (long)s * NEXP * SW), 0, NEXP * SW, 0x00020000);
#define UP_ROW(e_) __builtin_bit_cast(u32x4, __builtin_amdgcn_raw_buffer_load_b128(urs, (e_) * SW + 16 * c, 0, 0))
#define UP_IDX(tt, q4) (*reinterpret_cast<const int4*>(PIDX + (long)(tt) * 128 + 16 * g + 4 * (q4)))
#define UP_X(tt, q2) (*reinterpret_cast<const u32x4*>(H + (long)(tt) * DM + SW * s + 16 * c + 8 * (q2)))
        if (wv >= thi) continue;
        u32x4 A[8], B[8]; int4 en[4]; u32x4 xn[2];
        { int4 e0[4];
#pragma unroll
          for (int q4 = 0; q4 < 4; ++q4) e0[q4] = UP_IDX(wv, q4);
          A[0] = UP_ROW(e0[0].x); A[1] = UP_ROW(e0[0].y); A[2] = UP_ROW(e0[0].z); A[3] = UP_ROW(e0[0].w); A[4] = UP_ROW(e0[1].x); A[5] = UP_ROW(e0[1].y); A[6] = UP_ROW(e0[1].z); A[7] = UP_ROW(e0[1].w);
          B[0] = UP_ROW(e0[2].x); B[1] = UP_ROW(e0[2].y); B[2] = UP_ROW(e0[2].z); B[3] = UP_ROW(e0[2].w); B[4] = UP_ROW(e0[3].x); B[5] = UP_ROW(e0[3].y); B[6] = UP_ROW(e0[3].z); B[7] = UP_ROW(e0[3].w);
          const int t1 = (wv + nwv < thi) ? wv + nwv : wv;
#pragma unroll
          for (int q4 = 0; q4 < 4; ++q4) en[q4] = UP_IDX(t1, q4);
          xn[0] = UP_X(wv, 0); xn[1] = UP_X(wv, 1); }
        f32x2 dnx = (f32x2){0.f, 0.f};
        if (!first) dnx = *reinterpret_cast<const f32x2*>(dp + (long)wv * 128 + 16 * g + 2 * c);
#pragma unroll 1
        for (int t = wv; t < thi; t += nwv) {
            const int tn = (t + nwv < thi) ? t + nwv : t, tnn = (tn + nwv < thi) ? tn + nwv : tn;
            const f32x2 dcur = dnx;
            if (!first) dnx = *reinterpret_cast<const f32x2*>(dp + (long)tn * 128 + 16 * g + 2 * c);
            f32x2 xf[8];
#pragma unroll
            for (int q2 = 0; q2 < 2; ++q2) { const u32x4 hw = xn[q2];
                xf[4 * q2 + 0] = (f32x2){bflo(hw.x), bfhi(hw.x)}; xf[4 * q2 + 1] = (f32x2){bflo(hw.y), bfhi(hw.y)}; xf[4 * q2 + 2] = (f32x2){bflo(hw.z), bfhi(hw.z)}; xf[4 * q2 + 3] = (f32x2){bflo(hw.w), bfhi(hw.w)}; }
            xn[0] = UP_X(tn, 0); xn[1] = UP_X(tn, 1);
            float d[16];
#pragma unroll
            for (int i = 0; i < 8; ++i) { f32x2 f[8]; dec16(A[i], f); f32x2 a = (f32x2){0.f, 0.f};
#pragma unroll
                for (int k = 0; k < 8; ++k) a = __builtin_elementwise_fma(f[k], xf[k], a);
                d[i] = a[0] + a[1]; }
            A[0] = UP_ROW(en[0].x); A[1] = UP_ROW(en[0].y); A[2] = UP_ROW(en[0].z); A[3] = UP_ROW(en[0].w); A[4] = UP_ROW(en[1].x); A[5] = UP_ROW(en[1].y); A[6] = UP_ROW(en[1].z); A[7] = UP_ROW(en[1].w);
#pragma unroll
            for (int i = 0; i < 8; ++i) { f32x2 f[8]; dec16(B[i], f); f32x2 a = (f32x2){0.f, 0.f};
#pragma unroll
                for (int k = 0; k < 8; ++k) a = __builtin_elementwise_fma(f[k], xf[k], a);
                d[8 + i] = a[0] + a[1]; }
            B[0] = UP_ROW(en[2].x); B[1] = UP_ROW(en[2].y); B[2] = UP_ROW(en[2].z); B[3] = UP_ROW(en[2].w); B[4] = UP_ROW(en[3].x); B[5] = UP_ROW(en[3].y); B[6] = UP_ROW(en[3].z); B[7] = UP_ROW(en[3].w);
#pragma unroll
            for (int q4 = 0; q4 < 4; ++q4) en[q4] = UP_IDX(tnn, q4);
            float r8[8], r4[4], r2[2];
#pragma unroll
            for (int k = 0; k < 8; ++k) { const float keep = (c & 4) ? d[k + 8] : d[k], send = (c & 4) ? d[k] : d[k + 8]; r8[k] = keep + sx<4>(send); }
#pragma unroll
            for (int k = 0; k < 4; ++k) { const float keep = (c & 2) ? r8[k + 4] : r8[k], send = (c & 2) ? r8[k] : r8[k + 4]; r4[k] = keep + sx<2>(send); }
#pragma unroll
            for (int k = 0; k < 2; ++k) { const float keep = (c & 1) ? r4[k + 2] : r4[k], send = (c & 1) ? r4[k] : r4[k + 2]; r2[k] = keep + sx<1>(send); }
            float* o = dp + (long)t * 128 + 16 * g + 2 * c;
            f32x2 acc = (f32x2){r2[0], r2[1]};
            acc += dcur;
            if (!lastS) *reinterpret_cast<f32x2*>(o) = acc;
            else {
                const int p0 = 16 * g + 2 * c; const int2 ee = *reinterpret_cast<const int2*>(PIDX + (long)t * 128 + p0); const f32x2 gw = *reinterpret_cast<const f32x2*>(PW + (long)t * 128 + p0);
                const float a0 = gw[0] * gelu_exact(acc[0] * SU[ee.x]) * SV[ee.x], a1 = gw[1] * gelu_exact(acc[1] * SU[ee.y]) * SV[ee.y];
                u32x2 pk; pk.x = (cvt_pk_bf16(0.f, a0) & 0xffff0000u) | (unsigned)ee.x; pk.y = (cvt_pk_bf16(0.f, a1) & 0xffff0000u) | (unsigned)ee.y;
                *reinterpret_cast<u32x2*>(PACKT + ((long)(p0 >> 2) * T + t) * 4 + (p0 & 3)) = pk; }
        }
#undef UP_ROW
#undef UP_IDX
#undef UP_X
    }
}
__device__ __forceinline__ void actpass(const float* __restrict__ DOTP, const int* __restrict__ PIDX, const float* __restrict__ PW, const float* __restrict__ SU, const float* __restrict__ SV, float* __restrict__ ACT, int nx, long gt, long nt) {
    for (long i = gt; i < (long)T * 128; i += nt) { float dsum = 0.f;
        for (int x = 0; x < nx; ++x) dsum += DOTP[(long)x * T * 128 + i];
        const int e = PIDX[i]; const float av = PW[i] * gelu_exact(dsum * SU[e]) * SV[e]; const long t = i >> 7; const int pp = (int)(i & 127);
        reinterpret_cast<unsigned*>(ACT)[((long)(pp >> 2) * T + t) * 4 + (pp & 3)] = (cvt_pk_bf16(0.f, av) & 0xffff0000u) | (unsigned)e; }
}
__device__ __forceinline__ void vpass(const unsigned char* __restrict__ PV, const int* __restrict__ PIDX, const float* __restrict__ ACT, float* __restrict__ X, const float* __restrict__ gate, const XInfo xin, int wid, int lane) {
    const int g = lane >> 3, c = lane & 7; const int wv = xin.rank * 8 + wid, nwv = xin.nloc * 8;
    for (int s = xin.xi; s < NSL; s += xin.nx) {
        int4 en[4]; f32x4 an[4];
#pragma unroll
        for (int q4 = 0; q4 < 4; ++q4) { en[q4] = *reinterpret_cast<const int4*>(PIDX + (long)(wv < T ? wv : 0) * 128 + 16 * g + 4 * q4); an[q4] = *reinterpret_cast<const f32x4*>(ACT + (long)(wv < T ? wv : 0) * 128 + 16 * g + 4 * q4); }
        for (int t = wv; t < T; t += nwv) {
            int e[16]; float a[16];
#pragma unroll
            for (int q4 = 0; q4 < 4; ++q4) { e[4 * q4] = en[q4].x; e[4 * q4 + 1] = en[q4].y; e[4 * q4 + 2] = en[q4].z; e[4 * q4 + 3] = en[q4].w; a[4 * q4] = an[q4][0]; a[4 * q4 + 1] = an[q4][1]; a[4 * q4 + 2] = an[q4][2]; a[4 * q4 + 3] = an[q4][3]; }
            u32x4 w[16];
#pragma unroll
            for (int i = 0; i < 16; ++i) w[i] = *reinterpret_cast<const u32x4*>(PV + ((long)s * NEXP + e[i]) * SW + 16 * c);
            { const int tn = (t + nwv < T) ? t + nwv : t;
#pragma unroll
              for (int q4 = 0; q4 < 4; ++q4) { en[q4] = *reinterpret_cast<const int4*>(PIDX + (long)tn * 128 + 16 * g + 4 * q4); an[q4] = *reinterpret_cast<const f32x4*>(ACT + (long)tn * 128 + 16 * g + 4 * q4); } }
            f32x2 o[8];
#pragma unroll
            for (int k = 0; k < 8; ++k) o[k] = (f32x2){0.f, 0.f};
#pragma unroll
            for (int i = 0; i < 16; ++i) { f32x2 f[8]; dec16(w[i], f); const f32x2 a2 = (f32x2){a[i], a[i]};
#pragma unroll
                for (int k = 0; k < 8; ++k) o[k] = __builtin_elementwise_fma(f[k], a2, o[k]); }
            f32x2 r4[4], r2[2], r1;
#pragma unroll
            for (int k = 0; k < 4; ++k) { const f32x2 keep = (g & 4) ? o[k + 4] : o[k], send = (g & 4) ? o[k] : o[k + 4]; r4[k] = keep + (f32x2){sx<32>(send[0]), sx<32>(send[1])}; }
#pragma unroll
            for (int k = 0; k < 2; ++k) { const f32x2 keep = (g & 2) ? r4[k + 2] : r4[k], send = (g & 2) ? r4[k] : r4[k + 2]; r2[k] = keep + (f32x2){sx<16>(send[0]), sx<16>(send[1])}; }
            { const f32x2 keep = (g & 1) ? r2[1] : r2[0], send = (g & 1) ? r2[0] : r2[1]; r1 = keep + (f32x2){sx<8>(send[0]), sx<8>(send[1])}; }
            const int col = SW * s + 16 * c + 2 * g;
            const f32x2 gv = *reinterpret_cast<const f32x2*>(gate + (long)cond_row(t) * 12288 + col);
            float* xp = X + (long)t * DM + col; f32x2 xv = *reinterpret_cast<const f32x2*>(xp);
            xv += gv * r1; *reinterpret_cast<f32x2*>(xp) = xv;
        }
    }
}

__device__ __forceinline__ void vpass_lds(const unsigned char* __restrict__ PV, const unsigned* __restrict__ PACKT, float* __restrict__ X, const float* __restrict__ gate, char* lds, int bid, int nb, int s_end, int tid) {
    const int wid = tid >> 6, lane = tid & 63;
    for (int s = bid; s < s_end; s += nb) {
        __syncthreads();
        { const u32x4* src = reinterpret_cast<const u32x4*>(PV + (long)s * NEXP * 8); u32x4* dst = reinterpret_cast<u32x4*>(lds);
#pragma unroll 4
          for (int i = tid; i < NEXP * 8 / 16; i += 512) dst[i] = src[i]; }
        __syncthreads();
        u32x4 h0[8], h1[8];
        const __amdgpu_buffer_rsrc_t vrs = __builtin_amdgcn_make_buffer_rsrc((void*)PACKT, 0, (int)((size_t)T * 128 * 4), 0x00020000);
#define VP_LD(k, toff) __builtin_bit_cast(u32x4, __builtin_amdgcn_raw_buffer_load_b128(vrs, (int)(toff), (int)((size_t)(k) * T * 16), 0))
        { const unsigned toff = (unsigned)(wid * 64 + lane) * 16u;
#pragma unroll
          for (int k = 0; k < 8; ++k) h0[k] = VP_LD(k, toff);
#pragma unroll
          for (int k = 0; k < 8; ++k) h1[k] = VP_LD(8 + k, toff); }
#define VP_STEP(HB) do { _Pragma("unroll") for (int kk = 0; kk < 8; kk += 2) { unsigned pw[8]; \
            _Pragma("unroll") for (int k = 0; k < 2; ++k) { pw[4 * k] = HB[kk + k].x; pw[4 * k + 1] = HB[kk + k].y; pw[4 * k + 2] = HB[kk + k].z; pw[4 * k + 3] = HB[kk + k].w; } \
            u32x2 w[8]; \
            _Pragma("unroll") for (int k = 0; k < 8; ++k) w[k] = *reinterpret_cast<const u32x2*>(lds + (pw[k] & 0xffffu) * 8u); \
            _Pragma("unroll") for (int k = 0; k < 8; ++k) { const float a = __uint_as_float(pw[k] & 0xffff0000u); \
                const f32x2 f0 = __builtin_amdgcn_cvt_pk_f32_fp8((int)w[k].x, false), f1 = __builtin_amdgcn_cvt_pk_f32_fp8((int)w[k].x, true), f2 = __builtin_amdgcn_cvt_pk_f32_fp8((int)w[k].y, false), f3 = __builtin_amdgcn_cvt_pk_f32_fp8((int)w[k].y, true); \
                acc[0] = fmaf(a, f0[0], acc[0]); acc[1] = fmaf(a, f0[1], acc[1]); acc[2] = fmaf(a, f1[0], acc[2]); acc[3] = fmaf(a, f1[1], acc[3]); \
                acc[4] = fmaf(a, f2[0], acc[4]); acc[5] = fmaf(a, f2[1], acc[5]); acc[6] = fmaf(a, f3[0], acc[6]); acc[7] = fmaf(a, f3[1], acc[7]); } } } while (0)
#pragma unroll 1
        for (int tg = wid; tg < T / 64; tg += 8) { const int t = tg * 64 + lane; const int tgn = (tg + 8 < T / 64) ? tg + 8 : tg;
            const unsigned toff = (unsigned)t * 16u, toffn = (unsigned)(tgn * 64 + lane) * 16u;
            float acc[8];
#pragma unroll
            for (int j = 0; j < 8; ++j) acc[j] = 0.f;
            VP_STEP(h0);
#pragma unroll
            for (int k = 0; k < 8; ++k) h0[k] = VP_LD(16 + k, toff);
            VP_STEP(h1);
#pragma unroll
            for (int k = 0; k < 8; ++k) h1[k] = VP_LD(24 + k, toff);
            VP_STEP(h0);
#pragma unroll
            for (int k = 0; k < 8; ++k) h0[k] = VP_LD(k, toffn);
            VP_STEP(h1);
#pragma unroll
            for (int k = 0; k < 8; ++k) h1[k] = VP_LD(8 + k, toffn);
            const float* gr = gate + (long)cond_row(t) * 12288 + 8 * s; float* xp = X + (long)t * DM + 8 * s;
            const f32x4 g0 = *reinterpret_cast<const f32x4*>(gr), g1 = *reinterpret_cast<const f32x4*>(gr + 4);
            f32x4 x0 = *reinterpret_cast<const f32x4*>(xp), x1 = *reinterpret_cast<const f32x4*>(xp + 4);
            x0[0] += g0[0] * acc[0]; x0[1] += g0[1] * acc[1]; x0[2] += g0[2] * acc[2]; x0[3] += g0[3] * acc[3];
            x1[0] += g1[0] * acc[4]; x1[1] += g1[1] * acc[5]; x1[2] += g1[2] * acc[6]; x1[3] += g1[3] * acc[7];
            *reinterpret_cast<f32x4*>(xp) = x0; *reinterpret_cast<f32x4*>(xp + 4) = x1; }
#undef VP_STEP
#undef VP_LD
    }
    __syncthreads();
}
}
namespace ph {
__device__ __forceinline__ int gwave() { return obid() * 8 + (otid() >> 6); }
__device__ __forceinline__ int nwaves() { return ogrid() * 8; }
__device__ __forceinline__ long gthread() { return (long)obid() * 512 + otid(); }
__device__ __forceinline__ long nthreads() { return (long)ogrid() * 512; }

__device__ __forceinline__ void transpose_tile(const float* __restrict__ src, int C, int r0, int c0, bf16_t* __restrict__ dst, long dpitch, float* tile) {
    const int tid = otid();
#pragma unroll
    for (int i = 0; i < 8; ++i) { const int idx = tid + 512 * i, r = idx >> 6, c = idx & 63; tile[r * 65 + c] = src[(long)(r0 + r) * C + c0 + c]; }
    __syncthreads();
    { const int c = tid >> 3, rc = (tid & 7) * 8; float f[8];
#pragma unroll
      for (int j = 0; j < 8; ++j) f[j] = tile[(rc + j) * 65 + c];
      *reinterpret_cast<u32x4*>(dst + (long)(c0 + c) * dpitch + r0 + rc) = pack8(f); }
    __syncthreads();
}

__device__ __forceinline__ void zero_chunks(bf16_t* base, long nrows, long rowpitch, int col0, int nchunk) {
    const long total = nrows * nchunk;
    for (long i = gthread(); i < total; i += nthreads()) { const long r = i / nchunk; const int ch = (int)(i % nchunk);
        *reinterpret_cast<u32x4*>(base + r * rowpitch + col0 + ch * 8) = (u32x4){0u, 0u, 0u, 0u}; }
}

__device__ __forceinline__ void prologue(KParams& p, char* lds) {
    unsigned char* ws = optr(gp(p.ws)); const int tid = otid();
    float* tile = (float*)lds;
    { struct TJob { const float* src; bf16_t* dst; int R, C, r0, c0, perm; };
      auto decode = [&](int it) { TJob j; j.perm = 0; const int l = it / 10656; int r = it % 10656;
        if (r < 5664) { j.src = gp(p.w_in) + (long)l * DM * INW; j.R = DM; j.C = INW; j.dst = (bf16_t*)(ws + WS_WIN) + (long)l * INWP * DM; }
        else if (r < 6048) { r -= 5664; j.src = gp(p.w_uq) + (long)l * 512 * 3072; j.R = 512; j.C = 3072; j.dst = (bf16_t*)(ws + WS_WUQ) + (long)l * 3072 * 512; j.perm = 1; }
        else if (r < 6560) { r -= 6048; j.src = gp(p.w_ukv) + (long)l * 512 * 4096; j.R = 512; j.C = 4096; j.dst = (bf16_t*)(ws + WS_WUKV) + (long)l * 4096 * 512; }
        else { r -= 6560; const int m = r >> 10; r &= 1023; j.R = DM; j.C = DM;
            j.src = (m == 0 ? gp(p.w_a) : m == 1 ? gp(p.w_b) : m == 2 ? gp(p.w_o) : gp(p.w_pq)) + (long)l * DM * DM;
            j.dst = (bf16_t*)(ws + (m == 0 ? WS_WA : m == 1 ? WS_WB : m == 2 ? WS_WO : WS_WPQ)) + (long)l * DM * DM; }
        const int ntc = j.C / 64; j.r0 = (r / ntc) * 64; j.c0 = (r % ntc) * 64; return j; };
      const int NTILES = 2 * 10656, G_ = ogrid(); int it = obid(); float v[8]; TJob cur{};
      if (it < NTILES) { cur = decode(it);
#pragma unroll
        for (int i = 0; i < 8; ++i) { const int idx = tid + 512 * i, r = idx >> 6, c = idx & 63; v[i] = cur.src[(long)(cur.r0 + r) * cur.C + cur.c0 + c]; } }
      while (it < NTILES) { const int itn = it + G_; float vn[8]; TJob nxt{};
        if (itn < NTILES) { nxt = decode(itn);
#pragma unroll
            for (int i = 0; i < 8; ++i) { const int idx = tid + 512 * i, r = idx >> 6, c = idx & 63; vn[i] = nxt.src[(long)(nxt.r0 + r) * nxt.C + nxt.c0 + c]; } }
#pragma unroll
        for (int i = 0; i < 8; ++i) { const int idx = tid + 512 * i, r = idx >> 6, c = idx & 63; tile[r * 65 + c] = v[i]; }
        __syncthreads();
        { const int c = tid >> 3, rc = (tid & 7) * 8; float f[8];
#pragma unroll
          for (int jj = 0; jj < 8; ++jj) f[jj] = tile[(rc + jj) * 65 + c];
          int drow = cur.c0 + c;
          if (cur.perm) { const int gq = drow / 768, o = drow - 768 * gq, hh = o / 192, w = o - 192 * hh;
              drow = 768 * gq + (w < 128 ? 128 * hh + w : (w < 160 ? 512 + 32 * hh + (w - 128) : 640 + 32 * hh + (w - 160))); }
          *reinterpret_cast<u32x4*>(cur.dst + (long)drow * cur.R + cur.r0 + rc) = pack8(f); }
        __syncthreads();
#pragma unroll
        for (int i = 0; i < 8; ++i) v[i] = vn[i];
        cur = nxt; it = itn; } }
    for (long i = gthread(); i < 2L * 16 * 512 * 32; i += nthreads()) { const int ch = (int)(i & 31); const long row = i >> 5; const int c = (int)(row & 511), h = (int)((row >> 9) & 15), l = (int)(row >> 13);
        u32x4 w = (u32x4){0u, 0u, 0u, 0u};
        if (ch < 16) { const float* s = gp(p.w_ukv) + (((long)l * 512 + c) * 16 + h) * 256 + ch * 8; float f[8];
#pragma unroll
            for (int j = 0; j < 8; ++j) f[j] = s[j];
            w = pack8(f); }
        *reinterpret_cast<u32x4*>((bf16_t*)(ws + WS_WUK) + row * 256 + ch * 8) = w; }
    for (long i = gthread(); i < 2L * 4096; i += nthreads()) { const bool second = i >= 4096; const long j8 = (second ? i - 4096 : i) * 8; const float* s = (second ? gp(p.peer_k2) : gp(p.peer_k1)) + j8; float f[8];
#pragma unroll
        for (int j = 0; j < 8; ++j) f[j] = s[j];
        *reinterpret_cast<u32x4*>((bf16_t*)(ws + (second ? WS_PK2 : WS_PK1)) + j8) = pack8(f); }
    for (int l = 0; l < 2; ++l) zero_chunks((bf16_t*)(ws + WS_WIN) + ((long)l * INWP + INW) * DM, INWP - INW, DM, 0, DM / 8);
    for (int b = 0; b < DB; ++b) zero_chunks((bf16_t*)(ws + WS_CKA) + ((long)b * KPAD + KALL) * QLD, KPAD - KALL, QLD, 0, QLD / 8);
    zero_chunks((bf16_t*)(ws + WS_CKA), (long)DB * KPAD, QLD, 576, 8);
    zero_chunks((bf16_t*)(ws + WS_CKT), (long)DB * 512, KPAD, KALL, (KPAD - KALL) / 8);
    zero_chunks((bf16_t*)(ws + WS_QL), (long)DB * 1024, QLD, 576, 8);
    for (long i = gthread(); i < 4096L * 96; i += nthreads()) { const int pos = (int)(i / 96), k = (int)(i % 96); const bool big = k >= 32; const int fi = big ? k - 32 : k; const float d = big ? 128.f : 64.f;
        const float inv = __builtin_amdgcn_exp2f(-(2.0f * (float)fi / d) * 13.287712379549449f);
        const float ang = (float)pos * inv; double rv = (double)ang * 0.15915494309189535; rv -= floor(rv); const float fr = (float)rv;
        float* dst = big ? (float*)(ws + WS_TAB128) + ((long)pos * 64 + fi) * 2 : (float*)(ws + WS_TAB64) + ((long)pos * 32 + fi) * 2;
        dst[0] = __builtin_amdgcn_cosf(fr); dst[1] = __builtin_amdgcn_sinf(fr); }
    { float* sc = (float*)lds;
      for (int it = obid(); it < 2 * 12 * 8; it += ogrid()) { const int l = it / 96, cc = (it % 96) / 8, ks = it % 8;
        __syncthreads();
        for (int i = tid; i < NCOND * 256; i += 512) { const int r = i >> 8, k = i & 255; const float c = r < NB ? gp(p.c_prompt)[(long)r * DM + ks * 256 + k] : gp(p.c_sample)[(long)(r - NB) * DM + ks * 256 + k]; sc[i] = siluf_(c); }
        __syncthreads();
        float a0[NCOND], a1[NCOND];
#pragma unroll
        for (int r = 0; r < NCOND; ++r) { a0[r] = 0.f; a1[r] = 0.f; }
        const float* wp = gp(p.w_ada) + ((long)l * DM + ks * 256) * 12288 + cc * 1024 + 2 * tid;
#pragma unroll 1
        for (int k = 0; k < 256; k += 4) { const f32x2 w0 = *reinterpret_cast<const f32x2*>(wp), w1 = *reinterpret_cast<const f32x2*>(wp + 12288), w2 = *reinterpret_cast<const f32x2*>(wp + 2 * 12288), w3 = *reinterpret_cast<const f32x2*>(wp + 3 * 12288);
            wp += 4 * 12288;
#pragma unroll
            for (int r = 0; r < NCOND; ++r) { const f32x4 s = *reinterpret_cast<const f32x4*>(sc + r * 256 + k);
                a0[r] = fmaf(s[0], w0[0], fmaf(s[1], w1[0], fmaf(s[2], w2[0], fmaf(s[3], w3[0], a0[r]))));
                a1[r] = fmaf(s[0], w0[1], fmaf(s[1], w1[1], fmaf(s[2], w2[1], fmaf(s[3], w3[1], a1[r]))));
                if ((r % 6) == 5) __builtin_amdgcn_sched_barrier(0); } }
        float* dst = (float*)(ws + WS_ADAP) + (((long)ks * 2 + l) * NCOND) * 12288 + cc * 1024 + 2 * tid;
#pragma unroll
        for (int r = 0; r < NCOND; ++r) *reinterpret_cast<f32x2*>(dst + (long)r * 12288) = (f32x2){a0[r], a1[r]}; }
      __syncthreads(); }
}

__device__ __forceinline__ void wpq_int8(KParams& p) {
    unsigned char* ws = optr(gp(p.ws)); const int lane = otid() & 63;
    for (int r = gwave(); r < 2 * DM; r += nwaves()) { const bf16_t* src = (const bf16_t*)(ws + WS_WPQ) + (long)r * DM; float f[4][8]; float am = 0.f;
#pragma unroll
        for (int j = 0; j < 4; ++j) { unpack8(*reinterpret_cast<const u32x4*>(src + 512 * j + 8 * lane), f[j]);
#pragma unroll
            for (int i = 0; i < 8; ++i) am = fmaxf(am, fabsf(f[j][i])); }
        am = wave_max(am); const float qs = am > 0.f ? 127.0f / am : 0.f;
#pragma unroll
        for (int j = 0; j < 4; ++j) { unsigned w2[2];
#pragma unroll
            for (int hh = 0; hh < 2; ++hh) { unsigned w = 0u;
#pragma unroll
                for (int i = 0; i < 4; ++i) w |= ((unsigned)((int)__builtin_rintf(f[j][4 * hh + i] * qs) & 0xff)) << (8 * i);
                w2[hh] = w; }
            *reinterpret_cast<u32x2*>(ws + WS_WPQ8 + (long)r * DM + 512 * j + 8 * lane) = (u32x2){w2[0], w2[1]}; }
        if (lane == 0) ((float*)(ws + WS_SB8))[r] = am * (1.0f / 127.0f); }
}

__device__ __forceinline__ void wb_int8(KParams& p, int l) {
    unsigned char* ws = optr(gp(p.ws)); const int lane = otid() & 63;
    for (int r = gwave(); r < DM; r += nwaves()) { const bf16_t* src = (const bf16_t*)(ws + WS_WB) + ((long)l * DM + r) * DM; float f[4][8]; float am = 0.f;
#pragma unroll
        for (int j = 0; j < 4; ++j) { unpack8(*reinterpret_cast<const u32x4*>(src + 512 * j + 8 * lane), f[j]);
#pragma unroll
            for (int i = 0; i < 8; ++i) am = fmaxf(am, fabsf(f[j][i])); }
        am = wave_max(am); const float qs = am > 0.f ? 127.0f / am : 0.f;
#pragma unroll
        for (int j = 0; j < 4; ++j) { unsigned w2[2];
#pragma unroll
            for (int hh = 0; hh < 2; ++hh) { unsigned w = 0u;
#pragma unroll
                for (int i = 0; i < 4; ++i) w |= ((unsigned)((int)__builtin_rintf(f[j][4 * hh + i] * qs) & 0xff)) << (8 * i);
                w2[hh] = w; }
            *reinterpret_cast<u32x2*>(ws + WS_WB8 + (long)r * DM + 512 * j + 8 * lane) = (u32x2){w2[0], w2[1]}; }
        if (lane == 0) ((float*)(ws + WS_SBB))[r] = am * (1.0f / 127.0f); }
}

__device__ __forceinline__ void win_int8(KParams& p, int l) {
    unsigned char* ws = optr(gp(p.ws)); const int lane = otid() & 63;
    for (int jr = gwave(); jr < NB8 * 256; jr += nwaves()) { const int blk = jr >> 8, n = (blk < 2 ? blk : (blk < 5 ? blk + 3 : blk + 16)) * 256 + (jr & 255);
        const bf16_t* src = (const bf16_t*)(ws + WS_WIN) + ((long)l * INWP + n) * DM; float f[4][8]; float am = 0.f;
#pragma unroll
        for (int j = 0; j < 4; ++j) { unpack8(*reinterpret_cast<const u32x4*>(src + 512 * j + 8 * lane), f[j]);
#pragma unroll
            for (int i = 0; i < 8; ++i) am = fmaxf(am, fabsf(f[j][i])); }
        am = wave_max(am); const float qs = am > 0.f ? 127.0f / am : 0.f;
#pragma unroll
        for (int j = 0; j < 4; ++j) { unsigned w2[2];
#pragma unroll
            for (int hh = 0; hh < 2; ++hh) { unsigned w = 0u;
#pragma unroll
                for (int i = 0; i < 4; ++i) w |= ((unsigned)((int)__builtin_rintf(f[j][4 * hh + i] * qs) & 0xff)) << (8 * i);
                w2[hh] = w; }
            *reinterpret_cast<u32x2*>(ws + WS_WIN8 + (long)jr * DM + 512 * j + 8 * lane) = (u32x2){w2[0], w2[1]}; }
        if (lane == 0) ((float*)(ws + WS_SBW))[n] = am * (1.0f / 127.0f); }
}

__device__ __forceinline__ void ada_reduce(KParams& p) {
    unsigned char* ws = optr(gp(p.ws)); const float* ap = (const float*)(ws + WS_ADAP); float* ad = (float*)(ws + WS_ADA); const long n = 2L * NCOND * 12288;
    for (long i = gthread(); i < n; i += nthreads()) { const int l = (int)(i / (NCOND * 12288L)); const int j = (int)(i % 12288);
        float s = gp(p.b_ada)[(long)l * 12288 + j];
#pragma unroll
        for (int ks = 0; ks < 8; ++ks) s += ap[(long)ks * n + i];
        ad[i] = s; }
}

__device__ __forceinline__ void modulate(KParams& p, int l, int which) {
    const int lane = otid() & 63; unsigned char* ws = optr(gp(p.ws)); const float* X = gp(p.out); bf16_t* H = (bf16_t*)(ws + WS_H);
    const float* g = (which ? gp(p.g_ffn) : gp(p.g_mix)) + (long)l * DM; const float* ada = (const float*)(ws + WS_ADA) + (long)l * NCOND * 12288 + (which ? 3 : 0) * DM;
    for (int t = gwave(); t < T; t += nwaves()) {
        const float* xr = (l == 0 && which == 0) ? (t < TP ? gp(p.x_prompt) + (long)t * DM : gp(p.x_sample) + (long)(t - TP) * DM) : X + (long)t * DM; f32x4 v[8]; float ss = 0.f;
#pragma unroll
        for (int j = 0; j < 8; ++j) { v[j] = *reinterpret_cast<const f32x4*>(xr + 256 * j + 4 * lane); ss += v[j][0] * v[j][0] + v[j][1] * v[j][1] + v[j][2] * v[j][2] + v[j][3] * v[j][3]; }
        ss = wave_sum(ss); const float rinv = rsqrtf(ss * (1.0f / DM) + EPS);
        const float* sh = ada + (long)cond_row(t) * 12288; const float* sc = sh + DM;
#pragma unroll
        for (int j = 0; j < 8; ++j) { const int c = 256 * j + 4 * lane; const f32x4 gv = *reinterpret_cast<const f32x4*>(g + c), sv = *reinterpret_cast<const f32x4*>(sc + c), hv = *reinterpret_cast<const f32x4*>(sh + c);
            const f32x4 y = v[j] * rinv * gv * (sv + 1.0f) + hv; u32x2 w; w.x = cvt_pk_bf16(y[0], y[1]); w.y = cvt_pk_bf16(y[2], y[3]);
            *reinterpret_cast<u32x2*>(H + (long)t * DM + c) = w; v[j] = y; }
        {
            float am = 0.f;
#pragma unroll
            for (int j = 0; j < 8; ++j) am = fmaxf(am, fmaxf(fmaxf(fabsf(v[j][0]), fabsf(v[j][1])), fmaxf(fabsf(v[j][2]), fabsf(v[j][3]))));
            am = wave_max(am); const float qs = am > 0.f ? 127.0f / am : 0.f;
#pragma unroll
            for (int j = 0; j < 8; ++j) { const int c = 256 * j + 4 * lane;
                const int q0 = (int)__builtin_rintf(v[j][0] * qs), q1 = (int)__builtin_rintf(v[j][1] * qs), q2 = (int)__builtin_rintf(v[j][2] * qs), q3 = (int)__builtin_rintf(v[j][3] * qs);
                *reinterpret_cast<unsigned*>(ws + WS_H8 + (long)t * DM + c) = (unsigned)(q0 & 0xff) | ((unsigned)(q1 & 0xff) << 8) | ((unsigned)(q2 & 0xff) << 16) | ((unsigned)(q3 & 0xff) << 24); }
            if (lane == 0) ((float*)(ws + WS_SA8))[t] = am * (1.0f / 127.0f); }
    }
}

__device__ __forceinline__ void cache_convert(KParams& p, int l, char* lds, int it0, int it1, int bidx, int nb) {
    const int tid = otid(); unsigned char* ws = optr(gp(p.ws)); float* tile = (float*)lds; bf16_t* CKA = (bf16_t*)(ws + WS_CKA); bf16_t* CKT = (bf16_t*)(ws + WS_CKT);
    { const int NT_ = it1, G_ = nb; int it = it0 + bidx; float v[8];
      const float* cbase = gp(p.cache_ckv) + (long)l * DB * PAST * 512;
#define CC_SRC(itx) (cbase + (((long)((itx) >> 8)) * PAST + (((itx) >> 3) & 31) * 64) * 512 + ((itx) & 7) * 64)
      if (it < NT_) { const float* src = CC_SRC(it);
#pragma unroll
        for (int i = 0; i < 8; ++i) { const int idx = tid + 512 * i, r = idx >> 6, c = idx & 63; v[i] = src[(long)r * 512 + c]; } }
      while (it < NT_) { const int b = it >> 8, kt = (it >> 3) & 31, ct = it & 7; const int itn = it + G_; float vn[8];
        if (itn < NT_) { const float* src = CC_SRC(itn);
#pragma unroll
            for (int i = 0; i < 8; ++i) { const int idx = tid + 512 * i, r = idx >> 6, c = idx & 63; vn[i] = src[(long)r * 512 + c]; } }
#pragma unroll
        for (int i = 0; i < 8; ++i) { const int idx = tid + 512 * i, r = idx >> 6, c = idx & 63; tile[r * 65 + c] = v[i]; }
        __syncthreads();
        { const int r = tid >> 3, cc = (tid & 7) * 8; float f[8];
#pragma unroll
          for (int j = 0; j < 8; ++j) f[j] = tile[r * 65 + cc + j];
          *reinterpret_cast<u32x4*>(CKA + ((long)b * KPAD + kt * 64 + r) * QLD + ct * 64 + cc) = pack8(f);
#pragma unroll
          for (int j = 0; j < 8; ++j) f[j] = tile[(cc + j) * 65 + r];
          *reinterpret_cast<u32x4*>(CKT + ((long)b * 512 + ct * 64 + r) * KPAD + kt * 64 + cc) = pack8(f); }
        __syncthreads();
#pragma unroll
        for (int i = 0; i < 8; ++i) v[i] = vn[i];
        it = itn; }
#undef CC_SRC
    }
    for (long i = (long)it0 * 64 + (long)bidx * 512 + tid; i < (long)it1 * 64; i += (long)nb * 512) { const long row = i >> 3; const int ch = (int)(i & 7); const int b = (int)(row >> 11), k = (int)(row & 2047);
        const float* s = gp(p.cache_krope) + (((long)l * DB + b) * PAST + k) * 64 + ch * 8; float f[8];
#pragma unroll
        for (int j = 0; j < 8; ++j) f[j] = s[j];
        *reinterpret_cast<u32x4*>(CKA + ((long)b * KPAD + k) * QLD + 512 + ch * 8) = pack8(f); }
}

__device__ __forceinline__ void quant_row8(const float (&o)[8], unsigned char* dst, float* sc, int lane) {
    float am = 0.f;
#pragma unroll
    for (int j = 0; j < 8; ++j) am = fmaxf(am, fabsf(o[j]));
    am = wave_max(am); const float qs = am > 0.f ? 127.0f / am : 0.f; unsigned w2[2];
#pragma unroll
    for (int hh = 0; hh < 2; ++hh) { unsigned w = 0u;
#pragma unroll
        for (int i = 0; i < 4; ++i) w |= ((unsigned)((int)__builtin_rintf(o[4 * hh + i] * qs) & 0xff)) << (8 * i);
        w2[hh] = w; }
    *reinterpret_cast<u32x2*>(dst) = (u32x2){w2[0], w2[1]};
    if (lane == 0) *sc = am * (1.0f / 127.0f);
}
__device__ __forceinline__ void wu_int8(KParams& p, int l) {
    unsigned char* ws = optr(gp(p.ws)); const int lane = otid() & 63;
    for (int r = gwave(); r < 3072 + 4096; r += nwaves()) { const bool kv = r >= 3072; const int rr = kv ? r - 3072 : r;
        const bf16_t* src = kv ? (const bf16_t*)(ws + WS_WUKV) + ((long)l * 4096 + rr) * 512 : (const bf16_t*)(ws + WS_WUQ) + ((long)l * 3072 + rr) * 512;
        float f[8]; unpack8(*reinterpret_cast<const u32x4*>(src + 8 * lane), f);
        quant_row8(f, ws + (kv ? WS_WUKV8 : WS_WUQ8) + (long)rr * 512 + 8 * lane, (float*)(ws + (kv ? WS_SBK : WS_SBQ)) + rr, lane); }
}

__device__ __forceinline__ void post_win(KParams& p, int l) {
    const int lane = otid() & 63; unsigned char* ws = optr(gp(p.ws));
    bf16_t* Y = (bf16_t*)(ws + WS_Y); bf16_t* CQN = (bf16_t*)(ws + WS_CQN); bf16_t* CKVNP = (bf16_t*)(ws + WS_CKVNP); bf16_t* KRP = (bf16_t*)(ws + WS_KRP); bf16_t* CKA = (bf16_t*)(ws + WS_CKA); bf16_t* CKT = (bf16_t*)(ws + WS_CKT);
    const float* T64 = (const float*)(ws + WS_TAB64); const float* T128 = (const float*)(ws + WS_TAB128);
    for (int t = gwave(); t < T; t += nwaves()) {
        bf16_t* y = Y + (long)t * INWP; const int pos = tok_pos(t); const bool samp = t >= TP; const int ts = t - TP, b = ts >> 6, s = ts & 63;
        { float f[8], o[8]; unpack8(*reinterpret_cast<const u32x4*>(y + C_CQ + 8 * lane), f); float ss = 0.f;
#pragma unroll
          for (int j = 0; j < 8; ++j) ss += f[j] * f[j];
          ss = wave_sum(ss); const float rinv = rsqrtf(ss * (1.0f / 512.f) + EPS); const float* g = gp(p.g_q) + (long)l * 512 + 8 * lane;
#pragma unroll
          for (int j = 0; j < 8; ++j) o[j] = f[j] * rinv * g[j];
          quant_row8(o, (unsigned char*)CQN + (long)t * 512 + 8 * lane, (float*)(ws + WS_SAQ) + t, lane); }
        { float f[8], o[8]; unpack8(*reinterpret_cast<const u32x4*>(y + C_CKV + 8 * lane), f); float ss = 0.f;
#pragma unroll
          for (int j = 0; j < 8; ++j) ss += f[j] * f[j];
          ss = wave_sum(ss); const float rinv = rsqrtf(ss * (1.0f / 512.f) + EPS); const float* g = gp(p.g_kv) + (long)l * 512 + 8 * lane;
#pragma unroll
          for (int j = 0; j < 8; ++j) o[j] = f[j] * rinv * g[j];
          float* od = gp(p.out) + (samp ? O_CKVS + ((long)l * TS + ts) * 512 : O_CKVP + ((long)l * TP + t) * 512) + 8 * lane;
          *reinterpret_cast<f32x4*>(od) = (f32x4){o[0], o[1], o[2], o[3]}; *reinterpret_cast<f32x4*>(od + 4) = (f32x4){o[4], o[5], o[6], o[7]};
          const u32x4 w = pack8(o);
          if (!samp) quant_row8(o, (unsigned char*)CKVNP + (long)t * 512 + 8 * lane, (float*)(ws + WS_SAK) + t, lane);
          else { *reinterpret_cast<u32x4*>(CKA + ((long)b * KPAD + PAST + s) * QLD + 8 * lane) = w;
#pragma unroll
              for (int j = 0; j < 8; ++j) CKT[((long)b * 512 + 8 * lane + j) * KPAD + PAST + s] = f2bf(o[j]); } }
        if (lane < 32) { const float x1 = bf2f(y[C_KR + lane]), x2 = bf2f(y[C_KR + 32 + lane]); const float c = T64[((long)pos * 32 + lane) * 2], sn = T64[((long)pos * 32 + lane) * 2 + 1];
            const float o1 = x1 * c - x2 * sn, o2 = x1 * sn + x2 * c;
            float* od = gp(p.out) + (samp ? O_KRS + ((long)l * TS + ts) * 64 : O_KRP + ((long)l * TP + t) * 64); od[lane] = o1; od[32 + lane] = o2;
            if (!samp) { KRP[(long)t * 64 + lane] = f2bf(o1); KRP[(long)t * 64 + 32 + lane] = f2bf(o2); }
            else { bf16_t* d = CKA + ((long)b * KPAD + PAST + s) * QLD + 512; d[lane] = f2bf(o1); d[32 + lane] = f2bf(o2); } }
        { const int hh = lane >> 3, d0 = (lane & 7) * 8; const float* cs = T128 + ((long)pos * 64 + d0) * 2; float cv[8], sv[8];
#pragma unroll
          for (int j = 0; j < 4; ++j) { const f32x4 q = *reinterpret_cast<const f32x4*>(cs + 4 * j); cv[2 * j] = q[0]; sv[2 * j] = q[1]; cv[2 * j + 1] = q[2]; sv[2 * j + 1] = q[3]; }
#pragma unroll
          for (int which = 0; which < 2; ++which) { bf16_t* base = y + (which ? C_RK : C_RQ) + hh * 128 + d0; const float sca = which ? 0.08838834764831845f : 1.0f;
              float a[8], bq[8], o1[8], o2[8]; unpack8(*reinterpret_cast<const u32x4*>(base), a); unpack8(*reinterpret_cast<const u32x4*>(base + 64), bq);
#pragma unroll
              for (int j = 0; j < 8; ++j) { o1[j] = (a[j] * cv[j] - bq[j] * sv[j]) * sca; o2[j] = (a[j] * sv[j] + bq[j] * cv[j]) * sca; }
              *reinterpret_cast<u32x4*>(base) = pack8(o1); *reinterpret_cast<u32x4*>(base + 64) = pack8(o2); } }
    }
}

__device__ __forceinline__ void post_q(KParams& p) {
    const int lane = otid() & 63; unsigned char* ws = optr(gp(p.ws)); bf16_t* Q = (bf16_t*)(ws + WS_Q); bf16_t* QL = (bf16_t*)(ws + WS_QL); const float* T64 = (const float*)(ws + WS_TAB64);
    for (int t = gwave(); t < T; t += nwaves()) { const int pos = tok_pos(t); const int hd = lane >> 2, d0 = (lane & 3) * 8;
        bf16_t* base = Q + (long)t * 3072 + hd * 192 + 128 + d0; const float* cs = T64 + ((long)pos * 32 + d0) * 2; float cv[8], sv[8];
#pragma unroll
        for (int j = 0; j < 4; ++j) { const f32x4 q = *reinterpret_cast<const f32x4*>(cs + 4 * j); cv[2 * j] = q[0]; sv[2 * j] = q[1]; cv[2 * j + 1] = q[2]; sv[2 * j + 1] = q[3]; }
        float a[8], bq[8], o1[8], o2[8]; unpack8(*reinterpret_cast<const u32x4*>(base), a); unpack8(*reinterpret_cast<const u32x4*>(base + 32), bq);
#pragma unroll
        for (int j = 0; j < 8; ++j) { o1[j] = a[j] * cv[j] - bq[j] * sv[j]; o2[j] = a[j] * sv[j] + bq[j] * cv[j]; }
        const u32x4 w1 = pack8(o1), w2 = pack8(o2);
        *reinterpret_cast<u32x4*>(base) = w1; *reinterpret_cast<u32x4*>(base + 32) = w2;
        if (t >= TP) { const int ts = t - TP, b = ts >> 6, s = ts & 63; bf16_t* d = QL + ((long)b * 1024 + hd * 64 + s) * QLD + 512 + d0;
            *reinterpret_cast<u32x4*>(d) = w1; *reinterpret_cast<u32x4*>(d + 32) = w2; } }
}

__device__ __forceinline__ void softmax_rows(KParams& p) {
    const int lane = otid() & 63; unsigned char* ws = optr(gp(p.ws)); bf16_t* SP = (bf16_t*)(ws + WS_SP);
    for (int r = gwave(); r < DB * 1024; r += nwaves()) { bf16_t* row = SP + (long)r * KPAD; float v[5][8]; float mx = -3.0e38f;
#pragma unroll
        for (int j = 0; j < 5; ++j) { const int ch = lane + 64 * j;
            if (ch < KALL / 8) { unpack8(*reinterpret_cast<const u32x4*>(row + ch * 8), v[j]);
#pragma unroll
                for (int i = 0; i < 8; ++i) { v[j][i] *= MLA_SCALE; mx = fmaxf(mx, v[j][i]); } }
            else {
#pragma unroll
                for (int i = 0; i < 8; ++i) v[j][i] = -3.0e38f; } }
        mx = wave_max(mx); float sum = 0.f;
#pragma unroll
        for (int j = 0; j < 5; ++j) { const int ch = lane + 64 * j;
#pragma unroll
            for (int i = 0; i < 8; ++i) { v[j][i] = (ch < KALL / 8) ? __expf(v[j][i] - mx) : 0.f; sum += v[j][i]; } }
        sum = wave_sum(sum); const float inv = 1.0f / sum;
#pragma unroll
        for (int j = 0; j < 5; ++j) { const int ch = lane + 64 * j;
            if (ch < KPAD / 8) { float o[8];
#pragma unroll
                for (int i = 0; i < 8; ++i) o[i] = v[j][i] * inv;
                *reinterpret_cast<u32x4*>(row + ch * 8) = pack8(o); } } }
}

__device__ __forceinline__ void gnorm_gate(KParams& p, int w0, int nw) {
    const int lane = otid() & 63; unsigned char* ws = optr(gp(p.ws)); const bf16_t* OB = (const bf16_t*)(ws + WS_OB); const bf16_t* Y = (const bf16_t*)(ws + WS_Y);
    for (int t = w0; t < T; t += nw) { const int c0 = (lane >> 3) * 256 + (lane & 7) * 32; float x[4][8]; float s = 0.f;
#pragma unroll
        for (int i = 0; i < 4; ++i) { unpack8(*reinterpret_cast<const u32x4*>(OB + ((long)lane * T + t) * 32 + 8 * i), x[i]);
#pragma unroll
            for (int j = 0; j < 8; ++j) s += x[i][j]; }
        s += sx<1>(s); s += sx<2>(s); s += sx<4>(s); const float mu = s * (1.0f / 256.f); float q = 0.f;
#pragma unroll
        for (int i = 0; i < 4; ++i)
#pragma unroll
            for (int j = 0; j < 8; ++j) { const float d = x[i][j] - mu; q += d * d; }
        q += sx<1>(q); q += sx<2>(q); q += sx<4>(q); const float rstd = rsqrtf(q * (1.0f / 256.f) + EPS);
        float am = 0.f;
#pragma unroll
        for (int i = 0; i < 4; ++i) { float g[8]; unpack8(*reinterpret_cast<const u32x4*>(Y + (long)t * INWP + C_RG + c0 + 8 * i), g);
#pragma unroll
            for (int j = 0; j < 8; ++j) { x[i][j] = siluf_(g[j]) * (x[i][j] - mu) * rstd; am = fmaxf(am, fabsf(x[i][j])); } }
        am = wave_max(am); const float qs = am > 0.f ? 127.0f / am : 0.f; unsigned w[8];
#pragma unroll
        for (int i = 0; i < 4; ++i)
#pragma unroll
            for (int hh = 0; hh < 2; ++hh) { unsigned v = 0u;
#pragma unroll
                for (int j = 0; j < 4; ++j) v |= ((unsigned)((int)__builtin_rintf(x[i][4 * hh + j] * qs) & 0xff)) << (8 * j);
                w[2 * i + hh] = v; }
        *reinterpret_cast<u32x4*>(ws + WS_BG + (long)t * DM + c0) = (u32x4){w[0], w[1], w[2], w[3]};
        *reinterpret_cast<u32x4*>(ws + WS_BG + (long)t * DM + c0 + 16) = (u32x4){w[4], w[5], w[6], w[7]};
        if (lane == 0) ((float*)(ws + WS_SA8))[t] = am * (1.0f / 127.0f); }
}

__device__ __forceinline__ void peer_convert(KParams& p, int l, int r0, int r1, int w0, int nw) {
    unsigned char* ws = optr(gp(p.ws)); const int lane = otid() & 63;
    const float* su = gp(p.peer_u) + (long)l * NEXP * DM; const float* sv = gp(p.peer_v) + (long)l * NEXP * DM;
    for (int r = r0 + w0; r < r1; r += nw) { const bool second = r >= NEXP; const int row = second ? r - NEXP : r; const float* s = (second ? sv : su) + (long)row * DM;
        f32x4 v[8]; float am = 0.f;
#pragma unroll
        for (int j = 0; j < 8; ++j) { v[j] = *reinterpret_cast<const f32x4*>(s + 512 * (j >> 2) * 2 + 16 * lane + 4 * (j & 3));
            am = fmaxf(am, fmaxf(fmaxf(fabsf(v[j][0]), fabsf(v[j][1])), fmaxf(fabsf(v[j][2]), fabsf(v[j][3])))); }
        am = wave_max(am);
        float sc = 1.0f, isc = 1.0f;
        if (am > 0.f) { const int e = (int)((__float_as_uint(am) >> 23) & 0xffu) - 127;
            int k = 7 - e; k = k > 100 ? 100 : (k < -100 ? -100 : k);
            sc = __uint_as_float((unsigned)(127 + k) << 23); isc = __uint_as_float((unsigned)(127 - k) << 23); }
        unsigned w[8];
#pragma unroll
        for (int j = 0; j < 8; ++j) { int pk = __builtin_amdgcn_cvt_pk_fp8_f32(v[j][0] * sc, v[j][1] * sc, 0, false); pk = __builtin_amdgcn_cvt_pk_fp8_f32(v[j][2] * sc, v[j][3] * sc, pk, true); w[j] = (unsigned)pk; }
        if (!second) {
            unsigned char* dst = ws + WS_PU + ((long)(lane >> 3) * NEXP + row) * 128 + 16 * (lane & 7);
            *reinterpret_cast<u32x4*>(dst) = (u32x4){w[0], w[1], w[2], w[3]};
            *reinterpret_cast<u32x4*>(dst + 8L * NEXP * 128) = (u32x4){w[4], w[5], w[6], w[7]};
        } else {
            unsigned char* dst = ws + WS_PV + ((long)(2 * lane) * NEXP + row) * 8;
            *reinterpret_cast<u32x2*>(dst) = (u32x2){w[0], w[1]}; *reinterpret_cast<u32x2*>(dst + (long)NEXP * 8) = (u32x2){w[2], w[3]};
            *reinterpret_cast<u32x2*>(dst + 128L * NEXP * 8) = (u32x2){w[4], w[5]}; *reinterpret_cast<u32x2*>(dst + 129L * NEXP * 8) = (u32x2){w[6], w[7]}; }
        if (lane == 0) ((float*)(ws + (second ? WS_PSV : WS_PSU)))[row] = isc; }
}

__device__ __forceinline__ void final_norm(KParams& p) {
    const int lane = otid() & 63; float* X = gp(p.out);
    for (int t = gwave(); t < T; t += nwaves()) { float* xr = X + (long)t * DM; f32x4 v[8]; float ss = 0.f;
#pragma unroll
        for (int j = 0; j < 8; ++j) { v[j] = *reinterpret_cast<const f32x4*>(xr + 256 * j + 4 * lane); ss += v[j][0] * v[j][0] + v[j][1] * v[j][1] + v[j][2] * v[j][2] + v[j][3] * v[j][3]; }
        ss = wave_sum(ss); const float rinv = rsqrtf(ss * (1.0f / DM) + EPS);
#pragma unroll
        for (int j = 0; j < 8; ++j) { const int c = 256 * j + 4 * lane; const f32x4 gv = *reinterpret_cast<const f32x4*>(gp(p.g_final) + c); *reinterpret_cast<f32x4*>(xr + c) = v[j] * rinv * gv; } }
}
}
__global__ void __launch_bounds__(512, 2) mega_fwd(Params p_by_value_unused) {
    extern __shared__ __attribute__((aligned(16))) unsigned char shm[];
    LAS unsigned char* lds = (LAS unsigned char*)shm; char* ldsg = (char*)shm;
    if (threadIdx.x < 8) ((LAS unsigned*)(lds + LDS_BARW))[threadIdx.x] = 0u;
    __syncthreads();
    if (threadIdx.x == 0) { unsigned* tk = (unsigned*)(gp(KP.ws) + WS_CTL + CTL_RANK) + 64 * xb_xcc_id(); ((volatile LAS unsigned*)(lds + LDS_BARW))[2] = xb_add(tk, 1u); }
    const XcdBarrier bar = xcd_barrier_post((unsigned*)(gp(KP.ws) + WS_CTL), (volatile LAS unsigned*)(lds + LDS_BARW));
#define GRID_SYNC() xcd_barrier(bar)
#ifndef STOP_AT
#define STOP_AT 0
#endif
#ifdef DBG_DUMP
#define STOPCHK(n) do { if (STOP_AT == (n)) { float* xo = gp(KP.out); const bf16_t* src = (const bf16_t*)(gp(KP.ws) + DBG_DUMP); for (long i = ph::gthread(); i < (long)T * DM; i += ph::nthreads()) xo[i] = bf2f(src[i]); return; } } while (0)
#elif defined(DBG_SANITIZE)
#define STOPCHK(n) do { if (STOP_AT == (n) || (STOP_AT > 100 && l == 1 && STOP_AT - 100 == (n))) { float* xo = gp(KP.out); for (long i = ph::gthread(); i < (long)T * DM; i += ph::nthreads()) { const float v = xo[i]; if (!(v - v == 0.0f)) xo[i] = 7.0f; } return; } } while (0)
#else
#define STOPCHK(n) do { if (STOP_AT == (n) || (STOP_AT > 100 && l == 1 && STOP_AT - 100 == (n))) return; } while (0)
#endif
    using namespace pg8;
#define WSP(off) ((bf16_t*)(optr(gp(KP.ws)) + (off)))
#define H WSP(WS_H)
#define Y WSP(WS_Y)
#define CQN WSP(WS_CQN)
#define CKVNP WSP(WS_CKVNP)
#define KRP WSP(WS_KRP)
#define Q WSP(WS_Q)
#define YA WSP(WS_YA)
#define KV WSP(WS_KV)
#define SP WSP(WS_SP)
#define MIX WSP(WS_MIX)
#define OA WSP(WS_OA)
#define QP WSP(WS_QP)
#define CKA WSP(WS_CKA)
#define CKT WSP(WS_CKT)
#define QL WSP(WS_QL)
#define OL WSP(WS_OL)
#define BG WSP(WS_BG)
    int l = 0;
    ph::prologue(KP, ldsg);
#ifdef DUP_PRO
    ph::prologue(KP, ldsg);
#endif
    GRID_SYNC(); STOPCHK(1);
    if (threadIdx.x == 0) { unsigned* barw = (unsigned*)(gp(KP.ws) + WS_CTL); const unsigned me = xb_xcc_id(); unsigned nx = 0, xi = 0, nloc = 1;
        for (unsigned j = 0; j < 16; ++j) { const unsigned cn = xb_ld(&barw[XB_XCNT(j)]); if (cn) { if (j < me) ++xi; ++nx; } if (j == me) nloc = cn ? cn : 1u; }
        volatile LAS unsigned* iw = (volatile LAS unsigned*)(lds + LDS_BARW); iw[3] = xi; iw[4] = nx; iw[5] = nloc; }
    __syncthreads();
    ph::ada_reduce(KP);
    ph::wpq_int8(KP);
    GRID_SYNC(); STOPCHK(2);
    for (l = 0; l < DEPTH; ++l) {
#define WIN (WSP(WS_WIN) + (long)l * INWP * DM)
#define WUQ (WSP(WS_WUQ) + (long)l * 3072 * 512)
#define WUKV (WSP(WS_WUKV) + (long)l * 4096 * 512)
#define WUK (WSP(WS_WUK) + (long)l * 16 * 512 * 256)
#define WA (WSP(WS_WA) + (long)l * DM * DM)
#define WB (WSP(WS_WB) + (long)l * DM * DM)
#define WO (WSP(WS_WO) + (long)l * DM * DM)
#define WPQ (WSP(WS_WPQ) + (long)l * DM * DM)
#define ADA ((const float*)(optr(gp(KP.ws)) + WS_ADA) + (long)l * NCOND * 12288)
        ph::modulate(KP, l, 0);
        ph::win_int8(KP, l);
        ph::wb_int8(KP, l);
        ph::wu_int8(KP, l);
        ph::cache_convert(KP, l, ldsg, l == 0 ? 0 : 4096, 8192, obid(), ogrid());
        GRID_SYNC(); STOPCHK(3);
        { Sched<5> S; S.init(T / 256, INWP / 256 - NB8, (T / 256) * (INWP / 256 - NB8), DM, DM); gemm_phase(lds, Gemm{H, WIN, DM, DM, DM}, S, EpiBf16{Y, INWP, 0}); }
        { Sched<6> S; S.init(T / 256, NB8, (T / 256) * NB8, DM / 2, DM / 2);
          { const int G_ = ogrid(); S.rotate((((((T / 256) * NB8) % G_) + 7) & ~7) % G_); }
          unsigned char* ws8 = optr(gp(KP.ws));
          gemm_phase<EpiQ8, Sched<6>, true>(lds, Gemm{(const bf16_t*)(ws8 + WS_H8), (const bf16_t*)(ws8 + WS_WIN8), DM / 2, DM / 2, DM / 2}, S, EpiQ8{Y, INWP, (const float*)(ws8 + WS_SA8), (const float*)(ws8 + WS_SBW)}); }
#ifdef DUP_WIN
        { Sched<0> S; S.init(T / 256, INWP / 256, (T / 256) * (INWP / 256), DM, DM); gemm_phase(lds, Gemm{H, WIN, DM, DM, DM}, S, EpiBf16{Y, INWP, 0}); }
#endif
        GRID_SYNC(); STOPCHK(4);
        ph::post_win(KP, l);
        GRID_SYNC(); STOPCHK(5);
        { unsigned char* ws8 = optr(gp(KP.ws));
          { Sched<0> S; S.init(T / 256, 3072 / 256, (T / 256) * 12, 256, 256); gemm_phase<EpiQ, Sched<0>, 2>(lds, Gemm{CQN, (const bf16_t*)(ws8 + WS_WUQ8), 256, 256, 256, (const float*)(ws8 + WS_SAQ), (const float*)(ws8 + WS_SBQ)}, S, EpiQ{Q, QL, (const float*)(ws8 + WS_TAB64)}); }
          { Sched<0> S; S.init(TP / 256, 4096 / 256, (TP / 256) * 16, 256, 256); gemm_phase<EpiBf16, Sched<0>, 2>(lds, Gemm{CKVNP, (const bf16_t*)(ws8 + WS_WUKV8), 256, 256, 256, (const float*)(ws8 + WS_SAK), (const float*)(ws8 + WS_SBK)}, S, EpiBf16{KV, 4096, 0}); } }
        GRID_SYNC(); STOPCHK(6);
#ifndef DUP_ATTN
#define DUP_ATTN 1
#endif
#ifndef DUP_RET
#define DUP_RET 1
#endif
#ifndef DUP_GATHER
#define DUP_GATHER 0
#endif
#pragma unroll 1
        for (int rep_ = 0; rep_ < DUP_ATTN; ++rep_)
        { for (int u = obid(); u < 512; u += ogrid()) { const int c = u & 255, i = u >> 8, xcd = c & 7, slot = c >> 3; const int bh = xcd * 4 + (slot >> 3) + 32 * i, pr = slot & 7, b = bh >> 4, h = bh & 15;
#pragma unroll 1
              for (int z = 0; z < 2; ++z) { const int qb = z ? 15 - pr : pr; const long tok0 = (long)b * SEQ + 256 * qb;
                  att::attn_block(Q + tok0 * 3072 + h * 192, KV + (long)b * SEQ * 4096 + h * 256, KRP + (long)b * SEQ * 64, KV + (long)b * SEQ * 4096 + h * 256 + 128, OA + tok0 * DM + h * 128, qb, ldsg); } } }
        { Sched<1> S; S.init(0, 0, 256, 3072, 256); gemm_phase(lds, Gemm{Q, WUK, 256, 3072, 256}, S, EpiRowMap<1>{QL, nullptr}); }
        GRID_SYNC(); STOPCHK(8);
        { Sched<2> S; S.init(0, 0, DB * 36, QLD, QLD); gemm_phase(lds, Gemm{QL, CKA, QLD, QLD, QLD}, S, EpiExp{SP, (float*)(optr(gp(KP.ws)) + WS_CTL + CTL_RSUM) + (long)l * 32768}); }
        GRID_SYNC(); STOPCHK(9);
        { Sched<3> S; S.init(0, 0, 256, KPAD, KPAD); gemm_phase(lds, Gemm{SP, CKT, 2176, KPAD, KPAD}, S, EpiRowMap<3>{OL, (const float*)(optr(gp(KP.ws)) + WS_CTL + CTL_RSUM) + (long)l * 32768}); }
        GRID_SYNC(); STOPCHK(11);
        { Sched<4> S; S.init(0, 0, 128, 512, 512); gemm_phase(lds, Gemm{OL, WUKV, 512, 512, 512}, S, EpiOV{OA}); }
#pragma unroll 1
        for (int rep_ = 0; rep_ < DUP_RET; ++rep_)
        for (int u = obid(); u < 256 + DB * 64; u += ogrid()) ret::unit(KP, l, u, ldsg);
#ifdef DUP_RETP
        for (int u = obid(); u < 256; u += ogrid()) ret::unit(KP, l, u, ldsg);
#endif
        GRID_SYNC(); STOPCHK(12);
        { Sched<0> S; S.init(T / 256, DM / 256, (T / 256) * 8, DM, DM); gemm_phase(lds, Gemm{OA, WA, DM, DM, DM}, S, EpiBf16{YA, DM, 0}); }
        { const int G_ = ogrid(), rem_ = ((T / 256) * 8) % G_; const int b_ = obid();
          if (rem_ == 0) ph::gnorm_gate(KP, ph::gwave(), ph::nwaves());
          else if (b_ >= rem_) ph::gnorm_gate(KP, (b_ - rem_) * 8 + (otid() >> 6), (G_ - rem_) * 8); }
#ifdef DUP_WA
#pragma unroll 1
        for (int rep_ = 0; rep_ < DUP_WA; ++rep_)
        { Sched<0> S; S.init(T / 256, DM / 256, (T / 256) * 8, DM, DM); gemm_phase(lds, Gemm{OA, WA, DM, DM, DM}, S, EpiBf16{YA, DM, 0}); }
#endif
        GRID_SYNC(); STOPCHK(14);
        { Sched<0> S; S.init(T / 256, DM / 256, (T / 256) * 8, DM / 2, DM / 2); unsigned char* ws8 = optr(gp(KP.ws));
          gemm_phase<EpiMix, Sched<0>, true>(lds, Gemm{(const bf16_t*)(ws8 + WS_BG), (const bf16_t*)(ws8 + WS_WB8), DM / 2, DM / 2, DM / 2}, S, EpiMix{Y, YA, MIX, (const float*)(ws8 + WS_SA8), (const float*)(ws8 + WS_SBB)}); }
        { const int G_ = ogrid(), rem_ = ((T / 256) * 8) % G_; const int b_ = obid();
          if (rem_ == 0) ph::peer_convert(KP, l, 0, NEXP, ph::gwave(), ph::nwaves());
          else if (b_ >= rem_) ph::peer_convert(KP, l, 0, NEXP, (b_ - rem_) * 8 + (otid() >> 6), (G_ - rem_) * 8); }
        GRID_SYNC(); STOPCHK(15);
        { Sched<0> S; S.init(T / 256, DM / 256, (T / 256) * 8, DM, DM); gemm_phase(lds, Gemm{MIX, WO, DM, DM, DM}, S, EpiRes{gp(KP.out), ADA + 2 * DM, l == 0 ? gp(KP.x_prompt) : gp(KP.out), l == 0 ? gp(KP.x_sample) : gp(KP.out) + (long)TP * DM}); }
        { const int G_ = ogrid(), rem_ = ((T / 256) * 8) % G_; const int b_ = obid();
          if (rem_ == 0) ph::peer_convert(KP, l, NEXP, 2 * NEXP, ph::gwave(), ph::nwaves());
          else if (b_ >= rem_) ph::peer_convert(KP, l, NEXP, 2 * NEXP, (b_ - rem_) * 8 + (otid() >> 6), (G_ - rem_) * 8); }
        GRID_SYNC(); STOPCHK(16);
        ph::modulate(KP, l, 1);
        GRID_SYNC(); STOPCHK(17);
        { Sched<0> S; S.init(T / 256, DM / 256, (T / 256) * 8, DM / 2, DM / 2);
          unsigned char* ws8 = optr(gp(KP.ws));
          gemm_phase<EpiQ8, Sched<0>, true>(lds, Gemm{(const bf16_t*)(ws8 + WS_H8), (const bf16_t*)(ws8 + WS_WPQ8 + (long)l * DM * DM), DM / 2, DM / 2, DM / 2}, S, EpiQ8{QP, DM, (const float*)(ws8 + WS_SA8), (const float*)(ws8 + WS_SB8) + (long)l * DM});
#ifdef DUP_WPQ
          gemm_phase<EpiQ8, Sched<0>, true>(lds, Gemm{(const bf16_t*)(ws8 + WS_H8), (const bf16_t*)(ws8 + WS_WPQ8 + (long)l * DM * DM), DM / 2, DM / 2, DM / 2}, S, EpiQ8{QP, DM, (const float*)(ws8 + WS_SA8), (const float*)(ws8 + WS_SB8) + (long)l * DM});
#endif
        }
        if (l + 1 < DEPTH) { const int G_ = ogrid(), rem_ = ((T / 256) * 8) % G_; const int b_ = obid();
          if (rem_ == 0) ph::cache_convert(KP, l + 1, ldsg, 0, 4096, b_, G_);
          else if (b_ >= rem_) ph::cache_convert(KP, l + 1, ldsg, 0, 4096, b_ - rem_, G_ - rem_); }
        GRID_SYNC(); STOPCHK(18);
        { const int tid_ = otid(); const int lane = tid_ & 63; float* strip = (float*)ldsg + tid_ * 33; unsigned char* ws = optr(gp(KP.ws));
          const bf16_t* k1g = (const bf16_t*)(ws + WS_PK1) + (long)l * 128 * 128; const bf16_t* k2g = (const bf16_t*)(ws + WS_PK2) + (long)l * 128 * 128;
          bf16_t* k1 = (bf16_t*)(ldsg + 512 * 33 * 4 + 64); bf16_t* k2 = k1 + 128 * peer::KPITCH;
          for (int i = tid_; i < 2 * 128 * 16; i += 512) { const int which = i >> 11, r = (i >> 4) & 127, ch = i & 15;
              *reinterpret_cast<u32x4*>((which ? k2 : k1) + r * peer::KPITCH + ch * 8) = *reinterpret_cast<const u32x4*>((which ? k2g : k1g) + r * 128 + ch * 8); }
          __syncthreads();
          for (int wu = ph::gwave(); wu < (T / 32) * PH; wu += ph::nwaves()) peer::select_unit(QP, k1, k2, (int*)(ws + WS_PIDX), (float*)(ws + WS_PW), (wu >> 3) * 32, wu & 7, lane, strip);
#ifdef DUP_SEL
          for (int wu = ph::gwave(); wu < (T / 32) * PH; wu += ph::nwaves()) peer::select_unit(QP, k1, k2, (int*)(ws + WS_PIDX), (float*)(ws + WS_PW), (wu >> 3) * 32, wu & 7, lane, strip);
#endif
        }
        GRID_SYNC(); STOPCHK(19);
        { const int tid_ = otid(); const int lane = tid_ & 63, wid = tid_ >> 6; unsigned char* ws = optr(gp(KP.ws));
          volatile LAS unsigned* iw = (volatile LAS unsigned*)(lds + LDS_BARW); peer::XInfo xin; xin.rank = __builtin_amdgcn_readfirstlane((int)iw[2]); xin.xi = __builtin_amdgcn_readfirstlane((int)iw[3]); xin.nx = __builtin_amdgcn_readfirstlane((int)iw[4]); xin.nloc = __builtin_amdgcn_readfirstlane((int)iw[5]);
          if (xin.nx >= 1 && xin.nx <= 8) {
              peer::upass(H, (const unsigned char*)(ws + WS_PU), (const int*)(ws + WS_PIDX), (const float*)(ws + WS_PW), (const float*)(ws + WS_PSU), (const float*)(ws + WS_PSV), (float*)(ws + WS_DOTP), (unsigned*)(ws + WS_ACT), xin, wid, lane);
              GRID_SYNC();
              int vs0_, vsn_, vse_;
              if ((256 % xin.nx) == 0) { const int spx = 256 / xin.nx; vs0_ = xin.xi * spx + xin.rank; vsn_ = xin.nloc; vse_ = (xin.xi + 1) * spx; }
              else { vs0_ = obid(); vsn_ = ogrid(); vse_ = 256; }
              peer::vpass_lds((const unsigned char*)(ws + WS_PV), (const unsigned*)(ws + WS_ACT), gp(KP.out), ADA + 5 * DM, ldsg, vs0_, vsn_, vse_, tid_);
#ifdef DUP_VP
              peer::vpass_lds((const unsigned char*)(ws + WS_PV), (const unsigned*)(ws + WS_ACT), (float*)(ws + WS_OB), ADA + 5 * DM, ldsg, vs0_, vsn_, vse_, tid_);
#endif
          } else {
              for (int t = ph::gwave(); t < T; t += ph::nwaves()) peer::gather_token(H, (const unsigned char*)(ws + WS_PU), (const unsigned char*)(ws + WS_PV), (const float*)(ws + WS_PSU), (const float*)(ws + WS_PSV), (const int*)(ws + WS_PIDX), (const float*)(ws + WS_PW), gp(KP.out), ADA + 5 * DM, t, lane);
          } }
        GRID_SYNC(); STOPCHK(20);
    }
    ph::final_norm(KP);
}

extern "C" void kernel_launch(void* const* d_in, const int* in_sizes, int n_in, void* d_out, int out_size, void* d_ws, size_t ws_size, hipStream_t stream) {
    static int grid = 0;
    if (grid == 0) {
        if (n_in != 25 || out_size != (int)O_END || ws_size < WS_END) { fprintf(stderr, "kernel_launch: shape mismatch: n_in %d out %d (want %ld) ws %zu (want >= %zu)\n", n_in, out_size, O_END, ws_size, (size_t)WS_END); grid = -1; return; }
        int dev = 0, cus = 0, per_cu = 0;
        if (hipGetDevice(&dev) != hipSuccess || hipDeviceGetAttribute(&cus, hipDeviceAttributeMultiprocessorCount, dev) != hipSuccess) { fprintf(stderr, "kernel_launch: device query failed\n"); grid = -1; return; }
        if (hipFuncSetAttribute((const void*)mega_fwd, hipFuncAttributeMaxDynamicSharedMemorySize, LDS_BYTES) != hipSuccess) { fprintf(stderr, "kernel_launch: hipFuncSetAttribute failed\n"); grid = -1; return; }
        if (hipOccupancyMaxActiveBlocksPerMultiprocessor(&per_cu, (const void*)mega_fwd, 512, LDS_BYTES) != hipSuccess || per_cu < 1) { fprintf(stderr, "kernel_launch: occupancy query says %d blocks per CU\n", per_cu); grid = -1; return; }
        grid = cus;
#ifdef FORCE_GRID
        grid = FORCE_GRID;
#endif
    }
    if (grid < 0) return;
    (void)hipMemsetAsync((char*)d_ws + WS_CTL, 0, CTL_BYTES, stream);
    Params p{};
    const float* const* in = (const float* const*)d_in;
    p.x_prompt = in[0]; p.x_sample = in[1]; p.c_prompt = in[2]; p.c_sample = in[3]; p.cache_ckv = in[4]; p.cache_krope = in[5]; p.state_ret = in[6]; p.w_ada = in[7]; p.b_ada = in[8];
    p.g_mix = in[9]; p.g_ffn = in[10]; p.w_in = in[11]; p.g_q = in[12]; p.w_uq = in[13]; p.g_kv = in[14]; p.w_ukv = in[15]; p.w_a = in[16]; p.w_b = in[17]; p.w_o = in[18]; p.w_pq = in[19];
    p.peer_k1 = in[20]; p.peer_k2 = in[21]; p.peer_u = in[22]; p.peer_v = in[23]; p.g_final = in[24];
    p.out = (float*)d_out; p.ws = (unsigned char*)d_ws;
    for (int h = 0; h < 8; ++h) p.lg[h] = (float)log1p(-pow(2.0, -5.0 - (double)h));
    p.grid = grid; p.pad_ = 0;
    hipLaunchKernelGGL(mega_fwd, dim3(grid), dim3(512), LDS_BYTES, stream, p);
    const hipError_t le = hipGetLastError();
    if (le != hipSuccess) fprintf(stderr, "kernel_launch: launch failed: %s\n", hipGetErrorName(le));
}
```

```cpp
#include <hip/hip_runtime.h>
#include <cstdio>
#include <cstdint>
#include <cmath>

#define LAS __attribute__((address_space(3)))
typedef unsigned short bf16_t;
typedef short bf16x8 __attribute__((ext_vector_type(8)));
typedef float f32x4 __attribute__((ext_vector_type(4)));
typedef float f32x2 __attribute__((ext_vector_type(2)));
typedef float f32x16 __attribute__((ext_vector_type(16)));
typedef unsigned u32x4 __attribute__((ext_vector_type(4)));
typedef unsigned u32x2 __attribute__((ext_vector_type(2)));
typedef short s16x4 __attribute__((ext_vector_type(4)));
typedef int i32x4 __attribute__((ext_vector_type(4)));

constexpr int DM = 2048, NB = 4, SEQ = 4096, DEPTH = 2, DB = 32, DS = 64, PAST = 2048;
constexpr int TP = NB * SEQ, TS = DB * DS, T = TP + TS;
constexpr int NCOND = NB + DB;
constexpr int QLORA = 512, KVLORA = 512, ROPE = 64, NOPE = 128, VD = 128, MH = 16, QKD = 192;
constexpr int RH = 8, RQK = 128, RV = 256;
constexpr int PH = 8, NKEYS = 128, NEXP = 16384, PTOPK = 16;
constexpr int INW = 11328, INWP = 11520;
constexpr int C_CQ = 0, C_CKV = 512, C_KR = 1024, C_RQ = 1088, C_RK = 2112, C_RV = 3136, C_RG = 5184, C_GA = 7232, C_GB = 9280;
constexpr int KALL = PAST + DS;
constexpr int KPAD = 2304;
constexpr int QLD = 640;
constexpr float EPS = 1e-6f;
constexpr float MLA_SCALE = 0.07216878364870322f;

constexpr long O_Y = 0;
constexpr long O_CKVP = (long)T * DM;
constexpr long O_KRP = O_CKVP + 2L * TP * 512;
constexpr long O_RETP = O_KRP + 2L * TP * 64;
constexpr long O_CKVS = O_RETP + 2L * NB * RH * RQK * RV;
constexpr long O_KRS = O_CKVS + 2L * TS * 512;
constexpr long O_RETS = O_KRS + 2L * TS * 64;
constexpr long O_END = O_RETS + 2L * DB * RH * RQK * RV;

constexpr size_t al256(size_t x) { return (x + 255) / 256 * 256; }
constexpr size_t WS_CTL = 0;
constexpr size_t CTL_BYTES = 65536 + 2UL * 32768 * 4;
constexpr size_t CTL_RSUM = 65536;
constexpr size_t WS_TAB64 = WS_CTL + CTL_BYTES;
constexpr size_t WS_TAB128 = WS_TAB64 + 4096UL * 32 * 2 * 4;
constexpr size_t WS_ADA = WS_TAB128 + 4096UL * 64 * 2 * 4;
constexpr size_t WS_ADAP = WS_ADA + 2UL * NCOND * 12288 * 4;
constexpr size_t WS_WIN = WS_ADAP + 8UL * 2 * NCOND * 12288 * 4;
constexpr size_t WS_WUQ = WS_WIN + 2UL * INWP * DM * 2;
constexpr size_t WS_WUKV = WS_WUQ + 2UL * 3072 * 512 * 2;
constexpr size_t WS_WUK = WS_WUKV + 2UL * 4096 * 512 * 2;
constexpr size_t WS_WA = WS_WUK + 2UL * 16 * 512 * 256 * 2;
constexpr size_t WS_WB = WS_WA + 2UL * DM * DM * 2;
constexpr size_t WS_WO = WS_WB + 2UL * DM * DM * 2;
constexpr size_t WS_WPQ = WS_WO + 2UL * DM * DM * 2;
constexpr size_t WS_PK1 = WS_WPQ + 2UL * DM * DM * 2;
constexpr size_t WS_PK2 = WS_PK1 + 2UL * 128 * 128 * 2;
constexpr size_t WS_H = WS_PK2 + 2UL * 128 * 128 * 2;
constexpr size_t WS_Y = WS_H + (size_t)T * DM * 2;
constexpr size_t WS_CQN = WS_Y + (size_t)T * INWP * 2;
constexpr size_t WS_CKVNP = WS_CQN + (size_t)T * 512 * 2;
constexpr size_t WS_KRP = WS_CKVNP + (size_t)TP * 512 * 2;
constexpr size_t WS_Q = WS_KRP + (size_t)TP * 64 * 2;
constexpr size_t WS_YA = WS_Q;
constexpr size_t WS_KV = WS_Q + (size_t)T * 3072 * 2 + 4096;
constexpr size_t WS_SP = WS_KV;
constexpr size_t WS_MIX = WS_KV;
constexpr size_t WS_OA = WS_KV + 32UL * 1024 * KPAD * 2;
constexpr size_t WS_QP = WS_OA;
constexpr size_t WS_CKA = WS_OA + (size_t)T * DM * 2;
constexpr size_t WS_CKT = WS_CKA + 32UL * KPAD * QLD * 2;
constexpr size_t WS_QL = WS_CKT + 32UL * 512 * KPAD * 2;
constexpr size_t WS_OL = WS_QL + 32UL * 1024 * QLD * 2;
constexpr size_t WS_OB = WS_OL + 16UL * 2048 * 512 * 2;
constexpr size_t WS_BG = WS_OB + (size_t)T * DM * 2;
constexpr size_t WS_PIDX = WS_BG + (size_t)T * DM * 2;
constexpr size_t WS_PW = WS_PIDX + (size_t)T * 128 * 4;
constexpr size_t WS_PU = WS_PW + (size_t)T * 128 * 4;
constexpr size_t WS_PV = WS_PU + (size_t)NEXP * DM;
constexpr size_t WS_PSU = WS_PV + (size_t)NEXP * DM;
constexpr size_t WS_PSV = WS_PSU + (size_t)NEXP * 4;
constexpr size_t WS_WPQ8 = WS_PSV + (size_t)NEXP * 4;
constexpr size_t WS_SB8 = WS_WPQ8 + 2UL * DM * DM;
constexpr size_t WS_SA8 = WS_SB8 + 2UL * DM * 4;
constexpr int NB8 = 36;
constexpr size_t WS_WIN8 = WS_BG + (size_t)T * DM;
constexpr size_t WS_WB8 = WS_WIN8 + (size_t)NB8 * 256 * DM;
constexpr size_t WS_WUQ8 = WS_WB8 + (size_t)DM * DM;
constexpr size_t WS_WUKV8 = WS_WUQ8 + 3072UL * 512;
static_assert(WS_WUKV8 + 4096UL * 512 <= WS_BG + (size_t)T * DM * 2, "int8 weights overflow the BG region");
constexpr size_t WS_SBW = WS_SA8 + al256((size_t)T * 4);
constexpr size_t WS_SBB = WS_SBW + al256((size_t)INWP * 4);
constexpr size_t WS_SBQ = WS_SBB + (size_t)DM * 4;
constexpr size_t WS_SBK = WS_SBQ + 3072UL * 4;
constexpr size_t WS_SAQ = WS_SBK + 4096UL * 4;
constexpr size_t WS_SAK = WS_SAQ + al256((size_t)T * 4);
constexpr size_t WS_END = WS_SAK + al256((size_t)TP * 4);
constexpr size_t WS_H8 = WS_OB;
static_assert((size_t)TP * 4096 * 2 <= 32UL * 1024 * KPAD * 2, "KV fits in the SP region");
static_assert(WS_END <= 1608000000UL, "workspace map too large");
static_assert(WS_WIN % 256 == 0 && WS_H % 256 == 0 && WS_Y % 256 == 0 && WS_Q % 256 == 0 && WS_KV % 256 == 0 && WS_CKA % 256 == 0, "alignment");

constexpr int LDS_BYTES = 147456;
constexpr int LDS_BARW = LDS_BYTES - 32;
constexpr size_t CTL_RANK = 16384;
constexpr size_t WS_DOTP = WS_Q;
constexpr size_t WS_ACT = WS_DOTP + 8UL * T * 128 * 4;
constexpr size_t WS_PIDXT = WS_ACT + (size_t)T * 128 * 4;
static_assert(WS_PIDXT + (size_t)T * 128 * 4 <= WS_KV, "PEER scratch fits in the Q region");

struct Params {
    const float *x_prompt, *x_sample, *c_prompt, *c_sample, *cache_ckv, *cache_krope, *state_ret, *w_ada, *b_ada, *g_mix, *g_ffn, *w_in, *g_q, *w_uq, *g_kv, *w_ukv,
                *w_a, *w_b, *w_o, *w_pq, *peer_k1, *peer_k2, *peer_u, *peer_v, *g_final;
    float* out; unsigned char* ws;
    float lg[8];
    int grid; int pad_;
};

typedef const __attribute__((address_space(4))) Params KParams;
__device__ __forceinline__ KParams* okarg() {
    const uintptr_t k = (uintptr_t)__builtin_amdgcn_kernarg_segment_ptr();
    unsigned lo = (unsigned)k, hi = (unsigned)(k >> 32);
    asm volatile("" : "+s"(lo), "+s"(hi)); return (KParams*)(((uintptr_t)hi << 32) | lo); }
#define KP (*okarg())
__device__ __forceinline__ int ogrid() { return KP.grid; }
__device__ __forceinline__ int obid() { int b = (int)blockIdx.x; asm volatile("" : "+s"(b) :: "memory"); return b; }
__device__ __forceinline__ int otid() { int t = (int)threadIdx.x; asm volatile("" : "+v"(t) :: "memory"); return t; }
template <class P> __device__ __forceinline__ P* gp(P* p) { return (P*)(__attribute__((address_space(1))) P*)(uintptr_t)p; }
template <class P> __device__ __forceinline__ P* optr(P* p) {
    unsigned lo = __builtin_amdgcn_readfirstlane((unsigned)(uintptr_t)p), hi = __builtin_amdgcn_readfirstlane((unsigned)((uintptr_t)p >> 32));
    asm volatile("" : "+s"(lo), "+s"(hi)); return gp((P*)(((uintptr_t)hi << 32) | lo)); }
typedef __bf16 bf16v2_t __attribute__((ext_vector_type(2)));
__device__ __forceinline__ unsigned cvt_pk_bf16(float lo, float hi) { f32x2 v = {lo, hi}; bf16v2_t r = __builtin_convertvector(v, bf16v2_t); return __builtin_bit_cast(unsigned, r); }
__device__ __forceinline__ bf16_t f2bf(float f) { return (bf16_t)(cvt_pk_bf16(f, 0.f) & 0xffffu); }
__device__ __forceinline__ float bf2f(bf16_t b) { return __uint_as_float(((unsigned)b) << 16); }
__device__ __forceinline__ float bflo(unsigned w) { return __uint_as_float(w << 16); }
__device__ __forceinline__ float bfhi(unsigned w) { return __uint_as_float(w & 0xffff0000u); }
__device__ __forceinline__ void unpack8(const u32x4 w, float (&f)[8]) { f[0] = bflo(w.x); f[1] = bfhi(w.x); f[2] = bflo(w.y); f[3] = bfhi(w.y); f[4] = bflo(w.z); f[5] = bfhi(w.z); f[6] = bflo(w.w); f[7] = bfhi(w.w); }
__device__ __forceinline__ u32x4 pack8(const float (&f)[8]) { u32x4 w; w.x = cvt_pk_bf16(f[0], f[1]); w.y = cvt_pk_bf16(f[2], f[3]); w.z = cvt_pk_bf16(f[4], f[5]); w.w = cvt_pk_bf16(f[6], f[7]); return w; }
template <int K> __device__ __forceinline__ float sx(float v) {
    if constexpr (K == 32) { const auto rr = __builtin_amdgcn_permlane32_swap(__float_as_uint(v), __float_as_uint(v), false, false); return __uint_as_float((otid() & 32) ? rr[0] : rr[1]); }
    else return __int_as_float(__builtin_amdgcn_ds_swizzle(__float_as_int(v), (K << 10) | 0x1F));
}
__device__ __forceinline__ float wave_sum(float v) { v += sx<32>(v); v += sx<16>(v); v += sx<8>(v); v += sx<4>(v); v += sx<2>(v); v += sx<1>(v); return v; }
__device__ __forceinline__ float wave_max(float v) { v = fmaxf(v, sx<32>(v)); v = fmaxf(v, sx<16>(v)); v = fmaxf(v, sx<8>(v)); v = fmaxf(v, sx<4>(v)); v = fmaxf(v, sx<2>(v)); v = fmaxf(v, sx<1>(v)); return v; }
__device__ __forceinline__ float sigmoidf_(float x) { return 1.0f / (1.0f + __expf(-x)); }
__device__ __forceinline__ float siluf_(float x) { return x / (1.0f + __expf(-x)); }
__device__ __forceinline__ int cond_row(int t) { return t < TP ? (t >> 12) : NB + ((t - TP) >> 6); }
__device__ __forceinline__ int tok_pos(int t) { return t < TP ? (t & 4095) : PAST + ((t - TP) & 63); }

#define XB_TMO      128
#define XB_XCNT(j)  (256  + 64 * (j))
#define XB_XSUB(j)  (1280 + 64 * (j))
#define XB_XGEN(j)  (2304 + 64 * (j))
#define XB_TOP      3328
#define XB_TOPGEN   3392
#define XCD_BAR_WORDS 3456
#define XB_SPIN_CAP (1u << 22)
__device__ __forceinline__ unsigned xb_ld(unsigned* p)              { return __hip_atomic_load(p, __ATOMIC_RELAXED, __HIP_MEMORY_SCOPE_AGENT); }
__device__ __forceinline__ unsigned xb_add(unsigned* p, unsigned v) { return __hip_atomic_fetch_add(p, v, __ATOMIC_RELAXED, __HIP_MEMORY_SCOPE_AGENT); }
__device__ __forceinline__ unsigned xb_xcc_id() { return (unsigned)__builtin_amdgcn_s_getreg((3 << 11) | 20) & 0xFu; }
#define XB_SPIN(cond, bar) do { unsigned _sp = 0; while (cond) { __builtin_amdgcn_s_sleep(1); \
    if ((++_sp & 255u) == 0u) { if (xb_ld(&(bar)[XB_TMO])) break; if (_sp > XB_SPIN_CAP) { atomicAdd(&(bar)[XB_TMO], 1u); break; } } } } while (0)
struct XcdBarrier { unsigned* bar; unsigned x; volatile LAS unsigned* st; };
__device__ __forceinline__ XcdBarrier xcd_barrier_post(unsigned* bar, volatile LAS unsigned* st) {
    XcdBarrier b; b.bar = bar; b.x = xb_xcc_id(); b.st = st;
    if (threadIdx.x == 0) (void)xb_add(&bar[XB_XCNT(b.x)], 1u);
    return b;
}
__device__ __forceinline__ void xcd_barrier_complete(unsigned* bar, unsigned x, unsigned& nloc, unsigned& nx) {
    const unsigned G = (unsigned)KP.grid;
    unsigned sum, cnt, mine, sp = 0u;
    for (;;) {
        sum = 0u; cnt = 0u; mine = 0u;
#pragma unroll
        for (unsigned j = 0; j < 16; ++j) { const unsigned c = xb_ld(&bar[XB_XCNT(j)]); sum += c; cnt += (c > 0u) ? 1u : 0u; mine = (j == x) ? c : mine; }
        if (sum == G) break;
        __builtin_amdgcn_s_sleep(1);
        if ((++sp & 255u) == 0u) { if (xb_ld(&bar[XB_TMO])) break; if (sp > XB_SPIN_CAP) { atomicAdd(&bar[XB_TMO], 1u); break; } }
    }
    nloc = mine > 0u ? mine : 1u; nx = cnt > 0u ? cnt : 1u;
}
__device__ __forceinline__ void xcd_barrier(const XcdBarrier& b) {
    asm volatile("s_waitcnt vmcnt(0)" ::: "memory");
    __syncthreads();
    if (otid() == 0) {
        unsigned* bar = (unsigned*)(gp(KP.ws) + WS_CTL);
        unsigned bx = xb_xcc_id(); asm volatile("" : "+s"(bx));
        __builtin_amdgcn_s_waitcnt(0);
        unsigned nloc = b.st[0], nx = b.st[1];
        if (nloc == 0u) { xcd_barrier_complete(bar, bx, nloc, nx); b.st[0] = nloc; b.st[1] = nx; }
        const unsigned old = xb_add(&bar[XB_XSUB(bx)], 1u);
        const unsigned gen = old / nloc;
        if (old + 1u == (gen + 1u) * nloc) {
            __builtin_amdgcn_fence(__ATOMIC_RELEASE, "agent");
            asm volatile("s_waitcnt vmcnt(0)" ::: "memory");
            const unsigned og = xb_add(&bar[XB_TOP], 1u);
            const unsigned tg = og / nx;
            if (og + 1u == (tg + 1u) * nx) xb_add(&bar[XB_TOPGEN], 1u);
            else XB_SPIN(xb_ld(&bar[XB_TOPGEN]) == tg, bar);
            __builtin_amdgcn_fence(__ATOMIC_ACQUIRE, "agent");
            xb_add(&bar[XB_XGEN(bx)], 1u);
            asm volatile("s_waitcnt vmcnt(0)" ::: "memory");
        } else {
            XB_SPIN(xb_ld(&bar[XB_XGEN(bx)]) == gen, bar);
            __builtin_amdgcn_fence(__ATOMIC_ACQUIRE, "agent");
            asm volatile("s_waitcnt vmcnt(0)" ::: "memory");
        }
    }
    __syncthreads();
}
namespace pg8 {
constexpr int BM = 256, BK = 64, HALF = 128, HTB = HALF * BK * 2, STAGE_BYTES = 8 * HTB, NXCD = 8, WGM = 8;
__host__ __device__ __forceinline__ int lds_byte(int r, int c) { const int st = (r >> 4) * 2 + (c >> 5), rr = r & 15, cc = c & 31, ob = rr * 64 + cc * 2; return st * 1024 + (ob ^ (((ob >> 9) & 1) << 5)); }
__host__ __device__ __forceinline__ void stage_rc(int b, int& R, int& C) { const int st = b / 1024, sb = b % 1024, swz = sb ^ (((sb >> 9) & 1) << 5); R = (st >> 1) * 16 + swz / 64; C = (st & 1) * 32 + (swz % 64) / 2; }
__host__ __device__ __forceinline__ int perm32(int rho) { const int n = rho >> 4, i = rho & 15; return 8 * (i >> 2) + 4 * n + (i & 3); }

struct Unit { int pm, pn; long aoff, boff; int x0, x1; };
struct Gemm { const bf16_t* A; const bf16_t* Bt; int K; int lda, ldb; const float* sa; const float* sb; };

template <int MODE> struct Sched {
    int nM, nN, nwg, G, c; long lda, ldb;
    __device__ void init(int nM_, int nN_, int nwg_, long lda_, long ldb_) { nM = nM_; nN = nN_; nwg = nwg_; G = ogrid(); c = obid(); lda = lda_; ldb = ldb_; }
    __device__ void rotate(int r) { c = (c + r) % G; }
    __device__ bool next(int i, Unit& u) const {
        const long L = (long)i * G + c; if (L >= nwg) return false;
        int wgid = (int)L;
        if (MODE == 0 || MODE == 5 || MODE == 6) {
            { const int q = nwg / NXCD, r = nwg % NXCD, xcd = wgid % NXCD, off = wgid / NXCD; wgid = (xcd < r ? xcd * (q + 1) : r * (q + 1) + (xcd - r) * q) + off; }
            const int nig = WGM * nN, gid = wgid / nig, fm = gid * WGM, gsz = (nM - fm) < WGM ? (nM - fm) : WGM;
            u.pm = fm + ((wgid % nig) % gsz); u.pn = (wgid % nig) / gsz; u.x0 = 0; u.x1 = 0;
            { const int pl = u.pn;
              if (MODE == 5) u.pn = pl < 3 ? pl + 2 : (pl < 8 ? pl + 5 : 20);
              if (MODE == 6) u.pn = pl < 2 ? pl : (pl < 5 ? pl + 3 : (pl < 12 ? pl + 8 : pl + 9));
              u.aoff = (long)u.pm * 256 * lda * 2; u.boff = (long)(MODE == 6 ? pl : u.pn) * 256 * ldb * 2; }
        } else if (MODE == 1) {
            const int h = wgid >> 4, rem = wgid & 15, rt = rem >> 1, pn = rem & 1;
            u.pm = rt; u.pn = pn; u.x0 = h; u.x1 = rt;
            u.aoff = ((long)(TP + 256 * rt) * 3072 + h * 192) * 2; u.boff = ((long)(h * 512 + 256 * pn) * 256) * 2;
        } else if (MODE == 2) {
            const int b = wgid / 36, rem = wgid % 36, pm = rem / 9, pn = rem % 9;
            u.pm = pm; u.pn = pn; u.x0 = b; u.x1 = 0;
            u.aoff = ((long)(b * 1024 + 256 * pm) * QLD) * 2; u.boff = ((long)(b * KPAD + 256 * pn) * QLD) * 2;
        } else if (MODE == 3) {
            const int b = wgid >> 3, pm = (wgid & 7) >> 1, pn = wgid & 1;
            u.pm = pm; u.pn = pn; u.x0 = b; u.x1 = 0;
            u.aoff = ((long)(b * 1024 + 256 * pm) * KPAD) * 2; u.boff = ((long)(b * 512 + 256 * pn) * KPAD) * 2;
        } else {
            const int h = wgid >> 3, rt = wgid & 7;
            u.pm = rt; u.pn = 0; u.x0 = h; u.x1 = rt;
            u.aoff = ((long)(h * 2048 + 256 * rt) * 512) * 2; u.boff = ((long)(h * 256) * 512) * 2;
        }
        return true;
    }
};

template <class Epi, class SchedT, int I8 = 0>
__device__ __forceinline__ void gemm_phase(LAS unsigned char* lds, const Gemm g, const SchedT& S, const Epi& E) {
    const int tid = otid(), wid = __builtin_amdgcn_readfirstlane(tid >> 6), lane = tid & 63, wr = wid >> 2, wc = wid & 3, fr = lane & 15, fq = lane >> 4;
    const int K = g.K, nt = K / BK;
    unsigned voffA[2], voffB[2];
#pragma unroll
    for (int i = 0; i < 2; ++i) { int R, C; stage_rc(tid * 16 + i * 8192, R, C); const int Rb = Epi::PERM ? ((R & ~31) + perm32(R & 31)) : R;
        voffA[i] = (unsigned)(R * g.lda + C) * 2u; voffB[i] = (unsigned)(Rb * g.ldb + C) * 2u; }
    const size_t kstep = (size_t)(BK * 2);
    const size_t hstepA = (size_t)HALF * g.lda * 2, hstepB = (size_t)HALF * g.ldb * 2;
    const unsigned ldsw = (unsigned)wid * 1024u;
    const int aoff = lds_byte(wr * 64 + fr, fq * 8), boff = lds_byte(wc * 32 + fr, fq * 8);
#define PG8_SA(b, h) (((b) * 2 + (h)) * HTB)
#define PG8_SB(b, h) ((4 + (b) * 2 + (h)) * HTB)
#define PG8_STAGE(bufoff, gbase, voff) do { _Pragma("unroll") for (int _i = 0; _i < 2; ++_i) \
        __builtin_amdgcn_global_load_lds((const unsigned*)((const char*)(gbase) + (voff)[_i]), (LAS unsigned*)(lds + (bufoff) + ldsw + _i * 8192), 16, 0, 0); } while (0)
#define PG8_LDA(dst, b, h) do { _Pragma("unroll") for (int m = 0; m < 4; ++m) _Pragma("unroll") for (int k = 0; k < 2; ++k) dst[m][k] = *(const LAS bf16x8*)(lds + PG8_SA(b, h) + aoff + m * 2048 + k * 1024); } while (0)
#define PG8_LDB(dst, b, h) do { _Pragma("unroll") for (int n = 0; n < 2; ++n) _Pragma("unroll") for (int k = 0; k < 2; ++k) dst[n][k] = *(const LAS bf16x8*)(lds + PG8_SB(b, h) + boff + n * 2048 + k * 1024); } while (0)
#define PG8_MMA(ai, bj, At, Bt) do { __builtin_amdgcn_s_setprio(1); _Pragma("unroll") for (int m = 0; m < 4; ++m) _Pragma("unroll") for (int n = 0; n < 2; ++n) _Pragma("unroll") for (int k = 0; k < 2; ++k) \
        { if constexpr (I8) acc[ai][bj][m][n] = __builtin_bit_cast(f32x4, __builtin_amdgcn_mfma_i32_16x16x64_i8(__builtin_bit_cast(i32x4, Bt[n][k]), __builtin_bit_cast(i32x4, At[m][k]), __builtin_bit_cast(i32x4, acc[ai][bj][m][n]), 0, 0, 0)); \
          else acc[ai][bj][m][n] = __builtin_amdgcn_mfma_f32_16x16x32_bf16(Bt[n][k], At[m][k], acc[ai][bj][m][n], 0, 0, 0); } __builtin_amdgcn_s_setprio(0); } while (0)
#define PG8_WAIT_V(n) asm volatile("s_waitcnt vmcnt(" #n ")" ::: "memory")
#define PG8_WAIT_L(n) asm volatile("s_waitcnt lgkmcnt(" #n ")" ::: "memory")
#define PG8_BAR __builtin_amdgcn_s_barrier()
#define PG8_SCHED __builtin_amdgcn_sched_barrier(0)
    Unit cur, nxt; int ui = 0;
    if (!S.next(0, cur)) return;
    f32x4 acc[2][2][4][2];
#pragma unroll
    for (int a = 0; a < 2; ++a)
#pragma unroll
        for (int b = 0; b < 2; ++b)
#pragma unroll
            for (int m = 0; m < 4; ++m)
#pragma unroll
                for (int n = 0; n < 2; ++n) acc[a][b][m][n] = (f32x4){0.f, 0.f, 0.f, 0.f};
    bf16x8 At[4][2], B0[2][2], B1[2][2];
    const char* cA = (const char*)g.A + cur.aoff; const char* cB = (const char*)g.Bt + cur.boff;
    PG8_STAGE(PG8_SB(0, 0), cB, voffB); PG8_STAGE(PG8_SA(0, 0), cA, voffA); PG8_STAGE(PG8_SB(0, 1), cB + hstepB, voffB); PG8_STAGE(PG8_SA(0, 1), cA + hstepA, voffA);
    if (wr == 1) PG8_BAR;
    PG8_WAIT_V(4); PG8_BAR;
    PG8_STAGE(PG8_SB(1, 0), cB + kstep, voffB); PG8_STAGE(PG8_SA(1, 0), cA + kstep, voffA); PG8_STAGE(PG8_SB(1, 1), cB + hstepB + kstep, voffB);
    PG8_WAIT_V(6); PG8_BAR;
    for (;;) {
        const bool has_next = S.next(ui + 1, nxt);
        const char* nA = has_next ? (const char*)g.A + nxt.aoff : cA; const char* nB = has_next ? (const char*)g.Bt + nxt.boff : cB;
        for (int t = 0; t < nt; t += 2) {
            const bool last = (t == nt - 2);
            const char* a1 = cA + (size_t)(t + 1) * kstep;
            const char* a2 = last ? nA : cA + (size_t)(t + 2) * kstep; const char* b2 = last ? nB : cB + (size_t)(t + 2) * kstep;
            const char* a3 = a2 + kstep; const char* b3 = b2 + kstep;
            PG8_LDB(B0, 0, 0); PG8_SCHED; PG8_LDA(At, 0, 0); PG8_STAGE(PG8_SA(1, 1), a1 + hstepA, voffA);
            PG8_WAIT_L(8); PG8_BAR; PG8_WAIT_L(0); PG8_MMA(0, 0, At, B0); PG8_BAR; PG8_SCHED;
            PG8_LDB(B1, 0, 1); PG8_STAGE(PG8_SB(0, 0), b2, voffB);
            PG8_BAR; PG8_WAIT_L(0); PG8_MMA(0, 1, At, B1); PG8_BAR;
            PG8_LDA(At, 0, 1); PG8_STAGE(PG8_SA(0, 0), a2, voffA);
            PG8_BAR; PG8_WAIT_L(0); PG8_MMA(1, 0, At, B0); PG8_BAR; PG8_SCHED;
            PG8_STAGE(PG8_SB(0, 1), b2 + hstepB, voffB);
            PG8_WAIT_V(6); PG8_BAR; PG8_MMA(1, 1, At, B1); PG8_BAR;
            PG8_LDB(B0, 1, 0); PG8_SCHED; PG8_LDA(At, 1, 0); PG8_STAGE(PG8_SA(0, 1), a2 + hstepA, voffA);
            PG8_WAIT_L(8); PG8_BAR; PG8_WAIT_L(0); PG8_MMA(0, 0, At, B0); PG8_BAR; PG8_SCHED;
            PG8_LDB(B1, 1, 1); PG8_STAGE(PG8_SB(1, 0), b3, voffB);
            PG8_BAR; PG8_WAIT_L(0); PG8_MMA(0, 1, At, B1); PG8_BAR;
            PG8_LDA(At, 1, 1); PG8_STAGE(PG8_SA(1, 0), a3, voffA);
            PG8_BAR; PG8_WAIT_L(0); PG8_MMA(1, 0, At, B0); PG8_BAR; PG8_SCHED;
            PG8_STAGE(PG8_SB(1, 1), b3 + hstepB, voffB);
            PG8_WAIT_V(6); PG8_BAR; PG8_MMA(1, 1, At, B1); PG8_BAR;
        }
        if constexpr (I8) {
#pragma unroll
            for (int a = 0; a < 2; ++a)
#pragma unroll
                for (int b = 0; b < 2; ++b)
#pragma unroll
                    for (int m = 0; m < 4; ++m)
#pragma unroll
                        for (int n = 0; n < 2; ++n) { const i32x4 iv = __builtin_bit_cast(i32x4, acc[a][b][m][n]); acc[a][b][m][n] = (f32x4){(float)iv[0], (float)iv[1], (float)iv[2], (float)iv[3]}; } }
        if constexpr (I8 == 2) {
            static_assert(Epi::PERM, "I8 == 2 assumes the PERM column layout");
            f32x4 sbv[2][2];
#pragma unroll
            for (int b = 0; b < 2; ++b) { const int c = cur.pn * BM + b * HALF + wc * 32 + 8 * fq; sbv[b][0] = *(const f32x4*)(g.sb + c); sbv[b][1] = *(const f32x4*)(g.sb + c + 4); }
#pragma unroll
            for (int a = 0; a < 2; ++a)
#pragma unroll
                for (int m = 0; m < 4; ++m) { const float s_ = g.sa[(long)cur.pm * BM + a * HALF + wr * 64 + m * 16 + fr];
#pragma unroll
                    for (int b = 0; b < 2; ++b) { acc[a][b][m][0] = acc[a][b][m][0] * sbv[b][0] * s_; acc[a][b][m][1] = acc[a][b][m][1] * sbv[b][1] * s_; } } }
        E(acc, cur, wr, wc, fr, fq);
        if (!has_next) break;
#pragma unroll
        for (int a = 0; a < 2; ++a)
#pragma unroll
            for (int b = 0; b < 2; ++b)
#pragma unroll
                for (int m = 0; m < 4; ++m)
#pragma unroll
                    for (int n = 0; n < 2; ++n) acc[a][b][m][n] = (f32x4){0.f, 0.f, 0.f, 0.f};
        cur = nxt; cA = nA; cB = nB; ++ui;
    }
    PG8_WAIT_V(0);
    if (wr == 0) PG8_BAR;
    PG8_BAR;
#undef PG8_SA
#undef PG8_SB
#undef PG8_STAGE
#undef PG8_LDA
#undef PG8_LDB
#undef PG8_MMA
#undef PG8_WAIT_V
#undef PG8_WAIT_L
#undef PG8_BAR
#undef PG8_SCHED
}

struct EpiBf16 {
    static constexpr bool PERM = true;
    bf16_t* O; long ldc; long bstride;
    __device__ __forceinline__ void operator()(const f32x4 (&acc)[2][2][4][2], const Unit& u, int wr, int wc, int fr, int fq) const {
        bf16_t* base = O + (long)u.x0 * bstride + (long)(u.pm * BM + wr * 64 + fr) * ldc + u.pn * BM + wc * 32 + 8 * fq;
#pragma unroll
        for (int ai = 0; ai < 2; ++ai)
#pragma unroll
            for (int m = 0; m < 4; ++m) { bf16_t* rowp = base + (long)(ai * HALF + m * 16) * ldc;
#pragma unroll
                for (int bj = 0; bj < 2; ++bj) { const f32x4 v0 = acc[ai][bj][m][0], v1 = acc[ai][bj][m][1];
                    u32x4 w; w.x = cvt_pk_bf16(v0[0], v0[1]); w.y = cvt_pk_bf16(v0[2], v0[3]); w.z = cvt_pk_bf16(v1[0], v1[1]); w.w = cvt_pk_bf16(v1[2], v1[3]);
                    *(u32x4*)(rowp + bj * HALF) = w; } }
    }
};
template <int RMODE> struct EpiRowMap {
    static constexpr bool PERM = true;
    bf16_t* O; const float* rsum;
    __device__ __forceinline__ void operator()(const f32x4 (&acc)[2][2][4][2], const Unit& u, int wr, int wc, int fr, int fq) const {
        const int col0 = u.pn * BM + wc * 32 + 8 * fq;
#pragma unroll
        for (int ai = 0; ai < 2; ++ai)
#pragma unroll
            for (int m = 0; m < 4; ++m) { const int r = ai * HALF + wr * 64 + m * 16 + fr; long drow; long ldc;
                if (RMODE == 1) { const int ts = 256 * u.x1 + r; drow = (long)(ts >> 6) * 1024 + u.x0 * 64 + (ts & 63); ldc = QLD; }
                float rs = 1.0f;
                if (RMODE == 1) { }
                else { const int qr = 256 * u.pm + r; drow = (long)(qr >> 6) * 2048 + u.x0 * 64 + (qr & 63); ldc = 512; rs = 1.0f / rsum[u.x0 * 1024 + qr]; }
                bf16_t* rowp = O + drow * ldc + col0;
#pragma unroll
                for (int bj = 0; bj < 2; ++bj) { const f32x4 v0 = acc[ai][bj][m][0] * rs, v1 = acc[ai][bj][m][1] * rs;
                    u32x4 w; w.x = cvt_pk_bf16(v0[0], v0[1]); w.y = cvt_pk_bf16(v0[2], v0[3]); w.z = cvt_pk_bf16(v1[0], v1[1]); w.w = cvt_pk_bf16(v1[2], v1[3]);
                    *(u32x4*)(rowp + bj * HALF) = w; } }
    }
};
struct EpiOV {
    static constexpr bool PERM = true;
    bf16_t* O;
    __device__ __forceinline__ void operator()(const f32x4 (&acc)[2][2][4][2], const Unit& u, int wr, int wc, int fr, int fq) const {
#pragma unroll
        for (int ai = 0; ai < 2; ++ai)
#pragma unroll
            for (int m = 0; m < 4; ++m) { const int r = ai * HALF + wr * 64 + m * 16 + fr;
                bf16_t* rowp = O + (long)(TP + 256 * u.x1 + r) * DM + u.x0 * 128 + wc * 32 + 8 * fq;
                const f32x4 v0 = acc[ai][1][m][0], v1 = acc[ai][1][m][1];
                u32x4 w; w.x = cvt_pk_bf16(v0[0], v0[1]); w.y = cvt_pk_bf16(v0[2], v0[3]); w.z = cvt_pk_bf16(v1[0], v1[1]); w.w = cvt_pk_bf16(v1[2], v1[3]);
                *(u32x4*)rowp = w; }
    }
};
struct EpiMix {
    static constexpr bool PERM = true;
    const bf16_t* Y; const bf16_t* YA; bf16_t* MIX; const float* sa; const float* sb;
    __device__ __forceinline__ void operator()(const f32x4 (&acc)[2][2][4][2], const Unit& u, int wr, int wc, int fr, int fq) const {
#pragma unroll
        for (int ai = 0; ai < 2; ++ai)
#pragma unroll
            for (int m = 0; m < 4; ++m) { const long t = (long)u.pm * BM + ai * HALF + wr * 64 + m * 16 + fr; const float s_ = sa[t];
#pragma unroll
                for (int bj = 0; bj < 2; ++bj) { const int c = u.pn * BM + bj * HALF + wc * 32 + 8 * fq;
                    const u32x4 ga = *(const u32x4*)(Y + t * INWP + C_GA + c), gb = *(const u32x4*)(Y + t * INWP + C_GB + c), ya = *(const u32x4*)(YA + t * DM + c);
                    float fa[8], fb[8], fy[8], o[8]; unpack8(ga, fa); unpack8(gb, fb); unpack8(ya, fy);
                    const f32x4 v0 = acc[ai][bj][m][0] * *(const f32x4*)(sb + c) * s_, v1 = acc[ai][bj][m][1] * *(const f32x4*)(sb + c + 4) * s_;
                    const float av[8] = {v0[0], v0[1], v0[2], v0[3], v1[0], v1[1], v1[2], v1[3]};
#pragma unroll
                    for (int j = 0; j < 8; ++j) {
#if defined(DBG_MIX) && DBG_MIX == 1
                        o[j] = sigmoidf_(fb[j]) * av[j];
#elif defined(DBG_MIX) && DBG_MIX == 2
                        o[j] = sigmoidf_(fa[j]) * fy[j];
#else
                        o[j] = sigmoidf_(fa[j]) * fy[j] + sigmoidf_(fb[j]) * av[j];
#endif
                    }
                    *(u32x4*)(MIX + t * DM + c) = pack8(o); } }
    }
};
struct EpiRes {
    static constexpr bool PERM = false;
    float* X; const float* gate;
    const float* XinP; const float* XinS;
    __device__ __forceinline__ void operator()(const f32x4 (&acc)[2][2][4][2], const Unit& u, int wr, int wc, int fr, int fq) const {
#pragma unroll
        for (int ai = 0; ai < 2; ++ai)
#pragma unroll
            for (int m = 0; m < 4; ++m) { const int t = u.pm * BM + ai * HALF + wr * 64 + m * 16 + fr; const float* gr = gate + (long)cond_row(t) * 12288; float* xr = X + (long)t * DM; const float* xi = t < TP ? XinP + (long)t * DM : XinS + (long)(t - TP) * DM;
#pragma unroll
                for (int bj = 0; bj < 2; ++bj)
#pragma unroll
                    for (int n = 0; n < 2; ++n) { const int c = u.pn * BM + bj * HALF + wc * 32 + n * 16 + 4 * fq;
                        const f32x4 gv = *(const f32x4*)(gr + c); const f32x4 xv = *(const f32x4*)(xi + c);
                        *(f32x4*)(xr + c) = xv + gv * acc[ai][bj][m][n]; } }
    }
};

struct EpiQ {
    static constexpr bool PERM = true;
    bf16_t* Q; bf16_t* QL; const float* T64;
    __device__ __forceinline__ void operator()(const f32x4 (&acc)[2][2][4][2], const Unit& u, int wr, int wc, int fr, int fq) const {
        const int grp = u.pn / 3, typ = u.pn - 3 * grp;
        if (typ < 2) {
#pragma unroll
            for (int ai = 0; ai < 2; ++ai)
#pragma unroll
                for (int m = 0; m < 4; ++m) { const long t = (long)u.pm * BM + ai * HALF + wr * 64 + m * 16 + fr;
#pragma unroll
                    for (int bj = 0; bj < 2; ++bj) { const f32x4 v0 = acc[ai][bj][m][0], v1 = acc[ai][bj][m][1];
                        u32x4 w; w.x = cvt_pk_bf16(v0[0], v0[1]); w.y = cvt_pk_bf16(v0[2], v0[3]); w.z = cvt_pk_bf16(v1[0], v1[1]); w.w = cvt_pk_bf16(v1[2], v1[3]);
                        *(u32x4*)(Q + t * 3072 + 768 * grp + 192 * (2 * typ + bj) + wc * 32 + 8 * fq) = w; } }
        } else {
#pragma unroll
            for (int ai = 0; ai < 2; ++ai)
#pragma unroll
                for (int m = 0; m < 4; ++m) { const int t = u.pm * BM + ai * HALF + wr * 64 + m * 16 + fr; const int pos = tok_pos(t);
                    const float* cs = T64 + ((long)pos * 32 + 8 * fq) * 2; float cv[8], sv[8];
#pragma unroll
                    for (int j = 0; j < 4; ++j) { const f32x4 qv = *(const f32x4*)(cs + 4 * j); cv[2 * j] = qv[0]; sv[2 * j] = qv[1]; cv[2 * j + 1] = qv[2]; sv[2 * j + 1] = qv[3]; }
                    const f32x4 a0 = acc[ai][0][m][0], a1 = acc[ai][0][m][1], b0 = acc[ai][1][m][0], b1 = acc[ai][1][m][1];
                    const float x1[8] = {a0[0], a0[1], a0[2], a0[3], a1[0], a1[1], a1[2], a1[3]}, x2[8] = {b0[0], b0[1], b0[2], b0[3], b1[0], b1[1], b1[2], b1[3]};
                    float o1[8], o2[8];
#pragma unroll
                    for (int j = 0; j < 8; ++j) { o1[j] = x1[j] * cv[j] - x2[j] * sv[j]; o2[j] = x1[j] * sv[j] + x2[j] * cv[j]; }
                    const u32x4 w1 = pack8(o1), w2 = pack8(o2); const int hd = 4 * grp + wc;
                    bf16_t* qd = Q + (long)t * 3072 + hd * 192 + 128 + 8 * fq; *(u32x4*)qd = w1; *(u32x4*)(qd + 32) = w2;
                    if (t >= TP) { const int ts = t - TP; bf16_t* d = QL + ((long)(ts >> 6) * 1024 + hd * 64 + (ts & 63)) * QLD + 512 + 8 * fq; *(u32x4*)d = w1; *(u32x4*)(d + 32) = w2; } }
        }
    }
};

struct EpiExp {
    static constexpr bool PERM = true;
    bf16_t* O; float* rsum;
    __device__ __forceinline__ void operator()(const f32x4 (&acc)[2][2][4][2], const Unit& u, int wr, int wc, int fr, int fq) const {
        bf16_t* base = O + (long)u.x0 * 1024 * KPAD + (long)(u.pm * BM + wr * 64 + fr) * KPAD + u.pn * BM + wc * 32 + 8 * fq;
#pragma unroll
        for (int ai = 0; ai < 2; ++ai)
#pragma unroll
            for (int m = 0; m < 4; ++m) { bf16_t* rowp = base + (long)(ai * HALF + m * 16) * KPAD; float part = 0.f;
#pragma unroll
                for (int bj = 0; bj < 2; ++bj) { const int c0 = u.pn * BM + bj * HALF + wc * 32 + 8 * fq; const f32x4 v0 = acc[ai][bj][m][0], v1 = acc[ai][bj][m][1];
                    const float sv[8] = {v0[0], v0[1], v0[2], v0[3], v1[0], v1[1], v1[2], v1[3]}; float e[8];
#pragma unroll
                    for (int j = 0; j < 8; ++j) { e[j] = (c0 + j < KALL) ? __expf(fminf(sv[j] * MLA_SCALE, 60.f)) : 0.f; part += e[j]; }
                    *(u32x4*)(rowp + bj * HALF) = pack8(e); }
                part += sx<16>(part); part += sx<32>(part);
                if (fq == 0) atomicAdd(rsum + u.x0 * 1024 + u.pm * BM + ai * HALF + wr * 64 + m * 16 + fr, part); }
    }
};

struct EpiQ8 {
    static constexpr bool PERM = true;
    bf16_t* O; long ldc; const float* sa; const float* sb;
    __device__ __forceinline__ void operator()(const f32x4 (&acc)[2][2][4][2], const Unit& u, int wr, int wc, int fr, int fq) const {
        f32x4 sbv[2][2];
#pragma unroll
        for (int bj = 0; bj < 2; ++bj) { const int c = u.pn * BM + bj * HALF + wc * 32 + 8 * fq; sbv[bj][0] = *(const f32x4*)(sb + c); sbv[bj][1] = *(const f32x4*)(sb + c + 4); }
#pragma unroll
        for (int ai = 0; ai < 2; ++ai)
#pragma unroll
            for (int m = 0; m < 4; ++m) { const long t = (long)u.pm * BM + ai * HALF + wr * 64 + m * 16 + fr; const float s = sa[t];
#pragma unroll
                for (int bj = 0; bj < 2; ++bj) { const f32x4 v0 = acc[ai][bj][m][0] * sbv[bj][0] * s, v1 = acc[ai][bj][m][1] * sbv[bj][1] * s;
                    u32x4 w; w.x = cvt_pk_bf16(v0[0], v0[1]); w.y = cvt_pk_bf16(v0[2], v0[3]); w.z = cvt_pk_bf16(v1[0], v1[1]); w.w = cvt_pk_bf16(v1[2], v1[3]);
                    *(u32x4*)(O + t * ldc + u.pn * BM + bj * HALF + wc * 32 + 8 * fq) = w; } }
    }
};
}
namespace att {
constexpr int NW = 8, QBLK = 32, KVBLK = 64;
constexpr float SCALE = MLA_SCALE;
constexpr float THR = 8.f;
constexpr int KROW = 384;
constexpr int SHM_V = KVBLK * 128 * 2, SHM_K = KVBLK * KROW;
constexpr int QR_PITCH = 144, SHM_QR = 256 * QR_PITCH;
constexpr int SHM_ATTN = 2 * SHM_V + 2 * SHM_K + NW * 64 * 4 + SHM_QR;
#define KSWZ(row, colB) ((row) * att::KROW + ((colB) ^ (((row) & 7) << 4)))
#define SBAR() __builtin_amdgcn_sched_barrier(0)
__device__ __forceinline__ int crow(int r, int hi) { return (r & 3) + 8 * (r >> 2) + 4 * hi; }

__device__ __forceinline__ void partialSM(f32x16& p0, f32x16& p1, float& m_reg, float& mn, float& alpha) {
  constexpr float C = SCALE * 1.4426950408889634f;
  float pmax = p0[0];
#pragma unroll
  for (int r = 1; r < 16; ++r) pmax = fmaxf(pmax, p0[r]);
#pragma unroll
  for (int r = 0; r < 16; ++r) pmax = fmaxf(pmax, p1[r]);
  { auto rr = __builtin_amdgcn_permlane32_swap(__float_as_uint(pmax), __float_as_uint(pmax), false, false);
    pmax = fmaxf(__uint_as_float(rr[0]), __uint_as_float(rr[1])); }
  if (__builtin_expect(__all(pmax - m_reg <= THR / SCALE), 1)) { mn = m_reg; alpha = 1.f; }
  else { mn = fmaxf(m_reg, pmax); alpha = __builtin_amdgcn_exp2f((m_reg - mn) * C); m_reg = mn; }
  float mnC = -mn * C;
#pragma unroll
  for (int r = 0; r < 16; ++r) p0[r] = fmaf(p0[r], C, mnC);
#pragma unroll
  for (int r = 0; r < 16; ++r) p1[r] = fmaf(p1[r], C, mnC);
#pragma unroll
  for (int r = 0; r < 16; ++r) p0[r] = __builtin_amdgcn_exp2f(p0[r]);
}
__device__ __forceinline__ void finishSM(f32x16& p0, f32x16& p1, float alpha, float& l_reg, bf16x8& pa0, bf16x8& pa1, bf16x8& pa2, bf16x8& pa3) {
#pragma unroll
  for (int r = 0; r < 16; ++r) p1[r] = __builtin_amdgcn_exp2f(p1[r]);
  float ps = 0;
#pragma unroll
  for (int r = 0; r < 16; ++r) ps += p0[r];
#pragma unroll
  for (int r = 0; r < 16; ++r) ps += p1[r];
  { auto rr = __builtin_amdgcn_permlane32_swap(__float_as_uint(ps), __float_as_uint(ps), false, false);
    ps = __uint_as_float(rr[0]) + __uint_as_float(rr[1]); }
  l_reg = l_reg * alpha + ps;
#define PK4(P, BASE, OUT) do { unsigned a0 = cvt_pk_bf16(P[BASE + 0], P[BASE + 1]), a1 = cvt_pk_bf16(P[BASE + 2], P[BASE + 3]);   \
    unsigned b0 = cvt_pk_bf16(P[BASE + 4], P[BASE + 5]), b1 = cvt_pk_bf16(P[BASE + 6], P[BASE + 7]);                              \
    auto r0 = __builtin_amdgcn_permlane32_swap(a0, b0, false, false); auto r1 = __builtin_amdgcn_permlane32_swap(a1, b1, false, false); \
    u32x4 w = {r0[0], r1[0], r0[1], r1[1]}; OUT = *reinterpret_cast<bf16x8*>(&w); } while (0)
  PK4(p0, 0, pa0); PK4(p0, 8, pa1); PK4(p1, 0, pa2); PK4(p1, 8, pa3);
#undef PK4
}
__device__ __forceinline__ void qkt(f32x16& p0, f32x16& p1, const char* Ks, const bf16x8* qr, const char* qrope, const int (&kbase)[4], bool vis) {
  p0 = f32x16{}; p1 = f32x16{};
  if (vis) {
#pragma unroll
  for (int d0 = 0; d0 < 12; ++d0) {
    bf16x8 b0 = *reinterpret_cast<const bf16x8*>(Ks + kbase[d0 & 3] + (d0 >> 2) * 128);
    bf16x8 b1 = *reinterpret_cast<const bf16x8*>(Ks + kbase[d0 & 3] + (d0 >> 2) * 128 + 32 * KROW);
    const bf16x8 qv = d0 < 8 ? qr[d0 < 8 ? d0 : 0] : *reinterpret_cast<const bf16x8*>(qrope + (d0 - 8) * 32);
    p0 = __builtin_amdgcn_mfma_f32_32x32x16_bf16(b0, qv, p0, 0, 0, 0);
    p1 = __builtin_amdgcn_mfma_f32_32x32x16_bf16(b1, qv, p1, 0, 0, 0); }
  }
  if (!vis) {
#pragma unroll
    for (int r = 0; r < 16; ++r) { p0[r] = -1e30f; p1[r] = -1e30f; } }
}
__device__ __forceinline__ int v_st(int k, int c) { const int kk = (k & ~0xC) | ((k & 4) << 1) | ((k & 8) >> 1); return ((kk >> 3) * 4 + (c >> 5)) * 512 + ((kk & 7) * 32 + (c & 31)) * 2; }
__device__ __forceinline__ int v_rd_base(int lane) { return ((lane & 3) << 3) | (((lane >> 2) & 3) << 6) | (((lane >> 4) & 1) << 5) | (((lane >> 5) & 1) << 8); }
constexpr int v_rd_off(int d0, int ks, int half) { return d0 * 512 + ks * 4096 + half * 2048; }
template <int OFF> __device__ __forceinline__ s16x4 tr_read(int vb) {
  s16x4 r; asm volatile("ds_read_b64_tr_b16 %0, %1 offset:%2" : "=&v"(r) : "v"(vb), "i"(OFF) : "memory"); return r;
}
template <int D0> __device__ __forceinline__ void pv_one(f32x16& od, int vb, bf16x8 pa0, bf16x8 pa1, bf16x8 pa2, bf16x8 pa3) {
  const s16x4 l0 = tr_read<v_rd_off(D0, 0, 0)>(vb), h0 = tr_read<v_rd_off(D0, 0, 1)>(vb), l1 = tr_read<v_rd_off(D0, 1, 0)>(vb), h1 = tr_read<v_rd_off(D0, 1, 1)>(vb);
  const s16x4 l2 = tr_read<v_rd_off(D0, 2, 0)>(vb), h2 = tr_read<v_rd_off(D0, 2, 1)>(vb), l3 = tr_read<v_rd_off(D0, 3, 0)>(vb), h3 = tr_read<v_rd_off(D0, 3, 1)>(vb);
  asm volatile("s_waitcnt lgkmcnt(0)" ::: "memory"); SBAR();
#define PK(L, H) (bf16x8){L[0], L[1], L[2], L[3], H[0], H[1], H[2], H[3]}
  od = __builtin_amdgcn_mfma_f32_32x32x16_bf16(pa0, PK(l0, h0), od, 0, 0, 0);
  od = __builtin_amdgcn_mfma_f32_32x32x16_bf16(pa1, PK(l1, h1), od, 0, 0, 0);
  od = __builtin_amdgcn_mfma_f32_32x32x16_bf16(pa2, PK(l2, h2), od, 0, 0, 0);
  od = __builtin_amdgcn_mfma_f32_32x32x16_bf16(pa3, PK(l3, h3), od, 0, 0, 0);
#undef PK
}
__device__ __forceinline__ void pv_d0(f32x16* o, int vb, bf16x8 pa0, bf16x8 pa1, bf16x8 pa2, bf16x8 pa3) {
  pv_one<0>(o[0], vb, pa0, pa1, pa2, pa3); pv_one<1>(o[1], vb, pa0, pa1, pa2, pa3); pv_one<2>(o[2], vb, pa0, pa1, pa2, pa3); pv_one<3>(o[3], vb, pa0, pa1, pa2, pa3);
}

__device__ __forceinline__ void attn_block(const bf16_t* __restrict__ Qb, const bf16_t* __restrict__ Kn, const bf16_t* __restrict__ Kr, const bf16_t* __restrict__ Vh,
                                           bf16_t* __restrict__ Ob, int qb, char* lds) {
  constexpr int LDQ = 3072, LDK = 4096, LDR = 64, LDO = 2048;
  const int tid = otid(), wid = tid >> 6, lane = tid & 63, r32 = lane & 31, hi = lane >> 5;
  char* V_lds = lds; char* K_lds = lds + 2 * SHM_V;
  float* ws = (float*)(lds + 2 * SHM_V + 2 * SHM_K) + wid * 64; float* li_l = ws; float* al_l = ws + 32;
  float m_reg = -1e30f, l_reg = 0; f32x16 o[4] = {}; bf16x8 qr[8];
  const bf16_t* Qw = Qb + (long)(wid * QBLK + r32) * LDQ + hi * 8;
#pragma unroll
  for (int d0 = 0; d0 < 8; ++d0) qr[d0] = *reinterpret_cast<const bf16x8*>(Qw + d0 * 16);
  char* qrope = lds + 2 * SHM_V + 2 * SHM_K + NW * 64 * 4 + (wid * QBLK + r32) * QR_PITCH + hi * 16;
#pragma unroll
  for (int d0 = 8; d0 < 12; ++d0) *reinterpret_cast<bf16x8*>(qrope + (d0 - 8) * 32) = *reinterpret_cast<const bf16x8*>(Qw + d0 * 16);
  asm volatile("s_waitcnt lgkmcnt(0)" ::: "memory");
  const int NT = 4 * qb + 4, jmax = 4 * qb + (wid >> 1);
  int kbase[4];
#pragma unroll
  for (int dl = 0; dl < 4; ++dl) kbase[dl] = r32 * KROW + (((dl << 5) | (hi << 4)) ^ ((r32 & 7) << 4));
  const int sr = tid >> 4, sc = (tid & 15) * 8, vst0 = v_st(sr, sc), vst1 = v_st(32 + sr, sc);
  const int rr = tid >> 3, rc = (tid & 7) * 8;
  const int vb0 = (int)(uintptr_t)V_lds + v_rd_base(lane);
  bf16x8 vs0, vs1, ks0, ks1, kr0;
#define SLOAD(k0) do { vs0 = *reinterpret_cast<const bf16x8*>(&Vh[(long)((k0) + sr) * LDK + sc]); vs1 = *reinterpret_cast<const bf16x8*>(&Vh[(long)((k0) + 32 + sr) * LDK + sc]); \
    ks0 = *reinterpret_cast<const bf16x8*>(&Kn[(long)((k0) + sr) * LDK + sc]); ks1 = *reinterpret_cast<const bf16x8*>(&Kn[(long)((k0) + 32 + sr) * LDK + sc]); \
    kr0 = *reinterpret_cast<const bf16x8*>(&Kr[(long)((k0) + rr) * LDR + rc]); } while (0)
#define SWRITE(b) do { *(bf16x8*)(V_lds + (b) * SHM_V + vst0) = vs0; *(bf16x8*)(V_lds + (b) * SHM_V + vst1) = vs1; int kc = sc * 2; \
    *(bf16x8*)(K_lds + (b) * SHM_K + KSWZ(sr, kc)) = ks0; *(bf16x8*)(K_lds + (b) * SHM_K + KSWZ(32 + sr, kc)) = ks1; \
    *(bf16x8*)(K_lds + (b) * SHM_K + KSWZ(rr, 256 + rc * 2)) = kr0; } while (0)
#define SWAIT() asm volatile("s_waitcnt vmcnt(0)" ::: "memory")
#define RESC(a) do { if (__any((a) < 1.f)) { if (hi == 0) al_l[r32] = (a); asm volatile("s_waitcnt lgkmcnt(0)" ::: "memory"); \
    _Pragma("unroll") for (int d = 0; d < 4; ++d) _Pragma("unroll") for (int r = 0; r < 16; ++r) o[d][r] *= al_l[crow(r, hi)]; } } while (0)
  f32x16 pA0, pA1, pB0, pB1; float mnA, mnB, alA, alB; bf16x8 pa0, pa1, pa2, pa3;
  SLOAD(0); SWAIT(); SWRITE(0); __syncthreads();
  qkt(pA0, pA1, K_lds, qr, qrope, kbase, true); partialSM(pA0, pA1, m_reg, mnA, alA);
  SLOAD(KVBLK);
  SWAIT(); SWRITE(1); __syncthreads();
  for (int j = 1; j + 1 < NT; j += 2) {
    SBAR(); qkt(pB0, pB1, K_lds + SHM_K, qr, qrope, kbase, j <= jmax);
    finishSM(pA0, pA1, alA, l_reg, pa0, pa1, pa2, pa3); SBAR();
    SLOAD((j + 1) * KVBLK); SBAR();
    if (j - 1 <= jmax) pv_d0(o, vb0, pa0, pa1, pa2, pa3);
    partialSM(pB0, pB1, m_reg, mnB, alB);
    __syncthreads(); SWAIT(); SWRITE(0);
    RESC(alB); __syncthreads();
    SBAR(); qkt(pA0, pA1, K_lds, qr, qrope, kbase, j + 1 <= jmax);
    finishSM(pB0, pB1, alB, l_reg, pa0, pa1, pa2, pa3); SBAR();
    SLOAD((j + 2) * KVBLK); SBAR();
    if (j <= jmax) pv_d0(o, vb0 + (int)SHM_V, pa0, pa1, pa2, pa3);
    partialSM(pA0, pA1, m_reg, mnA, alA);
    __syncthreads(); SWAIT(); SWRITE(1);
    RESC(alA); __syncthreads();
  }
  SBAR(); qkt(pB0, pB1, K_lds + SHM_K, qr, qrope, kbase, NT - 1 <= jmax);
  finishSM(pA0, pA1, alA, l_reg, pa0, pa1, pa2, pa3); SBAR();
  if (NT - 2 <= jmax) pv_d0(o, vb0, pa0, pa1, pa2, pa3);
  partialSM(pB0, pB1, m_reg, mnB, alB);
  __syncthreads(); RESC(alB);
  finishSM(pB0, pB1, alB, l_reg, pa0, pa1, pa2, pa3); SBAR();
  if (NT - 1 <= jmax) pv_d0(o, vb0 + (int)SHM_V, pa0, pa1, pa2, pa3);
  if (hi == 0) li_l[r32] = l_reg; asm volatile("s_waitcnt lgkmcnt(0)" ::: "memory");
  float rli[16];
#pragma unroll
  for (int r = 0; r < 16; ++r) rli[r] = __builtin_amdgcn_rcpf(li_l[crow(r, hi)]);
  bf16_t* Ow = Ob + (long)(wid * QBLK) * LDO;
#pragma unroll
  for (int r = 0; r < 16; ++r) { int orow = crow(r, hi);
#pragma unroll
    for (int d0 = 0; d0 < 4; ++d0) Ow[(long)orow * LDO + d0 * 32 + r32] = f2bf(o[d0][r] * rli[r]); }
  __syncthreads();
#undef SLOAD
#undef SWRITE
#undef SWAIT
#undef RESC
}
}
namespace ret {
constexpr int QP_ = 136;
__device__ __forceinline__ bf16x8 ldfrag(const bf16_t* p) { return *reinterpret_cast<const bf16x8*>(p); }
template <int CL> struct Lay {
    static constexpr int IP = CL + 8;
    static constexpr int QS = 0, KS = QS + CL * QP_ * 2, VT = KS + CL * QP_ * 2, VDT = VT + 32 * IP * 2, IN = VDT + 32 * IP * 2, ST = IN + CL * IP * 2, VS = ST + 32 * QP_ * 2, END = VS + CL * 40 * 2;
};
static_assert(Lay<128>::END <= LDS_BARW, "retention LDS");

template <int CL>
__device__ __forceinline__ void run(const bf16_t* __restrict__ Y, bf16_t* __restrict__ OB, const float* __restrict__ sp, float* __restrict__ so, long tok0, int nch, int h, int es, float lg, char* lds, int tid) {
    using L = Lay<CL>; constexpr int IP = L::IP, NQT = CL / 16, NKS = CL / 32, NPC = CL / 32;
    const int wid = __builtin_amdgcn_readfirstlane(tid >> 6), lane = tid & 63, l15 = lane & 15, l4 = lane >> 4;
    bf16_t* Qs = (bf16_t*)(lds + L::QS); bf16_t* Ks = (bf16_t*)(lds + L::KS); bf16_t* Vt = (bf16_t*)(lds + L::VT); bf16_t* Vdt = (bf16_t*)(lds + L::VDT); bf16_t* In = (bf16_t*)(lds + L::IN); bf16_t* St = (bf16_t*)(lds + L::ST); bf16_t* Vs = (bf16_t*)(lds + L::VS);
    const float gCL = __expf((float)CL * lg);
    f32x4 Sacc[2];
    if (sp) {
#pragma unroll
        for (int ej = 0; ej < 2; ++ej)
#pragma unroll
            for (int r = 0; r < 4; ++r) Sacc[ej][r] = sp[(long)(16 * wid + 4 * l4 + r) * RV + 16 * ej + l15];
    } else { Sacc[0] = (f32x4){0.f, 0.f, 0.f, 0.f}; Sacc[1] = (f32x4){0.f, 0.f, 0.f, 0.f}; }
    for (int i = tid; i < CL * IP / 8; i += 512) reinterpret_cast<u32x4*>(In)[i] = (u32x4){0u, 0u, 0u, 0u};
    u32x4 pq[NPC], pk[NPC], pv;
    const int vk = tid >> 2, ve0 = (tid & 3) * 8;
#define RET_LOAD(cc) do { const bf16_t* yrow_ = Y + (tok0 + (long)(cc) * CL) * INWP; \
        _Pragma("unroll") for (int i = 0; i < NPC; ++i) { const int idx = tid + i * 512, k = idx >> 4, d0 = (idx & 15) * 8; \
            pq[i] = *reinterpret_cast<const u32x4*>(yrow_ + (long)k * INWP + C_RQ + h * 128 + d0); pk[i] = *reinterpret_cast<const u32x4*>(yrow_ + (long)k * INWP + C_RK + h * 128 + d0); } \
        if (tid < 4 * CL) pv = *reinterpret_cast<const u32x4*>(yrow_ + (long)vk * INWP + C_RV + h * 256 + es * 32 + ve0); } while (0)
    RET_LOAD(0);
    for (int c = 0; c < nch; ++c) {
#pragma unroll
        for (int ej = 0; ej < 2; ++ej) { u32x2 w; w.x = cvt_pk_bf16(Sacc[ej][0], Sacc[ej][1]); w.y = cvt_pk_bf16(Sacc[ej][2], Sacc[ej][3]);
            *reinterpret_cast<u32x2*>(St + (16 * ej + l15) * QP_ + 16 * wid + 4 * l4) = w; }
#pragma unroll
        for (int i = 0; i < NPC; ++i) { const int idx = tid + i * 512, k = idx >> 4, d0 = (idx & 15) * 8;
            *reinterpret_cast<u32x4*>(Qs + k * QP_ + d0) = pq[i]; *reinterpret_cast<u32x4*>(Ks + k * QP_ + d0) = pk[i]; }
        if (tid < 4 * CL) *reinterpret_cast<u32x4*>(Vs + vk * 40 + ve0) = pv;
        if (c + 1 < nch) RET_LOAD(c + 1);
        __syncthreads();
        if (tid < 4 * CL) { const int e = tid & 31, kg = tid >> 5; float f[8], fd[8];
#pragma unroll
            for (int j = 0; j < 8; ++j) { f[j] = bf2f(Vs[(8 * kg + j) * 40 + e]); fd[j] = f[j] * __expf((float)(CL - 1 - 8 * kg - j) * lg); }
            *reinterpret_cast<u32x4*>(Vt + e * IP + 8 * kg) = pack8(f); *reinterpret_cast<u32x4*>(Vdt + e * IP + 8 * kg) = pack8(fd); }
#pragma unroll
        for (int it_ = 0; it_ < (NQT * (NQT + 1) / 2 + 7) / 8; ++it_) { const int idx = wid + 8 * it_; if (idx >= NQT * (NQT + 1) / 2) break;
            int qi = 0; while ((qi + 1) * (qi + 2) / 2 <= idx) ++qi; const int kj = idx - qi * (qi + 1) / 2;
            f32x4 a = (f32x4){0.f, 0.f, 0.f, 0.f}; const bf16_t* qp = Qs + (16 * qi + l15) * QP_ + 8 * l4; const bf16_t* kp = Ks + (16 * kj + l15) * QP_ + 8 * l4;
#pragma unroll
            for (int ks = 0; ks < 4; ++ks) a = __builtin_amdgcn_mfma_f32_16x16x32_bf16(ldfrag(qp + 32 * ks), ldfrag(kp + 32 * ks), a, 0, 0, 0);
            const int q0 = 16 * qi + 4 * l4, k = 16 * kj + l15;
#pragma unroll
            for (int r = 0; r < 4; ++r) { const int q = q0 + r; const float dm = (q >= k) ? __expf((float)(q - k) * lg) : 0.f;
                In[q * IP + k] = f2bf(a[r] * dm); } }
        __syncthreads();
#pragma unroll
        for (int ot = 0; ot < (2 * NQT) / 8; ++ot) { const int tI = wid + 8 * ot, qi = tI >> 1, ej = tI & 1; f32x4 a = (f32x4){0.f, 0.f, 0.f, 0.f};
#pragma unroll
            for (int ks = 0; ks < 4; ++ks) a = __builtin_amdgcn_mfma_f32_16x16x32_bf16(ldfrag(Qs + (16 * qi + l15) * QP_ + 32 * ks + 8 * l4), ldfrag(St + (16 * ej + l15) * QP_ + 32 * ks + 8 * l4), a, 0, 0, 0);
#pragma unroll
            for (int r = 0; r < 4; ++r) a[r] *= __expf((float)(16 * qi + 4 * l4 + r + 1) * lg);
#pragma unroll
            for (int ks = 0; ks < NKS; ++ks) if (ks <= (qi >> 1)) a = __builtin_amdgcn_mfma_f32_16x16x32_bf16(ldfrag(In + (16 * qi + l15) * IP + 32 * ks + 8 * l4), ldfrag(Vt + (16 * ej + l15) * IP + 32 * ks + 8 * l4), a, 0, 0, 0);
            bf16_t* op = OB + ((long)(h * 8 + es) * T + tok0 + (long)c * CL + 16 * qi + 4 * l4) * 32 + 16 * ej + l15;
#pragma unroll
            for (int r = 0; r < 4; ++r) op[r * 32] = f2bf(a[r]); }
        { f32x4 s0 = Sacc[0] * gCL, s1 = Sacc[1] * gCL;
#pragma unroll
          for (int ks = 0; ks < NKS; ++ks) { bf16x8 af;
#pragma unroll
              for (int j = 0; j < 8; ++j) af[j] = (short)Ks[(32 * ks + 8 * l4 + j) * QP_ + 16 * wid + l15];
              s0 = __builtin_amdgcn_mfma_f32_16x16x32_bf16(af, ldfrag(Vdt + l15 * IP + 32 * ks + 8 * l4), s0, 0, 0, 0);
              s1 = __builtin_amdgcn_mfma_f32_16x16x32_bf16(af, ldfrag(Vdt + (16 + l15) * IP + 32 * ks + 8 * l4), s1, 0, 0, 0); }
          Sacc[0] = s0; Sacc[1] = s1; }
        __syncthreads();
    }
#undef RET_LOAD
#pragma unroll
    for (int ej = 0; ej < 2; ++ej)
#pragma unroll
        for (int r = 0; r < 4; ++r) so[(long)(16 * wid + 4 * l4 + r) * RV + 16 * ej + l15] = Sacc[ej][r];
}

__device__ __forceinline__ void unit(KParams& p, int l, int u, char* lds) {
    const int tid = otid(); unsigned char* ws = optr(gp(p.ws)); const bf16_t* Y = (const bf16_t*)(ws + WS_Y); bf16_t* OB = (bf16_t*)(ws + WS_OB);
    const bool samp = u >= 256; const int v = samp ? u - 256 : u; const int b = v >> 6, h = (v >> 3) & 7, es = v & 7; const float lg = p.lg[h];
    if (samp) run<64>(Y, OB, gp(p.state_ret) + ((((long)l * DB + b) * RH + h) * RQK) * RV + es * 32, gp(p.out) + O_RETS + ((((long)l * DB + b) * RH + h) * RQK) * RV + es * 32, (long)TP + b * 64, 1, h, es, lg, lds, tid);
    else run<64>(Y, OB, nullptr, gp(p.out) + O_RETP + ((((long)l * NB + b) * RH + h) * RQK) * RV + es * 32, (long)b * SEQ, SEQ / 64, h, es, lg, lds, tid);
}
}
namespace peer {
__device__ __forceinline__ void ins16(float (&l)[16], float x) {
#pragma unroll
    for (int j = 0; j < 16; ++j) { const float hi = fmaxf(l[j], x); x = fminf(l[j], x); l[j] = hi; }
}
#define CE_DESC(a, b) do { const float hi_ = fmaxf(a, b), lo_ = fminf(a, b); a = hi_; b = lo_; } while (0)
#define CE_ASC(a, b) do { const float hi_ = fmaxf(a, b), lo_ = fminf(a, b); a = lo_; b = hi_; } while (0)
__device__ __forceinline__ void sort16_desc(float (&v)[16]) {
#pragma unroll
    for (int k = 2; k <= 16; k <<= 1)
#pragma unroll
        for (int j = k >> 1; j >= 1; j >>= 1)
#pragma unroll
            for (int i = 0; i < 16; ++i) { const int l = i ^ j; if (l > i) { if ((i & k) == 0) CE_DESC(v[i], v[l]); else CE_ASC(v[i], v[l]); } }
}
__device__ __forceinline__ void merge16_desc(float (&l)[16], const float (&o)[16]) {
#pragma unroll
    for (int i = 0; i < 16; ++i) l[i] = fmaxf(l[i], o[15 - i]);
#pragma unroll
    for (int j = 8; j >= 1; j >>= 1)
#pragma unroll
        for (int i = 0; i < 16; ++i) { const int m = i ^ j; if (m > i) CE_DESC(l[i], l[m]); }
}
constexpr int KPITCH = 136;
__device__ __forceinline__ void half_top16(const bf16_t* __restrict__ qrow, const bf16_t* __restrict__ keys, int lane, float (&l)[16]) {
    const int r32 = lane & 31, g = lane >> 5;
#pragma unroll
    for (int j = 0; j < 16; ++j) l[j] = -3.0e38f;
    bf16x8 qf[8];
#pragma unroll
    for (int ks = 0; ks < 8; ++ks) qf[ks] = *reinterpret_cast<const bf16x8*>(qrow + 16 * ks + 8 * g);
#pragma unroll 1
    for (int kb = 0; kb < 4; ++kb) { f32x16 a = f32x16{};
#pragma unroll
        for (int ks = 0; ks < 8; ++ks) { const bf16x8 kf = *reinterpret_cast<const bf16x8*>(keys + (32 * kb + r32) * KPITCH + 16 * ks + 8 * g);
            a = __builtin_amdgcn_mfma_f32_32x32x16_bf16(kf, qf[ks], a, 0, 0, 0); }
        float blk[16];
#pragma unroll
        for (int r = 0; r < 16; ++r) { const unsigned key = (unsigned)(32 * kb + (r & 3) + 8 * (r >> 2) + 4 * g);
            blk[r] = __uint_as_float((__float_as_uint(a[r]) & ~0x7Fu) | key); }
        sort16_desc(blk); merge16_desc(l, blk); }
}
__device__ __forceinline__ void merge_lists(float (&l)[16], const float (&o)[16]) { merge16_desc(l, o); }
__device__ __forceinline__ void select_unit(const bf16_t* __restrict__ QP, const bf16_t* __restrict__ k1, const bf16_t* __restrict__ k2, int* __restrict__ PIDX, float* __restrict__ PW,
                                            int t0, int h, int lane, float* lds_lane  ) {
    const int r32 = lane & 31, g = lane >> 5;
    const bf16_t* qrow = QP + (long)(t0 + r32) * DM + h * 256;
    float la[16], lb[16];
    half_top16(qrow, k1, lane, la);
    half_top16(qrow + 128, k2, lane, lb);
    float m0[16], m1[16];
#pragma unroll
    for (int j = 0; j < 16; ++j) { auto rr = __builtin_amdgcn_permlane32_swap(__float_as_uint(la[j]), __float_as_uint(lb[j]), false, false); m0[j] = __uint_as_float(rr[0]); m1[j] = __uint_as_float(rr[1]); }
    merge_lists(m0, m1);
    float L1[16], L2[16];
#pragma unroll
    for (int j = 0; j < 16; ++j) { auto rr = __builtin_amdgcn_permlane32_swap(__float_as_uint(m0[j]), __float_as_uint(m0[j]), false, false);
        L1[j] = __uint_as_float(rr[0]); L2[j] = __uint_as_float(rr[1]); }
#define CAND(i, j) __uint_as_float((__float_as_uint(L1[i] + L2[j]) & ~0xFFu) | (unsigned)((i) * 16 + (j)))
    float best[16], c2[16], c3[16];
#pragma unroll
    for (int j = 0; j < 16; ++j) best[j] = CAND(0, j);
    sort16_desc(best);
    c2[0] = CAND(1, 0); c2[1] = CAND(1, 1); c2[2] = CAND(1, 2); c2[3] = CAND(1, 3); c2[4] = CAND(1, 4); c2[5] = CAND(1, 5); c2[6] = CAND(1, 6); c2[7] = CAND(1, 7);
    c2[8] = CAND(2, 0); c2[9] = CAND(2, 1); c2[10] = CAND(2, 2); c2[11] = CAND(2, 3); c2[12] = CAND(2, 4); c2[13] = CAND(4, 0); c2[14] = CAND(4, 1); c2[15] = CAND(4, 2);
    sort16_desc(c2); merge16_desc(best, c2);
    c3[0] = CAND(3, 0); c3[1] = CAND(3, 1); c3[2] = CAND(3, 2); c3[3] = CAND(3, 3); c3[4] = CAND(5, 0); c3[5] = CAND(5, 1); c3[6] = CAND(6, 0); c3[7] = CAND(6, 1);
    c3[8] = CAND(7, 0); c3[9] = CAND(7, 1); c3[10] = CAND(8, 0); c3[11] = CAND(9, 0); c3[12] = CAND(10, 0); c3[13] = CAND(11, 0); c3[14] = CAND(12, 0); c3[15] = CAND(13, 0);
    sort16_desc(c3); merge16_desc(best, c3);
    ins16(best, CAND(14, 0)); ins16(best, CAND(15, 0));
#undef CAND
#pragma unroll
    for (int j = 0; j < 16; ++j) { lds_lane[j] = __uint_as_float(__float_as_uint(L1[j]) & 0x7Fu); lds_lane[16 + j] = __uint_as_float(__float_as_uint(L2[j]) & 0x7Fu); }
    asm volatile("s_waitcnt lgkmcnt(0)" ::: "memory");
    float wsum = 0.f, w[16]; int ei[16];
    const float mx = best[0];
#pragma unroll
    for (int k = 0; k < 16; ++k) { const unsigned code = __float_as_uint(best[k]) & 0xFFu; const int i = (int)(code >> 4), j = (int)(code & 15u);
        const int i1 = (int)__float_as_uint(lds_lane[i]), i2 = (int)__float_as_uint(lds_lane[16 + j]); ei[k] = i1 * NKEYS + i2;
        w[k] = __expf(best[k] - mx); wsum += w[k]; }
    const float inv = 1.0f / wsum;
    if (g == 0) { int* ip = PIDX + (long)(t0 + r32) * 128 + h * 16; float* wp = PW + (long)(t0 + r32) * 128 + h * 16;
#pragma unroll
        for (int k = 0; k < 16; k += 4) { *reinterpret_cast<int4*>(ip + k) = make_int4(ei[k], ei[k + 1], ei[k + 2], ei[k + 3]);
            *reinterpret_cast<float4*>(wp + k) = make_float4(w[k] * inv, w[k + 1] * inv, w[k + 2] * inv, w[k + 3] * inv); } }
}

__device__ __forceinline__ float gelu_exact(float x) { return 0.5f * x * (1.0f + erff(x * 0.70710678118654752f)); }

__device__ __forceinline__ void dec16(const u32x4 w, f32x2 (&f)[8]) {
    f[0] = __builtin_amdgcn_cvt_pk_f32_fp8((int)w.x, false); f[1] = __builtin_amdgcn_cvt_pk_f32_fp8((int)w.x, true);
    f[2] = __builtin_amdgcn_cvt_pk_f32_fp8((int)w.y, false); f[3] = __builtin_amdgcn_cvt_pk_f32_fp8((int)w.y, true);
    f[4] = __builtin_amdgcn_cvt_pk_f32_fp8((int)w.z, false); f[5] = __builtin_amdgcn_cvt_pk_f32_fp8((int)w.z, true);
    f[6] = __builtin_amdgcn_cvt_pk_f32_fp8((int)w.w, false); f[7] = __builtin_amdgcn_cvt_pk_f32_fp8((int)w.w, true);
}
__device__ __forceinline__ void gather_token(const bf16_t* __restrict__ H, const unsigned char* __restrict__ PU, const unsigned char* __restrict__ PV, const float* __restrict__ SU, const float* __restrict__ SV,
                                             const int* __restrict__ PIDX, const float* __restrict__ PW, float* __restrict__ X, const float* __restrict__ gate  , int t, int lane) {
    f32x2 xf[2][8];
#pragma unroll
    for (int hlf = 0; hlf < 2; ++hlf)
#pragma unroll
        for (int q = 0; q < 2; ++q) { const u32x4 w = *reinterpret_cast<const u32x4*>(H + (long)t * DM + 1024 * hlf + 16 * lane + 8 * q);
            xf[hlf][4 * q + 0] = (f32x2){bflo(w.x), bfhi(w.x)}; xf[hlf][4 * q + 1] = (f32x2){bflo(w.y), bfhi(w.y)}; xf[hlf][4 * q + 2] = (f32x2){bflo(w.z), bfhi(w.z)}; xf[hlf][4 * q + 3] = (f32x2){bflo(w.w), bfhi(w.w)}; }
    f32x2 out[2][8];
#pragma unroll
    for (int hlf = 0; hlf < 2; ++hlf)
#pragma unroll
        for (int i = 0; i < 8; ++i) out[hlf][i] = (f32x2){0.f, 0.f};
    const int myidx0 = PIDX[(long)t * 128 + lane], myidx1 = PIDX[(long)t * 128 + 64 + lane];
    const float myw0 = PW[(long)t * 128 + lane], myw1 = PW[(long)t * 128 + 64 + lane];
    const float msu0 = SU[myidx0], msu1 = SU[myidx1], msv0 = SV[myidx0], msv1 = SV[myidx1];
    for (int hk = 0; hk < 128; hk += 4) {
        const int src = hk & 63; const bool lo = hk < 64;
        const int selidx = lo ? myidx0 : myidx1; const int selw = __float_as_int(lo ? myw0 : myw1), selsu = __float_as_int(lo ? msu0 : msu1), selsv = __float_as_int(lo ? msv0 : msv1);
        int e[4]; float g[4], su[4], sv[4];
#pragma unroll
        for (int k = 0; k < 4; ++k) { e[k] = __builtin_amdgcn_readlane(selidx, src + k); g[k] = __int_as_float(__builtin_amdgcn_readlane(selw, src + k));
            su[k] = __int_as_float(__builtin_amdgcn_readlane(selsu, src + k)); sv[k] = __int_as_float(__builtin_amdgcn_readlane(selsv, src + k)); }
        u32x4 uw[4][2], vw[4][2];
#pragma unroll
        for (int k = 0; k < 4; ++k) { uw[k][0] = *reinterpret_cast<const u32x4*>(PU + ((long)(lane >> 3) * NEXP + e[k]) * 128 + 16 * (lane & 7)); uw[k][1] = *reinterpret_cast<const u32x4*>(PU + ((long)(8 + (lane >> 3)) * NEXP + e[k]) * 128 + 16 * (lane & 7)); }
#pragma unroll
        for (int k = 0; k < 4; ++k) { { const u32x2 a0 = *reinterpret_cast<const u32x2*>(PV + ((long)(2 * lane) * NEXP + e[k]) * 8), a1 = *reinterpret_cast<const u32x2*>(PV + ((long)(2 * lane + 1) * NEXP + e[k]) * 8);
              const u32x2 b0 = *reinterpret_cast<const u32x2*>(PV + ((long)(128 + 2 * lane) * NEXP + e[k]) * 8), b1 = *reinterpret_cast<const u32x2*>(PV + ((long)(129 + 2 * lane) * NEXP + e[k]) * 8);
              vw[k][0] = (u32x4){a0.x, a0.y, a1.x, a1.y}; vw[k][1] = (u32x4){b0.x, b0.y, b1.x, b1.y}; } }
        float a[4];
#pragma unroll
        for (int k = 0; k < 4; ++k) { f32x2 d = (f32x2){0.f, 0.f};
#pragma unroll
            for (int hlf = 0; hlf < 2; ++hlf) { f32x2 f[8]; dec16(uw[k][hlf], f);
#pragma unroll
                for (int i = 0; i < 8; ++i) d = __builtin_elementwise_fma(f[i], xf[hlf][i], d); }
            a[k] = wave_sum(d[0] + d[1]); }
#pragma unroll
        for (int k = 0; k < 4; ++k) { const float ak = g[k] * gelu_exact(a[k] * su[k]) * sv[k]; const f32x2 a2 = (f32x2){ak, ak};
#pragma unroll
            for (int hlf = 0; hlf < 2; ++hlf) { f32x2 f[8]; dec16(vw[k][hlf], f);
#pragma unroll
                for (int i = 0; i < 8; ++i) out[hlf][i] = __builtin_elementwise_fma(f[i], a2, out[hlf][i]); } }
    }
    const float* gr = gate + (long)cond_row(t) * 12288;
#pragma unroll
    for (int hlf = 0; hlf < 2; ++hlf)
#pragma unroll
        for (int q = 0; q < 4; ++q) { const int c = 1024 * hlf + 16 * lane + 4 * q; float* xp = X + (long)t * DM + c;
            const f32x4 gv = *reinterpret_cast<const f32x4*>(gr + c); f32x4 xv = *reinterpret_cast<const f32x4*>(xp);
            xv[0] += gv[0] * out[hlf][2 * q][0]; xv[1] += gv[1] * out[hlf][2 * q][1]; xv[2] += gv[2] * out[hlf][2 * q + 1][0]; xv[3] += gv[3] * out[hlf][2 * q + 1][1];
            *reinterpret_cast<f32x4*>(xp) = xv; }
}

constexpr int SW = 128, NSL = DM / SW;
struct XInfo { int rank, xi, nx, nloc; };
__device__ __forceinline__ void upass(const bf16_t* __restrict__ H, const unsigned char* __restrict__ PU, const int* __restrict__ PIDX, const float* __restrict__ PW, const float* __restrict__ SU, const float* __restrict__ SV,
                                      float* __restrict__ DOTP, unsigned* __restrict__ PACKT, const XInfo xin, int wid, int lane) {
    const int g = lane >> 3, c = lane & 7; const int nwv = xin.nloc * 8;
    const int tlo = (int)((long)T * xin.xi / xin.nx), thi = (int)((long)T * (xin.xi + 1) / xin.nx); const int wv = tlo + xin.rank * 8 + wid;
    float* dp = DOTP;
    for (int s = 0; s < NSL; ++s) { const bool first = (s == 0), lastS = (s == NSL - 1);
        const __amdgpu_buffer_rsrc_t urs = __builtin_amdgcn_make_buffer_rsrc((void*)(PU + (long)s * NEXP * SW), 0, NEXP * SW, 0x00020000);
#define UP_ROW(e_) __builtin_bit_cast(u32x4, __builtin_amdgcn_raw_buffer_load_b128(urs, (e_) * SW + 16 * c, 0, 0))
#define UP_IDX(tt, q4) (*reinterpret_cast<const int4*>(PIDX + (long)(tt) * 128 + 16 * g + 4 * (q4)))
#define UP_X(tt, q2) (*reinterpret_cast<const u32x4*>(H + (long)(tt) * DM + SW * s + 16 * c + 8 * (q2)))
        if (wv >= thi) continue;
        u32x4 A[8], B[8]; int4 en[4]; u32x4 xn[2];
        { int4 e0[4];
#pragma unroll
          for (int q4 = 0; q4 < 4; ++q4) e0[q4] = UP_IDX(wv, q4);
          A[0] = UP_ROW(e0[0].x); A[1] = UP_ROW(e0[0].y); A[2] = UP_ROW(e0[0].z); A[3] = UP_ROW(e0[0].w); A[4] = UP_ROW(e0[1].x); A[5] = UP_ROW(e0[1].y); A[6] = UP_ROW(e0[1].z); A[7] = UP_ROW(e0[1].w);
          B[0] = UP_ROW(e0[2].x); B[1] = UP_ROW(e0[2].y); B[2] = UP_ROW(e0[2].z); B[3] = UP_ROW(e0[2].w); B[4] = UP_ROW(e0[3].x); B[5] = UP_ROW(e0[3].y); B[6] = UP_ROW(e0[3].z); B[7] = UP_ROW(e0[3].w);
          const int t1 = (wv + nwv < thi) ? wv + nwv : wv;
#pragma unroll
          for (int q4 = 0; q4 < 4; ++q4) en[q4] = UP_IDX(t1, q4);
          xn[0] = UP_X(wv, 0); xn[1] = UP_X(wv, 1); }
        f32x2 dnx = (f32x2){0.f, 0.f};
        if (!first) dnx = *reinterpret_cast<const f32x2*>(dp + (long)wv * 128 + 16 * g + 2 * c);
#pragma unroll 1
        for (int t = wv; t < thi; t += nwv) {
            const int tn = (t + nwv < thi) ? t + nwv : t, tnn = (tn + nwv < thi) ? tn + nwv : tn;
            const f32x2 dcur = dnx;
            if (!first) dnx = *reinterpret_cast<const f32x2*>(dp + (long)tn * 128 + 16 * g + 2 * c);
            f32x2 xf[8];
#pragma unroll
            for (int q2 = 0; q2 < 2; ++q2) { const u32x4 hw = xn[q2];
                xf[4 * q2 + 0] = (f32x2){bflo(hw.x), bfhi(hw.x)}; xf[4 * q2 + 1] = (f32x2){bflo(hw.y), bfhi(hw.y)}; xf[4 * q2 + 2] = (f32x2){bflo(hw.z), bfhi(hw.z)}; xf[4 * q2 + 3] = (f32x2){bflo(hw.w), bfhi(hw.w)}; }
            xn[0] = UP_X(tn, 0); xn[1] = UP_X(tn, 1);
            float d[16];
#pragma unroll
            for (int i = 0; i < 8; ++i) { f32x2 f[8]; dec16(A[i], f); f32x2 a = (f32x2){0.f, 0.f};
#pragma unroll
                for (int k = 0; k < 8; ++k) a = __builtin_elementwise_fma(f[k], xf[k], a);
                d[i] = a[0] + a[1]; }
            A[0] = UP_ROW(en[0].x); A[1] = UP_ROW(en[0].y); A[2] = UP_ROW(en[0].z); A[3] = UP_ROW(en[0].w); A[4] = UP_ROW(en[1].x); A[5] = UP_ROW(en[1].y); A[6] = UP_ROW(en[1].z); A[7] = UP_ROW(en[1].w);
#pragma unroll
            for (int i = 0; i < 8; ++i) { f32x2 f[8]; dec16(B[i], f); f32x2 a = (f32x2){0.f, 0.f};
#pragma unroll
                for (int k = 0; k < 8; ++k) a = __builtin_elementwise_fma(f[k], xf[k], a);
                d[8 + i] = a[0] + a[1]; }
            B[0] = UP_ROW(en[2].x); B[1] = UP_ROW(en[2].y); B[2] = UP_ROW(en[2].z); B[3] = UP_ROW(en[2].w); B[4] = UP_ROW(en[3].x); B[5] = UP_ROW(en[3].y); B[6] = UP_ROW(en[3].z); B[7] = UP_ROW(en[3].w);
#pragma unroll
            for (int q4 = 0; q4 < 4; ++q4) en[q4] = UP_IDX(tnn, q4);
            float r8[8], r4[4], r2[2];
#pragma unroll
            for (int k = 0; k < 8; ++k) { const float keep = (c & 4) ? d[k + 8] : d[k], send = (c & 4) ? d[k] : d[k + 8]; r8[k] = keep + sx<4>(send); }
#pragma unroll
            for (int k = 0; k < 4; ++k) { const float keep = (c & 2) ? r8[k + 4] : r8[k], send = (c & 2) ? r8[k] : r8[k + 4]; r4[k] = keep + sx<2>(send); }
#pragma unroll
            for (int k = 0; k < 2; ++k) { const float keep = (c & 1) ? r4[k + 2] : r4[k], send = (c & 1) ? r4[k] : r4[k + 2]; r2[k] = keep + sx<1>(send); }
            float* o = dp + (long)t * 128 + 16 * g + 2 * c;
            f32x2 acc = (f32x2){r2[0], r2[1]};
            acc += dcur;
            if (!lastS) *reinterpret_cast<f32x2*>(o) = acc;
            else {
                const int p0 = 16 * g + 2 * c; const int2 ee = *reinterpret_cast<const int2*>(PIDX + (long)t * 128 + p0); const f32x2 gw = *reinterpret_cast<const f32x2*>(PW + (long)t * 128 + p0);
                const float a0 = gw[0] * gelu_exact(acc[0] * SU[ee.x]) * SV[ee.x], a1 = gw[1] * gelu_exact(acc[1] * SU[ee.y]) * SV[ee.y];
                u32x2 pk; pk.x = (cvt_pk_bf16(0.f, a0) & 0xffff0000u) | (unsigned)ee.x; pk.y = (cvt_pk_bf16(0.f, a1) & 0xffff0000u) | (unsigned)ee.y;
                *reinterpret_cast<u32x2*>(PACKT + ((long)(p0 >> 2) * T + t) * 4 + (p0 & 3)) = pk; }
        }
#undef UP_ROW
#undef UP_IDX
#undef UP_X
    }
}
__device__ __forceinline__ void actpass(const float* __restrict__ DOTP, const int* __restrict__ PIDX, const float* __restrict__ PW, const float* __restrict__ SU, const float* __restrict__ SV, float* __restrict__ ACT, int nx, long gt, long nt) {
    for (long i = gt; i < (long)T * 128; i += nt) { float dsum = 0.f;
        for (int x = 0; x < nx; ++x) dsum += DOTP[(long)x * T * 128 + i];
        const int e = PIDX[i]; const float av = PW[i] * gelu_exact(dsum * SU[e]) * SV[e]; const long t = i >> 7; const int pp = (int)(i & 127);
        reinterpret_cast<unsigned*>(ACT)[((long)(pp >> 2) * T + t) * 4 + (pp & 3)] = (cvt_pk_bf16(0.f, av) & 0xffff0000u) | (unsigned)e; }
}
__device__ __forceinline__ void vpass(const unsigned char* __restrict__ PV, const int* __restrict__ PIDX, const float* __restrict__ ACT, float* __restrict__ X, const float* __restrict__ gate, const XInfo xin, int wid, int lane) {
    const int g = lane >> 3, c = lane & 7; const int wv = xin.rank * 8 + wid, nwv = xin.nloc * 8;
    for (int s = xin.xi; s < NSL; s += xin.nx) {
        int4 en[4]; f32x4 an[4];
#pragma unroll
        for (int q4 = 0; q4 < 4; ++q4) { en[q4] = *reinterpret_cast<const int4*>(PIDX + (long)(wv < T ? wv : 0) * 128 + 16 * g + 4 * q4); an[q4] = *reinterpret_cast<const f32x4*>(ACT + (long)(wv < T ? wv : 0) * 128 + 16 * g + 4 * q4); }
        for (int t = wv; t < T; t += nwv) {
            int e[16]; float a[16];
#pragma unroll
            for (int q4 = 0; q4 < 4; ++q4) { e[4 * q4] = en[q4].x; e[4 * q4 + 1] = en[q4].y; e[4 * q4 + 2] = en[q4].z; e[4 * q4 + 3] = en[q4].w; a[4 * q4] = an[q4][0]; a[4 * q4 + 1] = an[q4][1]; a[4 * q4 + 2] = an[q4][2]; a[4 * q4 + 3] = an[q4][3]; }
            u32x4 w[16];
#pragma unroll
            for (int i = 0; i < 16; ++i) w[i] = *reinterpret_cast<const u32x4*>(PV + ((long)s * NEXP + e[i]) * SW + 16 * c);
            { const int tn = (t + nwv < T) ? t + nwv : t;
#pragma unroll
              for (int q4 = 0; q4 < 4; ++q4) { en[q4] = *reinterpret_cast<const int4*>(PIDX + (long)tn * 128 + 16 * g + 4 * q4); an[q4] = *reinterpret_cast<const f32x4*>(ACT + (long)tn * 128 + 16 * g + 4 * q4); } }
            f32x2 o[8];
#pragma unroll
            for (int k = 0; k < 8; ++k) o[k] = (f32x2){0.f, 0.f};
#pragma unroll
            for (int i = 0; i < 16; ++i) { f32x2 f[8]; dec16(w[i], f); const f32x2 a2 = (f32x2){a[i], a[i]};
#pragma unroll
                for (int k = 0; k < 8; ++k) o[k] = __builtin_elementwise_fma(f[k], a2, o[k]); }
            f32x2 r4[4], r2[2], r1;
#pragma unroll
            for (int k = 0; k < 4; ++k) { const f32x2 keep = (g & 4) ? o[k + 4] : o[k], send = (g & 4) ? o[k] : o[k + 4]; r4[k] = keep + (f32x2){sx<32>(send[0]), sx<32>(send[1])}; }
#pragma unroll
            for (int k = 0; k < 2; ++k) { const f32x2 keep = (g & 2) ? r4[k + 2] : r4[k], send = (g & 2) ? r4[k] : r4[k + 2]; r2[k] = keep + (f32x2){sx<16>(send[0]), sx<16>(send[1])}; }
            { const f32x2 keep = (g & 1) ? r2[1] : r2[0], send = (g & 1) ? r2[0] : r2[1]; r1 = keep + (f32x2){sx<8>(send[0]), sx<8>(send[1])}; }
            const int col = SW * s + 16 * c + 2 * g;
            const f32x2 gv = *reinterpret_cast<const f32x2*>(gate + (long)cond_row(t) * 12288 + col);
            float* xp = X + (long)t * DM + col; f32x2 xv = *reinterpret_cast<const f32x2*>(xp);
            xv += gv * r1; *reinterpret_cast<f32x2*>(xp) = xv;
        }
    }
}

__device__ __forceinline__ void vpass_lds(const unsigned char* __restrict__ PV, const unsigned* __restrict__ PACKT, float* __restrict__ X, const float* __restrict__ gate, char* lds, int bid, int nb, int s_end, int tid) {
    const int wid = tid >> 6, lane = tid & 63;
    for (int s = bid; s < s_end; s += nb) {
        __syncthreads();
        { const u32x4* src = reinterpret_cast<const u32x4*>(PV + (long)s * NEXP * 8); u32x4* dst = reinterpret_cast<u32x4*>(lds);
#pragma unroll 4
          for (int i = tid; i < NEXP * 8 / 16; i += 512) dst[i] = src[i]; }
        __syncthreads();
        u32x4 h0[8], h1[8];
        const __amdgpu_buffer_rsrc_t vrs = __builtin_amdgcn_make_buffer_rsrc((void*)PACKT, 0, (int)((size_t)T * 128 * 4), 0x00020000);
#define VP_LD(k, toff) __builtin_bit_cast(u32x4, __builtin_amdgcn_raw_buffer_load_b128(vrs, (int)(toff), (int)((size_t)(k) * T * 16), 0))
        { const unsigned toff = (unsigned)(wid * 64 + lane) * 16u;
#pragma unroll
          for (int k = 0; k < 8; ++k) h0[k] = VP_LD(k, toff);
#pragma unroll
          for (int k = 0; k < 8; ++k) h1[k] = VP_LD(8 + k, toff); }
#define VP_STEP(HB) do { _Pragma("unroll") for (int kk = 0; kk < 8; kk += 2) { unsigned pw[8]; \
            _Pragma("unroll") for (int k = 0; k < 2; ++k) { pw[4 * k] = HB[kk + k].x; pw[4 * k + 1] = HB[kk + k].y; pw[4 * k + 2] = HB[kk + k].z; pw[4 * k + 3] = HB[kk + k].w; } \
            u32x2 w[8]; \
            _Pragma("unroll") for (int k = 0; k < 8; ++k) w[k] = *reinterpret_cast<const u32x2*>(lds + (pw[k] & 0xffffu) * 8u); \
            _Pragma("unroll") for (int k = 0; k < 8; ++k) { const float a = __uint_as_float(pw[k] & 0xffff0000u); \
                const f32x2 f0 = __builtin_amdgcn_cvt_pk_f32_fp8((int)w[k].x, false), f1 = __builtin_amdgcn_cvt_pk_f32_fp8((int)w[k].x, true), f2 = __builtin_amdgcn_cvt_pk_f32_fp8((int)w[k].y, false), f3 = __builtin_amdgcn_cvt_pk_f32_fp8((int)w[k].y, true); \
                acc[0] = fmaf(a, f0[0], acc[0]); acc[1] = fmaf(a, f0[1], acc[1]); acc[2] = fmaf(a, f1[0], acc[2]); acc[3] = fmaf(a, f1[1], acc[3]); \
                acc[4] = fmaf(a, f2[0], acc[4]); acc[5] = fmaf(a, f2[1], acc[5]); acc[6] = fmaf(a, f3[0], acc[6]); acc[7] = fmaf(a, f3[1], acc[7]); } } } while (0)
#pragma unroll 1
        for (int tg = wid; tg < T / 64; tg += 8) { const int t = tg * 64 + lane; const int tgn = (tg + 8 < T / 64) ? tg + 8 : tg;
            const unsigned toff = (unsigned)t * 16u, toffn = (unsigned)(tgn * 64 + lane) * 16u;
            float acc[8];
#pragma unroll
            for (int j = 0; j < 8; ++j) acc[j] = 0.f;
            VP_STEP(h0);
#pragma unroll
            for (int k = 0; k < 8; ++k) h0[k] = VP_LD(16 + k, toff);
            VP_STEP(h1);
#pragma unroll
            for (int k = 0; k < 8; ++k) h1[k] = VP_LD(24 + k, toff);
            VP_STEP(h0);
#pragma unroll
            for (int k = 0; k < 8; ++k) h0[k] = VP_LD(k, toffn);
            VP_STEP(h1);
#pragma unroll
            for (int k = 0; k < 8; ++k) h1[k] = VP_LD(8 + k, toffn);
            const float* gr = gate + (long)cond_row(t) * 12288 + 8 * s; float* xp = X + (long)t * DM + 8 * s;
            const f32x4 g0 = *reinterpret_cast<const f32x4*>(gr), g1 = *reinterpret_cast<const f32x4*>(gr + 4);
            f32x4 x0 = *reinterpret_cast<const f32x4*>(xp), x1 = *reinterpret_cast<const f32x4*>(xp + 4);
            x0[0] += g0[0] * acc[0]; x0[1] += g0[1] * acc[1]; x0[2] += g0[2] * acc[2]; x0[3] += g0[3] * acc[3];
            x1[0] += g1[0] * acc[4]; x1[1] += g1[1] * acc[5]; x1[2] += g1[2] * acc[6]; x1[3] += g1[3] * acc[7];
            *reinterpret_cast<f32x4*>(xp) = x0; *reinterpret_cast<f32x4*>(xp + 4) = x1; }
#undef VP_STEP
#undef VP_LD
    }
    __syncthreads();
}
}
namespace ph {
__device__ __forceinline__ int gwave() { return obid() * 8 + (otid() >> 6); }
__device__ __forceinline__ int nwaves() { return ogrid() * 8; }
__device__ __forceinline__ long gthread() { return (long)obid() * 512 + otid(); }
__device__ __forceinline__ long nthreads() { return (long)ogrid() * 512; }

__device__ __forceinline__ void transpose_tile(const float* __restrict__ src, int C, int r0, int c0, bf16_t* __restrict__ dst, long dpitch, float* tile) {
    const int tid = otid();
#pragma unroll
    for (int i = 0; i < 8; ++i) { const int idx = tid + 512 * i, r = idx >> 6, c = idx & 63; tile[r * 65 + c] = src[(long)(r0 + r) * C + c0 + c]; }
    __syncthreads();
    { const int c = tid >> 3, rc = (tid & 7) * 8; float f[8];
#pragma unroll
      for (int j = 0; j < 8; ++j) f[j] = tile[(rc + j) * 65 + c];
      *reinterpret_cast<u32x4*>(dst + (long)(c0 + c) * dpitch + r0 + rc) = pack8(f); }
    __syncthreads();
}

__device__ __forceinline__ void zero_chunks(bf16_t* base, long nrows, long rowpitch, int col0, int nchunk) {
    const long total = nrows * nchunk;
    for (long i = gthread(); i < total; i += nthreads()) { const long r = i / nchunk; const int ch = (int)(i % nchunk);
        *reinterpret_cast<u32x4*>(base + r * rowpitch + col0 + ch * 8) = (u32x4){0u, 0u, 0u, 0u}; }
}

__device__ __forceinline__ void prologue(KParams& p, char* lds) {
    unsigned char* ws = optr(gp(p.ws)); const int tid = otid();
    float* tile = (float*)lds;
    { struct TJob { const float* src; bf16_t* dst; int R, C, r0, c0, perm; };
      auto decode = [&](int it) { TJob j; j.perm = 0; const int l = it / 10656; int r = it % 10656;
        if (r < 5664) { j.src = gp(p.w_in) + (long)l * DM * INW; j.R = DM; j.C = INW; j.dst = (bf16_t*)(ws + WS_WIN) + (long)l * INWP * DM; }
        else if (r < 6048) { r -= 5664; j.src = gp(p.w_uq) + (long)l * 512 * 3072; j.R = 512; j.C = 3072; j.dst = (bf16_t*)(ws + WS_WUQ) + (long)l * 3072 * 512; j.perm = 1; }
        else if (r < 6560) { r -= 6048; j.src = gp(p.w_ukv) + (long)l * 512 * 4096; j.R = 512; j.C = 4096; j.dst = (bf16_t*)(ws + WS_WUKV) + (long)l * 4096 * 512; }
        else { r -= 6560; const int m = r >> 10; r &= 1023; j.R = DM; j.C = DM;
            j.src = (m == 0 ? gp(p.w_a) : m == 1 ? gp(p.w_b) : m == 2 ? gp(p.w_o) : gp(p.w_pq)) + (long)l * DM * DM;
            j.dst = (bf16_t*)(ws + (m == 0 ? WS_WA : m == 1 ? WS_WB : m == 2 ? WS_WO : WS_WPQ)) + (long)l * DM * DM; }
        const int ntc = j.C / 64; j.r0 = (r / ntc) * 64; j.c0 = (r % ntc) * 64; return j; };
      const int NTILES = 2 * 10656, G_ = ogrid(); int it = obid(); float v[8]; TJob cur{};
      if (it < NTILES) { cur = decode(it);
#pragma unroll
        for (int i = 0; i < 8; ++i) { const int idx = tid + 512 * i, r = idx >> 6, c = idx & 63; v[i] = cur.src[(long)(cur.r0 + r) * cur.C + cur.c0 + c]; } }
      while (it < NTILES) { const int itn = it + G_; float vn[8]; TJob nxt{};
        if (itn < NTILES) { nxt = decode(itn);
#pragma unroll
            for (int i = 0; i < 8; ++i) { const int idx = tid + 512 * i, r = idx >> 6, c = idx & 63; vn[i] = nxt.src[(long)(nxt.r0 + r) * nxt.C + nxt.c0 + c]; } }
#pragma unroll
        for (int i = 0; i < 8; ++i) { const int idx = tid + 512 * i, r = idx >> 6, c = idx & 63; tile[r * 65 + c] = v[i]; }
        __syncthreads();
        { const int c = tid >> 3, rc = (tid & 7) * 8; float f[8];
#pragma unroll
          for (int jj = 0; jj < 8; ++jj) f[jj] = tile[(rc + jj) * 65 + c];
          int drow = cur.c0 + c;
          if (cur.perm) { const int gq = drow / 768, o = drow - 768 * gq, hh = o / 192, w = o - 192 * hh;
              drow = 768 * gq + (w < 128 ? 128 * hh + w : (w < 160 ? 512 + 32 * hh + (w - 128) : 640 + 32 * hh + (w - 160))); }
          *reinterpret_cast<u32x4*>(cur.dst + (long)drow * cur.R + cur.r0 + rc) = pack8(f); }
        __syncthreads();
#pragma unroll
        for (int i = 0; i < 8; ++i) v[i] = vn[i];
        cur = nxt; it = itn; } }
    for (long i = gthread(); i < 2L * 16 * 512 * 32; i += nthreads()) { const int ch = (int)(i & 31); const long row = i >> 5; const int c = (int)(row & 511), h = (int)((row >> 9) & 15), l = (int)(row >> 13);
        u32x4 w = (u32x4){0u, 0u, 0u, 0u};
        if (ch < 16) { const float* s = gp(p.w_ukv) + (((long)l * 512 + c) * 16 + h) * 256 + ch * 8; float f[8];
#pragma unroll
            for (int j = 0; j < 8; ++j) f[j] = s[j];
            w = pack8(f); }
        *reinterpret_cast<u32x4*>((bf16_t*)(ws + WS_WUK) + row * 256 + ch * 8) = w; }
    for (long i = gthread(); i < 2L * 4096; i += nthreads()) { const bool second = i >= 4096; const long j8 = (second ? i - 4096 : i) * 8; const float* s = (second ? gp(p.peer_k2) : gp(p.peer_k1)) + j8; float f[8];
#pragma unroll
        for (int j = 0; j < 8; ++j) f[j] = s[j];
        *reinterpret_cast<u32x4*>((bf16_t*)(ws + (second ? WS_PK2 : WS_PK1)) + j8) = pack8(f); }
    for (int l = 0; l < 2; ++l) zero_chunks((bf16_t*)(ws + WS_WIN) + ((long)l * INWP + INW) * DM, INWP - INW, DM, 0, DM / 8);
    for (int b = 0; b < DB; ++b) zero_chunks((bf16_t*)(ws + WS_CKA) + ((long)b * KPAD + KALL) * QLD, KPAD - KALL, QLD, 0, QLD / 8);
    zero_chunks((bf16_t*)(ws + WS_CKA), (long)DB * KPAD, QLD, 576, 8);
    zero_chunks((bf16_t*)(ws + WS_CKT), (long)DB * 512, KPAD, KALL, (KPAD - KALL) / 8);
    zero_chunks((bf16_t*)(ws + WS_QL), (long)DB * 1024, QLD, 576, 8);
    for (long i = gthread(); i < 4096L * 96; i += nthreads()) { const int pos = (int)(i / 96), k = (int)(i % 96); const bool big = k >= 32; const int fi = big ? k - 32 : k; const float d = big ? 128.f : 64.f;
        const float inv = __builtin_amdgcn_exp2f(-(2.0f * (float)fi / d) * 13.287712379549449f);
        const float ang = (float)pos * inv; double rv = (double)ang * 0.15915494309189535; rv -= floor(rv); const float fr = (float)rv;
        float* dst = big ? (float*)(ws + WS_TAB128) + ((long)pos * 64 + fi) * 2 : (float*)(ws + WS_TAB64) + ((long)pos * 32 + fi) * 2;
        dst[0] = __builtin_amdgcn_cosf(fr); dst[1] = __builtin_amdgcn_sinf(fr); }
    { float* sc = (float*)lds;
      for (int it = obid(); it < 2 * 12 * 8; it += ogrid()) { const int l = it / 96, cc = (it % 96) / 8, ks = it % 8;
        __syncthreads();
        for (int i = tid; i < NCOND * 256; i += 512) { const int r = i >> 8, k = i & 255; const float c = r < NB ? gp(p.c_prompt)[(long)r * DM + ks * 256 + k] : gp(p.c_sample)[(long)(r - NB) * DM + ks * 256 + k]; sc[i] = siluf_(c); }
        __syncthreads();
        float a0[NCOND], a1[NCOND];
#pragma unroll
        for (int r = 0; r < NCOND; ++r) { a0[r] = 0.f; a1[r] = 0.f; }
        const float* wp = gp(p.w_ada) + ((long)l * DM + ks * 256) * 12288 + cc * 1024 + 2 * tid;
#pragma unroll 1
        for (int k = 0; k < 256; k += 4) { const f32x2 w0 = *reinterpret_cast<const f32x2*>(wp), w1 = *reinterpret_cast<const f32x2*>(wp + 12288), w2 = *reinterpret_cast<const f32x2*>(wp + 2 * 12288), w3 = *reinterpret_cast<const f32x2*>(wp + 3 * 12288);
            wp += 4 * 12288;
#pragma unroll
            for (int r = 0; r < NCOND; ++r) { const f32x4 s = *reinterpret_cast<const f32x4*>(sc + r * 256 + k);
                a0[r] = fmaf(s[0], w0[0], fmaf(s[1], w1[0], fmaf(s[2], w2[0], fmaf(s[3], w3[0], a0[r]))));
                a1[r] = fmaf(s[0], w0[1], fmaf(s[1], w1[1], fmaf(s[2], w2[1], fmaf(s[3], w3[1], a1[r]))));
                if ((r % 6) == 5) __builtin_amdgcn_sched_barrier(0); } }
        float* dst = (float*)(ws + WS_ADAP) + (((long)ks * 2 + l) * NCOND) * 12288 + cc * 1024 + 2 * tid;
#pragma unroll
        for (int r = 0; r < NCOND; ++r) *reinterpret_cast<f32x2*>(dst + (long)r * 12288) = (f32x2){a0[r], a1[r]}; }
      __syncthreads(); }
}

__device__ __forceinline__ void wpq_int8(KParams& p) {
    unsigned char* ws = optr(gp(p.ws)); const int lane = otid() & 63;
    for (int r = gwave(); r < 2 * DM; r += nwaves()) { const bf16_t* src = (const bf16_t*)(ws + WS_WPQ) + (long)r * DM; float f[4][8]; float am = 0.f;
#pragma unroll
        for (int j = 0; j < 4; ++j) { unpack8(*reinterpret_cast<const u32x4*>(src + 512 * j + 8 * lane), f[j]);
#pragma unroll
            for (int i = 0; i < 8; ++i) am = fmaxf(am, fabsf(f[j][i])); }
        am = wave_max(am); const float qs = am > 0.f ? 127.0f / am : 0.f;
#pragma unroll
        for (int j = 0; j < 4; ++j) { unsigned w2[2];
#pragma unroll
            for (int hh = 0; hh < 2; ++hh) { unsigned w = 0u;
#pragma unroll
                for (int i = 0; i < 4; ++i) w |= ((unsigned)((int)__builtin_rintf(f[j][4 * hh + i] * qs) & 0xff)) << (8 * i);
                w2[hh] = w; }
            *reinterpret_cast<u32x2*>(ws + WS_WPQ8 + (long)r * DM + 512 * j + 8 * lane) = (u32x2){w2[0], w2[1]}; }
        if (lane == 0) ((float*)(ws + WS_SB8))[r] = am * (1.0f / 127.0f); }
}

__device__ __forceinline__ void wb_int8(KParams& p, int l) {
    unsigned char* ws = optr(gp(p.ws)); const int lane = otid() & 63;
    for (int r = gwave(); r < DM; r += nwaves()) { const bf16_t* src = (const bf16_t*)(ws + WS_WB) + ((long)l * DM + r) * DM; float f[4][8]; float am = 0.f;
#pragma unroll
        for (int j = 0; j < 4; ++j) { unpack8(*reinterpret_cast<const u32x4*>(src + 512 * j + 8 * lane), f[j]);
#pragma unroll
            for (int i = 0; i < 8; ++i) am = fmaxf(am, fabsf(f[j][i])); }
        am = wave_max(am); const float qs = am > 0.f ? 127.0f / am : 0.f;
#pragma unroll
        for (int j = 0; j < 4; ++j) { unsigned w2[2];
#pragma unroll
            for (int hh = 0; hh < 2; ++hh) { unsigned w = 0u;
#pragma unroll
                for (int i = 0; i < 4; ++i) w |= ((unsigned)((int)__builtin_rintf(f[j][4 * hh + i] * qs) & 0xff)) << (8 * i);
                w2[hh] = w; }
            *reinterpret_cast<u32x2*>(ws + WS_WB8 + (long)r * DM + 512 * j + 8 * lane) = (u32x2){w2[0], w2[1]}; }
        if (lane == 0) ((float*)(ws + WS_SBB))[r] = am * (1.0f / 127.0f); }
}

__device__ __forceinline__ void win_int8(KParams& p, int l) {
    unsigned char* ws = optr(gp(p.ws)); const int lane = otid() & 63;
    for (int jr = gwave(); jr < NB8 * 256; jr += nwaves()) { const int blk = jr >> 8, n = (blk < 2 ? blk : (blk < 5 ? blk + 3 : (blk < 12 ? blk + 8 : blk + 9))) * 256 + (jr & 255);
        const bf16_t* src = (const bf16_t*)(ws + WS_WIN) + ((long)l * INWP + n) * DM; float f[4][8]; float am = 0.f;
#pragma unroll
        for (int j = 0; j < 4; ++j) { unpack8(*reinterpret_cast<const u32x4*>(src + 512 * j + 8 * lane), f[j]);
#pragma unroll
            for (int i = 0; i < 8; ++i) am = fmaxf(am, fabsf(f[j][i])); }
        am = wave_max(am); const float qs = am > 0.f ? 127.0f / am : 0.f;
#pragma unroll
        for (int j = 0; j < 4; ++j) { unsigned w2[2];
#pragma unroll
            for (int hh = 0; hh < 2; ++hh) { unsigned w = 0u;
#pragma unroll
                for (int i = 0; i < 4; ++i) w |= ((unsigned)((int)__builtin_rintf(f[j][4 * hh + i] * qs) & 0xff)) << (8 * i);
                w2[hh] = w; }
            *reinterpret_cast<u32x2*>(ws + WS_WIN8 + (long)jr * DM + 512 * j + 8 * lane) = (u32x2){w2[0], w2[1]}; }
        if (lane == 0) ((float*)(ws + WS_SBW))[n] = am * (1.0f / 127.0f); }
}

__device__ __forceinline__ void ada_reduce(KParams& p) {
    unsigned char* ws = optr(gp(p.ws)); const float* ap = (const float*)(ws + WS_ADAP); float* ad = (float*)(ws + WS_ADA); const long n = 2L * NCOND * 12288;
    for (long i = gthread(); i < n; i += nthreads()) { const int l = (int)(i / (NCOND * 12288L)); const int j = (int)(i % 12288);
        float s = gp(p.b_ada)[(long)l * 12288 + j];
#pragma unroll
        for (int ks = 0; ks < 8; ++ks) s += ap[(long)ks * n + i];
        ad[i] = s; }
}

__device__ __forceinline__ void modulate(KParams& p, int l, int which) {
    const int lane = otid() & 63; unsigned char* ws = optr(gp(p.ws)); const float* X = gp(p.out); bf16_t* H = (bf16_t*)(ws + WS_H);
    const float* g = (which ? gp(p.g_ffn) : gp(p.g_mix)) + (long)l * DM; const float* ada = (const float*)(ws + WS_ADA) + (long)l * NCOND * 12288 + (which ? 3 : 0) * DM;
    for (int t = gwave(); t < T; t += nwaves()) {
        const float* xr = (l == 0 && which == 0) ? (t < TP ? gp(p.x_prompt) + (long)t * DM : gp(p.x_sample) + (long)(t - TP) * DM) : X + (long)t * DM; f32x4 v[8]; float ss = 0.f;
#pragma unroll
        for (int j = 0; j < 8; ++j) { v[j] = *reinterpret_cast<const f32x4*>(xr + 256 * j + 4 * lane); ss += v[j][0] * v[j][0] + v[j][1] * v[j][1] + v[j][2] * v[j][2] + v[j][3] * v[j][3]; }
        ss = wave_sum(ss); const float rinv = rsqrtf(ss * (1.0f / DM) + EPS);
        const float* sh = ada + (long)cond_row(t) * 12288; const float* sc = sh + DM;
#pragma unroll
        for (int j = 0; j < 8; ++j) { const int c = 256 * j + 4 * lane; const f32x4 gv = *reinterpret_cast<const f32x4*>(g + c), sv = *reinterpret_cast<const f32x4*>(sc + c), hv = *reinterpret_cast<const f32x4*>(sh + c);
            const f32x4 y = v[j] * rinv * gv * (sv + 1.0f) + hv; u32x2 w; w.x = cvt_pk_bf16(y[0], y[1]); w.y = cvt_pk_bf16(y[2], y[3]);
            *reinterpret_cast<u32x2*>(H + (long)t * DM + c) = w; v[j] = y; }
        {
            float am = 0.f;
#pragma unroll
            for (int j = 0; j < 8; ++j) am = fmaxf(am, fmaxf(fmaxf(fabsf(v[j][0]), fabsf(v[j][1])), fmaxf(fabsf(v[j][2]), fabsf(v[j][3]))));
            am = wave_max(am); const float qs = am > 0.f ? 127.0f / am : 0.f;
#pragma unroll
            for (int j = 0; j < 8; ++j) { const int c = 256 * j + 4 * lane;
                const int q0 = (int)__builtin_rintf(v[j][0] * qs), q1 = (int)__builtin_rintf(v[j][1] * qs), q2 = (int)__builtin_rintf(v[j][2] * qs), q3 = (int)__builtin_rintf(v[j][3] * qs);
                *reinterpret_cast<unsigned*>(ws + WS_H8 + (long)t * DM + c) = (unsigned)(q0 & 0xff) | ((unsigned)(q1 & 0xff) << 8) | ((unsigned)(q2 & 0xff) << 16) | ((unsigned)(q3 & 0xff) << 24); }
            if (lane == 0) ((float*)(ws + WS_SA8))[t] = am * (1.0f / 127.0f); }
    }
}

__device__ __forceinline__ void cache_convert(KParams& p, int l, char* lds, int it0, int it1, int bidx, int nb) {
    const int tid = otid(); unsigned char* ws = optr(gp(p.ws)); float* tile = (float*)lds; bf16_t* CKA = (bf16_t*)(ws + WS_CKA); bf16_t* CKT = (bf16_t*)(ws + WS_CKT);
    { const int NT_ = it1, G_ = nb; int it = it0 + bidx; float v[8];
      const float* cbase = gp(p.cache_ckv) + (long)l * DB * PAST * 512;
#define CC_SRC(itx) (cbase + (((long)((itx) >> 8)) * PAST + (((itx) >> 3) & 31) * 64) * 512 + ((itx) & 7) * 64)
      if (it < NT_) { const float* src = CC_SRC(it);
#pragma unroll
        for (int i = 0; i < 8; ++i) { const int idx = tid + 512 * i, r = idx >> 6, c = idx & 63; v[i] = src[(long)r * 512 + c]; } }
      while (it < NT_) { const int b = it >> 8, kt = (it >> 3) & 31, ct = it & 7; const int itn = it + G_; float vn[8];
        if (itn < NT_) { const float* src = CC_SRC(itn);
#pragma unroll
            for (int i = 0; i < 8; ++i) { const int idx = tid + 512 * i, r = idx >> 6, c = idx & 63; vn[i] = src[(long)r * 512 + c]; } }
#pragma unroll
        for (int i = 0; i < 8; ++i) { const int idx = tid + 512 * i, r = idx >> 6, c = idx & 63; tile[r * 65 + c] = v[i]; }
        __syncthreads();
        { const int r = tid >> 3, cc = (tid & 7) * 8; float f[8];
#pragma unroll
          for (int j = 0; j < 8; ++j) f[j] = tile[r * 65 + cc + j];
          *reinterpret_cast<u32x4*>(CKA + ((long)b * KPAD + kt * 64 + r) * QLD + ct * 64 + cc) = pack8(f);
#pragma unroll
          for (int j = 0; j < 8; ++j) f[j] = tile[(cc + j) * 65 + r];
          *reinterpret_cast<u32x4*>(CKT + ((long)b * 512 + ct * 64 + r) * KPAD + kt * 64 + cc) = pack8(f); }
        __syncthreads();
#pragma unroll
        for (int i = 0; i < 8; ++i) v[i] = vn[i];
        it = itn; }
#undef CC_SRC
    }
    for (long i = (long)it0 * 64 + (long)bidx * 512 + tid; i < (long)it1 * 64; i += (long)nb * 512) { const long row = i >> 3; const int ch = (int)(i & 7); const int b = (int)(row >> 11), k = (int)(row & 2047);
        const float* s = gp(p.cache_krope) + (((long)l * DB + b) * PAST + k) * 64 + ch * 8; float f[8];
#pragma unroll
        for (int j = 0; j < 8; ++j) f[j] = s[j];
        *reinterpret_cast<u32x4*>(CKA + ((long)b * KPAD + k) * QLD + 512 + ch * 8) = pack8(f); }
}

__device__ __forceinline__ void quant_row8(const float (&o)[8], unsigned char* dst, float* sc, int lane) {
    float am = 0.f;
#pragma unroll
    for (int j = 0; j < 8; ++j) am = fmaxf(am, fabsf(o[j]));
    am = wave_max(am); const float qs = am > 0.f ? 127.0f / am : 0.f; unsigned w2[2];
#pragma unroll
    for (int hh = 0; hh < 2; ++hh) { unsigned w = 0u;
#pragma unroll
        for (int i = 0; i < 4; ++i) w |= ((unsigned)((int)__builtin_rintf(o[4 * hh + i] * qs) & 0xff)) << (8 * i);
        w2[hh] = w; }
    *reinterpret_cast<u32x2*>(dst) = (u32x2){w2[0], w2[1]};
    if (lane == 0) *sc = am * (1.0f / 127.0f);
}
__device__ __forceinline__ void wu_int8(KParams& p, int l) {
    unsigned char* ws = optr(gp(p.ws)); const int lane = otid() & 63;
    for (int r = gwave(); r < 3072 + 4096; r += nwaves()) { const bool kv = r >= 3072; const int rr = kv ? r - 3072 : r;
        const bf16_t* src = kv ? (const bf16_t*)(ws + WS_WUKV) + ((long)l * 4096 + rr) * 512 : (const bf16_t*)(ws + WS_WUQ) + ((long)l * 3072 + rr) * 512;
        float f[8]; unpack8(*reinterpret_cast<const u32x4*>(src + 8 * lane), f);
        quant_row8(f, ws + (kv ? WS_WUKV8 : WS_WUQ8) + (long)rr * 512 + 8 * lane, (float*)(ws + (kv ? WS_SBK : WS_SBQ)) + rr, lane); }
}

__device__ __forceinline__ void post_win(KParams& p, int l) {
    const int lane = otid() & 63; unsigned char* ws = optr(gp(p.ws));
    bf16_t* Y = (bf16_t*)(ws + WS_Y); bf16_t* CQN = (bf16_t*)(ws + WS_CQN); bf16_t* CKVNP = (bf16_t*)(ws + WS_CKVNP); bf16_t* KRP = (bf16_t*)(ws + WS_KRP); bf16_t* CKA = (bf16_t*)(ws + WS_CKA); bf16_t* CKT = (bf16_t*)(ws + WS_CKT);
    const float* T64 = (const float*)(ws + WS_TAB64); const float* T128 = (const float*)(ws + WS_TAB128);
    for (int t = gwave(); t < T; t += nwaves()) {
        bf16_t* y = Y + (long)t * INWP; const int pos = tok_pos(t); const bool samp = t >= TP; const int ts = t - TP, b = ts >> 6, s = ts & 63;
        { float f[8], o[8]; unpack8(*reinterpret_cast<const u32x4*>(y + C_CQ + 8 * lane), f); float ss = 0.f;
#pragma unroll
          for (int j = 0; j < 8; ++j) ss += f[j] * f[j];
          ss = wave_sum(ss); const float rinv = rsqrtf(ss * (1.0f / 512.f) + EPS); const float* g = gp(p.g_q) + (long)l * 512 + 8 * lane;
#pragma unroll
          for (int j = 0; j < 8; ++j) o[j] = f[j] * rinv * g[j];
          quant_row8(o, (unsigned char*)CQN + (long)t * 512 + 8 * lane, (float*)(ws + WS_SAQ) + t, lane); }
        { float f[8], o[8]; unpack8(*reinterpret_cast<const u32x4*>(y + C_CKV + 8 * lane), f); float ss = 0.f;
#pragma unroll
          for (int j = 0; j < 8; ++j) ss += f[j] * f[j];
          ss = wave_sum(ss); const float rinv = rsqrtf(ss * (1.0f / 512.f) + EPS); const float* g = gp(p.g_kv) + (long)l * 512 + 8 * lane;
#pragma unroll
          for (int j = 0; j < 8; ++j) o[j] = f[j] * rinv * g[j];
          float* od = gp(p.out) + (samp ? O_CKVS + ((long)l * TS + ts) * 512 : O_CKVP + ((long)l * TP + t) * 512) + 8 * lane;
          *reinterpret_cast<f32x4*>(od) = (f32x4){o[0], o[1], o[2], o[3]}; *reinterpret_cast<f32x4*>(od + 4) = (f32x4){o[4], o[5], o[6], o[7]};
          const u32x4 w = pack8(o);
          if (!samp) quant_row8(o, (unsigned char*)CKVNP + (long)t * 512 + 8 * lane, (float*)(ws + WS_SAK) + t, lane);
          else { *reinterpret_cast<u32x4*>(CKA + ((long)b * KPAD + PAST + s) * QLD + 8 * lane) = w;
#pragma unroll
              for (int j = 0; j < 8; ++j) CKT[((long)b * 512 + 8 * lane + j) * KPAD + PAST + s] = f2bf(o[j]); } }
        if (lane < 32) { const float x1 = bf2f(y[C_KR + lane]), x2 = bf2f(y[C_KR + 32 + lane]); const float c = T64[((long)pos * 32 + lane) * 2], sn = T64[((long)pos * 32 + lane) * 2 + 1];
            const float o1 = x1 * c - x2 * sn, o2 = x1 * sn + x2 * c;
            float* od = gp(p.out) + (samp ? O_KRS + ((long)l * TS + ts) * 64 : O_KRP + ((long)l * TP + t) * 64); od[lane] = o1; od[32 + lane] = o2;
            if (!samp) { KRP[(long)t * 64 + lane] = f2bf(o1); KRP[(long)t * 64 + 32 + lane] = f2bf(o2); }
            else { bf16_t* d = CKA + ((long)b * KPAD + PAST + s) * QLD + 512; d[lane] = f2bf(o1); d[32 + lane] = f2bf(o2); } }
        { const int hh = lane >> 3, d0 = (lane & 7) * 8; const float* cs = T128 + ((long)pos * 64 + d0) * 2; float cv[8], sv[8];
#pragma unroll
          for (int j = 0; j < 4; ++j) { const f32x4 q = *reinterpret_cast<const f32x4*>(cs + 4 * j); cv[2 * j] = q[0]; sv[2 * j] = q[1]; cv[2 * j + 1] = q[2]; sv[2 * j + 1] = q[3]; }
#pragma unroll
          for (int which = 0; which < 2; ++which) { bf16_t* base = y + (which ? C_RK : C_RQ) + hh * 128 + d0; const float sca = which ? 0.08838834764831845f : 1.0f;
              float a[8], bq[8], o1[8], o2[8]; unpack8(*reinterpret_cast<const u32x4*>(base), a); unpack8(*reinterpret_cast<const u32x4*>(base + 64), bq);
#pragma unroll
              for (int j = 0; j < 8; ++j) { o1[j] = (a[j] * cv[j] - bq[j] * sv[j]) * sca; o2[j] = (a[j] * sv[j] + bq[j] * cv[j]) * sca; }
              *reinterpret_cast<u32x4*>(base) = pack8(o1); *reinterpret_cast<u32x4*>(base + 64) = pack8(o2); } }
    }
}

__device__ __forceinline__ void post_q(KParams& p) {
    const int lane = otid() & 63; unsigned char* ws = optr(gp(p.ws)); bf16_t* Q = (bf16_t*)(ws + WS_Q); bf16_t* QL = (bf16_t*)(ws + WS_QL); const float* T64 = (const float*)(ws + WS_TAB64);
    for (int t = gwave(); t < T; t += nwaves()) { const int pos = tok_pos(t); const int hd = lane >> 2, d0 = (lane & 3) * 8;
        bf16_t* base = Q + (long)t * 3072 + hd * 192 + 128 + d0; const float* cs = T64 + ((long)pos * 32 + d0) * 2; float cv[8], sv[8];
#pragma unroll
        for (int j = 0; j < 4; ++j) { const f32x4 q = *reinterpret_cast<const f32x4*>(cs + 4 * j); cv[2 * j] = q[0]; sv[2 * j] = q[1]; cv[2 * j + 1] = q[2]; sv[2 * j + 1] = q[3]; }
        float a[8], bq[8], o1[8], o2[8]; unpack8(*reinterpret_cast<const u32x4*>(base), a); unpack8(*reinterpret_cast<const u32x4*>(base + 32), bq);
#pragma unroll
        for (int j = 0; j < 8; ++j) { o1[j] = a[j] * cv[j] - bq[j] * sv[j]; o2[j] = a[j] * sv[j] + bq[j] * cv[j]; }
        const u32x4 w1 = pack8(o1), w2 = pack8(o2);
        *reinterpret_cast<u32x4*>(base) = w1; *reinterpret_cast<u32x4*>(base + 32) = w2;
        if (t >= TP) { const int ts = t - TP, b = ts >> 6, s = ts & 63; bf16_t* d = QL + ((long)b * 1024 + hd * 64 + s) * QLD + 512 + d0;
            *reinterpret_cast<u32x4*>(d) = w1; *reinterpret_cast<u32x4*>(d + 32) = w2; } }
}

__device__ __forceinline__ void softmax_rows(KParams& p) {
    const int lane = otid() & 63; unsigned char* ws = optr(gp(p.ws)); bf16_t* SP = (bf16_t*)(ws + WS_SP);
    for (int r = gwave(); r < DB * 1024; r += nwaves()) { bf16_t* row = SP + (long)r * KPAD; float v[5][8]; float mx = -3.0e38f;
#pragma unroll
        for (int j = 0; j < 5; ++j) { const int ch = lane + 64 * j;
            if (ch < KALL / 8) { unpack8(*reinterpret_cast<const u32x4*>(row + ch * 8), v[j]);
#pragma unroll
                for (int i = 0; i < 8; ++i) { v[j][i] *= MLA_SCALE; mx = fmaxf(mx, v[j][i]); } }
            else {
#pragma unroll
                for (int i = 0; i < 8; ++i) v[j][i] = -3.0e38f; } }
        mx = wave_max(mx); float sum = 0.f;
#pragma unroll
        for (int j = 0; j < 5; ++j) { const int ch = lane + 64 * j;
#pragma unroll
            for (int i = 0; i < 8; ++i) { v[j][i] = (ch < KALL / 8) ? __expf(v[j][i] - mx) : 0.f; sum += v[j][i]; } }
        sum = wave_sum(sum); const float inv = 1.0f / sum;
#pragma unroll
        for (int j = 0; j < 5; ++j) { const int ch = lane + 64 * j;
            if (ch < KPAD / 8) { float o[8];
#pragma unroll
                for (int i = 0; i < 8; ++i) o[i] = v[j][i] * inv;
                *reinterpret_cast<u32x4*>(row + ch * 8) = pack8(o); } } }
}

__device__ __forceinline__ void gnorm_gate(KParams& p, int w0, int nw) {
    const int lane = otid() & 63; unsigned char* ws = optr(gp(p.ws)); const bf16_t* OB = (const bf16_t*)(ws + WS_OB); const bf16_t* Y = (const bf16_t*)(ws + WS_Y);
    for (int t = w0; t < T; t += nw) { const int c0 = (lane >> 3) * 256 + (lane & 7) * 32; float x[4][8]; float s = 0.f;
#pragma unroll
        for (int i = 0; i < 4; ++i) { unpack8(*reinterpret_cast<const u32x4*>(OB + ((long)lane * T + t) * 32 + 8 * i), x[i]);
#pragma unroll
            for (int j = 0; j < 8; ++j) s += x[i][j]; }
        s += sx<1>(s); s += sx<2>(s); s += sx<4>(s); const float mu = s * (1.0f / 256.f); float q = 0.f;
#pragma unroll
        for (int i = 0; i < 4; ++i)
#pragma unroll
            for (int j = 0; j < 8; ++j) { const float d = x[i][j] - mu; q += d * d; }
        q += sx<1>(q); q += sx<2>(q); q += sx<4>(q); const float rstd = rsqrtf(q * (1.0f / 256.f) + EPS);
        float am = 0.f;
#pragma unroll
        for (int i = 0; i < 4; ++i) { float g[8]; unpack8(*reinterpret_cast<const u32x4*>(Y + (long)t * INWP + C_RG + c0 + 8 * i), g);
#pragma unroll
            for (int j = 0; j < 8; ++j) { x[i][j] = siluf_(g[j]) * (x[i][j] - mu) * rstd; am = fmaxf(am, fabsf(x[i][j])); } }
        am = wave_max(am); const float qs = am > 0.f ? 127.0f / am : 0.f; unsigned w[8];
#pragma unroll
        for (int i = 0; i < 4; ++i)
#pragma unroll
            for (int hh = 0; hh < 2; ++hh) { unsigned v = 0u;
#pragma unroll
                for (int j = 0; j < 4; ++j) v |= ((unsigned)((int)__builtin_rintf(x[i][4 * hh + j] * qs) & 0xff)) << (8 * j);
                w[2 * i + hh] = v; }
        *reinterpret_cast<u32x4*>(ws + WS_BG + (long)t * DM + c0) = (u32x4){w[0], w[1], w[2], w[3]};
        *reinterpret_cast<u32x4*>(ws + WS_BG + (long)t * DM + c0 + 16) = (u32x4){w[4], w[5], w[6], w[7]};
        if (lane == 0) ((float*)(ws + WS_SA8))[t] = am * (1.0f / 127.0f); }
}

__device__ __forceinline__ void peer_convert(KParams& p, int l, int r0, int r1, int w0, int nw) {
    unsigned char* ws = optr(gp(p.ws)); const int lane = otid() & 63;
    const float* su = gp(p.peer_u) + (long)l * NEXP * DM; const float* sv = gp(p.peer_v) + (long)l * NEXP * DM;
    for (int r = r0 + w0; r < r1; r += nw) { const bool second = r >= NEXP; const int row = second ? r - NEXP : r; const float* s = (second ? sv : su) + (long)row * DM;
        f32x4 v[8]; float am = 0.f;
#pragma unroll
        for (int j = 0; j < 8; ++j) { v[j] = *reinterpret_cast<const f32x4*>(s + 512 * (j >> 2) * 2 + 16 * lane + 4 * (j & 3));
            am = fmaxf(am, fmaxf(fmaxf(fabsf(v[j][0]), fabsf(v[j][1])), fmaxf(fabsf(v[j][2]), fabsf(v[j][3])))); }
        am = wave_max(am);
        float sc = 1.0f, isc = 1.0f;
        if (am > 0.f) { const int e = (int)((__float_as_uint(am) >> 23) & 0xffu) - 127;
            int k = 7 - e; k = k > 100 ? 100 : (k < -100 ? -100 : k);
            sc = __uint_as_float((unsigned)(127 + k) << 23); isc = __uint_as_float((unsigned)(127 - k) << 23); }
        unsigned w[8];
#pragma unroll
        for (int j = 0; j < 8; ++j) { int pk = __builtin_amdgcn_cvt_pk_fp8_f32(v[j][0] * sc, v[j][1] * sc, 0, false); pk = __builtin_amdgcn_cvt_pk_fp8_f32(v[j][2] * sc, v[j][3] * sc, pk, true); w[j] = (unsigned)pk; }
        if (!second) {
            unsigned char* dst = ws + WS_PU + ((long)(lane >> 3) * NEXP + row) * 128 + 16 * (lane & 7);
            *reinterpret_cast<u32x4*>(dst) = (u32x4){w[0], w[1], w[2], w[3]};
            *reinterpret_cast<u32x4*>(dst + 8L * NEXP * 128) = (u32x4){w[4], w[5], w[6], w[7]};
        } else {
            unsigned char* dst = ws + WS_PV + ((long)(2 * lane) * NEXP + row) * 8;
            *reinterpret_cast<u32x2*>(dst) = (u32x2){w[0], w[1]}; *reinterpret_cast<u32x2*>(dst + (long)NEXP * 8) = (u32x2){w[2], w[3]};
            *reinterpret_cast<u32x2*>(dst + 128L * NEXP * 8) = (u32x2){w[4], w[5]}; *reinterpret_cast<u32x2*>(dst + 129L * NEXP * 8) = (u32x2){w[6], w[7]}; }
        if (lane == 0) ((float*)(ws + (second ? WS_PSV : WS_PSU)))[row] = isc; }
}

__device__ __forceinline__ void final_norm(KParams& p) {
    const int lane = otid() & 63; float* X = gp(p.out);
    for (int t = gwave(); t < T; t += nwaves()) { float* xr = X + (long)t * DM; f32x4 v[8]; float ss = 0.f;
#pragma unroll
        for (int j = 0; j < 8; ++j) { v[j] = *reinterpret_cast<const f32x4*>(xr + 256 * j + 4 * lane); ss += v[j][0] * v[j][0] + v[j][1] * v[j][1] + v[j][2] * v[j][2] + v[j][3] * v[j][3]; }
        ss = wave_sum(ss); const float rinv = rsqrtf(ss * (1.0f / DM) + EPS);
#pragma unroll
        for (int j = 0; j < 8; ++j) { const int c = 256 * j + 4 * lane; const f32x4 gv = *reinterpret_cast<const f32x4*>(gp(p.g_final) + c); *reinterpret_cast<f32x4*>(xr + c) = v[j] * rinv * gv; } }
}
}
__global__ void __launch_bounds__(512, 2) mega_fwd(Params p_by_value_unused) {
    extern __shared__ __attribute__((aligned(16))) unsigned char shm[];
    LAS unsigned char* lds = (LAS unsigned char*)shm; char* ldsg = (char*)shm;
    if (threadIdx.x < 8) ((LAS unsigned*)(lds + LDS_BARW))[threadIdx.x] = 0u;
    __syncthreads();
    if (threadIdx.x == 0) { unsigned* tk = (unsigned*)(gp(KP.ws) + WS_CTL + CTL_RANK) + 64 * xb_xcc_id(); ((volatile LAS unsigned*)(lds + LDS_BARW))[2] = xb_add(tk, 1u); }
    const XcdBarrier bar = xcd_barrier_post((unsigned*)(gp(KP.ws) + WS_CTL), (volatile LAS unsigned*)(lds + LDS_BARW));
#define GRID_SYNC() xcd_barrier(bar)
#ifndef STOP_AT
#define STOP_AT 0
#endif
#ifdef DBG_DUMP
#define STOPCHK(n) do { if (STOP_AT == (n)) { float* xo = gp(KP.out); const bf16_t* src = (const bf16_t*)(gp(KP.ws) + DBG_DUMP); for (long i = ph::gthread(); i < (long)T * DM; i += ph::nthreads()) xo[i] = bf2f(src[i]); return; } } while (0)
#elif defined(DBG_SANITIZE)
#define STOPCHK(n) do { if (STOP_AT == (n) || (STOP_AT > 100 && l == 1 && STOP_AT - 100 == (n))) { float* xo = gp(KP.out); for (long i = ph::gthread(); i < (long)T * DM; i += ph::nthreads()) { const float v = xo[i]; if (!(v - v == 0.0f)) xo[i] = 7.0f; } return; } } while (0)
#else
#define STOPCHK(n) do { if (STOP_AT == (n) || (STOP_AT > 100 && l == 1 && STOP_AT - 100 == (n))) return; } while (0)
#endif
    using namespace pg8;
#define WSP(off) ((bf16_t*)(optr(gp(KP.ws)) + (off)))
#define H WSP(WS_H)
#define Y WSP(WS_Y)
#define CQN WSP(WS_CQN)
#define CKVNP WSP(WS_CKVNP)
#define KRP WSP(WS_KRP)
#define Q WSP(WS_Q)
#define YA WSP(WS_YA)
#define KV WSP(WS_KV)
#define SP WSP(WS_SP)
#define MIX WSP(WS_MIX)
#define OA WSP(WS_OA)
#define QP WSP(WS_QP)
#define CKA WSP(WS_CKA)
#define CKT WSP(WS_CKT)
#define QL WSP(WS_QL)
#define OL WSP(WS_OL)
#define BG WSP(WS_BG)
    int l = 0;
    ph::prologue(KP, ldsg);
#ifdef DUP_PRO
    ph::prologue(KP, ldsg);
#endif
    GRID_SYNC(); STOPCHK(1);
    if (threadIdx.x == 0) { unsigned* barw = (unsigned*)(gp(KP.ws) + WS_CTL); const unsigned me = xb_xcc_id(); unsigned nx = 0, xi = 0, nloc = 1;
        for (unsigned j = 0; j < 16; ++j) { const unsigned cn = xb_ld(&barw[XB_XCNT(j)]); if (cn) { if (j < me) ++xi; ++nx; } if (j == me) nloc = cn ? cn : 1u; }
        volatile LAS unsigned* iw = (volatile LAS unsigned*)(lds + LDS_BARW); iw[3] = xi; iw[4] = nx; iw[5] = nloc; }
    __syncthreads();
    ph::ada_reduce(KP);
    ph::wpq_int8(KP);
    GRID_SYNC(); STOPCHK(2);
    for (l = 0; l < DEPTH; ++l) {
#define WIN (WSP(WS_WIN) + (long)l * INWP * DM)
#define WUQ (WSP(WS_WUQ) + (long)l * 3072 * 512)
#define WUKV (WSP(WS_WUKV) + (long)l * 4096 * 512)
#define WUK (WSP(WS_WUK) + (long)l * 16 * 512 * 256)
#define WA (WSP(WS_WA) + (long)l * DM * DM)
#define WB (WSP(WS_WB) + (long)l * DM * DM)
#define WO (WSP(WS_WO) + (long)l * DM * DM)
#define WPQ (WSP(WS_WPQ) + (long)l * DM * DM)
#define ADA ((const float*)(optr(gp(KP.ws)) + WS_ADA) + (long)l * NCOND * 12288)
        ph::modulate(KP, l, 0);
        ph::win_int8(KP, l);
        ph::wb_int8(KP, l);
        ph::wu_int8(KP, l);
        ph::cache_convert(KP, l, ldsg, l == 0 ? 0 : 4096, 8192, obid(), ogrid());
        GRID_SYNC(); STOPCHK(3);
        { Sched<5> S; S.init(T / 256, INWP / 256 - NB8, (T / 256) * (INWP / 256 - NB8), DM, DM); gemm_phase(lds, Gemm{H, WIN, DM, DM, DM}, S, EpiBf16{Y, INWP, 0}); }
        { Sched<6> S; S.init(T / 256, NB8, (T / 256) * NB8, DM / 2, DM / 2);
          { const int G_ = ogrid(); S.rotate((((((T / 256) * NB8) % G_) + 7) & ~7) % G_); }
          unsigned char* ws8 = optr(gp(KP.ws));
          gemm_phase<EpiQ8, Sched<6>, true>(lds, Gemm{(const bf16_t*)(ws8 + WS_H8), (const bf16_t*)(ws8 + WS_WIN8), DM / 2, DM / 2, DM / 2}, S, EpiQ8{Y, INWP, (const float*)(ws8 + WS_SA8), (const float*)(ws8 + WS_SBW)}); }
#ifdef DUP_WIN
        { Sched<0> S; S.init(T / 256, INWP / 256, (T / 256) * (INWP / 256), DM, DM); gemm_phase(lds, Gemm{H, WIN, DM, DM, DM}, S, EpiBf16{Y, INWP, 0}); }
#endif
        GRID_SYNC(); STOPCHK(4);
        ph::post_win(KP, l);
        GRID_SYNC(); STOPCHK(5);
        { unsigned char* ws8 = optr(gp(KP.ws));
          { Sched<0> S; S.init(T / 256, 3072 / 256, (T / 256) * 12, 256, 256); gemm_phase<EpiQ, Sched<0>, 2>(lds, Gemm{CQN, (const bf16_t*)(ws8 + WS_WUQ8), 256, 256, 256, (const float*)(ws8 + WS_SAQ), (const float*)(ws8 + WS_SBQ)}, S, EpiQ{Q, QL, (const float*)(ws8 + WS_TAB64)}); }
          { Sched<0> S; S.init(TP / 256, 4096 / 256, (TP / 256) * 16, 256, 256); gemm_phase<EpiBf16, Sched<0>, 2>(lds, Gemm{CKVNP, (const bf16_t*)(ws8 + WS_WUKV8), 256, 256, 256, (const float*)(ws8 + WS_SAK), (const float*)(ws8 + WS_SBK)}, S, EpiBf16{KV, 4096, 0}); } }
        GRID_SYNC(); STOPCHK(6);
#ifndef DUP_ATTN
#define DUP_ATTN 1
#endif
#ifndef DUP_RET
#define DUP_RET 1
#endif
#ifndef DUP_GATHER
#define DUP_GATHER 0
#endif
#pragma unroll 1
        for (int rep_ = 0; rep_ < DUP_ATTN; ++rep_)
        { for (int u = obid(); u < 512; u += ogrid()) { const int c = u & 255, i = u >> 8, xcd = c & 7, slot = c >> 3; const int bh = xcd * 4 + (slot >> 3) + 32 * i, pr = slot & 7, b = bh >> 4, h = bh & 15;
#pragma unroll 1
              for (int z = 0; z < 2; ++z) { const int qb = z ? 15 - pr : pr; const long tok0 = (long)b * SEQ + 256 * qb;
                  att::attn_block(Q + tok0 * 3072 + h * 192, KV + (long)b * SEQ * 4096 + h * 256, KRP + (long)b * SEQ * 64, KV + (long)b * SEQ * 4096 + h * 256 + 128, OA + tok0 * DM + h * 128, qb, ldsg); } } }
        { Sched<1> S; S.init(0, 0, 256, 3072, 256); gemm_phase(lds, Gemm{Q, WUK, 256, 3072, 256}, S, EpiRowMap<1>{QL, nullptr}); }
        GRID_SYNC(); STOPCHK(8);
        { Sched<2> S; S.init(0, 0, DB * 36, QLD, QLD); gemm_phase(lds, Gemm{QL, CKA, QLD, QLD, QLD}, S, EpiExp{SP, (float*)(optr(gp(KP.ws)) + WS_CTL + CTL_RSUM) + (long)l * 32768}); }
        GRID_SYNC(); STOPCHK(9);
        { Sched<3> S; S.init(0, 0, 256, KPAD, KPAD); gemm_phase(lds, Gemm{SP, CKT, 2176, KPAD, KPAD}, S, EpiRowMap<3>{OL, (const float*)(optr(gp(KP.ws)) + WS_CTL + CTL_RSUM) + (long)l * 32768}); }
        GRID_SYNC(); STOPCHK(11);
        { Sched<4> S; S.init(0, 0, 128, 512, 512); gemm_phase(lds, Gemm{OL, WUKV, 512, 512, 512}, S, EpiOV{OA}); }
#pragma unroll 1
        for (int rep_ = 0; rep_ < DUP_RET; ++rep_)
        for (int u = obid(); u < 256 + DB * 64; u += ogrid()) ret::unit(KP, l, u, ldsg);
#ifdef DUP_RETP
        for (int u = obid(); u < 256; u += ogrid()) ret::unit(KP, l, u, ldsg);
#endif
        GRID_SYNC(); STOPCHK(12);
        { Sched<0> S; S.init(T / 256, DM / 256, (T / 256) * 8, DM, DM); gemm_phase(lds, Gemm{OA, WA, DM, DM, DM}, S, EpiBf16{YA, DM, 0}); }
        { const int G_ = ogrid(), rem_ = ((T / 256) * 8) % G_; const int b_ = obid();
          if (rem_ == 0) ph::gnorm_gate(KP, ph::gwave(), ph::nwaves());
          else if (b_ >= rem_) ph::gnorm_gate(KP, (b_ - rem_) * 8 + (otid() >> 6), (G_ - rem_) * 8); }
#ifdef DUP_WA
#pragma unroll 1
        for (int rep_ = 0; rep_ < DUP_WA; ++rep_)
        { Sched<0> S; S.init(T / 256, DM / 256, (T / 256) * 8, DM, DM); gemm_phase(lds, Gemm{OA, WA, DM, DM, DM}, S, EpiBf16{YA, DM, 0}); }
#endif
        GRID_SYNC(); STOPCHK(14);
        { Sched<0> S; S.init(T / 256, DM / 256, (T / 256) * 8, DM / 2, DM / 2); unsigned char* ws8 = optr(gp(KP.ws));
          gemm_phase<EpiMix, Sched<0>, true>(lds, Gemm{(const bf16_t*)(ws8 + WS_BG), (const bf16_t*)(ws8 + WS_WB8), DM / 2, DM / 2, DM / 2}, S, EpiMix{Y, YA, MIX, (const float*)(ws8 + WS_SA8), (const float*)(ws8 + WS_SBB)}); }
        { const int G_ = ogrid(), rem_ = ((T / 256) * 8) % G_; const int b_ = obid();
          if (rem_ == 0) ph::peer_convert(KP, l, 0, NEXP, ph::gwave(), ph::nwaves());
          else if (b_ >= rem_) ph::peer_convert(KP, l, 0, NEXP, (b_ - rem_) * 8 + (otid() >> 6), (G_ - rem_) * 8); }
        GRID_SYNC(); STOPCHK(15);
        { Sched<0> S; S.init(T / 256, DM / 256, (T / 256) * 8, DM, DM); gemm_phase(lds, Gemm{MIX, WO, DM, DM, DM}, S, EpiRes{gp(KP.out), ADA + 2 * DM, l == 0 ? gp(KP.x_prompt) : gp(KP.out), l == 0 ? gp(KP.x_sample) : gp(KP.out) + (long)TP * DM}); }
        { const int G_ = ogrid(), rem_ = ((T / 256) * 8) % G_; const int b_ = obid();
          if (rem_ == 0) ph::peer_convert(KP, l, NEXP, 2 * NEXP, ph::gwave(), ph::nwaves());
          else if (b_ >= rem_) ph::peer_convert(KP, l, NEXP, 2 * NEXP, (b_ - rem_) * 8 + (otid() >> 6), (G_ - rem_) * 8); }
        GRID_SYNC(); STOPCHK(16);
        ph::modulate(KP, l, 1);
        GRID_SYNC(); STOPCHK(17);
        { Sched<0> S; S.init(T / 256, DM / 256, (T / 256) * 8, DM / 2, DM / 2);
          unsigned char* ws8 = optr(gp(KP.ws));
          gemm_phase<EpiQ8, Sched<0>, true>(lds, Gemm{(const bf16_t*)(ws8 + WS_H8), (const bf16_t*)(ws8 + WS_WPQ8 + (long)l * DM * DM), DM / 2, DM / 2, DM / 2}, S, EpiQ8{QP, DM, (const float*)(ws8 + WS_SA8), (const float*)(ws8 + WS_SB8) + (long)l * DM});
#ifdef DUP_WPQ
          gemm_phase<EpiQ8, Sched<0>, true>(lds, Gemm{(const bf16_t*)(ws8 + WS_H8), (const bf16_t*)(ws8 + WS_WPQ8 + (long)l * DM * DM), DM / 2, DM / 2, DM / 2}, S, EpiQ8{QP, DM, (const float*)(ws8 + WS_SA8), (const float*)(ws8 + WS_SB8) + (long)l * DM});
#endif
        }
        if (l + 1 < DEPTH) { const int G_ = ogrid(), rem_ = ((T / 256) * 8) % G_; const int b_ = obid();
          if (rem_ == 0) ph::cache_convert(KP, l + 1, ldsg, 0, 4096, b_, G_);
          else if (b_ >= rem_) ph::cache_convert(KP, l + 1, ldsg, 0, 4096, b_ - rem_, G_ - rem_); }
        GRID_SYNC(); STOPCHK(18);
        { const int tid_ = otid(); const int lane = tid_ & 63; float* strip = (float*)ldsg + tid_ * 33; unsigned char* ws = optr(gp(KP.ws));
          const bf16_t* k1g = (const bf16_t*)(ws + WS_PK1) + (long)l * 128 * 128; const bf16_t* k2g = (const bf16_t*)(ws + WS_PK2) + (long)l * 128 * 128;
          bf16_t* k1 = (bf16_t*)(ldsg + 512 * 33 * 4 + 64); bf16_t* k2 = k1 + 128 * peer::KPITCH;
          for (int i = tid_; i < 2 * 128 * 16; i += 512) { const int which = i >> 11, r = (i >> 4) & 127, ch = i & 15;
              *reinterpret_cast<u32x4*>((which ? k2 : k1) + r * peer::KPITCH + ch * 8) = *reinterpret_cast<const u32x4*>((which ? k2g : k1g) + r * 128 + ch * 8); }
          __syncthreads();
          for (int wu = ph::gwave(); wu < (T / 32) * PH; wu += ph::nwaves()) peer::select_unit(QP, k1, k2, (int*)(ws + WS_PIDX), (float*)(ws + WS_PW), (wu >> 3) * 32, wu & 7, lane, strip);
#ifdef DUP_SEL
          for (int wu = ph::gwave(); wu < (T / 32) * PH; wu += ph::nwaves()) peer::select_unit(QP, k1, k2, (int*)(ws + WS_PIDX), (float*)(ws + WS_PW), (wu >> 3) * 32, wu & 7, lane, strip);
#endif
        }
        GRID_SYNC(); STOPCHK(19);
        { const int tid_ = otid(); const int lane = tid_ & 63, wid = tid_ >> 6; unsigned char* ws = optr(gp(KP.ws));
          volatile LAS unsigned* iw = (volatile LAS unsigned*)(lds + LDS_BARW); peer::XInfo xin; xin.rank = __builtin_amdgcn_readfirstlane((int)iw[2]); xin.xi = __builtin_amdgcn_readfirstlane((int)iw[3]); xin.nx = __builtin_amdgcn_readfirstlane((int)iw[4]); xin.nloc = __builtin_amdgcn_readfirstlane((int)iw[5]);
          if (xin.nx >= 1 && xin.nx <= 8) {
              peer::upass(H, (const unsigned char*)(ws + WS_PU), (const int*)(ws + WS_PIDX), (const float*)(ws + WS_PW), (const float*)(ws + WS_PSU), (const float*)(ws + WS_PSV), (float*)(ws + WS_DOTP), (unsigned*)(ws + WS_ACT), xin, wid, lane);
              GRID_SYNC();
              int vs0_, vsn_, vse_;
              if ((256 % xin.nx) == 0) { const int spx = 256 / xin.nx; vs0_ = xin.xi * spx + xin.rank; vsn_ = xin.nloc; vse_ = (xin.xi + 1) * spx; }
              else { vs0_ = obid(); vsn_ = ogrid(); vse_ = 256; }
              peer::vpass_lds((const unsigned char*)(ws + WS_PV), (const unsigned*)(ws + WS_ACT), gp(KP.out), ADA + 5 * DM, ldsg, vs0_, vsn_, vse_, tid_);
#ifdef DUP_VP
              peer::vpass_lds((const unsigned char*)(ws + WS_PV), (const unsigned*)(ws + WS_ACT), (float*)(ws + WS_OB), ADA + 5 * DM, ldsg, vs0_, vsn_, vse_, tid_);
#endif
          } else {
              for (int t = ph::gwave(); t < T; t += ph::nwaves()) peer::gather_token(H, (const unsigned char*)(ws + WS_PU), (const unsigned char*)(ws + WS_PV), (const float*)(ws + WS_PSU), (const float*)(ws + WS_PSV), (const int*)(ws + WS_PIDX), (const float*)(ws + WS_PW), gp(KP.out), ADA + 5 * DM, t, lane);
          } }
        GRID_SYNC(); STOPCHK(20);
    }
    ph::final_norm(KP);
}

extern "C" void kernel_launch(void* const* d_in, const int* in_sizes, int n_in, void* d_out, int out_size, void* d_ws, size_t ws_size, hipStream_t stream) {
    static int grid = 0;
    if (grid == 0) {
        if (n_in != 25 || out_size != (int)O_END || ws_size < WS_END) { fprintf(stderr, "kernel_launch: shape mismatch: n_in %d out %d (want %ld) ws %zu (want >= %zu)\n", n_in, out_size, O_END, ws_size, (size_t)WS_END); grid = -1; return; }
        int dev = 0, cus = 0, per_cu = 0;
        if (hipGetDevice(&dev) != hipSuccess || hipDeviceGetAttribute(&cus, hipDeviceAttributeMultiprocessorCount, dev) != hipSuccess) { fprintf(stderr, "kernel_launch: device query failed\n"); grid = -1; return; }
        if (hipFuncSetAttribute((const void*)mega_fwd, hipFuncAttributeMaxDynamicSharedMemorySize, LDS_BYTES) != hipSuccess) { fprintf(stderr, "kernel_launch: hipFuncSetAttribute failed\n"); grid = -1; return; }
        if (hipOccupancyMaxActiveBlocksPerMultiprocessor(&per_cu, (const void*)mega_fwd, 512, LDS_BYTES) != hipSuccess || per_cu < 1) { fprintf(stderr, "kernel_launch: occupancy query says %d blocks per CU\n", per_cu); grid = -1; return; }
        grid = cus;
#ifdef FORCE_GRID
        grid = FORCE_GRID;
#endif
    }
    if (grid < 0) return;
    (void)hipMemsetAsync((char*)d_ws + WS_CTL, 0, CTL_BYTES, stream);
    Params p{};
    const float* const* in = (const float* const*)d_in;
    p.x_prompt = in[0]; p.x_sample = in[1]; p.c_prompt = in[2]; p.c_sample = in[3]; p.cache_ckv = in[4]; p.cache_krope = in[5]; p.state_ret = in[6]; p.w_ada = in[7]; p.b_ada = in[8];
    p.g_mix = in[9]; p.g_ffn = in[10]; p.w_in = in[11]; p.g_q = in[12]; p.w_uq = in[13]; p.g_kv = in[14]; p.w_ukv = in[15]; p.w_a = in[16]; p.w_b = in[17]; p.w_o = in[18]; p.w_pq = in[19];
    p.peer_k1 = in[20]; p.peer_k2 = in[21]; p.peer_u = in[22]; p.peer_v = in[23]; p.g_final = in[24];
    p.out = (float*)d_out; p.ws = (unsigned char*)d_ws;
    for (int h = 0; h < 8; ++h) p.lg[h] = (float)log1p(-pow(2.0, -5.0 - (double)h));
    p.grid = grid; p.pad_ = 0;
    hipLaunchKernelGGL(mega_fwd, dim3(grid), dim3(512), LDS_BYTES, stream, p);
    const hipError_t le = hipGetLastError();
    if (le != hipSuccess) fprintf(stderr, "kernel_launch: launch failed: %s\n", hipGetErrorName(le));
}
```

```cpp
#include <hip/hip_runtime.h>
#include <cstdio>
#include <cstdint>
#include <cmath>

#define LAS __attribute__((address_space(3)))
typedef unsigned short bf16_t;
typedef short bf16x8 __attribute__((ext_vector_type(8)));
typedef float f32x4 __attribute__((ext_vector_type(4)));
typedef float f32x2 __attribute__((ext_vector_type(2)));
typedef float f32x16 __attribute__((ext_vector_type(16)));
typedef unsigned u32x4 __attribute__((ext_vector_type(4)));
typedef unsigned u32x2 __attribute__((ext_vector_type(2)));
typedef short s16x4 __attribute__((ext_vector_type(4)));
typedef int i32x4 __attribute__((ext_vector_type(4)));

constexpr int DM = 2048, NB = 4, SEQ = 4096, DEPTH = 2, DB = 32, DS = 64, PAST = 2048;
constexpr int TP = NB * SEQ, TS = DB * DS, T = TP + TS;
constexpr int NCOND = NB + DB;
constexpr int QLORA = 512, KVLORA = 512, ROPE = 64, NOPE = 128, VD = 128, MH = 16, QKD = 192;
constexpr int RH = 8, RQK = 128, RV = 256;
constexpr int PH = 8, NKEYS = 128, NEXP = 16384, PTOPK = 16;
constexpr int INW = 11328, INWP = 11520;
constexpr int C_CQ = 0, C_CKV = 512, C_KR = 1024, C_RQ = 1088, C_RK = 2112, C_RV = 3136, C_RG = 5184, C_GA = 7232, C_GB = 9280;
constexpr int KALL = PAST + DS;
constexpr int KPAD = 2304;
constexpr int QLD = 640;
constexpr float EPS = 1e-6f;
constexpr float MLA_SCALE = 0.07216878364870322f;

constexpr long O_Y = 0;
constexpr long O_CKVP = (long)T * DM;
constexpr long O_KRP = O_CKVP + 2L * TP * 512;
constexpr long O_RETP = O_KRP + 2L * TP * 64;
constexpr long O_CKVS = O_RETP + 2L * NB * RH * RQK * RV;
constexpr long O_KRS = O_CKVS + 2L * TS * 512;
constexpr long O_RETS = O_KRS + 2L * TS * 64;
constexpr long O_END = O_RETS + 2L * DB * RH * RQK * RV;

constexpr size_t al256(size_t x) { return (x + 255) / 256 * 256; }
constexpr size_t WS_CTL = 0;
constexpr size_t CTL_BYTES = 65536 + 2UL * 32768 * 4;
constexpr size_t CTL_RSUM = 65536;
constexpr size_t WS_TAB64 = WS_CTL + CTL_BYTES;
constexpr size_t WS_TAB128 = WS_TAB64 + 4096UL * 32 * 2 * 4;
constexpr size_t WS_ADA = WS_TAB128 + 4096UL * 64 * 2 * 4;
constexpr size_t WS_ADAP = WS_ADA + 2UL * NCOND * 12288 * 4;
constexpr size_t WS_WIN = WS_ADAP + 8UL * 2 * NCOND * 12288 * 4;
constexpr size_t WS_WUQ = WS_WIN + 2UL * INWP * DM * 2;
constexpr size_t WS_WUKV = WS_WUQ + 2UL * 3072 * 512 * 2;
constexpr size_t WS_WUK = WS_WUKV + 2UL * 4096 * 512 * 2;
constexpr size_t WS_WA = WS_WUK + 2UL * 16 * 512 * 256 * 2;
constexpr size_t WS_WB = WS_WA + 2UL * DM * DM * 2;
constexpr size_t WS_WO = WS_WB + 2UL * DM * DM * 2;
constexpr size_t WS_WPQ = WS_WO + 2UL * DM * DM * 2;
constexpr size_t WS_PK1 = WS_WPQ + 2UL * DM * DM * 2;
constexpr size_t WS_PK2 = WS_PK1 + 2UL * 128 * 128 * 2;
constexpr size_t WS_H = WS_PK2 + 2UL * 128 * 128 * 2;
constexpr size_t WS_Y = WS_H + (size_t)T * DM * 2;
constexpr size_t WS_CQN = WS_Y + (size_t)T * INWP * 2;
constexpr size_t WS_CKVNP = WS_CQN + (size_t)T * 512 * 2;
constexpr size_t WS_KRP = WS_CKVNP + (size_t)TP * 512 * 2;
constexpr size_t WS_Q = WS_KRP + (size_t)TP * 64 * 2;
constexpr size_t WS_YA = WS_Q;
constexpr size_t WS_KV = WS_Q + (size_t)T * 3072 * 2 + 4096;
constexpr size_t WS_SP = WS_KV;
constexpr size_t WS_MIX = WS_KV;
constexpr size_t WS_OA = WS_KV + 32UL * 1024 * KPAD * 2;
constexpr size_t WS_QP = WS_OA;
constexpr size_t WS_CKA = WS_OA + (size_t)T * DM * 2;
constexpr size_t WS_CKT = WS_CKA + 32UL * KPAD * QLD * 2;
constexpr size_t WS_QL = WS_CKT + 32UL * 512 * KPAD * 2;
constexpr size_t WS_OL = WS_QL + 32UL * 1024 * QLD * 2;
constexpr size_t WS_OB = WS_OL + 16UL * 2048 * 512 * 2;
constexpr size_t WS_BG = WS_OB + (size_t)T * DM * 2;
constexpr size_t WS_PIDX = WS_BG + (size_t)T * DM * 2;
constexpr size_t WS_PW = WS_PIDX + (size_t)T * 128 * 4;
constexpr size_t WS_PU = WS_PW + (size_t)T * 128 * 4;
constexpr size_t WS_PV = WS_PU + (size_t)NEXP * DM;
constexpr size_t WS_PSU = WS_PV + (size_t)NEXP * DM;
constexpr size_t WS_PSV = WS_PSU + (size_t)NEXP * 4;
constexpr size_t WS_WPQ8 = WS_PSV + (size_t)NEXP * 4;
constexpr size_t WS_SB8 = WS_WPQ8 + 2UL * DM * DM;
constexpr size_t WS_SA8 = WS_SB8 + 2UL * DM * 4;
constexpr int NB8 = 38;
constexpr size_t WS_WIN8 = WS_BG + (size_t)T * DM;
constexpr size_t WS_WB8 = WS_WIN8 + (size_t)NB8 * 256 * DM;
constexpr size_t WS_WUQ8 = WS_WB8 + (size_t)DM * DM;
constexpr size_t WS_WUKV8 = WS_WUQ8 + 3072UL * 512;
static_assert(WS_WUKV8 + 4096UL * 512 <= WS_BG + (size_t)T * DM * 2, "int8 weights overflow the BG region");
constexpr size_t WS_SBW = WS_SA8 + al256((size_t)T * 4);
constexpr size_t WS_SBB = WS_SBW + al256((size_t)INWP * 4);
constexpr size_t WS_SBQ = WS_SBB + (size_t)DM * 4;
constexpr size_t WS_SBK = WS_SBQ + 3072UL * 4;
constexpr size_t WS_SAQ = WS_SBK + 4096UL * 4;
constexpr size_t WS_SAK = WS_SAQ + al256((size_t)T * 4);
constexpr size_t WS_END = WS_SAK + al256((size_t)TP * 4);
constexpr size_t WS_H8 = WS_OB;
static_assert((size_t)TP * 4096 * 2 <= 32UL * 1024 * KPAD * 2, "KV fits in the SP region");
static_assert(WS_END <= 1608000000UL, "workspace map too large");
static_assert(WS_WIN % 256 == 0 && WS_H % 256 == 0 && WS_Y % 256 == 0 && WS_Q % 256 == 0 && WS_KV % 256 == 0 && WS_CKA % 256 == 0, "alignment");

constexpr int LDS_BYTES = 147456;
constexpr int LDS_BARW = LDS_BYTES - 32;
constexpr size_t CTL_RANK = 16384;
constexpr size_t WS_DOTP = WS_Q;
constexpr size_t WS_ACT = WS_DOTP + 8UL * T * 128 * 4;
constexpr size_t WS_PIDXT = WS_ACT + (size_t)T * 128 * 4;
static_assert(WS_PIDXT + (size_t)T * 128 * 4 <= WS_KV, "PEER scratch fits in the Q region");

struct Params {
    const float *x_prompt, *x_sample, *c_prompt, *c_sample, *cache_ckv, *cache_krope, *state_ret, *w_ada, *b_ada, *g_mix, *g_ffn, *w_in, *g_q, *w_uq, *g_kv, *w_ukv,
                *w_a, *w_b, *w_o, *w_pq, *peer_k1, *peer_k2, *peer_u, *peer_v, *g_final;
    float* out; unsigned char* ws;
    float lg[8];
    int grid; int pad_;
};

typedef const __attribute__((address_space(4))) Params KParams;
__device__ __forceinline__ KParams* okarg() {
    const uintptr_t k = (uintptr_t)__builtin_amdgcn_kernarg_segment_ptr();
    unsigned lo = (unsigned)k, hi = (unsigned)(k >> 32);
    asm volatile("" : "+s"(lo), "+s"(hi)); return (KParams*)(((uintptr_t)hi << 32) | lo); }
#define KP (*okarg())
__device__ __forceinline__ int ogrid() { return KP.grid; }
__device__ __forceinline__ int obid() { int b = (int)blockIdx.x; asm volatile("" : "+s"(b) :: "memory"); return b; }
__device__ __forceinline__ int otid() { int t = (int)threadIdx.x; asm volatile("" : "+v"(t) :: "memory"); return t; }
template <class P> __device__ __forceinline__ P* gp(P* p) { return (P*)(__attribute__((address_space(1))) P*)(uintptr_t)p; }
template <class P> __device__ __forceinline__ P* optr(P* p) {
    unsigned lo = __builtin_amdgcn_readfirstlane((unsigned)(uintptr_t)p), hi = __builtin_amdgcn_readfirstlane((unsigned)((uintptr_t)p >> 32));
    asm volatile("" : "+s"(lo), "+s"(hi)); return gp((P*)(((uintptr_t)hi << 32) | lo)); }
typedef __bf16 bf16v2_t __attribute__((ext_vector_type(2)));
__device__ __forceinline__ unsigned cvt_pk_bf16(float lo, float hi) { f32x2 v = {lo, hi}; bf16v2_t r = __builtin_convertvector(v, bf16v2_t); return __builtin_bit_cast(unsigned, r); }
__device__ __forceinline__ bf16_t f2bf(float f) { return (bf16_t)(cvt_pk_bf16(f, 0.f) & 0xffffu); }
__device__ __forceinline__ float bf2f(bf16_t b) { return __uint_as_float(((unsigned)b) << 16); }
__device__ __forceinline__ float bflo(unsigned w) { return __uint_as_float(w << 16); }
__device__ __forceinline__ float bfhi(unsigned w) { return __uint_as_float(w & 0xffff0000u); }
__device__ __forceinline__ void unpack8(const u32x4 w, float (&f)[8]) { f[0] = bflo(w.x); f[1] = bfhi(w.x); f[2] = bflo(w.y); f[3] = bfhi(w.y); f[4] = bflo(w.z); f[5] = bfhi(w.z); f[6] = bflo(w.w); f[7] = bfhi(w.w); }
__device__ __forceinline__ u32x4 pack8(const float (&f)[8]) { u32x4 w; w.x = cvt_pk_bf16(f[0], f[1]); w.y = cvt_pk_bf16(f[2], f[3]); w.z = cvt_pk_bf16(f[4], f[5]); w.w = cvt_pk_bf16(f[6], f[7]); return w; }
template <int K> __device__ __forceinline__ float sx(float v) {
    if constexpr (K == 32) { const auto rr = __builtin_amdgcn_permlane32_swap(__float_as_uint(v), __float_as_uint(v), false, false); return __uint_as_float((otid() & 32) ? rr[0] : rr[1]); }
    else return __int_as_float(__builtin_amdgcn_ds_swizzle(__float_as_int(v), (K << 10) | 0x1F));
}
__device__ __forceinline__ float wave_sum(float v) { v += sx<32>(v); v += sx<16>(v); v += sx<8>(v); v += sx<4>(v); v += sx<2>(v); v += sx<1>(v); return v; }
__device__ __forceinline__ float wave_max(float v) { v = fmaxf(v, sx<32>(v)); v = fmaxf(v, sx<16>(v)); v = fmaxf(v, sx<8>(v)); v = fmaxf(v, sx<4>(v)); v = fmaxf(v, sx<2>(v)); v = fmaxf(v, sx<1>(v)); return v; }
__device__ __forceinline__ float sigmoidf_(float x) { return 1.0f / (1.0f + __expf(-x)); }
__device__ __forceinline__ float siluf_(float x) { return x / (1.0f + __expf(-x)); }
__device__ __forceinline__ int cond_row(int t) { return t < TP ? (t >> 12) : NB + ((t - TP) >> 6); }
__device__ __forceinline__ int tok_pos(int t) { return t < TP ? (t & 4095) : PAST + ((t - TP) & 63); }

#define XB_TMO      128
#define XB_XCNT(j)  (256  + 64 * (j))
#define XB_XSUB(j)  (1280 + 64 * (j))
#define XB_XGEN(j)  (2304 + 64 * (j))
#define XB_TOP      3328
#define XB_TOPGEN   3392
#define XCD_BAR_WORDS 3456
#define XB_SPIN_CAP (1u << 22)
__device__ __forceinline__ unsigned xb_ld(unsigned* p)              { return __hip_atomic_load(p, __ATOMIC_RELAXED, __HIP_MEMORY_SCOPE_AGENT); }
__device__ __forceinline__ unsigned xb_add(unsigned* p, unsigned v) { return __hip_atomic_fetch_add(p, v, __ATOMIC_RELAXED, __HIP_MEMORY_SCOPE_AGENT); }
__device__ __forceinline__ unsigned xb_xcc_id() { return (unsigned)__builtin_amdgcn_s_getreg((3 << 11) | 20) & 0xFu; }
#define XB_SPIN(cond, bar) do { unsigned _sp = 0; while (cond) { __builtin_amdgcn_s_sleep(1); \
    if ((++_sp & 255u) == 0u) { if (xb_ld(&(bar)[XB_TMO])) break; if (_sp > XB_SPIN_CAP) { atomicAdd(&(bar)[XB_TMO], 1u); break; } } } } while (0)
struct XcdBarrier { unsigned* bar; unsigned x; volatile LAS unsigned* st; };
__device__ __forceinline__ XcdBarrier xcd_barrier_post(unsigned* bar, volatile LAS unsigned* st) {
    XcdBarrier b; b.bar = bar; b.x = xb_xcc_id(); b.st = st;
    if (threadIdx.x == 0) (void)xb_add(&bar[XB_XCNT(b.x)], 1u);
    return b;
}
__device__ __forceinline__ void xcd_barrier_complete(unsigned* bar, unsigned x, unsigned& nloc, unsigned& nx) {
    const unsigned G = (unsigned)KP.grid;
    unsigned sum, cnt, mine, sp = 0u;
    for (;;) {
        sum = 0u; cnt = 0u; mine = 0u;
#pragma unroll
        for (unsigned j = 0; j < 16; ++j) { const unsigned c = xb_ld(&bar[XB_XCNT(j)]); sum += c; cnt += (c > 0u) ? 1u : 0u; mine = (j == x) ? c : mine; }
        if (sum == G) break;
        __builtin_amdgcn_s_sleep(1);
        if ((++sp & 255u) == 0u) { if (xb_ld(&bar[XB_TMO])) break; if (sp > XB_SPIN_CAP) { atomicAdd(&bar[XB_TMO], 1u); break; } }
    }
    nloc = mine > 0u ? mine : 1u; nx = cnt > 0u ? cnt : 1u;
}
__device__ __forceinline__ void xcd_barrier(const XcdBarrier& b) {
    asm volatile("s_waitcnt vmcnt(0)" ::: "memory");
    __syncthreads();
    if (otid() == 0) {
        unsigned* bar = (unsigned*)(gp(KP.ws) + WS_CTL);
        unsigned bx = xb_xcc_id(); asm volatile("" : "+s"(bx));
        __builtin_amdgcn_s_waitcnt(0);
        unsigned nloc = b.st[0], nx = b.st[1];
        if (nloc == 0u) { xcd_barrier_complete(bar, bx, nloc, nx); b.st[0] = nloc; b.st[1] = nx; }
        const unsigned old = xb_add(&bar[XB_XSUB(bx)], 1u);
        const unsigned gen = old / nloc;
        if (old + 1u == (gen + 1u) * nloc) {
            __builtin_amdgcn_fence(__ATOMIC_RELEASE, "agent");
            asm volatile("s_waitcnt vmcnt(0)" ::: "memory");
            const unsigned og = xb_add(&bar[XB_TOP], 1u);
            const unsigned tg = og / nx;
            if (og + 1u == (tg + 1u) * nx) xb_add(&bar[XB_TOPGEN], 1u);
            else XB_SPIN(xb_ld(&bar[XB_TOPGEN]) == tg, bar);
            __builtin_amdgcn_fence(__ATOMIC_ACQUIRE, "agent");
            xb_add(&bar[XB_XGEN(bx)], 1u);
            asm volatile("s_waitcnt vmcnt(0)" ::: "memory");
        } else {
            XB_SPIN(xb_ld(&bar[XB_XGEN(bx)]) == gen, bar);
            __builtin_amdgcn_fence(__ATOMIC_ACQUIRE, "agent");
            asm volatile("s_waitcnt vmcnt(0)" ::: "memory");
        }
    }
    __syncthreads();
}
namespace pg8 {
constexpr int BM = 256, BK = 64, HALF = 128, HTB = HALF * BK * 2, STAGE_BYTES = 8 * HTB, NXCD = 8, WGM = 8;
__host__ __device__ __forceinline__ int lds_byte(int r, int c) { const int st = (r >> 4) * 2 + (c >> 5), rr = r & 15, cc = c & 31, ob = rr * 64 + cc * 2; return st * 1024 + (ob ^ (((ob >> 9) & 1) << 5)); }
__host__ __device__ __forceinline__ void stage_rc(int b, int& R, int& C) { const int st = b / 1024, sb = b % 1024, swz = sb ^ (((sb >> 9) & 1) << 5); R = (st >> 1) * 16 + swz / 64; C = (st & 1) * 32 + (swz % 64) / 2; }
__host__ __device__ __forceinline__ int perm32(int rho) { const int n = rho >> 4, i = rho & 15; return 8 * (i >> 2) + 4 * n + (i & 3); }

struct Unit { int pm, pn; long aoff, boff; int x0, x1; };
struct Gemm { const bf16_t* A; const bf16_t* Bt; int K; int lda, ldb; const float* sa; const float* sb; };

template <int MODE> struct Sched {
    int nM, nN, nwg, G, c; long lda, ldb;
    __device__ void init(int nM_, int nN_, int nwg_, long lda_, long ldb_) { nM = nM_; nN = nN_; nwg = nwg_; G = ogrid(); c = obid(); lda = lda_; ldb = ldb_; }
    __device__ void rotate(int r) { c = (c + r) % G; }
    __device__ bool next(int i, Unit& u) const {
        const long L = (long)i * G + c; if (L >= nwg) return false;
        int wgid = (int)L;
        if (MODE == 0 || MODE == 5 || MODE == 6) {
            { const int q = nwg / NXCD, r = nwg % NXCD, xcd = wgid % NXCD, off = wgid / NXCD; wgid = (xcd < r ? xcd * (q + 1) : r * (q + 1) + (xcd - r) * q) + off; }
            const int nig = WGM * nN, gid = wgid / nig, fm = gid * WGM, gsz = (nM - fm) < WGM ? (nM - fm) : WGM;
            u.pm = fm + ((wgid % nig) % gsz); u.pn = (wgid % nig) / gsz; u.x0 = 0; u.x1 = 0;
            { const int pl = u.pn;
              if (MODE == 5) u.pn = pl < 3 ? pl + 2 : pl + 5;
              if (MODE == 6) u.pn = pl < 2 ? pl : (pl < 5 ? pl + 3 : pl + 7);
              u.aoff = (long)u.pm * 256 * lda * 2; u.boff = (long)(MODE == 6 ? pl : u.pn) * 256 * ldb * 2; }
        } else if (MODE == 1) {
            const int h = wgid >> 4, rem = wgid & 15, rt = rem >> 1, pn = rem & 1;
            u.pm = rt; u.pn = pn; u.x0 = h; u.x1 = rt;
            u.aoff = ((long)(TP + 256 * rt) * 3072 + h * 192) * 2; u.boff = ((long)(h * 512 + 256 * pn) * 256) * 2;
        } else if (MODE == 2) {
            const int b = wgid / 36, rem = wgid % 36, pm = rem / 9, pn = rem % 9;
            u.pm = pm; u.pn = pn; u.x0 = b; u.x1 = 0;
            u.aoff = ((long)(b * 1024 + 256 * pm) * QLD) * 2; u.boff = ((long)(b * KPAD + 256 * pn) * QLD) * 2;
        } else if (MODE == 3) {
            const int b = wgid >> 3, pm = (wgid & 7) >> 1, pn = wgid & 1;
            u.pm = pm; u.pn = pn; u.x0 = b; u.x1 = 0;
            u.aoff = ((long)(b * 1024 + 256 * pm) * KPAD) * 2; u.boff = ((long)(b * 512 + 256 * pn) * KPAD) * 2;
        } else {
            const int h = wgid >> 3, rt = wgid & 7;
            u.pm = rt; u.pn = 0; u.x0 = h; u.x1 = rt;
            u.aoff = ((long)(h * 2048 + 256 * rt) * 512) * 2; u.boff = ((long)(h * 256) * 512) * 2;
        }
        return true;
    }
};

template <class Epi, class SchedT, int I8 = 0>
__device__ __forceinline__ void gemm_phase(LAS unsigned char* lds, const Gemm g, const SchedT& S, const Epi& E) {
    const int tid = otid(), wid = __builtin_amdgcn_readfirstlane(tid >> 6), lane = tid & 63, wr = wid >> 2, wc = wid & 3, fr = lane & 15, fq = lane >> 4;
    const int K = g.K, nt = K / BK;
    unsigned voffA[2], voffB[2];
#pragma unroll
    for (int i = 0; i < 2; ++i) { int R, C; stage_rc(tid * 16 + i * 8192, R, C); const int Rb = Epi::PERM ? ((R & ~31) + perm32(R & 31)) : R;
        voffA[i] = (unsigned)(R * g.lda + C) * 2u; voffB[i] = (unsigned)(Rb * g.ldb + C) * 2u; }
    const size_t kstep = (size_t)(BK * 2);
    const size_t hstepA = (size_t)HALF * g.lda * 2, hstepB = (size_t)HALF * g.ldb * 2;
    const unsigned ldsw = (unsigned)wid * 1024u;
    const int aoff = lds_byte(wr * 64 + fr, fq * 8), boff = lds_byte(wc * 32 + fr, fq * 8);
#define PG8_SA(b, h) (((b) * 2 + (h)) * HTB)
#define PG8_SB(b, h) ((4 + (b) * 2 + (h)) * HTB)
#define PG8_STAGE(bufoff, gbase, voff) do { _Pragma("unroll") for (int _i = 0; _i < 2; ++_i) \
        __builtin_amdgcn_global_load_lds((const unsigned*)((const char*)(gbase) + (voff)[_i]), (LAS unsigned*)(lds + (bufoff) + ldsw + _i * 8192), 16, 0, 0); } while (0)
#define PG8_LDA(dst, b, h) do { _Pragma("unroll") for (int m = 0; m < 4; ++m) _Pragma("unroll") for (int k = 0; k < 2; ++k) dst[m][k] = *(const LAS bf16x8*)(lds + PG8_SA(b, h) + aoff + m * 2048 + k * 1024); } while (0)
#define PG8_LDB(dst, b, h) do { _Pragma("unroll") for (int n = 0; n < 2; ++n) _Pragma("unroll") for (int k = 0; k < 2; ++k) dst[n][k] = *(const LAS bf16x8*)(lds + PG8_SB(b, h) + boff + n * 2048 + k * 1024); } while (0)
#define PG8_MMA(ai, bj, At, Bt) do { __builtin_amdgcn_s_setprio(1); _Pragma("unroll") for (int m = 0; m < 4; ++m) _Pragma("unroll") for (int n = 0; n < 2; ++n) _Pragma("unroll") for (int k = 0; k < 2; ++k) \
        { if constexpr (I8) acc[ai][bj][m][n] = __builtin_bit_cast(f32x4, __builtin_amdgcn_mfma_i32_16x16x64_i8(__builtin_bit_cast(i32x4, Bt[n][k]), __builtin_bit_cast(i32x4, At[m][k]), __builtin_bit_cast(i32x4, acc[ai][bj][m][n]), 0, 0, 0)); \
          else acc[ai][bj][m][n] = __builtin_amdgcn_mfma_f32_16x16x32_bf16(Bt[n][k], At[m][k], acc[ai][bj][m][n], 0, 0, 0); } __builtin_amdgcn_s_setprio(0); } while (0)
#define PG8_WAIT_V(n) asm volatile("s_waitcnt vmcnt(" #n ")" ::: "memory")
#define PG8_WAIT_L(n) asm volatile("s_waitcnt lgkmcnt(" #n ")" ::: "memory")
#define PG8_BAR __builtin_amdgcn_s_barrier()
#define PG8_SCHED __builtin_amdgcn_sched_barrier(0)
    Unit cur, nxt; int ui = 0;
    if (!S.next(0, cur)) return;
    f32x4 acc[2][2][4][2];
#pragma unroll
    for (int a = 0; a < 2; ++a)
#pragma unroll
        for (int b = 0; b < 2; ++b)
#pragma unroll
            for (int m = 0; m < 4; ++m)
#pragma unroll
                for (int n = 0; n < 2; ++n) acc[a][b][m][n] = (f32x4){0.f, 0.f, 0.f, 0.f};
    bf16x8 At[4][2], B0[2][2], B1[2][2];
    const char* cA = (const char*)g.A + cur.aoff; const char* cB = (const char*)g.Bt + cur.boff;
    PG8_STAGE(PG8_SB(0, 0), cB, voffB); PG8_STAGE(PG8_SA(0, 0), cA, voffA); PG8_STAGE(PG8_SB(0, 1), cB + hstepB, voffB); PG8_STAGE(PG8_SA(0, 1), cA + hstepA, voffA);
    if (wr == 1) PG8_BAR;
    PG8_WAIT_V(4); PG8_BAR;
    PG8_STAGE(PG8_SB(1, 0), cB + kstep, voffB); PG8_STAGE(PG8_SA(1, 0), cA + kstep, voffA); PG8_STAGE(PG8_SB(1, 1), cB + hstepB + kstep, voffB);
    PG8_WAIT_V(6); PG8_BAR;
    for (;;) {
        const bool has_next = S.next(ui + 1, nxt);
        const char* nA = has_next ? (const char*)g.A + nxt.aoff : cA; const char* nB = has_next ? (const char*)g.Bt + nxt.boff : cB;
        for (int t = 0; t < nt; t += 2) {
            const bool last = (t == nt - 2);
            const char* a1 = cA + (size_t)(t + 1) * kstep;
            const char* a2 = last ? nA : cA + (size_t)(t + 2) * kstep; const char* b2 = last ? nB : cB + (size_t)(t + 2) * kstep;
            const char* a3 = a2 + kstep; const char* b3 = b2 + kstep;
            PG8_LDB(B0, 0, 0); PG8_SCHED; PG8_LDA(At, 0, 0); PG8_STAGE(PG8_SA(1, 1), a1 + hstepA, voffA);
            PG8_WAIT_L(8); PG8_BAR; PG8_WAIT_L(0); PG8_MMA(0, 0, At, B0); PG8_BAR; PG8_SCHED;
            PG8_LDB(B1, 0, 1); PG8_STAGE(PG8_SB(0, 0), b2, voffB);
            PG8_BAR; PG8_WAIT_L(0); PG8_MMA(0, 1, At, B1); PG8_BAR;
            PG8_LDA(At, 0, 1); PG8_STAGE(PG8_SA(0, 0), a2, voffA);
            PG8_BAR; PG8_WAIT_L(0); PG8_MMA(1, 0, At, B0); PG8_BAR; PG8_SCHED;
            PG8_STAGE(PG8_SB(0, 1), b2 + hstepB, voffB);
            PG8_WAIT_V(6); PG8_BAR; PG8_MMA(1, 1, At, B1); PG8_BAR;
            PG8_LDB(B0, 1, 0); PG8_SCHED; PG8_LDA(At, 1, 0); PG8_STAGE(PG8_SA(0, 1), a2 + hstepA, voffA);
            PG8_WAIT_L(8); PG8_BAR; PG8_WAIT_L(0); PG8_MMA(0, 0, At, B0); PG8_BAR; PG8_SCHED;
            PG8_LDB(B1, 1, 1); PG8_STAGE(PG8_SB(1, 0), b3, voffB);
            PG8_BAR; PG8_WAIT_L(0); PG8_MMA(0, 1, At, B1); PG8_BAR;
            PG8_LDA(At, 1, 1); PG8_STAGE(PG8_SA(1, 0), a3, voffA);
            PG8_BAR; PG8_WAIT_L(0); PG8_MMA(1, 0, At, B0); PG8_BAR; PG8_SCHED;
            PG8_STAGE(PG8_SB(1, 1), b3 + hstepB, voffB);
            PG8_WAIT_V(6); PG8_BAR; PG8_MMA(1, 1, At, B1); PG8_BAR;
        }
        if constexpr (I8) {
#pragma unroll
            for (int a = 0; a < 2; ++a)
#pragma unroll
                for (int b = 0; b < 2; ++b)
#pragma unroll
                    for (int m = 0; m < 4; ++m)
#pragma unroll
                        for (int n = 0; n < 2; ++n) { const i32x4 iv = __builtin_bit_cast(i32x4, acc[a][b][m][n]); acc[a][b][m][n] = (f32x4){(float)iv[0], (float)iv[1], (float)iv[2], (float)iv[3]}; } }
        if constexpr (I8 == 2) {
            static_assert(Epi::PERM, "I8 == 2 assumes the PERM column layout");
            f32x4 sbv[2][2];
#pragma unroll
            for (int b = 0; b < 2; ++b) { const int c = cur.pn * BM + b * HALF + wc * 32 + 8 * fq; sbv[b][0] = *(const f32x4*)(g.sb + c); sbv[b][1] = *(const f32x4*)(g.sb + c + 4); }
#pragma unroll
            for (int a = 0; a < 2; ++a)
#pragma unroll
                for (int m = 0; m < 4; ++m) { const float s_ = g.sa[(long)cur.pm * BM + a * HALF + wr * 64 + m * 16 + fr];
#pragma unroll
                    for (int b = 0; b < 2; ++b) { acc[a][b][m][0] = acc[a][b][m][0] * sbv[b][0] * s_; acc[a][b][m][1] = acc[a][b][m][1] * sbv[b][1] * s_; } } }
        E(acc, cur, wr, wc, fr, fq);
        if (!has_next) break;
#pragma unroll
        for (int a = 0; a < 2; ++a)
#pragma unroll
            for (int b = 0; b < 2; ++b)
#pragma unroll
                for (int m = 0; m < 4; ++m)
#pragma unroll
                    for (int n = 0; n < 2; ++n) acc[a][b][m][n] = (f32x4){0.f, 0.f, 0.f, 0.f};
        cur = nxt; cA = nA; cB = nB; ++ui;
    }
    PG8_WAIT_V(0);
    if (wr == 0) PG8_BAR;
    PG8_BAR;
#undef PG8_SA
#undef PG8_SB
#undef PG8_STAGE
#undef PG8_LDA
#undef PG8_LDB
#undef PG8_MMA
#undef PG8_WAIT_V
#undef PG8_WAIT_L
#undef PG8_BAR
#undef PG8_SCHED
}

struct EpiBf16 {
    static constexpr bool PERM = true;
    bf16_t* O; long ldc; long bstride;
    __device__ __forceinline__ void operator()(const f32x4 (&acc)[2][2][4][2], const Unit& u, int wr, int wc, int fr, int fq) const {
        bf16_t* base = O + (long)u.x0 * bstride + (long)(u.pm * BM + wr * 64 + fr) * ldc + u.pn * BM + wc * 32 + 8 * fq;
#pragma unroll
        for (int ai = 0; ai < 2; ++ai)
#pragma unroll
            for (int m = 0; m < 4; ++m) { bf16_t* rowp = base + (long)(ai * HALF + m * 16) * ldc;
#pragma unroll
                for (int bj = 0; bj < 2; ++bj) { const f32x4 v0 = acc[ai][bj][m][0], v1 = acc[ai][bj][m][1];
                    u32x4 w; w.x = cvt_pk_bf16(v0[0], v0[1]); w.y = cvt_pk_bf16(v0[2], v0[3]); w.z = cvt_pk_bf16(v1[0], v1[1]); w.w = cvt_pk_bf16(v1[2], v1[3]);
                    *(u32x4*)(rowp + bj * HALF) = w; } }
    }
};
template <int RMODE> struct EpiRowMap {
    static constexpr bool PERM = true;
    bf16_t* O; const float* rsum;
    __device__ __forceinline__ void operator()(const f32x4 (&acc)[2][2][4][2], const Unit& u, int wr, int wc, int fr, int fq) const {
        const int col0 = u.pn * BM + wc * 32 + 8 * fq;
#pragma unroll
        for (int ai = 0; ai < 2; ++ai)
#pragma unroll
            for (int m = 0; m < 4; ++m) { const int r = ai * HALF + wr * 64 + m * 16 + fr; long drow; long ldc;
                if (RMODE == 1) { const int ts = 256 * u.x1 + r; drow = (long)(ts >> 6) * 1024 + u.x0 * 64 + (ts & 63); ldc = QLD; }
                float rs = 1.0f;
                if (RMODE == 1) { }
                else { const int qr = 256 * u.pm + r; drow = (long)(qr >> 6) * 2048 + u.x0 * 64 + (qr & 63); ldc = 512; rs = 1.0f / rsum[u.x0 * 1024 + qr]; }
                bf16_t* rowp = O + drow * ldc + col0;
#pragma unroll
                for (int bj = 0; bj < 2; ++bj) { const f32x4 v0 = acc[ai][bj][m][0] * rs, v1 = acc[ai][bj][m][1] * rs;
                    u32x4 w; w.x = cvt_pk_bf16(v0[0], v0[1]); w.y = cvt_pk_bf16(v0[2], v0[3]); w.z = cvt_pk_bf16(v1[0], v1[1]); w.w = cvt_pk_bf16(v1[2], v1[3]);
                    *(u32x4*)(rowp + bj * HALF) = w; } }
    }
};
struct EpiOV {
    static constexpr bool PERM = true;
    bf16_t* O;
    __device__ __forceinline__ void operator()(const f32x4 (&acc)[2][2][4][2], const Unit& u, int wr, int wc, int fr, int fq) const {
#pragma unroll
        for (int ai = 0; ai < 2; ++ai)
#pragma unroll
            for (int m = 0; m < 4; ++m) { const int r = ai * HALF + wr * 64 + m * 16 + fr;
                bf16_t* rowp = O + (long)(TP + 256 * u.x1 + r) * DM + u.x0 * 128 + wc * 32 + 8 * fq;
                const f32x4 v0 = acc[ai][1][m][0], v1 = acc[ai][1][m][1];
                u32x4 w; w.x = cvt_pk_bf16(v0[0], v0[1]); w.y = cvt_pk_bf16(v0[2], v0[3]); w.z = cvt_pk_bf16(v1[0], v1[1]); w.w = cvt_pk_bf16(v1[2], v1[3]);
                *(u32x4*)rowp = w; }
    }
};
struct EpiMix {
    static constexpr bool PERM = true;
    const bf16_t* Y; const bf16_t* YA; bf16_t* MIX; const float* sa; const float* sb;
    __device__ __forceinline__ void operator()(const f32x4 (&acc)[2][2][4][2], const Unit& u, int wr, int wc, int fr, int fq) const {
#pragma unroll
        for (int ai = 0; ai < 2; ++ai)
#pragma unroll
            for (int m = 0; m < 4; ++m) { const long t = (long)u.pm * BM + ai * HALF + wr * 64 + m * 16 + fr; const float s_ = sa[t];
#pragma unroll
                for (int bj = 0; bj < 2; ++bj) { const int c = u.pn * BM + bj * HALF + wc * 32 + 8 * fq;
                    const u32x4 ga = *(const u32x4*)(Y + t * INWP + C_GA + c), gb = *(const u32x4*)(Y + t * INWP + C_GB + c), ya = *(const u32x4*)(YA + t * DM + c);
                    float fa[8], fb[8], fy[8], o[8]; unpack8(ga, fa); unpack8(gb, fb); unpack8(ya, fy);
                    const f32x4 v0 = acc[ai][bj][m][0] * *(const f32x4*)(sb + c) * s_, v1 = acc[ai][bj][m][1] * *(const f32x4*)(sb + c + 4) * s_;
                    const float av[8] = {v0[0], v0[1], v0[2], v0[3], v1[0], v1[1], v1[2], v1[3]};
#pragma unroll
                    for (int j = 0; j < 8; ++j) {
#if defined(DBG_MIX) && DBG_MIX == 1
                        o[j] = sigmoidf_(fb[j]) * av[j];
#elif defined(DBG_MIX) && DBG_MIX == 2
                        o[j] = sigmoidf_(fa[j]) * fy[j];
#else
                        o[j] = sigmoidf_(fa[j]) * fy[j] + sigmoidf_(fb[j]) * av[j];
#endif
                    }
                    *(u32x4*)(MIX + t * DM + c) = pack8(o); } }
    }
};
struct EpiRes {
    static constexpr bool PERM = false;
    float* X; const float* gate;
    const float* XinP; const float* XinS;
    __device__ __forceinline__ void operator()(const f32x4 (&acc)[2][2][4][2], const Unit& u, int wr, int wc, int fr, int fq) const {
#pragma unroll
        for (int ai = 0; ai < 2; ++ai)
#pragma unroll
            for (int m = 0; m < 4; ++m) { const int t = u.pm * BM + ai * HALF + wr * 64 + m * 16 + fr; const float* gr = gate + (long)cond_row(t) * 12288; float* xr = X + (long)t * DM; const float* xi = t < TP ? XinP + (long)t * DM : XinS + (long)(t - TP) * DM;
#pragma unroll
                for (int bj = 0; bj < 2; ++bj)
#pragma unroll
                    for (int n = 0; n < 2; ++n) { const int c = u.pn * BM + bj * HALF + wc * 32 + n * 16 + 4 * fq;
                        const f32x4 gv = *(const f32x4*)(gr + c); const f32x4 xv = *(const f32x4*)(xi + c);
                        *(f32x4*)(xr + c) = xv + gv * acc[ai][bj][m][n]; } }
    }
};

struct EpiQ {
    static constexpr bool PERM = true;
    bf16_t* Q; bf16_t* QL; const float* T64;
    __device__ __forceinline__ void operator()(const f32x4 (&acc)[2][2][4][2], const Unit& u, int wr, int wc, int fr, int fq) const {
        const int grp = u.pn / 3, typ = u.pn - 3 * grp;
        if (typ < 2) {
#pragma unroll
            for (int ai = 0; ai < 2; ++ai)
#pragma unroll
                for (int m = 0; m < 4; ++m) { const long t = (long)u.pm * BM + ai * HALF + wr * 64 + m * 16 + fr;
#pragma unroll
                    for (int bj = 0; bj < 2; ++bj) { const f32x4 v0 = acc[ai][bj][m][0], v1 = acc[ai][bj][m][1];
                        u32x4 w; w.x = cvt_pk_bf16(v0[0], v0[1]); w.y = cvt_pk_bf16(v0[2], v0[3]); w.z = cvt_pk_bf16(v1[0], v1[1]); w.w = cvt_pk_bf16(v1[2], v1[3]);
                        *(u32x4*)(Q + t * 3072 + 768 * grp + 192 * (2 * typ + bj) + wc * 32 + 8 * fq) = w; } }
        } else {
#pragma unroll
            for (int ai = 0; ai < 2; ++ai)
#pragma unroll
                for (int m = 0; m < 4; ++m) { const int t = u.pm * BM + ai * HALF + wr * 64 + m * 16 + fr; const int pos = tok_pos(t);
                    const float* cs = T64 + ((long)pos * 32 + 8 * fq) * 2; float cv[8], sv[8];
#pragma unroll
                    for (int j = 0; j < 4; ++j) { const f32x4 qv = *(const f32x4*)(cs + 4 * j); cv[2 * j] = qv[0]; sv[2 * j] = qv[1]; cv[2 * j + 1] = qv[2]; sv[2 * j + 1] = qv[3]; }
                    const f32x4 a0 = acc[ai][0][m][0], a1 = acc[ai][0][m][1], b0 = acc[ai][1][m][0], b1 = acc[ai][1][m][1];
                    const float x1[8] = {a0[0], a0[1], a0[2], a0[3], a1[0], a1[1], a1[2], a1[3]}, x2[8] = {b0[0], b0[1], b0[2], b0[3], b1[0], b1[1], b1[2], b1[3]};
                    float o1[8], o2[8];
#pragma unroll
                    for (int j = 0; j < 8; ++j) { o1[j] = x1[j] * cv[j] - x2[j] * sv[j]; o2[j] = x1[j] * sv[j] + x2[j] * cv[j]; }
                    const u32x4 w1 = pack8(o1), w2 = pack8(o2); const int hd = 4 * grp + wc;
                    bf16_t* qd = Q + (long)t * 3072 + hd * 192 + 128 + 8 * fq; *(u32x4*)qd = w1; *(u32x4*)(qd + 32) = w2;
                    if (t >= TP) { const int ts = t - TP; bf16_t* d = QL + ((long)(ts >> 6) * 1024 + hd * 64 + (ts & 63)) * QLD + 512 + 8 * fq; *(u32x4*)d = w1; *(u32x4*)(d + 32) = w2; } }
        }
    }
};

struct EpiExp {
    static constexpr bool PERM = true;
    bf16_t* O; float* rsum;
    __device__ __forceinline__ void operator()(const f32x4 (&acc)[2][2][4][2], const Unit& u, int wr, int wc, int fr, int fq) const {
        bf16_t* base = O + (long)u.x0 * 1024 * KPAD + (long)(u.pm * BM + wr * 64 + fr) * KPAD + u.pn * BM + wc * 32 + 8 * fq;
#pragma unroll
        for (int ai = 0; ai < 2; ++ai)
#pragma unroll
            for (int m = 0; m < 4; ++m) { bf16_t* rowp = base + (long)(ai * HALF + m * 16) * KPAD; float part = 0.f;
#pragma unroll
                for (int bj = 0; bj < 2; ++bj) { const int c0 = u.pn * BM + bj * HALF + wc * 32 + 8 * fq; const f32x4 v0 = acc[ai][bj][m][0], v1 = acc[ai][bj][m][1];
                    const float sv[8] = {v0[0], v0[1], v0[2], v0[3], v1[0], v1[1], v1[2], v1[3]}; float e[8];
#pragma unroll
                    for (int j = 0; j < 8; ++j) { e[j] = (c0 + j < KALL) ? __expf(fminf(sv[j] * MLA_SCALE, 60.f)) : 0.f; part += e[j]; }
                    *(u32x4*)(rowp + bj * HALF) = pack8(e); }
                part += sx<16>(part); part += sx<32>(part);
                if (fq == 0) atomicAdd(rsum + u.x0 * 1024 + u.pm * BM + ai * HALF + wr * 64 + m * 16 + fr, part); }
    }
};

struct EpiQ8 {
    static constexpr bool PERM = true;
    bf16_t* O; long ldc; const float* sa; const float* sb;
    __device__ __forceinline__ void operator()(const f32x4 (&acc)[2][2][4][2], const Unit& u, int wr, int wc, int fr, int fq) const {
        f32x4 sbv[2][2];
#pragma unroll
        for (int bj = 0; bj < 2; ++bj) { const int c = u.pn * BM + bj * HALF + wc * 32 + 8 * fq; sbv[bj][0] = *(const f32x4*)(sb + c); sbv[bj][1] = *(const f32x4*)(sb + c + 4); }
#pragma unroll
        for (int ai = 0; ai < 2; ++ai)
#pragma unroll
            for (int m = 0; m < 4; ++m) { const long t = (long)u.pm * BM + ai * HALF + wr * 64 + m * 16 + fr; const float s = sa[t];
#pragma unroll
                for (int bj = 0; bj < 2; ++bj) { const f32x4 v0 = acc[ai][bj][m][0] * sbv[bj][0] * s, v1 = acc[ai][bj][m][1] * sbv[bj][1] * s;
                    u32x4 w; w.x = cvt_pk_bf16(v0[0], v0[1]); w.y = cvt_pk_bf16(v0[2], v0[3]); w.z = cvt_pk_bf16(v1[0], v1[1]); w.w = cvt_pk_bf16(v1[2], v1[3]);
                    *(u32x4*)(O + t * ldc + u.pn * BM + bj * HALF + wc * 32 + 8 * fq) = w; } }
    }
};
}
namespace att {
constexpr int NW = 8, QBLK = 32, KVBLK = 64;
constexpr float SCALE = MLA_SCALE;
constexpr float THR = 8.f;
constexpr int KROW = 384;
constexpr int SHM_V = KVBLK * 128 * 2, SHM_K = KVBLK * KROW;
constexpr int QR_PITCH = 144, SHM_QR = 256 * QR_PITCH;
constexpr int SHM_ATTN = 2 * SHM_V + 2 * SHM_K + NW * 64 * 4 + SHM_QR;
#define KSWZ(row, colB) ((row) * att::KROW + ((colB) ^ (((row) & 7) << 4)))
#define SBAR() __builtin_amdgcn_sched_barrier(0)
__device__ __forceinline__ int crow(int r, int hi) { return (r & 3) + 8 * (r >> 2) + 4 * hi; }

__device__ __forceinline__ void partialSM(f32x16& p0, f32x16& p1, float& m_reg, float& mn, float& alpha) {
  constexpr float C = SCALE * 1.4426950408889634f;
  float pmax = p0[0];
#pragma unroll
  for (int r = 1; r < 16; ++r) pmax = fmaxf(pmax, p0[r]);
#pragma unroll
  for (int r = 0; r < 16; ++r) pmax = fmaxf(pmax, p1[r]);
  { auto rr = __builtin_amdgcn_permlane32_swap(__float_as_uint(pmax), __float_as_uint(pmax), false, false);
    pmax = fmaxf(__uint_as_float(rr[0]), __uint_as_float(rr[1])); }
  if (__builtin_expect(__all(pmax - m_reg <= THR / SCALE), 1)) { mn = m_reg; alpha = 1.f; }
  else { mn = fmaxf(m_reg, pmax); alpha = __builtin_amdgcn_exp2f((m_reg - mn) * C); m_reg = mn; }
  float mnC = -mn * C;
#pragma unroll
  for (int r = 0; r < 16; ++r) p0[r] = fmaf(p0[r], C, mnC);
#pragma unroll
  for (int r = 0; r < 16; ++r) p1[r] = fmaf(p1[r], C, mnC);
#pragma unroll
  for (int r = 0; r < 16; ++r) p0[r] = __builtin_amdgcn_exp2f(p0[r]);
}
__device__ __forceinline__ void finishSM(f32x16& p0, f32x16& p1, float alpha, float& l_reg, bf16x8& pa0, bf16x8& pa1, bf16x8& pa2, bf16x8& pa3) {
#pragma unroll
  for (int r = 0; r < 16; ++r) p1[r] = __builtin_amdgcn_exp2f(p1[r]);
  float ps = 0;
#pragma unroll
  for (int r = 0; r < 16; ++r) ps += p0[r];
#pragma unroll
  for (int r = 0; r < 16; ++r) ps += p1[r];
  { auto rr = __builtin_amdgcn_permlane32_swap(__float_as_uint(ps), __float_as_uint(ps), false, false);
    ps = __uint_as_float(rr[0]) + __uint_as_float(rr[1]); }
  l_reg = l_reg * alpha + ps;
#define PK4(P, BASE, OUT) do { unsigned a0 = cvt_pk_bf16(P[BASE + 0], P[BASE + 1]), a1 = cvt_pk_bf16(P[BASE + 2], P[BASE + 3]);   \
    unsigned b0 = cvt_pk_bf16(P[BASE + 4], P[BASE + 5]), b1 = cvt_pk_bf16(P[BASE + 6], P[BASE + 7]);                              \
    auto r0 = __builtin_amdgcn_permlane32_swap(a0, b0, false, false); auto r1 = __builtin_amdgcn_permlane32_swap(a1, b1, false, false); \
    u32x4 w = {r0[0], r1[0], r0[1], r1[1]}; OUT = *reinterpret_cast<bf16x8*>(&w); } while (0)
  PK4(p0, 0, pa0); PK4(p0, 8, pa1); PK4(p1, 0, pa2); PK4(p1, 8, pa3);
#undef PK4
}
__device__ __forceinline__ void qkt(f32x16& p0, f32x16& p1, const char* Ks, const bf16x8* qr, const char* qrope, const int (&kbase)[4], bool vis) {
  p0 = f32x16{}; p1 = f32x16{};
  if (vis) {
#pragma unroll
  for (int d0 = 0; d0 < 12; ++d0) {
    bf16x8 b0 = *reinterpret_cast<const bf16x8*>(Ks + kbase[d0 & 3] + (d0 >> 2) * 128);
    bf16x8 b1 = *reinterpret_cast<const bf16x8*>(Ks + kbase[d0 & 3] + (d0 >> 2) * 128 + 32 * KROW);
    const bf16x8 qv = d0 < 8 ? qr[d0 < 8 ? d0 : 0] : *reinterpret_cast<const bf16x8*>(qrope + (d0 - 8) * 32);
    p0 = __builtin_amdgcn_mfma_f32_32x32x16_bf16(b0, qv, p0, 0, 0, 0);
    p1 = __builtin_amdgcn_mfma_f32_32x32x16_bf16(b1, qv, p1, 0, 0, 0); }
  }
  if (!vis) {
#pragma unroll
    for (int r = 0; r < 16; ++r) { p0[r] = -1e30f; p1[r] = -1e30f; } }
}
__device__ __forceinline__ int v_st(int k, int c) { const int kk = (k & ~0xC) | ((k & 4) << 1) | ((k & 8) >> 1); return ((kk >> 3) * 4 + (c >> 5)) * 512 + ((kk & 7) * 32 + (c & 31)) * 2; }
__device__ __forceinline__ int v_rd_base(int lane) { return ((lane & 3) << 3) | (((lane >> 2) & 3) << 6) | (((lane >> 4) & 1) << 5) | (((lane >> 5) & 1) << 8); }
constexpr int v_rd_off(int d0, int ks, int half) { return d0 * 512 + ks * 4096 + half * 2048; }
template <int OFF> __device__ __forceinline__ s16x4 tr_read(int vb) {
  s16x4 r; asm volatile("ds_read_b64_tr_b16 %0, %1 offset:%2" : "=&v"(r) : "v"(vb), "i"(OFF) : "memory"); return r;
}
template <int D0> __device__ __forceinline__ void pv_one(f32x16& od, int vb, bf16x8 pa0, bf16x8 pa1, bf16x8 pa2, bf16x8 pa3) {
  const s16x4 l0 = tr_read<v_rd_off(D0, 0, 0)>(vb), h0 = tr_read<v_rd_off(D0, 0, 1)>(vb), l1 = tr_read<v_rd_off(D0, 1, 0)>(vb), h1 = tr_read<v_rd_off(D0, 1, 1)>(vb);
  const s16x4 l2 = tr_read<v_rd_off(D0, 2, 0)>(vb), h2 = tr_read<v_rd_off(D0, 2, 1)>(vb), l3 = tr_read<v_rd_off(D0, 3, 0)>(vb), h3 = tr_read<v_rd_off(D0, 3, 1)>(vb);
  asm volatile("s_waitcnt lgkmcnt(0)" ::: "memory"); SBAR();
#define PK(L, H) (bf16x8){L[0], L[1], L[2], L[3], H[0], H[1], H[2], H[3]}
  od = __builtin_amdgcn_mfma_f32_32x32x16_bf16(pa0, PK(l0, h0), od, 0, 0, 0);
  od = __builtin_amdgcn_mfma_f32_32x32x16_bf16(pa1, PK(l1, h1), od, 0, 0, 0);
  od = __builtin_amdgcn_mfma_f32_32x32x16_bf16(pa2, PK(l2, h2), od, 0, 0, 0);
  od = __builtin_amdgcn_mfma_f32_32x32x16_bf16(pa3, PK(l3, h3), od, 0, 0, 0);
#undef PK
}
__device__ __forceinline__ void pv_d0(f32x16* o, int vb, bf16x8 pa0, bf16x8 pa1, bf16x8 pa2, bf16x8 pa3) {
  pv_one<0>(o[0], vb, pa0, pa1, pa2, pa3); pv_one<1>(o[1], vb, pa0, pa1, pa2, pa3); pv_one<2>(o[2], vb, pa0, pa1, pa2, pa3); pv_one<3>(o[3], vb, pa0, pa1, pa2, pa3);
}

__device__ __forceinline__ void attn_block(const bf16_t* __restrict__ Qb, const bf16_t* __restrict__ Kn, const bf16_t* __restrict__ Kr, const bf16_t* __restrict__ Vh,
                                           bf16_t* __restrict__ Ob, int qb, char* lds) {
  constexpr int LDQ = 3072, LDK = 4096, LDR = 64, LDO = 2048;
  const int tid = otid(), wid = tid >> 6, lane = tid & 63, r32 = lane & 31, hi = lane >> 5;
  char* V_lds = lds; char* K_lds = lds + 2 * SHM_V;
  float* ws = (float*)(lds + 2 * SHM_V + 2 * SHM_K) + wid * 64; float* li_l = ws; float* al_l = ws + 32;
  float m_reg = -1e30f, l_reg = 0; f32x16 o[4] = {}; bf16x8 qr[8];
  const bf16_t* Qw = Qb + (long)(wid * QBLK + r32) * LDQ + hi * 8;
#pragma unroll
  for (int d0 = 0; d0 < 8; ++d0) qr[d0] = *reinterpret_cast<const bf16x8*>(Qw + d0 * 16);
  char* qrope = lds + 2 * SHM_V + 2 * SHM_K + NW * 64 * 4 + (wid * QBLK + r32) * QR_PITCH + hi * 16;
#pragma unroll
  for (int d0 = 8; d0 < 12; ++d0) *reinterpret_cast<bf16x8*>(qrope + (d0 - 8) * 32) = *reinterpret_cast<const bf16x8*>(Qw + d0 * 16);
  asm volatile("s_waitcnt lgkmcnt(0)" ::: "memory");
  const int NT = 4 * qb + 4, jmax = 4 * qb + (wid >> 1);
  int kbase[4];
#pragma unroll
  for (int dl = 0; dl < 4; ++dl) kbase[dl] = r32 * KROW + (((dl << 5) | (hi << 4)) ^ ((r32 & 7) << 4));
  const int sr = tid >> 4, sc = (tid & 15) * 8, vst0 = v_st(sr, sc), vst1 = v_st(32 + sr, sc);
  const int rr = tid >> 3, rc = (tid & 7) * 8;
  const int vb0 = (int)(uintptr_t)V_lds + v_rd_base(lane);
  bf16x8 vs0, vs1, ks0, ks1, kr0;
#define SLOAD(k0) do { vs0 = *reinterpret_cast<const bf16x8*>(&Vh[(long)((k0) + sr) * LDK + sc]); vs1 = *reinterpret_cast<const bf16x8*>(&Vh[(long)((k0) + 32 + sr) * LDK + sc]); \
    ks0 = *reinterpret_cast<const bf16x8*>(&Kn[(long)((k0) + sr) * LDK + sc]); ks1 = *reinterpret_cast<const bf16x8*>(&Kn[(long)((k0) + 32 + sr) * LDK + sc]); \
    kr0 = *reinterpret_cast<const bf16x8*>(&Kr[(long)((k0) + rr) * LDR + rc]); } while (0)
#define SWRITE(b) do { *(bf16x8*)(V_lds + (b) * SHM_V + vst0) = vs0; *(bf16x8*)(V_lds + (b) * SHM_V + vst1) = vs1; int kc = sc * 2; \
    *(bf16x8*)(K_lds + (b) * SHM_K + KSWZ(sr, kc)) = ks0; *(bf16x8*)(K_lds + (b) * SHM_K + KSWZ(32 + sr, kc)) = ks1; \
    *(bf16x8*)(K_lds + (b) * SHM_K + KSWZ(rr, 256 + rc * 2)) = kr0; } while (0)
#define SWAIT() asm volatile("s_waitcnt vmcnt(0)" ::: "memory")
#define RESC(a) do { if (__any((a) < 1.f)) { if (hi == 0) al_l[r32] = (a); asm volatile("s_waitcnt lgkmcnt(0)" ::: "memory"); \
    _Pragma("unroll") for (int d = 0; d < 4; ++d) _Pragma("unroll") for (int r = 0; r < 16; ++r) o[d][r] *= al_l[crow(r, hi)]; } } while (0)
  f32x16 pA0, pA1, pB0, pB1; float mnA, mnB, alA, alB; bf16x8 pa0, pa1, pa2, pa3;
  SLOAD(0); SWAIT(); SWRITE(0); __syncthreads();
  qkt(pA0, pA1, K_lds, qr, qrope, kbase, true); partialSM(pA0, pA1, m_reg, mnA, alA);
  SLOAD(KVBLK);
  SWAIT(); SWRITE(1); __syncthreads();
  for (int j = 1; j + 1 < NT; j += 2) {
    SBAR(); qkt(pB0, pB1, K_lds + SHM_K, qr, qrope, kbase, j <= jmax);
    finishSM(pA0, pA1, alA, l_reg, pa0, pa1, pa2, pa3); SBAR();
    SLOAD((j + 1) * KVBLK); SBAR();
    if (j - 1 <= jmax) pv_d0(o, vb0, pa0, pa1, pa2, pa3);
    partialSM(pB0, pB1, m_reg, mnB, alB);
    __syncthreads(); SWAIT(); SWRITE(0);
    RESC(alB); __syncthreads();
    SBAR(); qkt(pA0, pA1, K_lds, qr, qrope, kbase, j + 1 <= jmax);
    finishSM(pB0, pB1, alB, l_reg, pa0, pa1, pa2, pa3); SBAR();
    SLOAD((j + 2) * KVBLK); SBAR();
    if (j <= jmax) pv_d0(o, vb0 + (int)SHM_V, pa0, pa1, pa2, pa3);
    partialSM(pA0, pA1, m_reg, mnA, alA);
    __syncthreads(); SWAIT(); SWRITE(1);
    RESC(alA); __syncthreads();
  }
  SBAR(); qkt(pB0, pB1, K_lds + SHM_K, qr, qrope, kbase, NT - 1 <= jmax);
  finishSM(pA0, pA1, alA, l_reg, pa0, pa1, pa2, pa3); SBAR();
  if (NT - 2 <= jmax) pv_d0(o, vb0, pa0, pa1, pa2, pa3);
  partialSM(pB0, pB1, m_reg, mnB, alB);
  __syncthreads(); RESC(alB);
  finishSM(pB0, pB1, alB, l_reg, pa0, pa1, pa2, pa3); SBAR();
  if (NT - 1 <= jmax) pv_d0(o, vb0 + (int)SHM_V, pa0, pa1, pa2, pa3);
  if (hi == 0) li_l[r32] = l_reg; asm volatile("s_waitcnt lgkmcnt(0)" ::: "memory");
  float rli[16];
#pragma unroll
  for (int r = 0; r < 16; ++r) rli[r] = __builtin_amdgcn_rcpf(li_l[crow(r, hi)]);
  bf16_t* Ow = Ob + (long)(wid * QBLK) * LDO;
#pragma unroll
  for (int r = 0; r < 16; ++r) { int orow = crow(r, hi);
#pragma unroll
    for (int d0 = 0; d0 < 4; ++d0) Ow[(long)orow * LDO + d0 * 32 + r32] = f2bf(o[d0][r] * rli[r]); }
  __syncthreads();
#undef SLOAD
#undef SWRITE
#undef SWAIT
#undef RESC
}
}
namespace ret {
constexpr int QP_ = 136;
__device__ __forceinline__ bf16x8 ldfrag(const bf16_t* p) { return *reinterpret_cast<const bf16x8*>(p); }
template <int CL> struct Lay {
    static constexpr int IP = CL + 8;
    static constexpr int QS = 0, KS = QS + CL * QP_ * 2, VT = KS + CL * QP_ * 2, VDT = VT + 32 * IP * 2, IN = VDT + 32 * IP * 2, ST = IN + CL * IP * 2, VS = ST + 32 * QP_ * 2, END = VS + CL * 40 * 2;
};
static_assert(Lay<128>::END <= LDS_BARW, "retention LDS");

template <int CL>
__device__ __forceinline__ void run(const bf16_t* __restrict__ Y, bf16_t* __restrict__ OB, const float* __restrict__ sp, float* __restrict__ so, long tok0, int nch, int h, int es, float lg, char* lds, int tid) {
    using L = Lay<CL>; constexpr int IP = L::IP, NQT = CL / 16, NKS = CL / 32, NPC = CL / 32;
    const int wid = __builtin_amdgcn_readfirstlane(tid >> 6), lane = tid & 63, l15 = lane & 15, l4 = lane >> 4;
    bf16_t* Qs = (bf16_t*)(lds + L::QS); bf16_t* Ks = (bf16_t*)(lds + L::KS); bf16_t* Vt = (bf16_t*)(lds + L::VT); bf16_t* Vdt = (bf16_t*)(lds + L::VDT); bf16_t* In = (bf16_t*)(lds + L::IN); bf16_t* St = (bf16_t*)(lds + L::ST); bf16_t* Vs = (bf16_t*)(lds + L::VS);
    const float gCL = __expf((float)CL * lg);
    f32x4 Sacc[2];
    if (sp) {
#pragma unroll
        for (int ej = 0; ej < 2; ++ej)
#pragma unroll
            for (int r = 0; r < 4; ++r) Sacc[ej][r] = sp[(long)(16 * wid + 4 * l4 + r) * RV + 16 * ej + l15];
    } else { Sacc[0] = (f32x4){0.f, 0.f, 0.f, 0.f}; Sacc[1] = (f32x4){0.f, 0.f, 0.f, 0.f}; }
    for (int i = tid; i < CL * IP / 8; i += 512) reinterpret_cast<u32x4*>(In)[i] = (u32x4){0u, 0u, 0u, 0u};
    u32x4 pq[NPC], pk[NPC], pv;
    const int vk = tid >> 2, ve0 = (tid & 3) * 8;
#define RET_LOAD(cc) do { const bf16_t* yrow_ = Y + (tok0 + (long)(cc) * CL) * INWP; \
        _Pragma("unroll") for (int i = 0; i < NPC; ++i) { const int idx = tid + i * 512, k = idx >> 4, d0 = (idx & 15) * 8; \
            pq[i] = *reinterpret_cast<const u32x4*>(yrow_ + (long)k * INWP + C_RQ + h * 128 + d0); pk[i] = *reinterpret_cast<const u32x4*>(yrow_ + (long)k * INWP + C_RK + h * 128 + d0); } \
        if (tid < 4 * CL) pv = *reinterpret_cast<const u32x4*>(yrow_ + (long)vk * INWP + C_RV + h * 256 + es * 32 + ve0); } while (0)
    RET_LOAD(0);
    for (int c = 0; c < nch; ++c) {
#pragma unroll
        for (int ej = 0; ej < 2; ++ej) { u32x2 w; w.x = cvt_pk_bf16(Sacc[ej][0], Sacc[ej][1]); w.y = cvt_pk_bf16(Sacc[ej][2], Sacc[ej][3]);
            *reinterpret_cast<u32x2*>(St + (16 * ej + l15) * QP_ + 16 * wid + 4 * l4) = w; }
#pragma unroll
        for (int i = 0; i < NPC; ++i) { const int idx = tid + i * 512, k = idx >> 4, d0 = (idx & 15) * 8;
            *reinterpret_cast<u32x4*>(Qs + k * QP_ + d0) = pq[i]; *reinterpret_cast<u32x4*>(Ks + k * QP_ + d0) = pk[i]; }
        if (tid < 4 * CL) *reinterpret_cast<u32x4*>(Vs + vk * 40 + ve0) = pv;
        if (c + 1 < nch) RET_LOAD(c + 1);
        __syncthreads();
        if (tid < 4 * CL) { const int e = tid & 31, kg = tid >> 5; float f[8], fd[8];
#pragma unroll
            for (int j = 0; j < 8; ++j) { f[j] = bf2f(Vs[(8 * kg + j) * 40 + e]); fd[j] = f[j] * __expf((float)(CL - 1 - 8 * kg - j) * lg); }
            *reinterpret_cast<u32x4*>(Vt + e * IP + 8 * kg) = pack8(f); *reinterpret_cast<u32x4*>(Vdt + e * IP + 8 * kg) = pack8(fd); }
#pragma unroll
        for (int it_ = 0; it_ < (NQT * (NQT + 1) / 2 + 7) / 8; ++it_) { const int idx = wid + 8 * it_; if (idx >= NQT * (NQT + 1) / 2) break;
            int qi = 0; while ((qi + 1) * (qi + 2) / 2 <= idx) ++qi; const int kj = idx - qi * (qi + 1) / 2;
            f32x4 a = (f32x4){0.f, 0.f, 0.f, 0.f}; const bf16_t* qp = Qs + (16 * qi + l15) * QP_ + 8 * l4; const bf16_t* kp = Ks + (16 * kj + l15) * QP_ + 8 * l4;
#pragma unroll
            for (int ks = 0; ks < 4; ++ks) a = __builtin_amdgcn_mfma_f32_16x16x32_bf16(ldfrag(qp + 32 * ks), ldfrag(kp + 32 * ks), a, 0, 0, 0);
            const int q0 = 16 * qi + 4 * l4, k = 16 * kj + l15;
#pragma unroll
            for (int r = 0; r < 4; ++r) { const int q = q0 + r; const float dm = (q >= k) ? __expf((float)(q - k) * lg) : 0.f;
                In[q * IP + k] = f2bf(a[r] * dm); } }
        __syncthreads();
#pragma unroll
        for (int ot = 0; ot < (2 * NQT) / 8; ++ot) { const int tI = wid + 8 * ot, qi = tI >> 1, ej = tI & 1; f32x4 a = (f32x4){0.f, 0.f, 0.f, 0.f};
#pragma unroll
            for (int ks = 0; ks < 4; ++ks) a = __builtin_amdgcn_mfma_f32_16x16x32_bf16(ldfrag(Qs + (16 * qi + l15) * QP_ + 32 * ks + 8 * l4), ldfrag(St + (16 * ej + l15) * QP_ + 32 * ks + 8 * l4), a, 0, 0, 0);
#pragma unroll
            for (int r = 0; r < 4; ++r) a[r] *= __expf((float)(16 * qi + 4 * l4 + r + 1) * lg);
#pragma unroll
            for (int ks = 0; ks < NKS; ++ks) if (ks <= (qi >> 1)) a = __builtin_amdgcn_mfma_f32_16x16x32_bf16(ldfrag(In + (16 * qi + l15) * IP + 32 * ks + 8 * l4), ldfrag(Vt + (16 * ej + l15) * IP + 32 * ks + 8 * l4), a, 0, 0, 0);
            bf16_t* op = OB + ((long)(h * 8 + es) * T + tok0 + (long)c * CL + 16 * qi + 4 * l4) * 32 + 16 * ej + l15;
#pragma unroll
            for (int r = 0; r < 4; ++r) op[r * 32] = f2bf(a[r]); }
        { f32x4 s0 = Sacc[0] * gCL, s1 = Sacc[1] * gCL;
#pragma unroll
          for (int ks = 0; ks < NKS; ++ks) { bf16x8 af;
#pragma unroll
              for (int j = 0; j < 8; ++j) af[j] = (short)Ks[(32 * ks + 8 * l4 + j) * QP_ + 16 * wid + l15];
              s0 = __builtin_amdgcn_mfma_f32_16x16x32_bf16(af, ldfrag(Vdt + l15 * IP + 32 * ks + 8 * l4), s0, 0, 0, 0);
              s1 = __builtin_amdgcn_mfma_f32_16x16x32_bf16(af, ldfrag(Vdt + (16 + l15) * IP + 32 * ks + 8 * l4), s1, 0, 0, 0); }
          Sacc[0] = s0; Sacc[1] = s1; }
        __syncthreads();
    }
#undef RET_LOAD
#pragma unroll
    for (int ej = 0; ej < 2; ++ej)
#pragma unroll
        for (int r = 0; r < 4; ++r) so[(long)(16 * wid + 4 * l4 + r) * RV + 16 * ej + l15] = Sacc[ej][r];
}

__device__ __forceinline__ void unit(KParams& p, int l, int u, char* lds) {
    const int tid = otid(); unsigned char* ws = optr(gp(p.ws)); const bf16_t* Y = (const bf16_t*)(ws + WS_Y); bf16_t* OB = (bf16_t*)(ws + WS_OB);
    const bool samp = u >= 256; const int v = samp ? u - 256 : u; const int b = v >> 6, h = (v >> 3) & 7, es = v & 7; const float lg = p.lg[h];
    if (samp) run<64>(Y, OB, gp(p.state_ret) + ((((long)l * DB + b) * RH + h) * RQK) * RV + es * 32, gp(p.out) + O_RETS + ((((long)l * DB + b) * RH + h) * RQK) * RV + es * 32, (long)TP + b * 64, 1, h, es, lg, lds, tid);
    else run<64>(Y, OB, nullptr, gp(p.out) + O_RETP + ((((long)l * NB + b) * RH + h) * RQK) * RV + es * 32, (long)b * SEQ, SEQ / 64, h, es, lg, lds, tid);
}
}
namespace peer {
__device__ __forceinline__ void ins16(float (&l)[16], float x) {
#pragma unroll
    for (int j = 0; j < 16; ++j) { const float hi = fmaxf(l[j], x); x = fminf(l[j], x); l[j] = hi; }
}
#define CE_DESC(a, b) do { const float hi_ = fmaxf(a, b), lo_ = fminf(a, b); a = hi_; b = lo_; } while (0)
#define CE_ASC(a, b) do { const float hi_ = fmaxf(a, b), lo_ = fminf(a, b); a = lo_; b = hi_; } while (0)
__device__ __forceinline__ void sort16_desc(float (&v)[16]) {
#pragma unroll
    for (int k = 2; k <= 16; k <<= 1)
#pragma unroll
        for (int j = k >> 1; j >= 1; j >>= 1)
#pragma unroll
            for (int i = 0; i < 16; ++i) { const int l = i ^ j; if (l > i) { if ((i & k) == 0) CE_DESC(v[i], v[l]); else CE_ASC(v[i], v[l]); } }
}
__device__ __forceinline__ void merge16_desc(float (&l)[16], const float (&o)[16]) {
#pragma unroll
    for (int i = 0; i < 16; ++i) l[i] = fmaxf(l[i], o[15 - i]);
#pragma unroll
    for (int j = 8; j >= 1; j >>= 1)
#pragma unroll
        for (int i = 0; i < 16; ++i) { const int m = i ^ j; if (m > i) CE_DESC(l[i], l[m]); }
}
constexpr int KPITCH = 136;
__device__ __forceinline__ void half_top16(const bf16_t* __restrict__ qrow, const bf16_t* __restrict__ keys, int lane, float (&l)[16]) {
    const int r32 = lane & 31, g = lane >> 5;
#pragma unroll
    for (int j = 0; j < 16; ++j) l[j] = -3.0e38f;
    bf16x8 qf[8];
#pragma unroll
    for (int ks = 0; ks < 8; ++ks) qf[ks] = *reinterpret_cast<const bf16x8*>(qrow + 16 * ks + 8 * g);
#pragma unroll 1
    for (int kb = 0; kb < 4; ++kb) { f32x16 a = f32x16{};
#pragma unroll
        for (int ks = 0; ks < 8; ++ks) { const bf16x8 kf = *reinterpret_cast<const bf16x8*>(keys + (32 * kb + r32) * KPITCH + 16 * ks + 8 * g);
            a = __builtin_amdgcn_mfma_f32_32x32x16_bf16(kf, qf[ks], a, 0, 0, 0); }
        float blk[16];
#pragma unroll
        for (int r = 0; r < 16; ++r) { const unsigned key = (unsigned)(32 * kb + (r & 3) + 8 * (r >> 2) + 4 * g);
            blk[r] = __uint_as_float((__float_as_uint(a[r]) & ~0x7Fu) | key); }
        sort16_desc(blk); merge16_desc(l, blk); }
}
__device__ __forceinline__ void merge_lists(float (&l)[16], const float (&o)[16]) { merge16_desc(l, o); }
__device__ __forceinline__ void select_unit(const bf16_t* __restrict__ QP, const bf16_t* __restrict__ k1, const bf16_t* __restrict__ k2, int* __restrict__ PIDX, float* __restrict__ PW,
                                            int t0, int h, int lane, float* lds_lane  ) {
    const int r32 = lane & 31, g = lane >> 5;
    const bf16_t* qrow = QP + (long)(t0 + r32) * DM + h * 256;
    float la[16], lb[16];
    half_top16(qrow, k1, lane, la);
    half_top16(qrow + 128, k2, lane, lb);
    float m0[16], m1[16];
#pragma unroll
    for (int j = 0; j < 16; ++j) { auto rr = __builtin_amdgcn_permlane32_swap(__float_as_uint(la[j]), __float_as_uint(lb[j]), false, false); m0[j] = __uint_as_float(rr[0]); m1[j] = __uint_as_float(rr[1]); }
    merge_lists(m0, m1);
    float L1[16], L2[16];
#pragma unroll
    for (int j = 0; j < 16; ++j) { auto rr = __builtin_amdgcn_permlane32_swap(__float_as_uint(m0[j]), __float_as_uint(m0[j]), false, false);
        L1[j] = __uint_as_float(rr[0]); L2[j] = __uint_as_float(rr[1]); }
#define CAND(i, j) __uint_as_float((__float_as_uint(L1[i] + L2[j]) & ~0xFFu) | (unsigned)((i) * 16 + (j)))
    float best[16], c2[16], c3[16];
#pragma unroll
    for (int j = 0; j < 16; ++j) best[j] = CAND(0, j);
    sort16_desc(best);
    c2[0] = CAND(1, 0); c2[1] = CAND(1, 1); c2[2] = CAND(1, 2); c2[3] = CAND(1, 3); c2[4] = CAND(1, 4); c2[5] = CAND(1, 5); c2[6] = CAND(1, 6); c2[7] = CAND(1, 7);
    c2[8] = CAND(2, 0); c2[9] = CAND(2, 1); c2[10] = CAND(2, 2); c2[11] = CAND(2, 3); c2[12] = CAND(2, 4); c2[13] = CAND(4, 0); c2[14] = CAND(4, 1); c2[15] = CAND(4, 2);
    sort16_desc(c2); merge16_desc(best, c2);
    c3[0] = CAND(3, 0); c3[1] = CAND(3, 1); c3[2] = CAND(3, 2); c3[3] = CAND(3, 3); c3[4] = CAND(5, 0); c3[5] = CAND(5, 1); c3[6] = CAND(6, 0); c3[7] = CAND(6, 1);
    c3[8] = CAND(7, 0); c3[9] = CAND(7, 1); c3[10] = CAND(8, 0); c3[11] = CAND(9, 0); c3[12] = CAND(10, 0); c3[13] = CAND(11, 0); c3[14] = CAND(12, 0); c3[15] = CAND(13, 0);
    sort16_desc(c3); merge16_desc(best, c3);
    ins16(best, CAND(14, 0)); ins16(best, CAND(15, 0));
#undef CAND
#pragma unroll
    for (int j = 0; j < 16; ++j) { lds_lane[j] = __uint_as_float(__float_as_uint(L1[j]) & 0x7Fu); lds_lane[16 + j] = __uint_as_float(__float_as_uint(L2[j]) & 0x7Fu); }
    asm volatile("s_waitcnt lgkmcnt(0)" ::: "memory");
    float wsum = 0.f, w[16]; int ei[16];
    const float mx = best[0];
#pragma unroll
    for (int k = 0; k < 16; ++k) { const unsigned code = __float_as_uint(best[k]) & 0xFFu; const int i = (int)(code >> 4), j = (int)(code & 15u);
        const int i1 = (int)__float_as_uint(lds_lane[i]), i2 = (int)__float_as_uint(lds_lane[16 + j]); ei[k] = i1 * NKEYS + i2;
        w[k] = __expf(best[k] - mx); wsum += w[k]; }
    const float inv = 1.0f / wsum;
    if (g == 0) { int* ip = PIDX + (long)(t0 + r32) * 128 + h * 16; float* wp = PW + (long)(t0 + r32) * 128 + h * 16;
#pragma unroll
        for (int k = 0; k < 16; k += 4) { *reinterpret_cast<int4*>(ip + k) = make_int4(ei[k], ei[k + 1], ei[k + 2], ei[k + 3]);
            *reinterpret_cast<float4*>(wp + k) = make_float4(w[k] * inv, w[k + 1] * inv, w[k + 2] * inv, w[k + 3] * inv); } }
}

__device__ __forceinline__ float gelu_exact(float x) { return 0.5f * x * (1.0f + erff(x * 0.70710678118654752f)); }

__device__ __forceinline__ void dec16(const u32x4 w, f32x2 (&f)[8]) {
    f[0] = __builtin_amdgcn_cvt_pk_f32_fp8((int)w.x, false); f[1] = __builtin_amdgcn_cvt_pk_f32_fp8((int)w.x, true);
    f[2] = __builtin_amdgcn_cvt_pk_f32_fp8((int)w.y, false); f[3] = __builtin_amdgcn_cvt_pk_f32_fp8((int)w.y, true);
    f[4] = __builtin_amdgcn_cvt_pk_f32_fp8((int)w.z, false); f[5] = __builtin_amdgcn_cvt_pk_f32_fp8((int)w.z, true);
    f[6] = __builtin_amdgcn_cvt_pk_f32_fp8((int)w.w, false); f[7] = __builtin_amdgcn_cvt_pk_f32_fp8((int)w.w, true);
}
__device__ __forceinline__ void gather_token(const bf16_t* __restrict__ H, const unsigned char* __restrict__ PU, const unsigned char* __restrict__ PV, const float* __restrict__ SU, const float* __restrict__ SV,
                                             const int* __restrict__ PIDX, const float* __restrict__ PW, float* __restrict__ X, const float* __restrict__ gate  , int t, int lane) {
    f32x2 xf[2][8];
#pragma unroll
    for (int hlf = 0; hlf < 2; ++hlf)
#pragma unroll
        for (int q = 0; q < 2; ++q) { const u32x4 w = *reinterpret_cast<const u32x4*>(H + (long)t * DM + 1024 * hlf + 16 * lane + 8 * q);
            xf[hlf][4 * q + 0] = (f32x2){bflo(w.x), bfhi(w.x)}; xf[hlf][4 * q + 1] = (f32x2){bflo(w.y), bfhi(w.y)}; xf[hlf][4 * q + 2] = (f32x2){bflo(w.z), bfhi(w.z)}; xf[hlf][4 * q + 3] = (f32x2){bflo(w.w), bfhi(w.w)}; }
    f32x2 out[2][8];
#pragma unroll
    for (int hlf = 0; hlf < 2; ++hlf)
#pragma unroll
        for (int i = 0; i < 8; ++i) out[hlf][i] = (f32x2){0.f, 0.f};
    const int myidx0 = PIDX[(long)t * 128 + lane], myidx1 = PIDX[(long)t * 128 + 64 + lane];
    const float myw0 = PW[(long)t * 128 + lane], myw1 = PW[(long)t * 128 + 64 + lane];
    const float msu0 = SU[myidx0], msu1 = SU[myidx1], msv0 = SV[myidx0], msv1 = SV[myidx1];
    for (int hk = 0; hk < 128; hk += 4) {
        const int src = hk & 63; const bool lo = hk < 64;
        const int selidx = lo ? myidx0 : myidx1; const int selw = __float_as_int(lo ? myw0 : myw1), selsu = __float_as_int(lo ? msu0 : msu1), selsv = __float_as_int(lo ? msv0 : msv1);
        int e[4]; float g[4], su[4], sv[4];
#pragma unroll
        for (int k = 0; k < 4; ++k) { e[k] = __builtin_amdgcn_readlane(selidx, src + k); g[k] = __int_as_float(__builtin_amdgcn_readlane(selw, src + k));
            su[k] = __int_as_float(__builtin_amdgcn_readlane(selsu, src + k)); sv[k] = __int_as_float(__builtin_amdgcn_readlane(selsv, src + k)); }
        u32x4 uw[4][2], vw[4][2];
#pragma unroll
        for (int k = 0; k < 4; ++k) { uw[k][0] = *reinterpret_cast<const u32x4*>(PU + ((long)(lane >> 3) * NEXP + e[k]) * 128 + 16 * (lane & 7)); uw[k][1] = *reinterpret_cast<const u32x4*>(PU + ((long)(8 + (lane >> 3)) * NEXP + e[k]) * 128 + 16 * (lane & 7)); }
#pragma unroll
        for (int k = 0; k < 4; ++k) { { const u32x2 a0 = *reinterpret_cast<const u32x2*>(PV + ((long)(2 * lane) * NEXP + e[k]) * 8), a1 = *reinterpret_cast<const u32x2*>(PV + ((long)(2 * lane + 1) * NEXP + e[k]) * 8);
              const u32x2 b0 = *reinterpret_cast<const u32x2*>(PV + ((long)(128 + 2 * lane) * NEXP + e[k]) * 8), b1 = *reinterpret_cast<const u32x2*>(PV + ((long)(129 + 2 * lane) * NEXP + e[k]) * 8);
              vw[k][0] = (u32x4){a0.x, a0.y, a1.x, a1.y}; vw[k][1] = (u32x4){b0.x, b0.y, b1.x, b1.y}; } }
        float a[4];
#pragma unroll
        for (int k = 0; k < 4; ++k) { f32x2 d = (f32x2){0.f, 0.f};
#pragma unroll
            for (int hlf = 0; hlf < 2; ++hlf) { f32x2 f[8]; dec16(uw[k][hlf], f);
#pragma unroll
                for (int i = 0; i < 8; ++i) d = __builtin_elementwise_fma(f[i], xf[hlf][i], d); }
            a[k] = wave_sum(d[0] + d[1]); }
#pragma unroll
        for (int k = 0; k < 4; ++k) { const float ak = g[k] * gelu_exact(a[k] * su[k]) * sv[k]; const f32x2 a2 = (f32x2){ak, ak};
#pragma unroll
            for (int hlf = 0; hlf < 2; ++hlf) { f32x2 f[8]; dec16(vw[k][hlf], f);
#pragma unroll
                for (int i = 0; i < 8; ++i) out[hlf][i] = __builtin_elementwise_fma(f[i], a2, out[hlf][i]); } }
    }
    const float* gr = gate + (long)cond_row(t) * 12288;
#pragma unroll
    for (int hlf = 0; hlf < 2; ++hlf)
#pragma unroll
        for (int q = 0; q < 4; ++q) { const int c = 1024 * hlf + 16 * lane + 4 * q; float* xp = X + (long)t * DM + c;
            const f32x4 gv = *reinterpret_cast<const f32x4*>(gr + c); f32x4 xv = *reinterpret_cast<const f32x4*>(xp);
            xv[0] += gv[0] * out[hlf][2 * q][0]; xv[1] += gv[1] * out[hlf][2 * q][1]; xv[2] += gv[2] * out[hlf][2 * q + 1][0]; xv[3] += gv[3] * out[hlf][2 * q + 1][1];
            *reinterpret_cast<f32x4*>(xp) = xv; }
}

constexpr int SW = 128, NSL = DM / SW;
struct XInfo { int rank, xi, nx, nloc; };
__device__ __forceinline__ void upass(const bf16_t* __restrict__ H, const unsigned char* __restrict__ PU, const int* __restrict__ PIDX, const float* __restrict__ PW, const float* __restrict__ SU, const float* __restrict__ SV,
                                      float* __restrict__ DOTP, unsigned* __restrict__ PACKT, const XInfo xin, int wid, int lane) {
    const int g = lane >> 3, c = lane & 7; const int nwv = xin.nloc * 8;
    const int tlo = (int)((long)T * xin.xi / xin.nx), thi = (int)((long)T * (xin.xi + 1) / xin.nx); const int wv = tlo + xin.rank * 8 + wid;
    float* dp = DOTP;
    for (int s = 0; s < NSL; ++s) { const bool first = (s == 0), lastS = (s == NSL - 1);
        const __amdgpu_buffer_rsrc_t urs = __builtin_amdgcn_make_buffer_rsrc((void*)(PU + (long)s * NEXP * SW), 0, NEXP * SW, 0x00020000);
#define UP_ROW(e_) __builtin_bit_cast(u32x4, __builtin_amdgcn_raw_buffer_load_b128(urs, (e_) * SW + 16 * c, 0, 0))
#define UP_IDX(tt, q4) (*reinterpret_cast<const int4*>(PIDX + (long)(tt) * 128 + 16 * g + 4 * (q4)))
#define UP_X(tt, q2) (*reinterpret_cast<const u32x4*>(H + (long)(tt) * DM + SW * s + 16 * c + 8 * (q2)))
        if (wv >= thi) continue;
        u32x4 A[8], B[8]; int4 en[4]; u32x4 xn[2];
        { int4 e0[4];
#pragma unroll
          for (int q4 = 0; q4 < 4; ++q4) e0[q4] = UP_IDX(wv, q4);
          A[0] = UP_ROW(e0[0].x); A[1] = UP_ROW(e0[0].y); A[2] = UP_ROW(e0[0].z); A[3] = UP_ROW(e0[0].w); A[4] = UP_ROW(e0[1].x); A[5] = UP_ROW(e0[1].y); A[6] = UP_ROW(e0[1].z); A[7] = UP_ROW(e0[1].w);
          B[0] = UP_ROW(e0[2].x); B[1] = UP_ROW(e0[2].y); B[2] = UP_ROW(e0[2].z); B[3] = UP_ROW(e0[2].w); B[4] = UP_ROW(e0[3].x); B[5] = UP_ROW(e0[3].y); B[6] = UP_ROW(e0[3].z); B[7] = UP_ROW(e0[3].w);
          const int t1 = (wv + nwv < thi) ? wv + nwv : wv;
#pragma unroll
          for (int q4 = 0; q4 < 4; ++q4) en[q4] = UP_IDX(t1, q4);
          xn[0] = UP_X(wv, 0); xn[1] = UP_X(wv, 1); }
        f32x2 dnx = (f32x2){0.f, 0.f};
        if (!first) dnx = *reinterpret_cast<const f32x2*>(dp + (long)wv * 128 + 16 * g + 2 * c);
#pragma unroll 1
        for (int t = wv; t < thi; t += nwv) {
            const int tn = (t + nwv < thi) ? t + nwv : t, tnn = (tn + nwv < thi) ? tn + nwv : tn;
            const f32x2 dcur = dnx;
            if (!first) dnx = *reinterpret_cast<const f32x2*>(dp + (long)tn * 128 + 16 * g + 2 * c);
            f32x2 xf[8];
#pragma unroll
            for (int q2 = 0; q2 < 2; ++q2) { const u32x4 hw = xn[q2];
                xf[4 * q2 + 0] = (f32x2){bflo(hw.x), bfhi(hw.x)}; xf[4 * q2 + 1] = (f32x2){bflo(hw.y), bfhi(hw.y)}; xf[4 * q2 + 2] = (f32x2){bflo(hw.z), bfhi(hw.z)}; xf[4 * q2 + 3] = (f32x2){bflo(hw.w), bfhi(hw.w)}; }
            xn[0] = UP_X(tn, 0); xn[1] = UP_X(tn, 1);
            float d[16];
#pragma unroll
            for (int i = 0; i < 8; ++i) { f32x2 f[8]; dec16(A[i], f); f32x2 a = (f32x2){0.f, 0.f};
#pragma unroll
                for (int k = 0; k < 8; ++k) a = __builtin_elementwise_fma(f[k], xf[k], a);
                d[i] = a[0] + a[1]; }
            A[0] = UP_ROW(en[0].x); A[1] = UP_ROW(en[0].y); A[2] = UP_ROW(en[0].z); A[3] = UP_ROW(en[0].w); A[4] = UP_ROW(en[1].x); A[5] = UP_ROW(en[1].y); A[6] = UP_ROW(en[1].z); A[7] = UP_ROW(en[1].w);
#pragma unroll
            for (int i = 0; i < 8; ++i) { f32x2 f[8]; dec16(B[i], f); f32x2 a = (f32x2){0.f, 0.f};
#pragma unroll
                for (int k = 0; k < 8; ++k) a = __builtin_elementwise_fma(f[k], xf[k], a);
                d[8 + i] = a[0] + a[1]; }
            B[0] = UP_ROW(en[2].x); B[1] = UP_ROW(en[2].y); B[2] = UP_ROW(en[2].z); B[3] = UP_ROW(en[2].w); B[4] = UP_ROW(en[3].x); B[5] = UP_ROW(en[3].y); B[6] = UP_ROW(en[3].z); B[7] = UP_ROW(en[3].w);
#pragma unroll
            for (int q4 = 0; q4 < 4; ++q4) en[q4] = UP_IDX(tnn, q4);
            float r8[8], r4[4], r2[2];
#pragma unroll
            for (int k = 0; k < 8; ++k) { const float keep = (c & 4) ? d[k + 8] : d[k], send = (c & 4) ? d[k] : d[k + 8]; r8[k] = keep + sx<4>(send); }
#pragma unroll
            for (int k = 0; k < 4; ++k) { const float keep = (c & 2) ? r8[k + 4] : r8[k], send = (c & 2) ? r8[k] : r8[k + 4]; r4[k] = keep + sx<2>(send); }
#pragma unroll
            for (int k = 0; k < 2; ++k) { const float keep = (c & 1) ? r4[k + 2] : r4[k], send = (c & 1) ? r4[k] : r4[k + 2]; r2[k] = keep + sx<1>(send); }
            float* o = dp + (long)t * 128 + 16 * g + 2 * c;
            f32x2 acc = (f32x2){r2[0], r2[1]};
            acc += dcur;
            if (!lastS) *reinterpret_cast<f32x2*>(o) = acc;
            else {
                const int p0 = 16 * g + 2 * c; const int2 ee = *reinterpret_cast<const int2*>(PIDX + (long)t * 128 + p0); const f32x2 gw = *reinterpret_cast<const f32x2*>(PW + (long)t * 128 + p0);
                const float a0 = gw[0] * gelu_exact(acc[0] * SU[ee.x]) * SV[ee.x], a1 = gw[1] * gelu_exact(acc[1] * SU[ee.y]) * SV[ee.y];
                u32x2 pk; pk.x = (cvt_pk_bf16(0.f, a0) & 0xffff0000u) | (unsigned)ee.x; pk.y = (cvt_pk_bf16(0.f, a1) & 0xffff0000u) | (unsigned)ee.y;
                *reinterpret_cast<u32x2*>(PACKT + ((long)(p0 >> 2) * T + t) * 4 + (p0 & 3)) = pk; }
        }
#undef UP_ROW
#undef UP_IDX
#undef UP_X
    }
}
__device__ __forceinline__ void actpass(const float* __restrict__ DOTP, const int* __restrict__ PIDX, const float* __restrict__ PW, const float* __restrict__ SU, const float* __restrict__ SV, float* __restrict__ ACT, int nx, long gt, long nt) {
    for (long i = gt; i < (long)T * 128; i += nt) { float dsum = 0.f;
        for (int x = 0; x < nx; ++x) dsum += DOTP[(long)x * T * 128 + i];
        const int e = PIDX[i]; const float av = PW[i] * gelu_exact(dsum * SU[e]) * SV[e]; const long t = i >> 7; const int pp = (int)(i & 127);
        reinterpret_cast<unsigned*>(ACT)[((long)(pp >> 2) * T + t) * 4 + (pp & 3)] = (cvt_pk_bf16(0.f, av) & 0xffff0000u) | (unsigned)e; }
}
__device__ __forceinline__ void vpass(const unsigned char* __restrict__ PV, const int* __restrict__ PIDX, const float* __restrict__ ACT, float* __restrict__ X, const float* __restrict__ gate, const XInfo xin, int wid, int lane) {
    const int g = lane >> 3, c = lane & 7; const int wv = xin.rank * 8 + wid, nwv = xin.nloc * 8;
    for (int s = xin.xi; s < NSL; s += xin.nx) {
        int4 en[4]; f32x4 an[4];
#pragma unroll
        for (int q4 = 0; q4 < 4; ++q4) { en[q4] = *reinterpret_cast<const int4*>(PIDX + (long)(wv < T ? wv : 0) * 128 + 16 * g + 4 * q4); an[q4] = *reinterpret_cast<const f32x4*>(ACT + (long)(wv < T ? wv : 0) * 128 + 16 * g + 4 * q4); }
        for (int t = wv; t < T; t += nwv) {
            int e[16]; float a[16];
#pragma unroll
            for (int q4 = 0; q4 < 4; ++q4) { e[4 * q4] = en[q4].x; e[4 * q4 + 1] = en[q4].y; e[4 * q4 + 2] = en[q4].z; e[4 * q4 + 3] = en[q4].w; a[4 * q4] = an[q4][0]; a[4 * q4 + 1] = an[q4][1]; a[4 * q4 + 2] = an[q4][2]; a[4 * q4 + 3] = an[q4][3]; }
            u32x4 w[16];
#pragma unroll
            for (int i = 0; i < 16; ++i) w[i] = *reinterpret_cast<const u32x4*>(PV + ((long)s * NEXP + e[i]) * SW + 16 * c);
            { const int tn = (t + nwv < T) ? t + nwv : t;
#pragma unroll
              for (int q4 = 0; q4 < 4; ++q4) { en[q4] = *reinterpret_cast<const int4*>(PIDX + (long)tn * 128 + 16 * g + 4 * q4); an[q4] = *reinterpret_cast<const f32x4*>(ACT + (long)tn * 128 + 16 * g + 4 * q4); } }
            f32x2 o[8];
#pragma unroll
            for (int k = 0; k < 8; ++k) o[k] = (f32x2){0.f, 0.f};
#pragma unroll
            for (int i = 0; i < 16; ++i) { f32x2 f[8]; dec16(w[i], f); const f32x2 a2 = (f32x2){a[i], a[i]};
#pragma unroll
                for (int k = 0; k < 8; ++k) o[k] = __builtin_elementwise_fma(f[k], a2, o[k]); }
            f32x2 r4[4], r2[2], r1;
#pragma unroll
            for (int k = 0; k < 4; ++k) { const f32x2 keep = (g & 4) ? o[k + 4] : o[k], send = (g & 4) ? o[k] : o[k + 4]; r4[k] = keep + (f32x2){sx<32>(send[0]), sx<32>(send[1])}; }
#pragma unroll
            for (int k = 0; k < 2; ++k) { const f32x2 keep = (g & 2) ? r4[k + 2] : r4[k], send = (g & 2) ? r4[k] : r4[k + 2]; r2[k] = keep + (f32x2){sx<16>(send[0]), sx<16>(send[1])}; }
            { const f32x2 keep = (g & 1) ? r2[1] : r2[0], send = (g & 1) ? r2[0] : r2[1]; r1 = keep + (f32x2){sx<8>(send[0]), sx<8>(send[1])}; }
            const int col = SW * s + 16 * c + 2 * g;
            const f32x2 gv = *reinterpret_cast<const f32x2*>(gate + (long)cond_row(t) * 12288 + col);
            float* xp = X + (long)t * DM + col; f32x2 xv = *reinterpret_cast<const f32x2*>(xp);
            xv += gv * r1; *reinterpret_cast<f32x2*>(xp) = xv;
        }
    }
}

__device__ __forceinline__ void vpass_lds(const unsigned char* __restrict__ PV, const unsigned* __restrict__ PACKT, float* __restrict__ X, const float* __restrict__ gate, char* lds, int bid, int nb, int s_end, int tid) {
    const int wid = tid >> 6, lane = tid & 63;
    for (int s = bid; s < s_end; s += nb) {
        __syncthreads();
        { const u32x4* src = reinterpret_cast<const u32x4*>(PV + (long)s * NEXP * 8); u32x4* dst = reinterpret_cast<u32x4*>(lds);
#pragma unroll 4
          for (int i = tid; i < NEXP * 8 / 16; i += 512) dst[i] = src[i]; }
        __syncthreads();
        u32x4 h0[8], h1[8];
        const __amdgpu_buffer_rsrc_t vrs = __builtin_amdgcn_make_buffer_rsrc((void*)PACKT, 0, (int)((size_t)T * 128 * 4), 0x00020000);
#define VP_LD(k, toff) __builtin_bit_cast(u32x4, __builtin_amdgcn_raw_buffer_load_b128(vrs, (int)(toff), (int)((size_t)(k) * T * 16), 0))
        { const unsigned toff = (unsigned)(wid * 64 + lane) * 16u;
#pragma unroll
          for (int k = 0; k < 8; ++k) h0[k] = VP_LD(k, toff);
#pragma unroll
          for (int k = 0; k < 8; ++k) h1[k] = VP_LD(8 + k, toff); }
#define VP_STEP(HB) do { _Pragma("unroll") for (int kk = 0; kk < 8; kk += 2) { unsigned pw[8]; \
            _Pragma("unroll") for (int k = 0; k < 2; ++k) { pw[4 * k] = HB[kk + k].x; pw[4 * k + 1] = HB[kk + k].y; pw[4 * k + 2] = HB[kk + k].z; pw[4 * k + 3] = HB[kk + k].w; } \
            u32x2 w[8]; \
            _Pragma("unroll") for (int k = 0; k < 8; ++k) w[k] = *reinterpret_cast<const u32x2*>(lds + (pw[k] & 0xffffu) * 8u); \
            _Pragma("unroll") for (int k = 0; k < 8; ++k) { const float a = __uint_as_float(pw[k] & 0xffff0000u); \
                const f32x2 f0 = __builtin_amdgcn_cvt_pk_f32_fp8((int)w[k].x, false), f1 = __builtin_amdgcn_cvt_pk_f32_fp8((int)w[k].x, true), f2 = __builtin_amdgcn_cvt_pk_f32_fp8((int)w[k].y, false), f3 = __builtin_amdgcn_cvt_pk_f32_fp8((int)w[k].y, true); \
                acc[0] = fmaf(a, f0[0], acc[0]); acc[1] = fmaf(a, f0[1], acc[1]); acc[2] = fmaf(a, f1[0], acc[2]); acc[3] = fmaf(a, f1[1], acc[3]); \
                acc[4] = fmaf(a, f2[0], acc[4]); acc[5] = fmaf(a, f2[1], acc[5]); acc[6] = fmaf(a, f3[0], acc[6]); acc[7] = fmaf(a, f3[1], acc[7]); } } } while (0)
#pragma unroll 1
        for (int tg = wid; tg < T / 64; tg += 8) { const int t = tg * 64 + lane; const int tgn = (tg + 8 < T / 64) ? tg + 8 : tg;
            const unsigned toff = (unsigned)t * 16u, toffn = (unsigned)(tgn * 64 + lane) * 16u;
            float acc[8];
#pragma unroll
            for (int j = 0; j < 8; ++j) acc[j] = 0.f;
            VP_STEP(h0);
#pragma unroll
            for (int k = 0; k < 8; ++k) h0[k] = VP_LD(16 + k, toff);
            VP_STEP(h1);
#pragma unroll
            for (int k = 0; k < 8; ++k) h1[k] = VP_LD(24 + k, toff);
            VP_STEP(h0);
#pragma unroll
            for (int k = 0; k < 8; ++k) h0[k] = VP_LD(k, toffn);
            VP_STEP(h1);
#pragma unroll
            for (int k = 0; k < 8; ++k) h1[k] = VP_LD(8 + k, toffn);
            const float* gr = gate + (long)cond_row(t) * 12288 + 8 * s; float* xp = X + (long)t * DM + 8 * s;
            const f32x4 g0 = *reinterpret_cast<const f32x4*>(gr), g1 = *reinterpret_cast<const f32x4*>(gr + 4);
            f32x4 x0 = *reinterpret_cast<const f32x4*>(xp), x1 = *reinterpret_cast<const f32x4*>(xp + 4);
            x0[0] += g0[0] * acc[0]; x0[1] += g0[1] * acc[1]; x0[2] += g0[2] * acc[2]; x0[3] += g0[3] * acc[3];
            x1[0] += g1[0] * acc[4]; x1[1] += g1[1] * acc[5]; x1[2] += g1[2] * acc[6]; x1[3] += g1[3] * acc[7];
            *reinterpret_cast<f32x4*>(xp) = x0; *reinterpret_cast<f32x4*>(xp + 4) = x1; }
#undef VP_STEP
#undef VP_LD
    }
    __syncthreads();
}
}
namespace ph {
__device__ __forceinline__ int gwave() { return obid() * 8 + (otid() >> 6); }
__device__ __forceinline__ int nwaves() { return ogrid() * 8; }
__device__ __forceinline__ long gthread() { return (long)obid() * 512 + otid(); }
__device__ __forceinline__ long nthreads() { return (long)ogrid() * 512; }

__device__ __forceinline__ void transpose_tile(const float* __restrict__ src, int C, int r0, int c0, bf16_t* __restrict__ dst, long dpitch, float* tile) {
    const int tid = otid();
#pragma unroll
    for (int i = 0; i < 8; ++i) { const int idx = tid + 512 * i, r = idx >> 6, c = idx & 63; tile[r * 65 + c] = src[(long)(r0 + r) * C + c0 + c]; }
    __syncthreads();
    { const int c = tid >> 3, rc = (tid & 7) * 8; float f[8];
#pragma unroll
      for (int j = 0; j < 8; ++j) f[j] = tile[(rc + j) * 65 + c];
      *reinterpret_cast<u32x4*>(dst + (long)(c0 + c) * dpitch + r0 + rc) = pack8(f); }
    __syncthreads();
}

__device__ __forceinline__ void zero_chunks(bf16_t* base, long nrows, long rowpitch, int col0, int nchunk) {
    const long total = nrows * nchunk;
    for (long i = gthread(); i < total; i += nthreads()) { const long r = i / nchunk; const int ch = (int)(i % nchunk);
        *reinterpret_cast<u32x4*>(base + r * rowpitch + col0 + ch * 8) = (u32x4){0u, 0u, 0u, 0u}; }
}

__device__ __forceinline__ void prologue(KParams& p, char* lds) {
    unsigned char* ws = optr(gp(p.ws)); const int tid = otid();
    float* tile = (float*)lds;
    { struct TJob { const float* src; bf16_t* dst; int R, C, r0, c0, perm; };
      auto decode = [&](int it) { TJob j; j.perm = 0; const int l = it / 10656; int r = it % 10656;
        if (r < 5664) { j.src = gp(p.w_in) + (long)l * DM * INW; j.R = DM; j.C = INW; j.dst = (bf16_t*)(ws + WS_WIN) + (long)l * INWP * DM; }
        else if (r < 6048) { r -= 5664; j.src = gp(p.w_uq) + (long)l * 512 * 3072; j.R = 512; j.C = 3072; j.dst = (bf16_t*)(ws + WS_WUQ) + (long)l * 3072 * 512; j.perm = 1; }
        else if (r < 6560) { r -= 6048; j.src = gp(p.w_ukv) + (long)l * 512 * 4096; j.R = 512; j.C = 4096; j.dst = (bf16_t*)(ws + WS_WUKV) + (long)l * 4096 * 512; }
        else { r -= 6560; const int m = r >> 10; r &= 1023; j.R = DM; j.C = DM;
            j.src = (m == 0 ? gp(p.w_a) : m == 1 ? gp(p.w_b) : m == 2 ? gp(p.w_o) : gp(p.w_pq)) + (long)l * DM * DM;
            j.dst = (bf16_t*)(ws + (m == 0 ? WS_WA : m == 1 ? WS_WB : m == 2 ? WS_WO : WS_WPQ)) + (long)l * DM * DM; }
        const int ntc = j.C / 64; j.r0 = (r / ntc) * 64; j.c0 = (r % ntc) * 64; return j; };
      const int NTILES = 2 * 10656, G_ = ogrid(); int it = obid(); float v[8]; TJob cur{};
      if (it < NTILES) { cur = decode(it);
#pragma unroll
        for (int i = 0; i < 8; ++i) { const int idx = tid + 512 * i, r = idx >> 6, c = idx & 63; v[i] = cur.src[(long)(cur.r0 + r) * cur.C + cur.c0 + c]; } }
      while (it < NTILES) { const int itn = it + G_; float vn[8]; TJob nxt{};
        if (itn < NTILES) { nxt = decode(itn);
#pragma unroll
            for (int i = 0; i < 8; ++i) { const int idx = tid + 512 * i, r = idx >> 6, c = idx & 63; vn[i] = nxt.src[(long)(nxt.r0 + r) * nxt.C + nxt.c0 + c]; } }
#pragma unroll
        for (int i = 0; i < 8; ++i) { const int idx = tid + 512 * i, r = idx >> 6, c = idx & 63; tile[r * 65 + c] = v[i]; }
        __syncthreads();
        { const int c = tid >> 3, rc = (tid & 7) * 8; float f[8];
#pragma unroll
          for (int jj = 0; jj < 8; ++jj) f[jj] = tile[(rc + jj) * 65 + c];
          int drow = cur.c0 + c;
          if (cur.perm) { const int gq = drow / 768, o = drow - 768 * gq, hh = o / 192, w = o - 192 * hh;
              drow = 768 * gq + (w < 128 ? 128 * hh + w : (w < 160 ? 512 + 32 * hh + (w - 128) : 640 + 32 * hh + (w - 160))); }
          *reinterpret_cast<u32x4*>(cur.dst + (long)drow * cur.R + cur.r0 + rc) = pack8(f); }
        __syncthreads();
#pragma unroll
        for (int i = 0; i < 8; ++i) v[i] = vn[i];
        cur = nxt; it = itn; } }
    for (long i = gthread(); i < 2L * 16 * 512 * 32; i += nthreads()) { const int ch = (int)(i & 31); const long row = i >> 5; const int c = (int)(row & 511), h = (int)((row >> 9) & 15), l = (int)(row >> 13);
        u32x4 w = (u32x4){0u, 0u, 0u, 0u};
        if (ch < 16) { const float* s = gp(p.w_ukv) + (((long)l * 512 + c) * 16 + h) * 256 + ch * 8; float f[8];
#pragma unroll
            for (int j = 0; j < 8; ++j) f[j] = s[j];
            w = pack8(f); }
        *reinterpret_cast<u32x4*>((bf16_t*)(ws + WS_WUK) + row * 256 + ch * 8) = w; }
    for (long i = gthread(); i < 2L * 4096; i += nthreads()) { const bool second = i >= 4096; const long j8 = (second ? i - 4096 : i) * 8; const float* s = (second ? gp(p.peer_k2) : gp(p.peer_k1)) + j8; float f[8];
#pragma unroll
        for (int j = 0; j < 8; ++j) f[j] = s[j];
        *reinterpret_cast<u32x4*>((bf16_t*)(ws + (second ? WS_PK2 : WS_PK1)) + j8) = pack8(f); }
    for (int l = 0; l < 2; ++l) zero_chunks((bf16_t*)(ws + WS_WIN) + ((long)l * INWP + INW) * DM, INWP - INW, DM, 0, DM / 8);
    for (int b = 0; b < DB; ++b) zero_chunks((bf16_t*)(ws + WS_CKA) + ((long)b * KPAD + KALL) * QLD, KPAD - KALL, QLD, 0, QLD / 8);
    zero_chunks((bf16_t*)(ws + WS_CKA), (long)DB * KPAD, QLD, 576, 8);
    zero_chunks((bf16_t*)(ws + WS_CKT), (long)DB * 512, KPAD, KALL, (KPAD - KALL) / 8);
    zero_chunks((bf16_t*)(ws + WS_QL), (long)DB * 1024, QLD, 576, 8);
    for (long i = gthread(); i < 4096L * 96; i += nthreads()) { const int pos = (int)(i / 96), k = (int)(i % 96); const bool big = k >= 32; const int fi = big ? k - 32 : k; const float d = big ? 128.f : 64.f;
        const float inv = __builtin_amdgcn_exp2f(-(2.0f * (float)fi / d) * 13.287712379549449f);
        const float ang = (float)pos * inv; double rv = (double)ang * 0.15915494309189535; rv -= floor(rv); const float fr = (float)rv;
        float* dst = big ? (float*)(ws + WS_TAB128) + ((long)pos * 64 + fi) * 2 : (float*)(ws + WS_TAB64) + ((long)pos * 32 + fi) * 2;
        dst[0] = __builtin_amdgcn_cosf(fr); dst[1] = __builtin_amdgcn_sinf(fr); }
    { float* sc = (float*)lds;
      for (int it = obid(); it < 2 * 12 * 8; it += ogrid()) { const int l = it / 96, cc = (it % 96) / 8, ks = it % 8;
        __syncthreads();
        for (int i = tid; i < NCOND * 256; i += 512) { const int r = i >> 8, k = i & 255; const float c = r < NB ? gp(p.c_prompt)[(long)r * DM + ks * 256 + k] : gp(p.c_sample)[(long)(r - NB) * DM + ks * 256 + k]; sc[i] = siluf_(c); }
        __syncthreads();
        float a0[NCOND], a1[NCOND];
#pragma unroll
        for (int r = 0; r < NCOND; ++r) { a0[r] = 0.f; a1[r] = 0.f; }
        const float* wp = gp(p.w_ada) + ((long)l * DM + ks * 256) * 12288 + cc * 1024 + 2 * tid;
#pragma unroll 1
        for (int k = 0; k < 256; k += 4) { const f32x2 w0 = *reinterpret_cast<const f32x2*>(wp), w1 = *reinterpret_cast<const f32x2*>(wp + 12288), w2 = *reinterpret_cast<const f32x2*>(wp + 2 * 12288), w3 = *reinterpret_cast<const f32x2*>(wp + 3 * 12288);
            wp += 4 * 12288;
#pragma unroll
            for (int r = 0; r < NCOND; ++r) { const f32x4 s = *reinterpret_cast<const f32x4*>(sc + r * 256 + k);
                a0[r] = fmaf(s[0], w0[0], fmaf(s[1], w1[0], fmaf(s[2], w2[0], fmaf(s[3], w3[0], a0[r]))));
                a1[r] = fmaf(s[0], w0[1], fmaf(s[1], w1[1], fmaf(s[2], w2[1], fmaf(s[3], w3[1], a1[r]))));
                if ((r % 6) == 5) __builtin_amdgcn_sched_barrier(0); } }
        float* dst = (float*)(ws + WS_ADAP) + (((long)ks * 2 + l) * NCOND) * 12288 + cc * 1024 + 2 * tid;
#pragma unroll
        for (int r = 0; r < NCOND; ++r) *reinterpret_cast<f32x2*>(dst + (long)r * 12288) = (f32x2){a0[r], a1[r]}; }
      __syncthreads(); }
}

__device__ __forceinline__ void wpq_int8(KParams& p) {
    unsigned char* ws = optr(gp(p.ws)); const int lane = otid() & 63;
    for (int r = gwave(); r < 2 * DM; r += nwaves()) { const bf16_t* src = (const bf16_t*)(ws + WS_WPQ) + (long)r * DM; float f[4][8]; float am = 0.f;
#pragma unroll
        for (int j = 0; j < 4; ++j) { unpack8(*reinterpret_cast<const u32x4*>(src + 512 * j + 8 * lane), f[j]);
#pragma unroll
            for (int i = 0; i < 8; ++i) am = fmaxf(am, fabsf(f[j][i])); }
        am = wave_max(am); const float qs = am > 0.f ? 127.0f / am : 0.f;
#pragma unroll
        for (int j = 0; j < 4; ++j) { unsigned w2[2];
#pragma unroll
            for (int hh = 0; hh < 2; ++hh) { unsigned w = 0u;
#pragma unroll
                for (int i = 0; i < 4; ++i) w |= ((unsigned)((int)__builtin_rintf(f[j][4 * hh + i] * qs) & 0xff)) << (8 * i);
                w2[hh] = w; }
            *reinterpret_cast<u32x2*>(ws + WS_WPQ8 + (long)r * DM + 512 * j + 8 * lane) = (u32x2){w2[0], w2[1]}; }
        if (lane == 0) ((float*)(ws + WS_SB8))[r] = am * (1.0f / 127.0f); }
}

__device__ __forceinline__ void wb_int8(KParams& p, int l) {
    unsigned char* ws = optr(gp(p.ws)); const int lane = otid() & 63;
    for (int r = gwave(); r < DM; r += nwaves()) { const bf16_t* src = (const bf16_t*)(ws + WS_WB) + ((long)l * DM + r) * DM; float f[4][8]; float am = 0.f;
#pragma unroll
        for (int j = 0; j < 4; ++j) { unpack8(*reinterpret_cast<const u32x4*>(src + 512 * j + 8 * lane), f[j]);
#pragma unroll
            for (int i = 0; i < 8; ++i) am = fmaxf(am, fabsf(f[j][i])); }
        am = wave_max(am); const float qs = am > 0.f ? 127.0f / am : 0.f;
#pragma unroll
        for (int j = 0; j < 4; ++j) { unsigned w2[2];
#pragma unroll
            for (int hh = 0; hh < 2; ++hh) { unsigned w = 0u;
#pragma unroll
                for (int i = 0; i < 4; ++i) w |= ((unsigned)((int)__builtin_rintf(f[j][4 * hh + i] * qs) & 0xff)) << (8 * i);
                w2[hh] = w; }
            *reinterpret_cast<u32x2*>(ws + WS_WB8 + (long)r * DM + 512 * j + 8 * lane) = (u32x2){w2[0], w2[1]}; }
        if (lane == 0) ((float*)(ws + WS_SBB))[r] = am * (1.0f / 127.0f); }
}

__device__ __forceinline__ void win_int8(KParams& p, int l) {
    unsigned char* ws = optr(gp(p.ws)); const int lane = otid() & 63;
    for (int jr = gwave(); jr < NB8 * 256; jr += nwaves()) { const int blk = jr >> 8, n = (blk < 2 ? blk : (blk < 5 ? blk + 3 : blk + 7)) * 256 + (jr & 255);
        const bf16_t* src = (const bf16_t*)(ws + WS_WIN) + ((long)l * INWP + n) * DM; float f[4][8]; float am = 0.f;
#pragma unroll
        for (int j = 0; j < 4; ++j) { unpack8(*reinterpret_cast<const u32x4*>(src + 512 * j + 8 * lane), f[j]);
#pragma unroll
            for (int i = 0; i < 8; ++i) am = fmaxf(am, fabsf(f[j][i])); }
        am = wave_max(am); const float qs = am > 0.f ? 127.0f / am : 0.f;
#pragma unroll
        for (int j = 0; j < 4; ++j) { unsigned w2[2];
#pragma unroll
            for (int hh = 0; hh < 2; ++hh) { unsigned w = 0u;
#pragma unroll
                for (int i = 0; i < 4; ++i) w |= ((unsigned)((int)__builtin_rintf(f[j][4 * hh + i] * qs) & 0xff)) << (8 * i);
                w2[hh] = w; }
            *reinterpret_cast<u32x2*>(ws + WS_WIN8 + (long)jr * DM + 512 * j + 8 * lane) = (u32x2){w2[0], w2[1]}; }
        if (lane == 0) ((float*)(ws + WS_SBW))[n] = am * (1.0f / 127.0f); }
}

__device__ __forceinline__ void ada_reduce(KParams& p) {
    unsigned char* ws = optr(gp(p.ws)); const float* ap = (const float*)(ws + WS_ADAP); float* ad = (float*)(ws + WS_ADA); const long n = 2L * NCOND * 12288;
    for (long i = gthread(); i < n; i += nthreads()) { const int l = (int)(i / (NCOND * 12288L)); const int j = (int)(i % 12288);
        float s = gp(p.b_ada)[(long)l * 12288 + j];
#pragma unroll
        for (int ks = 0; ks < 8; ++ks) s += ap[(long)ks * n + i];
        ad[i] = s; }
}

__device__ __forceinline__ void modulate(KParams& p, int l, int which) {
    const int lane = otid() & 63; unsigned char* ws = optr(gp(p.ws)); const float* X = gp(p.out); bf16_t* H = (bf16_t*)(ws + WS_H);
    const float* g = (which ? gp(p.g_ffn) : gp(p.g_mix)) + (long)l * DM; const float* ada = (const float*)(ws + WS_ADA) + (long)l * NCOND * 12288 + (which ? 3 : 0) * DM;
    for (int t = gwave(); t < T; t += nwaves()) {
        const float* xr = (l == 0 && which == 0) ? (t < TP ? gp(p.x_prompt) + (long)t * DM : gp(p.x_sample) + (long)(t - TP) * DM) : X + (long)t * DM; f32x4 v[8]; float ss = 0.f;
#pragma unroll
        for (int j = 0; j < 8; ++j) { v[j] = *reinterpret_cast<const f32x4*>(xr + 256 * j + 4 * lane); ss += v[j][0] * v[j][0] + v[j][1] * v[j][1] + v[j][2] * v[j][2] + v[j][3] * v[j][3]; }
        ss = wave_sum(ss); const float rinv = rsqrtf(ss * (1.0f / DM) + EPS);
        const float* sh = ada + (long)cond_row(t) * 12288; const float* sc = sh + DM;
#pragma unroll
        for (int j = 0; j < 8; ++j) { const int c = 256 * j + 4 * lane; const f32x4 gv = *reinterpret_cast<const f32x4*>(g + c), sv = *reinterpret_cast<const f32x4*>(sc + c), hv = *reinterpret_cast<const f32x4*>(sh + c);
            const f32x4 y = v[j] * rinv * gv * (sv + 1.0f) + hv; u32x2 w; w.x = cvt_pk_bf16(y[0], y[1]); w.y = cvt_pk_bf16(y[2], y[3]);
            *reinterpret_cast<u32x2*>(H + (long)t * DM + c) = w; v[j] = y; }
        {
            float am = 0.f;
#pragma unroll
            for (int j = 0; j < 8; ++j) am = fmaxf(am, fmaxf(fmaxf(fabsf(v[j][0]), fabsf(v[j][1])), fmaxf(fabsf(v[j][2]), fabsf(v[j][3]))));
            am = wave_max(am); const float qs = am > 0.f ? 127.0f / am : 0.f;
#pragma unroll
            for (int j = 0; j < 8; ++j) { const int c = 256 * j + 4 * lane;
                const int q0 = (int)__builtin_rintf(v[j][0] * qs), q1 = (int)__builtin_rintf(v[j][1] * qs), q2 = (int)__builtin_rintf(v[j][2] * qs), q3 = (int)__builtin_rintf(v[j][3] * qs);
                *reinterpret_cast<unsigned*>(ws + WS_H8 + (long)t * DM + c) = (unsigned)(q0 & 0xff) | ((unsigned)(q1 & 0xff) << 8) | ((unsigned)(q2 & 0xff) << 16) | ((unsigned)(q3 & 0xff) << 24); }
            if (lane == 0) ((float*)(ws + WS_SA8))[t] = am * (1.0f / 127.0f); }
    }
}

__device__ __forceinline__ void cache_convert(KParams& p, int l, char* lds, int it0, int it1, int bidx, int nb) {
    const int tid = otid(); unsigned char* ws = optr(gp(p.ws)); float* tile = (float*)lds; bf16_t* CKA = (bf16_t*)(ws + WS_CKA); bf16_t* CKT = (bf16_t*)(ws + WS_CKT);
    { const int NT_ = it1, G_ = nb; int it = it0 + bidx; float v[8];
      const float* cbase = gp(p.cache_ckv) + (long)l * DB * PAST * 512;
#define CC_SRC(itx) (cbase + (((long)((itx) >> 8)) * PAST + (((itx) >> 3) & 31) * 64) * 512 + ((itx) & 7) * 64)
      if (it < NT_) { const float* src = CC_SRC(it);
#pragma unroll
        for (int i = 0; i < 8; ++i) { const int idx = tid + 512 * i, r = idx >> 6, c = idx & 63; v[i] = src[(long)r * 512 + c]; } }
      while (it < NT_) { const int b = it >> 8, kt = (it >> 3) & 31, ct = it & 7; const int itn = it + G_; float vn[8];
        if (itn < NT_) { const float* src = CC_SRC(itn);
#pragma unroll
            for (int i = 0; i < 8; ++i) { const int idx = tid + 512 * i, r = idx >> 6, c = idx & 63; vn[i] = src[(long)r * 512 + c]; } }
#pragma unroll
        for (int i = 0; i < 8; ++i) { const int idx = tid + 512 * i, r = idx >> 6, c = idx & 63; tile[r * 65 + c] = v[i]; }
        __syncthreads();
        { const int r = tid >> 3, cc = (tid & 7) * 8; float f[8];
#pragma unroll
          for (int j = 0; j < 8; ++j) f[j] = tile[r * 65 + cc + j];
          *reinterpret_cast<u32x4*>(CKA + ((long)b * KPAD + kt * 64 + r) * QLD + ct * 64 + cc) = pack8(f);
#pragma unroll
          for (int j = 0; j < 8; ++j) f[j] = tile[(cc + j) * 65 + r];
          *reinterpret_cast<u32x4*>(CKT + ((long)b * 512 + ct * 64 + r) * KPAD + kt * 64 + cc) = pack8(f); }
        __syncthreads();
#pragma unroll
        for (int i = 0; i < 8; ++i) v[i] = vn[i];
        it = itn; }
#undef CC_SRC
    }
    for (long i = (long)it0 * 64 + (long)bidx * 512 + tid; i < (long)it1 * 64; i += (long)nb * 512) { const long row = i >> 3; const int ch = (int)(i & 7); const int b = (int)(row >> 11), k = (int)(row & 2047);
        const float* s = gp(p.cache_krope) + (((long)l * DB + b) * PAST + k) * 64 + ch * 8; float f[8];
#pragma unroll
        for (int j = 0; j < 8; ++j) f[j] = s[j];
        *reinterpret_cast<u32x4*>(CKA + ((long)b * KPAD + k) * QLD + 512 + ch * 8) = pack8(f); }
}

__device__ __forceinline__ void quant_row8(const float (&o)[8], unsigned char* dst, float* sc, int lane) {
    float am = 0.f;
#pragma unroll
    for (int j = 0; j < 8; ++j) am = fmaxf(am, fabsf(o[j]));
    am = wave_max(am); const float qs = am > 0.f ? 127.0f / am : 0.f; unsigned w2[2];
#pragma unroll
    for (int hh = 0; hh < 2; ++hh) { unsigned w = 0u;
#pragma unroll
        for (int i = 0; i < 4; ++i) w |= ((unsigned)((int)__builtin_rintf(o[4 * hh + i] * qs) & 0xff)) << (8 * i);
        w2[hh] = w; }
    *reinterpret_cast<u32x2*>(dst) = (u32x2){w2[0], w2[1]};
    if (lane == 0) *sc = am * (1.0f / 127.0f);
}
__device__ __forceinline__ void wu_int8(KParams& p, int l) {
    unsigned char* ws = optr(gp(p.ws)); const int lane = otid() & 63;
    for (int r = gwave(); r < 3072 + 4096; r += nwaves()) { const bool kv = r >= 3072; const int rr = kv ? r - 3072 : r;
        const bf16_t* src = kv ? (const bf16_t*)(ws + WS_WUKV) + ((long)l * 4096 + rr) * 512 : (const bf16_t*)(ws + WS_WUQ) + ((long)l * 3072 + rr) * 512;
        float f[8]; unpack8(*reinterpret_cast<const u32x4*>(src + 8 * lane), f);
        quant_row8(f, ws + (kv ? WS_WUKV8 : WS_WUQ8) + (long)rr * 512 + 8 * lane, (float*)(ws + (kv ? WS_SBK : WS_SBQ)) + rr, lane); }
}

__device__ __forceinline__ void post_win(KParams& p, int l) {
    const int lane = otid() & 63; unsigned char* ws = optr(gp(p.ws));
    bf16_t* Y = (bf16_t*)(ws + WS_Y); bf16_t* CQN = (bf16_t*)(ws + WS_CQN); bf16_t* CKVNP = (bf16_t*)(ws + WS_CKVNP); bf16_t* KRP = (bf16_t*)(ws + WS_KRP); bf16_t* CKA = (bf16_t*)(ws + WS_CKA); bf16_t* CKT = (bf16_t*)(ws + WS_CKT);
    const float* T64 = (const float*)(ws + WS_TAB64); const float* T128 = (const float*)(ws + WS_TAB128);
    for (int t = gwave(); t < T; t += nwaves()) {
        bf16_t* y = Y + (long)t * INWP; const int pos = tok_pos(t); const bool samp = t >= TP; const int ts = t - TP, b = ts >> 6, s = ts & 63;
        { float f[8], o[8]; unpack8(*reinterpret_cast<const u32x4*>(y + C_CQ + 8 * lane), f); float ss = 0.f;
#pragma unroll
          for (int j = 0; j < 8; ++j) ss += f[j] * f[j];
          ss = wave_sum(ss); const float rinv = rsqrtf(ss * (1.0f / 512.f) + EPS); const float* g = gp(p.g_q) + (long)l * 512 + 8 * lane;
#pragma unroll
          for (int j = 0; j < 8; ++j) o[j] = f[j] * rinv * g[j];
          quant_row8(o, (unsigned char*)CQN + (long)t * 512 + 8 * lane, (float*)(ws + WS_SAQ) + t, lane); }
        { float f[8], o[8]; unpack8(*reinterpret_cast<const u32x4*>(y + C_CKV + 8 * lane), f); float ss = 0.f;
#pragma unroll
          for (int j = 0; j < 8; ++j) ss += f[j] * f[j];
          ss = wave_sum(ss); const float rinv = rsqrtf(ss * (1.0f / 512.f) + EPS); const float* g = gp(p.g_kv) + (long)l * 512 + 8 * lane;
#pragma unroll
          for (int j = 0; j < 8; ++j) o[j] = f[j] * rinv * g[j];
          float* od = gp(p.out) + (samp ? O_CKVS + ((long)l * TS + ts) * 512 : O_CKVP + ((long)l * TP + t) * 512) + 8 * lane;
          *reinterpret_cast<f32x4*>(od) = (f32x4){o[0], o[1], o[2], o[3]}; *reinterpret_cast<f32x4*>(od + 4) = (f32x4){o[4], o[5], o[6], o[7]};
          const u32x4 w = pack8(o);
          if (!samp) quant_row8(o, (unsigned char*)CKVNP + (long)t * 512 + 8 * lane, (float*)(ws + WS_SAK) + t, lane);
          else { *reinterpret_cast<u32x4*>(CKA + ((long)b * KPAD + PAST + s) * QLD + 8 * lane) = w;
#pragma unroll
              for (int j = 0; j < 8; ++j) CKT[((long)b * 512 + 8 * lane + j) * KPAD + PAST + s] = f2bf(o[j]); } }
        if (lane < 32) { const float x1 = bf2f(y[C_KR + lane]), x2 = bf2f(y[C_KR + 32 + lane]); const float c = T64[((long)pos * 32 + lane) * 2], sn = T64[((long)pos * 32 + lane) * 2 + 1];
            const float o1 = x1 * c - x2 * sn, o2 = x1 * sn + x2 * c;
            float* od = gp(p.out) + (samp ? O_KRS + ((long)l * TS + ts) * 64 : O_KRP + ((long)l * TP + t) * 64); od[lane] = o1; od[32 + lane] = o2;
            if (!samp) { KRP[(long)t * 64 + lane] = f2bf(o1); KRP[(long)t * 64 + 32 + lane] = f2bf(o2); }
            else { bf16_t* d = CKA + ((long)b * KPAD + PAST + s) * QLD + 512; d[lane] = f2bf(o1); d[32 + lane] = f2bf(o2); } }
        { const int hh = lane >> 3, d0 = (lane & 7) * 8; const float* cs = T128 + ((long)pos * 64 + d0) * 2; float cv[8], sv[8];
#pragma unroll
          for (int j = 0; j < 4; ++j) { const f32x4 q = *reinterpret_cast<const f32x4*>(cs + 4 * j); cv[2 * j] = q[0]; sv[2 * j] = q[1]; cv[2 * j + 1] = q[2]; sv[2 * j + 1] = q[3]; }
#pragma unroll
          for (int which = 0; which < 2; ++which) { bf16_t* base = y + (which ? C_RK : C_RQ) + hh * 128 + d0; const float sca = which ? 0.08838834764831845f : 1.0f;
              float a[8], bq[8], o1[8], o2[8]; unpack8(*reinterpret_cast<const u32x4*>(base), a); unpack8(*reinterpret_cast<const u32x4*>(base + 64), bq);
#pragma unroll
              for (int j = 0; j < 8; ++j) { o1[j] = (a[j] * cv[j] - bq[j] * sv[j]) * sca; o2[j] = (a[j] * sv[j] + bq[j] * cv[j]) * sca; }
              *reinterpret_cast<u32x4*>(base) = pack8(o1); *reinterpret_cast<u32x4*>(base + 64) = pack8(o2); } }
    }
}

__device__ __forceinline__ void post_q(KParams& p) {
    const int lane = otid() & 63; unsigned char* ws = optr(gp(p.ws)); bf16_t* Q = (bf16_t*)(ws + WS_Q); bf16_t* QL = (bf16_t*)(ws + WS_QL); const float* T64 = (const float*)(ws + WS_TAB64);
    for (int t = gwave(); t < T; t += nwaves()) { const int pos = tok_pos(t); const int hd = lane >> 2, d0 = (lane & 3) * 8;
        bf16_t* base = Q + (long)t * 3072 + hd * 192 + 128 + d0; const float* cs = T64 + ((long)pos * 32 + d0) * 2; float cv[8], sv[8];
#pragma unroll
        for (int j = 0; j < 4; ++j) { const f32x4 q = *reinterpret_cast<const f32x4*>(cs + 4 * j); cv[2 * j] = q[0]; sv[2 * j] = q[1]; cv[2 * j + 1] = q[2]; sv[2 * j + 1] = q[3]; }
        float a[8], bq[8], o1[8], o2[8]; unpack8(*reinterpret_cast<const u32x4*>(base), a); unpack8(*reinterpret_cast<const u32x4*>(base + 32), bq);
#pragma unroll
        for (int j = 0; j < 8; ++j) { o1[j] = a[j] * cv[j] - bq[j] * sv[j]; o2[j] = a[j] * sv[j] + bq[j] * cv[j]; }
        const u32x4 w1 = pack8(o1), w2 = pack8(o2);
        *reinterpret_cast<u32x4*>(base) = w1; *reinterpret_cast<u32x4*>(base + 32) = w2;
        if (t >= TP) { const int ts = t - TP, b = ts >> 6, s = ts & 63; bf16_t* d = QL + ((long)b * 1024 + hd * 64 + s) * QLD + 512 + d0;
            *reinterpret_cast<u32x4*>(d) = w1; *reinterpret_cast<u32x4*>(d + 32) = w2; } }
}

__device__ __forceinline__ void softmax_rows(KParams& p) {
    const int lane = otid() & 63; unsigned char* ws = optr(gp(p.ws)); bf16_t* SP = (bf16_t*)(ws + WS_SP);
    for (int r = gwave(); r < DB * 1024; r += nwaves()) { bf16_t* row = SP + (long)r * KPAD; float v[5][8]; float mx = -3.0e38f;
#pragma unroll
        for (int j = 0; j < 5; ++j) { const int ch = lane + 64 * j;
            if (ch < KALL / 8) { unpack8(*reinterpret_cast<const u32x4*>(row + ch * 8), v[j]);
#pragma unroll
                for (int i = 0; i < 8; ++i) { v[j][i] *= MLA_SCALE; mx = fmaxf(mx, v[j][i]); } }
            else {
#pragma unroll
                for (int i = 0; i < 8; ++i) v[j][i] = -3.0e38f; } }
        mx = wave_max(mx); float sum = 0.f;
#pragma unroll
        for (int j = 0; j < 5; ++j) { const int ch = lane + 64 * j;
#pragma unroll
            for (int i = 0; i < 8; ++i) { v[j][i] = (ch < KALL / 8) ? __expf(v[j][i] - mx) : 0.f; sum += v[j][i]; } }
        sum = wave_sum(sum); const float inv = 1.0f / sum;
#pragma unroll
        for (int j = 0; j < 5; ++j) { const int ch = lane + 64 * j;
            if (ch < KPAD / 8) { float o[8];
#pragma unroll
                for (int i = 0; i < 8; ++i) o[i] = v[j][i] * inv;
                *reinterpret_cast<u32x4*>(row + ch * 8) = pack8(o); } } }
}

__device__ __forceinline__ void gnorm_gate(KParams& p, int w0, int nw) {
    const int lane = otid() & 63; unsigned char* ws = optr(gp(p.ws)); const bf16_t* OB = (const bf16_t*)(ws + WS_OB); const bf16_t* Y = (const bf16_t*)(ws + WS_Y);
    for (int t = w0; t < T; t += nw) { const int c0 = (lane >> 3) * 256 + (lane & 7) * 32; float x[4][8]; float s = 0.f;
#pragma unroll
        for (int i = 0; i < 4; ++i) { unpack8(*reinterpret_cast<const u32x4*>(OB + ((long)lane * T + t) * 32 + 8 * i), x[i]);
#pragma unroll
            for (int j = 0; j < 8; ++j) s += x[i][j]; }
        s += sx<1>(s); s += sx<2>(s); s += sx<4>(s); const float mu = s * (1.0f / 256.f); float q = 0.f;
#pragma unroll
        for (int i = 0; i < 4; ++i)
#pragma unroll
            for (int j = 0; j < 8; ++j) { const float d = x[i][j] - mu; q += d * d; }
        q += sx<1>(q); q += sx<2>(q); q += sx<4>(q); const float rstd = rsqrtf(q * (1.0f / 256.f) + EPS);
        float am = 0.f;
#pragma unroll
        for (int i = 0; i < 4; ++i) { float g[8]; unpack8(*reinterpret_cast<const u32x4*>(Y + (long)t * INWP + C_RG + c0 + 8 * i), g);
#pragma unroll
            for (int j = 0; j < 8; ++j) { x[i][j] = siluf_(g[j]) * (x[i][j] - mu) * rstd; am = fmaxf(am, fabsf(x[i][j])); } }
        am = wave_max(am); const float qs = am > 0.f ? 127.0f / am : 0.f; unsigned w[8];
#pragma unroll
        for (int i = 0; i < 4; ++i)
#pragma unroll
            for (int hh = 0; hh < 2; ++hh) { unsigned v = 0u;
#pragma unroll
                for (int j = 0; j < 4; ++j) v |= ((unsigned)((int)__builtin_rintf(x[i][4 * hh + j] * qs) & 0xff)) << (8 * j);
                w[2 * i + hh] = v; }
        *reinterpret_cast<u32x4*>(ws + WS_BG + (long)t * DM + c0) = (u32x4){w[0], w[1], w[2], w[3]};
        *reinterpret_cast<u32x4*>(ws + WS_BG + (long)t * DM + c0 + 16) = (u32x4){w[4], w[5], w[6], w[7]};
        if (lane == 0) ((float*)(ws + WS_SA8))[t] = am * (1.0f / 127.0f); }
}

__device__ __forceinline__ void peer_convert(KParams& p, int l, int r0, int r1, int w0, int nw) {
    unsigned char* ws = optr(gp(p.ws)); const int lane = otid() & 63;
    const float* su = gp(p.peer_u) + (long)l * NEXP * DM; const float* sv = gp(p.peer_v) + (long)l * NEXP * DM;
    for (int r = r0 + w0; r < r1; r += nw) { const bool second = r >= NEXP; const int row = second ? r - NEXP : r; const float* s = (second ? sv : su) + (long)row * DM;
        f32x4 v[8]; float am = 0.f;
#pragma unroll
        for (int j = 0; j < 8; ++j) { v[j] = *reinterpret_cast<const f32x4*>(s + 512 * (j >> 2) * 2 + 16 * lane + 4 * (j & 3));
            am = fmaxf(am, fmaxf(fmaxf(fabsf(v[j][0]), fabsf(v[j][1])), fmaxf(fabsf(v[j][2]), fabsf(v[j][3])))); }
        am = wave_max(am);
        float sc = 1.0f, isc = 1.0f;
        if (am > 0.f) { const int e = (int)((__float_as_uint(am) >> 23) & 0xffu) - 127;
            int k = 7 - e; k = k > 100 ? 100 : (k < -100 ? -100 : k);
            sc = __uint_as_float((unsigned)(127 + k) << 23); isc = __uint_as_float((unsigned)(127 - k) << 23); }
        unsigned w[8];
#pragma unroll
        for (int j = 0; j < 8; ++j) { int pk = __builtin_amdgcn_cvt_pk_fp8_f32(v[j][0] * sc, v[j][1] * sc, 0, false); pk = __builtin_amdgcn_cvt_pk_fp8_f32(v[j][2] * sc, v[j][3] * sc, pk, true); w[j] = (unsigned)pk; }
        if (!second) {
            unsigned char* dst = ws + WS_PU + ((long)(lane >> 3) * NEXP + row) * 128 + 16 * (lane & 7);
            *reinterpret_cast<u32x4*>(dst) = (u32x4){w[0], w[1], w[2], w[3]};
            *reinterpret_cast<u32x4*>(dst + 8L * NEXP * 128) = (u32x4){w[4], w[5], w[6], w[7]};
        } else {
            unsigned char* dst = ws + WS_PV + ((long)(2 * lane) * NEXP + row) * 8;
            *reinterpret_cast<u32x2*>(dst) = (u32x2){w[0], w[1]}; *reinterpret_cast<u32x2*>(dst + (long)NEXP * 8) = (u32x2){w[2], w[3]};
            *reinterpret_cast<u32x2*>(dst + 128L * NEXP * 8) = (u32x2){w[4], w[5]}; *reinterpret_cast<u32x2*>(dst + 129L * NEXP * 8) = (u32x2){w[6], w[7]}; }
        if (lane == 0) ((float*)(ws + (second ? WS_PSV : WS_PSU)))[row] = isc; }
}

__device__ __forceinline__ void final_norm(KParams& p) {
    const int lane = otid() & 63; float* X = gp(p.out);
    for (int t = gwave(); t < T; t += nwaves()) { float* xr = X + (long)t * DM; f32x4 v[8]; float ss = 0.f;
#pragma unroll
        for (int j = 0; j < 8; ++j) { v[j] = *reinterpret_cast<const f32x4*>(xr + 256 * j + 4 * lane); ss += v[j][0] * v[j][0] + v[j][1] * v[j][1] + v[j][2] * v[j][2] + v[j][3] * v[j][3]; }
        ss = wave_sum(ss); const float rinv = rsqrtf(ss * (1.0f / DM) + EPS);
#pragma unroll
        for (int j = 0; j < 8; ++j) { const int c = 256 * j + 4 * lane; const f32x4 gv = *reinterpret_cast<const f32x4*>(gp(p.g_final) + c); *reinterpret_cast<f32x4*>(xr + c) = v[j] * rinv * gv; } }
}
}
__global__ void __launch_bounds__(512, 2) mega_fwd(Params p_by_value_unused) {
    extern __shared__ __attribute__((aligned(16))) unsigned char shm[];
    LAS unsigned char* lds = (LAS unsigned char*)shm; char* ldsg = (char*)shm;
    if (threadIdx.x < 8) ((LAS unsigned*)(lds + LDS_BARW))[threadIdx.x] = 0u;
    __syncthreads();
    if (threadIdx.x == 0) { unsigned* tk = (unsigned*)(gp(KP.ws) + WS_CTL + CTL_RANK) + 64 * xb_xcc_id(); ((volatile LAS unsigned*)(lds + LDS_BARW))[2] = xb_add(tk, 1u); }
    const XcdBarrier bar = xcd_barrier_post((unsigned*)(gp(KP.ws) + WS_CTL), (volatile LAS unsigned*)(lds + LDS_BARW));
#define GRID_SYNC() xcd_barrier(bar)
#ifndef STOP_AT
#define STOP_AT 0
#endif
#ifdef DBG_DUMP
#define STOPCHK(n) do { if (STOP_AT == (n)) { float* xo = gp(KP.out); const bf16_t* src = (const bf16_t*)(gp(KP.ws) + DBG_DUMP); for (long i = ph::gthread(); i < (long)T * DM; i += ph::nthreads()) xo[i] = bf2f(src[i]); return; } } while (0)
#elif defined(DBG_SANITIZE)
#define STOPCHK(n) do { if (STOP_AT == (n) || (STOP_AT > 100 && l == 1 && STOP_AT - 100 == (n))) { float* xo = gp(KP.out); for (long i = ph::gthread(); i < (long)T * DM; i += ph::nthreads()) { const float v = xo[i]; if (!(v - v == 0.0f)) xo[i] = 7.0f; } return; } } while (0)
#else
#define STOPCHK(n) do { if (STOP_AT == (n) || (STOP_AT > 100 && l == 1 && STOP_AT - 100 == (n))) return; } while (0)
#endif
    using namespace pg8;
#define WSP(off) ((bf16_t*)(optr(gp(KP.ws)) + (off)))
#define H WSP(WS_H)
#define Y WSP(WS_Y)
#define CQN WSP(WS_CQN)
#define CKVNP WSP(WS_CKVNP)
#define KRP WSP(WS_KRP)
#define Q WSP(WS_Q)
#define YA WSP(WS_YA)
#define KV WSP(WS_KV)
#define SP WSP(WS_SP)
#define MIX WSP(WS_MIX)
#define OA WSP(WS_OA)
#define QP WSP(WS_QP)
#define CKA WSP(WS_CKA)
#define CKT WSP(WS_CKT)
#define QL WSP(WS_QL)
#define OL WSP(WS_OL)
#define BG WSP(WS_BG)
    int l = 0;
    ph::prologue(KP, ldsg);
#ifdef DUP_PRO
    ph::prologue(KP, ldsg);
#endif
    GRID_SYNC(); STOPCHK(1);
    if (threadIdx.x == 0) { unsigned* barw = (unsigned*)(gp(KP.ws) + WS_CTL); const unsigned me = xb_xcc_id(); unsigned nx = 0, xi = 0, nloc = 1;
        for (unsigned j = 0; j < 16; ++j) { const unsigned cn = xb_ld(&barw[XB_XCNT(j)]); if (cn) { if (j < me) ++xi; ++nx; } if (j == me) nloc = cn ? cn : 1u; }
        volatile LAS unsigned* iw = (volatile LAS unsigned*)(lds + LDS_BARW); iw[3] = xi; iw[4] = nx; iw[5] = nloc; }
    __syncthreads();
    ph::ada_reduce(KP);
    ph::wpq_int8(KP);
    GRID_SYNC(); STOPCHK(2);
    for (l = 0; l < DEPTH; ++l) {
#define WIN (WSP(WS_WIN) + (long)l * INWP * DM)
#define WUQ (WSP(WS_WUQ) + (long)l * 3072 * 512)
#define WUKV (WSP(WS_WUKV) + (long)l * 4096 * 512)
#define WUK (WSP(WS_WUK) + (long)l * 16 * 512 * 256)
#define WA (WSP(WS_WA) + (long)l * DM * DM)
#define WB (WSP(WS_WB) + (long)l * DM * DM)
#define WO (WSP(WS_WO) + (long)l * DM * DM)
#define WPQ (WSP(WS_WPQ) + (long)l * DM * DM)
#define ADA ((const float*)(optr(gp(KP.ws)) + WS_ADA) + (long)l * NCOND * 12288)
        ph::modulate(KP, l, 0);
        ph::win_int8(KP, l);
        ph::wb_int8(KP, l);
        ph::wu_int8(KP, l);
        ph::cache_convert(KP, l, ldsg, l == 0 ? 0 : 4096, 8192, obid(), ogrid());
        GRID_SYNC(); STOPCHK(3);
        { Sched<5> S; S.init(T / 256, INWP / 256 - NB8, (T / 256) * (INWP / 256 - NB8), DM, DM); gemm_phase(lds, Gemm{H, WIN, DM, DM, DM}, S, EpiBf16{Y, INWP, 0}); }
        { Sched<6> S; S.init(T / 256, NB8, (T / 256) * NB8, DM / 2, DM / 2);
          { const int G_ = ogrid(); S.rotate((((((T / 256) * NB8) % G_) + 7) & ~7) % G_); }
          unsigned char* ws8 = optr(gp(KP.ws));
          gemm_phase<EpiQ8, Sched<6>, true>(lds, Gemm{(const bf16_t*)(ws8 + WS_H8), (const bf16_t*)(ws8 + WS_WIN8), DM / 2, DM / 2, DM / 2}, S, EpiQ8{Y, INWP, (const float*)(ws8 + WS_SA8), (const float*)(ws8 + WS_SBW)}); }
#ifdef DUP_WIN
        { Sched<0> S; S.init(T / 256, INWP / 256, (T / 256) * (INWP / 256), DM, DM); gemm_phase(lds, Gemm{H, WIN, DM, DM, DM}, S, EpiBf16{Y, INWP, 0}); }
#endif
        GRID_SYNC(); STOPCHK(4);
        ph::post_win(KP, l);
        GRID_SYNC(); STOPCHK(5);
        { unsigned char* ws8 = optr(gp(KP.ws));
          { Sched<0> S; S.init(T / 256, 3072 / 256, (T / 256) * 12, 256, 256); gemm_phase<EpiQ, Sched<0>, 2>(lds, Gemm{CQN, (const bf16_t*)(ws8 + WS_WUQ8), 256, 256, 256, (const float*)(ws8 + WS_SAQ), (const float*)(ws8 + WS_SBQ)}, S, EpiQ{Q, QL, (const float*)(ws8 + WS_TAB64)}); }
          { Sched<0> S; S.init(TP / 256, 4096 / 256, (TP / 256) * 16, 256, 256); gemm_phase<EpiBf16, Sched<0>, 2>(lds, Gemm{CKVNP, (const bf16_t*)(ws8 + WS_WUKV8), 256, 256, 256, (const float*)(ws8 + WS_SAK), (const float*)(ws8 + WS_SBK)}, S, EpiBf16{KV, 4096, 0}); } }
        GRID_SYNC(); STOPCHK(6);
#ifndef DUP_ATTN
#define DUP_ATTN 1
#endif
#ifndef DUP_RET
#define DUP_RET 1
#endif
#ifndef DUP_GATHER
#define DUP_GATHER 0
#endif
#pragma unroll 1
        for (int rep_ = 0; rep_ < DUP_ATTN; ++rep_)
        { for (int u = obid(); u < 512; u += ogrid()) { const int c = u & 255, i = u >> 8, xcd = c & 7, slot = c >> 3; const int bh = xcd * 4 + (slot >> 3) + 32 * i, pr = slot & 7, b = bh >> 4, h = bh & 15;
#pragma unroll 1
              for (int z = 0; z < 2; ++z) { const int qb = z ? 15 - pr : pr; const long tok0 = (long)b * SEQ + 256 * qb;
                  att::attn_block(Q + tok0 * 3072 + h * 192, KV + (long)b * SEQ * 4096 + h * 256, KRP + (long)b * SEQ * 64, KV + (long)b * SEQ * 4096 + h * 256 + 128, OA + tok0 * DM + h * 128, qb, ldsg); } } }
        { Sched<1> S; S.init(0, 0, 256, 3072, 256); gemm_phase(lds, Gemm{Q, WUK, 256, 3072, 256}, S, EpiRowMap<1>{QL, nullptr}); }
        GRID_SYNC(); STOPCHK(8);
        { Sched<2> S; S.init(0, 0, DB * 36, QLD, QLD); gemm_phase(lds, Gemm{QL, CKA, QLD, QLD, QLD}, S, EpiExp{SP, (float*)(optr(gp(KP.ws)) + WS_CTL + CTL_RSUM) + (long)l * 32768}); }
        GRID_SYNC(); STOPCHK(9);
        { Sched<3> S; S.init(0, 0, 256, KPAD, KPAD); gemm_phase(lds, Gemm{SP, CKT, 2176, KPAD, KPAD}, S, EpiRowMap<3>{OL, (const float*)(optr(gp(KP.ws)) + WS_CTL + CTL_RSUM) + (long)l * 32768}); }
        GRID_SYNC(); STOPCHK(11);
        { Sched<4> S; S.init(0, 0, 128, 512, 512); gemm_phase(lds, Gemm{OL, WUKV, 512, 512, 512}, S, EpiOV{OA}); }
#pragma unroll 1
        for (int rep_ = 0; rep_ < DUP_RET; ++rep_)
        for (int u = obid(); u < 256 + DB * 64; u += ogrid()) ret::unit(KP, l, u, ldsg);
#ifdef DUP_RETP
        for (int u = obid(); u < 256; u += ogrid()) ret::unit(KP, l, u, ldsg);
#endif
        GRID_SYNC(); STOPCHK(12);
        { Sched<0> S; S.init(T / 256, DM / 256, (T / 256) * 8, DM, DM); gemm_phase(lds, Gemm{OA, WA, DM, DM, DM}, S, EpiBf16{YA, DM, 0}); }
        { const int G_ = ogrid(), rem_ = ((T / 256) * 8) % G_; const int b_ = obid();
          if (rem_ == 0) ph::gnorm_gate(KP, ph::gwave(), ph::nwaves());
          else if (b_ >= rem_) ph::gnorm_gate(KP, (b_ - rem_) * 8 + (otid() >> 6), (G_ - rem_) * 8); }
#ifdef DUP_WA
#pragma unroll 1
        for (int rep_ = 0; rep_ < DUP_WA; ++rep_)
        { Sched<0> S; S.init(T / 256, DM / 256, (T / 256) * 8, DM, DM); gemm_phase(lds, Gemm{OA, WA, DM, DM, DM}, S, EpiBf16{YA, DM, 0}); }
#endif
        GRID_SYNC(); STOPCHK(14);
        { Sched<0> S; S.init(T / 256, DM / 256, (T / 256) * 8, DM / 2, DM / 2); unsigned char* ws8 = optr(gp(KP.ws));
          gemm_phase<EpiMix, Sched<0>, true>(lds, Gemm{(const bf16_t*)(ws8 + WS_BG), (const bf16_t*)(ws8 + WS_WB8), DM / 2, DM / 2, DM / 2}, S, EpiMix{Y, YA, MIX, (const float*)(ws8 + WS_SA8), (const float*)(ws8 + WS_SBB)}); }
        { const int G_ = ogrid(), rem_ = ((T / 256) * 8) % G_; const int b_ = obid();
          if (rem_ == 0) ph::peer_convert(KP, l, 0, NEXP, ph::gwave(), ph::nwaves());
          else if (b_ >= rem_) ph::peer_convert(KP, l, 0, NEXP, (b_ - rem_) * 8 + (otid() >> 6), (G_ - rem_) * 8); }
        GRID_SYNC(); STOPCHK(15);
        { Sched<0> S; S.init(T / 256, DM / 256, (T / 256) * 8, DM, DM); gemm_phase(lds, Gemm{MIX, WO, DM, DM, DM}, S, EpiRes{gp(KP.out), ADA + 2 * DM, l == 0 ? gp(KP.x_prompt) : gp(KP.out), l == 0 ? gp(KP.x_sample) : gp(KP.out) + (long)TP * DM}); }
        { const int G_ = ogrid(), rem_ = ((T / 256) * 8) % G_; const int b_ = obid();
          if (rem_ == 0) ph::peer_convert(KP, l, NEXP, 2 * NEXP, ph::gwave(), ph::nwaves());
          else if (b_ >= rem_) ph::peer_convert(KP, l, NEXP, 2 * NEXP, (b_ - rem_) * 8 + (otid() >> 6), (G_ - rem_) * 8); }
        GRID_SYNC(); STOPCHK(16);
        ph::modulate(KP, l, 1);
        GRID_SYNC(); STOPCHK(17);
        { Sched<0> S; S.init(T / 256, DM / 256, (T / 256) * 8, DM / 2, DM / 2);
          unsigned char* ws8 = optr(gp(KP.ws));
          gemm_phase<EpiQ8, Sched<0>, true>(lds, Gemm{(const bf16_t*)(ws8 + WS_H8), (const bf16_t*)(ws8 + WS_WPQ8 + (long)l * DM * DM), DM / 2, DM / 2, DM / 2}, S, EpiQ8{QP, DM, (const float*)(ws8 + WS_SA8), (const float*)(ws8 + WS_SB8) + (long)l * DM});
#ifdef DUP_WPQ
          gemm_phase<EpiQ8, Sched<0>, true>(lds, Gemm{(const bf16_t*)(ws8 + WS_H8), (const bf16_t*)(ws8 + WS_WPQ8 + (long)l * DM * DM), DM / 2, DM / 2, DM / 2}, S, EpiQ8{QP, DM, (const float*)(ws8 + WS_SA8), (const float*)(ws8 + WS_SB8) + (long)l * DM});
#endif
        }
        if (l + 1 < DEPTH) { const int G_ = ogrid(), rem_ = ((T / 256) * 8) % G_; const int b_ = obid();
          if (rem_ == 0) ph::cache_convert(KP, l + 1, ldsg, 0, 4096, b_, G_);
          else if (b_ >= rem_) ph::cache_convert(KP, l + 1, ldsg, 0, 4096, b_ - rem_, G_ - rem_); }
        GRID_SYNC(); STOPCHK(18);
        { const int tid_ = otid(); const int lane = tid_ & 63; float* strip = (float*)ldsg + tid_ * 33; unsigned char* ws = optr(gp(KP.ws));
          const bf16_t* k1g = (const bf16_t*)(ws + WS_PK1) + (long)l * 128 * 128; const bf16_t* k2g = (const bf16_t*)(ws + WS_PK2) + (long)l * 128 * 128;
          bf16_t* k1 = (bf16_t*)(ldsg + 512 * 33 * 4 + 64); bf16_t* k2 = k1 + 128 * peer::KPITCH;
          for (int i = tid_; i < 2 * 128 * 16; i += 512) { const int which = i >> 11, r = (i >> 4) & 127, ch = i & 15;
              *reinterpret_cast<u32x4*>((which ? k2 : k1) + r * peer::KPITCH + ch * 8) = *reinterpret_cast<const u32x4*>((which ? k2g : k1g) + r * 128 + ch * 8); }
          __syncthreads();
          for (int wu = ph::gwave(); wu < (T / 32) * PH; wu += ph::nwaves()) peer::select_unit(QP, k1, k2, (int*)(ws + WS_PIDX), (float*)(ws + WS_PW), (wu >> 3) * 32, wu & 7, lane, strip);
#ifdef DUP_SEL
          for (int wu = ph::gwave(); wu < (T / 32) * PH; wu += ph::nwaves()) peer::select_unit(QP, k1, k2, (int*)(ws + WS_PIDX), (float*)(ws + WS_PW), (wu >> 3) * 32, wu & 7, lane, strip);
#endif
        }
        GRID_SYNC(); STOPCHK(19);
        { const int tid_ = otid(); const int lane = tid_ & 63, wid = tid_ >> 6; unsigned char* ws = optr(gp(KP.ws));
          volatile LAS unsigned* iw = (volatile LAS unsigned*)(lds + LDS_BARW); peer::XInfo xin; xin.rank = __builtin_amdgcn_readfirstlane((int)iw[2]); xin.xi = __builtin_amdgcn_readfirstlane((int)iw[3]); xin.nx = __builtin_amdgcn_readfirstlane((int)iw[4]); xin.nloc = __builtin_amdgcn_readfirstlane((int)iw[5]);
          if (xin.nx >= 1 && xin.nx <= 8) {
              peer::upass(H, (const unsigned char*)(ws + WS_PU), (const int*)(ws + WS_PIDX), (const float*)(ws + WS_PW), (const float*)(ws + WS_PSU), (const float*)(ws + WS_PSV), (float*)(ws + WS_DOTP), (unsigned*)(ws + WS_ACT), xin, wid, lane);
              GRID_SYNC();
              int vs0_, vsn_, vse_;
              if ((256 % xin.nx) == 0) { const int spx = 256 / xin.nx; vs0_ = xin.xi * spx + xin.rank; vsn_ = xin.nloc; vse_ = (xin.xi + 1) * spx; }
              else { vs0_ = obid(); vsn_ = ogrid(); vse_ = 256; }
              peer::vpass_lds((const unsigned char*)(ws + WS_PV), (const unsigned*)(ws + WS_ACT), gp(KP.out), ADA + 5 * DM, ldsg, vs0_, vsn_, vse_, tid_);
#ifdef DUP_VP
              peer::vpass_lds((const unsigned char*)(ws + WS_PV), (const unsigned*)(ws + WS_ACT), (float*)(ws + WS_OB), ADA + 5 * DM, ldsg, vs0_, vsn_, vse_, tid_);
#endif
          } else {
              for (int t = ph::gwave(); t < T; t += ph::nwaves()) peer::gather_token(H, (const unsigned char*)(ws + WS_PU), (const unsigned char*)(ws + WS_PV), (const float*)(ws + WS_PSU), (const float*)(ws + WS_PSV), (const int*)(ws + WS_PIDX), (const float*)(ws + WS_PW), gp(KP.out), ADA + 5 * DM, t, lane);
          } }
        GRID_SYNC(); STOPCHK(20);
    }
    ph::final_norm(KP);
}

extern "C" void kernel_launch(void* const* d_in, const int* in_sizes, int n_in, void* d_out, int out_size, void* d_ws, size_t ws_size, hipStream_t stream) {
    static int grid = 0;
    if (grid == 0) {
        if (n_in != 25 || out_size != (int)O_END || ws_size < WS_END) { fprintf(stderr, "kernel_launch: shape mismatch: n_in %d out %d (want %ld) ws %zu (want >= %zu)\n", n_in, out_size, O_END, ws_size, (size_t)WS_END); grid = -1; return; }
        int dev = 0, cus = 0, per_cu = 0;
        if (hipGetDevice(&dev) != hipSuccess || hipDeviceGetAttribute(&cus, hipDeviceAttributeMultiprocessorCount, dev) != hipSuccess) { fprintf(stderr, "kernel_launch: device query failed\n"); grid = -1; return; }
        if (hipFuncSetAttribute((const void*)mega_fwd, hipFuncAttributeMaxDynamicSharedMemorySize, LDS_BYTES) != hipSuccess) { fprintf(stderr, "kernel_launch: hipFuncSetAttribute failed\n"); grid = -1; return; }
        if (hipOccupancyMaxActiveBlocksPerMultiprocessor(&per_cu, (const void*)mega_fwd, 512, LDS_BYTES) != hipSuccess || per_cu < 1) { fprintf(stderr, "kernel_launch: occupancy query says %d blocks per CU\n", per_cu); grid = -1; return; }
        grid = cus;
#ifdef FORCE_GRID
        grid = FORCE_GRID;
#endif
    }
    if (grid < 0) return;
    (void)hipMemsetAsync((char*)d_ws + WS_CTL, 0, CTL_BYTES, stream);
    Params p{};
    const float* const* in = (const float* const*)d_in;
    p.x_prompt = in[0]; p.x_sample = in[1]; p.c_prompt = in[2]; p.c_sample = in[3]; p.cache_ckv = in[4]; p.cache_krope = in[5]; p.state_ret = in[6]; p.w_ada = in[7]; p.b_ada = in[8];
    p.g_mix = in[9]; p.g_ffn = in[10]; p.w_in = in[11]; p.g_q = in[12]; p.w_uq = in[13]; p.g_kv = in[14]; p.w_ukv = in[15]; p.w_a = in[16]; p.w_b = in[17]; p.w_o = in[18]; p.w_pq = in[19];
    p.peer_k1 = in[20]; p.peer_k2 = in[21]; p.peer_u = in[22]; p.peer_v = in[23]; p.g_final = in[24];
    p.out = (float*)d_out; p.ws = (unsigned char*)d_ws;
    for (int h = 0; h < 8; ++h) p.lg[h] = (float)log1p(-pow(2.0, -5.0 - (double)h));
    p.grid = grid; p.pad_ = 0;
    hipLaunchKernelGGL(mega_fwd, dim3(grid), dim3(512), LDS_BYTES, stream, p);
    const hipError_t le = hipGetLastError();
    if (le != hipSuccess) fprintf(stderr, "kernel_launch: launch failed: %s\n", hipGetErrorName(le));
}
```

```cpp
#include <hip/hip_runtime.h>
#include <cstdio>
#include <cstdint>
#include <cmath>

#define LAS __attribute__((address_space(3)))
typedef unsigned short bf16_t;
typedef short bf16x8 __attribute__((ext_vector_type(8)));
typedef float f32x4 __attribute__((ext_vector_type(4)));
typedef float f32x2 __attribute__((ext_vector_type(2)));
typedef float f32x16 __attribute__((ext_vector_type(16)));
typedef unsigned u32x4 __attribute__((ext_vector_type(4)));
typedef unsigned u32x2 __attribute__((ext_vector_type(2)));
typedef short s16x4 __attribute__((ext_vector_type(4)));
typedef int i32x4 __attribute__((ext_vector_type(4)));

constexpr int DM = 2048, NB = 4, SEQ = 4096, DEPTH = 2, DB = 32, DS = 64, PAST = 2048;
constexpr int TP = NB * SEQ, TS = DB * DS, T = TP + TS;
constexpr int NCOND = NB + DB;
constexpr int QLORA = 512, KVLORA = 512, ROPE = 64, NOPE = 128, VD = 128, MH = 16, QKD = 192;
constexpr int RH = 8, RQK = 128, RV = 256;
constexpr int PH = 8, NKEYS = 128, NEXP = 16384, PTOPK = 16;
constexpr int INW = 11328, INWP = 11520;
constexpr int C_CQ = 0, C_CKV = 512, C_KR = 1024, C_RQ = 1088, C_RK = 2112, C_RV = 3136, C_RG = 5184, C_GA = 7232, C_GB = 9280;
constexpr int KALL = PAST + DS;
constexpr int KPAD = 2304;
constexpr int QLD = 640;
constexpr float EPS = 1e-6f;
constexpr float MLA_SCALE = 0.07216878364870322f;

constexpr long O_Y = 0;
constexpr long O_CKVP = (long)T * DM;
constexpr long O_KRP = O_CKVP + 2L * TP * 512;
constexpr long O_RETP = O_KRP + 2L * TP * 64;
constexpr long O_CKVS = O_RETP + 2L * NB * RH * RQK * RV;
constexpr long O_KRS = O_CKVS + 2L * TS * 512;
constexpr long O_RETS = O_KRS + 2L * TS * 64;
constexpr long O_END = O_RETS + 2L * DB * RH * RQK * RV;

constexpr size_t al256(size_t x) { return (x + 255) / 256 * 256; }
constexpr size_t WS_CTL = 0;
constexpr size_t CTL_BYTES = 65536 + 2UL * 32768 * 4;
constexpr size_t CTL_RSUM = 65536;
constexpr size_t WS_TAB64 = WS_CTL + CTL_BYTES;
constexpr size_t WS_TAB128 = WS_TAB64 + 4096UL * 32 * 2 * 4;
constexpr size_t WS_ADA = WS_TAB128 + 4096UL * 64 * 2 * 4;
constexpr size_t WS_ADAP = WS_ADA + 2UL * NCOND * 12288 * 4;
constexpr size_t WS_WIN = WS_ADAP + 8UL * 2 * NCOND * 12288 * 4;
constexpr size_t WS_WUQ = WS_WIN + 2UL * INWP * DM * 2;
constexpr size_t WS_WUKV = WS_WUQ + 2UL * 3072 * 512 * 2;
constexpr size_t WS_WUK = WS_WUKV + 2UL * 4096 * 512 * 2;
constexpr size_t WS_WA = WS_WUK + 2UL * 16 * 512 * 256 * 2;
constexpr size_t WS_WB = WS_WA + 2UL * DM * DM * 2;
constexpr size_t WS_WO = WS_WB + 2UL * DM * DM * 2;
constexpr size_t WS_WPQ = WS_WO + 2UL * DM * DM * 2;
constexpr size_t WS_PK1 = WS_WPQ + 2UL * DM * DM * 2;
constexpr size_t WS_PK2 = WS_PK1 + 2UL * 128 * 128 * 2;
constexpr size_t WS_H = WS_PK2 + 2UL * 128 * 128 * 2;
constexpr size_t WS_Y = WS_H + (size_t)T * DM * 2;
constexpr size_t WS_CQN = WS_Y + (size_t)T * INWP * 2;
constexpr size_t WS_CKVNP = WS_CQN + (size_t)T * 512 * 2;
constexpr size_t WS_KRP = WS_CKVNP + (size_t)TP * 512 * 2;
constexpr size_t WS_Q = WS_KRP + (size_t)TP * 64 * 2;
constexpr size_t WS_YA = WS_Q;
constexpr size_t WS_KV = WS_Q + (size_t)T * 3072 * 2 + 4096;
constexpr size_t WS_SP = WS_KV;
constexpr size_t WS_MIX = WS_KV;
constexpr size_t WS_OA = WS_KV + 32UL * 1024 * KPAD * 2;
constexpr size_t WS_QP = WS_OA;
constexpr size_t WS_CKA = WS_OA + (size_t)T * DM * 2;
constexpr size_t WS_CKT = WS_CKA + 32UL * KPAD * QLD * 2;
constexpr size_t WS_QL = WS_CKT + 32UL * 512 * KPAD * 2;
constexpr size_t WS_OL = WS_QL + 32UL * 1024 * QLD * 2;
constexpr size_t WS_OB = WS_OL + 16UL * 2048 * 512 * 2;
constexpr size_t WS_BG = WS_OB + (size_t)T * DM * 2;
constexpr size_t WS_PIDX = WS_BG + (size_t)T * DM * 2;
constexpr size_t WS_PW = WS_PIDX + (size_t)T * 128 * 4;
constexpr size_t WS_PU = WS_PW + (size_t)T * 128 * 4;
constexpr size_t WS_PV = WS_PU + (size_t)NEXP * DM;
constexpr size_t WS_PSU = WS_PV + (size_t)NEXP * DM;
constexpr size_t WS_PSV = WS_PSU + (size_t)NEXP * 4;
constexpr size_t WS_WPQ8 = WS_PSV + (size_t)NEXP * 4;
constexpr size_t WS_SB8 = WS_WPQ8 + 2UL * DM * DM;
constexpr size_t WS_SA8 = WS_SB8 + 2UL * DM * 4;
constexpr int NB8 = 38;
constexpr size_t WS_WIN8 = WS_BG + (size_t)T * DM;
constexpr size_t WS_WB8 = WS_WIN8 + (size_t)NB8 * 256 * DM;
constexpr size_t WS_WUQ8 = WS_WB8 + (size_t)DM * DM;
constexpr size_t WS_WUKV8 = WS_WUQ8 + 3072UL * 512;
constexpr size_t WS_WA8 = WS_WUKV8 + 4096UL * 512;
constexpr size_t WS_WO8 = WS_WA8 + (size_t)DM * DM;
static_assert(WS_WO8 + (size_t)DM * DM <= WS_BG + (size_t)T * DM * 2, "int8 weights overflow the BG region");
constexpr size_t WS_OA8 = WS_Q + (size_t)T * DM * 2;
constexpr size_t WS_MIX8 = WS_KV + (size_t)T * DM * 2;
static_assert(WS_OA8 + (size_t)T * DM <= WS_KV && WS_MIX8 + (size_t)T * DM <= WS_KV + (size_t)TP * 4096 * 2, "int8 activation copies fit");
constexpr size_t WS_SBW = WS_SA8 + al256((size_t)T * 4);
constexpr size_t WS_SBB = WS_SBW + al256((size_t)INWP * 4);
constexpr size_t WS_SBQ = WS_SBB + (size_t)DM * 4;
constexpr size_t WS_SBK = WS_SBQ + 3072UL * 4;
constexpr size_t WS_SAQ = WS_SBK + 4096UL * 4;
constexpr size_t WS_SAK = WS_SAQ + al256((size_t)T * 4);
constexpr size_t WS_SBA = WS_SAK + al256((size_t)TP * 4);
constexpr size_t WS_SBO = WS_SBA + (size_t)DM * 4;
constexpr size_t WS_SAO = WS_SBO + (size_t)DM * 4;
constexpr size_t WS_END = WS_SAO + al256((size_t)T * 4);
constexpr size_t WS_H8 = WS_OB;
static_assert((size_t)TP * 4096 * 2 <= 32UL * 1024 * KPAD * 2, "KV fits in the SP region");
static_assert(WS_END <= 1608000000UL, "workspace map too large");
static_assert(WS_WIN % 256 == 0 && WS_H % 256 == 0 && WS_Y % 256 == 0 && WS_Q % 256 == 0 && WS_KV % 256 == 0 && WS_CKA % 256 == 0, "alignment");

constexpr int LDS_BYTES = 147456;
constexpr int LDS_BARW = LDS_BYTES - 32;
constexpr size_t CTL_RANK = 16384;
constexpr size_t WS_DOTP = WS_Q;
constexpr size_t WS_ACT = WS_DOTP + 8UL * T * 128 * 4;
constexpr size_t WS_PIDXT = WS_ACT + (size_t)T * 128 * 4;
static_assert(WS_PIDXT + (size_t)T * 128 * 4 <= WS_KV, "PEER scratch fits in the Q region");

struct Params {
    const float *x_prompt, *x_sample, *c_prompt, *c_sample, *cache_ckv, *cache_krope, *state_ret, *w_ada, *b_ada, *g_mix, *g_ffn, *w_in, *g_q, *w_uq, *g_kv, *w_ukv,
                *w_a, *w_b, *w_o, *w_pq, *peer_k1, *peer_k2, *peer_u, *peer_v, *g_final;
    float* out; unsigned char* ws;
    float lg[8];
    int grid; int pad_;
};

typedef const __attribute__((address_space(4))) Params KParams;
__device__ __forceinline__ KParams* okarg() {
    const uintptr_t k = (uintptr_t)__builtin_amdgcn_kernarg_segment_ptr();
    unsigned lo = (unsigned)k, hi = (unsigned)(k >> 32);
    asm volatile("" : "+s"(lo), "+s"(hi)); return (KParams*)(((uintptr_t)hi << 32) | lo); }
#define KP (*okarg())
__device__ __forceinline__ int ogrid() { return KP.grid; }
__device__ __forceinline__ int obid() { int b = (int)blockIdx.x; asm volatile("" : "+s"(b) :: "memory"); return b; }
__device__ __forceinline__ int otid() { int t = (int)threadIdx.x; asm volatile("" : "+v"(t) :: "memory"); return t; }
template <class P> __device__ __forceinline__ P* gp(P* p) { return (P*)(__attribute__((address_space(1))) P*)(uintptr_t)p; }
template <class P> __device__ __forceinline__ P* optr(P* p) {
    unsigned lo = __builtin_amdgcn_readfirstlane((unsigned)(uintptr_t)p), hi = __builtin_amdgcn_readfirstlane((unsigned)((uintptr_t)p >> 32));
    asm volatile("" : "+s"(lo), "+s"(hi)); return gp((P*)(((uintptr_t)hi << 32) | lo)); }
typedef __bf16 bf16v2_t __attribute__((ext_vector_type(2)));
__device__ __forceinline__ unsigned cvt_pk_bf16(float lo, float hi) { f32x2 v = {lo, hi}; bf16v2_t r = __builtin_convertvector(v, bf16v2_t); return __builtin_bit_cast(unsigned, r); }
__device__ __forceinline__ bf16_t f2bf(float f) { return (bf16_t)(cvt_pk_bf16(f, 0.f) & 0xffffu); }
__device__ __forceinline__ float bf2f(bf16_t b) { return __uint_as_float(((unsigned)b) << 16); }
__device__ __forceinline__ float bflo(unsigned w) { return __uint_as_float(w << 16); }
__device__ __forceinline__ float bfhi(unsigned w) { return __uint_as_float(w & 0xffff0000u); }
__device__ __forceinline__ void unpack8(const u32x4 w, float (&f)[8]) { f[0] = bflo(w.x); f[1] = bfhi(w.x); f[2] = bflo(w.y); f[3] = bfhi(w.y); f[4] = bflo(w.z); f[5] = bfhi(w.z); f[6] = bflo(w.w); f[7] = bfhi(w.w); }
__device__ __forceinline__ u32x4 pack8(const float (&f)[8]) { u32x4 w; w.x = cvt_pk_bf16(f[0], f[1]); w.y = cvt_pk_bf16(f[2], f[3]); w.z = cvt_pk_bf16(f[4], f[5]); w.w = cvt_pk_bf16(f[6], f[7]); return w; }
template <int K> __device__ __forceinline__ float sx(float v) {
    if constexpr (K == 32) { const auto rr = __builtin_amdgcn_permlane32_swap(__float_as_uint(v), __float_as_uint(v), false, false); return __uint_as_float((otid() & 32) ? rr[0] : rr[1]); }
    else return __int_as_float(__builtin_amdgcn_ds_swizzle(__float_as_int(v), (K << 10) | 0x1F));
}
__device__ __forceinline__ float wave_sum(float v) { v += sx<32>(v); v += sx<16>(v); v += sx<8>(v); v += sx<4>(v); v += sx<2>(v); v += sx<1>(v); return v; }
__device__ __forceinline__ float wave_max(float v) { v = fmaxf(v, sx<32>(v)); v = fmaxf(v, sx<16>(v)); v = fmaxf(v, sx<8>(v)); v = fmaxf(v, sx<4>(v)); v = fmaxf(v, sx<2>(v)); v = fmaxf(v, sx<1>(v)); return v; }
__device__ __forceinline__ float sigmoidf_(float x) { return 1.0f / (1.0f + __expf(-x)); }
__device__ __forceinline__ float siluf_(float x) { return x / (1.0f + __expf(-x)); }
__device__ __forceinline__ int cond_row(int t) { return t < TP ? (t >> 12) : NB + ((t - TP) >> 6); }
__device__ __forceinline__ int tok_pos(int t) { return t < TP ? (t & 4095) : PAST + ((t - TP) & 63); }

#define XB_TMO      128
#define XB_XCNT(j)  (256  + 64 * (j))
#define XB_XSUB(j)  (1280 + 64 * (j))
#define XB_XGEN(j)  (2304 + 64 * (j))
#define XB_TOP      3328
#define XB_TOPGEN   3392
#define XCD_BAR_WORDS 3456
#define XB_SPIN_CAP (1u << 22)
__device__ __forceinline__ unsigned xb_ld(unsigned* p)              { return __hip_atomic_load(p, __ATOMIC_RELAXED, __HIP_MEMORY_SCOPE_AGENT); }
__device__ __forceinline__ unsigned xb_add(unsigned* p, unsigned v) { return __hip_atomic_fetch_add(p, v, __ATOMIC_RELAXED, __HIP_MEMORY_SCOPE_AGENT); }
__device__ __forceinline__ unsigned xb_xcc_id() { return (unsigned)__builtin_amdgcn_s_getreg((3 << 11) | 20) & 0xFu; }
#define XB_SPIN(cond, bar) do { unsigned _sp = 0; while (cond) { __builtin_amdgcn_s_sleep(1); \
    if ((++_sp & 255u) == 0u) { if (xb_ld(&(bar)[XB_TMO])) break; if (_sp > XB_SPIN_CAP) { atomicAdd(&(bar)[XB_TMO], 1u); break; } } } } while (0)
struct XcdBarrier { unsigned* bar; unsigned x; volatile LAS unsigned* st; };
__device__ __forceinline__ XcdBarrier xcd_barrier_post(unsigned* bar, volatile LAS unsigned* st) {
    XcdBarrier b; b.bar = bar; b.x = xb_xcc_id(); b.st = st;
    if (threadIdx.x == 0) (void)xb_add(&bar[XB_XCNT(b.x)], 1u);
    return b;
}
__device__ __forceinline__ void xcd_barrier_complete(unsigned* bar, unsigned x, unsigned& nloc, unsigned& nx) {
    const unsigned G = (unsigned)KP.grid;
    unsigned sum, cnt, mine, sp = 0u;
    for (;;) {
        sum = 0u; cnt = 0u; mine = 0u;
#pragma unroll
        for (unsigned j = 0; j < 16; ++j) { const unsigned c = xb_ld(&bar[XB_XCNT(j)]); sum += c; cnt += (c > 0u) ? 1u : 0u; mine = (j == x) ? c : mine; }
        if (sum == G) break;
        __builtin_amdgcn_s_sleep(1);
        if ((++sp & 255u) == 0u) { if (xb_ld(&bar[XB_TMO])) break; if (sp > XB_SPIN_CAP) { atomicAdd(&bar[XB_TMO], 1u); break; } }
    }
    nloc = mine > 0u ? mine : 1u; nx = cnt > 0u ? cnt : 1u;
}
__device__ __forceinline__ void xcd_barrier(const XcdBarrier& b) {
    asm volatile("s_waitcnt vmcnt(0)" ::: "memory");
    __syncthreads();
    if (otid() == 0) {
        unsigned* bar = (unsigned*)(gp(KP.ws) + WS_CTL);
        unsigned bx = xb_xcc_id(); asm volatile("" : "+s"(bx));
        __builtin_amdgcn_s_waitcnt(0);
        unsigned nloc = b.st[0], nx = b.st[1];
        if (nloc == 0u) { xcd_barrier_complete(bar, bx, nloc, nx); b.st[0] = nloc; b.st[1] = nx; }
        const unsigned old = xb_add(&bar[XB_XSUB(bx)], 1u);
        const unsigned gen = old / nloc;
        if (old + 1u == (gen + 1u) * nloc) {
            __builtin_amdgcn_fence(__ATOMIC_RELEASE, "agent");
            asm volatile("s_waitcnt vmcnt(0)" ::: "memory");
            const unsigned og = xb_add(&bar[XB_TOP], 1u);
            const unsigned tg = og / nx;
            if (og + 1u == (tg + 1u) * nx) xb_add(&bar[XB_TOPGEN], 1u);
            else XB_SPIN(xb_ld(&bar[XB_TOPGEN]) == tg, bar);
            __builtin_amdgcn_fence(__ATOMIC_ACQUIRE, "agent");
            xb_add(&bar[XB_XGEN(bx)], 1u);
            asm volatile("s_waitcnt vmcnt(0)" ::: "memory");
        } else {
            XB_SPIN(xb_ld(&bar[XB_XGEN(bx)]) == gen, bar);
            __builtin_amdgcn_fence(__ATOMIC_ACQUIRE, "agent");
            asm volatile("s_waitcnt vmcnt(0)" ::: "memory");
        }
    }
    __syncthreads();
}
namespace pg8 {
constexpr int BM = 256, BK = 64, HALF = 128, HTB = HALF * BK * 2, STAGE_BYTES = 8 * HTB, NXCD = 8, WGM = 8;
__host__ __device__ __forceinline__ int lds_byte(int r, int c) { const int st = (r >> 4) * 2 + (c >> 5), rr = r & 15, cc = c & 31, ob = rr * 64 + cc * 2; return st * 1024 + (ob ^ (((ob >> 9) & 1) << 5)); }
__host__ __device__ __forceinline__ void stage_rc(int b, int& R, int& C) { const int st = b / 1024, sb = b % 1024, swz = sb ^ (((sb >> 9) & 1) << 5); R = (st >> 1) * 16 + swz / 64; C = (st & 1) * 32 + (swz % 64) / 2; }
__host__ __device__ __forceinline__ int perm32(int rho) { const int n = rho >> 4, i = rho & 15; return 8 * (i >> 2) + 4 * n + (i & 3); }

struct Unit { int pm, pn; long aoff, boff; int x0, x1; };
struct Gemm { const bf16_t* A; const bf16_t* Bt; int K; int lda, ldb; const float* sa; const float* sb; };

template <int MODE> struct Sched {
    int nM, nN, nwg, G, c; long lda, ldb;
    __device__ void init(int nM_, int nN_, int nwg_, long lda_, long ldb_) { nM = nM_; nN = nN_; nwg = nwg_; G = ogrid(); c = obid(); lda = lda_; ldb = ldb_; }
    __device__ void rotate(int r) { c = (c + r) % G; }
    __device__ bool next(int i, Unit& u) const {
        const long L = (long)i * G + c; if (L >= nwg) return false;
        int wgid = (int)L;
        if (MODE == 0 || MODE == 5 || MODE == 6) {
            { const int q = nwg / NXCD, r = nwg % NXCD, xcd = wgid % NXCD, off = wgid / NXCD; wgid = (xcd < r ? xcd * (q + 1) : r * (q + 1) + (xcd - r) * q) + off; }
            const int nig = WGM * nN, gid = wgid / nig, fm = gid * WGM, gsz = (nM - fm) < WGM ? (nM - fm) : WGM;
            u.pm = fm + ((wgid % nig) % gsz); u.pn = (wgid % nig) / gsz; u.x0 = 0; u.x1 = 0;
            { const int pl = u.pn;
              if (MODE == 5) u.pn = pl < 3 ? pl + 2 : pl + 5;
              if (MODE == 6) u.pn = pl < 2 ? pl : (pl < 5 ? pl + 3 : pl + 7);
              u.aoff = (long)u.pm * 256 * lda * 2; u.boff = (long)(MODE == 6 ? pl : u.pn) * 256 * ldb * 2; }
        } else if (MODE == 1) {
            const int h = wgid >> 4, rem = wgid & 15, rt = rem >> 1, pn = rem & 1;
            u.pm = rt; u.pn = pn; u.x0 = h; u.x1 = rt;
            u.aoff = ((long)(TP + 256 * rt) * 3072 + h * 192) * 2; u.boff = ((long)(h * 512 + 256 * pn) * 256) * 2;
        } else if (MODE == 2) {
            const int b = wgid / 36, rem = wgid % 36, pm = rem / 9, pn = rem % 9;
            u.pm = pm; u.pn = pn; u.x0 = b; u.x1 = 0;
            u.aoff = ((long)(b * 1024 + 256 * pm) * QLD) * 2; u.boff = ((long)(b * KPAD + 256 * pn) * QLD) * 2;
        } else if (MODE == 3) {
            const int b = wgid >> 3, pm = (wgid & 7) >> 1, pn = wgid & 1;
            u.pm = pm; u.pn = pn; u.x0 = b; u.x1 = 0;
            u.aoff = ((long)(b * 1024 + 256 * pm) * KPAD) * 2; u.boff = ((long)(b * 512 + 256 * pn) * KPAD) * 2;
        } else {
            const int h = wgid >> 3, rt = wgid & 7;
            u.pm = rt; u.pn = 0; u.x0 = h; u.x1 = rt;
            u.aoff = ((long)(h * 2048 + 256 * rt) * 512) * 2; u.boff = ((long)(h * 256) * 512) * 2;
        }
        return true;
    }
};

template <class Epi, class SchedT, int I8 = 0>
__device__ __forceinline__ void gemm_phase(LAS unsigned char* lds, const Gemm g, const SchedT& S, const Epi& E) {
    const int tid = otid(), wid = __builtin_amdgcn_readfirstlane(tid >> 6), lane = tid & 63, wr = wid >> 2, wc = wid & 3, fr = lane & 15, fq = lane >> 4;
    const int K = g.K, nt = K / BK;
    unsigned voffA[2], voffB[2];
#pragma unroll
    for (int i = 0; i < 2; ++i) { int R, C; stage_rc(tid * 16 + i * 8192, R, C); const int Rb = Epi::PERM ? ((R & ~31) + perm32(R & 31)) : R;
        voffA[i] = (unsigned)(R * g.lda + C) * 2u; voffB[i] = (unsigned)(Rb * g.ldb + C) * 2u; }
    const size_t kstep = (size_t)(BK * 2);
    const size_t hstepA = (size_t)HALF * g.lda * 2, hstepB = (size_t)HALF * g.ldb * 2;
    const unsigned ldsw = (unsigned)wid * 1024u;
    const int aoff = lds_byte(wr * 64 + fr, fq * 8), boff = lds_byte(wc * 32 + fr, fq * 8);
#define PG8_SA(b, h) (((b) * 2 + (h)) * HTB)
#define PG8_SB(b, h) ((4 + (b) * 2 + (h)) * HTB)
#define PG8_STAGE(bufoff, gbase, voff) do { _Pragma("unroll") for (int _i = 0; _i < 2; ++_i) \
        __builtin_amdgcn_global_load_lds((const unsigned*)((const char*)(gbase) + (voff)[_i]), (LAS unsigned*)(lds + (bufoff) + ldsw + _i * 8192), 16, 0, 0); } while (0)
#define PG8_LDA(dst, b, h) do { _Pragma("unroll") for (int m = 0; m < 4; ++m) _Pragma("unroll") for (int k = 0; k < 2; ++k) dst[m][k] = *(const LAS bf16x8*)(lds + PG8_SA(b, h) + aoff + m * 2048 + k * 1024); } while (0)
#define PG8_LDB(dst, b, h) do { _Pragma("unroll") for (int n = 0; n < 2; ++n) _Pragma("unroll") for (int k = 0; k < 2; ++k) dst[n][k] = *(const LAS bf16x8*)(lds + PG8_SB(b, h) + boff + n * 2048 + k * 1024); } while (0)
#define PG8_MMA(ai, bj, At, Bt) do { __builtin_amdgcn_s_setprio(1); _Pragma("unroll") for (int m = 0; m < 4; ++m) _Pragma("unroll") for (int n = 0; n < 2; ++n) _Pragma("unroll") for (int k = 0; k < 2; ++k) \
        { if constexpr (I8) acc[ai][bj][m][n] = __builtin_bit_cast(f32x4, __builtin_amdgcn_mfma_i32_16x16x64_i8(__builtin_bit_cast(i32x4, Bt[n][k]), __builtin_bit_cast(i32x4, At[m][k]), __builtin_bit_cast(i32x4, acc[ai][bj][m][n]), 0, 0, 0)); \
          else acc[ai][bj][m][n] = __builtin_amdgcn_mfma_f32_16x16x32_bf16(Bt[n][k], At[m][k], acc[ai][bj][m][n], 0, 0, 0); } __builtin_amdgcn_s_setprio(0); } while (0)
#define PG8_WAIT_V(n) asm volatile("s_waitcnt vmcnt(" #n ")" ::: "memory")
#define PG8_WAIT_L(n) asm volatile("s_waitcnt lgkmcnt(" #n ")" ::: "memory")
#define PG8_BAR __builtin_amdgcn_s_barrier()
#define PG8_SCHED __builtin_amdgcn_sched_barrier(0)
    Unit cur, nxt; int ui = 0;
    if (!S.next(0, cur)) return;
    f32x4 acc[2][2][4][2];
#pragma unroll
    for (int a = 0; a < 2; ++a)
#pragma unroll
        for (int b = 0; b < 2; ++b)
#pragma unroll
            for (int m = 0; m < 4; ++m)
#pragma unroll
                for (int n = 0; n < 2; ++n) acc[a][b][m][n] = (f32x4){0.f, 0.f, 0.f, 0.f};
    bf16x8 At[4][2], B0[2][2], B1[2][2];
    const char* cA = (const char*)g.A + cur.aoff; const char* cB = (const char*)g.Bt + cur.boff;
    PG8_STAGE(PG8_SB(0, 0), cB, voffB); PG8_STAGE(PG8_SA(0, 0), cA, voffA); PG8_STAGE(PG8_SB(0, 1), cB + hstepB, voffB); PG8_STAGE(PG8_SA(0, 1), cA + hstepA, voffA);
    if (wr == 1) PG8_BAR;
    PG8_WAIT_V(4); PG8_BAR;
    PG8_STAGE(PG8_SB(1, 0), cB + kstep, voffB); PG8_STAGE(PG8_SA(1, 0), cA + kstep, voffA); PG8_STAGE(PG8_SB(1, 1), cB + hstepB + kstep, voffB);
    PG8_WAIT_V(6); PG8_BAR;
    for (;;) {
        const bool has_next = S.next(ui + 1, nxt);
        const char* nA = has_next ? (const char*)g.A + nxt.aoff : cA; const char* nB = has_next ? (const char*)g.Bt + nxt.boff : cB;
        for (int t = 0; t < nt; t += 2) {
            const bool last = (t == nt - 2);
            const char* a1 = cA + (size_t)(t + 1) * kstep;
            const char* a2 = last ? nA : cA + (size_t)(t + 2) * kstep; const char* b2 = last ? nB : cB + (size_t)(t + 2) * kstep;
            const char* a3 = a2 + kstep; const char* b3 = b2 + kstep;
            PG8_LDB(B0, 0, 0); PG8_SCHED; PG8_LDA(At, 0, 0); PG8_STAGE(PG8_SA(1, 1), a1 + hstepA, voffA);
            PG8_WAIT_L(8); PG8_BAR; PG8_WAIT_L(0); PG8_MMA(0, 0, At, B0); PG8_BAR; PG8_SCHED;
            PG8_LDB(B1, 0, 1); PG8_STAGE(PG8_SB(0, 0), b2, voffB);
            PG8_BAR; PG8_WAIT_L(0); PG8_MMA(0, 1, At, B1); PG8_BAR;
            PG8_LDA(At, 0, 1); PG8_STAGE(PG8_SA(0, 0), a2, voffA);
            PG8_BAR; PG8_WAIT_L(0); PG8_MMA(1, 0, At, B0); PG8_BAR; PG8_SCHED;
            PG8_STAGE(PG8_SB(0, 1), b2 + hstepB, voffB);
            PG8_WAIT_V(6); PG8_BAR; PG8_MMA(1, 1, At, B1); PG8_BAR;
            PG8_LDB(B0, 1, 0); PG8_SCHED; PG8_LDA(At, 1, 0); PG8_STAGE(PG8_SA(0, 1), a2 + hstepA, voffA);
            PG8_WAIT_L(8); PG8_BAR; PG8_WAIT_L(0); PG8_MMA(0, 0, At, B0); PG8_BAR; PG8_SCHED;
            PG8_LDB(B1, 1, 1); PG8_STAGE(PG8_SB(1, 0), b3, voffB);
            PG8_BAR; PG8_WAIT_L(0); PG8_MMA(0, 1, At, B1); PG8_BAR;
            PG8_LDA(At, 1, 1); PG8_STAGE(PG8_SA(1, 0), a3, voffA);
            PG8_BAR; PG8_WAIT_L(0); PG8_MMA(1, 0, At, B0); PG8_BAR; PG8_SCHED;
            PG8_STAGE(PG8_SB(1, 1), b3 + hstepB, voffB);
            PG8_WAIT_V(6); PG8_BAR; PG8_MMA(1, 1, At, B1); PG8_BAR;
        }
        if constexpr (I8) {
#pragma unroll
            for (int a = 0; a < 2; ++a)
#pragma unroll
                for (int b = 0; b < 2; ++b)
#pragma unroll
                    for (int m = 0; m < 4; ++m)
#pragma unroll
                        for (int n = 0; n < 2; ++n) { const i32x4 iv = __builtin_bit_cast(i32x4, acc[a][b][m][n]); acc[a][b][m][n] = (f32x4){(float)iv[0], (float)iv[1], (float)iv[2], (float)iv[3]}; } }
        if constexpr (I8 == 2) {
            f32x4 sbv[2][2];
#pragma unroll
            for (int b = 0; b < 2; ++b) { const int c = cur.pn * BM + b * HALF + wc * 32 + (Epi::PERM ? 8 * fq : 4 * fq); sbv[b][0] = *(const f32x4*)(g.sb + c); sbv[b][1] = *(const f32x4*)(g.sb + c + (Epi::PERM ? 4 : 16)); }
#pragma unroll
            for (int a = 0; a < 2; ++a)
#pragma unroll
                for (int m = 0; m < 4; ++m) { const float s_ = g.sa[(long)cur.pm * BM + a * HALF + wr * 64 + m * 16 + fr];
#pragma unroll
                    for (int b = 0; b < 2; ++b) { acc[a][b][m][0] = acc[a][b][m][0] * sbv[b][0] * s_; acc[a][b][m][1] = acc[a][b][m][1] * sbv[b][1] * s_; } } }
        E(acc, cur, wr, wc, fr, fq);
        if (!has_next) break;
#pragma unroll
        for (int a = 0; a < 2; ++a)
#pragma unroll
            for (int b = 0; b < 2; ++b)
#pragma unroll
                for (int m = 0; m < 4; ++m)
#pragma unroll
                    for (int n = 0; n < 2; ++n) acc[a][b][m][n] = (f32x4){0.f, 0.f, 0.f, 0.f};
        cur = nxt; cA = nA; cB = nB; ++ui;
    }
    PG8_WAIT_V(0);
    if (wr == 0) PG8_BAR;
    PG8_BAR;
#undef PG8_SA
#undef PG8_SB
#undef PG8_STAGE
#undef PG8_LDA
#undef PG8_LDB
#undef PG8_MMA
#undef PG8_WAIT_V
#undef PG8_WAIT_L
#undef PG8_BAR
#undef PG8_SCHED
}

struct EpiBf16 {
    static constexpr bool PERM = true;
    bf16_t* O; long ldc; long bstride;
    __device__ __forceinline__ void operator()(const f32x4 (&acc)[2][2][4][2], const Unit& u, int wr, int wc, int fr, int fq) const {
        bf16_t* base = O + (long)u.x0 * bstride + (long)(u.pm * BM + wr * 64 + fr) * ldc + u.pn * BM + wc * 32 + 8 * fq;
#pragma unroll
        for (int ai = 0; ai < 2; ++ai)
#pragma unroll
            for (int m = 0; m < 4; ++m) { bf16_t* rowp = base + (long)(ai * HALF + m * 16) * ldc;
#pragma unroll
                for (int bj = 0; bj < 2; ++bj) { const f32x4 v0 = acc[ai][bj][m][0], v1 = acc[ai][bj][m][1];
                    u32x4 w; w.x = cvt_pk_bf16(v0[0], v0[1]); w.y = cvt_pk_bf16(v0[2], v0[3]); w.z = cvt_pk_bf16(v1[0], v1[1]); w.w = cvt_pk_bf16(v1[2], v1[3]);
                    *(u32x4*)(rowp + bj * HALF) = w; } }
    }
};
template <int RMODE> struct EpiRowMap {
    static constexpr bool PERM = true;
    bf16_t* O; const float* rsum;
    __device__ __forceinline__ void operator()(const f32x4 (&acc)[2][2][4][2], const Unit& u, int wr, int wc, int fr, int fq) const {
        const int col0 = u.pn * BM + wc * 32 + 8 * fq;
#pragma unroll
        for (int ai = 0; ai < 2; ++ai)
#pragma unroll
            for (int m = 0; m < 4; ++m) { const int r = ai * HALF + wr * 64 + m * 16 + fr; long drow; long ldc;
                if (RMODE == 1) { const int ts = 256 * u.x1 + r; drow = (long)(ts >> 6) * 1024 + u.x0 * 64 + (ts & 63); ldc = QLD; }
                float rs = 1.0f;
                if (RMODE == 1) { }
                else { const int qr = 256 * u.pm + r; drow = (long)(qr >> 6) * 2048 + u.x0 * 64 + (qr & 63); ldc = 512; rs = 1.0f / rsum[u.x0 * 1024 + qr]; }
                bf16_t* rowp = O + drow * ldc + col0;
#pragma unroll
                for (int bj = 0; bj < 2; ++bj) { const f32x4 v0 = acc[ai][bj][m][0] * rs, v1 = acc[ai][bj][m][1] * rs;
                    u32x4 w; w.x = cvt_pk_bf16(v0[0], v0[1]); w.y = cvt_pk_bf16(v0[2], v0[3]); w.z = cvt_pk_bf16(v1[0], v1[1]); w.w = cvt_pk_bf16(v1[2], v1[3]);
                    *(u32x4*)(rowp + bj * HALF) = w; } }
    }
};
struct EpiOV {
    static constexpr bool PERM = true;
    bf16_t* O;
    __device__ __forceinline__ void operator()(const f32x4 (&acc)[2][2][4][2], const Unit& u, int wr, int wc, int fr, int fq) const {
#pragma unroll
        for (int ai = 0; ai < 2; ++ai)
#pragma unroll
            for (int m = 0; m < 4; ++m) { const int r = ai * HALF + wr * 64 + m * 16 + fr;
                bf16_t* rowp = O + (long)(TP + 256 * u.x1 + r) * DM + u.x0 * 128 + wc * 32 + 8 * fq;
                const f32x4 v0 = acc[ai][1][m][0], v1 = acc[ai][1][m][1];
                u32x4 w; w.x = cvt_pk_bf16(v0[0], v0[1]); w.y = cvt_pk_bf16(v0[2], v0[3]); w.z = cvt_pk_bf16(v1[0], v1[1]); w.w = cvt_pk_bf16(v1[2], v1[3]);
                *(u32x4*)rowp = w; }
    }
};
struct EpiMix {
    static constexpr bool PERM = true;
    const bf16_t* Y; const bf16_t* YA; bf16_t* MIX; const float* sa; const float* sb;
    __device__ __forceinline__ void operator()(const f32x4 (&acc)[2][2][4][2], const Unit& u, int wr, int wc, int fr, int fq) const {
#pragma unroll
        for (int ai = 0; ai < 2; ++ai)
#pragma unroll
            for (int m = 0; m < 4; ++m) { const long t = (long)u.pm * BM + ai * HALF + wr * 64 + m * 16 + fr; const float s_ = sa[t];
#pragma unroll
                for (int bj = 0; bj < 2; ++bj) { const int c = u.pn * BM + bj * HALF + wc * 32 + 8 * fq;
                    const u32x4 ga = *(const u32x4*)(Y + t * INWP + C_GA + c), gb = *(const u32x4*)(Y + t * INWP + C_GB + c), ya = *(const u32x4*)(YA + t * DM + c);
                    float fa[8], fb[8], fy[8], o[8]; unpack8(ga, fa); unpack8(gb, fb); unpack8(ya, fy);
                    const f32x4 v0 = acc[ai][bj][m][0] * *(const f32x4*)(sb + c) * s_, v1 = acc[ai][bj][m][1] * *(const f32x4*)(sb + c + 4) * s_;
                    const float av[8] = {v0[0], v0[1], v0[2], v0[3], v1[0], v1[1], v1[2], v1[3]};
#pragma unroll
                    for (int j = 0; j < 8; ++j) {
#if defined(DBG_MIX) && DBG_MIX == 1
                        o[j] = sigmoidf_(fb[j]) * av[j];
#elif defined(DBG_MIX) && DBG_MIX == 2
                        o[j] = sigmoidf_(fa[j]) * fy[j];
#else
                        o[j] = sigmoidf_(fa[j]) * fy[j] + sigmoidf_(fb[j]) * av[j];
#endif
                    }
                    *(u32x4*)(MIX + t * DM + c) = pack8(o); } }
    }
};
struct EpiRes {
    static constexpr bool PERM = false;
    float* X; const float* gate;
    const float* XinP; const float* XinS;
    __device__ __forceinline__ void operator()(const f32x4 (&acc)[2][2][4][2], const Unit& u, int wr, int wc, int fr, int fq) const {
#pragma unroll
        for (int ai = 0; ai < 2; ++ai)
#pragma unroll
            for (int m = 0; m < 4; ++m) { const int t = u.pm * BM + ai * HALF + wr * 64 + m * 16 + fr; const float* gr = gate + (long)cond_row(t) * 12288; float* xr = X + (long)t * DM; const float* xi = t < TP ? XinP + (long)t * DM : XinS + (long)(t - TP) * DM;
#pragma unroll
                for (int bj = 0; bj < 2; ++bj)
#pragma unroll
                    for (int n = 0; n < 2; ++n) { const int c = u.pn * BM + bj * HALF + wc * 32 + n * 16 + 4 * fq;
                        const f32x4 gv = *(const f32x4*)(gr + c); const f32x4 xv = *(const f32x4*)(xi + c);
                        *(f32x4*)(xr + c) = xv + gv * acc[ai][bj][m][n]; } }
    }
};

struct EpiQ {
    static constexpr bool PERM = true;
    bf16_t* Q; bf16_t* QL; const float* T64;
    __device__ __forceinline__ void operator()(const f32x4 (&acc)[2][2][4][2], const Unit& u, int wr, int wc, int fr, int fq) const {
        const int grp = u.pn / 3, typ = u.pn - 3 * grp;
        if (typ < 2) {
#pragma unroll
            for (int ai = 0; ai < 2; ++ai)
#pragma unroll
                for (int m = 0; m < 4; ++m) { const long t = (long)u.pm * BM + ai * HALF + wr * 64 + m * 16 + fr;
#pragma unroll
                    for (int bj = 0; bj < 2; ++bj) { const f32x4 v0 = acc[ai][bj][m][0], v1 = acc[ai][bj][m][1];
                        u32x4 w; w.x = cvt_pk_bf16(v0[0], v0[1]); w.y = cvt_pk_bf16(v0[2], v0[3]); w.z = cvt_pk_bf16(v1[0], v1[1]); w.w = cvt_pk_bf16(v1[2], v1[3]);
                        *(u32x4*)(Q + t * 3072 + 768 * grp + 192 * (2 * typ + bj) + wc * 32 + 8 * fq) = w; } }
        } else {
#pragma unroll
            for (int ai = 0; ai < 2; ++ai)
#pragma unroll
                for (int m = 0; m < 4; ++m) { const int t = u.pm * BM + ai * HALF + wr * 64 + m * 16 + fr; const int pos = tok_pos(t);
                    const float* cs = T64 + ((long)pos * 32 + 8 * fq) * 2; float cv[8], sv[8];
#pragma unroll
                    for (int j = 0; j < 4; ++j) { const f32x4 qv = *(const f32x4*)(cs + 4 * j); cv[2 * j] = qv[0]; sv[2 * j] = qv[1]; cv[2 * j + 1] = qv[2]; sv[2 * j + 1] = qv[3]; }
                    const f32x4 a0 = acc[ai][0][m][0], a1 = acc[ai][0][m][1], b0 = acc[ai][1][m][0], b1 = acc[ai][1][m][1];
                    const float x1[8] = {a0[0], a0[1], a0[2], a0[3], a1[0], a1[1], a1[2], a1[3]}, x2[8] = {b0[0], b0[1], b0[2], b0[3], b1[0], b1[1], b1[2], b1[3]};
                    float o1[8], o2[8];
#pragma unroll
                    for (int j = 0; j < 8; ++j) { o1[j] = x1[j] * cv[j] - x2[j] * sv[j]; o2[j] = x1[j] * sv[j] + x2[j] * cv[j]; }
                    const u32x4 w1 = pack8(o1), w2 = pack8(o2); const int hd = 4 * grp + wc;
                    bf16_t* qd = Q + (long)t * 3072 + hd * 192 + 128 + 8 * fq; *(u32x4*)qd = w1; *(u32x4*)(qd + 32) = w2;
                    if (t >= TP) { const int ts = t - TP; bf16_t* d = QL + ((long)(ts >> 6) * 1024 + hd * 64 + (ts & 63)) * QLD + 512 + 8 * fq; *(u32x4*)d = w1; *(u32x4*)(d + 32) = w2; } }
        }
    }
};

struct EpiExp {
    static constexpr bool PERM = true;
    bf16_t* O; float* rsum;
    __device__ __forceinline__ void operator()(const f32x4 (&acc)[2][2][4][2], const Unit& u, int wr, int wc, int fr, int fq) const {
        bf16_t* base = O + (long)u.x0 * 1024 * KPAD + (long)(u.pm * BM + wr * 64 + fr) * KPAD + u.pn * BM + wc * 32 + 8 * fq;
#pragma unroll
        for (int ai = 0; ai < 2; ++ai)
#pragma unroll
            for (int m = 0; m < 4; ++m) { bf16_t* rowp = base + (long)(ai * HALF + m * 16) * KPAD; float part = 0.f;
#pragma unroll
                for (int bj = 0; bj < 2; ++bj) { const int c0 = u.pn * BM + bj * HALF + wc * 32 + 8 * fq; const f32x4 v0 = acc[ai][bj][m][0], v1 = acc[ai][bj][m][1];
                    const float sv[8] = {v0[0], v0[1], v0[2], v0[3], v1[0], v1[1], v1[2], v1[3]}; float e[8];
#pragma unroll
                    for (int j = 0; j < 8; ++j) { e[j] = (c0 + j < KALL) ? __expf(fminf(sv[j] * MLA_SCALE, 60.f)) : 0.f; part += e[j]; }
                    *(u32x4*)(rowp + bj * HALF) = pack8(e); }
                part += sx<16>(part); part += sx<32>(part);
                if (fq == 0) atomicAdd(rsum + u.x0 * 1024 + u.pm * BM + ai * HALF + wr * 64 + m * 16 + fr, part); }
    }
};

struct EpiQ8 {
    static constexpr bool PERM = true;
    bf16_t* O; long ldc; const float* sa; const float* sb;
    __device__ __forceinline__ void operator()(const f32x4 (&acc)[2][2][4][2], const Unit& u, int wr, int wc, int fr, int fq) const {
        f32x4 sbv[2][2];
#pragma unroll
        for (int bj = 0; bj < 2; ++bj) { const int c = u.pn * BM + bj * HALF + wc * 32 + 8 * fq; sbv[bj][0] = *(const f32x4*)(sb + c); sbv[bj][1] = *(const f32x4*)(sb + c + 4); }
#pragma unroll
        for (int ai = 0; ai < 2; ++ai)
#pragma unroll
            for (int m = 0; m < 4; ++m) { const long t = (long)u.pm * BM + ai * HALF + wr * 64 + m * 16 + fr; const float s = sa[t];
#pragma unroll
                for (int bj = 0; bj < 2; ++bj) { const f32x4 v0 = acc[ai][bj][m][0] * sbv[bj][0] * s, v1 = acc[ai][bj][m][1] * sbv[bj][1] * s;
                    u32x4 w; w.x = cvt_pk_bf16(v0[0], v0[1]); w.y = cvt_pk_bf16(v0[2], v0[3]); w.z = cvt_pk_bf16(v1[0], v1[1]); w.w = cvt_pk_bf16(v1[2], v1[3]);
                    *(u32x4*)(O + t * ldc + u.pn * BM + bj * HALF + wc * 32 + 8 * fq) = w; } }
    }
};
}
namespace att {
constexpr int NW = 8, QBLK = 32, KVBLK = 64;
constexpr float SCALE = MLA_SCALE;
constexpr float THR = 8.f;
constexpr int KROW = 384;
constexpr int SHM_V = KVBLK * 128 * 2, SHM_K = KVBLK * KROW;
constexpr int QR_PITCH = 144, SHM_QR = 256 * QR_PITCH;
constexpr int SHM_ATTN = 2 * SHM_V + 2 * SHM_K + NW * 64 * 4 + SHM_QR;
#define KSWZ(row, colB) ((row) * att::KROW + ((colB) ^ (((row) & 7) << 4)))
#define SBAR() __builtin_amdgcn_sched_barrier(0)
__device__ __forceinline__ int crow(int r, int hi) { return (r & 3) + 8 * (r >> 2) + 4 * hi; }

__device__ __forceinline__ void partialSM(f32x16& p0, f32x16& p1, float& m_reg, float& mn, float& alpha) {
  constexpr float C = SCALE * 1.4426950408889634f;
  float pmax = p0[0];
#pragma unroll
  for (int r = 1; r < 16; ++r) pmax = fmaxf(pmax, p0[r]);
#pragma unroll
  for (int r = 0; r < 16; ++r) pmax = fmaxf(pmax, p1[r]);
  { auto rr = __builtin_amdgcn_permlane32_swap(__float_as_uint(pmax), __float_as_uint(pmax), false, false);
    pmax = fmaxf(__uint_as_float(rr[0]), __uint_as_float(rr[1])); }
  if (__builtin_expect(__all(pmax - m_reg <= THR / SCALE), 1)) { mn = m_reg; alpha = 1.f; }
  else { mn = fmaxf(m_reg, pmax); alpha = __builtin_amdgcn_exp2f((m_reg - mn) * C); m_reg = mn; }
  float mnC = -mn * C;
#pragma unroll
  for (int r = 0; r < 16; ++r) p0[r] = fmaf(p0[r], C, mnC);
#pragma unroll
  for (int r = 0; r < 16; ++r) p1[r] = fmaf(p1[r], C, mnC);
#pragma unroll
  for (int r = 0; r < 16; ++r) p0[r] = __builtin_amdgcn_exp2f(p0[r]);
}
__device__ __forceinline__ void finishSM(f32x16& p0, f32x16& p1, float alpha, float& l_reg, bf16x8& pa0, bf16x8& pa1, bf16x8& pa2, bf16x8& pa3) {
#pragma unroll
  for (int r = 0; r < 16; ++r) p1[r] = __builtin_amdgcn_exp2f(p1[r]);
  float ps = 0;
#pragma unroll
  for (int r = 0; r < 16; ++r) ps += p0[r];
#pragma unroll
  for (int r = 0; r < 16; ++r) ps += p1[r];
  { auto rr = __builtin_amdgcn_permlane32_swap(__float_as_uint(ps), __float_as_uint(ps), false, false);
    ps = __uint_as_float(rr[0]) + __uint_as_float(rr[1]); }
  l_reg = l_reg * alpha + ps;
#define PK4(P, BASE, OUT) do { unsigned a0 = cvt_pk_bf16(P[BASE + 0], P[BASE + 1]), a1 = cvt_pk_bf16(P[BASE + 2], P[BASE + 3]);   \
    unsigned b0 = cvt_pk_bf16(P[BASE + 4], P[BASE + 5]), b1 = cvt_pk_bf16(P[BASE + 6], P[BASE + 7]);                              \
    auto r0 = __builtin_amdgcn_permlane32_swap(a0, b0, false, false); auto r1 = __builtin_amdgcn_permlane32_swap(a1, b1, false, false); \
    u32x4 w = {r0[0], r1[0], r0[1], r1[1]}; OUT = *reinterpret_cast<bf16x8*>(&w); } while (0)
  PK4(p0, 0, pa0); PK4(p0, 8, pa1); PK4(p1, 0, pa2); PK4(p1, 8, pa3);
#undef PK4
}
__device__ __forceinline__ void qkt(f32x16& p0, f32x16& p1, const char* Ks, const bf16x8* qr, const char* qrope, const int (&kbase)[4], bool vis) {
  p0 = f32x16{}; p1 = f32x16{};
  if (vis) {
#pragma unroll
  for (int d0 = 0; d0 < 12; ++d0) {
    bf16x8 b0 = *reinterpret_cast<const bf16x8*>(Ks + kbase[d0 & 3] + (d0 >> 2) * 128);
    bf16x8 b1 = *reinterpret_cast<const bf16x8*>(Ks + kbase[d0 & 3] + (d0 >> 2) * 128 + 32 * KROW);
    const bf16x8 qv = d0 < 8 ? qr[d0 < 8 ? d0 : 0] : *reinterpret_cast<const bf16x8*>(qrope + (d0 - 8) * 32);
    p0 = __builtin_amdgcn_mfma_f32_32x32x16_bf16(b0, qv, p0, 0, 0, 0);
    p1 = __builtin_amdgcn_mfma_f32_32x32x16_bf16(b1, qv, p1, 0, 0, 0); }
  }
  if (!vis) {
#pragma unroll
    for (int r = 0; r < 16; ++r) { p0[r] = -1e30f; p1[r] = -1e30f; } }
}
__device__ __forceinline__ int v_st(int k, int c) { const int kk = (k & ~0xC) | ((k & 4) << 1) | ((k & 8) >> 1); return ((kk >> 3) * 4 + (c >> 5)) * 512 + ((kk & 7) * 32 + (c & 31)) * 2; }
__device__ __forceinline__ int v_rd_base(int lane) { return ((lane & 3) << 3) | (((lane >> 2) & 3) << 6) | (((lane >> 4) & 1) << 5) | (((lane >> 5) & 1) << 8); }
constexpr int v_rd_off(int d0, int ks, int half) { return d0 * 512 + ks * 4096 + half * 2048; }
template <int OFF> __device__ __forceinline__ s16x4 tr_read(int vb) {
  s16x4 r; asm volatile("ds_read_b64_tr_b16 %0, %1 offset:%2" : "=&v"(r) : "v"(vb), "i"(OFF) : "memory"); return r;
}
template <int D0> __device__ __forceinline__ void pv_one(f32x16& od, int vb, bf16x8 pa0, bf16x8 pa1, bf16x8 pa2, bf16x8 pa3) {
  const s16x4 l0 = tr_read<v_rd_off(D0, 0, 0)>(vb), h0 = tr_read<v_rd_off(D0, 0, 1)>(vb), l1 = tr_read<v_rd_off(D0, 1, 0)>(vb), h1 = tr_read<v_rd_off(D0, 1, 1)>(vb);
  const s16x4 l2 = tr_read<v_rd_off(D0, 2, 0)>(vb), h2 = tr_read<v_rd_off(D0, 2, 1)>(vb), l3 = tr_read<v_rd_off(D0, 3, 0)>(vb), h3 = tr_read<v_rd_off(D0, 3, 1)>(vb);
  asm volatile("s_waitcnt lgkmcnt(0)" ::: "memory"); SBAR();
#define PK(L, H) (bf16x8){L[0], L[1], L[2], L[3], H[0], H[1], H[2], H[3]}
  od = __builtin_amdgcn_mfma_f32_32x32x16_bf16(pa0, PK(l0, h0), od, 0, 0, 0);
  od = __builtin_amdgcn_mfma_f32_32x32x16_bf16(pa1, PK(l1, h1), od, 0, 0, 0);
  od = __builtin_amdgcn_mfma_f32_32x32x16_bf16(pa2, PK(l2, h2), od, 0, 0, 0);
  od = __builtin_amdgcn_mfma_f32_32x32x16_bf16(pa3, PK(l3, h3), od, 0, 0, 0);
#undef PK
}
__device__ __forceinline__ void pv_d0(f32x16* o, int vb, bf16x8 pa0, bf16x8 pa1, bf16x8 pa2, bf16x8 pa3) {
  pv_one<0>(o[0], vb, pa0, pa1, pa2, pa3); pv_one<1>(o[1], vb, pa0, pa1, pa2, pa3); pv_one<2>(o[2], vb, pa0, pa1, pa2, pa3); pv_one<3>(o[3], vb, pa0, pa1, pa2, pa3);
}

__device__ __forceinline__ void attn_block(const bf16_t* __restrict__ Qb, const bf16_t* __restrict__ Kn, const bf16_t* __restrict__ Kr, const bf16_t* __restrict__ Vh,
                                           bf16_t* __restrict__ Ob, int qb, char* lds) {
  constexpr int LDQ = 3072, LDK = 4096, LDR = 64, LDO = 2048;
  const int tid = otid(), wid = tid >> 6, lane = tid & 63, r32 = lane & 31, hi = lane >> 5;
  char* V_lds = lds; char* K_lds = lds + 2 * SHM_V;
  float* ws = (float*)(lds + 2 * SHM_V + 2 * SHM_K) + wid * 64; float* li_l = ws; float* al_l = ws + 32;
  float m_reg = -1e30f, l_reg = 0; f32x16 o[4] = {}; bf16x8 qr[8];
  const bf16_t* Qw = Qb + (long)(wid * QBLK + r32) * LDQ + hi * 8;
#pragma unroll
  for (int d0 = 0; d0 < 8; ++d0) qr[d0] = *reinterpret_cast<const bf16x8*>(Qw + d0 * 16);
  char* qrope = lds + 2 * SHM_V + 2 * SHM_K + NW * 64 * 4 + (wid * QBLK + r32) * QR_PITCH + hi * 16;
#pragma unroll
  for (int d0 = 8; d0 < 12; ++d0) *reinterpret_cast<bf16x8*>(qrope + (d0 - 8) * 32) = *reinterpret_cast<const bf16x8*>(Qw + d0 * 16);
  asm volatile("s_waitcnt lgkmcnt(0)" ::: "memory");
  const int NT = 4 * qb + 4, jmax = 4 * qb + (wid >> 1);
  int kbase[4];
#pragma unroll
  for (int dl = 0; dl < 4; ++dl) kbase[dl] = r32 * KROW + (((dl << 5) | (hi << 4)) ^ ((r32 & 7) << 4));
  const int sr = tid >> 4, sc = (tid & 15) * 8, vst0 = v_st(sr, sc), vst1 = v_st(32 + sr, sc);
  const int rr = tid >> 3, rc = (tid & 7) * 8;
  const int vb0 = (int)(uintptr_t)V_lds + v_rd_base(lane);
  bf16x8 vs0, vs1, ks0, ks1, kr0;
#define SLOAD(k0) do { vs0 = *reinterpret_cast<const bf16x8*>(&Vh[(long)((k0) + sr) * LDK + sc]); vs1 = *reinterpret_cast<const bf16x8*>(&Vh[(long)((k0) + 32 + sr) * LDK + sc]); \
    ks0 = *reinterpret_cast<const bf16x8*>(&Kn[(long)((k0) + sr) * LDK + sc]); ks1 = *reinterpret_cast<const bf16x8*>(&Kn[(long)((k0) + 32 + sr) * LDK + sc]); \
    kr0 = *reinterpret_cast<const bf16x8*>(&Kr[(long)((k0) + rr) * LDR + rc]); } while (0)
#define SWRITE(b) do { *(bf16x8*)(V_lds + (b) * SHM_V + vst0) = vs0; *(bf16x8*)(V_lds + (b) * SHM_V + vst1) = vs1; int kc = sc * 2; \
    *(bf16x8*)(K_lds + (b) * SHM_K + KSWZ(sr, kc)) = ks0; *(bf16x8*)(K_lds + (b) * SHM_K + KSWZ(32 + sr, kc)) = ks1; \
    *(bf16x8*)(K_lds + (b) * SHM_K + KSWZ(rr, 256 + rc * 2)) = kr0; } while (0)
#define SWAIT() asm volatile("s_waitcnt vmcnt(0)" ::: "memory")
#define RESC(a) do { if (__any((a) < 1.f)) { if (hi == 0) al_l[r32] = (a); asm volatile("s_waitcnt lgkmcnt(0)" ::: "memory"); \
    _Pragma("unroll") for (int d = 0; d < 4; ++d) _Pragma("unroll") for (int r = 0; r < 16; ++r) o[d][r] *= al_l[crow(r, hi)]; } } while (0)
  f32x16 pA0, pA1, pB0, pB1; float mnA, mnB, alA, alB; bf16x8 pa0, pa1, pa2, pa3;
  SLOAD(0); SWAIT(); SWRITE(0); __syncthreads();
  qkt(pA0, pA1, K_lds, qr, qrope, kbase, true); partialSM(pA0, pA1, m_reg, mnA, alA);
  SLOAD(KVBLK);
  SWAIT(); SWRITE(1); __syncthreads();
  for (int j = 1; j + 1 < NT; j += 2) {
    SBAR(); qkt(pB0, pB1, K_lds + SHM_K, qr, qrope, kbase, j <= jmax);
    finishSM(pA0, pA1, alA, l_reg, pa0, pa1, pa2, pa3); SBAR();
    SLOAD((j + 1) * KVBLK); SBAR();
    if (j - 1 <= jmax) pv_d0(o, vb0, pa0, pa1, pa2, pa3);
    partialSM(pB0, pB1, m_reg, mnB, alB);
    __syncthreads(); SWAIT(); SWRITE(0);
    RESC(alB); __syncthreads();
    SBAR(); qkt(pA0, pA1, K_lds, qr, qrope, kbase, j + 1 <= jmax);
    finishSM(pB0, pB1, alB, l_reg, pa0, pa1, pa2, pa3); SBAR();
    SLOAD((j + 2) * KVBLK); SBAR();
    if (j <= jmax) pv_d0(o, vb0 + (int)SHM_V, pa0, pa1, pa2, pa3);
    partialSM(pA0, pA1, m_reg, mnA, alA);
    __syncthreads(); SWAIT(); SWRITE(1);
    RESC(alA); __syncthreads();
  }
  SBAR(); qkt(pB0, pB1, K_lds + SHM_K, qr, qrope, kbase, NT - 1 <= jmax);
  finishSM(pA0, pA1, alA, l_reg, pa0, pa1, pa2, pa3); SBAR();
  if (NT - 2 <= jmax) pv_d0(o, vb0, pa0, pa1, pa2, pa3);
  partialSM(pB0, pB1, m_reg, mnB, alB);
  __syncthreads(); RESC(alB);
  finishSM(pB0, pB1, alB, l_reg, pa0, pa1, pa2, pa3); SBAR();
  if (NT - 1 <= jmax) pv_d0(o, vb0 + (int)SHM_V, pa0, pa1, pa2, pa3);
  if (hi == 0) li_l[r32] = l_reg; asm volatile("s_waitcnt lgkmcnt(0)" ::: "memory");
  float rli[16];
#pragma unroll
  for (int r = 0; r < 16; ++r) rli[r] = __builtin_amdgcn_rcpf(li_l[crow(r, hi)]);
  bf16_t* Ow = Ob + (long)(wid * QBLK) * LDO;
#pragma unroll
  for (int r = 0; r < 16; ++r) { int orow = crow(r, hi);
#pragma unroll
    for (int d0 = 0; d0 < 4; ++d0) Ow[(long)orow * LDO + d0 * 32 + r32] = f2bf(o[d0][r] * rli[r]); }
  __syncthreads();
#undef SLOAD
#undef SWRITE
#undef SWAIT
#undef RESC
}
}
namespace ret {
constexpr int QP_ = 136;
__device__ __forceinline__ bf16x8 ldfrag(const bf16_t* p) { return *reinterpret_cast<const bf16x8*>(p); }
template <int CL> struct Lay {
    static constexpr int IP = CL + 8;
    static constexpr int QS = 0, KS = QS + CL * QP_ * 2, VT = KS + CL * QP_ * 2, VDT = VT + 32 * IP * 2, IN = VDT + 32 * IP * 2, ST = IN + CL * IP * 2, VS = ST + 32 * QP_ * 2, END = VS + CL * 40 * 2;
};
static_assert(Lay<128>::END <= LDS_BARW, "retention LDS");

template <int CL>
__device__ __forceinline__ void run(const bf16_t* __restrict__ Y, bf16_t* __restrict__ OB, const float* __restrict__ sp, float* __restrict__ so, long tok0, int nch, int h, int es, float lg, char* lds, int tid) {
    using L = Lay<CL>; constexpr int IP = L::IP, NQT = CL / 16, NKS = CL / 32, NPC = CL / 32;
    const int wid = __builtin_amdgcn_readfirstlane(tid >> 6), lane = tid & 63, l15 = lane & 15, l4 = lane >> 4;
    bf16_t* Qs = (bf16_t*)(lds + L::QS); bf16_t* Ks = (bf16_t*)(lds + L::KS); bf16_t* Vt = (bf16_t*)(lds + L::VT); bf16_t* Vdt = (bf16_t*)(lds + L::VDT); bf16_t* In = (bf16_t*)(lds + L::IN); bf16_t* St = (bf16_t*)(lds + L::ST); bf16_t* Vs = (bf16_t*)(lds + L::VS);
    const float gCL = __expf((float)CL * lg);
    f32x4 Sacc[2];
    if (sp) {
#pragma unroll
        for (int ej = 0; ej < 2; ++ej)
#pragma unroll
            for (int r = 0; r < 4; ++r) Sacc[ej][r] = sp[(long)(16 * wid + 4 * l4 + r) * RV + 16 * ej + l15];
    } else { Sacc[0] = (f32x4){0.f, 0.f, 0.f, 0.f}; Sacc[1] = (f32x4){0.f, 0.f, 0.f, 0.f}; }
    for (int i = tid; i < CL * IP / 8; i += 512) reinterpret_cast<u32x4*>(In)[i] = (u32x4){0u, 0u, 0u, 0u};
    u32x4 pq[NPC], pk[NPC], pv;
    const int vk = tid >> 2, ve0 = (tid & 3) * 8;
#define RET_LOAD(cc) do { const bf16_t* yrow_ = Y + (tok0 + (long)(cc) * CL) * INWP; \
        _Pragma("unroll") for (int i = 0; i < NPC; ++i) { const int idx = tid + i * 512, k = idx >> 4, d0 = (idx & 15) * 8; \
            pq[i] = *reinterpret_cast<const u32x4*>(yrow_ + (long)k * INWP + C_RQ + h * 128 + d0); pk[i] = *reinterpret_cast<const u32x4*>(yrow_ + (long)k * INWP + C_RK + h * 128 + d0); } \
        if (tid < 4 * CL) pv = *reinterpret_cast<const u32x4*>(yrow_ + (long)vk * INWP + C_RV + h * 256 + es * 32 + ve0); } while (0)
    RET_LOAD(0);
    for (int c = 0; c < nch; ++c) {
#pragma unroll
        for (int ej = 0; ej < 2; ++ej) { u32x2 w; w.x = cvt_pk_bf16(Sacc[ej][0], Sacc[ej][1]); w.y = cvt_pk_bf16(Sacc[ej][2], Sacc[ej][3]);
            *reinterpret_cast<u32x2*>(St + (16 * ej + l15) * QP_ + 16 * wid + 4 * l4) = w; }
#pragma unroll
        for (int i = 0; i < NPC; ++i) { const int idx = tid + i * 512, k = idx >> 4, d0 = (idx & 15) * 8;
            *reinterpret_cast<u32x4*>(Qs + k * QP_ + d0) = pq[i]; *reinterpret_cast<u32x4*>(Ks + k * QP_ + d0) = pk[i]; }
        if (tid < 4 * CL) *reinterpret_cast<u32x4*>(Vs + vk * 40 + ve0) = pv;
        if (c + 1 < nch) RET_LOAD(c + 1);
        __syncthreads();
        if (tid < 4 * CL) { const int e = tid & 31, kg = tid >> 5; float f[8], fd[8];
#pragma unroll
            for (int j = 0; j < 8; ++j) { f[j] = bf2f(Vs[(8 * kg + j) * 40 + e]); fd[j] = f[j] * __expf((float)(CL - 1 - 8 * kg - j) * lg); }
            *reinterpret_cast<u32x4*>(Vt + e * IP + 8 * kg) = pack8(f); *reinterpret_cast<u32x4*>(Vdt + e * IP + 8 * kg) = pack8(fd); }
#pragma unroll
        for (int it_ = 0; it_ < (NQT * (NQT + 1) / 2 + 7) / 8; ++it_) { const int idx = wid + 8 * it_; if (idx >= NQT * (NQT + 1) / 2) break;
            int qi = 0; while ((qi + 1) * (qi + 2) / 2 <= idx) ++qi; const int kj = idx - qi * (qi + 1) / 2;
            f32x4 a = (f32x4){0.f, 0.f, 0.f, 0.f}; const bf16_t* qp = Qs + (16 * qi + l15) * QP_ + 8 * l4; const bf16_t* kp = Ks + (16 * kj + l15) * QP_ + 8 * l4;
#pragma unroll
            for (int ks = 0; ks < 4; ++ks) a = __builtin_amdgcn_mfma_f32_16x16x32_bf16(ldfrag(qp + 32 * ks), ldfrag(kp + 32 * ks), a, 0, 0, 0);
            const int q0 = 16 * qi + 4 * l4, k = 16 * kj + l15;
#pragma unroll
            for (int r = 0; r < 4; ++r) { const int q = q0 + r; const float dm = (q >= k) ? __expf((float)(q - k) * lg) : 0.f;
                In[q * IP + k] = f2bf(a[r] * dm); } }
        __syncthreads();
#pragma unroll
        for (int ot = 0; ot < (2 * NQT) / 8; ++ot) { const int tI = wid + 8 * ot, qi = tI >> 1, ej = tI & 1; f32x4 a = (f32x4){0.f, 0.f, 0.f, 0.f};
#pragma unroll
            for (int ks = 0; ks < 4; ++ks) a = __builtin_amdgcn_mfma_f32_16x16x32_bf16(ldfrag(Qs + (16 * qi + l15) * QP_ + 32 * ks + 8 * l4), ldfrag(St + (16 * ej + l15) * QP_ + 32 * ks + 8 * l4), a, 0, 0, 0);
#pragma unroll
            for (int r = 0; r < 4; ++r) a[r] *= __expf((float)(16 * qi + 4 * l4 + r + 1) * lg);
#pragma unroll
            for (int ks = 0; ks < NKS; ++ks) if (ks <= (qi >> 1)) a = __builtin_amdgcn_mfma_f32_16x16x32_bf16(ldfrag(In + (16 * qi + l15) * IP + 32 * ks + 8 * l4), ldfrag(Vt + (16 * ej + l15) * IP + 32 * ks + 8 * l4), a, 0, 0, 0);
            bf16_t* op = OB + ((long)(h * 8 + es) * T + tok0 + (long)c * CL + 16 * qi + 4 * l4) * 32 + 16 * ej + l15;
#pragma unroll
            for (int r = 0; r < 4; ++r) op[r * 32] = f2bf(a[r]); }
        { f32x4 s0 = Sacc[0] * gCL, s1 = Sacc[1] * gCL;
#pragma unroll
          for (int ks = 0; ks < NKS; ++ks) { bf16x8 af;
#pragma unroll
              for (int j = 0; j < 8; ++j) af[j] = (short)Ks[(32 * ks + 8 * l4 + j) * QP_ + 16 * wid + l15];
              s0 = __builtin_amdgcn_mfma_f32_16x16x32_bf16(af, ldfrag(Vdt + l15 * IP + 32 * ks + 8 * l4), s0, 0, 0, 0);
              s1 = __builtin_amdgcn_mfma_f32_16x16x32_bf16(af, ldfrag(Vdt + (16 + l15) * IP + 32 * ks + 8 * l4), s1, 0, 0, 0); }
          Sacc[0] = s0; Sacc[1] = s1; }
        __syncthreads();
    }
#undef RET_LOAD
#pragma unroll
    for (int ej = 0; ej < 2; ++ej)
#pragma unroll
        for (int r = 0; r < 4; ++r) so[(long)(16 * wid + 4 * l4 + r) * RV + 16 * ej + l15] = Sacc[ej][r];
}

__device__ __forceinline__ void unit(KParams& p, int l, int u, char* lds) {
    const int tid = otid(); unsigned char* ws = optr(gp(p.ws)); const bf16_t* Y = (const bf16_t*)(ws + WS_Y); bf16_t* OB = (bf16_t*)(ws + WS_OB);
    const bool samp = u >= 256; const int v = samp ? u - 256 : u; const int b = v >> 6, h = (v >> 3) & 7, es = v & 7; const float lg = p.lg[h];
    if (samp) run<64>(Y, OB, gp(p.state_ret) + ((((long)l * DB + b) * RH + h) * RQK) * RV + es * 32, gp(p.out) + O_RETS + ((((long)l * DB + b) * RH + h) * RQK) * RV + es * 32, (long)TP + b * 64, 1, h, es, lg, lds, tid);
    else run<64>(Y, OB, nullptr, gp(p.out) + O_RETP + ((((long)l * NB + b) * RH + h) * RQK) * RV + es * 32, (long)b * SEQ, SEQ / 64, h, es, lg, lds, tid);
}
}
namespace peer {
__device__ __forceinline__ void ins16(float (&l)[16], float x) {
#pragma unroll
    for (int j = 0; j < 16; ++j) { const float hi = fmaxf(l[j], x); x = fminf(l[j], x); l[j] = hi; }
}
#define CE_DESC(a, b) do { const float hi_ = fmaxf(a, b), lo_ = fminf(a, b); a = hi_; b = lo_; } while (0)
#define CE_ASC(a, b) do { const float hi_ = fmaxf(a, b), lo_ = fminf(a, b); a = lo_; b = hi_; } while (0)
__device__ __forceinline__ void sort16_desc(float (&v)[16]) {
#pragma unroll
    for (int k = 2; k <= 16; k <<= 1)
#pragma unroll
        for (int j = k >> 1; j >= 1; j >>= 1)
#pragma unroll
            for (int i = 0; i < 16; ++i) { const int l = i ^ j; if (l > i) { if ((i & k) == 0) CE_DESC(v[i], v[l]); else CE_ASC(v[i], v[l]); } }
}
__device__ __forceinline__ void merge16_desc(float (&l)[16], const float (&o)[16]) {
#pragma unroll
    for (int i = 0; i < 16; ++i) l[i] = fmaxf(l[i], o[15 - i]);
#pragma unroll
    for (int j = 8; j >= 1; j >>= 1)
#pragma unroll
        for (int i = 0; i < 16; ++i) { const int m = i ^ j; if (m > i) CE_DESC(l[i], l[m]); }
}
constexpr int KPITCH = 136;
__device__ __forceinline__ void half_top16(const bf16_t* __restrict__ qrow, const bf16_t* __restrict__ keys, int lane, float (&l)[16]) {
    const int r32 = lane & 31, g = lane >> 5;
#pragma unroll
    for (int j = 0; j < 16; ++j) l[j] = -3.0e38f;
    bf16x8 qf[8];
#pragma unroll
    for (int ks = 0; ks < 8; ++ks) qf[ks] = *reinterpret_cast<const bf16x8*>(qrow + 16 * ks + 8 * g);
#pragma unroll 1
    for (int kb = 0; kb < 4; ++kb) { f32x16 a = f32x16{};
#pragma unroll
        for (int ks = 0; ks < 8; ++ks) { const bf16x8 kf = *reinterpret_cast<const bf16x8*>(keys + (32 * kb + r32) * KPITCH + 16 * ks + 8 * g);
            a = __builtin_amdgcn_mfma_f32_32x32x16_bf16(kf, qf[ks], a, 0, 0, 0); }
        float blk[16];
#pragma unroll
        for (int r = 0; r < 16; ++r) { const unsigned key = (unsigned)(32 * kb + (r & 3) + 8 * (r >> 2) + 4 * g);
            blk[r] = __uint_as_float((__float_as_uint(a[r]) & ~0x7Fu) | key); }
        sort16_desc(blk); merge16_desc(l, blk); }
}
__device__ __forceinline__ void merge_lists(float (&l)[16], const float (&o)[16]) { merge16_desc(l, o); }
__device__ __forceinline__ void select_unit(const bf16_t* __restrict__ QP, const bf16_t* __restrict__ k1, const bf16_t* __restrict__ k2, int* __restrict__ PIDX, float* __restrict__ PW,
                                            int t0, int h, int lane, float* lds_lane  ) {
    const int r32 = lane & 31, g = lane >> 5;
    const bf16_t* qrow = QP + (long)(t0 + r32) * DM + h * 256;
    float la[16], lb[16];
    half_top16(qrow, k1, lane, la);
    half_top16(qrow + 128, k2, lane, lb);
    float m0[16], m1[16];
#pragma unroll
    for (int j = 0; j < 16; ++j) { auto rr = __builtin_amdgcn_permlane32_swap(__float_as_uint(la[j]), __float_as_uint(lb[j]), false, false); m0[j] = __uint_as_float(rr[0]); m1[j] = __uint_as_float(rr[1]); }
    merge_lists(m0, m1);
    float L1[16], L2[16];
#pragma unroll
    for (int j = 0; j < 16; ++j) { auto rr = __builtin_amdgcn_permlane32_swap(__float_as_uint(m0[j]), __float_as_uint(m0[j]), false, false);
        L1[j] = __uint_as_float(rr[0]); L2[j] = __uint_as_float(rr[1]); }
#define CAND(i, j) __uint_as_float((__float_as_uint(L1[i] + L2[j]) & ~0xFFu) | (unsigned)((i) * 16 + (j)))
    float best[16], c2[16], c3[16];
#pragma unroll
    for (int j = 0; j < 16; ++j) best[j] = CAND(0, j);
    sort16_desc(best);
    c2[0] = CAND(1, 0); c2[1] = CAND(1, 1); c2[2] = CAND(1, 2); c2[3] = CAND(1, 3); c2[4] = CAND(1, 4); c2[5] = CAND(1, 5); c2[6] = CAND(1, 6); c2[7] = CAND(1, 7);
    c2[8] = CAND(2, 0); c2[9] = CAND(2, 1); c2[10] = CAND(2, 2); c2[11] = CAND(2, 3); c2[12] = CAND(2, 4); c2[13] = CAND(4, 0); c2[14] = CAND(4, 1); c2[15] = CAND(4, 2);
    sort16_desc(c2); merge16_desc(best, c2);
    c3[0] = CAND(3, 0); c3[1] = CAND(3, 1); c3[2] = CAND(3, 2); c3[3] = CAND(3, 3); c3[4] = CAND(5, 0); c3[5] = CAND(5, 1); c3[6] = CAND(6, 0); c3[7] = CAND(6, 1);
    c3[8] = CAND(7, 0); c3[9] = CAND(7, 1); c3[10] = CAND(8, 0); c3[11] = CAND(9, 0); c3[12] = CAND(10, 0); c3[13] = CAND(11, 0); c3[14] = CAND(12, 0); c3[15] = CAND(13, 0);
    sort16_desc(c3); merge16_desc(best, c3);
    ins16(best, CAND(14, 0)); ins16(best, CAND(15, 0));
#undef CAND
#pragma unroll
    for (int j = 0; j < 16; ++j) { lds_lane[j] = __uint_as_float(__float_as_uint(L1[j]) & 0x7Fu); lds_lane[16 + j] = __uint_as_float(__float_as_uint(L2[j]) & 0x7Fu); }
    asm volatile("s_waitcnt lgkmcnt(0)" ::: "memory");
    float wsum = 0.f, w[16]; int ei[16];
    const float mx = best[0];
#pragma unroll
    for (int k = 0; k < 16; ++k) { const unsigned code = __float_as_uint(best[k]) & 0xFFu; const int i = (int)(code >> 4), j = (int)(code & 15u);
        const int i1 = (int)__float_as_uint(lds_lane[i]), i2 = (int)__float_as_uint(lds_lane[16 + j]); ei[k] = i1 * NKEYS + i2;
        w[k] = __expf(best[k] - mx); wsum += w[k]; }
    const float inv = 1.0f / wsum;
    if (g == 0) { int* ip = PIDX + (long)(t0 + r32) * 128 + h * 16; float* wp = PW + (long)(t0 + r32) * 128 + h * 16;
#pragma unroll
        for (int k = 0; k < 16; k += 4) { *reinterpret_cast<int4*>(ip + k) = make_int4(ei[k], ei[k + 1], ei[k + 2], ei[k + 3]);
            *reinterpret_cast<float4*>(wp + k) = make_float4(w[k] * inv, w[k + 1] * inv, w[k + 2] * inv, w[k + 3] * inv); } }
}

__device__ __forceinline__ float gelu_exact(float x) { return 0.5f * x * (1.0f + erff(x * 0.70710678118654752f)); }

__device__ __forceinline__ void dec16(const u32x4 w, f32x2 (&f)[8]) {
    f[0] = __builtin_amdgcn_cvt_pk_f32_fp8((int)w.x, false); f[1] = __builtin_amdgcn_cvt_pk_f32_fp8((int)w.x, true);
    f[2] = __builtin_amdgcn_cvt_pk_f32_fp8((int)w.y, false); f[3] = __builtin_amdgcn_cvt_pk_f32_fp8((int)w.y, true);
    f[4] = __builtin_amdgcn_cvt_pk_f32_fp8((int)w.z, false); f[5] = __builtin_amdgcn_cvt_pk_f32_fp8((int)w.z, true);
    f[6] = __builtin_amdgcn_cvt_pk_f32_fp8((int)w.w, false); f[7] = __builtin_amdgcn_cvt_pk_f32_fp8((int)w.w, true);
}
__device__ __forceinline__ void gather_token(const bf16_t* __restrict__ H, const unsigned char* __restrict__ PU, const unsigned char* __restrict__ PV, const float* __restrict__ SU, const float* __restrict__ SV,
                                             const int* __restrict__ PIDX, const float* __restrict__ PW, float* __restrict__ X, const float* __restrict__ gate  , int t, int lane) {
    f32x2 xf[2][8];
#pragma unroll
    for (int hlf = 0; hlf < 2; ++hlf)
#pragma unroll
        for (int q = 0; q < 2; ++q) { const u32x4 w = *reinterpret_cast<const u32x4*>(H + (long)t * DM + 1024 * hlf + 16 * lane + 8 * q);
            xf[hlf][4 * q + 0] = (f32x2){bflo(w.x), bfhi(w.x)}; xf[hlf][4 * q + 1] = (f32x2){bflo(w.y), bfhi(w.y)}; xf[hlf][4 * q + 2] = (f32x2){bflo(w.z), bfhi(w.z)}; xf[hlf][4 * q + 3] = (f32x2){bflo(w.w), bfhi(w.w)}; }
    f32x2 out[2][8];
#pragma unroll
    for (int hlf = 0; hlf < 2; ++hlf)
#pragma unroll
        for (int i = 0; i < 8; ++i) out[hlf][i] = (f32x2){0.f, 0.f};
    const int myidx0 = PIDX[(long)t * 128 + lane], myidx1 = PIDX[(long)t * 128 + 64 + lane];
    const float myw0 = PW[(long)t * 128 + lane], myw1 = PW[(long)t * 128 + 64 + lane];
    const float msu0 = SU[myidx0], msu1 = SU[myidx1], msv0 = SV[myidx0], msv1 = SV[myidx1];
    for (int hk = 0; hk < 128; hk += 4) {
        const int src = hk & 63; const bool lo = hk < 64;
        const int selidx = lo ? myidx0 : myidx1; const int selw = __float_as_int(lo ? myw0 : myw1), selsu = __float_as_int(lo ? msu0 : msu1), selsv = __float_as_int(lo ? msv0 : msv1);
        int e[4]; float g[4], su[4], sv[4];
#pragma unroll
        for (int k = 0; k < 4; ++k) { e[k] = __builtin_amdgcn_readlane(selidx, src + k); g[k] = __int_as_float(__builtin_amdgcn_readlane(selw, src + k));
            su[k] = __int_as_float(__builtin_amdgcn_readlane(selsu, src + k)); sv[k] = __int_as_float(__builtin_amdgcn_readlane(selsv, src + k)); }
        u32x4 uw[4][2], vw[4][2];
#pragma unroll
        for (int k = 0; k < 4; ++k) { uw[k][0] = *reinterpret_cast<const u32x4*>(PU + ((long)(lane >> 3) * NEXP + e[k]) * 128 + 16 * (lane & 7)); uw[k][1] = *reinterpret_cast<const u32x4*>(PU + ((long)(8 + (lane >> 3)) * NEXP + e[k]) * 128 + 16 * (lane & 7)); }
#pragma unroll
        for (int k = 0; k < 4; ++k) { { const u32x2 a0 = *reinterpret_cast<const u32x2*>(PV + ((long)(2 * lane) * NEXP + e[k]) * 8), a1 = *reinterpret_cast<const u32x2*>(PV + ((long)(2 * lane + 1) * NEXP + e[k]) * 8);
              const u32x2 b0 = *reinterpret_cast<const u32x2*>(PV + ((long)(128 + 2 * lane) * NEXP + e[k]) * 8), b1 = *reinterpret_cast<const u32x2*>(PV + ((long)(129 + 2 * lane) * NEXP + e[k]) * 8);
              vw[k][0] = (u32x4){a0.x, a0.y, a1.x, a1.y}; vw[k][1] = (u32x4){b0.x, b0.y, b1.x, b1.y}; } }
        float a[4];
#pragma unroll
        for (int k = 0; k < 4; ++k) { f32x2 d = (f32x2){0.f, 0.f};
#pragma unroll
            for (int hlf = 0; hlf < 2; ++hlf) { f32x2 f[8]; dec16(uw[k][hlf], f);
#pragma unroll
                for (int i = 0; i < 8; ++i) d = __builtin_elementwise_fma(f[i], xf[hlf][i], d); }
            a[k] = wave_sum(d[0] + d[1]); }
#pragma unroll
        for (int k = 0; k < 4; ++k) { const float ak = g[k] * gelu_exact(a[k] * su[k]) * sv[k]; const f32x2 a2 = (f32x2){ak, ak};
#pragma unroll
            for (int hlf = 0; hlf < 2; ++hlf) { f32x2 f[8]; dec16(vw[k][hlf], f);
#pragma unroll
                for (int i = 0; i < 8; ++i) out[hlf][i] = __builtin_elementwise_fma(f[i], a2, out[hlf][i]); } }
    }
    const float* gr = gate + (long)cond_row(t) * 12288;
#pragma unroll
    for (int hlf = 0; hlf < 2; ++hlf)
#pragma unroll
        for (int q = 0; q < 4; ++q) { const int c = 1024 * hlf + 16 * lane + 4 * q; float* xp = X + (long)t * DM + c;
            const f32x4 gv = *reinterpret_cast<const f32x4*>(gr + c); f32x4 xv = *reinterpret_cast<const f32x4*>(xp);
            xv[0] += gv[0] * out[hlf][2 * q][0]; xv[1] += gv[1] * out[hlf][2 * q][1]; xv[2] += gv[2] * out[hlf][2 * q + 1][0]; xv[3] += gv[3] * out[hlf][2 * q + 1][1];
            *reinterpret_cast<f32x4*>(xp) = xv; }
}

constexpr int SW = 128, NSL = DM / SW;
struct XInfo { int rank, xi, nx, nloc; };
__device__ __forceinline__ void upass(const bf16_t* __restrict__ H, const unsigned char* __restrict__ PU, const int* __restrict__ PIDX, const float* __restrict__ PW, const float* __restrict__ SU, const float* __restrict__ SV,
                                      float* __restrict__ DOTP, unsigned* __restrict__ PACKT, const XInfo xin, int wid, int lane) {
    const int g = lane >> 3, c = lane & 7; const int nwv = xin.nloc * 8;
    const int tlo = (int)((long)T * xin.xi / xin.nx), thi = (int)((long)T * (xin.xi + 1) / xin.nx); const int wv = tlo + xin.rank * 8 + wid;
    float* dp = DOTP;
    for (int s = 0; s < NSL; ++s) { const bool first = (s == 0), lastS = (s == NSL - 1);
        const __amdgpu_buffer_rsrc_t urs = __builtin_amdgcn_make_buffer_rsrc((void*)(PU + (long)s * NEXP * SW), 0, NEXP * SW, 0x00020000);
#define UP_ROW(e_) __builtin_bit_cast(u32x4, __builtin_amdgcn_raw_buffer_load_b128(urs, (e_) * SW + 16 * c, 0, 0))
#define UP_IDX(tt, q4) (*reinterpret_cast<const int4*>(PIDX + (long)(tt) * 128 + 16 * g + 4 * (q4)))
#define UP_X(tt, q2) (*reinterpret_cast<const u32x4*>(H + (long)(tt) * DM + SW * s + 16 * c + 8 * (q2)))
        if (wv >= thi) continue;
        u32x4 A[8], B[8]; int4 en[4]; u32x4 xn[2];
        { int4 e0[4];
#pragma unroll
          for (int q4 = 0; q4 < 4; ++q4) e0[q4] = UP_IDX(wv, q4);
          A[0] = UP_ROW(e0[0].x); A[1] = UP_ROW(e0[0].y); A[2] = UP_ROW(e0[0].z); A[3] = UP_ROW(e0[0].w); A[4] = UP_ROW(e0[1].x); A[5] = UP_ROW(e0[1].y); A[6] = UP_ROW(e0[1].z); A[7] = UP_ROW(e0[1].w);
          B[0] = UP_ROW(e0[2].x); B[1] = UP_ROW(e0[2].y); B[2] = UP_ROW(e0[2].z); B[3] = UP_ROW(e0[2].w); B[4] = UP_ROW(e0[3].x); B[5] = UP_ROW(e0[3].y); B[6] = UP_ROW(e0[3].z); B[7] = UP_ROW(e0[3].w);
          const int t1 = (wv + nwv < thi) ? wv + nwv : wv;
#pragma unroll
          for (int q4 = 0; q4 < 4; ++q4) en[q4] = UP_IDX(t1, q4);
          xn[0] = UP_X(wv, 0); xn[1] = UP_X(wv, 1); }
        f32x2 dnx = (f32x2){0.f, 0.f};
        if (!first) dnx = *reinterpret_cast<const f32x2*>(dp + (long)wv * 128 + 16 * g + 2 * c);
#pragma unroll 1
        for (int t = wv; t < thi; t += nwv) {
            const int tn = (t + nwv < thi) ? t + nwv : t, tnn = (tn + nwv < thi) ? tn + nwv : tn;
            const f32x2 dcur = dnx;
            if (!first) dnx = *reinterpret_cast<const f32x2*>(dp + (long)tn * 128 + 16 * g + 2 * c);
            f32x2 xf[8];
#pragma unroll
            for (int q2 = 0; q2 < 2; ++q2) { const u32x4 hw = xn[q2];
                xf[4 * q2 + 0] = (f32x2){bflo(hw.x), bfhi(hw.x)}; xf[4 * q2 + 1] = (f32x2){bflo(hw.y), bfhi(hw.y)}; xf[4 * q2 + 2] = (f32x2){bflo(hw.z), bfhi(hw.z)}; xf[4 * q2 + 3] = (f32x2){bflo(hw.w), bfhi(hw.w)}; }
            xn[0] = UP_X(tn, 0); xn[1] = UP_X(tn, 1);
            float d[16];
#pragma unroll
            for (int i = 0; i < 8; ++i) { f32x2 f[8]; dec16(A[i], f); f32x2 a = (f32x2){0.f, 0.f};
#pragma unroll
                for (int k = 0; k < 8; ++k) a = __builtin_elementwise_fma(f[k], xf[k], a);
                d[i] = a[0] + a[1]; }
            A[0] = UP_ROW(en[0].x); A[1] = UP_ROW(en[0].y); A[2] = UP_ROW(en[0].z); A[3] = UP_ROW(en[0].w); A[4] = UP_ROW(en[1].x); A[5] = UP_ROW(en[1].y); A[6] = UP_ROW(en[1].z); A[7] = UP_ROW(en[1].w);
#pragma unroll
            for (int i = 0; i < 8; ++i) { f32x2 f[8]; dec16(B[i], f); f32x2 a = (f32x2){0.f, 0.f};
#pragma unroll
                for (int k = 0; k < 8; ++k) a = __builtin_elementwise_fma(f[k], xf[k], a);
                d[8 + i] = a[0] + a[1]; }
            B[0] = UP_ROW(en[2].x); B[1] = UP_ROW(en[2].y); B[2] = UP_ROW(en[2].z); B[3] = UP_ROW(en[2].w); B[4] = UP_ROW(en[3].x); B[5] = UP_ROW(en[3].y); B[6] = UP_ROW(en[3].z); B[7] = UP_ROW(en[3].w);
#pragma unroll
            for (int q4 = 0; q4 < 4; ++q4) en[q4] = UP_IDX(tnn, q4);
            float r8[8], r4[4], r2[2];
#pragma unroll
            for (int k = 0; k < 8; ++k) { const float keep = (c & 4) ? d[k + 8] : d[k], send = (c & 4) ? d[k] : d[k + 8]; r8[k] = keep + sx<4>(send); }
#pragma unroll
            for (int k = 0; k < 4; ++k) { const float keep = (c & 2) ? r8[k + 4] : r8[k], send = (c & 2) ? r8[k] : r8[k + 4]; r4[k] = keep + sx<2>(send); }
#pragma unroll
            for (int k = 0; k < 2; ++k) { const float keep = (c & 1) ? r4[k + 2] : r4[k], send = (c & 1) ? r4[k] : r4[k + 2]; r2[k] = keep + sx<1>(send); }
            float* o = dp + (long)t * 128 + 16 * g + 2 * c;
            f32x2 acc = (f32x2){r2[0], r2[1]};
            acc += dcur;
            if (!lastS) *reinterpret_cast<f32x2*>(o) = acc;
            else {
                const int p0 = 16 * g + 2 * c; const int2 ee = *reinterpret_cast<const int2*>(PIDX + (long)t * 128 + p0); const f32x2 gw = *reinterpret_cast<const f32x2*>(PW + (long)t * 128 + p0);
                const float a0 = gw[0] * gelu_exact(acc[0] * SU[ee.x]) * SV[ee.x], a1 = gw[1] * gelu_exact(acc[1] * SU[ee.y]) * SV[ee.y];
                u32x2 pk; pk.x = (cvt_pk_bf16(0.f, a0) & 0xffff0000u) | (unsigned)ee.x; pk.y = (cvt_pk_bf16(0.f, a1) & 0xffff0000u) | (unsigned)ee.y;
                *reinterpret_cast<u32x2*>(PACKT + ((long)(p0 >> 2) * T + t) * 4 + (p0 & 3)) = pk; }
        }
#undef UP_ROW
#undef UP_IDX
#undef UP_X
    }
}
__device__ __forceinline__ void actpass(const float* __restrict__ DOTP, const int* __restrict__ PIDX, const float* __restrict__ PW, const float* __restrict__ SU, const float* __restrict__ SV, float* __restrict__ ACT, int nx, long gt, long nt) {
    for (long i = gt; i < (long)T * 128; i += nt) { float dsum = 0.f;
        for (int x = 0; x < nx; ++x) dsum += DOTP[(long)x * T * 128 + i];
        const int e = PIDX[i]; const float av = PW[i] * gelu_exact(dsum * SU[e]) * SV[e]; const long t = i >> 7; const int pp = (int)(i & 127);
        reinterpret_cast<unsigned*>(ACT)[((long)(pp >> 2) * T + t) * 4 + (pp & 3)] = (cvt_pk_bf16(0.f, av) & 0xffff0000u) | (unsigned)e; }
}
__device__ __forceinline__ void vpass(const unsigned char* __restrict__ PV, const int* __restrict__ PIDX, const float* __restrict__ ACT, float* __restrict__ X, const float* __restrict__ gate, const XInfo xin, int wid, int lane) {
    const int g = lane >> 3, c = lane & 7; const int wv = xin.rank * 8 + wid, nwv = xin.nloc * 8;
    for (int s = xin.xi; s < NSL; s += xin.nx) {
        int4 en[4]; f32x4 an[4];
#pragma unroll
        for (int q4 = 0; q4 < 4; ++q4) { en[q4] = *reinterpret_cast<const int4*>(PIDX + (long)(wv < T ? wv : 0) * 128 + 16 * g + 4 * q4); an[q4] = *reinterpret_cast<const f32x4*>(ACT + (long)(wv < T ? wv : 0) * 128 + 16 * g + 4 * q4); }
        for (int t = wv; t < T; t += nwv) {
            int e[16]; float a[16];
#pragma unroll
            for (int q4 = 0; q4 < 4; ++q4) { e[4 * q4] = en[q4].x; e[4 * q4 + 1] = en[q4].y; e[4 * q4 + 2] = en[q4].z; e[4 * q4 + 3] = en[q4].w; a[4 * q4] = an[q4][0]; a[4 * q4 + 1] = an[q4][1]; a[4 * q4 + 2] = an[q4][2]; a[4 * q4 + 3] = an[q4][3]; }
            u32x4 w[16];
#pragma unroll
            for (int i = 0; i < 16; ++i) w[i] = *reinterpret_cast<const u32x4*>(PV + ((long)s * NEXP + e[i]) * SW + 16 * c);
            { const int tn = (t + nwv < T) ? t + nwv : t;
#pragma unroll
              for (int q4 = 0; q4 < 4; ++q4) { en[q4] = *reinterpret_cast<const int4*>(PIDX + (long)tn * 128 + 16 * g + 4 * q4); an[q4] = *reinterpret_cast<const f32x4*>(ACT + (long)tn * 128 + 16 * g + 4 * q4); } }
            f32x2 o[8];
#pragma unroll
            for (int k = 0; k < 8; ++k) o[k] = (f32x2){0.f, 0.f};
#pragma unroll
            for (int i = 0; i < 16; ++i) { f32x2 f[8]; dec16(w[i], f); const f32x2 a2 = (f32x2){a[i], a[i]};
#pragma unroll
                for (int k = 0; k < 8; ++k) o[k] = __builtin_elementwise_fma(f[k], a2, o[k]); }
            f32x2 r4[4], r2[2], r1;
#pragma unroll
            for (int k = 0; k < 4; ++k) { const f32x2 keep = (g & 4) ? o[k + 4] : o[k], send = (g & 4) ? o[k] : o[k + 4]; r4[k] = keep + (f32x2){sx<32>(send[0]), sx<32>(send[1])}; }
#pragma unroll
            for (int k = 0; k < 2; ++k) { const f32x2 keep = (g & 2) ? r4[k + 2] : r4[k], send = (g & 2) ? r4[k] : r4[k + 2]; r2[k] = keep + (f32x2){sx<16>(send[0]), sx<16>(send[1])}; }
            { const f32x2 keep = (g & 1) ? r2[1] : r2[0], send = (g & 1) ? r2[0] : r2[1]; r1 = keep + (f32x2){sx<8>(send[0]), sx<8>(send[1])}; }
            const int col = SW * s + 16 * c + 2 * g;
            const f32x2 gv = *reinterpret_cast<const f32x2*>(gate + (long)cond_row(t) * 12288 + col);
            float* xp = X + (long)t * DM + col; f32x2 xv = *reinterpret_cast<const f32x2*>(xp);
            xv += gv * r1; *reinterpret_cast<f32x2*>(xp) = xv;
        }
    }
}

__device__ __forceinline__ void vpass_lds(const unsigned char* __restrict__ PV, const unsigned* __restrict__ PACKT, float* __restrict__ X, const float* __restrict__ gate, char* lds, int bid, int nb, int s_end, int tid) {
    const int wid = tid >> 6, lane = tid & 63;
    for (int s = bid; s < s_end; s += nb) {
        __syncthreads();
        { const u32x4* src = reinterpret_cast<const u32x4*>(PV + (long)s * NEXP * 8); u32x4* dst = reinterpret_cast<u32x4*>(lds);
#pragma unroll 4
          for (int i = tid; i < NEXP * 8 / 16; i += 512) dst[i] = src[i]; }
        __syncthreads();
        u32x4 h0[8], h1[8];
        const __amdgpu_buffer_rsrc_t vrs = __builtin_amdgcn_make_buffer_rsrc((void*)PACKT, 0, (int)((size_t)T * 128 * 4), 0x00020000);
#define VP_LD(k, toff) __builtin_bit_cast(u32x4, __builtin_amdgcn_raw_buffer_load_b128(vrs, (int)(toff), (int)((size_t)(k) * T * 16), 0))
        { const unsigned toff = (unsigned)(wid * 64 + lane) * 16u;
#pragma unroll
          for (int k = 0; k < 8; ++k) h0[k] = VP_LD(k, toff);
#pragma unroll
          for (int k = 0; k < 8; ++k) h1[k] = VP_LD(8 + k, toff); }
#define VP_STEP(HB) do { _Pragma("unroll") for (int kk = 0; kk < 8; kk += 2) { unsigned pw[8]; \
            _Pragma("unroll") for (int k = 0; k < 2; ++k) { pw[4 * k] = HB[kk + k].x; pw[4 * k + 1] = HB[kk + k].y; pw[4 * k + 2] = HB[kk + k].z; pw[4 * k + 3] = HB[kk + k].w; } \
            u32x2 w[8]; \
            _Pragma("unroll") for (int k = 0; k < 8; ++k) w[k] = *reinterpret_cast<const u32x2*>(lds + (pw[k] & 0xffffu) * 8u); \
            _Pragma("unroll") for (int k = 0; k < 8; ++k) { const float a = __uint_as_float(pw[k] & 0xffff0000u); \
                const f32x2 f0 = __builtin_amdgcn_cvt_pk_f32_fp8((int)w[k].x, false), f1 = __builtin_amdgcn_cvt_pk_f32_fp8((int)w[k].x, true), f2 = __builtin_amdgcn_cvt_pk_f32_fp8((int)w[k].y, false), f3 = __builtin_amdgcn_cvt_pk_f32_fp8((int)w[k].y, true); \
                acc[0] = fmaf(a, f0[0], acc[0]); acc[1] = fmaf(a, f0[1], acc[1]); acc[2] = fmaf(a, f1[0], acc[2]); acc[3] = fmaf(a, f1[1], acc[3]); \
                acc[4] = fmaf(a, f2[0], acc[4]); acc[5] = fmaf(a, f2[1], acc[5]); acc[6] = fmaf(a, f3[0], acc[6]); acc[7] = fmaf(a, f3[1], acc[7]); } } } while (0)
#pragma unroll 1
        for (int tg = wid; tg < T / 64; tg += 8) { const int t = tg * 64 + lane; const int tgn = (tg + 8 < T / 64) ? tg + 8 : tg;
            const unsigned toff = (unsigned)t * 16u, toffn = (unsigned)(tgn * 64 + lane) * 16u;
            float acc[8];
#pragma unroll
            for (int j = 0; j < 8; ++j) acc[j] = 0.f;
            VP_STEP(h0);
#pragma unroll
            for (int k = 0; k < 8; ++k) h0[k] = VP_LD(16 + k, toff);
            VP_STEP(h1);
#pragma unroll
            for (int k = 0; k < 8; ++k) h1[k] = VP_LD(24 + k, toff);
            VP_STEP(h0);
#pragma unroll
            for (int k = 0; k < 8; ++k) h0[k] = VP_LD(k, toffn);
            VP_STEP(h1);
#pragma unroll
            for (int k = 0; k < 8; ++k) h1[k] = VP_LD(8 + k, toffn);
            const float* gr = gate + (long)cond_row(t) * 12288 + 8 * s; float* xp = X + (long)t * DM + 8 * s;
            const f32x4 g0 = *reinterpret_cast<const f32x4*>(gr), g1 = *reinterpret_cast<const f32x4*>(gr + 4);
            f32x4 x0 = *reinterpret_cast<const f32x4*>(xp), x1 = *reinterpret_cast<const f32x4*>(xp + 4);
            x0[0] += g0[0] * acc[0]; x0[1] += g0[1] * acc[1]; x0[2] += g0[2] * acc[2]; x0[3] += g0[3] * acc[3];
            x1[0] += g1[0] * acc[4]; x1[1] += g1[1] * acc[5]; x1[2] += g1[2] * acc[6]; x1[3] += g1[3] * acc[7];
            *reinterpret_cast<f32x4*>(xp) = x0; *reinterpret_cast<f32x4*>(xp + 4) = x1; }
#undef VP_STEP
#undef VP_LD
    }
    __syncthreads();
}
}
namespace ph {
__device__ __forceinline__ int gwave() { return obid() * 8 + (otid() >> 6); }
__device__ __forceinline__ int nwaves() { return ogrid() * 8; }
__device__ __forceinline__ long gthread() { return (long)obid() * 512 + otid(); }
__device__ __forceinline__ long nthreads() { return (long)ogrid() * 512; }

__device__ __forceinline__ void transpose_tile(const float* __restrict__ src, int C, int r0, int c0, bf16_t* __restrict__ dst, long dpitch, float* tile) {
    const int tid = otid();
#pragma unroll
    for (int i = 0; i < 8; ++i) { const int idx = tid + 512 * i, r = idx >> 6, c = idx & 63; tile[r * 65 + c] = src[(long)(r0 + r) * C + c0 + c]; }
    __syncthreads();
    { const int c = tid >> 3, rc = (tid & 7) * 8; float f[8];
#pragma unroll
      for (int j = 0; j < 8; ++j) f[j] = tile[(rc + j) * 65 + c];
      *reinterpret_cast<u32x4*>(dst + (long)(c0 + c) * dpitch + r0 + rc) = pack8(f); }
    __syncthreads();
}

__device__ __forceinline__ void zero_chunks(bf16_t* base, long nrows, long rowpitch, int col0, int nchunk) {
    const long total = nrows * nchunk;
    for (long i = gthread(); i < total; i += nthreads()) { const long r = i / nchunk; const int ch = (int)(i % nchunk);
        *reinterpret_cast<u32x4*>(base + r * rowpitch + col0 + ch * 8) = (u32x4){0u, 0u, 0u, 0u}; }
}

__device__ __forceinline__ void prologue(KParams& p, char* lds) {
    unsigned char* ws = optr(gp(p.ws)); const int tid = otid();
    float* tile = (float*)lds;
    { struct TJob { const float* src; bf16_t* dst; int R, C, r0, c0, perm; };
      auto decode = [&](int it) { TJob j; j.perm = 0; const int l = it / 10656; int r = it % 10656;
        if (r < 5664) { j.src = gp(p.w_in) + (long)l * DM * INW; j.R = DM; j.C = INW; j.dst = (bf16_t*)(ws + WS_WIN) + (long)l * INWP * DM; }
        else if (r < 6048) { r -= 5664; j.src = gp(p.w_uq) + (long)l * 512 * 3072; j.R = 512; j.C = 3072; j.dst = (bf16_t*)(ws + WS_WUQ) + (long)l * 3072 * 512; j.perm = 1; }
        else if (r < 6560) { r -= 6048; j.src = gp(p.w_ukv) + (long)l * 512 * 4096; j.R = 512; j.C = 4096; j.dst = (bf16_t*)(ws + WS_WUKV) + (long)l * 4096 * 512; }
        else { r -= 6560; const int m = r >> 10; r &= 1023; j.R = DM; j.C = DM;
            j.src = (m == 0 ? gp(p.w_a) : m == 1 ? gp(p.w_b) : m == 2 ? gp(p.w_o) : gp(p.w_pq)) + (long)l * DM * DM;
            j.dst = (bf16_t*)(ws + (m == 0 ? WS_WA : m == 1 ? WS_WB : m == 2 ? WS_WO : WS_WPQ)) + (long)l * DM * DM; }
        const int ntc = j.C / 64; j.r0 = (r / ntc) * 64; j.c0 = (r % ntc) * 64; return j; };
      const int NTILES = 2 * 10656, G_ = ogrid(); int it = obid(); float v[8]; TJob cur{};
      if (it < NTILES) { cur = decode(it);
#pragma unroll
        for (int i = 0; i < 8; ++i) { const int idx = tid + 512 * i, r = idx >> 6, c = idx & 63; v[i] = cur.src[(long)(cur.r0 + r) * cur.C + cur.c0 + c]; } }
      while (it < NTILES) { const int itn = it + G_; float vn[8]; TJob nxt{};
        if (itn < NTILES) { nxt = decode(itn);
#pragma unroll
            for (int i = 0; i < 8; ++i) { const int idx = tid + 512 * i, r = idx >> 6, c = idx & 63; vn[i] = nxt.src[(long)(nxt.r0 + r) * nxt.C + nxt.c0 + c]; } }
#pragma unroll
        for (int i = 0; i < 8; ++i) { const int idx = tid + 512 * i, r = idx >> 6, c = idx & 63; tile[r * 65 + c] = v[i]; }
        __syncthreads();
        { const int c = tid >> 3, rc = (tid & 7) * 8; float f[8];
#pragma unroll
          for (int jj = 0; jj < 8; ++jj) f[jj] = tile[(rc + jj) * 65 + c];
          int drow = cur.c0 + c;
          if (cur.perm) { const int gq = drow / 768, o = drow - 768 * gq, hh = o / 192, w = o - 192 * hh;
              drow = 768 * gq + (w < 128 ? 128 * hh + w : (w < 160 ? 512 + 32 * hh + (w - 128) : 640 + 32 * hh + (w - 160))); }
          *reinterpret_cast<u32x4*>(cur.dst + (long)drow * cur.R + cur.r0 + rc) = pack8(f); }
        __syncthreads();
#pragma unroll
        for (int i = 0; i < 8; ++i) v[i] = vn[i];
        cur = nxt; it = itn; } }
    for (long i = gthread(); i < 2L * 16 * 512 * 32; i += nthreads()) { const int ch = (int)(i & 31); const long row = i >> 5; const int c = (int)(row & 511), h = (int)((row >> 9) & 15), l = (int)(row >> 13);
        u32x4 w = (u32x4){0u, 0u, 0u, 0u};
        if (ch < 16) { const float* s = gp(p.w_ukv) + (((long)l * 512 + c) * 16 + h) * 256 + ch * 8; float f[8];
#pragma unroll
            for (int j = 0; j < 8; ++j) f[j] = s[j];
            w = pack8(f); }
        *reinterpret_cast<u32x4*>((bf16_t*)(ws + WS_WUK) + row * 256 + ch * 8) = w; }
    for (long i = gthread(); i < 2L * 4096; i += nthreads()) { const bool second = i >= 4096; const long j8 = (second ? i - 4096 : i) * 8; const float* s = (second ? gp(p.peer_k2) : gp(p.peer_k1)) + j8; float f[8];
#pragma unroll
        for (int j = 0; j < 8; ++j) f[j] = s[j];
        *reinterpret_cast<u32x4*>((bf16_t*)(ws + (second ? WS_PK2 : WS_PK1)) + j8) = pack8(f); }
    for (int l = 0; l < 2; ++l) zero_chunks((bf16_t*)(ws + WS_WIN) + ((long)l * INWP + INW) * DM, INWP - INW, DM, 0, DM / 8);
    for (int b = 0; b < DB; ++b) zero_chunks((bf16_t*)(ws + WS_CKA) + ((long)b * KPAD + KALL) * QLD, KPAD - KALL, QLD, 0, QLD / 8);
    zero_chunks((bf16_t*)(ws + WS_CKA), (long)DB * KPAD, QLD, 576, 8);
    zero_chunks((bf16_t*)(ws + WS_CKT), (long)DB * 512, KPAD, KALL, (KPAD - KALL) / 8);
    zero_chunks((bf16_t*)(ws + WS_QL), (long)DB * 1024, QLD, 576, 8);
    for (long i = gthread(); i < 4096L * 96; i += nthreads()) { const int pos = (int)(i / 96), k = (int)(i % 96); const bool big = k >= 32; const int fi = big ? k - 32 : k; const float d = big ? 128.f : 64.f;
        const float inv = __builtin_amdgcn_exp2f(-(2.0f * (float)fi / d) * 13.287712379549449f);
        const float ang = (float)pos * inv; double rv = (double)ang * 0.15915494309189535; rv -= floor(rv); const float fr = (float)rv;
        float* dst = big ? (float*)(ws + WS_TAB128) + ((long)pos * 64 + fi) * 2 : (float*)(ws + WS_TAB64) + ((long)pos * 32 + fi) * 2;
        dst[0] = __builtin_amdgcn_cosf(fr); dst[1] = __builtin_amdgcn_sinf(fr); }
    { float* sc = (float*)lds;
      for (int it = obid(); it < 2 * 12 * 8; it += ogrid()) { const int l = it / 96, cc = (it % 96) / 8, ks = it % 8;
        __syncthreads();
        for (int i = tid; i < NCOND * 256; i += 512) { const int r = i >> 8, k = i & 255; const float c = r < NB ? gp(p.c_prompt)[(long)r * DM + ks * 256 + k] : gp(p.c_sample)[(long)(r - NB) * DM + ks * 256 + k]; sc[i] = siluf_(c); }
        __syncthreads();
        float a0[NCOND], a1[NCOND];
#pragma unroll
        for (int r = 0; r < NCOND; ++r) { a0[r] = 0.f; a1[r] = 0.f; }
        const float* wp = gp(p.w_ada) + ((long)l * DM + ks * 256) * 12288 + cc * 1024 + 2 * tid;
#pragma unroll 1
        for (int k = 0; k < 256; k += 4) { const f32x2 w0 = *reinterpret_cast<const f32x2*>(wp), w1 = *reinterpret_cast<const f32x2*>(wp + 12288), w2 = *reinterpret_cast<const f32x2*>(wp + 2 * 12288), w3 = *reinterpret_cast<const f32x2*>(wp + 3 * 12288);
            wp += 4 * 12288;
#pragma unroll
            for (int r = 0; r < NCOND; ++r) { const f32x4 s = *reinterpret_cast<const f32x4*>(sc + r * 256 + k);
                a0[r] = fmaf(s[0], w0[0], fmaf(s[1], w1[0], fmaf(s[2], w2[0], fmaf(s[3], w3[0], a0[r]))));
                a1[r] = fmaf(s[0], w0[1], fmaf(s[1], w1[1], fmaf(s[2], w2[1], fmaf(s[3], w3[1], a1[r]))));
                if ((r % 6) == 5) __builtin_amdgcn_sched_barrier(0); } }
        float* dst = (float*)(ws + WS_ADAP) + (((long)ks * 2 + l) * NCOND) * 12288 + cc * 1024 + 2 * tid;
#pragma unroll
        for (int r = 0; r < NCOND; ++r) *reinterpret_cast<f32x2*>(dst + (long)r * 12288) = (f32x2){a0[r], a1[r]}; }
      __syncthreads(); }
}

__device__ __forceinline__ void wpq_int8(KParams& p) {
    unsigned char* ws = optr(gp(p.ws)); const int lane = otid() & 63;
    for (int r = gwave(); r < 2 * DM; r += nwaves()) { const bf16_t* src = (const bf16_t*)(ws + WS_WPQ) + (long)r * DM; float f[4][8]; float am = 0.f;
#pragma unroll
        for (int j = 0; j < 4; ++j) { unpack8(*reinterpret_cast<const u32x4*>(src + 512 * j + 8 * lane), f[j]);
#pragma unroll
            for (int i = 0; i < 8; ++i) am = fmaxf(am, fabsf(f[j][i])); }
        am = wave_max(am); const float qs = am > 0.f ? 127.0f / am : 0.f;
#pragma unroll
        for (int j = 0; j < 4; ++j) { unsigned w2[2];
#pragma unroll
            for (int hh = 0; hh < 2; ++hh) { unsigned w = 0u;
#pragma unroll
                for (int i = 0; i < 4; ++i) w |= ((unsigned)((int)__builtin_rintf(f[j][4 * hh + i] * qs) & 0xff)) << (8 * i);
                w2[hh] = w; }
            *reinterpret_cast<u32x2*>(ws + WS_WPQ8 + (long)r * DM + 512 * j + 8 * lane) = (u32x2){w2[0], w2[1]}; }
        if (lane == 0) ((float*)(ws + WS_SB8))[r] = am * (1.0f / 127.0f); }
}

__device__ __forceinline__ void rows2048_int8(KParams& p, size_t src_off, size_t dst_off, size_t sc_off, int nrows) {
    unsigned char* ws = optr(gp(p.ws)); const int lane = otid() & 63;
    for (int r = gwave(); r < nrows; r += nwaves()) { const bf16_t* src = (const bf16_t*)(ws + src_off) + (long)r * DM; float f[4][8]; float am = 0.f;
#pragma unroll
        for (int j = 0; j < 4; ++j) { unpack8(*reinterpret_cast<const u32x4*>(src + 512 * j + 8 * lane), f[j]);
#pragma unroll
            for (int i = 0; i < 8; ++i) am = fmaxf(am, fabsf(f[j][i])); }
        am = wave_max(am); const float qs = am > 0.f ? 127.0f / am : 0.f;
#pragma unroll
        for (int j = 0; j < 4; ++j) { unsigned w2[2];
#pragma unroll
            for (int hh = 0; hh < 2; ++hh) { unsigned w = 0u;
#pragma unroll
                for (int i = 0; i < 4; ++i) w |= ((unsigned)((int)__builtin_rintf(f[j][4 * hh + i] * qs) & 0xff)) << (8 * i);
                w2[hh] = w; }
            *reinterpret_cast<u32x2*>(ws + dst_off + (long)r * DM + 512 * j + 8 * lane) = (u32x2){w2[0], w2[1]}; }
        if (lane == 0) ((float*)(ws + sc_off))[r] = am * (1.0f / 127.0f); }
}
__device__ __forceinline__ void wb_int8(KParams& p, int l) {
    unsigned char* ws = optr(gp(p.ws)); const int lane = otid() & 63;
    for (int r = gwave(); r < DM; r += nwaves()) { const bf16_t* src = (const bf16_t*)(ws + WS_WB) + ((long)l * DM + r) * DM; float f[4][8]; float am = 0.f;
#pragma unroll
        for (int j = 0; j < 4; ++j) { unpack8(*reinterpret_cast<const u32x4*>(src + 512 * j + 8 * lane), f[j]);
#pragma unroll
            for (int i = 0; i < 8; ++i) am = fmaxf(am, fabsf(f[j][i])); }
        am = wave_max(am); const float qs = am > 0.f ? 127.0f / am : 0.f;
#pragma unroll
        for (int j = 0; j < 4; ++j) { unsigned w2[2];
#pragma unroll
            for (int hh = 0; hh < 2; ++hh) { unsigned w = 0u;
#pragma unroll
                for (int i = 0; i < 4; ++i) w |= ((unsigned)((int)__builtin_rintf(f[j][4 * hh + i] * qs) & 0xff)) << (8 * i);
                w2[hh] = w; }
            *reinterpret_cast<u32x2*>(ws + WS_WB8 + (long)r * DM + 512 * j + 8 * lane) = (u32x2){w2[0], w2[1]}; }
        if (lane == 0) ((float*)(ws + WS_SBB))[r] = am * (1.0f / 127.0f); }
}

__device__ __forceinline__ void win_int8(KParams& p, int l) {
    unsigned char* ws = optr(gp(p.ws)); const int lane = otid() & 63;
    for (int jr = gwave(); jr < NB8 * 256; jr += nwaves()) { const int blk = jr >> 8, n = (blk < 2 ? blk : (blk < 5 ? blk + 3 : blk + 7)) * 256 + (jr & 255);
        const bf16_t* src = (const bf16_t*)(ws + WS_WIN) + ((long)l * INWP + n) * DM; float f[4][8]; float am = 0.f;
#pragma unroll
        for (int j = 0; j < 4; ++j) { unpack8(*reinterpret_cast<const u32x4*>(src + 512 * j + 8 * lane), f[j]);
#pragma unroll
            for (int i = 0; i < 8; ++i) am = fmaxf(am, fabsf(f[j][i])); }
        am = wave_max(am); const float qs = am > 0.f ? 127.0f / am : 0.f;
#pragma unroll
        for (int j = 0; j < 4; ++j) { unsigned w2[2];
#pragma unroll
            for (int hh = 0; hh < 2; ++hh) { unsigned w = 0u;
#pragma unroll
                for (int i = 0; i < 4; ++i) w |= ((unsigned)((int)__builtin_rintf(f[j][4 * hh + i] * qs) & 0xff)) << (8 * i);
                w2[hh] = w; }
            *reinterpret_cast<u32x2*>(ws + WS_WIN8 + (long)jr * DM + 512 * j + 8 * lane) = (u32x2){w2[0], w2[1]}; }
        if (lane == 0) ((float*)(ws + WS_SBW))[n] = am * (1.0f / 127.0f); }
}

__device__ __forceinline__ void ada_reduce(KParams& p) {
    unsigned char* ws = optr(gp(p.ws)); const float* ap = (const float*)(ws + WS_ADAP); float* ad = (float*)(ws + WS_ADA); const long n = 2L * NCOND * 12288;
    for (long i = gthread(); i < n; i += nthreads()) { const int l = (int)(i / (NCOND * 12288L)); const int j = (int)(i % 12288);
        float s = gp(p.b_ada)[(long)l * 12288 + j];
#pragma unroll
        for (int ks = 0; ks < 8; ++ks) s += ap[(long)ks * n + i];
        ad[i] = s; }
}

__device__ __forceinline__ void modulate(KParams& p, int l, int which) {
    const int lane = otid() & 63; unsigned char* ws = optr(gp(p.ws)); const float* X = gp(p.out); bf16_t* H = (bf16_t*)(ws + WS_H);
    const float* g = (which ? gp(p.g_ffn) : gp(p.g_mix)) + (long)l * DM; const float* ada = (const float*)(ws + WS_ADA) + (long)l * NCOND * 12288 + (which ? 3 : 0) * DM;
    for (int t = gwave(); t < T; t += nwaves()) {
        const float* xr = (l == 0 && which == 0) ? (t < TP ? gp(p.x_prompt) + (long)t * DM : gp(p.x_sample) + (long)(t - TP) * DM) : X + (long)t * DM; f32x4 v[8]; float ss = 0.f;
#pragma unroll
        for (int j = 0; j < 8; ++j) { v[j] = *reinterpret_cast<const f32x4*>(xr + 256 * j + 4 * lane); ss += v[j][0] * v[j][0] + v[j][1] * v[j][1] + v[j][2] * v[j][2] + v[j][3] * v[j][3]; }
        ss = wave_sum(ss); const float rinv = rsqrtf(ss * (1.0f / DM) + EPS);
        const float* sh = ada + (long)cond_row(t) * 12288; const float* sc = sh + DM;
#pragma unroll
        for (int j = 0; j < 8; ++j) { const int c = 256 * j + 4 * lane; const f32x4 gv = *reinterpret_cast<const f32x4*>(g + c), sv = *reinterpret_cast<const f32x4*>(sc + c), hv = *reinterpret_cast<const f32x4*>(sh + c);
            const f32x4 y = v[j] * rinv * gv * (sv + 1.0f) + hv; u32x2 w; w.x = cvt_pk_bf16(y[0], y[1]); w.y = cvt_pk_bf16(y[2], y[3]);
            *reinterpret_cast<u32x2*>(H + (long)t * DM + c) = w; v[j] = y; }
        {
            float am = 0.f;
#pragma unroll
            for (int j = 0; j < 8; ++j) am = fmaxf(am, fmaxf(fmaxf(fabsf(v[j][0]), fabsf(v[j][1])), fmaxf(fabsf(v[j][2]), fabsf(v[j][3]))));
            am = wave_max(am); const float qs = am > 0.f ? 127.0f / am : 0.f;
#pragma unroll
            for (int j = 0; j < 8; ++j) { const int c = 256 * j + 4 * lane;
                const int q0 = (int)__builtin_rintf(v[j][0] * qs), q1 = (int)__builtin_rintf(v[j][1] * qs), q2 = (int)__builtin_rintf(v[j][2] * qs), q3 = (int)__builtin_rintf(v[j][3] * qs);
                *reinterpret_cast<unsigned*>(ws + WS_H8 + (long)t * DM + c) = (unsigned)(q0 & 0xff) | ((unsigned)(q1 & 0xff) << 8) | ((unsigned)(q2 & 0xff) << 16) | ((unsigned)(q3 & 0xff) << 24); }
            if (lane == 0) ((float*)(ws + WS_SA8))[t] = am * (1.0f / 127.0f); }
    }
}

__device__ __forceinline__ void cache_convert(KParams& p, int l, char* lds, int it0, int it1, int bidx, int nb) {
    const int tid = otid(); unsigned char* ws = optr(gp(p.ws)); float* tile = (float*)lds; bf16_t* CKA = (bf16_t*)(ws + WS_CKA); bf16_t* CKT = (bf16_t*)(ws + WS_CKT);
    { const int NT_ = it1, G_ = nb; int it = it0 + bidx; float v[8];
      const float* cbase = gp(p.cache_ckv) + (long)l * DB * PAST * 512;
#define CC_SRC(itx) (cbase + (((long)((itx) >> 8)) * PAST + (((itx) >> 3) & 31) * 64) * 512 + ((itx) & 7) * 64)
      if (it < NT_) { const float* src = CC_SRC(it);
#pragma unroll
        for (int i = 0; i < 8; ++i) { const int idx = tid + 512 * i, r = idx >> 6, c = idx & 63; v[i] = src[(long)r * 512 + c]; } }
      while (it < NT_) { const int b = it >> 8, kt = (it >> 3) & 31, ct = it & 7; const int itn = it + G_; float vn[8];
        if (itn < NT_) { const float* src = CC_SRC(itn);
#pragma unroll
            for (int i = 0; i < 8; ++i) { const int idx = tid + 512 * i, r = idx >> 6, c = idx & 63; vn[i] = src[(long)r * 512 + c]; } }
#pragma unroll
        for (int i = 0; i < 8; ++i) { const int idx = tid + 512 * i, r = idx >> 6, c = idx & 63; tile[r * 65 + c] = v[i]; }
        __syncthreads();
        { const int r = tid >> 3, cc = (tid & 7) * 8; float f[8];
#pragma unroll
          for (int j = 0; j < 8; ++j) f[j] = tile[r * 65 + cc + j];
          *reinterpret_cast<u32x4*>(CKA + ((long)b * KPAD + kt * 64 + r) * QLD + ct * 64 + cc) = pack8(f);
#pragma unroll
          for (int j = 0; j < 8; ++j) f[j] = tile[(cc + j) * 65 + r];
          *reinterpret_cast<u32x4*>(CKT + ((long)b * 512 + ct * 64 + r) * KPAD + kt * 64 + cc) = pack8(f); }
        __syncthreads();
#pragma unroll
        for (int i = 0; i < 8; ++i) v[i] = vn[i];
        it = itn; }
#undef CC_SRC
    }
    for (long i = (long)it0 * 64 + (long)bidx * 512 + tid; i < (long)it1 * 64; i += (long)nb * 512) { const long row = i >> 3; const int ch = (int)(i & 7); const int b = (int)(row >> 11), k = (int)(row & 2047);
        const float* s = gp(p.cache_krope) + (((long)l * DB + b) * PAST + k) * 64 + ch * 8; float f[8];
#pragma unroll
        for (int j = 0; j < 8; ++j) f[j] = s[j];
        *reinterpret_cast<u32x4*>(CKA + ((long)b * KPAD + k) * QLD + 512 + ch * 8) = pack8(f); }
}

__device__ __forceinline__ void quant_row8(const float (&o)[8], unsigned char* dst, float* sc, int lane) {
    float am = 0.f;
#pragma unroll
    for (int j = 0; j < 8; ++j) am = fmaxf(am, fabsf(o[j]));
    am = wave_max(am); const float qs = am > 0.f ? 127.0f / am : 0.f; unsigned w2[2];
#pragma unroll
    for (int hh = 0; hh < 2; ++hh) { unsigned w = 0u;
#pragma unroll
        for (int i = 0; i < 4; ++i) w |= ((unsigned)((int)__builtin_rintf(o[4 * hh + i] * qs) & 0xff)) << (8 * i);
        w2[hh] = w; }
    *reinterpret_cast<u32x2*>(dst) = (u32x2){w2[0], w2[1]};
    if (lane == 0) *sc = am * (1.0f / 127.0f);
}
__device__ __forceinline__ void wu_int8(KParams& p, int l) {
    unsigned char* ws = optr(gp(p.ws)); const int lane = otid() & 63;
    for (int r = gwave(); r < 3072 + 4096; r += nwaves()) { const bool kv = r >= 3072; const int rr = kv ? r - 3072 : r;
        const bf16_t* src = kv ? (const bf16_t*)(ws + WS_WUKV) + ((long)l * 4096 + rr) * 512 : (const bf16_t*)(ws + WS_WUQ) + ((long)l * 3072 + rr) * 512;
        float f[8]; unpack8(*reinterpret_cast<const u32x4*>(src + 8 * lane), f);
        quant_row8(f, ws + (kv ? WS_WUKV8 : WS_WUQ8) + (long)rr * 512 + 8 * lane, (float*)(ws + (kv ? WS_SBK : WS_SBQ)) + rr, lane); }
}

__device__ __forceinline__ void post_win(KParams& p, int l) {
    const int lane = otid() & 63; unsigned char* ws = optr(gp(p.ws));
    bf16_t* Y = (bf16_t*)(ws + WS_Y); bf16_t* CQN = (bf16_t*)(ws + WS_CQN); bf16_t* CKVNP = (bf16_t*)(ws + WS_CKVNP); bf16_t* KRP = (bf16_t*)(ws + WS_KRP); bf16_t* CKA = (bf16_t*)(ws + WS_CKA); bf16_t* CKT = (bf16_t*)(ws + WS_CKT);
    const float* T64 = (const float*)(ws + WS_TAB64); const float* T128 = (const float*)(ws + WS_TAB128);
    for (int t = gwave(); t < T; t += nwaves()) {
        bf16_t* y = Y + (long)t * INWP; const int pos = tok_pos(t); const bool samp = t >= TP; const int ts = t - TP, b = ts >> 6, s = ts & 63;
        { float f[8], o[8]; unpack8(*reinterpret_cast<const u32x4*>(y + C_CQ + 8 * lane), f); float ss = 0.f;
#pragma unroll
          for (int j = 0; j < 8; ++j) ss += f[j] * f[j];
          ss = wave_sum(ss); const float rinv = rsqrtf(ss * (1.0f / 512.f) + EPS); const float* g = gp(p.g_q) + (long)l * 512 + 8 * lane;
#pragma unroll
          for (int j = 0; j < 8; ++j) o[j] = f[j] * rinv * g[j];
          quant_row8(o, (unsigned char*)CQN + (long)t * 512 + 8 * lane, (float*)(ws + WS_SAQ) + t, lane); }
        { float f[8], o[8]; unpack8(*reinterpret_cast<const u32x4*>(y + C_CKV + 8 * lane), f); float ss = 0.f;
#pragma unroll
          for (int j = 0; j < 8; ++j) ss += f[j] * f[j];
          ss = wave_sum(ss); const float rinv = rsqrtf(ss * (1.0f / 512.f) + EPS); const float* g = gp(p.g_kv) + (long)l * 512 + 8 * lane;
#pragma unroll
          for (int j = 0; j < 8; ++j) o[j] = f[j] * rinv * g[j];
          float* od = gp(p.out) + (samp ? O_CKVS + ((long)l * TS + ts) * 512 : O_CKVP + ((long)l * TP + t) * 512) + 8 * lane;
          *reinterpret_cast<f32x4*>(od) = (f32x4){o[0], o[1], o[2], o[3]}; *reinterpret_cast<f32x4*>(od + 4) = (f32x4){o[4], o[5], o[6], o[7]};
          const u32x4 w = pack8(o);
          if (!samp) quant_row8(o, (unsigned char*)CKVNP + (long)t * 512 + 8 * lane, (float*)(ws + WS_SAK) + t, lane);
          else { *reinterpret_cast<u32x4*>(CKA + ((long)b * KPAD + PAST + s) * QLD + 8 * lane) = w;
#pragma unroll
              for (int j = 0; j < 8; ++j) CKT[((long)b * 512 + 8 * lane + j) * KPAD + PAST + s] = f2bf(o[j]); } }
        if (lane < 32) { const float x1 = bf2f(y[C_KR + lane]), x2 = bf2f(y[C_KR + 32 + lane]); const float c = T64[((long)pos * 32 + lane) * 2], sn = T64[((long)pos * 32 + lane) * 2 + 1];
            const float o1 = x1 * c - x2 * sn, o2 = x1 * sn + x2 * c;
            float* od = gp(p.out) + (samp ? O_KRS + ((long)l * TS + ts) * 64 : O_KRP + ((long)l * TP + t) * 64); od[lane] = o1; od[32 + lane] = o2;
            if (!samp) { KRP[(long)t * 64 + lane] = f2bf(o1); KRP[(long)t * 64 + 32 + lane] = f2bf(o2); }
            else { bf16_t* d = CKA + ((long)b * KPAD + PAST + s) * QLD + 512; d[lane] = f2bf(o1); d[32 + lane] = f2bf(o2); } }
        { const int hh = lane >> 3, d0 = (lane & 7) * 8; const float* cs = T128 + ((long)pos * 64 + d0) * 2; float cv[8], sv[8];
#pragma unroll
          for (int j = 0; j < 4; ++j) { const f32x4 q = *reinterpret_cast<const f32x4*>(cs + 4 * j); cv[2 * j] = q[0]; sv[2 * j] = q[1]; cv[2 * j + 1] = q[2]; sv[2 * j + 1] = q[3]; }
#pragma unroll
          for (int which = 0; which < 2; ++which) { bf16_t* base = y + (which ? C_RK : C_RQ) + hh * 128 + d0; const float sca = which ? 0.08838834764831845f : 1.0f;
              float a[8], bq[8], o1[8], o2[8]; unpack8(*reinterpret_cast<const u32x4*>(base), a); unpack8(*reinterpret_cast<const u32x4*>(base + 64), bq);
#pragma unroll
              for (int j = 0; j < 8; ++j) { o1[j] = (a[j] * cv[j] - bq[j] * sv[j]) * sca; o2[j] = (a[j] * sv[j] + bq[j] * cv[j]) * sca; }
              *reinterpret_cast<u32x4*>(base) = pack8(o1); *reinterpret_cast<u32x4*>(base + 64) = pack8(o2); } }
    }
}

__device__ __forceinline__ void post_q(KParams& p) {
    const int lane = otid() & 63; unsigned char* ws = optr(gp(p.ws)); bf16_t* Q = (bf16_t*)(ws + WS_Q); bf16_t* QL = (bf16_t*)(ws + WS_QL); const float* T64 = (const float*)(ws + WS_TAB64);
    for (int t = gwave(); t < T; t += nwaves()) { const int pos = tok_pos(t); const int hd = lane >> 2, d0 = (lane & 3) * 8;
        bf16_t* base = Q + (long)t * 3072 + hd * 192 + 128 + d0; const float* cs = T64 + ((long)pos * 32 + d0) * 2; float cv[8], sv[8];
#pragma unroll
        for (int j = 0; j < 4; ++j) { const f32x4 q = *reinterpret_cast<const f32x4*>(cs + 4 * j); cv[2 * j] = q[0]; sv[2 * j] = q[1]; cv[2 * j + 1] = q[2]; sv[2 * j + 1] = q[3]; }
        float a[8], bq[8], o1[8], o2[8]; unpack8(*reinterpret_cast<const u32x4*>(base), a); unpack8(*reinterpret_cast<const u32x4*>(base + 32), bq);
#pragma unroll
        for (int j = 0; j < 8; ++j) { o1[j] = a[j] * cv[j] - bq[j] * sv[j]; o2[j] = a[j] * sv[j] + bq[j] * cv[j]; }
        const u32x4 w1 = pack8(o1), w2 = pack8(o2);
        *reinterpret_cast<u32x4*>(base) = w1; *reinterpret_cast<u32x4*>(base + 32) = w2;
        if (t >= TP) { const int ts = t - TP, b = ts >> 6, s = ts & 63; bf16_t* d = QL + ((long)b * 1024 + hd * 64 + s) * QLD + 512 + d0;
            *reinterpret_cast<u32x4*>(d) = w1; *reinterpret_cast<u32x4*>(d + 32) = w2; } }
}

__device__ __forceinline__ void softmax_rows(KParams& p) {
    const int lane = otid() & 63; unsigned char* ws = optr(gp(p.ws)); bf16_t* SP = (bf16_t*)(ws + WS_SP);
    for (int r = gwave(); r < DB * 1024; r += nwaves()) { bf16_t* row = SP + (long)r * KPAD; float v[5][8]; float mx = -3.0e38f;
#pragma unroll
        for (int j = 0; j < 5; ++j) { const int ch = lane + 64 * j;
            if (ch < KALL / 8) { unpack8(*reinterpret_cast<const u32x4*>(row + ch * 8), v[j]);
#pragma unroll
                for (int i = 0; i < 8; ++i) { v[j][i] *= MLA_SCALE; mx = fmaxf(mx, v[j][i]); } }
            else {
#pragma unroll
                for (int i = 0; i < 8; ++i) v[j][i] = -3.0e38f; } }
        mx = wave_max(mx); float sum = 0.f;
#pragma unroll
        for (int j = 0; j < 5; ++j) { const int ch = lane + 64 * j;
#pragma unroll
            for (int i = 0; i < 8; ++i) { v[j][i] = (ch < KALL / 8) ? __expf(v[j][i] - mx) : 0.f; sum += v[j][i]; } }
        sum = wave_sum(sum); const float inv = 1.0f / sum;
#pragma unroll
        for (int j = 0; j < 5; ++j) { const int ch = lane + 64 * j;
            if (ch < KPAD / 8) { float o[8];
#pragma unroll
                for (int i = 0; i < 8; ++i) o[i] = v[j][i] * inv;
                *reinterpret_cast<u32x4*>(row + ch * 8) = pack8(o); } } }
}

__device__ __forceinline__ void gnorm_gate(KParams& p, int w0, int nw) {
    const int lane = otid() & 63; unsigned char* ws = optr(gp(p.ws)); const bf16_t* OB = (const bf16_t*)(ws + WS_OB); const bf16_t* Y = (const bf16_t*)(ws + WS_Y);
    for (int t = w0; t < T; t += nw) { const int c0 = (lane >> 3) * 256 + (lane & 7) * 32; float x[4][8]; float s = 0.f;
#pragma unroll
        for (int i = 0; i < 4; ++i) { unpack8(*reinterpret_cast<const u32x4*>(OB + ((long)lane * T + t) * 32 + 8 * i), x[i]);
#pragma unroll
            for (int j = 0; j < 8; ++j) s += x[i][j]; }
        s += sx<1>(s); s += sx<2>(s); s += sx<4>(s); const float mu = s * (1.0f / 256.f); float q = 0.f;
#pragma unroll
        for (int i = 0; i < 4; ++i)
#pragma unroll
            for (int j = 0; j < 8; ++j) { const float d = x[i][j] - mu; q += d * d; }
        q += sx<1>(q); q += sx<2>(q); q += sx<4>(q); const float rstd = rsqrtf(q * (1.0f / 256.f) + EPS);
        float am = 0.f;
#pragma unroll
        for (int i = 0; i < 4; ++i) { float g[8]; unpack8(*reinterpret_cast<const u32x4*>(Y + (long)t * INWP + C_RG + c0 + 8 * i), g);
#pragma unroll
            for (int j = 0; j < 8; ++j) { x[i][j] = siluf_(g[j]) * (x[i][j] - mu) * rstd; am = fmaxf(am, fabsf(x[i][j])); } }
        am = wave_max(am); const float qs = am > 0.f ? 127.0f / am : 0.f; unsigned w[8];
#pragma unroll
        for (int i = 0; i < 4; ++i)
#pragma unroll
            for (int hh = 0; hh < 2; ++hh) { unsigned v = 0u;
#pragma unroll
                for (int j = 0; j < 4; ++j) v |= ((unsigned)((int)__builtin_rintf(x[i][4 * hh + j] * qs) & 0xff)) << (8 * j);
                w[2 * i + hh] = v; }
        *reinterpret_cast<u32x4*>(ws + WS_BG + (long)t * DM + c0) = (u32x4){w[0], w[1], w[2], w[3]};
        *reinterpret_cast<u32x4*>(ws + WS_BG + (long)t * DM + c0 + 16) = (u32x4){w[4], w[5], w[6], w[7]};
        if (lane == 0) ((float*)(ws + WS_SA8))[t] = am * (1.0f / 127.0f); }
}

__device__ __forceinline__ void peer_convert(KParams& p, int l, int r0, int r1, int w0, int nw) {
    unsigned char* ws = optr(gp(p.ws)); const int lane = otid() & 63;
    const float* su = gp(p.peer_u) + (long)l * NEXP * DM; const float* sv = gp(p.peer_v) + (long)l * NEXP * DM;
    for (int r = r0 + w0; r < r1; r += nw) { const bool second = r >= NEXP; const int row = second ? r - NEXP : r; const float* s = (second ? sv : su) + (long)row * DM;
        f32x4 v[8]; float am = 0.f;
#pragma unroll
        for (int j = 0; j < 8; ++j) { v[j] = *reinterpret_cast<const f32x4*>(s + 512 * (j >> 2) * 2 + 16 * lane + 4 * (j & 3));
            am = fmaxf(am, fmaxf(fmaxf(fabsf(v[j][0]), fabsf(v[j][1])), fmaxf(fabsf(v[j][2]), fabsf(v[j][3])))); }
        am = wave_max(am);
        float sc = 1.0f, isc = 1.0f;
        if (am > 0.f) { const int e = (int)((__float_as_uint(am) >> 23) & 0xffu) - 127;
            int k = 7 - e; k = k > 100 ? 100 : (k < -100 ? -100 : k);
            sc = __uint_as_float((unsigned)(127 + k) << 23); isc = __uint_as_float((unsigned)(127 - k) << 23); }
        unsigned w[8];
#pragma unroll
        for (int j = 0; j < 8; ++j) { int pk = __builtin_amdgcn_cvt_pk_fp8_f32(v[j][0] * sc, v[j][1] * sc, 0, false); pk = __builtin_amdgcn_cvt_pk_fp8_f32(v[j][2] * sc, v[j][3] * sc, pk, true); w[j] = (unsigned)pk; }
        if (!second) {
            unsigned char* dst = ws + WS_PU + ((long)(lane >> 3) * NEXP + row) * 128 + 16 * (lane & 7);
            *reinterpret_cast<u32x4*>(dst) = (u32x4){w[0], w[1], w[2], w[3]};
            *reinterpret_cast<u32x4*>(dst + 8L * NEXP * 128) = (u32x4){w[4], w[5], w[6], w[7]};
        } else {
            unsigned char* dst = ws + WS_PV + ((long)(2 * lane) * NEXP + row) * 8;
            *reinterpret_cast<u32x2*>(dst) = (u32x2){w[0], w[1]}; *reinterpret_cast<u32x2*>(dst + (long)NEXP * 8) = (u32x2){w[2], w[3]};
            *reinterpret_cast<u32x2*>(dst + 128L * NEXP * 8) = (u32x2){w[4], w[5]}; *reinterpret_cast<u32x2*>(dst + 129L * NEXP * 8) = (u32x2){w[6], w[7]}; }
        if (lane == 0) ((float*)(ws + (second ? WS_PSV : WS_PSU)))[row] = isc; }
}

__device__ __forceinline__ void final_norm(KParams& p) {
    const int lane = otid() & 63; float* X = gp(p.out);
    for (int t = gwave(); t < T; t += nwaves()) { float* xr = X + (long)t * DM; f32x4 v[8]; float ss = 0.f;
#pragma unroll
        for (int j = 0; j < 8; ++j) { v[j] = *reinterpret_cast<const f32x4*>(xr + 256 * j + 4 * lane); ss += v[j][0] * v[j][0] + v[j][1] * v[j][1] + v[j][2] * v[j][2] + v[j][3] * v[j][3]; }
        ss = wave_sum(ss); const float rinv = rsqrtf(ss * (1.0f / DM) + EPS);
#pragma unroll
        for (int j = 0; j < 8; ++j) { const int c = 256 * j + 4 * lane; const f32x4 gv = *reinterpret_cast<const f32x4*>(gp(p.g_final) + c); *reinterpret_cast<f32x4*>(xr + c) = v[j] * rinv * gv; } }
}
}
__global__ void __launch_bounds__(512, 2) mega_fwd(Params p_by_value_unused) {
    extern __shared__ __attribute__((aligned(16))) unsigned char shm[];
    LAS unsigned char* lds = (LAS unsigned char*)shm; char* ldsg = (char*)shm;
    if (threadIdx.x < 8) ((LAS unsigned*)(lds + LDS_BARW))[threadIdx.x] = 0u;
    __syncthreads();
    if (threadIdx.x == 0) { unsigned* tk = (unsigned*)(gp(KP.ws) + WS_CTL + CTL_RANK) + 64 * xb_xcc_id(); ((volatile LAS unsigned*)(lds + LDS_BARW))[2] = xb_add(tk, 1u); }
    const XcdBarrier bar = xcd_barrier_post((unsigned*)(gp(KP.ws) + WS_CTL), (volatile LAS unsigned*)(lds + LDS_BARW));
#define GRID_SYNC() xcd_barrier(bar)
#ifndef STOP_AT
#define STOP_AT 0
#endif
#ifdef DBG_DUMP
#define STOPCHK(n) do { if (STOP_AT == (n)) { float* xo = gp(KP.out); const bf16_t* src = (const bf16_t*)(gp(KP.ws) + DBG_DUMP); for (long i = ph::gthread(); i < (long)T * DM; i += ph::nthreads()) xo[i] = bf2f(src[i]); return; } } while (0)
#elif defined(DBG_SANITIZE)
#define STOPCHK(n) do { if (STOP_AT == (n) || (STOP_AT > 100 && l == 1 && STOP_AT - 100 == (n))) { float* xo = gp(KP.out); for (long i = ph::gthread(); i < (long)T * DM; i += ph::nthreads()) { const float v = xo[i]; if (!(v - v == 0.0f)) xo[i] = 7.0f; } return; } } while (0)
#else
#define STOPCHK(n) do { if (STOP_AT == (n) || (STOP_AT > 100 && l == 1 && STOP_AT - 100 == (n))) return; } while (0)
#endif
    using namespace pg8;
#define WSP(off) ((bf16_t*)(optr(gp(KP.ws)) + (off)))
#define H WSP(WS_H)
#define Y WSP(WS_Y)
#define CQN WSP(WS_CQN)
#define CKVNP WSP(WS_CKVNP)
#define KRP WSP(WS_KRP)
#define Q WSP(WS_Q)
#define YA WSP(WS_YA)
#define KV WSP(WS_KV)
#define SP WSP(WS_SP)
#define MIX WSP(WS_MIX)
#define OA WSP(WS_OA)
#define QP WSP(WS_QP)
#define CKA WSP(WS_CKA)
#define CKT WSP(WS_CKT)
#define QL WSP(WS_QL)
#define OL WSP(WS_OL)
#define BG WSP(WS_BG)
    int l = 0;
    ph::prologue(KP, ldsg);
#ifdef DUP_PRO
    ph::prologue(KP, ldsg);
#endif
    GRID_SYNC(); STOPCHK(1);
    if (threadIdx.x == 0) { unsigned* barw = (unsigned*)(gp(KP.ws) + WS_CTL); const unsigned me = xb_xcc_id(); unsigned nx = 0, xi = 0, nloc = 1;
        for (unsigned j = 0; j < 16; ++j) { const unsigned cn = xb_ld(&barw[XB_XCNT(j)]); if (cn) { if (j < me) ++xi; ++nx; } if (j == me) nloc = cn ? cn : 1u; }
        volatile LAS unsigned* iw = (volatile LAS unsigned*)(lds + LDS_BARW); iw[3] = xi; iw[4] = nx; iw[5] = nloc; }
    __syncthreads();
    ph::ada_reduce(KP);
    ph::wpq_int8(KP);
    GRID_SYNC(); STOPCHK(2);
    for (l = 0; l < DEPTH; ++l) {
#define WIN (WSP(WS_WIN) + (long)l * INWP * DM)
#define WUQ (WSP(WS_WUQ) + (long)l * 3072 * 512)
#define WUKV (WSP(WS_WUKV) + (long)l * 4096 * 512)
#define WUK (WSP(WS_WUK) + (long)l * 16 * 512 * 256)
#define WA (WSP(WS_WA) + (long)l * DM * DM)
#define WB (WSP(WS_WB) + (long)l * DM * DM)
#define WO (WSP(WS_WO) + (long)l * DM * DM)
#define WPQ (WSP(WS_WPQ) + (long)l * DM * DM)
#define ADA ((const float*)(optr(gp(KP.ws)) + WS_ADA) + (long)l * NCOND * 12288)
        ph::modulate(KP, l, 0);
        ph::win_int8(KP, l);
        ph::wb_int8(KP, l);
        ph::wu_int8(KP, l);
        ph::rows2048_int8(KP, WS_WA + (size_t)l * DM * DM * 2, WS_WA8, WS_SBA, DM);
        ph::rows2048_int8(KP, WS_WO + (size_t)l * DM * DM * 2, WS_WO8, WS_SBO, DM);
        ph::cache_convert(KP, l, ldsg, l == 0 ? 0 : 4096, 8192, obid(), ogrid());
        GRID_SYNC(); STOPCHK(3);
        { Sched<5> S; S.init(T / 256, INWP / 256 - NB8, (T / 256) * (INWP / 256 - NB8), DM, DM); gemm_phase(lds, Gemm{H, WIN, DM, DM, DM}, S, EpiBf16{Y, INWP, 0}); }
        { Sched<6> S; S.init(T / 256, NB8, (T / 256) * NB8, DM / 2, DM / 2);
          { const int G_ = ogrid(); S.rotate((((((T / 256) * NB8) % G_) + 7) & ~7) % G_); }
          unsigned char* ws8 = optr(gp(KP.ws));
          gemm_phase<EpiQ8, Sched<6>, true>(lds, Gemm{(const bf16_t*)(ws8 + WS_H8), (const bf16_t*)(ws8 + WS_WIN8), DM / 2, DM / 2, DM / 2}, S, EpiQ8{Y, INWP, (const float*)(ws8 + WS_SA8), (const float*)(ws8 + WS_SBW)}); }
#ifdef DUP_WIN
        { Sched<0> S; S.init(T / 256, INWP / 256, (T / 256) * (INWP / 256), DM, DM); gemm_phase(lds, Gemm{H, WIN, DM, DM, DM}, S, EpiBf16{Y, INWP, 0}); }
#endif
        GRID_SYNC(); STOPCHK(4);
        ph::post_win(KP, l);
        GRID_SYNC(); STOPCHK(5);
        { unsigned char* ws8 = optr(gp(KP.ws));
          { Sched<0> S; S.init(T / 256, 3072 / 256, (T / 256) * 12, 256, 256); gemm_phase<EpiQ, Sched<0>, 2>(lds, Gemm{CQN, (const bf16_t*)(ws8 + WS_WUQ8), 256, 256, 256, (const float*)(ws8 + WS_SAQ), (const float*)(ws8 + WS_SBQ)}, S, EpiQ{Q, QL, (const float*)(ws8 + WS_TAB64)}); }
          { Sched<0> S; S.init(TP / 256, 4096 / 256, (TP / 256) * 16, 256, 256); gemm_phase<EpiBf16, Sched<0>, 2>(lds, Gemm{CKVNP, (const bf16_t*)(ws8 + WS_WUKV8), 256, 256, 256, (const float*)(ws8 + WS_SAK), (const float*)(ws8 + WS_SBK)}, S, EpiBf16{KV, 4096, 0}); } }
        GRID_SYNC(); STOPCHK(6);
#ifndef DUP_ATTN
#define DUP_ATTN 1
#endif
#ifndef DUP_RET
#define DUP_RET 1
#endif
#ifndef DUP_GATHER
#define DUP_GATHER 0
#endif
#pragma unroll 1
        for (int rep_ = 0; rep_ < DUP_ATTN; ++rep_)
        { for (int u = obid(); u < 512; u += ogrid()) { const int c = u & 255, i = u >> 8, xcd = c & 7, slot = c >> 3; const int bh = xcd * 4 + (slot >> 3) + 32 * i, pr = slot & 7, b = bh >> 4, h = bh & 15;
#pragma unroll 1
              for (int z = 0; z < 2; ++z) { const int qb = z ? 15 - pr : pr; const long tok0 = (long)b * SEQ + 256 * qb;
                  att::attn_block(Q + tok0 * 3072 + h * 192, KV + (long)b * SEQ * 4096 + h * 256, KRP + (long)b * SEQ * 64, KV + (long)b * SEQ * 4096 + h * 256 + 128, OA + tok0 * DM + h * 128, qb, ldsg); } } }
        { Sched<1> S; S.init(0, 0, 256, 3072, 256); gemm_phase(lds, Gemm{Q, WUK, 256, 3072, 256}, S, EpiRowMap<1>{QL, nullptr}); }
        GRID_SYNC(); STOPCHK(8);
        { Sched<2> S; S.init(0, 0, DB * 36, QLD, QLD); gemm_phase(lds, Gemm{QL, CKA, QLD, QLD, QLD}, S, EpiExp{SP, (float*)(optr(gp(KP.ws)) + WS_CTL + CTL_RSUM) + (long)l * 32768}); }
        GRID_SYNC(); STOPCHK(9);
        { Sched<3> S; S.init(0, 0, 256, KPAD, KPAD); gemm_phase(lds, Gemm{SP, CKT, 2176, KPAD, KPAD}, S, EpiRowMap<3>{OL, (const float*)(optr(gp(KP.ws)) + WS_CTL + CTL_RSUM) + (long)l * 32768}); }
        GRID_SYNC(); STOPCHK(11);
        { Sched<4> S; S.init(0, 0, 128, 512, 512); gemm_phase(lds, Gemm{OL, WUKV, 512, 512, 512}, S, EpiOV{OA}); }
#pragma unroll 1
        for (int rep_ = 0; rep_ < DUP_RET; ++rep_)
        for (int u = obid(); u < 256 + DB * 64; u += ogrid()) ret::unit(KP, l, u, ldsg);
#ifdef DUP_RETP
        for (int u = obid(); u < 256; u += ogrid()) ret::unit(KP, l, u, ldsg);
#endif
        GRID_SYNC(); STOPCHK(12);
        ph::rows2048_int8(KP, WS_OA, WS_OA8, WS_SAO, T);
        GRID_SYNC();
        { Sched<0> S; S.init(T / 256, DM / 256, (T / 256) * 8, DM / 2, DM / 2); unsigned char* ws8 = optr(gp(KP.ws));
          gemm_phase<EpiBf16, Sched<0>, 2>(lds, Gemm{(const bf16_t*)(ws8 + WS_OA8), (const bf16_t*)(ws8 + WS_WA8), DM / 2, DM / 2, DM / 2, (const float*)(ws8 + WS_SAO), (const float*)(ws8 + WS_SBA)}, S, EpiBf16{YA, DM, 0}); }
        { const int G_ = ogrid(), rem_ = ((T / 256) * 8) % G_; const int b_ = obid();
          if (rem_ == 0) ph::gnorm_gate(KP, ph::gwave(), ph::nwaves());
          else if (b_ >= rem_) ph::gnorm_gate(KP, (b_ - rem_) * 8 + (otid() >> 6), (G_ - rem_) * 8); }
#ifdef DUP_WA
#pragma unroll 1
        for (int rep_ = 0; rep_ < DUP_WA; ++rep_)
        { Sched<0> S; S.init(T / 256, DM / 256, (T / 256) * 8, DM, DM); gemm_phase(lds, Gemm{OA, WA, DM, DM, DM}, S, EpiBf16{YA, DM, 0}); }
#endif
        GRID_SYNC(); STOPCHK(14);
        { Sched<0> S; S.init(T / 256, DM / 256, (T / 256) * 8, DM / 2, DM / 2); unsigned char* ws8 = optr(gp(KP.ws));
          gemm_phase<EpiMix, Sched<0>, true>(lds, Gemm{(const bf16_t*)(ws8 + WS_BG), (const bf16_t*)(ws8 + WS_WB8), DM / 2, DM / 2, DM / 2}, S, EpiMix{Y, YA, MIX, (const float*)(ws8 + WS_SA8), (const float*)(ws8 + WS_SBB)}); }
        { const int G_ = ogrid(), rem_ = ((T / 256) * 8) % G_; const int b_ = obid();
          if (rem_ == 0) ph::peer_convert(KP, l, 0, NEXP, ph::gwave(), ph::nwaves());
          else if (b_ >= rem_) ph::peer_convert(KP, l, 0, NEXP, (b_ - rem_) * 8 + (otid() >> 6), (G_ - rem_) * 8); }
        GRID_SYNC(); STOPCHK(15);
        ph::rows2048_int8(KP, WS_MIX, WS_MIX8, WS_SA8, T);
        GRID_SYNC();
        { Sched<0> S; S.init(T / 256, DM / 256, (T / 256) * 8, DM / 2, DM / 2); unsigned char* ws8 = optr(gp(KP.ws));
          gemm_phase<EpiRes, Sched<0>, 2>(lds, Gemm{(const bf16_t*)(ws8 + WS_MIX8), (const bf16_t*)(ws8 + WS_WO8), DM / 2, DM / 2, DM / 2, (const float*)(ws8 + WS_SA8), (const float*)(ws8 + WS_SBO)}, S, EpiRes{gp(KP.out), ADA + 2 * DM, l == 0 ? gp(KP.x_prompt) : gp(KP.out), l == 0 ? gp(KP.x_sample) : gp(KP.out) + (long)TP * DM}); }
        { const int G_ = ogrid(), rem_ = ((T / 256) * 8) % G_; const int b_ = obid();
          if (rem_ == 0) ph::peer_convert(KP, l, NEXP, 2 * NEXP, ph::gwave(), ph::nwaves());
          else if (b_ >= rem_) ph::peer_convert(KP, l, NEXP, 2 * NEXP, (b_ - rem_) * 8 + (otid() >> 6), (G_ - rem_) * 8); }
        GRID_SYNC(); STOPCHK(16);
        ph::modulate(KP, l, 1);
        GRID_SYNC(); STOPCHK(17);
        { Sched<0> S; S.init(T / 256, DM / 256, (T / 256) * 8, DM / 2, DM / 2);
          unsigned char* ws8 = optr(gp(KP.ws));
          gemm_phase<EpiQ8, Sched<0>, true>(lds, Gemm{(const bf16_t*)(ws8 + WS_H8), (const bf16_t*)(ws8 + WS_WPQ8 + (long)l * DM * DM), DM / 2, DM / 2, DM / 2}, S, EpiQ8{QP, DM, (const float*)(ws8 + WS_SA8), (const float*)(ws8 + WS_SB8) + (long)l * DM});
#ifdef DUP_WPQ
          gemm_phase<EpiQ8, Sched<0>, true>(lds, Gemm{(const bf16_t*)(ws8 + WS_H8), (const bf16_t*)(ws8 + WS_WPQ8 + (long)l * DM * DM), DM / 2, DM / 2, DM / 2}, S, EpiQ8{QP, DM, (const float*)(ws8 + WS_SA8), (const float*)(ws8 + WS_SB8) + (long)l * DM});
#endif
        }
        if (l + 1 < DEPTH) { const int G_ = ogrid(), rem_ = ((T / 256) * 8) % G_; const int b_ = obid();
          if (rem_ == 0) ph::cache_convert(KP, l + 1, ldsg, 0, 4096, b_, G_);
          else if (b_ >= rem_) ph::cache_convert(KP, l + 1, ldsg, 0, 4096, b_ - rem_, G_ - rem_); }
        GRID_SYNC(); STOPCHK(18);
        { const int tid_ = otid(); const int lane = tid_ & 63; float* strip = (float*)ldsg + tid_ * 33; unsigned char* ws = optr(gp(KP.ws));
          const bf16_t* k1g = (const bf16_t*)(ws + WS_PK1) + (long)l * 128 * 128; const bf16_t* k2g = (const bf16_t*)(ws + WS_PK2) + (long)l * 128 * 128;
          bf16_t* k1 = (bf16_t*)(ldsg + 512 * 33 * 4 + 64); bf16_t* k2 = k1 + 128 * peer::KPITCH;
          for (int i = tid_; i < 2 * 128 * 16; i += 512) { const int which = i >> 11, r = (i >> 4) & 127, ch = i & 15;
              *reinterpret_cast<u32x4*>((which ? k2 : k1) + r * peer::KPITCH + ch * 8) = *reinterpret_cast<const u32x4*>((which ? k2g : k1g) + r * 128 + ch * 8); }
          __syncthreads();
          for (int wu = ph::gwave(); wu < (T / 32) * PH; wu += ph::nwaves()) peer::select_unit(QP, k1, k2, (int*)(ws + WS_PIDX), (float*)(ws + WS_PW), (wu >> 3) * 32, wu & 7, lane, strip);
#ifdef DUP_SEL
          for (int wu = ph::gwave(); wu < (T / 32) * PH; wu += ph::nwaves()) peer::select_unit(QP, k1, k2, (int*)(ws + WS_PIDX), (float*)(ws + WS_PW), (wu >> 3) * 32, wu & 7, lane, strip);
#endif
        }
        GRID_SYNC(); STOPCHK(19);
        { const int tid_ = otid(); const int lane = tid_ & 63, wid = tid_ >> 6; unsigned char* ws = optr(gp(KP.ws));
          volatile LAS unsigned* iw = (volatile LAS unsigned*)(lds + LDS_BARW); peer::XInfo xin; xin.rank = __builtin_amdgcn_readfirstlane((int)iw[2]); xin.xi = __builtin_amdgcn_readfirstlane((int)iw[3]); xin.nx = __builtin_amdgcn_readfirstlane((int)iw[4]); xin.nloc = __builtin_amdgcn_readfirstlane((int)iw[5]);
          if (xin.nx >= 1 && xin.nx <= 8) {
              peer::upass(H, (const unsigned char*)(ws + WS_PU), (const int*)(ws + WS_PIDX), (const float*)(ws + WS_PW), (const float*)(ws + WS_PSU), (const float*)(ws + WS_PSV), (float*)(ws + WS_DOTP), (unsigned*)(ws + WS_ACT), xin, wid, lane);
              GRID_SYNC();
              int vs0_, vsn_, vse_;
              if ((256 % xin.nx) == 0) { const int spx = 256 / xin.nx; vs0_ = xin.xi * spx + xin.rank; vsn_ = xin.nloc; vse_ = (xin.xi + 1) * spx; }
              else { vs0_ = obid(); vsn_ = ogrid(); vse_ = 256; }
              peer::vpass_lds((const unsigned char*)(ws + WS_PV), (const unsigned*)(ws + WS_ACT), gp(KP.out), ADA + 5 * DM, ldsg, vs0_, vsn_, vse_, tid_);
#ifdef DUP_VP
              peer::vpass_lds((const unsigned char*)(ws + WS_PV), (const unsigned*)(ws + WS_ACT), (float*)(ws + WS_OB), ADA + 5 * DM, ldsg, vs0_, vsn_, vse_, tid_);
#endif
          } else {
              for (int t = ph::gwave(); t < T; t += ph::nwaves()) peer::gather_token(H, (const unsigned char*)(ws + WS_PU), (const unsigned char*)(ws + WS_PV), (const float*)(ws + WS_PSU), (const float*)(ws + WS_PSV), (const int*)(ws + WS_PIDX), (const float*)(ws + WS_PW), gp(KP.out), ADA + 5 * DM, t, lane);
          } }
        GRID_SYNC(); STOPCHK(20);
    }
    ph::final_norm(KP);
}

extern "C" void kernel_launch(void* const* d_in, const int* in_sizes, int n_in, void* d_out, int out_size, void* d_ws, size_t ws_size, hipStream_t stream) {
    static int grid = 0;
    if (grid == 0) {
        if (n_in != 25 || out_size != (int)O_END || ws_size < WS_END) { fprintf(stderr, "kernel_launch: shape mismatch: n_in %d out %d (want %ld) ws %zu (want >= %zu)\n", n_in, out_size, O_END, ws_size, (size_t)WS_END); grid = -1; return; }
        int dev = 0, cus = 0, per_cu = 0;
        if (hipGetDevice(&dev) != hipSuccess || hipDeviceGetAttribute(&cus, hipDeviceAttributeMultiprocessorCount, dev) != hipSuccess) { fprintf(stderr, "kernel_launch: device query failed\n"); grid = -1; return; }
        if (hipFuncSetAttribute((const void*)mega_fwd, hipFuncAttributeMaxDynamicSharedMemorySize, LDS_BYTES) != hipSuccess) { fprintf(stderr, "kernel_launch: hipFuncSetAttribute failed\n"); grid = -1; return; }
        if (hipOccupancyMaxActiveBlocksPerMultiprocessor(&per_cu, (const void*)mega_fwd, 512, LDS_BYTES) != hipSuccess || per_cu < 1) { fprintf(stderr, "kernel_launch: occupancy query says %d blocks per CU\n", per_cu); grid = -1; return; }
        grid = cus;
#ifdef FORCE_GRID
        grid = FORCE_GRID;
#endif
    }
    if (grid < 0) return;
    (void)hipMemsetAsync((char*)d_ws + WS_CTL, 0, CTL_BYTES, stream);
    Params p{};
    const float* const* in = (const float* const*)d_in;
    p.x_prompt = in[0]; p.x_sample = in[1]; p.c_prompt = in[2]; p.c_sample = in[3]; p.cache_ckv = in[4]; p.cache_krope = in[5]; p.state_ret = in[6]; p.w_ada = in[7]; p.b_ada = in[8];
    p.g_mix = in[9]; p.g_ffn = in[10]; p.w_in = in[11]; p.g_q = in[12]; p.w_uq = in[13]; p.g_kv = in[14]; p.w_ukv = in[15]; p.w_a = in[16]; p.w_b = in[17]; p.w_o = in[18]; p.w_pq = in[19];
    p.peer_k1 = in[20]; p.peer_k2 = in[21]; p.peer_u = in[22]; p.peer_v = in[23]; p.g_final = in[24];
    p.out = (float*)d_out; p.ws = (unsigned char*)d_ws;
    for (int h = 0; h < 8; ++h) p.lg[h] = (float)log1p(-pow(2.0, -5.0 - (double)h));
    p.grid = grid; p.pad_ = 0;
    hipLaunchKernelGGL(mega_fwd, dim3(grid), dim3(512), LDS_BYTES, stream, p);
    const hipError_t le = hipGetLastError();
    if (le != hipSuccess) fprintf(stderr, "kernel_launch: launch failed: %s\n", hipGetErrorName(le));
}
```

```cpp
#include <hip/hip_runtime.h>
#include <cstdio>
#include <cstdint>
#include <cmath>

#define LAS __attribute__((address_space(3)))
typedef unsigned short bf16_t;
typedef short bf16x8 __attribute__((ext_vector_type(8)));
typedef float f32x4 __attribute__((ext_vector_type(4)));
typedef float f32x2 __attribute__((ext_vector_type(2)));
typedef float f32x16 __attribute__((ext_vector_type(16)));
typedef unsigned u32x4 __attribute__((ext_vector_type(4)));
typedef unsigned u32x2 __attribute__((ext_vector_type(2)));
typedef short s16x4 __attribute__((ext_vector_type(4)));
typedef int i32x4 __attribute__((ext_vector_type(4)));

constexpr int DM = 2048, NB = 4, SEQ = 4096, DEPTH = 2, DB = 32, DS = 64, PAST = 2048;
constexpr int TP = NB * SEQ, TS = DB * DS, T = TP + TS;
constexpr int NCOND = NB + DB;
constexpr int QLORA = 512, KVLORA = 512, ROPE = 64, NOPE = 128, VD = 128, MH = 16, QKD = 192;
constexpr int RH = 8, RQK = 128, RV = 256;
constexpr int PH = 8, NKEYS = 128, NEXP = 16384, PTOPK = 16;
constexpr int INW = 11328, INWP = 11520;
constexpr int C_CQ = 0, C_CKV = 512, C_KR = 1024, C_RQ = 1088, C_RK = 2112, C_RV = 3136, C_RG = 5184, C_GA = 7232, C_GB = 9280;
constexpr int KALL = PAST + DS;
constexpr int KPAD = 2304;
constexpr int QLD = 640;
constexpr float EPS = 1e-6f;
constexpr float MLA_SCALE = 0.07216878364870322f;

constexpr long O_Y = 0;
constexpr long O_CKVP = (long)T * DM;
constexpr long O_KRP = O_CKVP + 2L * TP * 512;
constexpr long O_RETP = O_KRP + 2L * TP * 64;
constexpr long O_CKVS = O_RETP + 2L * NB * RH * RQK * RV;
constexpr long O_KRS = O_CKVS + 2L * TS * 512;
constexpr long O_RETS = O_KRS + 2L * TS * 64;
constexpr long O_END = O_RETS + 2L * DB * RH * RQK * RV;

constexpr size_t al256(size_t x) { return (x + 255) / 256 * 256; }
constexpr size_t WS_CTL = 0;
constexpr size_t CTL_BYTES = 65536 + 2UL * 32768 * 4;
constexpr size_t CTL_RSUM = 65536;
constexpr size_t WS_TAB64 = WS_CTL + CTL_BYTES;
constexpr size_t WS_TAB128 = WS_TAB64 + 4096UL * 32 * 2 * 4;
constexpr size_t WS_ADA = WS_TAB128 + 4096UL * 64 * 2 * 4;
constexpr size_t WS_ADAP = WS_ADA + 2UL * NCOND * 12288 * 4;
constexpr size_t WS_WIN = WS_ADAP + 8UL * 2 * NCOND * 12288 * 4;
constexpr size_t WS_WUQ = WS_WIN + 2UL * INWP * DM * 2;
constexpr size_t WS_WUKV = WS_WUQ + 2UL * 3072 * 512 * 2;
constexpr size_t WS_WUK = WS_WUKV + 2UL * 4096 * 512 * 2;
constexpr size_t WS_WA = WS_WUK + 2UL * 16 * 512 * 256 * 2;
constexpr size_t WS_WB = WS_WA + 2UL * DM * DM * 2;
constexpr size_t WS_WO = WS_WB + 2UL * DM * DM * 2;
constexpr size_t WS_WPQ = WS_WO + 2UL * DM * DM * 2;
constexpr size_t WS_PK1 = WS_WPQ + 2UL * DM * DM * 2;
constexpr size_t WS_PK2 = WS_PK1 + 2UL * 128 * 128 * 2;
constexpr size_t WS_H = WS_PK2 + 2UL * 128 * 128 * 2;
constexpr size_t WS_Y = WS_H + (size_t)T * DM * 2;
constexpr size_t WS_CQN = WS_Y + (size_t)T * INWP * 2;
constexpr size_t WS_CKVNP = WS_CQN + (size_t)T * 512 * 2;
constexpr size_t WS_KRP = WS_CKVNP + (size_t)TP * 512 * 2;
constexpr size_t WS_Q = WS_KRP + (size_t)TP * 64 * 2;
constexpr size_t WS_YA = WS_Q;
constexpr size_t WS_KV = WS_Q + (size_t)T * 3072 * 2 + 4096;
constexpr size_t WS_SP = WS_KV;
constexpr size_t WS_MIX = WS_KV;
constexpr size_t WS_OA = WS_KV + 32UL * 1024 * KPAD * 2;
constexpr size_t WS_QP = WS_OA;
constexpr size_t WS_CKA = WS_OA + (size_t)T * DM * 2;
constexpr size_t WS_CKT = WS_CKA + 32UL * KPAD * QLD * 2;
constexpr size_t WS_QL = WS_CKT + 32UL * 512 * KPAD * 2;
constexpr size_t WS_OL = WS_QL + 32UL * 1024 * QLD * 2;
constexpr size_t WS_OB = WS_OL + 16UL * 2048 * 512 * 2;
constexpr size_t WS_BG = WS_OB + (size_t)T * DM * 2;
constexpr size_t WS_PIDX = WS_BG + (size_t)T * DM * 2;
constexpr size_t WS_PW = WS_PIDX + (size_t)T * 128 * 4;
constexpr size_t WS_PU = WS_PW + (size_t)T * 128 * 4;
constexpr size_t WS_PV = WS_PU + (size_t)NEXP * DM;
constexpr size_t WS_PSU = WS_PV + (size_t)NEXP * DM;
constexpr size_t WS_PSV = WS_PSU + (size_t)NEXP * 4;
constexpr size_t WS_WPQ8 = WS_PSV + (size_t)NEXP * 4;
constexpr size_t WS_SB8 = WS_WPQ8 + 2UL * DM * DM;
constexpr size_t WS_SA8 = WS_SB8 + 2UL * DM * 4;
constexpr int NB8 = 38;
constexpr size_t WS_WIN8 = WS_BG + (size_t)T * DM;
constexpr size_t WS_WB8 = WS_WIN8 + (size_t)NB8 * 256 * DM;
constexpr size_t WS_WUQ8 = WS_WB8 + (size_t)DM * DM;
constexpr size_t WS_WUKV8 = WS_WUQ8 + 3072UL * 512;
constexpr size_t WS_WA8 = WS_WUKV8 + 4096UL * 512;
constexpr size_t WS_WO8 = WS_WA8 + (size_t)DM * DM;
static_assert(WS_WO8 + (size_t)DM * DM <= WS_BG + (size_t)T * DM * 2, "int8 weights overflow the BG region");
constexpr size_t WS_OA8 = WS_Q + (size_t)T * DM * 2;
constexpr size_t WS_MIX8 = WS_KV + (size_t)T * DM * 2;
static_assert(WS_OA8 + (size_t)T * DM <= WS_KV && WS_MIX8 + (size_t)T * DM <= WS_KV + (size_t)TP * 4096 * 2, "int8 activation copies fit");
constexpr size_t WS_SBW = WS_SA8 + al256((size_t)T * 4);
constexpr size_t WS_SBB = WS_SBW + al256((size_t)INWP * 4);
constexpr size_t WS_SBQ = WS_SBB + (size_t)DM * 4;
constexpr size_t WS_SBK = WS_SBQ + 3072UL * 4;
constexpr size_t WS_SAQ = WS_SBK + 4096UL * 4;
constexpr size_t WS_SAK = WS_SAQ + al256((size_t)T * 4);
constexpr size_t WS_SBA = WS_SAK + al256((size_t)TP * 4);
constexpr size_t WS_SBO = WS_SBA + (size_t)DM * 4;
constexpr size_t WS_SAO = WS_SBO + (size_t)DM * 4;
constexpr size_t WS_END = WS_SAO + al256((size_t)T * 4);
constexpr size_t WS_H8 = WS_OB;
static_assert((size_t)TP * 4096 * 2 <= 32UL * 1024 * KPAD * 2, "KV fits in the SP region");
static_assert(WS_END <= 1608000000UL, "workspace map too large");
static_assert(WS_WIN % 256 == 0 && WS_H % 256 == 0 && WS_Y % 256 == 0 && WS_Q % 256 == 0 && WS_KV % 256 == 0 && WS_CKA % 256 == 0, "alignment");

constexpr int LDS_BYTES = 147456;
constexpr int LDS_BARW = LDS_BYTES - 32;
constexpr size_t CTL_RANK = 16384;
constexpr size_t WS_DOTP = WS_Q;
constexpr size_t WS_ACT = WS_DOTP + 8UL * T * 128 * 4;
constexpr size_t WS_PIDXT = WS_ACT + (size_t)T * 128 * 4;
static_assert(WS_PIDXT + (size_t)T * 128 * 4 <= WS_KV, "PEER scratch fits in the Q region");

struct Params {
    const float *x_prompt, *x_sample, *c_prompt, *c_sample, *cache_ckv, *cache_krope, *state_ret, *w_ada, *b_ada, *g_mix, *g_ffn, *w_in, *g_q, *w_uq, *g_kv, *w_ukv,
                *w_a, *w_b, *w_o, *w_pq, *peer_k1, *peer_k2, *peer_u, *peer_v, *g_final;
    float* out; unsigned char* ws;
    float lg[8];
    int grid; int pad_;
};

typedef const __attribute__((address_space(4))) Params KParams;
__device__ __forceinline__ KParams* okarg() {
    const uintptr_t k = (uintptr_t)__builtin_amdgcn_kernarg_segment_ptr();
    unsigned lo = (unsigned)k, hi = (unsigned)(k >> 32);
    asm volatile("" : "+s"(lo), "+s"(hi)); return (KParams*)(((uintptr_t)hi << 32) | lo); }
#define KP (*okarg())
__device__ __forceinline__ int ogrid() { return KP.grid; }
__device__ __forceinline__ int obid() { int b = (int)blockIdx.x; asm volatile("" : "+s"(b) :: "memory"); return b; }
__device__ __forceinline__ int otid() { int t = (int)threadIdx.x; asm volatile("" : "+v"(t) :: "memory"); return t; }
template <class P> __device__ __forceinline__ P* gp(P* p) { return (P*)(__attribute__((address_space(1))) P*)(uintptr_t)p; }
template <class P> __device__ __forceinline__ P* optr(P* p) {
    unsigned lo = __builtin_amdgcn_readfirstlane((unsigned)(uintptr_t)p), hi = __builtin_amdgcn_readfirstlane((unsigned)((uintptr_t)p >> 32));
    asm volatile("" : "+s"(lo), "+s"(hi)); return gp((P*)(((uintptr_t)hi << 32) | lo)); }
typedef __bf16 bf16v2_t __attribute__((ext_vector_type(2)));
__device__ __forceinline__ unsigned cvt_pk_bf16(float lo, float hi) { f32x2 v = {lo, hi}; bf16v2_t r = __builtin_convertvector(v, bf16v2_t); return __builtin_bit_cast(unsigned, r); }
__device__ __forceinline__ bf16_t f2bf(float f) { return (bf16_t)(cvt_pk_bf16(f, 0.f) & 0xffffu); }
__device__ __forceinline__ float bf2f(bf16_t b) { return __uint_as_float(((unsigned)b) << 16); }
__device__ __forceinline__ float bflo(unsigned w) { return __uint_as_float(w << 16); }
__device__ __forceinline__ float bfhi(unsigned w) { return __uint_as_float(w & 0xffff0000u); }
__device__ __forceinline__ void unpack8(const u32x4 w, float (&f)[8]) { f[0] = bflo(w.x); f[1] = bfhi(w.x); f[2] = bflo(w.y); f[3] = bfhi(w.y); f[4] = bflo(w.z); f[5] = bfhi(w.z); f[6] = bflo(w.w); f[7] = bfhi(w.w); }
__device__ __forceinline__ u32x4 pack8(const float (&f)[8]) { u32x4 w; w.x = cvt_pk_bf16(f[0], f[1]); w.y = cvt_pk_bf16(f[2], f[3]); w.z = cvt_pk_bf16(f[4], f[5]); w.w = cvt_pk_bf16(f[6], f[7]); return w; }
template <int K> __device__ __forceinline__ float sx(float v) {
    if constexpr (K == 32) { const auto rr = __builtin_amdgcn_permlane32_swap(__float_as_uint(v), __float_as_uint(v), false, false); return __uint_as_float((otid() & 32) ? rr[0] : rr[1]); }
    else return __int_as_float(__builtin_amdgcn_ds_swizzle(__float_as_int(v), (K << 10) | 0x1F));
}
__device__ __forceinline__ float wave_sum(float v) { v += sx<32>(v); v += sx<16>(v); v += sx<8>(v); v += sx<4>(v); v += sx<2>(v); v += sx<1>(v); return v; }
__device__ __forceinline__ float wave_max(float v) { v = fmaxf(v, sx<32>(v)); v = fmaxf(v, sx<16>(v)); v = fmaxf(v, sx<8>(v)); v = fmaxf(v, sx<4>(v)); v = fmaxf(v, sx<2>(v)); v = fmaxf(v, sx<1>(v)); return v; }
__device__ __forceinline__ float sigmoidf_(float x) { return 1.0f / (1.0f + __expf(-x)); }
__device__ __forceinline__ float siluf_(float x) { return x / (1.0f + __expf(-x)); }
__device__ __forceinline__ int cond_row(int t) { return t < TP ? (t >> 12) : NB + ((t - TP) >> 6); }
__device__ __forceinline__ int tok_pos(int t) { return t < TP ? (t & 4095) : PAST + ((t - TP) & 63); }

#define XB_TMO      128
#define XB_XCNT(j)  (256  + 64 * (j))
#define XB_XSUB(j)  (1280 + 64 * (j))
#define XB_XGEN(j)  (2304 + 64 * (j))
#define XB_TOP      3328
#define XB_TOPGEN   3392
#define XCD_BAR_WORDS 3456
#define XB_SPIN_CAP (1u << 22)
__device__ __forceinline__ unsigned xb_ld(unsigned* p)              { return __hip_atomic_load(p, __ATOMIC_RELAXED, __HIP_MEMORY_SCOPE_AGENT); }
__device__ __forceinline__ unsigned xb_add(unsigned* p, unsigned v) { return __hip_atomic_fetch_add(p, v, __ATOMIC_RELAXED, __HIP_MEMORY_SCOPE_AGENT); }
__device__ __forceinline__ unsigned xb_xcc_id() { return (unsigned)__builtin_amdgcn_s_getreg((3 << 11) | 20) & 0xFu; }
#define XB_SPIN(cond, bar) do { unsigned _sp = 0; while (cond) { __builtin_amdgcn_s_sleep(1); \
    if ((++_sp & 255u) == 0u) { if (xb_ld(&(bar)[XB_TMO])) break; if (_sp > XB_SPIN_CAP) { atomicAdd(&(bar)[XB_TMO], 1u); break; } } } } while (0)
struct XcdBarrier { unsigned* bar; unsigned x; volatile LAS unsigned* st; };
__device__ __forceinline__ XcdBarrier xcd_barrier_post(unsigned* bar, volatile LAS unsigned* st) {
    XcdBarrier b; b.bar = bar; b.x = xb_xcc_id(); b.st = st;
    if (threadIdx.x == 0) (void)xb_add(&bar[XB_XCNT(b.x)], 1u);
    return b;
}
__device__ __forceinline__ void xcd_barrier_complete(unsigned* bar, unsigned x, unsigned& nloc, unsigned& nx) {
    const unsigned G = (unsigned)KP.grid;
    unsigned sum, cnt, mine, sp = 0u;
    for (;;) {
        sum = 0u; cnt = 0u; mine = 0u;
#pragma unroll
        for (unsigned j = 0; j < 16; ++j) { const unsigned c = xb_ld(&bar[XB_XCNT(j)]); sum += c; cnt += (c > 0u) ? 1u : 0u; mine = (j == x) ? c : mine; }
        if (sum == G) break;
        __builtin_amdgcn_s_sleep(1);
        if ((++sp & 255u) == 0u) { if (xb_ld(&bar[XB_TMO])) break; if (sp > XB_SPIN_CAP) { atomicAdd(&bar[XB_TMO], 1u); break; } }
    }
    nloc = mine > 0u ? mine : 1u; nx = cnt > 0u ? cnt : 1u;
}
__device__ __forceinline__ void xcd_barrier(const XcdBarrier& b) {
    asm volatile("s_waitcnt vmcnt(0)" ::: "memory");
    __syncthreads();
    if (otid() == 0) {
        unsigned* bar = (unsigned*)(gp(KP.ws) + WS_CTL);
        unsigned bx = xb_xcc_id(); asm volatile("" : "+s"(bx));
        __builtin_amdgcn_s_waitcnt(0);
        unsigned nloc = b.st[0], nx = b.st[1];
        if (nloc == 0u) { xcd_barrier_complete(bar, bx, nloc, nx); b.st[0] = nloc; b.st[1] = nx; }
        const unsigned old = xb_add(&bar[XB_XSUB(bx)], 1u);
        const unsigned gen = old / nloc;
        if (old + 1u == (gen + 1u) * nloc) {
            __builtin_amdgcn_fence(__ATOMIC_RELEASE, "agent");
            asm volatile("s_waitcnt vmcnt(0)" ::: "memory");
            const unsigned og = xb_add(&bar[XB_TOP], 1u);
            const unsigned tg = og / nx;
            if (og + 1u == (tg + 1u) * nx) xb_add(&bar[XB_TOPGEN], 1u);
            else XB_SPIN(xb_ld(&bar[XB_TOPGEN]) == tg, bar);
            __builtin_amdgcn_fence(__ATOMIC_ACQUIRE, "agent");
            xb_add(&bar[XB_XGEN(bx)], 1u);
            asm volatile("s_waitcnt vmcnt(0)" ::: "memory");
        } else {
            XB_SPIN(xb_ld(&bar[XB_XGEN(bx)]) == gen, bar);
            __builtin_amdgcn_fence(__ATOMIC_ACQUIRE, "agent");
            asm volatile("s_waitcnt vmcnt(0)" ::: "memory");
        }
    }
    __syncthreads();
}
namespace pg8 {
constexpr int BM = 256, BK = 64, HALF = 128, HTB = HALF * BK * 2, STAGE_BYTES = 8 * HTB, NXCD = 8, WGM = 8;
__host__ __device__ __forceinline__ int lds_byte(int r, int c) { const int st = (r >> 4) * 2 + (c >> 5), rr = r & 15, cc = c & 31, ob = rr * 64 + cc * 2; return st * 1024 + (ob ^ (((ob >> 9) & 1) << 5)); }
__host__ __device__ __forceinline__ void stage_rc(int b, int& R, int& C) { const int st = b / 1024, sb = b % 1024, swz = sb ^ (((sb >> 9) & 1) << 5); R = (st >> 1) * 16 + swz / 64; C = (st & 1) * 32 + (swz % 64) / 2; }
__host__ __device__ __forceinline__ int perm32(int rho) { const int n = rho >> 4, i = rho & 15; return 8 * (i >> 2) + 4 * n + (i & 3); }

struct Unit { int pm, pn; long aoff, boff; int x0, x1; };
struct Gemm { const bf16_t* A; const bf16_t* Bt; int K; int lda, ldb; const float* sa; const float* sb; };

template <int MODE> struct Sched {
    int nM, nN, nwg, G, c; long lda, ldb;
    __device__ void init(int nM_, int nN_, int nwg_, long lda_, long ldb_) { nM = nM_; nN = nN_; nwg = nwg_; G = ogrid(); c = obid(); lda = lda_; ldb = ldb_; }
    __device__ void rotate(int r) { c = (c + r) % G; }
    __device__ bool next(int i, Unit& u) const {
        const long L = (long)i * G + c; if (L >= nwg) return false;
        int wgid = (int)L;
        if (MODE == 0 || MODE == 5 || MODE == 6) {
            { const int q = nwg / NXCD, r = nwg % NXCD, xcd = wgid % NXCD, off = wgid / NXCD; wgid = (xcd < r ? xcd * (q + 1) : r * (q + 1) + (xcd - r) * q) + off; }
            const int nig = WGM * nN, gid = wgid / nig, fm = gid * WGM, gsz = (nM - fm) < WGM ? (nM - fm) : WGM;
            u.pm = fm + ((wgid % nig) % gsz); u.pn = (wgid % nig) / gsz; u.x0 = 0; u.x1 = 0;
            { const int pl = u.pn;
              if (MODE == 5) u.pn = pl < 3 ? pl + 2 : pl + 5;
              if (MODE == 6) u.pn = pl < 2 ? pl : (pl < 5 ? pl + 3 : pl + 7);
              u.aoff = (long)u.pm * 256 * lda * 2; u.boff = (long)(MODE == 6 ? pl : u.pn) * 256 * ldb * 2; }
        } else if (MODE == 1) {
            const int h = wgid >> 4, rem = wgid & 15, rt = rem >> 1, pn = rem & 1;
            u.pm = rt; u.pn = pn; u.x0 = h; u.x1 = rt;
            u.aoff = ((long)(TP + 256 * rt) * 3072 + h * 192) * 2; u.boff = ((long)(h * 512 + 256 * pn) * 256) * 2;
        } else if (MODE == 2) {
            const int b = wgid / 36, rem = wgid % 36, pm = rem / 9, pn = rem % 9;
            u.pm = pm; u.pn = pn; u.x0 = b; u.x1 = 0;
            u.aoff = ((long)(b * 1024 + 256 * pm) * QLD) * 2; u.boff = ((long)(b * KPAD + 256 * pn) * QLD) * 2;
        } else if (MODE == 3) {
            const int b = wgid >> 3, pm = (wgid & 7) >> 1, pn = wgid & 1;
            u.pm = pm; u.pn = pn; u.x0 = b; u.x1 = 0;
            u.aoff = ((long)(b * 1024 + 256 * pm) * KPAD) * 2; u.boff = ((long)(b * 512 + 256 * pn) * KPAD) * 2;
        } else {
            const int h = wgid >> 3, rt = wgid & 7;
            u.pm = rt; u.pn = 0; u.x0 = h; u.x1 = rt;
            u.aoff = ((long)(h * 2048 + 256 * rt) * 512) * 2; u.boff = ((long)(h * 256) * 512) * 2;
        }
        return true;
    }
};

template <class Epi, class SchedT, int I8 = 0>
__device__ __forceinline__ void gemm_phase(LAS unsigned char* lds, const Gemm g, const SchedT& S, const Epi& E) {
    const int tid = otid(), wid = __builtin_amdgcn_readfirstlane(tid >> 6), lane = tid & 63, wr = wid >> 2, wc = wid & 3, fr = lane & 15, fq = lane >> 4;
    const int K = g.K, nt = K / BK;
    unsigned voffA[2], voffB[2];
#pragma unroll
    for (int i = 0; i < 2; ++i) { int R, C; stage_rc(tid * 16 + i * 8192, R, C); const int Rb = Epi::PERM ? ((R & ~31) + perm32(R & 31)) : R;
        voffA[i] = (unsigned)(R * g.lda + C) * 2u; voffB[i] = (unsigned)(Rb * g.ldb + C) * 2u; }
    const size_t kstep = (size_t)(BK * 2);
    const size_t hstepA = (size_t)HALF * g.lda * 2, hstepB = (size_t)HALF * g.ldb * 2;
    const unsigned ldsw = (unsigned)wid * 1024u;
    const int aoff = lds_byte(wr * 64 + fr, fq * 8), boff = lds_byte(wc * 32 + fr, fq * 8);
#define PG8_SA(b, h) (((b) * 2 + (h)) * HTB)
#define PG8_SB(b, h) ((4 + (b) * 2 + (h)) * HTB)
#define PG8_STAGE(bufoff, gbase, voff) do { _Pragma("unroll") for (int _i = 0; _i < 2; ++_i) \
        __builtin_amdgcn_global_load_lds((const unsigned*)((const char*)(gbase) + (voff)[_i]), (LAS unsigned*)(lds + (bufoff) + ldsw + _i * 8192), 16, 0, 0); } while (0)
#define PG8_LDA(dst, b, h) do { _Pragma("unroll") for (int m = 0; m < 4; ++m) _Pragma("unroll") for (int k = 0; k < 2; ++k) dst[m][k] = *(const LAS bf16x8*)(lds + PG8_SA(b, h) + aoff + m * 2048 + k * 1024); } while (0)
#define PG8_LDB(dst, b, h) do { _Pragma("unroll") for (int n = 0; n < 2; ++n) _Pragma("unroll") for (int k = 0; k < 2; ++k) dst[n][k] = *(const LAS bf16x8*)(lds + PG8_SB(b, h) + boff + n * 2048 + k * 1024); } while (0)
#define PG8_MMA(ai, bj, At, Bt) do { __builtin_amdgcn_s_setprio(1); _Pragma("unroll") for (int m = 0; m < 4; ++m) _Pragma("unroll") for (int n = 0; n < 2; ++n) _Pragma("unroll") for (int k = 0; k < 2; ++k) \
        { if constexpr (I8) acc[ai][bj][m][n] = __builtin_bit_cast(f32x4, __builtin_amdgcn_mfma_i32_16x16x64_i8(__builtin_bit_cast(i32x4, Bt[n][k]), __builtin_bit_cast(i32x4, At[m][k]), __builtin_bit_cast(i32x4, acc[ai][bj][m][n]), 0, 0, 0)); \
          else acc[ai][bj][m][n] = __builtin_amdgcn_mfma_f32_16x16x32_bf16(Bt[n][k], At[m][k], acc[ai][bj][m][n], 0, 0, 0); } __builtin_amdgcn_s_setprio(0); } while (0)
#define PG8_WAIT_V(n) asm volatile("s_waitcnt vmcnt(" #n ")" ::: "memory")
#define PG8_WAIT_L(n) asm volatile("s_waitcnt lgkmcnt(" #n ")" ::: "memory")
#define PG8_BAR __builtin_amdgcn_s_barrier()
#define PG8_SCHED __builtin_amdgcn_sched_barrier(0)
    Unit cur, nxt; int ui = 0;
    if (!S.next(0, cur)) return;
    f32x4 acc[2][2][4][2];
#pragma unroll
    for (int a = 0; a < 2; ++a)
#pragma unroll
        for (int b = 0; b < 2; ++b)
#pragma unroll
            for (int m = 0; m < 4; ++m)
#pragma unroll
                for (int n = 0; n < 2; ++n) acc[a][b][m][n] = (f32x4){0.f, 0.f, 0.f, 0.f};
    bf16x8 At[4][2], B0[2][2], B1[2][2];
    const char* cA = (const char*)g.A + cur.aoff; const char* cB = (const char*)g.Bt + cur.boff;
    PG8_STAGE(PG8_SB(0, 0), cB, voffB); PG8_STAGE(PG8_SA(0, 0), cA, voffA); PG8_STAGE(PG8_SB(0, 1), cB + hstepB, voffB); PG8_STAGE(PG8_SA(0, 1), cA + hstepA, voffA);
    if (wr == 1) PG8_BAR;
    PG8_WAIT_V(4); PG8_BAR;
    PG8_STAGE(PG8_SB(1, 0), cB + kstep, voffB); PG8_STAGE(PG8_SA(1, 0), cA + kstep, voffA); PG8_STAGE(PG8_SB(1, 1), cB + hstepB + kstep, voffB);
    PG8_WAIT_V(6); PG8_BAR;
    for (;;) {
        const bool has_next = S.next(ui + 1, nxt);
        const char* nA = has_next ? (const char*)g.A + nxt.aoff : cA; const char* nB = has_next ? (const char*)g.Bt + nxt.boff : cB;
        for (int t = 0; t < nt; t += 2) {
            const bool last = (t == nt - 2);
            const char* a1 = cA + (size_t)(t + 1) * kstep;
            const char* a2 = last ? nA : cA + (size_t)(t + 2) * kstep; const char* b2 = last ? nB : cB + (size_t)(t + 2) * kstep;
            const char* a3 = a2 + kstep; const char* b3 = b2 + kstep;
            PG8_LDB(B0, 0, 0); PG8_SCHED; PG8_LDA(At, 0, 0); PG8_STAGE(PG8_SA(1, 1), a1 + hstepA, voffA);
            PG8_WAIT_L(8); PG8_BAR; PG8_WAIT_L(0); PG8_MMA(0, 0, At, B0); PG8_BAR; PG8_SCHED;
            PG8_LDB(B1, 0, 1); PG8_STAGE(PG8_SB(0, 0), b2, voffB);
            PG8_BAR; PG8_WAIT_L(0); PG8_MMA(0, 1, At, B1); PG8_BAR;
            PG8_LDA(At, 0, 1); PG8_STAGE(PG8_SA(0, 0), a2, voffA);
            PG8_BAR; PG8_WAIT_L(0); PG8_MMA(1, 0, At, B0); PG8_BAR; PG8_SCHED;
            PG8_STAGE(PG8_SB(0, 1), b2 + hstepB, voffB);
            PG8_WAIT_V(6); PG8_BAR; PG8_MMA(1, 1, At, B1); PG8_BAR;
            PG8_LDB(B0, 1, 0); PG8_SCHED; PG8_LDA(At, 1, 0); PG8_STAGE(PG8_SA(0, 1), a2 + hstepA, voffA);
            PG8_WAIT_L(8); PG8_BAR; PG8_WAIT_L(0); PG8_MMA(0, 0, At, B0); PG8_BAR; PG8_SCHED;
            PG8_LDB(B1, 1, 1); PG8_STAGE(PG8_SB(1, 0), b3, voffB);
            PG8_BAR; PG8_WAIT_L(0); PG8_MMA(0, 1, At, B1); PG8_BAR;
            PG8_LDA(At, 1, 1); PG8_STAGE(PG8_SA(1, 0), a3, voffA);
            PG8_BAR; PG8_WAIT_L(0); PG8_MMA(1, 0, At, B0); PG8_BAR; PG8_SCHED;
            PG8_STAGE(PG8_SB(1, 1), b3 + hstepB, voffB);
            PG8_WAIT_V(6); PG8_BAR; PG8_MMA(1, 1, At, B1); PG8_BAR;
        }
        if constexpr (I8) {
#pragma unroll
            for (int a = 0; a < 2; ++a)
#pragma unroll
                for (int b = 0; b < 2; ++b)
#pragma unroll
                    for (int m = 0; m < 4; ++m)
#pragma unroll
                        for (int n = 0; n < 2; ++n) { const i32x4 iv = __builtin_bit_cast(i32x4, acc[a][b][m][n]); acc[a][b][m][n] = (f32x4){(float)iv[0], (float)iv[1], (float)iv[2], (float)iv[3]}; } }
        if constexpr (I8 == 2) {
            f32x4 sbv[2][2];
#pragma unroll
            for (int b = 0; b < 2; ++b) { const int c = cur.pn * BM + b * HALF + wc * 32 + (Epi::PERM ? 8 * fq : 4 * fq); sbv[b][0] = *(const f32x4*)(g.sb + c); sbv[b][1] = *(const f32x4*)(g.sb + c + (Epi::PERM ? 4 : 16)); }
#pragma unroll
            for (int a = 0; a < 2; ++a)
#pragma unroll
                for (int m = 0; m < 4; ++m) { const float s_ = g.sa[(long)cur.pm * BM + a * HALF + wr * 64 + m * 16 + fr];
#pragma unroll
                    for (int b = 0; b < 2; ++b) { acc[a][b][m][0] = acc[a][b][m][0] * sbv[b][0] * s_; acc[a][b][m][1] = acc[a][b][m][1] * sbv[b][1] * s_; } } }
        E(acc, cur, wr, wc, fr, fq);
        if (!has_next) break;
#pragma unroll
        for (int a = 0; a < 2; ++a)
#pragma unroll
            for (int b = 0; b < 2; ++b)
#pragma unroll
                for (int m = 0; m < 4; ++m)
#pragma unroll
                    for (int n = 0; n < 2; ++n) acc[a][b][m][n] = (f32x4){0.f, 0.f, 0.f, 0.f};
        cur = nxt; cA = nA; cB = nB; ++ui;
    }
    PG8_WAIT_V(0);
    if (wr == 0) PG8_BAR;
    PG8_BAR;
#undef PG8_SA
#undef PG8_SB
#undef PG8_STAGE
#undef PG8_LDA
#undef PG8_LDB
#undef PG8_MMA
#undef PG8_WAIT_V
#undef PG8_WAIT_L
#undef PG8_BAR
#undef PG8_SCHED
}

struct EpiBf16 {
    static constexpr bool PERM = true;
    bf16_t* O; long ldc; long bstride;
    __device__ __forceinline__ void operator()(const f32x4 (&acc)[2][2][4][2], const Unit& u, int wr, int wc, int fr, int fq) const {
        bf16_t* base = O + (long)u.x0 * bstride + (long)(u.pm * BM + wr * 64 + fr) * ldc + u.pn * BM + wc * 32 + 8 * fq;
#pragma unroll
        for (int ai = 0; ai < 2; ++ai)
#pragma unroll
            for (int m = 0; m < 4; ++m) { bf16_t* rowp = base + (long)(ai * HALF + m * 16) * ldc;
#pragma unroll
                for (int bj = 0; bj < 2; ++bj) { const f32x4 v0 = acc[ai][bj][m][0], v1 = acc[ai][bj][m][1];
                    u32x4 w; w.x = cvt_pk_bf16(v0[0], v0[1]); w.y = cvt_pk_bf16(v0[2], v0[3]); w.z = cvt_pk_bf16(v1[0], v1[1]); w.w = cvt_pk_bf16(v1[2], v1[3]);
                    *(u32x4*)(rowp + bj * HALF) = w; } }
    }
};
template <int RMODE> struct EpiRowMap {
    static constexpr bool PERM = true;
    bf16_t* O; const float* rsum;
    __device__ __forceinline__ void operator()(const f32x4 (&acc)[2][2][4][2], const Unit& u, int wr, int wc, int fr, int fq) const {
        const int col0 = u.pn * BM + wc * 32 + 8 * fq;
#pragma unroll
        for (int ai = 0; ai < 2; ++ai)
#pragma unroll
            for (int m = 0; m < 4; ++m) { const int r = ai * HALF + wr * 64 + m * 16 + fr; long drow; long ldc;
                if (RMODE == 1) { const int ts = 256 * u.x1 + r; drow = (long)(ts >> 6) * 1024 + u.x0 * 64 + (ts & 63); ldc = QLD; }
                float rs = 1.0f;
                if (RMODE == 1) { }
                else { const int qr = 256 * u.pm + r; drow = (long)(qr >> 6) * 2048 + u.x0 * 64 + (qr & 63); ldc = 512; rs = 1.0f / rsum[u.x0 * 1024 + qr]; }
                bf16_t* rowp = O + drow * ldc + col0;
#pragma unroll
                for (int bj = 0; bj < 2; ++bj) { const f32x4 v0 = acc[ai][bj][m][0] * rs, v1 = acc[ai][bj][m][1] * rs;
                    u32x4 w; w.x = cvt_pk_bf16(v0[0], v0[1]); w.y = cvt_pk_bf16(v0[2], v0[3]); w.z = cvt_pk_bf16(v1[0], v1[1]); w.w = cvt_pk_bf16(v1[2], v1[3]);
                    *(u32x4*)(rowp + bj * HALF) = w; } }
    }
};
struct EpiOV {
    static constexpr bool PERM = true;
    bf16_t* O;
    __device__ __forceinline__ void operator()(const f32x4 (&acc)[2][2][4][2], const Unit& u, int wr, int wc, int fr, int fq) const {
#pragma unroll
        for (int ai = 0; ai < 2; ++ai)
#pragma unroll
            for (int m = 0; m < 4; ++m) { const int r = ai * HALF + wr * 64 + m * 16 + fr;
                bf16_t* rowp = O + (long)(TP + 256 * u.x1 + r) * DM + u.x0 * 128 + wc * 32 + 8 * fq;
                const f32x4 v0 = acc[ai][1][m][0], v1 = acc[ai][1][m][1];
                u32x4 w; w.x = cvt_pk_bf16(v0[0], v0[1]); w.y = cvt_pk_bf16(v0[2], v0[3]); w.z = cvt_pk_bf16(v1[0], v1[1]); w.w = cvt_pk_bf16(v1[2], v1[3]);
                *(u32x4*)rowp = w; }
    }
};
struct EpiMix {
    static constexpr bool PERM = true;
    const bf16_t* Y; const bf16_t* YA; bf16_t* MIX; const float* sa; const float* sb;
    __device__ __forceinline__ void operator()(const f32x4 (&acc)[2][2][4][2], const Unit& u, int wr, int wc, int fr, int fq) const {
#pragma unroll
        for (int ai = 0; ai < 2; ++ai)
#pragma unroll
            for (int m = 0; m < 4; ++m) { const long t = (long)u.pm * BM + ai * HALF + wr * 64 + m * 16 + fr; const float s_ = sa[t];
#pragma unroll
                for (int bj = 0; bj < 2; ++bj) { const int c = u.pn * BM + bj * HALF + wc * 32 + 8 * fq;
                    const u32x4 ga = *(const u32x4*)(Y + t * INWP + C_GA + c), gb = *(const u32x4*)(Y + t * INWP + C_GB + c), ya = *(const u32x4*)(YA + t * DM + c);
                    float fa[8], fb[8], fy[8], o[8]; unpack8(ga, fa); unpack8(gb, fb); unpack8(ya, fy);
                    const f32x4 v0 = acc[ai][bj][m][0] * *(const f32x4*)(sb + c) * s_, v1 = acc[ai][bj][m][1] * *(const f32x4*)(sb + c + 4) * s_;
                    const float av[8] = {v0[0], v0[1], v0[2], v0[3], v1[0], v1[1], v1[2], v1[3]};
#pragma unroll
                    for (int j = 0; j < 8; ++j) {
#if defined(DBG_MIX) && DBG_MIX == 1
                        o[j] = sigmoidf_(fb[j]) * av[j];
#elif defined(DBG_MIX) && DBG_MIX == 2
                        o[j] = sigmoidf_(fa[j]) * fy[j];
#else
                        o[j] = sigmoidf_(fa[j]) * fy[j] + sigmoidf_(fb[j]) * av[j];
#endif
                    }
                    *(u32x4*)(MIX + t * DM + c) = pack8(o); } }
    }
};
struct EpiRes {
    static constexpr bool PERM = false;
    float* X; const float* gate;
    const float* XinP; const float* XinS;
    __device__ __forceinline__ void operator()(const f32x4 (&acc)[2][2][4][2], const Unit& u, int wr, int wc, int fr, int fq) const {
#pragma unroll
        for (int ai = 0; ai < 2; ++ai)
#pragma unroll
            for (int m = 0; m < 4; ++m) { const int t = u.pm * BM + ai * HALF + wr * 64 + m * 16 + fr; const float* gr = gate + (long)cond_row(t) * 12288; float* xr = X + (long)t * DM; const float* xi = t < TP ? XinP + (long)t * DM : XinS + (long)(t - TP) * DM;
#pragma unroll
                for (int bj = 0; bj < 2; ++bj)
#pragma unroll
                    for (int n = 0; n < 2; ++n) { const int c = u.pn * BM + bj * HALF + wc * 32 + n * 16 + 4 * fq;
                        const f32x4 gv = *(const f32x4*)(gr + c); const f32x4 xv = *(const f32x4*)(xi + c);
                        *(f32x4*)(xr + c) = xv + gv * acc[ai][bj][m][n]; } }
    }
};

struct EpiQ {
    static constexpr bool PERM = true;
    bf16_t* Q; bf16_t* QL; const float* T64;
    __device__ __forceinline__ void operator()(const f32x4 (&acc)[2][2][4][2], const Unit& u, int wr, int wc, int fr, int fq) const {
        const int grp = u.pn / 3, typ = u.pn - 3 * grp;
        if (typ < 2) {
#pragma unroll
            for (int ai = 0; ai < 2; ++ai)
#pragma unroll
                for (int m = 0; m < 4; ++m) { const long t = (long)u.pm * BM + ai * HALF + wr * 64 + m * 16 + fr;
#pragma unroll
                    for (int bj = 0; bj < 2; ++bj) { const f32x4 v0 = acc[ai][bj][m][0], v1 = acc[ai][bj][m][1];
                        u32x4 w; w.x = cvt_pk_bf16(v0[0], v0[1]); w.y = cvt_pk_bf16(v0[2], v0[3]); w.z = cvt_pk_bf16(v1[0], v1[1]); w.w = cvt_pk_bf16(v1[2], v1[3]);
                        *(u32x4*)(Q + t * 3072 + 768 * grp + 192 * (2 * typ + bj) + wc * 32 + 8 * fq) = w; } }
        } else {
#pragma unroll
            for (int ai = 0; ai < 2; ++ai)
#pragma unroll
                for (int m = 0; m < 4; ++m) { const int t = u.pm * BM + ai * HALF + wr * 64 + m * 16 + fr; const int pos = tok_pos(t);
                    const float* cs = T64 + ((long)pos * 32 + 8 * fq) * 2; float cv[8], sv[8];
#pragma unroll
                    for (int j = 0; j < 4; ++j) { const f32x4 qv = *(const f32x4*)(cs + 4 * j); cv[2 * j] = qv[0]; sv[2 * j] = qv[1]; cv[2 * j + 1] = qv[2]; sv[2 * j + 1] = qv[3]; }
                    const f32x4 a0 = acc[ai][0][m][0], a1 = acc[ai][0][m][1], b0 = acc[ai][1][m][0], b1 = acc[ai][1][m][1];
                    const float x1[8] = {a0[0], a0[1], a0[2], a0[3], a1[0], a1[1], a1[2], a1[3]}, x2[8] = {b0[0], b0[1], b0[2], b0[3], b1[0], b1[1], b1[2], b1[3]};
                    float o1[8], o2[8];
#pragma unroll
                    for (int j = 0; j < 8; ++j) { o1[j] = x1[j] * cv[j] - x2[j] * sv[j]; o2[j] = x1[j] * sv[j] + x2[j] * cv[j]; }
                    const u32x4 w1 = pack8(o1), w2 = pack8(o2); const int hd = 4 * grp + wc;
                    bf16_t* qd = Q + (long)t * 3072 + hd * 192 + 128 + 8 * fq; *(u32x4*)qd = w1; *(u32x4*)(qd + 32) = w2;
                    if (t >= TP) { const int ts = t - TP; bf16_t* d = QL + ((long)(ts >> 6) * 1024 + hd * 64 + (ts & 63)) * QLD + 512 + 8 * fq; *(u32x4*)d = w1; *(u32x4*)(d + 32) = w2; } }
        }
    }
};

struct EpiExp {
    static constexpr bool PERM = true;
    bf16_t* O; float* rsum;
    __device__ __forceinline__ void operator()(const f32x4 (&acc)[2][2][4][2], const Unit& u, int wr, int wc, int fr, int fq) const {
        bf16_t* base = O + (long)u.x0 * 1024 * KPAD + (long)(u.pm * BM + wr * 64 + fr) * KPAD + u.pn * BM + wc * 32 + 8 * fq;
#pragma unroll
        for (int ai = 0; ai < 2; ++ai)
#pragma unroll
            for (int m = 0; m < 4; ++m) { bf16_t* rowp = base + (long)(ai * HALF + m * 16) * KPAD; float part = 0.f;
#pragma unroll
                for (int bj = 0; bj < 2; ++bj) { const int c0 = u.pn * BM + bj * HALF + wc * 32 + 8 * fq; const f32x4 v0 = acc[ai][bj][m][0], v1 = acc[ai][bj][m][1];
                    const float sv[8] = {v0[0], v0[1], v0[2], v0[3], v1[0], v1[1], v1[2], v1[3]}; float e[8];
#pragma unroll
                    for (int j = 0; j < 8; ++j) { e[j] = (c0 + j < KALL) ? __expf(fminf(sv[j] * MLA_SCALE, 60.f)) : 0.f; part += e[j]; }
                    *(u32x4*)(rowp + bj * HALF) = pack8(e); }
                part += sx<16>(part); part += sx<32>(part);
                if (fq == 0) atomicAdd(rsum + u.x0 * 1024 + u.pm * BM + ai * HALF + wr * 64 + m * 16 + fr, part); }
    }
};

struct EpiQ8 {
    static constexpr bool PERM = true;
    bf16_t* O; long ldc; const float* sa; const float* sb;
    __device__ __forceinline__ void operator()(const f32x4 (&acc)[2][2][4][2], const Unit& u, int wr, int wc, int fr, int fq) const {
        f32x4 sbv[2][2];
#pragma unroll
        for (int bj = 0; bj < 2; ++bj) { const int c = u.pn * BM + bj * HALF + wc * 32 + 8 * fq; sbv[bj][0] = *(const f32x4*)(sb + c); sbv[bj][1] = *(const f32x4*)(sb + c + 4); }
#pragma unroll
        for (int ai = 0; ai < 2; ++ai)
#pragma unroll
            for (int m = 0; m < 4; ++m) { const long t = (long)u.pm * BM + ai * HALF + wr * 64 + m * 16 + fr; const float s = sa[t];
#pragma unroll
                for (int bj = 0; bj < 2; ++bj) { const f32x4 v0 = acc[ai][bj][m][0] * sbv[bj][0] * s, v1 = acc[ai][bj][m][1] * sbv[bj][1] * s;
                    u32x4 w; w.x = cvt_pk_bf16(v0[0], v0[1]); w.y = cvt_pk_bf16(v0[2], v0[3]); w.z = cvt_pk_bf16(v1[0], v1[1]); w.w = cvt_pk_bf16(v1[2], v1[3]);
                    *(u32x4*)(O + t * ldc + u.pn * BM + bj * HALF + wc * 32 + 8 * fq) = w; } }
    }
};
}
namespace att {
constexpr int NW = 8, QBLK = 32, KVBLK = 64;
constexpr float SCALE = MLA_SCALE;
constexpr float THR = 8.f;
constexpr int KROW = 384;
constexpr int SHM_V = KVBLK * 128 * 2, SHM_K = KVBLK * KROW;
constexpr int QR_PITCH = 144, SHM_QR = 256 * QR_PITCH;
constexpr int SHM_ATTN = 2 * SHM_V + 2 * SHM_K + NW * 64 * 4 + SHM_QR;
#define KSWZ(row, colB) ((row) * att::KROW + ((colB) ^ (((row) & 7) << 4)))
#define SBAR() __builtin_amdgcn_sched_barrier(0)
__device__ __forceinline__ int crow(int r, int hi) { return (r & 3) + 8 * (r >> 2) + 4 * hi; }

__device__ __forceinline__ void partialSM(f32x16& p0, f32x16& p1, float& m_reg, float& mn, float& alpha) {
  constexpr float C = SCALE * 1.4426950408889634f;
  float pmax = p0[0];
#pragma unroll
  for (int r = 1; r < 16; ++r) pmax = fmaxf(pmax, p0[r]);
#pragma unroll
  for (int r = 0; r < 16; ++r) pmax = fmaxf(pmax, p1[r]);
  { auto rr = __builtin_amdgcn_permlane32_swap(__float_as_uint(pmax), __float_as_uint(pmax), false, false);
    pmax = fmaxf(__uint_as_float(rr[0]), __uint_as_float(rr[1])); }
  if (__builtin_expect(__all(pmax - m_reg <= THR / SCALE), 1)) { mn = m_reg; alpha = 1.f; }
  else { mn = fmaxf(m_reg, pmax); alpha = __builtin_amdgcn_exp2f((m_reg - mn) * C); m_reg = mn; }
  float mnC = -mn * C;
#pragma unroll
  for (int r = 0; r < 16; ++r) p0[r] = fmaf(p0[r], C, mnC);
#pragma unroll
  for (int r = 0; r < 16; ++r) p1[r] = fmaf(p1[r], C, mnC);
#pragma unroll
  for (int r = 0; r < 16; ++r) p0[r] = __builtin_amdgcn_exp2f(p0[r]);
}
__device__ __forceinline__ void finishSM(f32x16& p0, f32x16& p1, float alpha, float& l_reg, bf16x8& pa0, bf16x8& pa1, bf16x8& pa2, bf16x8& pa3) {
#pragma unroll
  for (int r = 0; r < 16; ++r) p1[r] = __builtin_amdgcn_exp2f(p1[r]);
  float ps = 0;
#pragma unroll
  for (int r = 0; r < 16; ++r) ps += p0[r];
#pragma unroll
  for (int r = 0; r < 16; ++r) ps += p1[r];
  { auto rr = __builtin_amdgcn_permlane32_swap(__float_as_uint(ps), __float_as_uint(ps), false, false);
    ps = __uint_as_float(rr[0]) + __uint_as_float(rr[1]); }
  l_reg = l_reg * alpha + ps;
#define PK4(P, BASE, OUT) do { unsigned a0 = cvt_pk_bf16(P[BASE + 0], P[BASE + 1]), a1 = cvt_pk_bf16(P[BASE + 2], P[BASE + 3]);   \
    unsigned b0 = cvt_pk_bf16(P[BASE + 4], P[BASE + 5]), b1 = cvt_pk_bf16(P[BASE + 6], P[BASE + 7]);                              \
    auto r0 = __builtin_amdgcn_permlane32_swap(a0, b0, false, false); auto r1 = __builtin_amdgcn_permlane32_swap(a1, b1, false, false); \
    u32x4 w = {r0[0], r1[0], r0[1], r1[1]}; OUT = *reinterpret_cast<bf16x8*>(&w); } while (0)
  PK4(p0, 0, pa0); PK4(p0, 8, pa1); PK4(p1, 0, pa2); PK4(p1, 8, pa3);
#undef PK4
}
__device__ __forceinline__ void qkt(f32x16& p0, f32x16& p1, const char* Ks, const bf16x8* qr, const char* qrope, const int (&kbase)[4], bool vis) {
  p0 = f32x16{}; p1 = f32x16{};
  if (vis) {
#pragma unroll
  for (int d0 = 0; d0 < 12; ++d0) {
    bf16x8 b0 = *reinterpret_cast<const bf16x8*>(Ks + kbase[d0 & 3] + (d0 >> 2) * 128);
    bf16x8 b1 = *reinterpret_cast<const bf16x8*>(Ks + kbase[d0 & 3] + (d0 >> 2) * 128 + 32 * KROW);
    const bf16x8 qv = d0 < 8 ? qr[d0 < 8 ? d0 : 0] : *reinterpret_cast<const bf16x8*>(qrope + (d0 - 8) * 32);
    p0 = __builtin_amdgcn_mfma_f32_32x32x16_bf16(b0, qv, p0, 0, 0, 0);
    p1 = __builtin_amdgcn_mfma_f32_32x32x16_bf16(b1, qv, p1, 0, 0, 0); }
  }
  if (!vis) {
#pragma unroll
    for (int r = 0; r < 16; ++r) { p0[r] = -1e30f; p1[r] = -1e30f; } }
}
__device__ __forceinline__ int v_st(int k, int c) { const int kk = (k & ~0xC) | ((k & 4) << 1) | ((k & 8) >> 1); return ((kk >> 3) * 4 + (c >> 5)) * 512 + ((kk & 7) * 32 + (c & 31)) * 2; }
__device__ __forceinline__ int v_rd_base(int lane) { return ((lane & 3) << 3) | (((lane >> 2) & 3) << 6) | (((lane >> 4) & 1) << 5) | (((lane >> 5) & 1) << 8); }
constexpr int v_rd_off(int d0, int ks, int half) { return d0 * 512 + ks * 4096 + half * 2048; }
template <int OFF> __device__ __forceinline__ s16x4 tr_read(int vb) {
  s16x4 r; asm volatile("ds_read_b64_tr_b16 %0, %1 offset:%2" : "=&v"(r) : "v"(vb), "i"(OFF) : "memory"); return r;
}
template <int D0> __device__ __forceinline__ void pv_one(f32x16& od, int vb, bf16x8 pa0, bf16x8 pa1, bf16x8 pa2, bf16x8 pa3) {
  const s16x4 l0 = tr_read<v_rd_off(D0, 0, 0)>(vb), h0 = tr_read<v_rd_off(D0, 0, 1)>(vb), l1 = tr_read<v_rd_off(D0, 1, 0)>(vb), h1 = tr_read<v_rd_off(D0, 1, 1)>(vb);
  const s16x4 l2 = tr_read<v_rd_off(D0, 2, 0)>(vb), h2 = tr_read<v_rd_off(D0, 2, 1)>(vb), l3 = tr_read<v_rd_off(D0, 3, 0)>(vb), h3 = tr_read<v_rd_off(D0, 3, 1)>(vb);
  asm volatile("s_waitcnt lgkmcnt(0)" ::: "memory"); SBAR();
#define PK(L, H) (bf16x8){L[0], L[1], L[2], L[3], H[0], H[1], H[2], H[3]}
  od = __builtin_amdgcn_mfma_f32_32x32x16_bf16(pa0, PK(l0, h0), od, 0, 0, 0);
  od = __builtin_amdgcn_mfma_f32_32x32x16_bf16(pa1, PK(l1, h1), od, 0, 0, 0);
  od = __builtin_amdgcn_mfma_f32_32x32x16_bf16(pa2, PK(l2, h2), od, 0, 0, 0);
  od = __builtin_amdgcn_mfma_f32_32x32x16_bf16(pa3, PK(l3, h3), od, 0, 0, 0);
#undef PK
}
__device__ __forceinline__ void pv_d0(f32x16* o, int vb, bf16x8 pa0, bf16x8 pa1, bf16x8 pa2, bf16x8 pa3) {
  pv_one<0>(o[0], vb, pa0, pa1, pa2, pa3); pv_one<1>(o[1], vb, pa0, pa1, pa2, pa3); pv_one<2>(o[2], vb, pa0, pa1, pa2, pa3); pv_one<3>(o[3], vb, pa0, pa1, pa2, pa3);
}

__device__ __forceinline__ void attn_block(const bf16_t* __restrict__ Qb, const bf16_t* __restrict__ Kn, const bf16_t* __restrict__ Kr, const bf16_t* __restrict__ Vh,
                                           bf16_t* __restrict__ Ob, int qb, char* lds) {
  constexpr int LDQ = 3072, LDK = 4096, LDR = 64, LDO = 2048;
  const int tid = otid(), wid = tid >> 6, lane = tid & 63, r32 = lane & 31, hi = lane >> 5;
  char* V_lds = lds; char* K_lds = lds + 2 * SHM_V;
  float* ws = (float*)(lds + 2 * SHM_V + 2 * SHM_K) + wid * 64; float* li_l = ws; float* al_l = ws + 32;
  float m_reg = -1e30f, l_reg = 0; f32x16 o[4] = {}; bf16x8 qr[8];
  const bf16_t* Qw = Qb + (long)(wid * QBLK + r32) * LDQ + hi * 8;
#pragma unroll
  for (int d0 = 0; d0 < 8; ++d0) qr[d0] = *reinterpret_cast<const bf16x8*>(Qw + d0 * 16);
  char* qrope = lds + 2 * SHM_V + 2 * SHM_K + NW * 64 * 4 + (wid * QBLK + r32) * QR_PITCH + hi * 16;
#pragma unroll
  for (int d0 = 8; d0 < 12; ++d0) *reinterpret_cast<bf16x8*>(qrope + (d0 - 8) * 32) = *reinterpret_cast<const bf16x8*>(Qw + d0 * 16);
  asm volatile("s_waitcnt lgkmcnt(0)" ::: "memory");
  const int NT = 4 * qb + 4, jmax = 4 * qb + (wid >> 1);
  int kbase[4];
#pragma unroll
  for (int dl = 0; dl < 4; ++dl) kbase[dl] = r32 * KROW + (((dl << 5) | (hi << 4)) ^ ((r32 & 7) << 4));
  const int sr = tid >> 4, sc = (tid & 15) * 8, vst0 = v_st(sr, sc), vst1 = v_st(32 + sr, sc);
  const int rr = tid >> 3, rc = (tid & 7) * 8;
  const int vb0 = (int)(uintptr_t)V_lds + v_rd_base(lane);
  bf16x8 vs0, vs1, ks0, ks1, kr0;
#define SLOAD(k0) do { vs0 = *reinterpret_cast<const bf16x8*>(&Vh[(long)((k0) + sr) * LDK + sc]); vs1 = *reinterpret_cast<const bf16x8*>(&Vh[(long)((k0) + 32 + sr) * LDK + sc]); \
    ks0 = *reinterpret_cast<const bf16x8*>(&Kn[(long)((k0) + sr) * LDK + sc]); ks1 = *reinterpret_cast<const bf16x8*>(&Kn[(long)((k0) + 32 + sr) * LDK + sc]); \
    kr0 = *reinterpret_cast<const bf16x8*>(&Kr[(long)((k0) + rr) * LDR + rc]); } while (0)
#define SWRITE(b) do { *(bf16x8*)(V_lds + (b) * SHM_V + vst0) = vs0; *(bf16x8*)(V_lds + (b) * SHM_V + vst1) = vs1; int kc = sc * 2; \
    *(bf16x8*)(K_lds + (b) * SHM_K + KSWZ(sr, kc)) = ks0; *(bf16x8*)(K_lds + (b) * SHM_K + KSWZ(32 + sr, kc)) = ks1; \
    *(bf16x8*)(K_lds + (b) * SHM_K + KSWZ(rr, 256 + rc * 2)) = kr0; } while (0)
#define SWAIT() asm volatile("s_waitcnt vmcnt(0)" ::: "memory")
#define RESC(a) do { if (__any((a) < 1.f)) { if (hi == 0) al_l[r32] = (a); asm volatile("s_waitcnt lgkmcnt(0)" ::: "memory"); \
    _Pragma("unroll") for (int d = 0; d < 4; ++d) _Pragma("unroll") for (int r = 0; r < 16; ++r) o[d][r] *= al_l[crow(r, hi)]; } } while (0)
  f32x16 pA0, pA1, pB0, pB1; float mnA, mnB, alA, alB; bf16x8 pa0, pa1, pa2, pa3;
  SLOAD(0); SWAIT(); SWRITE(0); __syncthreads();
  qkt(pA0, pA1, K_lds, qr, qrope, kbase, true); partialSM(pA0, pA1, m_reg, mnA, alA);
  SLOAD(KVBLK);
  SWAIT(); SWRITE(1); __syncthreads();
  for (int j = 1; j + 1 < NT; j += 2) {
    SBAR(); qkt(pB0, pB1, K_lds + SHM_K, qr, qrope, kbase, j <= jmax);
    finishSM(pA0, pA1, alA, l_reg, pa0, pa1, pa2, pa3); SBAR();
    SLOAD((j + 1) * KVBLK); SBAR();
    if (j - 1 <= jmax) pv_d0(o, vb0, pa0, pa1, pa2, pa3);
    partialSM(pB0, pB1, m_reg, mnB, alB);
    __syncthreads(); SWAIT(); SWRITE(0);
    RESC(alB); __syncthreads();
    SBAR(); qkt(pA0, pA1, K_lds, qr, qrope, kbase, j + 1 <= jmax);
    finishSM(pB0, pB1, alB, l_reg, pa0, pa1, pa2, pa3); SBAR();
    SLOAD((j + 2) * KVBLK); SBAR();
    if (j <= jmax) pv_d0(o, vb0 + (int)SHM_V, pa0, pa1, pa2, pa3);
    partialSM(pA0, pA1, m_reg, mnA, alA);
    __syncthreads(); SWAIT(); SWRITE(1);
    RESC(alA); __syncthreads();
  }
  SBAR(); qkt(pB0, pB1, K_lds + SHM_K, qr, qrope, kbase, NT - 1 <= jmax);
  finishSM(pA0, pA1, alA, l_reg, pa0, pa1, pa2, pa3); SBAR();
  if (NT - 2 <= jmax) pv_d0(o, vb0, pa0, pa1, pa2, pa3);
  partialSM(pB0, pB1, m_reg, mnB, alB);
  __syncthreads(); RESC(alB);
  finishSM(pB0, pB1, alB, l_reg, pa0, pa1, pa2, pa3); SBAR();
  if (NT - 1 <= jmax) pv_d0(o, vb0 + (int)SHM_V, pa0, pa1, pa2, pa3);
  if (hi == 0) li_l[r32] = l_reg; asm volatile("s_waitcnt lgkmcnt(0)" ::: "memory");
  float rli[16];
#pragma unroll
  for (int r = 0; r < 16; ++r) rli[r] = __builtin_amdgcn_rcpf(li_l[crow(r, hi)]);
  bf16_t* Ow = Ob + (long)(wid * QBLK) * LDO;
#pragma unroll
  for (int r = 0; r < 16; ++r) { int orow = crow(r, hi);
#pragma unroll
    for (int d0 = 0; d0 < 4; ++d0) Ow[(long)orow * LDO + d0 * 32 + r32] = f2bf(o[d0][r] * rli[r]); }
  __syncthreads();
#undef SLOAD
#undef SWRITE
#undef SWAIT
#undef RESC
}
}
namespace ret {
constexpr int QP_ = 136;
__device__ __forceinline__ bf16x8 ldfrag(const bf16_t* p) { return *reinterpret_cast<const bf16x8*>(p); }
template <int CL> struct Lay {
    static constexpr int IP = CL + 8;
    static constexpr int QS = 0, KS = QS + CL * QP_ * 2, VT = KS + CL * QP_ * 2, VDT = VT + 32 * IP * 2, IN = VDT + 32 * IP * 2, ST = IN + CL * IP * 2, VS = ST + 32 * QP_ * 2, END = VS + CL * 40 * 2;
};
static_assert(Lay<128>::END <= LDS_BARW, "retention LDS");

template <int CL>
__device__ __forceinline__ void run(const bf16_t* __restrict__ Y, bf16_t* __restrict__ OB, const float* __restrict__ sp, float* __restrict__ so, long tok0, int nch, int h, int es, float lg, char* lds, int tid) {
    using L = Lay<CL>; constexpr int IP = L::IP, NQT = CL / 16, NKS = CL / 32, NPC = CL / 32;
    const int wid = __builtin_amdgcn_readfirstlane(tid >> 6), lane = tid & 63, l15 = lane & 15, l4 = lane >> 4;
    bf16_t* Qs = (bf16_t*)(lds + L::QS); bf16_t* Ks = (bf16_t*)(lds + L::KS); bf16_t* Vt = (bf16_t*)(lds + L::VT); bf16_t* Vdt = (bf16_t*)(lds + L::VDT); bf16_t* In = (bf16_t*)(lds + L::IN); bf16_t* St = (bf16_t*)(lds + L::ST); bf16_t* Vs = (bf16_t*)(lds + L::VS);
    const float gCL = __expf((float)CL * lg);
    f32x4 Sacc[2];
    if (sp) {
#pragma unroll
        for (int ej = 0; ej < 2; ++ej)
#pragma unroll
            for (int r = 0; r < 4; ++r) Sacc[ej][r] = sp[(long)(16 * wid + 4 * l4 + r) * RV + 16 * ej + l15];
    } else { Sacc[0] = (f32x4){0.f, 0.f, 0.f, 0.f}; Sacc[1] = (f32x4){0.f, 0.f, 0.f, 0.f}; }
    for (int i = tid; i < CL * IP / 8; i += 512) reinterpret_cast<u32x4*>(In)[i] = (u32x4){0u, 0u, 0u, 0u};
    u32x4 pq[NPC], pk[NPC], pv;
    const int vk = tid >> 2, ve0 = (tid & 3) * 8;
#define RET_LOAD(cc) do { const bf16_t* yrow_ = Y + (tok0 + (long)(cc) * CL) * INWP; \
        _Pragma("unroll") for (int i = 0; i < NPC; ++i) { const int idx = tid + i * 512, k = idx >> 4, d0 = (idx & 15) * 8; \
            pq[i] = *reinterpret_cast<const u32x4*>(yrow_ + (long)k * INWP + C_RQ + h * 128 + d0); pk[i] = *reinterpret_cast<const u32x4*>(yrow_ + (long)k * INWP + C_RK + h * 128 + d0); } \
        if (tid < 4 * CL) pv = *reinterpret_cast<const u32x4*>(yrow_ + (long)vk * INWP + C_RV + h * 256 + es * 32 + ve0); } while (0)
    RET_LOAD(0);
    for (int c = 0; c < nch; ++c) {
#pragma unroll
        for (int ej = 0; ej < 2; ++ej) { u32x2 w; w.x = cvt_pk_bf16(Sacc[ej][0], Sacc[ej][1]); w.y = cvt_pk_bf16(Sacc[ej][2], Sacc[ej][3]);
            *reinterpret_cast<u32x2*>(St + (16 * ej + l15) * QP_ + 16 * wid + 4 * l4) = w; }
#pragma unroll
        for (int i = 0; i < NPC; ++i) { const int idx = tid + i * 512, k = idx >> 4, d0 = (idx & 15) * 8;
            *reinterpret_cast<u32x4*>(Qs + k * QP_ + d0) = pq[i]; *reinterpret_cast<u32x4*>(Ks + k * QP_ + d0) = pk[i]; }
        if (tid < 4 * CL) *reinterpret_cast<u32x4*>(Vs + vk * 40 + ve0) = pv;
        if (c + 1 < nch) RET_LOAD(c + 1);
        __syncthreads();
        if (tid < 4 * CL) { const int e = tid & 31, kg = tid >> 5; float f[8], fd[8];
#pragma unroll
            for (int j = 0; j < 8; ++j) { f[j] = bf2f(Vs[(8 * kg + j) * 40 + e]); fd[j] = f[j] * __expf((float)(CL - 1 - 8 * kg - j) * lg); }
            *reinterpret_cast<u32x4*>(Vt + e * IP + 8 * kg) = pack8(f); *reinterpret_cast<u32x4*>(Vdt + e * IP + 8 * kg) = pack8(fd); }
#pragma unroll
        for (int it_ = 0; it_ < (NQT * (NQT + 1) / 2 + 7) / 8; ++it_) { const int idx = wid + 8 * it_; if (idx >= NQT * (NQT + 1) / 2) break;
            int qi = 0; while ((qi + 1) * (qi + 2) / 2 <= idx) ++qi; const int kj = idx - qi * (qi + 1) / 2;
            f32x4 a = (f32x4){0.f, 0.f, 0.f, 0.f}; const bf16_t* qp = Qs + (16 * qi + l15) * QP_ + 8 * l4; const bf16_t* kp = Ks + (16 * kj + l15) * QP_ + 8 * l4;
#pragma unroll
            for (int ks = 0; ks < 4; ++ks) a = __builtin_amdgcn_mfma_f32_16x16x32_bf16(ldfrag(qp + 32 * ks), ldfrag(kp + 32 * ks), a, 0, 0, 0);
            const int q0 = 16 * qi + 4 * l4, k = 16 * kj + l15;
#pragma unroll
            for (int r = 0; r < 4; ++r) { const int q = q0 + r; const float dm = (q >= k) ? __expf((float)(q - k) * lg) : 0.f;
                In[q * IP + k] = f2bf(a[r] * dm); } }
        __syncthreads();
#pragma unroll
        for (int ot = 0; ot < (2 * NQT) / 8; ++ot) { const int tI = wid + 8 * ot, qi = tI >> 1, ej = tI & 1; f32x4 a = (f32x4){0.f, 0.f, 0.f, 0.f};
#pragma unroll
            for (int ks = 0; ks < 4; ++ks) a = __builtin_amdgcn_mfma_f32_16x16x32_bf16(ldfrag(Qs + (16 * qi + l15) * QP_ + 32 * ks + 8 * l4), ldfrag(St + (16 * ej + l15) * QP_ + 32 * ks + 8 * l4), a, 0, 0, 0);
#pragma unroll
            for (int r = 0; r < 4; ++r) a[r] *= __expf((float)(16 * qi + 4 * l4 + r + 1) * lg);
#pragma unroll
            for (int ks = 0; ks < NKS; ++ks) if (ks <= (qi >> 1)) a = __builtin_amdgcn_mfma_f32_16x16x32_bf16(ldfrag(In + (16 * qi + l15) * IP + 32 * ks + 8 * l4), ldfrag(Vt + (16 * ej + l15) * IP + 32 * ks + 8 * l4), a, 0, 0, 0);
            bf16_t* op = OB + ((long)(h * 8 + es) * T + tok0 + (long)c * CL + 16 * qi + 4 * l4) * 32 + 16 * ej + l15;
#pragma unroll
            for (int r = 0; r < 4; ++r) op[r * 32] = f2bf(a[r]); }
        { f32x4 s0 = Sacc[0] * gCL, s1 = Sacc[1] * gCL;
#pragma unroll
          for (int ks = 0; ks < NKS; ++ks) { bf16x8 af;
#pragma unroll
              for (int j = 0; j < 8; ++j) af[j] = (short)Ks[(32 * ks + 8 * l4 + j) * QP_ + 16 * wid + l15];
              s0 = __builtin_amdgcn_mfma_f32_16x16x32_bf16(af, ldfrag(Vdt + l15 * IP + 32 * ks + 8 * l4), s0, 0, 0, 0);
              s1 = __builtin_amdgcn_mfma_f32_16x16x32_bf16(af, ldfrag(Vdt + (16 + l15) * IP + 32 * ks + 8 * l4), s1, 0, 0, 0); }
          Sacc[0] = s0; Sacc[1] = s1; }
        __syncthreads();
    }
#undef RET_LOAD
#pragma unroll
    for (int ej = 0; ej < 2; ++ej)
#pragma unroll
        for (int r = 0; r < 4; ++r) so[(long)(16 * wid + 4 * l4 + r) * RV + 16 * ej + l15] = Sacc[ej][r];
}

__device__ __forceinline__ void unit(KParams& p, int l, int u, char* lds) {
    const int tid = otid(); unsigned char* ws = optr(gp(p.ws)); const bf16_t* Y = (const bf16_t*)(ws + WS_Y); bf16_t* OB = (bf16_t*)(ws + WS_OB);
    const bool samp = u >= 256; const int v = samp ? u - 256 : u; const int b = v >> 6, h = (v >> 3) & 7, es = v & 7; const float lg = p.lg[h];
    if (samp) run<64>(Y, OB, gp(p.state_ret) + ((((long)l * DB + b) * RH + h) * RQK) * RV + es * 32, gp(p.out) + O_RETS + ((((long)l * DB + b) * RH + h) * RQK) * RV + es * 32, (long)TP + b * 64, 1, h, es, lg, lds, tid);
    else run<64>(Y, OB, nullptr, gp(p.out) + O_RETP + ((((long)l * NB + b) * RH + h) * RQK) * RV + es * 32, (long)b * SEQ, SEQ / 64, h, es, lg, lds, tid);
}
}
namespace peer {
__device__ __forceinline__ void ins16(float (&l)[16], float x) {
#pragma unroll
    for (int j = 0; j < 16; ++j) { const float hi = fmaxf(l[j], x); x = fminf(l[j], x); l[j] = hi; }
}
#define CE_DESC(a, b) do { const float hi_ = fmaxf(a, b), lo_ = fminf(a, b); a = hi_; b = lo_; } while (0)
#define CE_ASC(a, b) do { const float hi_ = fmaxf(a, b), lo_ = fminf(a, b); a = lo_; b = hi_; } while (0)
__device__ __forceinline__ void sort16_desc(float (&v)[16]) {
#pragma unroll
    for (int k = 2; k <= 16; k <<= 1)
#pragma unroll
        for (int j = k >> 1; j >= 1; j >>= 1)
#pragma unroll
            for (int i = 0; i < 16; ++i) { const int l = i ^ j; if (l > i) { if ((i & k) == 0) CE_DESC(v[i], v[l]); else CE_ASC(v[i], v[l]); } }
}
__device__ __forceinline__ void merge16_desc(float (&l)[16], const float (&o)[16]) {
#pragma unroll
    for (int i = 0; i < 16; ++i) l[i] = fmaxf(l[i], o[15 - i]);
#pragma unroll
    for (int j = 8; j >= 1; j >>= 1)
#pragma unroll
        for (int i = 0; i < 16; ++i) { const int m = i ^ j; if (m > i) CE_DESC(l[i], l[m]); }
}
constexpr int KPITCH = 136;
__device__ __forceinline__ void half_top16(const bf16_t* __restrict__ qrow, const bf16_t* __restrict__ keys, int lane, float (&l)[16]) {
    const int r32 = lane & 31, g = lane >> 5;
#pragma unroll
    for (int j = 0; j < 16; ++j) l[j] = -3.0e38f;
    bf16x8 qf[8];
#pragma unroll
    for (int ks = 0; ks < 8; ++ks) qf[ks] = *reinterpret_cast<const bf16x8*>(qrow + 16 * ks + 8 * g);
#pragma unroll 1
    for (int kb = 0; kb < 4; ++kb) { f32x16 a = f32x16{};
#pragma unroll
        for (int ks = 0; ks < 8; ++ks) { const bf16x8 kf = *reinterpret_cast<const bf16x8*>(keys + (32 * kb + r32) * KPITCH + 16 * ks + 8 * g);
            a = __builtin_amdgcn_mfma_f32_32x32x16_bf16(kf, qf[ks], a, 0, 0, 0); }
        float blk[16];
#pragma unroll
        for (int r = 0; r < 16; ++r) { const unsigned key = (unsigned)(32 * kb + (r & 3) + 8 * (r >> 2) + 4 * g);
            blk[r] = __uint_as_float((__float_as_uint(a[r]) & ~0x7Fu) | key); }
        sort16_desc(blk); merge16_desc(l, blk); }
}
__device__ __forceinline__ void merge_lists(float (&l)[16], const float (&o)[16]) { merge16_desc(l, o); }
__device__ __forceinline__ void select_unit(const bf16_t* __restrict__ QP, const bf16_t* __restrict__ k1, const bf16_t* __restrict__ k2, int* __restrict__ PIDX, float* __restrict__ PW,
                                            int t0, int h, int lane, float* lds_lane  ) {
    const int r32 = lane & 31, g = lane >> 5;
    const bf16_t* qrow = QP + (long)(t0 + r32) * DM + h * 256;
    float la[16], lb[16];
    half_top16(qrow, k1, lane, la);
    half_top16(qrow + 128, k2, lane, lb);
    float m0[16], m1[16];
#pragma unroll
    for (int j = 0; j < 16; ++j) { auto rr = __builtin_amdgcn_permlane32_swap(__float_as_uint(la[j]), __float_as_uint(lb[j]), false, false); m0[j] = __uint_as_float(rr[0]); m1[j] = __uint_as_float(rr[1]); }
    merge_lists(m0, m1);
    float L1[16], L2[16];
#pragma unroll
    for (int j = 0; j < 16; ++j) { auto rr = __builtin_amdgcn_permlane32_swap(__float_as_uint(m0[j]), __float_as_uint(m0[j]), false, false);
        L1[j] = __uint_as_float(rr[0]); L2[j] = __uint_as_float(rr[1]); }
#define CAND(i, j) __uint_as_float((__float_as_uint(L1[i] + L2[j]) & ~0xFFu) | (unsigned)((i) * 16 + (j)))
    float best[16], c2[16], c3[16];
#pragma unroll
    for (int j = 0; j < 16; ++j) best[j] = CAND(0, j);
    sort16_desc(best);
    c2[0] = CAND(1, 0); c2[1] = CAND(1, 1); c2[2] = CAND(1, 2); c2[3] = CAND(1, 3); c2[4] = CAND(1, 4); c2[5] = CAND(1, 5); c2[6] = CAND(1, 6); c2[7] = CAND(1, 7);
    c2[8] = CAND(2, 0); c2[9] = CAND(2, 1); c2[10] = CAND(2, 2); c2[11] = CAND(2, 3); c2[12] = CAND(2, 4); c2[13] = CAND(4, 0); c2[14] = CAND(4, 1); c2[15] = CAND(4, 2);
    sort16_desc(c2); merge16_desc(best, c2);
    c3[0] = CAND(3, 0); c3[1] = CAND(3, 1); c3[2] = CAND(3, 2); c3[3] = CAND(3, 3); c3[4] = CAND(5, 0); c3[5] = CAND(5, 1); c3[6] = CAND(6, 0); c3[7] = CAND(6, 1);
    c3[8] = CAND(7, 0); c3[9] = CAND(7, 1); c3[10] = CAND(8, 0); c3[11] = CAND(9, 0); c3[12] = CAND(10, 0); c3[13] = CAND(11, 0); c3[14] = CAND(12, 0); c3[15] = CAND(13, 0);
    sort16_desc(c3); merge16_desc(best, c3);
    ins16(best, CAND(14, 0)); ins16(best, CAND(15, 0));
#undef CAND
#pragma unroll
    for (int j = 0; j < 16; ++j) { lds_lane[j] = __uint_as_float(__float_as_uint(L1[j]) & 0x7Fu); lds_lane[16 + j] = __uint_as_float(__float_as_uint(L2[j]) & 0x7Fu); }
    asm volatile("s_waitcnt lgkmcnt(0)" ::: "memory");
    float wsum = 0.f, w[16]; int ei[16];
    const float mx = best[0];
#pragma unroll
    for (int k = 0; k < 16; ++k) { const unsigned code = __float_as_uint(best[k]) & 0xFFu; const int i = (int)(code >> 4), j = (int)(code & 15u);
        const int i1 = (int)__float_as_uint(lds_lane[i]), i2 = (int)__float_as_uint(lds_lane[16 + j]); ei[k] = i1 * NKEYS + i2;
        w[k] = __expf(best[k] - mx); wsum += w[k]; }
    const float inv = 1.0f / wsum;
    if (g == 0) { int* ip = PIDX + (long)(t0 + r32) * 128 + h * 16; float* wp = PW + (long)(t0 + r32) * 128 + h * 16;
#pragma unroll
        for (int k = 0; k < 16; k += 4) { *reinterpret_cast<int4*>(ip + k) = make_int4(ei[k], ei[k + 1], ei[k + 2], ei[k + 3]);
            *reinterpret_cast<float4*>(wp + k) = make_float4(w[k] * inv, w[k + 1] * inv, w[k + 2] * inv, w[k + 3] * inv); } }
}

__device__ __forceinline__ float gelu_exact(float x) { return 0.5f * x * (1.0f + erff(x * 0.70710678118654752f)); }

__device__ __forceinline__ void dec16(const u32x4 w, f32x2 (&f)[8]) {
    f[0] = __builtin_amdgcn_cvt_pk_f32_fp8((int)w.x, false); f[1] = __builtin_amdgcn_cvt_pk_f32_fp8((int)w.x, true);
    f[2] = __builtin_amdgcn_cvt_pk_f32_fp8((int)w.y, false); f[3] = __builtin_amdgcn_cvt_pk_f32_fp8((int)w.y, true);
    f[4] = __builtin_amdgcn_cvt_pk_f32_fp8((int)w.z, false); f[5] = __builtin_amdgcn_cvt_pk_f32_fp8((int)w.z, true);
    f[6] = __builtin_amdgcn_cvt_pk_f32_fp8((int)w.w, false); f[7] = __builtin_amdgcn_cvt_pk_f32_fp8((int)w.w, true);
}
__device__ __forceinline__ void dec16_i8(const u32x4 w, f32x2 (&f)[8]) {
    const unsigned ww[4] = {w.x, w.y, w.z, w.w};
#pragma unroll
    for (int i = 0; i < 4; ++i) { f[2 * i] = (f32x2){(float)(int)(signed char)(ww[i] & 0xffu), (float)(int)(signed char)((ww[i] >> 8) & 0xffu)}; f[2 * i + 1] = (f32x2){(float)(int)(signed char)((ww[i] >> 16) & 0xffu), (float)(int)(signed char)(ww[i] >> 24)}; }
}
__device__ __forceinline__ void gather_token(const bf16_t* __restrict__ H, const unsigned char* __restrict__ PU, const unsigned char* __restrict__ PV, const float* __restrict__ SU, const float* __restrict__ SV,
                                             const int* __restrict__ PIDX, const float* __restrict__ PW, float* __restrict__ X, const float* __restrict__ gate  , int t, int lane) {
    f32x2 xf[2][8];
#pragma unroll
    for (int hlf = 0; hlf < 2; ++hlf)
#pragma unroll
        for (int q = 0; q < 2; ++q) { const u32x4 w = *reinterpret_cast<const u32x4*>(H + (long)t * DM + 1024 * hlf + 16 * lane + 8 * q);
            xf[hlf][4 * q + 0] = (f32x2){bflo(w.x), bfhi(w.x)}; xf[hlf][4 * q + 1] = (f32x2){bflo(w.y), bfhi(w.y)}; xf[hlf][4 * q + 2] = (f32x2){bflo(w.z), bfhi(w.z)}; xf[hlf][4 * q + 3] = (f32x2){bflo(w.w), bfhi(w.w)}; }
    f32x2 out[2][8];
#pragma unroll
    for (int hlf = 0; hlf < 2; ++hlf)
#pragma unroll
        for (int i = 0; i < 8; ++i) out[hlf][i] = (f32x2){0.f, 0.f};
    const int myidx0 = PIDX[(long)t * 128 + lane], myidx1 = PIDX[(long)t * 128 + 64 + lane];
    const float myw0 = PW[(long)t * 128 + lane], myw1 = PW[(long)t * 128 + 64 + lane];
    const float msu0 = SU[myidx0], msu1 = SU[myidx1], msv0 = SV[myidx0], msv1 = SV[myidx1];
    for (int hk = 0; hk < 128; hk += 4) {
        const int src = hk & 63; const bool lo = hk < 64;
        const int selidx = lo ? myidx0 : myidx1; const int selw = __float_as_int(lo ? myw0 : myw1), selsu = __float_as_int(lo ? msu0 : msu1), selsv = __float_as_int(lo ? msv0 : msv1);
        int e[4]; float g[4], su[4], sv[4];
#pragma unroll
        for (int k = 0; k < 4; ++k) { e[k] = __builtin_amdgcn_readlane(selidx, src + k); g[k] = __int_as_float(__builtin_amdgcn_readlane(selw, src + k));
            su[k] = __int_as_float(__builtin_amdgcn_readlane(selsu, src + k)); sv[k] = __int_as_float(__builtin_amdgcn_readlane(selsv, src + k)); }
        u32x4 uw[4][2], vw[4][2];
#pragma unroll
        for (int k = 0; k < 4; ++k) { uw[k][0] = *reinterpret_cast<const u32x4*>(PU + ((long)(lane >> 3) * NEXP + e[k]) * 128 + 16 * (lane & 7)); uw[k][1] = *reinterpret_cast<const u32x4*>(PU + ((long)(8 + (lane >> 3)) * NEXP + e[k]) * 128 + 16 * (lane & 7)); }
#pragma unroll
        for (int k = 0; k < 4; ++k) { { const u32x2 a0 = *reinterpret_cast<const u32x2*>(PV + ((long)(2 * lane) * NEXP + e[k]) * 8), a1 = *reinterpret_cast<const u32x2*>(PV + ((long)(2 * lane + 1) * NEXP + e[k]) * 8);
              const u32x2 b0 = *reinterpret_cast<const u32x2*>(PV + ((long)(128 + 2 * lane) * NEXP + e[k]) * 8), b1 = *reinterpret_cast<const u32x2*>(PV + ((long)(129 + 2 * lane) * NEXP + e[k]) * 8);
              vw[k][0] = (u32x4){a0.x, a0.y, a1.x, a1.y}; vw[k][1] = (u32x4){b0.x, b0.y, b1.x, b1.y}; } }
        float a[4];
#pragma unroll
        for (int k = 0; k < 4; ++k) { f32x2 d = (f32x2){0.f, 0.f};
#pragma unroll
            for (int hlf = 0; hlf < 2; ++hlf) { f32x2 f[8]; dec16_i8(uw[k][hlf], f);
#pragma unroll
                for (int i = 0; i < 8; ++i) d = __builtin_elementwise_fma(f[i], xf[hlf][i], d); }
            a[k] = wave_sum(d[0] + d[1]); }
#pragma unroll
        for (int k = 0; k < 4; ++k) { const float ak = g[k] * gelu_exact(a[k] * su[k]) * sv[k]; const f32x2 a2 = (f32x2){ak, ak};
#pragma unroll
            for (int hlf = 0; hlf < 2; ++hlf) { f32x2 f[8]; dec16(vw[k][hlf], f);
#pragma unroll
                for (int i = 0; i < 8; ++i) out[hlf][i] = __builtin_elementwise_fma(f[i], a2, out[hlf][i]); } }
    }
    const float* gr = gate + (long)cond_row(t) * 12288;
#pragma unroll
    for (int hlf = 0; hlf < 2; ++hlf)
#pragma unroll
        for (int q = 0; q < 4; ++q) { const int c = 1024 * hlf + 16 * lane + 4 * q; float* xp = X + (long)t * DM + c;
            const f32x4 gv = *reinterpret_cast<const f32x4*>(gr + c); f32x4 xv = *reinterpret_cast<const f32x4*>(xp);
            xv[0] += gv[0] * out[hlf][2 * q][0]; xv[1] += gv[1] * out[hlf][2 * q][1]; xv[2] += gv[2] * out[hlf][2 * q + 1][0]; xv[3] += gv[3] * out[hlf][2 * q + 1][1];
            *reinterpret_cast<f32x4*>(xp) = xv; }
}

constexpr int SW = 128, NSL = DM / SW;
struct XInfo { int rank, xi, nx, nloc; };
__device__ __forceinline__ void upass(const unsigned char* __restrict__ H8, const float* __restrict__ SA, const unsigned char* __restrict__ PU, const int* __restrict__ PIDX, const float* __restrict__ PW, const float* __restrict__ SU, const float* __restrict__ SV,
                                      int* __restrict__ DOTP, unsigned* __restrict__ PACKT, const XInfo xin, int wid, int lane) {
    const int g = lane >> 3, c = lane & 7; const int nwv = xin.nloc * 8;
    const int tlo = (int)((long)T * xin.xi / xin.nx), thi = (int)((long)T * (xin.xi + 1) / xin.nx); const int wv = tlo + xin.rank * 8 + wid;
    int* dp = DOTP;
#define SXI(K, v_) __float_as_int(sx<K>(__int_as_float(v_)))
    for (int s = 0; s < NSL; ++s) { const bool first = (s == 0), lastS = (s == NSL - 1);
        const __amdgpu_buffer_rsrc_t urs = __builtin_amdgcn_make_buffer_rsrc((void*)(PU + (long)s * NEXP * SW), 0, NEXP * SW, 0x00020000);
#define UP_ROW(e_) __builtin_bit_cast(u32x4, __builtin_amdgcn_raw_buffer_load_b128(urs, (e_) * SW + 16 * c, 0, 0))
#define UP_IDX(tt, q4) (*reinterpret_cast<const int4*>(PIDX + (long)(tt) * 128 + 16 * g + 4 * (q4)))
#define UP_X(tt) (*reinterpret_cast<const u32x4*>(H8 + (long)(tt) * DM + SW * s + 16 * c))
#define UP_DOT(r_) __builtin_amdgcn_sdot4((int)(r_).x, (int)xv.x, __builtin_amdgcn_sdot4((int)(r_).y, (int)xv.y, __builtin_amdgcn_sdot4((int)(r_).z, (int)xv.z, __builtin_amdgcn_sdot4((int)(r_).w, (int)xv.w, 0, false), false), false), false)
        if (wv >= thi) continue;
        u32x4 A[8], B[8]; int4 en[4]; u32x4 xn;
        { int4 e0[4];
#pragma unroll
          for (int q4 = 0; q4 < 4; ++q4) e0[q4] = UP_IDX(wv, q4);
          A[0] = UP_ROW(e0[0].x); A[1] = UP_ROW(e0[0].y); A[2] = UP_ROW(e0[0].z); A[3] = UP_ROW(e0[0].w); A[4] = UP_ROW(e0[1].x); A[5] = UP_ROW(e0[1].y); A[6] = UP_ROW(e0[1].z); A[7] = UP_ROW(e0[1].w);
          B[0] = UP_ROW(e0[2].x); B[1] = UP_ROW(e0[2].y); B[2] = UP_ROW(e0[2].z); B[3] = UP_ROW(e0[2].w); B[4] = UP_ROW(e0[3].x); B[5] = UP_ROW(e0[3].y); B[6] = UP_ROW(e0[3].z); B[7] = UP_ROW(e0[3].w);
          const int t1 = (wv + nwv < thi) ? wv + nwv : wv;
#pragma unroll
          for (int q4 = 0; q4 < 4; ++q4) en[q4] = UP_IDX(t1, q4);
          xn = UP_X(wv); }
        int2 dnx = make_int2(0, 0);
        if (!first) dnx = *reinterpret_cast<const int2*>(dp + (long)wv * 128 + 16 * g + 2 * c);
#pragma unroll 1
        for (int t = wv; t < thi; t += nwv) {
            const int tn = (t + nwv < thi) ? t + nwv : t, tnn = (tn + nwv < thi) ? tn + nwv : tn;
            const int2 dcur = dnx;
            if (!first) dnx = *reinterpret_cast<const int2*>(dp + (long)tn * 128 + 16 * g + 2 * c);
            const u32x4 xv = xn; xn = UP_X(tn);
            int d[16];
#pragma unroll
            for (int i = 0; i < 8; ++i) d[i] = UP_DOT(A[i]);
            A[0] = UP_ROW(en[0].x); A[1] = UP_ROW(en[0].y); A[2] = UP_ROW(en[0].z); A[3] = UP_ROW(en[0].w); A[4] = UP_ROW(en[1].x); A[5] = UP_ROW(en[1].y); A[6] = UP_ROW(en[1].z); A[7] = UP_ROW(en[1].w);
#pragma unroll
            for (int i = 0; i < 8; ++i) d[8 + i] = UP_DOT(B[i]);
            B[0] = UP_ROW(en[2].x); B[1] = UP_ROW(en[2].y); B[2] = UP_ROW(en[2].z); B[3] = UP_ROW(en[2].w); B[4] = UP_ROW(en[3].x); B[5] = UP_ROW(en[3].y); B[6] = UP_ROW(en[3].z); B[7] = UP_ROW(en[3].w);
#pragma unroll
            for (int q4 = 0; q4 < 4; ++q4) en[q4] = UP_IDX(tnn, q4);
            int r8[8], r4[4], r2[2];
#pragma unroll
            for (int k = 0; k < 8; ++k) { const int keep = (c & 4) ? d[k + 8] : d[k], send = (c & 4) ? d[k] : d[k + 8]; r8[k] = keep + SXI(4, send); }
#pragma unroll
            for (int k = 0; k < 4; ++k) { const int keep = (c & 2) ? r8[k + 4] : r8[k], send = (c & 2) ? r8[k] : r8[k + 4]; r4[k] = keep + SXI(2, send); }
#pragma unroll
            for (int k = 0; k < 2; ++k) { const int keep = (c & 1) ? r4[k + 2] : r4[k], send = (c & 1) ? r4[k] : r4[k + 2]; r2[k] = keep + SXI(1, send); }
            int* o = dp + (long)t * 128 + 16 * g + 2 * c;
            const int a0i = r2[0] + dcur.x, a1i = r2[1] + dcur.y;
            if (!lastS) *reinterpret_cast<int2*>(o) = make_int2(a0i, a1i);
            else {
                const int p0 = 16 * g + 2 * c; const int2 ee = *reinterpret_cast<const int2*>(PIDX + (long)t * 128 + p0); const f32x2 gw = *reinterpret_cast<const f32x2*>(PW + (long)t * 128 + p0); const float sa = SA[t];
                const float a0 = gw[0] * gelu_exact((float)a0i * sa * SU[ee.x]) * SV[ee.x], a1 = gw[1] * gelu_exact((float)a1i * sa * SU[ee.y]) * SV[ee.y];
                u32x2 pk; pk.x = (cvt_pk_bf16(0.f, a0) & 0xffff0000u) | (unsigned)ee.x; pk.y = (cvt_pk_bf16(0.f, a1) & 0xffff0000u) | (unsigned)ee.y;
                *reinterpret_cast<u32x2*>(PACKT + ((long)(p0 >> 2) * T + t) * 4 + (p0 & 3)) = pk; }
        }
#undef UP_ROW
#undef UP_IDX
#undef UP_X
#undef UP_DOT
    }
#undef SXI
}
__device__ __forceinline__ void actpass(const float* __restrict__ DOTP, const int* __restrict__ PIDX, const float* __restrict__ PW, const float* __restrict__ SU, const float* __restrict__ SV, float* __restrict__ ACT, int nx, long gt, long nt) {
    for (long i = gt; i < (long)T * 128; i += nt) { float dsum = 0.f;
        for (int x = 0; x < nx; ++x) dsum += DOTP[(long)x * T * 128 + i];
        const int e = PIDX[i]; const float av = PW[i] * gelu_exact(dsum * SU[e]) * SV[e]; const long t = i >> 7; const int pp = (int)(i & 127);
        reinterpret_cast<unsigned*>(ACT)[((long)(pp >> 2) * T + t) * 4 + (pp & 3)] = (cvt_pk_bf16(0.f, av) & 0xffff0000u) | (unsigned)e; }
}
__device__ __forceinline__ void vpass(const unsigned char* __restrict__ PV, const int* __restrict__ PIDX, const float* __restrict__ ACT, float* __restrict__ X, const float* __restrict__ gate, const XInfo xin, int wid, int lane) {
    const int g = lane >> 3, c = lane & 7; const int wv = xin.rank * 8 + wid, nwv = xin.nloc * 8;
    for (int s = xin.xi; s < NSL; s += xin.nx) {
        int4 en[4]; f32x4 an[4];
#pragma unroll
        for (int q4 = 0; q4 < 4; ++q4) { en[q4] = *reinterpret_cast<const int4*>(PIDX + (long)(wv < T ? wv : 0) * 128 + 16 * g + 4 * q4); an[q4] = *reinterpret_cast<const f32x4*>(ACT + (long)(wv < T ? wv : 0) * 128 + 16 * g + 4 * q4); }
        for (int t = wv; t < T; t += nwv) {
            int e[16]; float a[16];
#pragma unroll
            for (int q4 = 0; q4 < 4; ++q4) { e[4 * q4] = en[q4].x; e[4 * q4 + 1] = en[q4].y; e[4 * q4 + 2] = en[q4].z; e[4 * q4 + 3] = en[q4].w; a[4 * q4] = an[q4][0]; a[4 * q4 + 1] = an[q4][1]; a[4 * q4 + 2] = an[q4][2]; a[4 * q4 + 3] = an[q4][3]; }
            u32x4 w[16];
#pragma unroll
            for (int i = 0; i < 16; ++i) w[i] = *reinterpret_cast<const u32x4*>(PV + ((long)s * NEXP + e[i]) * SW + 16 * c);
            { const int tn = (t + nwv < T) ? t + nwv : t;
#pragma unroll
              for (int q4 = 0; q4 < 4; ++q4) { en[q4] = *reinterpret_cast<const int4*>(PIDX + (long)tn * 128 + 16 * g + 4 * q4); an[q4] = *reinterpret_cast<const f32x4*>(ACT + (long)tn * 128 + 16 * g + 4 * q4); } }
            f32x2 o[8];
#pragma unroll
            for (int k = 0; k < 8; ++k) o[k] = (f32x2){0.f, 0.f};
#pragma unroll
            for (int i = 0; i < 16; ++i) { f32x2 f[8]; dec16(w[i], f); const f32x2 a2 = (f32x2){a[i], a[i]};
#pragma unroll
                for (int k = 0; k < 8; ++k) o[k] = __builtin_elementwise_fma(f[k], a2, o[k]); }
            f32x2 r4[4], r2[2], r1;
#pragma unroll
            for (int k = 0; k < 4; ++k) { const f32x2 keep = (g & 4) ? o[k + 4] : o[k], send = (g & 4) ? o[k] : o[k + 4]; r4[k] = keep + (f32x2){sx<32>(send[0]), sx<32>(send[1])}; }
#pragma unroll
            for (int k = 0; k < 2; ++k) { const f32x2 keep = (g & 2) ? r4[k + 2] : r4[k], send = (g & 2) ? r4[k] : r4[k + 2]; r2[k] = keep + (f32x2){sx<16>(send[0]), sx<16>(send[1])}; }
            { const f32x2 keep = (g & 1) ? r2[1] : r2[0], send = (g & 1) ? r2[0] : r2[1]; r1 = keep + (f32x2){sx<8>(send[0]), sx<8>(send[1])}; }
            const int col = SW * s + 16 * c + 2 * g;
            const f32x2 gv = *reinterpret_cast<const f32x2*>(gate + (long)cond_row(t) * 12288 + col);
            float* xp = X + (long)t * DM + col; f32x2 xv = *reinterpret_cast<const f32x2*>(xp);
            xv += gv * r1; *reinterpret_cast<f32x2*>(xp) = xv;
        }
    }
}

__device__ __forceinline__ void vpass_lds(const unsigned char* __restrict__ PV, const unsigned* __restrict__ PACKT, float* __restrict__ X, const float* __restrict__ gate, char* lds, int bid, int nb, int s_end, int tid) {
    const int wid = tid >> 6, lane = tid & 63;
    for (int s = bid; s < s_end; s += nb) {
        __syncthreads();
        { const u32x4* src = reinterpret_cast<const u32x4*>(PV + (long)s * NEXP * 8); u32x4* dst = reinterpret_cast<u32x4*>(lds);
#pragma unroll 4
          for (int i = tid; i < NEXP * 8 / 16; i += 512) dst[i] = src[i]; }
        __syncthreads();
        u32x4 h0[8], h1[8];
        const __amdgpu_buffer_rsrc_t vrs = __builtin_amdgcn_make_buffer_rsrc((void*)PACKT, 0, (int)((size_t)T * 128 * 4), 0x00020000);
#define VP_LD(k, toff) __builtin_bit_cast(u32x4, __builtin_amdgcn_raw_buffer_load_b128(vrs, (int)(toff), (int)((size_t)(k) * T * 16), 0))
        { const unsigned toff = (unsigned)(wid * 64 + lane) * 16u;
#pragma unroll
          for (int k = 0; k < 8; ++k) h0[k] = VP_LD(k, toff);
#pragma unroll
          for (int k = 0; k < 8; ++k) h1[k] = VP_LD(8 + k, toff); }
#define VP_STEP(HB) do { _Pragma("unroll") for (int kk = 0; kk < 8; kk += 2) { unsigned pw[8]; \
            _Pragma("unroll") for (int k = 0; k < 2; ++k) { pw[4 * k] = HB[kk + k].x; pw[4 * k + 1] = HB[kk + k].y; pw[4 * k + 2] = HB[kk + k].z; pw[4 * k + 3] = HB[kk + k].w; } \
            u32x2 w[8]; \
            _Pragma("unroll") for (int k = 0; k < 8; ++k) w[k] = *reinterpret_cast<const u32x2*>(lds + (pw[k] & 0xffffu) * 8u); \
            _Pragma("unroll") for (int k = 0; k < 8; ++k) { const float a = __uint_as_float(pw[k] & 0xffff0000u); \
                const f32x2 f0 = __builtin_amdgcn_cvt_pk_f32_fp8((int)w[k].x, false), f1 = __builtin_amdgcn_cvt_pk_f32_fp8((int)w[k].x, true), f2 = __builtin_amdgcn_cvt_pk_f32_fp8((int)w[k].y, false), f3 = __builtin_amdgcn_cvt_pk_f32_fp8((int)w[k].y, true); \
                acc[0] = fmaf(a, f0[0], acc[0]); acc[1] = fmaf(a, f0[1], acc[1]); acc[2] = fmaf(a, f1[0], acc[2]); acc[3] = fmaf(a, f1[1], acc[3]); \
                acc[4] = fmaf(a, f2[0], acc[4]); acc[5] = fmaf(a, f2[1], acc[5]); acc[6] = fmaf(a, f3[0], acc[6]); acc[7] = fmaf(a, f3[1], acc[7]); } } } while (0)
#pragma unroll 1
        for (int tg = wid; tg < T / 64; tg += 8) { const int t = tg * 64 + lane; const int tgn = (tg + 8 < T / 64) ? tg + 8 : tg;
            const unsigned toff = (unsigned)t * 16u, toffn = (unsigned)(tgn * 64 + lane) * 16u;
            float acc[8];
#pragma unroll
            for (int j = 0; j < 8; ++j) acc[j] = 0.f;
            VP_STEP(h0);
#pragma unroll
            for (int k = 0; k < 8; ++k) h0[k] = VP_LD(16 + k, toff);
            VP_STEP(h1);
#pragma unroll
            for (int k = 0; k < 8; ++k) h1[k] = VP_LD(24 + k, toff);
            VP_STEP(h0);
#pragma unroll
            for (int k = 0; k < 8; ++k) h0[k] = VP_LD(k, toffn);
            VP_STEP(h1);
#pragma unroll
            for (int k = 0; k < 8; ++k) h1[k] = VP_LD(8 + k, toffn);
            const float* gr = gate + (long)cond_row(t) * 12288 + 8 * s; float* xp = X + (long)t * DM + 8 * s;
            const f32x4 g0 = *reinterpret_cast<const f32x4*>(gr), g1 = *reinterpret_cast<const f32x4*>(gr + 4);
            f32x4 x0 = *reinterpret_cast<const f32x4*>(xp), x1 = *reinterpret_cast<const f32x4*>(xp + 4);
            x0[0] += g0[0] * acc[0]; x0[1] += g0[1] * acc[1]; x0[2] += g0[2] * acc[2]; x0[3] += g0[3] * acc[3];
            x1[0] += g1[0] * acc[4]; x1[1] += g1[1] * acc[5]; x1[2] += g1[2] * acc[6]; x1[3] += g1[3] * acc[7];
            *reinterpret_cast<f32x4*>(xp) = x0; *reinterpret_cast<f32x4*>(xp + 4) = x1; }
#undef VP_STEP
#undef VP_LD
    }
    __syncthreads();
}
}
namespace ph {
__device__ __forceinline__ int gwave() { return obid() * 8 + (otid() >> 6); }
__device__ __forceinline__ int nwaves() { return ogrid() * 8; }
__device__ __forceinline__ long gthread() { return (long)obid() * 512 + otid(); }
__device__ __forceinline__ long nthreads() { return (long)ogrid() * 512; }

__device__ __forceinline__ void transpose_tile(const float* __restrict__ src, int C, int r0, int c0, bf16_t* __restrict__ dst, long dpitch, float* tile) {
    const int tid = otid();
#pragma unroll
    for (int i = 0; i < 8; ++i) { const int idx = tid + 512 * i, r = idx >> 6, c = idx & 63; tile[r * 65 + c] = src[(long)(r0 + r) * C + c0 + c]; }
    __syncthreads();
    { const int c = tid >> 3, rc = (tid & 7) * 8; float f[8];
#pragma unroll
      for (int j = 0; j < 8; ++j) f[j] = tile[(rc + j) * 65 + c];
      *reinterpret_cast<u32x4*>(dst + (long)(c0 + c) * dpitch + r0 + rc) = pack8(f); }
    __syncthreads();
}

__device__ __forceinline__ void zero_chunks(bf16_t* base, long nrows, long rowpitch, int col0, int nchunk) {
    const long total = nrows * nchunk;
    for (long i = gthread(); i < total; i += nthreads()) { const long r = i / nchunk; const int ch = (int)(i % nchunk);
        *reinterpret_cast<u32x4*>(base + r * rowpitch + col0 + ch * 8) = (u32x4){0u, 0u, 0u, 0u}; }
}

__device__ __forceinline__ void prologue(KParams& p, char* lds) {
    unsigned char* ws = optr(gp(p.ws)); const int tid = otid();
    float* tile = (float*)lds;
    { struct TJob { const float* src; bf16_t* dst; int R, C, r0, c0, perm; };
      auto decode = [&](int it) { TJob j; j.perm = 0; const int l = it / 10656; int r = it % 10656;
        if (r < 5664) { j.src = gp(p.w_in) + (long)l * DM * INW; j.R = DM; j.C = INW; j.dst = (bf16_t*)(ws + WS_WIN) + (long)l * INWP * DM; }
        else if (r < 6048) { r -= 5664; j.src = gp(p.w_uq) + (long)l * 512 * 3072; j.R = 512; j.C = 3072; j.dst = (bf16_t*)(ws + WS_WUQ) + (long)l * 3072 * 512; j.perm = 1; }
        else if (r < 6560) { r -= 6048; j.src = gp(p.w_ukv) + (long)l * 512 * 4096; j.R = 512; j.C = 4096; j.dst = (bf16_t*)(ws + WS_WUKV) + (long)l * 4096 * 512; }
        else { r -= 6560; const int m = r >> 10; r &= 1023; j.R = DM; j.C = DM;
            j.src = (m == 0 ? gp(p.w_a) : m == 1 ? gp(p.w_b) : m == 2 ? gp(p.w_o) : gp(p.w_pq)) + (long)l * DM * DM;
            j.dst = (bf16_t*)(ws + (m == 0 ? WS_WA : m == 1 ? WS_WB : m == 2 ? WS_WO : WS_WPQ)) + (long)l * DM * DM; }
        const int ntc = j.C / 64; j.r0 = (r / ntc) * 64; j.c0 = (r % ntc) * 64; return j; };
      const int NTILES = 2 * 10656, G_ = ogrid(); int it = obid(); float v[8]; TJob cur{};
      if (it < NTILES) { cur = decode(it);
#pragma unroll
        for (int i = 0; i < 8; ++i) { const int idx = tid + 512 * i, r = idx >> 6, c = idx & 63; v[i] = cur.src[(long)(cur.r0 + r) * cur.C + cur.c0 + c]; } }
      while (it < NTILES) { const int itn = it + G_; float vn[8]; TJob nxt{};
        if (itn < NTILES) { nxt = decode(itn);
#pragma unroll
            for (int i = 0; i < 8; ++i) { const int idx = tid + 512 * i, r = idx >> 6, c = idx & 63; vn[i] = nxt.src[(long)(nxt.r0 + r) * nxt.C + nxt.c0 + c]; } }
#pragma unroll
        for (int i = 0; i < 8; ++i) { const int idx = tid + 512 * i, r = idx >> 6, c = idx & 63; tile[r * 65 + c] = v[i]; }
        __syncthreads();
        { const int c = tid >> 3, rc = (tid & 7) * 8; float f[8];
#pragma unroll
          for (int jj = 0; jj < 8; ++jj) f[jj] = tile[(rc + jj) * 65 + c];
          int drow = cur.c0 + c;
          if (cur.perm) { const int gq = drow / 768, o = drow - 768 * gq, hh = o / 192, w = o - 192 * hh;
              drow = 768 * gq + (w < 128 ? 128 * hh + w : (w < 160 ? 512 + 32 * hh + (w - 128) : 640 + 32 * hh + (w - 160))); }
          *reinterpret_cast<u32x4*>(cur.dst + (long)drow * cur.R + cur.r0 + rc) = pack8(f); }
        __syncthreads();
#pragma unroll
        for (int i = 0; i < 8; ++i) v[i] = vn[i];
        cur = nxt; it = itn; } }
    for (long i = gthread(); i < 2L * 16 * 512 * 32; i += nthreads()) { const int ch = (int)(i & 31); const long row = i >> 5; const int c = (int)(row & 511), h = (int)((row >> 9) & 15), l = (int)(row >> 13);
        u32x4 w = (u32x4){0u, 0u, 0u, 0u};
        if (ch < 16) { const float* s = gp(p.w_ukv) + (((long)l * 512 + c) * 16 + h) * 256 + ch * 8; float f[8];
#pragma unroll
            for (int j = 0; j < 8; ++j) f[j] = s[j];
            w = pack8(f); }
        *reinterpret_cast<u32x4*>((bf16_t*)(ws + WS_WUK) + row * 256 + ch * 8) = w; }
    for (long i = gthread(); i < 2L * 4096; i += nthreads()) { const bool second = i >= 4096; const long j8 = (second ? i - 4096 : i) * 8; const float* s = (second ? gp(p.peer_k2) : gp(p.peer_k1)) + j8; float f[8];
#pragma unroll
        for (int j = 0; j < 8; ++j) f[j] = s[j];
        *reinterpret_cast<u32x4*>((bf16_t*)(ws + (second ? WS_PK2 : WS_PK1)) + j8) = pack8(f); }
    for (int l = 0; l < 2; ++l) zero_chunks((bf16_t*)(ws + WS_WIN) + ((long)l * INWP + INW) * DM, INWP - INW, DM, 0, DM / 8);
    for (int b = 0; b < DB; ++b) zero_chunks((bf16_t*)(ws + WS_CKA) + ((long)b * KPAD + KALL) * QLD, KPAD - KALL, QLD, 0, QLD / 8);
    zero_chunks((bf16_t*)(ws + WS_CKA), (long)DB * KPAD, QLD, 576, 8);
    zero_chunks((bf16_t*)(ws + WS_CKT), (long)DB * 512, KPAD, KALL, (KPAD - KALL) / 8);
    zero_chunks((bf16_t*)(ws + WS_QL), (long)DB * 1024, QLD, 576, 8);
    for (long i = gthread(); i < 4096L * 96; i += nthreads()) { const int pos = (int)(i / 96), k = (int)(i % 96); const bool big = k >= 32; const int fi = big ? k - 32 : k; const float d = big ? 128.f : 64.f;
        const float inv = __builtin_amdgcn_exp2f(-(2.0f * (float)fi / d) * 13.287712379549449f);
        const float ang = (float)pos * inv; double rv = (double)ang * 0.15915494309189535; rv -= floor(rv); const float fr = (float)rv;
        float* dst = big ? (float*)(ws + WS_TAB128) + ((long)pos * 64 + fi) * 2 : (float*)(ws + WS_TAB64) + ((long)pos * 32 + fi) * 2;
        dst[0] = __builtin_amdgcn_cosf(fr); dst[1] = __builtin_amdgcn_sinf(fr); }
    { float* sc = (float*)lds;
      for (int it = obid(); it < 2 * 12 * 8; it += ogrid()) { const int l = it / 96, cc = (it % 96) / 8, ks = it % 8;
        __syncthreads();
        for (int i = tid; i < NCOND * 256; i += 512) { const int r = i >> 8, k = i & 255; const float c = r < NB ? gp(p.c_prompt)[(long)r * DM + ks * 256 + k] : gp(p.c_sample)[(long)(r - NB) * DM + ks * 256 + k]; sc[i] = siluf_(c); }
        __syncthreads();
        float a0[NCOND], a1[NCOND];
#pragma unroll
        for (int r = 0; r < NCOND; ++r) { a0[r] = 0.f; a1[r] = 0.f; }
        const float* wp = gp(p.w_ada) + ((long)l * DM + ks * 256) * 12288 + cc * 1024 + 2 * tid;
#pragma unroll 1
        for (int k = 0; k < 256; k += 4) { const f32x2 w0 = *reinterpret_cast<const f32x2*>(wp), w1 = *reinterpret_cast<const f32x2*>(wp + 12288), w2 = *reinterpret_cast<const f32x2*>(wp + 2 * 12288), w3 = *reinterpret_cast<const f32x2*>(wp + 3 * 12288);
            wp += 4 * 12288;
#pragma unroll
            for (int r = 0; r < NCOND; ++r) { const f32x4 s = *reinterpret_cast<const f32x4*>(sc + r * 256 + k);
                a0[r] = fmaf(s[0], w0[0], fmaf(s[1], w1[0], fmaf(s[2], w2[0], fmaf(s[3], w3[0], a0[r]))));
                a1[r] = fmaf(s[0], w0[1], fmaf(s[1], w1[1], fmaf(s[2], w2[1], fmaf(s[3], w3[1], a1[r]))));
                if ((r % 6) == 5) __builtin_amdgcn_sched_barrier(0); } }
        float* dst = (float*)(ws + WS_ADAP) + (((long)ks * 2 + l) * NCOND) * 12288 + cc * 1024 + 2 * tid;
#pragma unroll
        for (int r = 0; r < NCOND; ++r) *reinterpret_cast<f32x2*>(dst + (long)r * 12288) = (f32x2){a0[r], a1[r]}; }
      __syncthreads(); }
}

__device__ __forceinline__ void wpq_int8(KParams& p) {
    unsigned char* ws = optr(gp(p.ws)); const int lane = otid() & 63;
    for (int r = gwave(); r < 2 * DM; r += nwaves()) { const bf16_t* src = (const bf16_t*)(ws + WS_WPQ) + (long)r * DM; float f[4][8]; float am = 0.f;
#pragma unroll
        for (int j = 0; j < 4; ++j) { unpack8(*reinterpret_cast<const u32x4*>(src + 512 * j + 8 * lane), f[j]);
#pragma unroll
            for (int i = 0; i < 8; ++i) am = fmaxf(am, fabsf(f[j][i])); }
        am = wave_max(am); const float qs = am > 0.f ? 127.0f / am : 0.f;
#pragma unroll
        for (int j = 0; j < 4; ++j) { unsigned w2[2];
#pragma unroll
            for (int hh = 0; hh < 2; ++hh) { unsigned w = 0u;
#pragma unroll
                for (int i = 0; i < 4; ++i) w |= ((unsigned)((int)__builtin_rintf(f[j][4 * hh + i] * qs) & 0xff)) << (8 * i);
                w2[hh] = w; }
            *reinterpret_cast<u32x2*>(ws + WS_WPQ8 + (long)r * DM + 512 * j + 8 * lane) = (u32x2){w2[0], w2[1]}; }
        if (lane == 0) ((float*)(ws + WS_SB8))[r] = am * (1.0f / 127.0f); }
}

__device__ __forceinline__ void rows2048_int8(KParams& p, size_t src_off, size_t dst_off, size_t sc_off, int nrows) {
    unsigned char* ws = optr(gp(p.ws)); const int lane = otid() & 63;
    for (int r = gwave(); r < nrows; r += nwaves()) { const bf16_t* src = (const bf16_t*)(ws + src_off) + (long)r * DM; float f[4][8]; float am = 0.f;
#pragma unroll
        for (int j = 0; j < 4; ++j) { unpack8(*reinterpret_cast<const u32x4*>(src + 512 * j + 8 * lane), f[j]);
#pragma unroll
            for (int i = 0; i < 8; ++i) am = fmaxf(am, fabsf(f[j][i])); }
        am = wave_max(am); const float qs = am > 0.f ? 127.0f / am : 0.f;
#pragma unroll
        for (int j = 0; j < 4; ++j) { unsigned w2[2];
#pragma unroll
            for (int hh = 0; hh < 2; ++hh) { unsigned w = 0u;
#pragma unroll
                for (int i = 0; i < 4; ++i) w |= ((unsigned)((int)__builtin_rintf(f[j][4 * hh + i] * qs) & 0xff)) << (8 * i);
                w2[hh] = w; }
            *reinterpret_cast<u32x2*>(ws + dst_off + (long)r * DM + 512 * j + 8 * lane) = (u32x2){w2[0], w2[1]}; }
        if (lane == 0) ((float*)(ws + sc_off))[r] = am * (1.0f / 127.0f); }
}
__device__ __forceinline__ void wb_int8(KParams& p, int l) {
    unsigned char* ws = optr(gp(p.ws)); const int lane = otid() & 63;
    for (int r = gwave(); r < DM; r += nwaves()) { const bf16_t* src = (const bf16_t*)(ws + WS_WB) + ((long)l * DM + r) * DM; float f[4][8]; float am = 0.f;
#pragma unroll
        for (int j = 0; j < 4; ++j) { unpack8(*reinterpret_cast<const u32x4*>(src + 512 * j + 8 * lane), f[j]);
#pragma unroll
            for (int i = 0; i < 8; ++i) am = fmaxf(am, fabsf(f[j][i])); }
        am = wave_max(am); const float qs = am > 0.f ? 127.0f / am : 0.f;
#pragma unroll
        for (int j = 0; j < 4; ++j) { unsigned w2[2];
#pragma unroll
            for (int hh = 0; hh < 2; ++hh) { unsigned w = 0u;
#pragma unroll
                for (int i = 0; i < 4; ++i) w |= ((unsigned)((int)__builtin_rintf(f[j][4 * hh + i] * qs) & 0xff)) << (8 * i);
                w2[hh] = w; }
            *reinterpret_cast<u32x2*>(ws + WS_WB8 + (long)r * DM + 512 * j + 8 * lane) = (u32x2){w2[0], w2[1]}; }
        if (lane == 0) ((float*)(ws + WS_SBB))[r] = am * (1.0f / 127.0f); }
}

__device__ __forceinline__ void win_int8(KParams& p, int l) {
    unsigned char* ws = optr(gp(p.ws)); const int lane = otid() & 63;
    for (int jr = gwave(); jr < NB8 * 256; jr += nwaves()) { const int blk = jr >> 8, n = (blk < 2 ? blk : (blk < 5 ? blk + 3 : blk + 7)) * 256 + (jr & 255);
        const bf16_t* src = (const bf16_t*)(ws + WS_WIN) + ((long)l * INWP + n) * DM; float f[4][8]; float am = 0.f;
#pragma unroll
        for (int j = 0; j < 4; ++j) { unpack8(*reinterpret_cast<const u32x4*>(src + 512 * j + 8 * lane), f[j]);
#pragma unroll
            for (int i = 0; i < 8; ++i) am = fmaxf(am, fabsf(f[j][i])); }
        am = wave_max(am); const float qs = am > 0.f ? 127.0f / am : 0.f;
#pragma unroll
        for (int j = 0; j < 4; ++j) { unsigned w2[2];
#pragma unroll
            for (int hh = 0; hh < 2; ++hh) { unsigned w = 0u;
#pragma unroll
                for (int i = 0; i < 4; ++i) w |= ((unsigned)((int)__builtin_rintf(f[j][4 * hh + i] * qs) & 0xff)) << (8 * i);
                w2[hh] = w; }
            *reinterpret_cast<u32x2*>(ws + WS_WIN8 + (long)jr * DM + 512 * j + 8 * lane) = (u32x2){w2[0], w2[1]}; }
        if (lane == 0) ((float*)(ws + WS_SBW))[n] = am * (1.0f / 127.0f); }
}

__device__ __forceinline__ void ada_reduce(KParams& p) {
    unsigned char* ws = optr(gp(p.ws)); const float* ap = (const float*)(ws + WS_ADAP); float* ad = (float*)(ws + WS_ADA); const long n = 2L * NCOND * 12288;
    for (long i = gthread(); i < n; i += nthreads()) { const int l = (int)(i / (NCOND * 12288L)); const int j = (int)(i % 12288);
        float s = gp(p.b_ada)[(long)l * 12288 + j];
#pragma unroll
        for (int ks = 0; ks < 8; ++ks) s += ap[(long)ks * n + i];
        ad[i] = s; }
}

__device__ __forceinline__ void modulate(KParams& p, int l, int which) {
    const int lane = otid() & 63; unsigned char* ws = optr(gp(p.ws)); const float* X = gp(p.out); bf16_t* H = (bf16_t*)(ws + WS_H);
    const float* g = (which ? gp(p.g_ffn) : gp(p.g_mix)) + (long)l * DM; const float* ada = (const float*)(ws + WS_ADA) + (long)l * NCOND * 12288 + (which ? 3 : 0) * DM;
    for (int t = gwave(); t < T; t += nwaves()) {
        const float* xr = (l == 0 && which == 0) ? (t < TP ? gp(p.x_prompt) + (long)t * DM : gp(p.x_sample) + (long)(t - TP) * DM) : X + (long)t * DM; f32x4 v[8]; float ss = 0.f;
#pragma unroll
        for (int j = 0; j < 8; ++j) { v[j] = *reinterpret_cast<const f32x4*>(xr + 256 * j + 4 * lane); ss += v[j][0] * v[j][0] + v[j][1] * v[j][1] + v[j][2] * v[j][2] + v[j][3] * v[j][3]; }
        ss = wave_sum(ss); const float rinv = rsqrtf(ss * (1.0f / DM) + EPS);
        const float* sh = ada + (long)cond_row(t) * 12288; const float* sc = sh + DM;
#pragma unroll
        for (int j = 0; j < 8; ++j) { const int c = 256 * j + 4 * lane; const f32x4 gv = *reinterpret_cast<const f32x4*>(g + c), sv = *reinterpret_cast<const f32x4*>(sc + c), hv = *reinterpret_cast<const f32x4*>(sh + c);
            const f32x4 y = v[j] * rinv * gv * (sv + 1.0f) + hv; u32x2 w; w.x = cvt_pk_bf16(y[0], y[1]); w.y = cvt_pk_bf16(y[2], y[3]);
            *reinterpret_cast<u32x2*>(H + (long)t * DM + c) = w; v[j] = y; }
        {
            float am = 0.f;
#pragma unroll
            for (int j = 0; j < 8; ++j) am = fmaxf(am, fmaxf(fmaxf(fabsf(v[j][0]), fabsf(v[j][1])), fmaxf(fabsf(v[j][2]), fabsf(v[j][3]))));
            am = wave_max(am); const float qs = am > 0.f ? 127.0f / am : 0.f;
#pragma unroll
            for (int j = 0; j < 8; ++j) { const int c = 256 * j + 4 * lane;
                const int q0 = (int)__builtin_rintf(v[j][0] * qs), q1 = (int)__builtin_rintf(v[j][1] * qs), q2 = (int)__builtin_rintf(v[j][2] * qs), q3 = (int)__builtin_rintf(v[j][3] * qs);
                *reinterpret_cast<unsigned*>(ws + WS_H8 + (long)t * DM + c) = (unsigned)(q0 & 0xff) | ((unsigned)(q1 & 0xff) << 8) | ((unsigned)(q2 & 0xff) << 16) | ((unsigned)(q3 & 0xff) << 24); }
            if (lane == 0) ((float*)(ws + WS_SA8))[t] = am * (1.0f / 127.0f); }
    }
}

__device__ __forceinline__ void cache_convert(KParams& p, int l, char* lds, int it0, int it1, int bidx, int nb) {
    const int tid = otid(); unsigned char* ws = optr(gp(p.ws)); float* tile = (float*)lds; bf16_t* CKA = (bf16_t*)(ws + WS_CKA); bf16_t* CKT = (bf16_t*)(ws + WS_CKT);
    { const int NT_ = it1, G_ = nb; int it = it0 + bidx; float v[8];
      const float* cbase = gp(p.cache_ckv) + (long)l * DB * PAST * 512;
#define CC_SRC(itx) (cbase + (((long)((itx) >> 8)) * PAST + (((itx) >> 3) & 31) * 64) * 512 + ((itx) & 7) * 64)
      if (it < NT_) { const float* src = CC_SRC(it);
#pragma unroll
        for (int i = 0; i < 8; ++i) { const int idx = tid + 512 * i, r = idx >> 6, c = idx & 63; v[i] = src[(long)r * 512 + c]; } }
      while (it < NT_) { const int b = it >> 8, kt = (it >> 3) & 31, ct = it & 7; const int itn = it + G_; float vn[8];
        if (itn < NT_) { const float* src = CC_SRC(itn);
#pragma unroll
            for (int i = 0; i < 8; ++i) { const int idx = tid + 512 * i, r = idx >> 6, c = idx & 63; vn[i] = src[(long)r * 512 + c]; } }
#pragma unroll
        for (int i = 0; i < 8; ++i) { const int idx = tid + 512 * i, r = idx >> 6, c = idx & 63; tile[r * 65 + c] = v[i]; }
        __syncthreads();
        { const int r = tid >> 3, cc = (tid & 7) * 8; float f[8];
#pragma unroll
          for (int j = 0; j < 8; ++j) f[j] = tile[r * 65 + cc + j];
          *reinterpret_cast<u32x4*>(CKA + ((long)b * KPAD + kt * 64 + r) * QLD + ct * 64 + cc) = pack8(f);
#pragma unroll
          for (int j = 0; j < 8; ++j) f[j] = tile[(cc + j) * 65 + r];
          *reinterpret_cast<u32x4*>(CKT + ((long)b * 512 + ct * 64 + r) * KPAD + kt * 64 + cc) = pack8(f); }
        __syncthreads();
#pragma unroll
        for (int i = 0; i < 8; ++i) v[i] = vn[i];
        it = itn; }
#undef CC_SRC
    }
    for (long i = (long)it0 * 64 + (long)bidx * 512 + tid; i < (long)it1 * 64; i += (long)nb * 512) { const long row = i >> 3; const int ch = (int)(i & 7); const int b = (int)(row >> 11), k = (int)(row & 2047);
        const float* s = gp(p.cache_krope) + (((long)l * DB + b) * PAST + k) * 64 + ch * 8; float f[8];
#pragma unroll
        for (int j = 0; j < 8; ++j) f[j] = s[j];
        *reinterpret_cast<u32x4*>(CKA + ((long)b * KPAD + k) * QLD + 512 + ch * 8) = pack8(f); }
}

__device__ __forceinline__ void quant_row8(const float (&o)[8], unsigned char* dst, float* sc, int lane) {
    float am = 0.f;
#pragma unroll
    for (int j = 0; j < 8; ++j) am = fmaxf(am, fabsf(o[j]));
    am = wave_max(am); const float qs = am > 0.f ? 127.0f / am : 0.f; unsigned w2[2];
#pragma unroll
    for (int hh = 0; hh < 2; ++hh) { unsigned w = 0u;
#pragma unroll
        for (int i = 0; i < 4; ++i) w |= ((unsigned)((int)__builtin_rintf(o[4 * hh + i] * qs) & 0xff)) << (8 * i);
        w2[hh] = w; }
    *reinterpret_cast<u32x2*>(dst) = (u32x2){w2[0], w2[1]};
    if (lane == 0) *sc = am * (1.0f / 127.0f);
}
__device__ __forceinline__ void wu_int8(KParams& p, int l) {
    unsigned char* ws = optr(gp(p.ws)); const int lane = otid() & 63;
    for (int r = gwave(); r < 3072 + 4096; r += nwaves()) { const bool kv = r >= 3072; const int rr = kv ? r - 3072 : r;
        const bf16_t* src = kv ? (const bf16_t*)(ws + WS_WUKV) + ((long)l * 4096 + rr) * 512 : (const bf16_t*)(ws + WS_WUQ) + ((long)l * 3072 + rr) * 512;
        float f[8]; unpack8(*reinterpret_cast<const u32x4*>(src + 8 * lane), f);
        quant_row8(f, ws + (kv ? WS_WUKV8 : WS_WUQ8) + (long)rr * 512 + 8 * lane, (float*)(ws + (kv ? WS_SBK : WS_SBQ)) + rr, lane); }
}

__device__ __forceinline__ void post_win(KParams& p, int l) {
    const int lane = otid() & 63; unsigned char* ws = optr(gp(p.ws));
    bf16_t* Y = (bf16_t*)(ws + WS_Y); bf16_t* CQN = (bf16_t*)(ws + WS_CQN); bf16_t* CKVNP = (bf16_t*)(ws + WS_CKVNP); bf16_t* KRP = (bf16_t*)(ws + WS_KRP); bf16_t* CKA = (bf16_t*)(ws + WS_CKA); bf16_t* CKT = (bf16_t*)(ws + WS_CKT);
    const float* T64 = (const float*)(ws + WS_TAB64); const float* T128 = (const float*)(ws + WS_TAB128);
    for (int t = gwave(); t < T; t += nwaves()) {
        bf16_t* y = Y + (long)t * INWP; const int pos = tok_pos(t); const bool samp = t >= TP; const int ts = t - TP, b = ts >> 6, s = ts & 63;
        { float f[8], o[8]; unpack8(*reinterpret_cast<const u32x4*>(y + C_CQ + 8 * lane), f); float ss = 0.f;
#pragma unroll
          for (int j = 0; j < 8; ++j) ss += f[j] * f[j];
          ss = wave_sum(ss); const float rinv = rsqrtf(ss * (1.0f / 512.f) + EPS); const float* g = gp(p.g_q) + (long)l * 512 + 8 * lane;
#pragma unroll
          for (int j = 0; j < 8; ++j) o[j] = f[j] * rinv * g[j];
          quant_row8(o, (unsigned char*)CQN + (long)t * 512 + 8 * lane, (float*)(ws + WS_SAQ) + t, lane); }
        { float f[8], o[8]; unpack8(*reinterpret_cast<const u32x4*>(y + C_CKV + 8 * lane), f); float ss = 0.f;
#pragma unroll
          for (int j = 0; j < 8; ++j) ss += f[j] * f[j];
          ss = wave_sum(ss); const float rinv = rsqrtf(ss * (1.0f / 512.f) + EPS); const float* g = gp(p.g_kv) + (long)l * 512 + 8 * lane;
#pragma unroll
          for (int j = 0; j < 8; ++j) o[j] = f[j] * rinv * g[j];
          float* od = gp(p.out) + (samp ? O_CKVS + ((long)l * TS + ts) * 512 : O_CKVP + ((long)l * TP + t) * 512) + 8 * lane;
          *reinterpret_cast<f32x4*>(od) = (f32x4){o[0], o[1], o[2], o[3]}; *reinterpret_cast<f32x4*>(od + 4) = (f32x4){o[4], o[5], o[6], o[7]};
          const u32x4 w = pack8(o);
          if (!samp) quant_row8(o, (unsigned char*)CKVNP + (long)t * 512 + 8 * lane, (float*)(ws + WS_SAK) + t, lane);
          else { *reinterpret_cast<u32x4*>(CKA + ((long)b * KPAD + PAST + s) * QLD + 8 * lane) = w;
#pragma unroll
              for (int j = 0; j < 8; ++j) CKT[((long)b * 512 + 8 * lane + j) * KPAD + PAST + s] = f2bf(o[j]); } }
        if (lane < 32) { const float x1 = bf2f(y[C_KR + lane]), x2 = bf2f(y[C_KR + 32 + lane]); const float c = T64[((long)pos * 32 + lane) * 2], sn = T64[((long)pos * 32 + lane) * 2 + 1];
            const float o1 = x1 * c - x2 * sn, o2 = x1 * sn + x2 * c;
            float* od = gp(p.out) + (samp ? O_KRS + ((long)l * TS + ts) * 64 : O_KRP + ((long)l * TP + t) * 64); od[lane] = o1; od[32 + lane] = o2;
            if (!samp) { KRP[(long)t * 64 + lane] = f2bf(o1); KRP[(long)t * 64 + 32 + lane] = f2bf(o2); }
            else { bf16_t* d = CKA + ((long)b * KPAD + PAST + s) * QLD + 512; d[lane] = f2bf(o1); d[32 + lane] = f2bf(o2); } }
        { const int hh = lane >> 3, d0 = (lane & 7) * 8; const float* cs = T128 + ((long)pos * 64 + d0) * 2; float cv[8], sv[8];
#pragma unroll
          for (int j = 0; j < 4; ++j) { const f32x4 q = *reinterpret_cast<const f32x4*>(cs + 4 * j); cv[2 * j] = q[0]; sv[2 * j] = q[1]; cv[2 * j + 1] = q[2]; sv[2 * j + 1] = q[3]; }
#pragma unroll
          for (int which = 0; which < 2; ++which) { bf16_t* base = y + (which ? C_RK : C_RQ) + hh * 128 + d0; const float sca = which ? 0.08838834764831845f : 1.0f;
              float a[8], bq[8], o1[8], o2[8]; unpack8(*reinterpret_cast<const u32x4*>(base), a); unpack8(*reinterpret_cast<const u32x4*>(base + 64), bq);
#pragma unroll
              for (int j = 0; j < 8; ++j) { o1[j] = (a[j] * cv[j] - bq[j] * sv[j]) * sca; o2[j] = (a[j] * sv[j] + bq[j] * cv[j]) * sca; }
              *reinterpret_cast<u32x4*>(base) = pack8(o1); *reinterpret_cast<u32x4*>(base + 64) = pack8(o2); } }
    }
}

__device__ __forceinline__ void post_q(KParams& p) {
    const int lane = otid() & 63; unsigned char* ws = optr(gp(p.ws)); bf16_t* Q = (bf16_t*)(ws + WS_Q); bf16_t* QL = (bf16_t*)(ws + WS_QL); const float* T64 = (const float*)(ws + WS_TAB64);
    for (int t = gwave(); t < T; t += nwaves()) { const int pos = tok_pos(t); const int hd = lane >> 2, d0 = (lane & 3) * 8;
        bf16_t* base = Q + (long)t * 3072 + hd * 192 + 128 + d0; const float* cs = T64 + ((long)pos * 32 + d0) * 2; float cv[8], sv[8];
#pragma unroll
        for (int j = 0; j < 4; ++j) { const f32x4 q = *reinterpret_cast<const f32x4*>(cs + 4 * j); cv[2 * j] = q[0]; sv[2 * j] = q[1]; cv[2 * j + 1] = q[2]; sv[2 * j + 1] = q[3]; }
        float a[8], bq[8], o1[8], o2[8]; unpack8(*reinterpret_cast<const u32x4*>(base), a); unpack8(*reinterpret_cast<const u32x4*>(base + 32), bq);
#pragma unroll
        for (int j = 0; j < 8; ++j) { o1[j] = a[j] * cv[j] - bq[j] * sv[j]; o2[j] = a[j] * sv[j] + bq[j] * cv[j]; }
        const u32x4 w1 = pack8(o1), w2 = pack8(o2);
        *reinterpret_cast<u32x4*>(base) = w1; *reinterpret_cast<u32x4*>(base + 32) = w2;
        if (t >= TP) { const int ts = t - TP, b = ts >> 6, s = ts & 63; bf16_t* d = QL + ((long)b * 1024 + hd * 64 + s) * QLD + 512 + d0;
            *reinterpret_cast<u32x4*>(d) = w1; *reinterpret_cast<u32x4*>(d + 32) = w2; } }
}

__device__ __forceinline__ void softmax_rows(KParams& p) {
    const int lane = otid() & 63; unsigned char* ws = optr(gp(p.ws)); bf16_t* SP = (bf16_t*)(ws + WS_SP);
    for (int r = gwave(); r < DB * 1024; r += nwaves()) { bf16_t* row = SP + (long)r * KPAD; float v[5][8]; float mx = -3.0e38f;
#pragma unroll
        for (int j = 0; j < 5; ++j) { const int ch = lane + 64 * j;
            if (ch < KALL / 8) { unpack8(*reinterpret_cast<const u32x4*>(row + ch * 8), v[j]);
#pragma unroll
                for (int i = 0; i < 8; ++i) { v[j][i] *= MLA_SCALE; mx = fmaxf(mx, v[j][i]); } }
            else {
#pragma unroll
                for (int i = 0; i < 8; ++i) v[j][i] = -3.0e38f; } }
        mx = wave_max(mx); float sum = 0.f;
#pragma unroll
        for (int j = 0; j < 5; ++j) { const int ch = lane + 64 * j;
#pragma unroll
            for (int i = 0; i < 8; ++i) { v[j][i] = (ch < KALL / 8) ? __expf(v[j][i] - mx) : 0.f; sum += v[j][i]; } }
        sum = wave_sum(sum); const float inv = 1.0f / sum;
#pragma unroll
        for (int j = 0; j < 5; ++j) { const int ch = lane + 64 * j;
            if (ch < KPAD / 8) { float o[8];
#pragma unroll
                for (int i = 0; i < 8; ++i) o[i] = v[j][i] * inv;
                *reinterpret_cast<u32x4*>(row + ch * 8) = pack8(o); } } }
}

__device__ __forceinline__ void gnorm_gate(KParams& p, int w0, int nw) {
    const int lane = otid() & 63; unsigned char* ws = optr(gp(p.ws)); const bf16_t* OB = (const bf16_t*)(ws + WS_OB); const bf16_t* Y = (const bf16_t*)(ws + WS_Y);
    for (int t = w0; t < T; t += nw) { const int c0 = (lane >> 3) * 256 + (lane & 7) * 32; float x[4][8]; float s = 0.f;
#pragma unroll
        for (int i = 0; i < 4; ++i) { unpack8(*reinterpret_cast<const u32x4*>(OB + ((long)lane * T + t) * 32 + 8 * i), x[i]);
#pragma unroll
            for (int j = 0; j < 8; ++j) s += x[i][j]; }
        s += sx<1>(s); s += sx<2>(s); s += sx<4>(s); const float mu = s * (1.0f / 256.f); float q = 0.f;
#pragma unroll
        for (int i = 0; i < 4; ++i)
#pragma unroll
            for (int j = 0; j < 8; ++j) { const float d = x[i][j] - mu; q += d * d; }
        q += sx<1>(q); q += sx<2>(q); q += sx<4>(q); const float rstd = rsqrtf(q * (1.0f / 256.f) + EPS);
        float am = 0.f;
#pragma unroll
        for (int i = 0; i < 4; ++i) { float g[8]; unpack8(*reinterpret_cast<const u32x4*>(Y + (long)t * INWP + C_RG + c0 + 8 * i), g);
#pragma unroll
            for (int j = 0; j < 8; ++j) { x[i][j] = siluf_(g[j]) * (x[i][j] - mu) * rstd; am = fmaxf(am, fabsf(x[i][j])); } }
        am = wave_max(am); const float qs = am > 0.f ? 127.0f / am : 0.f; unsigned w[8];
#pragma unroll
        for (int i = 0; i < 4; ++i)
#pragma unroll
            for (int hh = 0; hh < 2; ++hh) { unsigned v = 0u;
#pragma unroll
                for (int j = 0; j < 4; ++j) v |= ((unsigned)((int)__builtin_rintf(x[i][4 * hh + j] * qs) & 0xff)) << (8 * j);
                w[2 * i + hh] = v; }
        *reinterpret_cast<u32x4*>(ws + WS_BG + (long)t * DM + c0) = (u32x4){w[0], w[1], w[2], w[3]};
        *reinterpret_cast<u32x4*>(ws + WS_BG + (long)t * DM + c0 + 16) = (u32x4){w[4], w[5], w[6], w[7]};
        if (lane == 0) ((float*)(ws + WS_SA8))[t] = am * (1.0f / 127.0f); }
}

__device__ __forceinline__ void peer_convert(KParams& p, int l, int r0, int r1, int w0, int nw) {
    unsigned char* ws = optr(gp(p.ws)); const int lane = otid() & 63;
    const float* su = gp(p.peer_u) + (long)l * NEXP * DM; const float* sv = gp(p.peer_v) + (long)l * NEXP * DM;
    for (int r = r0 + w0; r < r1; r += nw) { const bool second = r >= NEXP; const int row = second ? r - NEXP : r; const float* s = (second ? sv : su) + (long)row * DM;
        f32x4 v[8]; float am = 0.f;
#pragma unroll
        for (int j = 0; j < 8; ++j) { v[j] = *reinterpret_cast<const f32x4*>(s + 512 * (j >> 2) * 2 + 16 * lane + 4 * (j & 3));
            am = fmaxf(am, fmaxf(fmaxf(fabsf(v[j][0]), fabsf(v[j][1])), fmaxf(fabsf(v[j][2]), fabsf(v[j][3])))); }
        am = wave_max(am);
        float sc = 1.0f, isc = 1.0f;
        if (am > 0.f) { const int e = (int)((__float_as_uint(am) >> 23) & 0xffu) - 127;
            int k = 7 - e; k = k > 100 ? 100 : (k < -100 ? -100 : k);
            sc = __uint_as_float((unsigned)(127 + k) << 23); isc = __uint_as_float((unsigned)(127 - k) << 23); }
        unsigned w[8];
        if (!second) {
            const float qs = am > 0.f ? 127.0f / am : 0.f; isc = am * (1.0f / 127.0f);
#pragma unroll
            for (int j = 0; j < 8; ++j) w[j] = ((unsigned)((int)__builtin_rintf(v[j][0] * qs) & 0xff)) | (((unsigned)((int)__builtin_rintf(v[j][1] * qs) & 0xff)) << 8) | (((unsigned)((int)__builtin_rintf(v[j][2] * qs) & 0xff)) << 16) | (((unsigned)((int)__builtin_rintf(v[j][3] * qs) & 0xff)) << 24);
        } else {
#pragma unroll
            for (int j = 0; j < 8; ++j) { int pk = __builtin_amdgcn_cvt_pk_fp8_f32(v[j][0] * sc, v[j][1] * sc, 0, false); pk = __builtin_amdgcn_cvt_pk_fp8_f32(v[j][2] * sc, v[j][3] * sc, pk, true); w[j] = (unsigned)pk; } }
        if (!second) {
            unsigned char* dst = ws + WS_PU + ((long)(lane >> 3) * NEXP + row) * 128 + 16 * (lane & 7);
            *reinterpret_cast<u32x4*>(dst) = (u32x4){w[0], w[1], w[2], w[3]};
            *reinterpret_cast<u32x4*>(dst + 8L * NEXP * 128) = (u32x4){w[4], w[5], w[6], w[7]};
        } else {
            unsigned char* dst = ws + WS_PV + ((long)(2 * lane) * NEXP + row) * 8;
            *reinterpret_cast<u32x2*>(dst) = (u32x2){w[0], w[1]}; *reinterpret_cast<u32x2*>(dst + (long)NEXP * 8) = (u32x2){w[2], w[3]};
            *reinterpret_cast<u32x2*>(dst + 128L * NEXP * 8) = (u32x2){w[4], w[5]}; *reinterpret_cast<u32x2*>(dst + 129L * NEXP * 8) = (u32x2){w[6], w[7]}; }
        if (lane == 0) ((float*)(ws + (second ? WS_PSV : WS_PSU)))[row] = isc; }
}

__device__ __forceinline__ void final_norm(KParams& p) {
    const int lane = otid() & 63; float* X = gp(p.out);
    for (int t = gwave(); t < T; t += nwaves()) { float* xr = X + (long)t * DM; f32x4 v[8]; float ss = 0.f;
#pragma unroll
        for (int j = 0; j < 8; ++j) { v[j] = *reinterpret_cast<const f32x4*>(xr + 256 * j + 4 * lane); ss += v[j][0] * v[j][0] + v[j][1] * v[j][1] + v[j][2] * v[j][2] + v[j][3] * v[j][3]; }
        ss = wave_sum(ss); const float rinv = rsqrtf(ss * (1.0f / DM) + EPS);
#pragma unroll
        for (int j = 0; j < 8; ++j) { const int c = 256 * j + 4 * lane; const f32x4 gv = *reinterpret_cast<const f32x4*>(gp(p.g_final) + c); *reinterpret_cast<f32x4*>(xr + c) = v[j] * rinv * gv; } }
}
}
__global__ void __launch_bounds__(512, 2) mega_fwd(Params p_by_value_unused) {
    extern __shared__ __attribute__((aligned(16))) unsigned char shm[];
    LAS unsigned char* lds = (LAS unsigned char*)shm; char* ldsg = (char*)shm;
    if (threadIdx.x < 8) ((LAS unsigned*)(lds + LDS_BARW))[threadIdx.x] = 0u;
    __syncthreads();
    if (threadIdx.x == 0) { unsigned* tk = (unsigned*)(gp(KP.ws) + WS_CTL + CTL_RANK) + 64 * xb_xcc_id(); ((volatile LAS unsigned*)(lds + LDS_BARW))[2] = xb_add(tk, 1u); }
    const XcdBarrier bar = xcd_barrier_post((unsigned*)(gp(KP.ws) + WS_CTL), (volatile LAS unsigned*)(lds + LDS_BARW));
#define GRID_SYNC() xcd_barrier(bar)
#ifndef STOP_AT
#define STOP_AT 0
#endif
#ifdef DBG_DUMP
#define STOPCHK(n) do { if (STOP_AT == (n)) { float* xo = gp(KP.out); const bf16_t* src = (const bf16_t*)(gp(KP.ws) + DBG_DUMP); for (long i = ph::gthread(); i < (long)T * DM; i += ph::nthreads()) xo[i] = bf2f(src[i]); return; } } while (0)
#elif defined(DBG_SANITIZE)
#define STOPCHK(n) do { if (STOP_AT == (n) || (STOP_AT > 100 && l == 1 && STOP_AT - 100 == (n))) { float* xo = gp(KP.out); for (long i = ph::gthread(); i < (long)T * DM; i += ph::nthreads()) { const float v = xo[i]; if (!(v - v == 0.0f)) xo[i] = 7.0f; } return; } } while (0)
#else
#define STOPCHK(n) do { if (STOP_AT == (n) || (STOP_AT > 100 && l == 1 && STOP_AT - 100 == (n))) return; } while (0)
#endif
    using namespace pg8;
#define WSP(off) ((bf16_t*)(optr(gp(KP.ws)) + (off)))
#define H WSP(WS_H)
#define Y WSP(WS_Y)
#define CQN WSP(WS_CQN)
#define CKVNP WSP(WS_CKVNP)
#define KRP WSP(WS_KRP)
#define Q WSP(WS_Q)
#define YA WSP(WS_YA)
#define KV WSP(WS_KV)
#define SP WSP(WS_SP)
#define MIX WSP(WS_MIX)
#define OA WSP(WS_OA)
#define QP WSP(WS_QP)
#define CKA WSP(WS_CKA)
#define CKT WSP(WS_CKT)
#define QL WSP(WS_QL)
#define OL WSP(WS_OL)
#define BG WSP(WS_BG)
    int l = 0;
    ph::prologue(KP, ldsg);
#ifdef DUP_PRO
    ph::prologue(KP, ldsg);
#endif
    GRID_SYNC(); STOPCHK(1);
    if (threadIdx.x == 0) { unsigned* barw = (unsigned*)(gp(KP.ws) + WS_CTL); const unsigned me = xb_xcc_id(); unsigned nx = 0, xi = 0, nloc = 1;
        for (unsigned j = 0; j < 16; ++j) { const unsigned cn = xb_ld(&barw[XB_XCNT(j)]); if (cn) { if (j < me) ++xi; ++nx; } if (j == me) nloc = cn ? cn : 1u; }
        volatile LAS unsigned* iw = (volatile LAS unsigned*)(lds + LDS_BARW); iw[3] = xi; iw[4] = nx; iw[5] = nloc; }
    __syncthreads();
    ph::ada_reduce(KP);
    ph::wpq_int8(KP);
    GRID_SYNC(); STOPCHK(2);
    for (l = 0; l < DEPTH; ++l) {
#define WIN (WSP(WS_WIN) + (long)l * INWP * DM)
#define WUQ (WSP(WS_WUQ) + (long)l * 3072 * 512)
#define WUKV (WSP(WS_WUKV) + (long)l * 4096 * 512)
#define WUK (WSP(WS_WUK) + (long)l * 16 * 512 * 256)
#define WA (WSP(WS_WA) + (long)l * DM * DM)
#define WB (WSP(WS_WB) + (long)l * DM * DM)
#define WO (WSP(WS_WO) + (long)l * DM * DM)
#define WPQ (WSP(WS_WPQ) + (long)l * DM * DM)
#define ADA ((const float*)(optr(gp(KP.ws)) + WS_ADA) + (long)l * NCOND * 12288)
        ph::modulate(KP, l, 0);
        ph::win_int8(KP, l);
        ph::wb_int8(KP, l);
        ph::wu_int8(KP, l);
        ph::rows2048_int8(KP, WS_WA + (size_t)l * DM * DM * 2, WS_WA8, WS_SBA, DM);
        ph::rows2048_int8(KP, WS_WO + (size_t)l * DM * DM * 2, WS_WO8, WS_SBO, DM);
        ph::cache_convert(KP, l, ldsg, l == 0 ? 0 : 4096, 8192, obid(), ogrid());
        GRID_SYNC(); STOPCHK(3);
        { Sched<5> S; S.init(T / 256, INWP / 256 - NB8, (T / 256) * (INWP / 256 - NB8), DM, DM); gemm_phase(lds, Gemm{H, WIN, DM, DM, DM}, S, EpiBf16{Y, INWP, 0}); }
        { Sched<6> S; S.init(T / 256, NB8, (T / 256) * NB8, DM / 2, DM / 2);
          { const int G_ = ogrid(); S.rotate((((((T / 256) * NB8) % G_) + 7) & ~7) % G_); }
          unsigned char* ws8 = optr(gp(KP.ws));
          gemm_phase<EpiQ8, Sched<6>, true>(lds, Gemm{(const bf16_t*)(ws8 + WS_H8), (const bf16_t*)(ws8 + WS_WIN8), DM / 2, DM / 2, DM / 2}, S, EpiQ8{Y, INWP, (const float*)(ws8 + WS_SA8), (const float*)(ws8 + WS_SBW)}); }
#ifdef DUP_WIN
        { Sched<0> S; S.init(T / 256, INWP / 256, (T / 256) * (INWP / 256), DM, DM); gemm_phase(lds, Gemm{H, WIN, DM, DM, DM}, S, EpiBf16{Y, INWP, 0}); }
#endif
        GRID_SYNC(); STOPCHK(4);
        ph::post_win(KP, l);
        GRID_SYNC(); STOPCHK(5);
        { unsigned char* ws8 = optr(gp(KP.ws));
          { Sched<0> S; S.init(T / 256, 3072 / 256, (T / 256) * 12, 256, 256); gemm_phase<EpiQ, Sched<0>, 2>(lds, Gemm{CQN, (const bf16_t*)(ws8 + WS_WUQ8), 256, 256, 256, (const float*)(ws8 + WS_SAQ), (const float*)(ws8 + WS_SBQ)}, S, EpiQ{Q, QL, (const float*)(ws8 + WS_TAB64)}); }
          { Sched<0> S; S.init(TP / 256, 4096 / 256, (TP / 256) * 16, 256, 256); gemm_phase<EpiBf16, Sched<0>, 2>(lds, Gemm{CKVNP, (const bf16_t*)(ws8 + WS_WUKV8), 256, 256, 256, (const float*)(ws8 + WS_SAK), (const float*)(ws8 + WS_SBK)}, S, EpiBf16{KV, 4096, 0}); } }
        GRID_SYNC(); STOPCHK(6);
#ifndef DUP_ATTN
#define DUP_ATTN 1
#endif
#ifndef DUP_RET
#define DUP_RET 1
#endif
#ifndef DUP_GATHER
#define DUP_GATHER 0
#endif
#pragma unroll 1
        for (int rep_ = 0; rep_ < DUP_ATTN; ++rep_)
        { for (int u = obid(); u < 512; u += ogrid()) { const int c = u & 255, i = u >> 8, xcd = c & 7, slot = c >> 3; const int bh = xcd * 4 + (slot >> 3) + 32 * i, pr = slot & 7, b = bh >> 4, h = bh & 15;
#pragma unroll 1
              for (int z = 0; z < 2; ++z) { const int qb = z ? 15 - pr : pr; const long tok0 = (long)b * SEQ + 256 * qb;
                  att::attn_block(Q + tok0 * 3072 + h * 192, KV + (long)b * SEQ * 4096 + h * 256, KRP + (long)b * SEQ * 64, KV + (long)b * SEQ * 4096 + h * 256 + 128, OA + tok0 * DM + h * 128, qb, ldsg); } } }
        { Sched<1> S; S.init(0, 0, 256, 3072, 256); gemm_phase(lds, Gemm{Q, WUK, 256, 3072, 256}, S, EpiRowMap<1>{QL, nullptr}); }
        GRID_SYNC(); STOPCHK(8);
        { Sched<2> S; S.init(0, 0, DB * 36, QLD, QLD); gemm_phase(lds, Gemm{QL, CKA, QLD, QLD, QLD}, S, EpiExp{SP, (float*)(optr(gp(KP.ws)) + WS_CTL + CTL_RSUM) + (long)l * 32768}); }
        GRID_SYNC(); STOPCHK(9);
        { Sched<3> S; S.init(0, 0, 256, KPAD, KPAD); gemm_phase(lds, Gemm{SP, CKT, 2176, KPAD, KPAD}, S, EpiRowMap<3>{OL, (const float*)(optr(gp(KP.ws)) + WS_CTL + CTL_RSUM) + (long)l * 32768}); }
        GRID_SYNC(); STOPCHK(11);
        { Sched<4> S; S.init(0, 0, 128, 512, 512); gemm_phase(lds, Gemm{OL, WUKV, 512, 512, 512}, S, EpiOV{OA}); }
#pragma unroll 1
        for (int rep_ = 0; rep_ < DUP_RET; ++rep_)
        for (int u = obid(); u < 256 + DB * 64; u += ogrid()) ret::unit(KP, l, u, ldsg);
#ifdef DUP_RETP
        for (int u = obid(); u < 256; u += ogrid()) ret::unit(KP, l, u, ldsg);
#endif
        GRID_SYNC(); STOPCHK(12);
        ph::rows2048_int8(KP, WS_OA, WS_OA8, WS_SAO, T);
        GRID_SYNC();
        { Sched<0> S; S.init(T / 256, DM / 256, (T / 256) * 8, DM / 2, DM / 2); unsigned char* ws8 = optr(gp(KP.ws));
          gemm_phase<EpiBf16, Sched<0>, 2>(lds, Gemm{(const bf16_t*)(ws8 + WS_OA8), (const bf16_t*)(ws8 + WS_WA8), DM / 2, DM / 2, DM / 2, (const float*)(ws8 + WS_SAO), (const float*)(ws8 + WS_SBA)}, S, EpiBf16{YA, DM, 0}); }
        { const int G_ = ogrid(), rem_ = ((T / 256) * 8) % G_; const int b_ = obid();
          if (rem_ == 0) ph::gnorm_gate(KP, ph::gwave(), ph::nwaves());
          else if (b_ >= rem_) ph::gnorm_gate(KP, (b_ - rem_) * 8 + (otid() >> 6), (G_ - rem_) * 8); }
#ifdef DUP_WA
#pragma unroll 1
        for (int rep_ = 0; rep_ < DUP_WA; ++rep_)
        { Sched<0> S; S.init(T / 256, DM / 256, (T / 256) * 8, DM, DM); gemm_phase(lds, Gemm{OA, WA, DM, DM, DM}, S, EpiBf16{YA, DM, 0}); }
#endif
        GRID_SYNC(); STOPCHK(14);
        { Sched<0> S; S.init(T / 256, DM / 256, (T / 256) * 8, DM / 2, DM / 2); unsigned char* ws8 = optr(gp(KP.ws));
          gemm_phase<EpiMix, Sched<0>, true>(lds, Gemm{(const bf16_t*)(ws8 + WS_BG), (const bf16_t*)(ws8 + WS_WB8), DM / 2, DM / 2, DM / 2}, S, EpiMix{Y, YA, MIX, (const float*)(ws8 + WS_SA8), (const float*)(ws8 + WS_SBB)}); }
        { const int G_ = ogrid(), rem_ = ((T / 256) * 8) % G_; const int b_ = obid();
          if (rem_ == 0) ph::peer_convert(KP, l, 0, NEXP, ph::gwave(), ph::nwaves());
          else if (b_ >= rem_) ph::peer_convert(KP, l, 0, NEXP, (b_ - rem_) * 8 + (otid() >> 6), (G_ - rem_) * 8); }
        GRID_SYNC(); STOPCHK(15);
        ph::rows2048_int8(KP, WS_MIX, WS_MIX8, WS_SA8, T);
        GRID_SYNC();
        { Sched<0> S; S.init(T / 256, DM / 256, (T / 256) * 8, DM / 2, DM / 2); unsigned char* ws8 = optr(gp(KP.ws));
          gemm_phase<EpiRes, Sched<0>, 2>(lds, Gemm{(const bf16_t*)(ws8 + WS_MIX8), (const bf16_t*)(ws8 + WS_WO8), DM / 2, DM / 2, DM / 2, (const float*)(ws8 + WS_SA8), (const float*)(ws8 + WS_SBO)}, S, EpiRes{gp(KP.out), ADA + 2 * DM, l == 0 ? gp(KP.x_prompt) : gp(KP.out), l == 0 ? gp(KP.x_sample) : gp(KP.out) + (long)TP * DM}); }
        { const int G_ = ogrid(), rem_ = ((T / 256) * 8) % G_; const int b_ = obid();
          if (rem_ == 0) ph::peer_convert(KP, l, NEXP, 2 * NEXP, ph::gwave(), ph::nwaves());
          else if (b_ >= rem_) ph::peer_convert(KP, l, NEXP, 2 * NEXP, (b_ - rem_) * 8 + (otid() >> 6), (G_ - rem_) * 8); }
        GRID_SYNC(); STOPCHK(16);
        ph::modulate(KP, l, 1);
        GRID_SYNC(); STOPCHK(17);
        { Sched<0> S; S.init(T / 256, DM / 256, (T / 256) * 8, DM / 2, DM / 2);
          unsigned char* ws8 = optr(gp(KP.ws));
          gemm_phase<EpiQ8, Sched<0>, true>(lds, Gemm{(const bf16_t*)(ws8 + WS_H8), (const bf16_t*)(ws8 + WS_WPQ8 + (long)l * DM * DM), DM / 2, DM / 2, DM / 2}, S, EpiQ8{QP, DM, (const float*)(ws8 + WS_SA8), (const float*)(ws8 + WS_SB8) + (long)l * DM});
#ifdef DUP_WPQ
          gemm_phase<EpiQ8, Sched<0>, true>(lds, Gemm{(const bf16_t*)(ws8 + WS_H8), (const bf16_t*)(ws8 + WS_WPQ8 + (long)l * DM * DM), DM / 2, DM / 2, DM / 2}, S, EpiQ8{QP, DM, (const float*)(ws8 + WS_SA8), (const float*)(ws8 + WS_SB8) + (long)l * DM});
#endif
        }
        if (l + 1 < DEPTH) { const int G_ = ogrid(), rem_ = ((T / 256) * 8) % G_; const int b_ = obid();
          if (rem_ == 0) ph::cache_convert(KP, l + 1, ldsg, 0, 4096, b_, G_);
          else if (b_ >= rem_) ph::cache_convert(KP, l + 1, ldsg, 0, 4096, b_ - rem_, G_ - rem_); }
        GRID_SYNC(); STOPCHK(18);
        { const int tid_ = otid(); const int lane = tid_ & 63; float* strip = (float*)ldsg + tid_ * 33; unsigned char* ws = optr(gp(KP.ws));
          const bf16_t* k1g = (const bf16_t*)(ws + WS_PK1) + (long)l * 128 * 128; const bf16_t* k2g = (const bf16_t*)(ws + WS_PK2) + (long)l * 128 * 128;
          bf16_t* k1 = (bf16_t*)(ldsg + 512 * 33 * 4 + 64); bf16_t* k2 = k1 + 128 * peer::KPITCH;
          for (int i = tid_; i < 2 * 128 * 16; i += 512) { const int which = i >> 11, r = (i >> 4) & 127, ch = i & 15;
              *reinterpret_cast<u32x4*>((which ? k2 : k1) + r * peer::KPITCH + ch * 8) = *reinterpret_cast<const u32x4*>((which ? k2g : k1g) + r * 128 + ch * 8); }
          __syncthreads();
          for (int wu = ph::gwave(); wu < (T / 32) * PH; wu += ph::nwaves()) peer::select_unit(QP, k1, k2, (int*)(ws + WS_PIDX), (float*)(ws + WS_PW), (wu >> 3) * 32, wu & 7, lane, strip);
#ifdef DUP_SEL
          for (int wu = ph::gwave(); wu < (T / 32) * PH; wu += ph::nwaves()) peer::select_unit(QP, k1, k2, (int*)(ws + WS_PIDX), (float*)(ws + WS_PW), (wu >> 3) * 32, wu & 7, lane, strip);
#endif
        }
        GRID_SYNC(); STOPCHK(19);
        { const int tid_ = otid(); const int lane = tid_ & 63, wid = tid_ >> 6; unsigned char* ws = optr(gp(KP.ws));
          volatile LAS unsigned* iw = (volatile LAS unsigned*)(lds + LDS_BARW); peer::XInfo xin; xin.rank = __builtin_amdgcn_readfirstlane((int)iw[2]); xin.xi = __builtin_amdgcn_readfirstlane((int)iw[3]); xin.nx = __builtin_amdgcn_readfirstlane((int)iw[4]); xin.nloc = __builtin_amdgcn_readfirstlane((int)iw[5]);
          if (xin.nx >= 1 && xin.nx <= 8) {
              peer::upass((const unsigned char*)(ws + WS_H8), (const float*)(ws + WS_SA8), (const unsigned char*)(ws + WS_PU), (const int*)(ws + WS_PIDX), (const float*)(ws + WS_PW), (const float*)(ws + WS_PSU), (const float*)(ws + WS_PSV), (int*)(ws + WS_DOTP), (unsigned*)(ws + WS_ACT), xin, wid, lane);
              GRID_SYNC();
              int vs0_, vsn_, vse_;
              if ((256 % xin.nx) == 0) { const int spx = 256 / xin.nx; vs0_ = xin.xi * spx + xin.rank; vsn_ = xin.nloc; vse_ = (xin.xi + 1) * spx; }
              else { vs0_ = obid(); vsn_ = ogrid(); vse_ = 256; }
              peer::vpass_lds((const unsigned char*)(ws + WS_PV), (const unsigned*)(ws + WS_ACT), gp(KP.out), ADA + 5 * DM, ldsg, vs0_, vsn_, vse_, tid_);
#ifdef DUP_VP
              peer::vpass_lds((const unsigned char*)(ws + WS_PV), (const unsigned*)(ws + WS_ACT), (float*)(ws + WS_OB), ADA + 5 * DM, ldsg, vs0_, vsn_, vse_, tid_);
#endif
          } else {
              for (int t = ph::gwave(); t < T; t += ph::nwaves()) peer::gather_token(H, (const unsigned char*)(ws + WS_PU), (const unsigned char*)(ws + WS_PV), (const float*)(ws + WS_PSU), (const float*)(ws + WS_PSV), (const int*)(ws + WS_PIDX), (const float*)(ws + WS_PW), gp(KP.out), ADA + 5 * DM, t, lane);
          } }
        GRID_SYNC(); STOPCHK(20);
    }
    ph::final_norm(KP);
}

extern "C" void kernel_launch(void* const* d_in, const int* in_sizes, int n_in, void* d_out, int out_size, void* d_ws, size_t ws_size, hipStream_t stream) {
    static int grid = 0;
    if (grid == 0) {
        if (n_in != 25 || out_size != (int)O_END || ws_size < WS_END) { fprintf(stderr, "kernel_launch: shape mismatch: n_in %d out %d (want %ld) ws %zu (want >= %zu)\n", n_in, out_size, O_END, ws_size, (size_t)WS_END); grid = -1; return; }
        int dev = 0, cus = 0, per_cu = 0;
        if (hipGetDevice(&dev) != hipSuccess || hipDeviceGetAttribute(&cus, hipDeviceAttributeMultiprocessorCount, dev) != hipSuccess) { fprintf(stderr, "kernel_launch: device query failed\n"); grid = -1; return; }
        if (hipFuncSetAttribute((const void*)mega_fwd, hipFuncAttributeMaxDynamicSharedMemorySize, LDS_BYTES) != hipSuccess) { fprintf(stderr, "kernel_launch: hipFuncSetAttribute failed\n"); grid = -1; return; }
        if (hipOccupancyMaxActiveBlocksPerMultiprocessor(&per_cu, (const void*)mega_fwd, 512, LDS_BYTES) != hipSuccess || per_cu < 1) { fprintf(stderr, "kernel_launch: occupancy query says %d blocks per CU\n", per_cu); grid = -1; return; }
        grid = cus;
#ifdef FORCE_GRID
        grid = FORCE_GRID;
#endif
    }
    if (grid < 0) return;
    (void)hipMemsetAsync((char*)d_ws + WS_CTL, 0, CTL_BYTES, stream);
    Params p{};
    const float* const* in = (const float* const*)d_in;
    p.x_prompt = in[0]; p.x_sample = in[1]; p.c_prompt = in[2]; p.c_sample = in[3]; p.cache_ckv = in[4]; p.cache_krope = in[5]; p.state_ret = in[6]; p.w_ada = in[7]; p.b_ada = in[8];
    p.g_mix = in[9]; p.g_ffn = in[10]; p.w_in = in[11]; p.g_q = in[12]; p.w_uq = in[13]; p.g_kv = in[14]; p.w_ukv = in[15]; p.w_a = in[16]; p.w_b = in[17]; p.w_o = in[18]; p.w_pq = in[19];
    p.peer_k1 = in[20]; p.peer_k2 = in[21]; p.peer_u = in[22]; p.peer_v = in[23]; p.g_final = in[24];
    p.out = (float*)d_out; p.ws = (unsigned char*)d_ws;
    for (int h = 0; h < 8; ++h) p.lg[h] = (float)log1p(-pow(2.0, -5.0 - (double)h));
    p.grid = grid; p.pad_ = 0;
    hipLaunchKernelGGL(mega_fwd, dim3(grid), dim3(512), LDS_BYTES, stream, p);
    const hipError_t le = hipGetLastError();
    if (le != hipSuccess) fprintf(stderr, "kernel_launch: launch failed: %s\n", hipGetErrorName(le));
}
```

```cpp
#include <hip/hip_runtime.h>
#include <cstdio>
#include <cstdint>
#include <cmath>

#define LAS __attribute__((address_space(3)))
typedef unsigned short bf16_t;
typedef short bf16x8 __attribute__((ext_vector_type(8)));
typedef float f32x4 __attribute__((ext_vector_type(4)));
typedef float f32x2 __attribute__((ext_vector_type(2)));
typedef float f32x16 __attribute__((ext_vector_type(16)));
typedef unsigned u32x4 __attribute__((ext_vector_type(4)));
typedef unsigned u32x2 __attribute__((ext_vector_type(2)));
typedef short s16x4 __attribute__((ext_vector_type(4)));
typedef int i32x4 __attribute__((ext_vector_type(4)));

constexpr int DM = 2048, NB = 4, SEQ = 4096, DEPTH = 2, DB = 32, DS = 64, PAST = 2048;
constexpr int TP = NB * SEQ, TS = DB * DS, T = TP + TS;
constexpr int NCOND = NB + DB;
constexpr int QLORA = 512, KVLORA = 512, ROPE = 64, NOPE = 128, VD = 128, MH = 16, QKD = 192;
constexpr int RH = 8, RQK = 128, RV = 256;
constexpr int PH = 8, NKEYS = 128, NEXP = 16384, PTOPK = 16;
constexpr int INW = 11328, INWP = 11520;
constexpr int C_CQ = 0, C_CKV = 512, C_KR = 1024, C_RQ = 1088, C_RK = 2112, C_RV = 3136, C_RG = 5184, C_GA = 7232, C_GB = 9280;
constexpr int KALL = PAST + DS;
constexpr int KPAD = 2304;
constexpr int QLD = 640;
constexpr float EPS = 1e-6f;
constexpr float MLA_SCALE = 0.07216878364870322f;

constexpr long O_Y = 0;
constexpr long O_CKVP = (long)T * DM;
constexpr long O_KRP = O_CKVP + 2L * TP * 512;
constexpr long O_RETP = O_KRP + 2L * TP * 64;
constexpr long O_CKVS = O_RETP + 2L * NB * RH * RQK * RV;
constexpr long O_KRS = O_CKVS + 2L * TS * 512;
constexpr long O_RETS = O_KRS + 2L * TS * 64;
constexpr long O_END = O_RETS + 2L * DB * RH * RQK * RV;

constexpr size_t al256(size_t x) { return (x + 255) / 256 * 256; }
constexpr size_t WS_CTL = 0;
constexpr size_t CTL_BYTES = 65536 + 2UL * 32768 * 4;
constexpr size_t CTL_RSUM = 65536;
constexpr size_t WS_TAB64 = WS_CTL + CTL_BYTES;
constexpr size_t WS_TAB128 = WS_TAB64 + 4096UL * 32 * 2 * 4;
constexpr size_t WS_ADA = WS_TAB128 + 4096UL * 64 * 2 * 4;
constexpr size_t WS_ADAP = WS_ADA + 2UL * NCOND * 12288 * 4;
constexpr size_t WS_WIN = WS_ADAP + 8UL * 2 * NCOND * 12288 * 4;
constexpr size_t WS_WUQ = WS_WIN + 2UL * INWP * DM * 2;
constexpr size_t WS_WUKV = WS_WUQ + 2UL * 3072 * 512 * 2;
constexpr size_t WS_WUK = WS_WUKV + 2UL * 4096 * 512 * 2;
constexpr size_t WS_WA = WS_WUK + 2UL * 16 * 512 * 256 * 2;
constexpr size_t WS_WB = WS_WA + 2UL * DM * DM * 2;
constexpr size_t WS_WO = WS_WB + 2UL * DM * DM * 2;
constexpr size_t WS_WPQ = WS_WO + 2UL * DM * DM * 2;
constexpr size_t WS_PK1 = WS_WPQ + 2UL * DM * DM * 2;
constexpr size_t WS_PK2 = WS_PK1 + 2UL * 128 * 128 * 2;
constexpr size_t WS_H = WS_PK2 + 2UL * 128 * 128 * 2;
constexpr size_t WS_Y = WS_H + (size_t)T * DM * 2;
constexpr size_t WS_CQN = WS_Y + (size_t)T * INWP * 2;
constexpr size_t WS_CKVNP = WS_CQN + (size_t)T * 512 * 2;
constexpr size_t WS_KRP = WS_CKVNP + (size_t)TP * 512 * 2;
constexpr size_t WS_Q = WS_KRP + (size_t)TP * 64 * 2;
constexpr size_t WS_YA = WS_Q;
constexpr size_t WS_KV = WS_Q + (size_t)T * 3072 * 2 + 4096;
constexpr size_t WS_SP = WS_KV;
constexpr size_t WS_MIX = WS_KV;
constexpr size_t WS_OA = WS_KV + 32UL * 1024 * KPAD * 2;
constexpr size_t WS_QP = WS_OA;
constexpr size_t WS_CKA = WS_OA + (size_t)T * DM * 2;
constexpr size_t WS_CKT = WS_CKA + 32UL * KPAD * QLD * 2;
constexpr size_t WS_QL = WS_CKT + 32UL * 512 * KPAD * 2;
constexpr size_t WS_OL = WS_QL + 32UL * 1024 * QLD * 2;
constexpr size_t WS_OB = WS_OL + 16UL * 2048 * 512 * 2;
constexpr size_t WS_BG = WS_OB + (size_t)T * DM * 2;
constexpr size_t WS_PIDX = WS_BG + (size_t)T * DM * 2;
constexpr size_t WS_PW = WS_PIDX + (size_t)T * 128 * 4;
constexpr size_t WS_PU = WS_PW + (size_t)T * 128 * 4;
constexpr size_t WS_PV = WS_PU + (size_t)NEXP * DM;
constexpr size_t WS_PSU = WS_PV + (size_t)NEXP * DM;
constexpr size_t WS_PSV = WS_PSU + (size_t)NEXP * 4;
constexpr size_t WS_WPQ8 = WS_PSV + (size_t)NEXP * 4;
constexpr size_t WS_SB8 = WS_WPQ8 + 2UL * DM * DM;
constexpr size_t WS_SA8 = WS_SB8 + 2UL * DM * 4;
constexpr int NB8 = 38;
constexpr size_t WS_WIN8 = WS_BG + (size_t)T * DM;
constexpr size_t WS_WB8 = WS_WIN8 + (size_t)NB8 * 256 * DM;
constexpr size_t WS_WUQ8 = WS_WB8 + (size_t)DM * DM;
constexpr size_t WS_WUKV8 = WS_WUQ8 + 3072UL * 512;
constexpr size_t WS_WA8 = WS_WUKV8 + 4096UL * 512;
constexpr size_t WS_WO8 = WS_WA8 + (size_t)DM * DM;
static_assert(WS_WO8 + (size_t)DM * DM <= WS_BG + (size_t)T * DM * 2, "int8 weights overflow the BG region");
constexpr size_t WS_OA8 = WS_Q + (size_t)T * DM * 2;
constexpr size_t WS_MIX8 = WS_KV + (size_t)T * DM * 2;
static_assert(WS_OA8 + (size_t)T * DM <= WS_KV && WS_MIX8 + (size_t)T * DM <= WS_KV + (size_t)TP * 4096 * 2, "int8 activation copies fit");
constexpr size_t WS_SBW = WS_SA8 + al256((size_t)T * 4);
constexpr size_t WS_SBB = WS_SBW + al256((size_t)INWP * 4);
constexpr size_t WS_SBQ = WS_SBB + (size_t)DM * 4;
constexpr size_t WS_SBK = WS_SBQ + 3072UL * 4;
constexpr size_t WS_SAQ = WS_SBK + 4096UL * 4;
constexpr size_t WS_SAK = WS_SAQ + al256((size_t)T * 4);
constexpr size_t WS_SBA = WS_SAK + al256((size_t)TP * 4);
constexpr size_t WS_SBO = WS_SBA + (size_t)DM * 4;
constexpr size_t WS_SAO = WS_SBO + (size_t)DM * 4;
constexpr size_t WS_END = WS_SAO + al256((size_t)T * 4);
constexpr size_t WS_H8 = WS_OB;
static_assert((size_t)TP * 4096 * 2 <= 32UL * 1024 * KPAD * 2, "KV fits in the SP region");
static_assert(WS_END <= 1608000000UL, "workspace map too large");
static_assert(WS_WIN % 256 == 0 && WS_H % 256 == 0 && WS_Y % 256 == 0 && WS_Q % 256 == 0 && WS_KV % 256 == 0 && WS_CKA % 256 == 0, "alignment");

constexpr int LDS_BYTES = 147456;
constexpr int LDS_BARW = LDS_BYTES - 32;
constexpr size_t CTL_RANK = 16384;
constexpr size_t WS_DOTP = WS_Q;
constexpr size_t WS_ACT = WS_DOTP + 8UL * T * 128 * 4;
constexpr size_t WS_PIDXT = WS_ACT + (size_t)T * 128 * 4;
static_assert(WS_PIDXT + (size_t)T * 128 * 4 <= WS_KV, "PEER scratch fits in the Q region");

struct Params {
    const float *x_prompt, *x_sample, *c_prompt, *c_sample, *cache_ckv, *cache_krope, *state_ret, *w_ada, *b_ada, *g_mix, *g_ffn, *w_in, *g_q, *w_uq, *g_kv, *w_ukv,
                *w_a, *w_b, *w_o, *w_pq, *peer_k1, *peer_k2, *peer_u, *peer_v, *g_final;
    float* out; unsigned char* ws;
    float lg[8];
    int grid; int pad_;
};

typedef const __attribute__((address_space(4))) Params KParams;
__device__ __forceinline__ KParams* okarg() {
    const uintptr_t k = (uintptr_t)__builtin_amdgcn_kernarg_segment_ptr();
    unsigned lo = (unsigned)k, hi = (unsigned)(k >> 32);
    asm volatile("" : "+s"(lo), "+s"(hi)); return (KParams*)(((uintptr_t)hi << 32) | lo); }
#define KP (*okarg())
__device__ __forceinline__ int ogrid() { return KP.grid; }
__device__ __forceinline__ int obid() { int b = (int)blockIdx.x; asm volatile("" : "+s"(b) :: "memory"); return b; }
__device__ __forceinline__ int otid() { int t = (int)threadIdx.x; asm volatile("" : "+v"(t) :: "memory"); return t; }
template <class P> __device__ __forceinline__ P* gp(P* p) { return (P*)(__attribute__((address_space(1))) P*)(uintptr_t)p; }
template <class P> __device__ __forceinline__ P* optr(P* p) {
    unsigned lo = __builtin_amdgcn_readfirstlane((unsigned)(uintptr_t)p), hi = __builtin_amdgcn_readfirstlane((unsigned)((uintptr_t)p >> 32));
    asm volatile("" : "+s"(lo), "+s"(hi)); return gp((P*)(((uintptr_t)hi << 32) | lo)); }
typedef __bf16 bf16v2_t __attribute__((ext_vector_type(2)));
__device__ __forceinline__ unsigned cvt_pk_bf16(float lo, float hi) { f32x2 v = {lo, hi}; bf16v2_t r = __builtin_convertvector(v, bf16v2_t); return __builtin_bit_cast(unsigned, r); }
__device__ __forceinline__ bf16_t f2bf(float f) { return (bf16_t)(cvt_pk_bf16(f, 0.f) & 0xffffu); }
__device__ __forceinline__ float bf2f(bf16_t b) { return __uint_as_float(((unsigned)b) << 16); }
__device__ __forceinline__ float bflo(unsigned w) { return __uint_as_float(w << 16); }
__device__ __forceinline__ float bfhi(unsigned w) { return __uint_as_float(w & 0xffff0000u); }
__device__ __forceinline__ void unpack8(const u32x4 w, float (&f)[8]) { f[0] = bflo(w.x); f[1] = bfhi(w.x); f[2] = bflo(w.y); f[3] = bfhi(w.y); f[4] = bflo(w.z); f[5] = bfhi(w.z); f[6] = bflo(w.w); f[7] = bfhi(w.w); }
__device__ __forceinline__ u32x4 pack8(const float (&f)[8]) { u32x4 w; w.x = cvt_pk_bf16(f[0], f[1]); w.y = cvt_pk_bf16(f[2], f[3]); w.z = cvt_pk_bf16(f[4], f[5]); w.w = cvt_pk_bf16(f[6], f[7]); return w; }
template <int K> __device__ __forceinline__ float sx(float v) {
    if constexpr (K == 32) { const auto rr = __builtin_amdgcn_permlane32_swap(__float_as_uint(v), __float_as_uint(v), false, false); return __uint_as_float((otid() & 32) ? rr[0] : rr[1]); }
    else return __int_as_float(__builtin_amdgcn_ds_swizzle(__float_as_int(v), (K << 10) | 0x1F));
}
__device__ __forceinline__ float wave_sum(float v) { v += sx<32>(v); v += sx<16>(v); v += sx<8>(v); v += sx<4>(v); v += sx<2>(v); v += sx<1>(v); return v; }
__device__ __forceinline__ float wave_max(float v) { v = fmaxf(v, sx<32>(v)); v = fmaxf(v, sx<16>(v)); v = fmaxf(v, sx<8>(v)); v = fmaxf(v, sx<4>(v)); v = fmaxf(v, sx<2>(v)); v = fmaxf(v, sx<1>(v)); return v; }
__device__ __forceinline__ float sigmoidf_(float x) { return 1.0f / (1.0f + __expf(-x)); }
__device__ __forceinline__ float siluf_(float x) { return x / (1.0f + __expf(-x)); }
__device__ __forceinline__ int cond_row(int t) { return t < TP ? (t >> 12) : NB + ((t - TP) >> 6); }
__device__ __forceinline__ int tok_pos(int t) { return t < TP ? (t & 4095) : PAST + ((t - TP) & 63); }

#define XB_TMO      128
#define XB_XCNT(j)  (256  + 64 * (j))
#define XB_XSUB(j)  (1280 + 64 * (j))
#define XB_XGEN(j)  (2304 + 64 * (j))
#define XB_TOP      3328
#define XB_TOPGEN   3392
#define XCD_BAR_WORDS 3456
#define XB_SPIN_CAP (1u << 22)
__device__ __forceinline__ unsigned xb_ld(unsigned* p)              { return __hip_atomic_load(p, __ATOMIC_RELAXED, __HIP_MEMORY_SCOPE_AGENT); }
__device__ __forceinline__ unsigned xb_add(unsigned* p, unsigned v) { return __hip_atomic_fetch_add(p, v, __ATOMIC_RELAXED, __HIP_MEMORY_SCOPE_AGENT); }
__device__ __forceinline__ unsigned xb_xcc_id() { return (unsigned)__builtin_amdgcn_s_getreg((3 << 11) | 20) & 0xFu; }
#define XB_SPIN(cond, bar) do { unsigned _sp = 0; while (cond) { __builtin_amdgcn_s_sleep(1); \
    if ((++_sp & 255u) == 0u) { if (xb_ld(&(bar)[XB_TMO])) break; if (_sp > XB_SPIN_CAP) { atomicAdd(&(bar)[XB_TMO], 1u); break; } } } } while (0)
struct XcdBarrier { unsigned* bar; unsigned x; volatile LAS unsigned* st; };
__device__ __forceinline__ XcdBarrier xcd_barrier_post(unsigned* bar, volatile LAS unsigned* st) {
    XcdBarrier b; b.bar = bar; b.x = xb_xcc_id(); b.st = st;
    if (threadIdx.x == 0) (void)xb_add(&bar[XB_XCNT(b.x)], 1u);
    return b;
}
__device__ __forceinline__ void xcd_barrier_complete(unsigned* bar, unsigned x, unsigned& nloc, unsigned& nx) {
    const unsigned G = (unsigned)KP.grid;
    unsigned sum, cnt, mine, sp = 0u;
    for (;;) {
        sum = 0u; cnt = 0u; mine = 0u;
#pragma unroll
        for (unsigned j = 0; j < 16; ++j) { const unsigned c = xb_ld(&bar[XB_XCNT(j)]); sum += c; cnt += (c > 0u) ? 1u : 0u; mine = (j == x) ? c : mine; }
        if (sum == G) break;
        __builtin_amdgcn_s_sleep(1);
        if ((++sp & 255u) == 0u) { if (xb_ld(&bar[XB_TMO])) break; if (sp > XB_SPIN_CAP) { atomicAdd(&bar[XB_TMO], 1u); break; } }
    }
    nloc = mine > 0u ? mine : 1u; nx = cnt > 0u ? cnt : 1u;
}
__device__ __forceinline__ void xcd_barrier(const XcdBarrier& b) {
    asm volatile("s_waitcnt vmcnt(0)" ::: "memory");
    __syncthreads();
    if (otid() == 0) {
        unsigned* bar = (unsigned*)(gp(KP.ws) + WS_CTL);
        unsigned bx = xb_xcc_id(); asm volatile("" : "+s"(bx));
        __builtin_amdgcn_s_waitcnt(0);
        unsigned nloc = b.st[0], nx = b.st[1];
        if (nloc == 0u) { xcd_barrier_complete(bar, bx, nloc, nx); b.st[0] = nloc; b.st[1] = nx; }
        const unsigned old = xb_add(&bar[XB_XSUB(bx)], 1u);
        const unsigned gen = old / nloc;
        if (old + 1u == (gen + 1u) * nloc) {
            __builtin_amdgcn_fence(__ATOMIC_RELEASE, "agent");
            asm volatile("s_waitcnt vmcnt(0)" ::: "memory");
            const unsigned og = xb_add(&bar[XB_TOP], 1u);
            const unsigned tg = og / nx;
            if (og + 1u == (tg + 1u) * nx) xb_add(&bar[XB_TOPGEN], 1u);
            else XB_SPIN(xb_ld(&bar[XB_TOPGEN]) == tg, bar);
            __builtin_amdgcn_fence(__ATOMIC_ACQUIRE, "agent");
            xb_add(&bar[XB_XGEN(bx)], 1u);
            asm volatile("s_waitcnt vmcnt(0)" ::: "memory");
        } else {
            XB_SPIN(xb_ld(&bar[XB_XGEN(bx)]) == gen, bar);
            __builtin_amdgcn_fence(__ATOMIC_ACQUIRE, "agent");
            asm volatile("s_waitcnt vmcnt(0)" ::: "memory");
        }
    }
    __syncthreads();
}
namespace pg8 {
constexpr int BM = 256, BK = 64, HALF = 128, HTB = HALF * BK * 2, STAGE_BYTES = 8 * HTB, NXCD = 8, WGM = 8;
__host__ __device__ __forceinline__ int lds_byte(int r, int c) { const int st = (r >> 4) * 2 + (c >> 5), rr = r & 15, cc = c & 31, ob = rr * 64 + cc * 2; return st * 1024 + (ob ^ (((ob >> 9) & 1) << 5)); }
__host__ __device__ __forceinline__ void stage_rc(int b, int& R, int& C) { const int st = b / 1024, sb = b % 1024, swz = sb ^ (((sb >> 9) & 1) << 5); R = (st >> 1) * 16 + swz / 64; C = (st & 1) * 32 + (swz % 64) / 2; }
__host__ __device__ __forceinline__ int perm32(int rho) { const int n = rho >> 4, i = rho & 15; return 8 * (i >> 2) + 4 * n + (i & 3); }

struct Unit { int pm, pn; long aoff, boff; int x0, x1; };
struct Gemm { const bf16_t* A; const bf16_t* Bt; int K; int lda, ldb; const float* sa; const float* sb; };

template <int MODE> struct Sched {
    int nM, nN, nwg, G, c; long lda, ldb;
    __device__ void init(int nM_, int nN_, int nwg_, long lda_, long ldb_) { nM = nM_; nN = nN_; nwg = nwg_; G = ogrid(); c = obid(); lda = lda_; ldb = ldb_; }
    __device__ void rotate(int r) { c = (c + r) % G; }
    __device__ bool next(int i, Unit& u) const {
        const long L = (long)i * G + c; if (L >= nwg) return false;
        int wgid = (int)L;
        if (MODE == 0 || MODE == 5 || MODE == 6) {
            { const int q = nwg / NXCD, r = nwg % NXCD, xcd = wgid % NXCD, off = wgid / NXCD; wgid = (xcd < r ? xcd * (q + 1) : r * (q + 1) + (xcd - r) * q) + off; }
            const int nig = WGM * nN, gid = wgid / nig, fm = gid * WGM, gsz = (nM - fm) < WGM ? (nM - fm) : WGM;
            u.pm = fm + ((wgid % nig) % gsz); u.pn = (wgid % nig) / gsz; u.x0 = 0; u.x1 = 0;
            { const int pl = u.pn;
              if (MODE == 5) u.pn = pl < 3 ? pl + 2 : pl + 5;
              if (MODE == 6) u.pn = pl < 2 ? pl : (pl < 5 ? pl + 3 : pl + 7);
              u.aoff = (long)u.pm * 256 * lda * 2; u.boff = (long)(MODE == 6 ? pl : u.pn) * 256 * ldb * 2; }
        } else if (MODE == 1) {
            const int h = wgid >> 4, rem = wgid & 15, rt = rem >> 1, pn = rem & 1;
            u.pm = rt; u.pn = pn; u.x0 = h; u.x1 = rt;
            u.aoff = ((long)(TP + 256 * rt) * 3072 + h * 192) * 2; u.boff = ((long)(h * 512 + 256 * pn) * 256) * 2;
        } else if (MODE == 2) {
            const int b = wgid / 36, rem = wgid % 36, pm = rem / 9, pn = rem % 9;
            u.pm = pm; u.pn = pn; u.x0 = b; u.x1 = 0;
            u.aoff = ((long)(b * 1024 + 256 * pm) * QLD) * 2; u.boff = ((long)(b * KPAD + 256 * pn) * QLD) * 2;
        } else if (MODE == 3) {
            const int b = wgid >> 3, pm = (wgid & 7) >> 1, pn = wgid & 1;
            u.pm = pm; u.pn = pn; u.x0 = b; u.x1 = 0;
            u.aoff = ((long)(b * 1024 + 256 * pm) * KPAD) * 2; u.boff = ((long)(b * 512 + 256 * pn) * KPAD) * 2;
        } else {
            const int h = wgid >> 3, rt = wgid & 7;
            u.pm = rt; u.pn = 0; u.x0 = h; u.x1 = rt;
            u.aoff = ((long)(h * 2048 + 256 * rt) * 512) * 2; u.boff = ((long)(h * 256) * 512) * 2;
        }
        return true;
    }
};

template <class Epi, class SchedT, int I8 = 0>
__device__ __forceinline__ void gemm_phase(LAS unsigned char* lds, const Gemm g, const SchedT& S, const Epi& E) {
    const int tid = otid(), wid = __builtin_amdgcn_readfirstlane(tid >> 6), lane = tid & 63, wr = wid >> 2, wc = wid & 3, fr = lane & 15, fq = lane >> 4;
    const int K = g.K, nt = K / BK;
    unsigned voffA[2], voffB[2];
#pragma unroll
    for (int i = 0; i < 2; ++i) { int R, C; stage_rc(tid * 16 + i * 8192, R, C); const int Rb = Epi::PERM ? ((R & ~31) + perm32(R & 31)) : R;
        voffA[i] = (unsigned)(R * g.lda + C) * 2u; voffB[i] = (unsigned)(Rb * g.ldb + C) * 2u; }
    const size_t kstep = (size_t)(BK * 2);
    const size_t hstepA = (size_t)HALF * g.lda * 2, hstepB = (size_t)HALF * g.ldb * 2;
    const unsigned ldsw = (unsigned)wid * 1024u;
    const int aoff = lds_byte(wr * 64 + fr, fq * 8), boff = lds_byte(wc * 32 + fr, fq * 8);
#define PG8_SA(b, h) (((b) * 2 + (h)) * HTB)
#define PG8_SB(b, h) ((4 + (b) * 2 + (h)) * HTB)
#define PG8_STAGE(bufoff, gbase, voff) do { _Pragma("unroll") for (int _i = 0; _i < 2; ++_i) \
        __builtin_amdgcn_global_load_lds((const unsigned*)((const char*)(gbase) + (voff)[_i]), (LAS unsigned*)(lds + (bufoff) + ldsw + _i * 8192), 16, 0, 0); } while (0)
#define PG8_LDA(dst, b, h) do { _Pragma("unroll") for (int m = 0; m < 4; ++m) _Pragma("unroll") for (int k = 0; k < 2; ++k) dst[m][k] = *(const LAS bf16x8*)(lds + PG8_SA(b, h) + aoff + m * 2048 + k * 1024); } while (0)
#define PG8_LDB(dst, b, h) do { _Pragma("unroll") for (int n = 0; n < 2; ++n) _Pragma("unroll") for (int k = 0; k < 2; ++k) dst[n][k] = *(const LAS bf16x8*)(lds + PG8_SB(b, h) + boff + n * 2048 + k * 1024); } while (0)
#define PG8_MMA(ai, bj, At, Bt) do { __builtin_amdgcn_s_setprio(1); _Pragma("unroll") for (int m = 0; m < 4; ++m) _Pragma("unroll") for (int n = 0; n < 2; ++n) _Pragma("unroll") for (int k = 0; k < 2; ++k) \
        { if constexpr (I8) acc[ai][bj][m][n] = __builtin_bit_cast(f32x4, __builtin_amdgcn_mfma_i32_16x16x64_i8(__builtin_bit_cast(i32x4, Bt[n][k]), __builtin_bit_cast(i32x4, At[m][k]), __builtin_bit_cast(i32x4, acc[ai][bj][m][n]), 0, 0, 0)); \
          else acc[ai][bj][m][n] = __builtin_amdgcn_mfma_f32_16x16x32_bf16(Bt[n][k], At[m][k], acc[ai][bj][m][n], 0, 0, 0); } __builtin_amdgcn_s_setprio(0); } while (0)
#define PG8_WAIT_V(n) asm volatile("s_waitcnt vmcnt(" #n ")" ::: "memory")
#define PG8_WAIT_L(n) asm volatile("s_waitcnt lgkmcnt(" #n ")" ::: "memory")
#define PG8_BAR __builtin_amdgcn_s_barrier()
#define PG8_SCHED __builtin_amdgcn_sched_barrier(0)
    Unit cur, nxt; int ui = 0;
    if (!S.next(0, cur)) return;
    f32x4 acc[2][2][4][2];
#pragma unroll
    for (int a = 0; a < 2; ++a)
#pragma unroll
        for (int b = 0; b < 2; ++b)
#pragma unroll
            for (int m = 0; m < 4; ++m)
#pragma unroll
                for (int n = 0; n < 2; ++n) acc[a][b][m][n] = (f32x4){0.f, 0.f, 0.f, 0.f};
    bf16x8 At[4][2], B0[2][2], B1[2][2];
    const char* cA = (const char*)g.A + cur.aoff; const char* cB = (const char*)g.Bt + cur.boff;
    PG8_STAGE(PG8_SB(0, 0), cB, voffB); PG8_STAGE(PG8_SA(0, 0), cA, voffA); PG8_STAGE(PG8_SB(0, 1), cB + hstepB, voffB); PG8_STAGE(PG8_SA(0, 1), cA + hstepA, voffA);
    if (wr == 1) PG8_BAR;
    PG8_WAIT_V(4); PG8_BAR;
    PG8_STAGE(PG8_SB(1, 0), cB + kstep, voffB); PG8_STAGE(PG8_SA(1, 0), cA + kstep, voffA); PG8_STAGE(PG8_SB(1, 1), cB + hstepB + kstep, voffB);
    PG8_WAIT_V(6); PG8_BAR;
    for (;;) {
        const bool has_next = S.next(ui + 1, nxt);
        const char* nA = has_next ? (const char*)g.A + nxt.aoff : cA; const char* nB = has_next ? (const char*)g.Bt + nxt.boff : cB;
        for (int t = 0; t < nt; t += 2) {
            const bool last = (t == nt - 2);
            const char* a1 = cA + (size_t)(t + 1) * kstep;
            const char* a2 = last ? nA : cA + (size_t)(t + 2) * kstep; const char* b2 = last ? nB : cB + (size_t)(t + 2) * kstep;
            const char* a3 = a2 + kstep; const char* b3 = b2 + kstep;
            PG8_LDB(B0, 0, 0); PG8_SCHED; PG8_LDA(At, 0, 0); PG8_STAGE(PG8_SA(1, 1), a1 + hstepA, voffA);
            PG8_WAIT_L(8); PG8_BAR; PG8_WAIT_L(0); PG8_MMA(0, 0, At, B0); PG8_BAR; PG8_SCHED;
            PG8_LDB(B1, 0, 1); PG8_STAGE(PG8_SB(0, 0), b2, voffB);
            PG8_BAR; PG8_WAIT_L(0); PG8_MMA(0, 1, At, B1); PG8_BAR;
            PG8_LDA(At, 0, 1); PG8_STAGE(PG8_SA(0, 0), a2, voffA);
            PG8_BAR; PG8_WAIT_L(0); PG8_MMA(1, 0, At, B0); PG8_BAR; PG8_SCHED;
            PG8_STAGE(PG8_SB(0, 1), b2 + hstepB, voffB);
            PG8_WAIT_V(6); PG8_BAR; PG8_MMA(1, 1, At, B1); PG8_BAR;
            PG8_LDB(B0, 1, 0); PG8_SCHED; PG8_LDA(At, 1, 0); PG8_STAGE(PG8_SA(0, 1), a2 + hstepA, voffA);
            PG8_WAIT_L(8); PG8_BAR; PG8_WAIT_L(0); PG8_MMA(0, 0, At, B0); PG8_BAR; PG8_SCHED;
            PG8_LDB(B1, 1, 1); PG8_STAGE(PG8_SB(1, 0), b3, voffB);
            PG8_BAR; PG8_WAIT_L(0); PG8_MMA(0, 1, At, B1); PG8_BAR;
            PG8_LDA(At, 1, 1); PG8_STAGE(PG8_SA(1, 0), a3, voffA);
            PG8_BAR; PG8_WAIT_L(0); PG8_MMA(1, 0, At, B0); PG8_BAR; PG8_SCHED;
            PG8_STAGE(PG8_SB(1, 1), b3 + hstepB, voffB);
            PG8_WAIT_V(6); PG8_BAR; PG8_MMA(1, 1, At, B1); PG8_BAR;
        }
        if constexpr (I8) {
#pragma unroll
            for (int a = 0; a < 2; ++a)
#pragma unroll
                for (int b = 0; b < 2; ++b)
#pragma unroll
                    for (int m = 0; m < 4; ++m)
#pragma unroll
                        for (int n = 0; n < 2; ++n) { const i32x4 iv = __builtin_bit_cast(i32x4, acc[a][b][m][n]); acc[a][b][m][n] = (f32x4){(float)iv[0], (float)iv[1], (float)iv[2], (float)iv[3]}; } }
        if constexpr (I8 == 2) {
            f32x4 sbv[2][2];
#pragma unroll
            for (int b = 0; b < 2; ++b) { const int c = cur.pn * BM + b * HALF + wc * 32 + (Epi::PERM ? 8 * fq : 4 * fq); sbv[b][0] = *(const f32x4*)(g.sb + c); sbv[b][1] = *(const f32x4*)(g.sb + c + (Epi::PERM ? 4 : 16)); }
#pragma unroll
            for (int a = 0; a < 2; ++a)
#pragma unroll
                for (int m = 0; m < 4; ++m) { const float s_ = g.sa[(long)cur.pm * BM + a * HALF + wr * 64 + m * 16 + fr];
#pragma unroll
                    for (int b = 0; b < 2; ++b) { acc[a][b][m][0] = acc[a][b][m][0] * sbv[b][0] * s_; acc[a][b][m][1] = acc[a][b][m][1] * sbv[b][1] * s_; } } }
        E(acc, cur, wr, wc, fr, fq);
        if (!has_next) break;
#pragma unroll
        for (int a = 0; a < 2; ++a)
#pragma unroll
            for (int b = 0; b < 2; ++b)
#pragma unroll
                for (int m = 0; m < 4; ++m)
#pragma unroll
                    for (int n = 0; n < 2; ++n) acc[a][b][m][n] = (f32x4){0.f, 0.f, 0.f, 0.f};
        cur = nxt; cA = nA; cB = nB; ++ui;
    }
    PG8_WAIT_V(0);
    if (wr == 0) PG8_BAR;
    PG8_BAR;
#undef PG8_SA
#undef PG8_SB
#undef PG8_STAGE
#undef PG8_LDA
#undef PG8_LDB
#undef PG8_MMA
#undef PG8_WAIT_V
#undef PG8_WAIT_L
#undef PG8_BAR
#undef PG8_SCHED
}

struct EpiBf16 {
    static constexpr bool PERM = true;
    bf16_t* O; long ldc; long bstride;
    __device__ __forceinline__ void operator()(const f32x4 (&acc)[2][2][4][2], const Unit& u, int wr, int wc, int fr, int fq) const {
        bf16_t* base = O + (long)u.x0 * bstride + (long)(u.pm * BM + wr * 64 + fr) * ldc + u.pn * BM + wc * 32 + 8 * fq;
#pragma unroll
        for (int ai = 0; ai < 2; ++ai)
#pragma unroll
            for (int m = 0; m < 4; ++m) { bf16_t* rowp = base + (long)(ai * HALF + m * 16) * ldc;
#pragma unroll
                for (int bj = 0; bj < 2; ++bj) { const f32x4 v0 = acc[ai][bj][m][0], v1 = acc[ai][bj][m][1];
                    u32x4 w; w.x = cvt_pk_bf16(v0[0], v0[1]); w.y = cvt_pk_bf16(v0[2], v0[3]); w.z = cvt_pk_bf16(v1[0], v1[1]); w.w = cvt_pk_bf16(v1[2], v1[3]);
                    *(u32x4*)(rowp + bj * HALF) = w; } }
    }
};
template <int RMODE> struct EpiRowMap {
    static constexpr bool PERM = true;
    bf16_t* O; const float* rsum;
    __device__ __forceinline__ void operator()(const f32x4 (&acc)[2][2][4][2], const Unit& u, int wr, int wc, int fr, int fq) const {
        const int col0 = u.pn * BM + wc * 32 + 8 * fq;
#pragma unroll
        for (int ai = 0; ai < 2; ++ai)
#pragma unroll
            for (int m = 0; m < 4; ++m) { const int r = ai * HALF + wr * 64 + m * 16 + fr; long drow; long ldc;
                if (RMODE == 1) { const int ts = 256 * u.x1 + r; drow = (long)(ts >> 6) * 1024 + u.x0 * 64 + (ts & 63); ldc = QLD; }
                float rs = 1.0f;
                if (RMODE == 1) { }
                else { const int qr = 256 * u.pm + r; drow = (long)(qr >> 6) * 2048 + u.x0 * 64 + (qr & 63); ldc = 512; rs = 1.0f / rsum[u.x0 * 1024 + qr]; }
                bf16_t* rowp = O + drow * ldc + col0;
#pragma unroll
                for (int bj = 0; bj < 2; ++bj) { const f32x4 v0 = acc[ai][bj][m][0] * rs, v1 = acc[ai][bj][m][1] * rs;
                    u32x4 w; w.x = cvt_pk_bf16(v0[0], v0[1]); w.y = cvt_pk_bf16(v0[2], v0[3]); w.z = cvt_pk_bf16(v1[0], v1[1]); w.w = cvt_pk_bf16(v1[2], v1[3]);
                    *(u32x4*)(rowp + bj * HALF) = w; } }
    }
};
struct EpiOV {
    static constexpr bool PERM = true;
    bf16_t* O;
    __device__ __forceinline__ void operator()(const f32x4 (&acc)[2][2][4][2], const Unit& u, int wr, int wc, int fr, int fq) const {
#pragma unroll
        for (int ai = 0; ai < 2; ++ai)
#pragma unroll
            for (int m = 0; m < 4; ++m) { const int r = ai * HALF + wr * 64 + m * 16 + fr;
                bf16_t* rowp = O + (long)(TP + 256 * u.x1 + r) * DM + u.x0 * 128 + wc * 32 + 8 * fq;
                const f32x4 v0 = acc[ai][1][m][0], v1 = acc[ai][1][m][1];
                u32x4 w; w.x = cvt_pk_bf16(v0[0], v0[1]); w.y = cvt_pk_bf16(v0[2], v0[3]); w.z = cvt_pk_bf16(v1[0], v1[1]); w.w = cvt_pk_bf16(v1[2], v1[3]);
                *(u32x4*)rowp = w; }
    }
};
struct EpiMix {
    static constexpr bool PERM = true;
    const bf16_t* Y; const bf16_t* YA; bf16_t* MIX; const float* sa; const float* sb;
    __device__ __forceinline__ void operator()(const f32x4 (&acc)[2][2][4][2], const Unit& u, int wr, int wc, int fr, int fq) const {
#pragma unroll
        for (int ai = 0; ai < 2; ++ai)
#pragma unroll
            for (int m = 0; m < 4; ++m) { const long t = (long)u.pm * BM + ai * HALF + wr * 64 + m * 16 + fr; const float s_ = sa[t];
#pragma unroll
                for (int bj = 0; bj < 2; ++bj) { const int c = u.pn * BM + bj * HALF + wc * 32 + 8 * fq;
                    const u32x4 ga = *(const u32x4*)(Y + t * INWP + C_GA + c), gb = *(const u32x4*)(Y + t * INWP + C_GB + c), ya = *(const u32x4*)(YA + t * DM + c);
                    float fa[8], fb[8], fy[8], o[8]; unpack8(ga, fa); unpack8(gb, fb); unpack8(ya, fy);
                    const f32x4 v0 = acc[ai][bj][m][0] * *(const f32x4*)(sb + c) * s_, v1 = acc[ai][bj][m][1] * *(const f32x4*)(sb + c + 4) * s_;
                    const float av[8] = {v0[0], v0[1], v0[2], v0[3], v1[0], v1[1], v1[2], v1[3]};
#pragma unroll
                    for (int j = 0; j < 8; ++j) {
#if defined(DBG_MIX) && DBG_MIX == 1
                        o[j] = sigmoidf_(fb[j]) * av[j];
#elif defined(DBG_MIX) && DBG_MIX == 2
                        o[j] = sigmoidf_(fa[j]) * fy[j];
#else
                        o[j] = sigmoidf_(fa[j]) * fy[j] + sigmoidf_(fb[j]) * av[j];
#endif
                    }
                    *(u32x4*)(MIX + t * DM + c) = pack8(o); } }
    }
};
struct EpiRes {
    static constexpr bool PERM = false;
    float* X; const float* gate;
    const float* XinP; const float* XinS;
    __device__ __forceinline__ void operator()(const f32x4 (&acc)[2][2][4][2], const Unit& u, int wr, int wc, int fr, int fq) const {
#pragma unroll
        for (int ai = 0; ai < 2; ++ai)
#pragma unroll
            for (int m = 0; m < 4; ++m) { const int t = u.pm * BM + ai * HALF + wr * 64 + m * 16 + fr; const float* gr = gate + (long)cond_row(t) * 12288; float* xr = X + (long)t * DM; const float* xi = t < TP ? XinP + (long)t * DM : XinS + (long)(t - TP) * DM;
#pragma unroll
                for (int bj = 0; bj < 2; ++bj)
#pragma unroll
                    for (int n = 0; n < 2; ++n) { const int c = u.pn * BM + bj * HALF + wc * 32 + n * 16 + 4 * fq;
                        const f32x4 gv = *(const f32x4*)(gr + c); const f32x4 xv = *(const f32x4*)(xi + c);
                        *(f32x4*)(xr + c) = xv + gv * acc[ai][bj][m][n]; } }
    }
};

struct EpiQ {
    static constexpr bool PERM = true;
    bf16_t* Q; bf16_t* QL; const float* T64;
    __device__ __forceinline__ void operator()(const f32x4 (&acc)[2][2][4][2], const Unit& u, int wr, int wc, int fr, int fq) const {
        const int grp = u.pn / 3, typ = u.pn - 3 * grp;
        if (typ < 2) {
#pragma unroll
            for (int ai = 0; ai < 2; ++ai)
#pragma unroll
                for (int m = 0; m < 4; ++m) { const long t = (long)u.pm * BM + ai * HALF + wr * 64 + m * 16 + fr;
#pragma unroll
                    for (int bj = 0; bj < 2; ++bj) { const f32x4 v0 = acc[ai][bj][m][0], v1 = acc[ai][bj][m][1];
                        u32x4 w; w.x = cvt_pk_bf16(v0[0], v0[1]); w.y = cvt_pk_bf16(v0[2], v0[3]); w.z = cvt_pk_bf16(v1[0], v1[1]); w.w = cvt_pk_bf16(v1[2], v1[3]);
                        *(u32x4*)(Q + t * 3072 + 768 * grp + 192 * (2 * typ + bj) + wc * 32 + 8 * fq) = w; } }
        } else {
#pragma unroll
            for (int ai = 0; ai < 2; ++ai)
#pragma unroll
                for (int m = 0; m < 4; ++m) { const int t = u.pm * BM + ai * HALF + wr * 64 + m * 16 + fr; const int pos = tok_pos(t);
                    const float* cs = T64 + ((long)pos * 32 + 8 * fq) * 2; float cv[8], sv[8];
#pragma unroll
                    for (int j = 0; j < 4; ++j) { const f32x4 qv = *(const f32x4*)(cs + 4 * j); cv[2 * j] = qv[0]; sv[2 * j] = qv[1]; cv[2 * j + 1] = qv[2]; sv[2 * j + 1] = qv[3]; }
                    const f32x4 a0 = acc[ai][0][m][0], a1 = acc[ai][0][m][1], b0 = acc[ai][1][m][0], b1 = acc[ai][1][m][1];
                    const float x1[8] = {a0[0], a0[1], a0[2], a0[3], a1[0], a1[1], a1[2], a1[3]}, x2[8] = {b0[0], b0[1], b0[2], b0[3], b1[0], b1[1], b1[2], b1[3]};
                    float o1[8], o2[8];
#pragma unroll
                    for (int j = 0; j < 8; ++j) { o1[j] = x1[j] * cv[j] - x2[j] * sv[j]; o2[j] = x1[j] * sv[j] + x2[j] * cv[j]; }
                    const u32x4 w1 = pack8(o1), w2 = pack8(o2); const int hd = 4 * grp + wc;
                    bf16_t* qd = Q + (long)t * 3072 + hd * 192 + 128 + 8 * fq; *(u32x4*)qd = w1; *(u32x4*)(qd + 32) = w2;
                    if (t >= TP) { const int ts = t - TP; bf16_t* d = QL + ((long)(ts >> 6) * 1024 + hd * 64 + (ts & 63)) * QLD + 512 + 8 * fq; *(u32x4*)d = w1; *(u32x4*)(d + 32) = w2; } }
        }
    }
};

struct EpiExp {
    static constexpr bool PERM = true;
    bf16_t* O; float* rsum;
    __device__ __forceinline__ void operator()(const f32x4 (&acc)[2][2][4][2], const Unit& u, int wr, int wc, int fr, int fq) const {
        bf16_t* base = O + (long)u.x0 * 1024 * KPAD + (long)(u.pm * BM + wr * 64 + fr) * KPAD + u.pn * BM + wc * 32 + 8 * fq;
#pragma unroll
        for (int ai = 0; ai < 2; ++ai)
#pragma unroll
            for (int m = 0; m < 4; ++m) { bf16_t* rowp = base + (long)(ai * HALF + m * 16) * KPAD; float part = 0.f;
#pragma unroll
                for (int bj = 0; bj < 2; ++bj) { const int c0 = u.pn * BM + bj * HALF + wc * 32 + 8 * fq; const f32x4 v0 = acc[ai][bj][m][0], v1 = acc[ai][bj][m][1];
                    const float sv[8] = {v0[0], v0[1], v0[2], v0[3], v1[0], v1[1], v1[2], v1[3]}; float e[8];
#pragma unroll
                    for (int j = 0; j < 8; ++j) { e[j] = (c0 + j < KALL) ? __expf(fminf(sv[j] * MLA_SCALE, 60.f)) : 0.f; part += e[j]; }
                    *(u32x4*)(rowp + bj * HALF) = pack8(e); }
                part += sx<16>(part); part += sx<32>(part);
                if (fq == 0) atomicAdd(rsum + u.x0 * 1024 + u.pm * BM + ai * HALF + wr * 64 + m * 16 + fr, part); }
    }
};

struct EpiQ8 {
    static constexpr bool PERM = true;
    bf16_t* O; long ldc; const float* sa; const float* sb;
    __device__ __forceinline__ void operator()(const f32x4 (&acc)[2][2][4][2], const Unit& u, int wr, int wc, int fr, int fq) const {
        f32x4 sbv[2][2];
#pragma unroll
        for (int bj = 0; bj < 2; ++bj) { const int c = u.pn * BM + bj * HALF + wc * 32 + 8 * fq; sbv[bj][0] = *(const f32x4*)(sb + c); sbv[bj][1] = *(const f32x4*)(sb + c + 4); }
#pragma unroll
        for (int ai = 0; ai < 2; ++ai)
#pragma unroll
            for (int m = 0; m < 4; ++m) { const long t = (long)u.pm * BM + ai * HALF + wr * 64 + m * 16 + fr; const float s = sa[t];
#pragma unroll
                for (int bj = 0; bj < 2; ++bj) { const f32x4 v0 = acc[ai][bj][m][0] * sbv[bj][0] * s, v1 = acc[ai][bj][m][1] * sbv[bj][1] * s;
                    u32x4 w; w.x = cvt_pk_bf16(v0[0], v0[1]); w.y = cvt_pk_bf16(v0[2], v0[3]); w.z = cvt_pk_bf16(v1[0], v1[1]); w.w = cvt_pk_bf16(v1[2], v1[3]);
                    *(u32x4*)(O + t * ldc + u.pn * BM + bj * HALF + wc * 32 + 8 * fq) = w; } }
    }
};
}
namespace att {
constexpr int NW = 8, QBLK = 32, KVBLK = 64;
constexpr float SCALE = MLA_SCALE;
constexpr float THR = 8.f;
constexpr int KROW = 384;
constexpr int SHM_V = KVBLK * 128 * 2, SHM_K = KVBLK * KROW;
constexpr int QR_PITCH = 144, SHM_QR = 256 * QR_PITCH;
constexpr int SHM_ATTN = 2 * SHM_V + 2 * SHM_K + NW * 64 * 4 + SHM_QR;
#define KSWZ(row, colB) ((row) * att::KROW + ((colB) ^ (((row) & 7) << 4)))
#define SBAR() __builtin_amdgcn_sched_barrier(0)
__device__ __forceinline__ int crow(int r, int hi) { return (r & 3) + 8 * (r >> 2) + 4 * hi; }

__device__ __forceinline__ void partialSM(f32x16& p0, f32x16& p1, float& m_reg, float& mn, float& alpha) {
  constexpr float C = SCALE * 1.4426950408889634f;
  float pmax = p0[0];
#pragma unroll
  for (int r = 1; r < 16; ++r) pmax = fmaxf(pmax, p0[r]);
#pragma unroll
  for (int r = 0; r < 16; ++r) pmax = fmaxf(pmax, p1[r]);
  { auto rr = __builtin_amdgcn_permlane32_swap(__float_as_uint(pmax), __float_as_uint(pmax), false, false);
    pmax = fmaxf(__uint_as_float(rr[0]), __uint_as_float(rr[1])); }
  if (__builtin_expect(__all(pmax - m_reg <= THR / SCALE), 1)) { mn = m_reg; alpha = 1.f; }
  else { mn = fmaxf(m_reg, pmax); alpha = __builtin_amdgcn_exp2f((m_reg - mn) * C); m_reg = mn; }
  float mnC = -mn * C;
#pragma unroll
  for (int r = 0; r < 16; ++r) p0[r] = fmaf(p0[r], C, mnC);
#pragma unroll
  for (int r = 0; r < 16; ++r) p1[r] = fmaf(p1[r], C, mnC);
#pragma unroll
  for (int r = 0; r < 16; ++r) p0[r] = __builtin_amdgcn_exp2f(p0[r]);
}
__device__ __forceinline__ void finishSM(f32x16& p0, f32x16& p1, float alpha, float& l_reg, bf16x8& pa0, bf16x8& pa1, bf16x8& pa2, bf16x8& pa3) {
#pragma unroll
  for (int r = 0; r < 16; ++r) p1[r] = __builtin_amdgcn_exp2f(p1[r]);
  float ps = 0;
#pragma unroll
  for (int r = 0; r < 16; ++r) ps += p0[r];
#pragma unroll
  for (int r = 0; r < 16; ++r) ps += p1[r];
  { auto rr = __builtin_amdgcn_permlane32_swap(__float_as_uint(ps), __float_as_uint(ps), false, false);
    ps = __uint_as_float(rr[0]) + __uint_as_float(rr[1]); }
  l_reg = l_reg * alpha + ps;
#define PK4(P, BASE, OUT) do { unsigned a0 = cvt_pk_bf16(P[BASE + 0], P[BASE + 1]), a1 = cvt_pk_bf16(P[BASE + 2], P[BASE + 3]);   \
    unsigned b0 = cvt_pk_bf16(P[BASE + 4], P[BASE + 5]), b1 = cvt_pk_bf16(P[BASE + 6], P[BASE + 7]);                              \
    auto r0 = __builtin_amdgcn_permlane32_swap(a0, b0, false, false); auto r1 = __builtin_amdgcn_permlane32_swap(a1, b1, false, false); \
    u32x4 w = {r0[0], r1[0], r0[1], r1[1]}; OUT = *reinterpret_cast<bf16x8*>(&w); } while (0)
  PK4(p0, 0, pa0); PK4(p0, 8, pa1); PK4(p1, 0, pa2); PK4(p1, 8, pa3);
#undef PK4
}
__device__ __forceinline__ void qkt(f32x16& p0, f32x16& p1, const char* Ks, const bf16x8* qr, const char* qrope, const int (&kbase)[4], bool vis) {
  p0 = f32x16{}; p1 = f32x16{};
  if (vis) {
#pragma unroll
  for (int d0 = 0; d0 < 12; ++d0) {
    bf16x8 b0 = *reinterpret_cast<const bf16x8*>(Ks + kbase[d0 & 3] + (d0 >> 2) * 128);
    bf16x8 b1 = *reinterpret_cast<const bf16x8*>(Ks + kbase[d0 & 3] + (d0 >> 2) * 128 + 32 * KROW);
    const bf16x8 qv = d0 < 8 ? qr[d0 < 8 ? d0 : 0] : *reinterpret_cast<const bf16x8*>(qrope + (d0 - 8) * 32);
    p0 = __builtin_amdgcn_mfma_f32_32x32x16_bf16(b0, qv, p0, 0, 0, 0);
    p1 = __builtin_amdgcn_mfma_f32_32x32x16_bf16(b1, qv, p1, 0, 0, 0); }
  }
  if (!vis) {
#pragma unroll
    for (int r = 0; r < 16; ++r) { p0[r] = -1e30f; p1[r] = -1e30f; } }
}
__device__ __forceinline__ int v_st(int k, int c) { const int kk = (k & ~0xC) | ((k & 4) << 1) | ((k & 8) >> 1); return ((kk >> 3) * 4 + (c >> 5)) * 512 + ((kk & 7) * 32 + (c & 31)) * 2; }
__device__ __forceinline__ int v_rd_base(int lane) { return ((lane & 3) << 3) | (((lane >> 2) & 3) << 6) | (((lane >> 4) & 1) << 5) | (((lane >> 5) & 1) << 8); }
constexpr int v_rd_off(int d0, int ks, int half) { return d0 * 512 + ks * 4096 + half * 2048; }
template <int OFF> __device__ __forceinline__ s16x4 tr_read(int vb) {
  s16x4 r; asm volatile("ds_read_b64_tr_b16 %0, %1 offset:%2" : "=&v"(r) : "v"(vb), "i"(OFF) : "memory"); return r;
}
template <int D0> __device__ __forceinline__ void pv_one(f32x16& od, int vb, bf16x8 pa0, bf16x8 pa1, bf16x8 pa2, bf16x8 pa3) {
  const s16x4 l0 = tr_read<v_rd_off(D0, 0, 0)>(vb), h0 = tr_read<v_rd_off(D0, 0, 1)>(vb), l1 = tr_read<v_rd_off(D0, 1, 0)>(vb), h1 = tr_read<v_rd_off(D0, 1, 1)>(vb);
  const s16x4 l2 = tr_read<v_rd_off(D0, 2, 0)>(vb), h2 = tr_read<v_rd_off(D0, 2, 1)>(vb), l3 = tr_read<v_rd_off(D0, 3, 0)>(vb), h3 = tr_read<v_rd_off(D0, 3, 1)>(vb);
  asm volatile("s_waitcnt lgkmcnt(0)" ::: "memory"); SBAR();
#define PK(L, H) (bf16x8){L[0], L[1], L[2], L[3], H[0], H[1], H[2], H[3]}
  od = __builtin_amdgcn_mfma_f32_32x32x16_bf16(pa0, PK(l0, h0), od, 0, 0, 0);
  od = __builtin_amdgcn_mfma_f32_32x32x16_bf16(pa1, PK(l1, h1), od, 0, 0, 0);
  od = __builtin_amdgcn_mfma_f32_32x32x16_bf16(pa2, PK(l2, h2), od, 0, 0, 0);
  od = __builtin_amdgcn_mfma_f32_32x32x16_bf16(pa3, PK(l3, h3), od, 0, 0, 0);
#undef PK
}
__device__ __forceinline__ void pv_d0(f32x16* o, int vb, bf16x8 pa0, bf16x8 pa1, bf16x8 pa2, bf16x8 pa3) {
  pv_one<0>(o[0], vb, pa0, pa1, pa2, pa3); pv_one<1>(o[1], vb, pa0, pa1, pa2, pa3); pv_one<2>(o[2], vb, pa0, pa1, pa2, pa3); pv_one<3>(o[3], vb, pa0, pa1, pa2, pa3);
}

__device__ __forceinline__ void attn_block(const bf16_t* __restrict__ Qb, const bf16_t* __restrict__ Kn, const bf16_t* __restrict__ Kr, const bf16_t* __restrict__ Vh,
                                           bf16_t* __restrict__ Ob, int qb, char* lds) {
  constexpr int LDQ = 3072, LDK = 4096, LDR = 64, LDO = 2048;
  const int tid = otid(), wid = tid >> 6, lane = tid & 63, r32 = lane & 31, hi = lane >> 5;
  char* V_lds = lds; char* K_lds = lds + 2 * SHM_V;
  float* ws = (float*)(lds + 2 * SHM_V + 2 * SHM_K) + wid * 64; float* li_l = ws; float* al_l = ws + 32;
  float m_reg = -1e30f, l_reg = 0; f32x16 o[4] = {}; bf16x8 qr[8];
  const bf16_t* Qw = Qb + (long)(wid * QBLK + r32) * LDQ + hi * 8;
#pragma unroll
  for (int d0 = 0; d0 < 8; ++d0) qr[d0] = *reinterpret_cast<const bf16x8*>(Qw + d0 * 16);
  char* qrope = lds + 2 * SHM_V + 2 * SHM_K + NW * 64 * 4 + (wid * QBLK + r32) * QR_PITCH + hi * 16;
#pragma unroll
  for (int d0 = 8; d0 < 12; ++d0) *reinterpret_cast<bf16x8*>(qrope + (d0 - 8) * 32) = *reinterpret_cast<const bf16x8*>(Qw + d0 * 16);
  asm volatile("s_waitcnt lgkmcnt(0)" ::: "memory");
  const int NT = 4 * qb + 4, jmax = 4 * qb + (wid >> 1);
  int kbase[4];
#pragma unroll
  for (int dl = 0; dl < 4; ++dl) kbase[dl] = r32 * KROW + (((dl << 5) | (hi << 4)) ^ ((r32 & 7) << 4));
  const int sr = tid >> 4, sc = (tid & 15) * 8, vst0 = v_st(sr, sc), vst1 = v_st(32 + sr, sc);
  const int rr = tid >> 3, rc = (tid & 7) * 8;
  const int vb0 = (int)(uintptr_t)V_lds + v_rd_base(lane);
  bf16x8 vs0, vs1, ks0, ks1, kr0;
#define SLOAD(k0) do { vs0 = *reinterpret_cast<const bf16x8*>(&Vh[(long)((k0) + sr) * LDK + sc]); vs1 = *reinterpret_cast<const bf16x8*>(&Vh[(long)((k0) + 32 + sr) * LDK + sc]); \
    ks0 = *reinterpret_cast<const bf16x8*>(&Kn[(long)((k0) + sr) * LDK + sc]); ks1 = *reinterpret_cast<const bf16x8*>(&Kn[(long)((k0) + 32 + sr) * LDK + sc]); \
    kr0 = *reinterpret_cast<const bf16x8*>(&Kr[(long)((k0) + rr) * LDR + rc]); } while (0)
#define SWRITE(b) do { *(bf16x8*)(V_lds + (b) * SHM_V + vst0) = vs0; *(bf16x8*)(V_lds + (b) * SHM_V + vst1) = vs1; int kc = sc * 2; \
    *(bf16x8*)(K_lds + (b) * SHM_K + KSWZ(sr, kc)) = ks0; *(bf16x8*)(K_lds + (b) * SHM_K + KSWZ(32 + sr, kc)) = ks1; \
    *(bf16x8*)(K_lds + (b) * SHM_K + KSWZ(rr, 256 + rc * 2)) = kr0; } while (0)
#define SWAIT() asm volatile("s_waitcnt vmcnt(0)" ::: "memory")
#define RESC(a) do { if (__any((a) < 1.f)) { if (hi == 0) al_l[r32] = (a); asm volatile("s_waitcnt lgkmcnt(0)" ::: "memory"); \
    _Pragma("unroll") for (int d = 0; d < 4; ++d) _Pragma("unroll") for (int r = 0; r < 16; ++r) o[d][r] *= al_l[crow(r, hi)]; } } while (0)
  f32x16 pA0, pA1, pB0, pB1; float mnA, mnB, alA, alB; bf16x8 pa0, pa1, pa2, pa3;
  SLOAD(0); SWAIT(); SWRITE(0); __syncthreads();
  qkt(pA0, pA1, K_lds, qr, qrope, kbase, true); partialSM(pA0, pA1, m_reg, mnA, alA);
  SLOAD(KVBLK);
  SWAIT(); SWRITE(1); __syncthreads();
  for (int j = 1; j + 1 < NT; j += 2) {
    SBAR(); qkt(pB0, pB1, K_lds + SHM_K, qr, qrope, kbase, j <= jmax);
    finishSM(pA0, pA1, alA, l_reg, pa0, pa1, pa2, pa3); SBAR();
    SLOAD((j + 1) * KVBLK); SBAR();
    if (j - 1 <= jmax) pv_d0(o, vb0, pa0, pa1, pa2, pa3);
    partialSM(pB0, pB1, m_reg, mnB, alB);
    __syncthreads(); SWAIT(); SWRITE(0);
    RESC(alB); __syncthreads();
    SBAR(); qkt(pA0, pA1, K_lds, qr, qrope, kbase, j + 1 <= jmax);
    finishSM(pB0, pB1, alB, l_reg, pa0, pa1, pa2, pa3); SBAR();
    SLOAD((j + 2) * KVBLK); SBAR();
    if (j <= jmax) pv_d0(o, vb0 + (int)SHM_V, pa0, pa1, pa2, pa3);
    partialSM(pA0, pA1, m_reg, mnA, alA);
    __syncthreads(); SWAIT(); SWRITE(1);
    RESC(alA); __syncthreads();
  }
  SBAR(); qkt(pB0, pB1, K_lds + SHM_K, qr, qrope, kbase, NT - 1 <= jmax);
  finishSM(pA0, pA1, alA, l_reg, pa0, pa1, pa2, pa3); SBAR();
  if (NT - 2 <= jmax) pv_d0(o, vb0, pa0, pa1, pa2, pa3);
  partialSM(pB0, pB1, m_reg, mnB, alB);
  __syncthreads(); RESC(alB);
  finishSM(pB0, pB1, alB, l_reg, pa0, pa1, pa2, pa3); SBAR();
  if (NT - 1 <= jmax) pv_d0(o, vb0 + (int)SHM_V, pa0, pa1, pa2, pa3);
  if (hi == 0) li_l[r32] = l_reg; asm volatile("s_waitcnt lgkmcnt(0)" ::: "memory");
  float rli[16];
#pragma unroll
  for (int r = 0; r < 16; ++r) rli[r] = __builtin_amdgcn_rcpf(li_l[crow(r, hi)]);
  bf16_t* Ow = Ob + (long)(wid * QBLK) * LDO;
#pragma unroll
  for (int r = 0; r < 16; ++r) { int orow = crow(r, hi);
#pragma unroll
    for (int d0 = 0; d0 < 4; ++d0) Ow[(long)orow * LDO + d0 * 32 + r32] = f2bf(o[d0][r] * rli[r]); }
  __syncthreads();
#undef SLOAD
#undef SWRITE
#undef SWAIT
#undef RESC
}
}
namespace ret {
constexpr int QP_ = 136;
__device__ __forceinline__ bf16x8 ldfrag(const bf16_t* p) { return *reinterpret_cast<const bf16x8*>(p); }
template <int CL> struct Lay {
    static constexpr int IP = CL + 8;
    static constexpr int QS = 0, KS = QS + CL * QP_ * 2, VT = KS + CL * QP_ * 2, VDT = VT + 32 * IP * 2, IN = VDT + 32 * IP * 2, ST = IN + CL * IP * 2, VS = ST + 32 * QP_ * 2, END = VS + CL * 40 * 2;
};
static_assert(Lay<128>::END <= LDS_BARW, "retention LDS");

template <int CL>
__device__ __forceinline__ void run(const bf16_t* __restrict__ Y, bf16_t* __restrict__ OB, const float* __restrict__ sp, float* __restrict__ so, long tok0, int nch, int h, int es, float lg, char* lds, int tid) {
    using L = Lay<CL>; constexpr int IP = L::IP, NQT = CL / 16, NKS = CL / 32, NPC = CL / 32;
    const int wid = __builtin_amdgcn_readfirstlane(tid >> 6), lane = tid & 63, l15 = lane & 15, l4 = lane >> 4;
    bf16_t* Qs = (bf16_t*)(lds + L::QS); bf16_t* Ks = (bf16_t*)(lds + L::KS); bf16_t* Vt = (bf16_t*)(lds + L::VT); bf16_t* Vdt = (bf16_t*)(lds + L::VDT); bf16_t* In = (bf16_t*)(lds + L::IN); bf16_t* St = (bf16_t*)(lds + L::ST); bf16_t* Vs = (bf16_t*)(lds + L::VS);
    const float gCL = __expf((float)CL * lg);
    f32x4 Sacc[2];
    if (sp) {
#pragma unroll
        for (int ej = 0; ej < 2; ++ej)
#pragma unroll
            for (int r = 0; r < 4; ++r) Sacc[ej][r] = sp[(long)(16 * wid + 4 * l4 + r) * RV + 16 * ej + l15];
    } else { Sacc[0] = (f32x4){0.f, 0.f, 0.f, 0.f}; Sacc[1] = (f32x4){0.f, 0.f, 0.f, 0.f}; }
    for (int i = tid; i < CL * IP / 8; i += 512) reinterpret_cast<u32x4*>(In)[i] = (u32x4){0u, 0u, 0u, 0u};
    u32x4 pq[NPC], pk[NPC], pv;
    const int vk = tid >> 2, ve0 = (tid & 3) * 8;
#define RET_LOAD(cc) do { const bf16_t* yrow_ = Y + (tok0 + (long)(cc) * CL) * INWP; \
        _Pragma("unroll") for (int i = 0; i < NPC; ++i) { const int idx = tid + i * 512, k = idx >> 4, d0 = (idx & 15) * 8; \
            pq[i] = *reinterpret_cast<const u32x4*>(yrow_ + (long)k * INWP + C_RQ + h * 128 + d0); pk[i] = *reinterpret_cast<const u32x4*>(yrow_ + (long)k * INWP + C_RK + h * 128 + d0); } \
        if (tid < 4 * CL) pv = *reinterpret_cast<const u32x4*>(yrow_ + (long)vk * INWP + C_RV + h * 256 + es * 32 + ve0); } while (0)
    RET_LOAD(0);
    for (int c = 0; c < nch; ++c) {
#pragma unroll
        for (int ej = 0; ej < 2; ++ej) { u32x2 w; w.x = cvt_pk_bf16(Sacc[ej][0], Sacc[ej][1]); w.y = cvt_pk_bf16(Sacc[ej][2], Sacc[ej][3]);
            *reinterpret_cast<u32x2*>(St + (16 * ej + l15) * QP_ + 16 * wid + 4 * l4) = w; }
#pragma unroll
        for (int i = 0; i < NPC; ++i) { const int idx = tid + i * 512, k = idx >> 4, d0 = (idx & 15) * 8;
            *reinterpret_cast<u32x4*>(Qs + k * QP_ + d0) = pq[i]; *reinterpret_cast<u32x4*>(Ks + k * QP_ + d0) = pk[i]; }
        if (tid < 4 * CL) *reinterpret_cast<u32x4*>(Vs + vk * 40 + ve0) = pv;
        if (c + 1 < nch) RET_LOAD(c + 1);
        __syncthreads();
        if (tid < 4 * CL) { const int e = tid & 31, kg = tid >> 5; float f[8], fd[8];
#pragma unroll
            for (int j = 0; j < 8; ++j) { f[j] = bf2f(Vs[(8 * kg + j) * 40 + e]); fd[j] = f[j] * __expf((float)(CL - 1 - 8 * kg - j) * lg); }
            *reinterpret_cast<u32x4*>(Vt + e * IP + 8 * kg) = pack8(f); *reinterpret_cast<u32x4*>(Vdt + e * IP + 8 * kg) = pack8(fd); }
#pragma unroll
        for (int it_ = 0; it_ < (NQT * (NQT + 1) / 2 + 7) / 8; ++it_) { const int idx = wid + 8 * it_; if (idx >= NQT * (NQT + 1) / 2) break;
            int qi = 0; while ((qi + 1) * (qi + 2) / 2 <= idx) ++qi; const int kj = idx - qi * (qi + 1) / 2;
            f32x4 a = (f32x4){0.f, 0.f, 0.f, 0.f}; const bf16_t* qp = Qs + (16 * qi + l15) * QP_ + 8 * l4; const bf16_t* kp = Ks + (16 * kj + l15) * QP_ + 8 * l4;
#pragma unroll
            for (int ks = 0; ks < 4; ++ks) a = __builtin_amdgcn_mfma_f32_16x16x32_bf16(ldfrag(qp + 32 * ks), ldfrag(kp + 32 * ks), a, 0, 0, 0);
            const int q0 = 16 * qi + 4 * l4, k = 16 * kj + l15;
#pragma unroll
            for (int r = 0; r < 4; ++r) { const int q = q0 + r; const float dm = (q >= k) ? __expf((float)(q - k) * lg) : 0.f;
                In[q * IP + k] = f2bf(a[r] * dm); } }
        __syncthreads();
#pragma unroll
        for (int ot = 0; ot < (2 * NQT) / 8; ++ot) { const int tI = wid + 8 * ot, qi = tI >> 1, ej = tI & 1; f32x4 a = (f32x4){0.f, 0.f, 0.f, 0.f};
#pragma unroll
            for (int ks = 0; ks < 4; ++ks) a = __builtin_amdgcn_mfma_f32_16x16x32_bf16(ldfrag(Qs + (16 * qi + l15) * QP_ + 32 * ks + 8 * l4), ldfrag(St + (16 * ej + l15) * QP_ + 32 * ks + 8 * l4), a, 0, 0, 0);
#pragma unroll
            for (int r = 0; r < 4; ++r) a[r] *= __expf((float)(16 * qi + 4 * l4 + r + 1) * lg);
#pragma unroll
            for (int ks = 0; ks < NKS; ++ks) if (ks <= (qi >> 1)) a = __builtin_amdgcn_mfma_f32_16x16x32_bf16(ldfrag(In + (16 * qi + l15) * IP + 32 * ks + 8 * l4), ldfrag(Vt + (16 * ej + l15) * IP + 32 * ks + 8 * l4), a, 0, 0, 0);
            bf16_t* op = OB + ((long)(h * 8 + es) * T + tok0 + (long)c * CL + 16 * qi + 4 * l4) * 32 + 16 * ej + l15;
#pragma unroll
            for (int r = 0; r < 4; ++r) op[r * 32] = f2bf(a[r]); }
        { f32x4 s0 = Sacc[0] * gCL, s1 = Sacc[1] * gCL;
#pragma unroll
          for (int ks = 0; ks < NKS; ++ks) { bf16x8 af;
#pragma unroll
              for (int j = 0; j < 8; ++j) af[j] = (short)Ks[(32 * ks + 8 * l4 + j) * QP_ + 16 * wid + l15];
              s0 = __builtin_amdgcn_mfma_f32_16x16x32_bf16(af, ldfrag(Vdt + l15 * IP + 32 * ks + 8 * l4), s0, 0, 0, 0);
              s1 = __builtin_amdgcn_mfma_f32_16x16x32_bf16(af, ldfrag(Vdt + (16 + l15) * IP + 32 * ks + 8 * l4), s1, 0, 0, 0); }
          Sacc[0] = s0; Sacc[1] = s1; }
        __syncthreads();
    }
#undef RET_LOAD
#pragma unroll
    for (int ej = 0; ej < 2; ++ej)
#pragma unroll
        for (int r = 0; r < 4; ++r) so[(long)(16 * wid + 4 * l4 + r) * RV + 16 * ej + l15] = Sacc[ej][r];
}

__device__ __forceinline__ void unit(KParams& p, int l, int u, char* lds) {
    const int tid = otid(); unsigned char* ws = optr(gp(p.ws)); const bf16_t* Y = (const bf16_t*)(ws + WS_Y); bf16_t* OB = (bf16_t*)(ws + WS_OB);
    const bool samp = u >= 256; const int v = samp ? u - 256 : u; const int b = v >> 6, h = (v >> 3) & 7, es = v & 7; const float lg = p.lg[h];
    if (samp) run<64>(Y, OB, gp(p.state_ret) + ((((long)l * DB + b) * RH + h) * RQK) * RV + es * 32, gp(p.out) + O_RETS + ((((long)l * DB + b) * RH + h) * RQK) * RV + es * 32, (long)TP + b * 64, 1, h, es, lg, lds, tid);
    else run<64>(Y, OB, nullptr, gp(p.out) + O_RETP + ((((long)l * NB + b) * RH + h) * RQK) * RV + es * 32, (long)b * SEQ, SEQ / 64, h, es, lg, lds, tid);
}
}
namespace peer {
__device__ __forceinline__ void ins16(float (&l)[16], float x) {
#pragma unroll
    for (int j = 0; j < 16; ++j) { const float hi = fmaxf(l[j], x); x = fminf(l[j], x); l[j] = hi; }
}
#define CE_DESC(a, b) do { const float hi_ = fmaxf(a, b), lo_ = fminf(a, b); a = hi_; b = lo_; } while (0)
#define CE_ASC(a, b) do { const float hi_ = fmaxf(a, b), lo_ = fminf(a, b); a = lo_; b = hi_; } while (0)
__device__ __forceinline__ void sort16_desc(float (&v)[16]) {
#pragma unroll
    for (int k = 2; k <= 16; k <<= 1)
#pragma unroll
        for (int j = k >> 1; j >= 1; j >>= 1)
#pragma unroll
            for (int i = 0; i < 16; ++i) { const int l = i ^ j; if (l > i) { if ((i & k) == 0) CE_DESC(v[i], v[l]); else CE_ASC(v[i], v[l]); } }
}
__device__ __forceinline__ void merge16_desc(float (&l)[16], const float (&o)[16]) {
#pragma unroll
    for (int i = 0; i < 16; ++i) l[i] = fmaxf(l[i], o[15 - i]);
#pragma unroll
    for (int j = 8; j >= 1; j >>= 1)
#pragma unroll
        for (int i = 0; i < 16; ++i) { const int m = i ^ j; if (m > i) CE_DESC(l[i], l[m]); }
}
constexpr int KPITCH = 136;
__device__ __forceinline__ void half_top16(const bf16_t* __restrict__ qrow, const bf16_t* __restrict__ keys, int lane, float (&l)[16]) {
    const int r32 = lane & 31, g = lane >> 5;
#pragma unroll
    for (int j = 0; j < 16; ++j) l[j] = -3.0e38f;
    bf16x8 qf[8];
#pragma unroll
    for (int ks = 0; ks < 8; ++ks) qf[ks] = *reinterpret_cast<const bf16x8*>(qrow + 16 * ks + 8 * g);
#pragma unroll 1
    for (int kb = 0; kb < 4; ++kb) { f32x16 a = f32x16{};
#pragma unroll
        for (int ks = 0; ks < 8; ++ks) { const bf16x8 kf = *reinterpret_cast<const bf16x8*>(keys + (32 * kb + r32) * KPITCH + 16 * ks + 8 * g);
            a = __builtin_amdgcn_mfma_f32_32x32x16_bf16(kf, qf[ks], a, 0, 0, 0); }
        float blk[16];
#pragma unroll
        for (int r = 0; r < 16; ++r) { const unsigned key = (unsigned)(32 * kb + (r & 3) + 8 * (r >> 2) + 4 * g);
            blk[r] = __uint_as_float((__float_as_uint(a[r]) & ~0x7Fu) | key); }
        sort16_desc(blk); merge16_desc(l, blk); }
}
__device__ __forceinline__ void merge_lists(float (&l)[16], const float (&o)[16]) { merge16_desc(l, o); }
__device__ __forceinline__ void select_unit(const bf16_t* __restrict__ QP, const bf16_t* __restrict__ k1, const bf16_t* __restrict__ k2, int* __restrict__ PIDX, float* __restrict__ PW,
                                            int t0, int h, int lane, float* lds_lane  ) {
    const int r32 = lane & 31, g = lane >> 5;
    const bf16_t* qrow = QP + (long)(t0 + r32) * DM + h * 256;
    float la[16], lb[16];
    half_top16(qrow, k1, lane, la);
    half_top16(qrow + 128, k2, lane, lb);
    float m0[16], m1[16];
#pragma unroll
    for (int j = 0; j < 16; ++j) { auto rr = __builtin_amdgcn_permlane32_swap(__float_as_uint(la[j]), __float_as_uint(lb[j]), false, false); m0[j] = __uint_as_float(rr[0]); m1[j] = __uint_as_float(rr[1]); }
    merge_lists(m0, m1);
    float L1[16], L2[16];
#pragma unroll
    for (int j = 0; j < 16; ++j) { auto rr = __builtin_amdgcn_permlane32_swap(__float_as_uint(m0[j]), __float_as_uint(m0[j]), false, false);
        L1[j] = __uint_as_float(rr[0]); L2[j] = __uint_as_float(rr[1]); }
#define CAND(i, j) __uint_as_float((__float_as_uint(L1[i] + L2[j]) & ~0xFFu) | (unsigned)((i) * 16 + (j)))
    float best[16], c2[16], c3[16];
#pragma unroll
    for (int j = 0; j < 16; ++j) best[j] = CAND(0, j);
    sort16_desc(best);
    c2[0] = CAND(1, 0); c2[1] = CAND(1, 1); c2[2] = CAND(1, 2); c2[3] = CAND(1, 3); c2[4] = CAND(1, 4); c2[5] = CAND(1, 5); c2[6] = CAND(1, 6); c2[7] = CAND(1, 7);
    c2[8] = CAND(2, 0); c2[9] = CAND(2, 1); c2[10] = CAND(2, 2); c2[11] = CAND(2, 3); c2[12] = CAND(2, 4); c2[13] = CAND(4, 0); c2[14] = CAND(4, 1); c2[15] = CAND(4, 2);
    sort16_desc(c2); merge16_desc(best, c2);
    c3[0] = CAND(3, 0); c3[1] = CAND(3, 1); c3[2] = CAND(3, 2); c3[3] = CAND(3, 3); c3[4] = CAND(5, 0); c3[5] = CAND(5, 1); c3[6] = CAND(6, 0); c3[7] = CAND(6, 1);
    c3[8] = CAND(7, 0); c3[9] = CAND(7, 1); c3[10] = CAND(8, 0); c3[11] = CAND(9, 0); c3[12] = CAND(10, 0); c3[13] = CAND(11, 0); c3[14] = CAND(12, 0); c3[15] = CAND(13, 0);
    sort16_desc(c3); merge16_desc(best, c3);
    ins16(best, CAND(14, 0)); ins16(best, CAND(15, 0));
#undef CAND
#pragma unroll
    for (int j = 0; j < 16; ++j) { lds_lane[j] = __uint_as_float(__float_as_uint(L1[j]) & 0x7Fu); lds_lane[16 + j] = __uint_as_float(__float_as_uint(L2[j]) & 0x7Fu); }
    asm volatile("s_waitcnt lgkmcnt(0)" ::: "memory");
    float wsum = 0.f, w[16]; int ei[16];
    const float mx = best[0];
#pragma unroll
    for (int k = 0; k < 16; ++k) { const unsigned code = __float_as_uint(best[k]) & 0xFFu; const int i = (int)(code >> 4), j = (int)(code & 15u);
        const int i1 = (int)__float_as_uint(lds_lane[i]), i2 = (int)__float_as_uint(lds_lane[16 + j]); ei[k] = i1 * NKEYS + i2;
        w[k] = __expf(best[k] - mx); wsum += w[k]; }
    const float inv = 1.0f / wsum;
    if (g == 0) { int* ip = PIDX + (long)(t0 + r32) * 128 + h * 16; float* wp = PW + (long)(t0 + r32) * 128 + h * 16;
#pragma unroll
        for (int k = 0; k < 16; k += 4) { *reinterpret_cast<int4*>(ip + k) = make_int4(ei[k], ei[k + 1], ei[k + 2], ei[k + 3]);
            *reinterpret_cast<float4*>(wp + k) = make_float4(w[k] * inv, w[k + 1] * inv, w[k + 2] * inv, w[k + 3] * inv); } }
}

__device__ __forceinline__ float gelu_exact(float x) { return 0.5f * x * (1.0f + erff(x * 0.70710678118654752f)); }

__device__ __forceinline__ void dec16(const u32x4 w, f32x2 (&f)[8]) {
    f[0] = __builtin_amdgcn_cvt_pk_f32_fp8((int)w.x, false); f[1] = __builtin_amdgcn_cvt_pk_f32_fp8((int)w.x, true);
    f[2] = __builtin_amdgcn_cvt_pk_f32_fp8((int)w.y, false); f[3] = __builtin_amdgcn_cvt_pk_f32_fp8((int)w.y, true);
    f[4] = __builtin_amdgcn_cvt_pk_f32_fp8((int)w.z, false); f[5] = __builtin_amdgcn_cvt_pk_f32_fp8((int)w.z, true);
    f[6] = __builtin_amdgcn_cvt_pk_f32_fp8((int)w.w, false); f[7] = __builtin_amdgcn_cvt_pk_f32_fp8((int)w.w, true);
}
__device__ __forceinline__ void dec16_i8(const u32x4 w, f32x2 (&f)[8]) {
    const unsigned ww[4] = {w.x, w.y, w.z, w.w};
#pragma unroll
    for (int i = 0; i < 4; ++i) { f[2 * i] = (f32x2){(float)(int)(signed char)(ww[i] & 0xffu), (float)(int)(signed char)((ww[i] >> 8) & 0xffu)}; f[2 * i + 1] = (f32x2){(float)(int)(signed char)((ww[i] >> 16) & 0xffu), (float)(int)(signed char)(ww[i] >> 24)}; }
}
__device__ __forceinline__ void gather_token(const unsigned char* __restrict__ H8, const float* __restrict__ SA8, const unsigned char* __restrict__ PU, const unsigned char* __restrict__ PV, const float* __restrict__ SU, const float* __restrict__ SV,
                                             const int* __restrict__ PIDX, const float* __restrict__ PW, float* __restrict__ X, const float* __restrict__ gate  , int t, int lane) {
    f32x2 xf[2][8];
#pragma unroll
    for (int hlf = 0; hlf < 2; ++hlf) dec16_i8(*reinterpret_cast<const u32x4*>(H8 + (long)t * DM + 1024 * hlf + 16 * lane), xf[hlf]);
    const float sat = SA8[t];
    f32x2 out[2][8];
#pragma unroll
    for (int hlf = 0; hlf < 2; ++hlf)
#pragma unroll
        for (int i = 0; i < 8; ++i) out[hlf][i] = (f32x2){0.f, 0.f};
    const int myidx0 = PIDX[(long)t * 128 + lane], myidx1 = PIDX[(long)t * 128 + 64 + lane];
    const float myw0 = PW[(long)t * 128 + lane], myw1 = PW[(long)t * 128 + 64 + lane];
    const float msu0 = SU[myidx0], msu1 = SU[myidx1], msv0 = SV[myidx0], msv1 = SV[myidx1];
    for (int hk = 0; hk < 128; hk += 4) {
        const int src = hk & 63; const bool lo = hk < 64;
        const int selidx = lo ? myidx0 : myidx1; const int selw = __float_as_int(lo ? myw0 : myw1), selsu = __float_as_int(lo ? msu0 : msu1), selsv = __float_as_int(lo ? msv0 : msv1);
        int e[4]; float g[4], su[4], sv[4];
#pragma unroll
        for (int k = 0; k < 4; ++k) { e[k] = __builtin_amdgcn_readlane(selidx, src + k); g[k] = __int_as_float(__builtin_amdgcn_readlane(selw, src + k));
            su[k] = __int_as_float(__builtin_amdgcn_readlane(selsu, src + k)); sv[k] = __int_as_float(__builtin_amdgcn_readlane(selsv, src + k)); }
        u32x4 uw[4][2], vw[4][2];
#pragma unroll
        for (int k = 0; k < 4; ++k) { uw[k][0] = *reinterpret_cast<const u32x4*>(PU + ((long)(lane >> 3) * NEXP + e[k]) * 128 + 16 * (lane & 7)); uw[k][1] = *reinterpret_cast<const u32x4*>(PU + ((long)(8 + (lane >> 3)) * NEXP + e[k]) * 128 + 16 * (lane & 7)); }
#pragma unroll
        for (int k = 0; k < 4; ++k) { { const u32x2 a0 = *reinterpret_cast<const u32x2*>(PV + ((long)(2 * lane) * NEXP + e[k]) * 8), a1 = *reinterpret_cast<const u32x2*>(PV + ((long)(2 * lane + 1) * NEXP + e[k]) * 8);
              const u32x2 b0 = *reinterpret_cast<const u32x2*>(PV + ((long)(128 + 2 * lane) * NEXP + e[k]) * 8), b1 = *reinterpret_cast<const u32x2*>(PV + ((long)(129 + 2 * lane) * NEXP + e[k]) * 8);
              vw[k][0] = (u32x4){a0.x, a0.y, a1.x, a1.y}; vw[k][1] = (u32x4){b0.x, b0.y, b1.x, b1.y}; } }
        float a[4];
#pragma unroll
        for (int k = 0; k < 4; ++k) { f32x2 d = (f32x2){0.f, 0.f};
#pragma unroll
            for (int hlf = 0; hlf < 2; ++hlf) { f32x2 f[8]; dec16_i8(uw[k][hlf], f);
#pragma unroll
                for (int i = 0; i < 8; ++i) d = __builtin_elementwise_fma(f[i], xf[hlf][i], d); }
            a[k] = wave_sum(d[0] + d[1]) * sat; }
#pragma unroll
        for (int k = 0; k < 4; ++k) { const float ak = g[k] * gelu_exact(a[k] * su[k]) * sv[k]; const f32x2 a2 = (f32x2){ak, ak};
#pragma unroll
            for (int hlf = 0; hlf < 2; ++hlf) { f32x2 f[8]; dec16(vw[k][hlf], f);
#pragma unroll
                for (int i = 0; i < 8; ++i) out[hlf][i] = __builtin_elementwise_fma(f[i], a2, out[hlf][i]); } }
    }
    const float* gr = gate + (long)cond_row(t) * 12288;
#pragma unroll
    for (int hlf = 0; hlf < 2; ++hlf)
#pragma unroll
        for (int q = 0; q < 4; ++q) { const int c = 1024 * hlf + 16 * lane + 4 * q; float* xp = X + (long)t * DM + c;
            const f32x4 gv = *reinterpret_cast<const f32x4*>(gr + c); f32x4 xv = *reinterpret_cast<const f32x4*>(xp);
            xv[0] += gv[0] * out[hlf][2 * q][0]; xv[1] += gv[1] * out[hlf][2 * q][1]; xv[2] += gv[2] * out[hlf][2 * q + 1][0]; xv[3] += gv[3] * out[hlf][2 * q + 1][1];
            *reinterpret_cast<f32x4*>(xp) = xv; }
}

constexpr int SW = 128, NSL = DM / SW;
struct XInfo { int rank, xi, nx, nloc; };
__device__ __forceinline__ void upass(const unsigned char* __restrict__ H8, const float* __restrict__ SA, const unsigned char* __restrict__ PU, const int* __restrict__ PIDX, const float* __restrict__ PW, const float* __restrict__ SU, const float* __restrict__ SV,
                                      int* __restrict__ DOTP, unsigned* __restrict__ PACKT, const XInfo xin, int wid, int lane) {
    const int g = lane >> 3, c = lane & 7; const int nwv = xin.nloc * 8;
    const int tlo = (int)((long)T * xin.xi / xin.nx), thi = (int)((long)T * (xin.xi + 1) / xin.nx); const int wv = tlo + xin.rank * 8 + wid;
    int* dp = DOTP;
#define SXI(K, v_) __float_as_int(sx<K>(__int_as_float(v_)))
    for (int s = 0; s < NSL; ++s) { const bool first = (s == 0), lastS = (s == NSL - 1);
        const __amdgpu_buffer_rsrc_t urs = __builtin_amdgcn_make_buffer_rsrc((void*)(PU + (long)s * NEXP * SW), 0, NEXP * SW, 0x00020000);
#define UP_ROW(e_) __builtin_bit_cast(u32x4, __builtin_amdgcn_raw_buffer_load_b128(urs, (e_) * SW + 16 * c, 0, 0))
#define UP_IDX(tt, q4) (*reinterpret_cast<const int4*>(PIDX + (long)(tt) * 128 + 16 * g + 4 * (q4)))
#define UP_X(tt) (*reinterpret_cast<const u32x4*>(H8 + (long)(tt) * DM + SW * s + 16 * c))
#define UP_DOT(r_) __builtin_amdgcn_sdot4((int)(r_).x, (int)xv.x, __builtin_amdgcn_sdot4((int)(r_).y, (int)xv.y, __builtin_amdgcn_sdot4((int)(r_).z, (int)xv.z, __builtin_amdgcn_sdot4((int)(r_).w, (int)xv.w, 0, false), false), false), false)
        if (wv >= thi) continue;
        u32x4 A[8], B[8]; int4 en[4]; u32x4 xn;
        { int4 e0[4];
#pragma unroll
          for (int q4 = 0; q4 < 4; ++q4) e0[q4] = UP_IDX(wv, q4);
          A[0] = UP_ROW(e0[0].x); A[1] = UP_ROW(e0[0].y); A[2] = UP_ROW(e0[0].z); A[3] = UP_ROW(e0[0].w); A[4] = UP_ROW(e0[1].x); A[5] = UP_ROW(e0[1].y); A[6] = UP_ROW(e0[1].z); A[7] = UP_ROW(e0[1].w);
          B[0] = UP_ROW(e0[2].x); B[1] = UP_ROW(e0[2].y); B[2] = UP_ROW(e0[2].z); B[3] = UP_ROW(e0[2].w); B[4] = UP_ROW(e0[3].x); B[5] = UP_ROW(e0[3].y); B[6] = UP_ROW(e0[3].z); B[7] = UP_ROW(e0[3].w);
          const int t1 = (wv + nwv < thi) ? wv + nwv : wv;
#pragma unroll
          for (int q4 = 0; q4 < 4; ++q4) en[q4] = UP_IDX(t1, q4);
          xn = UP_X(wv); }
        int2 dnx = make_int2(0, 0);
        if (!first) dnx = *reinterpret_cast<const int2*>(dp + (long)wv * 128 + 16 * g + 2 * c);
#pragma unroll 1
        for (int t = wv; t < thi; t += nwv) {
            const int tn = (t + nwv < thi) ? t + nwv : t, tnn = (tn + nwv < thi) ? tn + nwv : tn;
            const int2 dcur = dnx;
            if (!first) dnx = *reinterpret_cast<const int2*>(dp + (long)tn * 128 + 16 * g + 2 * c);
            const u32x4 xv = xn; xn = UP_X(tn);
            int d[16];
#pragma unroll
            for (int i = 0; i < 8; ++i) d[i] = UP_DOT(A[i]);
            A[0] = UP_ROW(en[0].x); A[1] = UP_ROW(en[0].y); A[2] = UP_ROW(en[0].z); A[3] = UP_ROW(en[0].w); A[4] = UP_ROW(en[1].x); A[5] = UP_ROW(en[1].y); A[6] = UP_ROW(en[1].z); A[7] = UP_ROW(en[1].w);
#pragma unroll
            for (int i = 0; i < 8; ++i) d[8 + i] = UP_DOT(B[i]);
            B[0] = UP_ROW(en[2].x); B[1] = UP_ROW(en[2].y); B[2] = UP_ROW(en[2].z); B[3] = UP_ROW(en[2].w); B[4] = UP_ROW(en[3].x); B[5] = UP_ROW(en[3].y); B[6] = UP_ROW(en[3].z); B[7] = UP_ROW(en[3].w);
#pragma unroll
            for (int q4 = 0; q4 < 4; ++q4) en[q4] = UP_IDX(tnn, q4);
            int r8[8], r4[4], r2[2];
#pragma unroll
            for (int k = 0; k < 8; ++k) { const int keep = (c & 4) ? d[k + 8] : d[k], send = (c & 4) ? d[k] : d[k + 8]; r8[k] = keep + SXI(4, send); }
#pragma unroll
            for (int k = 0; k < 4; ++k) { const int keep = (c & 2) ? r8[k + 4] : r8[k], send = (c & 2) ? r8[k] : r8[k + 4]; r4[k] = keep + SXI(2, send); }
#pragma unroll
            for (int k = 0; k < 2; ++k) { const int keep = (c & 1) ? r4[k + 2] : r4[k], send = (c & 1) ? r4[k] : r4[k + 2]; r2[k] = keep + SXI(1, send); }
            int* o = dp + (long)t * 128 + 16 * g + 2 * c;
            const int a0i = r2[0] + dcur.x, a1i = r2[1] + dcur.y;
            if (!lastS) *reinterpret_cast<int2*>(o) = make_int2(a0i, a1i);
            else {
                const int p0 = 16 * g + 2 * c; const int2 ee = *reinterpret_cast<const int2*>(PIDX + (long)t * 128 + p0); const f32x2 gw = *reinterpret_cast<const f32x2*>(PW + (long)t * 128 + p0); const float sa = SA[t];
                const float a0 = gw[0] * gelu_exact((float)a0i * sa * SU[ee.x]) * SV[ee.x], a1 = gw[1] * gelu_exact((float)a1i * sa * SU[ee.y]) * SV[ee.y];
                u32x2 pk; pk.x = (cvt_pk_bf16(0.f, a0) & 0xffff0000u) | (unsigned)ee.x; pk.y = (cvt_pk_bf16(0.f, a1) & 0xffff0000u) | (unsigned)ee.y;
                *reinterpret_cast<u32x2*>(PACKT + ((long)(p0 >> 2) * T + t) * 4 + (p0 & 3)) = pk; }
        }
#undef UP_ROW
#undef UP_IDX
#undef UP_X
#undef UP_DOT
    }
#undef SXI
}
__device__ __forceinline__ void actpass(const float* __restrict__ DOTP, const int* __restrict__ PIDX, const float* __restrict__ PW, const float* __restrict__ SU, const float* __restrict__ SV, float* __restrict__ ACT, int nx, long gt, long nt) {
    for (long i = gt; i < (long)T * 128; i += nt) { float dsum = 0.f;
        for (int x = 0; x < nx; ++x) dsum += DOTP[(long)x * T * 128 + i];
        const int e = PIDX[i]; const float av = PW[i] * gelu_exact(dsum * SU[e]) * SV[e]; const long t = i >> 7; const int pp = (int)(i & 127);
        reinterpret_cast<unsigned*>(ACT)[((long)(pp >> 2) * T + t) * 4 + (pp & 3)] = (cvt_pk_bf16(0.f, av) & 0xffff0000u) | (unsigned)e; }
}
__device__ __forceinline__ void vpass(const unsigned char* __restrict__ PV, const int* __restrict__ PIDX, const float* __restrict__ ACT, float* __restrict__ X, const float* __restrict__ gate, const XInfo xin, int wid, int lane) {
    const int g = lane >> 3, c = lane & 7; const int wv = xin.rank * 8 + wid, nwv = xin.nloc * 8;
    for (int s = xin.xi; s < NSL; s += xin.nx) {
        int4 en[4]; f32x4 an[4];
#pragma unroll
        for (int q4 = 0; q4 < 4; ++q4) { en[q4] = *reinterpret_cast<const int4*>(PIDX + (long)(wv < T ? wv : 0) * 128 + 16 * g + 4 * q4); an[q4] = *reinterpret_cast<const f32x4*>(ACT + (long)(wv < T ? wv : 0) * 128 + 16 * g + 4 * q4); }
        for (int t = wv; t < T; t += nwv) {
            int e[16]; float a[16];
#pragma unroll
            for (int q4 = 0; q4 < 4; ++q4) { e[4 * q4] = en[q4].x; e[4 * q4 + 1] = en[q4].y; e[4 * q4 + 2] = en[q4].z; e[4 * q4 + 3] = en[q4].w; a[4 * q4] = an[q4][0]; a[4 * q4 + 1] = an[q4][1]; a[4 * q4 + 2] = an[q4][2]; a[4 * q4 + 3] = an[q4][3]; }
            u32x4 w[16];
#pragma unroll
            for (int i = 0; i < 16; ++i) w[i] = *reinterpret_cast<const u32x4*>(PV + ((long)s * NEXP + e[i]) * SW + 16 * c);
            { const int tn = (t + nwv < T) ? t + nwv : t;
#pragma unroll
              for (int q4 = 0; q4 < 4; ++q4) { en[q4] = *reinterpret_cast<const int4*>(PIDX + (long)tn * 128 + 16 * g + 4 * q4); an[q4] = *reinterpret_cast<const f32x4*>(ACT + (long)tn * 128 + 16 * g + 4 * q4); } }
            f32x2 o[8];
#pragma unroll
            for (int k = 0; k < 8; ++k) o[k] = (f32x2){0.f, 0.f};
#pragma unroll
            for (int i = 0; i < 16; ++i) { f32x2 f[8]; dec16(w[i], f); const f32x2 a2 = (f32x2){a[i], a[i]};
#pragma unroll
                for (int k = 0; k < 8; ++k) o[k] = __builtin_elementwise_fma(f[k], a2, o[k]); }
            f32x2 r4[4], r2[2], r1;
#pragma unroll
            for (int k = 0; k < 4; ++k) { const f32x2 keep = (g & 4) ? o[k + 4] : o[k], send = (g & 4) ? o[k] : o[k + 4]; r4[k] = keep + (f32x2){sx<32>(send[0]), sx<32>(send[1])}; }
#pragma unroll
            for (int k = 0; k < 2; ++k) { const f32x2 keep = (g & 2) ? r4[k + 2] : r4[k], send = (g & 2) ? r4[k] : r4[k + 2]; r2[k] = keep + (f32x2){sx<16>(send[0]), sx<16>(send[1])}; }
            { const f32x2 keep = (g & 1) ? r2[1] : r2[0], send = (g & 1) ? r2[0] : r2[1]; r1 = keep + (f32x2){sx<8>(send[0]), sx<8>(send[1])}; }
            const int col = SW * s + 16 * c + 2 * g;
            const f32x2 gv = *reinterpret_cast<const f32x2*>(gate + (long)cond_row(t) * 12288 + col);
            float* xp = X + (long)t * DM + col; f32x2 xv = *reinterpret_cast<const f32x2*>(xp);
            xv += gv * r1; *reinterpret_cast<f32x2*>(xp) = xv;
        }
    }
}

__device__ __forceinline__ void vpass_lds(const unsigned char* __restrict__ PV, const unsigned* __restrict__ PACKT, float* __restrict__ X, const float* __restrict__ gate, char* lds, int bid, int nb, int s_end, int tid) {
    const int wid = tid >> 6, lane = tid & 63;
    for (int s = bid; s < s_end; s += nb) {
        __syncthreads();
        { const u32x4* src = reinterpret_cast<const u32x4*>(PV + (long)s * NEXP * 8); u32x4* dst = reinterpret_cast<u32x4*>(lds);
#pragma unroll 4
          for (int i = tid; i < NEXP * 8 / 16; i += 512) dst[i] = src[i]; }
        __syncthreads();
        u32x4 h0[8], h1[8];
        const __amdgpu_buffer_rsrc_t vrs = __builtin_amdgcn_make_buffer_rsrc((void*)PACKT, 0, (int)((size_t)T * 128 * 4), 0x00020000);
#define VP_LD(k, toff) __builtin_bit_cast(u32x4, __builtin_amdgcn_raw_buffer_load_b128(vrs, (int)(toff), (int)((size_t)(k) * T * 16), 0))
        { const unsigned toff = (unsigned)(wid * 64 + lane) * 16u;
#pragma unroll
          for (int k = 0; k < 8; ++k) h0[k] = VP_LD(k, toff);
#pragma unroll
          for (int k = 0; k < 8; ++k) h1[k] = VP_LD(8 + k, toff); }
#define VP_STEP(HB) do { _Pragma("unroll") for (int kk = 0; kk < 8; kk += 2) { unsigned pw[8]; \
            _Pragma("unroll") for (int k = 0; k < 2; ++k) { pw[4 * k] = HB[kk + k].x; pw[4 * k + 1] = HB[kk + k].y; pw[4 * k + 2] = HB[kk + k].z; pw[4 * k + 3] = HB[kk + k].w; } \
            u32x2 w[8]; \
            _Pragma("unroll") for (int k = 0; k < 8; ++k) w[k] = *reinterpret_cast<const u32x2*>(lds + (pw[k] & 0xffffu) * 8u); \
            _Pragma("unroll") for (int k = 0; k < 8; ++k) { const float a = __uint_as_float(pw[k] & 0xffff0000u); \
                const f32x2 f0 = __builtin_amdgcn_cvt_pk_f32_fp8((int)w[k].x, false), f1 = __builtin_amdgcn_cvt_pk_f32_fp8((int)w[k].x, true), f2 = __builtin_amdgcn_cvt_pk_f32_fp8((int)w[k].y, false), f3 = __builtin_amdgcn_cvt_pk_f32_fp8((int)w[k].y, true); \
                acc[0] = fmaf(a, f0[0], acc[0]); acc[1] = fmaf(a, f0[1], acc[1]); acc[2] = fmaf(a, f1[0], acc[2]); acc[3] = fmaf(a, f1[1], acc[3]); \
                acc[4] = fmaf(a, f2[0], acc[4]); acc[5] = fmaf(a, f2[1], acc[5]); acc[6] = fmaf(a, f3[0], acc[6]); acc[7] = fmaf(a, f3[1], acc[7]); } } } while (0)
#pragma unroll 1
        for (int tg = wid; tg < T / 64; tg += 8) { const int t = tg * 64 + lane; const int tgn = (tg + 8 < T / 64) ? tg + 8 : tg;
            const unsigned toff = (unsigned)t * 16u, toffn = (unsigned)(tgn * 64 + lane) * 16u;
            float acc[8];
#pragma unroll
            for (int j = 0; j < 8; ++j) acc[j] = 0.f;
            VP_STEP(h0);
#pragma unroll
            for (int k = 0; k < 8; ++k) h0[k] = VP_LD(16 + k, toff);
            VP_STEP(h1);
#pragma unroll
            for (int k = 0; k < 8; ++k) h1[k] = VP_LD(24 + k, toff);
            VP_STEP(h0);
#pragma unroll
            for (int k = 0; k < 8; ++k) h0[k] = VP_LD(k, toffn);
            VP_STEP(h1);
#pragma unroll
            for (int k = 0; k < 8; ++k) h1[k] = VP_LD(8 + k, toffn);
            const float* gr = gate + (long)cond_row(t) * 12288 + 8 * s; float* xp = X + (long)t * DM + 8 * s;
            const f32x4 g0 = *reinterpret_cast<const f32x4*>(gr), g1 = *reinterpret_cast<const f32x4*>(gr + 4);
            f32x4 x0 = *reinterpret_cast<const f32x4*>(xp), x1 = *reinterpret_cast<const f32x4*>(xp + 4);
            x0[0] += g0[0] * acc[0]; x0[1] += g0[1] * acc[1]; x0[2] += g0[2] * acc[2]; x0[3] += g0[3] * acc[3];
            x1[0] += g1[0] * acc[4]; x1[1] += g1[1] * acc[5]; x1[2] += g1[2] * acc[6]; x1[3] += g1[3] * acc[7];
            *reinterpret_cast<f32x4*>(xp) = x0; *reinterpret_cast<f32x4*>(xp + 4) = x1; }
#undef VP_STEP
#undef VP_LD
    }
    __syncthreads();
}
}
namespace ph {
__device__ __forceinline__ int gwave() { return obid() * 8 + (otid() >> 6); }
__device__ __forceinline__ int nwaves() { return ogrid() * 8; }
__device__ __forceinline__ long gthread() { return (long)obid() * 512 + otid(); }
__device__ __forceinline__ long nthreads() { return (long)ogrid() * 512; }

__device__ __forceinline__ void transpose_tile(const float* __restrict__ src, int C, int r0, int c0, bf16_t* __restrict__ dst, long dpitch, float* tile) {
    const int tid = otid();
#pragma unroll
    for (int i = 0; i < 8; ++i) { const int idx = tid + 512 * i, r = idx >> 6, c = idx & 63; tile[r * 65 + c] = src[(long)(r0 + r) * C + c0 + c]; }
    __syncthreads();
    { const int c = tid >> 3, rc = (tid & 7) * 8; float f[8];
#pragma unroll
      for (int j = 0; j < 8; ++j) f[j] = tile[(rc + j) * 65 + c];
      *reinterpret_cast<u32x4*>(dst + (long)(c0 + c) * dpitch + r0 + rc) = pack8(f); }
    __syncthreads();
}

__device__ __forceinline__ void zero_chunks(bf16_t* base, long nrows, long rowpitch, int col0, int nchunk) {
    const long total = nrows * nchunk;
    for (long i = gthread(); i < total; i += nthreads()) { const long r = i / nchunk; const int ch = (int)(i % nchunk);
        *reinterpret_cast<u32x4*>(base + r * rowpitch + col0 + ch * 8) = (u32x4){0u, 0u, 0u, 0u}; }
}

__device__ __forceinline__ void prologue(KParams& p, char* lds) {
    unsigned char* ws = optr(gp(p.ws)); const int tid = otid();
    float* tile = (float*)lds;
    { struct TJob { const float* src; bf16_t* dst; int R, C, r0, c0, perm; };
      auto decode = [&](int it) { TJob j; j.perm = 0; const int l = it / 10656; int r = it % 10656;
        if (r < 5664) { j.src = gp(p.w_in) + (long)l * DM * INW; j.R = DM; j.C = INW; j.dst = (bf16_t*)(ws + WS_WIN) + (long)l * INWP * DM; }
        else if (r < 6048) { r -= 5664; j.src = gp(p.w_uq) + (long)l * 512 * 3072; j.R = 512; j.C = 3072; j.dst = (bf16_t*)(ws + WS_WUQ) + (long)l * 3072 * 512; j.perm = 1; }
        else if (r < 6560) { r -= 6048; j.src = gp(p.w_ukv) + (long)l * 512 * 4096; j.R = 512; j.C = 4096; j.dst = (bf16_t*)(ws + WS_WUKV) + (long)l * 4096 * 512; }
        else { r -= 6560; const int m = r >> 10; r &= 1023; j.R = DM; j.C = DM;
            j.src = (m == 0 ? gp(p.w_a) : m == 1 ? gp(p.w_b) : m == 2 ? gp(p.w_o) : gp(p.w_pq)) + (long)l * DM * DM;
            j.dst = (bf16_t*)(ws + (m == 0 ? WS_WA : m == 1 ? WS_WB : m == 2 ? WS_WO : WS_WPQ)) + (long)l * DM * DM; }
        const int ntc = j.C / 64; j.r0 = (r / ntc) * 64; j.c0 = (r % ntc) * 64; return j; };
      const int NTILES = 2 * 10656, G_ = ogrid(); int it = obid(); float v[8]; TJob cur{};
      if (it < NTILES) { cur = decode(it);
#pragma unroll
        for (int i = 0; i < 8; ++i) { const int idx = tid + 512 * i, r = idx >> 6, c = idx & 63; v[i] = cur.src[(long)(cur.r0 + r) * cur.C + cur.c0 + c]; } }
      while (it < NTILES) { const int itn = it + G_; float vn[8]; TJob nxt{};
        if (itn < NTILES) { nxt = decode(itn);
#pragma unroll
            for (int i = 0; i < 8; ++i) { const int idx = tid + 512 * i, r = idx >> 6, c = idx & 63; vn[i] = nxt.src[(long)(nxt.r0 + r) * nxt.C + nxt.c0 + c]; } }
#pragma unroll
        for (int i = 0; i < 8; ++i) { const int idx = tid + 512 * i, r = idx >> 6, c = idx & 63; tile[r * 65 + c] = v[i]; }
        __syncthreads();
        { const int c = tid >> 3, rc = (tid & 7) * 8; float f[8];
#pragma unroll
          for (int jj = 0; jj < 8; ++jj) f[jj] = tile[(rc + jj) * 65 + c];
          int drow = cur.c0 + c;
          if (cur.perm) { const int gq = drow / 768, o = drow - 768 * gq, hh = o / 192, w = o - 192 * hh;
              drow = 768 * gq + (w < 128 ? 128 * hh + w : (w < 160 ? 512 + 32 * hh + (w - 128) : 640 + 32 * hh + (w - 160))); }
          *reinterpret_cast<u32x4*>(cur.dst + (long)drow * cur.R + cur.r0 + rc) = pack8(f); }
        __syncthreads();
#pragma unroll
        for (int i = 0; i < 8; ++i) v[i] = vn[i];
        cur = nxt; it = itn; } }
    for (long i = gthread(); i < 2L * 16 * 512 * 32; i += nthreads()) { const int ch = (int)(i & 31); const long row = i >> 5; const int c = (int)(row & 511), h = (int)((row >> 9) & 15), l = (int)(row >> 13);
        u32x4 w = (u32x4){0u, 0u, 0u, 0u};
        if (ch < 16) { const float* s = gp(p.w_ukv) + (((long)l * 512 + c) * 16 + h) * 256 + ch * 8; float f[8];
#pragma unroll
            for (int j = 0; j < 8; ++j) f[j] = s[j];
            w = pack8(f); }
        *reinterpret_cast<u32x4*>((bf16_t*)(ws + WS_WUK) + row * 256 + ch * 8) = w; }
    for (long i = gthread(); i < 2L * 4096; i += nthreads()) { const bool second = i >= 4096; const long j8 = (second ? i - 4096 : i) * 8; const float* s = (second ? gp(p.peer_k2) : gp(p.peer_k1)) + j8; float f[8];
#pragma unroll
        for (int j = 0; j < 8; ++j) f[j] = s[j];
        *reinterpret_cast<u32x4*>((bf16_t*)(ws + (second ? WS_PK2 : WS_PK1)) + j8) = pack8(f); }
    for (int l = 0; l < 2; ++l) zero_chunks((bf16_t*)(ws + WS_WIN) + ((long)l * INWP + INW) * DM, INWP - INW, DM, 0, DM / 8);
    for (int b = 0; b < DB; ++b) zero_chunks((bf16_t*)(ws + WS_CKA) + ((long)b * KPAD + KALL) * QLD, KPAD - KALL, QLD, 0, QLD / 8);
    zero_chunks((bf16_t*)(ws + WS_CKA), (long)DB * KPAD, QLD, 576, 8);
    zero_chunks((bf16_t*)(ws + WS_CKT), (long)DB * 512, KPAD, KALL, (KPAD - KALL) / 8);
    zero_chunks((bf16_t*)(ws + WS_QL), (long)DB * 1024, QLD, 576, 8);
    for (long i = gthread(); i < 4096L * 96; i += nthreads()) { const int pos = (int)(i / 96), k = (int)(i % 96); const bool big = k >= 32; const int fi = big ? k - 32 : k; const float d = big ? 128.f : 64.f;
        const float inv = __builtin_amdgcn_exp2f(-(2.0f * (float)fi / d) * 13.287712379549449f);
        const float ang = (float)pos * inv; double rv = (double)ang * 0.15915494309189535; rv -= floor(rv); const float fr = (float)rv;
        float* dst = big ? (float*)(ws + WS_TAB128) + ((long)pos * 64 + fi) * 2 : (float*)(ws + WS_TAB64) + ((long)pos * 32 + fi) * 2;
        dst[0] = __builtin_amdgcn_cosf(fr); dst[1] = __builtin_amdgcn_sinf(fr); }
    { float* sc = (float*)lds;
      for (int it = obid(); it < 2 * 12 * 8; it += ogrid()) { const int l = it / 96, cc = (it % 96) / 8, ks = it % 8;
        __syncthreads();
        for (int i = tid; i < NCOND * 256; i += 512) { const int r = i >> 8, k = i & 255; const float c = r < NB ? gp(p.c_prompt)[(long)r * DM + ks * 256 + k] : gp(p.c_sample)[(long)(r - NB) * DM + ks * 256 + k]; sc[i] = siluf_(c); }
        __syncthreads();
        float a0[NCOND], a1[NCOND];
#pragma unroll
        for (int r = 0; r < NCOND; ++r) { a0[r] = 0.f; a1[r] = 0.f; }
        const float* wp = gp(p.w_ada) + ((long)l * DM + ks * 256) * 12288 + cc * 1024 + 2 * tid;
#pragma unroll 1
        for (int k = 0; k < 256; k += 4) { const f32x2 w0 = *reinterpret_cast<const f32x2*>(wp), w1 = *reinterpret_cast<const f32x2*>(wp + 12288), w2 = *reinterpret_cast<const f32x2*>(wp + 2 * 12288), w3 = *reinterpret_cast<const f32x2*>(wp + 3 * 12288);
            wp += 4 * 12288;
#pragma unroll
            for (int r = 0; r < NCOND; ++r) { const f32x4 s = *reinterpret_cast<const f32x4*>(sc + r * 256 + k);
                a0[r] = fmaf(s[0], w0[0], fmaf(s[1], w1[0], fmaf(s[2], w2[0], fmaf(s[3], w3[0], a0[r]))));
                a1[r] = fmaf(s[0], w0[1], fmaf(s[1], w1[1], fmaf(s[2], w2[1], fmaf(s[3], w3[1], a1[r]))));
                if ((r % 6) == 5) __builtin_amdgcn_sched_barrier(0); } }
        float* dst = (float*)(ws + WS_ADAP) + (((long)ks * 2 + l) * NCOND) * 12288 + cc * 1024 + 2 * tid;
#pragma unroll
        for (int r = 0; r < NCOND; ++r) *reinterpret_cast<f32x2*>(dst + (long)r * 12288) = (f32x2){a0[r], a1[r]}; }
      __syncthreads(); }
}

__device__ __forceinline__ void wpq_int8(KParams& p) {
    unsigned char* ws = optr(gp(p.ws)); const int lane = otid() & 63;
    for (int r = gwave(); r < 2 * DM; r += nwaves()) { const bf16_t* src = (const bf16_t*)(ws + WS_WPQ) + (long)r * DM; float f[4][8]; float am = 0.f;
#pragma unroll
        for (int j = 0; j < 4; ++j) { unpack8(*reinterpret_cast<const u32x4*>(src + 512 * j + 8 * lane), f[j]);
#pragma unroll
            for (int i = 0; i < 8; ++i) am = fmaxf(am, fabsf(f[j][i])); }
        am = wave_max(am); const float qs = am > 0.f ? 127.0f / am : 0.f;
#pragma unroll
        for (int j = 0; j < 4; ++j) { unsigned w2[2];
#pragma unroll
            for (int hh = 0; hh < 2; ++hh) { unsigned w = 0u;
#pragma unroll
                for (int i = 0; i < 4; ++i) w |= ((unsigned)((int)__builtin_rintf(f[j][4 * hh + i] * qs) & 0xff)) << (8 * i);
                w2[hh] = w; }
            *reinterpret_cast<u32x2*>(ws + WS_WPQ8 + (long)r * DM + 512 * j + 8 * lane) = (u32x2){w2[0], w2[1]}; }
        if (lane == 0) ((float*)(ws + WS_SB8))[r] = am * (1.0f / 127.0f); }
}

__device__ __forceinline__ void rows2048_int8(KParams& p, size_t src_off, size_t dst_off, size_t sc_off, int nrows) {
    unsigned char* ws = optr(gp(p.ws)); const int lane = otid() & 63;
    for (int r = gwave(); r < nrows; r += nwaves()) { const bf16_t* src = (const bf16_t*)(ws + src_off) + (long)r * DM; float f[4][8]; float am = 0.f;
#pragma unroll
        for (int j = 0; j < 4; ++j) { unpack8(*reinterpret_cast<const u32x4*>(src + 512 * j + 8 * lane), f[j]);
#pragma unroll
            for (int i = 0; i < 8; ++i) am = fmaxf(am, fabsf(f[j][i])); }
        am = wave_max(am); const float qs = am > 0.f ? 127.0f / am : 0.f;
#pragma unroll
        for (int j = 0; j < 4; ++j) { unsigned w2[2];
#pragma unroll
            for (int hh = 0; hh < 2; ++hh) { unsigned w = 0u;
#pragma unroll
                for (int i = 0; i < 4; ++i) w |= ((unsigned)((int)__builtin_rintf(f[j][4 * hh + i] * qs) & 0xff)) << (8 * i);
                w2[hh] = w; }
            *reinterpret_cast<u32x2*>(ws + dst_off + (long)r * DM + 512 * j + 8 * lane) = (u32x2){w2[0], w2[1]}; }
        if (lane == 0) ((float*)(ws + sc_off))[r] = am * (1.0f / 127.0f); }
}
__device__ __forceinline__ void wb_int8(KParams& p, int l) {
    unsigned char* ws = optr(gp(p.ws)); const int lane = otid() & 63;
    for (int r = gwave(); r < DM; r += nwaves()) { const bf16_t* src = (const bf16_t*)(ws + WS_WB) + ((long)l * DM + r) * DM; float f[4][8]; float am = 0.f;
#pragma unroll
        for (int j = 0; j < 4; ++j) { unpack8(*reinterpret_cast<const u32x4*>(src + 512 * j + 8 * lane), f[j]);
#pragma unroll
            for (int i = 0; i < 8; ++i) am = fmaxf(am, fabsf(f[j][i])); }
        am = wave_max(am); const float qs = am > 0.f ? 127.0f / am : 0.f;
#pragma unroll
        for (int j = 0; j < 4; ++j) { unsigned w2[2];
#pragma unroll
            for (int hh = 0; hh < 2; ++hh) { unsigned w = 0u;
#pragma unroll
                for (int i = 0; i < 4; ++i) w |= ((unsigned)((int)__builtin_rintf(f[j][4 * hh + i] * qs) & 0xff)) << (8 * i);
                w2[hh] = w; }
            *reinterpret_cast<u32x2*>(ws + WS_WB8 + (long)r * DM + 512 * j + 8 * lane) = (u32x2){w2[0], w2[1]}; }
        if (lane == 0) ((float*)(ws + WS_SBB))[r] = am * (1.0f / 127.0f); }
}

__device__ __forceinline__ void win_int8(KParams& p, int l) {
    unsigned char* ws = optr(gp(p.ws)); const int lane = otid() & 63;
    for (int jr = gwave(); jr < NB8 * 256; jr += nwaves()) { const int blk = jr >> 8, n = (blk < 2 ? blk : (blk < 5 ? blk + 3 : blk + 7)) * 256 + (jr & 255);
        const bf16_t* src = (const bf16_t*)(ws + WS_WIN) + ((long)l * INWP + n) * DM; float f[4][8]; float am = 0.f;
#pragma unroll
        for (int j = 0; j < 4; ++j) { unpack8(*reinterpret_cast<const u32x4*>(src + 512 * j + 8 * lane), f[j]);
#pragma unroll
            for (int i = 0; i < 8; ++i) am = fmaxf(am, fabsf(f[j][i])); }
        am = wave_max(am); const float qs = am > 0.f ? 127.0f / am : 0.f;
#pragma unroll
        for (int j = 0; j < 4; ++j) { unsigned w2[2];
#pragma unroll
            for (int hh = 0; hh < 2; ++hh) { unsigned w = 0u;
#pragma unroll
                for (int i = 0; i < 4; ++i) w |= ((unsigned)((int)__builtin_rintf(f[j][4 * hh + i] * qs) & 0xff)) << (8 * i);
                w2[hh] = w; }
            *reinterpret_cast<u32x2*>(ws + WS_WIN8 + (long)jr * DM + 512 * j + 8 * lane) = (u32x2){w2[0], w2[1]}; }
        if (lane == 0) ((float*)(ws + WS_SBW))[n] = am * (1.0f / 127.0f); }
}

__device__ __forceinline__ void ada_reduce(KParams& p) {
    unsigned char* ws = optr(gp(p.ws)); const float* ap = (const float*)(ws + WS_ADAP); float* ad = (float*)(ws + WS_ADA); const long n = 2L * NCOND * 12288;
    for (long i = gthread(); i < n; i += nthreads()) { const int l = (int)(i / (NCOND * 12288L)); const int j = (int)(i % 12288);
        float s = gp(p.b_ada)[(long)l * 12288 + j];
#pragma unroll
        for (int ks = 0; ks < 8; ++ks) s += ap[(long)ks * n + i];
        ad[i] = s; }
}

__device__ __forceinline__ void modulate(KParams& p, int l, int which) {
    const int lane = otid() & 63; unsigned char* ws = optr(gp(p.ws)); const float* X = gp(p.out); bf16_t* H = (bf16_t*)(ws + WS_H);
    const float* g = (which ? gp(p.g_ffn) : gp(p.g_mix)) + (long)l * DM; const float* ada = (const float*)(ws + WS_ADA) + (long)l * NCOND * 12288 + (which ? 3 : 0) * DM;
    for (int t = gwave(); t < T; t += nwaves()) {
        const float* xr = (l == 0 && which == 0) ? (t < TP ? gp(p.x_prompt) + (long)t * DM : gp(p.x_sample) + (long)(t - TP) * DM) : X + (long)t * DM; f32x4 v[8]; float ss = 0.f;
#pragma unroll
        for (int j = 0; j < 8; ++j) { v[j] = *reinterpret_cast<const f32x4*>(xr + 256 * j + 4 * lane); ss += v[j][0] * v[j][0] + v[j][1] * v[j][1] + v[j][2] * v[j][2] + v[j][3] * v[j][3]; }
        ss = wave_sum(ss); const float rinv = rsqrtf(ss * (1.0f / DM) + EPS);
        const float* sh = ada + (long)cond_row(t) * 12288; const float* sc = sh + DM;
#pragma unroll
        for (int j = 0; j < 8; ++j) { const int c = 256 * j + 4 * lane; const f32x4 gv = *reinterpret_cast<const f32x4*>(g + c), sv = *reinterpret_cast<const f32x4*>(sc + c), hv = *reinterpret_cast<const f32x4*>(sh + c);
            const f32x4 y = v[j] * rinv * gv * (sv + 1.0f) + hv; u32x2 w; w.x = cvt_pk_bf16(y[0], y[1]); w.y = cvt_pk_bf16(y[2], y[3]);
            if (!which) *reinterpret_cast<u32x2*>(H + (long)t * DM + c) = w;
            v[j] = y; }
        {
            float am = 0.f;
#pragma unroll
            for (int j = 0; j < 8; ++j) am = fmaxf(am, fmaxf(fmaxf(fabsf(v[j][0]), fabsf(v[j][1])), fmaxf(fabsf(v[j][2]), fabsf(v[j][3]))));
            am = wave_max(am); const float qs = am > 0.f ? 127.0f / am : 0.f;
#pragma unroll
            for (int j = 0; j < 8; ++j) { const int c = 256 * j + 4 * lane;
                const int q0 = (int)__builtin_rintf(v[j][0] * qs), q1 = (int)__builtin_rintf(v[j][1] * qs), q2 = (int)__builtin_rintf(v[j][2] * qs), q3 = (int)__builtin_rintf(v[j][3] * qs);
                *reinterpret_cast<unsigned*>(ws + WS_H8 + (long)t * DM + c) = (unsigned)(q0 & 0xff) | ((unsigned)(q1 & 0xff) << 8) | ((unsigned)(q2 & 0xff) << 16) | ((unsigned)(q3 & 0xff) << 24); }
            if (lane == 0) ((float*)(ws + WS_SA8))[t] = am * (1.0f / 127.0f); }
    }
}

__device__ __forceinline__ void cache_convert(KParams& p, int l, char* lds, int it0, int it1, int bidx, int nb) {
    const int tid = otid(); unsigned char* ws = optr(gp(p.ws)); float* tile = (float*)lds; bf16_t* CKA = (bf16_t*)(ws + WS_CKA); bf16_t* CKT = (bf16_t*)(ws + WS_CKT);
    { const int NT_ = it1, G_ = nb; int it = it0 + bidx; float v[8];
      const float* cbase = gp(p.cache_ckv) + (long)l * DB * PAST * 512;
#define CC_SRC(itx) (cbase + (((long)((itx) >> 8)) * PAST + (((itx) >> 3) & 31) * 64) * 512 + ((itx) & 7) * 64)
      if (it < NT_) { const float* src = CC_SRC(it);
#pragma unroll
        for (int i = 0; i < 8; ++i) { const int idx = tid + 512 * i, r = idx >> 6, c = idx & 63; v[i] = src[(long)r * 512 + c]; } }
      while (it < NT_) { const int b = it >> 8, kt = (it >> 3) & 31, ct = it & 7; const int itn = it + G_; float vn[8];
        if (itn < NT_) { const float* src = CC_SRC(itn);
#pragma unroll
            for (int i = 0; i < 8; ++i) { const int idx = tid + 512 * i, r = idx >> 6, c = idx & 63; vn[i] = src[(long)r * 512 + c]; } }
#pragma unroll
        for (int i = 0; i < 8; ++i) { const int idx = tid + 512 * i, r = idx >> 6, c = idx & 63; tile[r * 65 + c] = v[i]; }
        __syncthreads();
        { const int r = tid >> 3, cc = (tid & 7) * 8; float f[8];
#pragma unroll
          for (int j = 0; j < 8; ++j) f[j] = tile[r * 65 + cc + j];
          *reinterpret_cast<u32x4*>(CKA + ((long)b * KPAD + kt * 64 + r) * QLD + ct * 64 + cc) = pack8(f);
#pragma unroll
          for (int j = 0; j < 8; ++j) f[j] = tile[(cc + j) * 65 + r];
          *reinterpret_cast<u32x4*>(CKT + ((long)b * 512 + ct * 64 + r) * KPAD + kt * 64 + cc) = pack8(f); }
        __syncthreads();
#pragma unroll
        for (int i = 0; i < 8; ++i) v[i] = vn[i];
        it = itn; }
#undef CC_SRC
    }
    for (long i = (long)it0 * 64 + (long)bidx * 512 + tid; i < (long)it1 * 64; i += (long)nb * 512) { const long row = i >> 3; const int ch = (int)(i & 7); const int b = (int)(row >> 11), k = (int)(row & 2047);
        const float* s = gp(p.cache_krope) + (((long)l * DB + b) * PAST + k) * 64 + ch * 8; float f[8];
#pragma unroll
        for (int j = 0; j < 8; ++j) f[j] = s[j];
        *reinterpret_cast<u32x4*>(CKA + ((long)b * KPAD + k) * QLD + 512 + ch * 8) = pack8(f); }
}

__device__ __forceinline__ void quant_row8(const float (&o)[8], unsigned char* dst, float* sc, int lane) {
    float am = 0.f;
#pragma unroll
    for (int j = 0; j < 8; ++j) am = fmaxf(am, fabsf(o[j]));
    am = wave_max(am); const float qs = am > 0.f ? 127.0f / am : 0.f; unsigned w2[2];
#pragma unroll
    for (int hh = 0; hh < 2; ++hh) { unsigned w = 0u;
#pragma unroll
        for (int i = 0; i < 4; ++i) w |= ((unsigned)((int)__builtin_rintf(o[4 * hh + i] * qs) & 0xff)) << (8 * i);
        w2[hh] = w; }
    *reinterpret_cast<u32x2*>(dst) = (u32x2){w2[0], w2[1]};
    if (lane == 0) *sc = am * (1.0f / 127.0f);
}
__device__ __forceinline__ void wu_int8(KParams& p, int l) {
    unsigned char* ws = optr(gp(p.ws)); const int lane = otid() & 63;
    for (int r = gwave(); r < 3072 + 4096; r += nwaves()) { const bool kv = r >= 3072; const int rr = kv ? r - 3072 : r;
        const bf16_t* src = kv ? (const bf16_t*)(ws + WS_WUKV) + ((long)l * 4096 + rr) * 512 : (const bf16_t*)(ws + WS_WUQ) + ((long)l * 3072 + rr) * 512;
        float f[8]; unpack8(*reinterpret_cast<const u32x4*>(src + 8 * lane), f);
        quant_row8(f, ws + (kv ? WS_WUKV8 : WS_WUQ8) + (long)rr * 512 + 8 * lane, (float*)(ws + (kv ? WS_SBK : WS_SBQ)) + rr, lane); }
}

__device__ __forceinline__ void post_win(KParams& p, int l) {
    const int lane = otid() & 63; unsigned char* ws = optr(gp(p.ws));
    bf16_t* Y = (bf16_t*)(ws + WS_Y); bf16_t* CQN = (bf16_t*)(ws + WS_CQN); bf16_t* CKVNP = (bf16_t*)(ws + WS_CKVNP); bf16_t* KRP = (bf16_t*)(ws + WS_KRP); bf16_t* CKA = (bf16_t*)(ws + WS_CKA); bf16_t* CKT = (bf16_t*)(ws + WS_CKT);
    const float* T64 = (const float*)(ws + WS_TAB64); const float* T128 = (const float*)(ws + WS_TAB128);
    for (int t = gwave(); t < T; t += nwaves()) {
        bf16_t* y = Y + (long)t * INWP; const int pos = tok_pos(t); const bool samp = t >= TP; const int ts = t - TP, b = ts >> 6, s = ts & 63;
        { float f[8], o[8]; unpack8(*reinterpret_cast<const u32x4*>(y + C_CQ + 8 * lane), f); float ss = 0.f;
#pragma unroll
          for (int j = 0; j < 8; ++j) ss += f[j] * f[j];
          ss = wave_sum(ss); const float rinv = rsqrtf(ss * (1.0f / 512.f) + EPS); const float* g = gp(p.g_q) + (long)l * 512 + 8 * lane;
#pragma unroll
          for (int j = 0; j < 8; ++j) o[j] = f[j] * rinv * g[j];
          quant_row8(o, (unsigned char*)CQN + (long)t * 512 + 8 * lane, (float*)(ws + WS_SAQ) + t, lane); }
        { float f[8], o[8]; unpack8(*reinterpret_cast<const u32x4*>(y + C_CKV + 8 * lane), f); float ss = 0.f;
#pragma unroll
          for (int j = 0; j < 8; ++j) ss += f[j] * f[j];
          ss = wave_sum(ss); const float rinv = rsqrtf(ss * (1.0f / 512.f) + EPS); const float* g = gp(p.g_kv) + (long)l * 512 + 8 * lane;
#pragma unroll
          for (int j = 0; j < 8; ++j) o[j] = f[j] * rinv * g[j];
          float* od = gp(p.out) + (samp ? O_CKVS + ((long)l * TS + ts) * 512 : O_CKVP + ((long)l * TP + t) * 512) + 8 * lane;
          *reinterpret_cast<f32x4*>(od) = (f32x4){o[0], o[1], o[2], o[3]}; *reinterpret_cast<f32x4*>(od + 4) = (f32x4){o[4], o[5], o[6], o[7]};
          const u32x4 w = pack8(o);
          if (!samp) quant_row8(o, (unsigned char*)CKVNP + (long)t * 512 + 8 * lane, (float*)(ws + WS_SAK) + t, lane);
          else { *reinterpret_cast<u32x4*>(CKA + ((long)b * KPAD + PAST + s) * QLD + 8 * lane) = w;
#pragma unroll
              for (int j = 0; j < 8; ++j) CKT[((long)b * 512 + 8 * lane + j) * KPAD + PAST + s] = f2bf(o[j]); } }
        if (lane < 32) { const float x1 = bf2f(y[C_KR + lane]), x2 = bf2f(y[C_KR + 32 + lane]); const float c = T64[((long)pos * 32 + lane) * 2], sn = T64[((long)pos * 32 + lane) * 2 + 1];
            const float o1 = x1 * c - x2 * sn, o2 = x1 * sn + x2 * c;
            float* od = gp(p.out) + (samp ? O_KRS + ((long)l * TS + ts) * 64 : O_KRP + ((long)l * TP + t) * 64); od[lane] = o1; od[32 + lane] = o2;
            if (!samp) { KRP[(long)t * 64 + lane] = f2bf(o1); KRP[(long)t * 64 + 32 + lane] = f2bf(o2); }
            else { bf16_t* d = CKA + ((long)b * KPAD + PAST + s) * QLD + 512; d[lane] = f2bf(o1); d[32 + lane] = f2bf(o2); } }
        { const int hh = lane >> 3, d0 = (lane & 7) * 8; const float* cs = T128 + ((long)pos * 64 + d0) * 2; float cv[8], sv[8];
#pragma unroll
          for (int j = 0; j < 4; ++j) { const f32x4 q = *reinterpret_cast<const f32x4*>(cs + 4 * j); cv[2 * j] = q[0]; sv[2 * j] = q[1]; cv[2 * j + 1] = q[2]; sv[2 * j + 1] = q[3]; }
#pragma unroll
          for (int which = 0; which < 2; ++which) { bf16_t* base = y + (which ? C_RK : C_RQ) + hh * 128 + d0; const float sca = which ? 0.08838834764831845f : 1.0f;
              float a[8], bq[8], o1[8], o2[8]; unpack8(*reinterpret_cast<const u32x4*>(base), a); unpack8(*reinterpret_cast<const u32x4*>(base + 64), bq);
#pragma unroll
              for (int j = 0; j < 8; ++j) { o1[j] = (a[j] * cv[j] - bq[j] * sv[j]) * sca; o2[j] = (a[j] * sv[j] + bq[j] * cv[j]) * sca; }
              *reinterpret_cast<u32x4*>(base) = pack8(o1); *reinterpret_cast<u32x4*>(base + 64) = pack8(o2); } }
    }
}

__device__ __forceinline__ void post_q(KParams& p) {
    const int lane = otid() & 63; unsigned char* ws = optr(gp(p.ws)); bf16_t* Q = (bf16_t*)(ws + WS_Q); bf16_t* QL = (bf16_t*)(ws + WS_QL); const float* T64 = (const float*)(ws + WS_TAB64);
    for (int t = gwave(); t < T; t += nwaves()) { const int pos = tok_pos(t); const int hd = lane >> 2, d0 = (lane & 3) * 8;
        bf16_t* base = Q + (long)t * 3072 + hd * 192 + 128 + d0; const float* cs = T64 + ((long)pos * 32 + d0) * 2; float cv[8], sv[8];
#pragma unroll
        for (int j = 0; j < 4; ++j) { const f32x4 q = *reinterpret_cast<const f32x4*>(cs + 4 * j); cv[2 * j] = q[0]; sv[2 * j] = q[1]; cv[2 * j + 1] = q[2]; sv[2 * j + 1] = q[3]; }
        float a[8], bq[8], o1[8], o2[8]; unpack8(*reinterpret_cast<const u32x4*>(base), a); unpack8(*reinterpret_cast<const u32x4*>(base + 32), bq);
#pragma unroll
        for (int j = 0; j < 8; ++j) { o1[j] = a[j] * cv[j] - bq[j] * sv[j]; o2[j] = a[j] * sv[j] + bq[j] * cv[j]; }
        const u32x4 w1 = pack8(o1), w2 = pack8(o2);
        *reinterpret_cast<u32x4*>(base) = w1; *reinterpret_cast<u32x4*>(base + 32) = w2;
        if (t >= TP) { const int ts = t - TP, b = ts >> 6, s = ts & 63; bf16_t* d = QL + ((long)b * 1024 + hd * 64 + s) * QLD + 512 + d0;
            *reinterpret_cast<u32x4*>(d) = w1; *reinterpret_cast<u32x4*>(d + 32) = w2; } }
}

__device__ __forceinline__ void softmax_rows(KParams& p) {
    const int lane = otid() & 63; unsigned char* ws = optr(gp(p.ws)); bf16_t* SP = (bf16_t*)(ws + WS_SP);
    for (int r = gwave(); r < DB * 1024; r += nwaves()) { bf16_t* row = SP + (long)r * KPAD; float v[5][8]; float mx = -3.0e38f;
#pragma unroll
        for (int j = 0; j < 5; ++j) { const int ch = lane + 64 * j;
            if (ch < KALL / 8) { unpack8(*reinterpret_cast<const u32x4*>(row + ch * 8), v[j]);
#pragma unroll
                for (int i = 0; i < 8; ++i) { v[j][i] *= MLA_SCALE; mx = fmaxf(mx, v[j][i]); } }
            else {
#pragma unroll
                for (int i = 0; i < 8; ++i) v[j][i] = -3.0e38f; } }
        mx = wave_max(mx); float sum = 0.f;
#pragma unroll
        for (int j = 0; j < 5; ++j) { const int ch = lane + 64 * j;
#pragma unroll
            for (int i = 0; i < 8; ++i) { v[j][i] = (ch < KALL / 8) ? __expf(v[j][i] - mx) : 0.f; sum += v[j][i]; } }
        sum = wave_sum(sum); const float inv = 1.0f / sum;
#pragma unroll
        for (int j = 0; j < 5; ++j) { const int ch = lane + 64 * j;
            if (ch < KPAD / 8) { float o[8];
#pragma unroll
                for (int i = 0; i < 8; ++i) o[i] = v[j][i] * inv;
                *reinterpret_cast<u32x4*>(row + ch * 8) = pack8(o); } } }
}

__device__ __forceinline__ void gnorm_gate(KParams& p, int w0, int nw) {
    const int lane = otid() & 63; unsigned char* ws = optr(gp(p.ws)); const bf16_t* OB = (const bf16_t*)(ws + WS_OB); const bf16_t* Y = (const bf16_t*)(ws + WS_Y);
    for (int t = w0; t < T; t += nw) { const int c0 = (lane >> 3) * 256 + (lane & 7) * 32; float x[4][8]; float s = 0.f;
#pragma unroll
        for (int i = 0; i < 4; ++i) { unpack8(*reinterpret_cast<const u32x4*>(OB + ((long)lane * T + t) * 32 + 8 * i), x[i]);
#pragma unroll
            for (int j = 0; j < 8; ++j) s += x[i][j]; }
        s += sx<1>(s); s += sx<2>(s); s += sx<4>(s); const float mu = s * (1.0f / 256.f); float q = 0.f;
#pragma unroll
        for (int i = 0; i < 4; ++i)
#pragma unroll
            for (int j = 0; j < 8; ++j) { const float d = x[i][j] - mu; q += d * d; }
        q += sx<1>(q); q += sx<2>(q); q += sx<4>(q); const float rstd = rsqrtf(q * (1.0f / 256.f) + EPS);
        float am = 0.f;
#pragma unroll
        for (int i = 0; i < 4; ++i) { float g[8]; unpack8(*reinterpret_cast<const u32x4*>(Y + (long)t * INWP + C_RG + c0 + 8 * i), g);
#pragma unroll
            for (int j = 0; j < 8; ++j) { x[i][j] = siluf_(g[j]) * (x[i][j] - mu) * rstd; am = fmaxf(am, fabsf(x[i][j])); } }
        am = wave_max(am); const float qs = am > 0.f ? 127.0f / am : 0.f; unsigned w[8];
#pragma unroll
        for (int i = 0; i < 4; ++i)
#pragma unroll
            for (int hh = 0; hh < 2; ++hh) { unsigned v = 0u;
#pragma unroll
                for (int j = 0; j < 4; ++j) v |= ((unsigned)((int)__builtin_rintf(x[i][4 * hh + j] * qs) & 0xff)) << (8 * j);
                w[2 * i + hh] = v; }
        *reinterpret_cast<u32x4*>(ws + WS_BG + (long)t * DM + c0) = (u32x4){w[0], w[1], w[2], w[3]};
        *reinterpret_cast<u32x4*>(ws + WS_BG + (long)t * DM + c0 + 16) = (u32x4){w[4], w[5], w[6], w[7]};
        if (lane == 0) ((float*)(ws + WS_SA8))[t] = am * (1.0f / 127.0f); }
}

__device__ __forceinline__ void peer_convert(KParams& p, int l, int r0, int r1, int w0, int nw) {
    unsigned char* ws = optr(gp(p.ws)); const int lane = otid() & 63;
    const float* su = gp(p.peer_u) + (long)l * NEXP * DM; const float* sv = gp(p.peer_v) + (long)l * NEXP * DM;
    for (int r = r0 + w0; r < r1; r += nw) { const bool second = r >= NEXP; const int row = second ? r - NEXP : r; const float* s = (second ? sv : su) + (long)row * DM;
        f32x4 v[8]; float am = 0.f;
#pragma unroll
        for (int j = 0; j < 8; ++j) { v[j] = *reinterpret_cast<const f32x4*>(s + 512 * (j >> 2) * 2 + 16 * lane + 4 * (j & 3));
            am = fmaxf(am, fmaxf(fmaxf(fabsf(v[j][0]), fabsf(v[j][1])), fmaxf(fabsf(v[j][2]), fabsf(v[j][3])))); }
        am = wave_max(am);
        float sc = 1.0f, isc = 1.0f;
        if (am > 0.f) { const int e = (int)((__float_as_uint(am) >> 23) & 0xffu) - 127;
            int k = 7 - e; k = k > 100 ? 100 : (k < -100 ? -100 : k);
            sc = __uint_as_float((unsigned)(127 + k) << 23); isc = __uint_as_float((unsigned)(127 - k) << 23); }
        unsigned w[8];
        if (!second) {
            const float qs = am > 0.f ? 127.0f / am : 0.f; isc = am * (1.0f / 127.0f);
#pragma unroll
            for (int j = 0; j < 8; ++j) w[j] = ((unsigned)((int)__builtin_rintf(v[j][0] * qs) & 0xff)) | (((unsigned)((int)__builtin_rintf(v[j][1] * qs) & 0xff)) << 8) | (((unsigned)((int)__builtin_rintf(v[j][2] * qs) & 0xff)) << 16) | (((unsigned)((int)__builtin_rintf(v[j][3] * qs) & 0xff)) << 24);
        } else {
#pragma unroll
            for (int j = 0; j < 8; ++j) { int pk = __builtin_amdgcn_cvt_pk_fp8_f32(v[j][0] * sc, v[j][1] * sc, 0, false); pk = __builtin_amdgcn_cvt_pk_fp8_f32(v[j][2] * sc, v[j][3] * sc, pk, true); w[j] = (unsigned)pk; } }
        if (!second) {
            unsigned char* dst = ws + WS_PU + ((long)(lane >> 3) * NEXP + row) * 128 + 16 * (lane & 7);
            *reinterpret_cast<u32x4*>(dst) = (u32x4){w[0], w[1], w[2], w[3]};
            *reinterpret_cast<u32x4*>(dst + 8L * NEXP * 128) = (u32x4){w[4], w[5], w[6], w[7]};
        } else {
            unsigned char* dst = ws + WS_PV + ((long)(2 * lane) * NEXP + row) * 8;
            *reinterpret_cast<u32x2*>(dst) = (u32x2){w[0], w[1]}; *reinterpret_cast<u32x2*>(dst + (long)NEXP * 8) = (u32x2){w[2], w[3]};
            *reinterpret_cast<u32x2*>(dst + 128L * NEXP * 8) = (u32x2){w[4], w[5]}; *reinterpret_cast<u32x2*>(dst + 129L * NEXP * 8) = (u32x2){w[6], w[7]}; }
        if (lane == 0) ((float*)(ws + (second ? WS_PSV : WS_PSU)))[row] = isc; }
}

__device__ __forceinline__ void final_norm(KParams& p) {
    const int lane = otid() & 63; float* X = gp(p.out);
    for (int t = gwave(); t < T; t += nwaves()) { float* xr = X + (long)t * DM; f32x4 v[8]; float ss = 0.f;
#pragma unroll
        for (int j = 0; j < 8; ++j) { v[j] = *reinterpret_cast<const f32x4*>(xr + 256 * j + 4 * lane); ss += v[j][0] * v[j][0] + v[j][1] * v[j][1] + v[j][2] * v[j][2] + v[j][3] * v[j][3]; }
        ss = wave_sum(ss); const float rinv = rsqrtf(ss * (1.0f / DM) + EPS);
#pragma unroll
        for (int j = 0; j < 8; ++j) { const int c = 256 * j + 4 * lane; const f32x4 gv = *reinterpret_cast<const f32x4*>(gp(p.g_final) + c); *reinterpret_cast<f32x4*>(xr + c) = v[j] * rinv * gv; } }
}
}
__global__ void __launch_bounds__(512, 2) mega_fwd(Params p_by_value_unused) {
    extern __shared__ __attribute__((aligned(16))) unsigned char shm[];
    LAS unsigned char* lds = (LAS unsigned char*)shm; char* ldsg = (char*)shm;
    if (threadIdx.x < 8) ((LAS unsigned*)(lds + LDS_BARW))[threadIdx.x] = 0u;
    __syncthreads();
    if (threadIdx.x == 0) { unsigned* tk = (unsigned*)(gp(KP.ws) + WS_CTL + CTL_RANK) + 64 * xb_xcc_id(); ((volatile LAS unsigned*)(lds + LDS_BARW))[2] = xb_add(tk, 1u); }
    const XcdBarrier bar = xcd_barrier_post((unsigned*)(gp(KP.ws) + WS_CTL), (volatile LAS unsigned*)(lds + LDS_BARW));
#define GRID_SYNC() xcd_barrier(bar)
#ifndef STOP_AT
#define STOP_AT 0
#endif
#ifdef DBG_DUMP
#define STOPCHK(n) do { if (STOP_AT == (n)) { float* xo = gp(KP.out); const bf16_t* src = (const bf16_t*)(gp(KP.ws) + DBG_DUMP); for (long i = ph::gthread(); i < (long)T * DM; i += ph::nthreads()) xo[i] = bf2f(src[i]); return; } } while (0)
#elif defined(DBG_SANITIZE)
#define STOPCHK(n) do { if (STOP_AT == (n) || (STOP_AT > 100 && l == 1 && STOP_AT - 100 == (n))) { float* xo = gp(KP.out); for (long i = ph::gthread(); i < (long)T * DM; i += ph::nthreads()) { const float v = xo[i]; if (!(v - v == 0.0f)) xo[i] = 7.0f; } return; } } while (0)
#else
#define STOPCHK(n) do { if (STOP_AT == (n) || (STOP_AT > 100 && l == 1 && STOP_AT - 100 == (n))) return; } while (0)
#endif
    using namespace pg8;
#define WSP(off) ((bf16_t*)(optr(gp(KP.ws)) + (off)))
#define H WSP(WS_H)
#define Y WSP(WS_Y)
#define CQN WSP(WS_CQN)
#define CKVNP WSP(WS_CKVNP)
#define KRP WSP(WS_KRP)
#define Q WSP(WS_Q)
#define YA WSP(WS_YA)
#define KV WSP(WS_KV)
#define SP WSP(WS_SP)
#define MIX WSP(WS_MIX)
#define OA WSP(WS_OA)
#define QP WSP(WS_QP)
#define CKA WSP(WS_CKA)
#define CKT WSP(WS_CKT)
#define QL WSP(WS_QL)
#define OL WSP(WS_OL)
#define BG WSP(WS_BG)
    int l = 0;
    ph::prologue(KP, ldsg);
#ifdef DUP_PRO
    ph::prologue(KP, ldsg);
#endif
    GRID_SYNC(); STOPCHK(1);
    if (threadIdx.x == 0) { unsigned* barw = (unsigned*)(gp(KP.ws) + WS_CTL); const unsigned me = xb_xcc_id(); unsigned nx = 0, xi = 0, nloc = 1;
        for (unsigned j = 0; j < 16; ++j) { const unsigned cn = xb_ld(&barw[XB_XCNT(j)]); if (cn) { if (j < me) ++xi; ++nx; } if (j == me) nloc = cn ? cn : 1u; }
        volatile LAS unsigned* iw = (volatile LAS unsigned*)(lds + LDS_BARW); iw[3] = xi; iw[4] = nx; iw[5] = nloc; }
    __syncthreads();
    ph::ada_reduce(KP);
    ph::wpq_int8(KP);
    GRID_SYNC(); STOPCHK(2);
    for (l = 0; l < DEPTH; ++l) {
#define WIN (WSP(WS_WIN) + (long)l * INWP * DM)
#define WUQ (WSP(WS_WUQ) + (long)l * 3072 * 512)
#define WUKV (WSP(WS_WUKV) + (long)l * 4096 * 512)
#define WUK (WSP(WS_WUK) + (long)l * 16 * 512 * 256)
#define WA (WSP(WS_WA) + (long)l * DM * DM)
#define WB (WSP(WS_WB) + (long)l * DM * DM)
#define WO (WSP(WS_WO) + (long)l * DM * DM)
#define WPQ (WSP(WS_WPQ) + (long)l * DM * DM)
#define ADA ((const float*)(optr(gp(KP.ws)) + WS_ADA) + (long)l * NCOND * 12288)
        ph::modulate(KP, l, 0);
        ph::win_int8(KP, l);
        ph::wb_int8(KP, l);
        ph::wu_int8(KP, l);
        ph::rows2048_int8(KP, WS_WA + (size_t)l * DM * DM * 2, WS_WA8, WS_SBA, DM);
        ph::rows2048_int8(KP, WS_WO + (size_t)l * DM * DM * 2, WS_WO8, WS_SBO, DM);
        ph::cache_convert(KP, l, ldsg, l == 0 ? 0 : 4096, 8192, obid(), ogrid());
        GRID_SYNC(); STOPCHK(3);
        { Sched<5> S; S.init(T / 256, INWP / 256 - NB8, (T / 256) * (INWP / 256 - NB8), DM, DM); gemm_phase(lds, Gemm{H, WIN, DM, DM, DM}, S, EpiBf16{Y, INWP, 0}); }
        { Sched<6> S; S.init(T / 256, NB8, (T / 256) * NB8, DM / 2, DM / 2);
          { const int G_ = ogrid(); S.rotate((((((T / 256) * NB8) % G_) + 7) & ~7) % G_); }
          unsigned char* ws8 = optr(gp(KP.ws));
          gemm_phase<EpiQ8, Sched<6>, true>(lds, Gemm{(const bf16_t*)(ws8 + WS_H8), (const bf16_t*)(ws8 + WS_WIN8), DM / 2, DM / 2, DM / 2}, S, EpiQ8{Y, INWP, (const float*)(ws8 + WS_SA8), (const float*)(ws8 + WS_SBW)}); }
#ifdef DUP_WIN
        { Sched<0> S; S.init(T / 256, INWP / 256, (T / 256) * (INWP / 256), DM, DM); gemm_phase(lds, Gemm{H, WIN, DM, DM, DM}, S, EpiBf16{Y, INWP, 0}); }
#endif
        GRID_SYNC(); STOPCHK(4);
        ph::post_win(KP, l);
        GRID_SYNC(); STOPCHK(5);
        { unsigned char* ws8 = optr(gp(KP.ws));
          { Sched<0> S; S.init(T / 256, 3072 / 256, (T / 256) * 12, 256, 256); gemm_phase<EpiQ, Sched<0>, 2>(lds, Gemm{CQN, (const bf16_t*)(ws8 + WS_WUQ8), 256, 256, 256, (const float*)(ws8 + WS_SAQ), (const float*)(ws8 + WS_SBQ)}, S, EpiQ{Q, QL, (const float*)(ws8 + WS_TAB64)}); }
          { Sched<0> S; S.init(TP / 256, 4096 / 256, (TP / 256) * 16, 256, 256); gemm_phase<EpiBf16, Sched<0>, 2>(lds, Gemm{CKVNP, (const bf16_t*)(ws8 + WS_WUKV8), 256, 256, 256, (const float*)(ws8 + WS_SAK), (const float*)(ws8 + WS_SBK)}, S, EpiBf16{KV, 4096, 0}); } }
        GRID_SYNC(); STOPCHK(6);
#ifndef DUP_ATTN
#define DUP_ATTN 1
#endif
#ifndef DUP_RET
#define DUP_RET 1
#endif
#ifndef DUP_GATHER
#define DUP_GATHER 0
#endif
#pragma unroll 1
        for (int rep_ = 0; rep_ < DUP_ATTN; ++rep_)
        { for (int u = obid(); u < 512; u += ogrid()) { const int c = u & 255, i = u >> 8, xcd = c & 7, slot = c >> 3; const int bh = xcd * 4 + (slot >> 3) + 32 * i, pr = slot & 7, b = bh >> 4, h = bh & 15;
#pragma unroll 1
              for (int z = 0; z < 2; ++z) { const int qb = z ? 15 - pr : pr; const long tok0 = (long)b * SEQ + 256 * qb;
                  att::attn_block(Q + tok0 * 3072 + h * 192, KV + (long)b * SEQ * 4096 + h * 256, KRP + (long)b * SEQ * 64, KV + (long)b * SEQ * 4096 + h * 256 + 128, OA + tok0 * DM + h * 128, qb, ldsg); } } }
        { Sched<1> S; S.init(0, 0, 256, 3072, 256); gemm_phase(lds, Gemm{Q, WUK, 256, 3072, 256}, S, EpiRowMap<1>{QL, nullptr}); }
        GRID_SYNC(); STOPCHK(8);
        { Sched<2> S; S.init(0, 0, DB * 36, QLD, QLD); gemm_phase(lds, Gemm{QL, CKA, QLD, QLD, QLD}, S, EpiExp{SP, (float*)(optr(gp(KP.ws)) + WS_CTL + CTL_RSUM) + (long)l * 32768}); }
        GRID_SYNC(); STOPCHK(9);
        { Sched<3> S; S.init(0, 0, 256, KPAD, KPAD); gemm_phase(lds, Gemm{SP, CKT, 2176, KPAD, KPAD}, S, EpiRowMap<3>{OL, (const float*)(optr(gp(KP.ws)) + WS_CTL + CTL_RSUM) + (long)l * 32768}); }
        GRID_SYNC(); STOPCHK(11);
        { Sched<4> S; S.init(0, 0, 128, 512, 512); gemm_phase(lds, Gemm{OL, WUKV, 512, 512, 512}, S, EpiOV{OA}); }
#pragma unroll 1
        for (int rep_ = 0; rep_ < DUP_RET; ++rep_)
        for (int u = obid(); u < 256 + DB * 64; u += ogrid()) ret::unit(KP, l, u, ldsg);
#ifdef DUP_RETP
        for (int u = obid(); u < 256; u += ogrid()) ret::unit(KP, l, u, ldsg);
#endif
        GRID_SYNC(); STOPCHK(12);
        ph::rows2048_int8(KP, WS_OA, WS_OA8, WS_SAO, T);
        GRID_SYNC();
        { Sched<0> S; S.init(T / 256, DM / 256, (T / 256) * 8, DM / 2, DM / 2); unsigned char* ws8 = optr(gp(KP.ws));
          gemm_phase<EpiBf16, Sched<0>, 2>(lds, Gemm{(const bf16_t*)(ws8 + WS_OA8), (const bf16_t*)(ws8 + WS_WA8), DM / 2, DM / 2, DM / 2, (const float*)(ws8 + WS_SAO), (const float*)(ws8 + WS_SBA)}, S, EpiBf16{YA, DM, 0}); }
        { const int G_ = ogrid(), rem_ = ((T / 256) * 8) % G_; const int b_ = obid();
          if (rem_ == 0) ph::gnorm_gate(KP, ph::gwave(), ph::nwaves());
          else if (b_ >= rem_) ph::gnorm_gate(KP, (b_ - rem_) * 8 + (otid() >> 6), (G_ - rem_) * 8); }
#ifdef DUP_WA
#pragma unroll 1
        for (int rep_ = 0; rep_ < DUP_WA; ++rep_)
        { Sched<0> S; S.init(T / 256, DM / 256, (T / 256) * 8, DM, DM); gemm_phase(lds, Gemm{OA, WA, DM, DM, DM}, S, EpiBf16{YA, DM, 0}); }
#endif
        GRID_SYNC(); STOPCHK(14);
        { Sched<0> S; S.init(T / 256, DM / 256, (T / 256) * 8, DM / 2, DM / 2); unsigned char* ws8 = optr(gp(KP.ws));
          gemm_phase<EpiMix, Sched<0>, true>(lds, Gemm{(const bf16_t*)(ws8 + WS_BG), (const bf16_t*)(ws8 + WS_WB8), DM / 2, DM / 2, DM / 2}, S, EpiMix{Y, YA, MIX, (const float*)(ws8 + WS_SA8), (const float*)(ws8 + WS_SBB)}); }
        { const int G_ = ogrid(), rem_ = ((T / 256) * 8) % G_; const int b_ = obid();
          if (rem_ == 0) ph::peer_convert(KP, l, 0, NEXP, ph::gwave(), ph::nwaves());
          else if (b_ >= rem_) ph::peer_convert(KP, l, 0, NEXP, (b_ - rem_) * 8 + (otid() >> 6), (G_ - rem_) * 8); }
        GRID_SYNC(); STOPCHK(15);
        ph::rows2048_int8(KP, WS_MIX, WS_MIX8, WS_SA8, T);
        GRID_SYNC();
        { Sched<0> S; S.init(T / 256, DM / 256, (T / 256) * 8, DM / 2, DM / 2); unsigned char* ws8 = optr(gp(KP.ws));
          gemm_phase<EpiRes, Sched<0>, 2>(lds, Gemm{(const bf16_t*)(ws8 + WS_MIX8), (const bf16_t*)(ws8 + WS_WO8), DM / 2, DM / 2, DM / 2, (const float*)(ws8 + WS_SA8), (const float*)(ws8 + WS_SBO)}, S, EpiRes{gp(KP.out), ADA + 2 * DM, l == 0 ? gp(KP.x_prompt) : gp(KP.out), l == 0 ? gp(KP.x_sample) : gp(KP.out) + (long)TP * DM}); }
        { const int G_ = ogrid(), rem_ = ((T / 256) * 8) % G_; const int b_ = obid();
          if (rem_ == 0) ph::peer_convert(KP, l, NEXP, 2 * NEXP, ph::gwave(), ph::nwaves());
          else if (b_ >= rem_) ph::peer_convert(KP, l, NEXP, 2 * NEXP, (b_ - rem_) * 8 + (otid() >> 6), (G_ - rem_) * 8); }
        GRID_SYNC(); STOPCHK(16);
        ph::modulate(KP, l, 1);
        GRID_SYNC(); STOPCHK(17);
        { Sched<0> S; S.init(T / 256, DM / 256, (T / 256) * 8, DM / 2, DM / 2);
          unsigned char* ws8 = optr(gp(KP.ws));
          gemm_phase<EpiQ8, Sched<0>, true>(lds, Gemm{(const bf16_t*)(ws8 + WS_H8), (const bf16_t*)(ws8 + WS_WPQ8 + (long)l * DM * DM), DM / 2, DM / 2, DM / 2}, S, EpiQ8{QP, DM, (const float*)(ws8 + WS_SA8), (const float*)(ws8 + WS_SB8) + (long)l * DM});
#ifdef DUP_WPQ
          gemm_phase<EpiQ8, Sched<0>, true>(lds, Gemm{(const bf16_t*)(ws8 + WS_H8), (const bf16_t*)(ws8 + WS_WPQ8 + (long)l * DM * DM), DM / 2, DM / 2, DM / 2}, S, EpiQ8{QP, DM, (const float*)(ws8 + WS_SA8), (const float*)(ws8 + WS_SB8) + (long)l * DM});
#endif
        }
        if (l + 1 < DEPTH) { const int G_ = ogrid(), rem_ = ((T / 256) * 8) % G_; const int b_ = obid();
          if (rem_ == 0) ph::cache_convert(KP, l + 1, ldsg, 0, 4096, b_, G_);
          else if (b_ >= rem_) ph::cache_convert(KP, l + 1, ldsg, 0, 4096, b_ - rem_, G_ - rem_); }
        GRID_SYNC(); STOPCHK(18);
        { const int tid_ = otid(); const int lane = tid_ & 63; float* strip = (float*)ldsg + tid_ * 33; unsigned char* ws = optr(gp(KP.ws));
          const bf16_t* k1g = (const bf16_t*)(ws + WS_PK1) + (long)l * 128 * 128; const bf16_t* k2g = (const bf16_t*)(ws + WS_PK2) + (long)l * 128 * 128;
          bf16_t* k1 = (bf16_t*)(ldsg + 512 * 33 * 4 + 64); bf16_t* k2 = k1 + 128 * peer::KPITCH;
          for (int i = tid_; i < 2 * 128 * 16; i += 512) { const int which = i >> 11, r = (i >> 4) & 127, ch = i & 15;
              *reinterpret_cast<u32x4*>((which ? k2 : k1) + r * peer::KPITCH + ch * 8) = *reinterpret_cast<const u32x4*>((which ? k2g : k1g) + r * 128 + ch * 8); }
          __syncthreads();
          for (int wu = ph::gwave(); wu < (T / 32) * PH; wu += ph::nwaves()) peer::select_unit(QP, k1, k2, (int*)(ws + WS_PIDX), (float*)(ws + WS_PW), (wu >> 3) * 32, wu & 7, lane, strip);
#ifdef DUP_SEL
          for (int wu = ph::gwave(); wu < (T / 32) * PH; wu += ph::nwaves()) peer::select_unit(QP, k1, k2, (int*)(ws + WS_PIDX), (float*)(ws + WS_PW), (wu >> 3) * 32, wu & 7, lane, strip);
#endif
        }
        GRID_SYNC(); STOPCHK(19);
        { const int tid_ = otid(); const int lane = tid_ & 63, wid = tid_ >> 6; unsigned char* ws = optr(gp(KP.ws));
          volatile LAS unsigned* iw = (volatile LAS unsigned*)(lds + LDS_BARW); peer::XInfo xin; xin.rank = __builtin_amdgcn_readfirstlane((int)iw[2]); xin.xi = __builtin_amdgcn_readfirstlane((int)iw[3]); xin.nx = __builtin_amdgcn_readfirstlane((int)iw[4]); xin.nloc = __builtin_amdgcn_readfirstlane((int)iw[5]);
          if (xin.nx >= 1 && xin.nx <= 8) {
              peer::upass((const unsigned char*)(ws + WS_H8), (const float*)(ws + WS_SA8), (const unsigned char*)(ws + WS_PU), (const int*)(ws + WS_PIDX), (const float*)(ws + WS_PW), (const float*)(ws + WS_PSU), (const float*)(ws + WS_PSV), (int*)(ws + WS_DOTP), (unsigned*)(ws + WS_ACT), xin, wid, lane);
              GRID_SYNC();
              int vs0_, vsn_, vse_;
              if ((256 % xin.nx) == 0) { const int spx = 256 / xin.nx; vs0_ = xin.xi * spx + xin.rank; vsn_ = xin.nloc; vse_ = (xin.xi + 1) * spx; }
              else { vs0_ = obid(); vsn_ = ogrid(); vse_ = 256; }
              peer::vpass_lds((const unsigned char*)(ws + WS_PV), (const unsigned*)(ws + WS_ACT), gp(KP.out), ADA + 5 * DM, ldsg, vs0_, vsn_, vse_, tid_);
#ifdef DUP_VP
              peer::vpass_lds((const unsigned char*)(ws + WS_PV), (const unsigned*)(ws + WS_ACT), (float*)(ws + WS_OB), ADA + 5 * DM, ldsg, vs0_, vsn_, vse_, tid_);
#endif
          } else {
              for (int t = ph::gwave(); t < T; t += ph::nwaves()) peer::gather_token((const unsigned char*)(ws + WS_H8), (const float*)(ws + WS_SA8), (const unsigned char*)(ws + WS_PU), (const unsigned char*)(ws + WS_PV), (const float*)(ws + WS_PSU), (const float*)(ws + WS_PSV), (const int*)(ws + WS_PIDX), (const float*)(ws + WS_PW), gp(KP.out), ADA + 5 * DM, t, lane);
          } }
        GRID_SYNC(); STOPCHK(20);
    }
    ph::final_norm(KP);
}

extern "C" void kernel_launch(void* const* d_in, const int* in_sizes, int n_in, void* d_out, int out_size, void* d_ws, size_t ws_size, hipStream_t stream) {
    static int grid = 0;
    if (grid == 0) {
        if (n_in != 25 || out_size != (int)O_END || ws_size < WS_END) { fprintf(stderr, "kernel_launch: shape mismatch: n_in %d out %d (want %ld) ws %zu (want >= %zu)\n", n_in, out_size, O_END, ws_size, (size_t)WS_END); grid = -1; return; }
        int dev = 0, cus = 0, per_cu = 0;
        if (hipGetDevice(&dev) != hipSuccess || hipDeviceGetAttribute(&cus, hipDeviceAttributeMultiprocessorCount, dev) != hipSuccess) { fprintf(stderr, "kernel_launch: device query failed\n"); grid = -1; return; }
        if (hipFuncSetAttribute((const void*)mega_fwd, hipFuncAttributeMaxDynamicSharedMemorySize, LDS_BYTES) != hipSuccess) { fprintf(stderr, "kernel_launch: hipFuncSetAttribute failed\n"); grid = -1; return; }
        if (hipOccupancyMaxActiveBlocksPerMultiprocessor(&per_cu, (const void*)mega_fwd, 512, LDS_BYTES) != hipSuccess || per_cu < 1) { fprintf(stderr, "kernel_launch: occupancy query says %d blocks per CU\n", per_cu); grid = -1; return; }
        grid = cus;
#ifdef FORCE_GRID
        grid = FORCE_GRID;
#endif
    }
    if (grid < 0) return;
    (void)hipMemsetAsync((char*)d_ws + WS_CTL, 0, CTL_BYTES, stream);
    Params p{};
    const float* const* in = (const float* const*)d_in;
    p.x_prompt = in[0]; p.x_sample = in[1]; p.c_prompt = in[2]; p.c_sample = in[3]; p.cache_ckv = in[4]; p.cache_krope = in[5]; p.state_ret = in[6]; p.w_ada = in[7]; p.b_ada = in[8];
    p.g_mix = in[9]; p.g_ffn = in[10]; p.w_in = in[11]; p.g_q = in[12]; p.w_uq = in[13]; p.g_kv = in[14]; p.w_ukv = in[15]; p.w_a = in[16]; p.w_b = in[17]; p.w_o = in[18]; p.w_pq = in[19];
    p.peer_k1 = in[20]; p.peer_k2 = in[21]; p.peer_u = in[22]; p.peer_v = in[23]; p.g_final = in[24];
    p.out = (float*)d_out; p.ws = (unsigned char*)d_ws;
    for (int h = 0; h < 8; ++h) p.lg[h] = (float)log1p(-pow(2.0, -5.0 - (double)h));
    p.grid = grid; p.pad_ = 0;
    hipLaunchKernelGGL(mega_fwd, dim3(grid), dim3(512), LDS_BYTES, stream, p);
    const hipError_t le = hipGetLastError();
    if (le != hipSuccess) fprintf(stderr, "kernel_launch: launch failed: %s\n", hipGetErrorName(le));
}
```

```cpp
#include <hip/hip_runtime.h>
#include <cstdio>
#include <cstdint>
#include <cmath>

#define LAS __attribute__((address_space(3)))
typedef unsigned short bf16_t;
typedef short bf16x8 __attribute__((ext_vector_type(8)));
typedef float f32x4 __attribute__((ext_vector_type(4)));
typedef float f32x2 __attribute__((ext_vector_type(2)));
typedef float f32x16 __attribute__((ext_vector_type(16)));
typedef unsigned u32x4 __attribute__((ext_vector_type(4)));
typedef unsigned u32x2 __attribute__((ext_vector_type(2)));
typedef short s16x4 __attribute__((ext_vector_type(4)));
typedef int i32x4 __attribute__((ext_vector_type(4)));

constexpr int DM = 2048, NB = 4, SEQ = 4096, DEPTH = 2, DB = 32, DS = 64, PAST = 2048;
constexpr int TP = NB * SEQ, TS = DB * DS, T = TP + TS;
constexpr int NCOND = NB + DB;
constexpr int QLORA = 512, KVLORA = 512, ROPE = 64, NOPE = 128, VD = 128, MH = 16, QKD = 192;
constexpr int RH = 8, RQK = 128, RV = 256;
constexpr int PH = 8, NKEYS = 128, NEXP = 16384, PTOPK = 16;
constexpr int INW = 11328, INWP = 11520;
constexpr int C_CQ = 0, C_CKV = 512, C_KR = 1024, C_RQ = 1088, C_RK = 2112, C_RV = 3136, C_RG = 5184, C_GA = 7232, C_GB = 9280;
constexpr int KALL = PAST + DS;
constexpr int KPAD = 2304;
constexpr int QLD = 640;
constexpr float EPS = 1e-6f;
constexpr float MLA_SCALE = 0.07216878364870322f;

constexpr long O_Y = 0;
constexpr long O_CKVP = (long)T * DM;
constexpr long O_KRP = O_CKVP + 2L * TP * 512;
constexpr long O_RETP = O_KRP + 2L * TP * 64;
constexpr long O_CKVS = O_RETP + 2L * NB * RH * RQK * RV;
constexpr long O_KRS = O_CKVS + 2L * TS * 512;
constexpr long O_RETS = O_KRS + 2L * TS * 64;
constexpr long O_END = O_RETS + 2L * DB * RH * RQK * RV;

constexpr size_t al256(size_t x) { return (x + 255) / 256 * 256; }
constexpr size_t WS_CTL = 0;
constexpr size_t CTL_BYTES = 65536 + 2UL * 32768 * 4;
constexpr size_t CTL_RSUM = 65536;
constexpr size_t WS_TAB64 = WS_CTL + CTL_BYTES;
constexpr size_t WS_TAB128 = WS_TAB64 + 4096UL * 32 * 2 * 4;
constexpr size_t WS_ADA = WS_TAB128 + 4096UL * 64 * 2 * 4;
constexpr size_t WS_ADAP = WS_ADA + 2UL * NCOND * 12288 * 4;
constexpr size_t WS_WIN = WS_ADAP + 8UL * 2 * NCOND * 12288 * 4;
constexpr size_t WS_WUQ = WS_WIN + 2UL * INWP * DM * 2;
constexpr size_t WS_WUKV = WS_WUQ + 2UL * 3072 * 512 * 2;
constexpr size_t WS_WUK = WS_WUKV + 2UL * 4096 * 512 * 2;
constexpr size_t WS_WA = WS_WUK + 2UL * 16 * 512 * 256 * 2;
constexpr size_t WS_WB = WS_WA + 2UL * DM * DM * 2;
constexpr size_t WS_WO = WS_WB + 2UL * DM * DM * 2;
constexpr size_t WS_WPQ = WS_WO + 2UL * DM * DM * 2;
constexpr size_t WS_PK1 = WS_WPQ + 2UL * DM * DM * 2;
constexpr size_t WS_PK2 = WS_PK1 + 2UL * 128 * 128 * 2;
constexpr size_t WS_H = WS_PK2 + 2UL * 128 * 128 * 2;
constexpr size_t WS_Y = WS_H + (size_t)T * DM * 2;
constexpr size_t WS_CQN = WS_Y + (size_t)T * INWP * 2;
constexpr size_t WS_CKVNP = WS_CQN + (size_t)T * 512 * 2;
constexpr size_t WS_KRP = WS_CKVNP + (size_t)TP * 512 * 2;
constexpr size_t WS_Q = WS_KRP + (size_t)TP * 64 * 2;
constexpr size_t WS_YA = WS_Q;
constexpr size_t WS_KV = WS_Q + (size_t)T * 3072 * 2 + 4096;
constexpr size_t WS_SP = WS_KV;
constexpr size_t WS_MIX = WS_KV;
constexpr size_t WS_OA = WS_KV + 32UL * 1024 * KPAD * 2;
constexpr size_t WS_QP = WS_OA;
constexpr size_t WS_CKA = WS_OA + (size_t)T * DM * 2;
constexpr size_t WS_CKT = WS_CKA + 32UL * KPAD * QLD * 2;
constexpr size_t WS_QL = WS_CKT + 32UL * 512 * KPAD * 2;
constexpr size_t WS_OL = WS_QL + 32UL * 1024 * QLD * 2;
constexpr size_t WS_OB = WS_OL + 16UL * 2048 * 512 * 2;
constexpr size_t WS_BG = WS_OB + (size_t)T * DM * 2;
constexpr size_t WS_PIDX = WS_BG + (size_t)T * DM * 2;
constexpr size_t WS_PW = WS_PIDX + (size_t)T * 128 * 4;
constexpr size_t WS_PU = WS_PW + (size_t)T * 128 * 4;
constexpr size_t WS_PV = WS_PU + (size_t)NEXP * DM;
constexpr size_t WS_PSU = WS_PV + (size_t)NEXP * DM;
constexpr size_t WS_PSV = WS_PSU + (size_t)NEXP * 4;
constexpr size_t WS_WPQ8 = WS_PSV + (size_t)NEXP * 4;
constexpr size_t WS_SB8 = WS_WPQ8 + 2UL * DM * DM;
constexpr size_t WS_SA8 = WS_SB8 + 2UL * DM * 4;
constexpr int NB8 = 38;
constexpr size_t WS_WIN8 = WS_BG + (size_t)T * DM;
constexpr size_t WS_WB8 = WS_WIN8 + (size_t)NB8 * 256 * DM;
constexpr size_t WS_WUQ8 = WS_WB8 + (size_t)DM * DM;
constexpr size_t WS_WUKV8 = WS_WUQ8 + 3072UL * 512;
constexpr size_t WS_WA8 = WS_WUKV8 + 4096UL * 512;
constexpr size_t WS_WO8 = WS_WA8 + (size_t)DM * DM;
static_assert(WS_WO8 + (size_t)DM * DM <= WS_BG + (size_t)T * DM * 2, "int8 weights overflow the BG region");
constexpr size_t WS_OA8 = WS_Q + (size_t)T * DM * 2;
constexpr size_t WS_MIX8 = WS_KV + (size_t)T * DM * 2;
static_assert(WS_OA8 + (size_t)T * DM <= WS_KV && WS_MIX8 + (size_t)T * DM <= WS_KV + (size_t)TP * 4096 * 2, "int8 activation copies fit");
constexpr size_t WS_SBW = WS_SA8 + al256((size_t)T * 4);
constexpr size_t WS_SBB = WS_SBW + al256((size_t)INWP * 4);
constexpr size_t WS_SBQ = WS_SBB + (size_t)DM * 4;
constexpr size_t WS_SBK = WS_SBQ + 3072UL * 4;
constexpr size_t WS_SAQ = WS_SBK + 4096UL * 4;
constexpr size_t WS_SAK = WS_SAQ + al256((size_t)T * 4);
constexpr size_t WS_SBA = WS_SAK + al256((size_t)TP * 4);
constexpr size_t WS_SBO = WS_SBA + (size_t)DM * 4;
constexpr size_t WS_SAO = WS_SBO + (size_t)DM * 4;
constexpr size_t WS_END = WS_SAO + al256((size_t)T * 4);
constexpr size_t WS_H8 = WS_OB;
static_assert((size_t)TP * 4096 * 2 <= 32UL * 1024 * KPAD * 2, "KV fits in the SP region");
static_assert(WS_END <= 1608000000UL, "workspace map too large");
static_assert(WS_WIN % 256 == 0 && WS_H % 256 == 0 && WS_Y % 256 == 0 && WS_Q % 256 == 0 && WS_KV % 256 == 0 && WS_CKA % 256 == 0, "alignment");

constexpr int LDS_BYTES = 147456;
constexpr int LDS_BARW = LDS_BYTES - 32;
constexpr size_t CTL_RANK = 16384;
constexpr size_t WS_DOTP = WS_Q;
constexpr size_t WS_ACT = WS_DOTP + 8UL * T * 128 * 4;
constexpr size_t WS_PIDXT = WS_ACT + (size_t)T * 128 * 4;
static_assert(WS_PIDXT + (size_t)T * 128 * 4 <= WS_KV, "PEER scratch fits in the Q region");

struct Params {
    const float *x_prompt, *x_sample, *c_prompt, *c_sample, *cache_ckv, *cache_krope, *state_ret, *w_ada, *b_ada, *g_mix, *g_ffn, *w_in, *g_q, *w_uq, *g_kv, *w_ukv,
                *w_a, *w_b, *w_o, *w_pq, *peer_k1, *peer_k2, *peer_u, *peer_v, *g_final;
    float* out; unsigned char* ws;
    float lg[8];
    int grid; int pad_;
};

typedef const __attribute__((address_space(4))) Params KParams;
__device__ __forceinline__ KParams* okarg() {
    const uintptr_t k = (uintptr_t)__builtin_amdgcn_kernarg_segment_ptr();
    unsigned lo = (unsigned)k, hi = (unsigned)(k >> 32);
    asm volatile("" : "+s"(lo), "+s"(hi)); return (KParams*)(((uintptr_t)hi << 32) | lo); }
#define KP (*okarg())
__device__ __forceinline__ int ogrid() { return KP.grid; }
__device__ __forceinline__ int obid() { int b = (int)blockIdx.x; asm volatile("" : "+s"(b) :: "memory"); return b; }
__device__ __forceinline__ int otid() { int t = (int)threadIdx.x; asm volatile("" : "+v"(t) :: "memory"); return t; }
template <class P> __device__ __forceinline__ P* gp(P* p) { return (P*)(__attribute__((address_space(1))) P*)(uintptr_t)p; }
template <class P> __device__ __forceinline__ P* optr(P* p) {
    unsigned lo = __builtin_amdgcn_readfirstlane((unsigned)(uintptr_t)p), hi = __builtin_amdgcn_readfirstlane((unsigned)((uintptr_t)p >> 32));
    asm volatile("" : "+s"(lo), "+s"(hi)); return gp((P*)(((uintptr_t)hi << 32) | lo)); }
typedef __bf16 bf16v2_t __attribute__((ext_vector_type(2)));
__device__ __forceinline__ unsigned cvt_pk_bf16(float lo, float hi) { f32x2 v = {lo, hi}; bf16v2_t r = __builtin_convertvector(v, bf16v2_t); return __builtin_bit_cast(unsigned, r); }
__device__ __forceinline__ bf16_t f2bf(float f) { return (bf16_t)(cvt_pk_bf16(f, 0.f) & 0xffffu); }
__device__ __forceinline__ float bf2f(bf16_t b) { return __uint_as_float(((unsigned)b) << 16); }
__device__ __forceinline__ float bflo(unsigned w) { return __uint_as_float(w << 16); }
__device__ __forceinline__ float bfhi(unsigned w) { return __uint_as_float(w & 0xffff0000u); }
__device__ __forceinline__ void unpack8(const u32x4 w, float (&f)[8]) { f[0] = bflo(w.x); f[1] = bfhi(w.x); f[2] = bflo(w.y); f[3] = bfhi(w.y); f[4] = bflo(w.z); f[5] = bfhi(w.z); f[6] = bflo(w.w); f[7] = bfhi(w.w); }
__device__ __forceinline__ u32x4 pack8(const float (&f)[8]) { u32x4 w; w.x = cvt_pk_bf16(f[0], f[1]); w.y = cvt_pk_bf16(f[2], f[3]); w.z = cvt_pk_bf16(f[4], f[5]); w.w = cvt_pk_bf16(f[6], f[7]); return w; }
template <int K> __device__ __forceinline__ float sx(float v) {
    if constexpr (K == 32) { const auto rr = __builtin_amdgcn_permlane32_swap(__float_as_uint(v), __float_as_uint(v), false, false); return __uint_as_float((otid() & 32) ? rr[0] : rr[1]); }
    else return __int_as_float(__builtin_amdgcn_ds_swizzle(__float_as_int(v), (K << 10) | 0x1F));
}
__device__ __forceinline__ float wave_sum(float v) { v += sx<32>(v); v += sx<16>(v); v += sx<8>(v); v += sx<4>(v); v += sx<2>(v); v += sx<1>(v); return v; }
__device__ __forceinline__ float wave_max(float v) { v = fmaxf(v, sx<32>(v)); v = fmaxf(v, sx<16>(v)); v = fmaxf(v, sx<8>(v)); v = fmaxf(v, sx<4>(v)); v = fmaxf(v, sx<2>(v)); v = fmaxf(v, sx<1>(v)); return v; }
__device__ __forceinline__ float sigmoidf_(float x) { return 1.0f / (1.0f + __expf(-x)); }
__device__ __forceinline__ float siluf_(float x) { return x / (1.0f + __expf(-x)); }
__device__ __forceinline__ int cond_row(int t) { return t < TP ? (t >> 12) : NB + ((t - TP) >> 6); }
__device__ __forceinline__ int tok_pos(int t) { return t < TP ? (t & 4095) : PAST + ((t - TP) & 63); }

#define XB_TMO      128
#define XB_XCNT(j)  (256  + 64 * (j))
#define XB_XSUB(j)  (1280 + 64 * (j))
#define XB_XGEN(j)  (2304 + 64 * (j))
#define XB_TOP      3328
#define XB_TOPGEN   3392
#define XCD_BAR_WORDS 3456
#define XB_SPIN_CAP (1u << 22)
__device__ __forceinline__ unsigned xb_ld(unsigned* p)              { return __hip_atomic_load(p, __ATOMIC_RELAXED, __HIP_MEMORY_SCOPE_AGENT); }
__device__ __forceinline__ unsigned xb_add(unsigned* p, unsigned v) { return __hip_atomic_fetch_add(p, v, __ATOMIC_RELAXED, __HIP_MEMORY_SCOPE_AGENT); }
__device__ __forceinline__ unsigned xb_xcc_id() { return (unsigned)__builtin_amdgcn_s_getreg((3 << 11) | 20) & 0xFu; }
#define XB_SPIN(cond, bar) do { unsigned _sp = 0; while (cond) { __builtin_amdgcn_s_sleep(1); \
    if ((++_sp & 255u) == 0u) { if (xb_ld(&(bar)[XB_TMO])) break; if (_sp > XB_SPIN_CAP) { atomicAdd(&(bar)[XB_TMO], 1u); break; } } } } while (0)
struct XcdBarrier { unsigned* bar; unsigned x; volatile LAS unsigned* st; };
__device__ __forceinline__ XcdBarrier xcd_barrier_post(unsigned* bar, volatile LAS unsigned* st) {
    XcdBarrier b; b.bar = bar; b.x = xb_xcc_id(); b.st = st;
    if (threadIdx.x == 0) (void)xb_add(&bar[XB_XCNT(b.x)], 1u);
    return b;
}
__device__ __forceinline__ void xcd_barrier_complete(unsigned* bar, unsigned x, unsigned& nloc, unsigned& nx) {
    const unsigned G = (unsigned)KP.grid;
    unsigned sum, cnt, mine, sp = 0u;
    for (;;) {
        sum = 0u; cnt = 0u; mine = 0u;
#pragma unroll
        for (unsigned j = 0; j < 16; ++j) { const unsigned c = xb_ld(&bar[XB_XCNT(j)]); sum += c; cnt += (c > 0u) ? 1u : 0u; mine = (j == x) ? c : mine; }
        if (sum == G) break;
        __builtin_amdgcn_s_sleep(1);
        if ((++sp & 255u) == 0u) { if (xb_ld(&bar[XB_TMO])) break; if (sp > XB_SPIN_CAP) { atomicAdd(&bar[XB_TMO], 1u); break; } }
    }
    nloc = mine > 0u ? mine : 1u; nx = cnt > 0u ? cnt : 1u;
}
__device__ __forceinline__ void xcd_barrier(const XcdBarrier& b) {
    asm volatile("s_waitcnt vmcnt(0)" ::: "memory");
    __syncthreads();
    if (otid() == 0) {
        unsigned* bar = (unsigned*)(gp(KP.ws) + WS_CTL);
        unsigned bx = xb_xcc_id(); asm volatile("" : "+s"(bx));
        __builtin_amdgcn_s_waitcnt(0);
        unsigned nloc = b.st[0], nx = b.st[1];
        if (nloc == 0u) { xcd_barrier_complete(bar, bx, nloc, nx); b.st[0] = nloc; b.st[1] = nx; }
        const unsigned old = xb_add(&bar[XB_XSUB(bx)], 1u);
        const unsigned gen = old / nloc;
        if (old + 1u == (gen + 1u) * nloc) {
            __builtin_amdgcn_fence(__ATOMIC_RELEASE, "agent");
            asm volatile("s_waitcnt vmcnt(0)" ::: "memory");
            const unsigned og = xb_add(&bar[XB_TOP], 1u);
            const unsigned tg = og / nx;
            if (og + 1u == (tg + 1u) * nx) xb_add(&bar[XB_TOPGEN], 1u);
            else XB_SPIN(xb_ld(&bar[XB_TOPGEN]) == tg, bar);
            __builtin_amdgcn_fence(__ATOMIC_ACQUIRE, "agent");
            xb_add(&bar[XB_XGEN(bx)], 1u);
            asm volatile("s_waitcnt vmcnt(0)" ::: "memory");
        } else {
            XB_SPIN(xb_ld(&bar[XB_XGEN(bx)]) == gen, bar);
            __builtin_amdgcn_fence(__ATOMIC_ACQUIRE, "agent");
            asm volatile("s_waitcnt vmcnt(0)" ::: "memory");
        }
    }
    __syncthreads();
}
namespace pg8 {
constexpr int BM = 256, BK = 64, HALF = 128, HTB = HALF * BK * 2, STAGE_BYTES = 8 * HTB, NXCD = 8, WGM = 8;
__host__ __device__ __forceinline__ int lds_byte(int r, int c) { const int st = (r >> 4) * 2 + (c >> 5), rr = r & 15, cc = c & 31, ob = rr * 64 + cc * 2; return st * 1024 + (ob ^ (((ob >> 9) & 1) << 5)); }
__host__ __device__ __forceinline__ void stage_rc(int b, int& R, int& C) { const int st = b / 1024, sb = b % 1024, swz = sb ^ (((sb >> 9) & 1) << 5); R = (st >> 1) * 16 + swz / 64; C = (st & 1) * 32 + (swz % 64) / 2; }
__host__ __device__ __forceinline__ int perm32(int rho) { const int n = rho >> 4, i = rho & 15; return 8 * (i >> 2) + 4 * n + (i & 3); }

struct Unit { int pm, pn; long aoff, boff; int x0, x1; };
struct Gemm { const bf16_t* A; const bf16_t* Bt; int K; int lda, ldb; const float* sa; const float* sb; };

template <int MODE> struct Sched {
    int nM, nN, nwg, G, c; long lda, ldb;
    __device__ void init(int nM_, int nN_, int nwg_, long lda_, long ldb_) { nM = nM_; nN = nN_; nwg = nwg_; G = ogrid(); c = obid(); lda = lda_; ldb = ldb_; }
    __device__ void rotate(int r) { c = (c + r) % G; }
    __device__ bool next(int i, Unit& u) const {
        const long L = (long)i * G + c; if (L >= nwg) return false;
        int wgid = (int)L;
        if (MODE == 0 || MODE == 5 || MODE == 6) {
            { const int q = nwg / NXCD, r = nwg % NXCD, xcd = wgid % NXCD, off = wgid / NXCD; wgid = (xcd < r ? xcd * (q + 1) : r * (q + 1) + (xcd - r) * q) + off; }
            const int nig = WGM * nN, gid = wgid / nig, fm = gid * WGM, gsz = (nM - fm) < WGM ? (nM - fm) : WGM;
            u.pm = fm + ((wgid % nig) % gsz); u.pn = (wgid % nig) / gsz; u.x0 = 0; u.x1 = 0;
            { const int pl = u.pn;
              if (MODE == 5) u.pn = pl < 3 ? pl + 2 : pl + 5;
              if (MODE == 6) u.pn = pl < 2 ? pl : (pl < 5 ? pl + 3 : pl + 7);
              u.aoff = (long)u.pm * 256 * lda * 2; u.boff = (long)(MODE == 6 ? pl : u.pn) * 256 * ldb * 2; }
        } else if (MODE == 1) {
            const int h = wgid >> 4, rem = wgid & 15, rt = rem >> 1, pn = rem & 1;
            u.pm = rt; u.pn = pn; u.x0 = h; u.x1 = rt;
            u.aoff = ((long)(TP + 256 * rt) * 3072 + h * 192) * 2; u.boff = ((long)(h * 512 + 256 * pn) * 256) * 2;
        } else if (MODE == 2) {
            const int b = wgid / 36, rem = wgid % 36, pm = rem / 9, pn = rem % 9;
            u.pm = pm; u.pn = pn; u.x0 = b; u.x1 = 0;
            u.aoff = ((long)(b * 1024 + 256 * pm) * QLD) * 2; u.boff = ((long)(b * KPAD + 256 * pn) * QLD) * 2;
        } else if (MODE == 3) {
            const int b = wgid >> 3, pm = (wgid & 7) >> 1, pn = wgid & 1;
            u.pm = pm; u.pn = pn; u.x0 = b; u.x1 = 0;
            u.aoff = ((long)(b * 1024 + 256 * pm) * KPAD) * 2; u.boff = ((long)(b * 512 + 256 * pn) * KPAD) * 2;
        } else {
            const int h = wgid >> 3, rt = wgid & 7;
            u.pm = rt; u.pn = 0; u.x0 = h; u.x1 = rt;
            u.aoff = ((long)(h * 2048 + 256 * rt) * 512) * 2; u.boff = ((long)(h * 256) * 512) * 2;
        }
        return true;
    }
};

template <class Epi, class SchedT, int I8 = 0>
__device__ __forceinline__ void gemm_phase(LAS unsigned char* lds, const Gemm g, const SchedT& S, const Epi& E) {
    const int tid = otid(), wid = __builtin_amdgcn_readfirstlane(tid >> 6), lane = tid & 63, wr = wid >> 2, wc = wid & 3, fr = lane & 15, fq = lane >> 4;
    const int K = g.K, nt = K / BK;
    unsigned voffA[2], voffB[2];
#pragma unroll
    for (int i = 0; i < 2; ++i) { int R, C; stage_rc(tid * 16 + i * 8192, R, C); const int Rb = Epi::PERM ? ((R & ~31) + perm32(R & 31)) : R;
        voffA[i] = (unsigned)(R * g.lda + C) * 2u; voffB[i] = (unsigned)(Rb * g.ldb + C) * 2u; }
    const size_t kstep = (size_t)(BK * 2);
    const size_t hstepA = (size_t)HALF * g.lda * 2, hstepB = (size_t)HALF * g.ldb * 2;
    const unsigned ldsw = (unsigned)wid * 1024u;
    const int aoff = lds_byte(wr * 64 + fr, fq * 8), boff = lds_byte(wc * 32 + fr, fq * 8);
#define PG8_SA(b, h) (((b) * 2 + (h)) * HTB)
#define PG8_SB(b, h) ((4 + (b) * 2 + (h)) * HTB)
#define PG8_STAGE(bufoff, gbase, voff) do { _Pragma("unroll") for (int _i = 0; _i < 2; ++_i) \
        __builtin_amdgcn_global_load_lds((const unsigned*)((const char*)(gbase) + (voff)[_i]), (LAS unsigned*)(lds + (bufoff) + ldsw + _i * 8192), 16, 0, 0); } while (0)
#define PG8_LDA(dst, b, h) do { _Pragma("unroll") for (int m = 0; m < 4; ++m) _Pragma("unroll") for (int k = 0; k < 2; ++k) dst[m][k] = *(const LAS bf16x8*)(lds + PG8_SA(b, h) + aoff + m * 2048 + k * 1024); } while (0)
#define PG8_LDB(dst, b, h) do { _Pragma("unroll") for (int n = 0; n < 2; ++n) _Pragma("unroll") for (int k = 0; k < 2; ++k) dst[n][k] = *(const LAS bf16x8*)(lds + PG8_SB(b, h) + boff + n * 2048 + k * 1024); } while (0)
#define PG8_MMA(ai, bj, At, Bt) do { __builtin_amdgcn_s_setprio(1); _Pragma("unroll") for (int m = 0; m < 4; ++m) _Pragma("unroll") for (int n = 0; n < 2; ++n) _Pragma("unroll") for (int k = 0; k < 2; ++k) \
        { if constexpr (I8) acc[ai][bj][m][n] = __builtin_bit_cast(f32x4, __builtin_amdgcn_mfma_i32_16x16x64_i8(__builtin_bit_cast(i32x4, Bt[n][k]), __builtin_bit_cast(i32x4, At[m][k]), __builtin_bit_cast(i32x4, acc[ai][bj][m][n]), 0, 0, 0)); \
          else acc[ai][bj][m][n] = __builtin_amdgcn_mfma_f32_16x16x32_bf16(Bt[n][k], At[m][k], acc[ai][bj][m][n], 0, 0, 0); } __builtin_amdgcn_s_setprio(0); } while (0)
#define PG8_WAIT_V(n) asm volatile("s_waitcnt vmcnt(" #n ")" ::: "memory")
#define PG8_WAIT_L(n) asm volatile("s_waitcnt lgkmcnt(" #n ")" ::: "memory")
#define PG8_BAR __builtin_amdgcn_s_barrier()
#define PG8_SCHED __builtin_amdgcn_sched_barrier(0)
    Unit cur, nxt; int ui = 0;
    if (!S.next(0, cur)) return;
    f32x4 acc[2][2][4][2];
#pragma unroll
    for (int a = 0; a < 2; ++a)
#pragma unroll
        for (int b = 0; b < 2; ++b)
#pragma unroll
            for (int m = 0; m < 4; ++m)
#pragma unroll
                for (int n = 0; n < 2; ++n) acc[a][b][m][n] = (f32x4){0.f, 0.f, 0.f, 0.f};
    bf16x8 At[4][2], B0[2][2], B1[2][2];
    const char* cA = (const char*)g.A + cur.aoff; const char* cB = (const char*)g.Bt + cur.boff;
    PG8_STAGE(PG8_SB(0, 0), cB, voffB); PG8_STAGE(PG8_SA(0, 0), cA, voffA); PG8_STAGE(PG8_SB(0, 1), cB + hstepB, voffB); PG8_STAGE(PG8_SA(0, 1), cA + hstepA, voffA);
    if (wr == 1) PG8_BAR;
    PG8_WAIT_V(4); PG8_BAR;
    PG8_STAGE(PG8_SB(1, 0), cB + kstep, voffB); PG8_STAGE(PG8_SA(1, 0), cA + kstep, voffA); PG8_STAGE(PG8_SB(1, 1), cB + hstepB + kstep, voffB);
    PG8_WAIT_V(6); PG8_BAR;
    for (;;) {
        const bool has_next = S.next(ui + 1, nxt);
        const char* nA = has_next ? (const char*)g.A + nxt.aoff : cA; const char* nB = has_next ? (const char*)g.Bt + nxt.boff : cB;
        for (int t = 0; t < nt; t += 2) {
            const bool last = (t == nt - 2);
            const char* a1 = cA + (size_t)(t + 1) * kstep;
            const char* a2 = last ? nA : cA + (size_t)(t + 2) * kstep; const char* b2 = last ? nB : cB + (size_t)(t + 2) * kstep;
            const char* a3 = a2 + kstep; const char* b3 = b2 + kstep;
            PG8_LDB(B0, 0, 0); PG8_SCHED; PG8_LDA(At, 0, 0); PG8_STAGE(PG8_SA(1, 1), a1 + hstepA, voffA);
            PG8_WAIT_L(8); PG8_BAR; PG8_WAIT_L(0); PG8_MMA(0, 0, At, B0); PG8_BAR; PG8_SCHED;
            PG8_LDB(B1, 0, 1); PG8_STAGE(PG8_SB(0, 0), b2, voffB);
            PG8_BAR; PG8_WAIT_L(0); PG8_MMA(0, 1, At, B1); PG8_BAR;
            PG8_LDA(At, 0, 1); PG8_STAGE(PG8_SA(0, 0), a2, voffA);
            PG8_BAR; PG8_WAIT_L(0); PG8_MMA(1, 0, At, B0); PG8_BAR; PG8_SCHED;
            PG8_STAGE(PG8_SB(0, 1), b2 + hstepB, voffB);
            PG8_WAIT_V(6); PG8_BAR; PG8_MMA(1, 1, At, B1); PG8_BAR;
            PG8_LDB(B0, 1, 0); PG8_SCHED; PG8_LDA(At, 1, 0); PG8_STAGE(PG8_SA(0, 1), a2 + hstepA, voffA);
            PG8_WAIT_L(8); PG8_BAR; PG8_WAIT_L(0); PG8_MMA(0, 0, At, B0); PG8_BAR; PG8_SCHED;
            PG8_LDB(B1, 1, 1); PG8_STAGE(PG8_SB(1, 0), b3, voffB);
            PG8_BAR; PG8_WAIT_L(0); PG8_MMA(0, 1, At, B1); PG8_BAR;
            PG8_LDA(At, 1, 1); PG8_STAGE(PG8_SA(1, 0), a3, voffA);
            PG8_BAR; PG8_WAIT_L(0); PG8_MMA(1, 0, At, B0); PG8_BAR; PG8_SCHED;
            PG8_STAGE(PG8_SB(1, 1), b3 + hstepB, voffB);
            PG8_WAIT_V(6); PG8_BAR; PG8_MMA(1, 1, At, B1); PG8_BAR;
        }
        if constexpr (I8) {
#pragma unroll
            for (int a = 0; a < 2; ++a)
#pragma unroll
                for (int b = 0; b < 2; ++b)
#pragma unroll
                    for (int m = 0; m < 4; ++m)
#pragma unroll
                        for (int n = 0; n < 2; ++n) { const i32x4 iv = __builtin_bit_cast(i32x4, acc[a][b][m][n]); acc[a][b][m][n] = (f32x4){(float)iv[0], (float)iv[1], (float)iv[2], (float)iv[3]}; } }
        if constexpr (I8 == 2) {
            f32x4 sbv[2][2];
#pragma unroll
            for (int b = 0; b < 2; ++b) { const int c = cur.pn * BM + b * HALF + wc * 32 + (Epi::PERM ? 8 * fq : 4 * fq); sbv[b][0] = *(const f32x4*)(g.sb + c); sbv[b][1] = *(const f32x4*)(g.sb + c + (Epi::PERM ? 4 : 16)); }
#pragma unroll
            for (int a = 0; a < 2; ++a)
#pragma unroll
                for (int m = 0; m < 4; ++m) { const float s_ = g.sa[(long)cur.pm * BM + a * HALF + wr * 64 + m * 16 + fr];
#pragma unroll
                    for (int b = 0; b < 2; ++b) { acc[a][b][m][0] = acc[a][b][m][0] * sbv[b][0] * s_; acc[a][b][m][1] = acc[a][b][m][1] * sbv[b][1] * s_; } } }
        E(acc, cur, wr, wc, fr, fq);
        if (!has_next) break;
#pragma unroll
        for (int a = 0; a < 2; ++a)
#pragma unroll
            for (int b = 0; b < 2; ++b)
#pragma unroll
                for (int m = 0; m < 4; ++m)
#pragma unroll
                    for (int n = 0; n < 2; ++n) acc[a][b][m][n] = (f32x4){0.f, 0.f, 0.f, 0.f};
        cur = nxt; cA = nA; cB = nB; ++ui;
    }
    PG8_WAIT_V(0);
    if (wr == 0) PG8_BAR;
    PG8_BAR;
#undef PG8_SA
#undef PG8_SB
#undef PG8_STAGE
#undef PG8_LDA
#undef PG8_LDB
#undef PG8_MMA
#undef PG8_WAIT_V
#undef PG8_WAIT_L
#undef PG8_BAR
#undef PG8_SCHED
}

struct EpiBf16 {
    static constexpr bool PERM = true;
    bf16_t* O; long ldc; long bstride;
    __device__ __forceinline__ void operator()(const f32x4 (&acc)[2][2][4][2], const Unit& u, int wr, int wc, int fr, int fq) const {
        bf16_t* base = O + (long)u.x0 * bstride + (long)(u.pm * BM + wr * 64 + fr) * ldc + u.pn * BM + wc * 32 + 8 * fq;
#pragma unroll
        for (int ai = 0; ai < 2; ++ai)
#pragma unroll
            for (int m = 0; m < 4; ++m) { bf16_t* rowp = base + (long)(ai * HALF + m * 16) * ldc;
#pragma unroll
                for (int bj = 0; bj < 2; ++bj) { const f32x4 v0 = acc[ai][bj][m][0], v1 = acc[ai][bj][m][1];
                    u32x4 w; w.x = cvt_pk_bf16(v0[0], v0[1]); w.y = cvt_pk_bf16(v0[2], v0[3]); w.z = cvt_pk_bf16(v1[0], v1[1]); w.w = cvt_pk_bf16(v1[2], v1[3]);
                    *(u32x4*)(rowp + bj * HALF) = w; } }
    }
};
template <int RMODE> struct EpiRowMap {
    static constexpr bool PERM = true;
    bf16_t* O; const float* rsum;
    __device__ __forceinline__ void operator()(const f32x4 (&acc)[2][2][4][2], const Unit& u, int wr, int wc, int fr, int fq) const {
        const int col0 = u.pn * BM + wc * 32 + 8 * fq;
#pragma unroll
        for (int ai = 0; ai < 2; ++ai)
#pragma unroll
            for (int m = 0; m < 4; ++m) { const int r = ai * HALF + wr * 64 + m * 16 + fr; long drow; long ldc;
                if (RMODE == 1) { const int ts = 256 * u.x1 + r; drow = (long)(ts >> 6) * 1024 + u.x0 * 64 + (ts & 63); ldc = QLD; }
                float rs = 1.0f;
                if (RMODE == 1) { }
                else { const int qr = 256 * u.pm + r; drow = (long)(qr >> 6) * 2048 + u.x0 * 64 + (qr & 63); ldc = 512; rs = 1.0f / rsum[u.x0 * 1024 + qr]; }
                bf16_t* rowp = O + drow * ldc + col0;
#pragma unroll
                for (int bj = 0; bj < 2; ++bj) { const f32x4 v0 = acc[ai][bj][m][0] * rs, v1 = acc[ai][bj][m][1] * rs;
                    u32x4 w; w.x = cvt_pk_bf16(v0[0], v0[1]); w.y = cvt_pk_bf16(v0[2], v0[3]); w.z = cvt_pk_bf16(v1[0], v1[1]); w.w = cvt_pk_bf16(v1[2], v1[3]);
                    *(u32x4*)(rowp + bj * HALF) = w; } }
    }
};
struct EpiOV {
    static constexpr bool PERM = true;
    bf16_t* O;
    __device__ __forceinline__ void operator()(const f32x4 (&acc)[2][2][4][2], const Unit& u, int wr, int wc, int fr, int fq) const {
#pragma unroll
        for (int ai = 0; ai < 2; ++ai)
#pragma unroll
            for (int m = 0; m < 4; ++m) { const int r = ai * HALF + wr * 64 + m * 16 + fr;
                bf16_t* rowp = O + (long)(TP + 256 * u.x1 + r) * DM + u.x0 * 128 + wc * 32 + 8 * fq;
                const f32x4 v0 = acc[ai][1][m][0], v1 = acc[ai][1][m][1];
                u32x4 w; w.x = cvt_pk_bf16(v0[0], v0[1]); w.y = cvt_pk_bf16(v0[2], v0[3]); w.z = cvt_pk_bf16(v1[0], v1[1]); w.w = cvt_pk_bf16(v1[2], v1[3]);
                *(u32x4*)rowp = w; }
    }
};
struct EpiMix {
    static constexpr bool PERM = true;
    const bf16_t* Y; const bf16_t* YA; bf16_t* MIX; const float* sa; const float* sb;
    __device__ __forceinline__ void operator()(const f32x4 (&acc)[2][2][4][2], const Unit& u, int wr, int wc, int fr, int fq) const {
#pragma unroll
        for (int ai = 0; ai < 2; ++ai)
#pragma unroll
            for (int m = 0; m < 4; ++m) { const long t = (long)u.pm * BM + ai * HALF + wr * 64 + m * 16 + fr; const float s_ = sa[t];
#pragma unroll
                for (int bj = 0; bj < 2; ++bj) { const int c = u.pn * BM + bj * HALF + wc * 32 + 8 * fq;
                    const u32x4 ga = *(const u32x4*)(Y + t * INWP + C_GA + c), gb = *(const u32x4*)(Y + t * INWP + C_GB + c), ya = *(const u32x4*)(YA + t * DM + c);
                    float fa[8], fb[8], fy[8], o[8]; unpack8(ga, fa); unpack8(gb, fb); unpack8(ya, fy);
                    const f32x4 v0 = acc[ai][bj][m][0] * *(const f32x4*)(sb + c) * s_, v1 = acc[ai][bj][m][1] * *(const f32x4*)(sb + c + 4) * s_;
                    const float av[8] = {v0[0], v0[1], v0[2], v0[3], v1[0], v1[1], v1[2], v1[3]};
#pragma unroll
                    for (int j = 0; j < 8; ++j) {
#if defined(DBG_MIX) && DBG_MIX == 1
                        o[j] = sigmoidf_(fb[j]) * av[j];
#elif defined(DBG_MIX) && DBG_MIX == 2
                        o[j] = sigmoidf_(fa[j]) * fy[j];
#else
                        o[j] = sigmoidf_(fa[j]) * fy[j] + sigmoidf_(fb[j]) * av[j];
#endif
                    }
                    *(u32x4*)(MIX + t * DM + c) = pack8(o); } }
    }
};
struct EpiRes {
    static constexpr bool PERM = false;
    float* X; const float* gate;
    const float* XinP; const float* XinS;
    __device__ __forceinline__ void operator()(const f32x4 (&acc)[2][2][4][2], const Unit& u, int wr, int wc, int fr, int fq) const {
#pragma unroll
        for (int ai = 0; ai < 2; ++ai)
#pragma unroll
            for (int m = 0; m < 4; ++m) { const int t = u.pm * BM + ai * HALF + wr * 64 + m * 16 + fr; const float* gr = gate + (long)cond_row(t) * 12288; float* xr = X + (long)t * DM; const float* xi = t < TP ? XinP + (long)t * DM : XinS + (long)(t - TP) * DM;
#pragma unroll
                for (int bj = 0; bj < 2; ++bj)
#pragma unroll
                    for (int n = 0; n < 2; ++n) { const int c = u.pn * BM + bj * HALF + wc * 32 + n * 16 + 4 * fq;
                        const f32x4 gv = *(const f32x4*)(gr + c); const f32x4 xv = *(const f32x4*)(xi + c);
                        *(f32x4*)(xr + c) = xv + gv * acc[ai][bj][m][n]; } }
    }
};

struct EpiQ {
    static constexpr bool PERM = true;
    bf16_t* Q; bf16_t* QL; const float* T64;
    __device__ __forceinline__ void operator()(const f32x4 (&acc)[2][2][4][2], const Unit& u, int wr, int wc, int fr, int fq) const {
        const int grp = u.pn / 3, typ = u.pn - 3 * grp;
        if (typ < 2) {
#pragma unroll
            for (int ai = 0; ai < 2; ++ai)
#pragma unroll
                for (int m = 0; m < 4; ++m) { const long t = (long)u.pm * BM + ai * HALF + wr * 64 + m * 16 + fr;
#pragma unroll
                    for (int bj = 0; bj < 2; ++bj) { const f32x4 v0 = acc[ai][bj][m][0], v1 = acc[ai][bj][m][1];
                        u32x4 w; w.x = cvt_pk_bf16(v0[0], v0[1]); w.y = cvt_pk_bf16(v0[2], v0[3]); w.z = cvt_pk_bf16(v1[0], v1[1]); w.w = cvt_pk_bf16(v1[2], v1[3]);
                        *(u32x4*)(Q + t * 3072 + 768 * grp + 192 * (2 * typ + bj) + wc * 32 + 8 * fq) = w; } }
        } else {
#pragma unroll
            for (int ai = 0; ai < 2; ++ai)
#pragma unroll
                for (int m = 0; m < 4; ++m) { const int t = u.pm * BM + ai * HALF + wr * 64 + m * 16 + fr; const int pos = tok_pos(t);
                    const float* cs = T64 + ((long)pos * 32 + 8 * fq) * 2; float cv[8], sv[8];
#pragma unroll
                    for (int j = 0; j < 4; ++j) { const f32x4 qv = *(const f32x4*)(cs + 4 * j); cv[2 * j] = qv[0]; sv[2 * j] = qv[1]; cv[2 * j + 1] = qv[2]; sv[2 * j + 1] = qv[3]; }
                    const f32x4 a0 = acc[ai][0][m][0], a1 = acc[ai][0][m][1], b0 = acc[ai][1][m][0], b1 = acc[ai][1][m][1];
                    const float x1[8] = {a0[0], a0[1], a0[2], a0[3], a1[0], a1[1], a1[2], a1[3]}, x2[8] = {b0[0], b0[1], b0[2], b0[3], b1[0], b1[1], b1[2], b1[3]};
                    float o1[8], o2[8];
#pragma unroll
                    for (int j = 0; j < 8; ++j) { o1[j] = x1[j] * cv[j] - x2[j] * sv[j]; o2[j] = x1[j] * sv[j] + x2[j] * cv[j]; }
                    const u32x4 w1 = pack8(o1), w2 = pack8(o2); const int hd = 4 * grp + wc;
                    bf16_t* qd = Q + (long)t * 3072 + hd * 192 + 128 + 8 * fq; *(u32x4*)qd = w1; *(u32x4*)(qd + 32) = w2;
                    if (t >= TP) { const int ts = t - TP; bf16_t* d = QL + ((long)(ts >> 6) * 1024 + hd * 64 + (ts & 63)) * QLD + 512 + 8 * fq; *(u32x4*)d = w1; *(u32x4*)(d + 32) = w2; } }
        }
    }
};

struct EpiExp {
    static constexpr bool PERM = true;
    bf16_t* O; float* rsum;
    __device__ __forceinline__ void operator()(const f32x4 (&acc)[2][2][4][2], const Unit& u, int wr, int wc, int fr, int fq) const {
        bf16_t* base = O + (long)u.x0 * 1024 * KPAD + (long)(u.pm * BM + wr * 64 + fr) * KPAD + u.pn * BM + wc * 32 + 8 * fq;
#pragma unroll
        for (int ai = 0; ai < 2; ++ai)
#pragma unroll
            for (int m = 0; m < 4; ++m) { bf16_t* rowp = base + (long)(ai * HALF + m * 16) * KPAD; float part = 0.f;
#pragma unroll
                for (int bj = 0; bj < 2; ++bj) { const int c0 = u.pn * BM + bj * HALF + wc * 32 + 8 * fq; const f32x4 v0 = acc[ai][bj][m][0], v1 = acc[ai][bj][m][1];
                    const float sv[8] = {v0[0], v0[1], v0[2], v0[3], v1[0], v1[1], v1[2], v1[3]}; float e[8];
#pragma unroll
                    for (int j = 0; j < 8; ++j) { e[j] = (c0 + j < KALL) ? __expf(fminf(sv[j] * MLA_SCALE, 60.f)) : 0.f; part += e[j]; }
                    *(u32x4*)(rowp + bj * HALF) = pack8(e); }
                part += sx<16>(part); part += sx<32>(part);
                if (fq == 0) atomicAdd(rsum + u.x0 * 1024 + u.pm * BM + ai * HALF + wr * 64 + m * 16 + fr, part); }
    }
};

struct EpiQ8 {
    static constexpr bool PERM = true;
    bf16_t* O; long ldc; const float* sa; const float* sb;
    __device__ __forceinline__ void operator()(const f32x4 (&acc)[2][2][4][2], const Unit& u, int wr, int wc, int fr, int fq) const {
        f32x4 sbv[2][2];
#pragma unroll
        for (int bj = 0; bj < 2; ++bj) { const int c = u.pn * BM + bj * HALF + wc * 32 + 8 * fq; sbv[bj][0] = *(const f32x4*)(sb + c); sbv[bj][1] = *(const f32x4*)(sb + c + 4); }
#pragma unroll
        for (int ai = 0; ai < 2; ++ai)
#pragma unroll
            for (int m = 0; m < 4; ++m) { const long t = (long)u.pm * BM + ai * HALF + wr * 64 + m * 16 + fr; const float s = sa[t];
#pragma unroll
                for (int bj = 0; bj < 2; ++bj) { const f32x4 v0 = acc[ai][bj][m][0] * sbv[bj][0] * s, v1 = acc[ai][bj][m][1] * sbv[bj][1] * s;
                    u32x4 w; w.x = cvt_pk_bf16(v0[0], v0[1]); w.y = cvt_pk_bf16(v0[2], v0[3]); w.z = cvt_pk_bf16(v1[0], v1[1]); w.w = cvt_pk_bf16(v1[2], v1[3]);
                    *(u32x4*)(O + t * ldc + u.pn * BM + bj * HALF + wc * 32 + 8 * fq) = w; } }
    }
};
}
namespace att {
constexpr int NW = 8, QBLK = 32, KVBLK = 64;
constexpr float SCALE = MLA_SCALE;
constexpr float THR = 8.f;
constexpr int KROW = 384;
constexpr int SHM_V = KVBLK * 128 * 2, SHM_K = KVBLK * KROW;
constexpr int QR_PITCH = 144, SHM_QR = 256 * QR_PITCH;
constexpr int SHM_ATTN = 2 * SHM_V + 2 * SHM_K + NW * 64 * 4 + SHM_QR;
#define KSWZ(row, colB) ((row) * att::KROW + ((colB) ^ (((row) & 7) << 4)))
#define SBAR() __builtin_amdgcn_sched_barrier(0)
__device__ __forceinline__ int crow(int r, int hi) { return (r & 3) + 8 * (r >> 2) + 4 * hi; }

__device__ __forceinline__ void partialSM(f32x16& p0, f32x16& p1, float& m_reg, float& mn, float& alpha) {
  constexpr float C = SCALE * 1.4426950408889634f;
  float pmax = p0[0];
#pragma unroll
  for (int r = 1; r < 16; ++r) pmax = fmaxf(pmax, p0[r]);
#pragma unroll
  for (int r = 0; r < 16; ++r) pmax = fmaxf(pmax, p1[r]);
  { auto rr = __builtin_amdgcn_permlane32_swap(__float_as_uint(pmax), __float_as_uint(pmax), false, false);
    pmax = fmaxf(__uint_as_float(rr[0]), __uint_as_float(rr[1])); }
  if (__builtin_expect(__all(pmax - m_reg <= THR / SCALE), 1)) { mn = m_reg; alpha = 1.f; }
  else { mn = fmaxf(m_reg, pmax); alpha = __builtin_amdgcn_exp2f((m_reg - mn) * C); m_reg = mn; }
  float mnC = -mn * C;
#pragma unroll
  for (int r = 0; r < 16; ++r) p0[r] = fmaf(p0[r], C, mnC);
#pragma unroll
  for (int r = 0; r < 16; ++r) p1[r] = fmaf(p1[r], C, mnC);
#pragma unroll
  for (int r = 0; r < 16; ++r) p0[r] = __builtin_amdgcn_exp2f(p0[r]);
}
__device__ __forceinline__ void finishSM(f32x16& p0, f32x16& p1, float alpha, float& l_reg, bf16x8& pa0, bf16x8& pa1, bf16x8& pa2, bf16x8& pa3) {
#pragma unroll
  for (int r = 0; r < 16; ++r) p1[r] = __builtin_amdgcn_exp2f(p1[r]);
  float ps = 0;
#pragma unroll
  for (int r = 0; r < 16; ++r) ps += p0[r];
#pragma unroll
  for (int r = 0; r < 16; ++r) ps += p1[r];
  { auto rr = __builtin_amdgcn_permlane32_swap(__float_as_uint(ps), __float_as_uint(ps), false, false);
    ps = __uint_as_float(rr[0]) + __uint_as_float(rr[1]); }
  l_reg = l_reg * alpha + ps;
#define PK4(P, BASE, OUT) do { unsigned a0 = cvt_pk_bf16(P[BASE + 0], P[BASE + 1]), a1 = cvt_pk_bf16(P[BASE + 2], P[BASE + 3]);   \
    unsigned b0 = cvt_pk_bf16(P[BASE + 4], P[BASE + 5]), b1 = cvt_pk_bf16(P[BASE + 6], P[BASE + 7]);                              \
    auto r0 = __builtin_amdgcn_permlane32_swap(a0, b0, false, false); auto r1 = __builtin_amdgcn_permlane32_swap(a1, b1, false, false); \
    u32x4 w = {r0[0], r1[0], r0[1], r1[1]}; OUT = *reinterpret_cast<bf16x8*>(&w); } while (0)
  PK4(p0, 0, pa0); PK4(p0, 8, pa1); PK4(p1, 0, pa2); PK4(p1, 8, pa3);
#undef PK4
}
__device__ __forceinline__ void qkt(f32x16& p0, f32x16& p1, const char* Ks, const bf16x8* qr, const char* qrope, const int (&kbase)[4], bool vis) {
  p0 = f32x16{}; p1 = f32x16{};
  if (vis) {
#pragma unroll
  for (int d0 = 0; d0 < 12; ++d0) {
    bf16x8 b0 = *reinterpret_cast<const bf16x8*>(Ks + kbase[d0 & 3] + (d0 >> 2) * 128);
    bf16x8 b1 = *reinterpret_cast<const bf16x8*>(Ks + kbase[d0 & 3] + (d0 >> 2) * 128 + 32 * KROW);
    const bf16x8 qv = d0 < 8 ? qr[d0 < 8 ? d0 : 0] : *reinterpret_cast<const bf16x8*>(qrope + (d0 - 8) * 32);
    p0 = __builtin_amdgcn_mfma_f32_32x32x16_bf16(b0, qv, p0, 0, 0, 0);
    p1 = __builtin_amdgcn_mfma_f32_32x32x16_bf16(b1, qv, p1, 0, 0, 0); }
  }
  if (!vis) {
#pragma unroll
    for (int r = 0; r < 16; ++r) { p0[r] = -1e30f; p1[r] = -1e30f; } }
}
__device__ __forceinline__ int v_st(int k, int c) { const int kk = (k & ~0xC) | ((k & 4) << 1) | ((k & 8) >> 1); return ((kk >> 3) * 4 + (c >> 5)) * 512 + ((kk & 7) * 32 + (c & 31)) * 2; }
__device__ __forceinline__ int v_rd_base(int lane) { return ((lane & 3) << 3) | (((lane >> 2) & 3) << 6) | (((lane >> 4) & 1) << 5) | (((lane >> 5) & 1) << 8); }
constexpr int v_rd_off(int d0, int ks, int half) { return d0 * 512 + ks * 4096 + half * 2048; }
template <int OFF> __device__ __forceinline__ s16x4 tr_read(int vb) {
  s16x4 r; asm volatile("ds_read_b64_tr_b16 %0, %1 offset:%2" : "=&v"(r) : "v"(vb), "i"(OFF) : "memory"); return r;
}
template <int D0> __device__ __forceinline__ void pv_one(f32x16& od, int vb, bf16x8 pa0, bf16x8 pa1, bf16x8 pa2, bf16x8 pa3) {
  const s16x4 l0 = tr_read<v_rd_off(D0, 0, 0)>(vb), h0 = tr_read<v_rd_off(D0, 0, 1)>(vb), l1 = tr_read<v_rd_off(D0, 1, 0)>(vb), h1 = tr_read<v_rd_off(D0, 1, 1)>(vb);
  const s16x4 l2 = tr_read<v_rd_off(D0, 2, 0)>(vb), h2 = tr_read<v_rd_off(D0, 2, 1)>(vb), l3 = tr_read<v_rd_off(D0, 3, 0)>(vb), h3 = tr_read<v_rd_off(D0, 3, 1)>(vb);
  asm volatile("s_waitcnt lgkmcnt(0)" ::: "memory"); SBAR();
#define PK(L, H) (bf16x8){L[0], L[1], L[2], L[3], H[0], H[1], H[2], H[3]}
  od = __builtin_amdgcn_mfma_f32_32x32x16_bf16(pa0, PK(l0, h0), od, 0, 0, 0);
  od = __builtin_amdgcn_mfma_f32_32x32x16_bf16(pa1, PK(l1, h1), od, 0, 0, 0);
  od = __builtin_amdgcn_mfma_f32_32x32x16_bf16(pa2, PK(l2, h2), od, 0, 0, 0);
  od = __builtin_amdgcn_mfma_f32_32x32x16_bf16(pa3, PK(l3, h3), od, 0, 0, 0);
#undef PK
}
__device__ __forceinline__ void pv_d0(f32x16* o, int vb, bf16x8 pa0, bf16x8 pa1, bf16x8 pa2, bf16x8 pa3) {
  pv_one<0>(o[0], vb, pa0, pa1, pa2, pa3); pv_one<1>(o[1], vb, pa0, pa1, pa2, pa3); pv_one<2>(o[2], vb, pa0, pa1, pa2, pa3); pv_one<3>(o[3], vb, pa0, pa1, pa2, pa3);
}

__device__ __forceinline__ void attn_block(const bf16_t* __restrict__ Qb, const bf16_t* __restrict__ Kn, const bf16_t* __restrict__ Kr, const bf16_t* __restrict__ Vh,
                                           bf16_t* __restrict__ Ob, int qb, char* lds) {
  constexpr int LDQ = 3072, LDK = 4096, LDR = 64, LDO = 2048;
  const int tid = otid(), wid = tid >> 6, lane = tid & 63, r32 = lane & 31, hi = lane >> 5;
  char* V_lds = lds; char* K_lds = lds + 2 * SHM_V;
  float* ws = (float*)(lds + 2 * SHM_V + 2 * SHM_K) + wid * 64; float* li_l = ws; float* al_l = ws + 32;
  float m_reg = -1e30f, l_reg = 0; f32x16 o[4] = {}; bf16x8 qr[8];
  const bf16_t* Qw = Qb + (long)(wid * QBLK + r32) * LDQ + hi * 8;
#pragma unroll
  for (int d0 = 0; d0 < 8; ++d0) qr[d0] = *reinterpret_cast<const bf16x8*>(Qw + d0 * 16);
  char* qrope = lds + 2 * SHM_V + 2 * SHM_K + NW * 64 * 4 + (wid * QBLK + r32) * QR_PITCH + hi * 16;
#pragma unroll
  for (int d0 = 8; d0 < 12; ++d0) *reinterpret_cast<bf16x8*>(qrope + (d0 - 8) * 32) = *reinterpret_cast<const bf16x8*>(Qw + d0 * 16);
  asm volatile("s_waitcnt lgkmcnt(0)" ::: "memory");
  const int NT = 4 * qb + 4, jmax = 4 * qb + (wid >> 1);
  int kbase[4];
#pragma unroll
  for (int dl = 0; dl < 4; ++dl) kbase[dl] = r32 * KROW + (((dl << 5) | (hi << 4)) ^ ((r32 & 7) << 4));
  const int sr = tid >> 4, sc = (tid & 15) * 8, vst0 = v_st(sr, sc), vst1 = v_st(32 + sr, sc);
  const int rr = tid >> 3, rc = (tid & 7) * 8;
  const int vb0 = (int)(uintptr_t)V_lds + v_rd_base(lane);
  bf16x8 vs0, vs1, ks0, ks1, kr0;
#define SLOAD(k0) do { vs0 = *reinterpret_cast<const bf16x8*>(&Vh[(long)((k0) + sr) * LDK + sc]); vs1 = *reinterpret_cast<const bf16x8*>(&Vh[(long)((k0) + 32 + sr) * LDK + sc]); \
    ks0 = *reinterpret_cast<const bf16x8*>(&Kn[(long)((k0) + sr) * LDK + sc]); ks1 = *reinterpret_cast<const bf16x8*>(&Kn[(long)((k0) + 32 + sr) * LDK + sc]); \
    kr0 = *reinterpret_cast<const bf16x8*>(&Kr[(long)((k0) + rr) * LDR + rc]); } while (0)
#define SWRITE(b) do { *(bf16x8*)(V_lds + (b) * SHM_V + vst0) = vs0; *(bf16x8*)(V_lds + (b) * SHM_V + vst1) = vs1; int kc = sc * 2; \
    *(bf16x8*)(K_lds + (b) * SHM_K + KSWZ(sr, kc)) = ks0; *(bf16x8*)(K_lds + (b) * SHM_K + KSWZ(32 + sr, kc)) = ks1; \
    *(bf16x8*)(K_lds + (b) * SHM_K + KSWZ(rr, 256 + rc * 2)) = kr0; } while (0)
#define SWAIT() asm volatile("s_waitcnt vmcnt(0)" ::: "memory")
#define RESC(a) do { if (__any((a) < 1.f)) { if (hi == 0) al_l[r32] = (a); asm volatile("s_waitcnt lgkmcnt(0)" ::: "memory"); \
    _Pragma("unroll") for (int d = 0; d < 4; ++d) _Pragma("unroll") for (int r = 0; r < 16; ++r) o[d][r] *= al_l[crow(r, hi)]; } } while (0)
  f32x16 pA0, pA1, pB0, pB1; float mnA, mnB, alA, alB; bf16x8 pa0, pa1, pa2, pa3;
  SLOAD(0); SWAIT(); SWRITE(0); __syncthreads();
  qkt(pA0, pA1, K_lds, qr, qrope, kbase, true); partialSM(pA0, pA1, m_reg, mnA, alA);
  SLOAD(KVBLK);
  SWAIT(); SWRITE(1); __syncthreads();
  for (int j = 1; j + 1 < NT; j += 2) {
    SBAR(); qkt(pB0, pB1, K_lds + SHM_K, qr, qrope, kbase, j <= jmax);
    finishSM(pA0, pA1, alA, l_reg, pa0, pa1, pa2, pa3); SBAR();
    SLOAD((j + 1) * KVBLK); SBAR();
    if (j - 1 <= jmax) pv_d0(o, vb0, pa0, pa1, pa2, pa3);
    partialSM(pB0, pB1, m_reg, mnB, alB);
    __syncthreads(); SWAIT(); SWRITE(0);
    RESC(alB); __syncthreads();
    SBAR(); qkt(pA0, pA1, K_lds, qr, qrope, kbase, j + 1 <= jmax);
    finishSM(pB0, pB1, alB, l_reg, pa0, pa1, pa2, pa3); SBAR();
    SLOAD((j + 2) * KVBLK); SBAR();
    if (j <= jmax) pv_d0(o, vb0 + (int)SHM_V, pa0, pa1, pa2, pa3);
    partialSM(pA0, pA1, m_reg, mnA, alA);
    __syncthreads(); SWAIT(); SWRITE(1);
    RESC(alA); __syncthreads();
  }
  SBAR(); qkt(pB0, pB1, K_lds + SHM_K, qr, qrope, kbase, NT - 1 <= jmax);
  finishSM(pA0, pA1, alA, l_reg, pa0, pa1, pa2, pa3); SBAR();
  if (NT - 2 <= jmax) pv_d0(o, vb0, pa0, pa1, pa2, pa3);
  partialSM(pB0, pB1, m_reg, mnB, alB);
  __syncthreads(); RESC(alB);
  finishSM(pB0, pB1, alB, l_reg, pa0, pa1, pa2, pa3); SBAR();
  if (NT - 1 <= jmax) pv_d0(o, vb0 + (int)SHM_V, pa0, pa1, pa2, pa3);
  if (hi == 0) li_l[r32] = l_reg; asm volatile("s_waitcnt lgkmcnt(0)" ::: "memory");
  float rli[16];
#pragma unroll
  for (int r = 0; r < 16; ++r) rli[r] = __builtin_amdgcn_rcpf(li_l[crow(r, hi)]);
  bf16_t* Ow = Ob + (long)(wid * QBLK) * LDO;
#pragma unroll
  for (int r = 0; r < 16; ++r) { int orow = crow(r, hi);
#pragma unroll
    for (int d0 = 0; d0 < 4; ++d0) Ow[(long)orow * LDO + d0 * 32 + r32] = f2bf(o[d0][r] * rli[r]); }
  __syncthreads();
#undef SLOAD
#undef SWRITE
#undef SWAIT
#undef RESC
}
}
namespace ret {
constexpr int QP_ = 136;
__device__ __forceinline__ bf16x8 ldfrag(const bf16_t* p) { return *reinterpret_cast<const bf16x8*>(p); }
template <int CL> struct Lay {
    static constexpr int IP = CL + 8;
    static constexpr int QS = 0, KS = QS + CL * QP_ * 2, VT = KS + CL * QP_ * 2, VDT = VT + 32 * IP * 2, IN = VDT + 32 * IP * 2, ST = IN + CL * IP * 2, VS = ST + 32 * QP_ * 2, END = VS + CL * 40 * 2;
};
static_assert(Lay<128>::END <= LDS_BARW, "retention LDS");

template <int CL>
__device__ __forceinline__ void run(const bf16_t* __restrict__ Y, bf16_t* __restrict__ OB, const float* __restrict__ sp, float* __restrict__ so, long tok0, int nch, int h, int es, float lg, char* lds, int tid) {
    using L = Lay<CL>; constexpr int IP = L::IP, NQT = CL / 16, NKS = CL / 32, NPC = CL / 32;
    const int wid = __builtin_amdgcn_readfirstlane(tid >> 6), lane = tid & 63, l15 = lane & 15, l4 = lane >> 4;
    bf16_t* Qs = (bf16_t*)(lds + L::QS); bf16_t* Ks = (bf16_t*)(lds + L::KS); bf16_t* Vt = (bf16_t*)(lds + L::VT); bf16_t* Vdt = (bf16_t*)(lds + L::VDT); bf16_t* In = (bf16_t*)(lds + L::IN); bf16_t* St = (bf16_t*)(lds + L::ST); bf16_t* Vs = (bf16_t*)(lds + L::VS);
    const float gCL = __expf((float)CL * lg);
    f32x4 Sacc[2];
    if (sp) {
#pragma unroll
        for (int ej = 0; ej < 2; ++ej)
#pragma unroll
            for (int r = 0; r < 4; ++r) Sacc[ej][r] = sp[(long)(16 * wid + 4 * l4 + r) * RV + 16 * ej + l15];
    } else { Sacc[0] = (f32x4){0.f, 0.f, 0.f, 0.f}; Sacc[1] = (f32x4){0.f, 0.f, 0.f, 0.f}; }
    for (int i = tid; i < CL * IP / 8; i += 512) reinterpret_cast<u32x4*>(In)[i] = (u32x4){0u, 0u, 0u, 0u};
    u32x4 pq[NPC], pk[NPC], pv;
    const int vk = tid >> 2, ve0 = (tid & 3) * 8;
#define RET_LOAD(cc) do { const bf16_t* yrow_ = Y + (tok0 + (long)(cc) * CL) * INWP; \
        _Pragma("unroll") for (int i = 0; i < NPC; ++i) { const int idx = tid + i * 512, k = idx >> 4, d0 = (idx & 15) * 8; \
            pq[i] = *reinterpret_cast<const u32x4*>(yrow_ + (long)k * INWP + C_RQ + h * 128 + d0); pk[i] = *reinterpret_cast<const u32x4*>(yrow_ + (long)k * INWP + C_RK + h * 128 + d0); } \
        if (tid < 4 * CL) pv = *reinterpret_cast<const u32x4*>(yrow_ + (long)vk * INWP + C_RV + h * 256 + es * 32 + ve0); } while (0)
    RET_LOAD(0);
    for (int c = 0; c < nch; ++c) {
#pragma unroll
        for (int ej = 0; ej < 2; ++ej) { u32x2 w; w.x = cvt_pk_bf16(Sacc[ej][0], Sacc[ej][1]); w.y = cvt_pk_bf16(Sacc[ej][2], Sacc[ej][3]);
            *reinterpret_cast<u32x2*>(St + (16 * ej + l15) * QP_ + 16 * wid + 4 * l4) = w; }
#pragma unroll
        for (int i = 0; i < NPC; ++i) { const int idx = tid + i * 512, k = idx >> 4, d0 = (idx & 15) * 8;
            *reinterpret_cast<u32x4*>(Qs + k * QP_ + d0) = pq[i]; *reinterpret_cast<u32x4*>(Ks + k * QP_ + d0) = pk[i]; }
        if (tid < 4 * CL) *reinterpret_cast<u32x4*>(Vs + vk * 40 + ve0) = pv;
        if (c + 1 < nch) RET_LOAD(c + 1);
        __syncthreads();
        if (tid < 4 * CL) { const int e = tid & 31, kg = tid >> 5; float f[8], fd[8];
#pragma unroll
            for (int j = 0; j < 8; ++j) { f[j] = bf2f(Vs[(8 * kg + j) * 40 + e]); fd[j] = f[j] * __expf((float)(CL - 1 - 8 * kg - j) * lg); }
            *reinterpret_cast<u32x4*>(Vt + e * IP + 8 * kg) = pack8(f); *reinterpret_cast<u32x4*>(Vdt + e * IP + 8 * kg) = pack8(fd); }
#pragma unroll
        for (int it_ = 0; it_ < (NQT * (NQT + 1) / 2 + 7) / 8; ++it_) { const int idx = wid + 8 * it_; if (idx >= NQT * (NQT + 1) / 2) break;
            int qi = 0; while ((qi + 1) * (qi + 2) / 2 <= idx) ++qi; const int kj = idx - qi * (qi + 1) / 2;
            f32x4 a = (f32x4){0.f, 0.f, 0.f, 0.f}; const bf16_t* qp = Qs + (16 * qi + l15) * QP_ + 8 * l4; const bf16_t* kp = Ks + (16 * kj + l15) * QP_ + 8 * l4;
#pragma unroll
            for (int ks = 0; ks < 4; ++ks) a = __builtin_amdgcn_mfma_f32_16x16x32_bf16(ldfrag(qp + 32 * ks), ldfrag(kp + 32 * ks), a, 0, 0, 0);
            const int q0 = 16 * qi + 4 * l4, k = 16 * kj + l15;
#pragma unroll
            for (int r = 0; r < 4; ++r) { const int q = q0 + r; const float dm = (q >= k) ? __expf((float)(q - k) * lg) : 0.f;
                In[q * IP + k] = f2bf(a[r] * dm); } }
        __syncthreads();
#pragma unroll
        for (int ot = 0; ot < (2 * NQT) / 8; ++ot) { const int tI = wid + 8 * ot, qi = tI >> 1, ej = tI & 1; f32x4 a = (f32x4){0.f, 0.f, 0.f, 0.f};
#pragma unroll
            for (int ks = 0; ks < 4; ++ks) a = __builtin_amdgcn_mfma_f32_16x16x32_bf16(ldfrag(Qs + (16 * qi + l15) * QP_ + 32 * ks + 8 * l4), ldfrag(St + (16 * ej + l15) * QP_ + 32 * ks + 8 * l4), a, 0, 0, 0);
#pragma unroll
            for (int r = 0; r < 4; ++r) a[r] *= __expf((float)(16 * qi + 4 * l4 + r + 1) * lg);
#pragma unroll
            for (int ks = 0; ks < NKS; ++ks) if (ks <= (qi >> 1)) a = __builtin_amdgcn_mfma_f32_16x16x32_bf16(ldfrag(In + (16 * qi + l15) * IP + 32 * ks + 8 * l4), ldfrag(Vt + (16 * ej + l15) * IP + 32 * ks + 8 * l4), a, 0, 0, 0);
            bf16_t* op = OB + ((long)(h * 8 + es) * T + tok0 + (long)c * CL + 16 * qi + 4 * l4) * 32 + 16 * ej + l15;
#pragma unroll
            for (int r = 0; r < 4; ++r) op[r * 32] = f2bf(a[r]); }
        { f32x4 s0 = Sacc[0] * gCL, s1 = Sacc[1] * gCL;
#pragma unroll
          for (int ks = 0; ks < NKS; ++ks) { bf16x8 af;
#pragma unroll
              for (int j = 0; j < 8; ++j) af[j] = (short)Ks[(32 * ks + 8 * l4 + j) * QP_ + 16 * wid + l15];
              s0 = __builtin_amdgcn_mfma_f32_16x16x32_bf16(af, ldfrag(Vdt + l15 * IP + 32 * ks + 8 * l4), s0, 0, 0, 0);
              s1 = __builtin_amdgcn_mfma_f32_16x16x32_bf16(af, ldfrag(Vdt + (16 + l15) * IP + 32 * ks + 8 * l4), s1, 0, 0, 0); }
          Sacc[0] = s0; Sacc[1] = s1; }
        __syncthreads();
    }
#undef RET_LOAD
#pragma unroll
    for (int ej = 0; ej < 2; ++ej)
#pragma unroll
        for (int r = 0; r < 4; ++r) so[(long)(16 * wid + 4 * l4 + r) * RV + 16 * ej + l15] = Sacc[ej][r];
}

__device__ __forceinline__ void unit(KParams& p, int l, int u, char* lds) {
    const int tid = otid(); unsigned char* ws = optr(gp(p.ws)); const bf16_t* Y = (const bf16_t*)(ws + WS_Y); bf16_t* OB = (bf16_t*)(ws + WS_OB);
    const bool samp = u >= 256; const int v = samp ? u - 256 : u; const int b = v >> 6, h = (v >> 3) & 7, es = v & 7; const float lg = p.lg[h];
    if (samp) run<64>(Y, OB, gp(p.state_ret) + ((((long)l * DB + b) * RH + h) * RQK) * RV + es * 32, gp(p.out) + O_RETS + ((((long)l * DB + b) * RH + h) * RQK) * RV + es * 32, (long)TP + b * 64, 1, h, es, lg, lds, tid);
    else run<64>(Y, OB, nullptr, gp(p.out) + O_RETP + ((((long)l * NB + b) * RH + h) * RQK) * RV + es * 32, (long)b * SEQ, SEQ / 64, h, es, lg, lds, tid);
}
}
namespace peer {
__device__ __forceinline__ void ins16(float (&l)[16], float x) {
#pragma unroll
    for (int j = 0; j < 16; ++j) { const float hi = fmaxf(l[j], x); x = fminf(l[j], x); l[j] = hi; }
}
#define CE_DESC(a, b) do { const float hi_ = fmaxf(a, b), lo_ = fminf(a, b); a = hi_; b = lo_; } while (0)
#define CE_ASC(a, b) do { const float hi_ = fmaxf(a, b), lo_ = fminf(a, b); a = lo_; b = hi_; } while (0)
__device__ __forceinline__ void sort16_desc(float (&v)[16]) {
#pragma unroll
    for (int k = 2; k <= 16; k <<= 1)
#pragma unroll
        for (int j = k >> 1; j >= 1; j >>= 1)
#pragma unroll
            for (int i = 0; i < 16; ++i) { const int l = i ^ j; if (l > i) { if ((i & k) == 0) CE_DESC(v[i], v[l]); else CE_ASC(v[i], v[l]); } }
}
__device__ __forceinline__ void merge16_desc(float (&l)[16], const float (&o)[16]) {
#pragma unroll
    for (int i = 0; i < 16; ++i) l[i] = fmaxf(l[i], o[15 - i]);
#pragma unroll
    for (int j = 8; j >= 1; j >>= 1)
#pragma unroll
        for (int i = 0; i < 16; ++i) { const int m = i ^ j; if (m > i) CE_DESC(l[i], l[m]); }
}
constexpr int KPITCH = 136;
__device__ __forceinline__ void half_top16(const bf16_t* __restrict__ qrow, const bf16_t* __restrict__ keys, int lane, float (&l)[16]) {
    const int r32 = lane & 31, g = lane >> 5;
#pragma unroll
    for (int j = 0; j < 16; ++j) l[j] = -3.0e38f;
    bf16x8 qf[8];
#pragma unroll
    for (int ks = 0; ks < 8; ++ks) qf[ks] = *reinterpret_cast<const bf16x8*>(qrow + 16 * ks + 8 * g);
#pragma unroll 1
    for (int kb = 0; kb < 4; ++kb) { f32x16 a = f32x16{};
#pragma unroll
        for (int ks = 0; ks < 8; ++ks) { const bf16x8 kf = *reinterpret_cast<const bf16x8*>(keys + (32 * kb + r32) * KPITCH + 16 * ks + 8 * g);
            a = __builtin_amdgcn_mfma_f32_32x32x16_bf16(kf, qf[ks], a, 0, 0, 0); }
        float blk[16];
#pragma unroll
        for (int r = 0; r < 16; ++r) { const unsigned key = (unsigned)(32 * kb + (r & 3) + 8 * (r >> 2) + 4 * g);
            blk[r] = __uint_as_float((__float_as_uint(a[r]) & ~0x7Fu) | key); }
        sort16_desc(blk); merge16_desc(l, blk); }
}
__device__ __forceinline__ void merge_lists(float (&l)[16], const float (&o)[16]) { merge16_desc(l, o); }
__device__ __forceinline__ void select_unit(const bf16_t* __restrict__ QP, const bf16_t* __restrict__ k1, const bf16_t* __restrict__ k2, int* __restrict__ PIDX, float* __restrict__ PW,
                                            int t0, int h, int lane, float* lds_lane  ) {
    const int r32 = lane & 31, g = lane >> 5;
    const bf16_t* qrow = QP + (long)(t0 + r32) * DM + h * 256;
    float la[16], lb[16];
    half_top16(qrow, k1, lane, la);
    half_top16(qrow + 128, k2, lane, lb);
    float m0[16], m1[16];
#pragma unroll
    for (int j = 0; j < 16; ++j) { auto rr = __builtin_amdgcn_permlane32_swap(__float_as_uint(la[j]), __float_as_uint(lb[j]), false, false); m0[j] = __uint_as_float(rr[0]); m1[j] = __uint_as_float(rr[1]); }
    merge_lists(m0, m1);
    float L1[16], L2[16];
#pragma unroll
    for (int j = 0; j < 16; ++j) { auto rr = __builtin_amdgcn_permlane32_swap(__float_as_uint(m0[j]), __float_as_uint(m0[j]), false, false);
        L1[j] = __uint_as_float(rr[0]); L2[j] = __uint_as_float(rr[1]); }
#define CAND(i, j) __uint_as_float((__float_as_uint(L1[i] + L2[j]) & ~0xFFu) | (unsigned)((i) * 16 + (j)))
    float best[16], c2[16], c3[16];
#pragma unroll
    for (int j = 0; j < 16; ++j) best[j] = CAND(0, j);
    sort16_desc(best);
    c2[0] = CAND(1, 0); c2[1] = CAND(1, 1); c2[2] = CAND(1, 2); c2[3] = CAND(1, 3); c2[4] = CAND(1, 4); c2[5] = CAND(1, 5); c2[6] = CAND(1, 6); c2[7] = CAND(1, 7);
    c2[8] = CAND(2, 0); c2[9] = CAND(2, 1); c2[10] = CAND(2, 2); c2[11] = CAND(2, 3); c2[12] = CAND(2, 4); c2[13] = CAND(4, 0); c2[14] = CAND(4, 1); c2[15] = CAND(4, 2);
    sort16_desc(c2); merge16_desc(best, c2);
    c3[0] = CAND(3, 0); c3[1] = CAND(3, 1); c3[2] = CAND(3, 2); c3[3] = CAND(3, 3); c3[4] = CAND(5, 0); c3[5] = CAND(5, 1); c3[6] = CAND(6, 0); c3[7] = CAND(6, 1);
    c3[8] = CAND(7, 0); c3[9] = CAND(7, 1); c3[10] = CAND(8, 0); c3[11] = CAND(9, 0); c3[12] = CAND(10, 0); c3[13] = CAND(11, 0); c3[14] = CAND(12, 0); c3[15] = CAND(13, 0);
    sort16_desc(c3); merge16_desc(best, c3);
    ins16(best, CAND(14, 0)); ins16(best, CAND(15, 0));
#undef CAND
#pragma unroll
    for (int j = 0; j < 16; ++j) { lds_lane[j] = __uint_as_float(__float_as_uint(L1[j]) & 0x7Fu); lds_lane[16 + j] = __uint_as_float(__float_as_uint(L2[j]) & 0x7Fu); }
    asm volatile("s_waitcnt lgkmcnt(0)" ::: "memory");
    float wsum = 0.f, w[16]; int ei[16];
    const float mx = best[0];
#pragma unroll
    for (int k = 0; k < 16; ++k) { const unsigned code = __float_as_uint(best[k]) & 0xFFu; const int i = (int)(code >> 4), j = (int)(code & 15u);
        const int i1 = (int)__float_as_uint(lds_lane[i]), i2 = (int)__float_as_uint(lds_lane[16 + j]); ei[k] = i1 * NKEYS + i2;
        w[k] = __expf(best[k] - mx); wsum += w[k]; }
    const float inv = 1.0f / wsum;
    if (g == 0) { int* ip = PIDX + (long)(t0 + r32) * 128 + h * 16; float* wp = PW + (long)(t0 + r32) * 128 + h * 16;
#pragma unroll
        for (int k = 0; k < 16; k += 4) { *reinterpret_cast<int4*>(ip + k) = make_int4(ei[k], ei[k + 1], ei[k + 2], ei[k + 3]);
            *reinterpret_cast<float4*>(wp + k) = make_float4(w[k] * inv, w[k + 1] * inv, w[k + 2] * inv, w[k + 3] * inv); } }
}

__device__ __forceinline__ float gelu_exact(float x) { return 0.5f * x * (1.0f + erff(x * 0.70710678118654752f)); }

__device__ __forceinline__ void dec16(const u32x4 w, f32x2 (&f)[8]) {
    f[0] = __builtin_amdgcn_cvt_pk_f32_fp8((int)w.x, false); f[1] = __builtin_amdgcn_cvt_pk_f32_fp8((int)w.x, true);
    f[2] = __builtin_amdgcn_cvt_pk_f32_fp8((int)w.y, false); f[3] = __builtin_amdgcn_cvt_pk_f32_fp8((int)w.y, true);
    f[4] = __builtin_amdgcn_cvt_pk_f32_fp8((int)w.z, false); f[5] = __builtin_amdgcn_cvt_pk_f32_fp8((int)w.z, true);
    f[6] = __builtin_amdgcn_cvt_pk_f32_fp8((int)w.w, false); f[7] = __builtin_amdgcn_cvt_pk_f32_fp8((int)w.w, true);
}
__device__ __forceinline__ void dec16_i8(const u32x4 w, f32x2 (&f)[8]) {
    const unsigned ww[4] = {w.x, w.y, w.z, w.w};
#pragma unroll
    for (int i = 0; i < 4; ++i) { f[2 * i] = (f32x2){(float)(int)(signed char)(ww[i] & 0xffu), (float)(int)(signed char)((ww[i] >> 8) & 0xffu)}; f[2 * i + 1] = (f32x2){(float)(int)(signed char)((ww[i] >> 16) & 0xffu), (float)(int)(signed char)(ww[i] >> 24)}; }
}
__device__ __forceinline__ void gather_token(const unsigned char* __restrict__ H8, const float* __restrict__ SA8, const unsigned char* __restrict__ PU, const unsigned char* __restrict__ PV, const float* __restrict__ SU, const float* __restrict__ SV,
                                             const int* __restrict__ PIDX, const float* __restrict__ PW, float* __restrict__ X, const float* __restrict__ gate  , int t, int lane) {
    f32x2 xf[2][8];
#pragma unroll
    for (int hlf = 0; hlf < 2; ++hlf) dec16_i8(*reinterpret_cast<const u32x4*>(H8 + (long)t * DM + 1024 * hlf + 16 * lane), xf[hlf]);
    const float sat = SA8[t];
    f32x2 out[2][8];
#pragma unroll
    for (int hlf = 0; hlf < 2; ++hlf)
#pragma unroll
        for (int i = 0; i < 8; ++i) out[hlf][i] = (f32x2){0.f, 0.f};
    const int myidx0 = PIDX[(long)t * 128 + lane], myidx1 = PIDX[(long)t * 128 + 64 + lane];
    const float myw0 = PW[(long)t * 128 + lane], myw1 = PW[(long)t * 128 + 64 + lane];
    const float msu0 = SU[myidx0], msu1 = SU[myidx1], msv0 = SV[myidx0], msv1 = SV[myidx1];
    for (int hk = 0; hk < 128; hk += 4) {
        const int src = hk & 63; const bool lo = hk < 64;
        const int selidx = lo ? myidx0 : myidx1; const int selw = __float_as_int(lo ? myw0 : myw1), selsu = __float_as_int(lo ? msu0 : msu1), selsv = __float_as_int(lo ? msv0 : msv1);
        int e[4]; float g[4], su[4], sv[4];
#pragma unroll
        for (int k = 0; k < 4; ++k) { e[k] = __builtin_amdgcn_readlane(selidx, src + k); g[k] = __int_as_float(__builtin_amdgcn_readlane(selw, src + k));
            su[k] = __int_as_float(__builtin_amdgcn_readlane(selsu, src + k)); sv[k] = __int_as_float(__builtin_amdgcn_readlane(selsv, src + k)); }
        u32x4 uw[4][2], vw[4][2];
#pragma unroll
        for (int k = 0; k < 4; ++k) { uw[k][0] = *reinterpret_cast<const u32x4*>(PU + ((long)(lane >> 3) * NEXP + e[k]) * 128 + 16 * (lane & 7)); uw[k][1] = *reinterpret_cast<const u32x4*>(PU + ((long)(8 + (lane >> 3)) * NEXP + e[k]) * 128 + 16 * (lane & 7)); }
#pragma unroll
        for (int k = 0; k < 4; ++k) { { const u32x2 a0 = *reinterpret_cast<const u32x2*>(PV + ((long)(2 * lane) * NEXP + e[k]) * 8), a1 = *reinterpret_cast<const u32x2*>(PV + ((long)(2 * lane + 1) * NEXP + e[k]) * 8);
              const u32x2 b0 = *reinterpret_cast<const u32x2*>(PV + ((long)(128 + 2 * lane) * NEXP + e[k]) * 8), b1 = *reinterpret_cast<const u32x2*>(PV + ((long)(129 + 2 * lane) * NEXP + e[k]) * 8);
              vw[k][0] = (u32x4){a0.x, a0.y, a1.x, a1.y}; vw[k][1] = (u32x4){b0.x, b0.y, b1.x, b1.y}; } }
        float a[4];
#pragma unroll
        for (int k = 0; k < 4; ++k) { f32x2 d = (f32x2){0.f, 0.f};
#pragma unroll
            for (int hlf = 0; hlf < 2; ++hlf) { f32x2 f[8]; dec16_i8(uw[k][hlf], f);
#pragma unroll
                for (int i = 0; i < 8; ++i) d = __builtin_elementwise_fma(f[i], xf[hlf][i], d); }
            a[k] = wave_sum(d[0] + d[1]) * sat; }
#pragma unroll
        for (int k = 0; k < 4; ++k) { const float ak = g[k] * gelu_exact(a[k] * su[k]) * sv[k]; const f32x2 a2 = (f32x2){ak, ak};
#pragma unroll
            for (int hlf = 0; hlf < 2; ++hlf) { f32x2 f[8]; dec16(vw[k][hlf], f);
#pragma unroll
                for (int i = 0; i < 8; ++i) out[hlf][i] = __builtin_elementwise_fma(f[i], a2, out[hlf][i]); } }
    }
    const float* gr = gate + (long)cond_row(t) * 12288;
#pragma unroll
    for (int hlf = 0; hlf < 2; ++hlf)
#pragma unroll
        for (int q = 0; q < 4; ++q) { const int c = 1024 * hlf + 16 * lane + 4 * q; float* xp = X + (long)t * DM + c;
            const f32x4 gv = *reinterpret_cast<const f32x4*>(gr + c); f32x4 xv = *reinterpret_cast<const f32x4*>(xp);
            xv[0] += gv[0] * out[hlf][2 * q][0]; xv[1] += gv[1] * out[hlf][2 * q][1]; xv[2] += gv[2] * out[hlf][2 * q + 1][0]; xv[3] += gv[3] * out[hlf][2 * q + 1][1];
            *reinterpret_cast<f32x4*>(xp) = xv; }
}

constexpr int SW = 128, NSL = DM / SW;
struct XInfo { int rank, xi, nx, nloc; };
__device__ __forceinline__ void upass(const unsigned char* __restrict__ H8, const float* __restrict__ SA, const unsigned char* __restrict__ PU, const int* __restrict__ PIDX, const float* __restrict__ PW, const float* __restrict__ SU, const float* __restrict__ SV,
                                      int* __restrict__ DOTP, unsigned* __restrict__ PACKT, const XInfo xin, int wid, int lane) {
    const int g = lane >> 3, c = lane & 7; const int nwv = xin.nloc * 8;
    const int tlo = (int)((long)T * xin.xi / xin.nx), thi = (int)((long)T * (xin.xi + 1) / xin.nx); const int wv = tlo + xin.rank * 8 + wid;
    int* dp = DOTP;
#define SXI(K, v_) __float_as_int(sx<K>(__int_as_float(v_)))
    for (int s = 0; s < NSL; ++s) { const bool first = (s == 0), lastS = (s == NSL - 1);
        const __amdgpu_buffer_rsrc_t urs = __builtin_amdgcn_make_buffer_rsrc((void*)(PU + (long)s * NEXP * SW), 0, NEXP * SW, 0x00020000);
#define UP_ROW(e_) __builtin_bit_cast(u32x4, __builtin_amdgcn_raw_buffer_load_b128(urs, (e_) * SW + 16 * c, 0, 0))
#define UP_IDX(tt, q4) (*reinterpret_cast<const int4*>(PIDX + (long)(tt) * 128 + 16 * g + 4 * (q4)))
#define UP_X(tt) (*reinterpret_cast<const u32x4*>(H8 + (long)(tt) * DM + SW * s + 16 * c))
#define UP_DOT(r_) __builtin_amdgcn_sdot4((int)(r_).x, (int)xv.x, __builtin_amdgcn_sdot4((int)(r_).y, (int)xv.y, __builtin_amdgcn_sdot4((int)(r_).z, (int)xv.z, __builtin_amdgcn_sdot4((int)(r_).w, (int)xv.w, 0, false), false), false), false)
        if (wv >= thi) continue;
        u32x4 A[8], B[8]; int4 en[4]; u32x4 xn;
        { int4 e0[4];
#pragma unroll
          for (int q4 = 0; q4 < 4; ++q4) e0[q4] = UP_IDX(wv, q4);
          A[0] = UP_ROW(e0[0].x); A[1] = UP_ROW(e0[0].y); A[2] = UP_ROW(e0[0].z); A[3] = UP_ROW(e0[0].w); A[4] = UP_ROW(e0[1].x); A[5] = UP_ROW(e0[1].y); A[6] = UP_ROW(e0[1].z); A[7] = UP_ROW(e0[1].w);
          B[0] = UP_ROW(e0[2].x); B[1] = UP_ROW(e0[2].y); B[2] = UP_ROW(e0[2].z); B[3] = UP_ROW(e0[2].w); B[4] = UP_ROW(e0[3].x); B[5] = UP_ROW(e0[3].y); B[6] = UP_ROW(e0[3].z); B[7] = UP_ROW(e0[3].w);
          const int t1 = (wv + nwv < thi) ? wv + nwv : wv;
#pragma unroll
          for (int q4 = 0; q4 < 4; ++q4) en[q4] = UP_IDX(t1, q4);
          xn = UP_X(wv); }
        int2 dnx = make_int2(0, 0);
        if (!first) dnx = *reinterpret_cast<const int2*>(dp + (long)wv * 128 + 16 * g + 2 * c);
#pragma unroll 1
        for (int t = wv; t < thi; t += nwv) {
            const int tn = (t + nwv < thi) ? t + nwv : t, tnn = (tn + nwv < thi) ? tn + nwv : tn;
            const int2 dcur = dnx;
            if (!first) dnx = *reinterpret_cast<const int2*>(dp + (long)tn * 128 + 16 * g + 2 * c);
            const u32x4 xv = xn; xn = UP_X(tn);
            int d[16];
#pragma unroll
            for (int i = 0; i < 8; ++i) d[i] = UP_DOT(A[i]);
            A[0] = UP_ROW(en[0].x); A[1] = UP_ROW(en[0].y); A[2] = UP_ROW(en[0].z); A[3] = UP_ROW(en[0].w); A[4] = UP_ROW(en[1].x); A[5] = UP_ROW(en[1].y); A[6] = UP_ROW(en[1].z); A[7] = UP_ROW(en[1].w);
#pragma unroll
            for (int i = 0; i < 8; ++i) d[8 + i] = UP_DOT(B[i]);
            B[0] = UP_ROW(en[2].x); B[1] = UP_ROW(en[2].y); B[2] = UP_ROW(en[2].z); B[3] = UP_ROW(en[2].w); B[4] = UP_ROW(en[3].x); B[5] = UP_ROW(en[3].y); B[6] = UP_ROW(en[3].z); B[7] = UP_ROW(en[3].w);
#pragma unroll
            for (int q4 = 0; q4 < 4; ++q4) en[q4] = UP_IDX(tnn, q4);
            int r8[8], r4[4], r2[2];
#pragma unroll
            for (int k = 0; k < 8; ++k) { const int keep = (c & 4) ? d[k + 8] : d[k], send = (c & 4) ? d[k] : d[k + 8]; r8[k] = keep + SXI(4, send); }
#pragma unroll
            for (int k = 0; k < 4; ++k) { const int keep = (c & 2) ? r8[k + 4] : r8[k], send = (c & 2) ? r8[k] : r8[k + 4]; r4[k] = keep + SXI(2, send); }
#pragma unroll
            for (int k = 0; k < 2; ++k) { const int keep = (c & 1) ? r4[k + 2] : r4[k], send = (c & 1) ? r4[k] : r4[k + 2]; r2[k] = keep + SXI(1, send); }
            int* o = dp + (long)t * 128 + 16 * g + 2 * c;
            const int a0i = r2[0] + dcur.x, a1i = r2[1] + dcur.y;
            if (!lastS) *reinterpret_cast<int2*>(o) = make_int2(a0i, a1i);
            else {
                const int p0 = 16 * g + 2 * c; const int2 ee = *reinterpret_cast<const int2*>(PIDX + (long)t * 128 + p0); const f32x2 gw = *reinterpret_cast<const f32x2*>(PW + (long)t * 128 + p0); const float sa = SA[t];
                const float a0 = gw[0] * gelu_exact((float)a0i * sa * SU[ee.x]) * SV[ee.x], a1 = gw[1] * gelu_exact((float)a1i * sa * SU[ee.y]) * SV[ee.y];
                u32x2 pk; pk.x = (cvt_pk_bf16(0.f, a0) & 0xffff0000u) | (unsigned)ee.x; pk.y = (cvt_pk_bf16(0.f, a1) & 0xffff0000u) | (unsigned)ee.y;
                *reinterpret_cast<u32x2*>(PACKT + ((long)(p0 >> 2) * T + t) * 4 + (p0 & 3)) = pk; }
        }
#undef UP_ROW
#undef UP_IDX
#undef UP_X
#undef UP_DOT
    }
#undef SXI
}
__device__ __forceinline__ void actpass(const float* __restrict__ DOTP, const int* __restrict__ PIDX, const float* __restrict__ PW, const float* __restrict__ SU, const float* __restrict__ SV, float* __restrict__ ACT, int nx, long gt, long nt) {
    for (long i = gt; i < (long)T * 128; i += nt) { float dsum = 0.f;
        for (int x = 0; x < nx; ++x) dsum += DOTP[(long)x * T * 128 + i];
        const int e = PIDX[i]; const float av = PW[i] * gelu_exact(dsum * SU[e]) * SV[e]; const long t = i >> 7; const int pp = (int)(i & 127);
        reinterpret_cast<unsigned*>(ACT)[((long)(pp >> 2) * T + t) * 4 + (pp & 3)] = (cvt_pk_bf16(0.f, av) & 0xffff0000u) | (unsigned)e; }
}
__device__ __forceinline__ void vpass(const unsigned char* __restrict__ PV, const int* __restrict__ PIDX, const float* __restrict__ ACT, float* __restrict__ X, const float* __restrict__ gate, const XInfo xin, int wid, int lane) {
    const int g = lane >> 3, c = lane & 7; const int wv = xin.rank * 8 + wid, nwv = xin.nloc * 8;
    for (int s = xin.xi; s < NSL; s += xin.nx) {
        int4 en[4]; f32x4 an[4];
#pragma unroll
        for (int q4 = 0; q4 < 4; ++q4) { en[q4] = *reinterpret_cast<const int4*>(PIDX + (long)(wv < T ? wv : 0) * 128 + 16 * g + 4 * q4); an[q4] = *reinterpret_cast<const f32x4*>(ACT + (long)(wv < T ? wv : 0) * 128 + 16 * g + 4 * q4); }
        for (int t = wv; t < T; t += nwv) {
            int e[16]; float a[16];
#pragma unroll
            for (int q4 = 0; q4 < 4; ++q4) { e[4 * q4] = en[q4].x; e[4 * q4 + 1] = en[q4].y; e[4 * q4 + 2] = en[q4].z; e[4 * q4 + 3] = en[q4].w; a[4 * q4] = an[q4][0]; a[4 * q4 + 1] = an[q4][1]; a[4 * q4 + 2] = an[q4][2]; a[4 * q4 + 3] = an[q4][3]; }
            u32x4 w[16];
#pragma unroll
            for (int i = 0; i < 16; ++i) w[i] = *reinterpret_cast<const u32x4*>(PV + ((long)s * NEXP + e[i]) * SW + 16 * c);
            { const int tn = (t + nwv < T) ? t + nwv : t;
#pragma unroll
              for (int q4 = 0; q4 < 4; ++q4) { en[q4] = *reinterpret_cast<const int4*>(PIDX + (long)tn * 128 + 16 * g + 4 * q4); an[q4] = *reinterpret_cast<const f32x4*>(ACT + (long)tn * 128 + 16 * g + 4 * q4); } }
            f32x2 o[8];
#pragma unroll
            for (int k = 0; k < 8; ++k) o[k] = (f32x2){0.f, 0.f};
#pragma unroll
            for (int i = 0; i < 16; ++i) { f32x2 f[8]; dec16(w[i], f); const f32x2 a2 = (f32x2){a[i], a[i]};
#pragma unroll
                for (int k = 0; k < 8; ++k) o[k] = __builtin_elementwise_fma(f[k], a2, o[k]); }
            f32x2 r4[4], r2[2], r1;
#pragma unroll
            for (int k = 0; k < 4; ++k) { const f32x2 keep = (g & 4) ? o[k + 4] : o[k], send = (g & 4) ? o[k] : o[k + 4]; r4[k] = keep + (f32x2){sx<32>(send[0]), sx<32>(send[1])}; }
#pragma unroll
            for (int k = 0; k < 2; ++k) { const f32x2 keep = (g & 2) ? r4[k + 2] : r4[k], send = (g & 2) ? r4[k] : r4[k + 2]; r2[k] = keep + (f32x2){sx<16>(send[0]), sx<16>(send[1])}; }
            { const f32x2 keep = (g & 1) ? r2[1] : r2[0], send = (g & 1) ? r2[0] : r2[1]; r1 = keep + (f32x2){sx<8>(send[0]), sx<8>(send[1])}; }
            const int col = SW * s + 16 * c + 2 * g;
            const f32x2 gv = *reinterpret_cast<const f32x2*>(gate + (long)cond_row(t) * 12288 + col);
            float* xp = X + (long)t * DM + col; f32x2 xv = *reinterpret_cast<const f32x2*>(xp);
            xv += gv * r1; *reinterpret_cast<f32x2*>(xp) = xv;
        }
    }
}

__device__ __forceinline__ void vpass_lds(const unsigned char* __restrict__ PV, const unsigned* __restrict__ PACKT, float* __restrict__ X, const float* __restrict__ gate, char* lds, int bid, int nb, int s_end, int tid) {
    const int wid = tid >> 6, lane = tid & 63;
    for (int s = bid; s < s_end; s += nb) {
        __syncthreads();
        { const u32x4* src = reinterpret_cast<const u32x4*>(PV + (long)s * NEXP * 8); u32x4* dst = reinterpret_cast<u32x4*>(lds);
#pragma unroll 4
          for (int i = tid; i < NEXP * 8 / 16; i += 512) dst[i] = src[i]; }
        __syncthreads();
        u32x4 h0[8], h1[8];
        const __amdgpu_buffer_rsrc_t vrs = __builtin_amdgcn_make_buffer_rsrc((void*)PACKT, 0, (int)((size_t)T * 128 * 4), 0x00020000);
#define VP_LD(k, toff) __builtin_bit_cast(u32x4, __builtin_amdgcn_raw_buffer_load_b128(vrs, (int)(toff), (int)((size_t)(k) * T * 16), 0))
        { const unsigned toff = (unsigned)(wid * 64 + lane) * 16u;
#pragma unroll
          for (int k = 0; k < 8; ++k) h0[k] = VP_LD(k, toff);
#pragma unroll
          for (int k = 0; k < 8; ++k) h1[k] = VP_LD(8 + k, toff); }
#define VP_STEP(HB) do { _Pragma("unroll") for (int kk = 0; kk < 8; kk += 2) { unsigned pw[8]; \
            _Pragma("unroll") for (int k = 0; k < 2; ++k) { pw[4 * k] = HB[kk + k].x; pw[4 * k + 1] = HB[kk + k].y; pw[4 * k + 2] = HB[kk + k].z; pw[4 * k + 3] = HB[kk + k].w; } \
            u32x2 w[8]; \
            _Pragma("unroll") for (int k = 0; k < 8; ++k) w[k] = *reinterpret_cast<const u32x2*>(lds + (pw[k] & 0xffffu) * 8u); \
            _Pragma("unroll") for (int k = 0; k < 8; ++k) { const float a = __uint_as_float(pw[k] & 0xffff0000u); \
                const f32x2 f0 = __builtin_amdgcn_cvt_pk_f32_fp8((int)w[k].x, false), f1 = __builtin_amdgcn_cvt_pk_f32_fp8((int)w[k].x, true), f2 = __builtin_amdgcn_cvt_pk_f32_fp8((int)w[k].y, false), f3 = __builtin_amdgcn_cvt_pk_f32_fp8((int)w[k].y, true); \
                acc[0] = fmaf(a, f0[0], acc[0]); acc[1] = fmaf(a, f0[1], acc[1]); acc[2] = fmaf(a, f1[0], acc[2]); acc[3] = fmaf(a, f1[1], acc[3]); \
                acc[4] = fmaf(a, f2[0], acc[4]); acc[5] = fmaf(a, f2[1], acc[5]); acc[6] = fmaf(a, f3[0], acc[6]); acc[7] = fmaf(a, f3[1], acc[7]); } } } while (0)
#pragma unroll 1
        for (int tg = wid; tg < T / 64; tg += 8) { const int t = tg * 64 + lane; const int tgn = (tg + 8 < T / 64) ? tg + 8 : tg;
            const unsigned toff = (unsigned)t * 16u, toffn = (unsigned)(tgn * 64 + lane) * 16u;
            float acc[8];
#pragma unroll
            for (int j = 0; j < 8; ++j) acc[j] = 0.f;
            VP_STEP(h0);
#pragma unroll
            for (int k = 0; k < 8; ++k) h0[k] = VP_LD(16 + k, toff);
            VP_STEP(h1);
#pragma unroll
            for (int k = 0; k < 8; ++k) h1[k] = VP_LD(24 + k, toff);
            VP_STEP(h0);
#pragma unroll
            for (int k = 0; k < 8; ++k) h0[k] = VP_LD(k, toffn);
            VP_STEP(h1);
#pragma unroll
            for (int k = 0; k < 8; ++k) h1[k] = VP_LD(8 + k, toffn);
            const float* gr = gate + (long)cond_row(t) * 12288 + 8 * s; float* xp = X + (long)t * DM + 8 * s;
            const f32x4 g0 = *reinterpret_cast<const f32x4*>(gr), g1 = *reinterpret_cast<const f32x4*>(gr + 4);
            f32x4 x0 = *reinterpret_cast<const f32x4*>(xp), x1 = *reinterpret_cast<const f32x4*>(xp + 4);
            x0[0] += g0[0] * acc[0]; x0[1] += g0[1] * acc[1]; x0[2] += g0[2] * acc[2]; x0[3] += g0[3] * acc[3];
            x1[0] += g1[0] * acc[4]; x1[1] += g1[1] * acc[5]; x1[2] += g1[2] * acc[6]; x1[3] += g1[3] * acc[7];
            *reinterpret_cast<f32x4*>(xp) = x0; *reinterpret_cast<f32x4*>(xp + 4) = x1; }
#undef VP_STEP
#undef VP_LD
    }
    __syncthreads();
}
}
namespace ph {
__device__ __forceinline__ int gwave() { return obid() * 8 + (otid() >> 6); }
__device__ __forceinline__ int nwaves() { return ogrid() * 8; }
__device__ __forceinline__ long gthread() { return (long)obid() * 512 + otid(); }
__device__ __forceinline__ long nthreads() { return (long)ogrid() * 512; }

__device__ __forceinline__ void transpose_tile(const float* __restrict__ src, int C, int r0, int c0, bf16_t* __restrict__ dst, long dpitch, float* tile) {
    const int tid = otid();
#pragma unroll
    for (int i = 0; i < 8; ++i) { const int idx = tid + 512 * i, r = idx >> 6, c = idx & 63; tile[r * 65 + c] = src[(long)(r0 + r) * C + c0 + c]; }
    __syncthreads();
    { const int c = tid >> 3, rc = (tid & 7) * 8; float f[8];
#pragma unroll
      for (int j = 0; j < 8; ++j) f[j] = tile[(rc + j) * 65 + c];
      *reinterpret_cast<u32x4*>(dst + (long)(c0 + c) * dpitch + r0 + rc) = pack8(f); }
    __syncthreads();
}

__device__ __forceinline__ void zero_chunks(bf16_t* base, long nrows, long rowpitch, int col0, int nchunk) {
    const long total = nrows * nchunk;
    for (long i = gthread(); i < total; i += nthreads()) { const long r = i / nchunk; const int ch = (int)(i % nchunk);
        *reinterpret_cast<u32x4*>(base + r * rowpitch + col0 + ch * 8) = (u32x4){0u, 0u, 0u, 0u}; }
}

__device__ __forceinline__ void prologue(KParams& p, char* lds) {
    unsigned char* ws = optr(gp(p.ws)); const int tid = otid();
    float* tile = (float*)lds;
    { struct TJob { const float* src; bf16_t* dst; int R, C, r0, c0, perm; };
      auto decode = [&](int it) { TJob j; j.perm = 0; const int l = it / 10656; int r = it % 10656;
        if (r < 5664) { j.src = gp(p.w_in) + (long)l * DM * INW; j.R = DM; j.C = INW; j.dst = (bf16_t*)(ws + WS_WIN) + (long)l * INWP * DM; }
        else if (r < 6048) { r -= 5664; j.src = gp(p.w_uq) + (long)l * 512 * 3072; j.R = 512; j.C = 3072; j.dst = (bf16_t*)(ws + WS_WUQ) + (long)l * 3072 * 512; j.perm = 1; }
        else if (r < 6560) { r -= 6048; j.src = gp(p.w_ukv) + (long)l * 512 * 4096; j.R = 512; j.C = 4096; j.dst = (bf16_t*)(ws + WS_WUKV) + (long)l * 4096 * 512; }
        else { r -= 6560; const int m = r >> 10; r &= 1023; j.R = DM; j.C = DM;
            j.src = (m == 0 ? gp(p.w_a) : m == 1 ? gp(p.w_b) : m == 2 ? gp(p.w_o) : gp(p.w_pq)) + (long)l * DM * DM;
            j.dst = (bf16_t*)(ws + (m == 0 ? WS_WA : m == 1 ? WS_WB : m == 2 ? WS_WO : WS_WPQ)) + (long)l * DM * DM; }
        const int ntc = j.C / 64; j.r0 = (r / ntc) * 64; j.c0 = (r % ntc) * 64; return j; };
      const int NTILES = 2 * 10656, G_ = ogrid(); int it = obid(); float v[8]; TJob cur{};
      if (it < NTILES) { cur = decode(it);
#pragma unroll
        for (int i = 0; i < 8; ++i) { const int idx = tid + 512 * i, r = idx >> 6, c = idx & 63; v[i] = cur.src[(long)(cur.r0 + r) * cur.C + cur.c0 + c]; } }
      while (it < NTILES) { const int itn = it + G_; float vn[8]; TJob nxt{};
        if (itn < NTILES) { nxt = decode(itn);
#pragma unroll
            for (int i = 0; i < 8; ++i) { const int idx = tid + 512 * i, r = idx >> 6, c = idx & 63; vn[i] = nxt.src[(long)(nxt.r0 + r) * nxt.C + nxt.c0 + c]; } }
#pragma unroll
        for (int i = 0; i < 8; ++i) { const int idx = tid + 512 * i, r = idx >> 6, c = idx & 63; tile[r * 65 + c] = v[i]; }
        __syncthreads();
        { const int c = tid >> 3, rc = (tid & 7) * 8; float f[8];
#pragma unroll
          for (int jj = 0; jj < 8; ++jj) f[jj] = tile[(rc + jj) * 65 + c];
          int drow = cur.c0 + c;
          if (cur.perm) { const int gq = drow / 768, o = drow - 768 * gq, hh = o / 192, w = o - 192 * hh;
              drow = 768 * gq + (w < 128 ? 128 * hh + w : (w < 160 ? 512 + 32 * hh + (w - 128) : 640 + 32 * hh + (w - 160))); }
          *reinterpret_cast<u32x4*>(cur.dst + (long)drow * cur.R + cur.r0 + rc) = pack8(f); }
        __syncthreads();
#pragma unroll
        for (int i = 0; i < 8; ++i) v[i] = vn[i];
        cur = nxt; it = itn; } }
    for (long i = gthread(); i < 2L * 16 * 512 * 32; i += nthreads()) { const int ch = (int)(i & 31); const long row = i >> 5; const int c = (int)(row & 511), h = (int)((row >> 9) & 15), l = (int)(row >> 13);
        u32x4 w = (u32x4){0u, 0u, 0u, 0u};
        if (ch < 16) { const float* s = gp(p.w_ukv) + (((long)l * 512 + c) * 16 + h) * 256 + ch * 8; float f[8];
#pragma unroll
            for (int j = 0; j < 8; ++j) f[j] = s[j];
            w = pack8(f); }
        *reinterpret_cast<u32x4*>((bf16_t*)(ws + WS_WUK) + row * 256 + ch * 8) = w; }
    for (long i = gthread(); i < 2L * 4096; i += nthreads()) { const bool second = i >= 4096; const long j8 = (second ? i - 4096 : i) * 8; const float* s = (second ? gp(p.peer_k2) : gp(p.peer_k1)) + j8; float f[8];
#pragma unroll
        for (int j = 0; j < 8; ++j) f[j] = s[j];
        *reinterpret_cast<u32x4*>((bf16_t*)(ws + (second ? WS_PK2 : WS_PK1)) + j8) = pack8(f); }
    for (int l = 0; l < 2; ++l) zero_chunks((bf16_t*)(ws + WS_WIN) + ((long)l * INWP + INW) * DM, INWP - INW, DM, 0, DM / 8);
    for (int b = 0; b < DB; ++b) zero_chunks((bf16_t*)(ws + WS_CKA) + ((long)b * KPAD + KALL) * QLD, KPAD - KALL, QLD, 0, QLD / 8);
    zero_chunks((bf16_t*)(ws + WS_CKA), (long)DB * KPAD, QLD, 576, 8);
    zero_chunks((bf16_t*)(ws + WS_CKT), (long)DB * 512, KPAD, KALL, (KPAD - KALL) / 8);
    zero_chunks((bf16_t*)(ws + WS_QL), (long)DB * 1024, QLD, 576, 8);
    for (long i = gthread(); i < 4096L * 96; i += nthreads()) { const int pos = (int)(i / 96), k = (int)(i % 96); const bool big = k >= 32; const int fi = big ? k - 32 : k; const float d = big ? 128.f : 64.f;
        const float inv = __builtin_amdgcn_exp2f(-(2.0f * (float)fi / d) * 13.287712379549449f);
        const float ang = (float)pos * inv; double rv = (double)ang * 0.15915494309189535; rv -= floor(rv); const float fr = (float)rv;
        float* dst = big ? (float*)(ws + WS_TAB128) + ((long)pos * 64 + fi) * 2 : (float*)(ws + WS_TAB64) + ((long)pos * 32 + fi) * 2;
        dst[0] = __builtin_amdgcn_cosf(fr); dst[1] = __builtin_amdgcn_sinf(fr); }
    { float* sc = (float*)lds;
      for (int it = obid(); it < 2 * 12 * 8; it += ogrid()) { const int l = it / 96, cc = (it % 96) / 8, ks = it % 8;
        __syncthreads();
        for (int i = tid; i < NCOND * 256; i += 512) { const int r = i >> 8, k = i & 255; const float c = r < NB ? gp(p.c_prompt)[(long)r * DM + ks * 256 + k] : gp(p.c_sample)[(long)(r - NB) * DM + ks * 256 + k]; sc[i] = siluf_(c); }
        __syncthreads();
        float a0[NCOND], a1[NCOND];
#pragma unroll
        for (int r = 0; r < NCOND; ++r) { a0[r] = 0.f; a1[r] = 0.f; }
        const float* wp = gp(p.w_ada) + ((long)l * DM + ks * 256) * 12288 + cc * 1024 + 2 * tid;
        f32x2 w0 = *reinterpret_cast<const f32x2*>(wp), w1 = *reinterpret_cast<const f32x2*>(wp + 12288), w2 = *reinterpret_cast<const f32x2*>(wp + 2 * 12288), w3 = *reinterpret_cast<const f32x2*>(wp + 3 * 12288);
#pragma unroll 1
        for (int k = 0; k < 256; k += 4) {
            wp += (k + 4 < 256) ? 4 * 12288 : 0;
            const f32x2 n0 = *reinterpret_cast<const f32x2*>(wp), n1 = *reinterpret_cast<const f32x2*>(wp + 12288), n2 = *reinterpret_cast<const f32x2*>(wp + 2 * 12288), n3 = *reinterpret_cast<const f32x2*>(wp + 3 * 12288);
            __builtin_amdgcn_sched_barrier(0);
#pragma unroll
            for (int r = 0; r < NCOND; ++r) { const f32x4 s = *reinterpret_cast<const f32x4*>(sc + r * 256 + k);
                a0[r] = fmaf(s[0], w0[0], fmaf(s[1], w1[0], fmaf(s[2], w2[0], fmaf(s[3], w3[0], a0[r]))));
                a1[r] = fmaf(s[0], w0[1], fmaf(s[1], w1[1], fmaf(s[2], w2[1], fmaf(s[3], w3[1], a1[r]))));
                if ((r % 6) == 5) __builtin_amdgcn_sched_barrier(0); }
            w0 = n0; w1 = n1; w2 = n2; w3 = n3; }
        float* dst = (float*)(ws + WS_ADAP) + (((long)ks * 2 + l) * NCOND) * 12288 + cc * 1024 + 2 * tid;
#pragma unroll
        for (int r = 0; r < NCOND; ++r) *reinterpret_cast<f32x2*>(dst + (long)r * 12288) = (f32x2){a0[r], a1[r]}; }
      __syncthreads(); }
}

__device__ __forceinline__ void wpq_int8(KParams& p) {
    unsigned char* ws = optr(gp(p.ws)); const int lane = otid() & 63;
    for (int r = gwave(); r < 2 * DM; r += nwaves()) { const bf16_t* src = (const bf16_t*)(ws + WS_WPQ) + (long)r * DM; float f[4][8]; float am = 0.f;
#pragma unroll
        for (int j = 0; j < 4; ++j) { unpack8(*reinterpret_cast<const u32x4*>(src + 512 * j + 8 * lane), f[j]);
#pragma unroll
            for (int i = 0; i < 8; ++i) am = fmaxf(am, fabsf(f[j][i])); }
        am = wave_max(am); const float qs = am > 0.f ? 127.0f / am : 0.f;
#pragma unroll
        for (int j = 0; j < 4; ++j) { unsigned w2[2];
#pragma unroll
            for (int hh = 0; hh < 2; ++hh) { unsigned w = 0u;
#pragma unroll
                for (int i = 0; i < 4; ++i) w |= ((unsigned)((int)__builtin_rintf(f[j][4 * hh + i] * qs) & 0xff)) << (8 * i);
                w2[hh] = w; }
            *reinterpret_cast<u32x2*>(ws + WS_WPQ8 + (long)r * DM + 512 * j + 8 * lane) = (u32x2){w2[0], w2[1]}; }
        if (lane == 0) ((float*)(ws + WS_SB8))[r] = am * (1.0f / 127.0f); }
}

__device__ __forceinline__ void rows2048_int8(KParams& p, size_t src_off, size_t dst_off, size_t sc_off, int nrows) {
    unsigned char* ws = optr(gp(p.ws)); const int lane = otid() & 63;
    for (int r = gwave(); r < nrows; r += nwaves()) { const bf16_t* src = (const bf16_t*)(ws + src_off) + (long)r * DM; float f[4][8]; float am = 0.f;
#pragma unroll
        for (int j = 0; j < 4; ++j) { unpack8(*reinterpret_cast<const u32x4*>(src + 512 * j + 8 * lane), f[j]);
#pragma unroll
            for (int i = 0; i < 8; ++i) am = fmaxf(am, fabsf(f[j][i])); }
        am = wave_max(am); const float qs = am > 0.f ? 127.0f / am : 0.f;
#pragma unroll
        for (int j = 0; j < 4; ++j) { unsigned w2[2];
#pragma unroll
            for (int hh = 0; hh < 2; ++hh) { unsigned w = 0u;
#pragma unroll
                for (int i = 0; i < 4; ++i) w |= ((unsigned)((int)__builtin_rintf(f[j][4 * hh + i] * qs) & 0xff)) << (8 * i);
                w2[hh] = w; }
            *reinterpret_cast<u32x2*>(ws + dst_off + (long)r * DM + 512 * j + 8 * lane) = (u32x2){w2[0], w2[1]}; }
        if (lane == 0) ((float*)(ws + sc_off))[r] = am * (1.0f / 127.0f); }
}
__device__ __forceinline__ void wb_int8(KParams& p, int l) {
    unsigned char* ws = optr(gp(p.ws)); const int lane = otid() & 63;
    for (int r = gwave(); r < DM; r += nwaves()) { const bf16_t* src = (const bf16_t*)(ws + WS_WB) + ((long)l * DM + r) * DM; float f[4][8]; float am = 0.f;
#pragma unroll
        for (int j = 0; j < 4; ++j) { unpack8(*reinterpret_cast<const u32x4*>(src + 512 * j + 8 * lane), f[j]);
#pragma unroll
            for (int i = 0; i < 8; ++i) am = fmaxf(am, fabsf(f[j][i])); }
        am = wave_max(am); const float qs = am > 0.f ? 127.0f / am : 0.f;
#pragma unroll
        for (int j = 0; j < 4; ++j) { unsigned w2[2];
#pragma unroll
            for (int hh = 0; hh < 2; ++hh) { unsigned w = 0u;
#pragma unroll
                for (int i = 0; i < 4; ++i) w |= ((unsigned)((int)__builtin_rintf(f[j][4 * hh + i] * qs) & 0xff)) << (8 * i);
                w2[hh] = w; }
            *reinterpret_cast<u32x2*>(ws + WS_WB8 + (long)r * DM + 512 * j + 8 * lane) = (u32x2){w2[0], w2[1]}; }
        if (lane == 0) ((float*)(ws + WS_SBB))[r] = am * (1.0f / 127.0f); }
}

__device__ __forceinline__ void win_int8(KParams& p, int l) {
    unsigned char* ws = optr(gp(p.ws)); const int lane = otid() & 63;
    for (int jr = gwave(); jr < NB8 * 256; jr += nwaves()) { const int blk = jr >> 8, n = (blk < 2 ? blk : (blk < 5 ? blk + 3 : blk + 7)) * 256 + (jr & 255);
        const bf16_t* src = (const bf16_t*)(ws + WS_WIN) + ((long)l * INWP + n) * DM; float f[4][8]; float am = 0.f;
#pragma unroll
        for (int j = 0; j < 4; ++j) { unpack8(*reinterpret_cast<const u32x4*>(src + 512 * j + 8 * lane), f[j]);
#pragma unroll
            for (int i = 0; i < 8; ++i) am = fmaxf(am, fabsf(f[j][i])); }
        am = wave_max(am); const float qs = am > 0.f ? 127.0f / am : 0.f;
#pragma unroll
        for (int j = 0; j < 4; ++j) { unsigned w2[2];
#pragma unroll
            for (int hh = 0; hh < 2; ++hh) { unsigned w = 0u;
#pragma unroll
                for (int i = 0; i < 4; ++i) w |= ((unsigned)((int)__builtin_rintf(f[j][4 * hh + i] * qs) & 0xff)) << (8 * i);
                w2[hh] = w; }
            *reinterpret_cast<u32x2*>(ws + WS_WIN8 + (long)jr * DM + 512 * j + 8 * lane) = (u32x2){w2[0], w2[1]}; }
        if (lane == 0) ((float*)(ws + WS_SBW))[n] = am * (1.0f / 127.0f); }
}

__device__ __forceinline__ void ada_reduce(KParams& p) {
    unsigned char* ws = optr(gp(p.ws)); const float* ap = (const float*)(ws + WS_ADAP); float* ad = (float*)(ws + WS_ADA); const long n = 2L * NCOND * 12288;
    for (long i = gthread(); i < n; i += nthreads()) { const int l = (int)(i / (NCOND * 12288L)); const int j = (int)(i % 12288);
        float s = gp(p.b_ada)[(long)l * 12288 + j];
#pragma unroll
        for (int ks = 0; ks < 8; ++ks) s += ap[(long)ks * n + i];
        ad[i] = s; }
}

__device__ __forceinline__ void modulate(KParams& p, int l, int which) {
    const int lane = otid() & 63; unsigned char* ws = optr(gp(p.ws)); const float* X = gp(p.out); bf16_t* H = (bf16_t*)(ws + WS_H);
    const float* g = (which ? gp(p.g_ffn) : gp(p.g_mix)) + (long)l * DM; const float* ada = (const float*)(ws + WS_ADA) + (long)l * NCOND * 12288 + (which ? 3 : 0) * DM;
    for (int t = gwave(); t < T; t += nwaves()) {
        const float* xr = (l == 0 && which == 0) ? (t < TP ? gp(p.x_prompt) + (long)t * DM : gp(p.x_sample) + (long)(t - TP) * DM) : X + (long)t * DM; f32x4 v[8]; float ss = 0.f;
#pragma unroll
        for (int j = 0; j < 8; ++j) { v[j] = *reinterpret_cast<const f32x4*>(xr + 256 * j + 4 * lane); ss += v[j][0] * v[j][0] + v[j][1] * v[j][1] + v[j][2] * v[j][2] + v[j][3] * v[j][3]; }
        ss = wave_sum(ss); const float rinv = rsqrtf(ss * (1.0f / DM) + EPS);
        const float* sh = ada + (long)cond_row(t) * 12288; const float* sc = sh + DM;
#pragma unroll
        for (int j = 0; j < 8; ++j) { const int c = 256 * j + 4 * lane; const f32x4 gv = *reinterpret_cast<const f32x4*>(g + c), sv = *reinterpret_cast<const f32x4*>(sc + c), hv = *reinterpret_cast<const f32x4*>(sh + c);
            const f32x4 y = v[j] * rinv * gv * (sv + 1.0f) + hv; u32x2 w; w.x = cvt_pk_bf16(y[0], y[1]); w.y = cvt_pk_bf16(y[2], y[3]);
            if (!which) *reinterpret_cast<u32x2*>(H + (long)t * DM + c) = w;
            v[j] = y; }
        {
            float am = 0.f;
#pragma unroll
            for (int j = 0; j < 8; ++j) am = fmaxf(am, fmaxf(fmaxf(fabsf(v[j][0]), fabsf(v[j][1])), fmaxf(fabsf(v[j][2]), fabsf(v[j][3]))));
            am = wave_max(am); const float qs = am > 0.f ? 127.0f / am : 0.f;
#pragma unroll
            for (int j = 0; j < 8; ++j) { const int c = 256 * j + 4 * lane;
                const int q0 = (int)__builtin_rintf(v[j][0] * qs), q1 = (int)__builtin_rintf(v[j][1] * qs), q2 = (int)__builtin_rintf(v[j][2] * qs), q3 = (int)__builtin_rintf(v[j][3] * qs);
                *reinterpret_cast<unsigned*>(ws + WS_H8 + (long)t * DM + c) = (unsigned)(q0 & 0xff) | ((unsigned)(q1 & 0xff) << 8) | ((unsigned)(q2 & 0xff) << 16) | ((unsigned)(q3 & 0xff) << 24); }
            if (lane == 0) ((float*)(ws + WS_SA8))[t] = am * (1.0f / 127.0f); }
    }
}

__device__ __forceinline__ void cache_convert(KParams& p, int l, char* lds, int it0, int it1, int bidx, int nb) {
    const int tid = otid(); unsigned char* ws = optr(gp(p.ws)); float* tile = (float*)lds; bf16_t* CKA = (bf16_t*)(ws + WS_CKA); bf16_t* CKT = (bf16_t*)(ws + WS_CKT);
    { const int NT_ = it1, G_ = nb; int it = it0 + bidx; float v[8];
      const float* cbase = gp(p.cache_ckv) + (long)l * DB * PAST * 512;
#define CC_SRC(itx) (cbase + (((long)((itx) >> 8)) * PAST + (((itx) >> 3) & 31) * 64) * 512 + ((itx) & 7) * 64)
      if (it < NT_) { const float* src = CC_SRC(it);
#pragma unroll
        for (int i = 0; i < 8; ++i) { const int idx = tid + 512 * i, r = idx >> 6, c = idx & 63; v[i] = src[(long)r * 512 + c]; } }
      while (it < NT_) { const int b = it >> 8, kt = (it >> 3) & 31, ct = it & 7; const int itn = it + G_; float vn[8];
        if (itn < NT_) { const float* src = CC_SRC(itn);
#pragma unroll
            for (int i = 0; i < 8; ++i) { const int idx = tid + 512 * i, r = idx >> 6, c = idx & 63; vn[i] = src[(long)r * 512 + c]; } }
#pragma unroll
        for (int i = 0; i < 8; ++i) { const int idx = tid + 512 * i, r = idx >> 6, c = idx & 63; tile[r * 65 + c] = v[i]; }
        __syncthreads();
        { const int r = tid >> 3, cc = (tid & 7) * 8; float f[8];
#pragma unroll
          for (int j = 0; j < 8; ++j) f[j] = tile[r * 65 + cc + j];
          *reinterpret_cast<u32x4*>(CKA + ((long)b * KPAD + kt * 64 + r) * QLD + ct * 64 + cc) = pack8(f);
#pragma unroll
          for (int j = 0; j < 8; ++j) f[j] = tile[(cc + j) * 65 + r];
          *reinterpret_cast<u32x4*>(CKT + ((long)b * 512 + ct * 64 + r) * KPAD + kt * 64 + cc) = pack8(f); }
        __syncthreads();
#pragma unroll
        for (int i = 0; i < 8; ++i) v[i] = vn[i];
        it = itn; }
#undef CC_SRC
    }
    for (long i = (long)it0 * 64 + (long)bidx * 512 + tid; i < (long)it1 * 64; i += (long)nb * 512) { const long row = i >> 3; const int ch = (int)(i & 7); const int b = (int)(row >> 11), k = (int)(row & 2047);
        const float* s = gp(p.cache_krope) + (((long)l * DB + b) * PAST + k) * 64 + ch * 8; float f[8];
#pragma unroll
        for (int j = 0; j < 8; ++j) f[j] = s[j];
        *reinterpret_cast<u32x4*>(CKA + ((long)b * KPAD + k) * QLD + 512 + ch * 8) = pack8(f); }
}

__device__ __forceinline__ void quant_row8(const float (&o)[8], unsigned char* dst, float* sc, int lane) {
    float am = 0.f;
#pragma unroll
    for (int j = 0; j < 8; ++j) am = fmaxf(am, fabsf(o[j]));
    am = wave_max(am); const float qs = am > 0.f ? 127.0f / am : 0.f; unsigned w2[2];
#pragma unroll
    for (int hh = 0; hh < 2; ++hh) { unsigned w = 0u;
#pragma unroll
        for (int i = 0; i < 4; ++i) w |= ((unsigned)((int)__builtin_rintf(o[4 * hh + i] * qs) & 0xff)) << (8 * i);
        w2[hh] = w; }
    *reinterpret_cast<u32x2*>(dst) = (u32x2){w2[0], w2[1]};
    if (lane == 0) *sc = am * (1.0f / 127.0f);
}
__device__ __forceinline__ void wu_int8(KParams& p, int l) {
    unsigned char* ws = optr(gp(p.ws)); const int lane = otid() & 63;
    for (int r = gwave(); r < 3072 + 4096; r += nwaves()) { const bool kv = r >= 3072; const int rr = kv ? r - 3072 : r;
        const bf16_t* src = kv ? (const bf16_t*)(ws + WS_WUKV) + ((long)l * 4096 + rr) * 512 : (const bf16_t*)(ws + WS_WUQ) + ((long)l * 3072 + rr) * 512;
        float f[8]; unpack8(*reinterpret_cast<const u32x4*>(src + 8 * lane), f);
        quant_row8(f, ws + (kv ? WS_WUKV8 : WS_WUQ8) + (long)rr * 512 + 8 * lane, (float*)(ws + (kv ? WS_SBK : WS_SBQ)) + rr, lane); }
}

__device__ __forceinline__ void post_win(KParams& p, int l) {
    const int lane = otid() & 63; unsigned char* ws = optr(gp(p.ws));
    bf16_t* Y = (bf16_t*)(ws + WS_Y); bf16_t* CQN = (bf16_t*)(ws + WS_CQN); bf16_t* CKVNP = (bf16_t*)(ws + WS_CKVNP); bf16_t* KRP = (bf16_t*)(ws + WS_KRP); bf16_t* CKA = (bf16_t*)(ws + WS_CKA); bf16_t* CKT = (bf16_t*)(ws + WS_CKT);
    const float* T64 = (const float*)(ws + WS_TAB64); const float* T128 = (const float*)(ws + WS_TAB128);
    for (int t = gwave(); t < T; t += nwaves()) {
        bf16_t* y = Y + (long)t * INWP; const int pos = tok_pos(t); const bool samp = t >= TP; const int ts = t - TP, b = ts >> 6, s = ts & 63;
        { float f[8], o[8]; unpack8(*reinterpret_cast<const u32x4*>(y + C_CQ + 8 * lane), f); float ss = 0.f;
#pragma unroll
          for (int j = 0; j < 8; ++j) ss += f[j] * f[j];
          ss = wave_sum(ss); const float rinv = rsqrtf(ss * (1.0f / 512.f) + EPS); const float* g = gp(p.g_q) + (long)l * 512 + 8 * lane;
#pragma unroll
          for (int j = 0; j < 8; ++j) o[j] = f[j] * rinv * g[j];
          quant_row8(o, (unsigned char*)CQN + (long)t * 512 + 8 * lane, (float*)(ws + WS_SAQ) + t, lane); }
        { float f[8], o[8]; unpack8(*reinterpret_cast<const u32x4*>(y + C_CKV + 8 * lane), f); float ss = 0.f;
#pragma unroll
          for (int j = 0; j < 8; ++j) ss += f[j] * f[j];
          ss = wave_sum(ss); const float rinv = rsqrtf(ss * (1.0f / 512.f) + EPS); const float* g = gp(p.g_kv) + (long)l * 512 + 8 * lane;
#pragma unroll
          for (int j = 0; j < 8; ++j) o[j] = f[j] * rinv * g[j];
          float* od = gp(p.out) + (samp ? O_CKVS + ((long)l * TS + ts) * 512 : O_CKVP + ((long)l * TP + t) * 512) + 8 * lane;
          *reinterpret_cast<f32x4*>(od) = (f32x4){o[0], o[1], o[2], o[3]}; *reinterpret_cast<f32x4*>(od + 4) = (f32x4){o[4], o[5], o[6], o[7]};
          const u32x4 w = pack8(o);
          if (!samp) quant_row8(o, (unsigned char*)CKVNP + (long)t * 512 + 8 * lane, (float*)(ws + WS_SAK) + t, lane);
          else { *reinterpret_cast<u32x4*>(CKA + ((long)b * KPAD + PAST + s) * QLD + 8 * lane) = w;
#pragma unroll
              for (int j = 0; j < 8; ++j) CKT[((long)b * 512 + 8 * lane + j) * KPAD + PAST + s] = f2bf(o[j]); } }
        if (lane < 32) { const float x1 = bf2f(y[C_KR + lane]), x2 = bf2f(y[C_KR + 32 + lane]); const float c = T64[((long)pos * 32 + lane) * 2], sn = T64[((long)pos * 32 + lane) * 2 + 1];
            const float o1 = x1 * c - x2 * sn, o2 = x1 * sn + x2 * c;
            float* od = gp(p.out) + (samp ? O_KRS + ((long)l * TS + ts) * 64 : O_KRP + ((long)l * TP + t) * 64); od[lane] = o1; od[32 + lane] = o2;
            if (!samp) { KRP[(long)t * 64 + lane] = f2bf(o1); KRP[(long)t * 64 + 32 + lane] = f2bf(o2); }
            else { bf16_t* d = CKA + ((long)b * KPAD + PAST + s) * QLD + 512; d[lane] = f2bf(o1); d[32 + lane] = f2bf(o2); } }
        { const int hh = lane >> 3, d0 = (lane & 7) * 8; const float* cs = T128 + ((long)pos * 64 + d0) * 2; float cv[8], sv[8];
#pragma unroll
          for (int j = 0; j < 4; ++j) { const f32x4 q = *reinterpret_cast<const f32x4*>(cs + 4 * j); cv[2 * j] = q[0]; sv[2 * j] = q[1]; cv[2 * j + 1] = q[2]; sv[2 * j + 1] = q[3]; }
#pragma unroll
          for (int which = 0; which < 2; ++which) { bf16_t* base = y + (which ? C_RK : C_RQ) + hh * 128 + d0; const float sca = which ? 0.08838834764831845f : 1.0f;
              float a[8], bq[8], o1[8], o2[8]; unpack8(*reinterpret_cast<const u32x4*>(base), a); unpack8(*reinterpret_cast<const u32x4*>(base + 64), bq);
#pragma unroll
              for (int j = 0; j < 8; ++j) { o1[j] = (a[j] * cv[j] - bq[j] * sv[j]) * sca; o2[j] = (a[j] * sv[j] + bq[j] * cv[j]) * sca; }
              *reinterpret_cast<u32x4*>(base) = pack8(o1); *reinterpret_cast<u32x4*>(base + 64) = pack8(o2); } }
    }
}

__device__ __forceinline__ void post_q(KParams& p) {
    const int lane = otid() & 63; unsigned char* ws = optr(gp(p.ws)); bf16_t* Q = (bf16_t*)(ws + WS_Q); bf16_t* QL = (bf16_t*)(ws + WS_QL); const float* T64 = (const float*)(ws + WS_TAB64);
    for (int t = gwave(); t < T; t += nwaves()) { const int pos = tok_pos(t); const int hd = lane >> 2, d0 = (lane & 3) * 8;
        bf16_t* base = Q + (long)t * 3072 + hd * 192 + 128 + d0; const float* cs = T64 + ((long)pos * 32 + d0) * 2; float cv[8], sv[8];
#pragma unroll
        for (int j = 0; j < 4; ++j) { const f32x4 q = *reinterpret_cast<const f32x4*>(cs + 4 * j); cv[2 * j] = q[0]; sv[2 * j] = q[1]; cv[2 * j + 1] = q[2]; sv[2 * j + 1] = q[3]; }
        float a[8], bq[8], o1[8], o2[8]; unpack8(*reinterpret_cast<const u32x4*>(base), a); unpack8(*reinterpret_cast<const u32x4*>(base + 32), bq);
#pragma unroll
        for (int j = 0; j < 8; ++j) { o1[j] = a[j] * cv[j] - bq[j] * sv[j]; o2[j] = a[j] * sv[j] + bq[j] * cv[j]; }
        const u32x4 w1 = pack8(o1), w2 = pack8(o2);
        *reinterpret_cast<u32x4*>(base) = w1; *reinterpret_cast<u32x4*>(base + 32) = w2;
        if (t >= TP) { const int ts = t - TP, b = ts >> 6, s = ts & 63; bf16_t* d = QL + ((long)b * 1024 + hd * 64 + s) * QLD + 512 + d0;
            *reinterpret_cast<u32x4*>(d) = w1; *reinterpret_cast<u32x4*>(d + 32) = w2; } }
}

__device__ __forceinline__ void softmax_rows(KParams& p) {
    const int lane = otid() & 63; unsigned char* ws = optr(gp(p.ws)); bf16_t* SP = (bf16_t*)(ws + WS_SP);
    for (int r = gwave(); r < DB * 1024; r += nwaves()) { bf16_t* row = SP + (long)r * KPAD; float v[5][8]; float mx = -3.0e38f;
#pragma unroll
        for (int j = 0; j < 5; ++j) { const int ch = lane + 64 * j;
            if (ch < KALL / 8) { unpack8(*reinterpret_cast<const u32x4*>(row + ch * 8), v[j]);
#pragma unroll
                for (int i = 0; i < 8; ++i) { v[j][i] *= MLA_SCALE; mx = fmaxf(mx, v[j][i]); } }
            else {
#pragma unroll
                for (int i = 0; i < 8; ++i) v[j][i] = -3.0e38f; } }
        mx = wave_max(mx); float sum = 0.f;
#pragma unroll
        for (int j = 0; j < 5; ++j) { const int ch = lane + 64 * j;
#pragma unroll
            for (int i = 0; i < 8; ++i) { v[j][i] = (ch < KALL / 8) ? __expf(v[j][i] - mx) : 0.f; sum += v[j][i]; } }
        sum = wave_sum(sum); const float inv = 1.0f / sum;
#pragma unroll
        for (int j = 0; j < 5; ++j) { const int ch = lane + 64 * j;
            if (ch < KPAD / 8) { float o[8];
#pragma unroll
                for (int i = 0; i < 8; ++i) o[i] = v[j][i] * inv;
                *reinterpret_cast<u32x4*>(row + ch * 8) = pack8(o); } } }
}

__device__ __forceinline__ void gnorm_gate(KParams& p, int w0, int nw) {
    const int lane = otid() & 63; unsigned char* ws = optr(gp(p.ws)); const bf16_t* OB = (const bf16_t*)(ws + WS_OB); const bf16_t* Y = (const bf16_t*)(ws + WS_Y);
    for (int t = w0; t < T; t += nw) { const int c0 = (lane >> 3) * 256 + (lane & 7) * 32; float x[4][8]; float s = 0.f;
#pragma unroll
        for (int i = 0; i < 4; ++i) { unpack8(*reinterpret_cast<const u32x4*>(OB + ((long)lane * T + t) * 32 + 8 * i), x[i]);
#pragma unroll
            for (int j = 0; j < 8; ++j) s += x[i][j]; }
        s += sx<1>(s); s += sx<2>(s); s += sx<4>(s); const float mu = s * (1.0f / 256.f); float q = 0.f;
#pragma unroll
        for (int i = 0; i < 4; ++i)
#pragma unroll
            for (int j = 0; j < 8; ++j) { const float d = x[i][j] - mu; q += d * d; }
        q += sx<1>(q); q += sx<2>(q); q += sx<4>(q); const float rstd = rsqrtf(q * (1.0f / 256.f) + EPS);
        float am = 0.f;
#pragma unroll
        for (int i = 0; i < 4; ++i) { float g[8]; unpack8(*reinterpret_cast<const u32x4*>(Y + (long)t * INWP + C_RG + c0 + 8 * i), g);
#pragma unroll
            for (int j = 0; j < 8; ++j) { x[i][j] = siluf_(g[j]) * (x[i][j] - mu) * rstd; am = fmaxf(am, fabsf(x[i][j])); } }
        am = wave_max(am); const float qs = am > 0.f ? 127.0f / am : 0.f; unsigned w[8];
#pragma unroll
        for (int i = 0; i < 4; ++i)
#pragma unroll
            for (int hh = 0; hh < 2; ++hh) { unsigned v = 0u;
#pragma unroll
                for (int j = 0; j < 4; ++j) v |= ((unsigned)((int)__builtin_rintf(x[i][4 * hh + j] * qs) & 0xff)) << (8 * j);
                w[2 * i + hh] = v; }
        *reinterpret_cast<u32x4*>(ws + WS_BG + (long)t * DM + c0) = (u32x4){w[0], w[1], w[2], w[3]};
        *reinterpret_cast<u32x4*>(ws + WS_BG + (long)t * DM + c0 + 16) = (u32x4){w[4], w[5], w[6], w[7]};
        if (lane == 0) ((float*)(ws + WS_SA8))[t] = am * (1.0f / 127.0f); }
}

__device__ __forceinline__ void peer_convert(KParams& p, int l, int r0, int r1, int w0, int nw) {
    unsigned char* ws = optr(gp(p.ws)); const int lane = otid() & 63;
    const float* su = gp(p.peer_u) + (long)l * NEXP * DM; const float* sv = gp(p.peer_v) + (long)l * NEXP * DM;
    for (int r = r0 + w0; r < r1; r += nw) { const bool second = r >= NEXP; const int row = second ? r - NEXP : r; const float* s = (second ? sv : su) + (long)row * DM;
        f32x4 v[8]; float am = 0.f;
#pragma unroll
        for (int j = 0; j < 8; ++j) { v[j] = *reinterpret_cast<const f32x4*>(s + 512 * (j >> 2) * 2 + 16 * lane + 4 * (j & 3));
            am = fmaxf(am, fmaxf(fmaxf(fabsf(v[j][0]), fabsf(v[j][1])), fmaxf(fabsf(v[j][2]), fabsf(v[j][3])))); }
        am = wave_max(am);
        float sc = 1.0f, isc = 1.0f;
        if (am > 0.f) { const int e = (int)((__float_as_uint(am) >> 23) & 0xffu) - 127;
            int k = 7 - e; k = k > 100 ? 100 : (k < -100 ? -100 : k);
            sc = __uint_as_float((unsigned)(127 + k) << 23); isc = __uint_as_float((unsigned)(127 - k) << 23); }
        unsigned w[8];
        if (!second) {
            const float qs = am > 0.f ? 127.0f / am : 0.f; isc = am * (1.0f / 127.0f);
#pragma unroll
            for (int j = 0; j < 8; ++j) w[j] = ((unsigned)((int)__builtin_rintf(v[j][0] * qs) & 0xff)) | (((unsigned)((int)__builtin_rintf(v[j][1] * qs) & 0xff)) << 8) | (((unsigned)((int)__builtin_rintf(v[j][2] * qs) & 0xff)) << 16) | (((unsigned)((int)__builtin_rintf(v[j][3] * qs) & 0xff)) << 24);
        } else {
#pragma unroll
            for (int j = 0; j < 8; ++j) { int pk = __builtin_amdgcn_cvt_pk_fp8_f32(v[j][0] * sc, v[j][1] * sc, 0, false); pk = __builtin_amdgcn_cvt_pk_fp8_f32(v[j][2] * sc, v[j][3] * sc, pk, true); w[j] = (unsigned)pk; } }
        if (!second) {
            unsigned char* dst = ws + WS_PU + ((long)(lane >> 3) * NEXP + row) * 128 + 16 * (lane & 7);
            *reinterpret_cast<u32x4*>(dst) = (u32x4){w[0], w[1], w[2], w[3]};
            *reinterpret_cast<u32x4*>(dst + 8L * NEXP * 128) = (u32x4){w[4], w[5], w[6], w[7]};
        } else {
            unsigned char* dst = ws + WS_PV + ((long)(2 * lane) * NEXP + row) * 8;
            *reinterpret_cast<u32x2*>(dst) = (u32x2){w[0], w[1]}; *reinterpret_cast<u32x2*>(dst + (long)NEXP * 8) = (u32x2){w[2], w[3]};
            *reinterpret_cast<u32x2*>(dst + 128L * NEXP * 8) = (u32x2){w[4], w[5]}; *reinterpret_cast<u32x2*>(dst + 129L * NEXP * 8) = (u32x2){w[6], w[7]}; }
        if (lane == 0) ((float*)(ws + (second ? WS_PSV : WS_PSU)))[row] = isc; }
}

__device__ __forceinline__ void final_norm(KParams& p) {
    const int lane = otid() & 63; float* X = gp(p.out);
    for (int t = gwave(); t < T; t += nwaves()) { float* xr = X + (long)t * DM; f32x4 v[8]; float ss = 0.f;
#pragma unroll
        for (int j = 0; j < 8; ++j) { v[j] = *reinterpret_cast<const f32x4*>(xr + 256 * j + 4 * lane); ss += v[j][0] * v[j][0] + v[j][1] * v[j][1] + v[j][2] * v[j][2] + v[j][3] * v[j][3]; }
        ss = wave_sum(ss); const float rinv = rsqrtf(ss * (1.0f / DM) + EPS);
#pragma unroll
        for (int j = 0; j < 8; ++j) { const int c = 256 * j + 4 * lane; const f32x4 gv = *reinterpret_cast<const f32x4*>(gp(p.g_final) + c); *reinterpret_cast<f32x4*>(xr + c) = v[j] * rinv * gv; } }
}
}
__global__ void __launch_bounds__(512, 2) mega_fwd(Params p_by_value_unused) {
    extern __shared__ __attribute__((aligned(16))) unsigned char shm[];
    LAS unsigned char* lds = (LAS unsigned char*)shm; char* ldsg = (char*)shm;
    if (threadIdx.x < 8) ((LAS unsigned*)(lds + LDS_BARW))[threadIdx.x] = 0u;
    __syncthreads();
    if (threadIdx.x == 0) { unsigned* tk = (unsigned*)(gp(KP.ws) + WS_CTL + CTL_RANK) + 64 * xb_xcc_id(); ((volatile LAS unsigned*)(lds + LDS_BARW))[2] = xb_add(tk, 1u); }
    const XcdBarrier bar = xcd_barrier_post((unsigned*)(gp(KP.ws) + WS_CTL), (volatile LAS unsigned*)(lds + LDS_BARW));
#define GRID_SYNC() xcd_barrier(bar)
#ifndef STOP_AT
#define STOP_AT 0
#endif
#ifdef DBG_DUMP
#define STOPCHK(n) do { if (STOP_AT == (n)) { float* xo = gp(KP.out); const bf16_t* src = (const bf16_t*)(gp(KP.ws) + DBG_DUMP); for (long i = ph::gthread(); i < (long)T * DM; i += ph::nthreads()) xo[i] = bf2f(src[i]); return; } } while (0)
#elif defined(DBG_SANITIZE)
#define STOPCHK(n) do { if (STOP_AT == (n) || (STOP_AT > 100 && l == 1 && STOP_AT - 100 == (n))) { float* xo = gp(KP.out); for (long i = ph::gthread(); i < (long)T * DM; i += ph::nthreads()) { const float v = xo[i]; if (!(v - v == 0.0f)) xo[i] = 7.0f; } return; } } while (0)
#else
#define STOPCHK(n) do { if (STOP_AT == (n) || (STOP_AT > 100 && l == 1 && STOP_AT - 100 == (n))) return; } while (0)
#endif
    using namespace pg8;
#define WSP(off) ((bf16_t*)(optr(gp(KP.ws)) + (off)))
#define H WSP(WS_H)
#define Y WSP(WS_Y)
#define CQN WSP(WS_CQN)
#define CKVNP WSP(WS_CKVNP)
#define KRP WSP(WS_KRP)
#define Q WSP(WS_Q)
#define YA WSP(WS_YA)
#define KV WSP(WS_KV)
#define SP WSP(WS_SP)
#define MIX WSP(WS_MIX)
#define OA WSP(WS_OA)
#define QP WSP(WS_QP)
#define CKA WSP(WS_CKA)
#define CKT WSP(WS_CKT)
#define QL WSP(WS_QL)
#define OL WSP(WS_OL)
#define BG WSP(WS_BG)
    int l = 0;
    ph::prologue(KP, ldsg);
#ifdef DUP_PRO
    ph::prologue(KP, ldsg);
#endif
    GRID_SYNC(); STOPCHK(1);
    if (threadIdx.x == 0) { unsigned* barw = (unsigned*)(gp(KP.ws) + WS_CTL); const unsigned me = xb_xcc_id(); unsigned nx = 0, xi = 0, nloc = 1;
        for (unsigned j = 0; j < 16; ++j) { const unsigned cn = xb_ld(&barw[XB_XCNT(j)]); if (cn) { if (j < me) ++xi; ++nx; } if (j == me) nloc = cn ? cn : 1u; }
        volatile LAS unsigned* iw = (volatile LAS unsigned*)(lds + LDS_BARW); iw[3] = xi; iw[4] = nx; iw[5] = nloc; }
    __syncthreads();
    ph::ada_reduce(KP);
    ph::wpq_int8(KP);
    GRID_SYNC(); STOPCHK(2);
    for (l = 0; l < DEPTH; ++l) {
#define WIN (WSP(WS_WIN) + (long)l * INWP * DM)
#define WUQ (WSP(WS_WUQ) + (long)l * 3072 * 512)
#define WUKV (WSP(WS_WUKV) + (long)l * 4096 * 512)
#define WUK (WSP(WS_WUK) + (long)l * 16 * 512 * 256)
#define WA (WSP(WS_WA) + (long)l * DM * DM)
#define WB (WSP(WS_WB) + (long)l * DM * DM)
#define WO (WSP(WS_WO) + (long)l * DM * DM)
#define WPQ (WSP(WS_WPQ) + (long)l * DM * DM)
#define ADA ((const float*)(optr(gp(KP.ws)) + WS_ADA) + (long)l * NCOND * 12288)
        ph::modulate(KP, l, 0);
        ph::win_int8(KP, l);
        ph::wb_int8(KP, l);
        ph::wu_int8(KP, l);
        ph::rows2048_int8(KP, WS_WA + (size_t)l * DM * DM * 2, WS_WA8, WS_SBA, DM);
        ph::rows2048_int8(KP, WS_WO + (size_t)l * DM * DM * 2, WS_WO8, WS_SBO, DM);
        ph::cache_convert(KP, l, ldsg, l == 0 ? 0 : 4096, 8192, obid(), ogrid());
        GRID_SYNC(); STOPCHK(3);
        { Sched<5> S; S.init(T / 256, INWP / 256 - NB8, (T / 256) * (INWP / 256 - NB8), DM, DM); gemm_phase(lds, Gemm{H, WIN, DM, DM, DM}, S, EpiBf16{Y, INWP, 0}); }
        { Sched<6> S; S.init(T / 256, NB8, (T / 256) * NB8, DM / 2, DM / 2);
          { const int G_ = ogrid(); S.rotate((((((T / 256) * NB8) % G_) + 7) & ~7) % G_); }
          unsigned char* ws8 = optr(gp(KP.ws));
          gemm_phase<EpiQ8, Sched<6>, true>(lds, Gemm{(const bf16_t*)(ws8 + WS_H8), (const bf16_t*)(ws8 + WS_WIN8), DM / 2, DM / 2, DM / 2}, S, EpiQ8{Y, INWP, (const float*)(ws8 + WS_SA8), (const float*)(ws8 + WS_SBW)}); }
#ifdef DUP_WIN
        { Sched<0> S; S.init(T / 256, INWP / 256, (T / 256) * (INWP / 256), DM, DM); gemm_phase(lds, Gemm{H, WIN, DM, DM, DM}, S, EpiBf16{Y, INWP, 0}); }
#endif
        GRID_SYNC(); STOPCHK(4);
        ph::post_win(KP, l);
        GRID_SYNC(); STOPCHK(5);
        { unsigned char* ws8 = optr(gp(KP.ws));
          { Sched<0> S; S.init(T / 256, 3072 / 256, (T / 256) * 12, 256, 256); gemm_phase<EpiQ, Sched<0>, 2>(lds, Gemm{CQN, (const bf16_t*)(ws8 + WS_WUQ8), 256, 256, 256, (const float*)(ws8 + WS_SAQ), (const float*)(ws8 + WS_SBQ)}, S, EpiQ{Q, QL, (const float*)(ws8 + WS_TAB64)}); }
          { Sched<0> S; S.init(TP / 256, 4096 / 256, (TP / 256) * 16, 256, 256); gemm_phase<EpiBf16, Sched<0>, 2>(lds, Gemm{CKVNP, (const bf16_t*)(ws8 + WS_WUKV8), 256, 256, 256, (const float*)(ws8 + WS_SAK), (const float*)(ws8 + WS_SBK)}, S, EpiBf16{KV, 4096, 0}); } }
        GRID_SYNC(); STOPCHK(6);
#ifndef DUP_ATTN
#define DUP_ATTN 1
#endif
#ifndef DUP_RET
#define DUP_RET 1
#endif
#ifndef DUP_GATHER
#define DUP_GATHER 0
#endif
#pragma unroll 1
        for (int rep_ = 0; rep_ < DUP_ATTN; ++rep_)
        { for (int u = obid(); u < 512; u += ogrid()) { const int c = u & 255, i = u >> 8, xcd = c & 7, slot = c >> 3; const int bh = xcd * 4 + (slot >> 3) + 32 * i, pr = slot & 7, b = bh >> 4, h = bh & 15;
#pragma unroll 1
              for (int z = 0; z < 2; ++z) { const int qb = z ? 15 - pr : pr; const long tok0 = (long)b * SEQ + 256 * qb;
                  att::attn_block(Q + tok0 * 3072 + h * 192, KV + (long)b * SEQ * 4096 + h * 256, KRP + (long)b * SEQ * 64, KV + (long)b * SEQ * 4096 + h * 256 + 128, OA + tok0 * DM + h * 128, qb, ldsg); } } }
        { Sched<1> S; S.init(0, 0, 256, 3072, 256); gemm_phase(lds, Gemm{Q, WUK, 256, 3072, 256}, S, EpiRowMap<1>{QL, nullptr}); }
        GRID_SYNC(); STOPCHK(8);
        { Sched<2> S; S.init(0, 0, DB * 36, QLD, QLD); gemm_phase(lds, Gemm{QL, CKA, QLD, QLD, QLD}, S, EpiExp{SP, (float*)(optr(gp(KP.ws)) + WS_CTL + CTL_RSUM) + (long)l * 32768}); }
        GRID_SYNC(); STOPCHK(9);
        { Sched<3> S; S.init(0, 0, 256, KPAD, KPAD); gemm_phase(lds, Gemm{SP, CKT, 2176, KPAD, KPAD}, S, EpiRowMap<3>{OL, (const float*)(optr(gp(KP.ws)) + WS_CTL + CTL_RSUM) + (long)l * 32768}); }
        GRID_SYNC(); STOPCHK(11);
        { Sched<4> S; S.init(0, 0, 128, 512, 512); gemm_phase(lds, Gemm{OL, WUKV, 512, 512, 512}, S, EpiOV{OA}); }
#pragma unroll 1
        for (int rep_ = 0; rep_ < DUP_RET; ++rep_)
        for (int u = obid(); u < 256 + DB * 64; u += ogrid()) ret::unit(KP, l, u, ldsg);
#ifdef DUP_RETP
        for (int u = obid(); u < 256; u += ogrid()) ret::unit(KP, l, u, ldsg);
#endif
        GRID_SYNC(); STOPCHK(12);
        ph::rows2048_int8(KP, WS_OA, WS_OA8, WS_SAO, T);
        GRID_SYNC();
        { Sched<0> S; S.init(T / 256, DM / 256, (T / 256) * 8, DM / 2, DM / 2); unsigned char* ws8 = optr(gp(KP.ws));
          gemm_phase<EpiBf16, Sched<0>, 2>(lds, Gemm{(const bf16_t*)(ws8 + WS_OA8), (const bf16_t*)(ws8 + WS_WA8), DM / 2, DM / 2, DM / 2, (const float*)(ws8 + WS_SAO), (const float*)(ws8 + WS_SBA)}, S, EpiBf16{YA, DM, 0}); }
        { const int G_ = ogrid(), rem_ = ((T / 256) * 8) % G_; const int b_ = obid();
          if (rem_ == 0) ph::gnorm_gate(KP, ph::gwave(), ph::nwaves());
          else if (b_ >= rem_) ph::gnorm_gate(KP, (b_ - rem_) * 8 + (otid() >> 6), (G_ - rem_) * 8); }
#ifdef DUP_WA
#pragma unroll 1
        for (int rep_ = 0; rep_ < DUP_WA; ++rep_)
        { Sched<0> S; S.init(T / 256, DM / 256, (T / 256) * 8, DM, DM); gemm_phase(lds, Gemm{OA, WA, DM, DM, DM}, S, EpiBf16{YA, DM, 0}); }
#endif
        GRID_SYNC(); STOPCHK(14);
        { Sched<0> S; S.init(T / 256, DM / 256, (T / 256) * 8, DM / 2, DM / 2); unsigned char* ws8 = optr(gp(KP.ws));
          gemm_phase<EpiMix, Sched<0>, true>(lds, Gemm{(const bf16_t*)(ws8 + WS_BG), (const bf16_t*)(ws8 + WS_WB8), DM / 2, DM / 2, DM / 2}, S, EpiMix{Y, YA, MIX, (const float*)(ws8 + WS_SA8), (const float*)(ws8 + WS_SBB)}); }
        { const int G_ = ogrid(), rem_ = ((T / 256) * 8) % G_; const int b_ = obid();
          if (rem_ == 0) ph::peer_convert(KP, l, 0, NEXP, ph::gwave(), ph::nwaves());
          else if (b_ >= rem_) ph::peer_convert(KP, l, 0, NEXP, (b_ - rem_) * 8 + (otid() >> 6), (G_ - rem_) * 8); }
        GRID_SYNC(); STOPCHK(15);
        ph::rows2048_int8(KP, WS_MIX, WS_MIX8, WS_SA8, T);
        GRID_SYNC();
        { Sched<0> S; S.init(T / 256, DM / 256, (T / 256) * 8, DM / 2, DM / 2); unsigned char* ws8 = optr(gp(KP.ws));
          gemm_phase<EpiRes, Sched<0>, 2>(lds, Gemm{(const bf16_t*)(ws8 + WS_MIX8), (const bf16_t*)(ws8 + WS_WO8), DM / 2, DM / 2, DM / 2, (const float*)(ws8 + WS_SA8), (const float*)(ws8 + WS_SBO)}, S, EpiRes{gp(KP.out), ADA + 2 * DM, l == 0 ? gp(KP.x_prompt) : gp(KP.out), l == 0 ? gp(KP.x_sample) : gp(KP.out) + (long)TP * DM}); }
        { const int G_ = ogrid(), rem_ = ((T / 256) * 8) % G_; const int b_ = obid();
          if (rem_ == 0) ph::peer_convert(KP, l, NEXP, 2 * NEXP, ph::gwave(), ph::nwaves());
          else if (b_ >= rem_) ph::peer_convert(KP, l, NEXP, 2 * NEXP, (b_ - rem_) * 8 + (otid() >> 6), (G_ - rem_) * 8); }
        GRID_SYNC(); STOPCHK(16);
        ph::modulate(KP, l, 1);
        GRID_SYNC(); STOPCHK(17);
        { Sched<0> S; S.init(T / 256, DM / 256, (T / 256) * 8, DM / 2, DM / 2);
          unsigned char* ws8 = optr(gp(KP.ws));
          gemm_phase<EpiQ8, Sched<0>, true>(lds, Gemm{(const bf16_t*)(ws8 + WS_H8), (const bf16_t*)(ws8 + WS_WPQ8 + (long)l * DM * DM), DM / 2, DM / 2, DM / 2}, S, EpiQ8{QP, DM, (const float*)(ws8 + WS_SA8), (const float*)(ws8 + WS_SB8) + (long)l * DM});
#ifdef DUP_WPQ
          gemm_phase<EpiQ8, Sched<0>, true>(lds, Gemm{(const bf16_t*)(ws8 + WS_H8), (const bf16_t*)(ws8 + WS_WPQ8 + (long)l * DM * DM), DM / 2, DM / 2, DM / 2}, S, EpiQ8{QP, DM, (const float*)(ws8 + WS_SA8), (const float*)(ws8 + WS_SB8) + (long)l * DM});
#endif
        }
        if (l + 1 < DEPTH) { const int G_ = ogrid(), rem_ = ((T / 256) * 8) % G_; const int b_ = obid();
          if (rem_ == 0) ph::cache_convert(KP, l + 1, ldsg, 0, 4096, b_, G_);
          else if (b_ >= rem_) ph::cache_convert(KP, l + 1, ldsg, 0, 4096, b_ - rem_, G_ - rem_); }
        GRID_SYNC(); STOPCHK(18);
        { const int tid_ = otid(); const int lane = tid_ & 63; float* strip = (float*)ldsg + tid_ * 33; unsigned char* ws = optr(gp(KP.ws));
          const bf16_t* k1g = (const bf16_t*)(ws + WS_PK1) + (long)l * 128 * 128; const bf16_t* k2g = (const bf16_t*)(ws + WS_PK2) + (long)l * 128 * 128;
          bf16_t* k1 = (bf16_t*)(ldsg + 512 * 33 * 4 + 64); bf16_t* k2 = k1 + 128 * peer::KPITCH;
          for (int i = tid_; i < 2 * 128 * 16; i += 512) { const int which = i >> 11, r = (i >> 4) & 127, ch = i & 15;
              *reinterpret_cast<u32x4*>((which ? k2 : k1) + r * peer::KPITCH + ch * 8) = *reinterpret_cast<const u32x4*>((which ? k2g : k1g) + r * 128 + ch * 8); }
          __syncthreads();
          for (int wu = ph::gwave(); wu < (T / 32) * PH; wu += ph::nwaves()) peer::select_unit(QP, k1, k2, (int*)(ws + WS_PIDX), (float*)(ws + WS_PW), (wu >> 3) * 32, wu & 7, lane, strip);
#ifdef DUP_SEL
          for (int wu = ph::gwave(); wu < (T / 32) * PH; wu += ph::nwaves()) peer::select_unit(QP, k1, k2, (int*)(ws + WS_PIDX), (float*)(ws + WS_PW), (wu >> 3) * 32, wu & 7, lane, strip);
#endif
        }
        GRID_SYNC(); STOPCHK(19);
        { const int tid_ = otid(); const int lane = tid_ & 63, wid = tid_ >> 6; unsigned char* ws = optr(gp(KP.ws));
          volatile LAS unsigned* iw = (volatile LAS unsigned*)(lds + LDS_BARW); peer::XInfo xin; xin.rank = __builtin_amdgcn_readfirstlane((int)iw[2]); xin.xi = __builtin_amdgcn_readfirstlane((int)iw[3]); xin.nx = __builtin_amdgcn_readfirstlane((int)iw[4]); xin.nloc = __builtin_amdgcn_readfirstlane((int)iw[5]);
          if (xin.nx >= 1 && xin.nx <= 8) {
              peer::upass((const unsigned char*)(ws + WS_H8), (const float*)(ws + WS_SA8), (const unsigned char*)(ws + WS_PU), (const int*)(ws + WS_PIDX), (const float*)(ws + WS_PW), (const float*)(ws + WS_PSU), (const float*)(ws + WS_PSV), (int*)(ws + WS_DOTP), (unsigned*)(ws + WS_ACT), xin, wid, lane);
              GRID_SYNC();
              int vs0_, vsn_, vse_;
              if ((256 % xin.nx) == 0) { const int spx = 256 / xin.nx; vs0_ = xin.xi * spx + xin.rank; vsn_ = xin.nloc; vse_ = (xin.xi + 1) * spx; }
              else { vs0_ = obid(); vsn_ = ogrid(); vse_ = 256; }
              peer::vpass_lds((const unsigned char*)(ws + WS_PV), (const unsigned*)(ws + WS_ACT), gp(KP.out), ADA + 5 * DM, ldsg, vs0_, vsn_, vse_, tid_);
#ifdef DUP_VP
              peer::vpass_lds((const unsigned char*)(ws + WS_PV), (const unsigned*)(ws + WS_ACT), (float*)(ws + WS_OB), ADA + 5 * DM, ldsg, vs0_, vsn_, vse_, tid_);
#endif
          } else {
              for (int t = ph::gwave(); t < T; t += ph::nwaves()) peer::gather_token((const unsigned char*)(ws + WS_H8), (const float*)(ws + WS_SA8), (const unsigned char*)(ws + WS_PU), (const unsigned char*)(ws + WS_PV), (const float*)(ws + WS_PSU), (const float*)(ws + WS_PSV), (const int*)(ws + WS_PIDX), (const float*)(ws + WS_PW), gp(KP.out), ADA + 5 * DM, t, lane);
          } }
        GRID_SYNC(); STOPCHK(20);
    }
    ph::final_norm(KP);
}

extern "C" void kernel_launch(void* const* d_in, const int* in_sizes, int n_in, void* d_out, int out_size, void* d_ws, size_t ws_size, hipStream_t stream) {
    static int grid = 0;
    if (grid == 0) {
        if (n_in != 25 || out_size != (int)O_END || ws_size < WS_END) { fprintf(stderr, "kernel_launch: shape mismatch: n_in %d out %d (want %ld) ws %zu (want >= %zu)\n", n_in, out_size, O_END, ws_size, (size_t)WS_END); grid = -1; return; }
        int dev = 0, cus = 0, per_cu = 0;
        if (hipGetDevice(&dev) != hipSuccess || hipDeviceGetAttribute(&cus, hipDeviceAttributeMultiprocessorCount, dev) != hipSuccess) { fprintf(stderr, "kernel_launch: device query failed\n"); grid = -1; return; }
        if (hipFuncSetAttribute((const void*)mega_fwd, hipFuncAttributeMaxDynamicSharedMemorySize, LDS_BYTES) != hipSuccess) { fprintf(stderr, "kernel_launch: hipFuncSetAttribute failed\n"); grid = -1; return; }
        if (hipOccupancyMaxActiveBlocksPerMultiprocessor(&per_cu, (const void*)mega_fwd, 512, LDS_BYTES) != hipSuccess || per_cu < 1) { fprintf(stderr, "kernel_launch: occupancy query says %d blocks per CU\n", per_cu); grid = -1; return; }
        grid = cus;
#ifdef FORCE_GRID
        grid = FORCE_GRID;
#endif
    }
    if (grid < 0) return;
    (void)hipMemsetAsync((char*)d_ws + WS_CTL, 0, CTL_BYTES, stream);
    Params p{};
    const float* const* in = (const float* const*)d_in;
    p.x_prompt = in[0]; p.x_sample = in[1]; p.c_prompt = in[2]; p.c_sample = in[3]; p.cache_ckv = in[4]; p.cache_krope = in[5]; p.state_ret = in[6]; p.w_ada = in[7]; p.b_ada = in[8];
    p.g_mix = in[9]; p.g_ffn = in[10]; p.w_in = in[11]; p.g_q = in[12]; p.w_uq = in[13]; p.g_kv = in[14]; p.w_ukv = in[15]; p.w_a = in[16]; p.w_b = in[17]; p.w_o = in[18]; p.w_pq = in[19];
    p.peer_k1 = in[20]; p.peer_k2 = in[21]; p.peer_u = in[22]; p.peer_v = in[23]; p.g_final = in[24];
    p.out = (float*)d_out; p.ws = (unsigned char*)d_ws;
    for (int h = 0; h < 8; ++h) p.lg[h] = (float)log1p(-pow(2.0, -5.0 - (double)h));
    p.grid = grid; p.pad_ = 0;
    hipLaunchKernelGGL(mega_fwd, dim3(grid), dim3(512), LDS_BYTES, stream, p);
    const hipError_t le = hipGetLastError();
    if (le != hipSuccess) fprintf(stderr, "kernel_launch: launch failed: %s\n", hipGetErrorName(le));
}
```

```cpp
#include <hip/hip_runtime.h>
#include <cstdio>
#include <cstdint>
#include <cmath>

#define LAS __attribute__((address_space(3)))
typedef unsigned short bf16_t;
typedef short bf16x8 __attribute__((ext_vector_type(8)));
typedef float f32x4 __attribute__((ext_vector_type(4)));
typedef float f32x2 __attribute__((ext_vector_type(2)));
typedef float f32x16 __attribute__((ext_vector_type(16)));
typedef unsigned u32x4 __attribute__((ext_vector_type(4)));
typedef unsigned u32x2 __attribute__((ext_vector_type(2)));
typedef short s16x4 __attribute__((ext_vector_type(4)));
typedef int i32x4 __attribute__((ext_vector_type(4)));

constexpr int DM = 2048, NB = 4, SEQ = 4096, DEPTH = 2, DB = 32, DS = 64, PAST = 2048;
constexpr int TP = NB * SEQ, TS = DB * DS, T = TP + TS;
constexpr int NCOND = NB + DB;
constexpr int QLORA = 512, KVLORA = 512, ROPE = 64, NOPE = 128, VD = 128, MH = 16, QKD = 192;
constexpr int RH = 8, RQK = 128, RV = 256;
constexpr int PH = 8, NKEYS = 128, NEXP = 16384, PTOPK = 16;
constexpr int INW = 11328, INWP = 11520;
constexpr int C_CQ = 0, C_CKV = 512, C_KR = 1024, C_RQ = 1088, C_RK = 2112, C_RV = 3136, C_RG = 5184, C_GA = 7232, C_GB = 9280;
constexpr int KALL = PAST + DS;
constexpr int KPAD = 2304;
constexpr int QLD = 640;
constexpr float EPS = 1e-6f;
constexpr float MLA_SCALE = 0.07216878364870322f;

constexpr long O_Y = 0;
constexpr long O_CKVP = (long)T * DM;
constexpr long O_KRP = O_CKVP + 2L * TP * 512;
constexpr long O_RETP = O_KRP + 2L * TP * 64;
constexpr long O_CKVS = O_RETP + 2L * NB * RH * RQK * RV;
constexpr long O_KRS = O_CKVS + 2L * TS * 512;
constexpr long O_RETS = O_KRS + 2L * TS * 64;
constexpr long O_END = O_RETS + 2L * DB * RH * RQK * RV;

constexpr size_t al256(size_t x) { return (x + 255) / 256 * 256; }
constexpr size_t WS_CTL = 0;
constexpr size_t CTL_BYTES = 65536 + 2UL * 32768 * 4;
constexpr size_t CTL_RSUM = 65536;
constexpr size_t WS_TAB64 = WS_CTL + CTL_BYTES;
constexpr size_t WS_TAB128 = WS_TAB64 + 4096UL * 32 * 2 * 4;
constexpr size_t WS_ADA = WS_TAB128 + 4096UL * 64 * 2 * 4;
constexpr size_t WS_ADAP = WS_ADA + 2UL * NCOND * 12288 * 4;
constexpr size_t WS_WIN = WS_ADAP + 8UL * 2 * NCOND * 12288 * 4;
constexpr size_t WS_WUQ = WS_WIN + 2UL * INWP * DM * 2;
constexpr size_t WS_WUKV = WS_WUQ + 2UL * 3072 * 512 * 2;
constexpr size_t WS_WUK = WS_WUKV + 2UL * 4096 * 512 * 2;
constexpr size_t WS_WA = WS_WUK + 2UL * 16 * 512 * 256 * 2;
constexpr size_t WS_WB = WS_WA + 2UL * DM * DM * 2;
constexpr size_t WS_WO = WS_WB + 2UL * DM * DM * 2;
constexpr size_t WS_WPQ = WS_WO + 2UL * DM * DM * 2;
constexpr size_t WS_PK1 = WS_WPQ + 2UL * DM * DM * 2;
constexpr size_t WS_PK2 = WS_PK1 + 2UL * 128 * 128 * 2;
constexpr size_t WS_H = WS_PK2 + 2UL * 128 * 128 * 2;
constexpr size_t WS_Y = WS_H + (size_t)T * DM * 2;
constexpr size_t WS_CQN = WS_Y + (size_t)T * INWP * 2;
constexpr size_t WS_CKVNP = WS_CQN + (size_t)T * 512 * 2;
constexpr size_t WS_KRP = WS_CKVNP + (size_t)TP * 512 * 2;
constexpr size_t WS_Q = WS_KRP + (size_t)TP * 64 * 2;
constexpr size_t WS_YA = WS_Q;
constexpr size_t WS_KV = WS_Q + (size_t)T * 3072 * 2 + 4096;
constexpr size_t WS_SP = WS_KV;
constexpr size_t WS_MIX = WS_KV;
constexpr size_t WS_OA = WS_KV + 32UL * 1024 * KPAD * 2;
constexpr size_t WS_QP = WS_OA;
constexpr size_t WS_CKA = WS_OA + (size_t)T * DM * 2;
constexpr size_t WS_CKT = WS_CKA + 32UL * KPAD * QLD * 2;
constexpr size_t WS_QL = WS_CKT + 32UL * 512 * KPAD * 2;
constexpr size_t WS_OL = WS_QL + 32UL * 1024 * QLD * 2;
constexpr size_t WS_OB = WS_OL + 16UL * 2048 * 512 * 2;
constexpr size_t WS_BG = WS_OB + (size_t)T * DM * 2;
constexpr size_t WS_PIDX = WS_BG + (size_t)T * DM * 2;
constexpr size_t WS_PW = WS_PIDX + (size_t)T * 128 * 4;
constexpr size_t WS_PU = WS_PW + (size_t)T * 128 * 4;
constexpr size_t WS_PV = WS_PU + (size_t)NEXP * DM;
constexpr size_t WS_PSU = WS_PV + (size_t)NEXP * DM;
constexpr size_t WS_PSV = WS_PSU + (size_t)NEXP * 4;
constexpr size_t WS_WPQ8 = WS_PSV + (size_t)NEXP * 4;
constexpr size_t WS_SB8 = WS_WPQ8 + 2UL * DM * DM;
constexpr size_t WS_SA8 = WS_SB8 + 2UL * DM * 4;
constexpr int NB8 = 38;
constexpr size_t WS_WIN8 = WS_BG + (size_t)T * DM;
constexpr size_t WS_WB8 = WS_WIN8 + (size_t)NB8 * 256 * DM;
constexpr size_t WS_WUQ8 = WS_WB8 + (size_t)DM * DM;
constexpr size_t WS_WUKV8 = WS_WUQ8 + 3072UL * 512;
constexpr size_t WS_WA8 = WS_WUKV8 + 4096UL * 512;
constexpr size_t WS_WO8 = WS_WA8 + (size_t)DM * DM;
static_assert(WS_WO8 + (size_t)DM * DM <= WS_BG + (size_t)T * DM * 2, "int8 weights overflow the BG region");
constexpr size_t WS_OA8 = WS_Q + (size_t)T * DM * 2;
constexpr size_t WS_MIX8 = WS_KV + (size_t)T * DM * 2;
static_assert(WS_OA8 + (size_t)T * DM <= WS_KV && WS_MIX8 + (size_t)T * DM <= WS_KV + (size_t)TP * 4096 * 2, "int8 activation copies fit");
constexpr size_t WS_SBW = WS_SA8 + al256((size_t)T * 4);
constexpr size_t WS_SBB = WS_SBW + al256((size_t)INWP * 4);
constexpr size_t WS_SBQ = WS_SBB + (size_t)DM * 4;
constexpr size_t WS_SBK = WS_SBQ + 3072UL * 4;
constexpr size_t WS_SAQ = WS_SBK + 4096UL * 4;
constexpr size_t WS_SAK = WS_SAQ + al256((size_t)T * 4);
constexpr size_t WS_SBA = WS_SAK + al256((size_t)TP * 4);
constexpr size_t WS_SBO = WS_SBA + (size_t)DM * 4;
constexpr size_t WS_SAO = WS_SBO + (size_t)DM * 4;
constexpr size_t WS_END = WS_SAO + al256((size_t)T * 4);
constexpr size_t WS_H8 = WS_OB;
static_assert((size_t)TP * 4096 * 2 <= 32UL * 1024 * KPAD * 2, "KV fits in the SP region");
static_assert(WS_END <= 1608000000UL, "workspace map too large");
static_assert(WS_WIN % 256 == 0 && WS_H % 256 == 0 && WS_Y % 256 == 0 && WS_Q % 256 == 0 && WS_KV % 256 == 0 && WS_CKA % 256 == 0, "alignment");

constexpr int LDS_BYTES = 147456;
constexpr int LDS_BARW = LDS_BYTES - 32;
constexpr size_t CTL_RANK = 16384;
constexpr size_t WS_DOTP = WS_Q;
constexpr size_t WS_ACT = WS_DOTP + 8UL * T * 128 * 4;
constexpr size_t WS_PIDXT = WS_ACT + (size_t)T * 128 * 4;
static_assert(WS_PIDXT + (size_t)T * 128 * 4 <= WS_KV, "PEER scratch fits in the Q region");

struct Params {
    const float *x_prompt, *x_sample, *c_prompt, *c_sample, *cache_ckv, *cache_krope, *state_ret, *w_ada, *b_ada, *g_mix, *g_ffn, *w_in, *g_q, *w_uq, *g_kv, *w_ukv,
                *w_a, *w_b, *w_o, *w_pq, *peer_k1, *peer_k2, *peer_u, *peer_v, *g_final;
    float* out; unsigned char* ws;
    float lg[8];
    int grid; int pad_;
};

typedef const __attribute__((address_space(4))) Params KParams;
__device__ __forceinline__ KParams* okarg() {
    const uintptr_t k = (uintptr_t)__builtin_amdgcn_kernarg_segment_ptr();
    unsigned lo = (unsigned)k, hi = (unsigned)(k >> 32);
    asm volatile("" : "+s"(lo), "+s"(hi)); return (KParams*)(((uintptr_t)hi << 32) | lo); }
#define KP (*okarg())
__device__ __forceinline__ int ogrid() { return KP.grid; }
__device__ __forceinline__ int obid() { int b = (int)blockIdx.x; asm volatile("" : "+s"(b) :: "memory"); return b; }
__device__ __forceinline__ int otid() { int t = (int)threadIdx.x; asm volatile("" : "+v"(t) :: "memory"); return t; }
template <class P> __device__ __forceinline__ P* gp(P* p) { return (P*)(__attribute__((address_space(1))) P*)(uintptr_t)p; }
template <class P> __device__ __forceinline__ P* optr(P* p) {
    unsigned lo = __builtin_amdgcn_readfirstlane((unsigned)(uintptr_t)p), hi = __builtin_amdgcn_readfirstlane((unsigned)((uintptr_t)p >> 32));
    asm volatile("" : "+s"(lo), "+s"(hi)); return gp((P*)(((uintptr_t)hi << 32) | lo)); }
typedef __bf16 bf16v2_t __attribute__((ext_vector_type(2)));
__device__ __forceinline__ unsigned cvt_pk_bf16(float lo, float hi) { f32x2 v = {lo, hi}; bf16v2_t r = __builtin_convertvector(v, bf16v2_t); return __builtin_bit_cast(unsigned, r); }
__device__ __forceinline__ bf16_t f2bf(float f) { return (bf16_t)(cvt_pk_bf16(f, 0.f) & 0xffffu); }
__device__ __forceinline__ float bf2f(bf16_t b) { return __uint_as_float(((unsigned)b) << 16); }
__device__ __forceinline__ float bflo(unsigned w) { return __uint_as_float(w << 16); }
__device__ __forceinline__ float bfhi(unsigned w) { return __uint_as_float(w & 0xffff0000u); }
__device__ __forceinline__ void unpack8(const u32x4 w, float (&f)[8]) { f[0] = bflo(w.x); f[1] = bfhi(w.x); f[2] = bflo(w.y); f[3] = bfhi(w.y); f[4] = bflo(w.z); f[5] = bfhi(w.z); f[6] = bflo(w.w); f[7] = bfhi(w.w); }
__device__ __forceinline__ u32x4 pack8(const float (&f)[8]) { u32x4 w; w.x = cvt_pk_bf16(f[0], f[1]); w.y = cvt_pk_bf16(f[2], f[3]); w.z = cvt_pk_bf16(f[4], f[5]); w.w = cvt_pk_bf16(f[6], f[7]); return w; }
template <int K> __device__ __forceinline__ float sx(float v) {
    if constexpr (K == 32) { const auto rr = __builtin_amdgcn_permlane32_swap(__float_as_uint(v), __float_as_uint(v), false, false); return __uint_as_float((otid() & 32) ? rr[0] : rr[1]); }
    else return __int_as_float(__builtin_amdgcn_ds_swizzle(__float_as_int(v), (K << 10) | 0x1F));
}
__device__ __forceinline__ float wave_sum(float v) { v += sx<32>(v); v += sx<16>(v); v += sx<8>(v); v += sx<4>(v); v += sx<2>(v); v += sx<1>(v); return v; }
__device__ __forceinline__ float wave_max(float v) { v = fmaxf(v, sx<32>(v)); v = fmaxf(v, sx<16>(v)); v = fmaxf(v, sx<8>(v)); v = fmaxf(v, sx<4>(v)); v = fmaxf(v, sx<2>(v)); v = fmaxf(v, sx<1>(v)); return v; }
__device__ __forceinline__ float sigmoidf_(float x) { return 1.0f / (1.0f + __expf(-x)); }
__device__ __forceinline__ float siluf_(float x) { return x / (1.0f + __expf(-x)); }
__device__ __forceinline__ int cond_row(int t) { return t < TP ? (t >> 12) : NB + ((t - TP) >> 6); }
__device__ __forceinline__ int tok_pos(int t) { return t < TP ? (t & 4095) : PAST + ((t - TP) & 63); }

#define XB_TMO      128
#define XB_XCNT(j)  (256  + 64 * (j))
#define XB_XSUB(j)  (1280 + 64 * (j))
#define XB_XGEN(j)  (2304 + 64 * (j))
#define XB_TOP      3328
#define XB_TOPGEN   3392
#define XCD_BAR_WORDS 3456
#define XB_SPIN_CAP (1u << 22)
__device__ __forceinline__ unsigned xb_ld(unsigned* p)              { return __hip_atomic_load(p, __ATOMIC_RELAXED, __HIP_MEMORY_SCOPE_AGENT); }
__device__ __forceinline__ unsigned xb_add(unsigned* p, unsigned v) { return __hip_atomic_fetch_add(p, v, __ATOMIC_RELAXED, __HIP_MEMORY_SCOPE_AGENT); }
__device__ __forceinline__ unsigned xb_xcc_id() { return (unsigned)__builtin_amdgcn_s_getreg((3 << 11) | 20) & 0xFu; }
#define XB_SPIN(cond, bar) do { unsigned _sp = 0; while (cond) { __builtin_amdgcn_s_sleep(0); \
    if ((++_sp & 255u) == 0u) { if (xb_ld(&(bar)[XB_TMO])) break; if (_sp > XB_SPIN_CAP) { atomicAdd(&(bar)[XB_TMO], 1u); break; } } } } while (0)
struct XcdBarrier { unsigned* bar; unsigned x; volatile LAS unsigned* st; };
__device__ __forceinline__ XcdBarrier xcd_barrier_post(unsigned* bar, volatile LAS unsigned* st) {
    XcdBarrier b; b.bar = bar; b.x = xb_xcc_id(); b.st = st;
    if (threadIdx.x == 0) (void)xb_add(&bar[XB_XCNT(b.x)], 1u);
    return b;
}
__device__ __forceinline__ void xcd_barrier_complete(unsigned* bar, unsigned x, unsigned& nloc, unsigned& nx) {
    const unsigned G = (unsigned)KP.grid;
    unsigned sum, cnt, mine, sp = 0u;
    for (;;) {
        sum = 0u; cnt = 0u; mine = 0u;
#pragma unroll
        for (unsigned j = 0; j < 16; ++j) { const unsigned c = xb_ld(&bar[XB_XCNT(j)]); sum += c; cnt += (c > 0u) ? 1u : 0u; mine = (j == x) ? c : mine; }
        if (sum == G) break;
        __builtin_amdgcn_s_sleep(1);
        if ((++sp & 255u) == 0u) { if (xb_ld(&bar[XB_TMO])) break; if (sp > XB_SPIN_CAP) { atomicAdd(&bar[XB_TMO], 1u); break; } }
    }
    nloc = mine > 0u ? mine : 1u; nx = cnt > 0u ? cnt : 1u;
}
__device__ __forceinline__ void xcd_barrier(const XcdBarrier& b) {
    asm volatile("s_waitcnt vmcnt(0)" ::: "memory");
    __syncthreads();
    if (otid() == 0) {
        unsigned* bar = (unsigned*)(gp(KP.ws) + WS_CTL);
        unsigned bx = xb_xcc_id(); asm volatile("" : "+s"(bx));
        __builtin_amdgcn_s_waitcnt(0);
        unsigned nloc = b.st[0], nx = b.st[1];
        if (nloc == 0u) { xcd_barrier_complete(bar, bx, nloc, nx); b.st[0] = nloc; b.st[1] = nx; }
        const unsigned old = xb_add(&bar[XB_XSUB(bx)], 1u);
        const unsigned gen = old / nloc;
        if (old + 1u == (gen + 1u) * nloc) {
            __builtin_amdgcn_fence(__ATOMIC_RELEASE, "agent");
            asm volatile("s_waitcnt vmcnt(0)" ::: "memory");
            const unsigned og = xb_add(&bar[XB_TOP], 1u);
            const unsigned tg = og / nx;
            if (og + 1u == (tg + 1u) * nx) xb_add(&bar[XB_TOPGEN], 1u);
            else XB_SPIN(xb_ld(&bar[XB_TOPGEN]) == tg, bar);
            __builtin_amdgcn_fence(__ATOMIC_ACQUIRE, "agent");
            xb_add(&bar[XB_XGEN(bx)], 1u);
            asm volatile("s_waitcnt vmcnt(0)" ::: "memory");
        } else {
            XB_SPIN(xb_ld(&bar[XB_XGEN(bx)]) == gen, bar);
            __builtin_amdgcn_fence(__ATOMIC_ACQUIRE, "agent");
            asm volatile("s_waitcnt vmcnt(0)" ::: "memory");
        }
    }
    __syncthreads();
}
namespace pg8 {
constexpr int BM = 256, BK = 64, HALF = 128, HTB = HALF * BK * 2, STAGE_BYTES = 8 * HTB, NXCD = 8, WGM = 8;
__host__ __device__ __forceinline__ int lds_byte(int r, int c) { const int st = (r >> 4) * 2 + (c >> 5), rr = r & 15, cc = c & 31, ob = rr * 64 + cc * 2; return st * 1024 + (ob ^ (((ob >> 9) & 1) << 5)); }
__host__ __device__ __forceinline__ void stage_rc(int b, int& R, int& C) { const int st = b / 1024, sb = b % 1024, swz = sb ^ (((sb >> 9) & 1) << 5); R = (st >> 1) * 16 + swz / 64; C = (st & 1) * 32 + (swz % 64) / 2; }
__host__ __device__ __forceinline__ int perm32(int rho) { const int n = rho >> 4, i = rho & 15; return 8 * (i >> 2) + 4 * n + (i & 3); }

struct Unit { int pm, pn; long aoff, boff; int x0, x1; };
struct Gemm { const bf16_t* A; const bf16_t* Bt; int K; int lda, ldb; const float* sa; const float* sb; };

template <int MODE> struct Sched {
    int nM, nN, nwg, G, c; long lda, ldb;
    __device__ void init(int nM_, int nN_, int nwg_, long lda_, long ldb_) { nM = nM_; nN = nN_; nwg = nwg_; G = ogrid(); c = obid(); lda = lda_; ldb = ldb_; }
    __device__ void rotate(int r) { c = (c + r) % G; }
    __device__ bool next(int i, Unit& u) const {
        const long L = (long)i * G + c; if (L >= nwg) return false;
        int wgid = (int)L;
        if (MODE == 0 || MODE == 5 || MODE == 6) {
            { const int q = nwg / NXCD, r = nwg % NXCD, xcd = wgid % NXCD, off = wgid / NXCD; wgid = (xcd < r ? xcd * (q + 1) : r * (q + 1) + (xcd - r) * q) + off; }
            const int nig = WGM * nN, gid = wgid / nig, fm = gid * WGM, gsz = (nM - fm) < WGM ? (nM - fm) : WGM;
            u.pm = fm + ((wgid % nig) % gsz); u.pn = (wgid % nig) / gsz; u.x0 = 0; u.x1 = 0;
            { const int pl = u.pn;
              if (MODE == 5) u.pn = pl < 3 ? pl + 2 : pl + 5;
              if (MODE == 6) u.pn = pl < 2 ? pl : (pl < 5 ? pl + 3 : pl + 7);
              u.aoff = (long)u.pm * 256 * lda * 2; u.boff = (long)(MODE == 6 ? pl : u.pn) * 256 * ldb * 2; }
        } else if (MODE == 1) {
            const int h = wgid >> 4, rem = wgid & 15, rt = rem >> 1, pn = rem & 1;
            u.pm = rt; u.pn = pn; u.x0 = h; u.x1 = rt;
            u.aoff = ((long)(TP + 256 * rt) * 3072 + h * 192) * 2; u.boff = ((long)(h * 512 + 256 * pn) * 256) * 2;
        } else if (MODE == 2) {
            const int b = wgid / 36, rem = wgid % 36, pm = rem / 9, pn = rem % 9;
            u.pm = pm; u.pn = pn; u.x0 = b; u.x1 = 0;
            u.aoff = ((long)(b * 1024 + 256 * pm) * QLD) * 2; u.boff = ((long)(b * KPAD + 256 * pn) * QLD) * 2;
        } else if (MODE == 3) {
            const int b = wgid >> 3, pm = (wgid & 7) >> 1, pn = wgid & 1;
            u.pm = pm; u.pn = pn; u.x0 = b; u.x1 = 0;
            u.aoff = ((long)(b * 1024 + 256 * pm) * KPAD) * 2; u.boff = ((long)(b * 512 + 256 * pn) * KPAD) * 2;
        } else {
            const int h = wgid >> 3, rt = wgid & 7;
            u.pm = rt; u.pn = 0; u.x0 = h; u.x1 = rt;
            u.aoff = ((long)(h * 2048 + 256 * rt) * 512) * 2; u.boff = ((long)(h * 256) * 512) * 2;
        }
        return true;
    }
};

template <class Epi, class SchedT, int I8 = 0>
__device__ __forceinline__ void gemm_phase(LAS unsigned char* lds, const Gemm g, const SchedT& S, const Epi& E) {
    const int tid = otid(), wid = __builtin_amdgcn_readfirstlane(tid >> 6), lane = tid & 63, wr = wid >> 2, wc = wid & 3, fr = lane & 15, fq = lane >> 4;
    const int K = g.K, nt = K / BK;
    unsigned voffA[2], voffB[2];
#pragma unroll
    for (int i = 0; i < 2; ++i) { int R, C; stage_rc(tid * 16 + i * 8192, R, C); const int Rb = Epi::PERM ? ((R & ~31) + perm32(R & 31)) : R;
        voffA[i] = (unsigned)(R * g.lda + C) * 2u; voffB[i] = (unsigned)(Rb * g.ldb + C) * 2u; }
    const size_t kstep = (size_t)(BK * 2);
    const size_t hstepA = (size_t)HALF * g.lda * 2, hstepB = (size_t)HALF * g.ldb * 2;
    const unsigned ldsw = (unsigned)wid * 1024u;
    const int aoff = lds_byte(wr * 64 + fr, fq * 8), boff = lds_byte(wc * 32 + fr, fq * 8);
#define PG8_SA(b, h) (((b) * 2 + (h)) * HTB)
#define PG8_SB(b, h) ((4 + (b) * 2 + (h)) * HTB)
#define PG8_STAGE(bufoff, gbase, voff) do { _Pragma("unroll") for (int _i = 0; _i < 2; ++_i) \
        __builtin_amdgcn_global_load_lds((const unsigned*)((const char*)(gbase) + (voff)[_i]), (LAS unsigned*)(lds + (bufoff) + ldsw + _i * 8192), 16, 0, 0); } while (0)
#define PG8_LDA(dst, b, h) do { _Pragma("unroll") for (int m = 0; m < 4; ++m) _Pragma("unroll") for (int k = 0; k < 2; ++k) dst[m][k] = *(const LAS bf16x8*)(lds + PG8_SA(b, h) + aoff + m * 2048 + k * 1024); } while (0)
#define PG8_LDB(dst, b, h) do { _Pragma("unroll") for (int n = 0; n < 2; ++n) _Pragma("unroll") for (int k = 0; k < 2; ++k) dst[n][k] = *(const LAS bf16x8*)(lds + PG8_SB(b, h) + boff + n * 2048 + k * 1024); } while (0)
#define PG8_MMA(ai, bj, At, Bt) do { __builtin_amdgcn_s_setprio(1); _Pragma("unroll") for (int m = 0; m < 4; ++m) _Pragma("unroll") for (int n = 0; n < 2; ++n) _Pragma("unroll") for (int k = 0; k < 2; ++k) \
        { if constexpr (I8) acc[ai][bj][m][n] = __builtin_bit_cast(f32x4, __builtin_amdgcn_mfma_i32_16x16x64_i8(__builtin_bit_cast(i32x4, Bt[n][k]), __builtin_bit_cast(i32x4, At[m][k]), __builtin_bit_cast(i32x4, acc[ai][bj][m][n]), 0, 0, 0)); \
          else acc[ai][bj][m][n] = __builtin_amdgcn_mfma_f32_16x16x32_bf16(Bt[n][k], At[m][k], acc[ai][bj][m][n], 0, 0, 0); } __builtin_amdgcn_s_setprio(0); } while (0)
#define PG8_WAIT_V(n) asm volatile("s_waitcnt vmcnt(" #n ")" ::: "memory")
#define PG8_WAIT_L(n) asm volatile("s_waitcnt lgkmcnt(" #n ")" ::: "memory")
#define PG8_BAR __builtin_amdgcn_s_barrier()
#define PG8_SCHED __builtin_amdgcn_sched_barrier(0)
    Unit cur, nxt; int ui = 0;
    if (!S.next(0, cur)) return;
    f32x4 acc[2][2][4][2];
#pragma unroll
    for (int a = 0; a < 2; ++a)
#pragma unroll
        for (int b = 0; b < 2; ++b)
#pragma unroll
            for (int m = 0; m < 4; ++m)
#pragma unroll
                for (int n = 0; n < 2; ++n) acc[a][b][m][n] = (f32x4){0.f, 0.f, 0.f, 0.f};
    bf16x8 At[4][2], B0[2][2], B1[2][2];
    const char* cA = (const char*)g.A + cur.aoff; const char* cB = (const char*)g.Bt + cur.boff;
    PG8_STAGE(PG8_SB(0, 0), cB, voffB); PG8_STAGE(PG8_SA(0, 0), cA, voffA); PG8_STAGE(PG8_SB(0, 1), cB + hstepB, voffB); PG8_STAGE(PG8_SA(0, 1), cA + hstepA, voffA);
    if (wr == 1) PG8_BAR;
    PG8_WAIT_V(4); PG8_BAR;
    PG8_STAGE(PG8_SB(1, 0), cB + kstep, voffB); PG8_STAGE(PG8_SA(1, 0), cA + kstep, voffA); PG8_STAGE(PG8_SB(1, 1), cB + hstepB + kstep, voffB);
    PG8_WAIT_V(6); PG8_BAR;
    for (;;) {
        const bool has_next = S.next(ui + 1, nxt);
        const char* nA = has_next ? (const char*)g.A + nxt.aoff : cA; const char* nB = has_next ? (const char*)g.Bt + nxt.boff : cB;
        for (int t = 0; t < nt; t += 2) {
            const bool last = (t == nt - 2);
            const char* a1 = cA + (size_t)(t + 1) * kstep;
            const char* a2 = last ? nA : cA + (size_t)(t + 2) * kstep; const char* b2 = last ? nB : cB + (size_t)(t + 2) * kstep;
            const char* a3 = a2 + kstep; const char* b3 = b2 + kstep;
            PG8_LDB(B0, 0, 0); PG8_SCHED; PG8_LDA(At, 0, 0); PG8_STAGE(PG8_SA(1, 1), a1 + hstepA, voffA);
            PG8_WAIT_L(8); PG8_BAR; PG8_WAIT_L(0); PG8_MMA(0, 0, At, B0); PG8_BAR; PG8_SCHED;
            PG8_LDB(B1, 0, 1); PG8_STAGE(PG8_SB(0, 0), b2, voffB);
            PG8_BAR; PG8_WAIT_L(0); PG8_MMA(0, 1, At, B1); PG8_BAR;
            PG8_LDA(At, 0, 1); PG8_STAGE(PG8_SA(0, 0), a2, voffA);
            PG8_BAR; PG8_WAIT_L(0); PG8_MMA(1, 0, At, B0); PG8_BAR; PG8_SCHED;
            PG8_STAGE(PG8_SB(0, 1), b2 + hstepB, voffB);
            PG8_WAIT_V(6); PG8_BAR; PG8_MMA(1, 1, At, B1); PG8_BAR;
            PG8_LDB(B0, 1, 0); PG8_SCHED; PG8_LDA(At, 1, 0); PG8_STAGE(PG8_SA(0, 1), a2 + hstepA, voffA);
            PG8_WAIT_L(8); PG8_BAR; PG8_WAIT_L(0); PG8_MMA(0, 0, At, B0); PG8_BAR; PG8_SCHED;
            PG8_LDB(B1, 1, 1); PG8_STAGE(PG8_SB(1, 0), b3, voffB);
            PG8_BAR; PG8_WAIT_L(0); PG8_MMA(0, 1, At, B1); PG8_BAR;
            PG8_LDA(At, 1, 1); PG8_STAGE(PG8_SA(1, 0), a3, voffA);
            PG8_BAR; PG8_WAIT_L(0); PG8_MMA(1, 0, At, B0); PG8_BAR; PG8_SCHED;
            PG8_STAGE(PG8_SB(1, 1), b3 + hstepB, voffB);
            PG8_WAIT_V(6); PG8_BAR; PG8_MMA(1, 1, At, B1); PG8_BAR;
        }
        if constexpr (I8) {
#pragma unroll
            for (int a = 0; a < 2; ++a)
#pragma unroll
                for (int b = 0; b < 2; ++b)
#pragma unroll
                    for (int m = 0; m < 4; ++m)
#pragma unroll
                        for (int n = 0; n < 2; ++n) { const i32x4 iv = __builtin_bit_cast(i32x4, acc[a][b][m][n]); acc[a][b][m][n] = (f32x4){(float)iv[0], (float)iv[1], (float)iv[2], (float)iv[3]}; } }
        if constexpr (I8 == 2) {
            f32x4 sbv[2][2];
#pragma unroll
            for (int b = 0; b < 2; ++b) { const int c = cur.pn * BM + b * HALF + wc * 32 + (Epi::PERM ? 8 * fq : 4 * fq); sbv[b][0] = *(const f32x4*)(g.sb + c); sbv[b][1] = *(const f32x4*)(g.sb + c + (Epi::PERM ? 4 : 16)); }
#pragma unroll
            for (int a = 0; a < 2; ++a)
#pragma unroll
                for (int m = 0; m < 4; ++m) { const float s_ = g.sa[(long)cur.pm * BM + a * HALF + wr * 64 + m * 16 + fr];
#pragma unroll
                    for (int b = 0; b < 2; ++b) { acc[a][b][m][0] = acc[a][b][m][0] * sbv[b][0] * s_; acc[a][b][m][1] = acc[a][b][m][1] * sbv[b][1] * s_; } } }
        E(acc, cur, wr, wc, fr, fq);
        if (!has_next) break;
#pragma unroll
        for (int a = 0; a < 2; ++a)
#pragma unroll
            for (int b = 0; b < 2; ++b)
#pragma unroll
                for (int m = 0; m < 4; ++m)
#pragma unroll
                    for (int n = 0; n < 2; ++n) acc[a][b][m][n] = (f32x4){0.f, 0.f, 0.f, 0.f};
        cur = nxt; cA = nA; cB = nB; ++ui;
    }
    PG8_WAIT_V(0);
    if (wr == 0) PG8_BAR;
    PG8_BAR;
#undef PG8_SA
#undef PG8_SB
#undef PG8_STAGE
#undef PG8_LDA
#undef PG8_LDB
#undef PG8_MMA
#undef PG8_WAIT_V
#undef PG8_WAIT_L
#undef PG8_BAR
#undef PG8_SCHED
}

struct EpiBf16 {
    static constexpr bool PERM = true;
    bf16_t* O; long ldc; long bstride;
    __device__ __forceinline__ void operator()(const f32x4 (&acc)[2][2][4][2], const Unit& u, int wr, int wc, int fr, int fq) const {
        bf16_t* base = O + (long)u.x0 * bstride + (long)(u.pm * BM + wr * 64 + fr) * ldc + u.pn * BM + wc * 32 + 8 * fq;
#pragma unroll
        for (int ai = 0; ai < 2; ++ai)
#pragma unroll
            for (int m = 0; m < 4; ++m) { bf16_t* rowp = base + (long)(ai * HALF + m * 16) * ldc;
#pragma unroll
                for (int bj = 0; bj < 2; ++bj) { const f32x4 v0 = acc[ai][bj][m][0], v1 = acc[ai][bj][m][1];
                    u32x4 w; w.x = cvt_pk_bf16(v0[0], v0[1]); w.y = cvt_pk_bf16(v0[2], v0[3]); w.z = cvt_pk_bf16(v1[0], v1[1]); w.w = cvt_pk_bf16(v1[2], v1[3]);
                    *(u32x4*)(rowp + bj * HALF) = w; } }
    }
};
template <int RMODE> struct EpiRowMap {
    static constexpr bool PERM = true;
    bf16_t* O; const float* rsum;
    __device__ __forceinline__ void operator()(const f32x4 (&acc)[2][2][4][2], const Unit& u, int wr, int wc, int fr, int fq) const {
        const int col0 = u.pn * BM + wc * 32 + 8 * fq;
#pragma unroll
        for (int ai = 0; ai < 2; ++ai)
#pragma unroll
            for (int m = 0; m < 4; ++m) { const int r = ai * HALF + wr * 64 + m * 16 + fr; long drow; long ldc;
                if (RMODE == 1) { const int ts = 256 * u.x1 + r; drow = (long)(ts >> 6) * 1024 + u.x0 * 64 + (ts & 63); ldc = QLD; }
                float rs = 1.0f;
                if (RMODE == 1) { }
                else { const int qr = 256 * u.pm + r; drow = (long)(qr >> 6) * 2048 + u.x0 * 64 + (qr & 63); ldc = 512; rs = 1.0f / rsum[u.x0 * 1024 + qr]; }
                bf16_t* rowp = O + drow * ldc + col0;
#pragma unroll
                for (int bj = 0; bj < 2; ++bj) { const f32x4 v0 = acc[ai][bj][m][0] * rs, v1 = acc[ai][bj][m][1] * rs;
                    u32x4 w; w.x = cvt_pk_bf16(v0[0], v0[1]); w.y = cvt_pk_bf16(v0[2], v0[3]); w.z = cvt_pk_bf16(v1[0], v1[1]); w.w = cvt_pk_bf16(v1[2], v1[3]);
                    *(u32x4*)(rowp + bj * HALF) = w; } }
    }
};
struct EpiOV {
    static constexpr bool PERM = true;
    bf16_t* O;
    __device__ __forceinline__ void operator()(const f32x4 (&acc)[2][2][4][2], const Unit& u, int wr, int wc, int fr, int fq) const {
#pragma unroll
        for (int ai = 0; ai < 2; ++ai)
#pragma unroll
            for (int m = 0; m < 4; ++m) { const int r = ai * HALF + wr * 64 + m * 16 + fr;
                bf16_t* rowp = O + (long)(TP + 256 * u.x1 + r) * DM + u.x0 * 128 + wc * 32 + 8 * fq;
                const f32x4 v0 = acc[ai][1][m][0], v1 = acc[ai][1][m][1];
                u32x4 w; w.x = cvt_pk_bf16(v0[0], v0[1]); w.y = cvt_pk_bf16(v0[2], v0[3]); w.z = cvt_pk_bf16(v1[0], v1[1]); w.w = cvt_pk_bf16(v1[2], v1[3]);
                *(u32x4*)rowp = w; }
    }
};
struct EpiMix {
    static constexpr bool PERM = true;
    const bf16_t* Y; const bf16_t* YA; bf16_t* MIX; const float* sa; const float* sb;
    __device__ __forceinline__ void operator()(const f32x4 (&acc)[2][2][4][2], const Unit& u, int wr, int wc, int fr, int fq) const {
#pragma unroll
        for (int ai = 0; ai < 2; ++ai)
#pragma unroll
            for (int m = 0; m < 4; ++m) { const long t = (long)u.pm * BM + ai * HALF + wr * 64 + m * 16 + fr; const float s_ = sa[t];
#pragma unroll
                for (int bj = 0; bj < 2; ++bj) { const int c = u.pn * BM + bj * HALF + wc * 32 + 8 * fq;
                    const u32x4 ga = *(const u32x4*)(Y + t * INWP + C_GA + c), gb = *(const u32x4*)(Y + t * INWP + C_GB + c), ya = *(const u32x4*)(YA + t * DM + c);
                    float fa[8], fb[8], fy[8], o[8]; unpack8(ga, fa); unpack8(gb, fb); unpack8(ya, fy);
                    const f32x4 v0 = acc[ai][bj][m][0] * *(const f32x4*)(sb + c) * s_, v1 = acc[ai][bj][m][1] * *(const f32x4*)(sb + c + 4) * s_;
                    const float av[8] = {v0[0], v0[1], v0[2], v0[3], v1[0], v1[1], v1[2], v1[3]};
#pragma unroll
                    for (int j = 0; j < 8; ++j) {
#if defined(DBG_MIX) && DBG_MIX == 1
                        o[j] = sigmoidf_(fb[j]) * av[j];
#elif defined(DBG_MIX) && DBG_MIX == 2
                        o[j] = sigmoidf_(fa[j]) * fy[j];
#else
                        o[j] = sigmoidf_(fa[j]) * fy[j] + sigmoidf_(fb[j]) * av[j];
#endif
                    }
                    *(u32x4*)(MIX + t * DM + c) = pack8(o); } }
    }
};
struct EpiRes {
    static constexpr bool PERM = false;
    float* X; const float* gate;
    const float* XinP; const float* XinS;
    __device__ __forceinline__ void operator()(const f32x4 (&acc)[2][2][4][2], const Unit& u, int wr, int wc, int fr, int fq) const {
#pragma unroll
        for (int ai = 0; ai < 2; ++ai)
#pragma unroll
            for (int m = 0; m < 4; ++m) { const int t = u.pm * BM + ai * HALF + wr * 64 + m * 16 + fr; const float* gr = gate + (long)cond_row(t) * 12288; float* xr = X + (long)t * DM; const float* xi = t < TP ? XinP + (long)t * DM : XinS + (long)(t - TP) * DM;
#pragma unroll
                for (int bj = 0; bj < 2; ++bj)
#pragma unroll
                    for (int n = 0; n < 2; ++n) { const int c = u.pn * BM + bj * HALF + wc * 32 + n * 16 + 4 * fq;
                        const f32x4 gv = *(const f32x4*)(gr + c); const f32x4 xv = *(const f32x4*)(xi + c);
                        *(f32x4*)(xr + c) = xv + gv * acc[ai][bj][m][n]; } }
    }
};

struct EpiQ {
    static constexpr bool PERM = true;
    bf16_t* Q; bf16_t* QL; const float* T64;
    __device__ __forceinline__ void operator()(const f32x4 (&acc)[2][2][4][2], const Unit& u, int wr, int wc, int fr, int fq) const {
        const int grp = u.pn / 3, typ = u.pn - 3 * grp;
        if (typ < 2) {
#pragma unroll
            for (int ai = 0; ai < 2; ++ai)
#pragma unroll
                for (int m = 0; m < 4; ++m) { const long t = (long)u.pm * BM + ai * HALF + wr * 64 + m * 16 + fr;
#pragma unroll
                    for (int bj = 0; bj < 2; ++bj) { const f32x4 v0 = acc[ai][bj][m][0], v1 = acc[ai][bj][m][1];
                        u32x4 w; w.x = cvt_pk_bf16(v0[0], v0[1]); w.y = cvt_pk_bf16(v0[2], v0[3]); w.z = cvt_pk_bf16(v1[0], v1[1]); w.w = cvt_pk_bf16(v1[2], v1[3]);
                        *(u32x4*)(Q + t * 3072 + 768 * grp + 192 * (2 * typ + bj) + wc * 32 + 8 * fq) = w; } }
        } else {
#pragma unroll
            for (int ai = 0; ai < 2; ++ai)
#pragma unroll
                for (int m = 0; m < 4; ++m) { const int t = u.pm * BM + ai * HALF + wr * 64 + m * 16 + fr; const int pos = tok_pos(t);
                    const float* cs = T64 + ((long)pos * 32 + 8 * fq) * 2; float cv[8], sv[8];
#pragma unroll
                    for (int j = 0; j < 4; ++j) { const f32x4 qv = *(const f32x4*)(cs + 4 * j); cv[2 * j] = qv[0]; sv[2 * j] = qv[1]; cv[2 * j + 1] = qv[2]; sv[2 * j + 1] = qv[3]; }
                    const f32x4 a0 = acc[ai][0][m][0], a1 = acc[ai][0][m][1], b0 = acc[ai][1][m][0], b1 = acc[ai][1][m][1];
                    const float x1[8] = {a0[0], a0[1], a0[2], a0[3], a1[0], a1[1], a1[2], a1[3]}, x2[8] = {b0[0], b0[1], b0[2], b0[3], b1[0], b1[1], b1[2], b1[3]};
                    float o1[8], o2[8];
#pragma unroll
                    for (int j = 0; j < 8; ++j) { o1[j] = x1[j] * cv[j] - x2[j] * sv[j]; o2[j] = x1[j] * sv[j] + x2[j] * cv[j]; }
                    const u32x4 w1 = pack8(o1), w2 = pack8(o2); const int hd = 4 * grp + wc;
                    bf16_t* qd = Q + (long)t * 3072 + hd * 192 + 128 + 8 * fq; *(u32x4*)qd = w1; *(u32x4*)(qd + 32) = w2;
                    if (t >= TP) { const int ts = t - TP; bf16_t* d = QL + ((long)(ts >> 6) * 1024 + hd * 64 + (ts & 63)) * QLD + 512 + 8 * fq; *(u32x4*)d = w1; *(u32x4*)(d + 32) = w2; } }
        }
    }
};

struct EpiExp {
    static constexpr bool PERM = true;
    bf16_t* O; float* rsum;
    __device__ __forceinline__ void operator()(const f32x4 (&acc)[2][2][4][2], const Unit& u, int wr, int wc, int fr, int fq) const {
        bf16_t* base = O + (long)u.x0 * 1024 * KPAD + (long)(u.pm * BM + wr * 64 + fr) * KPAD + u.pn * BM + wc * 32 + 8 * fq;
#pragma unroll
        for (int ai = 0; ai < 2; ++ai)
#pragma unroll
            for (int m = 0; m < 4; ++m) { bf16_t* rowp = base + (long)(ai * HALF + m * 16) * KPAD; float part = 0.f;
#pragma unroll
                for (int bj = 0; bj < 2; ++bj) { const int c0 = u.pn * BM + bj * HALF + wc * 32 + 8 * fq; const f32x4 v0 = acc[ai][bj][m][0], v1 = acc[ai][bj][m][1];
                    const float sv[8] = {v0[0], v0[1], v0[2], v0[3], v1[0], v1[1], v1[2], v1[3]}; float e[8];
#pragma unroll
                    for (int j = 0; j < 8; ++j) { e[j] = (c0 + j < KALL) ? __expf(fminf(sv[j] * MLA_SCALE, 60.f)) : 0.f; part += e[j]; }
                    *(u32x4*)(rowp + bj * HALF) = pack8(e); }
                part += sx<16>(part); part += sx<32>(part);
                if (fq == 0) atomicAdd(rsum + u.x0 * 1024 + u.pm * BM + ai * HALF + wr * 64 + m * 16 + fr, part); }
    }
};

struct EpiQ8 {
    static constexpr bool PERM = true;
    bf16_t* O; long ldc; const float* sa; const float* sb;
    __device__ __forceinline__ void operator()(const f32x4 (&acc)[2][2][4][2], const Unit& u, int wr, int wc, int fr, int fq) const {
        f32x4 sbv[2][2];
#pragma unroll
        for (int bj = 0; bj < 2; ++bj) { const int c = u.pn * BM + bj * HALF + wc * 32 + 8 * fq; sbv[bj][0] = *(const f32x4*)(sb + c); sbv[bj][1] = *(const f32x4*)(sb + c + 4); }
#pragma unroll
        for (int ai = 0; ai < 2; ++ai)
#pragma unroll
            for (int m = 0; m < 4; ++m) { const long t = (long)u.pm * BM + ai * HALF + wr * 64 + m * 16 + fr; const float s = sa[t];
#pragma unroll
                for (int bj = 0; bj < 2; ++bj) { const f32x4 v0 = acc[ai][bj][m][0] * sbv[bj][0] * s, v1 = acc[ai][bj][m][1] * sbv[bj][1] * s;
                    u32x4 w; w.x = cvt_pk_bf16(v0[0], v0[1]); w.y = cvt_pk_bf16(v0[2], v0[3]); w.z = cvt_pk_bf16(v1[0], v1[1]); w.w = cvt_pk_bf16(v1[2], v1[3]);
                    *(u32x4*)(O + t * ldc + u.pn * BM + bj * HALF + wc * 32 + 8 * fq) = w; } }
    }
};
}
namespace att {
constexpr int NW = 8, QBLK = 32, KVBLK = 64;
constexpr float SCALE = MLA_SCALE;
constexpr float THR = 8.f;
constexpr int KROW = 384;
constexpr int SHM_V = KVBLK * 128 * 2, SHM_K = KVBLK * KROW;
constexpr int QR_PITCH = 144, SHM_QR = 256 * QR_PITCH;
constexpr int SHM_ATTN = 2 * SHM_V + 2 * SHM_K + NW * 64 * 4 + SHM_QR;
#define KSWZ(row, colB) ((row) * att::KROW + ((colB) ^ (((row) & 7) << 4)))
#define SBAR() __builtin_amdgcn_sched_barrier(0)
__device__ __forceinline__ int crow(int r, int hi) { return (r & 3) + 8 * (r >> 2) + 4 * hi; }

__device__ __forceinline__ void partialSM(f32x16& p0, f32x16& p1, float& m_reg, float& mn, float& alpha) {
  constexpr float C = SCALE * 1.4426950408889634f;
  float pmax = p0[0];
#pragma unroll
  for (int r = 1; r < 16; ++r) pmax = fmaxf(pmax, p0[r]);
#pragma unroll
  for (int r = 0; r < 16; ++r) pmax = fmaxf(pmax, p1[r]);
  { auto rr = __builtin_amdgcn_permlane32_swap(__float_as_uint(pmax), __float_as_uint(pmax), false, false);
    pmax = fmaxf(__uint_as_float(rr[0]), __uint_as_float(rr[1])); }
  if (__builtin_expect(__all(pmax - m_reg <= THR / SCALE), 1)) { mn = m_reg; alpha = 1.f; }
  else { mn = fmaxf(m_reg, pmax); alpha = __builtin_amdgcn_exp2f((m_reg - mn) * C); m_reg = mn; }
  float mnC = -mn * C;
#pragma unroll
  for (int r = 0; r < 16; ++r) p0[r] = fmaf(p0[r], C, mnC);
#pragma unroll
  for (int r = 0; r < 16; ++r) p1[r] = fmaf(p1[r], C, mnC);
#pragma unroll
  for (int r = 0; r < 16; ++r) p0[r] = __builtin_amdgcn_exp2f(p0[r]);
}
__device__ __forceinline__ void finishSM(f32x16& p0, f32x16& p1, float alpha, float& l_reg, bf16x8& pa0, bf16x8& pa1, bf16x8& pa2, bf16x8& pa3) {
#pragma unroll
  for (int r = 0; r < 16; ++r) p1[r] = __builtin_amdgcn_exp2f(p1[r]);
  float ps = 0;
#pragma unroll
  for (int r = 0; r < 16; ++r) ps += p0[r];
#pragma unroll
  for (int r = 0; r < 16; ++r) ps += p1[r];
  { auto rr = __builtin_amdgcn_permlane32_swap(__float_as_uint(ps), __float_as_uint(ps), false, false);
    ps = __uint_as_float(rr[0]) + __uint_as_float(rr[1]); }
  l_reg = l_reg * alpha + ps;
#define PK4(P, BASE, OUT) do { unsigned a0 = cvt_pk_bf16(P[BASE + 0], P[BASE + 1]), a1 = cvt_pk_bf16(P[BASE + 2], P[BASE + 3]);   \
    unsigned b0 = cvt_pk_bf16(P[BASE + 4], P[BASE + 5]), b1 = cvt_pk_bf16(P[BASE + 6], P[BASE + 7]);                              \
    auto r0 = __builtin_amdgcn_permlane32_swap(a0, b0, false, false); auto r1 = __builtin_amdgcn_permlane32_swap(a1, b1, false, false); \
    u32x4 w = {r0[0], r1[0], r0[1], r1[1]}; OUT = *reinterpret_cast<bf16x8*>(&w); } while (0)
  PK4(p0, 0, pa0); PK4(p0, 8, pa1); PK4(p1, 0, pa2); PK4(p1, 8, pa3);
#undef PK4
}
__device__ __forceinline__ void qkt(f32x16& p0, f32x16& p1, const char* Ks, const bf16x8* qr, const char* qrope, const int (&kbase)[4], bool vis) {
  p0 = f32x16{}; p1 = f32x16{};
  if (vis) {
#pragma unroll
  for (int d0 = 0; d0 < 12; ++d0) {
    bf16x8 b0 = *reinterpret_cast<const bf16x8*>(Ks + kbase[d0 & 3] + (d0 >> 2) * 128);
    bf16x8 b1 = *reinterpret_cast<const bf16x8*>(Ks + kbase[d0 & 3] + (d0 >> 2) * 128 + 32 * KROW);
    const bf16x8 qv = d0 < 8 ? qr[d0 < 8 ? d0 : 0] : *reinterpret_cast<const bf16x8*>(qrope + (d0 - 8) * 32);
    p0 = __builtin_amdgcn_mfma_f32_32x32x16_bf16(b0, qv, p0, 0, 0, 0);
    p1 = __builtin_amdgcn_mfma_f32_32x32x16_bf16(b1, qv, p1, 0, 0, 0); }
  }
  if (!vis) {
#pragma unroll
    for (int r = 0; r < 16; ++r) { p0[r] = -1e30f; p1[r] = -1e30f; } }
}
__device__ __forceinline__ int v_st(int k, int c) { const int kk = (k & ~0xC) | ((k & 4) << 1) | ((k & 8) >> 1); return ((kk >> 3) * 4 + (c >> 5)) * 512 + ((kk & 7) * 32 + (c & 31)) * 2; }
__device__ __forceinline__ int v_rd_base(int lane) { return ((lane & 3) << 3) | (((lane >> 2) & 3) << 6) | (((lane >> 4) & 1) << 5) | (((lane >> 5) & 1) << 8); }
constexpr int v_rd_off(int d0, int ks, int half) { return d0 * 512 + ks * 4096 + half * 2048; }
template <int OFF> __device__ __forceinline__ s16x4 tr_read(int vb) {
  s16x4 r; asm volatile("ds_read_b64_tr_b16 %0, %1 offset:%2" : "=&v"(r) : "v"(vb), "i"(OFF) : "memory"); return r;
}
template <int D0> __device__ __forceinline__ void pv_one(f32x16& od, int vb, bf16x8 pa0, bf16x8 pa1, bf16x8 pa2, bf16x8 pa3) {
  const s16x4 l0 = tr_read<v_rd_off(D0, 0, 0)>(vb), h0 = tr_read<v_rd_off(D0, 0, 1)>(vb), l1 = tr_read<v_rd_off(D0, 1, 0)>(vb), h1 = tr_read<v_rd_off(D0, 1, 1)>(vb);
  const s16x4 l2 = tr_read<v_rd_off(D0, 2, 0)>(vb), h2 = tr_read<v_rd_off(D0, 2, 1)>(vb), l3 = tr_read<v_rd_off(D0, 3, 0)>(vb), h3 = tr_read<v_rd_off(D0, 3, 1)>(vb);
  asm volatile("s_waitcnt lgkmcnt(0)" ::: "memory"); SBAR();
#define PK(L, H) (bf16x8){L[0], L[1], L[2], L[3], H[0], H[1], H[2], H[3]}
  od = __builtin_amdgcn_mfma_f32_32x32x16_bf16(pa0, PK(l0, h0), od, 0, 0, 0);
  od = __builtin_amdgcn_mfma_f32_32x32x16_bf16(pa1, PK(l1, h1), od, 0, 0, 0);
  od = __builtin_amdgcn_mfma_f32_32x32x16_bf16(pa2, PK(l2, h2), od, 0, 0, 0);
  od = __builtin_amdgcn_mfma_f32_32x32x16_bf16(pa3, PK(l3, h3), od, 0, 0, 0);
#undef PK
}
__device__ __forceinline__ void pv_d0(f32x16* o, int vb, bf16x8 pa0, bf16x8 pa1, bf16x8 pa2, bf16x8 pa3) {
  pv_one<0>(o[0], vb, pa0, pa1, pa2, pa3); pv_one<1>(o[1], vb, pa0, pa1, pa2, pa3); pv_one<2>(o[2], vb, pa0, pa1, pa2, pa3); pv_one<3>(o[3], vb, pa0, pa1, pa2, pa3);
}

__device__ __forceinline__ void attn_block(const bf16_t* __restrict__ Qb, const bf16_t* __restrict__ Kn, const bf16_t* __restrict__ Kr, const bf16_t* __restrict__ Vh,
                                           bf16_t* __restrict__ Ob, int qb, char* lds) {
  constexpr int LDQ = 3072, LDK = 4096, LDR = 64, LDO = 2048;
  const int tid = otid(), wid = tid >> 6, lane = tid & 63, r32 = lane & 31, hi = lane >> 5;
  char* V_lds = lds; char* K_lds = lds + 2 * SHM_V;
  float* ws = (float*)(lds + 2 * SHM_V + 2 * SHM_K) + wid * 64; float* li_l = ws; float* al_l = ws + 32;
  float m_reg = -1e30f, l_reg = 0; f32x16 o[4] = {}; bf16x8 qr[8];
  const bf16_t* Qw = Qb + (long)(wid * QBLK + r32) * LDQ + hi * 8;
#pragma unroll
  for (int d0 = 0; d0 < 8; ++d0) qr[d0] = *reinterpret_cast<const bf16x8*>(Qw + d0 * 16);
  char* qrope = lds + 2 * SHM_V + 2 * SHM_K + NW * 64 * 4 + (wid * QBLK + r32) * QR_PITCH + hi * 16;
#pragma unroll
  for (int d0 = 8; d0 < 12; ++d0) *reinterpret_cast<bf16x8*>(qrope + (d0 - 8) * 32) = *reinterpret_cast<const bf16x8*>(Qw + d0 * 16);
  asm volatile("s_waitcnt lgkmcnt(0)" ::: "memory");
  const int NT = 4 * qb + 4, jmax = 4 * qb + (wid >> 1);
  int kbase[4];
#pragma unroll
  for (int dl = 0; dl < 4; ++dl) kbase[dl] = r32 * KROW + (((dl << 5) | (hi << 4)) ^ ((r32 & 7) << 4));
  const int sr = tid >> 4, sc = (tid & 15) * 8, vst0 = v_st(sr, sc), vst1 = v_st(32 + sr, sc);
  const int rr = tid >> 3, rc = (tid & 7) * 8;
  const int vb0 = (int)(uintptr_t)V_lds + v_rd_base(lane);
  bf16x8 vs0, vs1, ks0, ks1, kr0;
#define SLOAD(k0) do { vs0 = *reinterpret_cast<const bf16x8*>(&Vh[(long)((k0) + sr) * LDK + sc]); vs1 = *reinterpret_cast<const bf16x8*>(&Vh[(long)((k0) + 32 + sr) * LDK + sc]); \
    ks0 = *reinterpret_cast<const bf16x8*>(&Kn[(long)((k0) + sr) * LDK + sc]); ks1 = *reinterpret_cast<const bf16x8*>(&Kn[(long)((k0) + 32 + sr) * LDK + sc]); \
    kr0 = *reinterpret_cast<const bf16x8*>(&Kr[(long)((k0) + rr) * LDR + rc]); } while (0)
#define SWRITE(b) do { *(bf16x8*)(V_lds + (b) * SHM_V + vst0) = vs0; *(bf16x8*)(V_lds + (b) * SHM_V + vst1) = vs1; int kc = sc * 2; \
    *(bf16x8*)(K_lds + (b) * SHM_K + KSWZ(sr, kc)) = ks0; *(bf16x8*)(K_lds + (b) * SHM_K + KSWZ(32 + sr, kc)) = ks1; \
    *(bf16x8*)(K_lds + (b) * SHM_K + KSWZ(rr, 256 + rc * 2)) = kr0; } while (0)
#define SWAIT() asm volatile("s_waitcnt vmcnt(0)" ::: "memory")
#define RESC(a) do { if (__any((a) < 1.f)) { if (hi == 0) al_l[r32] = (a); asm volatile("s_waitcnt lgkmcnt(0)" ::: "memory"); \
    _Pragma("unroll") for (int d = 0; d < 4; ++d) _Pragma("unroll") for (int r = 0; r < 16; ++r) o[d][r] *= al_l[crow(r, hi)]; } } while (0)
  f32x16 pA0, pA1, pB0, pB1; float mnA, mnB, alA, alB; bf16x8 pa0, pa1, pa2, pa3;
  SLOAD(0); SWAIT(); SWRITE(0); __syncthreads();
  qkt(pA0, pA1, K_lds, qr, qrope, kbase, true); partialSM(pA0, pA1, m_reg, mnA, alA);
  SLOAD(KVBLK);
  SWAIT(); SWRITE(1); __syncthreads();
  for (int j = 1; j + 1 < NT; j += 2) {
    SBAR(); qkt(pB0, pB1, K_lds + SHM_K, qr, qrope, kbase, j <= jmax);
    finishSM(pA0, pA1, alA, l_reg, pa0, pa1, pa2, pa3); SBAR();
    SLOAD((j + 1) * KVBLK); SBAR();
    if (j - 1 <= jmax) pv_d0(o, vb0, pa0, pa1, pa2, pa3);
    partialSM(pB0, pB1, m_reg, mnB, alB);
    __syncthreads(); SWAIT(); SWRITE(0);
    RESC(alB); __syncthreads();
    SBAR(); qkt(pA0, pA1, K_lds, qr, qrope, kbase, j + 1 <= jmax);
    finishSM(pB0, pB1, alB, l_reg, pa0, pa1, pa2, pa3); SBAR();
    SLOAD((j + 2) * KVBLK); SBAR();
    if (j <= jmax) pv_d0(o, vb0 + (int)SHM_V, pa0, pa1, pa2, pa3);
    partialSM(pA0, pA1, m_reg, mnA, alA);
    __syncthreads(); SWAIT(); SWRITE(1);
    RESC(alA); __syncthreads();
  }
  SBAR(); qkt(pB0, pB1, K_lds + SHM_K, qr, qrope, kbase, NT - 1 <= jmax);
  finishSM(pA0, pA1, alA, l_reg, pa0, pa1, pa2, pa3); SBAR();
  if (NT - 2 <= jmax) pv_d0(o, vb0, pa0, pa1, pa2, pa3);
  partialSM(pB0, pB1, m_reg, mnB, alB);
  __syncthreads(); RESC(alB);
  finishSM(pB0, pB1, alB, l_reg, pa0, pa1, pa2, pa3); SBAR();
  if (NT - 1 <= jmax) pv_d0(o, vb0 + (int)SHM_V, pa0, pa1, pa2, pa3);
  if (hi == 0) li_l[r32] = l_reg; asm volatile("s_waitcnt lgkmcnt(0)" ::: "memory");
  float rli[16];
#pragma unroll
  for (int r = 0; r < 16; ++r) rli[r] = __builtin_amdgcn_rcpf(li_l[crow(r, hi)]);
  bf16_t* Ow = Ob + (long)(wid * QBLK) * LDO;
#pragma unroll
  for (int r = 0; r < 16; ++r) { int orow = crow(r, hi);
#pragma unroll
    for (int d0 = 0; d0 < 4; ++d0) Ow[(long)orow * LDO + d0 * 32 + r32] = f2bf(o[d0][r] * rli[r]); }
  __syncthreads();
#undef SLOAD
#undef SWRITE
#undef SWAIT
#undef RESC
}
}
namespace ret {
constexpr int QP_ = 136;
__device__ __forceinline__ bf16x8 ldfrag(const bf16_t* p) { return *reinterpret_cast<const bf16x8*>(p); }
template <int CL> struct Lay {
    static constexpr int IP = CL + 8;
    static constexpr int QS = 0, KS = QS + CL * QP_ * 2, VT = KS + CL * QP_ * 2, VDT = VT + 32 * IP * 2, IN = VDT + 32 * IP * 2, ST = IN + CL * IP * 2, VS = ST + 32 * QP_ * 2, END = VS + CL * 40 * 2;
};
static_assert(Lay<128>::END <= LDS_BARW, "retention LDS");

template <int CL>
__device__ __forceinline__ void run(const bf16_t* __restrict__ Y, bf16_t* __restrict__ OB, const float* __restrict__ sp, float* __restrict__ so, long tok0, int nch, int h, int es, float lg, char* lds, int tid) {
    using L = Lay<CL>; constexpr int IP = L::IP, NQT = CL / 16, NKS = CL / 32, NPC = CL / 32;
    const int wid = __builtin_amdgcn_readfirstlane(tid >> 6), lane = tid & 63, l15 = lane & 15, l4 = lane >> 4;
    bf16_t* Qs = (bf16_t*)(lds + L::QS); bf16_t* Ks = (bf16_t*)(lds + L::KS); bf16_t* Vt = (bf16_t*)(lds + L::VT); bf16_t* Vdt = (bf16_t*)(lds + L::VDT); bf16_t* In = (bf16_t*)(lds + L::IN); bf16_t* St = (bf16_t*)(lds + L::ST); bf16_t* Vs = (bf16_t*)(lds + L::VS);
    const float gCL = __expf((float)CL * lg);
    f32x4 Sacc[2];
    if (sp) {
#pragma unroll
        for (int ej = 0; ej < 2; ++ej)
#pragma unroll
            for (int r = 0; r < 4; ++r) Sacc[ej][r] = sp[(long)(16 * wid + 4 * l4 + r) * RV + 16 * ej + l15];
    } else { Sacc[0] = (f32x4){0.f, 0.f, 0.f, 0.f}; Sacc[1] = (f32x4){0.f, 0.f, 0.f, 0.f}; }
    for (int i = tid; i < CL * IP / 8; i += 512) reinterpret_cast<u32x4*>(In)[i] = (u32x4){0u, 0u, 0u, 0u};
    u32x4 pq[NPC], pk[NPC], pv;
    const int vk = tid >> 2, ve0 = (tid & 3) * 8;
#define RET_LOAD(cc) do { const bf16_t* yrow_ = Y + (tok0 + (long)(cc) * CL) * INWP; \
        _Pragma("unroll") for (int i = 0; i < NPC; ++i) { const int idx = tid + i * 512, k = idx >> 4, d0 = (idx & 15) * 8; \
            pq[i] = *reinterpret_cast<const u32x4*>(yrow_ + (long)k * INWP + C_RQ + h * 128 + d0); pk[i] = *reinterpret_cast<const u32x4*>(yrow_ + (long)k * INWP + C_RK + h * 128 + d0); } \
        if (tid < 4 * CL) pv = *reinterpret_cast<const u32x4*>(yrow_ + (long)vk * INWP + C_RV + h * 256 + es * 32 + ve0); } while (0)
    RET_LOAD(0);
    for (int c = 0; c < nch; ++c) {
#pragma unroll
        for (int ej = 0; ej < 2; ++ej) { u32x2 w; w.x = cvt_pk_bf16(Sacc[ej][0], Sacc[ej][1]); w.y = cvt_pk_bf16(Sacc[ej][2], Sacc[ej][3]);
            *reinterpret_cast<u32x2*>(St + (16 * ej + l15) * QP_ + 16 * wid + 4 * l4) = w; }
#pragma unroll
        for (int i = 0; i < NPC; ++i) { const int idx = tid + i * 512, k = idx >> 4, d0 = (idx & 15) * 8;
            *reinterpret_cast<u32x4*>(Qs + k * QP_ + d0) = pq[i]; *reinterpret_cast<u32x4*>(Ks + k * QP_ + d0) = pk[i]; }
        if (tid < 4 * CL) *reinterpret_cast<u32x4*>(Vs + vk * 40 + ve0) = pv;
        if (c + 1 < nch) RET_LOAD(c + 1);
        __syncthreads();
        if (tid < 4 * CL) { const int e = tid & 31, kg = tid >> 5; float f[8], fd[8];
#pragma unroll
            for (int j = 0; j < 8; ++j) { f[j] = bf2f(Vs[(8 * kg + j) * 40 + e]); fd[j] = f[j] * __expf((float)(CL - 1 - 8 * kg - j) * lg); }
            *reinterpret_cast<u32x4*>(Vt + e * IP + 8 * kg) = pack8(f); *reinterpret_cast<u32x4*>(Vdt + e * IP + 8 * kg) = pack8(fd); }
#pragma unroll
        for (int it_ = 0; it_ < (NQT * (NQT + 1) / 2 + 7) / 8; ++it_) { const int idx = wid + 8 * it_; if (idx >= NQT * (NQT + 1) / 2) break;
            int qi = 0; while ((qi + 1) * (qi + 2) / 2 <= idx) ++qi; const int kj = idx - qi * (qi + 1) / 2;
            f32x4 a = (f32x4){0.f, 0.f, 0.f, 0.f}; const bf16_t* qp = Qs + (16 * qi + l15) * QP_ + 8 * l4; const bf16_t* kp = Ks + (16 * kj + l15) * QP_ + 8 * l4;
#pragma unroll
            for (int ks = 0; ks < 4; ++ks) a = __builtin_amdgcn_mfma_f32_16x16x32_bf16(ldfrag(qp + 32 * ks), ldfrag(kp + 32 * ks), a, 0, 0, 0);
            const int q0 = 16 * qi + 4 * l4, k = 16 * kj + l15;
#pragma unroll
            for (int r = 0; r < 4; ++r) { const int q = q0 + r; const float dm = (q >= k) ? __expf((float)(q - k) * lg) : 0.f;
                In[q * IP + k] = f2bf(a[r] * dm); } }
        __syncthreads();
#pragma unroll
        for (int ot = 0; ot < (2 * NQT) / 8; ++ot) { const int tI = wid + 8 * ot, qi = tI >> 1, ej = tI & 1; f32x4 a = (f32x4){0.f, 0.f, 0.f, 0.f};
#pragma unroll
            for (int ks = 0; ks < 4; ++ks) a = __builtin_amdgcn_mfma_f32_16x16x32_bf16(ldfrag(Qs + (16 * qi + l15) * QP_ + 32 * ks + 8 * l4), ldfrag(St + (16 * ej + l15) * QP_ + 32 * ks + 8 * l4), a, 0, 0, 0);
#pragma unroll
            for (int r = 0; r < 4; ++r) a[r] *= __expf((float)(16 * qi + 4 * l4 + r + 1) * lg);
#pragma unroll
            for (int ks = 0; ks < NKS; ++ks) if (ks <= (qi >> 1)) a = __builtin_amdgcn_mfma_f32_16x16x32_bf16(ldfrag(In + (16 * qi + l15) * IP + 32 * ks + 8 * l4), ldfrag(Vt + (16 * ej + l15) * IP + 32 * ks + 8 * l4), a, 0, 0, 0);
            bf16_t* op = OB + ((long)(h * 8 + es) * T + tok0 + (long)c * CL + 16 * qi + 4 * l4) * 32 + 16 * ej + l15;
#pragma unroll
            for (int r = 0; r < 4; ++r) op[r * 32] = f2bf(a[r]); }
        { f32x4 s0 = Sacc[0] * gCL, s1 = Sacc[1] * gCL;
#pragma unroll
          for (int ks = 0; ks < NKS; ++ks) { bf16x8 af;
#pragma unroll
              for (int j = 0; j < 8; ++j) af[j] = (short)Ks[(32 * ks + 8 * l4 + j) * QP_ + 16 * wid + l15];
              s0 = __builtin_amdgcn_mfma_f32_16x16x32_bf16(af, ldfrag(Vdt + l15 * IP + 32 * ks + 8 * l4), s0, 0, 0, 0);
              s1 = __builtin_amdgcn_mfma_f32_16x16x32_bf16(af, ldfrag(Vdt + (16 + l15) * IP + 32 * ks + 8 * l4), s1, 0, 0, 0); }
          Sacc[0] = s0; Sacc[1] = s1; }
        __syncthreads();
    }
#undef RET_LOAD
#pragma unroll
    for (int ej = 0; ej < 2; ++ej)
#pragma unroll
        for (int r = 0; r < 4; ++r) so[(long)(16 * wid + 4 * l4 + r) * RV + 16 * ej + l15] = Sacc[ej][r];
}

__device__ __forceinline__ void unit(KParams& p, int l, int u, char* lds) {
    const int tid = otid(); unsigned char* ws = optr(gp(p.ws)); const bf16_t* Y = (const bf16_t*)(ws + WS_Y); bf16_t* OB = (bf16_t*)(ws + WS_OB);
    const bool samp = u >= 256; const int v = samp ? u - 256 : u; const int b = v >> 6, h = (v >> 3) & 7, es = v & 7; const float lg = p.lg[h];
    if (samp) run<64>(Y, OB, gp(p.state_ret) + ((((long)l * DB + b) * RH + h) * RQK) * RV + es * 32, gp(p.out) + O_RETS + ((((long)l * DB + b) * RH + h) * RQK) * RV + es * 32, (long)TP + b * 64, 1, h, es, lg, lds, tid);
    else run<64>(Y, OB, nullptr, gp(p.out) + O_RETP + ((((long)l * NB + b) * RH + h) * RQK) * RV + es * 32, (long)b * SEQ, SEQ / 64, h, es, lg, lds, tid);
}
}
namespace peer {
__device__ __forceinline__ void ins16(float (&l)[16], float x) {
#pragma unroll
    for (int j = 0; j < 16; ++j) { const float hi = fmaxf(l[j], x); x = fminf(l[j], x); l[j] = hi; }
}
#define CE_DESC(a, b) do { const float hi_ = fmaxf(a, b), lo_ = fminf(a, b); a = hi_; b = lo_; } while (0)
#define CE_ASC(a, b) do { const float hi_ = fmaxf(a, b), lo_ = fminf(a, b); a = lo_; b = hi_; } while (0)
__device__ __forceinline__ void sort16_desc(float (&v)[16]) {
#pragma unroll
    for (int k = 2; k <= 16; k <<= 1)
#pragma unroll
        for (int j = k >> 1; j >= 1; j >>= 1)
#pragma unroll
            for (int i = 0; i < 16; ++i) { const int l = i ^ j; if (l > i) { if ((i & k) == 0) CE_DESC(v[i], v[l]); else CE_ASC(v[i], v[l]); } }
}
__device__ __forceinline__ void merge16_desc(float (&l)[16], const float (&o)[16]) {
#pragma unroll
    for (int i = 0; i < 16; ++i) l[i] = fmaxf(l[i], o[15 - i]);
#pragma unroll
    for (int j = 8; j >= 1; j >>= 1)
#pragma unroll
        for (int i = 0; i < 16; ++i) { const int m = i ^ j; if (m > i) CE_DESC(l[i], l[m]); }
}
constexpr int KPITCH = 136;
__device__ __forceinline__ void half_top16(const bf16_t* __restrict__ qrow, const bf16_t* __restrict__ keys, int lane, float (&l)[16]) {
    const int r32 = lane & 31, g = lane >> 5;
#pragma unroll
    for (int j = 0; j < 16; ++j) l[j] = -3.0e38f;
    bf16x8 qf[8];
#pragma unroll
    for (int ks = 0; ks < 8; ++ks) qf[ks] = *reinterpret_cast<const bf16x8*>(qrow + 16 * ks + 8 * g);
#pragma unroll 1
    for (int kb = 0; kb < 4; ++kb) { f32x16 a = f32x16{};
#pragma unroll
        for (int ks = 0; ks < 8; ++ks) { const bf16x8 kf = *reinterpret_cast<const bf16x8*>(keys + (32 * kb + r32) * KPITCH + 16 * ks + 8 * g);
            a = __builtin_amdgcn_mfma_f32_32x32x16_bf16(kf, qf[ks], a, 0, 0, 0); }
        float blk[16];
#pragma unroll
        for (int r = 0; r < 16; ++r) { const unsigned key = (unsigned)(32 * kb + (r & 3) + 8 * (r >> 2) + 4 * g);
            blk[r] = __uint_as_float((__float_as_uint(a[r]) & ~0x7Fu) | key); }
        sort16_desc(blk); merge16_desc(l, blk); }
}
__device__ __forceinline__ void merge_lists(float (&l)[16], const float (&o)[16]) { merge16_desc(l, o); }
__device__ __forceinline__ void select_unit(const bf16_t* __restrict__ QP, const bf16_t* __restrict__ k1, const bf16_t* __restrict__ k2, int* __restrict__ PIDX, float* __restrict__ PW,
                                            int t0, int h, int lane, float* lds_lane  ) {
    const int r32 = lane & 31, g = lane >> 5;
    const bf16_t* qrow = QP + (long)(t0 + r32) * DM + h * 256;
    float la[16], lb[16];
    half_top16(qrow, k1, lane, la);
    half_top16(qrow + 128, k2, lane, lb);
    float m0[16], m1[16];
#pragma unroll
    for (int j = 0; j < 16; ++j) { auto rr = __builtin_amdgcn_permlane32_swap(__float_as_uint(la[j]), __float_as_uint(lb[j]), false, false); m0[j] = __uint_as_float(rr[0]); m1[j] = __uint_as_float(rr[1]); }
    merge_lists(m0, m1);
    float L1[16], L2[16];
#pragma unroll
    for (int j = 0; j < 16; ++j) { auto rr = __builtin_amdgcn_permlane32_swap(__float_as_uint(m0[j]), __float_as_uint(m0[j]), false, false);
        L1[j] = __uint_as_float(rr[0]); L2[j] = __uint_as_float(rr[1]); }
#define CAND(i, j) __uint_as_float((__float_as_uint(L1[i] + L2[j]) & ~0xFFu) | (unsigned)((i) * 16 + (j)))
    float best[16], c2[16], c3[16];
#pragma unroll
    for (int j = 0; j < 16; ++j) best[j] = CAND(0, j);
    sort16_desc(best);
    c2[0] = CAND(1, 0); c2[1] = CAND(1, 1); c2[2] = CAND(1, 2); c2[3] = CAND(1, 3); c2[4] = CAND(1, 4); c2[5] = CAND(1, 5); c2[6] = CAND(1, 6); c2[7] = CAND(1, 7);
    c2[8] = CAND(2, 0); c2[9] = CAND(2, 1); c2[10] = CAND(2, 2); c2[11] = CAND(2, 3); c2[12] = CAND(2, 4); c2[13] = CAND(4, 0); c2[14] = CAND(4, 1); c2[15] = CAND(4, 2);
    sort16_desc(c2); merge16_desc(best, c2);
    c3[0] = CAND(3, 0); c3[1] = CAND(3, 1); c3[2] = CAND(3, 2); c3[3] = CAND(3, 3); c3[4] = CAND(5, 0); c3[5] = CAND(5, 1); c3[6] = CAND(6, 0); c3[7] = CAND(6, 1);
    c3[8] = CAND(7, 0); c3[9] = CAND(7, 1); c3[10] = CAND(8, 0); c3[11] = CAND(9, 0); c3[12] = CAND(10, 0); c3[13] = CAND(11, 0); c3[14] = CAND(12, 0); c3[15] = CAND(13, 0);
    sort16_desc(c3); merge16_desc(best, c3);
    ins16(best, CAND(14, 0)); ins16(best, CAND(15, 0));
#undef CAND
#pragma unroll
    for (int j = 0; j < 16; ++j) { lds_lane[j] = __uint_as_float(__float_as_uint(L1[j]) & 0x7Fu); lds_lane[16 + j] = __uint_as_float(__float_as_uint(L2[j]) & 0x7Fu); }
    asm volatile("s_waitcnt lgkmcnt(0)" ::: "memory");
    float wsum = 0.f, w[16]; int ei[16];
    const float mx = best[0];
#pragma unroll
    for (int k = 0; k < 16; ++k) { const unsigned code = __float_as_uint(best[k]) & 0xFFu; const int i = (int)(code >> 4), j = (int)(code & 15u);
        const int i1 = (int)__float_as_uint(lds_lane[i]), i2 = (int)__float_as_uint(lds_lane[16 + j]); ei[k] = i1 * NKEYS + i2;
        w[k] = __expf(best[k] - mx); wsum += w[k]; }
    const float inv = 1.0f / wsum;
    if (g == 0) { int* ip = PIDX + (long)(t0 + r32) * 128 + h * 16; float* wp = PW + (long)(t0 + r32) * 128 + h * 16;
#pragma unroll
        for (int k = 0; k < 16; k += 4) { *reinterpret_cast<int4*>(ip + k) = make_int4(ei[k], ei[k + 1], ei[k + 2], ei[k + 3]);
            *reinterpret_cast<float4*>(wp + k) = make_float4(w[k] * inv, w[k + 1] * inv, w[k + 2] * inv, w[k + 3] * inv); } }
}

__device__ __forceinline__ float gelu_exact(float x) { return 0.5f * x * (1.0f + erff(x * 0.70710678118654752f)); }

__device__ __forceinline__ void dec16(const u32x4 w, f32x2 (&f)[8]) {
    f[0] = __builtin_amdgcn_cvt_pk_f32_fp8((int)w.x, false); f[1] = __builtin_amdgcn_cvt_pk_f32_fp8((int)w.x, true);
    f[2] = __builtin_amdgcn_cvt_pk_f32_fp8((int)w.y, false); f[3] = __builtin_amdgcn_cvt_pk_f32_fp8((int)w.y, true);
    f[4] = __builtin_amdgcn_cvt_pk_f32_fp8((int)w.z, false); f[5] = __builtin_amdgcn_cvt_pk_f32_fp8((int)w.z, true);
    f[6] = __builtin_amdgcn_cvt_pk_f32_fp8((int)w.w, false); f[7] = __builtin_amdgcn_cvt_pk_f32_fp8((int)w.w, true);
}
__device__ __forceinline__ void dec16_i8(const u32x4 w, f32x2 (&f)[8]) {
    const unsigned ww[4] = {w.x, w.y, w.z, w.w};
#pragma unroll
    for (int i = 0; i < 4; ++i) { f[2 * i] = (f32x2){(float)(int)(signed char)(ww[i] & 0xffu), (float)(int)(signed char)((ww[i] >> 8) & 0xffu)}; f[2 * i + 1] = (f32x2){(float)(int)(signed char)((ww[i] >> 16) & 0xffu), (float)(int)(signed char)(ww[i] >> 24)}; }
}
__device__ __forceinline__ void gather_token(const unsigned char* __restrict__ H8, const float* __restrict__ SA8, const unsigned char* __restrict__ PU, const unsigned char* __restrict__ PV, const float* __restrict__ SU, const float* __restrict__ SV,
                                             const int* __restrict__ PIDX, const float* __restrict__ PW, float* __restrict__ X, const float* __restrict__ gate  , int t, int lane) {
    f32x2 xf[2][8];
#pragma unroll
    for (int hlf = 0; hlf < 2; ++hlf) dec16_i8(*reinterpret_cast<const u32x4*>(H8 + (long)t * DM + 1024 * hlf + 16 * lane), xf[hlf]);
    const float sat = SA8[t];
    f32x2 out[2][8];
#pragma unroll
    for (int hlf = 0; hlf < 2; ++hlf)
#pragma unroll
        for (int i = 0; i < 8; ++i) out[hlf][i] = (f32x2){0.f, 0.f};
    const int myidx0 = PIDX[(long)t * 128 + lane], myidx1 = PIDX[(long)t * 128 + 64 + lane];
    const float myw0 = PW[(long)t * 128 + lane], myw1 = PW[(long)t * 128 + 64 + lane];
    const float msu0 = SU[myidx0], msu1 = SU[myidx1], msv0 = SV[myidx0], msv1 = SV[myidx1];
    for (int hk = 0; hk < 128; hk += 4) {
        const int src = hk & 63; const bool lo = hk < 64;
        const int selidx = lo ? myidx0 : myidx1; const int selw = __float_as_int(lo ? myw0 : myw1), selsu = __float_as_int(lo ? msu0 : msu1), selsv = __float_as_int(lo ? msv0 : msv1);
        int e[4]; float g[4], su[4], sv[4];
#pragma unroll
        for (int k = 0; k < 4; ++k) { e[k] = __builtin_amdgcn_readlane(selidx, src + k); g[k] = __int_as_float(__builtin_amdgcn_readlane(selw, src + k));
            su[k] = __int_as_float(__builtin_amdgcn_readlane(selsu, src + k)); sv[k] = __int_as_float(__builtin_amdgcn_readlane(selsv, src + k)); }
        u32x4 uw[4][2], vw[4][2];
#pragma unroll
        for (int k = 0; k < 4; ++k) { uw[k][0] = *reinterpret_cast<const u32x4*>(PU + ((long)(lane >> 3) * NEXP + e[k]) * 128 + 16 * (lane & 7)); uw[k][1] = *reinterpret_cast<const u32x4*>(PU + ((long)(8 + (lane >> 3)) * NEXP + e[k]) * 128 + 16 * (lane & 7)); }
#pragma unroll
        for (int k = 0; k < 4; ++k) { { const u32x2 a0 = *reinterpret_cast<const u32x2*>(PV + ((long)(2 * lane) * NEXP + e[k]) * 8), a1 = *reinterpret_cast<const u32x2*>(PV + ((long)(2 * lane + 1) * NEXP + e[k]) * 8);
              const u32x2 b0 = *reinterpret_cast<const u32x2*>(PV + ((long)(128 + 2 * lane) * NEXP + e[k]) * 8), b1 = *reinterpret_cast<const u32x2*>(PV + ((long)(129 + 2 * lane) * NEXP + e[k]) * 8);
              vw[k][0] = (u32x4){a0.x, a0.y, a1.x, a1.y}; vw[k][1] = (u32x4){b0.x, b0.y, b1.x, b1.y}; } }
        float a[4];
#pragma unroll
        for (int k = 0; k < 4; ++k) { f32x2 d = (f32x2){0.f, 0.f};
#pragma unroll
            for (int hlf = 0; hlf < 2; ++hlf) { f32x2 f[8]; dec16_i8(uw[k][hlf], f);
#pragma unroll
                for (int i = 0; i < 8; ++i) d = __builtin_elementwise_fma(f[i], xf[hlf][i], d); }
            a[k] = wave_sum(d[0] + d[1]) * sat; }
#pragma unroll
        for (int k = 0; k < 4; ++k) { const float ak = g[k] * gelu_exact(a[k] * su[k]) * sv[k]; const f32x2 a2 = (f32x2){ak, ak};
#pragma unroll
            for (int hlf = 0; hlf < 2; ++hlf) { f32x2 f[8]; dec16(vw[k][hlf], f);
#pragma unroll
                for (int i = 0; i < 8; ++i) out[hlf][i] = __builtin_elementwise_fma(f[i], a2, out[hlf][i]); } }
    }
    const float* gr = gate + (long)cond_row(t) * 12288;
#pragma unroll
    for (int hlf = 0; hlf < 2; ++hlf)
#pragma unroll
        for (int q = 0; q < 4; ++q) { const int c = 1024 * hlf + 16 * lane + 4 * q; float* xp = X + (long)t * DM + c;
            const f32x4 gv = *reinterpret_cast<const f32x4*>(gr + c); f32x4 xv = *reinterpret_cast<const f32x4*>(xp);
            xv[0] += gv[0] * out[hlf][2 * q][0]; xv[1] += gv[1] * out[hlf][2 * q][1]; xv[2] += gv[2] * out[hlf][2 * q + 1][0]; xv[3] += gv[3] * out[hlf][2 * q + 1][1];
            *reinterpret_cast<f32x4*>(xp) = xv; }
}

constexpr int SW = 128, NSL = DM / SW;
struct XInfo { int rank, xi, nx, nloc; };
__device__ __forceinline__ void upass(const unsigned char* __restrict__ H8, const float* __restrict__ SA, const unsigned char* __restrict__ PU, const int* __restrict__ PIDX, const float* __restrict__ PW, const float* __restrict__ SU, const float* __restrict__ SV,
                                      int* __restrict__ DOTP, unsigned* __restrict__ PACKT, const XInfo xin, int wid, int lane) {
    const int g = lane >> 3, c = lane & 7; const int nwv = xin.nloc * 8;
    const int tlo = (int)((long)T * xin.xi / xin.nx), thi = (int)((long)T * (xin.xi + 1) / xin.nx); const int wv = tlo + xin.rank * 8 + wid;
    int* dp = DOTP;
#define SXI(K, v_) __float_as_int(sx<K>(__int_as_float(v_)))
    for (int s = 0; s < NSL; ++s) { const bool first = (s == 0), lastS = (s == NSL - 1);
        const __amdgpu_buffer_rsrc_t urs = __builtin_amdgcn_make_buffer_rsrc((void*)(PU + (long)s * NEXP * SW), 0, NEXP * SW, 0x00020000);
#define UP_ROW(e_) __builtin_bit_cast(u32x4, __builtin_amdgcn_raw_buffer_load_b128(urs, (e_) * SW + 16 * c, 0, 0))
#define UP_IDX(tt, q4) (*reinterpret_cast<const int4*>(PIDX + (long)(tt) * 128 + 16 * g + 4 * (q4)))
#define UP_X(tt) (*reinterpret_cast<const u32x4*>(H8 + (long)(tt) * DM + SW * s + 16 * c))
#define UP_DOT(r_) __builtin_amdgcn_sdot4((int)(r_).x, (int)xv.x, __builtin_amdgcn_sdot4((int)(r_).y, (int)xv.y, __builtin_amdgcn_sdot4((int)(r_).z, (int)xv.z, __builtin_amdgcn_sdot4((int)(r_).w, (int)xv.w, 0, false), false), false), false)
        if (wv >= thi) continue;
        u32x4 A[8], B[8]; int4 en[4]; u32x4 xn;
        { int4 e0[4];
#pragma unroll
          for (int q4 = 0; q4 < 4; ++q4) e0[q4] = UP_IDX(wv, q4);
          A[0] = UP_ROW(e0[0].x); A[1] = UP_ROW(e0[0].y); A[2] = UP_ROW(e0[0].z); A[3] = UP_ROW(e0[0].w); A[4] = UP_ROW(e0[1].x); A[5] = UP_ROW(e0[1].y); A[6] = UP_ROW(e0[1].z); A[7] = UP_ROW(e0[1].w);
          B[0] = UP_ROW(e0[2].x); B[1] = UP_ROW(e0[2].y); B[2] = UP_ROW(e0[2].z); B[3] = UP_ROW(e0[2].w); B[4] = UP_ROW(e0[3].x); B[5] = UP_ROW(e0[3].y); B[6] = UP_ROW(e0[3].z); B[7] = UP_ROW(e0[3].w);
          const int t1 = (wv + nwv < thi) ? wv + nwv : wv;
#pragma unroll
          for (int q4 = 0; q4 < 4; ++q4) en[q4] = UP_IDX(t1, q4);
          xn = UP_X(wv); }
        int2 dnx = make_int2(0, 0);
        if (!first) dnx = *reinterpret_cast<const int2*>(dp + (long)wv * 128 + 16 * g + 2 * c);
#pragma unroll 1
        for (int t = wv; t < thi; t += nwv) {
            const int tn = (t + nwv < thi) ? t + nwv : t, tnn = (tn + nwv < thi) ? tn + nwv : tn;
            const int2 dcur = dnx;
            if (!first) dnx = *reinterpret_cast<const int2*>(dp + (long)tn * 128 + 16 * g + 2 * c);
            const u32x4 xv = xn; xn = UP_X(tn);
            int d[16];
#pragma unroll
            for (int i = 0; i < 8; ++i) d[i] = UP_DOT(A[i]);
            A[0] = UP_ROW(en[0].x); A[1] = UP_ROW(en[0].y); A[2] = UP_ROW(en[0].z); A[3] = UP_ROW(en[0].w); A[4] = UP_ROW(en[1].x); A[5] = UP_ROW(en[1].y); A[6] = UP_ROW(en[1].z); A[7] = UP_ROW(en[1].w);
#pragma unroll
            for (int i = 0; i < 8; ++i) d[8 + i] = UP_DOT(B[i]);
            B[0] = UP_ROW(en[2].x); B[1] = UP_ROW(en[2].y); B[2] = UP_ROW(en[2].z); B[3] = UP_ROW(en[2].w); B[4] = UP_ROW(en[3].x); B[5] = UP_ROW(en[3].y); B[6] = UP_ROW(en[3].z); B[7] = UP_ROW(en[3].w);
#pragma unroll
            for (int q4 = 0; q4 < 4; ++q4) en[q4] = UP_IDX(tnn, q4);
            int r8[8], r4[4], r2[2];
#pragma unroll
            for (int k = 0; k < 8; ++k) { const int keep = (c & 4) ? d[k + 8] : d[k], send = (c & 4) ? d[k] : d[k + 8]; r8[k] = keep + SXI(4, send); }
#pragma unroll
            for (int k = 0; k < 4; ++k) { const int keep = (c & 2) ? r8[k + 4] : r8[k], send = (c & 2) ? r8[k] : r8[k + 4]; r4[k] = keep + SXI(2, send); }
#pragma unroll
            for (int k = 0; k < 2; ++k) { const int keep = (c & 1) ? r4[k + 2] : r4[k], send = (c & 1) ? r4[k] : r4[k + 2]; r2[k] = keep + SXI(1, send); }
            int* o = dp + (long)t * 128 + 16 * g + 2 * c;
            const int a0i = r2[0] + dcur.x, a1i = r2[1] + dcur.y;
            if (!lastS) *reinterpret_cast<int2*>(o) = make_int2(a0i, a1i);
            else {
                const int p0 = 16 * g + 2 * c; const int2 ee = *reinterpret_cast<const int2*>(PIDX + (long)t * 128 + p0); const f32x2 gw = *reinterpret_cast<const f32x2*>(PW + (long)t * 128 + p0); const float sa = SA[t];
                const float a0 = gw[0] * gelu_exact((float)a0i * sa * SU[ee.x]) * SV[ee.x], a1 = gw[1] * gelu_exact((float)a1i * sa * SU[ee.y]) * SV[ee.y];
                u32x2 pk; pk.x = (cvt_pk_bf16(0.f, a0) & 0xffff0000u) | (unsigned)ee.x; pk.y = (cvt_pk_bf16(0.f, a1) & 0xffff0000u) | (unsigned)ee.y;
                *reinterpret_cast<u32x2*>(PACKT + ((long)(p0 >> 2) * T + t) * 4 + (p0 & 3)) = pk; }
        }
#undef UP_ROW
#undef UP_IDX
#undef UP_X
#undef UP_DOT
    }
#undef SXI
}
__device__ __forceinline__ void actpass(const float* __restrict__ DOTP, const int* __restrict__ PIDX, const float* __restrict__ PW, const float* __restrict__ SU, const float* __restrict__ SV, float* __restrict__ ACT, int nx, long gt, long nt) {
    for (long i = gt; i < (long)T * 128; i += nt) { float dsum = 0.f;
        for (int x = 0; x < nx; ++x) dsum += DOTP[(long)x * T * 128 + i];
        const int e = PIDX[i]; const float av = PW[i] * gelu_exact(dsum * SU[e]) * SV[e]; const long t = i >> 7; const int pp = (int)(i & 127);
        reinterpret_cast<unsigned*>(ACT)[((long)(pp >> 2) * T + t) * 4 + (pp & 3)] = (cvt_pk_bf16(0.f, av) & 0xffff0000u) | (unsigned)e; }
}
__device__ __forceinline__ void vpass(const unsigned char* __restrict__ PV, const int* __restrict__ PIDX, const float* __restrict__ ACT, float* __restrict__ X, const float* __restrict__ gate, const XInfo xin, int wid, int lane) {
    const int g = lane >> 3, c = lane & 7; const int wv = xin.rank * 8 + wid, nwv = xin.nloc * 8;
    for (int s = xin.xi; s < NSL; s += xin.nx) {
        int4 en[4]; f32x4 an[4];
#pragma unroll
        for (int q4 = 0; q4 < 4; ++q4) { en[q4] = *reinterpret_cast<const int4*>(PIDX + (long)(wv < T ? wv : 0) * 128 + 16 * g + 4 * q4); an[q4] = *reinterpret_cast<const f32x4*>(ACT + (long)(wv < T ? wv : 0) * 128 + 16 * g + 4 * q4); }
        for (int t = wv; t < T; t += nwv) {
            int e[16]; float a[16];
#pragma unroll
            for (int q4 = 0; q4 < 4; ++q4) { e[4 * q4] = en[q4].x; e[4 * q4 + 1] = en[q4].y; e[4 * q4 + 2] = en[q4].z; e[4 * q4 + 3] = en[q4].w; a[4 * q4] = an[q4][0]; a[4 * q4 + 1] = an[q4][1]; a[4 * q4 + 2] = an[q4][2]; a[4 * q4 + 3] = an[q4][3]; }
            u32x4 w[16];
#pragma unroll
            for (int i = 0; i < 16; ++i) w[i] = *reinterpret_cast<const u32x4*>(PV + ((long)s * NEXP + e[i]) * SW + 16 * c);
            { const int tn = (t + nwv < T) ? t + nwv : t;
#pragma unroll
              for (int q4 = 0; q4 < 4; ++q4) { en[q4] = *reinterpret_cast<const int4*>(PIDX + (long)tn * 128 + 16 * g + 4 * q4); an[q4] = *reinterpret_cast<const f32x4*>(ACT + (long)tn * 128 + 16 * g + 4 * q4); } }
            f32x2 o[8];
#pragma unroll
            for (int k = 0; k < 8; ++k) o[k] = (f32x2){0.f, 0.f};
#pragma unroll
            for (int i = 0; i < 16; ++i) { f32x2 f[8]; dec16(w[i], f); const f32x2 a2 = (f32x2){a[i], a[i]};
#pragma unroll
                for (int k = 0; k < 8; ++k) o[k] = __builtin_elementwise_fma(f[k], a2, o[k]); }
            f32x2 r4[4], r2[2], r1;
#pragma unroll
            for (int k = 0; k < 4; ++k) { const f32x2 keep = (g & 4) ? o[k + 4] : o[k], send = (g & 4) ? o[k] : o[k + 4]; r4[k] = keep + (f32x2){sx<32>(send[0]), sx<32>(send[1])}; }
#pragma unroll
            for (int k = 0; k < 2; ++k) { const f32x2 keep = (g & 2) ? r4[k + 2] : r4[k], send = (g & 2) ? r4[k] : r4[k + 2]; r2[k] = keep + (f32x2){sx<16>(send[0]), sx<16>(send[1])}; }
            { const f32x2 keep = (g & 1) ? r2[1] : r2[0], send = (g & 1) ? r2[0] : r2[1]; r1 = keep + (f32x2){sx<8>(send[0]), sx<8>(send[1])}; }
            const int col = SW * s + 16 * c + 2 * g;
            const f32x2 gv = *reinterpret_cast<const f32x2*>(gate + (long)cond_row(t) * 12288 + col);
            float* xp = X + (long)t * DM + col; f32x2 xv = *reinterpret_cast<const f32x2*>(xp);
            xv += gv * r1; *reinterpret_cast<f32x2*>(xp) = xv;
        }
    }
}

__device__ __forceinline__ void vpass_lds(const unsigned char* __restrict__ PV, const unsigned* __restrict__ PACKT, float* __restrict__ X, const float* __restrict__ gate, char* lds, int bid, int nb, int s_end, int tid) {
    const int wid = tid >> 6, lane = tid & 63;
    for (int s = bid; s < s_end; s += nb) {
        __syncthreads();
        { const u32x4* src = reinterpret_cast<const u32x4*>(PV + (long)s * NEXP * 8); u32x4* dst = reinterpret_cast<u32x4*>(lds);
#pragma unroll 4
          for (int i = tid; i < NEXP * 8 / 16; i += 512) dst[i] = src[i]; }
        __syncthreads();
        u32x4 h0[8], h1[8];
        const __amdgpu_buffer_rsrc_t vrs = __builtin_amdgcn_make_buffer_rsrc((void*)PACKT, 0, (int)((size_t)T * 128 * 4), 0x00020000);
#define VP_LD(k, toff) __builtin_bit_cast(u32x4, __builtin_amdgcn_raw_buffer_load_b128(vrs, (int)(toff), (int)((size_t)(k) * T * 16), 0))
        { const unsigned toff = (unsigned)(wid * 64 + lane) * 16u;
#pragma unroll
          for (int k = 0; k < 8; ++k) h0[k] = VP_LD(k, toff);
#pragma unroll
          for (int k = 0; k < 8; ++k) h1[k] = VP_LD(8 + k, toff); }
#define VP_STEP(HB) do { _Pragma("unroll") for (int kk = 0; kk < 8; kk += 2) { unsigned pw[8]; \
            _Pragma("unroll") for (int k = 0; k < 2; ++k) { pw[4 * k] = HB[kk + k].x; pw[4 * k + 1] = HB[kk + k].y; pw[4 * k + 2] = HB[kk + k].z; pw[4 * k + 3] = HB[kk + k].w; } \
            u32x2 w[8]; \
            _Pragma("unroll") for (int k = 0; k < 8; ++k) w[k] = *reinterpret_cast<const u32x2*>(lds + (pw[k] & 0xffffu) * 8u); \
            _Pragma("unroll") for (int k = 0; k < 8; ++k) { const float a = __uint_as_float(pw[k] & 0xffff0000u); \
                const f32x2 f0 = __builtin_amdgcn_cvt_pk_f32_fp8((int)w[k].x, false), f1 = __builtin_amdgcn_cvt_pk_f32_fp8((int)w[k].x, true), f2 = __builtin_amdgcn_cvt_pk_f32_fp8((int)w[k].y, false), f3 = __builtin_amdgcn_cvt_pk_f32_fp8((int)w[k].y, true); \
                acc[0] = fmaf(a, f0[0], acc[0]); acc[1] = fmaf(a, f0[1], acc[1]); acc[2] = fmaf(a, f1[0], acc[2]); acc[3] = fmaf(a, f1[1], acc[3]); \
                acc[4] = fmaf(a, f2[0], acc[4]); acc[5] = fmaf(a, f2[1], acc[5]); acc[6] = fmaf(a, f3[0], acc[6]); acc[7] = fmaf(a, f3[1], acc[7]); } } } while (0)
#pragma unroll 1
        for (int tg = wid; tg < T / 64; tg += 8) { const int t = tg * 64 + lane; const int tgn = (tg + 8 < T / 64) ? tg + 8 : tg;
            const unsigned toff = (unsigned)t * 16u, toffn = (unsigned)(tgn * 64 + lane) * 16u;
            float acc[8];
#pragma unroll
            for (int j = 0; j < 8; ++j) acc[j] = 0.f;
            VP_STEP(h0);
#pragma unroll
            for (int k = 0; k < 8; ++k) h0[k] = VP_LD(16 + k, toff);
            VP_STEP(h1);
#pragma unroll
            for (int k = 0; k < 8; ++k) h1[k] = VP_LD(24 + k, toff);
            VP_STEP(h0);
#pragma unroll
            for (int k = 0; k < 8; ++k) h0[k] = VP_LD(k, toffn);
            VP_STEP(h1);
#pragma unroll
            for (int k = 0; k < 8; ++k) h1[k] = VP_LD(8 + k, toffn);
            const float* gr = gate + (long)cond_row(t) * 12288 + 8 * s; float* xp = X + (long)t * DM + 8 * s;
            const f32x4 g0 = *reinterpret_cast<const f32x4*>(gr), g1 = *reinterpret_cast<const f32x4*>(gr + 4);
            f32x4 x0 = *reinterpret_cast<const f32x4*>(xp), x1 = *reinterpret_cast<const f32x4*>(xp + 4);
            x0[0] += g0[0] * acc[0]; x0[1] += g0[1] * acc[1]; x0[2] += g0[2] * acc[2]; x0[3] += g0[3] * acc[3];
            x1[0] += g1[0] * acc[4]; x1[1] += g1[1] * acc[5]; x1[2] += g1[2] * acc[6]; x1[3] += g1[3] * acc[7];
            *reinterpret_cast<f32x4*>(xp) = x0; *reinterpret_cast<f32x4*>(xp + 4) = x1; }
#undef VP_STEP
#undef VP_LD
    }
    __syncthreads();
}
}
namespace ph {
__device__ __forceinline__ int gwave() { return obid() * 8 + (otid() >> 6); }
__device__ __forceinline__ int nwaves() { return ogrid() * 8; }
__device__ __forceinline__ long gthread() { return (long)obid() * 512 + otid(); }
__device__ __forceinline__ long nthreads() { return (long)ogrid() * 512; }

__device__ __forceinline__ void transpose_tile(const float* __restrict__ src, int C, int r0, int c0, bf16_t* __restrict__ dst, long dpitch, float* tile) {
    const int tid = otid();
#pragma unroll
    for (int i = 0; i < 8; ++i) { const int idx = tid + 512 * i, r = idx >> 6, c = idx & 63; tile[r * 65 + c] = src[(long)(r0 + r) * C + c0 + c]; }
    __syncthreads();
    { const int c = tid >> 3, rc = (tid & 7) * 8; float f[8];
#pragma unroll
      for (int j = 0; j < 8; ++j) f[j] = tile[(rc + j) * 65 + c];
      *reinterpret_cast<u32x4*>(dst + (long)(c0 + c) * dpitch + r0 + rc) = pack8(f); }
    __syncthreads();
}

__device__ __forceinline__ void zero_chunks(bf16_t* base, long nrows, long rowpitch, int col0, int nchunk) {
    const long total = nrows * nchunk;
    for (long i = gthread(); i < total; i += nthreads()) { const long r = i / nchunk; const int ch = (int)(i % nchunk);
        *reinterpret_cast<u32x4*>(base + r * rowpitch + col0 + ch * 8) = (u32x4){0u, 0u, 0u, 0u}; }
}

__device__ __forceinline__ void prologue(KParams& p, char* lds) {
    unsigned char* ws = optr(gp(p.ws)); const int tid = otid();
    float* tile = (float*)lds;
    { struct TJob { const float* src; bf16_t* dst; int R, C, r0, c0, perm; };
      auto decode = [&](int it) { TJob j; j.perm = 0; const int l = it / 10656; int r = it % 10656;
        if (r < 5664) { j.src = gp(p.w_in) + (long)l * DM * INW; j.R = DM; j.C = INW; j.dst = (bf16_t*)(ws + WS_WIN) + (long)l * INWP * DM; }
        else if (r < 6048) { r -= 5664; j.src = gp(p.w_uq) + (long)l * 512 * 3072; j.R = 512; j.C = 3072; j.dst = (bf16_t*)(ws + WS_WUQ) + (long)l * 3072 * 512; j.perm = 1; }
        else if (r < 6560) { r -= 6048; j.src = gp(p.w_ukv) + (long)l * 512 * 4096; j.R = 512; j.C = 4096; j.dst = (bf16_t*)(ws + WS_WUKV) + (long)l * 4096 * 512; }
        else { r -= 6560; const int m = r >> 10; r &= 1023; j.R = DM; j.C = DM;
            j.src = (m == 0 ? gp(p.w_a) : m == 1 ? gp(p.w_b) : m == 2 ? gp(p.w_o) : gp(p.w_pq)) + (long)l * DM * DM;
            j.dst = (bf16_t*)(ws + (m == 0 ? WS_WA : m == 1 ? WS_WB : m == 2 ? WS_WO : WS_WPQ)) + (long)l * DM * DM; }
        const int ntc = j.C / 64; j.r0 = (r / ntc) * 64; j.c0 = (r % ntc) * 64; return j; };
      const int NTILES = 2 * 10656, G_ = ogrid(); int it = obid(); float v[8]; TJob cur{};
      if (it < NTILES) { cur = decode(it);
#pragma unroll
        for (int i = 0; i < 8; ++i) { const int idx = tid + 512 * i, r = idx >> 6, c = idx & 63; v[i] = cur.src[(long)(cur.r0 + r) * cur.C + cur.c0 + c]; } }
      while (it < NTILES) { const int itn = it + G_; float vn[8]; TJob nxt{};
        if (itn < NTILES) { nxt = decode(itn);
#pragma unroll
            for (int i = 0; i < 8; ++i) { const int idx = tid + 512 * i, r = idx >> 6, c = idx & 63; vn[i] = nxt.src[(long)(nxt.r0 + r) * nxt.C + nxt.c0 + c]; } }
#pragma unroll
        for (int i = 0; i < 8; ++i) { const int idx = tid + 512 * i, r = idx >> 6, c = idx & 63; tile[r * 65 + c] = v[i]; }
        __syncthreads();
        { const int c = tid >> 3, rc = (tid & 7) * 8; float f[8];
#pragma unroll
          for (int jj = 0; jj < 8; ++jj) f[jj] = tile[(rc + jj) * 65 + c];
          int drow = cur.c0 + c;
          if (cur.perm) { const int gq = drow / 768, o = drow - 768 * gq, hh = o / 192, w = o - 192 * hh;
              drow = 768 * gq + (w < 128 ? 128 * hh + w : (w < 160 ? 512 + 32 * hh + (w - 128) : 640 + 32 * hh + (w - 160))); }
          *reinterpret_cast<u32x4*>(cur.dst + (long)drow * cur.R + cur.r0 + rc) = pack8(f); }
        __syncthreads();
#pragma unroll
        for (int i = 0; i < 8; ++i) v[i] = vn[i];
        cur = nxt; it = itn; } }
    for (long i = gthread(); i < 2L * 16 * 512 * 32; i += nthreads()) { const int ch = (int)(i & 31); const long row = i >> 5; const int c = (int)(row & 511), h = (int)((row >> 9) & 15), l = (int)(row >> 13);
        u32x4 w = (u32x4){0u, 0u, 0u, 0u};
        if (ch < 16) { const float* s = gp(p.w_ukv) + (((long)l * 512 + c) * 16 + h) * 256 + ch * 8; float f[8];
#pragma unroll
            for (int j = 0; j < 8; ++j) f[j] = s[j];
            w = pack8(f); }
        *reinterpret_cast<u32x4*>((bf16_t*)(ws + WS_WUK) + row * 256 + ch * 8) = w; }
    for (long i = gthread(); i < 2L * 4096; i += nthreads()) { const bool second = i >= 4096; const long j8 = (second ? i - 4096 : i) * 8; const float* s = (second ? gp(p.peer_k2) : gp(p.peer_k1)) + j8; float f[8];
#pragma unroll
        for (int j = 0; j < 8; ++j) f[j] = s[j];
        *reinterpret_cast<u32x4*>((bf16_t*)(ws + (second ? WS_PK2 : WS_PK1)) + j8) = pack8(f); }
    for (int l = 0; l < 2; ++l) zero_chunks((bf16_t*)(ws + WS_WIN) + ((long)l * INWP + INW) * DM, INWP - INW, DM, 0, DM / 8);
    for (int b = 0; b < DB; ++b) zero_chunks((bf16_t*)(ws + WS_CKA) + ((long)b * KPAD + KALL) * QLD, KPAD - KALL, QLD, 0, QLD / 8);
    zero_chunks((bf16_t*)(ws + WS_CKA), (long)DB * KPAD, QLD, 576, 8);
    zero_chunks((bf16_t*)(ws + WS_CKT), (long)DB * 512, KPAD, KALL, (KPAD - KALL) / 8);
    zero_chunks((bf16_t*)(ws + WS_QL), (long)DB * 1024, QLD, 576, 8);
    for (long i = gthread(); i < 4096L * 96; i += nthreads()) { const int pos = (int)(i / 96), k = (int)(i % 96); const bool big = k >= 32; const int fi = big ? k - 32 : k; const float d = big ? 128.f : 64.f;
        const float inv = __builtin_amdgcn_exp2f(-(2.0f * (float)fi / d) * 13.287712379549449f);
        const float ang = (float)pos * inv; double rv = (double)ang * 0.15915494309189535; rv -= floor(rv); const float fr = (float)rv;
        float* dst = big ? (float*)(ws + WS_TAB128) + ((long)pos * 64 + fi) * 2 : (float*)(ws + WS_TAB64) + ((long)pos * 32 + fi) * 2;
        dst[0] = __builtin_amdgcn_cosf(fr); dst[1] = __builtin_amdgcn_sinf(fr); }
    { float* sc = (float*)lds;
      for (int it = obid(); it < 2 * 12 * 8; it += ogrid()) { const int l = it / 96, cc = (it % 96) / 8, ks = it % 8;
        __syncthreads();
        for (int i = tid; i < NCOND * 256; i += 512) { const int r = i >> 8, k = i & 255; const float c = r < NB ? gp(p.c_prompt)[(long)r * DM + ks * 256 + k] : gp(p.c_sample)[(long)(r - NB) * DM + ks * 256 + k]; sc[i] = siluf_(c); }
        __syncthreads();
        float a0[NCOND], a1[NCOND];
#pragma unroll
        for (int r = 0; r < NCOND; ++r) { a0[r] = 0.f; a1[r] = 0.f; }
        const float* wp = gp(p.w_ada) + ((long)l * DM + ks * 256) * 12288 + cc * 1024 + 2 * tid;
        f32x2 w0 = *reinterpret_cast<const f32x2*>(wp), w1 = *reinterpret_cast<const f32x2*>(wp + 12288), w2 = *reinterpret_cast<const f32x2*>(wp + 2 * 12288), w3 = *reinterpret_cast<const f32x2*>(wp + 3 * 12288);
#pragma unroll 1
        for (int k = 0; k < 256; k += 4) {
            wp += (k + 4 < 256) ? 4 * 12288 : 0;
            const f32x2 n0 = *reinterpret_cast<const f32x2*>(wp), n1 = *reinterpret_cast<const f32x2*>(wp + 12288), n2 = *reinterpret_cast<const f32x2*>(wp + 2 * 12288), n3 = *reinterpret_cast<const f32x2*>(wp + 3 * 12288);
            __builtin_amdgcn_sched_barrier(0);
#pragma unroll
            for (int r = 0; r < NCOND; ++r) { const f32x4 s = *reinterpret_cast<const f32x4*>(sc + r * 256 + k);
                a0[r] = fmaf(s[0], w0[0], fmaf(s[1], w1[0], fmaf(s[2], w2[0], fmaf(s[3], w3[0], a0[r]))));
                a1[r] = fmaf(s[0], w0[1], fmaf(s[1], w1[1], fmaf(s[2], w2[1], fmaf(s[3], w3[1], a1[r]))));
                if ((r % 6) == 5) __builtin_amdgcn_sched_barrier(0); }
            w0 = n0; w1 = n1; w2 = n2; w3 = n3; }
        float* dst = (float*)(ws + WS_ADAP) + (((long)ks * 2 + l) * NCOND) * 12288 + cc * 1024 + 2 * tid;
#pragma unroll
        for (int r = 0; r < NCOND; ++r) *reinterpret_cast<f32x2*>(dst + (long)r * 12288) = (f32x2){a0[r], a1[r]}; }
      __syncthreads(); }
}

__device__ __forceinline__ void wpq_int8(KParams& p) {
    unsigned char* ws = optr(gp(p.ws)); const int lane = otid() & 63;
    for (int r = gwave(); r < 2 * DM; r += nwaves()) { const bf16_t* src = (const bf16_t*)(ws + WS_WPQ) + (long)r * DM; float f[4][8]; float am = 0.f;
#pragma unroll
        for (int j = 0; j < 4; ++j) { unpack8(*reinterpret_cast<const u32x4*>(src + 512 * j + 8 * lane), f[j]);
#pragma unroll
            for (int i = 0; i < 8; ++i) am = fmaxf(am, fabsf(f[j][i])); }
        am = wave_max(am); const float qs = am > 0.f ? 127.0f / am : 0.f;
#pragma unroll
        for (int j = 0; j < 4; ++j) { unsigned w2[2];
#pragma unroll
            for (int hh = 0; hh < 2; ++hh) { unsigned w = 0u;
#pragma unroll
                for (int i = 0; i < 4; ++i) w |= ((unsigned)((int)__builtin_rintf(f[j][4 * hh + i] * qs) & 0xff)) << (8 * i);
                w2[hh] = w; }
            *reinterpret_cast<u32x2*>(ws + WS_WPQ8 + (long)r * DM + 512 * j + 8 * lane) = (u32x2){w2[0], w2[1]}; }
        if (lane == 0) ((float*)(ws + WS_SB8))[r] = am * (1.0f / 127.0f); }
}

__device__ __forceinline__ void rows2048_int8(KParams& p, size_t src_off, size_t dst_off, size_t sc_off, int nrows) {
    unsigned char* ws = optr(gp(p.ws)); const int lane = otid() & 63;
    for (int r = gwave(); r < nrows; r += nwaves()) { const bf16_t* src = (const bf16_t*)(ws + src_off) + (long)r * DM; float f[4][8]; float am = 0.f;
#pragma unroll
        for (int j = 0; j < 4; ++j) { unpack8(*reinterpret_cast<const u32x4*>(src + 512 * j + 8 * lane), f[j]);
#pragma unroll
            for (int i = 0; i < 8; ++i) am = fmaxf(am, fabsf(f[j][i])); }
        am = wave_max(am); const float qs = am > 0.f ? 127.0f / am : 0.f;
#pragma unroll
        for (int j = 0; j < 4; ++j) { unsigned w2[2];
#pragma unroll
            for (int hh = 0; hh < 2; ++hh) { unsigned w = 0u;
#pragma unroll
                for (int i = 0; i < 4; ++i) w |= ((unsigned)((int)__builtin_rintf(f[j][4 * hh + i] * qs) & 0xff)) << (8 * i);
                w2[hh] = w; }
            *reinterpret_cast<u32x2*>(ws + dst_off + (long)r * DM + 512 * j + 8 * lane) = (u32x2){w2[0], w2[1]}; }
        if (lane == 0) ((float*)(ws + sc_off))[r] = am * (1.0f / 127.0f); }
}
__device__ __forceinline__ void wb_int8(KParams& p, int l) {
    unsigned char* ws = optr(gp(p.ws)); const int lane = otid() & 63;
    for (int r = gwave(); r < DM; r += nwaves()) { const bf16_t* src = (const bf16_t*)(ws + WS_WB) + ((long)l * DM + r) * DM; float f[4][8]; float am = 0.f;
#pragma unroll
        for (int j = 0; j < 4; ++j) { unpack8(*reinterpret_cast<const u32x4*>(src + 512 * j + 8 * lane), f[j]);
#pragma unroll
            for (int i = 0; i < 8; ++i) am = fmaxf(am, fabsf(f[j][i])); }
        am = wave_max(am); const float qs = am > 0.f ? 127.0f / am : 0.f;
#pragma unroll
        for (int j = 0; j < 4; ++j) { unsigned w2[2];
#pragma unroll
            for (int hh = 0; hh < 2; ++hh) { unsigned w = 0u;
#pragma unroll
                for (int i = 0; i < 4; ++i) w |= ((unsigned)((int)__builtin_rintf(f[j][4 * hh + i] * qs) & 0xff)) << (8 * i);
                w2[hh] = w; }
            *reinterpret_cast<u32x2*>(ws + WS_WB8 + (long)r * DM + 512 * j + 8 * lane) = (u32x2){w2[0], w2[1]}; }
        if (lane == 0) ((float*)(ws + WS_SBB))[r] = am * (1.0f / 127.0f); }
}

__device__ __forceinline__ void win_int8(KParams& p, int l) {
    unsigned char* ws = optr(gp(p.ws)); const int lane = otid() & 63;
    for (int jr = gwave(); jr < NB8 * 256; jr += nwaves()) { const int blk = jr >> 8, n = (blk < 2 ? blk : (blk < 5 ? blk + 3 : blk + 7)) * 256 + (jr & 255);
        const bf16_t* src = (const bf16_t*)(ws + WS_WIN) + ((long)l * INWP + n) * DM; float f[4][8]; float am = 0.f;
#pragma unroll
        for (int j = 0; j < 4; ++j) { unpack8(*reinterpret_cast<const u32x4*>(src + 512 * j + 8 * lane), f[j]);
#pragma unroll
            for (int i = 0; i < 8; ++i) am = fmaxf(am, fabsf(f[j][i])); }
        am = wave_max(am); const float qs = am > 0.f ? 127.0f / am : 0.f;
#pragma unroll
        for (int j = 0; j < 4; ++j) { unsigned w2[2];
#pragma unroll
            for (int hh = 0; hh < 2; ++hh) { unsigned w = 0u;
#pragma unroll
                for (int i = 0; i < 4; ++i) w |= ((unsigned)((int)__builtin_rintf(f[j][4 * hh + i] * qs) & 0xff)) << (8 * i);
                w2[hh] = w; }
            *reinterpret_cast<u32x2*>(ws + WS_WIN8 + (long)jr * DM + 512 * j + 8 * lane) = (u32x2){w2[0], w2[1]}; }
        if (lane == 0) ((float*)(ws + WS_SBW))[n] = am * (1.0f / 127.0f); }
}

__device__ __forceinline__ void ada_reduce(KParams& p) {
    unsigned char* ws = optr(gp(p.ws)); const float* ap = (const float*)(ws + WS_ADAP); float* ad = (float*)(ws + WS_ADA); const long n = 2L * NCOND * 12288;
    for (long i = gthread(); i < n; i += nthreads()) { const int l = (int)(i / (NCOND * 12288L)); const int j = (int)(i % 12288);
        float s = gp(p.b_ada)[(long)l * 12288 + j];
#pragma unroll
        for (int ks = 0; ks < 8; ++ks) s += ap[(long)ks * n + i];
        ad[i] = s; }
}

__device__ __forceinline__ void modulate(KParams& p, int l, int which) {
    const int lane = otid() & 63; unsigned char* ws = optr(gp(p.ws)); const float* X = gp(p.out); bf16_t* H = (bf16_t*)(ws + WS_H);
    const float* g = (which ? gp(p.g_ffn) : gp(p.g_mix)) + (long)l * DM; const float* ada = (const float*)(ws + WS_ADA) + (long)l * NCOND * 12288 + (which ? 3 : 0) * DM;
    for (int t = gwave(); t < T; t += nwaves()) {
        const float* xr = (l == 0 && which == 0) ? (t < TP ? gp(p.x_prompt) + (long)t * DM : gp(p.x_sample) + (long)(t - TP) * DM) : X + (long)t * DM; f32x4 v[8]; float ss = 0.f;
#pragma unroll
        for (int j = 0; j < 8; ++j) { v[j] = *reinterpret_cast<const f32x4*>(xr + 256 * j + 4 * lane); ss += v[j][0] * v[j][0] + v[j][1] * v[j][1] + v[j][2] * v[j][2] + v[j][3] * v[j][3]; }
        ss = wave_sum(ss); const float rinv = rsqrtf(ss * (1.0f / DM) + EPS);
        const float* sh = ada + (long)cond_row(t) * 12288; const float* sc = sh + DM;
#pragma unroll
        for (int j = 0; j < 8; ++j) { const int c = 256 * j + 4 * lane; const f32x4 gv = *reinterpret_cast<const f32x4*>(g + c), sv = *reinterpret_cast<const f32x4*>(sc + c), hv = *reinterpret_cast<const f32x4*>(sh + c);
            const f32x4 y = v[j] * rinv * gv * (sv + 1.0f) + hv; u32x2 w; w.x = cvt_pk_bf16(y[0], y[1]); w.y = cvt_pk_bf16(y[2], y[3]);
            if (!which) *reinterpret_cast<u32x2*>(H + (long)t * DM + c) = w;
            v[j] = y; }
        {
            float am = 0.f;
#pragma unroll
            for (int j = 0; j < 8; ++j) am = fmaxf(am, fmaxf(fmaxf(fabsf(v[j][0]), fabsf(v[j][1])), fmaxf(fabsf(v[j][2]), fabsf(v[j][3]))));
            am = wave_max(am); const float qs = am > 0.f ? 127.0f / am : 0.f;
#pragma unroll
            for (int j = 0; j < 8; ++j) { const int c = 256 * j + 4 * lane;
                const int q0 = (int)__builtin_rintf(v[j][0] * qs), q1 = (int)__builtin_rintf(v[j][1] * qs), q2 = (int)__builtin_rintf(v[j][2] * qs), q3 = (int)__builtin_rintf(v[j][3] * qs);
                *reinterpret_cast<unsigned*>(ws + WS_H8 + (long)t * DM + c) = (unsigned)(q0 & 0xff) | ((unsigned)(q1 & 0xff) << 8) | ((unsigned)(q2 & 0xff) << 16) | ((unsigned)(q3 & 0xff) << 24); }
            if (lane == 0) ((float*)(ws + WS_SA8))[t] = am * (1.0f / 127.0f); }
    }
}

__device__ __forceinline__ void cache_convert(KParams& p, int l, char* lds, int it0, int it1, int bidx, int nb) {
    const int tid = otid(); unsigned char* ws = optr(gp(p.ws)); float* tile = (float*)lds; bf16_t* CKA = (bf16_t*)(ws + WS_CKA); bf16_t* CKT = (bf16_t*)(ws + WS_CKT);
    { const int NT_ = it1, G_ = nb; int it = it0 + bidx; float v[8];
      const float* cbase = gp(p.cache_ckv) + (long)l * DB * PAST * 512;
#define CC_SRC(itx) (cbase + (((long)((itx) >> 8)) * PAST + (((itx) >> 3) & 31) * 64) * 512 + ((itx) & 7) * 64)
      if (it < NT_) { const float* src = CC_SRC(it);
#pragma unroll
        for (int i = 0; i < 8; ++i) { const int idx = tid + 512 * i, r = idx >> 6, c = idx & 63; v[i] = src[(long)r * 512 + c]; } }
      while (it < NT_) { const int b = it >> 8, kt = (it >> 3) & 31, ct = it & 7; const int itn = it + G_; float vn[8];
        if (itn < NT_) { const float* src = CC_SRC(itn);
#pragma unroll
            for (int i = 0; i < 8; ++i) { const int idx = tid + 512 * i, r = idx >> 6, c = idx & 63; vn[i] = src[(long)r * 512 + c]; } }
#pragma unroll
        for (int i = 0; i < 8; ++i) { const int idx = tid + 512 * i, r = idx >> 6, c = idx & 63; tile[r * 65 + c] = v[i]; }
        __syncthreads();
        { const int r = tid >> 3, cc = (tid & 7) * 8; float f[8];
#pragma unroll
          for (int j = 0; j < 8; ++j) f[j] = tile[r * 65 + cc + j];
          *reinterpret_cast<u32x4*>(CKA + ((long)b * KPAD + kt * 64 + r) * QLD + ct * 64 + cc) = pack8(f);
#pragma unroll
          for (int j = 0; j < 8; ++j) f[j] = tile[(cc + j) * 65 + r];
          *reinterpret_cast<u32x4*>(CKT + ((long)b * 512 + ct * 64 + r) * KPAD + kt * 64 + cc) = pack8(f); }
        __syncthreads();
#pragma unroll
        for (int i = 0; i < 8; ++i) v[i] = vn[i];
        it = itn; }
#undef CC_SRC
    }
    for (long i = (long)it0 * 64 + (long)bidx * 512 + tid; i < (long)it1 * 64; i += (long)nb * 512) { const long row = i >> 3; const int ch = (int)(i & 7); const int b = (int)(row >> 11), k = (int)(row & 2047);
        const float* s = gp(p.cache_krope) + (((long)l * DB + b) * PAST + k) * 64 + ch * 8; float f[8];
#pragma unroll
        for (int j = 0; j < 8; ++j) f[j] = s[j];
        *reinterpret_cast<u32x4*>(CKA + ((long)b * KPAD + k) * QLD + 512 + ch * 8) = pack8(f); }
}

__device__ __forceinline__ void quant_row8(const float (&o)[8], unsigned char* dst, float* sc, int lane) {
    float am = 0.f;
#pragma unroll
    for (int j = 0; j < 8; ++j) am = fmaxf(am, fabsf(o[j]));
    am = wave_max(am); const float qs = am > 0.f ? 127.0f / am : 0.f; unsigned w2[2];
#pragma unroll
    for (int hh = 0; hh < 2; ++hh) { unsigned w = 0u;
#pragma unroll
        for (int i = 0; i < 4; ++i) w |= ((unsigned)((int)__builtin_rintf(o[4 * hh + i] * qs) & 0xff)) << (8 * i);
        w2[hh] = w; }
    *reinterpret_cast<u32x2*>(dst) = (u32x2){w2[0], w2[1]};
    if (lane == 0) *sc = am * (1.0f / 127.0f);
}
__device__ __forceinline__ void wu_int8(KParams& p, int l) {
    unsigned char* ws = optr(gp(p.ws)); const int lane = otid() & 63;
    for (int r = gwave(); r < 3072 + 4096; r += nwaves()) { const bool kv = r >= 3072; const int rr = kv ? r - 3072 : r;
        const bf16_t* src = kv ? (const bf16_t*)(ws + WS_WUKV) + ((long)l * 4096 + rr) * 512 : (const bf16_t*)(ws + WS_WUQ) + ((long)l * 3072 + rr) * 512;
        float f[8]; unpack8(*reinterpret_cast<const u32x4*>(src + 8 * lane), f);
        quant_row8(f, ws + (kv ? WS_WUKV8 : WS_WUQ8) + (long)rr * 512 + 8 * lane, (float*)(ws + (kv ? WS_SBK : WS_SBQ)) + rr, lane); }
}

__device__ __forceinline__ void post_win(KParams& p, int l) {
    const int lane = otid() & 63; unsigned char* ws = optr(gp(p.ws));
    bf16_t* Y = (bf16_t*)(ws + WS_Y); bf16_t* CQN = (bf16_t*)(ws + WS_CQN); bf16_t* CKVNP = (bf16_t*)(ws + WS_CKVNP); bf16_t* KRP = (bf16_t*)(ws + WS_KRP); bf16_t* CKA = (bf16_t*)(ws + WS_CKA); bf16_t* CKT = (bf16_t*)(ws + WS_CKT);
    const float* T64 = (const float*)(ws + WS_TAB64); const float* T128 = (const float*)(ws + WS_TAB128);
    for (int t = gwave(); t < T; t += nwaves()) {
        bf16_t* y = Y + (long)t * INWP; const int pos = tok_pos(t); const bool samp = t >= TP; const int ts = t - TP, b = ts >> 6, s = ts & 63;
        { float f[8], o[8]; unpack8(*reinterpret_cast<const u32x4*>(y + C_CQ + 8 * lane), f); float ss = 0.f;
#pragma unroll
          for (int j = 0; j < 8; ++j) ss += f[j] * f[j];
          ss = wave_sum(ss); const float rinv = rsqrtf(ss * (1.0f / 512.f) + EPS); const float* g = gp(p.g_q) + (long)l * 512 + 8 * lane;
#pragma unroll
          for (int j = 0; j < 8; ++j) o[j] = f[j] * rinv * g[j];
          quant_row8(o, (unsigned char*)CQN + (long)t * 512 + 8 * lane, (float*)(ws + WS_SAQ) + t, lane); }
        { float f[8], o[8]; unpack8(*reinterpret_cast<const u32x4*>(y + C_CKV + 8 * lane), f); float ss = 0.f;
#pragma unroll
          for (int j = 0; j < 8; ++j) ss += f[j] * f[j];
          ss = wave_sum(ss); const float rinv = rsqrtf(ss * (1.0f / 512.f) + EPS); const float* g = gp(p.g_kv) + (long)l * 512 + 8 * lane;
#pragma unroll
          for (int j = 0; j < 8; ++j) o[j] = f[j] * rinv * g[j];
          float* od = gp(p.out) + (samp ? O_CKVS + ((long)l * TS + ts) * 512 : O_CKVP + ((long)l * TP + t) * 512) + 8 * lane;
          *reinterpret_cast<f32x4*>(od) = (f32x4){o[0], o[1], o[2], o[3]}; *reinterpret_cast<f32x4*>(od + 4) = (f32x4){o[4], o[5], o[6], o[7]};
          const u32x4 w = pack8(o);
          if (!samp) quant_row8(o, (unsigned char*)CKVNP + (long)t * 512 + 8 * lane, (float*)(ws + WS_SAK) + t, lane);
          else { *reinterpret_cast<u32x4*>(CKA + ((long)b * KPAD + PAST + s) * QLD + 8 * lane) = w;
#pragma unroll
              for (int j = 0; j < 8; ++j) CKT[((long)b * 512 + 8 * lane + j) * KPAD + PAST + s] = f2bf(o[j]); } }
        if (lane < 32) { const float x1 = bf2f(y[C_KR + lane]), x2 = bf2f(y[C_KR + 32 + lane]); const float c = T64[((long)pos * 32 + lane) * 2], sn = T64[((long)pos * 32 + lane) * 2 + 1];
            const float o1 = x1 * c - x2 * sn, o2 = x1 * sn + x2 * c;
            float* od = gp(p.out) + (samp ? O_KRS + ((long)l * TS + ts) * 64 : O_KRP + ((long)l * TP + t) * 64); od[lane] = o1; od[32 + lane] = o2;
            if (!samp) { KRP[(long)t * 64 + lane] = f2bf(o1); KRP[(long)t * 64 + 32 + lane] = f2bf(o2); }
            else { bf16_t* d = CKA + ((long)b * KPAD + PAST + s) * QLD + 512; d[lane] = f2bf(o1); d[32 + lane] = f2bf(o2); } }
        { const int hh = lane >> 3, d0 = (lane & 7) * 8; const float* cs = T128 + ((long)pos * 64 + d0) * 2; float cv[8], sv[8];
#pragma unroll
          for (int j = 0; j < 4; ++j) { const f32x4 q = *reinterpret_cast<const f32x4*>(cs + 4 * j); cv[2 * j] = q[0]; sv[2 * j] = q[1]; cv[2 * j + 1] = q[2]; sv[2 * j + 1] = q[3]; }
#pragma unroll
          for (int which = 0; which < 2; ++which) { bf16_t* base = y + (which ? C_RK : C_RQ) + hh * 128 + d0; const float sca = which ? 0.08838834764831845f : 1.0f;
              float a[8], bq[8], o1[8], o2[8]; unpack8(*reinterpret_cast<const u32x4*>(base), a); unpack8(*reinterpret_cast<const u32x4*>(base + 64), bq);
#pragma unroll
              for (int j = 0; j < 8; ++j) { o1[j] = (a[j] * cv[j] - bq[j] * sv[j]) * sca; o2[j] = (a[j] * sv[j] + bq[j] * cv[j]) * sca; }
              *reinterpret_cast<u32x4*>(base) = pack8(o1); *reinterpret_cast<u32x4*>(base + 64) = pack8(o2); } }
    }
}

__device__ __forceinline__ void post_q(KParams& p) {
    const int lane = otid() & 63; unsigned char* ws = optr(gp(p.ws)); bf16_t* Q = (bf16_t*)(ws + WS_Q); bf16_t* QL = (bf16_t*)(ws + WS_QL); const float* T64 = (const float*)(ws + WS_TAB64);
    for (int t = gwave(); t < T; t += nwaves()) { const int pos = tok_pos(t); const int hd = lane >> 2, d0 = (lane & 3) * 8;
        bf16_t* base = Q + (long)t * 3072 + hd * 192 + 128 + d0; const float* cs = T64 + ((long)pos * 32 + d0) * 2; float cv[8], sv[8];
#pragma unroll
        for (int j = 0; j < 4; ++j) { const f32x4 q = *reinterpret_cast<const f32x4*>(cs + 4 * j); cv[2 * j] = q[0]; sv[2 * j] = q[1]; cv[2 * j + 1] = q[2]; sv[2 * j + 1] = q[3]; }
        float a[8], bq[8], o1[8], o2[8]; unpack8(*reinterpret_cast<const u32x4*>(base), a); unpack8(*reinterpret_cast<const u32x4*>(base + 32), bq);
#pragma unroll
        for (int j = 0; j < 8; ++j) { o1[j] = a[j] * cv[j] - bq[j] * sv[j]; o2[j] = a[j] * sv[j] + bq[j] * cv[j]; }
        const u32x4 w1 = pack8(o1), w2 = pack8(o2);
        *reinterpret_cast<u32x4*>(base) = w1; *reinterpret_cast<u32x4*>(base + 32) = w2;
        if (t >= TP) { const int ts = t - TP, b = ts >> 6, s = ts & 63; bf16_t* d = QL + ((long)b * 1024 + hd * 64 + s) * QLD + 512 + d0;
            *reinterpret_cast<u32x4*>(d) = w1; *reinterpret_cast<u32x4*>(d + 32) = w2; } }
}

__device__ __forceinline__ void softmax_rows(KParams& p) {
    const int lane = otid() & 63; unsigned char* ws = optr(gp(p.ws)); bf16_t* SP = (bf16_t*)(ws + WS_SP);
    for (int r = gwave(); r < DB * 1024; r += nwaves()) { bf16_t* row = SP + (long)r * KPAD; float v[5][8]; float mx = -3.0e38f;
#pragma unroll
        for (int j = 0; j < 5; ++j) { const int ch = lane + 64 * j;
            if (ch < KALL / 8) { unpack8(*reinterpret_cast<const u32x4*>(row + ch * 8), v[j]);
#pragma unroll
                for (int i = 0; i < 8; ++i) { v[j][i] *= MLA_SCALE; mx = fmaxf(mx, v[j][i]); } }
            else {
#pragma unroll
                for (int i = 0; i < 8; ++i) v[j][i] = -3.0e38f; } }
        mx = wave_max(mx); float sum = 0.f;
#pragma unroll
        for (int j = 0; j < 5; ++j) { const int ch = lane + 64 * j;
#pragma unroll
            for (int i = 0; i < 8; ++i) { v[j][i] = (ch < KALL / 8) ? __expf(v[j][i] - mx) : 0.f; sum += v[j][i]; } }
        sum = wave_sum(sum); const float inv = 1.0f / sum;
#pragma unroll
        for (int j = 0; j < 5; ++j) { const int ch = lane + 64 * j;
            if (ch < KPAD / 8) { float o[8];
#pragma unroll
                for (int i = 0; i < 8; ++i) o[i] = v[j][i] * inv;
                *reinterpret_cast<u32x4*>(row + ch * 8) = pack8(o); } } }
}

__device__ __forceinline__ void gnorm_gate(KParams& p, int w0, int nw) {
    const int lane = otid() & 63; unsigned char* ws = optr(gp(p.ws)); const bf16_t* OB = (const bf16_t*)(ws + WS_OB); const bf16_t* Y = (const bf16_t*)(ws + WS_Y);
    for (int t = w0; t < T; t += nw) { const int c0 = (lane >> 3) * 256 + (lane & 7) * 32; float x[4][8]; float s = 0.f;
#pragma unroll
        for (int i = 0; i < 4; ++i) { unpack8(*reinterpret_cast<const u32x4*>(OB + ((long)lane * T + t) * 32 + 8 * i), x[i]);
#pragma unroll
            for (int j = 0; j < 8; ++j) s += x[i][j]; }
        s += sx<1>(s); s += sx<2>(s); s += sx<4>(s); const float mu = s * (1.0f / 256.f); float q = 0.f;
#pragma unroll
        for (int i = 0; i < 4; ++i)
#pragma unroll
            for (int j = 0; j < 8; ++j) { const float d = x[i][j] - mu; q += d * d; }
        q += sx<1>(q); q += sx<2>(q); q += sx<4>(q); const float rstd = rsqrtf(q * (1.0f / 256.f) + EPS);
        float am = 0.f;
#pragma unroll
        for (int i = 0; i < 4; ++i) { float g[8]; unpack8(*reinterpret_cast<const u32x4*>(Y + (long)t * INWP + C_RG + c0 + 8 * i), g);
#pragma unroll
            for (int j = 0; j < 8; ++j) { x[i][j] = siluf_(g[j]) * (x[i][j] - mu) * rstd; am = fmaxf(am, fabsf(x[i][j])); } }
        am = wave_max(am); const float qs = am > 0.f ? 127.0f / am : 0.f; unsigned w[8];
#pragma unroll
        for (int i = 0; i < 4; ++i)
#pragma unroll
            for (int hh = 0; hh < 2; ++hh) { unsigned v = 0u;
#pragma unroll
                for (int j = 0; j < 4; ++j) v |= ((unsigned)((int)__builtin_rintf(x[i][4 * hh + j] * qs) & 0xff)) << (8 * j);
                w[2 * i + hh] = v; }
        *reinterpret_cast<u32x4*>(ws + WS_BG + (long)t * DM + c0) = (u32x4){w[0], w[1], w[2], w[3]};
        *reinterpret_cast<u32x4*>(ws + WS_BG + (long)t * DM + c0 + 16) = (u32x4){w[4], w[5], w[6], w[7]};
        if (lane == 0) ((float*)(ws + WS_SA8))[t] = am * (1.0f / 127.0f); }
}

__device__ __forceinline__ void peer_convert(KParams& p, int l, int r0, int r1, int w0, int nw) {
    unsigned char* ws = optr(gp(p.ws)); const int lane = otid() & 63;
    const float* su = gp(p.peer_u) + (long)l * NEXP * DM; const float* sv = gp(p.peer_v) + (long)l * NEXP * DM;
    for (int r = r0 + w0; r < r1; r += nw) { const bool second = r >= NEXP; const int row = second ? r - NEXP : r; const float* s = (second ? sv : su) + (long)row * DM;
        f32x4 v[8]; float am = 0.f;
#pragma unroll
        for (int j = 0; j < 8; ++j) { v[j] = *reinterpret_cast<const f32x4*>(s + 512 * (j >> 2) * 2 + 16 * lane + 4 * (j & 3));
            am = fmaxf(am, fmaxf(fmaxf(fabsf(v[j][0]), fabsf(v[j][1])), fmaxf(fabsf(v[j][2]), fabsf(v[j][3])))); }
        am = wave_max(am);
        float sc = 1.0f, isc = 1.0f;
        if (am > 0.f) { const int e = (int)((__float_as_uint(am) >> 23) & 0xffu) - 127;
            int k = 7 - e; k = k > 100 ? 100 : (k < -100 ? -100 : k);
            sc = __uint_as_float((unsigned)(127 + k) << 23); isc = __uint_as_float((unsigned)(127 - k) << 23); }
        unsigned w[8];
        if (!second) {
            const float qs = am > 0.f ? 127.0f / am : 0.f; isc = am * (1.0f / 127.0f);
#pragma unroll
            for (int j = 0; j < 8; ++j) w[j] = ((unsigned)((int)__builtin_rintf(v[j][0] * qs) & 0xff)) | (((unsigned)((int)__builtin_rintf(v[j][1] * qs) & 0xff)) << 8) | (((unsigned)((int)__builtin_rintf(v[j][2] * qs) & 0xff)) << 16) | (((unsigned)((int)__builtin_rintf(v[j][3] * qs) & 0xff)) << 24);
        } else {
#pragma unroll
            for (int j = 0; j < 8; ++j) { int pk = __builtin_amdgcn_cvt_pk_fp8_f32(v[j][0] * sc, v[j][1] * sc, 0, false); pk = __builtin_amdgcn_cvt_pk_fp8_f32(v[j][2] * sc, v[j][3] * sc, pk, true); w[j] = (unsigned)pk; } }
        if (!second) {
            unsigned char* dst = ws + WS_PU + ((long)(lane >> 3) * NEXP + row) * 128 + 16 * (lane & 7);
            *reinterpret_cast<u32x4*>(dst) = (u32x4){w[0], w[1], w[2], w[3]};
            *reinterpret_cast<u32x4*>(dst + 8L * NEXP * 128) = (u32x4){w[4], w[5], w[6], w[7]};
        } else {
            unsigned char* dst = ws + WS_PV + ((long)(2 * lane) * NEXP + row) * 8;
            *reinterpret_cast<u32x2*>(dst) = (u32x2){w[0], w[1]}; *reinterpret_cast<u32x2*>(dst + (long)NEXP * 8) = (u32x2){w[2], w[3]};
            *reinterpret_cast<u32x2*>(dst + 128L * NEXP * 8) = (u32x2){w[4], w[5]}; *reinterpret_cast<u32x2*>(dst + 129L * NEXP * 8) = (u32x2){w[6], w[7]}; }
        if (lane == 0) ((float*)(ws + (second ? WS_PSV : WS_PSU)))[row] = isc; }
}

__device__ __forceinline__ void final_norm(KParams& p) {
    const int lane = otid() & 63; float* X = gp(p.out);
    for (int t = gwave(); t < T; t += nwaves()) { float* xr = X + (long)t * DM; f32x4 v[8]; float ss = 0.f;
#pragma unroll
        for (int j = 0; j < 8; ++j) { v[j] = *reinterpret_cast<const f32x4*>(xr + 256 * j + 4 * lane); ss += v[j][0] * v[j][0] + v[j][1] * v[j][1] + v[j][2] * v[j][2] + v[j][3] * v[j][3]; }
        ss = wave_sum(ss); const float rinv = rsqrtf(ss * (1.0f / DM) + EPS);
#pragma unroll
        for (int j = 0; j < 8; ++j) { const int c = 256 * j + 4 * lane; const f32x4 gv = *reinterpret_cast<const f32x4*>(gp(p.g_final) + c); *reinterpret_cast<f32x4*>(xr + c) = v[j] * rinv * gv; } }
}
}
__global__ void __launch_bounds__(512, 2) mega_fwd(Params p_by_value_unused) {
    extern __shared__ __attribute__((aligned(16))) unsigned char shm[];
    LAS unsigned char* lds = (LAS unsigned char*)shm; char* ldsg = (char*)shm;
    if (threadIdx.x < 8) ((LAS unsigned*)(lds + LDS_BARW))[threadIdx.x] = 0u;
    __syncthreads();
    if (threadIdx.x == 0) { unsigned* tk = (unsigned*)(gp(KP.ws) + WS_CTL + CTL_RANK) + 64 * xb_xcc_id(); ((volatile LAS unsigned*)(lds + LDS_BARW))[2] = xb_add(tk, 1u); }
    const XcdBarrier bar = xcd_barrier_post((unsigned*)(gp(KP.ws) + WS_CTL), (volatile LAS unsigned*)(lds + LDS_BARW));
#define GRID_SYNC() xcd_barrier(bar)
#ifndef STOP_AT
#define STOP_AT 0
#endif
#ifdef DBG_DUMP
#define STOPCHK(n) do { if (STOP_AT == (n)) { float* xo = gp(KP.out); const bf16_t* src = (const bf16_t*)(gp(KP.ws) + DBG_DUMP); for (long i = ph::gthread(); i < (long)T * DM; i += ph::nthreads()) xo[i] = bf2f(src[i]); return; } } while (0)
#elif defined(DBG_SANITIZE)
#define STOPCHK(n) do { if (STOP_AT == (n) || (STOP_AT > 100 && l == 1 && STOP_AT - 100 == (n))) { float* xo = gp(KP.out); for (long i = ph::gthread(); i < (long)T * DM; i += ph::nthreads()) { const float v = xo[i]; if (!(v - v == 0.0f)) xo[i] = 7.0f; } return; } } while (0)
#else
#define STOPCHK(n) do { if (STOP_AT == (n) || (STOP_AT > 100 && l == 1 && STOP_AT - 100 == (n))) return; } while (0)
#endif
    using namespace pg8;
#define WSP(off) ((bf16_t*)(optr(gp(KP.ws)) + (off)))
#define H WSP(WS_H)
#define Y WSP(WS_Y)
#define CQN WSP(WS_CQN)
#define CKVNP WSP(WS_CKVNP)
#define KRP WSP(WS_KRP)
#define Q WSP(WS_Q)
#define YA WSP(WS_YA)
#define KV WSP(WS_KV)
#define SP WSP(WS_SP)
#define MIX WSP(WS_MIX)
#define OA WSP(WS_OA)
#define QP WSP(WS_QP)
#define CKA WSP(WS_CKA)
#define CKT WSP(WS_CKT)
#define QL WSP(WS_QL)
#define OL WSP(WS_OL)
#define BG WSP(WS_BG)
    int l = 0;
    ph::prologue(KP, ldsg);
#ifdef DUP_PRO
    ph::prologue(KP, ldsg);
#endif
    GRID_SYNC(); STOPCHK(1);
    if (threadIdx.x == 0) { unsigned* barw = (unsigned*)(gp(KP.ws) + WS_CTL); const unsigned me = xb_xcc_id(); unsigned nx = 0, xi = 0, nloc = 1;
        for (unsigned j = 0; j < 16; ++j) { const unsigned cn = xb_ld(&barw[XB_XCNT(j)]); if (cn) { if (j < me) ++xi; ++nx; } if (j == me) nloc = cn ? cn : 1u; }
        volatile LAS unsigned* iw = (volatile LAS unsigned*)(lds + LDS_BARW); iw[3] = xi; iw[4] = nx; iw[5] = nloc; }
    __syncthreads();
    ph::ada_reduce(KP);
    ph::wpq_int8(KP);
    GRID_SYNC(); STOPCHK(2);
    for (l = 0; l < DEPTH; ++l) {
#define WIN (WSP(WS_WIN) + (long)l * INWP * DM)
#define WUQ (WSP(WS_WUQ) + (long)l * 3072 * 512)
#define WUKV (WSP(WS_WUKV) + (long)l * 4096 * 512)
#define WUK (WSP(WS_WUK) + (long)l * 16 * 512 * 256)
#define WA (WSP(WS_WA) + (long)l * DM * DM)
#define WB (WSP(WS_WB) + (long)l * DM * DM)
#define WO (WSP(WS_WO) + (long)l * DM * DM)
#define WPQ (WSP(WS_WPQ) + (long)l * DM * DM)
#define ADA ((const float*)(optr(gp(KP.ws)) + WS_ADA) + (long)l * NCOND * 12288)
        ph::modulate(KP, l, 0);
        ph::win_int8(KP, l);
        ph::wb_int8(KP, l);
        ph::wu_int8(KP, l);
        ph::rows2048_int8(KP, WS_WA + (size_t)l * DM * DM * 2, WS_WA8, WS_SBA, DM);
        ph::rows2048_int8(KP, WS_WO + (size_t)l * DM * DM * 2, WS_WO8, WS_SBO, DM);
        ph::cache_convert(KP, l, ldsg, l == 0 ? 0 : 4096, 8192, obid(), ogrid());
        GRID_SYNC(); STOPCHK(3);
        { Sched<5> S; S.init(T / 256, INWP / 256 - NB8, (T / 256) * (INWP / 256 - NB8), DM, DM); gemm_phase(lds, Gemm{H, WIN, DM, DM, DM}, S, EpiBf16{Y, INWP, 0}); }
        { Sched<6> S; S.init(T / 256, NB8, (T / 256) * NB8, DM / 2, DM / 2);
          { const int G_ = ogrid(); S.rotate((((((T / 256) * NB8) % G_) + 7) & ~7) % G_); }
          unsigned char* ws8 = optr(gp(KP.ws));
          gemm_phase<EpiQ8, Sched<6>, true>(lds, Gemm{(const bf16_t*)(ws8 + WS_H8), (const bf16_t*)(ws8 + WS_WIN8), DM / 2, DM / 2, DM / 2}, S, EpiQ8{Y, INWP, (const float*)(ws8 + WS_SA8), (const float*)(ws8 + WS_SBW)}); }
#ifdef DUP_WIN
        { Sched<0> S; S.init(T / 256, INWP / 256, (T / 256) * (INWP / 256), DM, DM); gemm_phase(lds, Gemm{H, WIN, DM, DM, DM}, S, EpiBf16{Y, INWP, 0}); }
#endif
        GRID_SYNC(); STOPCHK(4);
        ph::post_win(KP, l);
        GRID_SYNC(); STOPCHK(5);
        { unsigned char* ws8 = optr(gp(KP.ws));
          { Sched<0> S; S.init(T / 256, 3072 / 256, (T / 256) * 12, 256, 256); gemm_phase<EpiQ, Sched<0>, 2>(lds, Gemm{CQN, (const bf16_t*)(ws8 + WS_WUQ8), 256, 256, 256, (const float*)(ws8 + WS_SAQ), (const float*)(ws8 + WS_SBQ)}, S, EpiQ{Q, QL, (const float*)(ws8 + WS_TAB64)}); }
          { Sched<0> S; S.init(TP / 256, 4096 / 256, (TP / 256) * 16, 256, 256); gemm_phase<EpiBf16, Sched<0>, 2>(lds, Gemm{CKVNP, (const bf16_t*)(ws8 + WS_WUKV8), 256, 256, 256, (const float*)(ws8 + WS_SAK), (const float*)(ws8 + WS_SBK)}, S, EpiBf16{KV, 4096, 0}); } }
        GRID_SYNC(); STOPCHK(6);
#ifndef DUP_ATTN
#define DUP_ATTN 1
#endif
#ifndef DUP_RET
#define DUP_RET 1
#endif
#ifndef DUP_GATHER
#define DUP_GATHER 0
#endif
#pragma unroll 1
        for (int rep_ = 0; rep_ < DUP_ATTN; ++rep_)
        { for (int u = obid(); u < 512; u += ogrid()) { const int c = u & 255, i = u >> 8, xcd = c & 7, slot = c >> 3; const int bh = xcd * 4 + (slot >> 3) + 32 * i, pr = slot & 7, b = bh >> 4, h = bh & 15;
#pragma unroll 1
              for (int z = 0; z < 2; ++z) { const int qb = z ? 15 - pr : pr; const long tok0 = (long)b * SEQ + 256 * qb;
                  att::attn_block(Q + tok0 * 3072 + h * 192, KV + (long)b * SEQ * 4096 + h * 256, KRP + (long)b * SEQ * 64, KV + (long)b * SEQ * 4096 + h * 256 + 128, OA + tok0 * DM + h * 128, qb, ldsg); } } }
        { Sched<1> S; S.init(0, 0, 256, 3072, 256); gemm_phase(lds, Gemm{Q, WUK, 256, 3072, 256}, S, EpiRowMap<1>{QL, nullptr}); }
        GRID_SYNC(); STOPCHK(8);
        { Sched<2> S; S.init(0, 0, DB * 36, QLD, QLD); gemm_phase(lds, Gemm{QL, CKA, QLD, QLD, QLD}, S, EpiExp{SP, (float*)(optr(gp(KP.ws)) + WS_CTL + CTL_RSUM) + (long)l * 32768}); }
        GRID_SYNC(); STOPCHK(9);
        { Sched<3> S; S.init(0, 0, 256, KPAD, KPAD); gemm_phase(lds, Gemm{SP, CKT, 2176, KPAD, KPAD}, S, EpiRowMap<3>{OL, (const float*)(optr(gp(KP.ws)) + WS_CTL + CTL_RSUM) + (long)l * 32768}); }
        GRID_SYNC(); STOPCHK(11);
        { Sched<4> S; S.init(0, 0, 128, 512, 512); gemm_phase(lds, Gemm{OL, WUKV, 512, 512, 512}, S, EpiOV{OA}); }
#pragma unroll 1
        for (int rep_ = 0; rep_ < DUP_RET; ++rep_)
        for (int u = obid(); u < 256 + DB * 64; u += ogrid()) ret::unit(KP, l, u, ldsg);
#ifdef DUP_RETP
        for (int u = obid(); u < 256; u += ogrid()) ret::unit(KP, l, u, ldsg);
#endif
        GRID_SYNC(); STOPCHK(12);
        ph::rows2048_int8(KP, WS_OA, WS_OA8, WS_SAO, T);
        GRID_SYNC();
        { Sched<0> S; S.init(T / 256, DM / 256, (T / 256) * 8, DM / 2, DM / 2); unsigned char* ws8 = optr(gp(KP.ws));
          gemm_phase<EpiBf16, Sched<0>, 2>(lds, Gemm{(const bf16_t*)(ws8 + WS_OA8), (const bf16_t*)(ws8 + WS_WA8), DM / 2, DM / 2, DM / 2, (const float*)(ws8 + WS_SAO), (const float*)(ws8 + WS_SBA)}, S, EpiBf16{YA, DM, 0}); }
        { const int G_ = ogrid(), rem_ = ((T / 256) * 8) % G_; const int b_ = obid();
          if (rem_ == 0) ph::gnorm_gate(KP, ph::gwave(), ph::nwaves());
          else if (b_ >= rem_) ph::gnorm_gate(KP, (b_ - rem_) * 8 + (otid() >> 6), (G_ - rem_) * 8); }
#ifdef DUP_WA
#pragma unroll 1
        for (int rep_ = 0; rep_ < DUP_WA; ++rep_)
        { Sched<0> S; S.init(T / 256, DM / 256, (T / 256) * 8, DM, DM); gemm_phase(lds, Gemm{OA, WA, DM, DM, DM}, S, EpiBf16{YA, DM, 0}); }
#endif
        GRID_SYNC(); STOPCHK(14);
        { Sched<0> S; S.init(T / 256, DM / 256, (T / 256) * 8, DM / 2, DM / 2); unsigned char* ws8 = optr(gp(KP.ws));
          gemm_phase<EpiMix, Sched<0>, true>(lds, Gemm{(const bf16_t*)(ws8 + WS_BG), (const bf16_t*)(ws8 + WS_WB8), DM / 2, DM / 2, DM / 2}, S, EpiMix{Y, YA, MIX, (const float*)(ws8 + WS_SA8), (const float*)(ws8 + WS_SBB)}); }
        { const int G_ = ogrid(), rem_ = ((T / 256) * 8) % G_; const int b_ = obid();
          if (rem_ == 0) ph::peer_convert(KP, l, 0, NEXP, ph::gwave(), ph::nwaves());
          else if (b_ >= rem_) ph::peer_convert(KP, l, 0, NEXP, (b_ - rem_) * 8 + (otid() >> 6), (G_ - rem_) * 8); }
        GRID_SYNC(); STOPCHK(15);
        ph::rows2048_int8(KP, WS_MIX, WS_MIX8, WS_SA8, T);
        GRID_SYNC();
        { Sched<0> S; S.init(T / 256, DM / 256, (T / 256) * 8, DM / 2, DM / 2); unsigned char* ws8 = optr(gp(KP.ws));
          gemm_phase<EpiRes, Sched<0>, 2>(lds, Gemm{(const bf16_t*)(ws8 + WS_MIX8), (const bf16_t*)(ws8 + WS_WO8), DM / 2, DM / 2, DM / 2, (const float*)(ws8 + WS_SA8), (const float*)(ws8 + WS_SBO)}, S, EpiRes{gp(KP.out), ADA + 2 * DM, l == 0 ? gp(KP.x_prompt) : gp(KP.out), l == 0 ? gp(KP.x_sample) : gp(KP.out) + (long)TP * DM}); }
        { const int G_ = ogrid(), rem_ = ((T / 256) * 8) % G_; const int b_ = obid();
          if (rem_ == 0) ph::peer_convert(KP, l, NEXP, 2 * NEXP, ph::gwave(), ph::nwaves());
          else if (b_ >= rem_) ph::peer_convert(KP, l, NEXP, 2 * NEXP, (b_ - rem_) * 8 + (otid() >> 6), (G_ - rem_) * 8); }
        GRID_SYNC(); STOPCHK(16);
        ph::modulate(KP, l, 1);
        GRID_SYNC(); STOPCHK(17);
        { Sched<0> S; S.init(T / 256, DM / 256, (T / 256) * 8, DM / 2, DM / 2);
          unsigned char* ws8 = optr(gp(KP.ws));
          gemm_phase<EpiQ8, Sched<0>, true>(lds, Gemm{(const bf16_t*)(ws8 + WS_H8), (const bf16_t*)(ws8 + WS_WPQ8 + (long)l * DM * DM), DM / 2, DM / 2, DM / 2}, S, EpiQ8{QP, DM, (const float*)(ws8 + WS_SA8), (const float*)(ws8 + WS_SB8) + (long)l * DM});
#ifdef DUP_WPQ
          gemm_phase<EpiQ8, Sched<0>, true>(lds, Gemm{(const bf16_t*)(ws8 + WS_H8), (const bf16_t*)(ws8 + WS_WPQ8 + (long)l * DM * DM), DM / 2, DM / 2, DM / 2}, S, EpiQ8{QP, DM, (const float*)(ws8 + WS_SA8), (const float*)(ws8 + WS_SB8) + (long)l * DM});
#endif
        }
        if (l + 1 < DEPTH) { const int G_ = ogrid(), rem_ = ((T / 256) * 8) % G_; const int b_ = obid();
          if (rem_ == 0) ph::cache_convert(KP, l + 1, ldsg, 0, 4096, b_, G_);
          else if (b_ >= rem_) ph::cache_convert(KP, l + 1, ldsg, 0, 4096, b_ - rem_, G_ - rem_); }
        GRID_SYNC(); STOPCHK(18);
        { const int tid_ = otid(); const int lane = tid_ & 63; float* strip = (float*)ldsg + tid_ * 33; unsigned char* ws = optr(gp(KP.ws));
          const bf16_t* k1g = (const bf16_t*)(ws + WS_PK1) + (long)l * 128 * 128; const bf16_t* k2g = (const bf16_t*)(ws + WS_PK2) + (long)l * 128 * 128;
          bf16_t* k1 = (bf16_t*)(ldsg + 512 * 33 * 4 + 64); bf16_t* k2 = k1 + 128 * peer::KPITCH;
          for (int i = tid_; i < 2 * 128 * 16; i += 512) { const int which = i >> 11, r = (i >> 4) & 127, ch = i & 15;
              *reinterpret_cast<u32x4*>((which ? k2 : k1) + r * peer::KPITCH + ch * 8) = *reinterpret_cast<const u32x4*>((which ? k2g : k1g) + r * 128 + ch * 8); }
          __syncthreads();
          for (int wu = ph::gwave(); wu < (T / 32) * PH; wu += ph::nwaves()) peer::select_unit(QP, k1, k2, (int*)(ws + WS_PIDX), (float*)(ws + WS_PW), (wu >> 3) * 32, wu & 7, lane, strip);
#ifdef DUP_SEL
          for (int wu = ph::gwave(); wu < (T / 32) * PH; wu += ph::nwaves()) peer::select_unit(QP, k1, k2, (int*)(ws + WS_PIDX), (float*)(ws + WS_PW), (wu >> 3) * 32, wu & 7, lane, strip);
#endif
        }
        GRID_SYNC(); STOPCHK(19);
        { const int tid_ = otid(); const int lane = tid_ & 63, wid = tid_ >> 6; unsigned char* ws = optr(gp(KP.ws));
          volatile LAS unsigned* iw = (volatile LAS unsigned*)(lds + LDS_BARW); peer::XInfo xin; xin.rank = __builtin_amdgcn_readfirstlane((int)iw[2]); xin.xi = __builtin_amdgcn_readfirstlane((int)iw[3]); xin.nx = __builtin_amdgcn_readfirstlane((int)iw[4]); xin.nloc = __builtin_amdgcn_readfirstlane((int)iw[5]);
          if (xin.nx >= 1 && xin.nx <= 8) {
              peer::upass((const unsigned char*)(ws + WS_H8), (const float*)(ws + WS_SA8), (const unsigned char*)(ws + WS_PU), (const int*)(ws + WS_PIDX), (const float*)(ws + WS_PW), (const float*)(ws + WS_PSU), (const float*)(ws + WS_PSV), (int*)(ws + WS_DOTP), (unsigned*)(ws + WS_ACT), xin, wid, lane);
              GRID_SYNC();
              int vs0_, vsn_, vse_;
              if ((256 % xin.nx) == 0) { const int spx = 256 / xin.nx; vs0_ = xin.xi * spx + xin.rank; vsn_ = xin.nloc; vse_ = (xin.xi + 1) * spx; }
              else { vs0_ = obid(); vsn_ = ogrid(); vse_ = 256; }
              peer::vpass_lds((const unsigned char*)(ws + WS_PV), (const unsigned*)(ws + WS_ACT), gp(KP.out), ADA + 5 * DM, ldsg, vs0_, vsn_, vse_, tid_);
#ifdef DUP_VP
              peer::vpass_lds((const unsigned char*)(ws + WS_PV), (const unsigned*)(ws + WS_ACT), (float*)(ws + WS_OB), ADA + 5 * DM, ldsg, vs0_, vsn_, vse_, tid_);
#endif
          } else {
              for (int t = ph::gwave(); t < T; t += ph::nwaves()) peer::gather_token((const unsigned char*)(ws + WS_H8), (const float*)(ws + WS_SA8), (const unsigned char*)(ws + WS_PU), (const unsigned char*)(ws + WS_PV), (const float*)(ws + WS_PSU), (const float*)(ws + WS_PSV), (const int*)(ws + WS_PIDX), (const float*)(ws + WS_PW), gp(KP.out), ADA + 5 * DM, t, lane);
          } }
        GRID_SYNC(); STOPCHK(20);
    }
    ph::final_norm(KP);
}

extern "C" void kernel_launch(void* const* d_in, const int* in_sizes, int n_in, void* d_out, int out_size, void* d_ws, size_t ws_size, hipStream_t stream) {
    static int grid = 0;
    if (grid == 0) {
        if (n_in != 25 || out_size != (int)O_END || ws_size < WS_END) { fprintf(stderr, "kernel_launch: shape mismatch: n_in %d out %d (want %ld) ws %zu (want >= %zu)\n", n_in, out_size, O_END, ws_size, (size_t)WS_END); grid = -1; return; }
        int dev = 0, cus = 0, per_cu = 0;
        if (hipGetDevice(&dev) != hipSuccess || hipDeviceGetAttribute(&cus, hipDeviceAttributeMultiprocessorCount, dev) != hipSuccess) { fprintf(stderr, "kernel_launch: device query failed\n"); grid = -1; return; }
        if (hipFuncSetAttribute((const void*)mega_fwd, hipFuncAttributeMaxDynamicSharedMemorySize, LDS_BYTES) != hipSuccess) { fprintf(stderr, "kernel_launch: hipFuncSetAttribute failed\n"); grid = -1; return; }
        if (hipOccupancyMaxActiveBlocksPerMultiprocessor(&per_cu, (const void*)mega_fwd, 512, LDS_BYTES) != hipSuccess || per_cu < 1) { fprintf(stderr, "kernel_launch: occupancy query says %d blocks per CU\n", per_cu); grid = -1; return; }
        grid = cus;
#ifdef FORCE_GRID
        grid = FORCE_GRID;
#endif
    }
    if (grid < 0) return;
    (void)hipMemsetAsync((char*)d_ws + WS_CTL, 0, CTL_BYTES, stream);
    Params p{};
    const float* const* in = (const float* const*)d_in;
    p.x_prompt = in[0]; p.x_sample = in[1]; p.c_prompt = in[2]; p.c_sample = in[3]; p.cache_ckv = in[4]; p.cache_krope = in[5]; p.state_ret = in[6]; p.w_ada = in[7]; p.b_ada = in[8];
    p.g_mix = in[9]; p.g_ffn = in[10]; p.w_in = in[11]; p.g_q = in[12]; p.w_uq = in[13]; p.g_kv = in[14]; p.w_ukv = in[15]; p.w_a = in[16]; p.w_b = in[17]; p.w_o = in[18]; p.w_pq = in[19];
    p.peer_k1 = in[20]; p.peer_k2 = in[21]; p.peer_u = in[22]; p.peer_v = in[23]; p.g_final = in[24];
    p.out = (float*)d_out; p.ws = (unsigned char*)d_ws;
    for (int h = 0; h < 8; ++h) p.lg[h] = (float)log1p(-pow(2.0, -5.0 - (double)h));
    p.grid = grid; p.pad_ = 0;
    hipLaunchKernelGGL(mega_fwd, dim3(grid), dim3(512), LDS_BYTES, stream, p);
    const hipError_t le = hipGetLastError();
    if (le != hipSuccess) fprintf(stderr, "kernel_launch: launch failed: %s\n", hipGetErrorName(le));
}
```
